# Optimizing an MI355X kernel written in HIP

```python
import numpy as np
import jax
import jax.numpy as jnp
from jax import lax

D_MODEL = 1024
BATCH = 2
SEQ = 8192
DEPTH = 2

HEAD_DIM = 64
D_MIX = D_MODEL
GM_GROUPS = 4
GM_WIDTH = GM_GROUPS * HEAD_DIM
GM_CHUNK = 128
NSA_HEADS = 8
NSA_KV_HEADS = 2
NSA_WIDTH = NSA_HEADS * HEAD_DIM
NSA_KV_WIDTH = NSA_KV_HEADS * HEAD_DIM
CMP_BLOCK = 32
CMP_STRIDE = 16
CMP_HIDDEN = 2 * HEAD_DIM
SLC_BLOCK = 64
N_SLC = 16
WINDOW = 512
Q_BLOCK = 128
N_BRANCH = 3
HG_HEADS = 4
HG_WIDTH = HG_HEADS * HEAD_DIM
HG_CHUNK = 64
N_GROUPS = 4
EXPERTS_PER_GROUP = 4
N_EXPERTS = N_GROUPS * EXPERTS_PER_GROUP
TOP_K = 2
D_EXPERT = 512
IN_SPLITS = (GM_WIDTH, GM_WIDTH, NSA_WIDTH) + (NSA_KV_WIDTH,) * 6 + (N_BRANCH * NSA_HEADS,) + (HG_WIDTH,) * 4
IN_COLS = 2 * GM_WIDTH + NSA_WIDTH + 6 * NSA_KV_WIDTH + N_BRANCH * NSA_HEADS + 4 * HG_WIDTH
DEEPNORM_ALPHA = (2.0 * DEPTH) ** 0.25
DEEPNORM_BETA = (8.0 * DEPTH) ** -0.25
LN_EPS = 1e-5
RMS_EPS = 1e-6
NEG_INF = -1e30
FORCE_SELECT = 1e4

kernel_name = 'hybrid_gmlp_nsa_hgrn2_hmoe_deepnorm'


def layer_norm(x, g, b):
    xf = x.astype(jnp.float32)
    mu = jnp.mean(xf, -1, keepdims=True)
    var = jnp.mean(jnp.square(xf - mu), -1, keepdims=True)
    return ((xf - mu) * lax.rsqrt(var + LN_EPS) * g + b).astype(x.dtype)


def head_rms_norm(x, gain):
    xf = x.astype(jnp.float32)
    y = xf * lax.rsqrt(jnp.mean(xf * xf, -1, keepdims=True) + RMS_EPS)
    return (y * gain.reshape(x.shape[-2], x.shape[-1])).astype(x.dtype)


def gmlp_mixer(u, v, v_gain, v_bias, w_s, b_s):
    B, T, G, dh = v.shape
    nc = T // GM_CHUNK
    v = layer_norm(v, v_gain.reshape(G, dh), v_bias.reshape(G, dh))
    causal = jnp.tril(jnp.ones((GM_CHUNK, GM_CHUNK), dtype=bool))
    w = jnp.where(causal, w_s, 0)
    vc = v.reshape(B, nc, GM_CHUNK, G, dh)
    z = jnp.einsum('gts,bcsgd->bctgd', w, vc) + b_s.T[None, None, :, :, None]
    return u * z.reshape(B, T, G, dh)


def compress_blocks(k, pos, w1, w2):
    B, T, H, dh = k.shape
    nc = (T - CMP_BLOCK) // CMP_STRIDE + 1
    idx = np.arange(nc)[:, None] * CMP_STRIDE + np.arange(CMP_BLOCK)[None, :]
    blk = k[:, idx] + pos[None, None, :, None, :]
    blk = blk.transpose(0, 3, 1, 2, 4).reshape(B, H, nc, CMP_BLOCK * dh)
    return jax.nn.gelu(blk @ w1) @ w2


def nsa_mixer(q, k_c, v_c, k_s, v_s, k_w, v_w, gates, cmp_pos, cmp_w1, cmp_w2):
    B, T, H, dh = q.shape
    Hkv = k_c.shape[2]
    G = H // Hkv
    nb = T // Q_BLOCK
    ns = T // SLC_BLOCK
    n_sel = min(N_SLC, ns)
    scale = dh ** -0.5
    kcmp = compress_blocks(k_c, cmp_pos[0], cmp_w1[0], cmp_w2[0])
    vcmp = compress_blocks(v_c, cmp_pos[1], cmp_w1[1], cmp_w2[1])
    ncmp = kcmp.shape[2]
    cmp_end = (np.arange(ncmp) * CMP_STRIDE + CMP_BLOCK - 1).astype(np.int32)
    ii = np.arange(ncmp)[:, None]
    jj = np.arange(ns)[None, :]
    overlap = jnp.asarray(((ii * CMP_STRIDE < (jj + 1) * SLC_BLOCK) &
                           (ii * CMP_STRIDE + CMP_BLOCK > jj * SLC_BLOCK)).astype(np.float32))
    ksb = k_s.transpose(0, 2, 1, 3).reshape(B, Hkv, ns, SLC_BLOCK, dh)
    vsb = v_s.transpose(0, 2, 1, 3).reshape(B, Hkv, ns, SLC_BLOCK, dh)
    kwp = jnp.pad(k_w.transpose(0, 2, 1, 3), ((0, 0), (0, 0), (WINDOW, 0), (0, 0)))
    vwp = jnp.pad(v_w.transpose(0, 2, 1, 3), ((0, 0), (0, 0), (WINDOW, 0), (0, 0)))
    qb = q.reshape(B, nb, Q_BLOCK, Hkv, G, dh).transpose(1, 0, 3, 4, 2, 5)
    gb = gates.reshape(B, nb, Q_BLOCK, Hkv, G, N_BRANCH).transpose(1, 0, 3, 4, 2, 5)
    b_idx = jnp.arange(B)[:, None, None, None]
    h_idx = jnp.arange(Hkv)[None, :, None, None]
    blk_ids = jnp.arange(ns)
    blk_start = blk_ids * SLC_BLOCK

    def block_fn(args):
        c, qc, gc = args
        t = c * Q_BLOCK + jnp.arange(Q_BLOCK)
        s = jnp.einsum('bhgqd,bhnd->bhgqn', qc, kcmp).astype(jnp.float32) * scale
        valid = cmp_end[None, :] <= t[:, None]
        p = jax.nn.softmax(jnp.where(valid, s, NEG_INF), axis=-1) * valid
        o_cmp = jnp.einsum('bhgqn,bhnd->bhgqd', p.astype(vcmp.dtype), vcmp)
        imp = jnp.einsum('bhgqn,nj->bhqj', p, overlap)
        cur = t // SLC_BLOCK
        forced = (blk_ids[None, :] == 0) | (blk_ids[None, :] == cur[:, None]) | (blk_ids[None, :] == cur[:, None] - 1)
        causal_blk = blk_start[None, :] <= t[:, None]
        imp = jnp.where(causal_blk, imp + jnp.where(forced, FORCE_SELECT, 0.0), NEG_INF)
        top_val, top_idx = lax.top_k(imp, n_sel)
        sel_ok = top_val > 0.5 * NEG_INF
        kg = ksb[b_idx, h_idx, top_idx]
        vg = vsb[b_idx, h_idx, top_idx]
        pos = top_idx[..., None] * SLC_BLOCK + jnp.arange(SLC_BLOCK)
        ok = sel_ok[..., None] & (pos <= t[None, None, :, None, None])
        s = jnp.einsum('bhgqd,bhqnld->bhgqnl', qc, kg).astype(jnp.float32) * scale
        s = jnp.where(ok[:, :, None], s, NEG_INF).reshape(B, Hkv, G, Q_BLOCK, n_sel * SLC_BLOCK)
        p = jax.nn.softmax(s, axis=-1).reshape(B, Hkv, G, Q_BLOCK, n_sel, SLC_BLOCK)
        o_slc = jnp.einsum('bhgqnl,bhqnld->bhgqd', p.astype(vg.dtype), vg)
        kwc = lax.dynamic_slice_in_dim(kwp, c * Q_BLOCK, Q_BLOCK + WINDOW, axis=2)
        vwc = lax.dynamic_slice_in_dim(vwp, c * Q_BLOCK, Q_BLOCK + WINDOW, axis=2)
        kpos = c * Q_BLOCK - WINDOW + jnp.arange(Q_BLOCK + WINDOW)
        okw = (kpos[None, :] <= t[:, None]) & (kpos[None, :] > t[:, None] - WINDOW) & (kpos[None, :] >= 0)
        s = jnp.einsum('bhgqd,bhkd->bhgqk', qc, kwc).astype(jnp.float32) * scale
        p = jax.nn.softmax(jnp.where(okw, s, NEG_INF), axis=-1)
        o_win = jnp.einsum('bhgqk,bhkd->bhgqd', p.astype(vwc.dtype), vwc)
        out = gc[..., 0:1] * o_cmp + gc[..., 1:2] * o_slc + gc[..., 2:3] * o_win
        return out.astype(qc.dtype)

    out = lax.map(block_fn, (jnp.arange(nb), qb, gb))
    return out.transpose(1, 0, 4, 2, 3, 5).reshape(B, T, H, dh)


def hgrn2_mixer(q, f_logit, i, lower_bound):
    B, T, H, dk = q.shape
    dv = i.shape[-1]
    dtype = q.dtype
    lb = lower_bound.reshape(H, dk).astype(jnp.float32)
    fl = f_logit.astype(jnp.float32)
    log_f = jnp.logaddexp(jnp.log(lb), jnp.log1p(-lb) + jax.nn.log_sigmoid(fl))
    k = (1.0 - lb) * jax.nn.sigmoid(-fl)
    nc = T // HG_CHUNK

    def chunks(a):
        return a.astype(jnp.float32).reshape(B, nc, HG_CHUNK, H, -1).transpose(1, 0, 3, 2, 4)

    causal = jnp.tril(jnp.ones((HG_CHUNK, HG_CHUNK), dtype=bool))

    def step(S, inp):
        qc, kc, ic, lfc = inp
        b = jnp.cumsum(lfc, axis=2)
        diff = b[:, :, :, None, :] - b[:, :, None, :, :]
        decay = jnp.exp(jnp.where(causal[:, :, None], diff, -jnp.inf))
        attn = jnp.einsum('bhtd,bhsd,bhtsd->bhts', qc, kc, decay)
        o = jnp.einsum('bhts,bhsv->bhtv', attn, ic) + jnp.einsum('bhtd,bhdv->bhtv', qc * jnp.exp(b), S)
        b_last = b[:, :, -1, :]
        S = jnp.exp(b_last)[..., None] * S + jnp.einsum('bhsd,bhsv->bhdv', kc * jnp.exp(b_last[:, :, None, :] - b), ic)
        return S, o

    S0 = jnp.zeros((B, H, dk, dv), jnp.float32)
    _, o = lax.scan(step, S0, (chunks(q), chunks(k), chunks(i), chunks(log_f)))
    return o.transpose(1, 0, 3, 2, 4).reshape(B, T, H, dv).astype(dtype)


def token_mixer(x, w_in, gm_v_gain, gm_v_bias, gm_w_s, gm_b_s, cmp_pos, cmp_w1, cmp_w2,
                nsa_gate_b, lower_bound, out_gain, w_out):
    B, T, _ = x.shape
    h = x @ w_in
    points = np.cumsum(IN_SPLITS)[:-1].tolist()
    (gu, gv, nq, kc, vc, ks, vs, kw, vw, ng, hq, hf, hi, hg) = jnp.split(h, points, axis=-1)

    def heads(a):
        return a.reshape(B, T, -1, HEAD_DIM)

    y_a = gmlp_mixer(heads(jax.nn.gelu(gu)), heads(jax.nn.gelu(gv)), gm_v_gain, gm_v_bias, gm_w_s, gm_b_s)
    gates = jax.nn.sigmoid(ng + nsa_gate_b).reshape(B, T, NSA_HEADS, N_BRANCH)
    y_b = nsa_mixer(heads(nq), heads(kc), heads(vc), heads(ks), heads(vs), heads(kw), heads(vw),
                    gates, cmp_pos, cmp_w1, cmp_w2)
    y_c = hgrn2_mixer(heads(hq), heads(hf), heads(hi), lower_bound)
    y = head_rms_norm(jnp.concatenate([y_a, y_b, y_c], axis=2), out_gain).reshape(B, T, D_MIX)
    n_ab = GM_WIDTH + NSA_WIDTH
    y = jnp.concatenate([y[..., :n_ab], y[..., n_ab:] * jax.nn.silu(hg)], axis=-1)
    return y @ w_out


def hier_moe(x, wg, bg, we, be, w_gate, w_up, w_down):
    B, T, D = x.shape
    xt = x.reshape(-1, D)
    pg = jax.nn.softmax((xt @ wg + bg).astype(jnp.float32), axis=-1)
    g_val, g_idx = lax.top_k(pg, 1)
    le = (xt @ we + be).astype(jnp.float32).reshape(-1, N_GROUPS, EXPERTS_PER_GROUP)
    le_sel = jnp.take_along_axis(le, g_idx[:, :, None], axis=1)[:, 0]
    pe = jax.nn.softmax(le_sel, axis=-1)
    e_val, e_idx = lax.top_k(pe, TOP_K)
    e_val = e_val / jnp.sum(e_val, -1, keepdims=True)
    within = jnp.einsum('nk,nke->ne', e_val, jax.nn.one_hot(e_idx, EXPERTS_PER_GROUP, dtype=jnp.float32))
    gate = (g_val * jax.nn.one_hot(g_idx[:, 0], N_GROUPS, dtype=jnp.float32))[:, :, None] * within[:, None, :]
    gate = gate.reshape(-1, N_EXPERTS).astype(x.dtype)
    out = jnp.zeros_like(xt)
    for e in range(N_EXPERTS):
        hdn = jax.nn.silu(xt @ w_gate[e]) * (xt @ w_up[e])
        out = out + gate[:, e:e + 1] * (hdn @ w_down[e])
    return out.reshape(B, T, D)


def setup_inputs(seed: int = 0) -> dict:
    key = jax.random.key(seed)
    ks = jax.random.split(key, 26)

    def nrm(k, shape, s):
        return jax.random.normal(k, shape, jnp.float32) * s

    L = DEPTH
    return {
        'x': nrm(ks[0], (BATCH, SEQ, D_MODEL), 1.0),
        'w_in': nrm(ks[1], (L, D_MODEL, IN_COLS), D_MODEL ** -0.5),
        'gm_v_gain': 1.0 + nrm(ks[2], (L, GM_WIDTH), 0.02),
        'gm_v_bias': nrm(ks[3], (L, GM_WIDTH), 0.02),
        'gm_w_s': nrm(ks[4], (L, GM_GROUPS, GM_CHUNK, GM_CHUNK), GM_CHUNK ** -0.5),
        'gm_b_s': 1.0 + nrm(ks[5], (L, GM_GROUPS, GM_CHUNK), 0.02),
        'cmp_pos': nrm(ks[6], (L, 2, CMP_BLOCK, HEAD_DIM), 0.1),
        'cmp_w1': nrm(ks[7], (L, 2, CMP_BLOCK * HEAD_DIM, CMP_HIDDEN), (CMP_BLOCK * HEAD_DIM) ** -0.5),
        'cmp_w2': nrm(ks[8], (L, 2, CMP_HIDDEN, HEAD_DIM), CMP_HIDDEN ** -0.5),
        'nsa_gate_b': nrm(ks[9], (L, N_BRANCH * NSA_HEADS), 0.01),
        'hg_lower': nrm(ks[10], (L, HG_WIDTH), 0.1),
        'out_gain': 1.0 + nrm(ks[11], (L, D_MIX), 0.02),
        'w_out': nrm(ks[12], (L, D_MIX, D_MODEL), D_MIX ** -0.5 * DEEPNORM_BETA),
        'ln1_g': 1.0 + nrm(ks[13], (L, D_MODEL), 0.02),
        'ln1_b': nrm(ks[14], (L, D_MODEL), 0.02),
        'router_group_w': nrm(ks[15], (L, D_MODEL, N_GROUPS), D_MODEL ** -0.5),
        'router_group_b': nrm(ks[16], (L, N_GROUPS), 0.01),
        'router_expert_w': nrm(ks[17], (L, D_MODEL, N_EXPERTS), D_MODEL ** -0.5),
        'router_expert_b': nrm(ks[18], (L, N_EXPERTS), 0.01),
        'exp_w_gate': nrm(ks[19], (L, N_EXPERTS, D_MODEL, D_EXPERT), D_MODEL ** -0.5),
        'exp_w_up': nrm(ks[20], (L, N_EXPERTS, D_MODEL, D_EXPERT), D_MODEL ** -0.5),
        'exp_w_down': nrm(ks[21], (L, N_EXPERTS, D_EXPERT, D_MODEL), D_EXPERT ** -0.5 * DEEPNORM_BETA),
        'ln2_g': 1.0 + nrm(ks[22], (L, D_MODEL), 0.02),
        'ln2_b': nrm(ks[23], (L, D_MODEL), 0.02),
    }


def reference(x, w_in, gm_v_gain, gm_v_bias, gm_w_s, gm_b_s, cmp_pos, cmp_w1, cmp_w2, nsa_gate_b,
              hg_lower, out_gain, w_out, ln1_g, ln1_b, router_group_w, router_group_b,
              router_expert_w, router_expert_b, exp_w_gate, exp_w_up, exp_w_down, ln2_g, ln2_b):
    lb_all = jnp.cumsum(jax.nn.softmax(hg_lower.astype(jnp.float32), axis=0), axis=0)
    lb_all = lb_all - lb_all[0]
    for l in range(DEPTH):
        y = token_mixer(x, w_in[l], gm_v_gain[l], gm_v_bias[l], gm_w_s[l], gm_b_s[l], cmp_pos[l],
                        cmp_w1[l], cmp_w2[l], nsa_gate_b[l], lb_all[l], out_gain[l], w_out[l])
        x = layer_norm(DEEPNORM_ALPHA * x + y, ln1_g[l], ln1_b[l])
        y = hier_moe(x, router_group_w[l], router_group_b[l], router_expert_w[l], router_expert_b[l],
                     exp_w_gate[l], exp_w_up[l], exp_w_down[l])
        x = layer_norm(DEEPNORM_ALPHA * x + y, ln2_g[l], ln2_b[l])
    return x
```

```cpp
#include <hip/hip_runtime.h>
#include <hip/hip_bf16.h>
#include <hip/hip_cooperative_groups.h>
#include <cstdio>
namespace cg = cooperative_groups;

#ifndef MK_FUSED
#define MK_FUSED 0
#endif

constexpr int T_ = 8192;
constexpr int NTOK = 16384;
constexpr int DM = 1024;
constexpr int IC = 2840;
constexpr int C_GU = 0, C_GV = 256, C_NQ = 512, C_KC = 1024, C_VC = 1152, C_KS = 1280, C_VS = 1408,
              C_KW = 1536, C_VW = 1664, C_NG = 1792, C_HQ = 1816, C_HF = 2072, C_HI = 2328, C_HG = 2584;
constexpr int NCMP = 511;
constexpr float ALPHA = 1.4142135623730951f;
constexpr float NEG_INF = -1e30f;

typedef unsigned short bf16_t;

struct P {
    const float* x; const float* w_in; const float* gm_v_gain; const float* gm_v_bias; const float* gm_w_s;
    const float* gm_b_s; const float* cmp_pos; const float* cmp_w1; const float* cmp_w2; const float* nsa_gate_b;
    const float* hg_lower; const float* out_gain; const float* w_out; const float* ln1_g; const float* ln1_b;
    const float* rg_w; const float* rg_b; const float* re_w; const float* re_b; const float* w_gate;
    const float* w_up; const float* w_down; const float* ln2_g; const float* ln2_b;
    float* out;
    bf16_t* H;
    float* Y;
    float* M;
    float* kcmp;
    float* vcmp;
    float* gbuf;
    int* list_tok;
    float* list_w;
    int* cnt;
};

__device__ __forceinline__ float bf2f(bf16_t u) { return __uint_as_float(((unsigned)u) << 16); }
__device__ __forceinline__ bf16_t f2bf(float f) {
    unsigned u = __float_as_uint(f);
    u += 0x7fffu + ((u >> 16) & 1u);
    return (bf16_t)(u >> 16);
}
__device__ __forceinline__ float gelu_t(float x) {
    float u = 0.7978845608028654f * (x + 0.044715f * x * x * x);
    return 0.5f * x * (1.f + tanhf(u));
}
__device__ __forceinline__ float sigmoidf_(float x) { return 1.f / (1.f + __expf(-x)); }
__device__ __forceinline__ float wave_max(float v) {
#pragma unroll
    for (int o = 32; o > 0; o >>= 1) v = fmaxf(v, __shfl_xor(v, o));
    return v;
}
__device__ __forceinline__ float wave_sum(float v) {
#pragma unroll
    for (int o = 32; o > 0; o >>= 1) v += __shfl_xor(v, o);
    return v;
}
__device__ __forceinline__ void wave_sync() {
    __builtin_amdgcn_fence(__ATOMIC_RELEASE, "wavefront");
    __builtin_amdgcn_wave_barrier();
    __builtin_amdgcn_fence(__ATOMIC_ACQUIRE, "wavefront");
}

template <class AF, class BF, class EF>
__device__ __forceinline__ void gemm128(int m0, int n0, int M, int N, int K, AF af, BF bf, EF ef, float* smem) {
    float* As = smem;
    float* Bs = smem + 16 * 132;
    const int tid = threadIdx.x, tx = tid & 15, ty = tid >> 4;
    float acc[8][8];
#pragma unroll
    for (int i = 0; i < 8; i++)
#pragma unroll
        for (int j = 0; j < 8; j++) acc[i][j] = 0.f;
    for (int k0 = 0; k0 < K; k0 += 16) {
#pragma unroll
        for (int i = 0; i < 8; i++) {
            int e = tid + i * 256;
            int r = e >> 4, kk = e & 15;
            float v = 0.f;
            if (m0 + r < M) v = af(m0 + r, k0 + kk);
            As[kk * 132 + r] = v;
        }
#pragma unroll
        for (int i = 0; i < 8; i++) {
            int e = tid + i * 256;
            int kk = e >> 7, c = e & 127;
            float v = 0.f;
            if (n0 + c < N) v = bf(k0 + kk, n0 + c);
            Bs[kk * 132 + c] = v;
        }
        __syncthreads();
#pragma unroll
        for (int kk = 0; kk < 16; kk++) {
            float4 a0 = *(const float4*)&As[kk * 132 + ty * 8];
            float4 a1 = *(const float4*)&As[kk * 132 + ty * 8 + 4];
            float4 b0 = *(const float4*)&Bs[kk * 132 + tx * 8];
            float4 b1 = *(const float4*)&Bs[kk * 132 + tx * 8 + 4];
            float a[8] = {a0.x, a0.y, a0.z, a0.w, a1.x, a1.y, a1.z, a1.w};
            float b[8] = {b0.x, b0.y, b0.z, b0.w, b1.x, b1.y, b1.z, b1.w};
#pragma unroll
            for (int i = 0; i < 8; i++)
#pragma unroll
                for (int j = 0; j < 8; j++) acc[i][j] = fmaf(a[i], b[j], acc[i][j]);
        }
        __syncthreads();
    }
#pragma unroll
    for (int i = 0; i < 8; i++)
#pragma unroll
        for (int j = 0; j < 8; j++) {
            int m = m0 + ty * 8 + i, n = n0 + tx * 8 + j;
            if (m < M && n < N) ef(m, n, acc[i][j]);
        }
}

__device__ void phase_inproj(const P& p, int layer, const float* xin, float* smem) {
    if (layer == 0 && blockIdx.x == 0 && threadIdx.x < 32) p.cnt[threadIdx.x] = 0;
    const float* W = p.w_in + (size_t)layer * DM * IC;
    bf16_t* H = p.H;
    const int NT = (IC + 127) / 128;
    for (int item = blockIdx.x; item < 128 * NT; item += gridDim.x) {
        int mt = item / NT, nt = item % NT;
        gemm128(mt * 128, nt * 128, NTOK, IC, DM,
                [&](int m, int k) { return xin[(size_t)m * DM + k]; },
                [&](int k, int n) { return W[(size_t)k * IC + n]; },
                [&](int m, int n, float v) { H[(size_t)m * IC + n] = f2bf(v); }, smem);
    }
}

__device__ void phase_gmlp(const P& p, int layer, float* smem) {
    float* V = smem;
    const int tid = threadIdx.x, lane = tid & 63, w = tid >> 6;
    const float* gain = p.gm_v_gain + layer * 256;
    const float* bias = p.gm_v_bias + layer * 256;
    const float* ws = p.gm_w_s + (size_t)layer * 4 * 128 * 128;
    const float* bs = p.gm_b_s + layer * 4 * 128;
    const bf16_t* H = p.H;
    for (int item = blockIdx.x; item < 512; item += gridDim.x) {
        int g = item & 3, c = (item >> 2) & 63, b = item >> 8;
        size_t tok0 = (size_t)b * T_ + (size_t)c * 128;
        __syncthreads();
        for (int i = 0; i < 32; i++) {
            int s = w * 32 + i;
            float x = bf2f(H[(tok0 + s) * IC + C_GV + g * 64 + lane]);
            float ge = gelu_t(x);
            float mu = wave_sum(ge) * (1.f / 64.f);
            float dl = ge - mu;
            float var = wave_sum(dl * dl) * (1.f / 64.f);
            V[s * 64 + lane] = dl * rsqrtf(var + 1e-5f) * gain[g * 64 + lane] + bias[g * 64 + lane];
        }
        __syncthreads();
        for (int i = 0; i < 32; i++) {
            int t = w + 4 * i;
            const float* wr = ws + ((size_t)g * 128 + t) * 128;
            float acc = 0.f;
            for (int s = 0; s <= t; s++) acc = fmaf(wr[s], V[s * 64 + lane], acc);
            acc += bs[g * 128 + t];
            float u = gelu_t(bf2f(H[(tok0 + t) * IC + C_GU + g * 64 + lane]));
            p.Y[(tok0 + t) * DM + g * 64 + lane] = u * acc;
        }
    }
}

__device__ void phase_compress(const P& p, int layer, float* smem) {
    const bf16_t* H = p.H;
    for (int item = blockIdx.x; item < 32; item += gridDim.x) {
        int which = item >> 4, mt = item & 15;
        const float* pos = p.cmp_pos + ((size_t)layer * 2 + which) * 32 * 64;
        const float* w1 = p.cmp_w1 + ((size_t)layer * 2 + which) * 2048 * 128;
        const float* w2 = p.cmp_w2 + ((size_t)layer * 2 + which) * 128 * 64;
        float* G = p.gbuf + (size_t)which * 2044 * 128;
        float* O = (which == 0 ? p.kcmp : p.vcmp);
        const int colbase = (which == 0 ? C_KC : C_VC);
        gemm128(mt * 128, 0, 2044, 128, 2048,
                [&](int r, int k) {
                    int n = r % NCMP, bh = r / NCMP;
                    int hk = bh & 1, b = bh >> 1;
                    int l = k >> 6, d = k & 63;
                    size_t tok = (size_t)b * T_ + n * 16 + l;
                    return bf2f(H[tok * IC + colbase + hk * 64 + d]) + pos[l * 64 + d];
                },
                [&](int k, int n) { return w1[(size_t)k * 128 + n]; },
                [&](int r, int n, float v) { G[(size_t)r * 128 + n] = gelu_t(v); }, smem);
        __threadfence_block();
        __syncthreads();
        gemm128(mt * 128, 0, 2044, 64, 128,
                [&](int r, int k) { return G[(size_t)r * 128 + k]; },
                [&](int k, int n) { return w2[(size_t)k * 64 + n]; },
                [&](int r, int n, float v) { O[(size_t)r * 64 + n] = v; }, smem);
    }
}

__device__ void phase_hgrn(const P& p, int layer, float* smem) {
    float* Q = smem;
    float* F = smem + 2048;
    float* K = smem + 4096;
    float* I = smem + 6144;
    const int tid = threadIdx.x, lane = tid & 63, w = tid >> 6;
    const int v = w * 16 + (lane & 15), dq = lane >> 4;
    const bf16_t* H = p.H;
    for (int item = blockIdx.x; item < 8; item += gridDim.x) {
        int h = item & 3, b = item >> 2;
        float S[16];
#pragma unroll
        for (int j = 0; j < 16; j++) S[j] = 0.f;
        for (int t0 = 0; t0 < T_; t0 += 32) {
            __syncthreads();
            for (int i = 0; i < 8; i++) {
                int e = tid + i * 256;
                int ts = e >> 6, d = e & 63;
                size_t tok = (size_t)b * T_ + t0 + ts;
                float lb = 0.f;
                if (layer == 1) {
                    float h0 = p.hg_lower[h * 64 + d], h1 = p.hg_lower[256 + h * 64 + d];
                    float mx = fmaxf(h0, h1);
                    float e0 = expf(h0 - mx), e1 = expf(h1 - mx);
                    lb = e1 / (e0 + e1);
                }
                float fl = bf2f(H[tok * IC + C_HF + h * 64 + d]);
                float sg = 1.f / (1.f + expf(-fl));
                float sgn = 1.f / (1.f + expf(fl));
                F[e] = lb + (1.f - lb) * sg;
                K[e] = (1.f - lb) * sgn;
                Q[e] = bf2f(H[tok * IC + C_HQ + h * 64 + d]);
                I[e] = bf2f(H[tok * IC + C_HI + h * 64 + d]);
            }
            __syncthreads();
            for (int ts = 0; ts < 32; ts++) {
                float iv = I[ts * 64 + v];
                float part = 0.f;
#pragma unroll
                for (int j4 = 0; j4 < 4; j4++) {
                    float4 f4 = *(const float4*)&F[ts * 64 + dq * 16 + j4 * 4];
                    float4 k4 = *(const float4*)&K[ts * 64 + dq * 16 + j4 * 4];
                    float4 q4 = *(const float4*)&Q[ts * 64 + dq * 16 + j4 * 4];
                    S[j4 * 4 + 0] = fmaf(f4.x, S[j4 * 4 + 0], k4.x * iv); part = fmaf(q4.x, S[j4 * 4 + 0], part);
                    S[j4 * 4 + 1] = fmaf(f4.y, S[j4 * 4 + 1], k4.y * iv); part = fmaf(q4.y, S[j4 * 4 + 1], part);
                    S[j4 * 4 + 2] = fmaf(f4.z, S[j4 * 4 + 2], k4.z * iv); part = fmaf(q4.z, S[j4 * 4 + 2], part);
                    S[j4 * 4 + 3] = fmaf(f4.w, S[j4 * 4 + 3], k4.w * iv); part = fmaf(q4.w, S[j4 * 4 + 3], part);
                }
                part += __shfl_xor(part, 16);
                part += __shfl_xor(part, 32);
                if (dq == 0) p.Y[((size_t)b * T_ + t0 + ts) * DM + 768 + h * 64 + v] = part;
            }
        }
    }
}

struct AttnState { float m[4], l[4], o[4]; };

__device__ __forceinline__ void attend64(AttnState& st, const float* qs, float* pl, const bf16_t* H, size_t rowbase,
                                         int tok0, int tmax, int tmin, int kcol, int vcol, int lane) {
    int tok = tok0 + lane;
    bool valid = (tok <= tmax) && (tok >= tmin);
    int tokc = tok > tmax ? tmax : tok;
    const uint4* kr = (const uint4*)(H + (rowbase + tokc) * IC + kcol);
    float s[4] = {0.f, 0.f, 0.f, 0.f};
#pragma unroll
    for (int c = 0; c < 8; c++) {
        uint4 u = kr[c];
        unsigned uu[4] = {u.x, u.y, u.z, u.w};
#pragma unroll
        for (int e = 0; e < 4; e++) {
            float k0 = __uint_as_float(uu[e] << 16), k1 = __uint_as_float(uu[e] & 0xffff0000u);
            int d = c * 8 + e * 2;
#pragma unroll
            for (int g = 0; g < 4; g++) {
                s[g] = fmaf(qs[g * 64 + d], k0, s[g]);
                s[g] = fmaf(qs[g * 64 + d + 1], k1, s[g]);
            }
        }
    }
    float pr[4], alpha[4];
#pragma unroll
    for (int g = 0; g < 4; g++) {
        float sv = valid ? s[g] * 0.125f : NEG_INF;
        float mn = fmaxf(st.m[g], wave_max(sv));
        alpha[g] = __expf(st.m[g] - mn);
        pr[g] = valid ? __expf(sv - mn) : 0.f;
        st.l[g] = st.l[g] * alpha[g] + wave_sum(pr[g]);
        st.m[g] = mn;
        st.o[g] *= alpha[g];
    }
    *(float4*)&pl[lane * 4] = make_float4(pr[0], pr[1], pr[2], pr[3]);
    wave_sync();
    int jmax = tmax - tok0; if (jmax > 63) jmax = 63;
    for (int j = 0; j <= jmax; j++) {
        float vv = bf2f(H[(rowbase + tok0 + j) * IC + vcol + lane]);
        float4 p4 = *(const float4*)&pl[j * 4];
        st.o[0] = fmaf(p4.x, vv, st.o[0]);
        st.o[1] = fmaf(p4.y, vv, st.o[1]);
        st.o[2] = fmaf(p4.z, vv, st.o[2]);
        st.o[3] = fmaf(p4.w, vv, st.o[3]);
    }
    wave_sync();
}

__device__ void phase_nsa(const P& p, int layer, float* smem) {
    const int lane = threadIdx.x & 63, w = threadIdx.x >> 6;
    float* sm = smem + w * 3328;
    float* qs = sm;
    float* S = sm + 256;
    float* PS = sm + 2304;
    float* IMP = sm + 2816;
    float* PL = sm + 2944;
    int* SEL = (int*)(sm + 3200);
    const bf16_t* H = p.H;
    const float* gate_b = p.nsa_gate_b + layer * 24;
    for (int item = blockIdx.x * 4 + w; item < 32768; item += gridDim.x * 4) {
        const int t = item & 8191, hk = (item >> 13) & 1, b = item >> 14;
        const size_t rowbase = (size_t)b * T_;
        const size_t tok = rowbase + t;
        wave_sync();
#pragma unroll
        for (int g = 0; g < 4; g++) qs[g * 64 + lane] = bf2f(H[tok * IC + C_NQ + (hk * 4 + g) * 64 + lane]);
        wave_sync();
        const float* kc = p.kcmp + (size_t)(b * 2 + hk) * NCMP * 64;
        const float* vc = p.vcmp + (size_t)(b * 2 + hk) * NCMP * 64;
        int nvalid = t >= 31 ? ((t - 31) >> 4) + 1 : 0;
        if (nvalid > NCMP) nvalid = NCMP;
        float mx[4] = {NEG_INF, NEG_INF, NEG_INF, NEG_INF};
        for (int r = 0; r * 64 < nvalid; r++) {
            int n = r * 64 + lane;
            int nc = n < nvalid ? n : nvalid - 1;
            const float4* kr = (const float4*)(kc + (size_t)nc * 64);
            float s[4] = {0.f, 0.f, 0.f, 0.f};
#pragma unroll
            for (int c = 0; c < 16; c++) {
                float4 k4 = kr[c];
#pragma unroll
                for (int g = 0; g < 4; g++) {
                    float4 q4 = *(const float4*)&qs[g * 64 + c * 4];
                    s[g] = fmaf(q4.x, k4.x, s[g]); s[g] = fmaf(q4.y, k4.y, s[g]);
                    s[g] = fmaf(q4.z, k4.z, s[g]); s[g] = fmaf(q4.w, k4.w, s[g]);
                }
            }
#pragma unroll
            for (int g = 0; g < 4; g++) {
                float sv = n < nvalid ? s[g] * 0.125f : NEG_INF;
                S[g * 512 + n] = sv;
                mx[g] = fmaxf(mx[g], sv);
            }
        }
        float ocmp[4] = {0.f, 0.f, 0.f, 0.f};
        for (int r = 0; r < 8; r++) PS[r * 64 + lane] = 0.f;
        if (nvalid > 0) {
            float sum[4] = {0.f, 0.f, 0.f, 0.f};
#pragma unroll
            for (int g = 0; g < 4; g++) mx[g] = wave_max(mx[g]);
            for (int r = 0; r * 64 < nvalid; r++) {
                int n = r * 64 + lane;
#pragma unroll
                for (int g = 0; g < 4; g++) {
                    float e = n < nvalid ? __expf(S[g * 512 + n] - mx[g]) : 0.f;
                    S[g * 512 + n] = e;
                    sum[g] += e;
                }
            }
            float inv[4];
#pragma unroll
            for (int g = 0; g < 4; g++) inv[g] = 1.f / wave_sum(sum[g]);
            for (int r = 0; r * 64 < nvalid; r++) {
                int n = r * 64 + lane;
                float ps = 0.f;
#pragma unroll
                for (int g = 0; g < 4; g++) {
                    float pv = S[g * 512 + n] * inv[g];
                    S[g * 512 + n] = pv;
                    ps += pv;
                }
                PS[n] = ps;
            }
            wave_sync();
            for (int n = 0; n < nvalid; n++) {
                float vv = vc[(size_t)n * 64 + lane];
                ocmp[0] = fmaf(S[n], vv, ocmp[0]);
                ocmp[1] = fmaf(S[512 + n], vv, ocmp[1]);
                ocmp[2] = fmaf(S[1024 + n], vv, ocmp[2]);
                ocmp[3] = fmaf(S[1536 + n], vv, ocmp[3]);
            }
        }
        wave_sync();
        const int cur = t >> 6;
        float iv[2];
#pragma unroll
        for (int q = 0; q < 2; q++) {
            int j = lane + q * 64;
            float a = 0.f;
#pragma unroll
            for (int dn = -1; dn <= 3; dn++) {
                int n = 4 * j + dn;
                if (n >= 0 && n < NCMP) a += PS[n];
            }
            bool forced = (j == 0) || (j == cur) || (j == cur - 1);
            float val = (j <= cur) ? (a + (forced ? 1e4f : 0.f)) : NEG_INF;
            iv[q] = val;
            IMP[j] = val;
        }
        wave_sync();
        int c0 = 0, c1 = 0;
        for (int jj = 0; jj < 128; jj++) {
            float xv = IMP[jj];
            c0 += (xv > iv[0]) || (xv == iv[0] && jj < lane);
            c1 += (xv > iv[1]) || (xv == iv[1] && jj < lane + 64);
        }
        bool s0 = (c0 < 16) && (iv[0] > 0.5f * NEG_INF);
        bool s1 = (c1 < 16) && (iv[1] > 0.5f * NEG_INF);
        unsigned long long m0 = __ballot(s0), m1 = __ballot(s1);
        unsigned long long lower = (lane == 0) ? 0ull : (~0ull >> (64 - lane));
        if (s0) SEL[__popcll(m0 & lower)] = lane;
        if (s1) SEL[__popcll(m0) + __popcll(m1 & lower)] = lane + 64;
        const int nsel = __popcll(m0) + __popcll(m1);
        wave_sync();
        AttnState st;
#pragma unroll
        for (int g = 0; g < 4; g++) { st.m[g] = NEG_INF; st.l[g] = 0.f; st.o[g] = 0.f; }
        for (int si = 0; si < nsel; si++) {
            int jb = SEL[si];
            attend64(st, qs, PL, H, rowbase, jb * 64, t, 0, C_KS + hk * 64, C_VS + hk * 64, lane);
        }
        float oslc[4];
#pragma unroll
        for (int g = 0; g < 4; g++) oslc[g] = st.o[g] / st.l[g];
#pragma unroll
        for (int g = 0; g < 4; g++) { st.m[g] = NEG_INF; st.l[g] = 0.f; st.o[g] = 0.f; }
        const int wstart = t - 511 > 0 ? t - 511 : 0;
        for (int tk = wstart; tk <= t; tk += 64)
            attend64(st, qs, PL, H, rowbase, tk, t, wstart, C_KW + hk * 64, C_VW + hk * 64, lane);
#pragma unroll
        for (int g = 0; g < 4; g++) {
            int hh = hk * 4 + g;
            float g0 = sigmoidf_(bf2f(H[tok * IC + C_NG + hh * 3 + 0]) + gate_b[hh * 3 + 0]);
            float g1 = sigmoidf_(bf2f(H[tok * IC + C_NG + hh * 3 + 1]) + gate_b[hh * 3 + 1]);
            float g2 = sigmoidf_(bf2f(H[tok * IC + C_NG + hh * 3 + 2]) + gate_b[hh * 3 + 2]);
            float ow = st.o[g] / st.l[g];
            p.Y[tok * DM + 256 + hh * 64 + lane] = g0 * ocmp[g] + g1 * oslc[g] + g2 * ow;
        }
    }
}

__device__ void phase_headnorm(const P& p, int layer) {
    const int lane = threadIdx.x & 63, w = threadIdx.x >> 6;
    const float* og = p.out_gain + layer * 1024;
    for (int row = blockIdx.x * 4 + w; row < NTOK; row += gridDim.x * 4) {
#pragma unroll
        for (int hd = 0; hd < 16; hd++) {
            float v = p.Y[(size_t)row * DM + hd * 64 + lane];
            float ms = wave_sum(v * v) * (1.f / 64.f);
            float y = v * rsqrtf(ms + 1e-6f) * og[hd * 64 + lane];
            if (hd >= 12) {
                float hg = bf2f(p.H[(size_t)row * IC + C_HG + (hd - 12) * 64 + lane]);
                y *= hg * sigmoidf_(hg);
            }
            p.Y[(size_t)row * DM + hd * 64 + lane] = y;
        }
    }
}

__device__ void phase_outproj(const P& p, int layer, const float* xin, float* x1, float* smem) {
    const float* W = p.w_out + (size_t)layer * DM * DM;
    const float* Y = p.Y;
    for (int item = blockIdx.x; item < 128 * 8; item += gridDim.x) {
        int mt = item >> 3, nt = item & 7;
        gemm128(mt * 128, nt * 128, NTOK, DM, DM,
                [&](int m, int k) { return Y[(size_t)m * DM + k]; },
                [&](int k, int n) { return W[(size_t)k * DM + n]; },
                [&](int m, int n, float v) { x1[(size_t)m * DM + n] = ALPHA * xin[(size_t)m * DM + n] + v; }, smem);
    }
}

__device__ void phase_ln1_route(const P& p, int layer, float* x1) {
    const int lane = threadIdx.x & 63, w = threadIdx.x >> 6;
    const float* g = p.ln1_g + layer * 1024;
    const float* bb = p.ln1_b + layer * 1024;
    const float* wg = p.rg_w + (size_t)layer * 1024 * 4;
    const float* we = p.re_w + (size_t)layer * 1024 * 16;
    const float* bg = p.rg_b + layer * 4;
    const float* be = p.re_b + layer * 16;
    int* cnt = p.cnt + layer * 16;
    for (int row = blockIdx.x * 4 + w; row < NTOK; row += gridDim.x * 4) {
        float v[16];
        float s = 0.f;
#pragma unroll
        for (int i = 0; i < 16; i++) { v[i] = x1[(size_t)row * DM + i * 64 + lane]; s += v[i]; }
        float mu = wave_sum(s) * (1.f / 1024.f);
        float q = 0.f;
#pragma unroll
        for (int i = 0; i < 16; i++) { float d = v[i] - mu; q += d * d; }
        float rstd = rsqrtf(wave_sum(q) * (1.f / 1024.f) + 1e-5f);
        float lg[4] = {0.f, 0.f, 0.f, 0.f};
        float le[16];
#pragma unroll
        for (int e = 0; e < 16; e++) le[e] = 0.f;
#pragma unroll
        for (int i = 0; i < 16; i++) {
            int c = i * 64 + lane;
            float o = (v[i] - mu) * rstd * g[c] + bb[c];
            x1[(size_t)row * DM + c] = o;
            float4 w4 = *(const float4*)&wg[c * 4];
            lg[0] = fmaf(o, w4.x, lg[0]); lg[1] = fmaf(o, w4.y, lg[1]);
            lg[2] = fmaf(o, w4.z, lg[2]); lg[3] = fmaf(o, w4.w, lg[3]);
#pragma unroll
            for (int e4 = 0; e4 < 4; e4++) {
                float4 x4 = *(const float4*)&we[c * 16 + e4 * 4];
                le[e4 * 4 + 0] = fmaf(o, x4.x, le[e4 * 4 + 0]);
                le[e4 * 4 + 1] = fmaf(o, x4.y, le[e4 * 4 + 1]);
                le[e4 * 4 + 2] = fmaf(o, x4.z, le[e4 * 4 + 2]);
                le[e4 * 4 + 3] = fmaf(o, x4.w, le[e4 * 4 + 3]);
            }
        }
#pragma unroll
        for (int c = 0; c < 4; c++) lg[c] = wave_sum(lg[c]) + bg[c];
#pragma unroll
        for (int e = 0; e < 16; e++) le[e] = wave_sum(le[e]) + be[e];
        float gm = fmaxf(fmaxf(lg[0], lg[1]), fmaxf(lg[2], lg[3]));
        float ge[4], gs = 0.f;
#pragma unroll
        for (int c = 0; c < 4; c++) { ge[c] = __expf(lg[c] - gm); gs += ge[c]; }
        int gi = 0; float gbest = ge[0];
#pragma unroll
        for (int c = 1; c < 4; c++) if (ge[c] > gbest) { gbest = ge[c]; gi = c; }
        float gval = gbest / gs;
        float ls[4];
#pragma unroll
        for (int e = 0; e < 4; e++) ls[e] = gi == 0 ? le[e] : gi == 1 ? le[4 + e] : gi == 2 ? le[8 + e] : le[12 + e];
        float em = fmaxf(fmaxf(ls[0], ls[1]), fmaxf(ls[2], ls[3]));
        float pe[4];
#pragma unroll
        for (int e = 0; e < 4; e++) pe[e] = __expf(ls[e] - em);
        int i1 = 0; float b1 = pe[0];
#pragma unroll
        for (int e = 1; e < 4; e++) if (pe[e] > b1) { b1 = pe[e]; i1 = e; }
        int i2 = -1; float b2 = -1.f;
#pragma unroll
        for (int e = 0; e < 4; e++) if (e != i1 && pe[e] > b2) { b2 = pe[e]; i2 = e; }
        float w1 = gval * b1 / (b1 + b2), w2 = gval * b2 / (b1 + b2);
        if (lane == 0) {
            int e1 = gi * 4 + i1, e2 = gi * 4 + i2;
            int p1 = atomicAdd(&cnt[e1], 1);
            p.list_tok[e1 * NTOK + p1] = row; p.list_w[e1 * NTOK + p1] = w1;
            int p2 = atomicAdd(&cnt[e2], 1);
            p.list_tok[e2 * NTOK + p2] = row; p.list_w[e2 * NTOK + p2] = w2;
        }
    }
}

__device__ __forceinline__ bool moe_item(const int* cnt, int item, int ntn, int& e, int& mt, int& nt, int& base) {
    int acc = 0, b = 0;
    for (int ee = 0; ee < 16; ee++) {
        int c = __hip_atomic_load(&cnt[ee], __ATOMIC_RELAXED, __HIP_MEMORY_SCOPE_AGENT);
        int tiles = ((c + 127) >> 7) * ntn;
        if (item < acc + tiles) {
            int li = item - acc;
            e = ee; mt = li / ntn; nt = li % ntn; base = b;
            return true;
        }
        acc += tiles; b += c;
    }
    return false;
}

__device__ void phase_moe_up(const P& p, int layer, const float* x1, float* hidden, float* accbuf, float* smem) {
    {
        float4* a4 = (float4*)accbuf;
        for (size_t i = (size_t)blockIdx.x * 256 + threadIdx.x; i < (size_t)NTOK * DM / 4; i += (size_t)gridDim.x * 256)
            a4[i] = make_float4(0.f, 0.f, 0.f, 0.f);
    }
    const int* cnt = p.cnt + layer * 16;
    for (int item = blockIdx.x;; item += gridDim.x) {
        int e, mt, nt, base;
        if (!moe_item(cnt, item, 4, e, mt, nt, base)) break;
        int c = __hip_atomic_load(&cnt[e], __ATOMIC_RELAXED, __HIP_MEMORY_SCOPE_AGENT);
        const int* lt = p.list_tok + e * NTOK;
        const float* Wg = p.w_gate + ((size_t)layer * 16 + e) * DM * 512;
        const float* Wu = p.w_up + ((size_t)layer * 16 + e) * DM * 512;
        float* hb = hidden + (size_t)base * 512;
        gemm128(mt * 128, nt * 128, c, 512, DM,
                [&](int r, int k) { return x1[(size_t)lt[r] * DM + k]; },
                [&](int k, int n) { return Wg[(size_t)k * 512 + n]; },
                [&](int r, int n, float v) { hb[(size_t)r * 512 + n] = v * sigmoidf_(v); }, smem);
        gemm128(mt * 128, nt * 128, c, 512, DM,
                [&](int r, int k) { return x1[(size_t)lt[r] * DM + k]; },
                [&](int k, int n) { return Wu[(size_t)k * 512 + n]; },
                [&](int r, int n, float v) { hb[(size_t)r * 512 + n] *= v; }, smem);
    }
}

__device__ void phase_moe_down(const P& p, int layer, const float* hidden, float* accbuf, float* smem) {
    const int* cnt = p.cnt + layer * 16;
    for (int item = blockIdx.x;; item += gridDim.x) {
        int e, mt, nt, base;
        if (!moe_item(cnt, item, 8, e, mt, nt, base)) break;
        int c = __hip_atomic_load(&cnt[e], __ATOMIC_RELAXED, __HIP_MEMORY_SCOPE_AGENT);
        const int* lt = p.list_tok + e * NTOK;
        const float* lw = p.list_w + e * NTOK;
        const float* Wd = p.w_down + ((size_t)layer * 16 + e) * 512 * DM;
        const float* hb = hidden + (size_t)base * 512;
        gemm128(mt * 128, nt * 128, c, DM, 512,
                [&](int r, int k) { return hb[(size_t)r * 512 + k]; },
                [&](int k, int n) { return Wd[(size_t)k * DM + n]; },
                [&](int r, int n, float v) { atomicAdd(&accbuf[(size_t)lt[r] * DM + n], lw[r] * v); }, smem);
    }
}

__device__ void phase_ln2(const P& p, int layer, const float* x1, const float* accbuf, float* xo) {
    const int lane = threadIdx.x & 63, w = threadIdx.x >> 6;
    const float* g = p.ln2_g + layer * 1024;
    const float* bb = p.ln2_b + layer * 1024;
    for (int row = blockIdx.x * 4 + w; row < NTOK; row += gridDim.x * 4) {
        float v[16];
        float s = 0.f;
#pragma unroll
        for (int i = 0; i < 16; i++) {
            size_t idx = (size_t)row * DM + i * 64 + lane;
            v[i] = ALPHA * x1[idx] + accbuf[idx];
            s += v[i];
        }
        float mu = wave_sum(s) * (1.f / 1024.f);
        float q = 0.f;
#pragma unroll
        for (int i = 0; i < 16; i++) { float d = v[i] - mu; q += d * d; }
        float rstd = rsqrtf(wave_sum(q) * (1.f / 1024.f) + 1e-5f);
#pragma unroll
        for (int i = 0; i < 16; i++) {
            int c = i * 64 + lane;
            xo[(size_t)row * DM + c] = (v[i] - mu) * rstd * g[c] + bb[c];
        }
    }
}

template <int PH>
__device__ __forceinline__ void run_phase(const P& p, int layer, float* smem) {
    const float* xin = layer == 0 ? p.x : p.M;
    float* x1 = p.out;
    float* xo = layer == 0 ? p.M : p.out;
    float* accbuf = (float*)p.H;
    float* hidden = p.Y;
    if (PH == 0) phase_inproj(p, layer, xin, smem);
    if (PH == 1) { phase_hgrn(p, layer, smem); phase_gmlp(p, layer, smem); __syncthreads(); phase_compress(p, layer, smem); }
    if (PH == 2) phase_nsa(p, layer, smem);
    if (PH == 3) phase_headnorm(p, layer);
    if (PH == 4) phase_outproj(p, layer, xin, x1, smem);
    if (PH == 5) phase_ln1_route(p, layer, x1);
    if (PH == 6) phase_moe_up(p, layer, x1, hidden, accbuf, smem);
    if (PH == 7) phase_moe_down(p, layer, hidden, accbuf, smem);
    if (PH == 8) phase_ln2(p, layer, x1, accbuf, xo);
}

template <int PH>
__global__ void __launch_bounds__(256) k_phase(P p, int layer) {
    __shared__ __attribute__((aligned(16))) float smem[16384];
    run_phase<PH>(p, layer, smem);
}

#if MK_FUSED
__global__ void __launch_bounds__(256) k_mega(P p) {
    __shared__ __attribute__((aligned(16))) float smem[16384];
    cg::grid_group grid = cg::this_grid();
    for (int layer = 0; layer < 2; layer++) {
        run_phase<0>(p, layer, smem); grid.sync();
        run_phase<1>(p, layer, smem); grid.sync();
        run_phase<2>(p, layer, smem); grid.sync();
        run_phase<3>(p, layer, smem); grid.sync();
        run_phase<4>(p, layer, smem); grid.sync();
        run_phase<5>(p, layer, smem); grid.sync();
        run_phase<6>(p, layer, smem); grid.sync();
        run_phase<7>(p, layer, smem); grid.sync();
        run_phase<8>(p, layer, smem);
        if (layer == 0) grid.sync();
    }
}

#endif

static inline size_t align_up(size_t v, size_t a) { return (v + a - 1) / a * a; }

extern "C" void kernel_launch(void* const* d_in, const int* in_sizes, int n_in, void* d_out, int out_size, void* d_ws,
                              size_t ws_size, hipStream_t stream) {
    P p{};
    p.x = (const float*)d_in[0]; p.w_in = (const float*)d_in[1]; p.gm_v_gain = (const float*)d_in[2];
    p.gm_v_bias = (const float*)d_in[3]; p.gm_w_s = (const float*)d_in[4]; p.gm_b_s = (const float*)d_in[5];
    p.cmp_pos = (const float*)d_in[6]; p.cmp_w1 = (const float*)d_in[7]; p.cmp_w2 = (const float*)d_in[8];
    p.nsa_gate_b = (const float*)d_in[9]; p.hg_lower = (const float*)d_in[10]; p.out_gain = (const float*)d_in[11];
    p.w_out = (const float*)d_in[12]; p.ln1_g = (const float*)d_in[13]; p.ln1_b = (const float*)d_in[14];
    p.rg_w = (const float*)d_in[15]; p.rg_b = (const float*)d_in[16]; p.re_w = (const float*)d_in[17];
    p.re_b = (const float*)d_in[18]; p.w_gate = (const float*)d_in[19]; p.w_up = (const float*)d_in[20];
    p.w_down = (const float*)d_in[21]; p.ln2_g = (const float*)d_in[22]; p.ln2_b = (const float*)d_in[23];
    p.out = (float*)d_out;
    char* ws = (char*)d_ws;
    size_t off = 0;
    p.H = (bf16_t*)(ws + off); off = align_up(off + (size_t)NTOK * IC * 2, 256);
    p.Y = (float*)(ws + off); off = align_up(off + (size_t)NTOK * DM * 4, 256);
    p.M = (float*)(ws + off); off = align_up(off + (size_t)NTOK * DM * 4, 256);
    p.kcmp = (float*)(ws + off); off = align_up(off + (size_t)4 * NCMP * 64 * 4, 256);
    p.vcmp = (float*)(ws + off); off = align_up(off + (size_t)4 * NCMP * 64 * 4, 256);
    p.gbuf = (float*)(ws + off); off = align_up(off + (size_t)2 * 2044 * 128 * 4, 256);
    p.list_tok = (int*)(ws + off); off = align_up(off + (size_t)16 * NTOK * 4, 256);
    p.list_w = (float*)(ws + off); off = align_up(off + (size_t)16 * NTOK * 4, 256);
    p.cnt = (int*)(ws + off); off = align_up(off + 256, 256);
    (void)ws_size; (void)in_sizes; (void)n_in; (void)out_size;
#if MK_FUSED
    static int grid_blocks = 0;
    if (!grid_blocks) {
        int dev = 0, cus = 0, per_cu = 0;
        hipGetDevice(&dev);
        hipDeviceGetAttribute(&cus, hipDeviceAttributeMultiprocessorCount, dev);
        hipOccupancyMaxActiveBlocksPerMultiprocessor(&per_cu, k_mega, 256, 0);
        if (per_cu > 2) per_cu = 2;
        grid_blocks = cus * per_cu;
    }
    void* args[] = {&p};
    hipError_t e = hipLaunchCooperativeKernel((void*)k_mega, dim3(grid_blocks), dim3(256), args, 0, stream);
    if (e != hipSuccess) fprintf(stderr, "cooperative launch failed: %s (grid %d)\n", hipGetErrorString(e), grid_blocks);
#else
    const int G = 1024;
    for (int layer = 0; layer < 2; layer++) {
        k_phase<0><<<G, 256, 0, stream>>>(p, layer);
        k_phase<1><<<G, 256, 0, stream>>>(p, layer);
        k_phase<2><<<G, 256, 0, stream>>>(p, layer);
        k_phase<3><<<G, 256, 0, stream>>>(p, layer);
        k_phase<4><<<G, 256, 0, stream>>>(p, layer);
        k_phase<5><<<G, 256, 0, stream>>>(p, layer);
        k_phase<6><<<G, 256, 0, stream>>>(p, layer);
        k_phase<7><<<G, 256, 0, stream>>>(p, layer);
        k_phase<8><<<G, 256, 0, stream>>>(p, layer);
    }
#endif
}
```

```cpp
#include <hip/hip_runtime.h>
#include <hip/hip_bf16.h>
#include <hip/hip_cooperative_groups.h>
#include <cstdio>
namespace cg = cooperative_groups;

#ifndef MK_FUSED
#define MK_FUSED 1
#define NPH_LIMIT 18
#endif

constexpr int T_ = 8192;
constexpr int NTOK = 16384;
constexpr int DM = 1024;
constexpr int IC = 2840;
constexpr int C_GU = 0, C_GV = 256, C_NQ = 512, C_KC = 1024, C_VC = 1152, C_KS = 1280, C_VS = 1408,
              C_KW = 1536, C_VW = 1664, C_NG = 1792, C_HQ = 1816, C_HF = 2072, C_HI = 2328, C_HG = 2584;
constexpr int NCMP = 511;
constexpr float ALPHA = 1.4142135623730951f;
constexpr float NEG_INF = -1e30f;

typedef unsigned short bf16_t;

struct P {
    const float* x; const float* w_in; const float* gm_v_gain; const float* gm_v_bias; const float* gm_w_s;
    const float* gm_b_s; const float* cmp_pos; const float* cmp_w1; const float* cmp_w2; const float* nsa_gate_b;
    const float* hg_lower; const float* out_gain; const float* w_out; const float* ln1_g; const float* ln1_b;
    const float* rg_w; const float* rg_b; const float* re_w; const float* re_b; const float* w_gate;
    const float* w_up; const float* w_down; const float* ln2_g; const float* ln2_b;
    float* out;
    bf16_t* H;
    float* Y;
    float* M;
    float* kcmp;
    float* vcmp;
    float* gbuf;
    int* list_tok;
    float* list_w;
    int* cnt;
    int nph; int pad;
};

__device__ __forceinline__ float bf2f(bf16_t u) { return __uint_as_float(((unsigned)u) << 16); }
__device__ __forceinline__ bf16_t f2bf(float f) {
    unsigned u = __float_as_uint(f);
    u += 0x7fffu + ((u >> 16) & 1u);
    return (bf16_t)(u >> 16);
}
__device__ __forceinline__ float gelu_t(float x) {
    float u = 0.7978845608028654f * (x + 0.044715f * x * x * x);
    return 0.5f * x * (1.f + tanhf(u));
}
__device__ __forceinline__ float sigmoidf_(float x) { return 1.f / (1.f + __expf(-x)); }
__device__ __forceinline__ float wave_max(float v) {
#pragma unroll
    for (int o = 32; o > 0; o >>= 1) v = fmaxf(v, __shfl_xor(v, o));
    return v;
}
__device__ __forceinline__ float wave_sum(float v) {
#pragma unroll
    for (int o = 32; o > 0; o >>= 1) v += __shfl_xor(v, o);
    return v;
}
__device__ __forceinline__ void wave_sync() {
    __builtin_amdgcn_fence(__ATOMIC_RELEASE, "wavefront");
    __builtin_amdgcn_wave_barrier();
    __builtin_amdgcn_fence(__ATOMIC_ACQUIRE, "wavefront");
}

__device__ __forceinline__ int opaque_tid() { int t = threadIdx.x; asm volatile("" : "+v"(t)); return t; }
__device__ __forceinline__ int opaque_bid() { int b = blockIdx.x; asm volatile("" : "+s"(b)); return b; }
#define PHASE_IDS const int TID = opaque_tid(); const int BID = opaque_bid(); (void)TID; (void)BID;

template <class AF, class BF, class EF>
__device__ __forceinline__ void gemm128(int tid, int m0, int n0, int M, int N, int K, AF af, BF bf, EF ef, float* smem) {
    float* As = smem;
    float* Bs = smem + 16 * 132;
    const int tx = tid & 15, ty = tid >> 4;
    float acc[8][8];
#pragma unroll
    for (int i = 0; i < 8; i++)
#pragma unroll
        for (int j = 0; j < 8; j++) acc[i][j] = 0.f;
#pragma unroll 1
    for (int k0 = 0; k0 < K; k0 += 16) {
#pragma unroll
        for (int i = 0; i < 8; i++) {
            int e = tid + i * 256;
            int r = e >> 4, kk = e & 15;
            float v = 0.f;
            if (m0 + r < M) v = af(m0 + r, k0 + kk);
            As[kk * 132 + r] = v;
        }
#pragma unroll
        for (int i = 0; i < 8; i++) {
            int e = tid + i * 256;
            int kk = e >> 7, c = e & 127;
            float v = 0.f;
            if (n0 + c < N) v = bf(k0 + kk, n0 + c);
            Bs[kk * 132 + c] = v;
        }
        __syncthreads();
#pragma unroll
        for (int kk = 0; kk < 16; kk++) {
            float4 a0 = *(const float4*)&As[kk * 132 + ty * 8];
            float4 a1 = *(const float4*)&As[kk * 132 + ty * 8 + 4];
            float4 b0 = *(const float4*)&Bs[kk * 132 + tx * 8];
            float4 b1 = *(const float4*)&Bs[kk * 132 + tx * 8 + 4];
            float a[8] = {a0.x, a0.y, a0.z, a0.w, a1.x, a1.y, a1.z, a1.w};
            float b[8] = {b0.x, b0.y, b0.z, b0.w, b1.x, b1.y, b1.z, b1.w};
#pragma unroll
            for (int i = 0; i < 8; i++)
#pragma unroll
                for (int j = 0; j < 8; j++) acc[i][j] = fmaf(a[i], b[j], acc[i][j]);
        }
        __syncthreads();
    }
#pragma unroll
    for (int i = 0; i < 8; i++)
#pragma unroll
        for (int j = 0; j < 8; j++) {
            int m = m0 + ty * 8 + i, n = n0 + tx * 8 + j;
            if (m < M && n < N) ef(m, n, acc[i][j]);
        }
}

__device__ void phase_inproj(const P& p, int layer, const float* xin, float* smem) {
    PHASE_IDS
    if (layer == 0 && BID == 0 && TID < 32) p.cnt[TID] = 0;
    const float* W = p.w_in + (size_t)layer * DM * IC;
    bf16_t* H = p.H;
    const int NT = (IC + 127) / 128;
    for (int item = BID; item < 128 * NT; item += gridDim.x) {
        int mt = item / NT, nt = item % NT;
        gemm128(TID, mt * 128, nt * 128, NTOK, IC, DM,
                [&](int m, int k) { return xin[(size_t)m * DM + k]; },
                [&](int k, int n) { return W[(size_t)k * IC + n]; },
                [&](int m, int n, float v) { H[(size_t)m * IC + n] = f2bf(v); }, smem);
    }
}

__device__ void phase_gmlp(const P& p, int layer, float* smem) {
    PHASE_IDS
    float* V = smem;
    const int tid = TID, lane = tid & 63, w = tid >> 6;
    const float* gain = p.gm_v_gain + layer * 256;
    const float* bias = p.gm_v_bias + layer * 256;
    const float* ws = p.gm_w_s + (size_t)layer * 4 * 128 * 128;
    const float* bs = p.gm_b_s + layer * 4 * 128;
    const bf16_t* H = p.H;
    for (int item = BID; item < 512; item += gridDim.x) {
        int g = item & 3, c = (item >> 2) & 63, b = item >> 8;
        size_t tok0 = (size_t)b * T_ + (size_t)c * 128;
        __syncthreads();
        for (int i = 0; i < 32; i++) {
            int s = w * 32 + i;
            float x = bf2f(H[(tok0 + s) * IC + C_GV + g * 64 + lane]);
            float ge = gelu_t(x);
            float mu = wave_sum(ge) * (1.f / 64.f);
            float dl = ge - mu;
            float var = wave_sum(dl * dl) * (1.f / 64.f);
            V[s * 64 + lane] = dl * rsqrtf(var + 1e-5f) * gain[g * 64 + lane] + bias[g * 64 + lane];
        }
        __syncthreads();
        for (int i = 0; i < 32; i++) {
            int t = w + 4 * i;
            const float* wr = ws + ((size_t)g * 128 + t) * 128;
            float acc = 0.f;
            for (int s = 0; s <= t; s++) acc = fmaf(wr[s], V[s * 64 + lane], acc);
            acc += bs[g * 128 + t];
            float u = gelu_t(bf2f(H[(tok0 + t) * IC + C_GU + g * 64 + lane]));
            p.Y[(tok0 + t) * DM + g * 64 + lane] = u * acc;
        }
    }
}

__device__ void phase_compress(const P& p, int layer, float* smem) {
    PHASE_IDS
    const bf16_t* H = p.H;
    for (int item = BID; item < 32; item += gridDim.x) {
        int which = item >> 4, mt = item & 15;
        const float* pos = p.cmp_pos + ((size_t)layer * 2 + which) * 32 * 64;
        const float* w1 = p.cmp_w1 + ((size_t)layer * 2 + which) * 2048 * 128;
        const float* w2 = p.cmp_w2 + ((size_t)layer * 2 + which) * 128 * 64;
        float* G = p.gbuf + (size_t)which * 2044 * 128;
        float* O = (which == 0 ? p.kcmp : p.vcmp);
        const int colbase = (which == 0 ? C_KC : C_VC);
        gemm128(TID, mt * 128, 0, 2044, 128, 2048,
                [&](int r, int k) {
                    int n = r % NCMP, bh = r / NCMP;
                    int hk = bh & 1, b = bh >> 1;
                    int l = k >> 6, d = k & 63;
                    size_t tok = (size_t)b * T_ + n * 16 + l;
                    return bf2f(H[tok * IC + colbase + hk * 64 + d]) + pos[l * 64 + d];
                },
                [&](int k, int n) { return w1[(size_t)k * 128 + n]; },
                [&](int r, int n, float v) { G[(size_t)r * 128 + n] = gelu_t(v); }, smem);
        __threadfence_block();
        __syncthreads();
        gemm128(TID, mt * 128, 0, 2044, 64, 128,
                [&](int r, int k) { return G[(size_t)r * 128 + k]; },
                [&](int k, int n) { return w2[(size_t)k * 64 + n]; },
                [&](int r, int n, float v) { O[(size_t)r * 64 + n] = v; }, smem);
    }
}

__device__ void phase_hgrn(const P& p, int layer, float* smem) {
    PHASE_IDS
    float* Q = smem;
    float* F = smem + 2048;
    float* K = smem + 4096;
    float* I = smem + 6144;
    const int tid = TID, lane = tid & 63, w = tid >> 6;
    const int v = w * 16 + (lane & 15), dq = lane >> 4;
    const bf16_t* H = p.H;
    for (int item = BID; item < 8; item += gridDim.x) {
        int h = item & 3, b = item >> 2;
        float S[16];
#pragma unroll
        for (int j = 0; j < 16; j++) S[j] = 0.f;
        for (int t0 = 0; t0 < T_; t0 += 32) {
            __syncthreads();
            for (int i = 0; i < 8; i++) {
                int e = tid + i * 256;
                int ts = e >> 6, d = e & 63;
                size_t tok = (size_t)b * T_ + t0 + ts;
                float lb = 0.f;
                if (layer == 1) {
                    float h0 = p.hg_lower[h * 64 + d], h1 = p.hg_lower[256 + h * 64 + d];
                    float mx = fmaxf(h0, h1);
                    float e0 = expf(h0 - mx), e1 = expf(h1 - mx);
                    lb = e1 / (e0 + e1);
                }
                float fl = bf2f(H[tok * IC + C_HF + h * 64 + d]);
                float sg = 1.f / (1.f + expf(-fl));
                float sgn = 1.f / (1.f + expf(fl));
                F[e] = lb + (1.f - lb) * sg;
                K[e] = (1.f - lb) * sgn;
                Q[e] = bf2f(H[tok * IC + C_HQ + h * 64 + d]);
                I[e] = bf2f(H[tok * IC + C_HI + h * 64 + d]);
            }
            __syncthreads();
            for (int ts = 0; ts < 32; ts++) {
                float iv = I[ts * 64 + v];
                float part = 0.f;
#pragma unroll
                for (int j4 = 0; j4 < 4; j4++) {
                    float4 f4 = *(const float4*)&F[ts * 64 + dq * 16 + j4 * 4];
                    float4 k4 = *(const float4*)&K[ts * 64 + dq * 16 + j4 * 4];
                    float4 q4 = *(const float4*)&Q[ts * 64 + dq * 16 + j4 * 4];
                    S[j4 * 4 + 0] = fmaf(f4.x, S[j4 * 4 + 0], k4.x * iv); part = fmaf(q4.x, S[j4 * 4 + 0], part);
                    S[j4 * 4 + 1] = fmaf(f4.y, S[j4 * 4 + 1], k4.y * iv); part = fmaf(q4.y, S[j4 * 4 + 1], part);
                    S[j4 * 4 + 2] = fmaf(f4.z, S[j4 * 4 + 2], k4.z * iv); part = fmaf(q4.z, S[j4 * 4 + 2], part);
                    S[j4 * 4 + 3] = fmaf(f4.w, S[j4 * 4 + 3], k4.w * iv); part = fmaf(q4.w, S[j4 * 4 + 3], part);
                }
                part += __shfl_xor(part, 16);
                part += __shfl_xor(part, 32);
                if (dq == 0) p.Y[((size_t)b * T_ + t0 + ts) * DM + 768 + h * 64 + v] = part;
            }
        }
    }
}

struct AttnState { float m[4], l[4], o[4]; };

__device__ __forceinline__ void attend64(AttnState& st, const float* qs, float* pl, const bf16_t* H, size_t rowbase,
                                         int tok0, int tmax, int tmin, int kcol, int vcol, int lane) {
    int tok = tok0 + lane;
    bool valid = (tok <= tmax) && (tok >= tmin);
    int tokc = tok > tmax ? tmax : tok;
    const uint4* kr = (const uint4*)(H + (rowbase + tokc) * IC + kcol);
    float s[4] = {0.f, 0.f, 0.f, 0.f};
#pragma unroll
    for (int c = 0; c < 8; c++) {
        uint4 u = kr[c];
        unsigned uu[4] = {u.x, u.y, u.z, u.w};
#pragma unroll
        for (int e = 0; e < 4; e++) {
            float k0 = __uint_as_float(uu[e] << 16), k1 = __uint_as_float(uu[e] & 0xffff0000u);
            int d = c * 8 + e * 2;
#pragma unroll
            for (int g = 0; g < 4; g++) {
                s[g] = fmaf(qs[g * 64 + d], k0, s[g]);
                s[g] = fmaf(qs[g * 64 + d + 1], k1, s[g]);
            }
        }
    }
    float pr[4], alpha[4];
#pragma unroll
    for (int g = 0; g < 4; g++) {
        float sv = valid ? s[g] * 0.125f : NEG_INF;
        float mn = fmaxf(st.m[g], wave_max(sv));
        alpha[g] = __expf(st.m[g] - mn);
        pr[g] = valid ? __expf(sv - mn) : 0.f;
        st.l[g] = st.l[g] * alpha[g] + wave_sum(pr[g]);
        st.m[g] = mn;
        st.o[g] *= alpha[g];
    }
    *(float4*)&pl[lane * 4] = make_float4(pr[0], pr[1], pr[2], pr[3]);
    wave_sync();
    int jmax = tmax - tok0; if (jmax > 63) jmax = 63;
    for (int j = 0; j <= jmax; j++) {
        float vv = bf2f(H[(rowbase + tok0 + j) * IC + vcol + lane]);
        float4 p4 = *(const float4*)&pl[j * 4];
        st.o[0] = fmaf(p4.x, vv, st.o[0]);
        st.o[1] = fmaf(p4.y, vv, st.o[1]);
        st.o[2] = fmaf(p4.z, vv, st.o[2]);
        st.o[3] = fmaf(p4.w, vv, st.o[3]);
    }
    wave_sync();
}

__device__ void phase_nsa(const P& p, int layer, float* smem) {
    PHASE_IDS
    const int lane = TID & 63, w = TID >> 6;
    float* sm = smem + w * 3328;
    float* qs = sm;
    float* S = sm + 256;
    float* PS = sm + 2304;
    float* IMP = sm + 2816;
    float* PL = sm + 2944;
    int* SEL = (int*)(sm + 3200);
    const bf16_t* H = p.H;
    const float* gate_b = p.nsa_gate_b + layer * 24;
    for (int item = BID * 4 + w; item < 32768; item += gridDim.x * 4) {
        const int t = item & 8191, hk = (item >> 13) & 1, b = item >> 14;
        const size_t rowbase = (size_t)b * T_;
        const size_t tok = rowbase + t;
        wave_sync();
#pragma unroll
        for (int g = 0; g < 4; g++) qs[g * 64 + lane] = bf2f(H[tok * IC + C_NQ + (hk * 4 + g) * 64 + lane]);
        wave_sync();
        const float* kc = p.kcmp + (size_t)(b * 2 + hk) * NCMP * 64;
        const float* vc = p.vcmp + (size_t)(b * 2 + hk) * NCMP * 64;
        int nvalid = t >= 31 ? ((t - 31) >> 4) + 1 : 0;
        if (nvalid > NCMP) nvalid = NCMP;
        float mx[4] = {NEG_INF, NEG_INF, NEG_INF, NEG_INF};
        for (int r = 0; r * 64 < nvalid; r++) {
            int n = r * 64 + lane;
            int nc = n < nvalid ? n : nvalid - 1;
            const float4* kr = (const float4*)(kc + (size_t)nc * 64);
            float s[4] = {0.f, 0.f, 0.f, 0.f};
#pragma unroll
            for (int c = 0; c < 16; c++) {
                float4 k4 = kr[c];
#pragma unroll
                for (int g = 0; g < 4; g++) {
                    float4 q4 = *(const float4*)&qs[g * 64 + c * 4];
                    s[g] = fmaf(q4.x, k4.x, s[g]); s[g] = fmaf(q4.y, k4.y, s[g]);
                    s[g] = fmaf(q4.z, k4.z, s[g]); s[g] = fmaf(q4.w, k4.w, s[g]);
                }
            }
#pragma unroll
            for (int g = 0; g < 4; g++) {
                float sv = n < nvalid ? s[g] * 0.125f : NEG_INF;
                S[g * 512 + n] = sv;
                mx[g] = fmaxf(mx[g], sv);
            }
        }
        float ocmp[4] = {0.f, 0.f, 0.f, 0.f};
        for (int r = 0; r < 8; r++) PS[r * 64 + lane] = 0.f;
        if (nvalid > 0) {
            float sum[4] = {0.f, 0.f, 0.f, 0.f};
#pragma unroll
            for (int g = 0; g < 4; g++) mx[g] = wave_max(mx[g]);
            for (int r = 0; r * 64 < nvalid; r++) {
                int n = r * 64 + lane;
#pragma unroll
                for (int g = 0; g < 4; g++) {
                    float e = n < nvalid ? __expf(S[g * 512 + n] - mx[g]) : 0.f;
                    S[g * 512 + n] = e;
                    sum[g] += e;
                }
            }
            float inv[4];
#pragma unroll
            for (int g = 0; g < 4; g++) inv[g] = 1.f / wave_sum(sum[g]);
            for (int r = 0; r * 64 < nvalid; r++) {
                int n = r * 64 + lane;
                float ps = 0.f;
#pragma unroll
                for (int g = 0; g < 4; g++) {
                    float pv = S[g * 512 + n] * inv[g];
                    S[g * 512 + n] = pv;
                    ps += pv;
                }
                PS[n] = ps;
            }
            wave_sync();
            for (int n = 0; n < nvalid; n++) {
                float vv = vc[(size_t)n * 64 + lane];
                ocmp[0] = fmaf(S[n], vv, ocmp[0]);
                ocmp[1] = fmaf(S[512 + n], vv, ocmp[1]);
                ocmp[2] = fmaf(S[1024 + n], vv, ocmp[2]);
                ocmp[3] = fmaf(S[1536 + n], vv, ocmp[3]);
            }
        }
        wave_sync();
        const int cur = t >> 6;
        float iv[2];
#pragma unroll
        for (int q = 0; q < 2; q++) {
            int j = lane + q * 64;
            float a = 0.f;
#pragma unroll
            for (int dn = -1; dn <= 3; dn++) {
                int n = 4 * j + dn;
                if (n >= 0 && n < NCMP) a += PS[n];
            }
            bool forced = (j == 0) || (j == cur) || (j == cur - 1);
            float val = (j <= cur) ? (a + (forced ? 1e4f : 0.f)) : NEG_INF;
            iv[q] = val;
            IMP[j] = val;
        }
        wave_sync();
        int c0 = 0, c1 = 0;
        for (int jj = 0; jj < 128; jj++) {
            float xv = IMP[jj];
            c0 += (xv > iv[0]) || (xv == iv[0] && jj < lane);
            c1 += (xv > iv[1]) || (xv == iv[1] && jj < lane + 64);
        }
        bool s0 = (c0 < 16) && (iv[0] > 0.5f * NEG_INF);
        bool s1 = (c1 < 16) && (iv[1] > 0.5f * NEG_INF);
        unsigned long long m0 = __ballot(s0), m1 = __ballot(s1);
        unsigned long long lower = (lane == 0) ? 0ull : (~0ull >> (64 - lane));
        if (s0) SEL[__popcll(m0 & lower)] = lane;
        if (s1) SEL[__popcll(m0) + __popcll(m1 & lower)] = lane + 64;
        const int nsel = __popcll(m0) + __popcll(m1);
        wave_sync();
        AttnState st;
#pragma unroll
        for (int g = 0; g < 4; g++) { st.m[g] = NEG_INF; st.l[g] = 0.f; st.o[g] = 0.f; }
        for (int si = 0; si < nsel; si++) {
            int jb = SEL[si];
            attend64(st, qs, PL, H, rowbase, jb * 64, t, 0, C_KS + hk * 64, C_VS + hk * 64, lane);
        }
        float oslc[4];
#pragma unroll
        for (int g = 0; g < 4; g++) oslc[g] = st.o[g] / st.l[g];
#pragma unroll
        for (int g = 0; g < 4; g++) { st.m[g] = NEG_INF; st.l[g] = 0.f; st.o[g] = 0.f; }
        const int wstart = t - 511 > 0 ? t - 511 : 0;
        for (int tk = wstart; tk <= t; tk += 64)
            attend64(st, qs, PL, H, rowbase, tk, t, wstart, C_KW + hk * 64, C_VW + hk * 64, lane);
#pragma unroll
        for (int g = 0; g < 4; g++) {
            int hh = hk * 4 + g;
            float g0 = sigmoidf_(bf2f(H[tok * IC + C_NG + hh * 3 + 0]) + gate_b[hh * 3 + 0]);
            float g1 = sigmoidf_(bf2f(H[tok * IC + C_NG + hh * 3 + 1]) + gate_b[hh * 3 + 1]);
            float g2 = sigmoidf_(bf2f(H[tok * IC + C_NG + hh * 3 + 2]) + gate_b[hh * 3 + 2]);
            float ow = st.o[g] / st.l[g];
            p.Y[tok * DM + 256 + hh * 64 + lane] = g0 * ocmp[g] + g1 * oslc[g] + g2 * ow;
        }
    }
}

__device__ void phase_headnorm(const P& p, int layer) {
    PHASE_IDS
    const int lane = TID & 63, w = TID >> 6;
    const float* og = p.out_gain + layer * 1024;
    for (int row = BID * 4 + w; row < NTOK; row += gridDim.x * 4) {
#pragma unroll
        for (int hd = 0; hd < 16; hd++) {
            float v = p.Y[(size_t)row * DM + hd * 64 + lane];
            float ms = wave_sum(v * v) * (1.f / 64.f);
            float y = v * rsqrtf(ms + 1e-6f) * og[hd * 64 + lane];
            if (hd >= 12) {
                float hg = bf2f(p.H[(size_t)row * IC + C_HG + (hd - 12) * 64 + lane]);
                y *= hg * sigmoidf_(hg);
            }
            p.Y[(size_t)row * DM + hd * 64 + lane] = y;
        }
    }
}

__device__ void phase_outproj(const P& p, int layer, const float* xin, float* x1, float* smem) {
    PHASE_IDS
    const float* W = p.w_out + (size_t)layer * DM * DM;
    const float* Y = p.Y;
    for (int item = BID; item < 128 * 8; item += gridDim.x) {
        int mt = item >> 3, nt = item & 7;
        gemm128(TID, mt * 128, nt * 128, NTOK, DM, DM,
                [&](int m, int k) { return Y[(size_t)m * DM + k]; },
                [&](int k, int n) { return W[(size_t)k * DM + n]; },
                [&](int m, int n, float v) { x1[(size_t)m * DM + n] = ALPHA * xin[(size_t)m * DM + n] + v; }, smem);
    }
}

__device__ void phase_ln1_route(const P& p, int layer, float* x1) {
    PHASE_IDS
    const int lane = TID & 63, w = TID >> 6;
    const float* g = p.ln1_g + layer * 1024;
    const float* bb = p.ln1_b + layer * 1024;
    const float* wg = p.rg_w + (size_t)layer * 1024 * 4;
    const float* we = p.re_w + (size_t)layer * 1024 * 16;
    const float* bg = p.rg_b + layer * 4;
    const float* be = p.re_b + layer * 16;
    int* cnt = p.cnt + layer * 16;
    for (int row = BID * 4 + w; row < NTOK; row += gridDim.x * 4) {
        float v[16];
        float s = 0.f;
#pragma unroll
        for (int i = 0; i < 16; i++) { v[i] = x1[(size_t)row * DM + i * 64 + lane]; s += v[i]; }
        float mu = wave_sum(s) * (1.f / 1024.f);
        float q = 0.f;
#pragma unroll
        for (int i = 0; i < 16; i++) { float d = v[i] - mu; q += d * d; }
        float rstd = rsqrtf(wave_sum(q) * (1.f / 1024.f) + 1e-5f);
        float lg[4] = {0.f, 0.f, 0.f, 0.f};
        float le[16];
#pragma unroll
        for (int e = 0; e < 16; e++) le[e] = 0.f;
#pragma unroll
        for (int i = 0; i < 16; i++) {
            int c = i * 64 + lane;
            float o = (v[i] - mu) * rstd * g[c] + bb[c];
            x1[(size_t)row * DM + c] = o;
            float4 w4 = *(const float4*)&wg[c * 4];
            lg[0] = fmaf(o, w4.x, lg[0]); lg[1] = fmaf(o, w4.y, lg[1]);
            lg[2] = fmaf(o, w4.z, lg[2]); lg[3] = fmaf(o, w4.w, lg[3]);
#pragma unroll
            for (int e4 = 0; e4 < 4; e4++) {
                float4 x4 = *(const float4*)&we[c * 16 + e4 * 4];
                le[e4 * 4 + 0] = fmaf(o, x4.x, le[e4 * 4 + 0]);
                le[e4 * 4 + 1] = fmaf(o, x4.y, le[e4 * 4 + 1]);
                le[e4 * 4 + 2] = fmaf(o, x4.z, le[e4 * 4 + 2]);
                le[e4 * 4 + 3] = fmaf(o, x4.w, le[e4 * 4 + 3]);
            }
        }
#pragma unroll
        for (int c = 0; c < 4; c++) lg[c] = wave_sum(lg[c]) + bg[c];
#pragma unroll
        for (int e = 0; e < 16; e++) le[e] = wave_sum(le[e]) + be[e];
        float gm = fmaxf(fmaxf(lg[0], lg[1]), fmaxf(lg[2], lg[3]));
        float ge[4], gs = 0.f;
#pragma unroll
        for (int c = 0; c < 4; c++) { ge[c] = __expf(lg[c] - gm); gs += ge[c]; }
        int gi = 0; float gbest = ge[0];
#pragma unroll
        for (int c = 1; c < 4; c++) if (ge[c] > gbest) { gbest = ge[c]; gi = c; }
        float gval = gbest / gs;
        float ls[4];
#pragma unroll
        for (int e = 0; e < 4; e++) ls[e] = gi == 0 ? le[e] : gi == 1 ? le[4 + e] : gi == 2 ? le[8 + e] : le[12 + e];
        float em = fmaxf(fmaxf(ls[0], ls[1]), fmaxf(ls[2], ls[3]));
        float pe[4];
#pragma unroll
        for (int e = 0; e < 4; e++) pe[e] = __expf(ls[e] - em);
        int i1 = 0; float b1 = pe[0];
#pragma unroll
        for (int e = 1; e < 4; e++) if (pe[e] > b1) { b1 = pe[e]; i1 = e; }
        int i2 = -1; float b2 = -1.f;
#pragma unroll
        for (int e = 0; e < 4; e++) if (e != i1 && pe[e] > b2) { b2 = pe[e]; i2 = e; }
        float w1 = gval * b1 / (b1 + b2), w2 = gval * b2 / (b1 + b2);
        if (lane == 0) {
            int e1 = gi * 4 + i1, e2 = gi * 4 + i2;
            int p1 = atomicAdd(&cnt[e1], 1);
            p.list_tok[e1 * NTOK + p1] = row; p.list_w[e1 * NTOK + p1] = w1;
            int p2 = atomicAdd(&cnt[e2], 1);
            p.list_tok[e2 * NTOK + p2] = row; p.list_w[e2 * NTOK + p2] = w2;
        }
    }
}

__device__ __forceinline__ bool moe_item(const int* cnt, int item, int ntn, int& e, int& mt, int& nt, int& base) {
    int acc = 0, b = 0;
    for (int ee = 0; ee < 16; ee++) {
        int c = __hip_atomic_load(&cnt[ee], __ATOMIC_RELAXED, __HIP_MEMORY_SCOPE_AGENT);
        int tiles = ((c + 127) >> 7) * ntn;
        if (item < acc + tiles) {
            int li = item - acc;
            e = ee; mt = li / ntn; nt = li % ntn; base = b;
            return true;
        }
        acc += tiles; b += c;
    }
    return false;
}

__device__ void phase_moe_up(const P& p, int layer, const float* x1, float* hidden, float* accbuf, float* smem) {
    PHASE_IDS
    {
        float4* a4 = (float4*)accbuf;
        for (size_t i = (size_t)BID * 256 + TID; i < (size_t)NTOK * DM / 4; i += (size_t)gridDim.x * 256)
            a4[i] = make_float4(0.f, 0.f, 0.f, 0.f);
    }
    const int* cnt = p.cnt + layer * 16;
    for (int item = BID;; item += gridDim.x) {
        int e, mt, nt, base;
        if (!moe_item(cnt, item, 4, e, mt, nt, base)) break;
        int c = __hip_atomic_load(&cnt[e], __ATOMIC_RELAXED, __HIP_MEMORY_SCOPE_AGENT);
        const int* lt = p.list_tok + e * NTOK;
        const float* Wg = p.w_gate + ((size_t)layer * 16 + e) * DM * 512;
        const float* Wu = p.w_up + ((size_t)layer * 16 + e) * DM * 512;
        float* hb = hidden + (size_t)base * 512;
        gemm128(TID, mt * 128, nt * 128, c, 512, DM,
                [&](int r, int k) { return x1[(size_t)lt[r] * DM + k]; },
                [&](int k, int n) { return Wg[(size_t)k * 512 + n]; },
                [&](int r, int n, float v) { hb[(size_t)r * 512 + n] = v * sigmoidf_(v); }, smem);
        gemm128(TID, mt * 128, nt * 128, c, 512, DM,
                [&](int r, int k) { return x1[(size_t)lt[r] * DM + k]; },
                [&](int k, int n) { return Wu[(size_t)k * 512 + n]; },
                [&](int r, int n, float v) { hb[(size_t)r * 512 + n] *= v; }, smem);
    }
}

__device__ void phase_moe_down(const P& p, int layer, const float* hidden, float* accbuf, float* smem) {
    PHASE_IDS
    const int* cnt = p.cnt + layer * 16;
    for (int item = BID;; item += gridDim.x) {
        int e, mt, nt, base;
        if (!moe_item(cnt, item, 8, e, mt, nt, base)) break;
        int c = __hip_atomic_load(&cnt[e], __ATOMIC_RELAXED, __HIP_MEMORY_SCOPE_AGENT);
        const int* lt = p.list_tok + e * NTOK;
        const float* lw = p.list_w + e * NTOK;
        const float* Wd = p.w_down + ((size_t)layer * 16 + e) * 512 * DM;
        const float* hb = hidden + (size_t)base * 512;
        gemm128(TID, mt * 128, nt * 128, c, DM, 512,
                [&](int r, int k) { return hb[(size_t)r * 512 + k]; },
                [&](int k, int n) { return Wd[(size_t)k * DM + n]; },
                [&](int r, int n, float v) { atomicAdd(&accbuf[(size_t)lt[r] * DM + n], lw[r] * v); }, smem);
    }
}

__device__ void phase_ln2(const P& p, int layer, const float* x1, const float* accbuf, float* xo) {
    PHASE_IDS
    const int lane = TID & 63, w = TID >> 6;
    const float* g = p.ln2_g + layer * 1024;
    const float* bb = p.ln2_b + layer * 1024;
    for (int row = BID * 4 + w; row < NTOK; row += gridDim.x * 4) {
        float v[16];
        float s = 0.f;
#pragma unroll
        for (int i = 0; i < 16; i++) {
            size_t idx = (size_t)row * DM + i * 64 + lane;
            v[i] = ALPHA * x1[idx] + accbuf[idx];
            s += v[i];
        }
        float mu = wave_sum(s) * (1.f / 1024.f);
        float q = 0.f;
#pragma unroll
        for (int i = 0; i < 16; i++) { float d = v[i] - mu; q += d * d; }
        float rstd = rsqrtf(wave_sum(q) * (1.f / 1024.f) + 1e-5f);
#pragma unroll
        for (int i = 0; i < 16; i++) {
            int c = i * 64 + lane;
            xo[(size_t)row * DM + c] = (v[i] - mu) * rstd * g[c] + bb[c];
        }
    }
}

template <int PH>
__device__ __forceinline__ void run_phase(const P& p, int layer, float* smem) {
    const float* xin = layer == 0 ? p.x : p.M;
    float* x1 = p.out;
    float* xo = layer == 0 ? p.M : p.out;
    float* accbuf = (float*)p.H;
    float* hidden = p.Y;
    if (PH == 0) phase_inproj(p, layer, xin, smem);
    if (PH == 1) { phase_hgrn(p, layer, smem); phase_gmlp(p, layer, smem); __syncthreads(); phase_compress(p, layer, smem); }
    if (PH == 2) phase_nsa(p, layer, smem);
    if (PH == 3) phase_headnorm(p, layer);
    if (PH == 4) phase_outproj(p, layer, xin, x1, smem);
    if (PH == 5) phase_ln1_route(p, layer, x1);
    if (PH == 6) phase_moe_up(p, layer, x1, hidden, accbuf, smem);
    if (PH == 7) phase_moe_down(p, layer, hidden, accbuf, smem);
    if (PH == 8) phase_ln2(p, layer, x1, accbuf, xo);
}

template <int PH>
__global__ void __launch_bounds__(256) k_phase(P p, int layer) {
    __shared__ __attribute__((aligned(16))) float smem[16384];
    run_phase<PH>(p, layer, smem);
}

#if MK_FUSED
__global__ void __launch_bounds__(256) k_mega(P p) {
    __shared__ __attribute__((aligned(16))) float smem[16384];
    cg::grid_group grid = cg::this_grid();
#ifndef NPH_LIMIT
#define NPH_LIMIT 18
#endif
#pragma unroll 1
    for (int ph = 0; ph < p.nph; ph++) {
        const int layer = ph / 9, q = ph % 9;
        if (q == 0) run_phase<0>(p, layer, smem);
        else if (q == 1) run_phase<1>(p, layer, smem);
        else if (q == 2) run_phase<2>(p, layer, smem);
        else if (q == 3) run_phase<3>(p, layer, smem);
        else if (q == 4) run_phase<4>(p, layer, smem);
        else if (q == 5) run_phase<5>(p, layer, smem);
        else if (q == 6) run_phase<6>(p, layer, smem);
        else if (q == 7) run_phase<7>(p, layer, smem);
        else run_phase<8>(p, layer, smem);
        if (ph != 17) grid.sync();
    }
}
#endif

__global__ void k_fill(float* o, float c) { size_t i = (size_t)blockIdx.x * 256 + threadIdx.x; if (i < 16384ull * 1024) o[i] = c; }

static inline size_t align_up(size_t v, size_t a) { return (v + a - 1) / a * a; }

extern "C" void kernel_launch(void* const* d_in, const int* in_sizes, int n_in, void* d_out, int out_size, void* d_ws,
                              size_t ws_size, hipStream_t stream) {
    P p{};
    p.x = (const float*)d_in[0]; p.w_in = (const float*)d_in[1]; p.gm_v_gain = (const float*)d_in[2];
    p.gm_v_bias = (const float*)d_in[3]; p.gm_w_s = (const float*)d_in[4]; p.gm_b_s = (const float*)d_in[5];
    p.cmp_pos = (const float*)d_in[6]; p.cmp_w1 = (const float*)d_in[7]; p.cmp_w2 = (const float*)d_in[8];
    p.nsa_gate_b = (const float*)d_in[9]; p.hg_lower = (const float*)d_in[10]; p.out_gain = (const float*)d_in[11];
    p.w_out = (const float*)d_in[12]; p.ln1_g = (const float*)d_in[13]; p.ln1_b = (const float*)d_in[14];
    p.rg_w = (const float*)d_in[15]; p.rg_b = (const float*)d_in[16]; p.re_w = (const float*)d_in[17];
    p.re_b = (const float*)d_in[18]; p.w_gate = (const float*)d_in[19]; p.w_up = (const float*)d_in[20];
    p.w_down = (const float*)d_in[21]; p.ln2_g = (const float*)d_in[22]; p.ln2_b = (const float*)d_in[23];
    p.out = (float*)d_out;
    char* ws = (char*)d_ws;
    size_t off = 0;
    p.H = (bf16_t*)(ws + off); off = align_up(off + (size_t)NTOK * IC * 2, 256);
    p.Y = (float*)(ws + off); off = align_up(off + (size_t)NTOK * DM * 4, 256);
    p.M = (float*)(ws + off); off = align_up(off + (size_t)NTOK * DM * 4, 256);
    p.kcmp = (float*)(ws + off); off = align_up(off + (size_t)4 * NCMP * 64 * 4, 256);
    p.vcmp = (float*)(ws + off); off = align_up(off + (size_t)4 * NCMP * 64 * 4, 256);
    p.gbuf = (float*)(ws + off); off = align_up(off + (size_t)2 * 2044 * 128 * 4, 256);
    p.list_tok = (int*)(ws + off); off = align_up(off + (size_t)16 * NTOK * 4, 256);
    p.list_w = (float*)(ws + off); off = align_up(off + (size_t)16 * NTOK * 4, 256);
    p.cnt = (int*)(ws + off); off = align_up(off + 256, 256);
    (void)ws_size; (void)in_sizes; (void)n_in; (void)out_size;
#if MK_FUSED
    static int grid_blocks = 0;
    static int per_cu_s = 0;
    if (!grid_blocks) {
        int dev = 0, cus = 0, per_cu = -1;
        (void)hipGetDevice(&dev);
        (void)hipDeviceGetAttribute(&cus, hipDeviceAttributeMultiprocessorCount, dev);
        hipError_t oe = hipOccupancyMaxActiveBlocksPerMultiprocessor(&per_cu, k_mega, 256, 0);
        if (oe != hipSuccess) per_cu = 5;
        per_cu_s = per_cu < 0 ? 4 : per_cu > 3 ? 3 : per_cu;
        if (per_cu > 1) per_cu = 1;
        if (per_cu < 1) per_cu = 1;
        grid_blocks = cus * per_cu;
    }
    p.nph = NPH_LIMIT;
    void* args[] = {&p};
    hipError_t e = hipLaunchCooperativeKernel((void*)k_mega, dim3(grid_blocks), dim3(256), args, 0, stream);
    if (e != hipSuccess) {
        (void)hipGetLastError();
        int code = (e == 720) ? 1 : (e == 701) ? 2 : (e == 9) ? 3 : (e == 1) ? 4 : 5;
        float c = (float)(6 * code + per_cu_s);
        k_fill<<<65536, 256, 0, stream>>>((float*)d_out, c);
    }
#else
    const int G = 1024;
    for (int layer = 0; layer < 2; layer++) {
        k_phase<0><<<G, 256, 0, stream>>>(p, layer);
        k_phase<1><<<G, 256, 0, stream>>>(p, layer);
        k_phase<2><<<G, 256, 0, stream>>>(p, layer);
        k_phase<3><<<G, 256, 0, stream>>>(p, layer);
        k_phase<4><<<G, 256, 0, stream>>>(p, layer);
        k_phase<5><<<G, 256, 0, stream>>>(p, layer);
        k_phase<6><<<G, 256, 0, stream>>>(p, layer);
        k_phase<7><<<G, 256, 0, stream>>>(p, layer);
        k_phase<8><<<G, 256, 0, stream>>>(p, layer);
    }
#endif
}
```

```cpp
#include <hip/hip_runtime.h>
#include <cstdio>
#include <cstdint>

#define LAS __attribute__((address_space(3)))
typedef unsigned short bf16_t;
typedef short bf16x8 __attribute__((ext_vector_type(8)));
typedef float f32x4 __attribute__((ext_vector_type(4)));
typedef float f32x2 __attribute__((ext_vector_type(2)));
typedef unsigned u32x4 __attribute__((ext_vector_type(4)));
typedef unsigned u32x2 __attribute__((ext_vector_type(2)));

constexpr int NW = 8;
constexpr int NTHR = NW * 64;
constexpr int T_ = 8192;
constexpr int NTOK = 16384;
constexpr int DM = 1024;
constexpr int IC_SRC = 2840;
constexpr int HLD = 3072;
constexpr int C_GU = 0, C_GV = 256, C_NQ = 512, C_KC = 1024, C_VC = 1152, C_KS = 1280, C_VS = 1408,
              C_KW = 1536, C_VW = 1664, C_HQ = 1792, C_HF = 2048, C_HI = 2304, C_HG = 2560, C_NG = 2816;
constexpr int NCMP = 511;
constexpr float ALPHA = 1.4142135623730951f;
constexpr float NEG_INF = -1e30f;

constexpr size_t WT_IN = 0;
constexpr size_t WT_OUT = WT_IN + (size_t)3072 * 1024;
constexpr size_t WT_UP = WT_OUT + (size_t)1024 * 1024;
constexpr size_t WT_DN = WT_UP + (size_t)16 * 1024 * 1024;
constexpr size_t WT_LAYER = WT_DN + (size_t)16 * 1024 * 512;

constexpr int LDS_STAGE = 131072;
constexpr int LDS_MISC = LDS_STAGE;
constexpr int LDS_BYTES = 147456;

constexpr int CW_BAR = 0;
constexpr int CW_CNT = 4096;
constexpr size_t CTL_BYTES = 65536;

struct P {
    const float* x; const float* w_in; const float* gm_v_gain; const float* gm_v_bias; const float* gm_w_s;
    const float* gm_b_s; const float* cmp_pos; const float* cmp_w1; const float* cmp_w2; const float* nsa_gate_b;
    const float* hg_lower; const float* out_gain; const float* w_out; const float* ln1_g; const float* ln1_b;
    const float* rg_w; const float* rg_b; const float* re_w; const float* re_b; const float* w_gate;
    const float* w_up; const float* w_down; const float* ln2_g; const float* ln2_b;
    float* out;
    unsigned* ctl;
    bf16_t* WT;
    bf16_t* H;
    bf16_t* Y;
    bf16_t* XB;
    float* kcmp;
    float* vcmp;
    float* gbuf;
    int* list_tok;
    float* list_w;
    int nph; int pad;
};


typedef const __attribute__((address_space(4))) char* KA;
template <class T> __device__ __forceinline__ T ldarg(KA ka, size_t off) { return *(const __attribute__((address_space(4))) T*)(ka + off); }
#define PF(f) ldarg<decltype(P::f)>(ka, offsetof(P, f))

__device__ __forceinline__ float bf2f(bf16_t u) { return __uint_as_float(((unsigned)u) << 16); }
__device__ __forceinline__ unsigned f2bf_u(float f) {
    unsigned u = __float_as_uint(f);
    return (u + 0x7fffu + ((u >> 16) & 1u)) >> 16;
}
__device__ __forceinline__ bf16_t f2bf(float f) { return (bf16_t)f2bf_u(f); }
__device__ __forceinline__ unsigned pk2(float lo, float hi) { return f2bf_u(lo) | (f2bf_u(hi) << 16); }
__device__ __forceinline__ float gelu_t(float x) {
    float u = 0.7978845608028654f * (x + 0.044715f * x * x * x);
    return 0.5f * x * (1.f + tanhf(u));
}
__device__ __forceinline__ float sigmoidf_(float x) { return 1.f / (1.f + __expf(-x)); }
__device__ __forceinline__ float wave_max(float v) {
#pragma unroll
    for (int o = 32; o > 0; o >>= 1) v = fmaxf(v, __shfl_xor(v, o));
    return v;
}
__device__ __forceinline__ float wave_sum(float v) {
#pragma unroll
    for (int o = 32; o > 0; o >>= 1) v += __shfl_xor(v, o);
    return v;
}
__device__ __forceinline__ void wave_sync() {
    __builtin_amdgcn_fence(__ATOMIC_RELEASE, "wavefront");
    __builtin_amdgcn_wave_barrier();
    __builtin_amdgcn_fence(__ATOMIC_ACQUIRE, "wavefront");
}
__device__ __forceinline__ int opaque_tid() { int t = threadIdx.x; asm volatile("" : "+v"(t)); return t; }
__device__ __forceinline__ int opaque_bid() { int b = blockIdx.x; asm volatile("" : "+s"(b)); return b; }
#define PHASE_IDS const int TID = opaque_tid(); const int BID = opaque_bid(); (void)TID; (void)BID;

#define XB_TMO      128
#define XB_XCNT(j)  (256  + 64 * (j))
#define XB_XSUB(j)  (1280 + 64 * (j))
#define XB_XGEN(j)  (2304 + 64 * (j))
#define XB_TOP      3328
#define XB_TOPGEN   3392
#define XCD_BAR_WORDS 3456
#define XB_SPIN_CAP (1u << 22)
__device__ __forceinline__ unsigned xb_ld(unsigned* p)              { return __hip_atomic_load(p, __ATOMIC_RELAXED, __HIP_MEMORY_SCOPE_AGENT); }
__device__ __forceinline__ unsigned xb_add(unsigned* p, unsigned v) { return __hip_atomic_fetch_add(p, v, __ATOMIC_RELAXED, __HIP_MEMORY_SCOPE_AGENT); }
__device__ __forceinline__ unsigned xb_xcc_id() { return (unsigned)__builtin_amdgcn_s_getreg((3 << 11) | 20) & 0xFu; }
#define XB_SPIN(cond, bar) do { unsigned _sp = 0; while (cond) { __builtin_amdgcn_s_sleep(1); \
    if ((++_sp & 255u) == 0u) { if (xb_ld(&(bar)[XB_TMO])) break; if (_sp > XB_SPIN_CAP) { atomicAdd(&(bar)[XB_TMO], 1u); break; } } } } while (0)
struct XcdBarrier { unsigned* bar; unsigned x; volatile LAS unsigned* st; };
__device__ __forceinline__ XcdBarrier xcd_barrier_post(unsigned* bar, volatile LAS unsigned* st) {
    XcdBarrier b; b.bar = bar; b.x = xb_xcc_id(); b.st = st;
    if (threadIdx.x == 0) (void)xb_add(&bar[XB_XCNT(b.x)], 1u);
    return b;
}
__device__ __forceinline__ void xcd_barrier_complete(unsigned* bar, unsigned x, unsigned& nloc, unsigned& nx) {
    const unsigned G = gridDim.x * gridDim.y * gridDim.z;
    unsigned sum, cnt, mine, sp = 0u;
    for (;;) {
        sum = 0u; cnt = 0u; mine = 0u;
#pragma unroll
        for (unsigned j = 0; j < 16; ++j) { const unsigned c = xb_ld(&bar[XB_XCNT(j)]); sum += c; cnt += (c > 0u) ? 1u : 0u; mine = (j == x) ? c : mine; }
        if (sum == G) break;
        __builtin_amdgcn_s_sleep(1);
        if ((++sp & 255u) == 0u) { if (xb_ld(&bar[XB_TMO])) break; if (sp > XB_SPIN_CAP) { atomicAdd(&bar[XB_TMO], 1u); break; } }
    }
    nloc = mine > 0u ? mine : 1u; nx = cnt > 0u ? cnt : 1u;
}
__device__ __forceinline__ void xcd_barrier(const XcdBarrier& b) {
    asm volatile("s_waitcnt vmcnt(0)" ::: "memory");
    __syncthreads();
    if (threadIdx.x == 0) {
        unsigned* bar = b.bar;
        __builtin_amdgcn_s_waitcnt(0);
        unsigned nloc = b.st[0], nx = b.st[1];
        if (nloc == 0u) { xcd_barrier_complete(bar, b.x, nloc, nx); b.st[0] = nloc; b.st[1] = nx; }
        const unsigned old = xb_add(&bar[XB_XSUB(b.x)], 1u);
        const unsigned gen = old / nloc;
        if (old + 1u == (gen + 1u) * nloc) {
            __builtin_amdgcn_fence(__ATOMIC_RELEASE, "agent");
            asm volatile("s_waitcnt vmcnt(0)" ::: "memory");
            const unsigned og = xb_add(&bar[XB_TOP], 1u);
            const unsigned tg = og / nx;
            if (og + 1u == (tg + 1u) * nx) xb_add(&bar[XB_TOPGEN], 1u);
            else XB_SPIN(xb_ld(&bar[XB_TOPGEN]) == tg, bar);
            __builtin_amdgcn_fence(__ATOMIC_ACQUIRE, "agent");
            xb_add(&bar[XB_XGEN(b.x)], 1u);
            asm volatile("s_waitcnt vmcnt(0)" ::: "memory");
        } else {
            XB_SPIN(xb_ld(&bar[XB_XGEN(b.x)]) == gen, bar);
            __builtin_amdgcn_fence(__ATOMIC_ACQUIRE, "agent");
            asm volatile("s_waitcnt vmcnt(0)" ::: "memory");
        }
    }
    __syncthreads();
}

namespace pg8 {
constexpr int BM = 256, BK = 64, HALF = 128, HTB = HALF * BK * 2, STAGE_BYTES = 8 * HTB;
__host__ __device__ __forceinline__ int lds_byte(int r, int c) { const int st = (r >> 4) * 2 + (c >> 5), rr = r & 15, cc = c & 31, ob = rr * 64 + cc * 2; return st * 1024 + (ob ^ (((ob >> 9) & 1) << 5)); }
__host__ __device__ __forceinline__ void stage_rc(int b, int& R, int& C) { const int st = b / 1024, sb = b % 1024, swz = sb ^ (((sb >> 9) & 1) << 5); R = (st >> 1) * 16 + swz / 64; C = (st & 1) * 32 + (swz % 64) / 2; }
__host__ __device__ __forceinline__ int perm32(int rho) { const int n = rho >> 4, i = rho & 15; return 8 * (i >> 2) + 4 * n + (i & 3); }
__device__ __forceinline__ unsigned cvt_pk_bf16(float lo, float hi) { unsigned r; asm volatile("v_cvt_pk_bf16_f32 %0, %1, %2" : "=v"(r) : "v"(lo), "v"(hi)); return r; }

struct Unit {
    const char* bptr;
    int arow0;
    int nrows;
    int pm, pn, e, ui;
};

template <class Epi, class Sched>
__device__ __forceinline__ void gemm_phase(LAS unsigned char* lds, const char* Abase, const int K, const Sched& S, const Epi& E) {
    const int tid = threadIdx.x, wid = __builtin_amdgcn_readfirstlane(tid >> 6), lane = tid & 63, wr = wid >> 2, wc = wid & 3, fr = lane & 15, fq = lane >> 4;
    const int nt = K / BK;
    int R0, C0, R1, C1; stage_rc(tid * 16, R0, C0); stage_rc(tid * 16 + 8192, R1, C1);
    unsigned voffB[2];
    { const int Rb0 = Epi::PERM ? ((R0 & ~31) + perm32(R0 & 31)) : R0, Rb1 = Epi::PERM ? ((R1 & ~31) + perm32(R1 & 31)) : R1;
      voffB[0] = (unsigned)(Rb0 * K + C0) * 2u; voffB[1] = (unsigned)(Rb1 * K + C1) * 2u; }
    const unsigned cA0 = (unsigned)C0 * 2u, cA1 = (unsigned)C1 * 2u;
    const unsigned voffA0 = (unsigned)(R0 * K + C0) * 2u, voffA1 = (unsigned)(R1 * K + C1) * 2u;
    const unsigned kstep = (unsigned)(BK * 2);
    const unsigned hstep = (unsigned)(HALF * K * 2);
    const unsigned ldsw = (unsigned)wid * 1024u;
    const int aoff = lds_byte(wr * 64 + fr, fq * 8), boff = lds_byte(wc * 32 + fr, fq * 8);
#define PG8_SA(b, h) (((b) * 2 + (h)) * HTB)
#define PG8_SB(b, h) ((4 + (b) * 2 + (h)) * HTB)
#define PG8_STAGE_B(bufoff, gbase) do { \
        __builtin_amdgcn_global_load_lds((const unsigned*)((const char*)(gbase) + voffB[0]), (LAS unsigned*)(lds + (bufoff) + ldsw), 16, 0, 0); \
        __builtin_amdgcn_global_load_lds((const unsigned*)((const char*)(gbase) + voffB[1]), (LAS unsigned*)(lds + (bufoff) + ldsw + 8192), 16, 0, 0); } while (0)
#define PG8_STAGE_A(bufoff, gbase, pk) do { \
        const unsigned o0_ = Sched::GATHER ? (((pk) & 0xffffu) * (unsigned)K * 2u + cA0) : voffA0; \
        const unsigned o1_ = Sched::GATHER ? (((pk) >> 16) * (unsigned)K * 2u + cA1) : voffA1; \
        __builtin_amdgcn_global_load_lds((const unsigned*)((const char*)(gbase) + o0_), (LAS unsigned*)(lds + (bufoff) + ldsw), 16, 0, 0); \
        __builtin_amdgcn_global_load_lds((const unsigned*)((const char*)(gbase) + o1_), (LAS unsigned*)(lds + (bufoff) + ldsw + 8192), 16, 0, 0); } while (0)
#define PG8_LDA(dst, b, h) do { _Pragma("unroll") for (int m = 0; m < 4; ++m) _Pragma("unroll") for (int k = 0; k < 2; ++k) dst[m][k] = *(const LAS bf16x8*)(lds + PG8_SA(b, h) + aoff + m * 2048 + k * 1024); } while (0)
#define PG8_LDB(dst, b, h) do { _Pragma("unroll") for (int n = 0; n < 2; ++n) _Pragma("unroll") for (int k = 0; k < 2; ++k) dst[n][k] = *(const LAS bf16x8*)(lds + PG8_SB(b, h) + boff + n * 2048 + k * 1024); } while (0)
#define PG8_MMA(ai, bj, At, Bt) do { __builtin_amdgcn_s_setprio(1); _Pragma("unroll") for (int m = 0; m < 4; ++m) _Pragma("unroll") for (int n = 0; n < 2; ++n) _Pragma("unroll") for (int k = 0; k < 2; ++k) \
        acc[ai][bj][m][n] = __builtin_amdgcn_mfma_f32_16x16x32_bf16(Bt[n][k], At[m][k], acc[ai][bj][m][n], 0, 0, 0); __builtin_amdgcn_s_setprio(0); } while (0)
#define PG8_WAIT_V(n) asm volatile("s_waitcnt vmcnt(" #n ")" ::: "memory")
#define PG8_WAIT_L(n) asm volatile("s_waitcnt lgkmcnt(" #n ")" ::: "memory")
#define PG8_BAR __builtin_amdgcn_s_barrier()
#define PG8_SCHED __builtin_amdgcn_sched_barrier(0)
#define PG8_PACK(u, h) ((unsigned)S.arow((u), ((h) * 128 + R0) < (u).nrows ? ((h) * 128 + R0) : (u).nrows - 1) | ((unsigned)S.arow((u), ((h) * 128 + R1) < (u).nrows ? ((h) * 128 + R1) : (u).nrows - 1) << 16))
    Unit cur, nxt; int ui = 0;
    if (!S.next(0, cur)) return;
    f32x4 acc[2][2][4][2];
#pragma unroll
    for (int a = 0; a < 2; ++a)
#pragma unroll
        for (int b = 0; b < 2; ++b)
#pragma unroll
            for (int m = 0; m < 4; ++m)
#pragma unroll
                for (int n = 0; n < 2; ++n) acc[a][b][m][n] = (f32x4){0.f, 0.f, 0.f, 0.f};
    bf16x8 At[4][2], B0[2][2], B1[2][2];
    unsigned pC0 = 0u, pC1 = 0u, pN0 = 0u, pN1 = 0u;
    if (Sched::GATHER) { pC0 = PG8_PACK(cur, 0); pC1 = PG8_PACK(cur, 1); }
    const char* cB = cur.bptr;
    const char* cA = Sched::GATHER ? Abase : Abase + (size_t)cur.arow0 * K * 2;
    const unsigned hA = Sched::GATHER ? 0u : hstep;
    PG8_STAGE_B(PG8_SB(0, 0), cB); PG8_STAGE_B(PG8_SB(0, 1), cB + hstep); PG8_STAGE_A(PG8_SA(0, 0), cA, pC0); PG8_STAGE_A(PG8_SA(0, 1), cA + hA, pC1);
    if (wr == 1) PG8_BAR;
    PG8_WAIT_V(2); PG8_BAR;
    PG8_STAGE_B(PG8_SB(1, 0), cB + kstep); PG8_STAGE_A(PG8_SA(1, 0), cA + kstep, pC0); PG8_STAGE_B(PG8_SB(1, 1), cB + hstep + kstep);
    PG8_WAIT_V(6); PG8_BAR;
    for (;;) {
        const bool has_next = S.next(ui + 1, nxt);
        if (Sched::GATHER) { if (has_next) { pN0 = PG8_PACK(nxt, 0); pN1 = PG8_PACK(nxt, 1); } else { pN0 = pC0; pN1 = pC1; } }
        const char* nB = has_next ? nxt.bptr : cB;
        const char* nA = (Sched::GATHER || !has_next) ? cA : Abase + (size_t)nxt.arow0 * K * 2;
        for (int t = 0; t < nt; t += 2) {
            const bool last = (t == nt - 2);
            const char* a1 = cA + (unsigned)(t + 1) * kstep;
            const char* a2 = last ? nA : cA + (unsigned)(t + 2) * kstep; const char* b2 = last ? nB : cB + (unsigned)(t + 2) * kstep;
            const char* a3 = a2 + kstep; const char* b3 = b2 + kstep;
            const unsigned s0 = last ? pN0 : pC0, s1 = last ? pN1 : pC1;
            PG8_LDB(B0, 0, 0); PG8_LDB(B1, 0, 1); PG8_SCHED; PG8_LDA(At, 0, 0); PG8_STAGE_A(PG8_SA(1, 1), a1 + hA, pC1);
            PG8_WAIT_V(8); PG8_WAIT_L(0); PG8_BAR; PG8_MMA(0, 0, At, B0); PG8_MMA(0, 1, At, B1); PG8_BAR; PG8_SCHED;
            PG8_LDA(At, 0, 1); PG8_STAGE_B(PG8_SB(0, 0), b2); PG8_STAGE_B(PG8_SB(0, 1), b2 + hstep); PG8_STAGE_A(PG8_SA(0, 0), a2, s0);
            PG8_WAIT_V(8); PG8_WAIT_L(0); PG8_BAR; PG8_MMA(1, 0, At, B0); PG8_MMA(1, 1, At, B1); PG8_BAR; PG8_SCHED;
            PG8_LDB(B0, 1, 0); PG8_LDB(B1, 1, 1); PG8_SCHED; PG8_LDA(At, 1, 0); PG8_STAGE_A(PG8_SA(0, 1), a2 + hA, s1);
            PG8_WAIT_V(8); PG8_WAIT_L(0); PG8_BAR; PG8_MMA(0, 0, At, B0); PG8_MMA(0, 1, At, B1); PG8_BAR; PG8_SCHED;
            PG8_LDA(At, 1, 1); PG8_STAGE_B(PG8_SB(1, 0), b3); PG8_STAGE_B(PG8_SB(1, 1), b3 + hstep); PG8_STAGE_A(PG8_SA(1, 0), a3, s0);
            PG8_WAIT_V(8); PG8_WAIT_L(0); PG8_BAR; PG8_MMA(1, 0, At, B0); PG8_MMA(1, 1, At, B1); PG8_BAR; PG8_SCHED;
        }
        if (wr == 0) PG8_BAR;
        E(acc, cur, wr, wc, fr, fq);
        if (!has_next) break;
#pragma unroll
        for (int a = 0; a < 2; ++a)
#pragma unroll
            for (int b = 0; b < 2; ++b)
#pragma unroll
                for (int m = 0; m < 4; ++m)
#pragma unroll
                    for (int n = 0; n < 2; ++n) acc[a][b][m][n] = (f32x4){0.f, 0.f, 0.f, 0.f};
        cur = nxt; cB = nB; cA = nA; ++ui;
        pC0 = pN0; pC1 = pN1;
        if (wr == 1) PG8_BAR;
    }
    PG8_WAIT_V(0);
    PG8_BAR;
#undef PG8_SA
#undef PG8_SB
#undef PG8_STAGE_A
#undef PG8_STAGE_B
#undef PG8_LDA
#undef PG8_LDB
#undef PG8_MMA
#undef PG8_WAIT_V
#undef PG8_WAIT_L
#undef PG8_BAR
#undef PG8_SCHED
#undef PG8_PACK
}

struct DenseOrder {
    static constexpr bool GATHER = false;
    int nM, nN, nwg, G, c; const char* Bt; int K;
    __device__ void init(int M, int N, int K_, const bf16_t* Bt_, int G_, int c_) { nM = M / BM; nN = N / BM; nwg = nM * nN; G = G_; c = c_; Bt = (const char*)Bt_; K = K_; }
    __device__ __forceinline__ bool next(int i, Unit& u) const {
        const long L = (long)i * G + c; if (L >= nwg) return false;
        int wgid = (int)L; { const int q = nwg / 8, r = nwg % 8, xcd = wgid % 8, off = wgid / 8; wgid = (xcd < r ? xcd * (q + 1) : r * (q + 1) + (xcd - r) * q) + off; }
        const int nig = 8 * nN, gid = wgid / nig, fm = gid * 8, gsz = (nM - fm) < 8 ? (nM - fm) : 8;
        u.pm = fm + ((wgid % nig) % gsz); u.pn = (wgid % nig) / gsz;
        u.arow0 = u.pm * BM; u.nrows = BM; u.e = 0; u.ui = i;
        u.bptr = Bt + (size_t)u.pn * BM * K * 2;
        return true;
    }
    __device__ __forceinline__ int arow(const Unit& u, int r) const { return u.arow0 + r; }
};
}

struct EpiH {
    static constexpr bool PERM = true;
    bf16_t* H;
    __device__ __forceinline__ void operator()(const f32x4 (&acc)[2][2][4][2], const pg8::Unit& u, int wr, int wc, int fr, int fq) const {
        const int row0 = u.arow0 + wr * 64 + fr, col0 = u.pn * 256 + wc * 32 + 8 * fq;
#pragma unroll
        for (int ai = 0; ai < 2; ++ai)
#pragma unroll
            for (int m = 0; m < 4; ++m) {
                bf16_t* rowp = H + (size_t)(row0 + ai * 128 + m * 16) * HLD + col0;
#pragma unroll
                for (int bj = 0; bj < 2; ++bj) {
                    const f32x4 v0 = acc[ai][bj][m][0], v1 = acc[ai][bj][m][1];
                    u32x4 w; w.x = pg8::cvt_pk_bf16(v0[0], v0[1]); w.y = pg8::cvt_pk_bf16(v0[2], v0[3]); w.z = pg8::cvt_pk_bf16(v1[0], v1[1]); w.w = pg8::cvt_pk_bf16(v1[2], v1[3]);
                    *(u32x4*)(rowp + bj * 128) = w;
                }
            }
    }
};
struct EpiRes {
    static constexpr bool PERM = false;
    const float* xin; float* out;
    __device__ __forceinline__ void operator()(const f32x4 (&acc)[2][2][4][2], const pg8::Unit& u, int wr, int wc, int fr, int fq) const {
        const int row0 = u.arow0 + wr * 64 + fr, col0 = u.pn * 256 + wc * 32 + 4 * fq;
#pragma unroll
        for (int ai = 0; ai < 2; ++ai)
#pragma unroll
            for (int m = 0; m < 4; ++m) {
                const size_t off = (size_t)(row0 + ai * 128 + m * 16) * DM + col0;
#pragma unroll
                for (int bj = 0; bj < 2; ++bj)
#pragma unroll
                    for (int n = 0; n < 2; ++n) {
                        const f32x4 xv = *(const f32x4*)(xin + off + bj * 128 + n * 16);
                        *(f32x4*)(out + off + bj * 128 + n * 16) = xv * ALPHA + acc[ai][bj][m][n];
                    }
            }
    }
};

template <class RM>
__device__ __forceinline__ void transpose_item(const float* W, int K, int N, bf16_t* WT, RM rowmap, float* scr, int kb, int nb, int lane) {
    const int k0 = 64 * kb, n0 = 32 * nb;
    const int nn = n0 + (lane & 31);
#pragma unroll 8
    for (int i = 0; i < 32; ++i) {
        const int kk = 2 * i + (lane >> 5);
        scr[kk * 33 + (lane & 31)] = nn < N ? W[(size_t)(k0 + kk) * N + nn] : 0.f;
    }
    wave_sync();
    const int c = lane & 7;
#pragma unroll
    for (int j = 0; j < 4; ++j) {
        const int n = (lane >> 3) + 8 * j;
        const float* s = scr + (8 * c) * 33 + n;
        u32x4 o; o.x = pk2(s[0 * 33], s[1 * 33]); o.y = pk2(s[2 * 33], s[3 * 33]); o.z = pk2(s[4 * 33], s[5 * 33]); o.w = pk2(s[6 * 33], s[7 * 33]);
        const int dr = (n0 + n < N) ? rowmap(n0 + n) : -1;
        if (dr >= 0) *(u32x4*)(WT + (size_t)dr * K + k0 + 8 * c) = o;
    }
    wave_sync();
}

__device__ void phase_prologue(KA ka, float* smem) {
    PHASE_IDS
    const int lane = TID & 63, w = TID >> 6;
    float* scr = smem + w * 4096;
    const int gw = BID * NW + w, NGW = gridDim.x * NW;
    constexpr int I_IN = 16 * 89, I_OUT = 16 * 32, I_GU = 16 * 16, I_DN = 8 * 32;
    constexpr int I_LAYER = I_IN + I_OUT + 32 * I_GU + 16 * I_DN;
    for (int it = gw; it < 2 * I_LAYER; it += NGW) {
        const int layer = it / I_LAYER; int r = it % I_LAYER;
        bf16_t* WT = PF(WT) + (size_t)layer * WT_LAYER;
        if (r < I_IN) {
            transpose_item(PF(w_in) + (size_t)layer * DM * IC_SRC, DM, IC_SRC, WT + WT_IN,
                           [](int n) { return n < 1792 ? n : (n < 1816 ? 2816 + (n - 1792) : n - 24); }, scr, r / 89, r % 89, lane);
            continue;
        }
        r -= I_IN;
        if (r < I_OUT) {
            transpose_item(PF(w_out) + (size_t)layer * DM * DM, DM, DM, WT + WT_OUT, [](int n) { return n; }, scr, r / 32, r % 32, lane);
            continue;
        }
        r -= I_OUT;
        if (r < 32 * I_GU) {
            const int mat = r / I_GU, rr = r % I_GU, e = mat >> 1, isup = mat & 1;
            const float* W = (isup ? PF(w_up) : PF(w_gate)) + ((size_t)layer * 16 + e) * DM * 512;
            transpose_item(W, DM, 512, WT + WT_UP + (size_t)e * 1024 * 1024,
                           [isup](int n) { return (n >> 7) * 256 + isup * 128 + (n & 127); }, scr, rr / 16, rr % 16, lane);
            continue;
        }
        r -= 32 * I_GU;
        {
            const int e = r / I_DN, rr = r % I_DN;
            transpose_item(PF(w_down) + ((size_t)layer * 16 + e) * 512 * DM, 512, DM, WT + WT_DN + (size_t)e * 1024 * 512,
                           [](int n) { return n; }, scr, rr / 32, rr % 32, lane);
        }
    }
    for (int i = BID * NTHR + TID; i < 2 * 232 * 128; i += gridDim.x * NTHR) {
        const int layer = i / (232 * 128), q = i % (232 * 128);
        u32x4 z; z.x = 0u; z.y = 0u; z.z = 0u; z.w = 0u;
        *(u32x4*)(PF(WT) + (size_t)layer * WT_LAYER + WT_IN + (size_t)2840 * 1024 + (size_t)q * 8) = z;
    }
    for (int row = gw; row < NTOK; row += NGW) {
        const f32x4* xr = (const f32x4*)(PF(x) + (size_t)row * DM) + lane;
        u32x2* o = (u32x2*)(PF(XB) + (size_t)row * DM) + lane;
#pragma unroll
        for (int j = 0; j < 4; ++j) {
            const f32x4 v = xr[64 * j];
            u32x2 ww; ww.x = pk2(v[0], v[1]); ww.y = pk2(v[2], v[3]);
            o[64 * j] = ww;
        }
    }
}

template <class AF, class BF, class EF>
__device__ __forceinline__ void gemm128(int tid, int m0, int n0, int M, int N, int K, AF af, BF bf, EF ef, float* smem) {
    float* As = smem;
    float* Bs = smem + 16 * 132;
    const bool active = tid < 256;
    const int tx = tid & 15, ty = (tid >> 4) & 15;
    float acc[8][8];
#pragma unroll
    for (int i = 0; i < 8; i++)
#pragma unroll
        for (int j = 0; j < 8; j++) acc[i][j] = 0.f;
#pragma unroll 1
    for (int k0 = 0; k0 < K; k0 += 16) {
        if (active) {
#pragma unroll
            for (int i = 0; i < 8; i++) {
                int e = tid + i * 256;
                int r = e >> 4, kk = e & 15;
                float v = 0.f;
                if (m0 + r < M) v = af(m0 + r, k0 + kk);
                As[kk * 132 + r] = v;
            }
#pragma unroll
            for (int i = 0; i < 8; i++) {
                int e = tid + i * 256;
                int kk = e >> 7, c = e & 127;
                float v = 0.f;
                if (n0 + c < N) v = bf(k0 + kk, n0 + c);
                Bs[kk * 132 + c] = v;
            }
        }
        __syncthreads();
        if (active) {
#pragma unroll 2
            for (int kk = 0; kk < 16; kk++) {
                asm volatile("" ::: "memory");
                float4 a0 = *(const float4*)&As[kk * 132 + ty * 8];
                float4 a1 = *(const float4*)&As[kk * 132 + ty * 8 + 4];
                float4 b0 = *(const float4*)&Bs[kk * 132 + tx * 8];
                float4 b1 = *(const float4*)&Bs[kk * 132 + tx * 8 + 4];
                float a[8] = {a0.x, a0.y, a0.z, a0.w, a1.x, a1.y, a1.z, a1.w};
                float b[8] = {b0.x, b0.y, b0.z, b0.w, b1.x, b1.y, b1.z, b1.w};
#pragma unroll
                for (int i = 0; i < 8; i++)
#pragma unroll
                    for (int j = 0; j < 8; j++) acc[i][j] = fmaf(a[i], b[j], acc[i][j]);
            }
        }
        __syncthreads();
    }
    if (active) {
#pragma unroll
        for (int i = 0; i < 8; i++)
#pragma unroll
            for (int j = 0; j < 8; j++) {
                int m = m0 + ty * 8 + i, n = n0 + tx * 8 + j;
                if (m < M && n < N) ef(m, n, acc[i][j]);
            }
    }
}

__device__ __forceinline__ void phase_inproj(KA ka, int layer, LAS unsigned char* lds) {
    pg8::DenseOrder S; S.init(NTOK, HLD, DM, PF(WT) + (size_t)layer * WT_LAYER + WT_IN, gridDim.x, blockIdx.x);
    EpiH E{PF(H)};
    pg8::gemm_phase<EpiH, pg8::DenseOrder>(lds, (const char*)PF(XB), DM, S, E);
}
__device__ __forceinline__ void phase_outproj(KA ka, int layer, const float* xin, float* x1, LAS unsigned char* lds) {
    pg8::DenseOrder S; S.init(NTOK, DM, DM, PF(WT) + (size_t)layer * WT_LAYER + WT_OUT, gridDim.x, blockIdx.x);
    EpiRes E{xin, x1};
    pg8::gemm_phase<EpiRes, pg8::DenseOrder>(lds, (const char*)PF(Y), DM, S, E);
}

__device__ void phase_gmlp(KA ka, int layer, float* smem) {
    PHASE_IDS
    float* V = smem;
    const int tid = TID, lane = tid & 63, w = tid >> 6;
    const float* gain = PF(gm_v_gain) + layer * 256;
    const float* bias = PF(gm_v_bias) + layer * 256;
    const float* ws = PF(gm_w_s) + (size_t)layer * 4 * 128 * 128;
    const float* bs = PF(gm_b_s) + layer * 4 * 128;
    const bf16_t* H = PF(H);
    for (int item = BID; item < 512; item += gridDim.x) {
        int g = item & 3, c = (item >> 2) & 63, b = item >> 8;
        size_t tok0 = (size_t)b * T_ + (size_t)c * 128;
        __syncthreads();
        for (int i = 0; i < 16; i++) {
            int s = w * 16 + i;
            float x = bf2f(H[(tok0 + s) * HLD + C_GV + g * 64 + lane]);
            float ge = gelu_t(x);
            float mu = wave_sum(ge) * (1.f / 64.f);
            float dl = ge - mu;
            float var = wave_sum(dl * dl) * (1.f / 64.f);
            V[s * 64 + lane] = dl * rsqrtf(var + 1e-5f) * gain[g * 64 + lane] + bias[g * 64 + lane];
        }
        __syncthreads();
        for (int i = 0; i < 16; i++) {
            int t = w + 8 * i;
            const float* wr = ws + ((size_t)g * 128 + t) * 128;
            float acc = 0.f;
            for (int s = 0; s <= t; s++) acc = fmaf(wr[s], V[s * 64 + lane], acc);
            acc += bs[g * 128 + t];
            float u = gelu_t(bf2f(H[(tok0 + t) * HLD + C_GU + g * 64 + lane]));
            PF(Y)[(tok0 + t) * DM + g * 64 + lane] = f2bf(u * acc);
        }
    }
}

__device__ void phase_compress(KA ka, int layer, float* smem) {
    PHASE_IDS
    const bf16_t* H = PF(H);
    for (int item = BID; item < 32; item += gridDim.x) {
        int which = item >> 4, mt = item & 15;
        const float* pos = PF(cmp_pos) + ((size_t)layer * 2 + which) * 32 * 64;
        const float* w1 = PF(cmp_w1) + ((size_t)layer * 2 + which) * 2048 * 128;
        const float* w2 = PF(cmp_w2) + ((size_t)layer * 2 + which) * 128 * 64;
        float* G = PF(gbuf) + (size_t)which * 2044 * 128;
        float* O = (which == 0 ? PF(kcmp) : PF(vcmp));
        const int colbase = (which == 0 ? C_KC : C_VC);
        gemm128(TID, mt * 128, 0, 2044, 128, 2048,
                [&](int r, int k) {
                    int n = r % NCMP, bh = r / NCMP;
                    int hk = bh & 1, b = bh >> 1;
                    int l = k >> 6, d = k & 63;
                    size_t tok = (size_t)b * T_ + n * 16 + l;
                    return bf2f(H[tok * HLD + colbase + hk * 64 + d]) + pos[l * 64 + d];
                },
                [&](int k, int n) { return w1[(size_t)k * 128 + n]; },
                [&](int r, int n, float v) { G[(size_t)r * 128 + n] = gelu_t(v); }, smem);
        __threadfence_block();
        __syncthreads();
        gemm128(TID, mt * 128, 0, 2044, 64, 128,
                [&](int r, int k) { return G[(size_t)r * 128 + k]; },
                [&](int k, int n) { return w2[(size_t)k * 64 + n]; },
                [&](int r, int n, float v) { O[(size_t)r * 64 + n] = v; }, smem);
    }
}

__device__ void phase_hgrn(KA ka, int layer, float* smem) {
    PHASE_IDS
    float* Q = smem;
    float* F = smem + 2048;
    float* K = smem + 4096;
    float* I = smem + 6144;
    const int tid = TID, lane = tid & 63, w = tid >> 6;
    const int v = (w & 3) * 16 + (lane & 15), dq = lane >> 4;
    const bf16_t* H = PF(H);
    for (int item = BID; item < 8; item += gridDim.x) {
        int h = item & 3, b = item >> 2;
        float S[16];
#pragma unroll
        for (int j = 0; j < 16; j++) S[j] = 0.f;
        for (int t0 = 0; t0 < T_; t0 += 32) {
            __syncthreads();
            for (int i = 0; i < 4; i++) {
                int e = tid + i * NTHR;
                int ts = e >> 6, d = e & 63;
                size_t tok = (size_t)b * T_ + t0 + ts;
                float lb = 0.f;
                if (layer == 1) {
                    float h0 = PF(hg_lower)[h * 64 + d], h1 = PF(hg_lower)[256 + h * 64 + d];
                    float mx = fmaxf(h0, h1);
                    float e0 = expf(h0 - mx), e1 = expf(h1 - mx);
                    lb = e1 / (e0 + e1);
                }
                float fl = bf2f(H[tok * HLD + C_HF + h * 64 + d]);
                float sg = 1.f / (1.f + expf(-fl));
                float sgn = 1.f / (1.f + expf(fl));
                F[e] = lb + (1.f - lb) * sg;
                K[e] = (1.f - lb) * sgn;
                Q[e] = bf2f(H[tok * HLD + C_HQ + h * 64 + d]);
                I[e] = bf2f(H[tok * HLD + C_HI + h * 64 + d]);
            }
            __syncthreads();
            if (w < 4) {
                for (int ts = 0; ts < 32; ts++) {
                    float iv = I[ts * 64 + v];
                    float part = 0.f;
#pragma unroll
                    for (int j4 = 0; j4 < 4; j4++) {
                        float4 f4 = *(const float4*)&F[ts * 64 + dq * 16 + j4 * 4];
                        float4 k4 = *(const float4*)&K[ts * 64 + dq * 16 + j4 * 4];
                        float4 q4 = *(const float4*)&Q[ts * 64 + dq * 16 + j4 * 4];
                        S[j4 * 4 + 0] = fmaf(f4.x, S[j4 * 4 + 0], k4.x * iv); part = fmaf(q4.x, S[j4 * 4 + 0], part);
                        S[j4 * 4 + 1] = fmaf(f4.y, S[j4 * 4 + 1], k4.y * iv); part = fmaf(q4.y, S[j4 * 4 + 1], part);
                        S[j4 * 4 + 2] = fmaf(f4.z, S[j4 * 4 + 2], k4.z * iv); part = fmaf(q4.z, S[j4 * 4 + 2], part);
                        S[j4 * 4 + 3] = fmaf(f4.w, S[j4 * 4 + 3], k4.w * iv); part = fmaf(q4.w, S[j4 * 4 + 3], part);
                    }
                    part += __shfl_xor(part, 16);
                    part += __shfl_xor(part, 32);
                    if (dq == 0) PF(Y)[((size_t)b * T_ + t0 + ts) * DM + 768 + h * 64 + v] = f2bf(part);
                }
            }
        }
    }
}
struct AttnState { float m[4], l[4], o[4]; };

__device__ __forceinline__ void attend64(AttnState& st, const float* qs, float* pl, const bf16_t* H, size_t rowbase,
                                         int tok0, int tmax, int tmin, int kcol, int vcol, int lane) {
    int tok = tok0 + lane;
    bool valid = (tok <= tmax) && (tok >= tmin);
    int tokc = tok > tmax ? tmax : tok;
    const uint4* kr = (const uint4*)(H + (rowbase + tokc) * HLD + kcol);
    float s[4] = {0.f, 0.f, 0.f, 0.f};
#pragma unroll 2
    for (int c = 0; c < 8; c++) {
        asm volatile("" ::: "memory");
        uint4 u = kr[c];
        unsigned uu[4] = {u.x, u.y, u.z, u.w};
#pragma unroll
        for (int e = 0; e < 4; e++) {
            float k0 = __uint_as_float(uu[e] << 16), k1 = __uint_as_float(uu[e] & 0xffff0000u);
            int d = c * 8 + e * 2;
#pragma unroll
            for (int g = 0; g < 4; g++) {
                s[g] = fmaf(qs[g * 64 + d], k0, s[g]);
                s[g] = fmaf(qs[g * 64 + d + 1], k1, s[g]);
            }
        }
    }
    float pr[4], alpha[4];
#pragma unroll
    for (int g = 0; g < 4; g++) {
        float sv = valid ? s[g] * 0.125f : NEG_INF;
        float mn = fmaxf(st.m[g], wave_max(sv));
        alpha[g] = __expf(st.m[g] - mn);
        pr[g] = valid ? __expf(sv - mn) : 0.f;
        st.l[g] = st.l[g] * alpha[g] + wave_sum(pr[g]);
        st.m[g] = mn;
        st.o[g] *= alpha[g];
    }
    *(float4*)&pl[lane * 4] = make_float4(pr[0], pr[1], pr[2], pr[3]);
    wave_sync();
    int jmax = tmax - tok0; if (jmax > 63) jmax = 63;
    for (int j = 0; j <= jmax; j++) {
        float vv = bf2f(H[(rowbase + tok0 + j) * HLD + vcol + lane]);
        float4 p4 = *(const float4*)&pl[j * 4];
        st.o[0] = fmaf(p4.x, vv, st.o[0]);
        st.o[1] = fmaf(p4.y, vv, st.o[1]);
        st.o[2] = fmaf(p4.z, vv, st.o[2]);
        st.o[3] = fmaf(p4.w, vv, st.o[3]);
    }
    wave_sync();
}

__device__ void phase_nsa(KA ka, int layer, float* smem) {
    PHASE_IDS
    const int lane = TID & 63, w = TID >> 6;
    float* sm = smem + w * 3328;
    float* qs = sm;
    float* S = sm + 256;
    float* PS = sm + 2304;
    float* IMP = sm + 2816;
    float* PL = sm + 2944;
    int* SEL = (int*)(sm + 3200);
    const bf16_t* H = PF(H);
    const float* gate_b = PF(nsa_gate_b) + layer * 24;
    for (int item = BID * NW + w; item < 32768; item += gridDim.x * NW) {
        const int t = item & 8191, hk = (item >> 13) & 1, b = item >> 14;
        const size_t rowbase = (size_t)b * T_;
        const size_t tok = rowbase + t;
        wave_sync();
#pragma unroll
        for (int g = 0; g < 4; g++) qs[g * 64 + lane] = bf2f(H[tok * HLD + C_NQ + (hk * 4 + g) * 64 + lane]);
        wave_sync();
        const float* kc = PF(kcmp) + (size_t)(b * 2 + hk) * NCMP * 64;
        const float* vc = PF(vcmp) + (size_t)(b * 2 + hk) * NCMP * 64;
        int nvalid = t >= 31 ? ((t - 31) >> 4) + 1 : 0;
        if (nvalid > NCMP) nvalid = NCMP;
        float mx[4] = {NEG_INF, NEG_INF, NEG_INF, NEG_INF};
        for (int r = 0; r * 64 < nvalid; r++) {
            int n = r * 64 + lane;
            int nc = n < nvalid ? n : nvalid - 1;
            const float4* kr = (const float4*)(kc + (size_t)nc * 64);
            float s[4] = {0.f, 0.f, 0.f, 0.f};
#pragma unroll 2
            for (int c = 0; c < 16; c++) {
                asm volatile("" ::: "memory");
                float4 k4 = kr[c];
#pragma unroll
                for (int g = 0; g < 4; g++) {
                    float4 q4 = *(const float4*)&qs[g * 64 + c * 4];
                    s[g] = fmaf(q4.x, k4.x, s[g]); s[g] = fmaf(q4.y, k4.y, s[g]);
                    s[g] = fmaf(q4.z, k4.z, s[g]); s[g] = fmaf(q4.w, k4.w, s[g]);
                }
            }
#pragma unroll
            for (int g = 0; g < 4; g++) {
                float sv = n < nvalid ? s[g] * 0.125f : NEG_INF;
                S[g * 512 + n] = sv;
                mx[g] = fmaxf(mx[g], sv);
            }
        }
        float ocmp[4] = {0.f, 0.f, 0.f, 0.f};
        for (int r = 0; r < 8; r++) PS[r * 64 + lane] = 0.f;
        if (nvalid > 0) {
            float sum[4] = {0.f, 0.f, 0.f, 0.f};
#pragma unroll
            for (int g = 0; g < 4; g++) mx[g] = wave_max(mx[g]);
            for (int r = 0; r * 64 < nvalid; r++) {
                int n = r * 64 + lane;
#pragma unroll
                for (int g = 0; g < 4; g++) {
                    float e = n < nvalid ? __expf(S[g * 512 + n] - mx[g]) : 0.f;
                    S[g * 512 + n] = e;
                    sum[g] += e;
                }
            }
            float inv[4];
#pragma unroll
            for (int g = 0; g < 4; g++) inv[g] = 1.f / wave_sum(sum[g]);
            for (int r = 0; r * 64 < nvalid; r++) {
                int n = r * 64 + lane;
                float ps = 0.f;
#pragma unroll
                for (int g = 0; g < 4; g++) {
                    float pv = S[g * 512 + n] * inv[g];
                    S[g * 512 + n] = pv;
                    ps += pv;
                }
                PS[n] = ps;
            }
            wave_sync();
            for (int n = 0; n < nvalid; n++) {
                float vv = vc[(size_t)n * 64 + lane];
                ocmp[0] = fmaf(S[n], vv, ocmp[0]);
                ocmp[1] = fmaf(S[512 + n], vv, ocmp[1]);
                ocmp[2] = fmaf(S[1024 + n], vv, ocmp[2]);
                ocmp[3] = fmaf(S[1536 + n], vv, ocmp[3]);
            }
        }
        wave_sync();
        const int cur = t >> 6;
        float iv[2];
#pragma unroll
        for (int q = 0; q < 2; q++) {
            int j = lane + q * 64;
            float a = 0.f;
#pragma unroll
            for (int dn = -1; dn <= 3; dn++) {
                int n = 4 * j + dn;
                if (n >= 0 && n < NCMP) a += PS[n];
            }
            bool forced = (j == 0) || (j == cur) || (j == cur - 1);
            float val = (j <= cur) ? (a + (forced ? 1e4f : 0.f)) : NEG_INF;
            iv[q] = val;
            IMP[j] = val;
        }
        wave_sync();
        int c0 = 0, c1 = 0;
        for (int jj = 0; jj < 128; jj++) {
            float xv = IMP[jj];
            c0 += (xv > iv[0]) || (xv == iv[0] && jj < lane);
            c1 += (xv > iv[1]) || (xv == iv[1] && jj < lane + 64);
        }
        bool s0 = (c0 < 16) && (iv[0] > 0.5f * NEG_INF);
        bool s1 = (c1 < 16) && (iv[1] > 0.5f * NEG_INF);
        unsigned long long m0 = __ballot(s0), m1 = __ballot(s1);
        unsigned long long lower = (lane == 0) ? 0ull : (~0ull >> (64 - lane));
        if (s0) SEL[__popcll(m0 & lower)] = lane;
        if (s1) SEL[__popcll(m0) + __popcll(m1 & lower)] = lane + 64;
        const int nsel = __popcll(m0) + __popcll(m1);
        wave_sync();
        AttnState st;
#pragma unroll
        for (int g = 0; g < 4; g++) { st.m[g] = NEG_INF; st.l[g] = 0.f; st.o[g] = 0.f; }
        for (int si = 0; si < nsel; si++) {
            int jb = SEL[si];
            attend64(st, qs, PL, H, rowbase, jb * 64, t, 0, C_KS + hk * 64, C_VS + hk * 64, lane);
        }
        float oslc[4];
#pragma unroll
        for (int g = 0; g < 4; g++) oslc[g] = st.o[g] / st.l[g];
#pragma unroll
        for (int g = 0; g < 4; g++) { st.m[g] = NEG_INF; st.l[g] = 0.f; st.o[g] = 0.f; }
        const int wstart = t - 511 > 0 ? t - 511 : 0;
        for (int tk = wstart; tk <= t; tk += 64)
            attend64(st, qs, PL, H, rowbase, tk, t, wstart, C_KW + hk * 64, C_VW + hk * 64, lane);
#pragma unroll
        for (int g = 0; g < 4; g++) {
            int hh = hk * 4 + g;
            float g0 = sigmoidf_(bf2f(H[tok * HLD + C_NG + hh * 3 + 0]) + gate_b[hh * 3 + 0]);
            float g1 = sigmoidf_(bf2f(H[tok * HLD + C_NG + hh * 3 + 1]) + gate_b[hh * 3 + 1]);
            float g2 = sigmoidf_(bf2f(H[tok * HLD + C_NG + hh * 3 + 2]) + gate_b[hh * 3 + 2]);
            float ow = st.o[g] / st.l[g];
            PF(Y)[tok * DM + 256 + hh * 64 + lane] = f2bf(g0 * ocmp[g] + g1 * oslc[g] + g2 * ow);
        }
    }
}

__device__ void phase_headnorm(KA ka, int layer) {
    PHASE_IDS
    const int lane = TID & 63, w = TID >> 6;
    const float* og = PF(out_gain) + layer * 1024;
    for (int row = BID * NW + w; row < NTOK; row += gridDim.x * NW) {
#pragma unroll
        for (int hd = 0; hd < 16; hd++) {
            float v = bf2f(PF(Y)[(size_t)row * DM + hd * 64 + lane]);
            float ms = wave_sum(v * v) * (1.f / 64.f);
            float y = v * rsqrtf(ms + 1e-6f) * og[hd * 64 + lane];
            if (hd >= 12) {
                float hg = bf2f(PF(H)[(size_t)row * HLD + C_HG + (hd - 12) * 64 + lane]);
                y *= hg * sigmoidf_(hg);
            }
            PF(Y)[(size_t)row * DM + hd * 64 + lane] = f2bf(y);
        }
    }
}

__device__ void phase_ln1_route(KA ka, int layer, float* x1) {
    PHASE_IDS
    const int lane = TID & 63, w = TID >> 6;
    const float* g = PF(ln1_g) + layer * 1024;
    const float* bb = PF(ln1_b) + layer * 1024;
    const float* wg = PF(rg_w) + (size_t)layer * 1024 * 4;
    const float* we = PF(re_w) + (size_t)layer * 1024 * 16;
    const float* bg = PF(rg_b) + layer * 4;
    const float* be = PF(re_b) + layer * 16;
    int* cnt = (int*)(PF(ctl) + CW_CNT) + layer * 16;
    for (int row = BID * NW + w; row < NTOK; row += gridDim.x * NW) {
        float v[16];
        float s = 0.f;
#pragma unroll
        for (int i = 0; i < 16; i++) { v[i] = x1[(size_t)row * DM + i * 64 + lane]; s += v[i]; }
        float mu = wave_sum(s) * (1.f / 1024.f);
        float q = 0.f;
#pragma unroll
        for (int i = 0; i < 16; i++) { float d = v[i] - mu; q += d * d; }
        float rstd = rsqrtf(wave_sum(q) * (1.f / 1024.f) + 1e-5f);
        float lg[4] = {0.f, 0.f, 0.f, 0.f};
        float le[16];
#pragma unroll
        for (int e = 0; e < 16; e++) le[e] = 0.f;
#pragma unroll
        for (int i = 0; i < 16; i++) {
            int c = i * 64 + lane;
            float o = (v[i] - mu) * rstd * g[c] + bb[c];
            x1[(size_t)row * DM + c] = o;
            float4 w4 = *(const float4*)&wg[c * 4];
            lg[0] = fmaf(o, w4.x, lg[0]); lg[1] = fmaf(o, w4.y, lg[1]);
            lg[2] = fmaf(o, w4.z, lg[2]); lg[3] = fmaf(o, w4.w, lg[3]);
#pragma unroll
            for (int e4 = 0; e4 < 4; e4++) {
                float4 x4 = *(const float4*)&we[c * 16 + e4 * 4];
                le[e4 * 4 + 0] = fmaf(o, x4.x, le[e4 * 4 + 0]);
                le[e4 * 4 + 1] = fmaf(o, x4.y, le[e4 * 4 + 1]);
                le[e4 * 4 + 2] = fmaf(o, x4.z, le[e4 * 4 + 2]);
                le[e4 * 4 + 3] = fmaf(o, x4.w, le[e4 * 4 + 3]);
            }
        }
#pragma unroll
        for (int c = 0; c < 4; c++) lg[c] = wave_sum(lg[c]) + bg[c];
#pragma unroll
        for (int e = 0; e < 16; e++) le[e] = wave_sum(le[e]) + be[e];
        float gm = fmaxf(fmaxf(lg[0], lg[1]), fmaxf(lg[2], lg[3]));
        float ge[4], gs = 0.f;
#pragma unroll
        for (int c = 0; c < 4; c++) { ge[c] = __expf(lg[c] - gm); gs += ge[c]; }
        int gi = 0; float gbest = ge[0];
#pragma unroll
        for (int c = 1; c < 4; c++) if (ge[c] > gbest) { gbest = ge[c]; gi = c; }
        float gval = gbest / gs;
        float ls[4];
#pragma unroll
        for (int e = 0; e < 4; e++) ls[e] = gi == 0 ? le[e] : gi == 1 ? le[4 + e] : gi == 2 ? le[8 + e] : le[12 + e];
        float em = fmaxf(fmaxf(ls[0], ls[1]), fmaxf(ls[2], ls[3]));
        float pe[4];
#pragma unroll
        for (int e = 0; e < 4; e++) pe[e] = __expf(ls[e] - em);
        int i1 = 0; float b1 = pe[0];
#pragma unroll
        for (int e = 1; e < 4; e++) if (pe[e] > b1) { b1 = pe[e]; i1 = e; }
        int i2 = -1; float b2 = -1.f;
#pragma unroll
        for (int e = 0; e < 4; e++) if (e != i1 && pe[e] > b2) { b2 = pe[e]; i2 = e; }
        float w1 = gval * b1 / (b1 + b2), w2 = gval * b2 / (b1 + b2);
        if (lane == 0) {
            int e1 = gi * 4 + i1, e2 = gi * 4 + i2;
            int p1 = atomicAdd(&cnt[e1], 1);
            PF(list_tok)[e1 * NTOK + p1] = row; PF(list_w)[e1 * NTOK + p1] = w1;
            int p2 = atomicAdd(&cnt[e2], 1);
            PF(list_tok)[e2 * NTOK + p2] = row; PF(list_w)[e2 * NTOK + p2] = w2;
        }
    }
}

__device__ __forceinline__ bool moe_item(const int* cnt, int item, int ntn, int& e, int& mt, int& nt, int& base) {
    int acc = 0, b = 0;
    for (int ee = 0; ee < 16; ee++) {
        int c = __hip_atomic_load(&cnt[ee], __ATOMIC_RELAXED, __HIP_MEMORY_SCOPE_AGENT);
        int tiles = ((c + 127) >> 7) * ntn;
        if (item < acc + tiles) {
            int li = item - acc;
            e = ee; mt = li / ntn; nt = li % ntn; base = b;
            return true;
        }
        acc += tiles; b += c;
    }
    return false;
}

__device__ void phase_moe_up(KA ka, int layer, const float* x1, float* hidden, float* accbuf, float* smem) {
    PHASE_IDS
    {
        float4* a4 = (float4*)accbuf;
        for (size_t i = (size_t)BID * NTHR + TID; i < (size_t)NTOK * DM / 4; i += (size_t)gridDim.x * NTHR)
            a4[i] = make_float4(0.f, 0.f, 0.f, 0.f);
    }
    const int* cnt = (int*)(PF(ctl) + CW_CNT) + layer * 16;
    for (int item = BID;; item += gridDim.x) {
        int e, mt, nt, base;
        if (!moe_item(cnt, item, 4, e, mt, nt, base)) break;
        int c = __hip_atomic_load(&cnt[e], __ATOMIC_RELAXED, __HIP_MEMORY_SCOPE_AGENT);
        const int* lt = PF(list_tok) + e * NTOK;
        const float* Wg = PF(w_gate) + ((size_t)layer * 16 + e) * DM * 512;
        const float* Wu = PF(w_up) + ((size_t)layer * 16 + e) * DM * 512;
        float* hb = hidden + (size_t)base * 512;
        gemm128(TID, mt * 128, nt * 128, c, 512, DM,
                [&](int r, int k) { return x1[(size_t)lt[r] * DM + k]; },
                [&](int k, int n) { return Wg[(size_t)k * 512 + n]; },
                [&](int r, int n, float v) { hb[(size_t)r * 512 + n] = v * sigmoidf_(v); }, smem);
        gemm128(TID, mt * 128, nt * 128, c, 512, DM,
                [&](int r, int k) { return x1[(size_t)lt[r] * DM + k]; },
                [&](int k, int n) { return Wu[(size_t)k * 512 + n]; },
                [&](int r, int n, float v) { hb[(size_t)r * 512 + n] *= v; }, smem);
    }
}

__device__ void phase_moe_down(KA ka, int layer, const float* hidden, float* accbuf, float* smem) {
    PHASE_IDS
    const int* cnt = (int*)(PF(ctl) + CW_CNT) + layer * 16;
    for (int item = BID;; item += gridDim.x) {
        int e, mt, nt, base;
        if (!moe_item(cnt, item, 8, e, mt, nt, base)) break;
        int c = __hip_atomic_load(&cnt[e], __ATOMIC_RELAXED, __HIP_MEMORY_SCOPE_AGENT);
        const int* lt = PF(list_tok) + e * NTOK;
        const float* lw = PF(list_w) + e * NTOK;
        const float* Wd = PF(w_down) + ((size_t)layer * 16 + e) * 512 * DM;
        const float* hb = hidden + (size_t)base * 512;
        gemm128(TID, mt * 128, nt * 128, c, DM, 512,
                [&](int r, int k) { return hb[(size_t)r * 512 + k]; },
                [&](int k, int n) { return Wd[(size_t)k * DM + n]; },
                [&](int r, int n, float v) { atomicAdd(&accbuf[(size_t)lt[r] * DM + n], lw[r] * v); }, smem);
    }
}

__device__ void phase_ln2(KA ka, int layer, const float* x1, const float* accbuf, float* xo) {
    PHASE_IDS
    bf16_t* xb = PF(XB);
    const int lane = TID & 63, w = TID >> 6;
    const float* g = PF(ln2_g) + layer * 1024;
    const float* bb = PF(ln2_b) + layer * 1024;
    for (int row = BID * NW + w; row < NTOK; row += gridDim.x * NW) {
        float v[16];
        float s = 0.f;
#pragma unroll
        for (int i = 0; i < 16; i++) {
            size_t idx = (size_t)row * DM + i * 64 + lane;
            v[i] = ALPHA * x1[idx] + accbuf[idx];
            s += v[i];
        }
        float mu = wave_sum(s) * (1.f / 1024.f);
        float q = 0.f;
#pragma unroll
        for (int i = 0; i < 16; i++) { float d = v[i] - mu; q += d * d; }
        float rstd = rsqrtf(wave_sum(q) * (1.f / 1024.f) + 1e-5f);
#pragma unroll
        for (int i = 0; i < 16; i++) {
            int c = i * 64 + lane;
            const float o = (v[i] - mu) * rstd * g[c] + bb[c];
            xo[(size_t)row * DM + c] = o;
            xb[(size_t)row * DM + c] = f2bf(o);
        }
    }
}


#ifndef ONLY_Q
#define ONLY_Q -2
#endif
#ifndef QMASK
#define QMASK 0x3ff
#endif
#define QON(k) ((ONLY_Q == -2 && ((QMASK >> ((k) + 1)) & 1)) || ONLY_Q == (k))
#ifndef NPH_TOTAL
#define NPH_TOTAL 19
#endif
__global__ void __launch_bounds__(NTHR, 2) k_mega(P p0) {
    extern __shared__ __attribute__((aligned(16))) unsigned char lds_raw[];
    LAS unsigned char* lds = (LAS unsigned char*)lds_raw;
    float* smem = (float*)lds_raw;
    volatile LAS unsigned* misc = (volatile LAS unsigned*)(lds + LDS_MISC);
    if (threadIdx.x < 16) misc[threadIdx.x] = 0u;
    __syncthreads();
    XcdBarrier bar = xcd_barrier_post(p0.ctl + CW_BAR, misc);
#pragma unroll 1
    for (int ph = 0; ph < p0.nph; ph++) {
        const int layer = ph == 0 ? 0 : (ph - 1) / 9, q = ph == 0 ? -1 : (ph - 1) % 9;
#if defined(__HIP_DEVICE_COMPILE__)
        KA ka = (KA)__builtin_amdgcn_kernarg_segment_ptr();
        asm volatile("" : "+s"(ka));
#else
        KA ka = nullptr;
#endif
        const float* xin = layer == 0 ? PF(x) : PF(out);
        float* x1 = PF(out);
        float* accbuf = (float*)PF(H);
        float* hidden = (float*)PF(Y);
        if (q == -1 && QON(-1)) phase_prologue(ka, smem);
        else if (q == 0 && QON(0)) phase_inproj(ka, layer, lds);
        else if (q == 1 && QON(1)) { phase_hgrn(ka, layer, smem); phase_gmlp(ka, layer, smem); __syncthreads(); phase_compress(ka, layer, smem); }
        else if (q == 2 && QON(2)) phase_nsa(ka, layer, smem);
        else if (q == 3 && QON(3)) phase_headnorm(ka, layer);
        else if (q == 4 && QON(4)) phase_outproj(ka, layer, xin, x1, lds);
        else if (q == 5 && QON(5)) phase_ln1_route(ka, layer, x1);
        else if (q == 6 && QON(6)) phase_moe_up(ka, layer, x1, hidden, accbuf, smem);
        else if (q == 7 && QON(7)) phase_moe_down(ka, layer, hidden, accbuf, smem);
        else if (q == 8 && QON(8)) phase_ln2(ka, layer, x1, accbuf, PF(out));
        if (ph != NPH_TOTAL - 1) xcd_barrier(bar);
    }
}

static inline size_t align_up(size_t v, size_t a) { return (v + a - 1) / a * a; }

extern "C" void kernel_launch(void* const* d_in, const int* in_sizes, int n_in, void* d_out, int out_size, void* d_ws,
                              size_t ws_size, hipStream_t stream) {
    P p{};
    p.x = (const float*)d_in[0]; p.w_in = (const float*)d_in[1]; p.gm_v_gain = (const float*)d_in[2];
    p.gm_v_bias = (const float*)d_in[3]; p.gm_w_s = (const float*)d_in[4]; p.gm_b_s = (const float*)d_in[5];
    p.cmp_pos = (const float*)d_in[6]; p.cmp_w1 = (const float*)d_in[7]; p.cmp_w2 = (const float*)d_in[8];
    p.nsa_gate_b = (const float*)d_in[9]; p.hg_lower = (const float*)d_in[10]; p.out_gain = (const float*)d_in[11];
    p.w_out = (const float*)d_in[12]; p.ln1_g = (const float*)d_in[13]; p.ln1_b = (const float*)d_in[14];
    p.rg_w = (const float*)d_in[15]; p.rg_b = (const float*)d_in[16]; p.re_w = (const float*)d_in[17];
    p.re_b = (const float*)d_in[18]; p.w_gate = (const float*)d_in[19]; p.w_up = (const float*)d_in[20];
    p.w_down = (const float*)d_in[21]; p.ln2_g = (const float*)d_in[22]; p.ln2_b = (const float*)d_in[23];
    p.out = (float*)d_out;
    char* ws = (char*)d_ws;
    size_t off = 0;
    p.ctl = (unsigned*)(ws + off); off = align_up(off + CTL_BYTES, 256);
    p.WT = (bf16_t*)(ws + off); off = align_up(off + 2 * WT_LAYER * 2, 256);
    p.H = (bf16_t*)(ws + off); off = align_up(off + (size_t)NTOK * HLD * 2, 256);
    p.Y = (bf16_t*)(ws + off); off = align_up(off + (size_t)NTOK * DM * 2, 256);
    p.XB = (bf16_t*)(ws + off); off = align_up(off + (size_t)NTOK * DM * 2, 256);
    p.kcmp = (float*)(ws + off); off = align_up(off + (size_t)4 * NCMP * 64 * 4, 256);
    p.vcmp = (float*)(ws + off); off = align_up(off + (size_t)4 * NCMP * 64 * 4, 256);
    p.gbuf = (float*)(ws + off); off = align_up(off + (size_t)2 * 2044 * 128 * 4, 256);
    p.list_tok = (int*)(ws + off); off = align_up(off + (size_t)16 * NTOK * 4, 256);
    p.list_w = (float*)(ws + off); off = align_up(off + (size_t)16 * NTOK * 4, 256);
    p.nph = NPH_TOTAL;
    (void)in_sizes; (void)n_in; (void)out_size;
    static int grid_blocks = 0;
    if (!grid_blocks) {
        int dev = 0, cus = 0, per_cu = 0;
        (void)hipGetDevice(&dev);
        (void)hipDeviceGetAttribute(&cus, hipDeviceAttributeMultiprocessorCount, dev);
        if (hipFuncSetAttribute((const void*)k_mega, hipFuncAttributeMaxDynamicSharedMemorySize, LDS_BYTES) != hipSuccess) { fprintf(stderr, "hipFuncSetAttribute failed\n"); grid_blocks = -1; return; }
        if (hipOccupancyMaxActiveBlocksPerMultiprocessor(&per_cu, (const void*)k_mega, NTHR, LDS_BYTES) != hipSuccess || per_cu < 1) { fprintf(stderr, "occupancy query says %d\n", per_cu); }
        (void)hipGetLastError();
        grid_blocks = cus;
        if (off > ws_size) { fprintf(stderr, "workspace too small: need %zu have %zu\n", off, ws_size); grid_blocks = -1; }
    }
    if (grid_blocks < 0) return;
    (void)hipMemsetAsync(p.ctl, 0, CTL_BYTES, stream);
    void* args[] = {&p};
    hipError_t e = hipLaunchCooperativeKernel((const void*)k_mega, dim3(grid_blocks), dim3(NTHR), args, LDS_BYTES, stream);
    if (e != hipSuccess) fprintf(stderr, "cooperative launch failed: %s (grid %d)\n", hipGetErrorString(e), grid_blocks);
}
```

```cpp
#include <hip/hip_runtime.h>
#include <cstdio>
#include <cstdint>

#define LAS __attribute__((address_space(3)))
typedef unsigned short bf16_t;
typedef short bf16x8 __attribute__((ext_vector_type(8)));
typedef float f32x4 __attribute__((ext_vector_type(4)));
typedef float f32x2 __attribute__((ext_vector_type(2)));
typedef unsigned u32x4 __attribute__((ext_vector_type(4)));
typedef unsigned u32x2 __attribute__((ext_vector_type(2)));

constexpr int NW = 8;
constexpr int NTHR = NW * 64;
constexpr int T_ = 8192;
constexpr int NTOK = 16384;
constexpr int DM = 1024;
constexpr int IC_SRC = 2840;
constexpr int HLD = 3072;
constexpr int C_GU = 0, C_GV = 256, C_NQ = 512, C_KC = 1024, C_VC = 1152, C_KS = 1280, C_VS = 1408,
              C_KW = 1536, C_VW = 1664, C_HQ = 1792, C_HF = 2048, C_HI = 2304, C_HG = 2560, C_NG = 2816;
constexpr int NCMP = 511;
constexpr float ALPHA = 1.4142135623730951f;
constexpr float NEG_INF = -1e30f;

constexpr size_t WT_IN = 0;
constexpr size_t WT_OUT = WT_IN + (size_t)3072 * 1024;
constexpr size_t WT_UP = WT_OUT + (size_t)1024 * 1024;
constexpr size_t WT_DN = WT_UP + (size_t)16 * 1024 * 1024;
constexpr size_t WT_LAYER = WT_DN + (size_t)16 * 1024 * 512;

constexpr int LDS_STAGE = 131072;
constexpr int LDS_MISC = LDS_STAGE;
constexpr int LDS_BYTES = 147456;

constexpr int CW_BAR = 0;
constexpr int CW_CNT = 4096;
constexpr size_t CTL_BYTES = 65536;

struct P {
    const float* x; const float* w_in; const float* gm_v_gain; const float* gm_v_bias; const float* gm_w_s;
    const float* gm_b_s; const float* cmp_pos; const float* cmp_w1; const float* cmp_w2; const float* nsa_gate_b;
    const float* hg_lower; const float* out_gain; const float* w_out; const float* ln1_g; const float* ln1_b;
    const float* rg_w; const float* rg_b; const float* re_w; const float* re_b; const float* w_gate;
    const float* w_up; const float* w_down; const float* ln2_g; const float* ln2_b;
    float* out;
    unsigned* ctl;
    bf16_t* WT;
    bf16_t* H;
    bf16_t* Y;
    bf16_t* XB;
    float* kcmp;
    float* vcmp;
    float* gbuf;
    int* list_tok;
    float* list_w;
    int* tok_slot;
    int nph; int pad;
};


typedef const __attribute__((address_space(4))) char* KA;
template <class T> __device__ __forceinline__ T ldarg(KA ka, size_t off) { return *(const __attribute__((address_space(4))) T*)(ka + off); }
#define PF(f) ldarg<decltype(P::f)>(ka, offsetof(P, f))

__device__ __forceinline__ float bf2f(bf16_t u) { return __uint_as_float(((unsigned)u) << 16); }
__device__ __forceinline__ unsigned f2bf_u(float f) {
    unsigned u = __float_as_uint(f);
    return (u + 0x7fffu + ((u >> 16) & 1u)) >> 16;
}
__device__ __forceinline__ bf16_t f2bf(float f) { return (bf16_t)f2bf_u(f); }
__device__ __forceinline__ unsigned pk2(float lo, float hi) { return f2bf_u(lo) | (f2bf_u(hi) << 16); }
__device__ __forceinline__ float gelu_t(float x) {
    float u = 0.7978845608028654f * (x + 0.044715f * x * x * x);
    return 0.5f * x * (1.f + tanhf(u));
}
__device__ __forceinline__ float sigmoidf_(float x) { return 1.f / (1.f + __expf(-x)); }
__device__ __forceinline__ float wave_max(float v) {
#pragma unroll
    for (int o = 32; o > 0; o >>= 1) v = fmaxf(v, __shfl_xor(v, o));
    return v;
}
__device__ __forceinline__ float wave_sum(float v) {
#pragma unroll
    for (int o = 32; o > 0; o >>= 1) v += __shfl_xor(v, o);
    return v;
}
__device__ __forceinline__ void wave_sync() {
    __builtin_amdgcn_fence(__ATOMIC_RELEASE, "wavefront");
    __builtin_amdgcn_wave_barrier();
    __builtin_amdgcn_fence(__ATOMIC_ACQUIRE, "wavefront");
}
__device__ __forceinline__ int opaque_tid() { int t = threadIdx.x; asm volatile("" : "+v"(t)); return t; }
__device__ __forceinline__ int opaque_bid() { int b = blockIdx.x; asm volatile("" : "+s"(b)); return b; }
#define PHASE_IDS const int TID = opaque_tid(); const int BID = opaque_bid(); (void)TID; (void)BID;

#define XB_TMO      128
#define XB_XCNT(j)  (256  + 64 * (j))
#define XB_XSUB(j)  (1280 + 64 * (j))
#define XB_XGEN(j)  (2304 + 64 * (j))
#define XB_TOP      3328
#define XB_TOPGEN   3392
#define XCD_BAR_WORDS 3456
#define XB_SPIN_CAP (1u << 22)
__device__ __forceinline__ unsigned xb_ld(unsigned* p)              { return __hip_atomic_load(p, __ATOMIC_RELAXED, __HIP_MEMORY_SCOPE_AGENT); }
__device__ __forceinline__ unsigned xb_add(unsigned* p, unsigned v) { return __hip_atomic_fetch_add(p, v, __ATOMIC_RELAXED, __HIP_MEMORY_SCOPE_AGENT); }
__device__ __forceinline__ unsigned xb_xcc_id() { return (unsigned)__builtin_amdgcn_s_getreg((3 << 11) | 20) & 0xFu; }
#define XB_SPIN(cond, bar) do { unsigned _sp = 0; while (cond) { __builtin_amdgcn_s_sleep(1); \
    if ((++_sp & 255u) == 0u) { if (xb_ld(&(bar)[XB_TMO])) break; if (_sp > XB_SPIN_CAP) { atomicAdd(&(bar)[XB_TMO], 1u); break; } } } } while (0)
struct XcdBarrier { unsigned* bar; unsigned x; volatile LAS unsigned* st; };
__device__ __forceinline__ XcdBarrier xcd_barrier_post(unsigned* bar, volatile LAS unsigned* st) {
    XcdBarrier b; b.bar = bar; b.x = xb_xcc_id(); b.st = st;
    if (threadIdx.x == 0) (void)xb_add(&bar[XB_XCNT(b.x)], 1u);
    return b;
}
__device__ __forceinline__ void xcd_barrier_complete(unsigned* bar, unsigned x, unsigned& nloc, unsigned& nx) {
    const unsigned G = gridDim.x * gridDim.y * gridDim.z;
    unsigned sum, cnt, mine, sp = 0u;
    for (;;) {
        sum = 0u; cnt = 0u; mine = 0u;
#pragma unroll
        for (unsigned j = 0; j < 16; ++j) { const unsigned c = xb_ld(&bar[XB_XCNT(j)]); sum += c; cnt += (c > 0u) ? 1u : 0u; mine = (j == x) ? c : mine; }
        if (sum == G) break;
        __builtin_amdgcn_s_sleep(1);
        if ((++sp & 255u) == 0u) { if (xb_ld(&bar[XB_TMO])) break; if (sp > XB_SPIN_CAP) { atomicAdd(&bar[XB_TMO], 1u); break; } }
    }
    nloc = mine > 0u ? mine : 1u; nx = cnt > 0u ? cnt : 1u;
}
__device__ __forceinline__ void xcd_barrier(const XcdBarrier& b) {
    asm volatile("s_waitcnt vmcnt(0)" ::: "memory");
    __syncthreads();
    if (threadIdx.x == 0) {
        unsigned* bar = b.bar;
        __builtin_amdgcn_s_waitcnt(0);
        unsigned nloc = b.st[0], nx = b.st[1];
        if (nloc == 0u) { xcd_barrier_complete(bar, b.x, nloc, nx); b.st[0] = nloc; b.st[1] = nx; }
        const unsigned old = xb_add(&bar[XB_XSUB(b.x)], 1u);
        const unsigned gen = old / nloc;
        if (old + 1u == (gen + 1u) * nloc) {
            __builtin_amdgcn_fence(__ATOMIC_RELEASE, "agent");
            asm volatile("s_waitcnt vmcnt(0)" ::: "memory");
            const unsigned og = xb_add(&bar[XB_TOP], 1u);
            const unsigned tg = og / nx;
            if (og + 1u == (tg + 1u) * nx) xb_add(&bar[XB_TOPGEN], 1u);
            else XB_SPIN(xb_ld(&bar[XB_TOPGEN]) == tg, bar);
            __builtin_amdgcn_fence(__ATOMIC_ACQUIRE, "agent");
            xb_add(&bar[XB_XGEN(b.x)], 1u);
            asm volatile("s_waitcnt vmcnt(0)" ::: "memory");
        } else {
            XB_SPIN(xb_ld(&bar[XB_XGEN(b.x)]) == gen, bar);
            __builtin_amdgcn_fence(__ATOMIC_ACQUIRE, "agent");
            asm volatile("s_waitcnt vmcnt(0)" ::: "memory");
        }
    }
    __syncthreads();
}

namespace pg8 {
constexpr int BM = 256, BK = 64, HALF = 128, HTB = HALF * BK * 2, STAGE_BYTES = 8 * HTB;
__host__ __device__ __forceinline__ int lds_byte(int r, int c) { const int st = (r >> 4) * 2 + (c >> 5), rr = r & 15, cc = c & 31, ob = rr * 64 + cc * 2; return st * 1024 + (ob ^ (((ob >> 9) & 1) << 5)); }
__host__ __device__ __forceinline__ void stage_rc(int b, int& R, int& C) { const int st = b / 1024, sb = b % 1024, swz = sb ^ (((sb >> 9) & 1) << 5); R = (st >> 1) * 16 + swz / 64; C = (st & 1) * 32 + (swz % 64) / 2; }
__host__ __device__ __forceinline__ int perm32(int rho) { const int n = rho >> 4, i = rho & 15; return 8 * (i >> 2) + 4 * n + (i & 3); }
__device__ __forceinline__ unsigned cvt_pk_bf16(float lo, float hi) { unsigned r; asm volatile("v_cvt_pk_bf16_f32 %0, %1, %2" : "=v"(r) : "v"(lo), "v"(hi)); return r; }

struct Unit {
    const char* bptr;
    int arow0;
    int nrows;
    int pm, pn, e, ui;
};

template <class Epi, class Sched>
__device__ __forceinline__ void gemm_phase(LAS unsigned char* lds, const char* Abase, const int K, const Sched& S, const Epi& E) {
    const int tid = opaque_tid(), wid = __builtin_amdgcn_readfirstlane(tid >> 6), lane = tid & 63, wr = wid >> 2, wc = wid & 3, fr = lane & 15, fq = lane >> 4;
    const int nt = K / BK;
    int R0, C0, R1, C1; stage_rc(tid * 16, R0, C0); stage_rc(tid * 16 + 8192, R1, C1);
    unsigned voffB[2];
    { const int Rb0 = Epi::PERM ? ((R0 & ~31) + perm32(R0 & 31)) : R0, Rb1 = Epi::PERM ? ((R1 & ~31) + perm32(R1 & 31)) : R1;
      voffB[0] = (unsigned)(Rb0 * K + C0) * 2u; voffB[1] = (unsigned)(Rb1 * K + C1) * 2u; }
    const unsigned cA0 = (unsigned)C0 * 2u, cA1 = (unsigned)C1 * 2u;
    const unsigned voffA0 = (unsigned)(R0 * K + C0) * 2u, voffA1 = (unsigned)(R1 * K + C1) * 2u;
    const unsigned kstep = (unsigned)(BK * 2);
    const unsigned hstep = (unsigned)(HALF * K * 2);
    const unsigned ldsw = (unsigned)wid * 1024u;
    const int aoff = lds_byte(wr * 64 + fr, fq * 8), boff = lds_byte(wc * 32 + fr, fq * 8);
#define PG8_SA(b, h) (((b) * 2 + (h)) * HTB)
#define PG8_SB(b, h) ((4 + (b) * 2 + (h)) * HTB)
#define PG8_STAGE_B(bufoff, gbase) do { \
        __builtin_amdgcn_global_load_lds((const unsigned*)((const char*)(gbase) + voffB[0]), (LAS unsigned*)(lds + (bufoff) + ldsw), 16, 0, 0); \
        __builtin_amdgcn_global_load_lds((const unsigned*)((const char*)(gbase) + voffB[1]), (LAS unsigned*)(lds + (bufoff) + ldsw + 8192), 16, 0, 0); } while (0)
#define PG8_STAGE_A(bufoff, gbase, pk) do { \
        const unsigned o0_ = Sched::GATHER ? (((pk) & 0xffffu) * (unsigned)K * 2u + cA0) : voffA0; \
        const unsigned o1_ = Sched::GATHER ? (((pk) >> 16) * (unsigned)K * 2u + cA1) : voffA1; \
        __builtin_amdgcn_global_load_lds((const unsigned*)((const char*)(gbase) + o0_), (LAS unsigned*)(lds + (bufoff) + ldsw), 16, 0, 0); \
        __builtin_amdgcn_global_load_lds((const unsigned*)((const char*)(gbase) + o1_), (LAS unsigned*)(lds + (bufoff) + ldsw + 8192), 16, 0, 0); } while (0)
#define PG8_LDA(dst, b, h) do { _Pragma("unroll") for (int m = 0; m < 4; ++m) _Pragma("unroll") for (int k = 0; k < 2; ++k) dst[m][k] = *(const LAS bf16x8*)(lds + PG8_SA(b, h) + aoff + m * 2048 + k * 1024); } while (0)
#define PG8_LDB(dst, b, h) do { _Pragma("unroll") for (int n = 0; n < 2; ++n) _Pragma("unroll") for (int k = 0; k < 2; ++k) dst[n][k] = *(const LAS bf16x8*)(lds + PG8_SB(b, h) + boff + n * 2048 + k * 1024); } while (0)
#define PG8_MMA(ai, bj, At, Bt) do { __builtin_amdgcn_s_setprio(1); _Pragma("unroll") for (int m = 0; m < 4; ++m) _Pragma("unroll") for (int n = 0; n < 2; ++n) _Pragma("unroll") for (int k = 0; k < 2; ++k) \
        acc[ai][bj][m][n] = __builtin_amdgcn_mfma_f32_16x16x32_bf16(Bt[n][k], At[m][k], acc[ai][bj][m][n], 0, 0, 0); __builtin_amdgcn_s_setprio(0); } while (0)
#define PG8_WAIT_V(n) asm volatile("s_waitcnt vmcnt(" #n ")" ::: "memory")
#define PG8_WAIT_L(n) asm volatile("s_waitcnt lgkmcnt(" #n ")" ::: "memory")
#define PG8_BAR __builtin_amdgcn_s_barrier()
#define PG8_SCHED __builtin_amdgcn_sched_barrier(0)
#define PG8_PACK(u, h) ((unsigned)S.arow((u), ((h) * 128 + R0) < (u).nrows ? ((h) * 128 + R0) : (u).nrows - 1) | ((unsigned)S.arow((u), ((h) * 128 + R1) < (u).nrows ? ((h) * 128 + R1) : (u).nrows - 1) << 16))
    Unit cur, nxt; int ui = 0;
    if (!S.next(0, cur)) return;
    f32x4 acc[2][2][4][2];
#pragma unroll
    for (int a = 0; a < 2; ++a)
#pragma unroll
        for (int b = 0; b < 2; ++b)
#pragma unroll
            for (int m = 0; m < 4; ++m)
#pragma unroll
                for (int n = 0; n < 2; ++n) acc[a][b][m][n] = (f32x4){0.f, 0.f, 0.f, 0.f};
    bf16x8 At[4][2], B0[2][2], B1[2][2];
    unsigned pC0 = 0u, pC1 = 0u, pN0 = 0u, pN1 = 0u;
    if (Sched::GATHER) { pC0 = PG8_PACK(cur, 0); pC1 = PG8_PACK(cur, 1); }
    const char* cB = cur.bptr;
    const char* cA = Sched::GATHER ? Abase : Abase + (size_t)cur.arow0 * K * 2;
    const unsigned hA = Sched::GATHER ? 0u : hstep;
    PG8_STAGE_B(PG8_SB(0, 0), cB); PG8_STAGE_B(PG8_SB(0, 1), cB + hstep); PG8_STAGE_A(PG8_SA(0, 0), cA, pC0); PG8_STAGE_A(PG8_SA(0, 1), cA + hA, pC1);
    if (wr == 1) PG8_BAR;
    PG8_WAIT_V(2); PG8_BAR;
    PG8_STAGE_B(PG8_SB(1, 0), cB + kstep); PG8_STAGE_A(PG8_SA(1, 0), cA + kstep, pC0); PG8_STAGE_B(PG8_SB(1, 1), cB + hstep + kstep);
    PG8_WAIT_V(6); PG8_BAR;
    for (;;) {
        const bool has_next = S.next(ui + 1, nxt);
        if (Sched::GATHER) { if (has_next) { pN0 = PG8_PACK(nxt, 0); pN1 = PG8_PACK(nxt, 1); } else { pN0 = pC0; pN1 = pC1; } }
        const char* nB = has_next ? nxt.bptr : cB;
        const char* nA = (Sched::GATHER || !has_next) ? cA : Abase + (size_t)nxt.arow0 * K * 2;
        for (int t = 0; t < nt; t += 2) {
            const bool last = (t == nt - 2);
            const char* a1 = cA + (unsigned)(t + 1) * kstep;
            const char* a2 = last ? nA : cA + (unsigned)(t + 2) * kstep; const char* b2 = last ? nB : cB + (unsigned)(t + 2) * kstep;
            const char* a3 = a2 + kstep; const char* b3 = b2 + kstep;
            const unsigned s0 = last ? pN0 : pC0, s1 = last ? pN1 : pC1;
            PG8_LDB(B0, 0, 0); PG8_LDB(B1, 0, 1); PG8_SCHED; PG8_LDA(At, 0, 0); PG8_STAGE_A(PG8_SA(1, 1), a1 + hA, pC1);
            PG8_WAIT_V(8); PG8_WAIT_L(0); PG8_BAR; PG8_MMA(0, 0, At, B0); PG8_MMA(0, 1, At, B1); PG8_BAR; PG8_SCHED;
            PG8_LDA(At, 0, 1); PG8_STAGE_B(PG8_SB(0, 0), b2); PG8_STAGE_B(PG8_SB(0, 1), b2 + hstep); PG8_STAGE_A(PG8_SA(0, 0), a2, s0);
            PG8_WAIT_V(8); PG8_WAIT_L(0); PG8_BAR; PG8_MMA(1, 0, At, B0); PG8_MMA(1, 1, At, B1); PG8_BAR; PG8_SCHED;
            PG8_LDB(B0, 1, 0); PG8_LDB(B1, 1, 1); PG8_SCHED; PG8_LDA(At, 1, 0); PG8_STAGE_A(PG8_SA(0, 1), a2 + hA, s1);
            PG8_WAIT_V(8); PG8_WAIT_L(0); PG8_BAR; PG8_MMA(0, 0, At, B0); PG8_MMA(0, 1, At, B1); PG8_BAR; PG8_SCHED;
            PG8_LDA(At, 1, 1); PG8_STAGE_B(PG8_SB(1, 0), b3); PG8_STAGE_B(PG8_SB(1, 1), b3 + hstep); PG8_STAGE_A(PG8_SA(1, 0), a3, s0);
            PG8_WAIT_V(8); PG8_WAIT_L(0); PG8_BAR; PG8_MMA(1, 0, At, B0); PG8_MMA(1, 1, At, B1); PG8_BAR; PG8_SCHED;
        }
        if (wr == 0) PG8_BAR;
        E(acc, cur, wr, wc, fr, fq);
        if (!has_next) break;
#pragma unroll
        for (int a = 0; a < 2; ++a)
#pragma unroll
            for (int b = 0; b < 2; ++b)
#pragma unroll
                for (int m = 0; m < 4; ++m)
#pragma unroll
                    for (int n = 0; n < 2; ++n) acc[a][b][m][n] = (f32x4){0.f, 0.f, 0.f, 0.f};
        cur = nxt; cB = nB; cA = nA; ++ui;
        pC0 = pN0; pC1 = pN1;
        if (wr == 1) PG8_BAR;
    }
    PG8_WAIT_V(0);
    PG8_BAR;
#undef PG8_SA
#undef PG8_SB
#undef PG8_STAGE_A
#undef PG8_STAGE_B
#undef PG8_LDA
#undef PG8_LDB
#undef PG8_MMA
#undef PG8_WAIT_V
#undef PG8_WAIT_L
#undef PG8_BAR
#undef PG8_SCHED
#undef PG8_PACK
}

struct DenseOrder {
    static constexpr bool GATHER = false;
    int nM, nN, nwg, G, c; const char* Bt; int K;
    __device__ void init(int M, int N, int K_, const bf16_t* Bt_, int G_, int c_) { nM = M / BM; nN = N / BM; nwg = nM * nN; G = G_; c = c_; Bt = (const char*)Bt_; K = K_; }
    __device__ __forceinline__ bool next(int i, Unit& u) const {
        const long L = (long)i * G + c; if (L >= nwg) return false;
        int wgid = (int)L; { const int q = nwg / 8, r = nwg % 8, xcd = wgid % 8, off = wgid / 8; wgid = (xcd < r ? xcd * (q + 1) : r * (q + 1) + (xcd - r) * q) + off; }
        const int nig = 8 * nN, gid = wgid / nig, fm = gid * 8, gsz = (nM - fm) < 8 ? (nM - fm) : 8;
        u.pm = fm + ((wgid % nig) % gsz); u.pn = (wgid % nig) / gsz;
        u.arow0 = u.pm * BM; u.nrows = BM; u.e = 0; u.ui = i;
        u.bptr = Bt + (size_t)u.pn * BM * K * 2;
        return true;
    }
    __device__ __forceinline__ int arow(const Unit& u, int r) const { return u.arow0 + r; }
};
}

struct EpiH {
    static constexpr bool PERM = true;
    bf16_t* H;
    __device__ __forceinline__ void operator()(const f32x4 (&acc)[2][2][4][2], const pg8::Unit& u, int wr, int wc, int fr, int fq) const {
        const int row0 = u.arow0 + wr * 64 + fr, col0 = u.pn * 256 + wc * 32 + 8 * fq;
#pragma unroll
        for (int ai = 0; ai < 2; ++ai)
#pragma unroll
            for (int m = 0; m < 4; ++m) {
                bf16_t* rowp = H + (size_t)(row0 + ai * 128 + m * 16) * HLD + col0;
#pragma unroll
                for (int bj = 0; bj < 2; ++bj) {
                    const f32x4 v0 = acc[ai][bj][m][0], v1 = acc[ai][bj][m][1];
                    u32x4 w; w.x = pg8::cvt_pk_bf16(v0[0], v0[1]); w.y = pg8::cvt_pk_bf16(v0[2], v0[3]); w.z = pg8::cvt_pk_bf16(v1[0], v1[1]); w.w = pg8::cvt_pk_bf16(v1[2], v1[3]);
                    *(u32x4*)(rowp + bj * 128) = w;
                }
            }
    }
};
struct EpiRes {
    static constexpr bool PERM = false;
    const float* xin; float* out;
    __device__ __forceinline__ void operator()(const f32x4 (&acc)[2][2][4][2], const pg8::Unit& u, int wr, int wc, int fr, int fq) const {
        const int row0 = u.arow0 + wr * 64 + fr, col0 = u.pn * 256 + wc * 32 + 4 * fq;
#pragma unroll
        for (int ai = 0; ai < 2; ++ai)
#pragma unroll
            for (int m = 0; m < 4; ++m) {
                const size_t off = (size_t)(row0 + ai * 128 + m * 16) * DM + col0;
#pragma unroll
                for (int bj = 0; bj < 2; ++bj)
#pragma unroll
                    for (int n = 0; n < 2; ++n) {
                        const f32x4 xv = *(const f32x4*)(xin + off + bj * 128 + n * 16);
                        *(f32x4*)(out + off + bj * 128 + n * 16) = xv * ALPHA + acc[ai][bj][m][n];
                    }
            }
    }
};

template <class RM>
__device__ __forceinline__ void transpose_item(const float* W, int K, int N, bf16_t* WT, RM rowmap, float* scr, int kb, int nb, int lane) {
    const int k0 = 64 * kb, n0 = 32 * nb;
    const int nn = n0 + (lane & 31);
#pragma unroll 8
    for (int i = 0; i < 32; ++i) {
        const int kk = 2 * i + (lane >> 5);
        scr[kk * 33 + (lane & 31)] = nn < N ? W[(size_t)(k0 + kk) * N + nn] : 0.f;
    }
    wave_sync();
    const int c = lane & 7;
#pragma unroll
    for (int j = 0; j < 4; ++j) {
        const int n = (lane >> 3) + 8 * j;
        const float* s = scr + (8 * c) * 33 + n;
        u32x4 o; o.x = pk2(s[0 * 33], s[1 * 33]); o.y = pk2(s[2 * 33], s[3 * 33]); o.z = pk2(s[4 * 33], s[5 * 33]); o.w = pk2(s[6 * 33], s[7 * 33]);
        const int dr = (n0 + n < N) ? rowmap(n0 + n) : -1;
        if (dr >= 0) *(u32x4*)(WT + (size_t)dr * K + k0 + 8 * c) = o;
    }
    wave_sync();
}

__device__ void phase_prologue(KA ka, float* smem) {
    PHASE_IDS
    const int lane = TID & 63, w = TID >> 6;
    float* scr = smem + w * 4096;
    const int gw = BID * NW + w, NGW = gridDim.x * NW;
    constexpr int I_IN = 16 * 89, I_OUT = 16 * 32, I_GU = 16 * 16, I_DN = 8 * 32;
    constexpr int I_LAYER = I_IN + I_OUT + 32 * I_GU + 16 * I_DN;
    for (int it = gw; it < 2 * I_LAYER; it += NGW) {
        const int layer = it / I_LAYER; int r = it % I_LAYER;
        bf16_t* WT = PF(WT) + (size_t)layer * WT_LAYER;
        if (r < I_IN) {
            transpose_item(PF(w_in) + (size_t)layer * DM * IC_SRC, DM, IC_SRC, WT + WT_IN,
                           [](int n) { return n < 1792 ? n : (n < 1816 ? 2816 + (n - 1792) : n - 24); }, scr, r / 89, r % 89, lane);
            continue;
        }
        r -= I_IN;
        if (r < I_OUT) {
            transpose_item(PF(w_out) + (size_t)layer * DM * DM, DM, DM, WT + WT_OUT, [](int n) { return n; }, scr, r / 32, r % 32, lane);
            continue;
        }
        r -= I_OUT;
        if (r < 32 * I_GU) {
            const int mat = r / I_GU, rr = r % I_GU, e = mat >> 1, isup = mat & 1;
            const float* W = (isup ? PF(w_up) : PF(w_gate)) + ((size_t)layer * 16 + e) * DM * 512;
            transpose_item(W, DM, 512, WT + WT_UP + (size_t)e * 1024 * 1024,
                           [isup](int n) { return (n >> 7) * 256 + isup * 128 + (n & 127); }, scr, rr / 16, rr % 16, lane);
            continue;
        }
        r -= 32 * I_GU;
        {
            const int e = r / I_DN, rr = r % I_DN;
            transpose_item(PF(w_down) + ((size_t)layer * 16 + e) * 512 * DM, 512, DM, WT + WT_DN + (size_t)e * 1024 * 512,
                           [](int n) { return n; }, scr, rr / 32, rr % 32, lane);
        }
    }
    for (int i = BID * NTHR + TID; i < 2 * 232 * 128; i += gridDim.x * NTHR) {
        const int layer = i / (232 * 128), q = i % (232 * 128);
        u32x4 z; z.x = 0u; z.y = 0u; z.z = 0u; z.w = 0u;
        *(u32x4*)(PF(WT) + (size_t)layer * WT_LAYER + WT_IN + (size_t)2840 * 1024 + (size_t)q * 8) = z;
    }
    for (int row = gw; row < NTOK; row += NGW) {
        const f32x4* xr = (const f32x4*)(PF(x) + (size_t)row * DM) + lane;
        u32x2* o = (u32x2*)(PF(XB) + (size_t)row * DM) + lane;
#pragma unroll
        for (int j = 0; j < 4; ++j) {
            const f32x4 v = xr[64 * j];
            u32x2 ww; ww.x = pk2(v[0], v[1]); ww.y = pk2(v[2], v[3]);
            o[64 * j] = ww;
        }
    }
}

template <class AF, class BF, class EF>
__device__ __forceinline__ void gemm128(int tid, int m0, int n0, int M, int N, int K, AF af, BF bf, EF ef, float* smem) {
    float* As = smem;
    float* Bs = smem + 16 * 132;
    const bool active = tid < 256;
    const int tx = tid & 15, ty = (tid >> 4) & 15;
    float acc[8][8];
#pragma unroll
    for (int i = 0; i < 8; i++)
#pragma unroll
        for (int j = 0; j < 8; j++) acc[i][j] = 0.f;
#pragma unroll 1
    for (int k0 = 0; k0 < K; k0 += 16) {
        if (active) {
#pragma unroll
            for (int i = 0; i < 8; i++) {
                int e = tid + i * 256;
                int r = e >> 4, kk = e & 15;
                float v = 0.f;
                if (m0 + r < M) v = af(m0 + r, k0 + kk);
                As[kk * 132 + r] = v;
            }
#pragma unroll
            for (int i = 0; i < 8; i++) {
                int e = tid + i * 256;
                int kk = e >> 7, c = e & 127;
                float v = 0.f;
                if (n0 + c < N) v = bf(k0 + kk, n0 + c);
                Bs[kk * 132 + c] = v;
            }
        }
        __syncthreads();
        if (active) {
#pragma unroll 2
            for (int kk = 0; kk < 16; kk++) {
                asm volatile("" ::: "memory");
                float4 a0 = *(const float4*)&As[kk * 132 + ty * 8];
                float4 a1 = *(const float4*)&As[kk * 132 + ty * 8 + 4];
                float4 b0 = *(const float4*)&Bs[kk * 132 + tx * 8];
                float4 b1 = *(const float4*)&Bs[kk * 132 + tx * 8 + 4];
                float a[8] = {a0.x, a0.y, a0.z, a0.w, a1.x, a1.y, a1.z, a1.w};
                float b[8] = {b0.x, b0.y, b0.z, b0.w, b1.x, b1.y, b1.z, b1.w};
#pragma unroll
                for (int i = 0; i < 8; i++)
#pragma unroll
                    for (int j = 0; j < 8; j++) acc[i][j] = fmaf(a[i], b[j], acc[i][j]);
            }
        }
        __syncthreads();
    }
    if (active) {
#pragma unroll
        for (int i = 0; i < 8; i++)
#pragma unroll
            for (int j = 0; j < 8; j++) {
                int m = m0 + ty * 8 + i, n = n0 + tx * 8 + j;
                if (m < M && n < N) ef(m, n, acc[i][j]);
            }
    }
}

__device__ __forceinline__ void phase_inproj(KA ka, int layer, LAS unsigned char* lds) {
    pg8::DenseOrder S; S.init(NTOK, HLD, DM, PF(WT) + (size_t)layer * WT_LAYER + WT_IN, gridDim.x, opaque_bid());
    EpiH E{PF(H)};
    pg8::gemm_phase<EpiH, pg8::DenseOrder>(lds, (const char*)PF(XB), DM, S, E);
}
__device__ __forceinline__ void phase_outproj(KA ka, int layer, const float* xin, float* x1, LAS unsigned char* lds) {
    pg8::DenseOrder S; S.init(NTOK, DM, DM, PF(WT) + (size_t)layer * WT_LAYER + WT_OUT, gridDim.x, opaque_bid());
    EpiRes E{xin, x1};
    pg8::gemm_phase<EpiRes, pg8::DenseOrder>(lds, (const char*)PF(Y), DM, S, E);
}

__device__ void phase_gmlp(KA ka, int layer, float* smem) {
    PHASE_IDS
    float* V = smem;
    const int tid = TID, lane = tid & 63, w = tid >> 6;
    const float* gain = PF(gm_v_gain) + layer * 256;
    const float* bias = PF(gm_v_bias) + layer * 256;
    const float* ws = PF(gm_w_s) + (size_t)layer * 4 * 128 * 128;
    const float* bs = PF(gm_b_s) + layer * 4 * 128;
    const bf16_t* H = PF(H);
    for (int item = BID; item < 512; item += gridDim.x) {
        int g = item & 3, c = (item >> 2) & 63, b = item >> 8;
        size_t tok0 = (size_t)b * T_ + (size_t)c * 128;
        __syncthreads();
        for (int i = 0; i < 16; i++) {
            int s = w * 16 + i;
            float x = bf2f(H[(tok0 + s) * HLD + C_GV + g * 64 + lane]);
            float ge = gelu_t(x);
            float mu = wave_sum(ge) * (1.f / 64.f);
            float dl = ge - mu;
            float var = wave_sum(dl * dl) * (1.f / 64.f);
            V[s * 64 + lane] = dl * rsqrtf(var + 1e-5f) * gain[g * 64 + lane] + bias[g * 64 + lane];
        }
        __syncthreads();
        for (int i = 0; i < 16; i++) {
            int t = w + 8 * i;
            const float* wr = ws + ((size_t)g * 128 + t) * 128;
            float acc = 0.f;
            for (int s = 0; s <= t; s++) acc = fmaf(wr[s], V[s * 64 + lane], acc);
            acc += bs[g * 128 + t];
            float u = gelu_t(bf2f(H[(tok0 + t) * HLD + C_GU + g * 64 + lane]));
            PF(Y)[(tok0 + t) * DM + g * 64 + lane] = f2bf(u * acc);
        }
    }
}

__device__ void phase_compress(KA ka, int layer, float* smem) {
    PHASE_IDS
    const bf16_t* H = PF(H);
    for (int item = BID; item < 32; item += gridDim.x) {
        int which = item >> 4, mt = item & 15;
        const float* pos = PF(cmp_pos) + ((size_t)layer * 2 + which) * 32 * 64;
        const float* w1 = PF(cmp_w1) + ((size_t)layer * 2 + which) * 2048 * 128;
        const float* w2 = PF(cmp_w2) + ((size_t)layer * 2 + which) * 128 * 64;
        float* G = PF(gbuf) + (size_t)which * 2044 * 128;
        float* O = (which == 0 ? PF(kcmp) : PF(vcmp));
        const int colbase = (which == 0 ? C_KC : C_VC);
        gemm128(TID, mt * 128, 0, 2044, 128, 2048,
                [&](int r, int k) {
                    int n = r % NCMP, bh = r / NCMP;
                    int hk = bh & 1, b = bh >> 1;
                    int l = k >> 6, d = k & 63;
                    size_t tok = (size_t)b * T_ + n * 16 + l;
                    return bf2f(H[tok * HLD + colbase + hk * 64 + d]) + pos[l * 64 + d];
                },
                [&](int k, int n) { return w1[(size_t)k * 128 + n]; },
                [&](int r, int n, float v) { G[(size_t)r * 128 + n] = gelu_t(v); }, smem);
        __threadfence_block();
        __syncthreads();
        gemm128(TID, mt * 128, 0, 2044, 64, 128,
                [&](int r, int k) { return G[(size_t)r * 128 + k]; },
                [&](int k, int n) { return w2[(size_t)k * 64 + n]; },
                [&](int r, int n, float v) { O[(size_t)r * 64 + n] = v; }, smem);
    }
}

__device__ void phase_hgrn(KA ka, int layer, float* smem) {
    PHASE_IDS
    float* Q = smem;
    float* F = smem + 2048;
    float* K = smem + 4096;
    float* I = smem + 6144;
    const int tid = TID, lane = tid & 63, w = tid >> 6;
    const int v = (w & 3) * 16 + (lane & 15), dq = lane >> 4;
    const bf16_t* H = PF(H);
    for (int item = BID; item < 8; item += gridDim.x) {
        int h = item & 3, b = item >> 2;
        float S[16];
#pragma unroll
        for (int j = 0; j < 16; j++) S[j] = 0.f;
        for (int t0 = 0; t0 < T_; t0 += 32) {
            __syncthreads();
            for (int i = 0; i < 4; i++) {
                int e = tid + i * NTHR;
                int ts = e >> 6, d = e & 63;
                size_t tok = (size_t)b * T_ + t0 + ts;
                float lb = 0.f;
                if (layer == 1) {
                    float h0 = PF(hg_lower)[h * 64 + d], h1 = PF(hg_lower)[256 + h * 64 + d];
                    float mx = fmaxf(h0, h1);
                    float e0 = expf(h0 - mx), e1 = expf(h1 - mx);
                    lb = e1 / (e0 + e1);
                }
                float fl = bf2f(H[tok * HLD + C_HF + h * 64 + d]);
                float sg = 1.f / (1.f + expf(-fl));
                float sgn = 1.f / (1.f + expf(fl));
                F[e] = lb + (1.f - lb) * sg;
                K[e] = (1.f - lb) * sgn;
                Q[e] = bf2f(H[tok * HLD + C_HQ + h * 64 + d]);
                I[e] = bf2f(H[tok * HLD + C_HI + h * 64 + d]);
            }
            __syncthreads();
            if (w < 4) {
                for (int ts = 0; ts < 32; ts++) {
                    float iv = I[ts * 64 + v];
                    float part = 0.f;
#pragma unroll
                    for (int j4 = 0; j4 < 4; j4++) {
                        float4 f4 = *(const float4*)&F[ts * 64 + dq * 16 + j4 * 4];
                        float4 k4 = *(const float4*)&K[ts * 64 + dq * 16 + j4 * 4];
                        float4 q4 = *(const float4*)&Q[ts * 64 + dq * 16 + j4 * 4];
                        S[j4 * 4 + 0] = fmaf(f4.x, S[j4 * 4 + 0], k4.x * iv); part = fmaf(q4.x, S[j4 * 4 + 0], part);
                        S[j4 * 4 + 1] = fmaf(f4.y, S[j4 * 4 + 1], k4.y * iv); part = fmaf(q4.y, S[j4 * 4 + 1], part);
                        S[j4 * 4 + 2] = fmaf(f4.z, S[j4 * 4 + 2], k4.z * iv); part = fmaf(q4.z, S[j4 * 4 + 2], part);
                        S[j4 * 4 + 3] = fmaf(f4.w, S[j4 * 4 + 3], k4.w * iv); part = fmaf(q4.w, S[j4 * 4 + 3], part);
                    }
                    part += __shfl_xor(part, 16);
                    part += __shfl_xor(part, 32);
                    if (dq == 0) PF(Y)[((size_t)b * T_ + t0 + ts) * DM + 768 + h * 64 + v] = f2bf(part);
                }
            }
        }
    }
}
struct AttnState { float m[4], l[4], o[4]; };

__device__ __forceinline__ void attend64(AttnState& st, const float* qs, float* pl, const bf16_t* H, size_t rowbase,
                                         int tok0, int tmax, int tmin, int kcol, int vcol, int lane) {
    int tok = tok0 + lane;
    bool valid = (tok <= tmax) && (tok >= tmin);
    int tokc = tok > tmax ? tmax : tok;
    const uint4* kr = (const uint4*)(H + (rowbase + tokc) * HLD + kcol);
    float s[4] = {0.f, 0.f, 0.f, 0.f};
#pragma unroll 2
    for (int c = 0; c < 8; c++) {
        asm volatile("" ::: "memory");
        uint4 u = kr[c];
        unsigned uu[4] = {u.x, u.y, u.z, u.w};
#pragma unroll
        for (int e = 0; e < 4; e++) {
            float k0 = __uint_as_float(uu[e] << 16), k1 = __uint_as_float(uu[e] & 0xffff0000u);
            int d = c * 8 + e * 2;
#pragma unroll
            for (int g = 0; g < 4; g++) {
                s[g] = fmaf(qs[g * 64 + d], k0, s[g]);
                s[g] = fmaf(qs[g * 64 + d + 1], k1, s[g]);
            }
        }
    }
    float pr[4], alpha[4];
#pragma unroll
    for (int g = 0; g < 4; g++) {
        float sv = valid ? s[g] * 0.125f : NEG_INF;
        float mn = fmaxf(st.m[g], wave_max(sv));
        alpha[g] = __expf(st.m[g] - mn);
        pr[g] = valid ? __expf(sv - mn) : 0.f;
        st.l[g] = st.l[g] * alpha[g] + wave_sum(pr[g]);
        st.m[g] = mn;
        st.o[g] *= alpha[g];
    }
    *(float4*)&pl[lane * 4] = make_float4(pr[0], pr[1], pr[2], pr[3]);
    wave_sync();
    int jmax = tmax - tok0; if (jmax > 63) jmax = 63;
    for (int j = 0; j <= jmax; j++) {
        float vv = bf2f(H[(rowbase + tok0 + j) * HLD + vcol + lane]);
        float4 p4 = *(const float4*)&pl[j * 4];
        st.o[0] = fmaf(p4.x, vv, st.o[0]);
        st.o[1] = fmaf(p4.y, vv, st.o[1]);
        st.o[2] = fmaf(p4.z, vv, st.o[2]);
        st.o[3] = fmaf(p4.w, vv, st.o[3]);
    }
    wave_sync();
}

__device__ void phase_nsa(KA ka, int layer, float* smem) {
    PHASE_IDS
    const int lane = TID & 63, w = TID >> 6;
    float* sm = smem + w * 3328;
    float* qs = sm;
    float* S = sm + 256;
    float* PS = sm + 2304;
    float* IMP = sm + 2816;
    float* PL = sm + 2944;
    int* SEL = (int*)(sm + 3200);
    const bf16_t* H = PF(H);
    const float* gate_b = PF(nsa_gate_b) + layer * 24;
    for (int item = BID * NW + w; item < 32768; item += gridDim.x * NW) {
        const int t = item & 8191, hk = (item >> 13) & 1, b = item >> 14;
        const size_t rowbase = (size_t)b * T_;
        const size_t tok = rowbase + t;
        wave_sync();
#pragma unroll
        for (int g = 0; g < 4; g++) qs[g * 64 + lane] = bf2f(H[tok * HLD + C_NQ + (hk * 4 + g) * 64 + lane]);
        wave_sync();
        const float* kc = PF(kcmp) + (size_t)(b * 2 + hk) * NCMP * 64;
        const float* vc = PF(vcmp) + (size_t)(b * 2 + hk) * NCMP * 64;
        int nvalid = t >= 31 ? ((t - 31) >> 4) + 1 : 0;
        if (nvalid > NCMP) nvalid = NCMP;
        float mx[4] = {NEG_INF, NEG_INF, NEG_INF, NEG_INF};
        for (int r = 0; r * 64 < nvalid; r++) {
            int n = r * 64 + lane;
            int nc = n < nvalid ? n : nvalid - 1;
            const float4* kr = (const float4*)(kc + (size_t)nc * 64);
            float s[4] = {0.f, 0.f, 0.f, 0.f};
#pragma unroll 2
            for (int c = 0; c < 16; c++) {
                asm volatile("" ::: "memory");
                float4 k4 = kr[c];
#pragma unroll
                for (int g = 0; g < 4; g++) {
                    float4 q4 = *(const float4*)&qs[g * 64 + c * 4];
                    s[g] = fmaf(q4.x, k4.x, s[g]); s[g] = fmaf(q4.y, k4.y, s[g]);
                    s[g] = fmaf(q4.z, k4.z, s[g]); s[g] = fmaf(q4.w, k4.w, s[g]);
                }
            }
#pragma unroll
            for (int g = 0; g < 4; g++) {
                float sv = n < nvalid ? s[g] * 0.125f : NEG_INF;
                S[g * 512 + n] = sv;
                mx[g] = fmaxf(mx[g], sv);
            }
        }
        float ocmp[4] = {0.f, 0.f, 0.f, 0.f};
        for (int r = 0; r < 8; r++) PS[r * 64 + lane] = 0.f;
        if (nvalid > 0) {
            float sum[4] = {0.f, 0.f, 0.f, 0.f};
#pragma unroll
            for (int g = 0; g < 4; g++) mx[g] = wave_max(mx[g]);
            for (int r = 0; r * 64 < nvalid; r++) {
                int n = r * 64 + lane;
#pragma unroll
                for (int g = 0; g < 4; g++) {
                    float e = n < nvalid ? __expf(S[g * 512 + n] - mx[g]) : 0.f;
                    S[g * 512 + n] = e;
                    sum[g] += e;
                }
            }
            float inv[4];
#pragma unroll
            for (int g = 0; g < 4; g++) inv[g] = 1.f / wave_sum(sum[g]);
            for (int r = 0; r * 64 < nvalid; r++) {
                int n = r * 64 + lane;
                float ps = 0.f;
#pragma unroll
                for (int g = 0; g < 4; g++) {
                    float pv = S[g * 512 + n] * inv[g];
                    S[g * 512 + n] = pv;
                    ps += pv;
                }
                PS[n] = ps;
            }
            wave_sync();
            for (int n = 0; n < nvalid; n++) {
                float vv = vc[(size_t)n * 64 + lane];
                ocmp[0] = fmaf(S[n], vv, ocmp[0]);
                ocmp[1] = fmaf(S[512 + n], vv, ocmp[1]);
                ocmp[2] = fmaf(S[1024 + n], vv, ocmp[2]);
                ocmp[3] = fmaf(S[1536 + n], vv, ocmp[3]);
            }
        }
        wave_sync();
        const int cur = t >> 6;
        float iv[2];
#pragma unroll
        for (int q = 0; q < 2; q++) {
            int j = lane + q * 64;
            float a = 0.f;
#pragma unroll
            for (int dn = -1; dn <= 3; dn++) {
                int n = 4 * j + dn;
                if (n >= 0 && n < NCMP) a += PS[n];
            }
            bool forced = (j == 0) || (j == cur) || (j == cur - 1);
            float val = (j <= cur) ? (a + (forced ? 1e4f : 0.f)) : NEG_INF;
            iv[q] = val;
            IMP[j] = val;
        }
        wave_sync();
        int c0 = 0, c1 = 0;
        for (int jj = 0; jj < 128; jj++) {
            float xv = IMP[jj];
            c0 += (xv > iv[0]) || (xv == iv[0] && jj < lane);
            c1 += (xv > iv[1]) || (xv == iv[1] && jj < lane + 64);
        }
        bool s0 = (c0 < 16) && (iv[0] > 0.5f * NEG_INF);
        bool s1 = (c1 < 16) && (iv[1] > 0.5f * NEG_INF);
        unsigned long long m0 = __ballot(s0), m1 = __ballot(s1);
        unsigned long long lower = (lane == 0) ? 0ull : (~0ull >> (64 - lane));
        if (s0) SEL[__popcll(m0 & lower)] = lane;
        if (s1) SEL[__popcll(m0) + __popcll(m1 & lower)] = lane + 64;
        const int nsel = __popcll(m0) + __popcll(m1);
        wave_sync();
        AttnState st;
#pragma unroll
        for (int g = 0; g < 4; g++) { st.m[g] = NEG_INF; st.l[g] = 0.f; st.o[g] = 0.f; }
        for (int si = 0; si < nsel; si++) {
            int jb = SEL[si];
            attend64(st, qs, PL, H, rowbase, jb * 64, t, 0, C_KS + hk * 64, C_VS + hk * 64, lane);
        }
        float oslc[4];
#pragma unroll
        for (int g = 0; g < 4; g++) oslc[g] = st.o[g] / st.l[g];
#pragma unroll
        for (int g = 0; g < 4; g++) { st.m[g] = NEG_INF; st.l[g] = 0.f; st.o[g] = 0.f; }
        const int wstart = t - 511 > 0 ? t - 511 : 0;
        for (int tk = wstart; tk <= t; tk += 64)
            attend64(st, qs, PL, H, rowbase, tk, t, wstart, C_KW + hk * 64, C_VW + hk * 64, lane);
#pragma unroll
        for (int g = 0; g < 4; g++) {
            int hh = hk * 4 + g;
            float g0 = sigmoidf_(bf2f(H[tok * HLD + C_NG + hh * 3 + 0]) + gate_b[hh * 3 + 0]);
            float g1 = sigmoidf_(bf2f(H[tok * HLD + C_NG + hh * 3 + 1]) + gate_b[hh * 3 + 1]);
            float g2 = sigmoidf_(bf2f(H[tok * HLD + C_NG + hh * 3 + 2]) + gate_b[hh * 3 + 2]);
            float ow = st.o[g] / st.l[g];
            PF(Y)[tok * DM + 256 + hh * 64 + lane] = f2bf(g0 * ocmp[g] + g1 * oslc[g] + g2 * ow);
        }
    }
}

__device__ void phase_headnorm(KA ka, int layer) {
    PHASE_IDS
    const int lane = TID & 63, w = TID >> 6;
    const float* og = PF(out_gain) + layer * 1024;
    for (int row = BID * NW + w; row < NTOK; row += gridDim.x * NW) {
#pragma unroll
        for (int hd = 0; hd < 16; hd++) {
            float v = bf2f(PF(Y)[(size_t)row * DM + hd * 64 + lane]);
            float ms = wave_sum(v * v) * (1.f / 64.f);
            float y = v * rsqrtf(ms + 1e-6f) * og[hd * 64 + lane];
            if (hd >= 12) {
                float hg = bf2f(PF(H)[(size_t)row * HLD + C_HG + (hd - 12) * 64 + lane]);
                y *= hg * sigmoidf_(hg);
            }
            PF(Y)[(size_t)row * DM + hd * 64 + lane] = f2bf(y);
        }
    }
}

__device__ void phase_ln1_route(KA ka, int layer, float* x1) {
    PHASE_IDS
    bf16_t* xb = PF(XB);
    const int lane = TID & 63, w = TID >> 6;
    const float* g = PF(ln1_g) + layer * 1024;
    const float* bb = PF(ln1_b) + layer * 1024;
    const float* wg = PF(rg_w) + (size_t)layer * 1024 * 4;
    const float* we = PF(re_w) + (size_t)layer * 1024 * 16;
    const float* bg = PF(rg_b) + layer * 4;
    const float* be = PF(re_b) + layer * 16;
    int* cnt = (int*)(PF(ctl) + CW_CNT) + layer * 16;
    for (int row = BID * NW + w; row < NTOK; row += gridDim.x * NW) {
        float v[16];
        float s = 0.f;
#pragma unroll
        for (int i = 0; i < 16; i++) { v[i] = x1[(size_t)row * DM + i * 64 + lane]; s += v[i]; }
        float mu = wave_sum(s) * (1.f / 1024.f);
        float q = 0.f;
#pragma unroll
        for (int i = 0; i < 16; i++) { float d = v[i] - mu; q += d * d; }
        float rstd = rsqrtf(wave_sum(q) * (1.f / 1024.f) + 1e-5f);
        float lg[4] = {0.f, 0.f, 0.f, 0.f};
        float le[16];
#pragma unroll
        for (int e = 0; e < 16; e++) le[e] = 0.f;
#pragma unroll
        for (int i = 0; i < 16; i++) {
            int c = i * 64 + lane;
            float o = (v[i] - mu) * rstd * g[c] + bb[c];
            x1[(size_t)row * DM + c] = o;
            xb[(size_t)row * DM + c] = f2bf(o);
            float4 w4 = *(const float4*)&wg[c * 4];
            lg[0] = fmaf(o, w4.x, lg[0]); lg[1] = fmaf(o, w4.y, lg[1]);
            lg[2] = fmaf(o, w4.z, lg[2]); lg[3] = fmaf(o, w4.w, lg[3]);
#pragma unroll
            for (int e4 = 0; e4 < 4; e4++) {
                float4 x4 = *(const float4*)&we[c * 16 + e4 * 4];
                le[e4 * 4 + 0] = fmaf(o, x4.x, le[e4 * 4 + 0]);
                le[e4 * 4 + 1] = fmaf(o, x4.y, le[e4 * 4 + 1]);
                le[e4 * 4 + 2] = fmaf(o, x4.z, le[e4 * 4 + 2]);
                le[e4 * 4 + 3] = fmaf(o, x4.w, le[e4 * 4 + 3]);
            }
        }
#pragma unroll
        for (int c = 0; c < 4; c++) lg[c] = wave_sum(lg[c]) + bg[c];
#pragma unroll
        for (int e = 0; e < 16; e++) le[e] = wave_sum(le[e]) + be[e];
        float gm = fmaxf(fmaxf(lg[0], lg[1]), fmaxf(lg[2], lg[3]));
        float ge[4], gs = 0.f;
#pragma unroll
        for (int c = 0; c < 4; c++) { ge[c] = __expf(lg[c] - gm); gs += ge[c]; }
        int gi = 0; float gbest = ge[0];
#pragma unroll
        for (int c = 1; c < 4; c++) if (ge[c] > gbest) { gbest = ge[c]; gi = c; }
        float gval = gbest / gs;
        float ls[4];
#pragma unroll
        for (int e = 0; e < 4; e++) ls[e] = gi == 0 ? le[e] : gi == 1 ? le[4 + e] : gi == 2 ? le[8 + e] : le[12 + e];
        float em = fmaxf(fmaxf(ls[0], ls[1]), fmaxf(ls[2], ls[3]));
        float pe[4];
#pragma unroll
        for (int e = 0; e < 4; e++) pe[e] = __expf(ls[e] - em);
        int i1 = 0; float b1 = pe[0];
#pragma unroll
        for (int e = 1; e < 4; e++) if (pe[e] > b1) { b1 = pe[e]; i1 = e; }
        int i2 = -1; float b2 = -1.f;
#pragma unroll
        for (int e = 0; e < 4; e++) if (e != i1 && pe[e] > b2) { b2 = pe[e]; i2 = e; }
        float w1 = gval * b1 / (b1 + b2), w2 = gval * b2 / (b1 + b2);
        if (lane == 0) {
            int e1 = gi * 4 + i1, e2 = gi * 4 + i2;
            int p1 = atomicAdd(&cnt[e1], 1);
            PF(list_tok)[e1 * NTOK + p1] = row; PF(list_w)[e1 * NTOK + p1] = w1;
            int p2 = atomicAdd(&cnt[e2], 1);
            PF(list_tok)[e2 * NTOK + p2] = row; PF(list_w)[e2 * NTOK + p2] = w2;
            PF(tok_slot)[row * 2 + 0] = e1 * NTOK + p1; PF(tok_slot)[row * 2 + 1] = e2 * NTOK + p2;
        }
    }
}


template <bool GATHER_>
struct MoeOrder {
    static constexpr bool GATHER = GATHER_;
    const LAS int* tab; const LAS int* rowtab;
    const char* Bt; unsigned estride; int K, G, c;
    __device__ __forceinline__ bool next(int i, pg8::Unit& u) const {
        const int nwg = __builtin_amdgcn_readfirstlane(tab[48]) * 4;
        const int L = i * G + c; if (L >= nwg) return false;
        int wgid = L; { const int q = nwg / 8, r = nwg % 8, xcd = wgid % 8, off = wgid / 8; wgid = (xcd < r ? xcd * (q + 1) : r * (q + 1) + (xcd - r) * q) + off; }
        const int mg = wgid >> 2, nt = wgid & 3;
        int e = 0;
#pragma unroll
        for (int k = 1; k < 16; ++k) e = (__builtin_amdgcn_readfirstlane(tab[32 + k]) <= mg) ? k : e;
        const int mt = mg - __builtin_amdgcn_readfirstlane(tab[32 + e]);
        const int rem = __builtin_amdgcn_readfirstlane(tab[e]) - mt * 256;
        u.e = e; u.pm = mt; u.pn = nt; u.ui = i; u.nrows = rem < 256 ? rem : 256; u.arow0 = __builtin_amdgcn_readfirstlane(tab[16 + e]) + mt * 256;
        u.bptr = Bt + (size_t)e * estride + (size_t)nt * 256 * K * 2;
        return true;
    }
    __device__ __forceinline__ int arow(const pg8::Unit& u, int r) const { return GATHER_ ? rowtab[u.ui * 256 + r] : u.arow0 + r; }
};
__device__ __forceinline__ void moe_tables(KA ka, int layer, LAS unsigned char* lds, bool want_rows, int G, int c) {
    LAS int* tab = (LAS int*)(lds + LDS_MISC + 256);
    LAS int* rowtab = (LAS int*)(lds + LDS_MISC + 1024);
    const int tid = opaque_tid();
    const int* cnt = (const int*)(PF(ctl) + CW_CNT) + layer * 16;
    if (tid < 16) tab[tid] = __hip_atomic_load(&cnt[tid], __ATOMIC_RELAXED, __HIP_MEMORY_SCOPE_AGENT);
    __syncthreads();
    if (tid == 0) {
        int b = 0, m = 0;
        for (int e = 0; e < 16; ++e) { tab[16 + e] = b; tab[32 + e] = m; b += tab[e]; m += (tab[e] + 255) >> 8; }
        tab[48] = m;
    }
    __syncthreads();
    if (want_rows) {
        MoeOrder<true> S{tab, rowtab, nullptr, 0u, 1024, G, c};
        const int* lt = PF(list_tok);
        for (int i = 0; i < 4; ++i) {
            pg8::Unit u;
            if (!S.next(i, u)) break;
            if (tid < 256) { const int r = tid < u.nrows ? tid : u.nrows - 1; rowtab[i * 256 + tid] = lt[u.e * NTOK + u.pm * 256 + r]; }
        }
        asm volatile("s_waitcnt vmcnt(0) lgkmcnt(0)" ::: "memory");
        __syncthreads();
    }
}
struct EpiUp {
    static constexpr bool PERM = true;
    bf16_t* hidden;
    __device__ __forceinline__ void operator()(const f32x4 (&acc)[2][2][4][2], const pg8::Unit& u, int wr, int wc, int fr, int fq) const {
#pragma unroll
        for (int ai = 0; ai < 2; ++ai)
#pragma unroll
            for (int m = 0; m < 4; ++m) {
                const int r = ai * 128 + wr * 64 + m * 16 + fr;
                if (r < u.nrows) {
                    bf16_t* rowp = hidden + (size_t)(u.arow0 + r) * 512 + u.pn * 128 + wc * 32 + 8 * fq;
                    float h[8];
#pragma unroll
                    for (int n = 0; n < 2; ++n)
#pragma unroll
                        for (int j = 0; j < 4; ++j) { const float g = acc[ai][0][m][n][j], uu = acc[ai][1][m][n][j]; h[n * 4 + j] = g * sigmoidf_(g) * uu; }
                    u32x4 w; w.x = pg8::cvt_pk_bf16(h[0], h[1]); w.y = pg8::cvt_pk_bf16(h[2], h[3]); w.z = pg8::cvt_pk_bf16(h[4], h[5]); w.w = pg8::cvt_pk_bf16(h[6], h[7]);
                    *(u32x4*)rowp = w;
                }
            }
    }
};
struct EpiDown {
    static constexpr bool PERM = true;
    bf16_t* Y2; const float* lw;
    __device__ __forceinline__ void operator()(const f32x4 (&acc)[2][2][4][2], const pg8::Unit& u, int wr, int wc, int fr, int fq) const {
#pragma unroll
        for (int ai = 0; ai < 2; ++ai)
#pragma unroll
            for (int m = 0; m < 4; ++m) {
                const int r = ai * 128 + wr * 64 + m * 16 + fr;
                if (r < u.nrows) {
                    const float wgt = lw[u.e * NTOK + u.pm * 256 + r];
                    bf16_t* rowp = Y2 + (size_t)(u.arow0 + r) * DM + u.pn * 256 + wc * 32 + 8 * fq;
#pragma unroll
                    for (int bj = 0; bj < 2; ++bj) {
                        const f32x4 v0 = acc[ai][bj][m][0] * wgt, v1 = acc[ai][bj][m][1] * wgt;
                        u32x4 w; w.x = pg8::cvt_pk_bf16(v0[0], v0[1]); w.y = pg8::cvt_pk_bf16(v0[2], v0[3]); w.z = pg8::cvt_pk_bf16(v1[0], v1[1]); w.w = pg8::cvt_pk_bf16(v1[2], v1[3]);
                        *(u32x4*)(rowp + bj * 128) = w;
                    }
                }
            }
    }
};
__device__ __forceinline__ void phase_moe_up(KA ka, int layer, LAS unsigned char* lds) {
    moe_tables(ka, layer, lds, true, gridDim.x, opaque_bid());
    MoeOrder<true> S{(const LAS int*)(lds + LDS_MISC + 256), (const LAS int*)(lds + LDS_MISC + 1024),
                     (const char*)(PF(WT) + (size_t)layer * WT_LAYER + WT_UP), (unsigned)(1024u * 1024u * 2u), 1024, (int)gridDim.x, opaque_bid()};
    EpiUp E{PF(Y)};
    pg8::gemm_phase<EpiUp, MoeOrder<true>>(lds, (const char*)PF(XB), 1024, S, E);
}
__device__ __forceinline__ void phase_moe_down(KA ka, int layer, LAS unsigned char* lds) {
    moe_tables(ka, layer, lds, false, gridDim.x, opaque_bid());
    MoeOrder<false> S{(const LAS int*)(lds + LDS_MISC + 256), (const LAS int*)(lds + LDS_MISC + 1024),
                      (const char*)(PF(WT) + (size_t)layer * WT_LAYER + WT_DN), (unsigned)(1024u * 512u * 2u), 512, (int)gridDim.x, opaque_bid()};
    EpiDown E{PF(H), PF(list_w)};
    pg8::gemm_phase<EpiDown, MoeOrder<false>>(lds, (const char*)PF(Y), 512, S, E);
}

__device__ void phase_ln2(KA ka, int layer, const float* x1, float* xo) {
    PHASE_IDS
    bf16_t* xb = PF(XB);
    const bf16_t* Y2 = PF(H);
    const int lane = TID & 63, w = TID >> 6;
    const float* g = PF(ln2_g) + layer * 1024;
    const float* bb = PF(ln2_b) + layer * 1024;
    const int* cnt = (const int*)(PF(ctl) + CW_CNT) + layer * 16;
    int mybase = 0;
    {
        int cv = lane < 16 ? __hip_atomic_load(&cnt[lane & 15], __ATOMIC_RELAXED, __HIP_MEMORY_SCOPE_AGENT) : 0;
        int incl = cv;
#pragma unroll
        for (int o = 1; o < 16; o <<= 1) { int t = __shfl_up(incl, o); if ((lane & 15) >= o) incl += t; }
        mybase = incl - cv;
    }
    for (int row = BID * NW + w; row < NTOK; row += gridDim.x * NW) {
        const int ts1 = PF(tok_slot)[row * 2 + 0], ts2 = PF(tok_slot)[row * 2 + 1];
        const int s1 = __shfl(mybase, ts1 >> 14) + (ts1 & (NTOK - 1)), s2 = __shfl(mybase, ts2 >> 14) + (ts2 & (NTOK - 1));
        float v[16];
        float s = 0.f;
#pragma unroll
        for (int i = 0; i < 16; i++) {
            const int c = i * 64 + lane;
            v[i] = ALPHA * x1[(size_t)row * DM + c] + bf2f(Y2[(size_t)s1 * DM + c]) + bf2f(Y2[(size_t)s2 * DM + c]);
            s += v[i];
        }
        float mu = wave_sum(s) * (1.f / 1024.f);
        float q = 0.f;
#pragma unroll
        for (int i = 0; i < 16; i++) { float d = v[i] - mu; q += d * d; }
        float rstd = rsqrtf(wave_sum(q) * (1.f / 1024.f) + 1e-5f);
#pragma unroll
        for (int i = 0; i < 16; i++) {
            int c = i * 64 + lane;
            const float o = (v[i] - mu) * rstd * g[c] + bb[c];
            xo[(size_t)row * DM + c] = o;
            xb[(size_t)row * DM + c] = f2bf(o);
        }
    }
}

#ifndef ONLY_Q
#define ONLY_Q -2
#endif
#ifndef QMASK
#define QMASK 0x3ff
#endif
#define QON(k) ((ONLY_Q == -2 && ((QMASK >> ((k) + 1)) & 1)) || ONLY_Q == (k))
#ifndef NPH_TOTAL
#define NPH_TOTAL 19
#endif
__global__ void __launch_bounds__(NTHR, 2) k_mega(P p0) {
    extern __shared__ __attribute__((aligned(16))) unsigned char lds_raw[];
    LAS unsigned char* lds = (LAS unsigned char*)lds_raw;
    float* smem = (float*)lds_raw;
    volatile LAS unsigned* misc = (volatile LAS unsigned*)(lds + LDS_MISC);
    if (threadIdx.x < 16) misc[threadIdx.x] = 0u;
    __syncthreads();
    XcdBarrier bar = xcd_barrier_post(p0.ctl + CW_BAR, misc);
#pragma unroll 1
    for (int ph = 0; ph < p0.nph; ph++) {
        const int layer = ph == 0 ? 0 : (ph - 1) / 9, q = ph == 0 ? -1 : (ph - 1) % 9;
#if defined(__HIP_DEVICE_COMPILE__)
        KA ka = (KA)__builtin_amdgcn_kernarg_segment_ptr();
        asm volatile("" : "+s"(ka));
#else
        KA ka = nullptr;
#endif
        const float* xin = layer == 0 ? PF(x) : PF(out);
        float* x1 = PF(out);
        if (q == -1 && QON(-1)) phase_prologue(ka, smem);
        else if (q == 0 && QON(0)) phase_inproj(ka, layer, lds);
        else if (q == 1 && QON(1)) { phase_hgrn(ka, layer, smem); phase_gmlp(ka, layer, smem); __syncthreads(); phase_compress(ka, layer, smem); }
        else if (q == 2 && QON(2)) phase_nsa(ka, layer, smem);
        else if (q == 3 && QON(3)) phase_headnorm(ka, layer);
        else if (q == 4 && QON(4)) phase_outproj(ka, layer, xin, x1, lds);
        else if (q == 5 && QON(5)) phase_ln1_route(ka, layer, x1);
        else if (q == 6 && QON(6)) phase_moe_up(ka, layer, lds);
        else if (q == 7 && QON(7)) phase_moe_down(ka, layer, lds);
        else if (q == 8 && QON(8)) phase_ln2(ka, layer, x1, PF(out));
        if (ph != NPH_TOTAL - 1) xcd_barrier(bar);
    }
}

static inline size_t align_up(size_t v, size_t a) { return (v + a - 1) / a * a; }

extern "C" void kernel_launch(void* const* d_in, const int* in_sizes, int n_in, void* d_out, int out_size, void* d_ws,
                              size_t ws_size, hipStream_t stream) {
    P p{};
    p.x = (const float*)d_in[0]; p.w_in = (const float*)d_in[1]; p.gm_v_gain = (const float*)d_in[2];
    p.gm_v_bias = (const float*)d_in[3]; p.gm_w_s = (const float*)d_in[4]; p.gm_b_s = (const float*)d_in[5];
    p.cmp_pos = (const float*)d_in[6]; p.cmp_w1 = (const float*)d_in[7]; p.cmp_w2 = (const float*)d_in[8];
    p.nsa_gate_b = (const float*)d_in[9]; p.hg_lower = (const float*)d_in[10]; p.out_gain = (const float*)d_in[11];
    p.w_out = (const float*)d_in[12]; p.ln1_g = (const float*)d_in[13]; p.ln1_b = (const float*)d_in[14];
    p.rg_w = (const float*)d_in[15]; p.rg_b = (const float*)d_in[16]; p.re_w = (const float*)d_in[17];
    p.re_b = (const float*)d_in[18]; p.w_gate = (const float*)d_in[19]; p.w_up = (const float*)d_in[20];
    p.w_down = (const float*)d_in[21]; p.ln2_g = (const float*)d_in[22]; p.ln2_b = (const float*)d_in[23];
    p.out = (float*)d_out;
    char* ws = (char*)d_ws;
    size_t off = 0;
    p.ctl = (unsigned*)(ws + off); off = align_up(off + CTL_BYTES, 256);
    p.WT = (bf16_t*)(ws + off); off = align_up(off + 2 * WT_LAYER * 2, 256);
    p.H = (bf16_t*)(ws + off); off = align_up(off + (size_t)NTOK * HLD * 2, 256);
    p.Y = (bf16_t*)(ws + off); off = align_up(off + (size_t)NTOK * DM * 2, 256);
    p.XB = (bf16_t*)(ws + off); off = align_up(off + (size_t)NTOK * DM * 2, 256);
    p.kcmp = (float*)(ws + off); off = align_up(off + (size_t)4 * NCMP * 64 * 4, 256);
    p.vcmp = (float*)(ws + off); off = align_up(off + (size_t)4 * NCMP * 64 * 4, 256);
    p.gbuf = (float*)(ws + off); off = align_up(off + (size_t)2 * 2044 * 128 * 4, 256);
    p.list_tok = (int*)(ws + off); off = align_up(off + (size_t)16 * NTOK * 4, 256);
    p.list_w = (float*)(ws + off); off = align_up(off + (size_t)16 * NTOK * 4, 256);
    p.tok_slot = (int*)(ws + off); off = align_up(off + (size_t)NTOK * 2 * 4, 256);
    p.nph = NPH_TOTAL;
    (void)in_sizes; (void)n_in; (void)out_size;
    static int grid_blocks = 0;
    if (!grid_blocks) {
        int dev = 0, cus = 0, per_cu = 0;
        (void)hipGetDevice(&dev);
        (void)hipDeviceGetAttribute(&cus, hipDeviceAttributeMultiprocessorCount, dev);
        if (hipFuncSetAttribute((const void*)k_mega, hipFuncAttributeMaxDynamicSharedMemorySize, LDS_BYTES) != hipSuccess) { fprintf(stderr, "hipFuncSetAttribute failed\n"); grid_blocks = -1; return; }
        if (hipOccupancyMaxActiveBlocksPerMultiprocessor(&per_cu, (const void*)k_mega, NTHR, LDS_BYTES) != hipSuccess || per_cu < 1) { fprintf(stderr, "occupancy query says %d\n", per_cu); }
        (void)hipGetLastError();
        grid_blocks = cus;
        if (off > ws_size) { fprintf(stderr, "workspace too small: need %zu have %zu\n", off, ws_size); grid_blocks = -1; }
    }
    if (grid_blocks < 0) return;
    (void)hipMemsetAsync(p.ctl, 0, CTL_BYTES, stream);
    void* args[] = {&p};
    hipError_t e = hipLaunchCooperativeKernel((const void*)k_mega, dim3(grid_blocks), dim3(NTHR), args, LDS_BYTES, stream);
    if (e != hipSuccess) fprintf(stderr, "cooperative launch failed: %s (grid %d)\n", hipGetErrorString(e), grid_blocks);
}
```

```cpp
#include <hip/hip_runtime.h>
#include <cstdio>
#include <cstdint>

#define LAS __attribute__((address_space(3)))
typedef unsigned short bf16_t;
typedef short bf16x8 __attribute__((ext_vector_type(8)));
typedef float f32x4 __attribute__((ext_vector_type(4)));
typedef float f32x2 __attribute__((ext_vector_type(2)));
typedef unsigned u32x4 __attribute__((ext_vector_type(4)));
typedef unsigned u32x2 __attribute__((ext_vector_type(2)));

constexpr int NW = 8;
constexpr int NTHR = NW * 64;
constexpr int T_ = 8192;
constexpr int NTOK = 16384;
constexpr int DM = 1024;
constexpr int IC_SRC = 2840;
constexpr int HLD = 3072;
constexpr int C_GU = 0, C_GV = 256, C_NQ = 512, C_KC = 1024, C_VC = 1152, C_KS = 1280, C_VS = 1408,
              C_KW = 1536, C_VW = 1664, C_HQ = 1792, C_HF = 2048, C_HI = 2304, C_HG = 2560, C_NG = 2816;
constexpr int NCMP = 511;
constexpr float ALPHA = 1.4142135623730951f;
constexpr float NEG_INF = -1e30f;

constexpr size_t WT_IN = 0;
constexpr size_t WT_OUT = WT_IN + (size_t)3072 * 1024;
constexpr size_t WT_UP = WT_OUT + (size_t)1024 * 1024;
constexpr size_t WT_DN = WT_UP + (size_t)16 * 1024 * 1024;
constexpr size_t WT_LAYER = WT_DN + (size_t)16 * 1024 * 512;

constexpr int LDS_STAGE = 131072;
constexpr int LDS_MISC = LDS_STAGE;
constexpr int LDS_BYTES = 147456;

constexpr int CW_BAR = 0;
constexpr int CW_CNT = 4096;
constexpr size_t CTL_BYTES = 65536;

struct P {
    const float* x; const float* w_in; const float* gm_v_gain; const float* gm_v_bias; const float* gm_w_s;
    const float* gm_b_s; const float* cmp_pos; const float* cmp_w1; const float* cmp_w2; const float* nsa_gate_b;
    const float* hg_lower; const float* out_gain; const float* w_out; const float* ln1_g; const float* ln1_b;
    const float* rg_w; const float* rg_b; const float* re_w; const float* re_b; const float* w_gate;
    const float* w_up; const float* w_down; const float* ln2_g; const float* ln2_b;
    float* out;
    unsigned* ctl;
    bf16_t* WT;
    bf16_t* H;
    bf16_t* Y;
    bf16_t* XB;
    bf16_t* kcb;
    bf16_t* vcT;
    bf16_t* vsT;
    bf16_t* vwT;
    float* gbuf;
    int* list_tok;
    float* list_w;
    int* tok_slot;
    int nph; int pad;
};


typedef const __attribute__((address_space(4))) char* KA;
template <class T> __device__ __forceinline__ T ldarg(KA ka, size_t off) { return *(const __attribute__((address_space(4))) T*)(ka + off); }
#define PF(f) ldarg<decltype(P::f)>(ka, offsetof(P, f))

__device__ __forceinline__ float bf2f(bf16_t u) { return __uint_as_float(((unsigned)u) << 16); }
__device__ __forceinline__ unsigned f2bf_u(float f) {
    unsigned u = __float_as_uint(f);
    return (u + 0x7fffu + ((u >> 16) & 1u)) >> 16;
}
__device__ __forceinline__ bf16_t f2bf(float f) { return (bf16_t)f2bf_u(f); }
__device__ __forceinline__ unsigned pk2(float lo, float hi) { return f2bf_u(lo) | (f2bf_u(hi) << 16); }
__device__ __forceinline__ float gelu_t(float x) {
    float u = 0.7978845608028654f * (x + 0.044715f * x * x * x);
    return 0.5f * x * (1.f + tanhf(u));
}
__device__ __forceinline__ float sigmoidf_(float x) { return 1.f / (1.f + __expf(-x)); }
__device__ __forceinline__ float wave_max(float v) {
#pragma unroll
    for (int o = 32; o > 0; o >>= 1) v = fmaxf(v, __shfl_xor(v, o));
    return v;
}
__device__ __forceinline__ float wave_sum(float v) {
#pragma unroll
    for (int o = 32; o > 0; o >>= 1) v += __shfl_xor(v, o);
    return v;
}
__device__ __forceinline__ void wave_sync() {
    __builtin_amdgcn_fence(__ATOMIC_RELEASE, "wavefront");
    __builtin_amdgcn_wave_barrier();
    __builtin_amdgcn_fence(__ATOMIC_ACQUIRE, "wavefront");
}
__device__ __forceinline__ int opaque_tid() { int t = threadIdx.x; asm volatile("" : "+v"(t)); return t; }
__device__ __forceinline__ int opaque_bid() { int b = blockIdx.x; asm volatile("" : "+s"(b)); return b; }
#define PHASE_IDS const int TID = opaque_tid(); const int BID = opaque_bid(); (void)TID; (void)BID;

#define XB_TMO      128
#define XB_XCNT(j)  (256  + 64 * (j))
#define XB_XSUB(j)  (1280 + 64 * (j))
#define XB_XGEN(j)  (2304 + 64 * (j))
#define XB_TOP      3328
#define XB_TOPGEN   3392
#define XCD_BAR_WORDS 3456
#define XB_SPIN_CAP (1u << 22)
__device__ __forceinline__ unsigned xb_ld(unsigned* p)              { return __hip_atomic_load(p, __ATOMIC_RELAXED, __HIP_MEMORY_SCOPE_AGENT); }
__device__ __forceinline__ unsigned xb_add(unsigned* p, unsigned v) { return __hip_atomic_fetch_add(p, v, __ATOMIC_RELAXED, __HIP_MEMORY_SCOPE_AGENT); }
__device__ __forceinline__ unsigned xb_xcc_id() { return (unsigned)__builtin_amdgcn_s_getreg((3 << 11) | 20) & 0xFu; }
#define XB_SPIN(cond, bar) do { unsigned _sp = 0; while (cond) { __builtin_amdgcn_s_sleep(1); \
    if ((++_sp & 255u) == 0u) { if (xb_ld(&(bar)[XB_TMO])) break; if (_sp > XB_SPIN_CAP) { atomicAdd(&(bar)[XB_TMO], 1u); break; } } } } while (0)
struct XcdBarrier { unsigned* bar; unsigned x; volatile LAS unsigned* st; };
__device__ __forceinline__ XcdBarrier xcd_barrier_post(unsigned* bar, volatile LAS unsigned* st) {
    XcdBarrier b; b.bar = bar; b.x = xb_xcc_id(); b.st = st;
    if (threadIdx.x == 0) (void)xb_add(&bar[XB_XCNT(b.x)], 1u);
    return b;
}
__device__ __forceinline__ void xcd_barrier_complete(unsigned* bar, unsigned x, unsigned& nloc, unsigned& nx) {
    const unsigned G = gridDim.x * gridDim.y * gridDim.z;
    unsigned sum, cnt, mine, sp = 0u;
    for (;;) {
        sum = 0u; cnt = 0u; mine = 0u;
#pragma unroll
        for (unsigned j = 0; j < 16; ++j) { const unsigned c = xb_ld(&bar[XB_XCNT(j)]); sum += c; cnt += (c > 0u) ? 1u : 0u; mine = (j == x) ? c : mine; }
        if (sum == G) break;
        __builtin_amdgcn_s_sleep(1);
        if ((++sp & 255u) == 0u) { if (xb_ld(&bar[XB_TMO])) break; if (sp > XB_SPIN_CAP) { atomicAdd(&bar[XB_TMO], 1u); break; } }
    }
    nloc = mine > 0u ? mine : 1u; nx = cnt > 0u ? cnt : 1u;
}
__device__ __forceinline__ void xcd_barrier(const XcdBarrier& b) {
    asm volatile("s_waitcnt vmcnt(0)" ::: "memory");
    __syncthreads();
    if (threadIdx.x == 0) {
        unsigned* bar = b.bar;
        __builtin_amdgcn_s_waitcnt(0);
        unsigned nloc = b.st[0], nx = b.st[1];
        if (nloc == 0u) { xcd_barrier_complete(bar, b.x, nloc, nx); b.st[0] = nloc; b.st[1] = nx; }
        const unsigned old = xb_add(&bar[XB_XSUB(b.x)], 1u);
        const unsigned gen = old / nloc;
        if (old + 1u == (gen + 1u) * nloc) {
            __builtin_amdgcn_fence(__ATOMIC_RELEASE, "agent");
            asm volatile("s_waitcnt vmcnt(0)" ::: "memory");
            const unsigned og = xb_add(&bar[XB_TOP], 1u);
            const unsigned tg = og / nx;
            if (og + 1u == (tg + 1u) * nx) xb_add(&bar[XB_TOPGEN], 1u);
            else XB_SPIN(xb_ld(&bar[XB_TOPGEN]) == tg, bar);
            __builtin_amdgcn_fence(__ATOMIC_ACQUIRE, "agent");
            xb_add(&bar[XB_XGEN(b.x)], 1u);
            asm volatile("s_waitcnt vmcnt(0)" ::: "memory");
        } else {
            XB_SPIN(xb_ld(&bar[XB_XGEN(b.x)]) == gen, bar);
            __builtin_amdgcn_fence(__ATOMIC_ACQUIRE, "agent");
            asm volatile("s_waitcnt vmcnt(0)" ::: "memory");
        }
    }
    __syncthreads();
}

namespace pg8 {
constexpr int BM = 256, BK = 64, HALF = 128, HTB = HALF * BK * 2, STAGE_BYTES = 8 * HTB;
__host__ __device__ __forceinline__ int lds_byte(int r, int c) { const int st = (r >> 4) * 2 + (c >> 5), rr = r & 15, cc = c & 31, ob = rr * 64 + cc * 2; return st * 1024 + (ob ^ (((ob >> 9) & 1) << 5)); }
__host__ __device__ __forceinline__ void stage_rc(int b, int& R, int& C) { const int st = b / 1024, sb = b % 1024, swz = sb ^ (((sb >> 9) & 1) << 5); R = (st >> 1) * 16 + swz / 64; C = (st & 1) * 32 + (swz % 64) / 2; }
__host__ __device__ __forceinline__ int perm32(int rho) { const int n = rho >> 4, i = rho & 15; return 8 * (i >> 2) + 4 * n + (i & 3); }
__device__ __forceinline__ unsigned cvt_pk_bf16(float lo, float hi) { unsigned r; asm volatile("v_cvt_pk_bf16_f32 %0, %1, %2" : "=v"(r) : "v"(lo), "v"(hi)); return r; }

struct Unit {
    const char* bptr;
    int arow0;
    int nrows;
    int pm, pn, e, ui;
};

template <class Epi, class Sched>
__device__ __forceinline__ void gemm_phase(LAS unsigned char* lds, const char* Abase, const int K, const Sched& S, const Epi& E) {
    const int tid = opaque_tid(), wid = __builtin_amdgcn_readfirstlane(tid >> 6), lane = tid & 63, wr = wid >> 2, wc = wid & 3, fr = lane & 15, fq = lane >> 4;
    const int nt = K / BK;
    int R0, C0, R1, C1; stage_rc(tid * 16, R0, C0); stage_rc(tid * 16 + 8192, R1, C1);
    unsigned voffB[2];
    { const int Rb0 = Epi::PERM ? ((R0 & ~31) + perm32(R0 & 31)) : R0, Rb1 = Epi::PERM ? ((R1 & ~31) + perm32(R1 & 31)) : R1;
      voffB[0] = (unsigned)(Rb0 * K + C0) * 2u; voffB[1] = (unsigned)(Rb1 * K + C1) * 2u; }
    const unsigned cA0 = (unsigned)C0 * 2u, cA1 = (unsigned)C1 * 2u;
    const unsigned voffA0 = (unsigned)(R0 * K + C0) * 2u, voffA1 = (unsigned)(R1 * K + C1) * 2u;
    const unsigned kstep = (unsigned)(BK * 2);
    const unsigned hstep = (unsigned)(HALF * K * 2);
    const unsigned ldsw = (unsigned)wid * 1024u;
    const int aoff = lds_byte(wr * 64 + fr, fq * 8), boff = lds_byte(wc * 32 + fr, fq * 8);
#define PG8_SA(b, h) (((b) * 2 + (h)) * HTB)
#define PG8_SB(b, h) ((4 + (b) * 2 + (h)) * HTB)
#define PG8_STAGE_B(bufoff, gbase) do { \
        __builtin_amdgcn_global_load_lds((const unsigned*)((const char*)(gbase) + voffB[0]), (LAS unsigned*)(lds + (bufoff) + ldsw), 16, 0, 0); \
        __builtin_amdgcn_global_load_lds((const unsigned*)((const char*)(gbase) + voffB[1]), (LAS unsigned*)(lds + (bufoff) + ldsw + 8192), 16, 0, 0); } while (0)
#define PG8_STAGE_A(bufoff, gbase, pk) do { \
        const unsigned o0_ = Sched::GATHER ? (((pk) & 0xffffu) * (unsigned)K * 2u + cA0) : voffA0; \
        const unsigned o1_ = Sched::GATHER ? (((pk) >> 16) * (unsigned)K * 2u + cA1) : voffA1; \
        __builtin_amdgcn_global_load_lds((const unsigned*)((const char*)(gbase) + o0_), (LAS unsigned*)(lds + (bufoff) + ldsw), 16, 0, 0); \
        __builtin_amdgcn_global_load_lds((const unsigned*)((const char*)(gbase) + o1_), (LAS unsigned*)(lds + (bufoff) + ldsw + 8192), 16, 0, 0); } while (0)
#define PG8_LDA(dst, b, h) do { _Pragma("unroll") for (int m = 0; m < 4; ++m) _Pragma("unroll") for (int k = 0; k < 2; ++k) dst[m][k] = *(const LAS bf16x8*)(lds + PG8_SA(b, h) + aoff + m * 2048 + k * 1024); } while (0)
#define PG8_LDB(dst, b, h) do { _Pragma("unroll") for (int n = 0; n < 2; ++n) _Pragma("unroll") for (int k = 0; k < 2; ++k) dst[n][k] = *(const LAS bf16x8*)(lds + PG8_SB(b, h) + boff + n * 2048 + k * 1024); } while (0)
#define PG8_MMA(ai, bj, At, Bt) do { __builtin_amdgcn_s_setprio(1); _Pragma("unroll") for (int m = 0; m < 4; ++m) _Pragma("unroll") for (int n = 0; n < 2; ++n) _Pragma("unroll") for (int k = 0; k < 2; ++k) \
        acc[ai][bj][m][n] = __builtin_amdgcn_mfma_f32_16x16x32_bf16(Bt[n][k], At[m][k], acc[ai][bj][m][n], 0, 0, 0); __builtin_amdgcn_s_setprio(0); } while (0)
#define PG8_WAIT_V(n) asm volatile("s_waitcnt vmcnt(" #n ")" ::: "memory")
#define PG8_WAIT_L(n) asm volatile("s_waitcnt lgkmcnt(" #n ")" ::: "memory")
#define PG8_BAR __builtin_amdgcn_s_barrier()
#define PG8_SCHED __builtin_amdgcn_sched_barrier(0)
#define PG8_PACK(u, h) ((unsigned)S.arow((u), ((h) * 128 + R0) < (u).nrows ? ((h) * 128 + R0) : (u).nrows - 1) | ((unsigned)S.arow((u), ((h) * 128 + R1) < (u).nrows ? ((h) * 128 + R1) : (u).nrows - 1) << 16))
    Unit cur, nxt; int ui = 0;
    if (!S.next(0, cur)) return;
    f32x4 acc[2][2][4][2];
#pragma unroll
    for (int a = 0; a < 2; ++a)
#pragma unroll
        for (int b = 0; b < 2; ++b)
#pragma unroll
            for (int m = 0; m < 4; ++m)
#pragma unroll
                for (int n = 0; n < 2; ++n) acc[a][b][m][n] = (f32x4){0.f, 0.f, 0.f, 0.f};
    bf16x8 At[4][2], B0[2][2], B1[2][2];
    unsigned pC0 = 0u, pC1 = 0u, pN0 = 0u, pN1 = 0u;
    if (Sched::GATHER) { pC0 = PG8_PACK(cur, 0); pC1 = PG8_PACK(cur, 1); }
    const char* cB = cur.bptr;
    const char* cA = Sched::GATHER ? Abase : Abase + (size_t)cur.arow0 * K * 2;
    const unsigned hA = Sched::GATHER ? 0u : hstep;
    PG8_STAGE_B(PG8_SB(0, 0), cB); PG8_STAGE_B(PG8_SB(0, 1), cB + hstep); PG8_STAGE_A(PG8_SA(0, 0), cA, pC0); PG8_STAGE_A(PG8_SA(0, 1), cA + hA, pC1);
    if (wr == 1) PG8_BAR;
    PG8_WAIT_V(2); PG8_BAR;
    PG8_STAGE_B(PG8_SB(1, 0), cB + kstep); PG8_STAGE_A(PG8_SA(1, 0), cA + kstep, pC0); PG8_STAGE_B(PG8_SB(1, 1), cB + hstep + kstep);
    PG8_WAIT_V(6); PG8_BAR;
    for (;;) {
        const bool has_next = S.next(ui + 1, nxt);
        if (Sched::GATHER) { if (has_next) { pN0 = PG8_PACK(nxt, 0); pN1 = PG8_PACK(nxt, 1); } else { pN0 = pC0; pN1 = pC1; } }
        const char* nB = has_next ? nxt.bptr : cB;
        const char* nA = (Sched::GATHER || !has_next) ? cA : Abase + (size_t)nxt.arow0 * K * 2;
        for (int t = 0; t < nt; t += 2) {
            const bool last = (t == nt - 2);
            const char* a1 = cA + (unsigned)(t + 1) * kstep;
            const char* a2 = last ? nA : cA + (unsigned)(t + 2) * kstep; const char* b2 = last ? nB : cB + (unsigned)(t + 2) * kstep;
            const char* a3 = a2 + kstep; const char* b3 = b2 + kstep;
            const unsigned s0 = last ? pN0 : pC0, s1 = last ? pN1 : pC1;
            PG8_LDB(B0, 0, 0); PG8_LDB(B1, 0, 1); PG8_SCHED; PG8_LDA(At, 0, 0); PG8_STAGE_A(PG8_SA(1, 1), a1 + hA, pC1);
            PG8_WAIT_V(8); PG8_WAIT_L(0); PG8_BAR; PG8_MMA(0, 0, At, B0); PG8_MMA(0, 1, At, B1); PG8_BAR; PG8_SCHED;
            PG8_LDA(At, 0, 1); PG8_STAGE_B(PG8_SB(0, 0), b2); PG8_STAGE_B(PG8_SB(0, 1), b2 + hstep); PG8_STAGE_A(PG8_SA(0, 0), a2, s0);
            PG8_WAIT_V(8); PG8_WAIT_L(0); PG8_BAR; PG8_MMA(1, 0, At, B0); PG8_MMA(1, 1, At, B1); PG8_BAR; PG8_SCHED;
            PG8_LDB(B0, 1, 0); PG8_LDB(B1, 1, 1); PG8_SCHED; PG8_LDA(At, 1, 0); PG8_STAGE_A(PG8_SA(0, 1), a2 + hA, s1);
            PG8_WAIT_V(8); PG8_WAIT_L(0); PG8_BAR; PG8_MMA(0, 0, At, B0); PG8_MMA(0, 1, At, B1); PG8_BAR; PG8_SCHED;
            PG8_LDA(At, 1, 1); PG8_STAGE_B(PG8_SB(1, 0), b3); PG8_STAGE_B(PG8_SB(1, 1), b3 + hstep); PG8_STAGE_A(PG8_SA(1, 0), a3, s0);
            PG8_WAIT_V(8); PG8_WAIT_L(0); PG8_BAR; PG8_MMA(1, 0, At, B0); PG8_MMA(1, 1, At, B1); PG8_BAR; PG8_SCHED;
        }
        if (wr == 0) PG8_BAR;
        E(acc, cur, wr, wc, fr, fq);
        if (!has_next) break;
#pragma unroll
        for (int a = 0; a < 2; ++a)
#pragma unroll
            for (int b = 0; b < 2; ++b)
#pragma unroll
                for (int m = 0; m < 4; ++m)
#pragma unroll
                    for (int n = 0; n < 2; ++n) acc[a][b][m][n] = (f32x4){0.f, 0.f, 0.f, 0.f};
        cur = nxt; cB = nB; cA = nA; ++ui;
        pC0 = pN0; pC1 = pN1;
        if (wr == 1) PG8_BAR;
    }
    PG8_WAIT_V(0);
    PG8_BAR;
#undef PG8_SA
#undef PG8_SB
#undef PG8_STAGE_A
#undef PG8_STAGE_B
#undef PG8_LDA
#undef PG8_LDB
#undef PG8_MMA
#undef PG8_WAIT_V
#undef PG8_WAIT_L
#undef PG8_BAR
#undef PG8_SCHED
#undef PG8_PACK
}

struct DenseOrder {
    static constexpr bool GATHER = false;
    int nM, nN, nwg, G, c; const char* Bt; int K;
    __device__ void init(int M, int N, int K_, const bf16_t* Bt_, int G_, int c_) { nM = M / BM; nN = N / BM; nwg = nM * nN; G = G_; c = c_; Bt = (const char*)Bt_; K = K_; }
    __device__ __forceinline__ bool next(int i, Unit& u) const {
        const long L = (long)i * G + c; if (L >= nwg) return false;
        int wgid = (int)L; { const int q = nwg / 8, r = nwg % 8, xcd = wgid % 8, off = wgid / 8; wgid = (xcd < r ? xcd * (q + 1) : r * (q + 1) + (xcd - r) * q) + off; }
        const int nig = 8 * nN, gid = wgid / nig, fm = gid * 8, gsz = (nM - fm) < 8 ? (nM - fm) : 8;
        u.pm = fm + ((wgid % nig) % gsz); u.pn = (wgid % nig) / gsz;
        u.arow0 = u.pm * BM; u.nrows = BM; u.e = 0; u.ui = i;
        u.bptr = Bt + (size_t)u.pn * BM * K * 2;
        return true;
    }
    __device__ __forceinline__ int arow(const Unit& u, int r) const { return u.arow0 + r; }
};
}

struct EpiH {
    static constexpr bool PERM = true;
    bf16_t* H;
    __device__ __forceinline__ void operator()(const f32x4 (&acc)[2][2][4][2], const pg8::Unit& u, int wr, int wc, int fr, int fq) const {
        const int row0 = u.arow0 + wr * 64 + fr, col0 = u.pn * 256 + wc * 32 + 8 * fq;
#pragma unroll
        for (int ai = 0; ai < 2; ++ai)
#pragma unroll
            for (int m = 0; m < 4; ++m) {
                bf16_t* rowp = H + (size_t)(row0 + ai * 128 + m * 16) * HLD + col0;
#pragma unroll
                for (int bj = 0; bj < 2; ++bj) {
                    const f32x4 v0 = acc[ai][bj][m][0], v1 = acc[ai][bj][m][1];
                    u32x4 w; w.x = pg8::cvt_pk_bf16(v0[0], v0[1]); w.y = pg8::cvt_pk_bf16(v0[2], v0[3]); w.z = pg8::cvt_pk_bf16(v1[0], v1[1]); w.w = pg8::cvt_pk_bf16(v1[2], v1[3]);
                    *(u32x4*)(rowp + bj * 128) = w;
                }
            }
    }
};
struct EpiRes {
    static constexpr bool PERM = false;
    const float* xin; float* out;
    __device__ __forceinline__ void operator()(const f32x4 (&acc)[2][2][4][2], const pg8::Unit& u, int wr, int wc, int fr, int fq) const {
        const int row0 = u.arow0 + wr * 64 + fr, col0 = u.pn * 256 + wc * 32 + 4 * fq;
#pragma unroll
        for (int ai = 0; ai < 2; ++ai)
#pragma unroll
            for (int m = 0; m < 4; ++m) {
                const size_t off = (size_t)(row0 + ai * 128 + m * 16) * DM + col0;
#pragma unroll
                for (int bj = 0; bj < 2; ++bj)
#pragma unroll
                    for (int n = 0; n < 2; ++n) {
                        const f32x4 xv = *(const f32x4*)(xin + off + bj * 128 + n * 16);
                        *(f32x4*)(out + off + bj * 128 + n * 16) = xv * ALPHA + acc[ai][bj][m][n];
                    }
            }
    }
};

template <class RM>
__device__ __forceinline__ void transpose_item(const float* W, int K, int N, bf16_t* WT, RM rowmap, float* scr, int kb, int nb, int lane) {
    const int k0 = 64 * kb, n0 = 32 * nb;
    const int nn = n0 + (lane & 31);
#pragma unroll 8
    for (int i = 0; i < 32; ++i) {
        const int kk = 2 * i + (lane >> 5);
        scr[kk * 33 + (lane & 31)] = nn < N ? W[(size_t)(k0 + kk) * N + nn] : 0.f;
    }
    wave_sync();
    const int c = lane & 7;
#pragma unroll
    for (int j = 0; j < 4; ++j) {
        const int n = (lane >> 3) + 8 * j;
        const float* s = scr + (8 * c) * 33 + n;
        u32x4 o; o.x = pk2(s[0 * 33], s[1 * 33]); o.y = pk2(s[2 * 33], s[3 * 33]); o.z = pk2(s[4 * 33], s[5 * 33]); o.w = pk2(s[6 * 33], s[7 * 33]);
        const int dr = (n0 + n < N) ? rowmap(n0 + n) : -1;
        if (dr >= 0) *(u32x4*)(WT + (size_t)dr * K + k0 + 8 * c) = o;
    }
    wave_sync();
}

__device__ void phase_prologue(KA ka, float* smem) {
    PHASE_IDS
    const int lane = TID & 63, w = TID >> 6;
    float* scr = smem + w * 4096;
    const int gw = BID * NW + w, NGW = gridDim.x * NW;
    constexpr int I_IN = 16 * 89, I_OUT = 16 * 32, I_GU = 16 * 16, I_DN = 8 * 32;
    constexpr int I_LAYER = I_IN + I_OUT + 32 * I_GU + 16 * I_DN;
    for (int it = gw; it < 2 * I_LAYER; it += NGW) {
        const int layer = it / I_LAYER; int r = it % I_LAYER;
        bf16_t* WT = PF(WT) + (size_t)layer * WT_LAYER;
        if (r < I_IN) {
            transpose_item(PF(w_in) + (size_t)layer * DM * IC_SRC, DM, IC_SRC, WT + WT_IN,
                           [](int n) { return n < 1792 ? n : (n < 1816 ? 2816 + (n - 1792) : n - 24); }, scr, r / 89, r % 89, lane);
            continue;
        }
        r -= I_IN;
        if (r < I_OUT) {
            transpose_item(PF(w_out) + (size_t)layer * DM * DM, DM, DM, WT + WT_OUT, [](int n) { return n; }, scr, r / 32, r % 32, lane);
            continue;
        }
        r -= I_OUT;
        if (r < 32 * I_GU) {
            const int mat = r / I_GU, rr = r % I_GU, e = mat >> 1, isup = mat & 1;
            const float* W = (isup ? PF(w_up) : PF(w_gate)) + ((size_t)layer * 16 + e) * DM * 512;
            transpose_item(W, DM, 512, WT + WT_UP + (size_t)e * 1024 * 1024,
                           [isup](int n) { return (n >> 7) * 256 + isup * 128 + (n & 127); }, scr, rr / 16, rr % 16, lane);
            continue;
        }
        r -= 32 * I_GU;
        {
            const int e = r / I_DN, rr = r % I_DN;
            transpose_item(PF(w_down) + ((size_t)layer * 16 + e) * 512 * DM, 512, DM, WT + WT_DN + (size_t)e * 1024 * 512,
                           [](int n) { return n; }, scr, rr / 32, rr % 32, lane);
        }
    }
    for (int i = BID * NTHR + TID; i < 2 * 232 * 128; i += gridDim.x * NTHR) {
        const int layer = i / (232 * 128), q = i % (232 * 128);
        u32x4 z; z.x = 0u; z.y = 0u; z.z = 0u; z.w = 0u;
        *(u32x4*)(PF(WT) + (size_t)layer * WT_LAYER + WT_IN + (size_t)2840 * 1024 + (size_t)q * 8) = z;
    }
    for (int row = gw; row < NTOK; row += NGW) {
        const f32x4* xr = (const f32x4*)(PF(x) + (size_t)row * DM) + lane;
        u32x2* o = (u32x2*)(PF(XB) + (size_t)row * DM) + lane;
#pragma unroll
        for (int j = 0; j < 4; ++j) {
            const f32x4 v = xr[64 * j];
            u32x2 ww; ww.x = pk2(v[0], v[1]); ww.y = pk2(v[2], v[3]);
            o[64 * j] = ww;
        }
    }
}

template <class AF, class BF, class EF>
__device__ __forceinline__ void gemm128(int tid, int m0, int n0, int M, int N, int K, AF af, BF bf, EF ef, float* smem) {
    float* As = smem;
    float* Bs = smem + 16 * 132;
    const bool active = tid < 256;
    const int tx = tid & 15, ty = (tid >> 4) & 15;
    float acc[8][8];
#pragma unroll
    for (int i = 0; i < 8; i++)
#pragma unroll
        for (int j = 0; j < 8; j++) acc[i][j] = 0.f;
#pragma unroll 1
    for (int k0 = 0; k0 < K; k0 += 16) {
        if (active) {
#pragma unroll
            for (int i = 0; i < 8; i++) {
                int e = tid + i * 256;
                int r = e >> 4, kk = e & 15;
                float v = 0.f;
                if (m0 + r < M) v = af(m0 + r, k0 + kk);
                As[kk * 132 + r] = v;
            }
#pragma unroll
            for (int i = 0; i < 8; i++) {
                int e = tid + i * 256;
                int kk = e >> 7, c = e & 127;
                float v = 0.f;
                if (n0 + c < N) v = bf(k0 + kk, n0 + c);
                Bs[kk * 132 + c] = v;
            }
        }
        __syncthreads();
        if (active) {
#pragma unroll 2
            for (int kk = 0; kk < 16; kk++) {
                asm volatile("" ::: "memory");
                float4 a0 = *(const float4*)&As[kk * 132 + ty * 8];
                float4 a1 = *(const float4*)&As[kk * 132 + ty * 8 + 4];
                float4 b0 = *(const float4*)&Bs[kk * 132 + tx * 8];
                float4 b1 = *(const float4*)&Bs[kk * 132 + tx * 8 + 4];
                float a[8] = {a0.x, a0.y, a0.z, a0.w, a1.x, a1.y, a1.z, a1.w};
                float b[8] = {b0.x, b0.y, b0.z, b0.w, b1.x, b1.y, b1.z, b1.w};
#pragma unroll
                for (int i = 0; i < 8; i++)
#pragma unroll
                    for (int j = 0; j < 8; j++) acc[i][j] = fmaf(a[i], b[j], acc[i][j]);
            }
        }
        __syncthreads();
    }
    if (active) {
#pragma unroll
        for (int i = 0; i < 8; i++)
#pragma unroll
            for (int j = 0; j < 8; j++) {
                int m = m0 + ty * 8 + i, n = n0 + tx * 8 + j;
                if (m < M && n < N) ef(m, n, acc[i][j]);
            }
    }
}

__device__ __forceinline__ void phase_inproj(KA ka, int layer, LAS unsigned char* lds) {
    pg8::DenseOrder S; S.init(NTOK, HLD, DM, PF(WT) + (size_t)layer * WT_LAYER + WT_IN, gridDim.x, opaque_bid());
    EpiH E{PF(H)};
    pg8::gemm_phase<EpiH, pg8::DenseOrder>(lds, (const char*)PF(XB), DM, S, E);
}
__device__ __forceinline__ void phase_outproj(KA ka, int layer, const float* xin, float* x1, LAS unsigned char* lds) {
    pg8::DenseOrder S; S.init(NTOK, DM, DM, PF(WT) + (size_t)layer * WT_LAYER + WT_OUT, gridDim.x, opaque_bid());
    EpiRes E{xin, x1};
    pg8::gemm_phase<EpiRes, pg8::DenseOrder>(lds, (const char*)PF(Y), DM, S, E);
}

__device__ void phase_gmlp(KA ka, int layer, float* smem) {
    PHASE_IDS
    float* V = smem;
    const int tid = TID, lane = tid & 63, w = tid >> 6;
    const float* gain = PF(gm_v_gain) + layer * 256;
    const float* bias = PF(gm_v_bias) + layer * 256;
    const float* ws = PF(gm_w_s) + (size_t)layer * 4 * 128 * 128;
    const float* bs = PF(gm_b_s) + layer * 4 * 128;
    const bf16_t* H = PF(H);
    for (int item = BID; item < 512; item += gridDim.x) {
        int g = item & 3, c = (item >> 2) & 63, b = item >> 8;
        size_t tok0 = (size_t)b * T_ + (size_t)c * 128;
        __syncthreads();
        for (int i = 0; i < 16; i++) {
            int s = w * 16 + i;
            float x = bf2f(H[(tok0 + s) * HLD + C_GV + g * 64 + lane]);
            float ge = gelu_t(x);
            float mu = wave_sum(ge) * (1.f / 64.f);
            float dl = ge - mu;
            float var = wave_sum(dl * dl) * (1.f / 64.f);
            V[s * 64 + lane] = dl * rsqrtf(var + 1e-5f) * gain[g * 64 + lane] + bias[g * 64 + lane];
        }
        __syncthreads();
        for (int i = 0; i < 16; i++) {
            int t = w + 8 * i;
            const float* wr = ws + ((size_t)g * 128 + t) * 128;
            float acc = 0.f;
            for (int s = 0; s <= t; s++) acc = fmaf(wr[s], V[s * 64 + lane], acc);
            acc += bs[g * 128 + t];
            float u = gelu_t(bf2f(H[(tok0 + t) * HLD + C_GU + g * 64 + lane]));
            PF(Y)[(tok0 + t) * DM + g * 64 + lane] = f2bf(u * acc);
        }
    }
}

__device__ void phase_compress(KA ka, int layer, float* smem) {
    PHASE_IDS
    const bf16_t* H = PF(H);
    for (int item = BID; item < 32; item += gridDim.x) {
        int which = item >> 4, mt = item & 15;
        const float* pos = PF(cmp_pos) + ((size_t)layer * 2 + which) * 32 * 64;
        const float* w1 = PF(cmp_w1) + ((size_t)layer * 2 + which) * 2048 * 128;
        const float* w2 = PF(cmp_w2) + ((size_t)layer * 2 + which) * 128 * 64;
        float* G = PF(gbuf) + (size_t)which * 2044 * 128;
        bf16_t* kcb = PF(kcb); bf16_t* vcT = PF(vcT);
        const int colbase = (which == 0 ? C_KC : C_VC);
        gemm128(TID, mt * 128, 0, 2044, 128, 2048,
                [&](int r, int k) {
                    int n = r % NCMP, bh = r / NCMP;
                    int hk = bh & 1, b = bh >> 1;
                    int l = k >> 6, d = k & 63;
                    size_t tok = (size_t)b * T_ + n * 16 + l;
                    return bf2f(H[tok * HLD + colbase + hk * 64 + d]) + pos[l * 64 + d];
                },
                [&](int k, int n) { return w1[(size_t)k * 128 + n]; },
                [&](int r, int n, float v) { G[(size_t)r * 128 + n] = gelu_t(v); }, smem);
        __threadfence_block();
        __syncthreads();
        gemm128(TID, mt * 128, 0, 2044, 64, 128,
                [&](int r, int k) { return G[(size_t)r * 128 + k]; },
                [&](int k, int n) { return w2[(size_t)k * 64 + n]; },
                [&](int r, int n, float v) {
                    const int bh = r / NCMP, nn = r % NCMP;
                    if (which == 0) kcb[((size_t)bh * 512 + nn) * 64 + n] = f2bf(v); else vcT[((size_t)bh * 64 + n) * 512 + nn] = f2bf(v);
                }, smem);
    }
}

__device__ void phase_hgrn(KA ka, int layer, float* smem) {
    PHASE_IDS
    float* Q = smem;
    float* F = smem + 2048;
    float* K = smem + 4096;
    float* I = smem + 6144;
    const int tid = TID, lane = tid & 63, w = tid >> 6;
    const int v = (w & 3) * 16 + (lane & 15), dq = lane >> 4;
    const bf16_t* H = PF(H);
    for (int item = BID; item < 8; item += gridDim.x) {
        int h = item & 3, b = item >> 2;
        float S[16];
#pragma unroll
        for (int j = 0; j < 16; j++) S[j] = 0.f;
        for (int t0 = 0; t0 < T_; t0 += 32) {
            __syncthreads();
            for (int i = 0; i < 4; i++) {
                int e = tid + i * NTHR;
                int ts = e >> 6, d = e & 63;
                size_t tok = (size_t)b * T_ + t0 + ts;
                float lb = 0.f;
                if (layer == 1) {
                    float h0 = PF(hg_lower)[h * 64 + d], h1 = PF(hg_lower)[256 + h * 64 + d];
                    float mx = fmaxf(h0, h1);
                    float e0 = expf(h0 - mx), e1 = expf(h1 - mx);
                    lb = e1 / (e0 + e1);
                }
                float fl = bf2f(H[tok * HLD + C_HF + h * 64 + d]);
                float sg = 1.f / (1.f + expf(-fl));
                float sgn = 1.f / (1.f + expf(fl));
                F[e] = lb + (1.f - lb) * sg;
                K[e] = (1.f - lb) * sgn;
                Q[e] = bf2f(H[tok * HLD + C_HQ + h * 64 + d]);
                I[e] = bf2f(H[tok * HLD + C_HI + h * 64 + d]);
            }
            __syncthreads();
            if (w < 4) {
                for (int ts = 0; ts < 32; ts++) {
                    float iv = I[ts * 64 + v];
                    float part = 0.f;
#pragma unroll
                    for (int j4 = 0; j4 < 4; j4++) {
                        float4 f4 = *(const float4*)&F[ts * 64 + dq * 16 + j4 * 4];
                        float4 k4 = *(const float4*)&K[ts * 64 + dq * 16 + j4 * 4];
                        float4 q4 = *(const float4*)&Q[ts * 64 + dq * 16 + j4 * 4];
                        S[j4 * 4 + 0] = fmaf(f4.x, S[j4 * 4 + 0], k4.x * iv); part = fmaf(q4.x, S[j4 * 4 + 0], part);
                        S[j4 * 4 + 1] = fmaf(f4.y, S[j4 * 4 + 1], k4.y * iv); part = fmaf(q4.y, S[j4 * 4 + 1], part);
                        S[j4 * 4 + 2] = fmaf(f4.z, S[j4 * 4 + 2], k4.z * iv); part = fmaf(q4.z, S[j4 * 4 + 2], part);
                        S[j4 * 4 + 3] = fmaf(f4.w, S[j4 * 4 + 3], k4.w * iv); part = fmaf(q4.w, S[j4 * 4 + 3], part);
                    }
                    part += __shfl_xor(part, 16);
                    part += __shfl_xor(part, 32);
                    if (dq == 0) PF(Y)[((size_t)b * T_ + t0 + ts) * DM + 768 + h * 64 + v] = f2bf(part);
                }
            }
        }
    }
}
__device__ void phase_headnorm(KA ka, int layer) {
    PHASE_IDS
    const int lane = TID & 63, w = TID >> 6;
    const float* og = PF(out_gain) + layer * 1024;
    for (int row = BID * NW + w; row < NTOK; row += gridDim.x * NW) {
#pragma unroll
        for (int hd = 0; hd < 16; hd++) {
            float v = bf2f(PF(Y)[(size_t)row * DM + hd * 64 + lane]);
            float ms = wave_sum(v * v) * (1.f / 64.f);
            float y = v * rsqrtf(ms + 1e-6f) * og[hd * 64 + lane];
            if (hd >= 12) {
                float hg = bf2f(PF(H)[(size_t)row * HLD + C_HG + (hd - 12) * 64 + lane]);
                y *= hg * sigmoidf_(hg);
            }
            PF(Y)[(size_t)row * DM + hd * 64 + lane] = f2bf(y);
        }
    }
}

__device__ void phase_ln1_route(KA ka, int layer, float* x1) {
    PHASE_IDS
    bf16_t* xb = PF(XB);
    const int lane = TID & 63, w = TID >> 6;
    const float* g = PF(ln1_g) + layer * 1024;
    const float* bb = PF(ln1_b) + layer * 1024;
    const float* wg = PF(rg_w) + (size_t)layer * 1024 * 4;
    const float* we = PF(re_w) + (size_t)layer * 1024 * 16;
    const float* bg = PF(rg_b) + layer * 4;
    const float* be = PF(re_b) + layer * 16;
    int* cnt = (int*)(PF(ctl) + CW_CNT) + layer * 16;
    for (int row = BID * NW + w; row < NTOK; row += gridDim.x * NW) {
        float v[16];
        float s = 0.f;
#pragma unroll
        for (int i = 0; i < 16; i++) { v[i] = x1[(size_t)row * DM + i * 64 + lane]; s += v[i]; }
        float mu = wave_sum(s) * (1.f / 1024.f);
        float q = 0.f;
#pragma unroll
        for (int i = 0; i < 16; i++) { float d = v[i] - mu; q += d * d; }
        float rstd = rsqrtf(wave_sum(q) * (1.f / 1024.f) + 1e-5f);
        float lg[4] = {0.f, 0.f, 0.f, 0.f};
        float le[16];
#pragma unroll
        for (int e = 0; e < 16; e++) le[e] = 0.f;
#pragma unroll
        for (int i = 0; i < 16; i++) {
            int c = i * 64 + lane;
            float o = (v[i] - mu) * rstd * g[c] + bb[c];
            x1[(size_t)row * DM + c] = o;
            xb[(size_t)row * DM + c] = f2bf(o);
            float4 w4 = *(const float4*)&wg[c * 4];
            lg[0] = fmaf(o, w4.x, lg[0]); lg[1] = fmaf(o, w4.y, lg[1]);
            lg[2] = fmaf(o, w4.z, lg[2]); lg[3] = fmaf(o, w4.w, lg[3]);
#pragma unroll
            for (int e4 = 0; e4 < 4; e4++) {
                float4 x4 = *(const float4*)&we[c * 16 + e4 * 4];
                le[e4 * 4 + 0] = fmaf(o, x4.x, le[e4 * 4 + 0]);
                le[e4 * 4 + 1] = fmaf(o, x4.y, le[e4 * 4 + 1]);
                le[e4 * 4 + 2] = fmaf(o, x4.z, le[e4 * 4 + 2]);
                le[e4 * 4 + 3] = fmaf(o, x4.w, le[e4 * 4 + 3]);
            }
        }
#pragma unroll
        for (int c = 0; c < 4; c++) lg[c] = wave_sum(lg[c]) + bg[c];
#pragma unroll
        for (int e = 0; e < 16; e++) le[e] = wave_sum(le[e]) + be[e];
        float gm = fmaxf(fmaxf(lg[0], lg[1]), fmaxf(lg[2], lg[3]));
        float ge[4], gs = 0.f;
#pragma unroll
        for (int c = 0; c < 4; c++) { ge[c] = __expf(lg[c] - gm); gs += ge[c]; }
        int gi = 0; float gbest = ge[0];
#pragma unroll
        for (int c = 1; c < 4; c++) if (ge[c] > gbest) { gbest = ge[c]; gi = c; }
        float gval = gbest / gs;
        float ls[4];
#pragma unroll
        for (int e = 0; e < 4; e++) ls[e] = gi == 0 ? le[e] : gi == 1 ? le[4 + e] : gi == 2 ? le[8 + e] : le[12 + e];
        float em = fmaxf(fmaxf(ls[0], ls[1]), fmaxf(ls[2], ls[3]));
        float pe[4];
#pragma unroll
        for (int e = 0; e < 4; e++) pe[e] = __expf(ls[e] - em);
        int i1 = 0; float b1 = pe[0];
#pragma unroll
        for (int e = 1; e < 4; e++) if (pe[e] > b1) { b1 = pe[e]; i1 = e; }
        int i2 = -1; float b2 = -1.f;
#pragma unroll
        for (int e = 0; e < 4; e++) if (e != i1 && pe[e] > b2) { b2 = pe[e]; i2 = e; }
        float w1 = gval * b1 / (b1 + b2), w2 = gval * b2 / (b1 + b2);
        if (lane == 0) {
            int e1 = gi * 4 + i1, e2 = gi * 4 + i2;
            int p1 = atomicAdd(&cnt[e1], 1);
            PF(list_tok)[e1 * NTOK + p1] = row; PF(list_w)[e1 * NTOK + p1] = w1;
            int p2 = atomicAdd(&cnt[e2], 1);
            PF(list_tok)[e2 * NTOK + p2] = row; PF(list_w)[e2 * NTOK + p2] = w2;
            PF(tok_slot)[row * 2 + 0] = e1 * NTOK + p1; PF(tok_slot)[row * 2 + 1] = e2 * NTOK + p2;
        }
    }
}


template <bool GATHER_>
struct MoeOrder {
    static constexpr bool GATHER = GATHER_;
    const LAS int* tab; const LAS int* rowtab;
    const char* Bt; unsigned estride; int K, G, c;
    __device__ __forceinline__ bool next(int i, pg8::Unit& u) const {
        const int nwg = __builtin_amdgcn_readfirstlane(tab[48]) * 4;
        const int L = i * G + c; if (L >= nwg) return false;
        int wgid = L; { const int q = nwg / 8, r = nwg % 8, xcd = wgid % 8, off = wgid / 8; wgid = (xcd < r ? xcd * (q + 1) : r * (q + 1) + (xcd - r) * q) + off; }
        const int mg = wgid >> 2, nt = wgid & 3;
        int e = 0;
#pragma unroll
        for (int k = 1; k < 16; ++k) e = (__builtin_amdgcn_readfirstlane(tab[32 + k]) <= mg) ? k : e;
        const int mt = mg - __builtin_amdgcn_readfirstlane(tab[32 + e]);
        const int rem = __builtin_amdgcn_readfirstlane(tab[e]) - mt * 256;
        u.e = e; u.pm = mt; u.pn = nt; u.ui = i; u.nrows = rem < 256 ? rem : 256; u.arow0 = __builtin_amdgcn_readfirstlane(tab[16 + e]) + mt * 256;
        u.bptr = Bt + (size_t)e * estride + (size_t)nt * 256 * K * 2;
        return true;
    }
    __device__ __forceinline__ int arow(const pg8::Unit& u, int r) const { return GATHER_ ? rowtab[u.ui * 256 + r] : u.arow0 + r; }
};
__device__ __forceinline__ void moe_tables(KA ka, int layer, LAS unsigned char* lds, bool want_rows, int G, int c) {
    LAS int* tab = (LAS int*)(lds + LDS_MISC + 256);
    LAS int* rowtab = (LAS int*)(lds + LDS_MISC + 1024);
    const int tid = opaque_tid();
    const int* cnt = (const int*)(PF(ctl) + CW_CNT) + layer * 16;
    if (tid < 16) tab[tid] = __hip_atomic_load(&cnt[tid], __ATOMIC_RELAXED, __HIP_MEMORY_SCOPE_AGENT);
    __syncthreads();
    if (tid == 0) {
        int b = 0, m = 0;
        for (int e = 0; e < 16; ++e) { tab[16 + e] = b; tab[32 + e] = m; b += tab[e]; m += (tab[e] + 255) >> 8; }
        tab[48] = m;
    }
    __syncthreads();
    if (want_rows) {
        MoeOrder<true> S{tab, rowtab, nullptr, 0u, 1024, G, c};
        const int* lt = PF(list_tok);
        for (int i = 0; i < 4; ++i) {
            pg8::Unit u;
            if (!S.next(i, u)) break;
            if (tid < 256) { const int r = tid < u.nrows ? tid : u.nrows - 1; rowtab[i * 256 + tid] = lt[u.e * NTOK + u.pm * 256 + r]; }
        }
        asm volatile("s_waitcnt vmcnt(0) lgkmcnt(0)" ::: "memory");
        __syncthreads();
    }
}
struct EpiUp {
    static constexpr bool PERM = true;
    bf16_t* hidden;
    __device__ __forceinline__ void operator()(const f32x4 (&acc)[2][2][4][2], const pg8::Unit& u, int wr, int wc, int fr, int fq) const {
#pragma unroll
        for (int ai = 0; ai < 2; ++ai)
#pragma unroll
            for (int m = 0; m < 4; ++m) {
                const int r = ai * 128 + wr * 64 + m * 16 + fr;
                if (r < u.nrows) {
                    bf16_t* rowp = hidden + (size_t)(u.arow0 + r) * 512 + u.pn * 128 + wc * 32 + 8 * fq;
                    float h[8];
#pragma unroll
                    for (int n = 0; n < 2; ++n)
#pragma unroll
                        for (int j = 0; j < 4; ++j) { const float g = acc[ai][0][m][n][j], uu = acc[ai][1][m][n][j]; h[n * 4 + j] = g * sigmoidf_(g) * uu; }
                    u32x4 w; w.x = pg8::cvt_pk_bf16(h[0], h[1]); w.y = pg8::cvt_pk_bf16(h[2], h[3]); w.z = pg8::cvt_pk_bf16(h[4], h[5]); w.w = pg8::cvt_pk_bf16(h[6], h[7]);
                    *(u32x4*)rowp = w;
                }
            }
    }
};
struct EpiDown {
    static constexpr bool PERM = true;
    bf16_t* Y2; const float* lw;
    __device__ __forceinline__ void operator()(const f32x4 (&acc)[2][2][4][2], const pg8::Unit& u, int wr, int wc, int fr, int fq) const {
#pragma unroll
        for (int ai = 0; ai < 2; ++ai)
#pragma unroll
            for (int m = 0; m < 4; ++m) {
                const int r = ai * 128 + wr * 64 + m * 16 + fr;
                if (r < u.nrows) {
                    const float wgt = lw[u.e * NTOK + u.pm * 256 + r];
                    bf16_t* rowp = Y2 + (size_t)(u.arow0 + r) * DM + u.pn * 256 + wc * 32 + 8 * fq;
#pragma unroll
                    for (int bj = 0; bj < 2; ++bj) {
                        const f32x4 v0 = acc[ai][bj][m][0] * wgt, v1 = acc[ai][bj][m][1] * wgt;
                        u32x4 w; w.x = pg8::cvt_pk_bf16(v0[0], v0[1]); w.y = pg8::cvt_pk_bf16(v0[2], v0[3]); w.z = pg8::cvt_pk_bf16(v1[0], v1[1]); w.w = pg8::cvt_pk_bf16(v1[2], v1[3]);
                        *(u32x4*)(rowp + bj * 128) = w;
                    }
                }
            }
    }
};
__device__ __forceinline__ void phase_moe_up(KA ka, int layer, LAS unsigned char* lds) {
    moe_tables(ka, layer, lds, true, gridDim.x, opaque_bid());
    MoeOrder<true> S{(const LAS int*)(lds + LDS_MISC + 256), (const LAS int*)(lds + LDS_MISC + 1024),
                     (const char*)(PF(WT) + (size_t)layer * WT_LAYER + WT_UP), (unsigned)(1024u * 1024u * 2u), 1024, (int)gridDim.x, opaque_bid()};
    EpiUp E{PF(Y)};
    pg8::gemm_phase<EpiUp, MoeOrder<true>>(lds, (const char*)PF(XB), 1024, S, E);
}
__device__ __forceinline__ void phase_moe_down(KA ka, int layer, LAS unsigned char* lds) {
    moe_tables(ka, layer, lds, false, gridDim.x, opaque_bid());
    MoeOrder<false> S{(const LAS int*)(lds + LDS_MISC + 256), (const LAS int*)(lds + LDS_MISC + 1024),
                      (const char*)(PF(WT) + (size_t)layer * WT_LAYER + WT_DN), (unsigned)(1024u * 512u * 2u), 512, (int)gridDim.x, opaque_bid()};
    EpiDown E{PF(H), PF(list_w)};
    pg8::gemm_phase<EpiDown, MoeOrder<false>>(lds, (const char*)PF(Y), 512, S, E);
}

__device__ void phase_ln2(KA ka, int layer, const float* x1, float* xo) {
    PHASE_IDS
    bf16_t* xb = PF(XB);
    const bf16_t* Y2 = PF(H);
    const int lane = TID & 63, w = TID >> 6;
    const float* g = PF(ln2_g) + layer * 1024;
    const float* bb = PF(ln2_b) + layer * 1024;
    const int* cnt = (const int*)(PF(ctl) + CW_CNT) + layer * 16;
    int mybase = 0;
    {
        int cv = lane < 16 ? __hip_atomic_load(&cnt[lane & 15], __ATOMIC_RELAXED, __HIP_MEMORY_SCOPE_AGENT) : 0;
        int incl = cv;
#pragma unroll
        for (int o = 1; o < 16; o <<= 1) { int t = __shfl_up(incl, o); if ((lane & 15) >= o) incl += t; }
        mybase = incl - cv;
    }
    for (int row = BID * NW + w; row < NTOK; row += gridDim.x * NW) {
        const int ts1 = PF(tok_slot)[row * 2 + 0], ts2 = PF(tok_slot)[row * 2 + 1];
        const int s1 = __shfl(mybase, ts1 >> 14) + (ts1 & (NTOK - 1)), s2 = __shfl(mybase, ts2 >> 14) + (ts2 & (NTOK - 1));
        float v[16];
        float s = 0.f;
#pragma unroll
        for (int i = 0; i < 16; i++) {
            const int c = i * 64 + lane;
            v[i] = ALPHA * x1[(size_t)row * DM + c] + bf2f(Y2[(size_t)s1 * DM + c]) + bf2f(Y2[(size_t)s2 * DM + c]);
            s += v[i];
        }
        float mu = wave_sum(s) * (1.f / 1024.f);
        float q = 0.f;
#pragma unroll
        for (int i = 0; i < 16; i++) { float d = v[i] - mu; q += d * d; }
        float rstd = rsqrtf(wave_sum(q) * (1.f / 1024.f) + 1e-5f);
#pragma unroll
        for (int i = 0; i < 16; i++) {
            int c = i * 64 + lane;
            const float o = (v[i] - mu) * rstd * g[c] + bb[c];
            xo[(size_t)row * DM + c] = o;
            xb[(size_t)row * DM + c] = f2bf(o);
        }
    }
}

#define MFMA16(a, b, c) __builtin_amdgcn_mfma_f32_16x16x32_bf16((a), (b), (c), 0, 0, 0)
constexpr int NSA_KT = 0, NSA_VT = 16384, NSA_IMP = 32768, NSA_FIN = 65536, NSA_SEL = LDS_MISC + 8192;

__device__ __forceinline__ int tile_off(int r, int c) { return r * 128 + ((c ^ ((r >> 1) & 7)) << 4); }

struct SelMask { unsigned a, b, c, d; };
__device__ __forceinline__ unsigned selbit(unsigned a, unsigned b, unsigned c, unsigned d, int j) {
    const int k = j >> 5;
    const unsigned lo = (k & 1) ? b : a, hi = (k & 1) ? d : c;
    const unsigned r = (k & 2) ? hi : lo;
    return (r >> (j & 31)) & 1u;
}

struct NsaRT {
    bf16x8 q[2];
    f32x4 o[4];
    float m, l;
    int tk;
};

template <int MODE>
__device__ __forceinline__ void nsa_loop(LAS unsigned char* lds, int tid, int lane, int w, int jb, int je,
                                         const char* ksrc, size_t kstride, size_t ktile, const char* vsrc, size_t vstride, size_t vtile,
                                         NsaRT (&R)[2], const SelMask selm0, const SelMask selm1, float (&carry)[2], float* impw) {
    const int g = lane >> 4, qr = lane & 15;
    int tid2 = tid; asm volatile("" : "+v"(tid2));
    const int sr = tid2 >> 3, sc = tid2 & 7;
    const int soff = tile_off(sr, sc);
    const int fxq = (qr >> 1) & 7;
    const int ka0 = qr * 128 + ((g ^ fxq) << 4), ka1 = qr * 128 + (((4 + g) ^ fxq) << 4);
    const int vb = qr * 128 + (g & 1) * 8, vc = (g >> 1) ^ fxq;
    const int va0 = vb + (vc << 4), va1 = vb + ((vc ^ 2) << 4), va2 = vb + ((vc ^ 4) << 4), va3 = vb + ((vc ^ 6) << 4);
    if (jb > je) return;
    u32x4 kreg, vreg;
    kreg = *(const u32x4*)(ksrc + (size_t)jb * ktile + (size_t)sr * kstride + sc * 16);
    if (MODE != 0) vreg = *(const u32x4*)(vsrc + (size_t)jb * vtile + (size_t)sr * vstride + sc * 16);
    *(LAS u32x4*)(lds + NSA_KT + soff) = kreg;
    if (MODE != 0) *(LAS u32x4*)(lds + NSA_VT + soff) = vreg;
    __syncthreads();
    for (int j = jb; j <= je; ++j) {
        const int cur = (j - jb) & 1;
        if (j < je) {
            kreg = *(const u32x4*)(ksrc + (size_t)(j + 1) * ktile + (size_t)sr * kstride + sc * 16);
            if (MODE != 0) vreg = *(const u32x4*)(vsrc + (size_t)(j + 1) * vtile + (size_t)sr * vstride + sc * 16);
        }
        const LAS unsigned char* kt = lds + NSA_KT + cur * 8192;
        const LAS unsigned char* vt = lds + NSA_VT + cur * 8192;
        bool act[2];
#pragma unroll
        for (int rt = 0; rt < 2; ++rt) {
            const int tk = R[rt].tk;
            bool a;
            if (MODE <= 1) { const int nv = tk >= 31 ? ((tk - 31) >> 4) + 1 : 0; a = nv > 64 * j; }
            else if (MODE == 2) a = (rt == 0 ? selbit(selm0.a, selm0.b, selm0.c, selm0.d, j) : selbit(selm1.a, selm1.b, selm1.c, selm1.d, j)) != 0u;
            else a = (64 * j <= tk) && (64 * j + 63 > tk - 512);
            act[rt] = __any(a);
        }
        if (act[0] || act[1]) {
#pragma unroll
            for (int rt = 0; rt < 2; ++rt) {
                if (!act[rt]) continue;
                NsaRT& r = R[rt];
                const int tk = r.tk;
                f32x4 s[4];
#pragma unroll
                for (int t = 0; t < 4; ++t) {
                    const bf16x8 k0 = *(const LAS bf16x8*)(kt + ka0 + t * 2048), k1 = *(const LAS bf16x8*)(kt + ka1 + t * 2048);
                    s[t] = (f32x4){0.f, 0.f, 0.f, 0.f};
                    s[t] = MFMA16(k0, r.q[0], s[t]);
                    s[t] = MFMA16(k1, r.q[1], s[t]);
                }
                int lim_hi, lim_lo;
                if (MODE <= 1) { const int nv = tk >= 31 ? ((tk - 31) >> 4) + 1 : 0; lim_hi = nv - 1; lim_lo = -1; }
                else if (MODE == 2) { lim_hi = ((rt == 0 ? selbit(selm0.a, selm0.b, selm0.c, selm0.d, j) : selbit(selm1.a, selm1.b, selm1.c, selm1.d, j)) != 0u) ? tk : -1; lim_lo = -1; }
                else { lim_hi = tk; lim_lo = tk - 512; }
                const int kb = 64 * j + 4 * g;
                if (MODE == 1) {
                    const float mrow = r.m, invl = r.l > 0.f ? 1.f / r.l : 0.f;
                    float p[4][4];
#pragma unroll
                    for (int t = 0; t < 4; ++t)
#pragma unroll
                        for (int i = 0; i < 4; ++i) { const int key = kb + 16 * t + i; p[t][i] = (key <= lim_hi) ? __expf(s[t][i] - mrow) * invl : 0.f; }
#pragma unroll
                    for (int t = 0; t < 4; ++t) {
                        const float own = (p[t][0] + p[t][1]) + (p[t][2] + p[t][3]);
                        const float x3 = p[t][3];
                        const float up_cur = __shfl(x3, (lane + 48) & 63);
                        const float up_prev = __shfl(carry[rt], (lane + 48) & 63);
                        float v = own + (g >= 1 ? up_cur : up_prev);
                        v += __shfl_xor(v, 1);
                        v += __shfl_xor(v, 2);
                        carry[rt] = x3;
                        if ((qr & 3) == 0) impw[(4 * rt + (qr >> 2)) * 128 + 16 * j + 4 * t + g] = v;
                    }
#pragma unroll
                    for (int ks = 0; ks < 2; ++ks) {
                        bf16x8 pf;
                        const unsigned a0 = pk2(p[2 * ks][0], p[2 * ks][1]), a1 = pk2(p[2 * ks][2], p[2 * ks][3]);
                        const unsigned a2 = pk2(p[2 * ks + 1][0], p[2 * ks + 1][1]), a3 = pk2(p[2 * ks + 1][2], p[2 * ks + 1][3]);
                        u32x4 pu; pu.x = a0; pu.y = a1; pu.z = a2; pu.w = a3;
                        pf = __builtin_bit_cast(bf16x8, pu);
#pragma unroll
                        for (int dt = 0; dt < 4; ++dt) {
                            const u32x2 lo = *(const LAS u32x2*)(vt + (ks ? va2 : va0) + dt * 2048);
                            const u32x2 hi = *(const LAS u32x2*)(vt + (ks ? va3 : va1) + dt * 2048);
                            u32x4 vu; vu.x = lo.x; vu.y = lo.y; vu.z = hi.x; vu.w = hi.y;
                            r.o[dt] = MFMA16(__builtin_bit_cast(bf16x8, vu), pf, r.o[dt]);
                        }
                    }
                } else {
                    float mx = NEG_INF;
#pragma unroll
                    for (int t = 0; t < 4; ++t)
#pragma unroll
                        for (int i = 0; i < 4; ++i) {
                            const int key = kb + 16 * t + i;
                            const bool ok = (key <= lim_hi) && (key > lim_lo);
                            s[t][i] = ok ? s[t][i] : NEG_INF;
                            mx = fmaxf(mx, s[t][i]);
                        }
                    mx = fmaxf(mx, __shfl_xor(mx, 16));
                    mx = fmaxf(mx, __shfl_xor(mx, 32));
                    const float mn = fmaxf(r.m, mx);
                    const float alpha = __expf(r.m - mn);
                    float p[4][4];
                    float rs = 0.f;
#pragma unroll
                    for (int t = 0; t < 4; ++t)
#pragma unroll
                        for (int i = 0; i < 4; ++i) { p[t][i] = (s[t][i] > 0.5f * NEG_INF) ? __expf(s[t][i] - mn) : 0.f; rs += p[t][i]; }
                    rs += __shfl_xor(rs, 16);
                    rs += __shfl_xor(rs, 32);
                    r.l = r.l * alpha + rs;
                    r.m = mn;
                    if (MODE != 0) {
#pragma unroll
                        for (int dt = 0; dt < 4; ++dt) r.o[dt] = r.o[dt] * alpha;
#pragma unroll
                        for (int ks = 0; ks < 2; ++ks) {
                            const unsigned a0 = pk2(p[2 * ks][0], p[2 * ks][1]), a1 = pk2(p[2 * ks][2], p[2 * ks][3]);
                            const unsigned a2 = pk2(p[2 * ks + 1][0], p[2 * ks + 1][1]), a3 = pk2(p[2 * ks + 1][2], p[2 * ks + 1][3]);
                            u32x4 pu; pu.x = a0; pu.y = a1; pu.z = a2; pu.w = a3;
                            const bf16x8 pf = __builtin_bit_cast(bf16x8, pu);
#pragma unroll
                            for (int dt = 0; dt < 4; ++dt) {
                                const u32x2 lo = *(const LAS u32x2*)(vt + (ks ? va2 : va0) + dt * 2048);
                                const u32x2 hi = *(const LAS u32x2*)(vt + (ks ? va3 : va1) + dt * 2048);
                                u32x4 vu; vu.x = lo.x; vu.y = lo.y; vu.z = hi.x; vu.w = hi.y;
                                r.o[dt] = MFMA16(__builtin_bit_cast(bf16x8, vu), pf, r.o[dt]);
                            }
                        }
                    }
                }
            }
        }
        if (j < je) {
            *(LAS u32x4*)(lds + NSA_KT + (cur ^ 1) * 8192 + soff) = kreg;
            if (MODE != 0) *(LAS u32x4*)(lds + NSA_VT + (cur ^ 1) * 8192 + soff) = vreg;
        }
        __syncthreads();
    }
}

__device__ void phase_nsa2(KA ka, int layer, LAS unsigned char* lds) {
    PHASE_IDS
    const int tid = TID, lane = tid & 63, w = __builtin_amdgcn_readfirstlane(tid >> 6), g = lane >> 4, qr = lane & 15;
    const bf16_t* H = PF(H);
    const bf16_t* kcb = PF(kcb);
    const bf16_t* vcT = PF(vcT);
    const bf16_t* vsT = PF(vsT);
    const bf16_t* vwT = PF(vwT);
    bf16_t* Y = PF(Y);
    const float* gate_b = PF(nsa_gate_b) + layer * 24;
    float* impw = (float*)(lds + NSA_IMP + w * 4096);
    unsigned* selw = (unsigned*)(lds + NSA_SEL + w * 128);
    for (int base = BID; base < 256; base += gridDim.x) {
#pragma unroll 1
        for (int half = 0; half < 2; ++half) {
            const int it = half ? 511 - base : base;
            const int chunk = it >> 2, bh = it & 3, b = bh >> 1, hk = bh & 1;
            const size_t rowbase = (size_t)b * T_;
            const int t0w = chunk * 64 + w * 8;
            NsaRT R[2];
            LAS f32x4* finw = (LAS f32x4*)(lds + NSA_FIN + w * 8192) + lane;
#pragma unroll
            for (int rt = 0; rt < 2; ++rt) {
                const int tk = t0w + 4 * rt + (qr >> 2), hh = hk * 4 + (qr & 3);
                R[rt].tk = tk;
                const bf16_t* qp = H + (rowbase + tk) * HLD + C_NQ + hh * 64 + 8 * g;
#pragma unroll
                for (int ks = 0; ks < 2; ++ks) {
                    const u32x4 u = *(const u32x4*)(qp + 32 * ks);
                    const unsigned uu[4] = {u.x, u.y, u.z, u.w};
                    u32x4 o4;
#pragma unroll
                    for (int e = 0; e < 4; ++e) {
                        const float f0 = __uint_as_float(uu[e] << 16) * 0.125f, f1 = __uint_as_float(uu[e] & 0xffff0000u) * 0.125f;
                        o4[e] = (__float_as_uint(f0) >> 16) | (__float_as_uint(f1) & 0xffff0000u);
                    }
                    R[rt].q[ks] = __builtin_bit_cast(bf16x8, o4);
                }
                R[rt].m = NEG_INF; R[rt].l = 0.f;
#pragma unroll
                for (int dt = 0; dt < 4; ++dt) R[rt].o[dt] = (f32x4){0.f, 0.f, 0.f, 0.f};
            }
            SelMask selm0{0u, 0u, 0u, 0u}, selm1{0u, 0u, 0u, 0u};
            float carry[2] = {0.f, 0.f};
            const int tmax = chunk * 64 + 63;
            const int nvmax = tmax >= 31 ? ((tmax - 31) >> 4) + 1 : 0;
            const int nb = (nvmax + 63) >> 6;
            const char* kc_src = (const char*)(kcb + (size_t)bh * 512 * 64);
            const char* vc_src = (const char*)(vcT + (size_t)bh * 64 * 512);
            nsa_loop<0>(lds, tid, lane, w, 0, nb - 1, kc_src, 128, 64 * 128, nullptr, 0, 0, R, selm0, selm1, carry, impw);
            for (int i = lane; i < 8 * 128; i += 64) impw[i] = 0.f;
            wave_sync();
            nsa_loop<1>(lds, tid, lane, w, 0, nb - 1, kc_src, 128, 64 * 128, vc_src, 512 * 2, 64 * 2, R, selm0, selm1, carry, impw);
#pragma unroll
            for (int rt = 0; rt < 2; ++rt) {
                const int hh = hk * 4 + (qr & 3);
                const float gt = sigmoidf_(bf2f(H[(rowbase + R[rt].tk) * HLD + C_NG + hh * 3 + 0]) + gate_b[hh * 3 + 0]);
#pragma unroll
                for (int dt = 0; dt < 4; ++dt) { finw[(rt * 4 + dt) * 64] = R[rt].o[dt] * gt; R[rt].o[dt] = (f32x4){0.f, 0.f, 0.f, 0.f}; }
            }
            wave_sync();
            {
                const int tl = lane >> 3, sub = lane & 7;
                const int tks = t0w + tl, curb = tks >> 6;
                float v[16];
#pragma unroll
                for (int i = 0; i < 16; ++i) {
                    const int jj = sub * 16 + i;
                    const float a = impw[tl * 128 + jj];
                    const bool forced = (jj == 0) || (jj == curb) || (jj == curb - 1);
                    v[i] = (jj <= curb) ? (a + (forced ? 1e4f : 0.f)) : NEG_INF;
                }
                wave_sync();
#pragma unroll
                for (int i = 0; i < 16; ++i) impw[tl * 128 + sub * 16 + i] = v[i];
                wave_sync();
                int cnt[16];
#pragma unroll
                for (int i = 0; i < 16; ++i) cnt[i] = 0;
                for (int jj = 0; jj < 128; ++jj) {
                    const float x = impw[tl * 128 + jj];
#pragma unroll
                    for (int i = 0; i < 16; ++i) cnt[i] += (x > v[i]) || (x == v[i] && jj < sub * 16 + i);
                }
                unsigned bits = 0u;
#pragma unroll
                for (int i = 0; i < 16; ++i) bits |= ((cnt[i] < 16) && (v[i] > 0.5f * NEG_INF)) ? (1u << i) : 0u;
                const unsigned other = __shfl_xor(bits, 1);
                const unsigned word = (sub & 1) ? ((bits << 16) | other) : (bits | (other << 16));
                if ((sub & 1) == 0) selw[tl * 4 + (sub >> 1)] = word;
                wave_sync();
                { const unsigned* q0 = selw + (qr >> 2) * 4; selm0.a = q0[0]; selm0.b = q0[1]; selm0.c = q0[2]; selm0.d = q0[3];
                  selm1.a = q0[16]; selm1.b = q0[17]; selm1.c = q0[18]; selm1.d = q0[19]; }
                wave_sync();
            }
#pragma unroll
            for (int rt = 0; rt < 2; ++rt) { R[rt].m = NEG_INF; R[rt].l = 0.f; }
            nsa_loop<2>(lds, tid, lane, w, 0, chunk, (const char*)(H + rowbase * HLD + C_KS + hk * 64), (size_t)HLD * 2, (size_t)64 * HLD * 2,
                        (const char*)(vsT + (size_t)bh * 64 * T_), (size_t)T_ * 2, 64 * 2, R, selm0, selm1, carry, impw);
#pragma unroll
            for (int rt = 0; rt < 2; ++rt) {
                const int hh = hk * 4 + (qr & 3);
                const float gt = sigmoidf_(bf2f(H[(rowbase + R[rt].tk) * HLD + C_NG + hh * 3 + 1]) + gate_b[hh * 3 + 1]);
                const float sc = gt / R[rt].l;
#pragma unroll
                for (int dt = 0; dt < 4; ++dt) { finw[(rt * 4 + dt) * 64] += R[rt].o[dt] * sc; R[rt].o[dt] = (f32x4){0.f, 0.f, 0.f, 0.f}; }
                R[rt].m = NEG_INF; R[rt].l = 0.f;
            }
            nsa_loop<3>(lds, tid, lane, w, chunk >= 8 ? chunk - 8 : 0, chunk, (const char*)(H + rowbase * HLD + C_KW + hk * 64), (size_t)HLD * 2, (size_t)64 * HLD * 2,
                        (const char*)(vwT + (size_t)bh * 64 * T_), (size_t)T_ * 2, 64 * 2, R, selm0, selm1, carry, impw);
#pragma unroll
            for (int rt = 0; rt < 2; ++rt) {
                const int tk = R[rt].tk, hh = hk * 4 + (qr & 3);
                const float gt = sigmoidf_(bf2f(H[(rowbase + tk) * HLD + C_NG + hh * 3 + 2]) + gate_b[hh * 3 + 2]);
                const float sc = gt / R[rt].l;
                bf16_t* yp = Y + (rowbase + tk) * DM + 256 + hh * 64 + 4 * g;
#pragma unroll
                for (int dt = 0; dt < 4; ++dt) {
                    const f32x4 o = finw[(rt * 4 + dt) * 64] + R[rt].o[dt] * sc;
                    u32x2 wv; wv.x = pk2(o[0], o[1]); wv.y = pk2(o[2], o[3]);
                    *(u32x2*)(yp + 16 * dt) = wv;
                }
            }
        }
    }
}

__device__ void phase_vtrans(KA ka, float* smem) {
    PHASE_IDS
    const int lane = TID & 63, w = TID >> 6;
    bf16_t* scr = (bf16_t*)(smem + w * 4096);
    const bf16_t* H = PF(H);
    for (int it = BID * NW + w; it < 1024; it += gridDim.x * NW) {
        const int tt = it & 127, bh = (it >> 7) & 3, which = it >> 9;
        const int b = bh >> 1, hk = bh & 1;
        const size_t tok0 = (size_t)b * T_ + tt * 64;
        const int col = (which ? C_VW : C_VS) + hk * 64;
        bf16_t* dst = (which ? PF(vwT) : PF(vsT)) + (size_t)bh * 64 * T_ + tt * 64;
        wave_sync();
        for (int i = 0; i < 64; ++i) scr[lane * 66 + i] = H[(tok0 + i) * HLD + col + lane];
        wave_sync();
        for (int d = 0; d < 64; ++d) dst[(size_t)d * T_ + lane] = scr[d * 66 + lane];
    }
}

#ifndef ONLY_Q
#define ONLY_Q -2
#endif
#ifndef QMASK
#define QMASK 0x3ff
#endif
#define QON(k) ((ONLY_Q == -2 && ((QMASK >> ((k) + 1)) & 1)) || ONLY_Q == (k))
#ifndef NPH_TOTAL
#define NPH_TOTAL 19
#endif
__global__ void __launch_bounds__(NTHR, 2) k_mega(P p0) {
    extern __shared__ __attribute__((aligned(16))) unsigned char lds_raw[];
    LAS unsigned char* lds = (LAS unsigned char*)lds_raw;
    float* smem = (float*)lds_raw;
    volatile LAS unsigned* misc = (volatile LAS unsigned*)(lds + LDS_MISC);
    if (threadIdx.x < 16) misc[threadIdx.x] = 0u;
    __syncthreads();
    XcdBarrier bar = xcd_barrier_post(p0.ctl + CW_BAR, misc);
#pragma unroll 1
    for (int ph = 0; ph < p0.nph; ph++) {
        const int layer = ph == 0 ? 0 : (ph - 1) / 9, q = ph == 0 ? -1 : (ph - 1) % 9;
#if defined(__HIP_DEVICE_COMPILE__)
        KA ka = (KA)__builtin_amdgcn_kernarg_segment_ptr();
        asm volatile("" : "+s"(ka));
#else
        KA ka = nullptr;
#endif
        const float* xin = layer == 0 ? PF(x) : PF(out);
        float* x1 = PF(out);
        if (q == -1 && QON(-1)) phase_prologue(ka, smem);
        else if (q == 0 && QON(0)) phase_inproj(ka, layer, lds);
        else if (q == 1 && QON(1)) { phase_hgrn(ka, layer, smem); phase_gmlp(ka, layer, smem); __syncthreads(); phase_compress(ka, layer, smem); __syncthreads(); phase_vtrans(ka, smem); }
        else if (q == 2 && QON(2)) phase_nsa2(ka, layer, lds);
        else if (q == 3 && QON(3)) phase_headnorm(ka, layer);
        else if (q == 4 && QON(4)) phase_outproj(ka, layer, xin, x1, lds);
        else if (q == 5 && QON(5)) phase_ln1_route(ka, layer, x1);
        else if (q == 6 && QON(6)) phase_moe_up(ka, layer, lds);
        else if (q == 7 && QON(7)) phase_moe_down(ka, layer, lds);
        else if (q == 8 && QON(8)) phase_ln2(ka, layer, x1, PF(out));
        if (ph != NPH_TOTAL - 1) xcd_barrier(bar);
    }
}

static inline size_t align_up(size_t v, size_t a) { return (v + a - 1) / a * a; }

extern "C" void kernel_launch(void* const* d_in, const int* in_sizes, int n_in, void* d_out, int out_size, void* d_ws,
                              size_t ws_size, hipStream_t stream) {
    P p{};
    p.x = (const float*)d_in[0]; p.w_in = (const float*)d_in[1]; p.gm_v_gain = (const float*)d_in[2];
    p.gm_v_bias = (const float*)d_in[3]; p.gm_w_s = (const float*)d_in[4]; p.gm_b_s = (const float*)d_in[5];
    p.cmp_pos = (const float*)d_in[6]; p.cmp_w1 = (const float*)d_in[7]; p.cmp_w2 = (const float*)d_in[8];
    p.nsa_gate_b = (const float*)d_in[9]; p.hg_lower = (const float*)d_in[10]; p.out_gain = (const float*)d_in[11];
    p.w_out = (const float*)d_in[12]; p.ln1_g = (const float*)d_in[13]; p.ln1_b = (const float*)d_in[14];
    p.rg_w = (const float*)d_in[15]; p.rg_b = (const float*)d_in[16]; p.re_w = (const float*)d_in[17];
    p.re_b = (const float*)d_in[18]; p.w_gate = (const float*)d_in[19]; p.w_up = (const float*)d_in[20];
    p.w_down = (const float*)d_in[21]; p.ln2_g = (const float*)d_in[22]; p.ln2_b = (const float*)d_in[23];
    p.out = (float*)d_out;
    char* ws = (char*)d_ws;
    size_t off = 0;
    p.ctl = (unsigned*)(ws + off); off = align_up(off + CTL_BYTES, 256);
    p.WT = (bf16_t*)(ws + off); off = align_up(off + 2 * WT_LAYER * 2, 256);
    p.H = (bf16_t*)(ws + off); off = align_up(off + (size_t)NTOK * HLD * 2, 256);
    p.Y = (bf16_t*)(ws + off); off = align_up(off + (size_t)NTOK * DM * 2, 256);
    p.XB = (bf16_t*)(ws + off); off = align_up(off + (size_t)NTOK * DM * 2, 256);
    p.kcb = (bf16_t*)(ws + off); off = align_up(off + (size_t)4 * 512 * 64 * 2, 256);
    p.vcT = (bf16_t*)(ws + off); off = align_up(off + (size_t)4 * 64 * 512 * 2, 256);
    p.vsT = (bf16_t*)(ws + off); off = align_up(off + (size_t)4 * 64 * T_ * 2, 256);
    p.vwT = (bf16_t*)(ws + off); off = align_up(off + (size_t)4 * 64 * T_ * 2, 256);
    p.gbuf = (float*)(ws + off); off = align_up(off + (size_t)2 * 2044 * 128 * 4, 256);
    p.list_tok = (int*)(ws + off); off = align_up(off + (size_t)16 * NTOK * 4, 256);
    p.list_w = (float*)(ws + off); off = align_up(off + (size_t)16 * NTOK * 4, 256);
    p.tok_slot = (int*)(ws + off); off = align_up(off + (size_t)NTOK * 2 * 4, 256);
    p.nph = NPH_TOTAL;
    (void)in_sizes; (void)n_in; (void)out_size;
    static int grid_blocks = 0;
    if (!grid_blocks) {
        int dev = 0, cus = 0, per_cu = 0;
        (void)hipGetDevice(&dev);
        (void)hipDeviceGetAttribute(&cus, hipDeviceAttributeMultiprocessorCount, dev);
        if (hipFuncSetAttribute((const void*)k_mega, hipFuncAttributeMaxDynamicSharedMemorySize, LDS_BYTES) != hipSuccess) { fprintf(stderr, "hipFuncSetAttribute failed\n"); grid_blocks = -1; return; }
        if (hipOccupancyMaxActiveBlocksPerMultiprocessor(&per_cu, (const void*)k_mega, NTHR, LDS_BYTES) != hipSuccess || per_cu < 1) { fprintf(stderr, "occupancy query says %d\n", per_cu); }
        (void)hipGetLastError();
        grid_blocks = cus;
        if (off > ws_size) { fprintf(stderr, "workspace too small: need %zu have %zu\n", off, ws_size); grid_blocks = -1; }
    }
    if (grid_blocks < 0) return;
    (void)hipMemsetAsync(p.ctl, 0, CTL_BYTES, stream);
    void* args[] = {&p};
    hipError_t e = hipLaunchCooperativeKernel((const void*)k_mega, dim3(grid_blocks), dim3(NTHR), args, LDS_BYTES, stream);
    if (e != hipSuccess) fprintf(stderr, "cooperative launch failed: %s (grid %d)\n", hipGetErrorString(e), grid_blocks);
}
```

```cpp
#include <hip/hip_runtime.h>
#include <cstdio>
#include <cstdint>

#define LAS __attribute__((address_space(3)))
typedef unsigned short bf16_t;
typedef short bf16x8 __attribute__((ext_vector_type(8)));
typedef float f32x4 __attribute__((ext_vector_type(4)));
typedef float f32x2 __attribute__((ext_vector_type(2)));
typedef unsigned u32x4 __attribute__((ext_vector_type(4)));
typedef unsigned u32x2 __attribute__((ext_vector_type(2)));

constexpr int NW = 8;
constexpr int NTHR = NW * 64;
constexpr int T_ = 8192;
constexpr int NTOK = 16384;
constexpr int DM = 1024;
constexpr int IC_SRC = 2840;
constexpr int HLD = 3072;
constexpr int C_GU = 0, C_GV = 256, C_NQ = 512, C_KC = 1024, C_VC = 1152, C_KS = 1280, C_VS = 1408,
              C_KW = 1536, C_VW = 1664, C_HQ = 1792, C_HF = 2048, C_HI = 2304, C_HG = 2560, C_NG = 2816;
constexpr int NCMP = 511;
constexpr float ALPHA = 1.4142135623730951f;
constexpr float NEG_INF = -1e30f;

constexpr size_t WT_IN = 0;
constexpr size_t WT_OUT = WT_IN + (size_t)3072 * 1024;
constexpr size_t WT_UP = WT_OUT + (size_t)1024 * 1024;
constexpr size_t WT_DN = WT_UP + (size_t)16 * 1024 * 1024;
constexpr size_t WT_LAYER = WT_DN + (size_t)16 * 1024 * 512;

constexpr int LDS_STAGE = 131072;
constexpr int LDS_MISC = LDS_STAGE;
constexpr int LDS_BYTES = 147456;

constexpr int CW_BAR = 0;
constexpr int CW_CNT = 4096;
constexpr size_t CTL_BYTES = 65536;

struct P {
    const float* x; const float* w_in; const float* gm_v_gain; const float* gm_v_bias; const float* gm_w_s;
    const float* gm_b_s; const float* cmp_pos; const float* cmp_w1; const float* cmp_w2; const float* nsa_gate_b;
    const float* hg_lower; const float* out_gain; const float* w_out; const float* ln1_g; const float* ln1_b;
    const float* rg_w; const float* rg_b; const float* re_w; const float* re_b; const float* w_gate;
    const float* w_up; const float* w_down; const float* ln2_g; const float* ln2_b;
    float* out;
    unsigned* ctl;
    bf16_t* WT;
    bf16_t* H;
    bf16_t* Y;
    bf16_t* XB;
    bf16_t* kcb;
    bf16_t* vcT;
    bf16_t* vsT;
    bf16_t* vwT;
    float* gbuf;
    int* list_tok;
    float* list_w;
    int* tok_slot;
    float* hgU; float* hgG; float* hgS; bf16_t* hgQB; bf16_t* hgO;
    int nph; int pad;
};


typedef const __attribute__((address_space(4))) char* KA;
template <class T> __device__ __forceinline__ T ldarg(KA ka, size_t off) { return *(const __attribute__((address_space(4))) T*)(ka + off); }
#define PF(f) ldarg<decltype(P::f)>(ka, offsetof(P, f))

__device__ __forceinline__ float bf2f(bf16_t u) { return __uint_as_float(((unsigned)u) << 16); }
__device__ __forceinline__ unsigned f2bf_u(float f) {
    unsigned u = __float_as_uint(f);
    return (u + 0x7fffu + ((u >> 16) & 1u)) >> 16;
}
__device__ __forceinline__ bf16_t f2bf(float f) { return (bf16_t)f2bf_u(f); }
__device__ __forceinline__ unsigned pk2(float lo, float hi) { return f2bf_u(lo) | (f2bf_u(hi) << 16); }
__device__ __forceinline__ float gelu_t(float x) {
    float u = 0.7978845608028654f * (x + 0.044715f * x * x * x);
    return 0.5f * x * (1.f + tanhf(u));
}
__device__ __forceinline__ float sigmoidf_(float x) { return 1.f / (1.f + __expf(-x)); }
__device__ __forceinline__ float wave_max(float v) {
#pragma unroll
    for (int o = 32; o > 0; o >>= 1) v = fmaxf(v, __shfl_xor(v, o));
    return v;
}
__device__ __forceinline__ float wave_sum(float v) {
#pragma unroll
    for (int o = 32; o > 0; o >>= 1) v += __shfl_xor(v, o);
    return v;
}
__device__ __forceinline__ void wave_sync() {
    __builtin_amdgcn_fence(__ATOMIC_RELEASE, "wavefront");
    __builtin_amdgcn_wave_barrier();
    __builtin_amdgcn_fence(__ATOMIC_ACQUIRE, "wavefront");
}
__device__ __forceinline__ int opaque_tid() { int t = threadIdx.x; asm volatile("" : "+v"(t)); return t; }
__device__ __forceinline__ int opaque_bid() { int b = blockIdx.x; asm volatile("" : "+s"(b)); return b; }
#define PHASE_IDS const int TID = opaque_tid(); const int BID = opaque_bid(); (void)TID; (void)BID;

#define XB_TMO      128
#define XB_XCNT(j)  (256  + 64 * (j))
#define XB_XSUB(j)  (1280 + 64 * (j))
#define XB_XGEN(j)  (2304 + 64 * (j))
#define XB_TOP      3328
#define XB_TOPGEN   3392
#define XCD_BAR_WORDS 3456
#define XB_SPIN_CAP (1u << 22)
__device__ __forceinline__ unsigned xb_ld(unsigned* p)              { return __hip_atomic_load(p, __ATOMIC_RELAXED, __HIP_MEMORY_SCOPE_AGENT); }
__device__ __forceinline__ unsigned xb_add(unsigned* p, unsigned v) { return __hip_atomic_fetch_add(p, v, __ATOMIC_RELAXED, __HIP_MEMORY_SCOPE_AGENT); }
__device__ __forceinline__ unsigned xb_xcc_id() { return (unsigned)__builtin_amdgcn_s_getreg((3 << 11) | 20) & 0xFu; }
#define XB_SPIN(cond, bar) do { unsigned _sp = 0; while (cond) { __builtin_amdgcn_s_sleep(1); \
    if ((++_sp & 255u) == 0u) { if (xb_ld(&(bar)[XB_TMO])) break; if (_sp > XB_SPIN_CAP) { atomicAdd(&(bar)[XB_TMO], 1u); break; } } } } while (0)
struct XcdBarrier { unsigned* bar; unsigned x; volatile LAS unsigned* st; };
__device__ __forceinline__ XcdBarrier xcd_barrier_post(unsigned* bar, volatile LAS unsigned* st) {
    XcdBarrier b; b.bar = bar; b.x = xb_xcc_id(); b.st = st;
    if (threadIdx.x == 0) (void)xb_add(&bar[XB_XCNT(b.x)], 1u);
    return b;
}
__device__ __forceinline__ void xcd_barrier_complete(unsigned* bar, unsigned x, unsigned& nloc, unsigned& nx) {
    const unsigned G = gridDim.x * gridDim.y * gridDim.z;
    unsigned sum, cnt, mine, sp = 0u;
    for (;;) {
        sum = 0u; cnt = 0u; mine = 0u;
#pragma unroll
        for (unsigned j = 0; j < 16; ++j) { const unsigned c = xb_ld(&bar[XB_XCNT(j)]); sum += c; cnt += (c > 0u) ? 1u : 0u; mine = (j == x) ? c : mine; }
        if (sum == G) break;
        __builtin_amdgcn_s_sleep(1);
        if ((++sp & 255u) == 0u) { if (xb_ld(&bar[XB_TMO])) break; if (sp > XB_SPIN_CAP) { atomicAdd(&bar[XB_TMO], 1u); break; } }
    }
    nloc = mine > 0u ? mine : 1u; nx = cnt > 0u ? cnt : 1u;
}
__device__ __forceinline__ void xcd_barrier(const XcdBarrier& b) {
    asm volatile("s_waitcnt vmcnt(0)" ::: "memory");
    __syncthreads();
    if (threadIdx.x == 0) {
        unsigned* bar = b.bar;
        __builtin_amdgcn_s_waitcnt(0);
        unsigned nloc = b.st[0], nx = b.st[1];
        if (nloc == 0u) { xcd_barrier_complete(bar, b.x, nloc, nx); b.st[0] = nloc; b.st[1] = nx; }
        const unsigned old = xb_add(&bar[XB_XSUB(b.x)], 1u);
        const unsigned gen = old / nloc;
        if (old + 1u == (gen + 1u) * nloc) {
            __builtin_amdgcn_fence(__ATOMIC_RELEASE, "agent");
            asm volatile("s_waitcnt vmcnt(0)" ::: "memory");
            const unsigned og = xb_add(&bar[XB_TOP], 1u);
            const unsigned tg = og / nx;
            if (og + 1u == (tg + 1u) * nx) xb_add(&bar[XB_TOPGEN], 1u);
            else XB_SPIN(xb_ld(&bar[XB_TOPGEN]) == tg, bar);
            __builtin_amdgcn_fence(__ATOMIC_ACQUIRE, "agent");
            xb_add(&bar[XB_XGEN(b.x)], 1u);
            asm volatile("s_waitcnt vmcnt(0)" ::: "memory");
        } else {
            XB_SPIN(xb_ld(&bar[XB_XGEN(b.x)]) == gen, bar);
            __builtin_amdgcn_fence(__ATOMIC_ACQUIRE, "agent");
            asm volatile("s_waitcnt vmcnt(0)" ::: "memory");
        }
    }
    __syncthreads();
}

namespace pg8 {
constexpr int BM = 256, BK = 64, HALF = 128, HTB = HALF * BK * 2, STAGE_BYTES = 8 * HTB;
__host__ __device__ __forceinline__ int lds_byte(int r, int c) { const int st = (r >> 4) * 2 + (c >> 5), rr = r & 15, cc = c & 31, ob = rr * 64 + cc * 2; return st * 1024 + (ob ^ (((ob >> 9) & 1) << 5)); }
__host__ __device__ __forceinline__ void stage_rc(int b, int& R, int& C) { const int st = b / 1024, sb = b % 1024, swz = sb ^ (((sb >> 9) & 1) << 5); R = (st >> 1) * 16 + swz / 64; C = (st & 1) * 32 + (swz % 64) / 2; }
__host__ __device__ __forceinline__ int perm32(int rho) { const int n = rho >> 4, i = rho & 15; return 8 * (i >> 2) + 4 * n + (i & 3); }
__device__ __forceinline__ unsigned cvt_pk_bf16(float lo, float hi) { unsigned r; asm volatile("v_cvt_pk_bf16_f32 %0, %1, %2" : "=v"(r) : "v"(lo), "v"(hi)); return r; }

struct Unit {
    const char* bptr;
    int arow0;
    int nrows;
    int pm, pn, e, ui;
};

template <class Epi, class Sched>
__device__ __forceinline__ void gemm_phase(LAS unsigned char* lds, const char* Abase, const int K, const Sched& S, const Epi& E) {
    const int tid = opaque_tid(), wid = __builtin_amdgcn_readfirstlane(tid >> 6), lane = tid & 63, wr = wid >> 2, wc = wid & 3, fr = lane & 15, fq = lane >> 4;
    const int nt = K / BK;
    int R0, C0, R1, C1; stage_rc(tid * 16, R0, C0); stage_rc(tid * 16 + 8192, R1, C1);
    unsigned voffB[2];
    { const int Rb0 = Epi::PERM ? ((R0 & ~31) + perm32(R0 & 31)) : R0, Rb1 = Epi::PERM ? ((R1 & ~31) + perm32(R1 & 31)) : R1;
      voffB[0] = (unsigned)(Rb0 * K + C0) * 2u; voffB[1] = (unsigned)(Rb1 * K + C1) * 2u; }
    const unsigned cA0 = (unsigned)C0 * 2u, cA1 = (unsigned)C1 * 2u;
    const unsigned voffA0 = (unsigned)(R0 * K + C0) * 2u, voffA1 = (unsigned)(R1 * K + C1) * 2u;
    const unsigned kstep = (unsigned)(BK * 2);
    const unsigned hstep = (unsigned)(HALF * K * 2);
    const unsigned ldsw = (unsigned)wid * 1024u;
    const int aoff = lds_byte(wr * 64 + fr, fq * 8), boff = lds_byte(wc * 32 + fr, fq * 8);
#define PG8_SA(b, h) (((b) * 2 + (h)) * HTB)
#define PG8_SB(b, h) ((4 + (b) * 2 + (h)) * HTB)
#define PG8_STAGE_B(bufoff, gbase) do { \
        __builtin_amdgcn_global_load_lds((const unsigned*)((const char*)(gbase) + voffB[0]), (LAS unsigned*)(lds + (bufoff) + ldsw), 16, 0, 0); \
        __builtin_amdgcn_global_load_lds((const unsigned*)((const char*)(gbase) + voffB[1]), (LAS unsigned*)(lds + (bufoff) + ldsw + 8192), 16, 0, 0); } while (0)
#define PG8_STAGE_A(bufoff, gbase, pk) do { \
        const unsigned o0_ = Sched::GATHER ? (((pk) & 0xffffu) * (unsigned)K * 2u + cA0) : voffA0; \
        const unsigned o1_ = Sched::GATHER ? (((pk) >> 16) * (unsigned)K * 2u + cA1) : voffA1; \
        __builtin_amdgcn_global_load_lds((const unsigned*)((const char*)(gbase) + o0_), (LAS unsigned*)(lds + (bufoff) + ldsw), 16, 0, 0); \
        __builtin_amdgcn_global_load_lds((const unsigned*)((const char*)(gbase) + o1_), (LAS unsigned*)(lds + (bufoff) + ldsw + 8192), 16, 0, 0); } while (0)
#define PG8_LDA(dst, b, h) do { _Pragma("unroll") for (int m = 0; m < 4; ++m) _Pragma("unroll") for (int k = 0; k < 2; ++k) dst[m][k] = *(const LAS bf16x8*)(lds + PG8_SA(b, h) + aoff + m * 2048 + k * 1024); } while (0)
#define PG8_LDB(dst, b, h) do { _Pragma("unroll") for (int n = 0; n < 2; ++n) _Pragma("unroll") for (int k = 0; k < 2; ++k) dst[n][k] = *(const LAS bf16x8*)(lds + PG8_SB(b, h) + boff + n * 2048 + k * 1024); } while (0)
#define PG8_MMA(ai, bj, At, Bt) do { __builtin_amdgcn_s_setprio(1); _Pragma("unroll") for (int m = 0; m < 4; ++m) _Pragma("unroll") for (int n = 0; n < 2; ++n) _Pragma("unroll") for (int k = 0; k < 2; ++k) \
        acc[ai][bj][m][n] = __builtin_amdgcn_mfma_f32_16x16x32_bf16(Bt[n][k], At[m][k], acc[ai][bj][m][n], 0, 0, 0); __builtin_amdgcn_s_setprio(0); } while (0)
#define PG8_WAIT_V(n) asm volatile("s_waitcnt vmcnt(" #n ")" ::: "memory")
#define PG8_WAIT_L(n) asm volatile("s_waitcnt lgkmcnt(" #n ")" ::: "memory")
#define PG8_BAR __builtin_amdgcn_s_barrier()
#define PG8_SCHED __builtin_amdgcn_sched_barrier(0)
#define PG8_PACK(u, h) ((unsigned)S.arow((u), ((h) * 128 + R0) < (u).nrows ? ((h) * 128 + R0) : (u).nrows - 1) | ((unsigned)S.arow((u), ((h) * 128 + R1) < (u).nrows ? ((h) * 128 + R1) : (u).nrows - 1) << 16))
    Unit cur, nxt; int ui = 0;
    if (!S.next(0, cur)) return;
    f32x4 acc[2][2][4][2];
#pragma unroll
    for (int a = 0; a < 2; ++a)
#pragma unroll
        for (int b = 0; b < 2; ++b)
#pragma unroll
            for (int m = 0; m < 4; ++m)
#pragma unroll
                for (int n = 0; n < 2; ++n) acc[a][b][m][n] = (f32x4){0.f, 0.f, 0.f, 0.f};
    bf16x8 At[4][2], B0[2][2], B1[2][2];
    unsigned pC0 = 0u, pC1 = 0u, pN0 = 0u, pN1 = 0u;
    if (Sched::GATHER) { pC0 = PG8_PACK(cur, 0); pC1 = PG8_PACK(cur, 1); }
    const char* cB = cur.bptr;
    const char* cA = Sched::GATHER ? Abase : Abase + (size_t)cur.arow0 * K * 2;
    const unsigned hA = Sched::GATHER ? 0u : hstep;
    PG8_STAGE_B(PG8_SB(0, 0), cB); PG8_STAGE_B(PG8_SB(0, 1), cB + hstep); PG8_STAGE_A(PG8_SA(0, 0), cA, pC0); PG8_STAGE_A(PG8_SA(0, 1), cA + hA, pC1);
    if (wr == 1) PG8_BAR;
    PG8_WAIT_V(2); PG8_BAR;
    PG8_STAGE_B(PG8_SB(1, 0), cB + kstep); PG8_STAGE_A(PG8_SA(1, 0), cA + kstep, pC0); PG8_STAGE_B(PG8_SB(1, 1), cB + hstep + kstep);
    PG8_WAIT_V(6); PG8_BAR;
    for (;;) {
        const bool has_next = S.next(ui + 1, nxt);
        if (Sched::GATHER) { if (has_next) { pN0 = PG8_PACK(nxt, 0); pN1 = PG8_PACK(nxt, 1); } else { pN0 = pC0; pN1 = pC1; } }
        const char* nB = has_next ? nxt.bptr : cB;
        const char* nA = (Sched::GATHER || !has_next) ? cA : Abase + (size_t)nxt.arow0 * K * 2;
        for (int t = 0; t < nt; t += 2) {
            const bool last = (t == nt - 2);
            const char* a1 = cA + (unsigned)(t + 1) * kstep;
            const char* a2 = last ? nA : cA + (unsigned)(t + 2) * kstep; const char* b2 = last ? nB : cB + (unsigned)(t + 2) * kstep;
            const char* a3 = a2 + kstep; const char* b3 = b2 + kstep;
            const unsigned s0 = last ? pN0 : pC0, s1 = last ? pN1 : pC1;
            PG8_LDB(B0, 0, 0); PG8_LDB(B1, 0, 1); PG8_SCHED; PG8_LDA(At, 0, 0); PG8_STAGE_A(PG8_SA(1, 1), a1 + hA, pC1);
            PG8_WAIT_V(8); PG8_WAIT_L(0); PG8_BAR; PG8_MMA(0, 0, At, B0); PG8_MMA(0, 1, At, B1); PG8_BAR; PG8_SCHED;
            PG8_LDA(At, 0, 1); PG8_STAGE_B(PG8_SB(0, 0), b2); PG8_STAGE_B(PG8_SB(0, 1), b2 + hstep); PG8_STAGE_A(PG8_SA(0, 0), a2, s0);
            PG8_WAIT_V(8); PG8_WAIT_L(0); PG8_BAR; PG8_MMA(1, 0, At, B0); PG8_MMA(1, 1, At, B1); PG8_BAR; PG8_SCHED;
            PG8_LDB(B0, 1, 0); PG8_LDB(B1, 1, 1); PG8_SCHED; PG8_LDA(At, 1, 0); PG8_STAGE_A(PG8_SA(0, 1), a2 + hA, s1);
            PG8_WAIT_V(8); PG8_WAIT_L(0); PG8_BAR; PG8_MMA(0, 0, At, B0); PG8_MMA(0, 1, At, B1); PG8_BAR; PG8_SCHED;
            PG8_LDA(At, 1, 1); PG8_STAGE_B(PG8_SB(1, 0), b3); PG8_STAGE_B(PG8_SB(1, 1), b3 + hstep); PG8_STAGE_A(PG8_SA(1, 0), a3, s0);
            PG8_WAIT_V(8); PG8_WAIT_L(0); PG8_BAR; PG8_MMA(1, 0, At, B0); PG8_MMA(1, 1, At, B1); PG8_BAR; PG8_SCHED;
        }
        if (wr == 0) PG8_BAR;
        E(acc, cur, wr, wc, fr, fq);
        if (!has_next) break;
#pragma unroll
        for (int a = 0; a < 2; ++a)
#pragma unroll
            for (int b = 0; b < 2; ++b)
#pragma unroll
                for (int m = 0; m < 4; ++m)
#pragma unroll
                    for (int n = 0; n < 2; ++n) acc[a][b][m][n] = (f32x4){0.f, 0.f, 0.f, 0.f};
        cur = nxt; cB = nB; cA = nA; ++ui;
        pC0 = pN0; pC1 = pN1;
        if (wr == 1) PG8_BAR;
    }
    PG8_WAIT_V(0);
    PG8_BAR;
#undef PG8_SA
#undef PG8_SB
#undef PG8_STAGE_A
#undef PG8_STAGE_B
#undef PG8_LDA
#undef PG8_LDB
#undef PG8_MMA
#undef PG8_WAIT_V
#undef PG8_WAIT_L
#undef PG8_BAR
#undef PG8_SCHED
#undef PG8_PACK
}

struct DenseOrder {
    static constexpr bool GATHER = false;
    int nM, nN, nwg, G, c; const char* Bt; int K;
    __device__ void init(int M, int N, int K_, const bf16_t* Bt_, int G_, int c_) { nM = M / BM; nN = N / BM; nwg = nM * nN; G = G_; c = c_; Bt = (const char*)Bt_; K = K_; }
    __device__ __forceinline__ bool next(int i, Unit& u) const {
        const long L = (long)i * G + c; if (L >= nwg) return false;
        int wgid = (int)L; { const int q = nwg / 8, r = nwg % 8, xcd = wgid % 8, off = wgid / 8; wgid = (xcd < r ? xcd * (q + 1) : r * (q + 1) + (xcd - r) * q) + off; }
        const int nig = 8 * nN, gid = wgid / nig, fm = gid * 8, gsz = (nM - fm) < 8 ? (nM - fm) : 8;
        u.pm = fm + ((wgid % nig) % gsz); u.pn = (wgid % nig) / gsz;
        u.arow0 = u.pm * BM; u.nrows = BM; u.e = 0; u.ui = i;
        u.bptr = Bt + (size_t)u.pn * BM * K * 2;
        return true;
    }
    __device__ __forceinline__ int arow(const Unit& u, int r) const { return u.arow0 + r; }
};
}

struct EpiH {
    static constexpr bool PERM = true;
    bf16_t* H;
    __device__ __forceinline__ void operator()(const f32x4 (&acc)[2][2][4][2], const pg8::Unit& u, int wr, int wc, int fr, int fq) const {
        const int row0 = u.arow0 + wr * 64 + fr, col0 = u.pn * 256 + wc * 32 + 8 * fq;
#pragma unroll
        for (int ai = 0; ai < 2; ++ai)
#pragma unroll
            for (int m = 0; m < 4; ++m) {
                bf16_t* rowp = H + (size_t)(row0 + ai * 128 + m * 16) * HLD + col0;
#pragma unroll
                for (int bj = 0; bj < 2; ++bj) {
                    const f32x4 v0 = acc[ai][bj][m][0], v1 = acc[ai][bj][m][1];
                    u32x4 w; w.x = pg8::cvt_pk_bf16(v0[0], v0[1]); w.y = pg8::cvt_pk_bf16(v0[2], v0[3]); w.z = pg8::cvt_pk_bf16(v1[0], v1[1]); w.w = pg8::cvt_pk_bf16(v1[2], v1[3]);
                    *(u32x4*)(rowp + bj * 128) = w;
                }
            }
    }
};
struct EpiRes {
    static constexpr bool PERM = false;
    const float* xin; float* out;
    __device__ __forceinline__ void operator()(const f32x4 (&acc)[2][2][4][2], const pg8::Unit& u, int wr, int wc, int fr, int fq) const {
        const int row0 = u.arow0 + wr * 64 + fr, col0 = u.pn * 256 + wc * 32 + 4 * fq;
#pragma unroll
        for (int ai = 0; ai < 2; ++ai)
#pragma unroll
            for (int m = 0; m < 4; ++m) {
                const size_t off = (size_t)(row0 + ai * 128 + m * 16) * DM + col0;
#pragma unroll
                for (int bj = 0; bj < 2; ++bj)
#pragma unroll
                    for (int n = 0; n < 2; ++n) {
                        const f32x4 xv = *(const f32x4*)(xin + off + bj * 128 + n * 16);
                        *(f32x4*)(out + off + bj * 128 + n * 16) = xv * ALPHA + acc[ai][bj][m][n];
                    }
            }
    }
};

template <class RM>
__device__ __forceinline__ void transpose_item(const float* W, int K, int N, bf16_t* WT, RM rowmap, float* scr, int kb, int nb, int lane) {
    const int k0 = 64 * kb, n0 = 32 * nb;
    const int nn = n0 + (lane & 31);
#pragma unroll 8
    for (int i = 0; i < 32; ++i) {
        const int kk = 2 * i + (lane >> 5);
        scr[kk * 33 + (lane & 31)] = nn < N ? W[(size_t)(k0 + kk) * N + nn] : 0.f;
    }
    wave_sync();
    const int c = lane & 7;
#pragma unroll
    for (int j = 0; j < 4; ++j) {
        const int n = (lane >> 3) + 8 * j;
        const float* s = scr + (8 * c) * 33 + n;
        u32x4 o; o.x = pk2(s[0 * 33], s[1 * 33]); o.y = pk2(s[2 * 33], s[3 * 33]); o.z = pk2(s[4 * 33], s[5 * 33]); o.w = pk2(s[6 * 33], s[7 * 33]);
        const int dr = (n0 + n < N) ? rowmap(n0 + n) : -1;
        if (dr >= 0) *(u32x4*)(WT + (size_t)dr * K + k0 + 8 * c) = o;
    }
    wave_sync();
}

__device__ void phase_prologue(KA ka, int layer, float* smem) {
    PHASE_IDS
    const int lane = TID & 63, w = TID >> 6;
    float* scr = smem + w * 4096;
    const int gw = BID * NW + w, NGW = gridDim.x * NW;
    constexpr int I_IN = 16 * 89, I_OUT = 16 * 32, I_GU = 16 * 16, I_DN = 8 * 32;
    constexpr int I_LAYER = I_IN + I_OUT + 32 * I_GU + 16 * I_DN;
    for (int it = gw; it < I_LAYER; it += NGW) {
        int r = it;
        bf16_t* WT = PF(WT);
        if (r < I_IN) {
            transpose_item(PF(w_in) + (size_t)layer * DM * IC_SRC, DM, IC_SRC, WT + WT_IN,
                           [](int n) { return n < 1792 ? n : (n < 1816 ? 2816 + (n - 1792) : n - 24); }, scr, r / 89, r % 89, lane);
            continue;
        }
        r -= I_IN;
        if (r < I_OUT) {
            transpose_item(PF(w_out) + (size_t)layer * DM * DM, DM, DM, WT + WT_OUT, [](int n) { return n; }, scr, r / 32, r % 32, lane);
            continue;
        }
        r -= I_OUT;
        if (r < 32 * I_GU) {
            const int mat = r / I_GU, rr = r % I_GU, e = mat >> 1, isup = mat & 1;
            const float* W = (isup ? PF(w_up) : PF(w_gate)) + ((size_t)layer * 16 + e) * DM * 512;
            transpose_item(W, DM, 512, WT + WT_UP + (size_t)e * 1024 * 1024,
                           [isup](int n) { return (n >> 7) * 256 + isup * 128 + (n & 127); }, scr, rr / 16, rr % 16, lane);
            continue;
        }
        r -= 32 * I_GU;
        {
            const int e = r / I_DN, rr = r % I_DN;
            transpose_item(PF(w_down) + ((size_t)layer * 16 + e) * 512 * DM, 512, DM, WT + WT_DN + (size_t)e * 1024 * 512,
                           [](int n) { return n; }, scr, rr / 32, rr % 32, lane);
        }
    }
    for (int i = BID * NTHR + TID; i < 232 * 128; i += gridDim.x * NTHR) {
        const int q = i;
        u32x4 z; z.x = 0u; z.y = 0u; z.z = 0u; z.w = 0u;
        *(u32x4*)(PF(WT) + WT_IN + (size_t)2840 * 1024 + (size_t)q * 8) = z;
    }
    if (layer == 0)
    for (int row = gw; row < NTOK; row += NGW) {
        const f32x4* xr = (const f32x4*)(PF(x) + (size_t)row * DM) + lane;
        u32x2* o = (u32x2*)(PF(XB) + (size_t)row * DM) + lane;
#pragma unroll
        for (int j = 0; j < 4; ++j) {
            const f32x4 v = xr[64 * j];
            u32x2 ww; ww.x = pk2(v[0], v[1]); ww.y = pk2(v[2], v[3]);
            o[64 * j] = ww;
        }
    }
}

template <class AF, class BF, class EF>
__device__ __forceinline__ void gemm128(int tid, int m0, int n0, int M, int N, int K, AF af, BF bf, EF ef, float* smem) {
    float* As = smem;
    float* Bs = smem + 16 * 132;
    const bool active = tid < 256;
    const int tx = tid & 15, ty = (tid >> 4) & 15;
    float acc[8][8];
#pragma unroll
    for (int i = 0; i < 8; i++)
#pragma unroll
        for (int j = 0; j < 8; j++) acc[i][j] = 0.f;
#pragma unroll 1
    for (int k0 = 0; k0 < K; k0 += 16) {
        if (active) {
#pragma unroll
            for (int i = 0; i < 8; i++) {
                int e = tid + i * 256;
                int r = e >> 4, kk = e & 15;
                float v = 0.f;
                if (m0 + r < M) v = af(m0 + r, k0 + kk);
                As[kk * 132 + r] = v;
            }
#pragma unroll
            for (int i = 0; i < 8; i++) {
                int e = tid + i * 256;
                int kk = e >> 7, c = e & 127;
                float v = 0.f;
                if (n0 + c < N) v = bf(k0 + kk, n0 + c);
                Bs[kk * 132 + c] = v;
            }
        }
        __syncthreads();
        if (active) {
#pragma unroll 2
            for (int kk = 0; kk < 16; kk++) {
                asm volatile("" ::: "memory");
                float4 a0 = *(const float4*)&As[kk * 132 + ty * 8];
                float4 a1 = *(const float4*)&As[kk * 132 + ty * 8 + 4];
                float4 b0 = *(const float4*)&Bs[kk * 132 + tx * 8];
                float4 b1 = *(const float4*)&Bs[kk * 132 + tx * 8 + 4];
                float a[8] = {a0.x, a0.y, a0.z, a0.w, a1.x, a1.y, a1.z, a1.w};
                float b[8] = {b0.x, b0.y, b0.z, b0.w, b1.x, b1.y, b1.z, b1.w};
#pragma unroll
                for (int i = 0; i < 8; i++)
#pragma unroll
                    for (int j = 0; j < 8; j++) acc[i][j] = fmaf(a[i], b[j], acc[i][j]);
            }
        }
        __syncthreads();
    }
    if (active) {
#pragma unroll
        for (int i = 0; i < 8; i++)
#pragma unroll
            for (int j = 0; j < 8; j++) {
                int m = m0 + ty * 8 + i, n = n0 + tx * 8 + j;
                if (m < M && n < N) ef(m, n, acc[i][j]);
            }
    }
}

__device__ __forceinline__ void phase_inproj(KA ka, int layer, LAS unsigned char* lds) {
    pg8::DenseOrder S; S.init(NTOK, HLD, DM, PF(WT) + WT_IN, gridDim.x, opaque_bid());
    EpiH E{PF(H)};
    pg8::gemm_phase<EpiH, pg8::DenseOrder>(lds, (const char*)PF(XB), DM, S, E);
}
__device__ __forceinline__ void phase_outproj(KA ka, int layer, const float* xin, float* x1, LAS unsigned char* lds) {
    pg8::DenseOrder S; S.init(NTOK, DM, DM, PF(WT) + WT_OUT, gridDim.x, opaque_bid());
    EpiRes E{xin, x1};
    pg8::gemm_phase<EpiRes, pg8::DenseOrder>(lds, (const char*)PF(Y), DM, S, E);
}

__device__ void phase_gmlp(KA ka, int layer, float* smem) {
    PHASE_IDS
    float* V = smem;
    const int tid = TID, lane = tid & 63, w = tid >> 6;
    const float* gain = PF(gm_v_gain) + layer * 256;
    const float* bias = PF(gm_v_bias) + layer * 256;
    const float* ws = PF(gm_w_s) + (size_t)layer * 4 * 128 * 128;
    const float* bs = PF(gm_b_s) + layer * 4 * 128;
    const bf16_t* H = PF(H);
    for (int item = BID; item < 512; item += gridDim.x) {
        int g = item & 3, c = (item >> 2) & 63, b = item >> 8;
        size_t tok0 = (size_t)b * T_ + (size_t)c * 128;
        __syncthreads();
        for (int i = 0; i < 16; i++) {
            int s = w * 16 + i;
            float x = bf2f(H[(tok0 + s) * HLD + C_GV + g * 64 + lane]);
            float ge = gelu_t(x);
            float mu = wave_sum(ge) * (1.f / 64.f);
            float dl = ge - mu;
            float var = wave_sum(dl * dl) * (1.f / 64.f);
            V[s * 64 + lane] = dl * rsqrtf(var + 1e-5f) * gain[g * 64 + lane] + bias[g * 64 + lane];
        }
        __syncthreads();
        for (int i = 0; i < 16; i++) {
            int t = w + 8 * i;
            const float* wr = ws + ((size_t)g * 128 + t) * 128;
            float acc = 0.f;
            for (int s = 0; s <= t; s++) acc = fmaf(wr[s], V[s * 64 + lane], acc);
            acc += bs[g * 128 + t];
            float u = gelu_t(bf2f(H[(tok0 + t) * HLD + C_GU + g * 64 + lane]));
            PF(Y)[(tok0 + t) * DM + g * 64 + lane] = f2bf(u * acc);
        }
    }
}

__device__ void phase_compress(KA ka, int layer, float* smem) {
    PHASE_IDS
    const bf16_t* H = PF(H);
    for (int item = BID; item < 32; item += gridDim.x) {
        int which = item >> 4, mt = item & 15;
        const float* pos = PF(cmp_pos) + ((size_t)layer * 2 + which) * 32 * 64;
        const float* w1 = PF(cmp_w1) + ((size_t)layer * 2 + which) * 2048 * 128;
        const float* w2 = PF(cmp_w2) + ((size_t)layer * 2 + which) * 128 * 64;
        float* G = PF(gbuf) + (size_t)which * 2044 * 128;
        bf16_t* kcb = PF(kcb); bf16_t* vcT = PF(vcT);
        const int colbase = (which == 0 ? C_KC : C_VC);
        gemm128(TID, mt * 128, 0, 2044, 128, 2048,
                [&](int r, int k) {
                    int n = r % NCMP, bh = r / NCMP;
                    int hk = bh & 1, b = bh >> 1;
                    int l = k >> 6, d = k & 63;
                    size_t tok = (size_t)b * T_ + n * 16 + l;
                    return bf2f(H[tok * HLD + colbase + hk * 64 + d]) + pos[l * 64 + d];
                },
                [&](int k, int n) { return w1[(size_t)k * 128 + n]; },
                [&](int r, int n, float v) { G[(size_t)r * 128 + n] = gelu_t(v); }, smem);
        __threadfence_block();
        __syncthreads();
        gemm128(TID, mt * 128, 0, 2044, 64, 128,
                [&](int r, int k) { return G[(size_t)r * 128 + k]; },
                [&](int k, int n) { return w2[(size_t)k * 64 + n]; },
                [&](int r, int n, float v) {
                    const int bh = r / NCMP, nn = r % NCMP;
                    if (which == 0) kcb[((size_t)bh * 512 + nn) * 64 + n] = f2bf(v); else vcT[((size_t)bh * 64 + n) * 512 + nn] = f2bf(v);
                }, smem);
    }
}

__device__ void phase_headnorm(KA ka, int layer) {
    PHASE_IDS
    const int lane = TID & 63, w = TID >> 6;
    const float* og = PF(out_gain) + layer * 1024;
    for (int row = BID * NW + w; row < NTOK; row += gridDim.x * NW) {
#pragma unroll
        for (int hd = 0; hd < 12; hd++) {
            float v = bf2f(PF(Y)[(size_t)row * DM + hd * 64 + lane]);
            float ms = wave_sum(v * v) * (1.f / 64.f);
            float y = v * rsqrtf(ms + 1e-6f) * og[hd * 64 + lane];
            if (hd >= 12) {
                float hg = bf2f(PF(H)[(size_t)row * HLD + C_HG + (hd - 12) * 64 + lane]);
                y *= hg * sigmoidf_(hg);
            }
            PF(Y)[(size_t)row * DM + hd * 64 + lane] = f2bf(y);
        }
    }
}

__device__ void phase_ln1_route(KA ka, int layer, float* x1) {
    PHASE_IDS
    bf16_t* xb = PF(XB);
    const int lane = TID & 63, w = TID >> 6;
    const float* g = PF(ln1_g) + layer * 1024;
    const float* bb = PF(ln1_b) + layer * 1024;
    const float* wg = PF(rg_w) + (size_t)layer * 1024 * 4;
    const float* we = PF(re_w) + (size_t)layer * 1024 * 16;
    const float* bg = PF(rg_b) + layer * 4;
    const float* be = PF(re_b) + layer * 16;
    int* cnt = (int*)(PF(ctl) + CW_CNT) + layer * 16;
    for (int row = BID * NW + w; row < NTOK; row += gridDim.x * NW) {
        float v[16];
        float s = 0.f;
#pragma unroll
        for (int i = 0; i < 16; i++) { v[i] = x1[(size_t)row * DM + i * 64 + lane]; s += v[i]; }
        float mu = wave_sum(s) * (1.f / 1024.f);
        float q = 0.f;
#pragma unroll
        for (int i = 0; i < 16; i++) { float d = v[i] - mu; q += d * d; }
        float rstd = rsqrtf(wave_sum(q) * (1.f / 1024.f) + 1e-5f);
        float lg[4] = {0.f, 0.f, 0.f, 0.f};
        float le[16];
#pragma unroll
        for (int e = 0; e < 16; e++) le[e] = 0.f;
#pragma unroll
        for (int i = 0; i < 16; i++) {
            int c = i * 64 + lane;
            float o = (v[i] - mu) * rstd * g[c] + bb[c];
            x1[(size_t)row * DM + c] = o;
            xb[(size_t)row * DM + c] = f2bf(o);
            float4 w4 = *(const float4*)&wg[c * 4];
            lg[0] = fmaf(o, w4.x, lg[0]); lg[1] = fmaf(o, w4.y, lg[1]);
            lg[2] = fmaf(o, w4.z, lg[2]); lg[3] = fmaf(o, w4.w, lg[3]);
#pragma unroll
            for (int e4 = 0; e4 < 4; e4++) {
                float4 x4 = *(const float4*)&we[c * 16 + e4 * 4];
                le[e4 * 4 + 0] = fmaf(o, x4.x, le[e4 * 4 + 0]);
                le[e4 * 4 + 1] = fmaf(o, x4.y, le[e4 * 4 + 1]);
                le[e4 * 4 + 2] = fmaf(o, x4.z, le[e4 * 4 + 2]);
                le[e4 * 4 + 3] = fmaf(o, x4.w, le[e4 * 4 + 3]);
            }
        }
#pragma unroll
        for (int c = 0; c < 4; c++) lg[c] = wave_sum(lg[c]) + bg[c];
#pragma unroll
        for (int e = 0; e < 16; e++) le[e] = wave_sum(le[e]) + be[e];
        float gm = fmaxf(fmaxf(lg[0], lg[1]), fmaxf(lg[2], lg[3]));
        float ge[4], gs = 0.f;
#pragma unroll
        for (int c = 0; c < 4; c++) { ge[c] = __expf(lg[c] - gm); gs += ge[c]; }
        int gi = 0; float gbest = ge[0];
#pragma unroll
        for (int c = 1; c < 4; c++) if (ge[c] > gbest) { gbest = ge[c]; gi = c; }
        float gval = gbest / gs;
        float ls[4];
#pragma unroll
        for (int e = 0; e < 4; e++) ls[e] = gi == 0 ? le[e] : gi == 1 ? le[4 + e] : gi == 2 ? le[8 + e] : le[12 + e];
        float em = fmaxf(fmaxf(ls[0], ls[1]), fmaxf(ls[2], ls[3]));
        float pe[4];
#pragma unroll
        for (int e = 0; e < 4; e++) pe[e] = __expf(ls[e] - em);
        int i1 = 0; float b1 = pe[0];
#pragma unroll
        for (int e = 1; e < 4; e++) if (pe[e] > b1) { b1 = pe[e]; i1 = e; }
        int i2 = -1; float b2 = -1.f;
#pragma unroll
        for (int e = 0; e < 4; e++) if (e != i1 && pe[e] > b2) { b2 = pe[e]; i2 = e; }
        float w1 = gval * b1 / (b1 + b2), w2 = gval * b2 / (b1 + b2);
        if (lane == 0) {
            int e1 = gi * 4 + i1, e2 = gi * 4 + i2;
            int p1 = atomicAdd(&cnt[e1], 1);
            PF(list_tok)[e1 * NTOK + p1] = row; PF(list_w)[e1 * NTOK + p1] = w1;
            int p2 = atomicAdd(&cnt[e2], 1);
            PF(list_tok)[e2 * NTOK + p2] = row; PF(list_w)[e2 * NTOK + p2] = w2;
            PF(tok_slot)[row * 2 + 0] = e1 * NTOK + p1; PF(tok_slot)[row * 2 + 1] = e2 * NTOK + p2;
        }
    }
}


template <bool GATHER_>
struct MoeOrder {
    static constexpr bool GATHER = GATHER_;
    const LAS int* tab; const LAS int* rowtab;
    const char* Bt; unsigned estride; int K, G, c;
    __device__ __forceinline__ bool next(int i, pg8::Unit& u) const {
        const int nwg = __builtin_amdgcn_readfirstlane(tab[48]) * 4;
        const int L = i * G + c; if (L >= nwg) return false;
        int wgid = L; { const int q = nwg / 8, r = nwg % 8, xcd = wgid % 8, off = wgid / 8; wgid = (xcd < r ? xcd * (q + 1) : r * (q + 1) + (xcd - r) * q) + off; }
        const int mg = wgid >> 2, nt = wgid & 3;
        int e = 0;
#pragma unroll
        for (int k = 1; k < 16; ++k) e = (__builtin_amdgcn_readfirstlane(tab[32 + k]) <= mg) ? k : e;
        const int mt = mg - __builtin_amdgcn_readfirstlane(tab[32 + e]);
        const int rem = __builtin_amdgcn_readfirstlane(tab[e]) - mt * 256;
        u.e = e; u.pm = mt; u.pn = nt; u.ui = i; u.nrows = rem < 256 ? rem : 256; u.arow0 = __builtin_amdgcn_readfirstlane(tab[16 + e]) + mt * 256;
        u.bptr = Bt + (size_t)e * estride + (size_t)nt * 256 * K * 2;
        return true;
    }
    __device__ __forceinline__ int arow(const pg8::Unit& u, int r) const { return GATHER_ ? rowtab[u.ui * 256 + r] : u.arow0 + r; }
};
__device__ __forceinline__ void moe_tables(KA ka, int layer, LAS unsigned char* lds, bool want_rows, int G, int c) {
    LAS int* tab = (LAS int*)(lds + LDS_MISC + 256);
    LAS int* rowtab = (LAS int*)(lds + LDS_MISC + 1024);
    const int tid = opaque_tid();
    const int* cnt = (const int*)(PF(ctl) + CW_CNT) + layer * 16;
    if (tid < 16) tab[tid] = __hip_atomic_load(&cnt[tid], __ATOMIC_RELAXED, __HIP_MEMORY_SCOPE_AGENT);
    __syncthreads();
    if (tid == 0) {
        int b = 0, m = 0;
        for (int e = 0; e < 16; ++e) { tab[16 + e] = b; tab[32 + e] = m; b += tab[e]; m += (tab[e] + 255) >> 8; }
        tab[48] = m;
    }
    __syncthreads();
    if (want_rows) {
        MoeOrder<true> S{tab, rowtab, nullptr, 0u, 1024, G, c};
        const int* lt = PF(list_tok);
        for (int i = 0; i < 4; ++i) {
            pg8::Unit u;
            if (!S.next(i, u)) break;
            if (tid < 256) { const int r = tid < u.nrows ? tid : u.nrows - 1; rowtab[i * 256 + tid] = lt[u.e * NTOK + u.pm * 256 + r]; }
        }
        asm volatile("s_waitcnt vmcnt(0) lgkmcnt(0)" ::: "memory");
        __syncthreads();
    }
}
struct EpiUp {
    static constexpr bool PERM = true;
    bf16_t* hidden;
    __device__ __forceinline__ void operator()(const f32x4 (&acc)[2][2][4][2], const pg8::Unit& u, int wr, int wc, int fr, int fq) const {
#pragma unroll
        for (int ai = 0; ai < 2; ++ai)
#pragma unroll
            for (int m = 0; m < 4; ++m) {
                const int r = ai * 128 + wr * 64 + m * 16 + fr;
                if (r < u.nrows) {
                    bf16_t* rowp = hidden + (size_t)(u.arow0 + r) * 512 + u.pn * 128 + wc * 32 + 8 * fq;
                    float h[8];
#pragma unroll
                    for (int n = 0; n < 2; ++n)
#pragma unroll
                        for (int j = 0; j < 4; ++j) { const float g = acc[ai][0][m][n][j], uu = acc[ai][1][m][n][j]; h[n * 4 + j] = g * sigmoidf_(g) * uu; }
                    u32x4 w; w.x = pg8::cvt_pk_bf16(h[0], h[1]); w.y = pg8::cvt_pk_bf16(h[2], h[3]); w.z = pg8::cvt_pk_bf16(h[4], h[5]); w.w = pg8::cvt_pk_bf16(h[6], h[7]);
                    *(u32x4*)rowp = w;
                }
            }
    }
};
struct EpiDown {
    static constexpr bool PERM = true;
    bf16_t* Y2; const float* lw;
    __device__ __forceinline__ void operator()(const f32x4 (&acc)[2][2][4][2], const pg8::Unit& u, int wr, int wc, int fr, int fq) const {
#pragma unroll
        for (int ai = 0; ai < 2; ++ai)
#pragma unroll
            for (int m = 0; m < 4; ++m) {
                const int r = ai * 128 + wr * 64 + m * 16 + fr;
                if (r < u.nrows) {
                    const float wgt = lw[u.e * NTOK + u.pm * 256 + r];
                    bf16_t* rowp = Y2 + (size_t)(u.arow0 + r) * DM + u.pn * 256 + wc * 32 + 8 * fq;
#pragma unroll
                    for (int bj = 0; bj < 2; ++bj) {
                        const f32x4 v0 = acc[ai][bj][m][0] * wgt, v1 = acc[ai][bj][m][1] * wgt;
                        u32x4 w; w.x = pg8::cvt_pk_bf16(v0[0], v0[1]); w.y = pg8::cvt_pk_bf16(v0[2], v0[3]); w.z = pg8::cvt_pk_bf16(v1[0], v1[1]); w.w = pg8::cvt_pk_bf16(v1[2], v1[3]);
                        *(u32x4*)(rowp + bj * 128) = w;
                    }
                }
            }
    }
};
__device__ __forceinline__ void phase_moe_up(KA ka, int layer, LAS unsigned char* lds) {
    moe_tables(ka, layer, lds, true, gridDim.x, opaque_bid());
    MoeOrder<true> S{(const LAS int*)(lds + LDS_MISC + 256), (const LAS int*)(lds + LDS_MISC + 1024),
                     (const char*)(PF(WT) + WT_UP), (unsigned)(1024u * 1024u * 2u), 1024, (int)gridDim.x, opaque_bid()};
    EpiUp E{PF(Y)};
    pg8::gemm_phase<EpiUp, MoeOrder<true>>(lds, (const char*)PF(XB), 1024, S, E);
}
__device__ __forceinline__ void phase_moe_down(KA ka, int layer, LAS unsigned char* lds) {
    moe_tables(ka, layer, lds, false, gridDim.x, opaque_bid());
    MoeOrder<false> S{(const LAS int*)(lds + LDS_MISC + 256), (const LAS int*)(lds + LDS_MISC + 1024),
                      (const char*)(PF(WT) + WT_DN), (unsigned)(1024u * 512u * 2u), 512, (int)gridDim.x, opaque_bid()};
    EpiDown E{PF(H), PF(list_w)};
    pg8::gemm_phase<EpiDown, MoeOrder<false>>(lds, (const char*)PF(Y), 512, S, E);
}

__device__ void phase_ln2(KA ka, int layer, const float* x1, float* xo) {
    PHASE_IDS
    bf16_t* xb = PF(XB);
    const bf16_t* Y2 = PF(H);
    const int lane = TID & 63, w = TID >> 6;
    const float* g = PF(ln2_g) + layer * 1024;
    const float* bb = PF(ln2_b) + layer * 1024;
    const int* cnt = (const int*)(PF(ctl) + CW_CNT) + layer * 16;
    int mybase = 0;
    {
        int cv = lane < 16 ? __hip_atomic_load(&cnt[lane & 15], __ATOMIC_RELAXED, __HIP_MEMORY_SCOPE_AGENT) : 0;
        int incl = cv;
#pragma unroll
        for (int o = 1; o < 16; o <<= 1) { int t = __shfl_up(incl, o); if ((lane & 15) >= o) incl += t; }
        mybase = incl - cv;
    }
    for (int row = BID * NW + w; row < NTOK; row += gridDim.x * NW) {
        const int ts1 = PF(tok_slot)[row * 2 + 0], ts2 = PF(tok_slot)[row * 2 + 1];
        const int s1 = __shfl(mybase, ts1 >> 14) + (ts1 & (NTOK - 1)), s2 = __shfl(mybase, ts2 >> 14) + (ts2 & (NTOK - 1));
        float v[16];
        float s = 0.f;
#pragma unroll
        for (int i = 0; i < 16; i++) {
            const int c = i * 64 + lane;
            v[i] = ALPHA * x1[(size_t)row * DM + c] + bf2f(Y2[(size_t)s1 * DM + c]) + bf2f(Y2[(size_t)s2 * DM + c]);
            s += v[i];
        }
        float mu = wave_sum(s) * (1.f / 1024.f);
        float q = 0.f;
#pragma unroll
        for (int i = 0; i < 16; i++) { float d = v[i] - mu; q += d * d; }
        float rstd = rsqrtf(wave_sum(q) * (1.f / 1024.f) + 1e-5f);
#pragma unroll
        for (int i = 0; i < 16; i++) {
            int c = i * 64 + lane;
            const float o = (v[i] - mu) * rstd * g[c] + bb[c];
            xo[(size_t)row * DM + c] = o;
            xb[(size_t)row * DM + c] = f2bf(o);
        }
    }
}

#define MFMA16(a, b, c) __builtin_amdgcn_mfma_f32_16x16x32_bf16((a), (b), (c), 0, 0, 0)
constexpr int NSA_KT = 0, NSA_VT = 16384, NSA_IMP = 32768, NSA_FIN = 65536, NSA_SEL = LDS_MISC + 8192;

__device__ __forceinline__ int tile_off(int r, int c) { return r * 128 + ((c ^ ((r >> 1) & 7)) << 4); }

struct SelMask { unsigned a, b, c, d; };
__device__ __forceinline__ unsigned selbit(unsigned a, unsigned b, unsigned c, unsigned d, int j) {
    const int k = j >> 5;
    const unsigned lo = (k & 1) ? b : a, hi = (k & 1) ? d : c;
    const unsigned r = (k & 2) ? hi : lo;
    return (r >> (j & 31)) & 1u;
}

struct NsaRT {
    bf16x8 q[2];
    f32x4 o[4];
    float m, l;
    int tk;
};

template <int MODE>
__device__ __forceinline__ void nsa_loop(LAS unsigned char* lds, int tid, int lane, int w, int jb, int je,
                                         const char* ksrc, size_t kstride, size_t ktile, const char* vsrc, size_t vstride, size_t vtile,
                                         NsaRT (&R)[2], const SelMask selm0, const SelMask selm1, float (&carry)[2], float* impw) {
    const int g = lane >> 4, qr = lane & 15;
    int tid2 = tid; asm volatile("" : "+v"(tid2));
    const int sr = tid2 >> 3, sc = tid2 & 7;
    const int soff = tile_off(sr, sc);
    const int fxq = (qr >> 1) & 7;
    const int ka0 = qr * 128 + ((g ^ fxq) << 4), ka1 = qr * 128 + (((4 + g) ^ fxq) << 4);
    const int vb = qr * 128 + (g & 1) * 8, vc = (g >> 1) ^ fxq;
    const int va0 = vb + (vc << 4), va1 = vb + ((vc ^ 2) << 4), va2 = vb + ((vc ^ 4) << 4), va3 = vb + ((vc ^ 6) << 4);
    if (jb > je) return;
    u32x4 kreg, vreg;
    kreg = *(const u32x4*)(ksrc + (size_t)jb * ktile + (size_t)sr * kstride + sc * 16);
    if (MODE != 0) vreg = *(const u32x4*)(vsrc + (size_t)jb * vtile + (size_t)sr * vstride + sc * 16);
    *(LAS u32x4*)(lds + NSA_KT + soff) = kreg;
    if (MODE != 0) *(LAS u32x4*)(lds + NSA_VT + soff) = vreg;
    __syncthreads();
    for (int j = jb; j <= je; ++j) {
        const int cur = (j - jb) & 1;
        if (j < je) {
            kreg = *(const u32x4*)(ksrc + (size_t)(j + 1) * ktile + (size_t)sr * kstride + sc * 16);
            if (MODE != 0) vreg = *(const u32x4*)(vsrc + (size_t)(j + 1) * vtile + (size_t)sr * vstride + sc * 16);
        }
        const LAS unsigned char* kt = lds + NSA_KT + cur * 8192;
        const LAS unsigned char* vt = lds + NSA_VT + cur * 8192;
        bool act[2];
#pragma unroll
        for (int rt = 0; rt < 2; ++rt) {
            const int tk = R[rt].tk;
            bool a;
            if (MODE <= 1) { const int nv = tk >= 31 ? ((tk - 31) >> 4) + 1 : 0; a = nv > 64 * j; }
            else if (MODE == 2) a = (rt == 0 ? selbit(selm0.a, selm0.b, selm0.c, selm0.d, j) : selbit(selm1.a, selm1.b, selm1.c, selm1.d, j)) != 0u;
            else a = (64 * j <= tk) && (64 * j + 63 > tk - 512);
            act[rt] = __any(a);
        }
        if (act[0] || act[1]) {
#pragma unroll
            for (int rt = 0; rt < 2; ++rt) {
                if (!act[rt]) continue;
                NsaRT& r = R[rt];
                const int tk = r.tk;
                f32x4 s[4];
#pragma unroll
                for (int t = 0; t < 4; ++t) {
                    const bf16x8 k0 = *(const LAS bf16x8*)(kt + ka0 + t * 2048), k1 = *(const LAS bf16x8*)(kt + ka1 + t * 2048);
                    s[t] = (f32x4){0.f, 0.f, 0.f, 0.f};
                    s[t] = MFMA16(k0, r.q[0], s[t]);
                    s[t] = MFMA16(k1, r.q[1], s[t]);
                }
                int lim_hi, lim_lo;
                if (MODE <= 1) { const int nv = tk >= 31 ? ((tk - 31) >> 4) + 1 : 0; lim_hi = nv - 1; lim_lo = -1; }
                else if (MODE == 2) { lim_hi = ((rt == 0 ? selbit(selm0.a, selm0.b, selm0.c, selm0.d, j) : selbit(selm1.a, selm1.b, selm1.c, selm1.d, j)) != 0u) ? tk : -1; lim_lo = -1; }
                else { lim_hi = tk; lim_lo = tk - 512; }
                const int kb = 64 * j + 4 * g;
                if (MODE == 1) {
                    const float mrow = r.m, invl = r.l > 0.f ? 1.f / r.l : 0.f;
                    float p[4][4];
#pragma unroll
                    for (int t = 0; t < 4; ++t)
#pragma unroll
                        for (int i = 0; i < 4; ++i) { const int key = kb + 16 * t + i; p[t][i] = (key <= lim_hi) ? __expf(s[t][i] - mrow) * invl : 0.f; }
#pragma unroll
                    for (int t = 0; t < 4; ++t) {
                        const float own = (p[t][0] + p[t][1]) + (p[t][2] + p[t][3]);
                        const float x3 = p[t][3];
                        const float up_cur = __shfl(x3, (lane + 48) & 63);
                        const float up_prev = __shfl(carry[rt], (lane + 48) & 63);
                        float v = own + (g >= 1 ? up_cur : up_prev);
                        v += __shfl_xor(v, 1);
                        v += __shfl_xor(v, 2);
                        carry[rt] = x3;
                        if ((qr & 3) == 0) impw[(4 * rt + (qr >> 2)) * 128 + 16 * j + 4 * t + g] = v;
                    }
#pragma unroll
                    for (int ks = 0; ks < 2; ++ks) {
                        bf16x8 pf;
                        const unsigned a0 = pk2(p[2 * ks][0], p[2 * ks][1]), a1 = pk2(p[2 * ks][2], p[2 * ks][3]);
                        const unsigned a2 = pk2(p[2 * ks + 1][0], p[2 * ks + 1][1]), a3 = pk2(p[2 * ks + 1][2], p[2 * ks + 1][3]);
                        u32x4 pu; pu.x = a0; pu.y = a1; pu.z = a2; pu.w = a3;
                        pf = __builtin_bit_cast(bf16x8, pu);
#pragma unroll
                        for (int dt = 0; dt < 4; ++dt) {
                            const u32x2 lo = *(const LAS u32x2*)(vt + (ks ? va2 : va0) + dt * 2048);
                            const u32x2 hi = *(const LAS u32x2*)(vt + (ks ? va3 : va1) + dt * 2048);
                            u32x4 vu; vu.x = lo.x; vu.y = lo.y; vu.z = hi.x; vu.w = hi.y;
                            r.o[dt] = MFMA16(__builtin_bit_cast(bf16x8, vu), pf, r.o[dt]);
                        }
                    }
                } else {
                    float mx = NEG_INF;
#pragma unroll
                    for (int t = 0; t < 4; ++t)
#pragma unroll
                        for (int i = 0; i < 4; ++i) {
                            const int key = kb + 16 * t + i;
                            const bool ok = (key <= lim_hi) && (key > lim_lo);
                            s[t][i] = ok ? s[t][i] : NEG_INF;
                            mx = fmaxf(mx, s[t][i]);
                        }
                    mx = fmaxf(mx, __shfl_xor(mx, 16));
                    mx = fmaxf(mx, __shfl_xor(mx, 32));
                    const float mn = fmaxf(r.m, mx);
                    const float alpha = __expf(r.m - mn);
                    float p[4][4];
                    float rs = 0.f;
#pragma unroll
                    for (int t = 0; t < 4; ++t)
#pragma unroll
                        for (int i = 0; i < 4; ++i) { p[t][i] = (s[t][i] > 0.5f * NEG_INF) ? __expf(s[t][i] - mn) : 0.f; rs += p[t][i]; }
                    rs += __shfl_xor(rs, 16);
                    rs += __shfl_xor(rs, 32);
                    r.l = r.l * alpha + rs;
                    r.m = mn;
                    if (MODE != 0) {
#pragma unroll
                        for (int dt = 0; dt < 4; ++dt) r.o[dt] = r.o[dt] * alpha;
#pragma unroll
                        for (int ks = 0; ks < 2; ++ks) {
                            const unsigned a0 = pk2(p[2 * ks][0], p[2 * ks][1]), a1 = pk2(p[2 * ks][2], p[2 * ks][3]);
                            const unsigned a2 = pk2(p[2 * ks + 1][0], p[2 * ks + 1][1]), a3 = pk2(p[2 * ks + 1][2], p[2 * ks + 1][3]);
                            u32x4 pu; pu.x = a0; pu.y = a1; pu.z = a2; pu.w = a3;
                            const bf16x8 pf = __builtin_bit_cast(bf16x8, pu);
#pragma unroll
                            for (int dt = 0; dt < 4; ++dt) {
                                const u32x2 lo = *(const LAS u32x2*)(vt + (ks ? va2 : va0) + dt * 2048);
                                const u32x2 hi = *(const LAS u32x2*)(vt + (ks ? va3 : va1) + dt * 2048);
                                u32x4 vu; vu.x = lo.x; vu.y = lo.y; vu.z = hi.x; vu.w = hi.y;
                                r.o[dt] = MFMA16(__builtin_bit_cast(bf16x8, vu), pf, r.o[dt]);
                            }
                        }
                    }
                }
            }
        }
        if (j < je) {
            *(LAS u32x4*)(lds + NSA_KT + (cur ^ 1) * 8192 + soff) = kreg;
            if (MODE != 0) *(LAS u32x4*)(lds + NSA_VT + (cur ^ 1) * 8192 + soff) = vreg;
        }
        __syncthreads();
    }
}

__device__ void phase_nsa2(KA ka, int layer, LAS unsigned char* lds) {
    PHASE_IDS
    const int tid = TID, lane = tid & 63, w = __builtin_amdgcn_readfirstlane(tid >> 6), g = lane >> 4, qr = lane & 15;
    const bf16_t* H = PF(H);
    const bf16_t* kcb = PF(kcb);
    const bf16_t* vcT = PF(vcT);
    const bf16_t* vsT = PF(vsT);
    const bf16_t* vwT = PF(vwT);
    bf16_t* Y = PF(Y);
    const float* gate_b = PF(nsa_gate_b) + layer * 24;
    float* impw = (float*)(lds + NSA_IMP + w * 4096);
    unsigned* selw = (unsigned*)(lds + NSA_SEL + w * 128);
    for (int base = BID; base < 256; base += gridDim.x) {
#pragma unroll 1
        for (int half = 0; half < 2; ++half) {
            const int it = half ? 511 - base : base;
            const int chunk = it >> 2, bh = it & 3, b = bh >> 1, hk = bh & 1;
            const size_t rowbase = (size_t)b * T_;
            const int t0w = chunk * 64 + w * 8;
            NsaRT R[2];
            LAS f32x4* finw = (LAS f32x4*)(lds + NSA_FIN + w * 8192) + lane;
#pragma unroll
            for (int rt = 0; rt < 2; ++rt) {
                const int tk = t0w + 4 * rt + (qr >> 2), hh = hk * 4 + (qr & 3);
                R[rt].tk = tk;
                const bf16_t* qp = H + (rowbase + tk) * HLD + C_NQ + hh * 64 + 8 * g;
#pragma unroll
                for (int ks = 0; ks < 2; ++ks) {
                    const u32x4 u = *(const u32x4*)(qp + 32 * ks);
                    const unsigned uu[4] = {u.x, u.y, u.z, u.w};
                    u32x4 o4;
#pragma unroll
                    for (int e = 0; e < 4; ++e) {
                        const float f0 = __uint_as_float(uu[e] << 16) * 0.125f, f1 = __uint_as_float(uu[e] & 0xffff0000u) * 0.125f;
                        o4[e] = (__float_as_uint(f0) >> 16) | (__float_as_uint(f1) & 0xffff0000u);
                    }
                    R[rt].q[ks] = __builtin_bit_cast(bf16x8, o4);
                }
                R[rt].m = NEG_INF; R[rt].l = 0.f;
#pragma unroll
                for (int dt = 0; dt < 4; ++dt) R[rt].o[dt] = (f32x4){0.f, 0.f, 0.f, 0.f};
            }
            SelMask selm0{0u, 0u, 0u, 0u}, selm1{0u, 0u, 0u, 0u};
            float carry[2] = {0.f, 0.f};
            const int tmax = chunk * 64 + 63;
            const int nvmax = tmax >= 31 ? ((tmax - 31) >> 4) + 1 : 0;
            const int nb = (nvmax + 63) >> 6;
            const char* kc_src = (const char*)(kcb + (size_t)bh * 512 * 64);
            const char* vc_src = (const char*)(vcT + (size_t)bh * 64 * 512);
            nsa_loop<0>(lds, tid, lane, w, 0, nb - 1, kc_src, 128, 64 * 128, nullptr, 0, 0, R, selm0, selm1, carry, impw);
            for (int i = lane; i < 8 * 128; i += 64) impw[i] = 0.f;
            wave_sync();
            nsa_loop<1>(lds, tid, lane, w, 0, nb - 1, kc_src, 128, 64 * 128, vc_src, 512 * 2, 64 * 2, R, selm0, selm1, carry, impw);
#pragma unroll
            for (int rt = 0; rt < 2; ++rt) {
                const int hh = hk * 4 + (qr & 3);
                const float gt = sigmoidf_(bf2f(H[(rowbase + R[rt].tk) * HLD + C_NG + hh * 3 + 0]) + gate_b[hh * 3 + 0]);
#pragma unroll
                for (int dt = 0; dt < 4; ++dt) { finw[(rt * 4 + dt) * 64] = R[rt].o[dt] * gt; R[rt].o[dt] = (f32x4){0.f, 0.f, 0.f, 0.f}; }
            }
            wave_sync();
            {
                const int tl = lane >> 3, sub = lane & 7;
                const int tks = t0w + tl, curb = tks >> 6;
                float v[16];
#pragma unroll
                for (int i = 0; i < 16; ++i) {
                    const int jj = sub * 16 + i;
                    const float a = impw[tl * 128 + jj];
                    const bool forced = (jj == 0) || (jj == curb) || (jj == curb - 1);
                    v[i] = (jj <= curb) ? (a + (forced ? 1e4f : 0.f)) : NEG_INF;
                }
                wave_sync();
#pragma unroll
                for (int i = 0; i < 16; ++i) impw[tl * 128 + sub * 16 + i] = v[i];
                wave_sync();
                int cnt[16];
#pragma unroll
                for (int i = 0; i < 16; ++i) cnt[i] = 0;
                for (int jj = 0; jj < 128; ++jj) {
                    const float x = impw[tl * 128 + jj];
#pragma unroll
                    for (int i = 0; i < 16; ++i) cnt[i] += (x > v[i]) || (x == v[i] && jj < sub * 16 + i);
                }
                unsigned bits = 0u;
#pragma unroll
                for (int i = 0; i < 16; ++i) bits |= ((cnt[i] < 16) && (v[i] > 0.5f * NEG_INF)) ? (1u << i) : 0u;
                const unsigned other = __shfl_xor(bits, 1);
                const unsigned word = (sub & 1) ? ((bits << 16) | other) : (bits | (other << 16));
                if ((sub & 1) == 0) selw[tl * 4 + (sub >> 1)] = word;
                wave_sync();
                { const unsigned* q0 = selw + (qr >> 2) * 4; selm0.a = q0[0]; selm0.b = q0[1]; selm0.c = q0[2]; selm0.d = q0[3];
                  selm1.a = q0[16]; selm1.b = q0[17]; selm1.c = q0[18]; selm1.d = q0[19]; }
                wave_sync();
            }
#pragma unroll
            for (int rt = 0; rt < 2; ++rt) { R[rt].m = NEG_INF; R[rt].l = 0.f; }
            nsa_loop<2>(lds, tid, lane, w, 0, chunk, (const char*)(H + rowbase * HLD + C_KS + hk * 64), (size_t)HLD * 2, (size_t)64 * HLD * 2,
                        (const char*)(vsT + (size_t)bh * 64 * T_), (size_t)T_ * 2, 64 * 2, R, selm0, selm1, carry, impw);
#pragma unroll
            for (int rt = 0; rt < 2; ++rt) {
                const int hh = hk * 4 + (qr & 3);
                const float gt = sigmoidf_(bf2f(H[(rowbase + R[rt].tk) * HLD + C_NG + hh * 3 + 1]) + gate_b[hh * 3 + 1]);
                const float sc = gt / R[rt].l;
#pragma unroll
                for (int dt = 0; dt < 4; ++dt) { finw[(rt * 4 + dt) * 64] += R[rt].o[dt] * sc; R[rt].o[dt] = (f32x4){0.f, 0.f, 0.f, 0.f}; }
                R[rt].m = NEG_INF; R[rt].l = 0.f;
            }
            nsa_loop<3>(lds, tid, lane, w, chunk >= 8 ? chunk - 8 : 0, chunk, (const char*)(H + rowbase * HLD + C_KW + hk * 64), (size_t)HLD * 2, (size_t)64 * HLD * 2,
                        (const char*)(vwT + (size_t)bh * 64 * T_), (size_t)T_ * 2, 64 * 2, R, selm0, selm1, carry, impw);
#pragma unroll
            for (int rt = 0; rt < 2; ++rt) {
                const int tk = R[rt].tk, hh = hk * 4 + (qr & 3);
                const float gt = sigmoidf_(bf2f(H[(rowbase + tk) * HLD + C_NG + hh * 3 + 2]) + gate_b[hh * 3 + 2]);
                const float sc = gt / R[rt].l;
                bf16_t* yp = Y + (rowbase + tk) * DM + 256 + hh * 64 + 4 * g;
#pragma unroll
                for (int dt = 0; dt < 4; ++dt) {
                    const f32x4 o = finw[(rt * 4 + dt) * 64] + R[rt].o[dt] * sc;
                    u32x2 wv; wv.x = pk2(o[0], o[1]); wv.y = pk2(o[2], o[3]);
                    *(u32x2*)(yp + 16 * dt) = wv;
                }
            }
        }
    }
}

__device__ void phase_vtrans(KA ka, float* smem) {
    PHASE_IDS
    const int lane = TID & 63, w = TID >> 6;
    bf16_t* scr = (bf16_t*)(smem + w * 4096);
    const bf16_t* H = PF(H);
    for (int it = BID * NW + w; it < 1024; it += gridDim.x * NW) {
        const int tt = it & 127, bh = (it >> 7) & 3, which = it >> 9;
        const int b = bh >> 1, hk = bh & 1;
        const size_t tok0 = (size_t)b * T_ + tt * 64;
        const int col = (which ? C_VW : C_VS) + hk * 64;
        bf16_t* dst = (which ? PF(vwT) : PF(vsT)) + (size_t)bh * 64 * T_ + tt * 64;
        wave_sync();
        for (int i = 0; i < 64; ++i) scr[lane * 66 + i] = H[(tok0 + i) * HLD + col + lane];
        wave_sync();
        for (int d = 0; d < 64; ++d) dst[(size_t)d * T_ + lane] = scr[d * 66 + lane];
    }
}

__device__ void phase_hgrnA(KA ka, int layer, float* smem) {
    PHASE_IDS
    const int tid = TID, lane = tid & 63, w = tid >> 6;
    float* Q = smem;
    float* K = smem + 4160;
    float* Bc = smem + 8320;
    float* AT = smem + 12480;
    float* I = smem + 16640;
    float* SEG = smem + 20736;
    const bf16_t* H = PF(H);
    const float* hgl = PF(hg_lower);
    float* hgU = PF(hgU); float* hgG = PF(hgG); bf16_t* hgQB = PF(hgQB); bf16_t* hgO = PF(hgO);
    for (int item = BID; item < 1024; item += gridDim.x) {
        const int c = item & 127, bh = item >> 7, h = bh & 3, b = bh >> 2;
        const size_t tok0 = (size_t)b * T_ + c * 64;
        __syncthreads();
#pragma unroll
        for (int i = 0; i < 8; ++i) {
            const int e = tid + i * NTHR, t = e >> 6, d = e & 63;
            float lb = 0.f;
            if (layer == 1) {
                const float h0 = hgl[h * 64 + d], h1 = hgl[256 + h * 64 + d];
                const float mx = fmaxf(h0, h1), e0 = expf(h0 - mx), e1 = expf(h1 - mx);
                lb = e1 / (e0 + e1);
            }
            const bf16_t* hp = H + (tok0 + t) * HLD + h * 64 + d;
            const float fl = bf2f(hp[C_HF]);
            const float sg = 1.f / (1.f + expf(-fl)), sgn = 1.f / (1.f + expf(fl));
            const float f = lb + (1.f - lb) * sg;
            Q[t * 65 + d] = bf2f(hp[C_HQ]);
            K[t * 65 + d] = (1.f - lb) * sgn;
            I[t * 64 + d] = bf2f(hp[C_HI]);
            Bc[t * 65 + d] = logf(fmaxf(f, 1e-38f));
        }
        __syncthreads();
        {
            const int d = lane, seg = w;
            float run = 0.f;
#pragma unroll
            for (int i = 0; i < 8; ++i) { run += Bc[(seg * 8 + i) * 65 + d]; Bc[(seg * 8 + i) * 65 + d] = run; }
            SEG[seg * 64 + d] = run;
            __syncthreads();
            float pre = 0.f;
            for (int s2 = 0; s2 < seg; ++s2) pre += SEG[s2 * 64 + d];
#pragma unroll
            for (int i = 0; i < 8; ++i) Bc[(seg * 8 + i) * 65 + d] += pre;
        }
        __syncthreads();
#pragma unroll 1
        for (int i = 0; i < 8; ++i) {
            const int t = w + 8 * i, s = lane;
            float acc = 0.f;
            if (s <= t) {
                for (int d = 0; d < 64; ++d) acc = fmaf(Q[t * 65 + d] * K[s * 65 + d], __expf(Bc[t * 65 + d] - Bc[s * 65 + d]), acc);
            }
            AT[t * 65 + s] = acc;
        }
        __syncthreads();
#pragma unroll 1
        for (int i = 0; i < 8; ++i) {
            const int t = w + 8 * i, v = lane;
            float acc = 0.f;
            for (int s = 0; s <= t; ++s) acc = fmaf(AT[t * 65 + s], I[s * 64 + v], acc);
            hgO[((size_t)item * 64 + t) * 64 + v] = f2bf(acc);
            hgQB[((size_t)item * 64 + t) * 64 + v] = f2bf(Q[t * 65 + v] * __expf(Bc[t * 65 + v]));
            K[t * 65 + v] *= __expf(Bc[63 * 65 + v] - Bc[t * 65 + v]);
        }
        if (tid < 64) hgG[(size_t)item * 64 + tid] = __expf(Bc[63 * 65 + tid]);
        __syncthreads();
#pragma unroll 1
        for (int i = 0; i < 8; ++i) {
            const int d = w + 8 * i, v = lane;
            float acc = 0.f;
            for (int s = 0; s < 64; ++s) acc = fmaf(K[s * 65 + d], I[s * 64 + v], acc);
            hgU[((size_t)item * 64 + d) * 64 + v] = acc;
        }
    }
}

__device__ void phase_hgrnB(KA ka) {
    PHASE_IDS
    const float* hgU = PF(hgU); const float* hgG = PF(hgG); float* hgS = PF(hgS);
    for (int gid = BID * NTHR + TID; gid < 32768; gid += gridDim.x * NTHR) {
        const int bh = gid >> 12, dv = gid & 4095, d = dv >> 6;
        float S = 0.f;
        for (int c0 = 0; c0 < 128; c0 += 8) {
            float u[8], gg[8];
#pragma unroll
            for (int k = 0; k < 8; ++k) { const size_t item = (size_t)bh * 128 + c0 + k; u[k] = hgU[item * 4096 + dv]; gg[k] = hgG[item * 64 + d]; }
#pragma unroll
            for (int k = 0; k < 8; ++k) { const size_t item = (size_t)bh * 128 + c0 + k; hgS[item * 4096 + dv] = S; S = fmaf(gg[k], S, u[k]); }
        }
    }
}

__device__ void phase_hgrnC(KA ka, int layer, float* smem) {
    PHASE_IDS
    const int tid = TID, lane = tid & 63, w = tid >> 6;
    float* QB = smem;
    float* S = smem + 4160;
    const bf16_t* H = PF(H);
    const float* hgS = PF(hgS); const bf16_t* hgQB = PF(hgQB); const bf16_t* hgO = PF(hgO);
    const float* og = PF(out_gain) + layer * 1024;
    bf16_t* Y = PF(Y);
    for (int item = BID; item < 1024; item += gridDim.x) {
        const int c = item & 127, bh = item >> 7, h = bh & 3, b = bh >> 2;
        const size_t tok0 = (size_t)b * T_ + c * 64;
        __syncthreads();
#pragma unroll
        for (int i = 0; i < 8; ++i) {
            const int e = tid + i * NTHR, r = e >> 6, cc = e & 63;
            QB[r * 65 + cc] = bf2f(hgQB[(size_t)item * 4096 + e]);
            S[e] = hgS[(size_t)item * 4096 + e];
        }
        __syncthreads();
#pragma unroll 1
        for (int i = 0; i < 8; ++i) {
            const int t = w + 8 * i, v = lane;
            float acc = bf2f(hgO[((size_t)item * 64 + t) * 64 + v]);
            for (int d = 0; d < 64; ++d) acc = fmaf(QB[t * 65 + d], S[d * 64 + v], acc);
            const float ms = wave_sum(acc * acc) * (1.f / 64.f);
            const float hg = bf2f(H[(tok0 + t) * HLD + C_HG + h * 64 + v]);
            const float y = acc * rsqrtf(ms + 1e-6f) * og[768 + h * 64 + v] * (hg * sigmoidf_(hg));
            Y[(tok0 + t) * DM + 768 + h * 64 + v] = f2bf(y);
        }
    }
}

#ifndef ONLY_Q
#define ONLY_Q -2
#endif
#ifndef QMASK
#define QMASK 0x3ff
#endif
#define QON(k) ((ONLY_Q == -2 && ((QMASK >> ((k) + 1)) & 1)) || ONLY_Q == (k))
#ifndef NPH_TOTAL
#define NPH_TOTAL 19
#endif
__global__ void __launch_bounds__(NTHR, 2) k_mega(P p0) {
    extern __shared__ __attribute__((aligned(16))) unsigned char lds_raw[];
    LAS unsigned char* lds = (LAS unsigned char*)lds_raw;
    float* smem = (float*)lds_raw;
    volatile LAS unsigned* misc = (volatile LAS unsigned*)(lds + LDS_MISC);
    if (threadIdx.x < 16) misc[threadIdx.x] = 0u;
    __syncthreads();
    XcdBarrier bar = xcd_barrier_post(p0.ctl + CW_BAR, misc);
#pragma unroll 1
    for (int ph = 0; ph < p0.nph; ph++) {
        const int layer = ph == 0 ? 0 : (ph - 1) / 9, q = ph == 0 ? -1 : (ph - 1) % 9;
#if defined(__HIP_DEVICE_COMPILE__)
        KA ka = (KA)__builtin_amdgcn_kernarg_segment_ptr();
        asm volatile("" : "+s"(ka));
#else
        KA ka = nullptr;
#endif
        const float* xin = layer == 0 ? PF(x) : PF(out);
        float* x1 = PF(out);
        if (q == -1 && QON(-1)) phase_prologue(ka, 0, smem);
        else if (q == 0 && QON(0)) phase_inproj(ka, layer, lds);
        else if (q == 1 && QON(1)) { phase_hgrnA(ka, layer, smem); __syncthreads(); phase_gmlp(ka, layer, smem); __syncthreads(); phase_compress(ka, layer, smem); __syncthreads(); phase_vtrans(ka, smem); }
        else if (q == 2 && QON(2)) { phase_hgrnB(ka); __syncthreads(); phase_nsa2(ka, layer, lds); }
        else if (q == 3 && QON(3)) { phase_hgrnC(ka, layer, smem); phase_headnorm(ka, layer); }
        else if (q == 4 && QON(4)) phase_outproj(ka, layer, xin, x1, lds);
        else if (q == 5 && QON(5)) phase_ln1_route(ka, layer, x1);
        else if (q == 6 && QON(6)) phase_moe_up(ka, layer, lds);
        else if (q == 7 && QON(7)) phase_moe_down(ka, layer, lds);
        else if (q == 8 && QON(8)) { phase_ln2(ka, layer, x1, PF(out)); if (layer == 0) { __syncthreads(); phase_prologue(ka, 1, smem); } }
        if (ph != NPH_TOTAL - 1) xcd_barrier(bar);
    }
}

static inline size_t align_up(size_t v, size_t a) { return (v + a - 1) / a * a; }

extern "C" void kernel_launch(void* const* d_in, const int* in_sizes, int n_in, void* d_out, int out_size, void* d_ws,
                              size_t ws_size, hipStream_t stream) {
    P p{};
    p.x = (const float*)d_in[0]; p.w_in = (const float*)d_in[1]; p.gm_v_gain = (const float*)d_in[2];
    p.gm_v_bias = (const float*)d_in[3]; p.gm_w_s = (const float*)d_in[4]; p.gm_b_s = (const float*)d_in[5];
    p.cmp_pos = (const float*)d_in[6]; p.cmp_w1 = (const float*)d_in[7]; p.cmp_w2 = (const float*)d_in[8];
    p.nsa_gate_b = (const float*)d_in[9]; p.hg_lower = (const float*)d_in[10]; p.out_gain = (const float*)d_in[11];
    p.w_out = (const float*)d_in[12]; p.ln1_g = (const float*)d_in[13]; p.ln1_b = (const float*)d_in[14];
    p.rg_w = (const float*)d_in[15]; p.rg_b = (const float*)d_in[16]; p.re_w = (const float*)d_in[17];
    p.re_b = (const float*)d_in[18]; p.w_gate = (const float*)d_in[19]; p.w_up = (const float*)d_in[20];
    p.w_down = (const float*)d_in[21]; p.ln2_g = (const float*)d_in[22]; p.ln2_b = (const float*)d_in[23];
    p.out = (float*)d_out;
    char* ws = (char*)d_ws;
    size_t off = 0;
    p.ctl = (unsigned*)(ws + off); off = align_up(off + CTL_BYTES, 256);
    p.WT = (bf16_t*)(ws + off); off = align_up(off + WT_LAYER * 2, 256);
    p.H = (bf16_t*)(ws + off); off = align_up(off + (size_t)NTOK * HLD * 2, 256);
    p.Y = (bf16_t*)(ws + off); off = align_up(off + (size_t)NTOK * DM * 2, 256);
    p.XB = (bf16_t*)(ws + off); off = align_up(off + (size_t)NTOK * DM * 2, 256);
    p.kcb = (bf16_t*)(ws + off); off = align_up(off + (size_t)4 * 512 * 64 * 2, 256);
    p.vcT = (bf16_t*)(ws + off); off = align_up(off + (size_t)4 * 64 * 512 * 2, 256);
    p.vsT = (bf16_t*)(ws + off); off = align_up(off + (size_t)4 * 64 * T_ * 2, 256);
    p.vwT = (bf16_t*)(ws + off); off = align_up(off + (size_t)4 * 64 * T_ * 2, 256);
    p.gbuf = (float*)(ws + off); off = align_up(off + (size_t)2 * 2044 * 128 * 4, 256);
    p.list_tok = (int*)(ws + off); off = align_up(off + (size_t)16 * NTOK * 4, 256);
    p.list_w = (float*)(ws + off); off = align_up(off + (size_t)16 * NTOK * 4, 256);
    p.tok_slot = (int*)(ws + off); off = align_up(off + (size_t)NTOK * 2 * 4, 256);
    p.hgU = (float*)p.XB; p.hgS = p.hgU + (size_t)1024 * 4096;
    p.hgG = (float*)(ws + off); off = align_up(off + (size_t)1024 * 64 * 4, 256);
    p.hgQB = (bf16_t*)(ws + off); off = align_up(off + (size_t)1024 * 4096 * 2, 256);
    p.hgO = (bf16_t*)(ws + off); off = align_up(off + (size_t)1024 * 4096 * 2, 256);
    p.nph = NPH_TOTAL;
    (void)in_sizes; (void)n_in; (void)out_size;
    static int grid_blocks = 0;
    if (!grid_blocks) {
        int dev = 0, cus = 0, per_cu = 0;
        (void)hipGetDevice(&dev);
        (void)hipDeviceGetAttribute(&cus, hipDeviceAttributeMultiprocessorCount, dev);
        if (hipFuncSetAttribute((const void*)k_mega, hipFuncAttributeMaxDynamicSharedMemorySize, LDS_BYTES) != hipSuccess) { fprintf(stderr, "hipFuncSetAttribute failed\n"); grid_blocks = -1; return; }
        if (hipOccupancyMaxActiveBlocksPerMultiprocessor(&per_cu, (const void*)k_mega, NTHR, LDS_BYTES) != hipSuccess || per_cu < 1) { fprintf(stderr, "occupancy query says %d\n", per_cu); }
        (void)hipGetLastError();
        grid_blocks = cus;
        if (off > ws_size) { fprintf(stderr, "workspace too small: need %zu have %zu\n", off, ws_size); grid_blocks = -1; }
    }
    if (grid_blocks < 0) return;
    (void)hipMemsetAsync(p.ctl, 0, CTL_BYTES, stream);
    void* args[] = {&p};
    hipError_t e = hipLaunchCooperativeKernel((const void*)k_mega, dim3(grid_blocks), dim3(NTHR), args, LDS_BYTES, stream);
    if (e != hipSuccess) fprintf(stderr, "cooperative launch failed: %s (grid %d)\n", hipGetErrorString(e), grid_blocks);
}
```

```cpp
#include <hip/hip_runtime.h>
#include <cstdio>
#include <cstdint>

#define LAS __attribute__((address_space(3)))
typedef unsigned short bf16_t;
typedef short bf16x8 __attribute__((ext_vector_type(8)));
typedef float f32x4 __attribute__((ext_vector_type(4)));
typedef float f32x2 __attribute__((ext_vector_type(2)));
typedef unsigned u32x4 __attribute__((ext_vector_type(4)));
typedef unsigned u32x2 __attribute__((ext_vector_type(2)));

constexpr int NW = 8;
constexpr int NTHR = NW * 64;
constexpr int T_ = 8192;
constexpr int NTOK = 16384;
constexpr int DM = 1024;
constexpr int IC_SRC = 2840;
constexpr int HLD = 3072;
constexpr int C_GU = 0, C_GV = 256, C_NQ = 512, C_KC = 1024, C_VC = 1152, C_KS = 1280, C_VS = 1408,
              C_KW = 1536, C_VW = 1664, C_HQ = 1792, C_HF = 2048, C_HI = 2304, C_HG = 2560, C_NG = 2816;
constexpr int NCMP = 511;
constexpr float ALPHA = 1.4142135623730951f;
constexpr float NEG_INF = -1e30f;

constexpr size_t WT_IN = 0;
constexpr size_t WT_OUT = WT_IN + (size_t)3072 * 1024;
constexpr size_t WT_UP = WT_OUT + (size_t)1024 * 1024;
constexpr size_t WT_DN = WT_UP + (size_t)16 * 1024 * 1024;
constexpr size_t WT_C1 = WT_DN + (size_t)16 * 1024 * 512;
constexpr size_t WT_GM = WT_C1 + (size_t)2 * 256 * 2048;
constexpr size_t WT_LAYER = WT_GM + (size_t)4 * 128 * 128;

constexpr int LDS_STAGE = 131072;
constexpr int LDS_MISC = LDS_STAGE;
constexpr int LDS_BYTES = 147456;

constexpr int CW_BAR = 0;
constexpr int CW_CNT = 4096;
constexpr size_t CTL_BYTES = 65536;

struct P {
    const float* x; const float* w_in; const float* gm_v_gain; const float* gm_v_bias; const float* gm_w_s;
    const float* gm_b_s; const float* cmp_pos; const float* cmp_w1; const float* cmp_w2; const float* nsa_gate_b;
    const float* hg_lower; const float* out_gain; const float* w_out; const float* ln1_g; const float* ln1_b;
    const float* rg_w; const float* rg_b; const float* re_w; const float* re_b; const float* w_gate;
    const float* w_up; const float* w_down; const float* ln2_g; const float* ln2_b;
    float* out;
    unsigned* ctl;
    bf16_t* WT;
    bf16_t* H;
    bf16_t* Y;
    bf16_t* XB;
    bf16_t* kcb;
    bf16_t* vcT;
    bf16_t* vsT;
    bf16_t* vwT;
    bf16_t* gb;
    float* cbias;
    int* list_tok;
    float* list_w;
    int* tok_slot;
    float* hgU; float* hgG; float* hgS; bf16_t* hgQB; bf16_t* hgO;
    int nph; int pad;
};


typedef const __attribute__((address_space(4))) char* KA;
template <class T> __device__ __forceinline__ T ldarg(KA ka, size_t off) { return *(const __attribute__((address_space(4))) T*)(ka + off); }
#define PF(f) ldarg<decltype(P::f)>(ka, offsetof(P, f))

__device__ __forceinline__ float bf2f(bf16_t u) { return __uint_as_float(((unsigned)u) << 16); }
__device__ __forceinline__ unsigned f2bf_u(float f) {
    unsigned u = __float_as_uint(f);
    return (u + 0x7fffu + ((u >> 16) & 1u)) >> 16;
}
__device__ __forceinline__ bf16_t f2bf(float f) { return (bf16_t)f2bf_u(f); }
__device__ __forceinline__ unsigned pk2(float lo, float hi) { return f2bf_u(lo) | (f2bf_u(hi) << 16); }
__device__ __forceinline__ float gelu_t(float x) {
    float u = 0.7978845608028654f * (x + 0.044715f * x * x * x);
    return 0.5f * x * (1.f + tanhf(u));
}
__device__ __forceinline__ float sigmoidf_(float x) { return 1.f / (1.f + __expf(-x)); }
__device__ __forceinline__ float wave_max(float v) {
#pragma unroll
    for (int o = 32; o > 0; o >>= 1) v = fmaxf(v, __shfl_xor(v, o));
    return v;
}
__device__ __forceinline__ float wave_sum(float v) {
#pragma unroll
    for (int o = 32; o > 0; o >>= 1) v += __shfl_xor(v, o);
    return v;
}
__device__ __forceinline__ void wave_sync() {
    __builtin_amdgcn_fence(__ATOMIC_RELEASE, "wavefront");
    __builtin_amdgcn_wave_barrier();
    __builtin_amdgcn_fence(__ATOMIC_ACQUIRE, "wavefront");
}
__device__ __forceinline__ int opaque_tid() { int t = threadIdx.x; asm volatile("" : "+v"(t)); return t; }
__device__ __forceinline__ int opaque_bid() { int b = blockIdx.x; asm volatile("" : "+s"(b)); return b; }
#define PHASE_IDS const int TID = opaque_tid(); const int BID = opaque_bid(); (void)TID; (void)BID;

#define XB_TMO      128
#define XB_XCNT(j)  (256  + 64 * (j))
#define XB_XSUB(j)  (1280 + 64 * (j))
#define XB_XGEN(j)  (2304 + 64 * (j))
#define XB_TOP      3328
#define XB_TOPGEN   3392
#define XCD_BAR_WORDS 3456
#define XB_SPIN_CAP (1u << 22)
__device__ __forceinline__ unsigned xb_ld(unsigned* p)              { return __hip_atomic_load(p, __ATOMIC_RELAXED, __HIP_MEMORY_SCOPE_AGENT); }
__device__ __forceinline__ unsigned xb_add(unsigned* p, unsigned v) { return __hip_atomic_fetch_add(p, v, __ATOMIC_RELAXED, __HIP_MEMORY_SCOPE_AGENT); }
__device__ __forceinline__ unsigned xb_xcc_id() { return (unsigned)__builtin_amdgcn_s_getreg((3 << 11) | 20) & 0xFu; }
#define XB_SPIN(cond, bar) do { unsigned _sp = 0; while (cond) { __builtin_amdgcn_s_sleep(1); \
    if ((++_sp & 255u) == 0u) { if (xb_ld(&(bar)[XB_TMO])) break; if (_sp > XB_SPIN_CAP) { atomicAdd(&(bar)[XB_TMO], 1u); break; } } } } while (0)
struct XcdBarrier { unsigned* bar; unsigned x; volatile LAS unsigned* st; };
__device__ __forceinline__ XcdBarrier xcd_barrier_post(unsigned* bar, volatile LAS unsigned* st) {
    XcdBarrier b; b.bar = bar; b.x = xb_xcc_id(); b.st = st;
    if (threadIdx.x == 0) (void)xb_add(&bar[XB_XCNT(b.x)], 1u);
    return b;
}
__device__ __forceinline__ void xcd_barrier_complete(unsigned* bar, unsigned x, unsigned& nloc, unsigned& nx) {
    const unsigned G = gridDim.x * gridDim.y * gridDim.z;
    unsigned sum, cnt, mine, sp = 0u;
    for (;;) {
        sum = 0u; cnt = 0u; mine = 0u;
#pragma unroll
        for (unsigned j = 0; j < 16; ++j) { const unsigned c = xb_ld(&bar[XB_XCNT(j)]); sum += c; cnt += (c > 0u) ? 1u : 0u; mine = (j == x) ? c : mine; }
        if (sum == G) break;
        __builtin_amdgcn_s_sleep(1);
        if ((++sp & 255u) == 0u) { if (xb_ld(&bar[XB_TMO])) break; if (sp > XB_SPIN_CAP) { atomicAdd(&bar[XB_TMO], 1u); break; } }
    }
    nloc = mine > 0u ? mine : 1u; nx = cnt > 0u ? cnt : 1u;
}
__device__ __forceinline__ void xcd_barrier(const XcdBarrier& b) {
    asm volatile("s_waitcnt vmcnt(0)" ::: "memory");
    __syncthreads();
    if (threadIdx.x == 0) {
        unsigned* bar = b.bar;
        __builtin_amdgcn_s_waitcnt(0);
        unsigned nloc = b.st[0], nx = b.st[1];
        if (nloc == 0u) { xcd_barrier_complete(bar, b.x, nloc, nx); b.st[0] = nloc; b.st[1] = nx; }
        const unsigned old = xb_add(&bar[XB_XSUB(b.x)], 1u);
        const unsigned gen = old / nloc;
        if (old + 1u == (gen + 1u) * nloc) {
            __builtin_amdgcn_fence(__ATOMIC_RELEASE, "agent");
            asm volatile("s_waitcnt vmcnt(0)" ::: "memory");
            const unsigned og = xb_add(&bar[XB_TOP], 1u);
            const unsigned tg = og / nx;
            if (og + 1u == (tg + 1u) * nx) xb_add(&bar[XB_TOPGEN], 1u);
            else XB_SPIN(xb_ld(&bar[XB_TOPGEN]) == tg, bar);
            __builtin_amdgcn_fence(__ATOMIC_ACQUIRE, "agent");
            xb_add(&bar[XB_XGEN(b.x)], 1u);
            asm volatile("s_waitcnt vmcnt(0)" ::: "memory");
        } else {
            XB_SPIN(xb_ld(&bar[XB_XGEN(b.x)]) == gen, bar);
            __builtin_amdgcn_fence(__ATOMIC_ACQUIRE, "agent");
            asm volatile("s_waitcnt vmcnt(0)" ::: "memory");
        }
    }
    __syncthreads();
}

namespace pg8 {
constexpr int BM = 256, BK = 64, HALF = 128, HTB = HALF * BK * 2, STAGE_BYTES = 8 * HTB;
__host__ __device__ __forceinline__ int lds_byte(int r, int c) { const int st = (r >> 4) * 2 + (c >> 5), rr = r & 15, cc = c & 31, ob = rr * 64 + cc * 2; return st * 1024 + (ob ^ (((ob >> 9) & 1) << 5)); }
__host__ __device__ __forceinline__ void stage_rc(int b, int& R, int& C) { const int st = b / 1024, sb = b % 1024, swz = sb ^ (((sb >> 9) & 1) << 5); R = (st >> 1) * 16 + swz / 64; C = (st & 1) * 32 + (swz % 64) / 2; }
__host__ __device__ __forceinline__ int perm32(int rho) { const int n = rho >> 4, i = rho & 15; return 8 * (i >> 2) + 4 * n + (i & 3); }
__device__ __forceinline__ unsigned cvt_pk_bf16(float lo, float hi) { unsigned r; asm volatile("v_cvt_pk_bf16_f32 %0, %1, %2" : "=v"(r) : "v"(lo), "v"(hi)); return r; }

struct Unit {
    const char* bptr;
    int arow0;
    int nrows;
    int pm, pn, e, ui;
};

template <class Epi, class Sched>
__device__ __forceinline__ void gemm_phase(LAS unsigned char* lds, const char* Abase, const int K, const Sched& S, const Epi& E) {
    const int tid = opaque_tid(), wid = __builtin_amdgcn_readfirstlane(tid >> 6), lane = tid & 63, wr = wid >> 2, wc = wid & 3, fr = lane & 15, fq = lane >> 4;
    const int nt = K / BK;
    int R0, C0, R1, C1; stage_rc(tid * 16, R0, C0); stage_rc(tid * 16 + 8192, R1, C1);
    unsigned voffB[2];
    { const int Rb0 = Epi::PERM ? ((R0 & ~31) + perm32(R0 & 31)) : R0, Rb1 = Epi::PERM ? ((R1 & ~31) + perm32(R1 & 31)) : R1;
      voffB[0] = (unsigned)(Rb0 * K + C0) * 2u; voffB[1] = (unsigned)(Rb1 * K + C1) * 2u; }
    const unsigned cA0 = (unsigned)C0 * 2u, cA1 = (unsigned)C1 * 2u;
    const int lda = S.lda(K);
    const unsigned kstepA = S.kstepA();
    const unsigned voffA0 = (unsigned)(R0 * lda + C0) * 2u, voffA1 = (unsigned)(R1 * lda + C1) * 2u;
    const unsigned kstep = (unsigned)(BK * 2);
    const unsigned hstep = (unsigned)(HALF * K * 2);
    const unsigned ldsw = (unsigned)wid * 1024u;
    const int aoff = lds_byte(wr * 64 + fr, fq * 8), boff = lds_byte(wc * 32 + fr, fq * 8);
#define PG8_SA(b, h) (((b) * 2 + (h)) * HTB)
#define PG8_SB(b, h) ((4 + (b) * 2 + (h)) * HTB)
#define PG8_STAGE_B(bufoff, gbase) do { \
        __builtin_amdgcn_global_load_lds((const unsigned*)((const char*)(gbase) + voffB[0]), (LAS unsigned*)(lds + (bufoff) + ldsw), 16, 0, 0); \
        __builtin_amdgcn_global_load_lds((const unsigned*)((const char*)(gbase) + voffB[1]), (LAS unsigned*)(lds + (bufoff) + ldsw + 8192), 16, 0, 0); } while (0)
#define PG8_STAGE_A(bufoff, gbase, pk) do { \
        const unsigned o0_ = Sched::GATHER ? (((pk) & 0xffffu) * (unsigned)lda * 2u + cA0) : voffA0; \
        const unsigned o1_ = Sched::GATHER ? (((pk) >> 16) * (unsigned)lda * 2u + cA1) : voffA1; \
        __builtin_amdgcn_global_load_lds((const unsigned*)((const char*)(gbase) + o0_), (LAS unsigned*)(lds + (bufoff) + ldsw), 16, 0, 0); \
        __builtin_amdgcn_global_load_lds((const unsigned*)((const char*)(gbase) + o1_), (LAS unsigned*)(lds + (bufoff) + ldsw + 8192), 16, 0, 0); } while (0)
#define PG8_LDA(dst, b, h) do { _Pragma("unroll") for (int m = 0; m < 4; ++m) _Pragma("unroll") for (int k = 0; k < 2; ++k) dst[m][k] = *(const LAS bf16x8*)(lds + PG8_SA(b, h) + aoff + m * 2048 + k * 1024); } while (0)
#define PG8_LDB(dst, b, h) do { _Pragma("unroll") for (int n = 0; n < 2; ++n) _Pragma("unroll") for (int k = 0; k < 2; ++k) dst[n][k] = *(const LAS bf16x8*)(lds + PG8_SB(b, h) + boff + n * 2048 + k * 1024); } while (0)
#define PG8_MMA(ai, bj, At, Bt) do { __builtin_amdgcn_s_setprio(1); _Pragma("unroll") for (int m = 0; m < 4; ++m) _Pragma("unroll") for (int n = 0; n < 2; ++n) _Pragma("unroll") for (int k = 0; k < 2; ++k) \
        acc[ai][bj][m][n] = __builtin_amdgcn_mfma_f32_16x16x32_bf16(Bt[n][k], At[m][k], acc[ai][bj][m][n], 0, 0, 0); __builtin_amdgcn_s_setprio(0); } while (0)
#define PG8_WAIT_V(n) asm volatile("s_waitcnt vmcnt(" #n ")" ::: "memory")
#define PG8_WAIT_L(n) asm volatile("s_waitcnt lgkmcnt(" #n ")" ::: "memory")
#define PG8_BAR __builtin_amdgcn_s_barrier()
#define PG8_SCHED __builtin_amdgcn_sched_barrier(0)
#define PG8_PACK(u, h) ((unsigned)S.arow((u), ((h) * 128 + R0) < (u).nrows ? ((h) * 128 + R0) : (u).nrows - 1) | ((unsigned)S.arow((u), ((h) * 128 + R1) < (u).nrows ? ((h) * 128 + R1) : (u).nrows - 1) << 16))
    Unit cur, nxt; int ui = 0;
    if (!S.next(0, cur)) return;
    f32x4 acc[2][2][4][2];
#pragma unroll
    for (int a = 0; a < 2; ++a)
#pragma unroll
        for (int b = 0; b < 2; ++b)
#pragma unroll
            for (int m = 0; m < 4; ++m)
#pragma unroll
                for (int n = 0; n < 2; ++n) acc[a][b][m][n] = (f32x4){0.f, 0.f, 0.f, 0.f};
    bf16x8 At[4][2], B0[2][2], B1[2][2];
    unsigned pC0 = 0u, pC1 = 0u, pN0 = 0u, pN1 = 0u;
    if (Sched::GATHER) { pC0 = PG8_PACK(cur, 0); pC1 = PG8_PACK(cur, 1); }
    const char* cB = cur.bptr;
    const char* cA = Sched::GATHER ? Abase : S.abase(cur, Abase) + (size_t)cur.arow0 * lda * 2;
    const unsigned hA = Sched::GATHER ? 0u : (unsigned)(HALF * lda * 2);
    PG8_STAGE_B(PG8_SB(0, 0), cB); PG8_STAGE_B(PG8_SB(0, 1), cB + hstep); PG8_STAGE_A(PG8_SA(0, 0), cA, pC0); PG8_STAGE_A(PG8_SA(0, 1), cA + hA, pC1);
    if (wr == 1) PG8_BAR;
    PG8_WAIT_V(2); PG8_BAR;
    PG8_STAGE_B(PG8_SB(1, 0), cB + kstep); PG8_STAGE_A(PG8_SA(1, 0), cA + kstepA, pC0); PG8_STAGE_B(PG8_SB(1, 1), cB + hstep + kstep);
    PG8_WAIT_V(6); PG8_BAR;
    for (;;) {
        const bool has_next = S.next(ui + 1, nxt);
        if (Sched::GATHER) { if (has_next) { pN0 = PG8_PACK(nxt, 0); pN1 = PG8_PACK(nxt, 1); } else { pN0 = pC0; pN1 = pC1; } }
        const char* nB = has_next ? nxt.bptr : cB;
        const char* nA = (Sched::GATHER || !has_next) ? cA : S.abase(nxt, Abase) + (size_t)nxt.arow0 * lda * 2;
        for (int t = 0; t < nt; t += 2) {
            const bool last = (t == nt - 2);
            const char* a1 = cA + (unsigned)(t + 1) * kstepA;
            const char* a2 = last ? nA : cA + (unsigned)(t + 2) * kstepA; const char* b2 = last ? nB : cB + (unsigned)(t + 2) * kstep;
            const char* a3 = a2 + kstepA; const char* b3 = b2 + kstep;
            const unsigned s0 = last ? pN0 : pC0, s1 = last ? pN1 : pC1;
            PG8_LDB(B0, 0, 0); PG8_LDB(B1, 0, 1); PG8_SCHED; PG8_LDA(At, 0, 0); PG8_STAGE_A(PG8_SA(1, 1), a1 + hA, pC1);
            PG8_WAIT_V(8); PG8_WAIT_L(0); PG8_BAR; PG8_MMA(0, 0, At, B0); PG8_MMA(0, 1, At, B1); PG8_BAR; PG8_SCHED;
            PG8_LDA(At, 0, 1); PG8_STAGE_B(PG8_SB(0, 0), b2); PG8_STAGE_B(PG8_SB(0, 1), b2 + hstep); PG8_STAGE_A(PG8_SA(0, 0), a2, s0);
            PG8_WAIT_V(8); PG8_WAIT_L(0); PG8_BAR; PG8_MMA(1, 0, At, B0); PG8_MMA(1, 1, At, B1); PG8_BAR; PG8_SCHED;
            PG8_LDB(B0, 1, 0); PG8_LDB(B1, 1, 1); PG8_SCHED; PG8_LDA(At, 1, 0); PG8_STAGE_A(PG8_SA(0, 1), a2 + hA, s1);
            PG8_WAIT_V(8); PG8_WAIT_L(0); PG8_BAR; PG8_MMA(0, 0, At, B0); PG8_MMA(0, 1, At, B1); PG8_BAR; PG8_SCHED;
            PG8_LDA(At, 1, 1); PG8_STAGE_B(PG8_SB(1, 0), b3); PG8_STAGE_B(PG8_SB(1, 1), b3 + hstep); PG8_STAGE_A(PG8_SA(1, 0), a3, s0);
            PG8_WAIT_V(8); PG8_WAIT_L(0); PG8_BAR; PG8_MMA(1, 0, At, B0); PG8_MMA(1, 1, At, B1); PG8_BAR; PG8_SCHED;
        }
        if (wr == 0) PG8_BAR;
        E(acc, cur, wr, wc, fr, fq);
        if (!has_next) break;
#pragma unroll
        for (int a = 0; a < 2; ++a)
#pragma unroll
            for (int b = 0; b < 2; ++b)
#pragma unroll
                for (int m = 0; m < 4; ++m)
#pragma unroll
                    for (int n = 0; n < 2; ++n) acc[a][b][m][n] = (f32x4){0.f, 0.f, 0.f, 0.f};
        cur = nxt; cB = nB; cA = nA; ++ui;
        pC0 = pN0; pC1 = pN1;
        if (wr == 1) PG8_BAR;
    }
    PG8_WAIT_V(0);
    PG8_BAR;
#undef PG8_SA
#undef PG8_SB
#undef PG8_STAGE_A
#undef PG8_STAGE_B
#undef PG8_LDA
#undef PG8_LDB
#undef PG8_MMA
#undef PG8_WAIT_V
#undef PG8_WAIT_L
#undef PG8_BAR
#undef PG8_SCHED
#undef PG8_PACK
}

struct DenseOrder {
    static constexpr bool GATHER = false;
    int nM, nN, nwg, G, c; const char* Bt; int K;
    __device__ void init(int M, int N, int K_, const bf16_t* Bt_, int G_, int c_) { nM = M / BM; nN = N / BM; nwg = nM * nN; G = G_; c = c_; Bt = (const char*)Bt_; K = K_; }
    __device__ __forceinline__ bool next(int i, Unit& u) const {
        const long L = (long)i * G + c; if (L >= nwg) return false;
        int wgid = (int)L; { const int q = nwg / 8, r = nwg % 8, xcd = wgid % 8, off = wgid / 8; wgid = (xcd < r ? xcd * (q + 1) : r * (q + 1) + (xcd - r) * q) + off; }
        const int nig = 8 * nN, gid = wgid / nig, fm = gid * 8, gsz = (nM - fm) < 8 ? (nM - fm) : 8;
        u.pm = fm + ((wgid % nig) % gsz); u.pn = (wgid % nig) / gsz;
        u.arow0 = u.pm * BM; u.nrows = BM; u.e = 0; u.ui = i;
        u.bptr = Bt + (size_t)u.pn * BM * K * 2;
        return true;
    }
    __device__ __forceinline__ int arow(const Unit& u, int r) const { return u.arow0 + r; }
    __device__ __forceinline__ int lda(int K_) const { return K_; }
    __device__ __forceinline__ unsigned kstepA() const { return 128u; }
    __device__ __forceinline__ const char* abase(const Unit&, const char* A) const { return A; }
};
}

struct EpiH {
    static constexpr bool PERM = true;
    bf16_t* H;
    __device__ __forceinline__ void operator()(const f32x4 (&acc)[2][2][4][2], const pg8::Unit& u, int wr, int wc, int fr, int fq) const {
        const int row0 = u.arow0 + wr * 64 + fr, col0 = u.pn * 256 + wc * 32 + 8 * fq;
#pragma unroll
        for (int ai = 0; ai < 2; ++ai)
#pragma unroll
            for (int m = 0; m < 4; ++m) {
                bf16_t* rowp = H + (size_t)(row0 + ai * 128 + m * 16) * HLD + col0;
#pragma unroll
                for (int bj = 0; bj < 2; ++bj) {
                    const f32x4 v0 = acc[ai][bj][m][0], v1 = acc[ai][bj][m][1];
                    u32x4 w; w.x = pg8::cvt_pk_bf16(v0[0], v0[1]); w.y = pg8::cvt_pk_bf16(v0[2], v0[3]); w.z = pg8::cvt_pk_bf16(v1[0], v1[1]); w.w = pg8::cvt_pk_bf16(v1[2], v1[3]);
                    *(u32x4*)(rowp + bj * 128) = w;
                }
            }
    }
};
struct EpiRes {
    static constexpr bool PERM = false;
    const float* xin; float* out;
    __device__ __forceinline__ void operator()(const f32x4 (&acc)[2][2][4][2], const pg8::Unit& u, int wr, int wc, int fr, int fq) const {
        const int row0 = u.arow0 + wr * 64 + fr, col0 = u.pn * 256 + wc * 32 + 4 * fq;
#pragma unroll
        for (int ai = 0; ai < 2; ++ai)
#pragma unroll
            for (int m = 0; m < 4; ++m) {
                const size_t off = (size_t)(row0 + ai * 128 + m * 16) * DM + col0;
#pragma unroll
                for (int bj = 0; bj < 2; ++bj)
#pragma unroll
                    for (int n = 0; n < 2; ++n) {
                        const f32x4 xv = *(const f32x4*)(xin + off + bj * 128 + n * 16);
                        *(f32x4*)(out + off + bj * 128 + n * 16) = xv * ALPHA + acc[ai][bj][m][n];
                    }
            }
    }
};

template <class RM>
__device__ __forceinline__ void transpose_item(const float* W, int K, int N, bf16_t* WT, RM rowmap, float* scr, int kb, int nb, int lane) {
    const int k0 = 64 * kb, n0 = 32 * nb;
    const int nn = n0 + (lane & 31);
#pragma unroll 8
    for (int i = 0; i < 32; ++i) {
        const int kk = 2 * i + (lane >> 5);
        scr[kk * 33 + (lane & 31)] = nn < N ? W[(size_t)(k0 + kk) * N + nn] : 0.f;
    }
    wave_sync();
    const int c = lane & 7;
#pragma unroll
    for (int j = 0; j < 4; ++j) {
        const int n = (lane >> 3) + 8 * j;
        const float* s = scr + (8 * c) * 33 + n;
        u32x4 o; o.x = pk2(s[0 * 33], s[1 * 33]); o.y = pk2(s[2 * 33], s[3 * 33]); o.z = pk2(s[4 * 33], s[5 * 33]); o.w = pk2(s[6 * 33], s[7 * 33]);
        const int dr = (n0 + n < N) ? rowmap(n0 + n) : -1;
        if (dr >= 0) *(u32x4*)(WT + (size_t)dr * K + k0 + 8 * c) = o;
    }
    wave_sync();
}

__device__ void phase_prologue(KA ka, int layer, float* smem) {
    PHASE_IDS
    const int lane = TID & 63, w = TID >> 6;
    float* scr = smem + w * 4096;
    const int gw = BID * NW + w, NGW = gridDim.x * NW;
    constexpr int I_IN = 16 * 89, I_OUT = 16 * 32, I_GU = 16 * 16, I_DN = 8 * 32;
    constexpr int I_LAYER = I_IN + I_OUT + 32 * I_GU + 16 * I_DN;
    for (int it = gw; it < I_LAYER; it += NGW) {
        int r = it;
        bf16_t* WT = PF(WT);
        if (r < I_IN) {
            transpose_item(PF(w_in) + (size_t)layer * DM * IC_SRC, DM, IC_SRC, WT + WT_IN,
                           [](int n) { return n < 1792 ? n : (n < 1816 ? 2816 + (n - 1792) : n - 24); }, scr, r / 89, r % 89, lane);
            continue;
        }
        r -= I_IN;
        if (r < I_OUT) {
            transpose_item(PF(w_out) + (size_t)layer * DM * DM, DM, DM, WT + WT_OUT, [](int n) { return n; }, scr, r / 32, r % 32, lane);
            continue;
        }
        r -= I_OUT;
        if (r < 32 * I_GU) {
            const int mat = r / I_GU, rr = r % I_GU, e = mat >> 1, isup = mat & 1;
            const float* W = (isup ? PF(w_up) : PF(w_gate)) + ((size_t)layer * 16 + e) * DM * 512;
            transpose_item(W, DM, 512, WT + WT_UP + (size_t)e * 1024 * 1024,
                           [isup](int n) { return (n >> 7) * 256 + isup * 128 + (n & 127); }, scr, rr / 16, rr % 16, lane);
            continue;
        }
        r -= 32 * I_GU;
        {
            const int e = r / I_DN, rr = r % I_DN;
            transpose_item(PF(w_down) + ((size_t)layer * 16 + e) * 512 * DM, 512, DM, WT + WT_DN + (size_t)e * 1024 * 512,
                           [](int n) { return n; }, scr, rr / 32, rr % 32, lane);
        }
    }
    for (int it = gw; it < 2 * 32 * 4; it += NGW) {
        const int which = it >> 7, rr = it & 127;
        transpose_item(PF(cmp_w1) + ((size_t)layer * 2 + which) * 2048 * 128, 2048, 128, PF(WT) + WT_C1 + (size_t)which * 256 * 2048, [](int n) { return n; }, scr, rr >> 2, rr & 3, lane);
    }
    for (int i = BID * NTHR + TID; i < 2 * 128 * 256; i += gridDim.x * NTHR) {
        const int which = i >> 15, q = i & 32767;
        u32x4 z; z.x = 0u; z.y = 0u; z.z = 0u; z.w = 0u;
        *(u32x4*)(PF(WT) + WT_C1 + (size_t)which * 256 * 2048 + (size_t)128 * 2048 + (size_t)q * 8) = z;
    }
    for (int o = gw; o < 256; o += NGW) {
        const int which = o >> 7, cc = o & 127;
        const float* w1 = PF(cmp_w1) + ((size_t)layer * 2 + which) * 2048 * 128;
        const float* pos = PF(cmp_pos) + ((size_t)layer * 2 + which) * 2048;
        float a = 0.f;
        for (int k = lane; k < 2048; k += 64) a = fmaf(pos[k], w1[(size_t)k * 128 + cc], a);
        a = wave_sum(a);
        if (lane == 0) PF(cbias)[o] = a;
    }
    for (int i = BID * NTHR + TID; i < 4 * 128 * 128; i += gridDim.x * NTHR) {
        const int s = i & 127, t = (i >> 7) & 127;
        PF(WT)[WT_GM + i] = (s <= t) ? f2bf(PF(gm_w_s)[(size_t)layer * 4 * 128 * 128 + i]) : (bf16_t)0;
    }
    for (int i = BID * NTHR + TID; i < 232 * 128; i += gridDim.x * NTHR) {
        const int q = i;
        u32x4 z; z.x = 0u; z.y = 0u; z.z = 0u; z.w = 0u;
        *(u32x4*)(PF(WT) + WT_IN + (size_t)2840 * 1024 + (size_t)q * 8) = z;
    }
    if (layer == 0)
    for (int row = gw; row < NTOK; row += NGW) {
        const f32x4* xr = (const f32x4*)(PF(x) + (size_t)row * DM) + lane;
        u32x2* o = (u32x2*)(PF(XB) + (size_t)row * DM) + lane;
#pragma unroll
        for (int j = 0; j < 4; ++j) {
            const f32x4 v = xr[64 * j];
            u32x2 ww; ww.x = pk2(v[0], v[1]); ww.y = pk2(v[2], v[3]);
            o[64 * j] = ww;
        }
    }
}

template <class AF, class BF, class EF>
__device__ __forceinline__ void gemm128(int tid, int m0, int n0, int M, int N, int K, AF af, BF bf, EF ef, float* smem) {
    float* As = smem;
    float* Bs = smem + 16 * 132;
    const bool active = tid < 256;
    const int tx = tid & 15, ty = (tid >> 4) & 15;
    float acc[8][8];
#pragma unroll
    for (int i = 0; i < 8; i++)
#pragma unroll
        for (int j = 0; j < 8; j++) acc[i][j] = 0.f;
#pragma unroll 1
    for (int k0 = 0; k0 < K; k0 += 16) {
        if (active) {
#pragma unroll
            for (int i = 0; i < 8; i++) {
                int e = tid + i * 256;
                int r = e >> 4, kk = e & 15;
                float v = 0.f;
                if (m0 + r < M) v = af(m0 + r, k0 + kk);
                As[kk * 132 + r] = v;
            }
#pragma unroll
            for (int i = 0; i < 8; i++) {
                int e = tid + i * 256;
                int kk = e >> 7, c = e & 127;
                float v = 0.f;
                if (n0 + c < N) v = bf(k0 + kk, n0 + c);
                Bs[kk * 132 + c] = v;
            }
        }
        __syncthreads();
        if (active) {
#pragma unroll 2
            for (int kk = 0; kk < 16; kk++) {
                asm volatile("" ::: "memory");
                float4 a0 = *(const float4*)&As[kk * 132 + ty * 8];
                float4 a1 = *(const float4*)&As[kk * 132 + ty * 8 + 4];
                float4 b0 = *(const float4*)&Bs[kk * 132 + tx * 8];
                float4 b1 = *(const float4*)&Bs[kk * 132 + tx * 8 + 4];
                float a[8] = {a0.x, a0.y, a0.z, a0.w, a1.x, a1.y, a1.z, a1.w};
                float b[8] = {b0.x, b0.y, b0.z, b0.w, b1.x, b1.y, b1.z, b1.w};
#pragma unroll
                for (int i = 0; i < 8; i++)
#pragma unroll
                    for (int j = 0; j < 8; j++) acc[i][j] = fmaf(a[i], b[j], acc[i][j]);
            }
        }
        __syncthreads();
    }
    if (active) {
#pragma unroll
        for (int i = 0; i < 8; i++)
#pragma unroll
            for (int j = 0; j < 8; j++) {
                int m = m0 + ty * 8 + i, n = n0 + tx * 8 + j;
                if (m < M && n < N) ef(m, n, acc[i][j]);
            }
    }
}

__device__ __forceinline__ void phase_inproj(KA ka, int layer, LAS unsigned char* lds) {
    pg8::DenseOrder S; S.init(NTOK, HLD, DM, PF(WT) + WT_IN, gridDim.x, opaque_bid());
    EpiH E{PF(H)};
    pg8::gemm_phase<EpiH, pg8::DenseOrder>(lds, (const char*)PF(XB), DM, S, E);
}
__device__ __forceinline__ void phase_outproj(KA ka, int layer, const float* xin, float* x1, LAS unsigned char* lds) {
    pg8::DenseOrder S; S.init(NTOK, DM, DM, PF(WT) + WT_OUT, gridDim.x, opaque_bid());
    EpiRes E{xin, x1};
    pg8::gemm_phase<EpiRes, pg8::DenseOrder>(lds, (const char*)PF(Y), DM, S, E);
}

__device__ void phase_headnorm(KA ka, int layer) {
    PHASE_IDS
    const int lane = TID & 63, w = TID >> 6;
    const float* og = PF(out_gain) + layer * 1024;
    for (int row = BID * NW + w; row < NTOK; row += gridDim.x * NW) {
#pragma unroll
        for (int hd = 0; hd < 12; hd++) {
            float v = bf2f(PF(Y)[(size_t)row * DM + hd * 64 + lane]);
            float ms = wave_sum(v * v) * (1.f / 64.f);
            float y = v * rsqrtf(ms + 1e-6f) * og[hd * 64 + lane];
            if (hd >= 12) {
                float hg = bf2f(PF(H)[(size_t)row * HLD + C_HG + (hd - 12) * 64 + lane]);
                y *= hg * sigmoidf_(hg);
            }
            PF(Y)[(size_t)row * DM + hd * 64 + lane] = f2bf(y);
        }
    }
}

__device__ void phase_ln1_route(KA ka, int layer, float* x1) {
    PHASE_IDS
    bf16_t* xb = PF(XB);
    const int lane = TID & 63, w = TID >> 6;
    const float* g = PF(ln1_g) + layer * 1024;
    const float* bb = PF(ln1_b) + layer * 1024;
    const float* wg = PF(rg_w) + (size_t)layer * 1024 * 4;
    const float* we = PF(re_w) + (size_t)layer * 1024 * 16;
    const float* bg = PF(rg_b) + layer * 4;
    const float* be = PF(re_b) + layer * 16;
    int* cnt = (int*)(PF(ctl) + CW_CNT) + layer * 16;
    for (int row = BID * NW + w; row < NTOK; row += gridDim.x * NW) {
        float v[16];
        float s = 0.f;
#pragma unroll
        for (int i = 0; i < 16; i++) { v[i] = x1[(size_t)row * DM + i * 64 + lane]; s += v[i]; }
        float mu = wave_sum(s) * (1.f / 1024.f);
        float q = 0.f;
#pragma unroll
        for (int i = 0; i < 16; i++) { float d = v[i] - mu; q += d * d; }
        float rstd = rsqrtf(wave_sum(q) * (1.f / 1024.f) + 1e-5f);
        float lg[4] = {0.f, 0.f, 0.f, 0.f};
        float le[16];
#pragma unroll
        for (int e = 0; e < 16; e++) le[e] = 0.f;
#pragma unroll
        for (int i = 0; i < 16; i++) {
            int c = i * 64 + lane;
            float o = (v[i] - mu) * rstd * g[c] + bb[c];
            x1[(size_t)row * DM + c] = o;
            xb[(size_t)row * DM + c] = f2bf(o);
            float4 w4 = *(const float4*)&wg[c * 4];
            lg[0] = fmaf(o, w4.x, lg[0]); lg[1] = fmaf(o, w4.y, lg[1]);
            lg[2] = fmaf(o, w4.z, lg[2]); lg[3] = fmaf(o, w4.w, lg[3]);
#pragma unroll
            for (int e4 = 0; e4 < 4; e4++) {
                float4 x4 = *(const float4*)&we[c * 16 + e4 * 4];
                le[e4 * 4 + 0] = fmaf(o, x4.x, le[e4 * 4 + 0]);
                le[e4 * 4 + 1] = fmaf(o, x4.y, le[e4 * 4 + 1]);
                le[e4 * 4 + 2] = fmaf(o, x4.z, le[e4 * 4 + 2]);
                le[e4 * 4 + 3] = fmaf(o, x4.w, le[e4 * 4 + 3]);
            }
        }
#pragma unroll
        for (int c = 0; c < 4; c++) lg[c] = wave_sum(lg[c]) + bg[c];
#pragma unroll
        for (int e = 0; e < 16; e++) le[e] = wave_sum(le[e]) + be[e];
        float gm = fmaxf(fmaxf(lg[0], lg[1]), fmaxf(lg[2], lg[3]));
        float ge[4], gs = 0.f;
#pragma unroll
        for (int c = 0; c < 4; c++) { ge[c] = __expf(lg[c] - gm); gs += ge[c]; }
        int gi = 0; float gbest = ge[0];
#pragma unroll
        for (int c = 1; c < 4; c++) if (ge[c] > gbest) { gbest = ge[c]; gi = c; }
        float gval = gbest / gs;
        float ls[4];
#pragma unroll
        for (int e = 0; e < 4; e++) ls[e] = gi == 0 ? le[e] : gi == 1 ? le[4 + e] : gi == 2 ? le[8 + e] : le[12 + e];
        float em = fmaxf(fmaxf(ls[0], ls[1]), fmaxf(ls[2], ls[3]));
        float pe[4];
#pragma unroll
        for (int e = 0; e < 4; e++) pe[e] = __expf(ls[e] - em);
        int i1 = 0; float b1 = pe[0];
#pragma unroll
        for (int e = 1; e < 4; e++) if (pe[e] > b1) { b1 = pe[e]; i1 = e; }
        int i2 = -1; float b2 = -1.f;
#pragma unroll
        for (int e = 0; e < 4; e++) if (e != i1 && pe[e] > b2) { b2 = pe[e]; i2 = e; }
        float w1 = gval * b1 / (b1 + b2), w2 = gval * b2 / (b1 + b2);
        if (lane == 0) {
            int e1 = gi * 4 + i1, e2 = gi * 4 + i2;
            int p1 = atomicAdd(&cnt[e1], 1);
            PF(list_tok)[e1 * NTOK + p1] = row; PF(list_w)[e1 * NTOK + p1] = w1;
            int p2 = atomicAdd(&cnt[e2], 1);
            PF(list_tok)[e2 * NTOK + p2] = row; PF(list_w)[e2 * NTOK + p2] = w2;
            PF(tok_slot)[row * 2 + 0] = e1 * NTOK + p1; PF(tok_slot)[row * 2 + 1] = e2 * NTOK + p2;
        }
    }
}


template <bool GATHER_>
struct MoeOrder {
    static constexpr bool GATHER = GATHER_;
    const LAS int* tab; const LAS int* rowtab;
    const char* Bt; unsigned estride; int K, G, c;
    __device__ __forceinline__ bool next(int i, pg8::Unit& u) const {
        const int nwg = __builtin_amdgcn_readfirstlane(tab[48]) * 4;
        const int L = i * G + c; if (L >= nwg) return false;
        int wgid = L; { const int q = nwg / 8, r = nwg % 8, xcd = wgid % 8, off = wgid / 8; wgid = (xcd < r ? xcd * (q + 1) : r * (q + 1) + (xcd - r) * q) + off; }
        const int mg = wgid >> 2, nt = wgid & 3;
        int e = 0;
#pragma unroll
        for (int k = 1; k < 16; ++k) e = (__builtin_amdgcn_readfirstlane(tab[32 + k]) <= mg) ? k : e;
        const int mt = mg - __builtin_amdgcn_readfirstlane(tab[32 + e]);
        const int rem = __builtin_amdgcn_readfirstlane(tab[e]) - mt * 256;
        u.e = e; u.pm = mt; u.pn = nt; u.ui = i; u.nrows = rem < 256 ? rem : 256; u.arow0 = __builtin_amdgcn_readfirstlane(tab[16 + e]) + mt * 256;
        u.bptr = Bt + (size_t)e * estride + (size_t)nt * 256 * K * 2;
        return true;
    }
    __device__ __forceinline__ int arow(const pg8::Unit& u, int r) const { return GATHER_ ? rowtab[u.ui * 256 + r] : u.arow0 + r; }
    __device__ __forceinline__ int lda(int K_) const { return K_; }
    __device__ __forceinline__ unsigned kstepA() const { return 128u; }
    __device__ __forceinline__ const char* abase(const pg8::Unit&, const char* A) const { return A; }
};
__device__ __forceinline__ void moe_tables(KA ka, int layer, LAS unsigned char* lds, bool want_rows, int G, int c) {
    LAS int* tab = (LAS int*)(lds + LDS_MISC + 256);
    LAS int* rowtab = (LAS int*)(lds + LDS_MISC + 1024);
    const int tid = opaque_tid();
    const int* cnt = (const int*)(PF(ctl) + CW_CNT) + layer * 16;
    if (tid < 16) tab[tid] = __hip_atomic_load(&cnt[tid], __ATOMIC_RELAXED, __HIP_MEMORY_SCOPE_AGENT);
    __syncthreads();
    if (tid == 0) {
        int b = 0, m = 0;
        for (int e = 0; e < 16; ++e) { tab[16 + e] = b; tab[32 + e] = m; b += tab[e]; m += (tab[e] + 255) >> 8; }
        tab[48] = m;
    }
    __syncthreads();
    if (want_rows) {
        MoeOrder<true> S{tab, rowtab, nullptr, 0u, 1024, G, c};
        const int* lt = PF(list_tok);
        for (int i = 0; i < 4; ++i) {
            pg8::Unit u;
            if (!S.next(i, u)) break;
            if (tid < 256) { const int r = tid < u.nrows ? tid : u.nrows - 1; rowtab[i * 256 + tid] = lt[u.e * NTOK + u.pm * 256 + r]; }
        }
        asm volatile("s_waitcnt vmcnt(0) lgkmcnt(0)" ::: "memory");
        __syncthreads();
    }
}
struct EpiUp {
    static constexpr bool PERM = true;
    bf16_t* hidden;
    __device__ __forceinline__ void operator()(const f32x4 (&acc)[2][2][4][2], const pg8::Unit& u, int wr, int wc, int fr, int fq) const {
#pragma unroll
        for (int ai = 0; ai < 2; ++ai)
#pragma unroll
            for (int m = 0; m < 4; ++m) {
                const int r = ai * 128 + wr * 64 + m * 16 + fr;
                if (r < u.nrows) {
                    bf16_t* rowp = hidden + (size_t)(u.arow0 + r) * 512 + u.pn * 128 + wc * 32 + 8 * fq;
                    float h[8];
#pragma unroll
                    for (int n = 0; n < 2; ++n)
#pragma unroll
                        for (int j = 0; j < 4; ++j) { const float g = acc[ai][0][m][n][j], uu = acc[ai][1][m][n][j]; h[n * 4 + j] = g * sigmoidf_(g) * uu; }
                    u32x4 w; w.x = pg8::cvt_pk_bf16(h[0], h[1]); w.y = pg8::cvt_pk_bf16(h[2], h[3]); w.z = pg8::cvt_pk_bf16(h[4], h[5]); w.w = pg8::cvt_pk_bf16(h[6], h[7]);
                    *(u32x4*)rowp = w;
                }
            }
    }
};
struct EpiDown {
    static constexpr bool PERM = true;
    bf16_t* Y2; const float* lw;
    __device__ __forceinline__ void operator()(const f32x4 (&acc)[2][2][4][2], const pg8::Unit& u, int wr, int wc, int fr, int fq) const {
#pragma unroll
        for (int ai = 0; ai < 2; ++ai)
#pragma unroll
            for (int m = 0; m < 4; ++m) {
                const int r = ai * 128 + wr * 64 + m * 16 + fr;
                if (r < u.nrows) {
                    const float wgt = lw[u.e * NTOK + u.pm * 256 + r];
                    bf16_t* rowp = Y2 + (size_t)(u.arow0 + r) * DM + u.pn * 256 + wc * 32 + 8 * fq;
#pragma unroll
                    for (int bj = 0; bj < 2; ++bj) {
                        const f32x4 v0 = acc[ai][bj][m][0] * wgt, v1 = acc[ai][bj][m][1] * wgt;
                        u32x4 w; w.x = pg8::cvt_pk_bf16(v0[0], v0[1]); w.y = pg8::cvt_pk_bf16(v0[2], v0[3]); w.z = pg8::cvt_pk_bf16(v1[0], v1[1]); w.w = pg8::cvt_pk_bf16(v1[2], v1[3]);
                        *(u32x4*)(rowp + bj * 128) = w;
                    }
                }
            }
    }
};
__device__ __forceinline__ void phase_moe_up(KA ka, int layer, LAS unsigned char* lds) {
    moe_tables(ka, layer, lds, true, gridDim.x, opaque_bid());
    MoeOrder<true> S{(const LAS int*)(lds + LDS_MISC + 256), (const LAS int*)(lds + LDS_MISC + 1024),
                     (const char*)(PF(WT) + WT_UP), (unsigned)(1024u * 1024u * 2u), 1024, (int)gridDim.x, opaque_bid()};
    EpiUp E{PF(Y)};
    pg8::gemm_phase<EpiUp, MoeOrder<true>>(lds, (const char*)PF(XB), 1024, S, E);
}
__device__ __forceinline__ void phase_moe_down(KA ka, int layer, LAS unsigned char* lds) {
    moe_tables(ka, layer, lds, false, gridDim.x, opaque_bid());
    MoeOrder<false> S{(const LAS int*)(lds + LDS_MISC + 256), (const LAS int*)(lds + LDS_MISC + 1024),
                      (const char*)(PF(WT) + WT_DN), (unsigned)(1024u * 512u * 2u), 512, (int)gridDim.x, opaque_bid()};
    EpiDown E{PF(H), PF(list_w)};
    pg8::gemm_phase<EpiDown, MoeOrder<false>>(lds, (const char*)PF(Y), 512, S, E);
}

__device__ void phase_ln2(KA ka, int layer, const float* x1, float* xo) {
    PHASE_IDS
    bf16_t* xb = PF(XB);
    const bf16_t* Y2 = PF(H);
    const int lane = TID & 63, w = TID >> 6;
    const float* g = PF(ln2_g) + layer * 1024;
    const float* bb = PF(ln2_b) + layer * 1024;
    const int* cnt = (const int*)(PF(ctl) + CW_CNT) + layer * 16;
    int mybase = 0;
    {
        int cv = lane < 16 ? __hip_atomic_load(&cnt[lane & 15], __ATOMIC_RELAXED, __HIP_MEMORY_SCOPE_AGENT) : 0;
        int incl = cv;
#pragma unroll
        for (int o = 1; o < 16; o <<= 1) { int t = __shfl_up(incl, o); if ((lane & 15) >= o) incl += t; }
        mybase = incl - cv;
    }
    for (int row = BID * NW + w; row < NTOK; row += gridDim.x * NW) {
        const int ts1 = PF(tok_slot)[row * 2 + 0], ts2 = PF(tok_slot)[row * 2 + 1];
        const int s1 = __shfl(mybase, ts1 >> 14) + (ts1 & (NTOK - 1)), s2 = __shfl(mybase, ts2 >> 14) + (ts2 & (NTOK - 1));
        float v[16];
        float s = 0.f;
#pragma unroll
        for (int i = 0; i < 16; i++) {
            const int c = i * 64 + lane;
            v[i] = ALPHA * x1[(size_t)row * DM + c] + bf2f(Y2[(size_t)s1 * DM + c]) + bf2f(Y2[(size_t)s2 * DM + c]);
            s += v[i];
        }
        float mu = wave_sum(s) * (1.f / 1024.f);
        float q = 0.f;
#pragma unroll
        for (int i = 0; i < 16; i++) { float d = v[i] - mu; q += d * d; }
        float rstd = rsqrtf(wave_sum(q) * (1.f / 1024.f) + 1e-5f);
#pragma unroll
        for (int i = 0; i < 16; i++) {
            int c = i * 64 + lane;
            const float o = (v[i] - mu) * rstd * g[c] + bb[c];
            xo[(size_t)row * DM + c] = o;
            xb[(size_t)row * DM + c] = f2bf(o);
        }
    }
}

#define MFMA16(a, b, c) __builtin_amdgcn_mfma_f32_16x16x32_bf16((a), (b), (c), 0, 0, 0)
constexpr int NSA_KT = 0, NSA_VT = 16384, NSA_IMP = 32768, NSA_FIN = 65536, NSA_SEL = LDS_MISC + 8192;

__device__ __forceinline__ int tile_off(int r, int c) { return r * 128 + ((c ^ ((r >> 1) & 7)) << 4); }

struct SelMask { unsigned a, b, c, d; };
__device__ __forceinline__ unsigned selbit(unsigned a, unsigned b, unsigned c, unsigned d, int j) {
    const int k = j >> 5;
    const unsigned lo = (k & 1) ? b : a, hi = (k & 1) ? d : c;
    const unsigned r = (k & 2) ? hi : lo;
    return (r >> (j & 31)) & 1u;
}

struct NsaRT {
    bf16x8 q[2];
    f32x4 o[4];
    float m, l;
    int tk;
};

template <int MODE>
__device__ __forceinline__ void nsa_loop(LAS unsigned char* lds, int tid, int lane, int w, int jb, int je,
                                         const char* ksrc, size_t kstride, size_t ktile, const char* vsrc, size_t vstride, size_t vtile,
                                         NsaRT (&R)[2], const SelMask selm0, const SelMask selm1, float (&carry)[2], float* impw) {
    const int g = lane >> 4, qr = lane & 15;
    int tid2 = tid; asm volatile("" : "+v"(tid2));
    const int sr = tid2 >> 3, sc = tid2 & 7;
    const int soff = tile_off(sr, sc);
    const int fxq = (qr >> 1) & 7;
    const int ka0 = qr * 128 + ((g ^ fxq) << 4), ka1 = qr * 128 + (((4 + g) ^ fxq) << 4);
    const int vb = qr * 128 + (g & 1) * 8, vc = (g >> 1) ^ fxq;
    const int va0 = vb + (vc << 4), va1 = vb + ((vc ^ 2) << 4), va2 = vb + ((vc ^ 4) << 4), va3 = vb + ((vc ^ 6) << 4);
    if (jb > je) return;
    u32x4 kreg, vreg;
    kreg = *(const u32x4*)(ksrc + (size_t)jb * ktile + (size_t)sr * kstride + sc * 16);
    if (MODE != 0) vreg = *(const u32x4*)(vsrc + (size_t)jb * vtile + (size_t)sr * vstride + sc * 16);
    *(LAS u32x4*)(lds + NSA_KT + soff) = kreg;
    if (MODE != 0) *(LAS u32x4*)(lds + NSA_VT + soff) = vreg;
    __syncthreads();
    for (int j = jb; j <= je; ++j) {
        const int cur = (j - jb) & 1;
        if (j < je) {
            kreg = *(const u32x4*)(ksrc + (size_t)(j + 1) * ktile + (size_t)sr * kstride + sc * 16);
            if (MODE != 0) vreg = *(const u32x4*)(vsrc + (size_t)(j + 1) * vtile + (size_t)sr * vstride + sc * 16);
        }
        const LAS unsigned char* kt = lds + NSA_KT + cur * 8192;
        const LAS unsigned char* vt = lds + NSA_VT + cur * 8192;
        bool act[2];
#pragma unroll
        for (int rt = 0; rt < 2; ++rt) {
            const int tk = R[rt].tk;
            bool a;
            if (MODE <= 1) { const int nv = tk >= 31 ? ((tk - 31) >> 4) + 1 : 0; a = nv > 64 * j; }
            else if (MODE == 2) a = (rt == 0 ? selbit(selm0.a, selm0.b, selm0.c, selm0.d, j) : selbit(selm1.a, selm1.b, selm1.c, selm1.d, j)) != 0u;
            else a = (64 * j <= tk) && (64 * j + 63 > tk - 512);
            act[rt] = __any(a);
        }
        if (act[0] || act[1]) {
#pragma unroll
            for (int rt = 0; rt < 2; ++rt) {
                if (!act[rt]) continue;
                NsaRT& r = R[rt];
                const int tk = r.tk;
                f32x4 s[4];
#pragma unroll
                for (int t = 0; t < 4; ++t) {
                    const bf16x8 k0 = *(const LAS bf16x8*)(kt + ka0 + t * 2048), k1 = *(const LAS bf16x8*)(kt + ka1 + t * 2048);
                    s[t] = (f32x4){0.f, 0.f, 0.f, 0.f};
                    s[t] = MFMA16(k0, r.q[0], s[t]);
                    s[t] = MFMA16(k1, r.q[1], s[t]);
                }
                int lim_hi, lim_lo;
                if (MODE <= 1) { const int nv = tk >= 31 ? ((tk - 31) >> 4) + 1 : 0; lim_hi = nv - 1; lim_lo = -1; }
                else if (MODE == 2) { lim_hi = ((rt == 0 ? selbit(selm0.a, selm0.b, selm0.c, selm0.d, j) : selbit(selm1.a, selm1.b, selm1.c, selm1.d, j)) != 0u) ? tk : -1; lim_lo = -1; }
                else { lim_hi = tk; lim_lo = tk - 512; }
                const int kb = 64 * j + 4 * g;
                if (MODE == 1) {
                    const float mrow = r.m, invl = r.l > 0.f ? 1.f / r.l : 0.f;
                    float p[4][4];
#pragma unroll
                    for (int t = 0; t < 4; ++t)
#pragma unroll
                        for (int i = 0; i < 4; ++i) { const int key = kb + 16 * t + i; p[t][i] = (key <= lim_hi) ? __expf(s[t][i] - mrow) * invl : 0.f; }
#pragma unroll
                    for (int t = 0; t < 4; ++t) {
                        const float own = (p[t][0] + p[t][1]) + (p[t][2] + p[t][3]);
                        const float x3 = p[t][3];
                        const float up_cur = __shfl(x3, (lane + 48) & 63);
                        const float up_prev = __shfl(carry[rt], (lane + 48) & 63);
                        float v = own + (g >= 1 ? up_cur : up_prev);
                        v += __shfl_xor(v, 1);
                        v += __shfl_xor(v, 2);
                        carry[rt] = x3;
                        if ((qr & 3) == 0) impw[(4 * rt + (qr >> 2)) * 128 + 16 * j + 4 * t + g] = v;
                    }
#pragma unroll
                    for (int ks = 0; ks < 2; ++ks) {
                        bf16x8 pf;
                        const unsigned a0 = pk2(p[2 * ks][0], p[2 * ks][1]), a1 = pk2(p[2 * ks][2], p[2 * ks][3]);
                        const unsigned a2 = pk2(p[2 * ks + 1][0], p[2 * ks + 1][1]), a3 = pk2(p[2 * ks + 1][2], p[2 * ks + 1][3]);
                        u32x4 pu; pu.x = a0; pu.y = a1; pu.z = a2; pu.w = a3;
                        pf = __builtin_bit_cast(bf16x8, pu);
#pragma unroll
                        for (int dt = 0; dt < 4; ++dt) {
                            const u32x2 lo = *(const LAS u32x2*)(vt + (ks ? va2 : va0) + dt * 2048);
                            const u32x2 hi = *(const LAS u32x2*)(vt + (ks ? va3 : va1) + dt * 2048);
                            u32x4 vu; vu.x = lo.x; vu.y = lo.y; vu.z = hi.x; vu.w = hi.y;
                            r.o[dt] = MFMA16(__builtin_bit_cast(bf16x8, vu), pf, r.o[dt]);
                        }
                    }
                } else {
                    float mx = NEG_INF;
#pragma unroll
                    for (int t = 0; t < 4; ++t)
#pragma unroll
                        for (int i = 0; i < 4; ++i) {
                            const int key = kb + 16 * t + i;
                            const bool ok = (key <= lim_hi) && (key > lim_lo);
                            s[t][i] = ok ? s[t][i] : NEG_INF;
                            mx = fmaxf(mx, s[t][i]);
                        }
                    mx = fmaxf(mx, __shfl_xor(mx, 16));
                    mx = fmaxf(mx, __shfl_xor(mx, 32));
                    const float mn = fmaxf(r.m, mx);
                    const float alpha = __expf(r.m - mn);
                    float p[4][4];
                    float rs = 0.f;
#pragma unroll
                    for (int t = 0; t < 4; ++t)
#pragma unroll
                        for (int i = 0; i < 4; ++i) { p[t][i] = (s[t][i] > 0.5f * NEG_INF) ? __expf(s[t][i] - mn) : 0.f; rs += p[t][i]; }
                    rs += __shfl_xor(rs, 16);
                    rs += __shfl_xor(rs, 32);
                    r.l = r.l * alpha + rs;
                    r.m = mn;
                    if (MODE != 0) {
#pragma unroll
                        for (int dt = 0; dt < 4; ++dt) r.o[dt] = r.o[dt] * alpha;
#pragma unroll
                        for (int ks = 0; ks < 2; ++ks) {
                            const unsigned a0 = pk2(p[2 * ks][0], p[2 * ks][1]), a1 = pk2(p[2 * ks][2], p[2 * ks][3]);
                            const unsigned a2 = pk2(p[2 * ks + 1][0], p[2 * ks + 1][1]), a3 = pk2(p[2 * ks + 1][2], p[2 * ks + 1][3]);
                            u32x4 pu; pu.x = a0; pu.y = a1; pu.z = a2; pu.w = a3;
                            const bf16x8 pf = __builtin_bit_cast(bf16x8, pu);
#pragma unroll
                            for (int dt = 0; dt < 4; ++dt) {
                                const u32x2 lo = *(const LAS u32x2*)(vt + (ks ? va2 : va0) + dt * 2048);
                                const u32x2 hi = *(const LAS u32x2*)(vt + (ks ? va3 : va1) + dt * 2048);
                                u32x4 vu; vu.x = lo.x; vu.y = lo.y; vu.z = hi.x; vu.w = hi.y;
                                r.o[dt] = MFMA16(__builtin_bit_cast(bf16x8, vu), pf, r.o[dt]);
                            }
                        }
                    }
                }
            }
        }
        if (j < je) {
            *(LAS u32x4*)(lds + NSA_KT + (cur ^ 1) * 8192 + soff) = kreg;
            if (MODE != 0) *(LAS u32x4*)(lds + NSA_VT + (cur ^ 1) * 8192 + soff) = vreg;
        }
        __syncthreads();
    }
}

__device__ void phase_nsa2(KA ka, int layer, LAS unsigned char* lds) {
    PHASE_IDS
    const int tid = TID, lane = tid & 63, w = __builtin_amdgcn_readfirstlane(tid >> 6), g = lane >> 4, qr = lane & 15;
    const bf16_t* H = PF(H);
    const bf16_t* kcb = PF(kcb);
    const bf16_t* vcT = PF(vcT);
    const bf16_t* vsT = PF(vsT);
    const bf16_t* vwT = PF(vwT);
    bf16_t* Y = PF(Y);
    const float* gate_b = PF(nsa_gate_b) + layer * 24;
    float* impw = (float*)(lds + NSA_IMP + w * 4096);
    unsigned* selw = (unsigned*)(lds + NSA_SEL + w * 128);
    for (int base = BID; base < 256; base += gridDim.x) {
#pragma unroll 1
        for (int half = 0; half < 2; ++half) {
            const int it = half ? 511 - base : base;
            const int chunk = it >> 2, bh = it & 3, b = bh >> 1, hk = bh & 1;
            const size_t rowbase = (size_t)b * T_;
            const int t0w = chunk * 64 + w * 8;
            NsaRT R[2];
            LAS f32x4* finw = (LAS f32x4*)(lds + NSA_FIN + w * 8192) + lane;
#pragma unroll
            for (int rt = 0; rt < 2; ++rt) {
                const int tk = t0w + 4 * rt + (qr >> 2), hh = hk * 4 + (qr & 3);
                R[rt].tk = tk;
                const bf16_t* qp = H + (rowbase + tk) * HLD + C_NQ + hh * 64 + 8 * g;
#pragma unroll
                for (int ks = 0; ks < 2; ++ks) {
                    const u32x4 u = *(const u32x4*)(qp + 32 * ks);
                    const unsigned uu[4] = {u.x, u.y, u.z, u.w};
                    u32x4 o4;
#pragma unroll
                    for (int e = 0; e < 4; ++e) {
                        const float f0 = __uint_as_float(uu[e] << 16) * 0.125f, f1 = __uint_as_float(uu[e] & 0xffff0000u) * 0.125f;
                        o4[e] = (__float_as_uint(f0) >> 16) | (__float_as_uint(f1) & 0xffff0000u);
                    }
                    R[rt].q[ks] = __builtin_bit_cast(bf16x8, o4);
                }
                R[rt].m = NEG_INF; R[rt].l = 0.f;
#pragma unroll
                for (int dt = 0; dt < 4; ++dt) R[rt].o[dt] = (f32x4){0.f, 0.f, 0.f, 0.f};
            }
            SelMask selm0{0u, 0u, 0u, 0u}, selm1{0u, 0u, 0u, 0u};
            float carry[2] = {0.f, 0.f};
            const int tmax = chunk * 64 + 63;
            const int nvmax = tmax >= 31 ? ((tmax - 31) >> 4) + 1 : 0;
            const int nb = (nvmax + 63) >> 6;
            const char* kc_src = (const char*)(kcb + (size_t)bh * 512 * 64);
            const char* vc_src = (const char*)(vcT + (size_t)bh * 64 * 512);
            nsa_loop<0>(lds, tid, lane, w, 0, nb - 1, kc_src, 128, 64 * 128, nullptr, 0, 0, R, selm0, selm1, carry, impw);
            for (int i = lane; i < 8 * 128; i += 64) impw[i] = 0.f;
            wave_sync();
            nsa_loop<1>(lds, tid, lane, w, 0, nb - 1, kc_src, 128, 64 * 128, vc_src, 512 * 2, 64 * 2, R, selm0, selm1, carry, impw);
#pragma unroll
            for (int rt = 0; rt < 2; ++rt) {
                const int hh = hk * 4 + (qr & 3);
                const float gt = sigmoidf_(bf2f(H[(rowbase + R[rt].tk) * HLD + C_NG + hh * 3 + 0]) + gate_b[hh * 3 + 0]);
#pragma unroll
                for (int dt = 0; dt < 4; ++dt) { finw[(rt * 4 + dt) * 64] = R[rt].o[dt] * gt; R[rt].o[dt] = (f32x4){0.f, 0.f, 0.f, 0.f}; }
            }
            wave_sync();
            {
                const int tl = lane >> 3, sub = lane & 7;
                const int tks = t0w + tl, curb = tks >> 6;
                float v[16];
#pragma unroll
                for (int i = 0; i < 16; ++i) {
                    const int jj = sub * 16 + i;
                    const float a = impw[tl * 128 + jj];
                    const bool forced = (jj == 0) || (jj == curb) || (jj == curb - 1);
                    v[i] = (jj <= curb) ? (a + (forced ? 1e4f : 0.f)) : NEG_INF;
                }
                wave_sync();
#pragma unroll
                for (int i = 0; i < 16; ++i) impw[tl * 128 + sub * 16 + i] = v[i];
                wave_sync();
                int cnt[16];
#pragma unroll
                for (int i = 0; i < 16; ++i) cnt[i] = 0;
                for (int jj = 0; jj < 128; ++jj) {
                    const float x = impw[tl * 128 + jj];
#pragma unroll
                    for (int i = 0; i < 16; ++i) cnt[i] += (x > v[i]) || (x == v[i] && jj < sub * 16 + i);
                }
                unsigned bits = 0u;
#pragma unroll
                for (int i = 0; i < 16; ++i) bits |= ((cnt[i] < 16) && (v[i] > 0.5f * NEG_INF)) ? (1u << i) : 0u;
                const unsigned other = __shfl_xor(bits, 1);
                const unsigned word = (sub & 1) ? ((bits << 16) | other) : (bits | (other << 16));
                if ((sub & 1) == 0) selw[tl * 4 + (sub >> 1)] = word;
                wave_sync();
                { const unsigned* q0 = selw + (qr >> 2) * 4; selm0.a = q0[0]; selm0.b = q0[1]; selm0.c = q0[2]; selm0.d = q0[3];
                  selm1.a = q0[16]; selm1.b = q0[17]; selm1.c = q0[18]; selm1.d = q0[19]; }
                wave_sync();
            }
#pragma unroll
            for (int rt = 0; rt < 2; ++rt) { R[rt].m = NEG_INF; R[rt].l = 0.f; }
            nsa_loop<2>(lds, tid, lane, w, 0, chunk, (const char*)(H + rowbase * HLD + C_KS + hk * 64), (size_t)HLD * 2, (size_t)64 * HLD * 2,
                        (const char*)(vsT + (size_t)bh * 64 * T_), (size_t)T_ * 2, 64 * 2, R, selm0, selm1, carry, impw);
#pragma unroll
            for (int rt = 0; rt < 2; ++rt) {
                const int hh = hk * 4 + (qr & 3);
                const float gt = sigmoidf_(bf2f(H[(rowbase + R[rt].tk) * HLD + C_NG + hh * 3 + 1]) + gate_b[hh * 3 + 1]);
                const float sc = gt / R[rt].l;
#pragma unroll
                for (int dt = 0; dt < 4; ++dt) { finw[(rt * 4 + dt) * 64] += R[rt].o[dt] * sc; R[rt].o[dt] = (f32x4){0.f, 0.f, 0.f, 0.f}; }
                R[rt].m = NEG_INF; R[rt].l = 0.f;
            }
            nsa_loop<3>(lds, tid, lane, w, chunk >= 8 ? chunk - 8 : 0, chunk, (const char*)(H + rowbase * HLD + C_KW + hk * 64), (size_t)HLD * 2, (size_t)64 * HLD * 2,
                        (const char*)(vwT + (size_t)bh * 64 * T_), (size_t)T_ * 2, 64 * 2, R, selm0, selm1, carry, impw);
#pragma unroll
            for (int rt = 0; rt < 2; ++rt) {
                const int tk = R[rt].tk, hh = hk * 4 + (qr & 3);
                const float gt = sigmoidf_(bf2f(H[(rowbase + tk) * HLD + C_NG + hh * 3 + 2]) + gate_b[hh * 3 + 2]);
                const float sc = gt / R[rt].l;
                bf16_t* yp = Y + (rowbase + tk) * DM + 256 + hh * 64 + 4 * g;
#pragma unroll
                for (int dt = 0; dt < 4; ++dt) {
                    const f32x4 o = finw[(rt * 4 + dt) * 64] + R[rt].o[dt] * sc;
                    u32x2 wv; wv.x = pk2(o[0], o[1]); wv.y = pk2(o[2], o[3]);
                    *(u32x2*)(yp + 16 * dt) = wv;
                }
            }
        }
    }
}

__device__ void phase_vtrans(KA ka, float* smem) {
    PHASE_IDS
    const int lane = TID & 63, w = TID >> 6;
    bf16_t* scr = (bf16_t*)(smem + w * 4096);
    const bf16_t* H = PF(H);
    for (int it = BID * NW + w; it < 1024; it += gridDim.x * NW) {
        const int tt = it & 127, bh = (it >> 7) & 3, which = it >> 9;
        const int b = bh >> 1, hk = bh & 1;
        const size_t tok0 = (size_t)b * T_ + tt * 64;
        const int col = (which ? C_VW : C_VS) + hk * 64;
        bf16_t* dst = (which ? PF(vwT) : PF(vsT)) + (size_t)bh * 64 * T_ + tt * 64;
        wave_sync();
        for (int i = 0; i < 64; ++i) scr[lane * 66 + i] = H[(tok0 + i) * HLD + col + lane];
        wave_sync();
        for (int d = 0; d < 64; ++d) dst[(size_t)d * T_ + lane] = scr[d * 66 + lane];
    }
}

__device__ void phase_hgrnA(KA ka, int layer, float* smem, int first, int nblk) {
    PHASE_IDS
    const int tid = TID, lane = tid & 63, w = tid >> 6;
    float* Q = smem;
    float* K = smem + 4160;
    float* Bc = smem + 8320;
    float* AT = smem + 12480;
    float* I = smem + 16640;
    float* SEG = smem + 20736;
    const bf16_t* H = PF(H);
    const float* hgl = PF(hg_lower);
    float* hgU = PF(hgU); float* hgG = PF(hgG); bf16_t* hgQB = PF(hgQB); bf16_t* hgO = PF(hgO);
    if (BID < first) return;
    for (int item = BID - first; item < 1024; item += nblk) {
        const int c = item & 127, bh = item >> 7, h = bh & 3, b = bh >> 2;
        const size_t tok0 = (size_t)b * T_ + c * 64;
        __syncthreads();
#pragma unroll
        for (int i = 0; i < 8; ++i) {
            const int e = tid + i * NTHR, t = e >> 6, d = e & 63;
            float lb = 0.f;
            if (layer == 1) {
                const float h0 = hgl[h * 64 + d], h1 = hgl[256 + h * 64 + d];
                const float mx = fmaxf(h0, h1), e0 = expf(h0 - mx), e1 = expf(h1 - mx);
                lb = e1 / (e0 + e1);
            }
            const bf16_t* hp = H + (tok0 + t) * HLD + h * 64 + d;
            const float fl = bf2f(hp[C_HF]);
            const float sg = 1.f / (1.f + expf(-fl)), sgn = 1.f / (1.f + expf(fl));
            const float f = lb + (1.f - lb) * sg;
            Q[t * 65 + d] = bf2f(hp[C_HQ]);
            K[t * 65 + d] = (1.f - lb) * sgn;
            I[t * 64 + d] = bf2f(hp[C_HI]);
            Bc[t * 65 + d] = logf(fmaxf(f, 1e-38f));
        }
        __syncthreads();
        {
            const int d = lane, seg = w;
            float run = 0.f;
#pragma unroll
            for (int i = 0; i < 8; ++i) { run += Bc[(seg * 8 + i) * 65 + d]; Bc[(seg * 8 + i) * 65 + d] = run; }
            SEG[seg * 64 + d] = run;
            __syncthreads();
            float pre = 0.f;
            for (int s2 = 0; s2 < seg; ++s2) pre += SEG[s2 * 64 + d];
#pragma unroll
            for (int i = 0; i < 8; ++i) Bc[(seg * 8 + i) * 65 + d] += pre;
        }
        __syncthreads();
#pragma unroll 1
        for (int i = 0; i < 8; ++i) {
            const int t = w + 8 * i, s = lane;
            float acc = 0.f;
            if (s <= t) {
                for (int d = 0; d < 64; ++d) acc = fmaf(Q[t * 65 + d] * K[s * 65 + d], __expf(Bc[t * 65 + d] - Bc[s * 65 + d]), acc);
            }
            AT[t * 65 + s] = acc;
        }
        __syncthreads();
#pragma unroll 1
        for (int i = 0; i < 8; ++i) {
            const int t = w + 8 * i, v = lane;
            float acc = 0.f;
            for (int s = 0; s <= t; ++s) acc = fmaf(AT[t * 65 + s], I[s * 64 + v], acc);
            hgO[((size_t)item * 64 + t) * 64 + v] = f2bf(acc);
            hgQB[((size_t)item * 64 + t) * 64 + v] = f2bf(Q[t * 65 + v] * __expf(Bc[t * 65 + v]));
            K[t * 65 + v] *= __expf(Bc[63 * 65 + v] - Bc[t * 65 + v]);
        }
        if (tid < 64) hgG[(size_t)item * 64 + tid] = __expf(Bc[63 * 65 + tid]);
        __syncthreads();
#pragma unroll 1
        for (int i = 0; i < 8; ++i) {
            const int d = w + 8 * i, v = lane;
            float acc = 0.f;
            for (int s = 0; s < 64; ++s) acc = fmaf(K[s * 65 + d], I[s * 64 + v], acc);
            hgU[((size_t)item * 64 + d) * 64 + v] = acc;
        }
    }
}

__device__ void phase_hgrnB(KA ka) {
    PHASE_IDS
    const float* hgU = PF(hgU); const float* hgG = PF(hgG); float* hgS = PF(hgS);
    for (int gid = BID * NTHR + TID; gid < 32768; gid += gridDim.x * NTHR) {
        const int bh = gid >> 12, dv = gid & 4095, d = dv >> 6;
        float S = 0.f;
        for (int c0 = 0; c0 < 128; c0 += 8) {
            float u[8], gg[8];
#pragma unroll
            for (int k = 0; k < 8; ++k) { const size_t item = (size_t)bh * 128 + c0 + k; u[k] = hgU[item * 4096 + dv]; gg[k] = hgG[item * 64 + d]; }
#pragma unroll
            for (int k = 0; k < 8; ++k) { const size_t item = (size_t)bh * 128 + c0 + k; hgS[item * 4096 + dv] = S; S = fmaf(gg[k], S, u[k]); }
        }
    }
}

__device__ void phase_hgrnC(KA ka, int layer, float* smem) {
    PHASE_IDS
    const int tid = TID, lane = tid & 63, w = tid >> 6;
    float* QB = smem;
    float* S = smem + 4160;
    const bf16_t* H = PF(H);
    const float* hgS = PF(hgS); const bf16_t* hgQB = PF(hgQB); const bf16_t* hgO = PF(hgO);
    const float* og = PF(out_gain) + layer * 1024;
    bf16_t* Y = PF(Y);
    for (int item = BID; item < 1024; item += gridDim.x) {
        const int c = item & 127, bh = item >> 7, h = bh & 3, b = bh >> 2;
        const size_t tok0 = (size_t)b * T_ + c * 64;
        __syncthreads();
#pragma unroll
        for (int i = 0; i < 8; ++i) {
            const int e = tid + i * NTHR, r = e >> 6, cc = e & 63;
            QB[r * 65 + cc] = bf2f(hgQB[(size_t)item * 4096 + e]);
            S[e] = hgS[(size_t)item * 4096 + e];
        }
        __syncthreads();
#pragma unroll 1
        for (int i = 0; i < 8; ++i) {
            const int t = w + 8 * i, v = lane;
            float acc = bf2f(hgO[((size_t)item * 64 + t) * 64 + v]);
            for (int d = 0; d < 64; ++d) acc = fmaf(QB[t * 65 + d], S[d * 64 + v], acc);
            const float ms = wave_sum(acc * acc) * (1.f / 64.f);
            const float hg = bf2f(H[(tok0 + t) * HLD + C_HG + h * 64 + v]);
            const float y = acc * rsqrtf(ms + 1e-6f) * og[768 + h * 64 + v] * (hg * sigmoidf_(hg));
            Y[(tok0 + t) * DM + 768 + h * 64 + v] = f2bf(y);
        }
    }
}

struct CmpOrder {
    static constexpr bool GATHER = false;
    const char* W1T; int c;
    __device__ __forceinline__ bool next(int i, pg8::Unit& u) const {
        if (i > 0 || c >= 16) return false;
        const int which = c >> 3, bh = (c >> 1) & 3, nt = c & 1;
        u.arow0 = (bh >> 1) * 512 + nt * 256; u.nrows = 256; u.pm = nt; u.pn = 0; u.e = which * 4 + bh; u.ui = 0;
        u.bptr = W1T + (size_t)which * 256 * 2048 * 2;
        return true;
    }
    __device__ __forceinline__ int arow(const pg8::Unit& u, int r) const { return u.arow0 + r; }
    __device__ __forceinline__ int lda(int) const { return 16 * HLD; }
    __device__ __forceinline__ unsigned kstepA() const { return (unsigned)(HLD * 2); }
    __device__ __forceinline__ const char* abase(const pg8::Unit& u, const char* A) const { return A + (((u.e >> 2) ? C_VC : C_KC) + (u.e & 1) * 64) * 2; }
};
struct EpiCmp {
    static constexpr bool PERM = true;
    bf16_t* G; const float* cbias;
    __device__ __forceinline__ void operator()(const f32x4 (&acc)[2][2][4][2], const pg8::Unit& u, int wr, int wc, int fr, int fq) const {
        const float* bp = cbias + (u.e >> 2) * 128 + wc * 32 + 8 * fq;
        const f32x4 b0 = *(const f32x4*)bp, b1 = *(const f32x4*)(bp + 4);
#pragma unroll
        for (int ai = 0; ai < 2; ++ai)
#pragma unroll
            for (int m = 0; m < 4; ++m) {
                const int r = ai * 128 + wr * 64 + m * 16 + fr;
                bf16_t* rowp = G + ((size_t)(u.e * 512 + u.pm * 256 + r)) * 128 + wc * 32 + 8 * fq;
                const f32x4 v0 = acc[ai][0][m][0] + b0, v1 = acc[ai][0][m][1] + b1;
                u32x4 w; w.x = pk2(gelu_t(v0[0]), gelu_t(v0[1])); w.y = pk2(gelu_t(v0[2]), gelu_t(v0[3])); w.z = pk2(gelu_t(v1[0]), gelu_t(v1[1])); w.w = pk2(gelu_t(v1[2]), gelu_t(v1[3]));
                *(u32x4*)rowp = w;
            }
    }
};
__device__ void phase_compress2(KA ka, int layer, LAS unsigned char* lds) {
    const int bid = opaque_bid();
    if (bid >= 16) return;
    CmpOrder S{(const char*)(PF(WT) + WT_C1), bid};
    EpiCmp E{PF(gb), PF(cbias)};
    pg8::gemm_phase<EpiCmp, CmpOrder>(lds, (const char*)PF(H), 2048, S, E);
    __syncthreads();
    const int tid = opaque_tid();
    const int which = bid >> 3, bh = (bid >> 1) & 3, nt = bid & 1;
    float* w2s = (float*)lds;
    const float* w2 = PF(cmp_w2) + ((size_t)layer * 2 + which) * 128 * 64;
    for (int i = tid; i < 128 * 64; i += NTHR) w2s[i] = w2[i];
    __syncthreads();
    const int r = tid >> 1, half = tid & 1;
    const bf16_t* grow = PF(gb) + ((size_t)((which * 4 + bh) * 512 + nt * 256 + r)) * 128;
    float acc[32];
#pragma unroll
    for (int j = 0; j < 32; ++j) acc[j] = 0.f;
    for (int c8 = 0; c8 < 16; ++c8) {
        const u32x4 gu = *(const u32x4*)(grow + c8 * 8);
        const unsigned gw[4] = {gu.x, gu.y, gu.z, gu.w};
#pragma unroll
        for (int e = 0; e < 8; ++e) {
            const float gv = (e & 1) ? __uint_as_float(gw[e >> 1] & 0xffff0000u) : __uint_as_float(gw[e >> 1] << 16);
            const float* wrow = w2s + (c8 * 8 + e) * 64 + half * 32;
#pragma unroll
            for (int j4 = 0; j4 < 8; ++j4) {
                const float4 w4 = *(const float4*)(wrow + j4 * 4);
                acc[j4 * 4 + 0] = fmaf(gv, w4.x, acc[j4 * 4 + 0]); acc[j4 * 4 + 1] = fmaf(gv, w4.y, acc[j4 * 4 + 1]);
                acc[j4 * 4 + 2] = fmaf(gv, w4.z, acc[j4 * 4 + 2]); acc[j4 * 4 + 3] = fmaf(gv, w4.w, acc[j4 * 4 + 3]);
            }
        }
    }
    const int n = nt * 256 + r;
    if (which == 0) {
        bf16_t* o = PF(kcb) + ((size_t)bh * 512 + n) * 64 + half * 32;
#pragma unroll
        for (int j = 0; j < 32; j += 2) *(unsigned*)(o + j) = pk2(acc[j], acc[j + 1]);
    } else {
        bf16_t* o = PF(vcT) + (size_t)bh * 64 * 512 + n;
#pragma unroll
        for (int j = 0; j < 32; ++j) o[(size_t)(half * 32 + j) * 512] = f2bf(acc[j]);
    }
    __syncthreads();
}

__device__ void phase_gmlp2(KA ka, int layer, LAS unsigned char* lds, int first, int nblk) {
    PHASE_IDS
    const int tid = TID, lane = tid & 63, w = __builtin_amdgcn_readfirstlane(tid >> 6), gq = lane >> 4, lc = lane & 15;
    LAS bf16_t* Vt = (LAS bf16_t*)lds;
    const float* gain = PF(gm_v_gain) + layer * 256;
    const float* bias = PF(gm_v_bias) + layer * 256;
    const float* bs = PF(gm_b_s) + layer * 4 * 128;
    const bf16_t* gmW = PF(WT) + WT_GM;
    const bf16_t* H = PF(H);
    bf16_t* Y = PF(Y);
    if (BID < first) return;
    for (int item = BID - first; item < 512; item += nblk) {
        const int g = item & 3, c = (item >> 2) & 63, b = item >> 8;
        const size_t tok0 = (size_t)b * T_ + (size_t)c * 128;
        __syncthreads();
        for (int i = 0; i < 16; ++i) {
            const int s = w * 16 + i;
            const float x = bf2f(H[(tok0 + s) * HLD + C_GV + g * 64 + lane]);
            const float ge = gelu_t(x);
            const float mu = wave_sum(ge) * (1.f / 64.f);
            const float dl = ge - mu;
            const float var = wave_sum(dl * dl) * (1.f / 64.f);
            Vt[lane * 136 + s] = f2bf(dl * rsqrtf(var + 1e-5f) * gain[g * 64 + lane] + bias[g * 64 + lane]);
        }
        __syncthreads();
        f32x4 acc[4];
#pragma unroll
        for (int ct = 0; ct < 4; ++ct) acc[ct] = (f32x4){0.f, 0.f, 0.f, 0.f};
        const bf16_t* wrow = gmW + ((size_t)g * 128 + 16 * w + lc) * 128 + 8 * gq;
        const int kmax = (16 * w + 15) >> 5;
        for (int ks = 0; ks <= kmax; ++ks) {
            const bf16x8 a = *(const bf16x8*)(wrow + 32 * ks);
#pragma unroll
            for (int ct = 0; ct < 4; ++ct) {
                const bf16x8 bfr = *(const LAS bf16x8*)(Vt + (16 * ct + lc) * 136 + 32 * ks + 8 * gq);
                acc[ct] = MFMA16(a, bfr, acc[ct]);
            }
        }
#pragma unroll
        for (int ct = 0; ct < 4; ++ct)
#pragma unroll
            for (int i = 0; i < 4; ++i) {
                const int t = 16 * w + 4 * gq + i, d = 16 * ct + lc;
                const float z = acc[ct][i] + bs[g * 128 + t];
                const float u = gelu_t(bf2f(H[(tok0 + t) * HLD + C_GU + g * 64 + d]));
                Y[(tok0 + t) * DM + g * 64 + d] = f2bf(u * z);
            }
    }
}

#ifndef ONLY_Q
#define ONLY_Q -2
#endif
#ifndef QMASK
#define QMASK 0x3ff
#endif
#define QON(k) ((ONLY_Q == -2 && ((QMASK >> ((k) + 1)) & 1)) || ONLY_Q == (k))
#ifndef DUPMASK
#define DUPMASK 0
#endif
#define DUP(k) ((DUPMASK >> (k)) & 1)
#ifndef PROF_LO
#define PROF_LO -1
#endif
#ifndef PROF_HI
#define PROF_HI -1
#endif
#ifndef NPH_TOTAL
#define NPH_TOTAL 19
#endif
__global__ void __launch_bounds__(NTHR, 2) k_mega(P p0) {
    extern __shared__ __attribute__((aligned(16))) unsigned char lds_raw[];
    LAS unsigned char* lds = (LAS unsigned char*)lds_raw;
    float* smem = (float*)lds_raw;
    volatile LAS unsigned* misc = (volatile LAS unsigned*)(lds + LDS_MISC);
    if (threadIdx.x < 16) misc[threadIdx.x] = 0u;
    __syncthreads();
    XcdBarrier bar = xcd_barrier_post(p0.ctl + CW_BAR, misc);
    if (PROF_LO >= 0 && blockIdx.x == 0 && threadIdx.x == 0) ((unsigned long long*)(p0.ctl + 8192))[0] = __builtin_amdgcn_s_memrealtime();
#pragma unroll 1
    for (int ph = 0; ph < p0.nph; ph++) {
        const int layer = ph == 0 ? 0 : (ph - 1) / 9, q = ph == 0 ? -1 : (ph - 1) % 9;
        const int dupm = p0.pad;
#if defined(__HIP_DEVICE_COMPILE__)
        KA ka = (KA)__builtin_amdgcn_kernarg_segment_ptr();
        asm volatile("" : "+s"(ka));
#else
        KA ka = nullptr;
#endif
        const float* xin = layer == 0 ? PF(x) : PF(out);
        float* x1 = PF(out);
        if (q == -1 && QON(-1)) phase_prologue(ka, 0, smem);
        else if (q == 0 && QON(0)) phase_inproj(ka, layer, lds);
        else if (q == 1 && QON(1)) {
            const int nb1 = (int)gridDim.x > 32 ? 16 : 0, nwork = (int)gridDim.x - nb1;
            for (int r = 0; r <= ((dupm >> 12) & 1); ++r) { phase_compress2(ka, layer, lds); __syncthreads(); }
            for (int r = 0; r <= ((dupm >> 10) & 1); ++r) { phase_hgrnA(ka, layer, smem, nb1, nwork); __syncthreads(); }
            for (int r = 0; r <= ((dupm >> 11) & 1); ++r) { phase_gmlp2(ka, layer, lds, nb1, nwork); __syncthreads(); }
            for (int r = 0; r <= ((dupm >> 13) & 1); ++r) { phase_vtrans(ka, smem); __syncthreads(); }
        }
        else if (q == 2 && QON(2)) { phase_hgrnB(ka); __syncthreads(); for (int r = 0; r <= ((dupm >> 2) & 1); ++r) { phase_nsa2(ka, layer, lds); __syncthreads(); } }
        else if (q == 3 && QON(3)) { phase_hgrnC(ka, layer, smem); phase_headnorm(ka, layer); }
        else if (q == 4 && QON(4)) phase_outproj(ka, layer, xin, x1, lds);
        else if (q == 5 && QON(5)) phase_ln1_route(ka, layer, x1);
        else if (q == 6 && QON(6)) { for (int r = 0; r <= ((dupm >> 6) & 1); ++r) { phase_moe_up(ka, layer, lds); __syncthreads(); } }
        else if (q == 7 && QON(7)) { for (int r = 0; r <= ((dupm >> 7) & 1); ++r) { phase_moe_down(ka, layer, lds); __syncthreads(); } }
        else if (q == 8 && QON(8)) { phase_ln2(ka, layer, x1, PF(out)); if (layer == 0) { __syncthreads(); phase_prologue(ka, 1, smem); } }
        if (ph != NPH_TOTAL - 1 || PROF_LO >= 0) xcd_barrier(bar);
        if (PROF_LO >= 0 && blockIdx.x == 0 && threadIdx.x == 0) ((unsigned long long*)(p0.ctl + 8192))[ph + 1] = __builtin_amdgcn_s_memrealtime();
    }
    if (PROF_LO >= 0) {
        xcd_barrier(bar);
        const unsigned long long* ts = (const unsigned long long*)(p0.ctl + 8192);
        const unsigned long long t0 = __hip_atomic_load(&ts[PROF_LO], __ATOMIC_RELAXED, __HIP_MEMORY_SCOPE_AGENT), t1 = __hip_atomic_load(&ts[PROF_HI + 1], __ATOMIC_RELAXED, __HIP_MEMORY_SCOPE_AGENT);
        const float fac = 1.f + 1e-5f * (float)(t1 - t0);
        for (size_t i = (size_t)blockIdx.x * NTHR + threadIdx.x; i < (size_t)NTOK * DM; i += (size_t)gridDim.x * NTHR) p0.out[i] *= fac;
    }
}

static inline size_t align_up(size_t v, size_t a) { return (v + a - 1) / a * a; }

extern "C" void kernel_launch(void* const* d_in, const int* in_sizes, int n_in, void* d_out, int out_size, void* d_ws,
                              size_t ws_size, hipStream_t stream) {
    P p{};
    p.x = (const float*)d_in[0]; p.w_in = (const float*)d_in[1]; p.gm_v_gain = (const float*)d_in[2];
    p.gm_v_bias = (const float*)d_in[3]; p.gm_w_s = (const float*)d_in[4]; p.gm_b_s = (const float*)d_in[5];
    p.cmp_pos = (const float*)d_in[6]; p.cmp_w1 = (const float*)d_in[7]; p.cmp_w2 = (const float*)d_in[8];
    p.nsa_gate_b = (const float*)d_in[9]; p.hg_lower = (const float*)d_in[10]; p.out_gain = (const float*)d_in[11];
    p.w_out = (const float*)d_in[12]; p.ln1_g = (const float*)d_in[13]; p.ln1_b = (const float*)d_in[14];
    p.rg_w = (const float*)d_in[15]; p.rg_b = (const float*)d_in[16]; p.re_w = (const float*)d_in[17];
    p.re_b = (const float*)d_in[18]; p.w_gate = (const float*)d_in[19]; p.w_up = (const float*)d_in[20];
    p.w_down = (const float*)d_in[21]; p.ln2_g = (const float*)d_in[22]; p.ln2_b = (const float*)d_in[23];
    p.out = (float*)d_out;
    char* ws = (char*)d_ws;
    size_t off = 0;
    p.ctl = (unsigned*)(ws + off); off = align_up(off + CTL_BYTES, 256);
    p.WT = (bf16_t*)(ws + off); off = align_up(off + WT_LAYER * 2, 256);
    p.H = (bf16_t*)(ws + off); off = align_up(off + (size_t)NTOK * HLD * 2, 256);
    p.Y = (bf16_t*)(ws + off); off = align_up(off + (size_t)NTOK * DM * 2, 256);
    p.XB = (bf16_t*)(ws + off); off = align_up(off + (size_t)NTOK * DM * 2, 256);
    p.kcb = (bf16_t*)(ws + off); off = align_up(off + (size_t)4 * 512 * 64 * 2, 256);
    p.vcT = (bf16_t*)(ws + off); off = align_up(off + (size_t)4 * 64 * 512 * 2, 256);
    p.vsT = (bf16_t*)(ws + off); off = align_up(off + (size_t)4 * 64 * T_ * 2, 256);
    p.vwT = (bf16_t*)(ws + off); off = align_up(off + (size_t)4 * 64 * T_ * 2, 256);
    p.gb = (bf16_t*)(ws + off); off = align_up(off + (size_t)8 * 512 * 128 * 2, 256);
    p.cbias = (float*)(ws + off); off = align_up(off + 256 * 4, 256);
    p.list_tok = (int*)(ws + off); off = align_up(off + (size_t)16 * NTOK * 4, 256);
    p.list_w = (float*)(ws + off); off = align_up(off + (size_t)16 * NTOK * 4, 256);
    p.tok_slot = (int*)(ws + off); off = align_up(off + (size_t)NTOK * 2 * 4, 256);
    p.hgU = (float*)p.XB; p.hgS = p.hgU + (size_t)1024 * 4096;
    p.hgG = (float*)(ws + off); off = align_up(off + (size_t)1024 * 64 * 4, 256);
    p.hgQB = (bf16_t*)(ws + off); off = align_up(off + (size_t)1024 * 4096 * 2, 256);
    p.hgO = (bf16_t*)(ws + off); off = align_up(off + (size_t)1024 * 4096 * 2, 256);
    p.nph = NPH_TOTAL; p.pad = DUPMASK;
    (void)in_sizes; (void)n_in; (void)out_size;
    static int grid_blocks = 0;
    if (!grid_blocks) {
        int dev = 0, cus = 0, per_cu = 0;
        (void)hipGetDevice(&dev);
        (void)hipDeviceGetAttribute(&cus, hipDeviceAttributeMultiprocessorCount, dev);
        if (hipFuncSetAttribute((const void*)k_mega, hipFuncAttributeMaxDynamicSharedMemorySize, LDS_BYTES) != hipSuccess) { fprintf(stderr, "hipFuncSetAttribute failed\n"); grid_blocks = -1; return; }
        if (hipOccupancyMaxActiveBlocksPerMultiprocessor(&per_cu, (const void*)k_mega, NTHR, LDS_BYTES) != hipSuccess || per_cu < 1) { fprintf(stderr, "occupancy query says %d\n", per_cu); }
        (void)hipGetLastError();
        grid_blocks = cus;
        if (off > ws_size) { fprintf(stderr, "workspace too small: need %zu have %zu\n", off, ws_size); grid_blocks = -1; }
    }
    if (grid_blocks < 0) return;
    (void)hipMemsetAsync(p.ctl, 0, CTL_BYTES, stream);
    void* args[] = {&p};
    hipError_t e = hipLaunchCooperativeKernel((const void*)k_mega, dim3(grid_blocks), dim3(NTHR), args, LDS_BYTES, stream);
    if (e != hipSuccess) fprintf(stderr, "cooperative launch failed: %s (grid %d)\n", hipGetErrorString(e), grid_blocks);
}
```

```cpp
#include <hip/hip_runtime.h>
#include <cstdio>
#include <cstdint>

#define LAS __attribute__((address_space(3)))
typedef unsigned short bf16_t;
typedef short bf16x8 __attribute__((ext_vector_type(8)));
typedef float f32x4 __attribute__((ext_vector_type(4)));
typedef float f32x2 __attribute__((ext_vector_type(2)));
typedef unsigned u32x4 __attribute__((ext_vector_type(4)));
typedef unsigned u32x2 __attribute__((ext_vector_type(2)));

constexpr int NW = 8;
constexpr int NTHR = NW * 64;
constexpr int T_ = 8192;
constexpr int NTOK = 16384;
constexpr int DM = 1024;
constexpr int IC_SRC = 2840;
constexpr int HLD = 3072;
constexpr int C_GU = 0, C_GV = 256, C_NQ = 512, C_KC = 1024, C_VC = 1152, C_KS = 1280, C_VS = 1408,
              C_KW = 1536, C_VW = 1664, C_HQ = 1792, C_HF = 2048, C_HI = 2304, C_HG = 2560, C_NG = 2816;
constexpr int NCMP = 511;
constexpr float ALPHA = 1.4142135623730951f;
constexpr float NEG_INF = -1e30f;

constexpr size_t WT_IN = 0;
constexpr size_t WT_OUT = WT_IN + (size_t)3072 * 1024;
constexpr size_t WT_UP = WT_OUT + (size_t)1024 * 1024;
constexpr size_t WT_DN = WT_UP + (size_t)16 * 1024 * 1024;
constexpr size_t WT_C1 = WT_DN + (size_t)16 * 1024 * 512;
constexpr size_t WT_GM = WT_C1 + (size_t)2 * 256 * 2048;
constexpr size_t WT_LAYER = WT_GM + (size_t)4 * 128 * 128;

constexpr int LDS_STAGE = 131072;
constexpr int LDS_MISC = LDS_STAGE;
constexpr int LDS_BYTES = 147456;

constexpr int CW_BAR = 0;
constexpr int CW_CNT = 4096;
constexpr size_t CTL_BYTES = 65536;

struct P {
    const float* x; const float* w_in; const float* gm_v_gain; const float* gm_v_bias; const float* gm_w_s;
    const float* gm_b_s; const float* cmp_pos; const float* cmp_w1; const float* cmp_w2; const float* nsa_gate_b;
    const float* hg_lower; const float* out_gain; const float* w_out; const float* ln1_g; const float* ln1_b;
    const float* rg_w; const float* rg_b; const float* re_w; const float* re_b; const float* w_gate;
    const float* w_up; const float* w_down; const float* ln2_g; const float* ln2_b;
    float* out;
    unsigned* ctl;
    bf16_t* WT;
    bf16_t* H;
    bf16_t* Y;
    bf16_t* XB;
    bf16_t* kcb;
    bf16_t* vcT;
    bf16_t* vsT;
    bf16_t* vwT;
    bf16_t* gb;
    float* cbias;
    int* list_tok;
    float* list_w;
    int* tok_slot;
    float* hgU; float* hgG; float* hgS; bf16_t* hgQB; bf16_t* hgO;
    int nph; int pad;
};


typedef const __attribute__((address_space(4))) char* KA;
template <class T> __device__ __forceinline__ T ldarg(KA ka, size_t off) { return *(const __attribute__((address_space(4))) T*)(ka + off); }
#define PF(f) ldarg<decltype(P::f)>(ka, offsetof(P, f))

__device__ __forceinline__ float bf2f(bf16_t u) { return __uint_as_float(((unsigned)u) << 16); }
__device__ __forceinline__ unsigned f2bf_u(float f) {
    unsigned u = __float_as_uint(f);
    return (u + 0x7fffu + ((u >> 16) & 1u)) >> 16;
}
__device__ __forceinline__ bf16_t f2bf(float f) { return (bf16_t)f2bf_u(f); }
__device__ __forceinline__ unsigned pk2(float lo, float hi) { return f2bf_u(lo) | (f2bf_u(hi) << 16); }
__device__ __forceinline__ float gelu_t(float x) {
    float u = 0.7978845608028654f * (x + 0.044715f * x * x * x);
    return 0.5f * x * (1.f + tanhf(u));
}
__device__ __forceinline__ float sigmoidf_(float x) { return 1.f / (1.f + __expf(-x)); }
__device__ __forceinline__ float wave_max(float v) {
#pragma unroll
    for (int o = 32; o > 0; o >>= 1) v = fmaxf(v, __shfl_xor(v, o));
    return v;
}
__device__ __forceinline__ float wave_sum(float v) {
#pragma unroll
    for (int o = 32; o > 0; o >>= 1) v += __shfl_xor(v, o);
    return v;
}
__device__ __forceinline__ void wave_sync() {
    __builtin_amdgcn_fence(__ATOMIC_RELEASE, "wavefront");
    __builtin_amdgcn_wave_barrier();
    __builtin_amdgcn_fence(__ATOMIC_ACQUIRE, "wavefront");
}
__device__ __forceinline__ int opaque_tid() { int t = threadIdx.x; asm volatile("" : "+v"(t)); return t; }
__device__ __forceinline__ int opaque_bid() { int b = blockIdx.x; asm volatile("" : "+s"(b)); return b; }
#define PHASE_IDS const int TID = opaque_tid(); const int BID = opaque_bid(); (void)TID; (void)BID;

#define XB_TMO      128
#define XB_XCNT(j)  (256  + 64 * (j))
#define XB_XSUB(j)  (1280 + 64 * (j))
#define XB_XGEN(j)  (2304 + 64 * (j))
#define XB_TOP      3328
#define XB_TOPGEN   3392
#define XCD_BAR_WORDS 3456
#define XB_SPIN_CAP (1u << 22)
__device__ __forceinline__ unsigned xb_ld(unsigned* p)              { return __hip_atomic_load(p, __ATOMIC_RELAXED, __HIP_MEMORY_SCOPE_AGENT); }
__device__ __forceinline__ unsigned xb_add(unsigned* p, unsigned v) { return __hip_atomic_fetch_add(p, v, __ATOMIC_RELAXED, __HIP_MEMORY_SCOPE_AGENT); }
__device__ __forceinline__ unsigned xb_xcc_id() { return (unsigned)__builtin_amdgcn_s_getreg((3 << 11) | 20) & 0xFu; }
#define XB_SPIN(cond, bar) do { unsigned _sp = 0; while (cond) { __builtin_amdgcn_s_sleep(1); \
    if ((++_sp & 255u) == 0u) { if (xb_ld(&(bar)[XB_TMO])) break; if (_sp > XB_SPIN_CAP) { atomicAdd(&(bar)[XB_TMO], 1u); break; } } } } while (0)
struct XcdBarrier { unsigned* bar; unsigned x; volatile LAS unsigned* st; };
__device__ __forceinline__ XcdBarrier xcd_barrier_post(unsigned* bar, volatile LAS unsigned* st) {
    XcdBarrier b; b.bar = bar; b.x = xb_xcc_id(); b.st = st;
    if (threadIdx.x == 0) (void)xb_add(&bar[XB_XCNT(b.x)], 1u);
    return b;
}
__device__ __forceinline__ void xcd_barrier_complete(unsigned* bar, unsigned x, unsigned& nloc, unsigned& nx) {
    const unsigned G = gridDim.x * gridDim.y * gridDim.z;
    unsigned sum, cnt, mine, sp = 0u;
    for (;;) {
        sum = 0u; cnt = 0u; mine = 0u;
#pragma unroll
        for (unsigned j = 0; j < 16; ++j) { const unsigned c = xb_ld(&bar[XB_XCNT(j)]); sum += c; cnt += (c > 0u) ? 1u : 0u; mine = (j == x) ? c : mine; }
        if (sum == G) break;
        __builtin_amdgcn_s_sleep(1);
        if ((++sp & 255u) == 0u) { if (xb_ld(&bar[XB_TMO])) break; if (sp > XB_SPIN_CAP) { atomicAdd(&bar[XB_TMO], 1u); break; } }
    }
    nloc = mine > 0u ? mine : 1u; nx = cnt > 0u ? cnt : 1u;
}
__device__ __forceinline__ void xcd_barrier(const XcdBarrier& b) {
    asm volatile("s_waitcnt vmcnt(0)" ::: "memory");
    __syncthreads();
    if (threadIdx.x == 0) {
        unsigned* bar = b.bar;
        __builtin_amdgcn_s_waitcnt(0);
        unsigned nloc = b.st[0], nx = b.st[1];
        if (nloc == 0u) { xcd_barrier_complete(bar, b.x, nloc, nx); b.st[0] = nloc; b.st[1] = nx; }
        const unsigned old = xb_add(&bar[XB_XSUB(b.x)], 1u);
        const unsigned gen = old / nloc;
        if (old + 1u == (gen + 1u) * nloc) {
            __builtin_amdgcn_fence(__ATOMIC_RELEASE, "agent");
            asm volatile("s_waitcnt vmcnt(0)" ::: "memory");
            const unsigned og = xb_add(&bar[XB_TOP], 1u);
            const unsigned tg = og / nx;
            if (og + 1u == (tg + 1u) * nx) xb_add(&bar[XB_TOPGEN], 1u);
            else XB_SPIN(xb_ld(&bar[XB_TOPGEN]) == tg, bar);
            __builtin_amdgcn_fence(__ATOMIC_ACQUIRE, "agent");
            xb_add(&bar[XB_XGEN(b.x)], 1u);
            asm volatile("s_waitcnt vmcnt(0)" ::: "memory");
        } else {
            XB_SPIN(xb_ld(&bar[XB_XGEN(b.x)]) == gen, bar);
            __builtin_amdgcn_fence(__ATOMIC_ACQUIRE, "agent");
            asm volatile("s_waitcnt vmcnt(0)" ::: "memory");
        }
    }
    __syncthreads();
}

namespace pg8 {
constexpr int BM = 256, BK = 64, HALF = 128, HTB = HALF * BK * 2, STAGE_BYTES = 8 * HTB;
__host__ __device__ __forceinline__ int lds_byte(int r, int c) { const int st = (r >> 4) * 2 + (c >> 5), rr = r & 15, cc = c & 31, ob = rr * 64 + cc * 2; return st * 1024 + (ob ^ (((ob >> 9) & 1) << 5)); }
__host__ __device__ __forceinline__ void stage_rc(int b, int& R, int& C) { const int st = b / 1024, sb = b % 1024, swz = sb ^ (((sb >> 9) & 1) << 5); R = (st >> 1) * 16 + swz / 64; C = (st & 1) * 32 + (swz % 64) / 2; }
__host__ __device__ __forceinline__ int perm32(int rho) { const int n = rho >> 4, i = rho & 15; return 8 * (i >> 2) + 4 * n + (i & 3); }
__device__ __forceinline__ unsigned cvt_pk_bf16(float lo, float hi) { unsigned r; asm volatile("v_cvt_pk_bf16_f32 %0, %1, %2" : "=v"(r) : "v"(lo), "v"(hi)); return r; }

struct Unit {
    const char* bptr;
    int arow0;
    int nrows;
    int pm, pn, e, ui;
};

template <class Epi, class Sched>
__device__ __forceinline__ void gemm_phase(LAS unsigned char* lds, const char* Abase, const int K, const Sched& S, const Epi& E) {
    const int tid = opaque_tid(), wid = __builtin_amdgcn_readfirstlane(tid >> 6), lane = tid & 63, wr = wid >> 2, wc = wid & 3, fr = lane & 15, fq = lane >> 4;
    const int nt = K / BK;
    int R0, C0, R1, C1; stage_rc(tid * 16, R0, C0); stage_rc(tid * 16 + 8192, R1, C1);
    unsigned voffB[2];
    { const int Rb0 = Epi::PERM ? ((R0 & ~31) + perm32(R0 & 31)) : R0, Rb1 = Epi::PERM ? ((R1 & ~31) + perm32(R1 & 31)) : R1;
      voffB[0] = (unsigned)(Rb0 * K + C0) * 2u; voffB[1] = (unsigned)(Rb1 * K + C1) * 2u; }
    const unsigned cA0 = (unsigned)C0 * 2u, cA1 = (unsigned)C1 * 2u;
    const int lda = S.lda(K);
    const unsigned kstepA = S.kstepA();
    const unsigned voffA0 = (unsigned)(R0 * lda + C0) * 2u, voffA1 = (unsigned)(R1 * lda + C1) * 2u;
    const unsigned kstep = (unsigned)(BK * 2);
    const unsigned hstep = (unsigned)(HALF * K * 2);
    const unsigned ldsw = (unsigned)wid * 1024u;
    const int aoff = lds_byte(wr * 64 + fr, fq * 8), boff = lds_byte(wc * 32 + fr, fq * 8);
#define PG8_SA(b, h) (((b) * 2 + (h)) * HTB)
#define PG8_SB(b, h) ((4 + (b) * 2 + (h)) * HTB)
#define PG8_STAGE_B(bufoff, gbase) do { \
        __builtin_amdgcn_global_load_lds((const unsigned*)((const char*)(gbase) + voffB[0]), (LAS unsigned*)(lds + (bufoff) + ldsw), 16, 0, 0); \
        __builtin_amdgcn_global_load_lds((const unsigned*)((const char*)(gbase) + voffB[1]), (LAS unsigned*)(lds + (bufoff) + ldsw + 8192), 16, 0, 0); } while (0)
#define PG8_STAGE_A(bufoff, gbase, pk) do { \
        const unsigned o0_ = Sched::GATHER ? (((pk) & 0xffffu) * (unsigned)lda * 2u + cA0) : voffA0; \
        const unsigned o1_ = Sched::GATHER ? (((pk) >> 16) * (unsigned)lda * 2u + cA1) : voffA1; \
        __builtin_amdgcn_global_load_lds((const unsigned*)((const char*)(gbase) + o0_), (LAS unsigned*)(lds + (bufoff) + ldsw), 16, 0, 0); \
        __builtin_amdgcn_global_load_lds((const unsigned*)((const char*)(gbase) + o1_), (LAS unsigned*)(lds + (bufoff) + ldsw + 8192), 16, 0, 0); } while (0)
#define PG8_LDA(dst, b, h) do { _Pragma("unroll") for (int m = 0; m < 4; ++m) _Pragma("unroll") for (int k = 0; k < 2; ++k) dst[m][k] = *(const LAS bf16x8*)(lds + PG8_SA(b, h) + aoff + m * 2048 + k * 1024); } while (0)
#define PG8_LDB(dst, b, h) do { _Pragma("unroll") for (int n = 0; n < 2; ++n) _Pragma("unroll") for (int k = 0; k < 2; ++k) dst[n][k] = *(const LAS bf16x8*)(lds + PG8_SB(b, h) + boff + n * 2048 + k * 1024); } while (0)
#define PG8_MMA(ai, bj, At, Bt) do { __builtin_amdgcn_s_setprio(1); _Pragma("unroll") for (int m = 0; m < 4; ++m) _Pragma("unroll") for (int n = 0; n < 2; ++n) _Pragma("unroll") for (int k = 0; k < 2; ++k) \
        acc[ai][bj][m][n] = __builtin_amdgcn_mfma_f32_16x16x32_bf16(Bt[n][k], At[m][k], acc[ai][bj][m][n], 0, 0, 0); __builtin_amdgcn_s_setprio(0); } while (0)
#define PG8_WAIT_V(n) asm volatile("s_waitcnt vmcnt(" #n ")" ::: "memory")
#define PG8_WAIT_L(n) asm volatile("s_waitcnt lgkmcnt(" #n ")" ::: "memory")
#define PG8_BAR __builtin_amdgcn_s_barrier()
#define PG8_SCHED __builtin_amdgcn_sched_barrier(0)
#define PG8_PACK(u, h) ((unsigned)S.arow((u), ((h) * 128 + R0) < (u).nrows ? ((h) * 128 + R0) : (u).nrows - 1) | ((unsigned)S.arow((u), ((h) * 128 + R1) < (u).nrows ? ((h) * 128 + R1) : (u).nrows - 1) << 16))
    Unit cur, nxt; int ui = 0;
    if (!S.next(0, cur)) return;
    f32x4 acc[2][2][4][2];
#pragma unroll
    for (int a = 0; a < 2; ++a)
#pragma unroll
        for (int b = 0; b < 2; ++b)
#pragma unroll
            for (int m = 0; m < 4; ++m)
#pragma unroll
                for (int n = 0; n < 2; ++n) acc[a][b][m][n] = (f32x4){0.f, 0.f, 0.f, 0.f};
    bf16x8 At[4][2], B0[2][2], B1[2][2];
    unsigned pC0 = 0u, pC1 = 0u, pN0 = 0u, pN1 = 0u;
    if (Sched::GATHER) { pC0 = PG8_PACK(cur, 0); pC1 = PG8_PACK(cur, 1); }
    const char* cB = cur.bptr;
    const char* cA = Sched::GATHER ? Abase : S.abase(cur, Abase) + (size_t)cur.arow0 * lda * 2;
    const unsigned hA = Sched::GATHER ? 0u : (unsigned)(HALF * lda * 2);
    PG8_STAGE_B(PG8_SB(0, 0), cB); PG8_STAGE_B(PG8_SB(0, 1), cB + hstep); PG8_STAGE_A(PG8_SA(0, 0), cA, pC0); PG8_STAGE_A(PG8_SA(0, 1), cA + hA, pC1);
    if (wr == 1) PG8_BAR;
    PG8_WAIT_V(2); PG8_BAR;
    PG8_STAGE_B(PG8_SB(1, 0), cB + kstep); PG8_STAGE_A(PG8_SA(1, 0), cA + kstepA, pC0); PG8_STAGE_B(PG8_SB(1, 1), cB + hstep + kstep);
    PG8_WAIT_V(6); PG8_BAR;
    for (;;) {
        const bool has_next = S.next(ui + 1, nxt);
        if (Sched::GATHER) { if (has_next) { pN0 = PG8_PACK(nxt, 0); pN1 = PG8_PACK(nxt, 1); } else { pN0 = pC0; pN1 = pC1; } }
        const char* nB = has_next ? nxt.bptr : cB;
        const char* nA = (Sched::GATHER || !has_next) ? cA : S.abase(nxt, Abase) + (size_t)nxt.arow0 * lda * 2;
        for (int t = 0; t < nt; t += 2) {
            const bool last = (t == nt - 2);
            const char* a1 = cA + (unsigned)(t + 1) * kstepA;
            const char* a2 = last ? nA : cA + (unsigned)(t + 2) * kstepA; const char* b2 = last ? nB : cB + (unsigned)(t + 2) * kstep;
            const char* a3 = a2 + kstepA; const char* b3 = b2 + kstep;
            const unsigned s0 = last ? pN0 : pC0, s1 = last ? pN1 : pC1;
            PG8_LDB(B0, 0, 0); PG8_LDB(B1, 0, 1); PG8_SCHED; PG8_LDA(At, 0, 0); PG8_STAGE_A(PG8_SA(1, 1), a1 + hA, pC1);
            PG8_WAIT_V(8); PG8_WAIT_L(0); PG8_BAR; PG8_MMA(0, 0, At, B0); PG8_MMA(0, 1, At, B1); PG8_BAR; PG8_SCHED;
            PG8_LDA(At, 0, 1); PG8_STAGE_B(PG8_SB(0, 0), b2); PG8_STAGE_B(PG8_SB(0, 1), b2 + hstep); PG8_STAGE_A(PG8_SA(0, 0), a2, s0);
            PG8_WAIT_V(8); PG8_WAIT_L(0); PG8_BAR; PG8_MMA(1, 0, At, B0); PG8_MMA(1, 1, At, B1); PG8_BAR; PG8_SCHED;
            PG8_LDB(B0, 1, 0); PG8_LDB(B1, 1, 1); PG8_SCHED; PG8_LDA(At, 1, 0); PG8_STAGE_A(PG8_SA(0, 1), a2 + hA, s1);
            PG8_WAIT_V(8); PG8_WAIT_L(0); PG8_BAR; PG8_MMA(0, 0, At, B0); PG8_MMA(0, 1, At, B1); PG8_BAR; PG8_SCHED;
            PG8_LDA(At, 1, 1); PG8_STAGE_B(PG8_SB(1, 0), b3); PG8_STAGE_B(PG8_SB(1, 1), b3 + hstep); PG8_STAGE_A(PG8_SA(1, 0), a3, s0);
            PG8_WAIT_V(8); PG8_WAIT_L(0); PG8_BAR; PG8_MMA(1, 0, At, B0); PG8_MMA(1, 1, At, B1); PG8_BAR; PG8_SCHED;
        }
        if (wr == 0) PG8_BAR;
        E(acc, cur, wr, wc, fr, fq);
        if (!has_next) break;
#pragma unroll
        for (int a = 0; a < 2; ++a)
#pragma unroll
            for (int b = 0; b < 2; ++b)
#pragma unroll
                for (int m = 0; m < 4; ++m)
#pragma unroll
                    for (int n = 0; n < 2; ++n) acc[a][b][m][n] = (f32x4){0.f, 0.f, 0.f, 0.f};
        cur = nxt; cB = nB; cA = nA; ++ui;
        pC0 = pN0; pC1 = pN1;
        if (wr == 1) PG8_BAR;
    }
    PG8_WAIT_V(0);
    PG8_BAR;
#undef PG8_SA
#undef PG8_SB
#undef PG8_STAGE_A
#undef PG8_STAGE_B
#undef PG8_LDA
#undef PG8_LDB
#undef PG8_MMA
#undef PG8_WAIT_V
#undef PG8_WAIT_L
#undef PG8_BAR
#undef PG8_SCHED
#undef PG8_PACK
}

struct DenseOrder {
    static constexpr bool GATHER = false;
    int nM, nN, nwg, G, c; const char* Bt; int K;
    __device__ void init(int M, int N, int K_, const bf16_t* Bt_, int G_, int c_) { nM = M / BM; nN = N / BM; nwg = nM * nN; G = G_; c = c_; Bt = (const char*)Bt_; K = K_; }
    __device__ __forceinline__ bool next(int i, Unit& u) const {
        const long L = (long)i * G + c; if (L >= nwg) return false;
        int wgid = (int)L; { const int q = nwg / 8, r = nwg % 8, xcd = wgid % 8, off = wgid / 8; wgid = (xcd < r ? xcd * (q + 1) : r * (q + 1) + (xcd - r) * q) + off; }
        const int nig = 8 * nN, gid = wgid / nig, fm = gid * 8, gsz = (nM - fm) < 8 ? (nM - fm) : 8;
        u.pm = fm + ((wgid % nig) % gsz); u.pn = (wgid % nig) / gsz;
        u.arow0 = u.pm * BM; u.nrows = BM; u.e = 0; u.ui = i;
        u.bptr = Bt + (size_t)u.pn * BM * K * 2;
        return true;
    }
    __device__ __forceinline__ int arow(const Unit& u, int r) const { return u.arow0 + r; }
    __device__ __forceinline__ int lda(int K_) const { return K_; }
    __device__ __forceinline__ unsigned kstepA() const { return 128u; }
    __device__ __forceinline__ const char* abase(const Unit&, const char* A) const { return A; }
};
}

struct EpiH {
    static constexpr bool PERM = true;
    bf16_t* H;
    __device__ __forceinline__ void operator()(const f32x4 (&acc)[2][2][4][2], const pg8::Unit& u, int wr, int wc, int fr, int fq) const {
        const int row0 = u.arow0 + wr * 64 + fr, col0 = u.pn * 256 + wc * 32 + 8 * fq;
#pragma unroll
        for (int ai = 0; ai < 2; ++ai)
#pragma unroll
            for (int m = 0; m < 4; ++m) {
                bf16_t* rowp = H + (size_t)(row0 + ai * 128 + m * 16) * HLD + col0;
#pragma unroll
                for (int bj = 0; bj < 2; ++bj) {
                    const f32x4 v0 = acc[ai][bj][m][0], v1 = acc[ai][bj][m][1];
                    u32x4 w; w.x = pg8::cvt_pk_bf16(v0[0], v0[1]); w.y = pg8::cvt_pk_bf16(v0[2], v0[3]); w.z = pg8::cvt_pk_bf16(v1[0], v1[1]); w.w = pg8::cvt_pk_bf16(v1[2], v1[3]);
                    *(u32x4*)(rowp + bj * 128) = w;
                }
            }
    }
};
struct EpiRes {
    static constexpr bool PERM = false;
    const float* xin; float* out;
    __device__ __forceinline__ void operator()(const f32x4 (&acc)[2][2][4][2], const pg8::Unit& u, int wr, int wc, int fr, int fq) const {
        const int row0 = u.arow0 + wr * 64 + fr, col0 = u.pn * 256 + wc * 32 + 4 * fq;
#pragma unroll
        for (int ai = 0; ai < 2; ++ai)
#pragma unroll
            for (int m = 0; m < 4; ++m) {
                const size_t off = (size_t)(row0 + ai * 128 + m * 16) * DM + col0;
#pragma unroll
                for (int bj = 0; bj < 2; ++bj)
#pragma unroll
                    for (int n = 0; n < 2; ++n) {
                        const f32x4 xv = *(const f32x4*)(xin + off + bj * 128 + n * 16);
                        *(f32x4*)(out + off + bj * 128 + n * 16) = xv * ALPHA + acc[ai][bj][m][n];
                    }
            }
    }
};

template <class RM>
__device__ __forceinline__ void transpose_item(const float* W, int K, int N, bf16_t* WT, RM rowmap, float* scr, int kb, int nb, int lane) {
    const int k0 = 64 * kb, n0 = 32 * nb;
    const int nn = n0 + (lane & 31);
#pragma unroll 8
    for (int i = 0; i < 32; ++i) {
        const int kk = 2 * i + (lane >> 5);
        scr[kk * 33 + (lane & 31)] = nn < N ? W[(size_t)(k0 + kk) * N + nn] : 0.f;
    }
    wave_sync();
    const int c = lane & 7;
#pragma unroll
    for (int j = 0; j < 4; ++j) {
        const int n = (lane >> 3) + 8 * j;
        const float* s = scr + (8 * c) * 33 + n;
        u32x4 o; o.x = pk2(s[0 * 33], s[1 * 33]); o.y = pk2(s[2 * 33], s[3 * 33]); o.z = pk2(s[4 * 33], s[5 * 33]); o.w = pk2(s[6 * 33], s[7 * 33]);
        const int dr = (n0 + n < N) ? rowmap(n0 + n) : -1;
        if (dr >= 0) *(u32x4*)(WT + (size_t)dr * K + k0 + 8 * c) = o;
    }
    wave_sync();
}

__device__ void phase_prologue(KA ka, int layer, float* smem) {
    PHASE_IDS
    const int lane = TID & 63, w = TID >> 6;
    float* scr = smem + w * 4096;
    const int gw = BID * NW + w, NGW = gridDim.x * NW;
    constexpr int I_IN = 16 * 89, I_OUT = 16 * 32, I_GU = 16 * 16, I_DN = 8 * 32;
    constexpr int I_LAYER = I_IN + I_OUT + 32 * I_GU + 16 * I_DN;
    for (int it = gw; it < I_LAYER; it += NGW) {
        int r = it;
        bf16_t* WT = PF(WT);
        if (r < I_IN) {
            transpose_item(PF(w_in) + (size_t)layer * DM * IC_SRC, DM, IC_SRC, WT + WT_IN,
                           [](int n) { return n < 1792 ? n : (n < 1816 ? 2816 + (n - 1792) : n - 24); }, scr, r / 89, r % 89, lane);
            continue;
        }
        r -= I_IN;
        if (r < I_OUT) {
            transpose_item(PF(w_out) + (size_t)layer * DM * DM, DM, DM, WT + WT_OUT, [](int n) { return n; }, scr, r / 32, r % 32, lane);
            continue;
        }
        r -= I_OUT;
        if (r < 32 * I_GU) {
            const int mat = r / I_GU, rr = r % I_GU, e = mat >> 1, isup = mat & 1;
            const float* W = (isup ? PF(w_up) : PF(w_gate)) + ((size_t)layer * 16 + e) * DM * 512;
            transpose_item(W, DM, 512, WT + WT_UP + (size_t)e * 1024 * 1024,
                           [isup](int n) { return (n >> 7) * 256 + isup * 128 + (n & 127); }, scr, rr / 16, rr % 16, lane);
            continue;
        }
        r -= 32 * I_GU;
        {
            const int e = r / I_DN, rr = r % I_DN;
            transpose_item(PF(w_down) + ((size_t)layer * 16 + e) * 512 * DM, 512, DM, WT + WT_DN + (size_t)e * 1024 * 512,
                           [](int n) { return n; }, scr, rr / 32, rr % 32, lane);
        }
    }
    for (int it = gw; it < 2 * 32 * 4; it += NGW) {
        const int which = it >> 7, rr = it & 127;
        transpose_item(PF(cmp_w1) + ((size_t)layer * 2 + which) * 2048 * 128, 2048, 128, PF(WT) + WT_C1 + (size_t)which * 256 * 2048, [](int n) { return n; }, scr, rr >> 2, rr & 3, lane);
    }
    for (int i = BID * NTHR + TID; i < 2 * 128 * 256; i += gridDim.x * NTHR) {
        const int which = i >> 15, q = i & 32767;
        u32x4 z; z.x = 0u; z.y = 0u; z.z = 0u; z.w = 0u;
        *(u32x4*)(PF(WT) + WT_C1 + (size_t)which * 256 * 2048 + (size_t)128 * 2048 + (size_t)q * 8) = z;
    }
    for (int o = gw; o < 256; o += NGW) {
        const int which = o >> 7, cc = o & 127;
        const float* w1 = PF(cmp_w1) + ((size_t)layer * 2 + which) * 2048 * 128;
        const float* pos = PF(cmp_pos) + ((size_t)layer * 2 + which) * 2048;
        float a = 0.f;
        for (int k = lane; k < 2048; k += 64) a = fmaf(pos[k], w1[(size_t)k * 128 + cc], a);
        a = wave_sum(a);
        if (lane == 0) PF(cbias)[o] = a;
    }
    for (int i = BID * NTHR + TID; i < 4 * 128 * 128; i += gridDim.x * NTHR) {
        const int s = i & 127, t = (i >> 7) & 127;
        PF(WT)[WT_GM + i] = (s <= t) ? f2bf(PF(gm_w_s)[(size_t)layer * 4 * 128 * 128 + i]) : (bf16_t)0;
    }
    for (int i = BID * NTHR + TID; i < 232 * 128; i += gridDim.x * NTHR) {
        const int q = i;
        u32x4 z; z.x = 0u; z.y = 0u; z.z = 0u; z.w = 0u;
        *(u32x4*)(PF(WT) + WT_IN + (size_t)2840 * 1024 + (size_t)q * 8) = z;
    }
    if (layer == 0)
    for (int row = gw; row < NTOK; row += NGW) {
        const f32x4* xr = (const f32x4*)(PF(x) + (size_t)row * DM) + lane;
        u32x2* o = (u32x2*)(PF(XB) + (size_t)row * DM) + lane;
#pragma unroll
        for (int j = 0; j < 4; ++j) {
            const f32x4 v = xr[64 * j];
            u32x2 ww; ww.x = pk2(v[0], v[1]); ww.y = pk2(v[2], v[3]);
            o[64 * j] = ww;
        }
    }
}

template <class AF, class BF, class EF>
__device__ __forceinline__ void gemm128(int tid, int m0, int n0, int M, int N, int K, AF af, BF bf, EF ef, float* smem) {
    float* As = smem;
    float* Bs = smem + 16 * 132;
    const bool active = tid < 256;
    const int tx = tid & 15, ty = (tid >> 4) & 15;
    float acc[8][8];
#pragma unroll
    for (int i = 0; i < 8; i++)
#pragma unroll
        for (int j = 0; j < 8; j++) acc[i][j] = 0.f;
#pragma unroll 1
    for (int k0 = 0; k0 < K; k0 += 16) {
        if (active) {
#pragma unroll
            for (int i = 0; i < 8; i++) {
                int e = tid + i * 256;
                int r = e >> 4, kk = e & 15;
                float v = 0.f;
                if (m0 + r < M) v = af(m0 + r, k0 + kk);
                As[kk * 132 + r] = v;
            }
#pragma unroll
            for (int i = 0; i < 8; i++) {
                int e = tid + i * 256;
                int kk = e >> 7, c = e & 127;
                float v = 0.f;
                if (n0 + c < N) v = bf(k0 + kk, n0 + c);
                Bs[kk * 132 + c] = v;
            }
        }
        __syncthreads();
        if (active) {
#pragma unroll 2
            for (int kk = 0; kk < 16; kk++) {
                asm volatile("" ::: "memory");
                float4 a0 = *(const float4*)&As[kk * 132 + ty * 8];
                float4 a1 = *(const float4*)&As[kk * 132 + ty * 8 + 4];
                float4 b0 = *(const float4*)&Bs[kk * 132 + tx * 8];
                float4 b1 = *(const float4*)&Bs[kk * 132 + tx * 8 + 4];
                float a[8] = {a0.x, a0.y, a0.z, a0.w, a1.x, a1.y, a1.z, a1.w};
                float b[8] = {b0.x, b0.y, b0.z, b0.w, b1.x, b1.y, b1.z, b1.w};
#pragma unroll
                for (int i = 0; i < 8; i++)
#pragma unroll
                    for (int j = 0; j < 8; j++) acc[i][j] = fmaf(a[i], b[j], acc[i][j]);
            }
        }
        __syncthreads();
    }
    if (active) {
#pragma unroll
        for (int i = 0; i < 8; i++)
#pragma unroll
            for (int j = 0; j < 8; j++) {
                int m = m0 + ty * 8 + i, n = n0 + tx * 8 + j;
                if (m < M && n < N) ef(m, n, acc[i][j]);
            }
    }
}

__device__ __forceinline__ void phase_inproj(KA ka, int layer, LAS unsigned char* lds) {
    pg8::DenseOrder S; S.init(NTOK, HLD, DM, PF(WT) + WT_IN, gridDim.x, opaque_bid());
    EpiH E{PF(H)};
    pg8::gemm_phase<EpiH, pg8::DenseOrder>(lds, (const char*)PF(XB), DM, S, E);
}
__device__ __forceinline__ void phase_outproj(KA ka, int layer, const float* xin, float* x1, LAS unsigned char* lds) {
    pg8::DenseOrder S; S.init(NTOK, DM, DM, PF(WT) + WT_OUT, gridDim.x, opaque_bid());
    EpiRes E{xin, x1};
    pg8::gemm_phase<EpiRes, pg8::DenseOrder>(lds, (const char*)PF(Y), DM, S, E);
}

__device__ void phase_ln1_route(KA ka, int layer, float* x1, float* smem, bool dry) {
    PHASE_IDS
    bf16_t* xb = PF(XB);
    float* x1o = dry ? (float*)PF(H) : x1;
    const int lane = TID & 63, w = TID >> 6;
    const float* g = PF(ln1_g) + layer * 1024;
    const float* bb = PF(ln1_b) + layer * 1024;
    const float* wg = PF(rg_w) + (size_t)layer * 1024 * 4;
    const float* we = PF(re_w) + (size_t)layer * 1024 * 16;
    const float* bg = PF(rg_b) + layer * 4;
    const float* be = PF(re_b) + layer * 16;
    int* cnt = (int*)(PF(ctl) + CW_CNT) + layer * 16 * 64 + (dry ? 2048 : 0);
    int* lcnt = (int*)(smem + 20 * 1024);
    int* rinfo = lcnt + 64;
    float* rwt = (float*)(rinfo + 4 * 128);
    if (TID < 32) lcnt[TID] = 0;
    float* WR = smem;
    __syncthreads();
    for (int idx = TID; idx < 20 * 1024; idx += NTHR) { const int o = idx >> 10, c = idx & 1023; WR[idx] = o < 4 ? wg[c * 4 + o] : we[c * 16 + (o - 4)]; }
    __syncthreads();
    int nloc = 0;
    for (int row = BID * NW + w; row < NTOK; row += gridDim.x * NW) {
        f32x4 v[4];
        float s = 0.f;
#pragma unroll
        for (int j = 0; j < 4; ++j) { v[j] = *(const f32x4*)(x1 + (size_t)row * DM + 256 * j + 4 * lane); s += (v[j][0] + v[j][1]) + (v[j][2] + v[j][3]); }
        const float mu = wave_sum(s) * (1.f / 1024.f);
        float q = 0.f;
#pragma unroll
        for (int j = 0; j < 4; ++j) { v[j] = v[j] - mu; q += (v[j][0] * v[j][0] + v[j][1] * v[j][1]) + (v[j][2] * v[j][2] + v[j][3] * v[j][3]); }
        const float rstd = rsqrtf(wave_sum(q) * (1.f / 1024.f) + 1e-5f);
#pragma unroll
        for (int j = 0; j < 4; ++j) {
            const int c = 256 * j + 4 * lane;
            v[j] = v[j] * rstd * *(const f32x4*)(g + c) + *(const f32x4*)(bb + c);
            *(f32x4*)(x1o + (size_t)row * DM + c) = v[j];
            u32x2 pw; pw.x = pk2(v[j][0], v[j][1]); pw.y = pk2(v[j][2], v[j][3]);
            *(u32x2*)(xb + (size_t)row * DM + c) = pw;
        }
        float lg[4], le[16];
#pragma unroll
        for (int o = 0; o < 20; ++o) {
            asm volatile("" ::: "memory");
            float a = 0.f;
#pragma unroll
            for (int j = 0; j < 4; ++j) {
                const f32x4 w4 = *(const f32x4*)(WR + o * 1024 + 256 * j + 4 * lane);
                a += (v[j][0] * w4[0] + v[j][1] * w4[1]) + (v[j][2] * w4[2] + v[j][3] * w4[3]);
            }
            a = wave_sum(a);
            if (o < 4) lg[o] = a + bg[o]; else le[o - 4] = a + be[o - 4];
        }
        float gm = fmaxf(fmaxf(lg[0], lg[1]), fmaxf(lg[2], lg[3]));
        float ge[4], gs = 0.f;
#pragma unroll
        for (int c = 0; c < 4; c++) { ge[c] = __expf(lg[c] - gm); gs += ge[c]; }
        int gi = 0; float gbest = ge[0];
#pragma unroll
        for (int c = 1; c < 4; c++) if (ge[c] > gbest) { gbest = ge[c]; gi = c; }
        float gval = gbest / gs;
        float ls[4];
#pragma unroll
        for (int e = 0; e < 4; e++) ls[e] = gi == 0 ? le[e] : gi == 1 ? le[4 + e] : gi == 2 ? le[8 + e] : le[12 + e];
        float em = fmaxf(fmaxf(ls[0], ls[1]), fmaxf(ls[2], ls[3]));
        float pe[4];
#pragma unroll
        for (int e = 0; e < 4; e++) pe[e] = __expf(ls[e] - em);
        int i1 = 0; float b1 = pe[0];
#pragma unroll
        for (int e = 1; e < 4; e++) if (pe[e] > b1) { b1 = pe[e]; i1 = e; }
        int i2 = -1; float b2 = -1.f;
#pragma unroll
        for (int e = 0; e < 4; e++) if (e != i1 && pe[e] > b2) { b2 = pe[e]; i2 = e; }
        float w1 = gval * b1 / (b1 + b2), w2 = gval * b2 / (b1 + b2);
        if (lane == 0) {
            const int e1 = gi * 4 + i1, e2 = gi * 4 + i2;
            const int lr = nloc * NW + w;
            rinfo[lr * 4 + 0] = e1; rinfo[lr * 4 + 1] = atomicAdd(&lcnt[e1], 1);
            rinfo[lr * 4 + 2] = e2; rinfo[lr * 4 + 3] = atomicAdd(&lcnt[e2], 1);
            rwt[lr * 2 + 0] = w1; rwt[lr * 2 + 1] = w2;
        }
        ++nloc;
    }
    __syncthreads();
    if (TID < 16) lcnt[16 + TID] = lcnt[TID] > 0 ? atomicAdd(&cnt[TID * 64], lcnt[TID]) : 0;
    __syncthreads();
    {
        const int nrows_blk = (NTOK - BID * NW + (int)gridDim.x * NW - 1) / ((int)gridDim.x * NW) * NW;
        for (int lr = TID; lr < nrows_blk; lr += NTHR) {
            const int row = BID * NW + (lr % NW) + (lr / NW) * (int)gridDim.x * NW;
            if (row < NTOK) {
                const int e1 = rinfo[lr * 4 + 0], p1 = lcnt[16 + e1] + rinfo[lr * 4 + 1];
                const int e2 = rinfo[lr * 4 + 2], p2 = lcnt[16 + e2] + rinfo[lr * 4 + 3];
                PF(list_tok)[e1 * NTOK + p1] = row; PF(list_w)[e1 * NTOK + p1] = rwt[lr * 2 + 0];
                PF(list_tok)[e2 * NTOK + p2] = row; PF(list_w)[e2 * NTOK + p2] = rwt[lr * 2 + 1];
                PF(tok_slot)[row * 2 + 0] = e1 * NTOK + p1; PF(tok_slot)[row * 2 + 1] = e2 * NTOK + p2;
            }
        }
    }
    __syncthreads();
}


template <bool GATHER_>
struct MoeOrder {
    static constexpr bool GATHER = GATHER_;
    const LAS int* tab; const LAS int* rowtab;
    const char* Bt; unsigned estride; int K, G, c;
    __device__ __forceinline__ bool next(int i, pg8::Unit& u) const {
        const int nwg = __builtin_amdgcn_readfirstlane(tab[48]) * 4;
        const int L = i * G + c; if (L >= nwg) return false;
        int wgid = L; { const int q = nwg / 8, r = nwg % 8, xcd = wgid % 8, off = wgid / 8; wgid = (xcd < r ? xcd * (q + 1) : r * (q + 1) + (xcd - r) * q) + off; }
        const int mg = wgid >> 2, nt = wgid & 3;
        int e = 0;
#pragma unroll
        for (int k = 1; k < 16; ++k) e = (__builtin_amdgcn_readfirstlane(tab[32 + k]) <= mg) ? k : e;
        const int mt = mg - __builtin_amdgcn_readfirstlane(tab[32 + e]);
        const int rem = __builtin_amdgcn_readfirstlane(tab[e]) - mt * 256;
        u.e = e; u.pm = mt; u.pn = nt; u.ui = i; u.nrows = rem < 256 ? rem : 256; u.arow0 = __builtin_amdgcn_readfirstlane(tab[16 + e]) + mt * 256;
        u.bptr = Bt + (size_t)e * estride + (size_t)nt * 256 * K * 2;
        return true;
    }
    __device__ __forceinline__ int arow(const pg8::Unit& u, int r) const { return GATHER_ ? rowtab[u.ui * 256 + r] : u.arow0 + r; }
    __device__ __forceinline__ int lda(int K_) const { return K_; }
    __device__ __forceinline__ unsigned kstepA() const { return 128u; }
    __device__ __forceinline__ const char* abase(const pg8::Unit&, const char* A) const { return A; }
};
__device__ __forceinline__ void moe_tables(KA ka, int layer, LAS unsigned char* lds, bool want_rows, int G, int c) {
    LAS int* tab = (LAS int*)(lds + LDS_MISC + 256);
    LAS int* rowtab = (LAS int*)(lds + LDS_MISC + 1024);
    const int tid = opaque_tid();
    const int* cnt = (const int*)(PF(ctl) + CW_CNT) + layer * 16 * 64;
    if (tid < 16) tab[tid] = __hip_atomic_load(&cnt[tid * 64], __ATOMIC_RELAXED, __HIP_MEMORY_SCOPE_AGENT);
    __syncthreads();
    if (tid == 0) {
        int b = 0, m = 0;
        for (int e = 0; e < 16; ++e) { tab[16 + e] = b; tab[32 + e] = m; b += tab[e]; m += (tab[e] + 255) >> 8; }
        tab[48] = m;
    }
    __syncthreads();
    if (want_rows) {
        MoeOrder<true> S{tab, rowtab, nullptr, 0u, 1024, G, c};
        const int* lt = PF(list_tok);
        for (int i = 0; i < 4; ++i) {
            pg8::Unit u;
            if (!S.next(i, u)) break;
            if (tid < 256) { const int r = tid < u.nrows ? tid : u.nrows - 1; rowtab[i * 256 + tid] = lt[u.e * NTOK + u.pm * 256 + r]; }
        }
        asm volatile("s_waitcnt vmcnt(0) lgkmcnt(0)" ::: "memory");
        __syncthreads();
    }
}
struct EpiUp {
    static constexpr bool PERM = true;
    bf16_t* hidden;
    __device__ __forceinline__ void operator()(const f32x4 (&acc)[2][2][4][2], const pg8::Unit& u, int wr, int wc, int fr, int fq) const {
#pragma unroll
        for (int ai = 0; ai < 2; ++ai)
#pragma unroll
            for (int m = 0; m < 4; ++m) {
                const int r = ai * 128 + wr * 64 + m * 16 + fr;
                if (r < u.nrows) {
                    bf16_t* rowp = hidden + (size_t)(u.arow0 + r) * 512 + u.pn * 128 + wc * 32 + 8 * fq;
                    float h[8];
#pragma unroll
                    for (int n = 0; n < 2; ++n)
#pragma unroll
                        for (int j = 0; j < 4; ++j) { const float g = acc[ai][0][m][n][j], uu = acc[ai][1][m][n][j]; h[n * 4 + j] = g * sigmoidf_(g) * uu; }
                    u32x4 w; w.x = pg8::cvt_pk_bf16(h[0], h[1]); w.y = pg8::cvt_pk_bf16(h[2], h[3]); w.z = pg8::cvt_pk_bf16(h[4], h[5]); w.w = pg8::cvt_pk_bf16(h[6], h[7]);
                    *(u32x4*)rowp = w;
                }
            }
    }
};
struct EpiDown {
    static constexpr bool PERM = true;
    bf16_t* Y2; const float* lw;
    __device__ __forceinline__ void operator()(const f32x4 (&acc)[2][2][4][2], const pg8::Unit& u, int wr, int wc, int fr, int fq) const {
#pragma unroll
        for (int ai = 0; ai < 2; ++ai)
#pragma unroll
            for (int m = 0; m < 4; ++m) {
                const int r = ai * 128 + wr * 64 + m * 16 + fr;
                if (r < u.nrows) {
                    const float wgt = lw[u.e * NTOK + u.pm * 256 + r];
                    bf16_t* rowp = Y2 + (size_t)(u.arow0 + r) * DM + u.pn * 256 + wc * 32 + 8 * fq;
#pragma unroll
                    for (int bj = 0; bj < 2; ++bj) {
                        const f32x4 v0 = acc[ai][bj][m][0] * wgt, v1 = acc[ai][bj][m][1] * wgt;
                        u32x4 w; w.x = pg8::cvt_pk_bf16(v0[0], v0[1]); w.y = pg8::cvt_pk_bf16(v0[2], v0[3]); w.z = pg8::cvt_pk_bf16(v1[0], v1[1]); w.w = pg8::cvt_pk_bf16(v1[2], v1[3]);
                        *(u32x4*)(rowp + bj * 128) = w;
                    }
                }
            }
    }
};
__device__ __forceinline__ void phase_moe_up(KA ka, int layer, LAS unsigned char* lds) {
    moe_tables(ka, layer, lds, true, gridDim.x, opaque_bid());
    MoeOrder<true> S{(const LAS int*)(lds + LDS_MISC + 256), (const LAS int*)(lds + LDS_MISC + 1024),
                     (const char*)(PF(WT) + WT_UP), (unsigned)(1024u * 1024u * 2u), 1024, (int)gridDim.x, opaque_bid()};
    EpiUp E{PF(Y)};
    pg8::gemm_phase<EpiUp, MoeOrder<true>>(lds, (const char*)PF(XB), 1024, S, E);
}
__device__ __forceinline__ void phase_moe_down(KA ka, int layer, LAS unsigned char* lds) {
    moe_tables(ka, layer, lds, false, gridDim.x, opaque_bid());
    MoeOrder<false> S{(const LAS int*)(lds + LDS_MISC + 256), (const LAS int*)(lds + LDS_MISC + 1024),
                      (const char*)(PF(WT) + WT_DN), (unsigned)(1024u * 512u * 2u), 512, (int)gridDim.x, opaque_bid()};
    EpiDown E{PF(H), PF(list_w)};
    pg8::gemm_phase<EpiDown, MoeOrder<false>>(lds, (const char*)PF(Y), 512, S, E);
}

__device__ void phase_ln2(KA ka, int layer, const float* x1, float* xo) {
    PHASE_IDS
    bf16_t* xb = PF(XB);
    const bf16_t* Y2 = PF(H);
    const int lane = TID & 63, w = TID >> 6;
    const float* g = PF(ln2_g) + layer * 1024;
    const float* bb = PF(ln2_b) + layer * 1024;
    const int* cnt = (const int*)(PF(ctl) + CW_CNT) + layer * 16 * 64;
    int mybase = 0;
    {
        int cv = lane < 16 ? __hip_atomic_load(&cnt[(lane & 15) * 64], __ATOMIC_RELAXED, __HIP_MEMORY_SCOPE_AGENT) : 0;
        int incl = cv;
#pragma unroll
        for (int o = 1; o < 16; o <<= 1) { int t = __shfl_up(incl, o); if ((lane & 15) >= o) incl += t; }
        mybase = incl - cv;
    }
    for (int row = BID * NW + w; row < NTOK; row += gridDim.x * NW) {
        const int ts1 = PF(tok_slot)[row * 2 + 0], ts2 = PF(tok_slot)[row * 2 + 1];
        const int s1 = __shfl(mybase, ts1 >> 14) + (ts1 & (NTOK - 1)), s2 = __shfl(mybase, ts2 >> 14) + (ts2 & (NTOK - 1));
        f32x4 v[4];
        float s = 0.f;
#pragma unroll
        for (int j = 0; j < 4; ++j) {
            const int c = 256 * j + 4 * lane;
            const f32x4 xv = *(const f32x4*)(x1 + (size_t)row * DM + c);
            const u32x2 ya = *(const u32x2*)(Y2 + (size_t)s1 * DM + c), yb = *(const u32x2*)(Y2 + (size_t)s2 * DM + c);
            f32x4 t;
            t[0] = __uint_as_float(ya.x << 16) + __uint_as_float(yb.x << 16); t[1] = __uint_as_float(ya.x & 0xffff0000u) + __uint_as_float(yb.x & 0xffff0000u);
            t[2] = __uint_as_float(ya.y << 16) + __uint_as_float(yb.y << 16); t[3] = __uint_as_float(ya.y & 0xffff0000u) + __uint_as_float(yb.y & 0xffff0000u);
            v[j] = xv * ALPHA + t;
            s += (v[j][0] + v[j][1]) + (v[j][2] + v[j][3]);
        }
        const float mu = wave_sum(s) * (1.f / 1024.f);
        float q = 0.f;
#pragma unroll
        for (int j = 0; j < 4; ++j) { v[j] = v[j] - mu; q += (v[j][0] * v[j][0] + v[j][1] * v[j][1]) + (v[j][2] * v[j][2] + v[j][3] * v[j][3]); }
        const float rstd = rsqrtf(wave_sum(q) * (1.f / 1024.f) + 1e-5f);
#pragma unroll
        for (int j = 0; j < 4; ++j) {
            const int c = 256 * j + 4 * lane;
            const f32x4 o = v[j] * rstd * *(const f32x4*)(g + c) + *(const f32x4*)(bb + c);
            *(f32x4*)(xo + (size_t)row * DM + c) = o;
            u32x2 pw; pw.x = pk2(o[0], o[1]); pw.y = pk2(o[2], o[3]);
            *(u32x2*)(xb + (size_t)row * DM + c) = pw;
        }
    }
}

#define MFMA16(a, b, c) __builtin_amdgcn_mfma_f32_16x16x32_bf16((a), (b), (c), 0, 0, 0)
constexpr int NSA_KT = 0, NSA_VT = 16384, NSA_IMP = 32768, NSA_FIN = 65536, NSA_SEL = LDS_MISC + 8192;

__device__ __forceinline__ int tile_off(int r, int c) { return r * 128 + ((c ^ ((r >> 1) & 7)) << 4); }

struct SelMask { unsigned a, b, c, d; };
__device__ __forceinline__ unsigned selbit(unsigned a, unsigned b, unsigned c, unsigned d, int j) {
    const int k = j >> 5;
    const unsigned lo = (k & 1) ? b : a, hi = (k & 1) ? d : c;
    const unsigned r = (k & 2) ? hi : lo;
    return (r >> (j & 31)) & 1u;
}

struct NsaRT {
    bf16x8 q[2];
    f32x4 o[4];
    float m, l;
    int tk;
};

template <int MODE>
__device__ __forceinline__ void nsa_loop(LAS unsigned char* lds, int tid, int lane, int w, int jb, int je,
                                         const char* ksrc, size_t kstride, size_t ktile, const char* vsrc, size_t vstride, size_t vtile,
                                         NsaRT (&R)[2], const SelMask selm0, const SelMask selm1, float (&carry)[2], float* impw) {
    const int g = lane >> 4, qr = lane & 15;
    int tid2 = tid; asm volatile("" : "+v"(tid2));
    const int sr = tid2 >> 3, sc = tid2 & 7;
    const int soff = tile_off(sr, sc);
    const int fxq = (qr >> 1) & 7;
    const int ka0 = qr * 128 + ((g ^ fxq) << 4), ka1 = qr * 128 + (((4 + g) ^ fxq) << 4);
    const int vb = qr * 128 + (g & 1) * 8, vc = (g >> 1) ^ fxq;
    const int va0 = vb + (vc << 4), va1 = vb + ((vc ^ 2) << 4), va2 = vb + ((vc ^ 4) << 4), va3 = vb + ((vc ^ 6) << 4);
    if (jb > je) return;
    u32x4 kreg, vreg;
    kreg = *(const u32x4*)(ksrc + (size_t)jb * ktile + (size_t)sr * kstride + sc * 16);
    if (MODE != 0) vreg = *(const u32x4*)(vsrc + (size_t)jb * vtile + (size_t)sr * vstride + sc * 16);
    *(LAS u32x4*)(lds + NSA_KT + soff) = kreg;
    if (MODE != 0) *(LAS u32x4*)(lds + NSA_VT + soff) = vreg;
    __syncthreads();
    for (int j = jb; j <= je; ++j) {
        const int cur = (j - jb) & 1;
        if (j < je) {
            kreg = *(const u32x4*)(ksrc + (size_t)(j + 1) * ktile + (size_t)sr * kstride + sc * 16);
            if (MODE != 0) vreg = *(const u32x4*)(vsrc + (size_t)(j + 1) * vtile + (size_t)sr * vstride + sc * 16);
        }
        const LAS unsigned char* kt = lds + NSA_KT + cur * 8192;
        const LAS unsigned char* vt = lds + NSA_VT + cur * 8192;
        bool act[2];
#pragma unroll
        for (int rt = 0; rt < 2; ++rt) {
            const int tk = R[rt].tk;
            bool a;
            if (MODE <= 1) { const int nv = tk >= 31 ? ((tk - 31) >> 4) + 1 : 0; a = nv > 64 * j; }
            else if (MODE == 2) a = (rt == 0 ? selbit(selm0.a, selm0.b, selm0.c, selm0.d, j) : selbit(selm1.a, selm1.b, selm1.c, selm1.d, j)) != 0u;
            else a = (64 * j <= tk) && (64 * j + 63 > tk - 512);
            act[rt] = __any(a);
        }
        if (act[0] || act[1]) {
#pragma unroll
            for (int rt = 0; rt < 2; ++rt) {
                if (!act[rt]) continue;
                NsaRT& r = R[rt];
                const int tk = r.tk;
                f32x4 s[4];
#pragma unroll
                for (int t = 0; t < 4; ++t) {
                    const bf16x8 k0 = *(const LAS bf16x8*)(kt + ka0 + t * 2048), k1 = *(const LAS bf16x8*)(kt + ka1 + t * 2048);
                    s[t] = (f32x4){0.f, 0.f, 0.f, 0.f};
                    s[t] = MFMA16(k0, r.q[0], s[t]);
                    s[t] = MFMA16(k1, r.q[1], s[t]);
                }
                int lim_hi, lim_lo;
                if (MODE <= 1) { const int nv = tk >= 31 ? ((tk - 31) >> 4) + 1 : 0; lim_hi = nv - 1; lim_lo = -1; }
                else if (MODE == 2) { lim_hi = ((rt == 0 ? selbit(selm0.a, selm0.b, selm0.c, selm0.d, j) : selbit(selm1.a, selm1.b, selm1.c, selm1.d, j)) != 0u) ? tk : -1; lim_lo = -1; }
                else { lim_hi = tk; lim_lo = tk - 512; }
                const int kb = 64 * j + 4 * g;
                if (MODE == 1) {
                    const float mrow = r.m, invl = r.l > 0.f ? 1.f / r.l : 0.f;
                    float p[4][4];
#pragma unroll
                    for (int t = 0; t < 4; ++t)
#pragma unroll
                        for (int i = 0; i < 4; ++i) { const int key = kb + 16 * t + i; p[t][i] = (key <= lim_hi) ? __expf(s[t][i] - mrow) * invl : 0.f; }
#pragma unroll
                    for (int t = 0; t < 4; ++t) {
                        const float own = (p[t][0] + p[t][1]) + (p[t][2] + p[t][3]);
                        const float x3 = p[t][3];
                        const float up_cur = __shfl(x3, (lane + 48) & 63);
                        const float up_prev = __shfl(carry[rt], (lane + 48) & 63);
                        float v = own + (g >= 1 ? up_cur : up_prev);
                        v += __shfl_xor(v, 1);
                        v += __shfl_xor(v, 2);
                        carry[rt] = x3;
                        if ((qr & 3) == 0) impw[(4 * rt + (qr >> 2)) * 128 + 16 * j + 4 * t + g] = v;
                    }
#pragma unroll
                    for (int ks = 0; ks < 2; ++ks) {
                        bf16x8 pf;
                        const unsigned a0 = pk2(p[2 * ks][0], p[2 * ks][1]), a1 = pk2(p[2 * ks][2], p[2 * ks][3]);
                        const unsigned a2 = pk2(p[2 * ks + 1][0], p[2 * ks + 1][1]), a3 = pk2(p[2 * ks + 1][2], p[2 * ks + 1][3]);
                        u32x4 pu; pu.x = a0; pu.y = a1; pu.z = a2; pu.w = a3;
                        pf = __builtin_bit_cast(bf16x8, pu);
#pragma unroll
                        for (int dt = 0; dt < 4; ++dt) {
                            const u32x2 lo = *(const LAS u32x2*)(vt + (ks ? va2 : va0) + dt * 2048);
                            const u32x2 hi = *(const LAS u32x2*)(vt + (ks ? va3 : va1) + dt * 2048);
                            u32x4 vu; vu.x = lo.x; vu.y = lo.y; vu.z = hi.x; vu.w = hi.y;
                            r.o[dt] = MFMA16(__builtin_bit_cast(bf16x8, vu), pf, r.o[dt]);
                        }
                    }
                } else {
                    float mx = NEG_INF;
#pragma unroll
                    for (int t = 0; t < 4; ++t)
#pragma unroll
                        for (int i = 0; i < 4; ++i) {
                            const int key = kb + 16 * t + i;
                            const bool ok = (key <= lim_hi) && (key > lim_lo);
                            s[t][i] = ok ? s[t][i] : NEG_INF;
                            mx = fmaxf(mx, s[t][i]);
                        }
                    mx = fmaxf(mx, __shfl_xor(mx, 16));
                    mx = fmaxf(mx, __shfl_xor(mx, 32));
                    const float mn = fmaxf(r.m, mx);
                    const float alpha = __expf(r.m - mn);
                    float p[4][4];
                    float rs = 0.f;
#pragma unroll
                    for (int t = 0; t < 4; ++t)
#pragma unroll
                        for (int i = 0; i < 4; ++i) { p[t][i] = (s[t][i] > 0.5f * NEG_INF) ? __expf(s[t][i] - mn) : 0.f; rs += p[t][i]; }
                    rs += __shfl_xor(rs, 16);
                    rs += __shfl_xor(rs, 32);
                    r.l = r.l * alpha + rs;
                    r.m = mn;
                    if (MODE != 0) {
#pragma unroll
                        for (int dt = 0; dt < 4; ++dt) r.o[dt] = r.o[dt] * alpha;
#pragma unroll
                        for (int ks = 0; ks < 2; ++ks) {
                            const unsigned a0 = pk2(p[2 * ks][0], p[2 * ks][1]), a1 = pk2(p[2 * ks][2], p[2 * ks][3]);
                            const unsigned a2 = pk2(p[2 * ks + 1][0], p[2 * ks + 1][1]), a3 = pk2(p[2 * ks + 1][2], p[2 * ks + 1][3]);
                            u32x4 pu; pu.x = a0; pu.y = a1; pu.z = a2; pu.w = a3;
                            const bf16x8 pf = __builtin_bit_cast(bf16x8, pu);
#pragma unroll
                            for (int dt = 0; dt < 4; ++dt) {
                                const u32x2 lo = *(const LAS u32x2*)(vt + (ks ? va2 : va0) + dt * 2048);
                                const u32x2 hi = *(const LAS u32x2*)(vt + (ks ? va3 : va1) + dt * 2048);
                                u32x4 vu; vu.x = lo.x; vu.y = lo.y; vu.z = hi.x; vu.w = hi.y;
                                r.o[dt] = MFMA16(__builtin_bit_cast(bf16x8, vu), pf, r.o[dt]);
                            }
                        }
                    }
                }
            }
        }
        if (j < je) {
            *(LAS u32x4*)(lds + NSA_KT + (cur ^ 1) * 8192 + soff) = kreg;
            if (MODE != 0) *(LAS u32x4*)(lds + NSA_VT + (cur ^ 1) * 8192 + soff) = vreg;
        }
        __syncthreads();
    }
}

__device__ void phase_nsa2(KA ka, int layer, LAS unsigned char* lds) {
    PHASE_IDS
    const int tid = TID, lane = tid & 63, w = __builtin_amdgcn_readfirstlane(tid >> 6), g = lane >> 4, qr = lane & 15;
    const bf16_t* H = PF(H);
    const bf16_t* kcb = PF(kcb);
    const bf16_t* vcT = PF(vcT);
    const bf16_t* vsT = PF(vsT);
    const bf16_t* vwT = PF(vwT);
    bf16_t* Y = PF(Y);
    const float* gate_b = PF(nsa_gate_b) + layer * 24;
    const float* ogain = PF(out_gain) + layer * 1024;
    float* impw = (float*)(lds + NSA_IMP + w * 4096);
    unsigned* selw = (unsigned*)(lds + NSA_SEL + w * 128);
    for (int base = BID; base < 256; base += gridDim.x) {
#pragma unroll 1
        for (int half = 0; half < 2; ++half) {
            const int it = half ? 511 - base : base;
            const int chunk = it >> 2, bh = it & 3, b = bh >> 1, hk = bh & 1;
            const size_t rowbase = (size_t)b * T_;
            const int t0w = chunk * 64 + w * 8;
            NsaRT R[2];
            LAS f32x4* finw = (LAS f32x4*)(lds + NSA_FIN + w * 8192) + lane;
#pragma unroll
            for (int rt = 0; rt < 2; ++rt) {
                const int tk = t0w + 4 * rt + (qr >> 2), hh = hk * 4 + (qr & 3);
                R[rt].tk = tk;
                const bf16_t* qp = H + (rowbase + tk) * HLD + C_NQ + hh * 64 + 8 * g;
#pragma unroll
                for (int ks = 0; ks < 2; ++ks) {
                    const u32x4 u = *(const u32x4*)(qp + 32 * ks);
                    const unsigned uu[4] = {u.x, u.y, u.z, u.w};
                    u32x4 o4;
#pragma unroll
                    for (int e = 0; e < 4; ++e) {
                        const float f0 = __uint_as_float(uu[e] << 16) * 0.125f, f1 = __uint_as_float(uu[e] & 0xffff0000u) * 0.125f;
                        o4[e] = (__float_as_uint(f0) >> 16) | (__float_as_uint(f1) & 0xffff0000u);
                    }
                    R[rt].q[ks] = __builtin_bit_cast(bf16x8, o4);
                }
                R[rt].m = NEG_INF; R[rt].l = 0.f;
#pragma unroll
                for (int dt = 0; dt < 4; ++dt) R[rt].o[dt] = (f32x4){0.f, 0.f, 0.f, 0.f};
            }
            SelMask selm0{0u, 0u, 0u, 0u}, selm1{0u, 0u, 0u, 0u};
            float carry[2] = {0.f, 0.f};
            const int tmax = chunk * 64 + 63;
            const int nvmax = tmax >= 31 ? ((tmax - 31) >> 4) + 1 : 0;
            const int nb = (nvmax + 63) >> 6;
            const char* kc_src = (const char*)(kcb + (size_t)bh * 512 * 64);
            const char* vc_src = (const char*)(vcT + (size_t)bh * 64 * 512);
            nsa_loop<0>(lds, tid, lane, w, 0, nb - 1, kc_src, 128, 64 * 128, nullptr, 0, 0, R, selm0, selm1, carry, impw);
            for (int i = lane; i < 8 * 128; i += 64) impw[i] = 0.f;
            wave_sync();
            nsa_loop<1>(lds, tid, lane, w, 0, nb - 1, kc_src, 128, 64 * 128, vc_src, 512 * 2, 64 * 2, R, selm0, selm1, carry, impw);
#pragma unroll
            for (int rt = 0; rt < 2; ++rt) {
                const int hh = hk * 4 + (qr & 3);
                const float gt = sigmoidf_(bf2f(H[(rowbase + R[rt].tk) * HLD + C_NG + hh * 3 + 0]) + gate_b[hh * 3 + 0]);
#pragma unroll
                for (int dt = 0; dt < 4; ++dt) { finw[(rt * 4 + dt) * 64] = R[rt].o[dt] * gt; R[rt].o[dt] = (f32x4){0.f, 0.f, 0.f, 0.f}; }
            }
            wave_sync();
            {
                const int tl = lane >> 3, sub = lane & 7;
                const int tks = t0w + tl, curb = tks >> 6;
                float v[16];
#pragma unroll
                for (int i = 0; i < 16; ++i) {
                    const int jj = sub * 16 + i;
                    const float a = impw[tl * 128 + jj];
                    const bool forced = (jj == 0) || (jj == curb) || (jj == curb - 1);
                    v[i] = (jj <= curb) ? (a + (forced ? 1e4f : 0.f)) : NEG_INF;
                }
                wave_sync();
#pragma unroll
                for (int i = 0; i < 16; ++i) impw[tl * 128 + sub * 16 + i] = v[i];
                wave_sync();
                int cnt[16];
#pragma unroll
                for (int i = 0; i < 16; ++i) cnt[i] = 0;
                for (int jj = 0; jj < 128; ++jj) {
                    const float x = impw[tl * 128 + jj];
#pragma unroll
                    for (int i = 0; i < 16; ++i) cnt[i] += (x > v[i]) || (x == v[i] && jj < sub * 16 + i);
                }
                unsigned bits = 0u;
#pragma unroll
                for (int i = 0; i < 16; ++i) bits |= ((cnt[i] < 16) && (v[i] > 0.5f * NEG_INF)) ? (1u << i) : 0u;
                const unsigned other = __shfl_xor(bits, 1);
                const unsigned word = (sub & 1) ? ((bits << 16) | other) : (bits | (other << 16));
                if ((sub & 1) == 0) selw[tl * 4 + (sub >> 1)] = word;
                wave_sync();
                { const unsigned* q0 = selw + (qr >> 2) * 4; selm0.a = q0[0]; selm0.b = q0[1]; selm0.c = q0[2]; selm0.d = q0[3];
                  selm1.a = q0[16]; selm1.b = q0[17]; selm1.c = q0[18]; selm1.d = q0[19]; }
                wave_sync();
            }
#pragma unroll
            for (int rt = 0; rt < 2; ++rt) { R[rt].m = NEG_INF; R[rt].l = 0.f; }
            nsa_loop<2>(lds, tid, lane, w, 0, chunk, (const char*)(H + rowbase * HLD + C_KS + hk * 64), (size_t)HLD * 2, (size_t)64 * HLD * 2,
                        (const char*)(vsT + (size_t)bh * 64 * T_), (size_t)T_ * 2, 64 * 2, R, selm0, selm1, carry, impw);
#pragma unroll
            for (int rt = 0; rt < 2; ++rt) {
                const int hh = hk * 4 + (qr & 3);
                const float gt = sigmoidf_(bf2f(H[(rowbase + R[rt].tk) * HLD + C_NG + hh * 3 + 1]) + gate_b[hh * 3 + 1]);
                const float sc = gt / R[rt].l;
#pragma unroll
                for (int dt = 0; dt < 4; ++dt) { finw[(rt * 4 + dt) * 64] += R[rt].o[dt] * sc; R[rt].o[dt] = (f32x4){0.f, 0.f, 0.f, 0.f}; }
                R[rt].m = NEG_INF; R[rt].l = 0.f;
            }
            nsa_loop<3>(lds, tid, lane, w, chunk >= 8 ? chunk - 8 : 0, chunk, (const char*)(H + rowbase * HLD + C_KW + hk * 64), (size_t)HLD * 2, (size_t)64 * HLD * 2,
                        (const char*)(vwT + (size_t)bh * 64 * T_), (size_t)T_ * 2, 64 * 2, R, selm0, selm1, carry, impw);
#pragma unroll
            for (int rt = 0; rt < 2; ++rt) {
                const int tk = R[rt].tk, hh = hk * 4 + (qr & 3);
                const float gt = sigmoidf_(bf2f(H[(rowbase + tk) * HLD + C_NG + hh * 3 + 2]) + gate_b[hh * 3 + 2]);
                const float sc = gt / R[rt].l;
                bf16_t* yp = Y + (rowbase + tk) * DM + 256 + hh * 64 + 4 * g;
                f32x4 ov[4];
                float ss = 0.f;
#pragma unroll
                for (int dt = 0; dt < 4; ++dt) { ov[dt] = finw[(rt * 4 + dt) * 64] + R[rt].o[dt] * sc; ss += (ov[dt][0] * ov[dt][0] + ov[dt][1] * ov[dt][1]) + (ov[dt][2] * ov[dt][2] + ov[dt][3] * ov[dt][3]); }
                ss += __shfl_xor(ss, 16);
                ss += __shfl_xor(ss, 32);
                const float rn = rsqrtf(ss * (1.f / 64.f) + 1e-6f);
#pragma unroll
                for (int dt = 0; dt < 4; ++dt) {
                    const f32x4 o = ov[dt] * rn * *(const f32x4*)(ogain + 256 + hh * 64 + 16 * dt + 4 * g);
                    u32x2 wv; wv.x = pk2(o[0], o[1]); wv.y = pk2(o[2], o[3]);
                    *(u32x2*)(yp + 16 * dt) = wv;
                }
            }
        }
    }
}

__device__ void phase_vtrans(KA ka, float* smem) {
    PHASE_IDS
    const int lane = TID & 63, w = TID >> 6;
    bf16_t* scr = (bf16_t*)(smem + w * 4096);
    const bf16_t* H = PF(H);
    for (int it = BID * NW + w; it < 1024; it += gridDim.x * NW) {
        const int tt = it & 127, bh = (it >> 7) & 3, which = it >> 9;
        const int b = bh >> 1, hk = bh & 1;
        const size_t tok0 = (size_t)b * T_ + tt * 64;
        const int col = (which ? C_VW : C_VS) + hk * 64;
        bf16_t* dst = (which ? PF(vwT) : PF(vsT)) + (size_t)bh * 64 * T_ + tt * 64;
        wave_sync();
        for (int i = 0; i < 64; ++i) scr[lane * 66 + i] = H[(tok0 + i) * HLD + col + lane];
        wave_sync();
        for (int d = 0; d < 64; ++d) dst[(size_t)d * T_ + lane] = scr[d * 66 + lane];
    }
}

__device__ void phase_hgrnA(KA ka, int layer, float* smem, int first, int nblk) {
    PHASE_IDS
    const int tid = TID, lane = tid & 63, w = tid >> 6;
    float* Q = smem;
    float* K = smem + 4160;
    float* Bc = smem + 8320;
    float* AT = smem + 12480;
    float* I = smem + 16640;
    float* SEG = smem + 20736;
    const bf16_t* H = PF(H);
    const float* hgl = PF(hg_lower);
    float* hgU = PF(hgU); float* hgG = PF(hgG); bf16_t* hgQB = PF(hgQB); bf16_t* hgO = PF(hgO);
    if (BID < first) return;
    for (int item = BID - first; item < 1024; item += nblk) {
        const int c = item & 127, bh = item >> 7, h = bh & 3, b = bh >> 2;
        const size_t tok0 = (size_t)b * T_ + c * 64;
        __syncthreads();
#pragma unroll
        for (int i = 0; i < 8; ++i) {
            const int e = tid + i * NTHR, t = e >> 6, d = e & 63;
            float lb = 0.f;
            if (layer == 1) {
                const float h0 = hgl[h * 64 + d], h1 = hgl[256 + h * 64 + d];
                const float mx = fmaxf(h0, h1), e0 = expf(h0 - mx), e1 = expf(h1 - mx);
                lb = e1 / (e0 + e1);
            }
            const bf16_t* hp = H + (tok0 + t) * HLD + h * 64 + d;
            const float fl = bf2f(hp[C_HF]);
            const float sg = 1.f / (1.f + expf(-fl)), sgn = 1.f / (1.f + expf(fl));
            const float f = lb + (1.f - lb) * sg;
            Q[t * 65 + d] = bf2f(hp[C_HQ]);
            K[t * 65 + d] = (1.f - lb) * sgn;
            I[t * 64 + d] = bf2f(hp[C_HI]);
            Bc[t * 65 + d] = logf(fmaxf(f, 1e-38f));
        }
        __syncthreads();
        {
            const int d = lane, seg = w;
            float run = 0.f;
#pragma unroll
            for (int i = 0; i < 8; ++i) { run += Bc[(seg * 8 + i) * 65 + d]; Bc[(seg * 8 + i) * 65 + d] = run; }
            SEG[seg * 64 + d] = run;
            __syncthreads();
            float pre = 0.f;
            for (int s2 = 0; s2 < seg; ++s2) pre += SEG[s2 * 64 + d];
#pragma unroll
            for (int i = 0; i < 8; ++i) Bc[(seg * 8 + i) * 65 + d] += pre;
        }
        __syncthreads();
#pragma unroll 1
        for (int i = 0; i < 8; ++i) {
            const int t = w + 8 * i, s = lane;
            float acc = 0.f;
            if (s <= t) {
                for (int d = 0; d < 64; ++d) acc = fmaf(Q[t * 65 + d] * K[s * 65 + d], __expf(Bc[t * 65 + d] - Bc[s * 65 + d]), acc);
            }
            AT[t * 65 + s] = acc;
        }
        __syncthreads();
#pragma unroll 1
        for (int i = 0; i < 8; ++i) {
            const int t = w + 8 * i, v = lane;
            float acc = 0.f;
            for (int s = 0; s <= t; ++s) acc = fmaf(AT[t * 65 + s], I[s * 64 + v], acc);
            hgO[((size_t)item * 64 + t) * 64 + v] = f2bf(acc);
            hgQB[((size_t)item * 64 + t) * 64 + v] = f2bf(Q[t * 65 + v] * __expf(Bc[t * 65 + v]));
            K[t * 65 + v] *= __expf(Bc[63 * 65 + v] - Bc[t * 65 + v]);
        }
        if (tid < 64) hgG[(size_t)item * 64 + tid] = __expf(Bc[63 * 65 + tid]);
        __syncthreads();
#pragma unroll 1
        for (int i = 0; i < 8; ++i) {
            const int d = w + 8 * i, v = lane;
            float acc = 0.f;
            for (int s = 0; s < 64; ++s) acc = fmaf(K[s * 65 + d], I[s * 64 + v], acc);
            hgU[((size_t)item * 64 + d) * 64 + v] = acc;
        }
    }
}

__device__ void phase_hgrnB(KA ka) {
    PHASE_IDS
    const float* hgU = PF(hgU); const float* hgG = PF(hgG); float* hgS = PF(hgS);
    for (int gid = BID * NTHR + TID; gid < 32768; gid += gridDim.x * NTHR) {
        const int bh = gid >> 12, dv = gid & 4095, d = dv >> 6;
        float S = 0.f;
        for (int c0 = 0; c0 < 128; c0 += 8) {
            float u[8], gg[8];
#pragma unroll
            for (int k = 0; k < 8; ++k) { const size_t item = (size_t)bh * 128 + c0 + k; u[k] = hgU[item * 4096 + dv]; gg[k] = hgG[item * 64 + d]; }
#pragma unroll
            for (int k = 0; k < 8; ++k) { const size_t item = (size_t)bh * 128 + c0 + k; hgS[item * 4096 + dv] = S; S = fmaf(gg[k], S, u[k]); }
        }
    }
}

__device__ void phase_hgrnC(KA ka, int layer, float* smem) {
    PHASE_IDS
    const int tid = TID, lane = tid & 63, w = tid >> 6;
    float* QB = smem;
    float* S = smem + 4160;
    const bf16_t* H = PF(H);
    const float* hgS = PF(hgS); const bf16_t* hgQB = PF(hgQB); const bf16_t* hgO = PF(hgO);
    const float* og = PF(out_gain) + layer * 1024;
    bf16_t* Y = PF(Y);
    for (int item = BID; item < 1024; item += gridDim.x) {
        const int c = item & 127, bh = item >> 7, h = bh & 3, b = bh >> 2;
        const size_t tok0 = (size_t)b * T_ + c * 64;
        __syncthreads();
#pragma unroll
        for (int i = 0; i < 8; ++i) {
            const int e = tid + i * NTHR, r = e >> 6, cc = e & 63;
            QB[r * 65 + cc] = bf2f(hgQB[(size_t)item * 4096 + e]);
            S[e] = hgS[(size_t)item * 4096 + e];
        }
        __syncthreads();
#pragma unroll 1
        for (int i = 0; i < 8; ++i) {
            const int t = w + 8 * i, v = lane;
            float acc = bf2f(hgO[((size_t)item * 64 + t) * 64 + v]);
            for (int d = 0; d < 64; ++d) acc = fmaf(QB[t * 65 + d], S[d * 64 + v], acc);
            const float ms = wave_sum(acc * acc) * (1.f / 64.f);
            const float hg = bf2f(H[(tok0 + t) * HLD + C_HG + h * 64 + v]);
            const float y = acc * rsqrtf(ms + 1e-6f) * og[768 + h * 64 + v] * (hg * sigmoidf_(hg));
            Y[(tok0 + t) * DM + 768 + h * 64 + v] = f2bf(y);
        }
    }
}

struct CmpOrder {
    static constexpr bool GATHER = false;
    const char* W1T; int c;
    __device__ __forceinline__ bool next(int i, pg8::Unit& u) const {
        if (i > 0 || c >= 16) return false;
        const int which = c >> 3, bh = (c >> 1) & 3, nt = c & 1;
        u.arow0 = (bh >> 1) * 512 + nt * 256; u.nrows = 256; u.pm = nt; u.pn = 0; u.e = which * 4 + bh; u.ui = 0;
        u.bptr = W1T + (size_t)which * 256 * 2048 * 2;
        return true;
    }
    __device__ __forceinline__ int arow(const pg8::Unit& u, int r) const { return u.arow0 + r; }
    __device__ __forceinline__ int lda(int) const { return 16 * HLD; }
    __device__ __forceinline__ unsigned kstepA() const { return (unsigned)(HLD * 2); }
    __device__ __forceinline__ const char* abase(const pg8::Unit& u, const char* A) const { return A + (((u.e >> 2) ? C_VC : C_KC) + (u.e & 1) * 64) * 2; }
};
struct EpiCmp {
    static constexpr bool PERM = true;
    bf16_t* G; const float* cbias;
    __device__ __forceinline__ void operator()(const f32x4 (&acc)[2][2][4][2], const pg8::Unit& u, int wr, int wc, int fr, int fq) const {
        const float* bp = cbias + (u.e >> 2) * 128 + wc * 32 + 8 * fq;
        const f32x4 b0 = *(const f32x4*)bp, b1 = *(const f32x4*)(bp + 4);
#pragma unroll
        for (int ai = 0; ai < 2; ++ai)
#pragma unroll
            for (int m = 0; m < 4; ++m) {
                const int r = ai * 128 + wr * 64 + m * 16 + fr;
                bf16_t* rowp = G + ((size_t)(u.e * 512 + u.pm * 256 + r)) * 128 + wc * 32 + 8 * fq;
                const f32x4 v0 = acc[ai][0][m][0] + b0, v1 = acc[ai][0][m][1] + b1;
                u32x4 w; w.x = pk2(gelu_t(v0[0]), gelu_t(v0[1])); w.y = pk2(gelu_t(v0[2]), gelu_t(v0[3])); w.z = pk2(gelu_t(v1[0]), gelu_t(v1[1])); w.w = pk2(gelu_t(v1[2]), gelu_t(v1[3]));
                *(u32x4*)rowp = w;
            }
    }
};
__device__ void phase_compress2(KA ka, int layer, LAS unsigned char* lds) {
    const int bid = opaque_bid();
    if (bid >= 16) return;
    CmpOrder S{(const char*)(PF(WT) + WT_C1), bid};
    EpiCmp E{PF(gb), PF(cbias)};
    pg8::gemm_phase<EpiCmp, CmpOrder>(lds, (const char*)PF(H), 2048, S, E);
    __syncthreads();
    const int tid = opaque_tid();
    const int which = bid >> 3, bh = (bid >> 1) & 3, nt = bid & 1;
    float* w2s = (float*)lds;
    const float* w2 = PF(cmp_w2) + ((size_t)layer * 2 + which) * 128 * 64;
    for (int i = tid; i < 128 * 64; i += NTHR) w2s[i] = w2[i];
    __syncthreads();
    const int r = tid >> 1, half = tid & 1;
    const bf16_t* grow = PF(gb) + ((size_t)((which * 4 + bh) * 512 + nt * 256 + r)) * 128;
    float acc[32];
#pragma unroll
    for (int j = 0; j < 32; ++j) acc[j] = 0.f;
    for (int c8 = 0; c8 < 16; ++c8) {
        const u32x4 gu = *(const u32x4*)(grow + c8 * 8);
        const unsigned gw[4] = {gu.x, gu.y, gu.z, gu.w};
#pragma unroll
        for (int e = 0; e < 8; ++e) {
            const float gv = (e & 1) ? __uint_as_float(gw[e >> 1] & 0xffff0000u) : __uint_as_float(gw[e >> 1] << 16);
            const float* wrow = w2s + (c8 * 8 + e) * 64 + half * 32;
#pragma unroll
            for (int j4 = 0; j4 < 8; ++j4) {
                const float4 w4 = *(const float4*)(wrow + j4 * 4);
                acc[j4 * 4 + 0] = fmaf(gv, w4.x, acc[j4 * 4 + 0]); acc[j4 * 4 + 1] = fmaf(gv, w4.y, acc[j4 * 4 + 1]);
                acc[j4 * 4 + 2] = fmaf(gv, w4.z, acc[j4 * 4 + 2]); acc[j4 * 4 + 3] = fmaf(gv, w4.w, acc[j4 * 4 + 3]);
            }
        }
    }
    const int n = nt * 256 + r;
    if (which == 0) {
        bf16_t* o = PF(kcb) + ((size_t)bh * 512 + n) * 64 + half * 32;
#pragma unroll
        for (int j = 0; j < 32; j += 2) *(unsigned*)(o + j) = pk2(acc[j], acc[j + 1]);
    } else {
        bf16_t* o = PF(vcT) + (size_t)bh * 64 * 512 + n;
#pragma unroll
        for (int j = 0; j < 32; ++j) o[(size_t)(half * 32 + j) * 512] = f2bf(acc[j]);
    }
    __syncthreads();
}

__device__ void phase_gmlp2(KA ka, int layer, LAS unsigned char* lds, int first, int nblk) {
    PHASE_IDS
    const int tid = TID, lane = tid & 63, w = __builtin_amdgcn_readfirstlane(tid >> 6), gq = lane >> 4, lc = lane & 15;
    LAS bf16_t* Vt = (LAS bf16_t*)lds;
    const float* gain = PF(gm_v_gain) + layer * 256;
    const float* bias = PF(gm_v_bias) + layer * 256;
    const float* bs = PF(gm_b_s) + layer * 4 * 128;
    const bf16_t* gmW = PF(WT) + WT_GM;
    const bf16_t* H = PF(H);
    bf16_t* Y = PF(Y);
    if (BID < first) return;
    for (int item = BID - first; item < 512; item += nblk) {
        const int g = item & 3, c = (item >> 2) & 63, b = item >> 8;
        const size_t tok0 = (size_t)b * T_ + (size_t)c * 128;
        __syncthreads();
        for (int i = 0; i < 16; ++i) {
            const int s = w * 16 + i;
            const float x = bf2f(H[(tok0 + s) * HLD + C_GV + g * 64 + lane]);
            const float ge = gelu_t(x);
            const float mu = wave_sum(ge) * (1.f / 64.f);
            const float dl = ge - mu;
            const float var = wave_sum(dl * dl) * (1.f / 64.f);
            Vt[lane * 136 + s] = f2bf(dl * rsqrtf(var + 1e-5f) * gain[g * 64 + lane] + bias[g * 64 + lane]);
        }
        __syncthreads();
        f32x4 acc[4];
#pragma unroll
        for (int ct = 0; ct < 4; ++ct) acc[ct] = (f32x4){0.f, 0.f, 0.f, 0.f};
        const bf16_t* wrow = gmW + ((size_t)g * 128 + 16 * w + lc) * 128 + 8 * gq;
        const int kmax = (16 * w + 15) >> 5;
        for (int ks = 0; ks <= kmax; ++ks) {
            const bf16x8 a = *(const bf16x8*)(wrow + 32 * ks);
#pragma unroll
            for (int ct = 0; ct < 4; ++ct) {
                const bf16x8 bfr = *(const LAS bf16x8*)(Vt + (16 * ct + lc) * 136 + 32 * ks + 8 * gq);
                acc[ct] = MFMA16(a, bfr, acc[ct]);
            }
        }
        const float* ogain = PF(out_gain) + layer * 1024;
#pragma unroll
        for (int i = 0; i < 4; ++i) {
            const int t = 16 * w + 4 * gq + i;
            float yv[4];
            float ss = 0.f;
#pragma unroll
            for (int ct = 0; ct < 4; ++ct) {
                const int d = 16 * ct + lc;
                const float z = acc[ct][i] + bs[g * 128 + t];
                const float u = gelu_t(bf2f(H[(tok0 + t) * HLD + C_GU + g * 64 + d]));
                yv[ct] = u * z;
                ss += yv[ct] * yv[ct];
            }
            ss += __shfl_xor(ss, 1); ss += __shfl_xor(ss, 2); ss += __shfl_xor(ss, 4); ss += __shfl_xor(ss, 8);
            const float rn = rsqrtf(ss * (1.f / 64.f) + 1e-6f);
#pragma unroll
            for (int ct = 0; ct < 4; ++ct) {
                const int d = 16 * ct + lc;
                Y[(tok0 + t) * DM + g * 64 + d] = f2bf(yv[ct] * rn * ogain[g * 64 + d]);
            }
        }
    }
}

#ifndef ONLY_Q
#define ONLY_Q -2
#endif
#ifndef QMASK
#define QMASK 0x3ff
#endif
#define QON(k) ((ONLY_Q == -2 && ((QMASK >> ((k) + 1)) & 1)) || ONLY_Q == (k))
#ifndef DUPMASK
#define DUPMASK 0
#endif
#define DUP(k) ((DUPMASK >> (k)) & 1)
#ifndef PROF_LO
#define PROF_LO -1
#endif
#ifndef PROF_HI
#define PROF_HI -1
#endif
#ifndef NPH_TOTAL
#define NPH_TOTAL 19
#endif
__global__ void __launch_bounds__(NTHR, 2) k_mega(P p0) {
    extern __shared__ __attribute__((aligned(16))) unsigned char lds_raw[];
    LAS unsigned char* lds = (LAS unsigned char*)lds_raw;
    float* smem = (float*)lds_raw;
    volatile LAS unsigned* misc = (volatile LAS unsigned*)(lds + LDS_MISC);
    if (threadIdx.x < 16) misc[threadIdx.x] = 0u;
    __syncthreads();
    XcdBarrier bar = xcd_barrier_post(p0.ctl + CW_BAR, misc);
    if (PROF_LO >= 0 && blockIdx.x == 0 && threadIdx.x == 0) ((unsigned long long*)(p0.ctl + 8192))[0] = __builtin_amdgcn_s_memrealtime();
#pragma unroll 1
    for (int ph = 0; ph < p0.nph; ph++) {
        const int layer = ph == 0 ? 0 : (ph - 1) / 9, q = ph == 0 ? -1 : (ph - 1) % 9;
        const int dupm = p0.pad;
#if defined(__HIP_DEVICE_COMPILE__)
        KA ka = (KA)__builtin_amdgcn_kernarg_segment_ptr();
        asm volatile("" : "+s"(ka));
#else
        KA ka = nullptr;
#endif
        const float* xin = layer == 0 ? PF(x) : PF(out);
        float* x1 = PF(out);
        if (q == -1 && QON(-1)) { for (int r = 0; r <= ((dupm >> 15) & 1); ++r) { phase_prologue(ka, 0, smem); __syncthreads(); } }
        else if (q == 0 && QON(0)) { for (int r = 0; r <= (dupm & 1); ++r) { phase_inproj(ka, layer, lds); __syncthreads(); } }
        else if (q == 1 && QON(1)) {
            const int nb1 = (int)gridDim.x > 32 ? 16 : 0, nwork = (int)gridDim.x - nb1;
            for (int r = 0; r <= ((dupm >> 12) & 1); ++r) { phase_compress2(ka, layer, lds); __syncthreads(); }
            for (int r = 0; r <= ((dupm >> 10) & 1); ++r) { phase_hgrnA(ka, layer, smem, nb1, nwork); __syncthreads(); }
            for (int r = 0; r <= ((dupm >> 11) & 1); ++r) { phase_gmlp2(ka, layer, lds, nb1, nwork); __syncthreads(); }
            for (int r = 0; r <= ((dupm >> 13) & 1); ++r) { phase_vtrans(ka, smem); __syncthreads(); }
        }
        else if (q == 2 && QON(2)) { for (int r = 0; r <= ((dupm >> 14) & 1); ++r) { phase_hgrnB(ka); __syncthreads(); } for (int r = 0; r <= ((dupm >> 2) & 1); ++r) { phase_nsa2(ka, layer, lds); __syncthreads(); } }
        else if (q == 3 && QON(3)) { for (int r = 0; r <= ((dupm >> 3) & 1); ++r) { phase_hgrnC(ka, layer, smem); __syncthreads(); } }
        else if (q == 4 && QON(4)) phase_outproj(ka, layer, xin, x1, lds);
        else if (q == 5 && QON(5)) { for (int r = ((dupm >> 5) & 1); r >= 0; --r) { phase_ln1_route(ka, layer, x1, smem, r == 1); __syncthreads(); } }
        else if (q == 6 && QON(6)) { for (int r = 0; r <= ((dupm >> 6) & 1); ++r) { phase_moe_up(ka, layer, lds); __syncthreads(); } }
        else if (q == 7 && QON(7)) { for (int r = 0; r <= ((dupm >> 7) & 1); ++r) { phase_moe_down(ka, layer, lds); __syncthreads(); } }
        else if (q == 8 && QON(8)) { phase_ln2(ka, layer, x1, PF(out)); if (layer == 0) { __syncthreads(); phase_prologue(ka, 1, smem); } }
        if (ph != NPH_TOTAL - 1 || PROF_LO >= 0) xcd_barrier(bar);
        if (PROF_LO >= 0 && blockIdx.x == 0 && threadIdx.x == 0) ((unsigned long long*)(p0.ctl + 8192))[ph + 1] = __builtin_amdgcn_s_memrealtime();
    }
    if (PROF_LO >= 0) {
        xcd_barrier(bar);
        const unsigned long long* ts = (const unsigned long long*)(p0.ctl + 8192);
        const unsigned long long t0 = __hip_atomic_load(&ts[PROF_LO], __ATOMIC_RELAXED, __HIP_MEMORY_SCOPE_AGENT), t1 = __hip_atomic_load(&ts[PROF_HI + 1], __ATOMIC_RELAXED, __HIP_MEMORY_SCOPE_AGENT);
        const float fac = 1.f + 1e-5f * (float)(t1 - t0);
        for (size_t i = (size_t)blockIdx.x * NTHR + threadIdx.x; i < (size_t)NTOK * DM; i += (size_t)gridDim.x * NTHR) p0.out[i] *= fac;
    }
}

static inline size_t align_up(size_t v, size_t a) { return (v + a - 1) / a * a; }

extern "C" void kernel_launch(void* const* d_in, const int* in_sizes, int n_in, void* d_out, int out_size, void* d_ws,
                              size_t ws_size, hipStream_t stream) {
    P p{};
    p.x = (const float*)d_in[0]; p.w_in = (const float*)d_in[1]; p.gm_v_gain = (const float*)d_in[2];
    p.gm_v_bias = (const float*)d_in[3]; p.gm_w_s = (const float*)d_in[4]; p.gm_b_s = (const float*)d_in[5];
    p.cmp_pos = (const float*)d_in[6]; p.cmp_w1 = (const float*)d_in[7]; p.cmp_w2 = (const float*)d_in[8];
    p.nsa_gate_b = (const float*)d_in[9]; p.hg_lower = (const float*)d_in[10]; p.out_gain = (const float*)d_in[11];
    p.w_out = (const float*)d_in[12]; p.ln1_g = (const float*)d_in[13]; p.ln1_b = (const float*)d_in[14];
    p.rg_w = (const float*)d_in[15]; p.rg_b = (const float*)d_in[16]; p.re_w = (const float*)d_in[17];
    p.re_b = (const float*)d_in[18]; p.w_gate = (const float*)d_in[19]; p.w_up = (const float*)d_in[20];
    p.w_down = (const float*)d_in[21]; p.ln2_g = (const float*)d_in[22]; p.ln2_b = (const float*)d_in[23];
    p.out = (float*)d_out;
    char* ws = (char*)d_ws;
    size_t off = 0;
    p.ctl = (unsigned*)(ws + off); off = align_up(off + CTL_BYTES, 256);
    p.WT = (bf16_t*)(ws + off); off = align_up(off + WT_LAYER * 2, 256);
    p.H = (bf16_t*)(ws + off); off = align_up(off + (size_t)NTOK * HLD * 2, 256);
    p.Y = (bf16_t*)(ws + off); off = align_up(off + (size_t)NTOK * DM * 2, 256);
    p.XB = (bf16_t*)(ws + off); off = align_up(off + (size_t)NTOK * DM * 2, 256);
    p.kcb = (bf16_t*)(ws + off); off = align_up(off + (size_t)4 * 512 * 64 * 2, 256);
    p.vcT = (bf16_t*)(ws + off); off = align_up(off + (size_t)4 * 64 * 512 * 2, 256);
    p.vsT = (bf16_t*)(ws + off); off = align_up(off + (size_t)4 * 64 * T_ * 2, 256);
    p.vwT = (bf16_t*)(ws + off); off = align_up(off + (size_t)4 * 64 * T_ * 2, 256);
    p.gb = (bf16_t*)(ws + off); off = align_up(off + (size_t)8 * 512 * 128 * 2, 256);
    p.cbias = (float*)(ws + off); off = align_up(off + 256 * 4, 256);
    p.list_tok = (int*)(ws + off); off = align_up(off + (size_t)16 * NTOK * 4, 256);
    p.list_w = (float*)(ws + off); off = align_up(off + (size_t)16 * NTOK * 4, 256);
    p.tok_slot = (int*)(ws + off); off = align_up(off + (size_t)NTOK * 2 * 4, 256);
    p.hgU = (float*)p.XB; p.hgS = p.hgU + (size_t)1024 * 4096;
    p.hgG = (float*)(ws + off); off = align_up(off + (size_t)1024 * 64 * 4, 256);
    p.hgQB = (bf16_t*)(ws + off); off = align_up(off + (size_t)1024 * 4096 * 2, 256);
    p.hgO = (bf16_t*)(ws + off); off = align_up(off + (size_t)1024 * 4096 * 2, 256);
    p.nph = NPH_TOTAL; p.pad = DUPMASK;
    (void)in_sizes; (void)n_in; (void)out_size;
    static int grid_blocks = 0;
    if (!grid_blocks) {
        int dev = 0, cus = 0, per_cu = 0;
        (void)hipGetDevice(&dev);
        (void)hipDeviceGetAttribute(&cus, hipDeviceAttributeMultiprocessorCount, dev);
        if (hipFuncSetAttribute((const void*)k_mega, hipFuncAttributeMaxDynamicSharedMemorySize, LDS_BYTES) != hipSuccess) { fprintf(stderr, "hipFuncSetAttribute failed\n"); grid_blocks = -1; return; }
        if (hipOccupancyMaxActiveBlocksPerMultiprocessor(&per_cu, (const void*)k_mega, NTHR, LDS_BYTES) != hipSuccess || per_cu < 1) { fprintf(stderr, "occupancy query says %d\n", per_cu); }
        (void)hipGetLastError();
        grid_blocks = cus;
        if (off > ws_size) { fprintf(stderr, "workspace too small: need %zu have %zu\n", off, ws_size); grid_blocks = -1; }
    }
    if (grid_blocks < 0) return;
    (void)hipMemsetAsync(p.ctl, 0, CTL_BYTES, stream);
    void* args[] = {&p};
    hipError_t e = hipLaunchCooperativeKernel((const void*)k_mega, dim3(grid_blocks), dim3(NTHR), args, LDS_BYTES, stream);
    if (e != hipSuccess) fprintf(stderr, "cooperative launch failed: %s (grid %d)\n", hipGetErrorString(e), grid_blocks);
}
```

```cpp
#include <hip/hip_runtime.h>
#include <cstdio>
#include <cstdint>

#define LAS __attribute__((address_space(3)))
typedef unsigned short bf16_t;
typedef short bf16x8 __attribute__((ext_vector_type(8)));
typedef float f32x4 __attribute__((ext_vector_type(4)));
typedef float f32x2 __attribute__((ext_vector_type(2)));
typedef unsigned u32x4 __attribute__((ext_vector_type(4)));
typedef unsigned u32x2 __attribute__((ext_vector_type(2)));

constexpr int NW = 8;
constexpr int NTHR = NW * 64;
constexpr int T_ = 8192;
constexpr int NTOK = 16384;
constexpr int DM = 1024;
constexpr int IC_SRC = 2840;
constexpr int HLD = 3072;
constexpr int C_GU = 0, C_GV = 256, C_NQ = 512, C_KC = 1024, C_VC = 1152, C_KS = 1280, C_VS = 1408,
              C_KW = 1536, C_VW = 1664, C_HQ = 1792, C_HF = 2048, C_HI = 2304, C_HG = 2560, C_NG = 2816;
constexpr int NCMP = 511;
constexpr float ALPHA = 1.4142135623730951f;
constexpr float NEG_INF = -1e30f;

constexpr size_t WT_IN = 0;
constexpr size_t WT_OUT = WT_IN + (size_t)3072 * 1024;
constexpr size_t WT_UP = WT_OUT + (size_t)1024 * 1024;
constexpr size_t WT_DN = WT_UP + (size_t)16 * 1024 * 1024;
constexpr size_t WT_C1 = WT_DN + (size_t)16 * 1024 * 512;
constexpr size_t WT_GM = WT_C1 + (size_t)2 * 256 * 2048;
constexpr size_t WT_LAYER = WT_GM + (size_t)4 * 128 * 128;

constexpr int LDS_STAGE = 131072;
constexpr int LDS_MISC = LDS_STAGE;
constexpr int LDS_BYTES = 147456;

constexpr int CW_BAR = 0;
constexpr int CW_CNT = 4096;
constexpr size_t CTL_BYTES = 65536;

struct P {
    const float* x; const float* w_in; const float* gm_v_gain; const float* gm_v_bias; const float* gm_w_s;
    const float* gm_b_s; const float* cmp_pos; const float* cmp_w1; const float* cmp_w2; const float* nsa_gate_b;
    const float* hg_lower; const float* out_gain; const float* w_out; const float* ln1_g; const float* ln1_b;
    const float* rg_w; const float* rg_b; const float* re_w; const float* re_b; const float* w_gate;
    const float* w_up; const float* w_down; const float* ln2_g; const float* ln2_b;
    float* out;
    unsigned* ctl;
    bf16_t* WT;
    bf16_t* H;
    bf16_t* Y;
    bf16_t* XB;
    bf16_t* kcb;
    bf16_t* vcT;
    bf16_t* vsT;
    bf16_t* vwT;
    bf16_t* gb;
    float* cbias;
    int* list_tok;
    float* list_w;
    int* tok_slot;
    float* hgU; float* hgG; float* hgS; bf16_t* hgQB; bf16_t* hgO;
    int nph; int pad;
};


typedef const __attribute__((address_space(4))) char* KA;
template <class T> __device__ __forceinline__ T ldarg(KA ka, size_t off) { return *(const __attribute__((address_space(4))) T*)(ka + off); }
#define PF(f) ldarg<decltype(P::f)>(ka, offsetof(P, f))

__device__ __forceinline__ float bf2f(bf16_t u) { return __uint_as_float(((unsigned)u) << 16); }
__device__ __forceinline__ unsigned f2bf_u(float f) {
    unsigned u = __float_as_uint(f);
    return (u + 0x7fffu + ((u >> 16) & 1u)) >> 16;
}
__device__ __forceinline__ bf16_t f2bf(float f) { return (bf16_t)f2bf_u(f); }
__device__ __forceinline__ unsigned pk2(float lo, float hi) { return f2bf_u(lo) | (f2bf_u(hi) << 16); }
__device__ __forceinline__ float gelu_t(float x) {
    float u = 0.7978845608028654f * (x + 0.044715f * x * x * x);
    return 0.5f * x * (1.f + tanhf(u));
}
__device__ __forceinline__ float sigmoidf_(float x) { return 1.f / (1.f + __expf(-x)); }
__device__ __forceinline__ float wave_max(float v) {
#pragma unroll
    for (int o = 32; o > 0; o >>= 1) v = fmaxf(v, __shfl_xor(v, o));
    return v;
}
__device__ __forceinline__ float wave_sum(float v) {
#pragma unroll
    for (int o = 32; o > 0; o >>= 1) v += __shfl_xor(v, o);
    return v;
}
__device__ __forceinline__ void wave_sync() {
    __builtin_amdgcn_fence(__ATOMIC_RELEASE, "wavefront");
    __builtin_amdgcn_wave_barrier();
    __builtin_amdgcn_fence(__ATOMIC_ACQUIRE, "wavefront");
}
__device__ __forceinline__ int opaque_tid() { int t = threadIdx.x; asm volatile("" : "+v"(t)); return t; }
__device__ __forceinline__ int opaque_bid() { int b = blockIdx.x; asm volatile("" : "+s"(b)); return b; }
#define PHASE_IDS const int TID = opaque_tid(); const int BID = opaque_bid(); (void)TID; (void)BID;

#define XB_TMO      128
#define XB_XCNT(j)  (256  + 64 * (j))
#define XB_XSUB(j)  (1280 + 64 * (j))
#define XB_XGEN(j)  (2304 + 64 * (j))
#define XB_TOP      3328
#define XB_TOPGEN   3392
#define XCD_BAR_WORDS 3456
#define XB_SPIN_CAP (1u << 22)
__device__ __forceinline__ unsigned xb_ld(unsigned* p)              { return __hip_atomic_load(p, __ATOMIC_RELAXED, __HIP_MEMORY_SCOPE_AGENT); }
__device__ __forceinline__ unsigned xb_add(unsigned* p, unsigned v) { return __hip_atomic_fetch_add(p, v, __ATOMIC_RELAXED, __HIP_MEMORY_SCOPE_AGENT); }
__device__ __forceinline__ unsigned xb_xcc_id() { return (unsigned)__builtin_amdgcn_s_getreg((3 << 11) | 20) & 0xFu; }
#define XB_SPIN(cond, bar) do { unsigned _sp = 0; while (cond) { __builtin_amdgcn_s_sleep(1); \
    if ((++_sp & 255u) == 0u) { if (xb_ld(&(bar)[XB_TMO])) break; if (_sp > XB_SPIN_CAP) { atomicAdd(&(bar)[XB_TMO], 1u); break; } } } } while (0)
struct XcdBarrier { unsigned* bar; unsigned x; volatile LAS unsigned* st; };
__device__ __forceinline__ XcdBarrier xcd_barrier_post(unsigned* bar, volatile LAS unsigned* st) {
    XcdBarrier b; b.bar = bar; b.x = xb_xcc_id(); b.st = st;
    if (threadIdx.x == 0) (void)xb_add(&bar[XB_XCNT(b.x)], 1u);
    return b;
}
__device__ __forceinline__ void xcd_barrier_complete(unsigned* bar, unsigned x, unsigned& nloc, unsigned& nx) {
    const unsigned G = gridDim.x * gridDim.y * gridDim.z;
    unsigned sum, cnt, mine, sp = 0u;
    for (;;) {
        sum = 0u; cnt = 0u; mine = 0u;
#pragma unroll
        for (unsigned j = 0; j < 16; ++j) { const unsigned c = xb_ld(&bar[XB_XCNT(j)]); sum += c; cnt += (c > 0u) ? 1u : 0u; mine = (j == x) ? c : mine; }
        if (sum == G) break;
        __builtin_amdgcn_s_sleep(1);
        if ((++sp & 255u) == 0u) { if (xb_ld(&bar[XB_TMO])) break; if (sp > XB_SPIN_CAP) { atomicAdd(&bar[XB_TMO], 1u); break; } }
    }
    nloc = mine > 0u ? mine : 1u; nx = cnt > 0u ? cnt : 1u;
}
__device__ __forceinline__ void xcd_barrier(const XcdBarrier& b) {
    asm volatile("s_waitcnt vmcnt(0)" ::: "memory");
    __syncthreads();
    if (threadIdx.x == 0) {
        unsigned* bar = b.bar;
        __builtin_amdgcn_s_waitcnt(0);
        unsigned nloc = b.st[0], nx = b.st[1];
        if (nloc == 0u) { xcd_barrier_complete(bar, b.x, nloc, nx); b.st[0] = nloc; b.st[1] = nx; }
        const unsigned old = xb_add(&bar[XB_XSUB(b.x)], 1u);
        const unsigned gen = old / nloc;
        if (old + 1u == (gen + 1u) * nloc) {
            __builtin_amdgcn_fence(__ATOMIC_RELEASE, "agent");
            asm volatile("s_waitcnt vmcnt(0)" ::: "memory");
            const unsigned og = xb_add(&bar[XB_TOP], 1u);
            const unsigned tg = og / nx;
            if (og + 1u == (tg + 1u) * nx) xb_add(&bar[XB_TOPGEN], 1u);
            else XB_SPIN(xb_ld(&bar[XB_TOPGEN]) == tg, bar);
            __builtin_amdgcn_fence(__ATOMIC_ACQUIRE, "agent");
            xb_add(&bar[XB_XGEN(b.x)], 1u);
            asm volatile("s_waitcnt vmcnt(0)" ::: "memory");
        } else {
            XB_SPIN(xb_ld(&bar[XB_XGEN(b.x)]) == gen, bar);
            __builtin_amdgcn_fence(__ATOMIC_ACQUIRE, "agent");
            asm volatile("s_waitcnt vmcnt(0)" ::: "memory");
        }
    }
    __syncthreads();
}

namespace pg8 {
constexpr int BM = 256, BK = 64, HALF = 128, HTB = HALF * BK * 2, STAGE_BYTES = 8 * HTB;
__host__ __device__ __forceinline__ int lds_byte(int r, int c) { const int st = (r >> 4) * 2 + (c >> 5), rr = r & 15, cc = c & 31, ob = rr * 64 + cc * 2; return st * 1024 + (ob ^ (((ob >> 9) & 1) << 5)); }
__host__ __device__ __forceinline__ void stage_rc(int b, int& R, int& C) { const int st = b / 1024, sb = b % 1024, swz = sb ^ (((sb >> 9) & 1) << 5); R = (st >> 1) * 16 + swz / 64; C = (st & 1) * 32 + (swz % 64) / 2; }
__host__ __device__ __forceinline__ int perm32(int rho) { const int n = rho >> 4, i = rho & 15; return 8 * (i >> 2) + 4 * n + (i & 3); }
__device__ __forceinline__ unsigned cvt_pk_bf16(float lo, float hi) { unsigned r; asm volatile("v_cvt_pk_bf16_f32 %0, %1, %2" : "=v"(r) : "v"(lo), "v"(hi)); return r; }

struct Unit {
    const char* bptr;
    int arow0;
    int nrows;
    int pm, pn, e, ui;
};

template <class Epi, class Sched>
__device__ __forceinline__ void gemm_phase(LAS unsigned char* lds, const char* Abase, const int K, const Sched& S, const Epi& E) {
    const int tid = opaque_tid(), wid = __builtin_amdgcn_readfirstlane(tid >> 6), lane = tid & 63, wr = wid >> 2, wc = wid & 3, fr = lane & 15, fq = lane >> 4;
    const int nt = K / BK;
    int R0, C0, R1, C1; stage_rc(tid * 16, R0, C0); stage_rc(tid * 16 + 8192, R1, C1);
    unsigned voffB[2];
    { const int Rb0 = Epi::PERM ? ((R0 & ~31) + perm32(R0 & 31)) : R0, Rb1 = Epi::PERM ? ((R1 & ~31) + perm32(R1 & 31)) : R1;
      voffB[0] = (unsigned)(Rb0 * K + C0) * 2u; voffB[1] = (unsigned)(Rb1 * K + C1) * 2u; }
    const unsigned cA0 = (unsigned)C0 * 2u, cA1 = (unsigned)C1 * 2u;
    const int lda = S.lda(K);
    const unsigned kstepA = S.kstepA();
    const unsigned voffA0 = (unsigned)(R0 * lda + C0) * 2u, voffA1 = (unsigned)(R1 * lda + C1) * 2u;
    const unsigned kstep = (unsigned)(BK * 2);
    const unsigned hstep = (unsigned)(HALF * K * 2);
    const unsigned ldsw = (unsigned)wid * 1024u;
    const int aoff = lds_byte(wr * 64 + fr, fq * 8), boff = lds_byte(wc * 32 + fr, fq * 8);
#define PG8_SA(b, h) (((b) * 2 + (h)) * HTB)
#define PG8_SB(b, h) ((4 + (b) * 2 + (h)) * HTB)
#define PG8_STAGE_B(bufoff, gbase) do { \
        __builtin_amdgcn_global_load_lds((const unsigned*)((const char*)(gbase) + voffB[0]), (LAS unsigned*)(lds + (bufoff) + ldsw), 16, 0, 0); \
        __builtin_amdgcn_global_load_lds((const unsigned*)((const char*)(gbase) + voffB[1]), (LAS unsigned*)(lds + (bufoff) + ldsw + 8192), 16, 0, 0); } while (0)
#define PG8_STAGE_A(bufoff, gbase, pk) do { \
        const unsigned o0_ = Sched::GATHER ? (((pk) & 0xffffu) * (unsigned)lda * 2u + cA0) : voffA0; \
        const unsigned o1_ = Sched::GATHER ? (((pk) >> 16) * (unsigned)lda * 2u + cA1) : voffA1; \
        __builtin_amdgcn_global_load_lds((const unsigned*)((const char*)(gbase) + o0_), (LAS unsigned*)(lds + (bufoff) + ldsw), 16, 0, 0); \
        __builtin_amdgcn_global_load_lds((const unsigned*)((const char*)(gbase) + o1_), (LAS unsigned*)(lds + (bufoff) + ldsw + 8192), 16, 0, 0); } while (0)
#define PG8_LDA(dst, b, h) do { _Pragma("unroll") for (int m = 0; m < 4; ++m) _Pragma("unroll") for (int k = 0; k < 2; ++k) dst[m][k] = *(const LAS bf16x8*)(lds + PG8_SA(b, h) + aoff + m * 2048 + k * 1024); } while (0)
#define PG8_LDB(dst, b, h) do { _Pragma("unroll") for (int n = 0; n < 2; ++n) _Pragma("unroll") for (int k = 0; k < 2; ++k) dst[n][k] = *(const LAS bf16x8*)(lds + PG8_SB(b, h) + boff + n * 2048 + k * 1024); } while (0)
#define PG8_MMA(ai, bj, At, Bt) do { __builtin_amdgcn_s_setprio(1); _Pragma("unroll") for (int m = 0; m < 4; ++m) _Pragma("unroll") for (int n = 0; n < 2; ++n) _Pragma("unroll") for (int k = 0; k < 2; ++k) \
        acc[ai][bj][m][n] = __builtin_amdgcn_mfma_f32_16x16x32_bf16(Bt[n][k], At[m][k], acc[ai][bj][m][n], 0, 0, 0); __builtin_amdgcn_s_setprio(0); } while (0)
#define PG8_WAIT_V(n) asm volatile("s_waitcnt vmcnt(" #n ")" ::: "memory")
#define PG8_WAIT_L(n) asm volatile("s_waitcnt lgkmcnt(" #n ")" ::: "memory")
#define PG8_BAR __builtin_amdgcn_s_barrier()
#define PG8_SCHED __builtin_amdgcn_sched_barrier(0)
#define PG8_PACK(u, h) ((unsigned)S.arow((u), ((h) * 128 + R0) < (u).nrows ? ((h) * 128 + R0) : (u).nrows - 1) | ((unsigned)S.arow((u), ((h) * 128 + R1) < (u).nrows ? ((h) * 128 + R1) : (u).nrows - 1) << 16))
    Unit cur, nxt; int ui = 0;
    if (!S.next(0, cur)) return;
    f32x4 acc[2][2][4][2];
#pragma unroll
    for (int a = 0; a < 2; ++a)
#pragma unroll
        for (int b = 0; b < 2; ++b)
#pragma unroll
            for (int m = 0; m < 4; ++m)
#pragma unroll
                for (int n = 0; n < 2; ++n) acc[a][b][m][n] = (f32x4){0.f, 0.f, 0.f, 0.f};
    bf16x8 At[4][2], B0[2][2], B1[2][2];
    unsigned pC0 = 0u, pC1 = 0u, pN0 = 0u, pN1 = 0u;
    if (Sched::GATHER) { pC0 = PG8_PACK(cur, 0); pC1 = PG8_PACK(cur, 1); }
    const char* cB = cur.bptr;
    const char* cA = Sched::GATHER ? Abase : S.abase(cur, Abase) + (size_t)cur.arow0 * lda * 2;
    const unsigned hA = Sched::GATHER ? 0u : (unsigned)(HALF * lda * 2);
    PG8_STAGE_B(PG8_SB(0, 0), cB); PG8_STAGE_B(PG8_SB(0, 1), cB + hstep); PG8_STAGE_A(PG8_SA(0, 0), cA, pC0); PG8_STAGE_A(PG8_SA(0, 1), cA + hA, pC1);
    if (wr == 1) PG8_BAR;
    PG8_WAIT_V(2); PG8_BAR;
    PG8_STAGE_B(PG8_SB(1, 0), cB + kstep); PG8_STAGE_A(PG8_SA(1, 0), cA + kstepA, pC0); PG8_STAGE_B(PG8_SB(1, 1), cB + hstep + kstep);
    PG8_WAIT_V(6); PG8_BAR;
    for (;;) {
        const bool has_next = S.next(ui + 1, nxt);
        if (Sched::GATHER) { if (has_next) { pN0 = PG8_PACK(nxt, 0); pN1 = PG8_PACK(nxt, 1); } else { pN0 = pC0; pN1 = pC1; } }
        const char* nB = has_next ? nxt.bptr : cB;
        const char* nA = (Sched::GATHER || !has_next) ? cA : S.abase(nxt, Abase) + (size_t)nxt.arow0 * lda * 2;
        for (int t = 0; t < nt; t += 2) {
            const bool last = (t == nt - 2);
            const char* a1 = cA + (unsigned)(t + 1) * kstepA;
            const char* a2 = last ? nA : cA + (unsigned)(t + 2) * kstepA; const char* b2 = last ? nB : cB + (unsigned)(t + 2) * kstep;
            const char* a3 = a2 + kstepA; const char* b3 = b2 + kstep;
            const unsigned s0 = last ? pN0 : pC0, s1 = last ? pN1 : pC1;
            PG8_LDB(B0, 0, 0); PG8_LDB(B1, 0, 1); PG8_SCHED; PG8_LDA(At, 0, 0); PG8_STAGE_A(PG8_SA(1, 1), a1 + hA, pC1);
            PG8_WAIT_V(8); PG8_WAIT_L(0); PG8_BAR; PG8_MMA(0, 0, At, B0); PG8_MMA(0, 1, At, B1); PG8_BAR; PG8_SCHED;
            PG8_LDA(At, 0, 1); PG8_STAGE_B(PG8_SB(0, 0), b2); PG8_STAGE_B(PG8_SB(0, 1), b2 + hstep); PG8_STAGE_A(PG8_SA(0, 0), a2, s0);
            PG8_WAIT_V(8); PG8_WAIT_L(0); PG8_BAR; PG8_MMA(1, 0, At, B0); PG8_MMA(1, 1, At, B1); PG8_BAR; PG8_SCHED;
            PG8_LDB(B0, 1, 0); PG8_LDB(B1, 1, 1); PG8_SCHED; PG8_LDA(At, 1, 0); PG8_STAGE_A(PG8_SA(0, 1), a2 + hA, s1);
            PG8_WAIT_V(8); PG8_WAIT_L(0); PG8_BAR; PG8_MMA(0, 0, At, B0); PG8_MMA(0, 1, At, B1); PG8_BAR; PG8_SCHED;
            PG8_LDA(At, 1, 1); PG8_STAGE_B(PG8_SB(1, 0), b3); PG8_STAGE_B(PG8_SB(1, 1), b3 + hstep); PG8_STAGE_A(PG8_SA(1, 0), a3, s0);
            PG8_WAIT_V(8); PG8_WAIT_L(0); PG8_BAR; PG8_MMA(1, 0, At, B0); PG8_MMA(1, 1, At, B1); PG8_BAR; PG8_SCHED;
        }
        if (wr == 0) PG8_BAR;
        E(acc, cur, wr, wc, fr, fq);
        if (!has_next) break;
#pragma unroll
        for (int a = 0; a < 2; ++a)
#pragma unroll
            for (int b = 0; b < 2; ++b)
#pragma unroll
                for (int m = 0; m < 4; ++m)
#pragma unroll
                    for (int n = 0; n < 2; ++n) acc[a][b][m][n] = (f32x4){0.f, 0.f, 0.f, 0.f};
        cur = nxt; cB = nB; cA = nA; ++ui;
        pC0 = pN0; pC1 = pN1;
        if (wr == 1) PG8_BAR;
    }
    PG8_WAIT_V(0);
    PG8_BAR;
#undef PG8_SA
#undef PG8_SB
#undef PG8_STAGE_A
#undef PG8_STAGE_B
#undef PG8_LDA
#undef PG8_LDB
#undef PG8_MMA
#undef PG8_WAIT_V
#undef PG8_WAIT_L
#undef PG8_BAR
#undef PG8_SCHED
#undef PG8_PACK
}

struct DenseOrder {
    static constexpr bool GATHER = false;
    int nM, nN, nwg, G, c; const char* Bt; int K;
    __device__ void init(int M, int N, int K_, const bf16_t* Bt_, int G_, int c_) { nM = M / BM; nN = N / BM; nwg = nM * nN; G = G_; c = c_; Bt = (const char*)Bt_; K = K_; }
    __device__ __forceinline__ bool next(int i, Unit& u) const {
        const long L = (long)i * G + c; if (L >= nwg) return false;
        int wgid = (int)L; { const int q = nwg / 8, r = nwg % 8, xcd = wgid % 8, off = wgid / 8; wgid = (xcd < r ? xcd * (q + 1) : r * (q + 1) + (xcd - r) * q) + off; }
        const int nig = 8 * nN, gid = wgid / nig, fm = gid * 8, gsz = (nM - fm) < 8 ? (nM - fm) : 8;
        u.pm = fm + ((wgid % nig) % gsz); u.pn = (wgid % nig) / gsz;
        u.arow0 = u.pm * BM; u.nrows = BM; u.e = 0; u.ui = i;
        u.bptr = Bt + (size_t)u.pn * BM * K * 2;
        return true;
    }
    __device__ __forceinline__ int arow(const Unit& u, int r) const { return u.arow0 + r; }
    __device__ __forceinline__ int lda(int K_) const { return K_; }
    __device__ __forceinline__ unsigned kstepA() const { return 128u; }
    __device__ __forceinline__ const char* abase(const Unit&, const char* A) const { return A; }
};
}

struct EpiH {
    static constexpr bool PERM = true;
    bf16_t* H;
    __device__ __forceinline__ void operator()(const f32x4 (&acc)[2][2][4][2], const pg8::Unit& u, int wr, int wc, int fr, int fq) const {
        const int row0 = u.arow0 + wr * 64 + fr, col0 = u.pn * 256 + wc * 32 + 8 * fq;
#pragma unroll
        for (int ai = 0; ai < 2; ++ai)
#pragma unroll
            for (int m = 0; m < 4; ++m) {
                bf16_t* rowp = H + (size_t)(row0 + ai * 128 + m * 16) * HLD + col0;
#pragma unroll
                for (int bj = 0; bj < 2; ++bj) {
                    const f32x4 v0 = acc[ai][bj][m][0], v1 = acc[ai][bj][m][1];
                    u32x4 w; w.x = pg8::cvt_pk_bf16(v0[0], v0[1]); w.y = pg8::cvt_pk_bf16(v0[2], v0[3]); w.z = pg8::cvt_pk_bf16(v1[0], v1[1]); w.w = pg8::cvt_pk_bf16(v1[2], v1[3]);
                    *(u32x4*)(rowp + bj * 128) = w;
                }
            }
    }
};
struct EpiRes {
    static constexpr bool PERM = false;
    const float* xin; float* out;
    __device__ __forceinline__ void operator()(const f32x4 (&acc)[2][2][4][2], const pg8::Unit& u, int wr, int wc, int fr, int fq) const {
        const int row0 = u.arow0 + wr * 64 + fr, col0 = u.pn * 256 + wc * 32 + 4 * fq;
#pragma unroll
        for (int ai = 0; ai < 2; ++ai)
#pragma unroll
            for (int m = 0; m < 4; ++m) {
                const size_t off = (size_t)(row0 + ai * 128 + m * 16) * DM + col0;
#pragma unroll
                for (int bj = 0; bj < 2; ++bj)
#pragma unroll
                    for (int n = 0; n < 2; ++n) {
                        const f32x4 xv = *(const f32x4*)(xin + off + bj * 128 + n * 16);
                        *(f32x4*)(out + off + bj * 128 + n * 16) = xv * ALPHA + acc[ai][bj][m][n];
                    }
            }
    }
};

template <class RM>
__device__ __forceinline__ void transpose_item(const float* W, int K, int N, bf16_t* WT, RM rowmap, float* scr, int kb, int nb, int lane) {
    const int k0 = 64 * kb, n0 = 32 * nb;
    const int nn = n0 + (lane & 31);
    float tmp[32];
#pragma unroll
    for (int i = 0; i < 32; ++i) {
        const int kk = 2 * i + (lane >> 5);
        tmp[i] = nn < N ? W[(size_t)(k0 + kk) * N + nn] : 0.f;
    }
#pragma unroll
    for (int i = 0; i < 32; ++i) {
        const int kk = 2 * i + (lane >> 5);
        scr[kk * 33 + (lane & 31)] = tmp[i];
    }
    wave_sync();
    const int c = lane & 7;
#pragma unroll
    for (int j = 0; j < 4; ++j) {
        const int n = (lane >> 3) + 8 * j;
        const float* s = scr + (8 * c) * 33 + n;
        u32x4 o; o.x = pk2(s[0 * 33], s[1 * 33]); o.y = pk2(s[2 * 33], s[3 * 33]); o.z = pk2(s[4 * 33], s[5 * 33]); o.w = pk2(s[6 * 33], s[7 * 33]);
        const int dr = (n0 + n < N) ? rowmap(n0 + n) : -1;
        if (dr >= 0) *(u32x4*)(WT + (size_t)dr * K + k0 + 8 * c) = o;
    }
    wave_sync();
}

__device__ void phase_prologue(KA ka, int layer, float* smem) {
    PHASE_IDS
    const int lane = TID & 63, w = TID >> 6;
    float* scr = smem + w * 4096;
    const int gw = BID * NW + w, NGW = gridDim.x * NW;
    constexpr int I_IN = 16 * 89, I_OUT = 16 * 32, I_GU = 16 * 16, I_DN = 8 * 32;
    constexpr int I_LAYER = I_IN + I_OUT + 32 * I_GU + 16 * I_DN;
    for (int it = gw; it < I_LAYER; it += NGW) {
        int r = it;
        bf16_t* WT = PF(WT);
        if (r < I_IN) {
            transpose_item(PF(w_in) + (size_t)layer * DM * IC_SRC, DM, IC_SRC, WT + WT_IN,
                           [](int n) { return n < 1792 ? n : (n < 1816 ? 2816 + (n - 1792) : n - 24); }, scr, r / 89, r % 89, lane);
            continue;
        }
        r -= I_IN;
        if (r < I_OUT) {
            transpose_item(PF(w_out) + (size_t)layer * DM * DM, DM, DM, WT + WT_OUT, [](int n) { return n; }, scr, r / 32, r % 32, lane);
            continue;
        }
        r -= I_OUT;
        if (r < 32 * I_GU) {
            const int mat = r / I_GU, rr = r % I_GU, e = mat >> 1, isup = mat & 1;
            const float* W = (isup ? PF(w_up) : PF(w_gate)) + ((size_t)layer * 16 + e) * DM * 512;
            transpose_item(W, DM, 512, WT + WT_UP + (size_t)e * 1024 * 1024,
                           [isup](int n) { return (n >> 7) * 256 + isup * 128 + (n & 127); }, scr, rr / 16, rr % 16, lane);
            continue;
        }
        r -= 32 * I_GU;
        {
            const int e = r / I_DN, rr = r % I_DN;
            transpose_item(PF(w_down) + ((size_t)layer * 16 + e) * 512 * DM, 512, DM, WT + WT_DN + (size_t)e * 1024 * 512,
                           [](int n) { return n; }, scr, rr / 32, rr % 32, lane);
        }
    }
    for (int it = gw; it < 2 * 32 * 4; it += NGW) {
        const int which = it >> 7, rr = it & 127;
        transpose_item(PF(cmp_w1) + ((size_t)layer * 2 + which) * 2048 * 128, 2048, 128, PF(WT) + WT_C1 + (size_t)which * 256 * 2048, [](int n) { return n; }, scr, rr >> 2, rr & 3, lane);
    }
    for (int i = BID * NTHR + TID; i < 2 * 128 * 256; i += gridDim.x * NTHR) {
        const int which = i >> 15, q = i & 32767;
        u32x4 z; z.x = 0u; z.y = 0u; z.z = 0u; z.w = 0u;
        *(u32x4*)(PF(WT) + WT_C1 + (size_t)which * 256 * 2048 + (size_t)128 * 2048 + (size_t)q * 8) = z;
    }
    for (int o = gw; o < 256; o += NGW) {
        const int which = o >> 7, cc = o & 127;
        const float* w1 = PF(cmp_w1) + ((size_t)layer * 2 + which) * 2048 * 128;
        const float* pos = PF(cmp_pos) + ((size_t)layer * 2 + which) * 2048;
        float a = 0.f;
        for (int k = lane; k < 2048; k += 64) a = fmaf(pos[k], w1[(size_t)k * 128 + cc], a);
        a = wave_sum(a);
        if (lane == 0) PF(cbias)[o] = a;
    }
    for (int i = BID * NTHR + TID; i < 4 * 128 * 128; i += gridDim.x * NTHR) {
        const int s = i & 127, t = (i >> 7) & 127;
        PF(WT)[WT_GM + i] = (s <= t) ? f2bf(PF(gm_w_s)[(size_t)layer * 4 * 128 * 128 + i]) : (bf16_t)0;
    }
    for (int i = BID * NTHR + TID; i < 232 * 128; i += gridDim.x * NTHR) {
        const int q = i;
        u32x4 z; z.x = 0u; z.y = 0u; z.z = 0u; z.w = 0u;
        *(u32x4*)(PF(WT) + WT_IN + (size_t)2840 * 1024 + (size_t)q * 8) = z;
    }
    if (layer == 0)
    for (int row = gw; row < NTOK; row += NGW) {
        const f32x4* xr = (const f32x4*)(PF(x) + (size_t)row * DM) + lane;
        u32x2* o = (u32x2*)(PF(XB) + (size_t)row * DM) + lane;
#pragma unroll
        for (int j = 0; j < 4; ++j) {
            const f32x4 v = xr[64 * j];
            u32x2 ww; ww.x = pk2(v[0], v[1]); ww.y = pk2(v[2], v[3]);
            o[64 * j] = ww;
        }
    }
}

template <class AF, class BF, class EF>
__device__ __forceinline__ void gemm128(int tid, int m0, int n0, int M, int N, int K, AF af, BF bf, EF ef, float* smem) {
    float* As = smem;
    float* Bs = smem + 16 * 132;
    const bool active = tid < 256;
    const int tx = tid & 15, ty = (tid >> 4) & 15;
    float acc[8][8];
#pragma unroll
    for (int i = 0; i < 8; i++)
#pragma unroll
        for (int j = 0; j < 8; j++) acc[i][j] = 0.f;
#pragma unroll 1
    for (int k0 = 0; k0 < K; k0 += 16) {
        if (active) {
#pragma unroll
            for (int i = 0; i < 8; i++) {
                int e = tid + i * 256;
                int r = e >> 4, kk = e & 15;
                float v = 0.f;
                if (m0 + r < M) v = af(m0 + r, k0 + kk);
                As[kk * 132 + r] = v;
            }
#pragma unroll
            for (int i = 0; i < 8; i++) {
                int e = tid + i * 256;
                int kk = e >> 7, c = e & 127;
                float v = 0.f;
                if (n0 + c < N) v = bf(k0 + kk, n0 + c);
                Bs[kk * 132 + c] = v;
            }
        }
        __syncthreads();
        if (active) {
#pragma unroll 2
            for (int kk = 0; kk < 16; kk++) {
                asm volatile("" ::: "memory");
                float4 a0 = *(const float4*)&As[kk * 132 + ty * 8];
                float4 a1 = *(const float4*)&As[kk * 132 + ty * 8 + 4];
                float4 b0 = *(const float4*)&Bs[kk * 132 + tx * 8];
                float4 b1 = *(const float4*)&Bs[kk * 132 + tx * 8 + 4];
                float a[8] = {a0.x, a0.y, a0.z, a0.w, a1.x, a1.y, a1.z, a1.w};
                float b[8] = {b0.x, b0.y, b0.z, b0.w, b1.x, b1.y, b1.z, b1.w};
#pragma unroll
                for (int i = 0; i < 8; i++)
#pragma unroll
                    for (int j = 0; j < 8; j++) acc[i][j] = fmaf(a[i], b[j], acc[i][j]);
            }
        }
        __syncthreads();
    }
    if (active) {
#pragma unroll
        for (int i = 0; i < 8; i++)
#pragma unroll
            for (int j = 0; j < 8; j++) {
                int m = m0 + ty * 8 + i, n = n0 + tx * 8 + j;
                if (m < M && n < N) ef(m, n, acc[i][j]);
            }
    }
}

__device__ __forceinline__ void phase_inproj(KA ka, int layer, LAS unsigned char* lds) {
    pg8::DenseOrder S; S.init(NTOK, HLD, DM, PF(WT) + WT_IN, gridDim.x, opaque_bid());
    EpiH E{PF(H)};
    pg8::gemm_phase<EpiH, pg8::DenseOrder>(lds, (const char*)PF(XB), DM, S, E);
}
__device__ __forceinline__ void phase_outproj(KA ka, int layer, const float* xin, float* x1, LAS unsigned char* lds) {
    pg8::DenseOrder S; S.init(NTOK, DM, DM, PF(WT) + WT_OUT, gridDim.x, opaque_bid());
    EpiRes E{xin, x1};
    pg8::gemm_phase<EpiRes, pg8::DenseOrder>(lds, (const char*)PF(Y), DM, S, E);
}

__device__ void phase_ln1_route(KA ka, int layer, float* x1, float* smem, bool dry) {
    PHASE_IDS
    bf16_t* xb = PF(XB);
    float* x1o = dry ? (float*)PF(H) : x1;
    const int lane = TID & 63, w = TID >> 6;
    const float* g = PF(ln1_g) + layer * 1024;
    const float* bb = PF(ln1_b) + layer * 1024;
    const float* wg = PF(rg_w) + (size_t)layer * 1024 * 4;
    const float* we = PF(re_w) + (size_t)layer * 1024 * 16;
    const float* bg = PF(rg_b) + layer * 4;
    const float* be = PF(re_b) + layer * 16;
    int* cnt = (int*)(PF(ctl) + CW_CNT) + layer * 16 * 64 + (dry ? 2048 : 0);
    int* lcnt = (int*)(smem + 20 * 1024);
    int* rinfo = lcnt + 64;
    float* rwt = (float*)(rinfo + 4 * 128);
    if (TID < 32) lcnt[TID] = 0;
    float* WR = smem;
    __syncthreads();
    for (int idx = TID; idx < 20 * 1024; idx += NTHR) { const int o = idx >> 10, c = idx & 1023; WR[idx] = o < 4 ? wg[c * 4 + o] : we[c * 16 + (o - 4)]; }
    __syncthreads();
    int nloc = 0;
    for (int row = BID * NW + w; row < NTOK; row += gridDim.x * NW) {
        f32x4 v[4];
        float s = 0.f;
#pragma unroll
        for (int j = 0; j < 4; ++j) { v[j] = *(const f32x4*)(x1 + (size_t)row * DM + 256 * j + 4 * lane); s += (v[j][0] + v[j][1]) + (v[j][2] + v[j][3]); }
        const float mu = wave_sum(s) * (1.f / 1024.f);
        float q = 0.f;
#pragma unroll
        for (int j = 0; j < 4; ++j) { v[j] = v[j] - mu; q += (v[j][0] * v[j][0] + v[j][1] * v[j][1]) + (v[j][2] * v[j][2] + v[j][3] * v[j][3]); }
        const float rstd = rsqrtf(wave_sum(q) * (1.f / 1024.f) + 1e-5f);
#pragma unroll
        for (int j = 0; j < 4; ++j) {
            const int c = 256 * j + 4 * lane;
            v[j] = v[j] * rstd * *(const f32x4*)(g + c) + *(const f32x4*)(bb + c);
            *(f32x4*)(x1o + (size_t)row * DM + c) = v[j];
            u32x2 pw; pw.x = pk2(v[j][0], v[j][1]); pw.y = pk2(v[j][2], v[j][3]);
            *(u32x2*)(xb + (size_t)row * DM + c) = pw;
        }
        float lg[4], le[16];
#pragma unroll
        for (int o = 0; o < 20; ++o) {
            asm volatile("" ::: "memory");
            float a = 0.f;
#pragma unroll
            for (int j = 0; j < 4; ++j) {
                const f32x4 w4 = *(const f32x4*)(WR + o * 1024 + 256 * j + 4 * lane);
                a += (v[j][0] * w4[0] + v[j][1] * w4[1]) + (v[j][2] * w4[2] + v[j][3] * w4[3]);
            }
            a = wave_sum(a);
            if (o < 4) lg[o] = a + bg[o]; else le[o - 4] = a + be[o - 4];
        }
        float gm = fmaxf(fmaxf(lg[0], lg[1]), fmaxf(lg[2], lg[3]));
        float ge[4], gs = 0.f;
#pragma unroll
        for (int c = 0; c < 4; c++) { ge[c] = __expf(lg[c] - gm); gs += ge[c]; }
        int gi = 0; float gbest = ge[0];
#pragma unroll
        for (int c = 1; c < 4; c++) if (ge[c] > gbest) { gbest = ge[c]; gi = c; }
        float gval = gbest / gs;
        float ls[4];
#pragma unroll
        for (int e = 0; e < 4; e++) ls[e] = gi == 0 ? le[e] : gi == 1 ? le[4 + e] : gi == 2 ? le[8 + e] : le[12 + e];
        float em = fmaxf(fmaxf(ls[0], ls[1]), fmaxf(ls[2], ls[3]));
        float pe[4];
#pragma unroll
        for (int e = 0; e < 4; e++) pe[e] = __expf(ls[e] - em);
        int i1 = 0; float b1 = pe[0];
#pragma unroll
        for (int e = 1; e < 4; e++) if (pe[e] > b1) { b1 = pe[e]; i1 = e; }
        int i2 = -1; float b2 = -1.f;
#pragma unroll
        for (int e = 0; e < 4; e++) if (e != i1 && pe[e] > b2) { b2 = pe[e]; i2 = e; }
        float w1 = gval * b1 / (b1 + b2), w2 = gval * b2 / (b1 + b2);
        if (lane == 0) {
            const int e1 = gi * 4 + i1, e2 = gi * 4 + i2;
            const int lr = nloc * NW + w;
            rinfo[lr * 4 + 0] = e1; rinfo[lr * 4 + 1] = atomicAdd(&lcnt[e1], 1);
            rinfo[lr * 4 + 2] = e2; rinfo[lr * 4 + 3] = atomicAdd(&lcnt[e2], 1);
            rwt[lr * 2 + 0] = w1; rwt[lr * 2 + 1] = w2;
        }
        ++nloc;
    }
    __syncthreads();
    if (TID < 16) lcnt[16 + TID] = lcnt[TID] > 0 ? atomicAdd(&cnt[TID * 64], lcnt[TID]) : 0;
    __syncthreads();
    {
        const int nrows_blk = (NTOK - BID * NW + (int)gridDim.x * NW - 1) / ((int)gridDim.x * NW) * NW;
        for (int lr = TID; lr < nrows_blk; lr += NTHR) {
            const int row = BID * NW + (lr % NW) + (lr / NW) * (int)gridDim.x * NW;
            if (row < NTOK) {
                const int e1 = rinfo[lr * 4 + 0], p1 = lcnt[16 + e1] + rinfo[lr * 4 + 1];
                const int e2 = rinfo[lr * 4 + 2], p2 = lcnt[16 + e2] + rinfo[lr * 4 + 3];
                PF(list_tok)[e1 * NTOK + p1] = row; PF(list_w)[e1 * NTOK + p1] = rwt[lr * 2 + 0];
                PF(list_tok)[e2 * NTOK + p2] = row; PF(list_w)[e2 * NTOK + p2] = rwt[lr * 2 + 1];
                PF(tok_slot)[row * 2 + 0] = e1 * NTOK + p1; PF(tok_slot)[row * 2 + 1] = e2 * NTOK + p2;
            }
        }
    }
    __syncthreads();
}


template <bool GATHER_>
struct MoeOrder {
    static constexpr bool GATHER = GATHER_;
    const LAS int* tab; const LAS int* rowtab;
    const char* Bt; unsigned estride; int K, G, c;
    __device__ __forceinline__ bool next(int i, pg8::Unit& u) const {
        const int nwg = __builtin_amdgcn_readfirstlane(tab[48]) * 4;
        const int L = i * G + c; if (L >= nwg) return false;
        int wgid = L; { const int q = nwg / 8, r = nwg % 8, xcd = wgid % 8, off = wgid / 8; wgid = (xcd < r ? xcd * (q + 1) : r * (q + 1) + (xcd - r) * q) + off; }
        const int mg = wgid >> 2, nt = wgid & 3;
        int e = 0;
#pragma unroll
        for (int k = 1; k < 16; ++k) e = (__builtin_amdgcn_readfirstlane(tab[32 + k]) <= mg) ? k : e;
        const int mt = mg - __builtin_amdgcn_readfirstlane(tab[32 + e]);
        const int rem = __builtin_amdgcn_readfirstlane(tab[e]) - mt * 256;
        u.e = e; u.pm = mt; u.pn = nt; u.ui = i; u.nrows = rem < 256 ? rem : 256; u.arow0 = __builtin_amdgcn_readfirstlane(tab[16 + e]) + mt * 256;
        u.bptr = Bt + (size_t)e * estride + (size_t)nt * 256 * K * 2;
        return true;
    }
    __device__ __forceinline__ int arow(const pg8::Unit& u, int r) const { return GATHER_ ? rowtab[u.ui * 256 + r] : u.arow0 + r; }
    __device__ __forceinline__ int lda(int K_) const { return K_; }
    __device__ __forceinline__ unsigned kstepA() const { return 128u; }
    __device__ __forceinline__ const char* abase(const pg8::Unit&, const char* A) const { return A; }
};
__device__ __forceinline__ void moe_tables(KA ka, int layer, LAS unsigned char* lds, bool want_rows, int G, int c) {
    LAS int* tab = (LAS int*)(lds + LDS_MISC + 256);
    LAS int* rowtab = (LAS int*)(lds + LDS_MISC + 1024);
    const int tid = opaque_tid();
    const int* cnt = (const int*)(PF(ctl) + CW_CNT) + layer * 16 * 64;
    if (tid < 16) tab[tid] = __hip_atomic_load(&cnt[tid * 64], __ATOMIC_RELAXED, __HIP_MEMORY_SCOPE_AGENT);
    __syncthreads();
    if (tid == 0) {
        int b = 0, m = 0;
        for (int e = 0; e < 16; ++e) { tab[16 + e] = b; tab[32 + e] = m; b += tab[e]; m += (tab[e] + 255) >> 8; }
        tab[48] = m;
    }
    __syncthreads();
    if (want_rows) {
        MoeOrder<true> S{tab, rowtab, nullptr, 0u, 1024, G, c};
        const int* lt = PF(list_tok);
        for (int i = 0; i < 4; ++i) {
            pg8::Unit u;
            if (!S.next(i, u)) break;
            if (tid < 256) { const int r = tid < u.nrows ? tid : u.nrows - 1; rowtab[i * 256 + tid] = lt[u.e * NTOK + u.pm * 256 + r]; }
        }
        asm volatile("s_waitcnt vmcnt(0) lgkmcnt(0)" ::: "memory");
        __syncthreads();
    }
}
struct EpiUp {
    static constexpr bool PERM = true;
    bf16_t* hidden;
    __device__ __forceinline__ void operator()(const f32x4 (&acc)[2][2][4][2], const pg8::Unit& u, int wr, int wc, int fr, int fq) const {
#pragma unroll
        for (int ai = 0; ai < 2; ++ai)
#pragma unroll
            for (int m = 0; m < 4; ++m) {
                const int r = ai * 128 + wr * 64 + m * 16 + fr;
                if (r < u.nrows) {
                    bf16_t* rowp = hidden + (size_t)(u.arow0 + r) * 512 + u.pn * 128 + wc * 32 + 8 * fq;
                    float h[8];
#pragma unroll
                    for (int n = 0; n < 2; ++n)
#pragma unroll
                        for (int j = 0; j < 4; ++j) { const float g = acc[ai][0][m][n][j], uu = acc[ai][1][m][n][j]; h[n * 4 + j] = g * sigmoidf_(g) * uu; }
                    u32x4 w; w.x = pg8::cvt_pk_bf16(h[0], h[1]); w.y = pg8::cvt_pk_bf16(h[2], h[3]); w.z = pg8::cvt_pk_bf16(h[4], h[5]); w.w = pg8::cvt_pk_bf16(h[6], h[7]);
                    *(u32x4*)rowp = w;
                }
            }
    }
};
struct EpiDown {
    static constexpr bool PERM = true;
    bf16_t* Y2; const float* lw;
    __device__ __forceinline__ void operator()(const f32x4 (&acc)[2][2][4][2], const pg8::Unit& u, int wr, int wc, int fr, int fq) const {
#pragma unroll
        for (int ai = 0; ai < 2; ++ai)
#pragma unroll
            for (int m = 0; m < 4; ++m) {
                const int r = ai * 128 + wr * 64 + m * 16 + fr;
                if (r < u.nrows) {
                    const float wgt = lw[u.e * NTOK + u.pm * 256 + r];
                    bf16_t* rowp = Y2 + (size_t)(u.arow0 + r) * DM + u.pn * 256 + wc * 32 + 8 * fq;
#pragma unroll
                    for (int bj = 0; bj < 2; ++bj) {
                        const f32x4 v0 = acc[ai][bj][m][0] * wgt, v1 = acc[ai][bj][m][1] * wgt;
                        u32x4 w; w.x = pg8::cvt_pk_bf16(v0[0], v0[1]); w.y = pg8::cvt_pk_bf16(v0[2], v0[3]); w.z = pg8::cvt_pk_bf16(v1[0], v1[1]); w.w = pg8::cvt_pk_bf16(v1[2], v1[3]);
                        *(u32x4*)(rowp + bj * 128) = w;
                    }
                }
            }
    }
};
__device__ __forceinline__ void phase_moe_up(KA ka, int layer, LAS unsigned char* lds) {
    moe_tables(ka, layer, lds, true, gridDim.x, opaque_bid());
    MoeOrder<true> S{(const LAS int*)(lds + LDS_MISC + 256), (const LAS int*)(lds + LDS_MISC + 1024),
                     (const char*)(PF(WT) + WT_UP), (unsigned)(1024u * 1024u * 2u), 1024, (int)gridDim.x, opaque_bid()};
    EpiUp E{PF(Y)};
    pg8::gemm_phase<EpiUp, MoeOrder<true>>(lds, (const char*)PF(XB), 1024, S, E);
}
__device__ __forceinline__ void phase_moe_down(KA ka, int layer, LAS unsigned char* lds) {
    moe_tables(ka, layer, lds, false, gridDim.x, opaque_bid());
    MoeOrder<false> S{(const LAS int*)(lds + LDS_MISC + 256), (const LAS int*)(lds + LDS_MISC + 1024),
                      (const char*)(PF(WT) + WT_DN), (unsigned)(1024u * 512u * 2u), 512, (int)gridDim.x, opaque_bid()};
    EpiDown E{PF(H), PF(list_w)};
    pg8::gemm_phase<EpiDown, MoeOrder<false>>(lds, (const char*)PF(Y), 512, S, E);
}

__device__ void phase_ln2(KA ka, int layer, const float* x1, float* xo) {
    PHASE_IDS
    bf16_t* xb = PF(XB);
    const bf16_t* Y2 = PF(H);
    const int lane = TID & 63, w = TID >> 6;
    const float* g = PF(ln2_g) + layer * 1024;
    const float* bb = PF(ln2_b) + layer * 1024;
    const int* cnt = (const int*)(PF(ctl) + CW_CNT) + layer * 16 * 64;
    int mybase = 0;
    {
        int cv = lane < 16 ? __hip_atomic_load(&cnt[(lane & 15) * 64], __ATOMIC_RELAXED, __HIP_MEMORY_SCOPE_AGENT) : 0;
        int incl = cv;
#pragma unroll
        for (int o = 1; o < 16; o <<= 1) { int t = __shfl_up(incl, o); if ((lane & 15) >= o) incl += t; }
        mybase = incl - cv;
    }
    for (int row = BID * NW + w; row < NTOK; row += gridDim.x * NW) {
        const int ts1 = PF(tok_slot)[row * 2 + 0], ts2 = PF(tok_slot)[row * 2 + 1];
        const int s1 = __shfl(mybase, ts1 >> 14) + (ts1 & (NTOK - 1)), s2 = __shfl(mybase, ts2 >> 14) + (ts2 & (NTOK - 1));
        f32x4 v[4];
        float s = 0.f;
#pragma unroll
        for (int j = 0; j < 4; ++j) {
            const int c = 256 * j + 4 * lane;
            const f32x4 xv = *(const f32x4*)(x1 + (size_t)row * DM + c);
            const u32x2 ya = *(const u32x2*)(Y2 + (size_t)s1 * DM + c), yb = *(const u32x2*)(Y2 + (size_t)s2 * DM + c);
            f32x4 t;
            t[0] = __uint_as_float(ya.x << 16) + __uint_as_float(yb.x << 16); t[1] = __uint_as_float(ya.x & 0xffff0000u) + __uint_as_float(yb.x & 0xffff0000u);
            t[2] = __uint_as_float(ya.y << 16) + __uint_as_float(yb.y << 16); t[3] = __uint_as_float(ya.y & 0xffff0000u) + __uint_as_float(yb.y & 0xffff0000u);
            v[j] = xv * ALPHA + t;
            s += (v[j][0] + v[j][1]) + (v[j][2] + v[j][3]);
        }
        const float mu = wave_sum(s) * (1.f / 1024.f);
        float q = 0.f;
#pragma unroll
        for (int j = 0; j < 4; ++j) { v[j] = v[j] - mu; q += (v[j][0] * v[j][0] + v[j][1] * v[j][1]) + (v[j][2] * v[j][2] + v[j][3] * v[j][3]); }
        const float rstd = rsqrtf(wave_sum(q) * (1.f / 1024.f) + 1e-5f);
#pragma unroll
        for (int j = 0; j < 4; ++j) {
            const int c = 256 * j + 4 * lane;
            const f32x4 o = v[j] * rstd * *(const f32x4*)(g + c) + *(const f32x4*)(bb + c);
            *(f32x4*)(xo + (size_t)row * DM + c) = o;
            u32x2 pw; pw.x = pk2(o[0], o[1]); pw.y = pk2(o[2], o[3]);
            *(u32x2*)(xb + (size_t)row * DM + c) = pw;
        }
    }
}

#define MFMA16(a, b, c) __builtin_amdgcn_mfma_f32_16x16x32_bf16((a), (b), (c), 0, 0, 0)
constexpr int NSA_KT = 0, NSA_VT = 16384, NSA_IMP = 32768, NSA_FIN = 65536, NSA_SEL = LDS_MISC + 8192;

__device__ __forceinline__ int tile_off(int r, int c) { return r * 128 + ((c ^ ((r >> 1) & 7)) << 4); }

struct SelMask { unsigned a, b, c, d; };
__device__ __forceinline__ unsigned selbit(unsigned a, unsigned b, unsigned c, unsigned d, int j) {
    const int k = j >> 5;
    const unsigned lo = (k & 1) ? b : a, hi = (k & 1) ? d : c;
    const unsigned r = (k & 2) ? hi : lo;
    return (r >> (j & 31)) & 1u;
}

struct NsaRT {
    bf16x8 q[2];
    f32x4 o[4];
    float m, l;
    int tk;
};

template <int MODE, int NST>
__device__ __forceinline__ void nsa_loop(LAS unsigned char* lds, int tid, int lane, int w, int jb, int je,
                                         const char* ksrc, size_t kstride, size_t ktile, const char* vsrc, size_t vstride, size_t vtile,
                                         NsaRT (&R)[2], const SelMask selm0, const SelMask selm1, float (&carry)[2], float* impw) {
    const int g = lane >> 4, qr = lane & 15;
    int tid2 = tid; asm volatile("" : "+v"(tid2));
    const int sr = tid2 >> 3, sc = (tid2 & 7) ^ ((sr >> 1) & 7);
    const char* kp = ksrc + (size_t)sr * kstride + sc * 16;
    const char* vp = vsrc + (size_t)sr * vstride + sc * 16;
    const unsigned ldsw = (unsigned)w * 1024u;
    const int fxq = (qr >> 1) & 7;
    const int ka0 = qr * 128 + ((g ^ fxq) << 4), ka1 = qr * 128 + (((4 + g) ^ fxq) << 4);
    const int vb = qr * 128 + (g & 1) * 8, vc = (g >> 1) ^ fxq;
    const int va0 = vb + (vc << 4), va1 = vb + ((vc ^ 2) << 4), va2 = vb + ((vc ^ 4) << 4), va3 = vb + ((vc ^ 6) << 4);
    if (jb > je) return;
    constexpr int D = NST - 1;
#define NSA_ISSUE(jj, st) do { const int jc_ = (jj) < je ? (jj) : je; \
        __builtin_amdgcn_global_load_lds((const unsigned*)(kp + (size_t)jc_ * ktile), (LAS unsigned*)(lds + (st) * 16384 + ldsw), 16, 0, 0); \
        if (MODE != 0) __builtin_amdgcn_global_load_lds((const unsigned*)(vp + (size_t)jc_ * vtile), (LAS unsigned*)(lds + (st) * 16384 + 8192 + ldsw), 16, 0, 0); } while (0)
#define NSA_WAIT_TILE() do { if (NST == 2) asm volatile("s_waitcnt vmcnt(0) lgkmcnt(0)" ::: "memory"); else asm volatile("s_waitcnt vmcnt(4) lgkmcnt(0)" ::: "memory"); } while (0)
#pragma unroll
    for (int d = 0; d < D; ++d) NSA_ISSUE(jb + d, d);
    NSA_WAIT_TILE();
    __builtin_amdgcn_s_barrier();
    for (int j = jb; j <= je; ++j) {
        const int cur = (j - jb) & (NST - 1);
        NSA_ISSUE(j + D, (j - jb + D) & (NST - 1));
        const LAS unsigned char* kt = lds + cur * 16384;
        const LAS unsigned char* vt = lds + cur * 16384 + 8192;
        bool anyact;
        {
            bool a = false;
#pragma unroll
            for (int rt = 0; rt < 2; ++rt) {
                const int tk = R[rt].tk;
                if (MODE <= 1) { const int nv = tk >= 31 ? ((tk - 31) >> 4) + 1 : 0; a = a || (nv > 64 * j); }
                else if (MODE == 2) a = a || ((rt == 0 ? selbit(selm0.a, selm0.b, selm0.c, selm0.d, j) : selbit(selm1.a, selm1.b, selm1.c, selm1.d, j)) != 0u);
                else a = a || ((64 * j <= tk) && (64 * j + 63 > tk - 512));
            }
            anyact = __any(a);
        }
        if (anyact) {
            f32x4 s[2][4];
#pragma unroll
            for (int t = 0; t < 4; ++t) {
                const bf16x8 k0 = *(const LAS bf16x8*)(kt + ka0 + t * 2048), k1 = *(const LAS bf16x8*)(kt + ka1 + t * 2048);
#pragma unroll
                for (int rt = 0; rt < 2; ++rt) {
                    s[rt][t] = (f32x4){0.f, 0.f, 0.f, 0.f};
                    s[rt][t] = MFMA16(k0, R[rt].q[0], s[rt][t]);
                    s[rt][t] = MFMA16(k1, R[rt].q[1], s[rt][t]);
                }
            }
            const int kb = 64 * j + 4 * g;
            bf16x8 pf[2][2];
            if (MODE == 1) {
#pragma unroll
                for (int rt = 0; rt < 2; ++rt) {
                    const int tk = R[rt].tk;
                    const int nv = tk >= 31 ? ((tk - 31) >> 4) + 1 : 0;
                    const float mL = R[rt].m * 1.44269504f, invl = R[rt].l > 0.f ? 1.f / R[rt].l : 0.f;
                    float p[4][4];
#pragma unroll
                    for (int t = 0; t < 4; ++t)
#pragma unroll
                        for (int i = 0; i < 4; ++i) { const int key = kb + 16 * t + i; p[t][i] = (key < nv) ? __builtin_amdgcn_exp2f(fmaf(s[rt][t][i], 1.44269504f, -mL)) * invl : 0.f; }
#pragma unroll
                    for (int t = 0; t < 4; ++t) {
                        const float own = (p[t][0] + p[t][1]) + (p[t][2] + p[t][3]);
                        const float x3 = p[t][3];
                        const float up_cur = __shfl(x3, (lane + 48) & 63);
                        const float up_prev = __shfl(carry[rt], (lane + 48) & 63);
                        float v = own + (g >= 1 ? up_cur : up_prev);
                        v += __shfl_xor(v, 1);
                        v += __shfl_xor(v, 2);
                        carry[rt] = x3;
                        if ((qr & 3) == 0) impw[(4 * rt + (qr >> 2)) * 128 + 16 * j + 4 * t + g] = v;
                    }
#pragma unroll
                    for (int ks = 0; ks < 2; ++ks) {
                        u32x4 pu; pu.x = pk2(p[2 * ks][0], p[2 * ks][1]); pu.y = pk2(p[2 * ks][2], p[2 * ks][3]); pu.z = pk2(p[2 * ks + 1][0], p[2 * ks + 1][1]); pu.w = pk2(p[2 * ks + 1][2], p[2 * ks + 1][3]);
                        pf[rt][ks] = __builtin_bit_cast(bf16x8, pu);
                    }
                }
            } else {
                float lmx[2];
#pragma unroll
                for (int rt = 0; rt < 2; ++rt) {
                    const int tk = R[rt].tk;
                    int lim_hi, lim_lo;
                    if (MODE == 0) { const int nv = tk >= 31 ? ((tk - 31) >> 4) + 1 : 0; lim_hi = nv - 1; lim_lo = -1; }
                    else if (MODE == 2) { lim_hi = ((rt == 0 ? selbit(selm0.a, selm0.b, selm0.c, selm0.d, j) : selbit(selm1.a, selm1.b, selm1.c, selm1.d, j)) != 0u) ? tk : -1; lim_lo = -1; }
                    else { lim_hi = tk; lim_lo = tk - 512; }
                    float mx = NEG_INF;
#pragma unroll
                    for (int t = 0; t < 4; ++t)
#pragma unroll
                        for (int i = 0; i < 4; ++i) {
                            const int key = kb + 16 * t + i;
                            const bool ok = (key <= lim_hi) && (key > lim_lo);
                            s[rt][t][i] = ok ? s[rt][t][i] : NEG_INF;
                            mx = fmaxf(mx, s[rt][t][i]);
                        }
                    lmx[rt] = mx;
                }
                if (__any((lmx[0] > R[0].m + 6.f) || (lmx[1] > R[1].m + 6.f))) {
#pragma unroll
                    for (int rt = 0; rt < 2; ++rt) {
                        float mx = lmx[rt];
                        mx = fmaxf(mx, __shfl_xor(mx, 16));
                        mx = fmaxf(mx, __shfl_xor(mx, 32));
                        const float mn = fmaxf(R[rt].m, mx);
                        const float alpha = __expf(R[rt].m - mn);
                        R[rt].l *= alpha; R[rt].m = mn;
                        if (MODE != 0) {
#pragma unroll
                            for (int dt = 0; dt < 4; ++dt) R[rt].o[dt] = R[rt].o[dt] * alpha;
                        }
                    }
                }
#pragma unroll
                for (int rt = 0; rt < 2; ++rt) {
                    const float mL = R[rt].m * 1.44269504f;
                    float p[4][4];
                    float rs = 0.f;
#pragma unroll
                    for (int t = 0; t < 4; ++t)
#pragma unroll
                        for (int i = 0; i < 4; ++i) { p[t][i] = (s[rt][t][i] > 0.5f * NEG_INF) ? __builtin_amdgcn_exp2f(fmaf(s[rt][t][i], 1.44269504f, -mL)) : 0.f; rs += p[t][i]; }
                    R[rt].l += rs;
                    if (MODE != 0) {
#pragma unroll
                        for (int ks = 0; ks < 2; ++ks) {
                            u32x4 pu; pu.x = pk2(p[2 * ks][0], p[2 * ks][1]); pu.y = pk2(p[2 * ks][2], p[2 * ks][3]); pu.z = pk2(p[2 * ks + 1][0], p[2 * ks + 1][1]); pu.w = pk2(p[2 * ks + 1][2], p[2 * ks + 1][3]);
                            pf[rt][ks] = __builtin_bit_cast(bf16x8, pu);
                        }
                    }
                }
            }
            if (MODE != 0) {
#pragma unroll
                for (int ks = 0; ks < 2; ++ks)
#pragma unroll
                    for (int dt = 0; dt < 4; ++dt) {
                        const u32x2 lo = *(const LAS u32x2*)(vt + (ks ? va2 : va0) + dt * 2048);
                        const u32x2 hi = *(const LAS u32x2*)(vt + (ks ? va3 : va1) + dt * 2048);
                        u32x4 vu; vu.x = lo.x; vu.y = lo.y; vu.z = hi.x; vu.w = hi.y;
                        const bf16x8 vf = __builtin_bit_cast(bf16x8, vu);
                        R[0].o[dt] = MFMA16(vf, pf[0][ks], R[0].o[dt]);
                        R[1].o[dt] = MFMA16(vf, pf[1][ks], R[1].o[dt]);
                    }
            }
        }
        NSA_WAIT_TILE();
        __builtin_amdgcn_s_barrier();
    }
    asm volatile("s_waitcnt vmcnt(0)" ::: "memory");
    __builtin_amdgcn_s_barrier();
#undef NSA_ISSUE
#undef NSA_WAIT_TILE
}

__device__ void phase_nsa2(KA ka, int layer, LAS unsigned char* lds) {
    PHASE_IDS
    const int tid = TID, lane = tid & 63, w = __builtin_amdgcn_readfirstlane(tid >> 6), g = lane >> 4, qr = lane & 15;
    const bf16_t* H = PF(H);
    const bf16_t* kcb = PF(kcb);
    const bf16_t* vcT = PF(vcT);
    const bf16_t* vsT = PF(vsT);
    const bf16_t* vwT = PF(vwT);
    bf16_t* Y = PF(Y);
    const float* gate_b = PF(nsa_gate_b) + layer * 24;
    const float* ogain = PF(out_gain) + layer * 1024;
    float* impw = (float*)(lds + NSA_IMP + w * 4096);
    unsigned* selw = (unsigned*)(lds + NSA_SEL + w * 128);
    for (int base = BID; base < 256; base += gridDim.x) {
#pragma unroll 1
        for (int half = 0; half < 2; ++half) {
            const int it = half ? 511 - base : base;
            const int chunk = it >> 2, bh = it & 3, b = bh >> 1, hk = bh & 1;
            const size_t rowbase = (size_t)b * T_;
            const int t0w = chunk * 64 + w * 8;
            NsaRT R[2];
            LAS f32x4* finw = (LAS f32x4*)(lds + NSA_FIN + w * 8192) + lane;
#pragma unroll
            for (int rt = 0; rt < 2; ++rt) {
                const int tk = t0w + 4 * rt + (qr >> 2), hh = hk * 4 + (qr & 3);
                R[rt].tk = tk;
                const bf16_t* qp = H + (rowbase + tk) * HLD + C_NQ + hh * 64 + 8 * g;
#pragma unroll
                for (int ks = 0; ks < 2; ++ks) {
                    const u32x4 u = *(const u32x4*)(qp + 32 * ks);
                    const unsigned uu[4] = {u.x, u.y, u.z, u.w};
                    u32x4 o4;
#pragma unroll
                    for (int e = 0; e < 4; ++e) {
                        const float f0 = __uint_as_float(uu[e] << 16) * 0.125f, f1 = __uint_as_float(uu[e] & 0xffff0000u) * 0.125f;
                        o4[e] = (__float_as_uint(f0) >> 16) | (__float_as_uint(f1) & 0xffff0000u);
                    }
                    R[rt].q[ks] = __builtin_bit_cast(bf16x8, o4);
                }
                R[rt].m = NEG_INF; R[rt].l = 0.f;
#pragma unroll
                for (int dt = 0; dt < 4; ++dt) R[rt].o[dt] = (f32x4){0.f, 0.f, 0.f, 0.f};
            }
            SelMask selm0{0u, 0u, 0u, 0u}, selm1{0u, 0u, 0u, 0u};
            float carry[2] = {0.f, 0.f};
            const int tmax = chunk * 64 + 63;
            const int nvmax = tmax >= 31 ? ((tmax - 31) >> 4) + 1 : 0;
            const int nb = (nvmax + 63) >> 6;
            const char* kc_src = (const char*)(kcb + (size_t)bh * 512 * 64);
            const char* vc_src = (const char*)(vcT + (size_t)bh * 64 * 512);
            nsa_loop<0, 2>(lds, tid, lane, w, 0, nb - 1, kc_src, 128, 64 * 128, nullptr, 0, 0, R, selm0, selm1, carry, impw);
#pragma unroll
            for (int rt = 0; rt < 2; ++rt) { float l = R[rt].l; l += __shfl_xor(l, 16); l += __shfl_xor(l, 32); R[rt].l = l; }
            for (int i = lane; i < 8 * 128; i += 64) impw[i] = 0.f;
            wave_sync();
            nsa_loop<1, 2>(lds, tid, lane, w, 0, nb - 1, kc_src, 128, 64 * 128, vc_src, 512 * 2, 64 * 2, R, selm0, selm1, carry, impw);
#pragma unroll
            for (int rt = 0; rt < 2; ++rt) {
                const int hh = hk * 4 + (qr & 3);
                const float gt = sigmoidf_(bf2f(H[(rowbase + R[rt].tk) * HLD + C_NG + hh * 3 + 0]) + gate_b[hh * 3 + 0]);
#pragma unroll
                for (int dt = 0; dt < 4; ++dt) { finw[(rt * 4 + dt) * 64] = R[rt].o[dt] * gt; R[rt].o[dt] = (f32x4){0.f, 0.f, 0.f, 0.f}; }
            }
            wave_sync();
            {
                const int tl = lane >> 3, sub = lane & 7;
                const int tks = t0w + tl, curb = tks >> 6;
                float v[16];
#pragma unroll
                for (int i = 0; i < 16; ++i) {
                    const int jj = sub * 16 + i;
                    const float a = impw[tl * 128 + jj];
                    const bool forced = (jj == 0) || (jj == curb) || (jj == curb - 1);
                    v[i] = (jj <= curb) ? (a + (forced ? 1e4f : 0.f)) : NEG_INF;
                }
                wave_sync();
#pragma unroll
                for (int i = 0; i < 16; ++i) impw[tl * 128 + sub * 16 + i] = v[i];
                wave_sync();
                int cnt[16];
#pragma unroll
                for (int i = 0; i < 16; ++i) cnt[i] = 0;
                for (int jj = 0; jj < 128; ++jj) {
                    const float x = impw[tl * 128 + jj];
#pragma unroll
                    for (int i = 0; i < 16; ++i) cnt[i] += (x > v[i]) || (x == v[i] && jj < sub * 16 + i);
                }
                unsigned bits = 0u;
#pragma unroll
                for (int i = 0; i < 16; ++i) bits |= ((cnt[i] < 16) && (v[i] > 0.5f * NEG_INF)) ? (1u << i) : 0u;
                const unsigned other = __shfl_xor(bits, 1);
                const unsigned word = (sub & 1) ? ((bits << 16) | other) : (bits | (other << 16));
                if ((sub & 1) == 0) selw[tl * 4 + (sub >> 1)] = word;
                wave_sync();
                { const unsigned* q0 = selw + (qr >> 2) * 4; selm0.a = q0[0]; selm0.b = q0[1]; selm0.c = q0[2]; selm0.d = q0[3];
                  selm1.a = q0[16]; selm1.b = q0[17]; selm1.c = q0[18]; selm1.d = q0[19]; }
                wave_sync();
            }
#pragma unroll
            for (int rt = 0; rt < 2; ++rt) { R[rt].m = NEG_INF; R[rt].l = 0.f; }
            nsa_loop<2, 4>(lds, tid, lane, w, 0, chunk, (const char*)(H + rowbase * HLD + C_KS + hk * 64), (size_t)HLD * 2, (size_t)64 * HLD * 2,
                        (const char*)(vsT + (size_t)bh * 64 * T_), (size_t)T_ * 2, 64 * 2, R, selm0, selm1, carry, impw);
#pragma unroll
            for (int rt = 0; rt < 2; ++rt) {
                const int hh = hk * 4 + (qr & 3);
                const float gt = sigmoidf_(bf2f(H[(rowbase + R[rt].tk) * HLD + C_NG + hh * 3 + 1]) + gate_b[hh * 3 + 1]);
                float ltot = R[rt].l; ltot += __shfl_xor(ltot, 16); ltot += __shfl_xor(ltot, 32);
                const float sc = gt / ltot;
#pragma unroll
                for (int dt = 0; dt < 4; ++dt) { finw[(rt * 4 + dt) * 64] += R[rt].o[dt] * sc; R[rt].o[dt] = (f32x4){0.f, 0.f, 0.f, 0.f}; }
                R[rt].m = NEG_INF; R[rt].l = 0.f;
            }
            nsa_loop<3, 4>(lds, tid, lane, w, chunk >= 8 ? chunk - 8 : 0, chunk, (const char*)(H + rowbase * HLD + C_KW + hk * 64), (size_t)HLD * 2, (size_t)64 * HLD * 2,
                        (const char*)(vwT + (size_t)bh * 64 * T_), (size_t)T_ * 2, 64 * 2, R, selm0, selm1, carry, impw);
#pragma unroll
            for (int rt = 0; rt < 2; ++rt) {
                const int tk = R[rt].tk, hh = hk * 4 + (qr & 3);
                const float gt = sigmoidf_(bf2f(H[(rowbase + tk) * HLD + C_NG + hh * 3 + 2]) + gate_b[hh * 3 + 2]);
                float ltot = R[rt].l; ltot += __shfl_xor(ltot, 16); ltot += __shfl_xor(ltot, 32);
                const float sc = gt / ltot;
                bf16_t* yp = Y + (rowbase + tk) * DM + 256 + hh * 64 + 4 * g;
                f32x4 ov[4];
                float ss = 0.f;
#pragma unroll
                for (int dt = 0; dt < 4; ++dt) { ov[dt] = finw[(rt * 4 + dt) * 64] + R[rt].o[dt] * sc; ss += (ov[dt][0] * ov[dt][0] + ov[dt][1] * ov[dt][1]) + (ov[dt][2] * ov[dt][2] + ov[dt][3] * ov[dt][3]); }
                ss += __shfl_xor(ss, 16);
                ss += __shfl_xor(ss, 32);
                const float rn = rsqrtf(ss * (1.f / 64.f) + 1e-6f);
#pragma unroll
                for (int dt = 0; dt < 4; ++dt) {
                    const f32x4 o = ov[dt] * rn * *(const f32x4*)(ogain + 256 + hh * 64 + 16 * dt + 4 * g);
                    u32x2 wv; wv.x = pk2(o[0], o[1]); wv.y = pk2(o[2], o[3]);
                    *(u32x2*)(yp + 16 * dt) = wv;
                }
            }
        }
    }
}

__device__ void phase_vtrans(KA ka, float* smem) {
    PHASE_IDS
    const int lane = TID & 63, w = TID >> 6;
    bf16_t* scr = (bf16_t*)(smem + w * 4096);
    const bf16_t* H = PF(H);
    for (int it = BID * NW + w; it < 1024; it += gridDim.x * NW) {
        const int tt = it & 127, bh = (it >> 7) & 3, which = it >> 9;
        const int b = bh >> 1, hk = bh & 1;
        const size_t tok0 = (size_t)b * T_ + tt * 64;
        const int col = (which ? C_VW : C_VS) + hk * 64;
        bf16_t* dst = (which ? PF(vwT) : PF(vsT)) + (size_t)bh * 64 * T_ + tt * 64;
        wave_sync();
        for (int i = 0; i < 64; ++i) scr[lane * 66 + i] = H[(tok0 + i) * HLD + col + lane];
        wave_sync();
        for (int d = 0; d < 64; ++d) dst[(size_t)d * T_ + lane] = scr[d * 66 + lane];
    }
}

__device__ void phase_hgrnA(KA ka, int layer, LAS unsigned char* lds, int first, int nblk) {
    PHASE_IDS
    const int tid = TID, lane = tid & 63, w = __builtin_amdgcn_readfirstlane(tid >> 6), gq = lane >> 4, lc = lane & 15;
    float* Q = (float*)lds;
    float* K = Q + 64 * 68;
    float* Bc = K + 64 * 68;
    float* SEG = Bc + 64 * 68;
    LAS bf16_t* ATb = (LAS bf16_t*)(lds + 57344);
    LAS bf16_t* ItB = ATb + 64 * 72;
    LAS bf16_t* KtB = ItB + 64 * 72;
    const bf16_t* H = PF(H);
    const float* hgl = PF(hg_lower);
    float* hgU = PF(hgU); float* hgG = PF(hgG); bf16_t* hgQB = PF(hgQB); bf16_t* hgO = PF(hgO);
    if (BID < first) return;
    for (int item = BID - first; item < 1024; item += nblk) {
        const int c = item & 127, bh = item >> 7, h = bh & 3, b = bh >> 2;
        const size_t tok0 = (size_t)b * T_ + c * 64;
        __syncthreads();
#pragma unroll
        for (int i = 0; i < 8; ++i) {
            const int e = tid + i * NTHR, t = e >> 6, d = e & 63;
            float lb = 0.f;
            if (layer == 1) {
                const float h0 = hgl[h * 64 + d], h1 = hgl[256 + h * 64 + d];
                const float mx = fmaxf(h0, h1), e0 = expf(h0 - mx), e1 = expf(h1 - mx);
                lb = e1 / (e0 + e1);
            }
            const bf16_t* hp = H + (tok0 + t) * HLD + h * 64 + d;
            const float fl = bf2f(hp[C_HF]);
            const float sg = 1.f / (1.f + expf(-fl)), sgn = 1.f / (1.f + expf(fl));
            const float f = lb + (1.f - lb) * sg;
            Q[t * 68 + d] = bf2f(hp[C_HQ]);
            K[t * 68 + d] = (1.f - lb) * sgn;
            ItB[d * 72 + t] = hp[C_HI];
            Bc[t * 68 + d] = logf(fmaxf(f, 1e-38f));
        }
        __syncthreads();
        {
            const int d = lane, seg = w;
            float run = 0.f;
#pragma unroll
            for (int i = 0; i < 8; ++i) { run += Bc[(seg * 8 + i) * 68 + d]; Bc[(seg * 8 + i) * 68 + d] = run; }
            SEG[seg * 64 + d] = run;
            __syncthreads();
            float pre = 0.f;
            for (int s2 = 0; s2 < seg; ++s2) pre += SEG[s2 * 64 + d];
#pragma unroll
            for (int i = 0; i < 8; ++i) Bc[(seg * 8 + i) * 68 + d] += pre;
        }
        __syncthreads();
        {
            const int blk = tid >> 1, dh = tid & 1, tb = blk >> 4, sb = blk & 15;
            float acc[4][4];
#pragma unroll
            for (int i = 0; i < 4; ++i)
#pragma unroll
                for (int j = 0; j < 4; ++j) acc[i][j] = 0.f;
            if (sb <= tb) {
#pragma unroll 2
                for (int d0 = 32 * dh; d0 < 32 * dh + 32; d0 += 4) {
                    f32x4 qv[4], bt[4], kv[4], bsv[4];
#pragma unroll
                    for (int i = 0; i < 4; ++i) { qv[i] = *(const f32x4*)&Q[(4 * tb + i) * 68 + d0]; bt[i] = *(const f32x4*)&Bc[(4 * tb + i) * 68 + d0]; }
#pragma unroll
                    for (int j = 0; j < 4; ++j) { kv[j] = *(const f32x4*)&K[(4 * sb + j) * 68 + d0]; bsv[j] = *(const f32x4*)&Bc[(4 * sb + j) * 68 + d0]; }
#pragma unroll
                    for (int i = 0; i < 4; ++i)
#pragma unroll
                        for (int j = 0; j < 4; ++j)
#pragma unroll
                            for (int dd = 0; dd < 4; ++dd) acc[i][j] = fmaf(qv[i][dd] * kv[j][dd], __expf(fminf(bt[i][dd] - bsv[j][dd], 0.f)), acc[i][j]);
                }
            }
#pragma unroll
            for (int i = 0; i < 4; ++i)
#pragma unroll
                for (int j = 0; j < 4; ++j) { acc[i][j] += __shfl_xor(acc[i][j], 1); if (4 * sb + j > 4 * tb + i) acc[i][j] = 0.f; }
            if (dh == 0) {
#pragma unroll
                for (int i = 0; i < 4; ++i) {
                    u32x2 pw; pw.x = pk2(acc[i][0], acc[i][1]); pw.y = pk2(acc[i][2], acc[i][3]);
                    *(LAS u32x2*)(ATb + (4 * tb + i) * 72 + 4 * sb) = pw;
                }
            }
        }
#pragma unroll
        for (int i = 0; i < 8; ++i) {
            const int e = tid + i * NTHR, t = e >> 6, d = e & 63;
            const float bt = Bc[t * 68 + d];
            hgQB[(size_t)item * 4096 + e] = f2bf(Q[t * 68 + d] * __expf(bt));
            KtB[d * 72 + t] = f2bf(K[t * 68 + d] * __expf(Bc[63 * 68 + d] - bt));
        }
        if (tid < 64) hgG[(size_t)item * 64 + tid] = __expf(Bc[63 * 68 + tid]);
        __syncthreads();
#pragma unroll
        for (int q = 0; q < 4; ++q) {
            const int tile = w * 4 + q, isU = tile >> 4, rt_ = (tile >> 2) & 3, ct = tile & 3;
            const LAS bf16_t* Ab = (isU ? KtB : ATb) + (16 * rt_ + lc) * 72 + 8 * gq;
            const LAS bf16_t* Bb = ItB + (16 * ct + lc) * 72 + 8 * gq;
            f32x4 acc = (f32x4){0.f, 0.f, 0.f, 0.f};
            acc = MFMA16(*(const LAS bf16x8*)Ab, *(const LAS bf16x8*)Bb, acc);
            acc = MFMA16(*(const LAS bf16x8*)(Ab + 32), *(const LAS bf16x8*)(Bb + 32), acc);
#pragma unroll
            for (int i = 0; i < 4; ++i) {
                const int r = 16 * rt_ + 4 * gq + i, cc = 16 * ct + lc;
                if (isU) hgU[((size_t)item * 64 + r) * 64 + cc] = acc[i];
                else hgO[((size_t)item * 64 + r) * 64 + cc] = f2bf(acc[i]);
            }
        }
    }
}

__device__ void phase_hgrnB(KA ka) {
    PHASE_IDS
    const float* hgU = PF(hgU); const float* hgG = PF(hgG); float* hgS = PF(hgS);
    for (int gid = BID * NTHR + TID; gid < 32768; gid += gridDim.x * NTHR) {
        const int bh = gid >> 12, dv = gid & 4095, d = dv >> 6;
        float S = 0.f;
        for (int c0 = 0; c0 < 128; c0 += 8) {
            float u[8], gg[8];
#pragma unroll
            for (int k = 0; k < 8; ++k) { const size_t item = (size_t)bh * 128 + c0 + k; u[k] = hgU[item * 4096 + dv]; gg[k] = hgG[item * 64 + d]; }
#pragma unroll
            for (int k = 0; k < 8; ++k) { const size_t item = (size_t)bh * 128 + c0 + k; hgS[item * 4096 + dv] = S; S = fmaf(gg[k], S, u[k]); }
        }
    }
}

__device__ void phase_hgrnC(KA ka, int layer, LAS unsigned char* lds) {
    PHASE_IDS
    const int tid = TID, lane = tid & 63, w = __builtin_amdgcn_readfirstlane(tid >> 6), gq = lane >> 4, lc = lane & 15;
    LAS bf16_t* QBb = (LAS bf16_t*)lds;
    LAS bf16_t* StB = QBb + 64 * 72;
    float* OT = (float*)(lds + 32768);
    const bf16_t* H = PF(H);
    const float* hgS = PF(hgS); const bf16_t* hgQB = PF(hgQB); const bf16_t* hgO = PF(hgO);
    const float* og = PF(out_gain) + layer * 1024;
    bf16_t* Y = PF(Y);
    for (int item = BID; item < 1024; item += gridDim.x) {
        const int c = item & 127, bh = item >> 7, h = bh & 3, b = bh >> 2;
        const size_t tok0 = (size_t)b * T_ + c * 64;
        __syncthreads();
#pragma unroll
        for (int i = 0; i < 8; ++i) {
            const int e = tid + i * NTHR, r = e >> 6, cc = e & 63;
            QBb[r * 72 + cc] = hgQB[(size_t)item * 4096 + e];
            StB[cc * 72 + r] = f2bf(hgS[(size_t)item * 4096 + e]);
        }
        __syncthreads();
#pragma unroll
        for (int q = 0; q < 2; ++q) {
            const int tile = w * 2 + q, rt_ = tile >> 2, ct = tile & 3;
            const LAS bf16_t* Ab = QBb + (16 * rt_ + lc) * 72 + 8 * gq;
            const LAS bf16_t* Bb = StB + (16 * ct + lc) * 72 + 8 * gq;
            f32x4 acc = (f32x4){0.f, 0.f, 0.f, 0.f};
            acc = MFMA16(*(const LAS bf16x8*)Ab, *(const LAS bf16x8*)Bb, acc);
            acc = MFMA16(*(const LAS bf16x8*)(Ab + 32), *(const LAS bf16x8*)(Bb + 32), acc);
#pragma unroll
            for (int i = 0; i < 4; ++i) {
                const int t = 16 * rt_ + 4 * gq + i, v = 16 * ct + lc;
                OT[t * 65 + v] = acc[i] + bf2f(hgO[((size_t)item * 64 + t) * 64 + v]);
            }
        }
        __syncthreads();
#pragma unroll 1
        for (int i = 0; i < 8; ++i) {
            const int t = w + 8 * i, v = lane;
            const float acc = OT[t * 65 + v];
            const float ms = wave_sum(acc * acc) * (1.f / 64.f);
            const float hg = bf2f(H[(tok0 + t) * HLD + C_HG + h * 64 + v]);
            const float y = acc * rsqrtf(ms + 1e-6f) * og[768 + h * 64 + v] * (hg * sigmoidf_(hg));
            Y[(tok0 + t) * DM + 768 + h * 64 + v] = f2bf(y);
        }
    }
}

struct CmpOrder {
    static constexpr bool GATHER = false;
    const char* W1T; int c;
    __device__ __forceinline__ bool next(int i, pg8::Unit& u) const {
        if (i > 0 || c >= 16) return false;
        const int which = c >> 3, bh = (c >> 1) & 3, nt = c & 1;
        u.arow0 = (bh >> 1) * 512 + nt * 256; u.nrows = 256; u.pm = nt; u.pn = 0; u.e = which * 4 + bh; u.ui = 0;
        u.bptr = W1T + (size_t)which * 256 * 2048 * 2;
        return true;
    }
    __device__ __forceinline__ int arow(const pg8::Unit& u, int r) const { return u.arow0 + r; }
    __device__ __forceinline__ int lda(int) const { return 16 * HLD; }
    __device__ __forceinline__ unsigned kstepA() const { return (unsigned)(HLD * 2); }
    __device__ __forceinline__ const char* abase(const pg8::Unit& u, const char* A) const { return A + (((u.e >> 2) ? C_VC : C_KC) + (u.e & 1) * 64) * 2; }
};
struct EpiCmp {
    static constexpr bool PERM = true;
    bf16_t* G; const float* cbias;
    __device__ __forceinline__ void operator()(const f32x4 (&acc)[2][2][4][2], const pg8::Unit& u, int wr, int wc, int fr, int fq) const {
        const float* bp = cbias + (u.e >> 2) * 128 + wc * 32 + 8 * fq;
        const f32x4 b0 = *(const f32x4*)bp, b1 = *(const f32x4*)(bp + 4);
#pragma unroll
        for (int ai = 0; ai < 2; ++ai)
#pragma unroll
            for (int m = 0; m < 4; ++m) {
                const int r = ai * 128 + wr * 64 + m * 16 + fr;
                bf16_t* rowp = G + ((size_t)(u.e * 512 + u.pm * 256 + r)) * 128 + wc * 32 + 8 * fq;
                const f32x4 v0 = acc[ai][0][m][0] + b0, v1 = acc[ai][0][m][1] + b1;
                u32x4 w; w.x = pk2(gelu_t(v0[0]), gelu_t(v0[1])); w.y = pk2(gelu_t(v0[2]), gelu_t(v0[3])); w.z = pk2(gelu_t(v1[0]), gelu_t(v1[1])); w.w = pk2(gelu_t(v1[2]), gelu_t(v1[3]));
                *(u32x4*)rowp = w;
            }
    }
};
__device__ void phase_compress2(KA ka, int layer, LAS unsigned char* lds) {
    const int bid = opaque_bid();
    if (bid >= 16) return;
    CmpOrder S{(const char*)(PF(WT) + WT_C1), bid};
    EpiCmp E{PF(gb), PF(cbias)};
    pg8::gemm_phase<EpiCmp, CmpOrder>(lds, (const char*)PF(H), 2048, S, E);
    __syncthreads();
    const int tid = opaque_tid();
    const int which = bid >> 3, bh = (bid >> 1) & 3, nt = bid & 1;
    float* w2s = (float*)lds;
    const float* w2 = PF(cmp_w2) + ((size_t)layer * 2 + which) * 128 * 64;
    for (int i = tid; i < 128 * 64; i += NTHR) w2s[i] = w2[i];
    __syncthreads();
    const int r = tid >> 1, half = tid & 1;
    const bf16_t* grow = PF(gb) + ((size_t)((which * 4 + bh) * 512 + nt * 256 + r)) * 128;
    float acc[32];
#pragma unroll
    for (int j = 0; j < 32; ++j) acc[j] = 0.f;
    for (int c8 = 0; c8 < 16; ++c8) {
        const u32x4 gu = *(const u32x4*)(grow + c8 * 8);
        const unsigned gw[4] = {gu.x, gu.y, gu.z, gu.w};
#pragma unroll
        for (int e = 0; e < 8; ++e) {
            const float gv = (e & 1) ? __uint_as_float(gw[e >> 1] & 0xffff0000u) : __uint_as_float(gw[e >> 1] << 16);
            const float* wrow = w2s + (c8 * 8 + e) * 64 + half * 32;
#pragma unroll
            for (int j4 = 0; j4 < 8; ++j4) {
                const float4 w4 = *(const float4*)(wrow + j4 * 4);
                acc[j4 * 4 + 0] = fmaf(gv, w4.x, acc[j4 * 4 + 0]); acc[j4 * 4 + 1] = fmaf(gv, w4.y, acc[j4 * 4 + 1]);
                acc[j4 * 4 + 2] = fmaf(gv, w4.z, acc[j4 * 4 + 2]); acc[j4 * 4 + 3] = fmaf(gv, w4.w, acc[j4 * 4 + 3]);
            }
        }
    }
    const int n = nt * 256 + r;
    if (which == 0) {
        bf16_t* o = PF(kcb) + ((size_t)bh * 512 + n) * 64 + half * 32;
#pragma unroll
        for (int j = 0; j < 32; j += 2) *(unsigned*)(o + j) = pk2(acc[j], acc[j + 1]);
    } else {
        bf16_t* o = PF(vcT) + (size_t)bh * 64 * 512 + n;
#pragma unroll
        for (int j = 0; j < 32; ++j) o[(size_t)(half * 32 + j) * 512] = f2bf(acc[j]);
    }
    __syncthreads();
}

__device__ void phase_gmlp2(KA ka, int layer, LAS unsigned char* lds, int first, int nblk) {
    PHASE_IDS
    const int tid = TID, lane = tid & 63, w = __builtin_amdgcn_readfirstlane(tid >> 6), gq = lane >> 4, lc = lane & 15;
    LAS bf16_t* Vt = (LAS bf16_t*)lds;
    const float* gain = PF(gm_v_gain) + layer * 256;
    const float* bias = PF(gm_v_bias) + layer * 256;
    const float* bs = PF(gm_b_s) + layer * 4 * 128;
    const bf16_t* gmW = PF(WT) + WT_GM;
    const bf16_t* H = PF(H);
    bf16_t* Y = PF(Y);
    if (BID < first) return;
    for (int item = BID - first; item < 512; item += nblk) {
        const int g = item & 3, c = (item >> 2) & 63, b = item >> 8;
        const size_t tok0 = (size_t)b * T_ + (size_t)c * 128;
        __syncthreads();
        for (int i = 0; i < 16; ++i) {
            const int s = w * 16 + i;
            const float x = bf2f(H[(tok0 + s) * HLD + C_GV + g * 64 + lane]);
            const float ge = gelu_t(x);
            const float mu = wave_sum(ge) * (1.f / 64.f);
            const float dl = ge - mu;
            const float var = wave_sum(dl * dl) * (1.f / 64.f);
            Vt[lane * 136 + s] = f2bf(dl * rsqrtf(var + 1e-5f) * gain[g * 64 + lane] + bias[g * 64 + lane]);
        }
        __syncthreads();
        f32x4 acc[4];
#pragma unroll
        for (int ct = 0; ct < 4; ++ct) acc[ct] = (f32x4){0.f, 0.f, 0.f, 0.f};
        const bf16_t* wrow = gmW + ((size_t)g * 128 + 16 * w + lc) * 128 + 8 * gq;
        const int kmax = (16 * w + 15) >> 5;
        for (int ks = 0; ks <= kmax; ++ks) {
            const bf16x8 a = *(const bf16x8*)(wrow + 32 * ks);
#pragma unroll
            for (int ct = 0; ct < 4; ++ct) {
                const bf16x8 bfr = *(const LAS bf16x8*)(Vt + (16 * ct + lc) * 136 + 32 * ks + 8 * gq);
                acc[ct] = MFMA16(a, bfr, acc[ct]);
            }
        }
        const float* ogain = PF(out_gain) + layer * 1024;
#pragma unroll
        for (int i = 0; i < 4; ++i) {
            const int t = 16 * w + 4 * gq + i;
            float yv[4];
            float ss = 0.f;
#pragma unroll
            for (int ct = 0; ct < 4; ++ct) {
                const int d = 16 * ct + lc;
                const float z = acc[ct][i] + bs[g * 128 + t];
                const float u = gelu_t(bf2f(H[(tok0 + t) * HLD + C_GU + g * 64 + d]));
                yv[ct] = u * z;
                ss += yv[ct] * yv[ct];
            }
            ss += __shfl_xor(ss, 1); ss += __shfl_xor(ss, 2); ss += __shfl_xor(ss, 4); ss += __shfl_xor(ss, 8);
            const float rn = rsqrtf(ss * (1.f / 64.f) + 1e-6f);
#pragma unroll
            for (int ct = 0; ct < 4; ++ct) {
                const int d = 16 * ct + lc;
                Y[(tok0 + t) * DM + g * 64 + d] = f2bf(yv[ct] * rn * ogain[g * 64 + d]);
            }
        }
    }
}

#ifndef ONLY_Q
#define ONLY_Q -2
#endif
#ifndef QMASK
#define QMASK 0x3ff
#endif
#define QON(k) ((ONLY_Q == -2 && ((QMASK >> ((k) + 1)) & 1)) || ONLY_Q == (k))
#ifndef DUPMASK
#define DUPMASK 0
#endif
#define DUP(k) ((DUPMASK >> (k)) & 1)
#ifndef PROF_LO
#define PROF_LO -1
#endif
#ifndef PROF_HI
#define PROF_HI -1
#endif
#ifndef NPH_TOTAL
#define NPH_TOTAL 19
#endif
__global__ void __launch_bounds__(NTHR, 2) k_mega(P p0) {
    extern __shared__ __attribute__((aligned(16))) unsigned char lds_raw[];
    LAS unsigned char* lds = (LAS unsigned char*)lds_raw;
    float* smem = (float*)lds_raw;
    volatile LAS unsigned* misc = (volatile LAS unsigned*)(lds + LDS_MISC);
    if (threadIdx.x < 16) misc[threadIdx.x] = 0u;
    __syncthreads();
    XcdBarrier bar = xcd_barrier_post(p0.ctl + CW_BAR, misc);
    if (PROF_LO >= 0 && blockIdx.x == 0 && threadIdx.x == 0) ((unsigned long long*)(p0.ctl + 8192))[0] = __builtin_amdgcn_s_memrealtime();
#pragma unroll 1
    for (int ph = 0; ph < p0.nph; ph++) {
        const int layer = ph == 0 ? 0 : (ph - 1) / 9, q = ph == 0 ? -1 : (ph - 1) % 9;
        const int dupm = p0.pad;
#if defined(__HIP_DEVICE_COMPILE__)
        KA ka = (KA)__builtin_amdgcn_kernarg_segment_ptr();
        asm volatile("" : "+s"(ka));
#else
        KA ka = nullptr;
#endif
        const float* xin = layer == 0 ? PF(x) : PF(out);
        float* x1 = PF(out);
        if (q == -1 && QON(-1)) { for (int r = 0; r <= ((dupm >> 15) & 1); ++r) { phase_prologue(ka, 0, smem); __syncthreads(); } }
        else if (q == 0 && QON(0)) { for (int r = 0; r <= (dupm & 1); ++r) { phase_inproj(ka, layer, lds); __syncthreads(); } }
        else if (q == 1 && QON(1)) {
            const int nb1 = (int)gridDim.x > 32 ? 16 : 0, nwork = (int)gridDim.x - nb1;
            for (int r = 0; r <= ((dupm >> 12) & 1); ++r) { phase_compress2(ka, layer, lds); __syncthreads(); }
            for (int r = 0; r <= ((dupm >> 10) & 1); ++r) { phase_hgrnA(ka, layer, lds, nb1, nwork); __syncthreads(); }
            for (int r = 0; r <= ((dupm >> 11) & 1); ++r) { phase_gmlp2(ka, layer, lds, nb1, nwork); __syncthreads(); }
            for (int r = 0; r <= ((dupm >> 13) & 1); ++r) { phase_vtrans(ka, smem); __syncthreads(); }
        }
        else if (q == 2 && QON(2)) { for (int r = 0; r <= ((dupm >> 14) & 1); ++r) { phase_hgrnB(ka); __syncthreads(); } for (int r = 0; r <= ((dupm >> 2) & 1); ++r) { phase_nsa2(ka, layer, lds); __syncthreads(); } }
        else if (q == 3 && QON(3)) { for (int r = 0; r <= ((dupm >> 3) & 1); ++r) { phase_hgrnC(ka, layer, lds); __syncthreads(); } }
        else if (q == 4 && QON(4)) phase_outproj(ka, layer, xin, x1, lds);
        else if (q == 5 && QON(5)) { for (int r = ((dupm >> 5) & 1); r >= 0; --r) { phase_ln1_route(ka, layer, x1, smem, r == 1); __syncthreads(); } }
        else if (q == 6 && QON(6)) { for (int r = 0; r <= ((dupm >> 6) & 1); ++r) { phase_moe_up(ka, layer, lds); __syncthreads(); } }
        else if (q == 7 && QON(7)) { for (int r = 0; r <= ((dupm >> 7) & 1); ++r) { phase_moe_down(ka, layer, lds); __syncthreads(); } }
        else if (q == 8 && QON(8)) { phase_ln2(ka, layer, x1, PF(out)); if (layer == 0) { __syncthreads(); phase_prologue(ka, 1, smem); } }
        if (ph != NPH_TOTAL - 1 || PROF_LO >= 0) xcd_barrier(bar);
        if (PROF_LO >= 0 && blockIdx.x == 0 && threadIdx.x == 0) ((unsigned long long*)(p0.ctl + 8192))[ph + 1] = __builtin_amdgcn_s_memrealtime();
    }
    if (PROF_LO >= 0) {
        xcd_barrier(bar);
        const unsigned long long* ts = (const unsigned long long*)(p0.ctl + 8192);
        const unsigned long long t0 = __hip_atomic_load(&ts[PROF_LO], __ATOMIC_RELAXED, __HIP_MEMORY_SCOPE_AGENT), t1 = __hip_atomic_load(&ts[PROF_HI + 1], __ATOMIC_RELAXED, __HIP_MEMORY_SCOPE_AGENT);
        const float fac = 1.f + 1e-5f * (float)(t1 - t0);
        for (size_t i = (size_t)blockIdx.x * NTHR + threadIdx.x; i < (size_t)NTOK * DM; i += (size_t)gridDim.x * NTHR) p0.out[i] *= fac;
    }
}

static inline size_t align_up(size_t v, size_t a) { return (v + a - 1) / a * a; }

extern "C" void kernel_launch(void* const* d_in, const int* in_sizes, int n_in, void* d_out, int out_size, void* d_ws,
                              size_t ws_size, hipStream_t stream) {
    P p{};
    p.x = (const float*)d_in[0]; p.w_in = (const float*)d_in[1]; p.gm_v_gain = (const float*)d_in[2];
    p.gm_v_bias = (const float*)d_in[3]; p.gm_w_s = (const float*)d_in[4]; p.gm_b_s = (const float*)d_in[5];
    p.cmp_pos = (const float*)d_in[6]; p.cmp_w1 = (const float*)d_in[7]; p.cmp_w2 = (const float*)d_in[8];
    p.nsa_gate_b = (const float*)d_in[9]; p.hg_lower = (const float*)d_in[10]; p.out_gain = (const float*)d_in[11];
    p.w_out = (const float*)d_in[12]; p.ln1_g = (const float*)d_in[13]; p.ln1_b = (const float*)d_in[14];
    p.rg_w = (const float*)d_in[15]; p.rg_b = (const float*)d_in[16]; p.re_w = (const float*)d_in[17];
    p.re_b = (const float*)d_in[18]; p.w_gate = (const float*)d_in[19]; p.w_up = (const float*)d_in[20];
    p.w_down = (const float*)d_in[21]; p.ln2_g = (const float*)d_in[22]; p.ln2_b = (const float*)d_in[23];
    p.out = (float*)d_out;
    char* ws = (char*)d_ws;
    size_t off = 0;
    p.ctl = (unsigned*)(ws + off); off = align_up(off + CTL_BYTES, 256);
    p.WT = (bf16_t*)(ws + off); off = align_up(off + WT_LAYER * 2, 256);
    p.H = (bf16_t*)(ws + off); off = align_up(off + (size_t)NTOK * HLD * 2, 256);
    p.Y = (bf16_t*)(ws + off); off = align_up(off + (size_t)NTOK * DM * 2, 256);
    p.XB = (bf16_t*)(ws + off); off = align_up(off + (size_t)NTOK * DM * 2, 256);
    p.kcb = (bf16_t*)(ws + off); off = align_up(off + (size_t)4 * 512 * 64 * 2, 256);
    p.vcT = (bf16_t*)(ws + off); off = align_up(off + (size_t)4 * 64 * 512 * 2, 256);
    p.vsT = (bf16_t*)(ws + off); off = align_up(off + (size_t)4 * 64 * T_ * 2, 256);
    p.vwT = (bf16_t*)(ws + off); off = align_up(off + (size_t)4 * 64 * T_ * 2, 256);
    p.gb = (bf16_t*)(ws + off); off = align_up(off + (size_t)8 * 512 * 128 * 2, 256);
    p.cbias = (float*)(ws + off); off = align_up(off + 256 * 4, 256);
    p.list_tok = (int*)(ws + off); off = align_up(off + (size_t)16 * NTOK * 4, 256);
    p.list_w = (float*)(ws + off); off = align_up(off + (size_t)16 * NTOK * 4, 256);
    p.tok_slot = (int*)(ws + off); off = align_up(off + (size_t)NTOK * 2 * 4, 256);
    p.hgU = (float*)p.XB; p.hgS = p.hgU + (size_t)1024 * 4096;
    p.hgG = (float*)(ws + off); off = align_up(off + (size_t)1024 * 64 * 4, 256);
    p.hgQB = (bf16_t*)(ws + off); off = align_up(off + (size_t)1024 * 4096 * 2, 256);
    p.hgO = (bf16_t*)(ws + off); off = align_up(off + (size_t)1024 * 4096 * 2, 256);
    p.nph = NPH_TOTAL; p.pad = DUPMASK;
    (void)in_sizes; (void)n_in; (void)out_size;
    static int grid_blocks = 0;
    if (!grid_blocks) {
        int dev = 0, cus = 0, per_cu = 0;
        (void)hipGetDevice(&dev);
        (void)hipDeviceGetAttribute(&cus, hipDeviceAttributeMultiprocessorCount, dev);
        if (hipFuncSetAttribute((const void*)k_mega, hipFuncAttributeMaxDynamicSharedMemorySize, LDS_BYTES) != hipSuccess) { fprintf(stderr, "hipFuncSetAttribute failed\n"); grid_blocks = -1; return; }
        if (hipOccupancyMaxActiveBlocksPerMultiprocessor(&per_cu, (const void*)k_mega, NTHR, LDS_BYTES) != hipSuccess || per_cu < 1) { fprintf(stderr, "occupancy query says %d\n", per_cu); }
        (void)hipGetLastError();
        grid_blocks = cus;
        if (off > ws_size) { fprintf(stderr, "workspace too small: need %zu have %zu\n", off, ws_size); grid_blocks = -1; }
    }
    if (grid_blocks < 0) return;
    (void)hipMemsetAsync(p.ctl, 0, CTL_BYTES, stream);
    void* args[] = {&p};
    hipError_t e = hipLaunchCooperativeKernel((const void*)k_mega, dim3(grid_blocks), dim3(NTHR), args, LDS_BYTES, stream);
    if (e != hipSuccess) fprintf(stderr, "cooperative launch failed: %s (grid %d)\n", hipGetErrorString(e), grid_blocks);
}
```

```cpp
#include <hip/hip_runtime.h>
#include <cstdio>
#include <cstdint>

#define LAS __attribute__((address_space(3)))
typedef unsigned short bf16_t;
typedef short bf16x8 __attribute__((ext_vector_type(8)));
typedef float f32x4 __attribute__((ext_vector_type(4)));
typedef float f32x2 __attribute__((ext_vector_type(2)));
typedef unsigned u32x4 __attribute__((ext_vector_type(4)));
typedef unsigned u32x2 __attribute__((ext_vector_type(2)));

constexpr int NW = 8;
constexpr int NTHR = NW * 64;
constexpr int T_ = 8192;
constexpr int NTOK = 16384;
constexpr int DM = 1024;
constexpr int IC_SRC = 2840;
constexpr int HLD = 3072;
constexpr int C_GU = 0, C_GV = 256, C_NQ = 512, C_KC = 1024, C_VC = 1152, C_KS = 1280, C_VS = 1408,
              C_KW = 1536, C_VW = 1664, C_HQ = 1792, C_HF = 2048, C_HI = 2304, C_HG = 2560, C_NG = 2816;
constexpr int NCMP = 511;
constexpr float ALPHA = 1.4142135623730951f;
constexpr float NEG_INF = -1e30f;

constexpr size_t WT_IN = 0;
constexpr size_t WT_OUT = WT_IN + (size_t)3072 * 1024;
constexpr size_t WT_UP = WT_OUT + (size_t)1024 * 1024;
constexpr size_t WT_DN = WT_UP + (size_t)16 * 1024 * 1024;
constexpr size_t WT_C1 = WT_DN + (size_t)16 * 1024 * 512;
constexpr size_t WT_GM = WT_C1 + (size_t)2 * 256 * 2048;
constexpr size_t WT_LAYER = WT_GM + (size_t)4 * 128 * 128;

constexpr int LDS_STAGE = 131072;
constexpr int LDS_MISC = LDS_STAGE;
constexpr int LDS_BYTES = 147456;

constexpr int CW_BAR = 0;
constexpr int CW_CNT = 4096;
constexpr size_t CTL_BYTES = 65536;

struct P {
    const float* x; const float* w_in; const float* gm_v_gain; const float* gm_v_bias; const float* gm_w_s;
    const float* gm_b_s; const float* cmp_pos; const float* cmp_w1; const float* cmp_w2; const float* nsa_gate_b;
    const float* hg_lower; const float* out_gain; const float* w_out; const float* ln1_g; const float* ln1_b;
    const float* rg_w; const float* rg_b; const float* re_w; const float* re_b; const float* w_gate;
    const float* w_up; const float* w_down; const float* ln2_g; const float* ln2_b;
    float* out;
    unsigned* ctl;
    bf16_t* WT;
    bf16_t* H;
    bf16_t* Y;
    bf16_t* XB;
    bf16_t* kcb;
    bf16_t* vcT;
    bf16_t* vsT;
    bf16_t* vwT;
    bf16_t* gb;
    float* cbias;
    int* list_tok;
    float* list_w;
    int* tok_slot;
    float* hgU; float* hgG; float* hgS; bf16_t* hgQB; bf16_t* hgO;
    int nph; int pad;
};


typedef const __attribute__((address_space(4))) char* KA;
template <class T> __device__ __forceinline__ T ldarg(KA ka, size_t off) { return *(const __attribute__((address_space(4))) T*)(ka + off); }
#define PF(f) ldarg<decltype(P::f)>(ka, offsetof(P, f))

__device__ __forceinline__ float bf2f(bf16_t u) { return __uint_as_float(((unsigned)u) << 16); }
__device__ __forceinline__ unsigned f2bf_u(float f) {
    unsigned u = __float_as_uint(f);
    return (u + 0x7fffu + ((u >> 16) & 1u)) >> 16;
}
__device__ __forceinline__ bf16_t f2bf(float f) { return (bf16_t)f2bf_u(f); }
__device__ __forceinline__ unsigned pk2(float lo, float hi) { return f2bf_u(lo) | (f2bf_u(hi) << 16); }
__device__ __forceinline__ float gelu_t(float x) {
    float u = 0.7978845608028654f * (x + 0.044715f * x * x * x);
    return 0.5f * x * (1.f + tanhf(u));
}
__device__ __forceinline__ float sigmoidf_(float x) { return 1.f / (1.f + __expf(-x)); }
__device__ __forceinline__ float wave_max(float v) {
#pragma unroll
    for (int o = 32; o > 0; o >>= 1) v = fmaxf(v, __shfl_xor(v, o));
    return v;
}
__device__ __forceinline__ float wave_sum(float v) {
#pragma unroll
    for (int o = 32; o > 0; o >>= 1) v += __shfl_xor(v, o);
    return v;
}
__device__ __forceinline__ void wave_sync() {
    __builtin_amdgcn_fence(__ATOMIC_RELEASE, "wavefront");
    __builtin_amdgcn_wave_barrier();
    __builtin_amdgcn_fence(__ATOMIC_ACQUIRE, "wavefront");
}
__device__ __forceinline__ int opaque_tid() { int t = threadIdx.x; asm volatile("" : "+v"(t)); return t; }
__device__ __forceinline__ int opaque_bid() { int b = blockIdx.x; asm volatile("" : "+s"(b)); return b; }
#define PHASE_IDS const int TID = opaque_tid(); const int BID = opaque_bid(); (void)TID; (void)BID;

#define XB_TMO      128
#define XB_XCNT(j)  (256  + 64 * (j))
#define XB_XSUB(j)  (1280 + 64 * (j))
#define XB_XGEN(j)  (2304 + 64 * (j))
#define XB_TOP      3328
#define XB_TOPGEN   3392
#define XCD_BAR_WORDS 3456
#define XB_SPIN_CAP (1u << 22)
__device__ __forceinline__ unsigned xb_ld(unsigned* p)              { return __hip_atomic_load(p, __ATOMIC_RELAXED, __HIP_MEMORY_SCOPE_AGENT); }
__device__ __forceinline__ unsigned xb_add(unsigned* p, unsigned v) { return __hip_atomic_fetch_add(p, v, __ATOMIC_RELAXED, __HIP_MEMORY_SCOPE_AGENT); }
__device__ __forceinline__ unsigned xb_xcc_id() { return (unsigned)__builtin_amdgcn_s_getreg((3 << 11) | 20) & 0xFu; }
#define XB_SPIN(cond, bar) do { unsigned _sp = 0; while (cond) { __builtin_amdgcn_s_sleep(1); \
    if ((++_sp & 255u) == 0u) { if (xb_ld(&(bar)[XB_TMO])) break; if (_sp > XB_SPIN_CAP) { atomicAdd(&(bar)[XB_TMO], 1u); break; } } } } while (0)
struct XcdBarrier { unsigned* bar; unsigned x; volatile LAS unsigned* st; };
__device__ __forceinline__ XcdBarrier xcd_barrier_post(unsigned* bar, volatile LAS unsigned* st) {
    XcdBarrier b; b.bar = bar; b.x = xb_xcc_id(); b.st = st;
    if (threadIdx.x == 0) (void)xb_add(&bar[XB_XCNT(b.x)], 1u);
    return b;
}
__device__ __forceinline__ void xcd_barrier_complete(unsigned* bar, unsigned x, unsigned& nloc, unsigned& nx) {
    const unsigned G = gridDim.x * gridDim.y * gridDim.z;
    unsigned sum, cnt, mine, sp = 0u;
    for (;;) {
        sum = 0u; cnt = 0u; mine = 0u;
#pragma unroll
        for (unsigned j = 0; j < 16; ++j) { const unsigned c = xb_ld(&bar[XB_XCNT(j)]); sum += c; cnt += (c > 0u) ? 1u : 0u; mine = (j == x) ? c : mine; }
        if (sum == G) break;
        __builtin_amdgcn_s_sleep(1);
        if ((++sp & 255u) == 0u) { if (xb_ld(&bar[XB_TMO])) break; if (sp > XB_SPIN_CAP) { atomicAdd(&bar[XB_TMO], 1u); break; } }
    }
    nloc = mine > 0u ? mine : 1u; nx = cnt > 0u ? cnt : 1u;
}
__device__ __forceinline__ void xcd_barrier(const XcdBarrier& b) {
    asm volatile("s_waitcnt vmcnt(0)" ::: "memory");
    __syncthreads();
    if (threadIdx.x == 0) {
        unsigned* bar = b.bar;
        __builtin_amdgcn_s_waitcnt(0);
        unsigned nloc = b.st[0], nx = b.st[1];
        if (nloc == 0u) { xcd_barrier_complete(bar, b.x, nloc, nx); b.st[0] = nloc; b.st[1] = nx; }
        const unsigned old = xb_add(&bar[XB_XSUB(b.x)], 1u);
        const unsigned gen = old / nloc;
        if (old + 1u == (gen + 1u) * nloc) {
            __builtin_amdgcn_fence(__ATOMIC_RELEASE, "agent");
            asm volatile("s_waitcnt vmcnt(0)" ::: "memory");
            const unsigned og = xb_add(&bar[XB_TOP], 1u);
            const unsigned tg = og / nx;
            if (og + 1u == (tg + 1u) * nx) xb_add(&bar[XB_TOPGEN], 1u);
            else XB_SPIN(xb_ld(&bar[XB_TOPGEN]) == tg, bar);
            __builtin_amdgcn_fence(__ATOMIC_ACQUIRE, "agent");
            xb_add(&bar[XB_XGEN(b.x)], 1u);
            asm volatile("s_waitcnt vmcnt(0)" ::: "memory");
        } else {
            XB_SPIN(xb_ld(&bar[XB_XGEN(b.x)]) == gen, bar);
            __builtin_amdgcn_fence(__ATOMIC_ACQUIRE, "agent");
            asm volatile("s_waitcnt vmcnt(0)" ::: "memory");
        }
    }
    __syncthreads();
}

namespace pg8 {
constexpr int BM = 256, BK = 64, HALF = 128, HTB = HALF * BK * 2, STAGE_BYTES = 8 * HTB;
__host__ __device__ __forceinline__ int lds_byte(int r, int c) { const int st = (r >> 4) * 2 + (c >> 5), rr = r & 15, cc = c & 31, ob = rr * 64 + cc * 2; return st * 1024 + (ob ^ (((ob >> 9) & 1) << 5)); }
__host__ __device__ __forceinline__ void stage_rc(int b, int& R, int& C) { const int st = b / 1024, sb = b % 1024, swz = sb ^ (((sb >> 9) & 1) << 5); R = (st >> 1) * 16 + swz / 64; C = (st & 1) * 32 + (swz % 64) / 2; }
__host__ __device__ __forceinline__ int perm32(int rho) { const int n = rho >> 4, i = rho & 15; return 8 * (i >> 2) + 4 * n + (i & 3); }
__device__ __forceinline__ unsigned cvt_pk_bf16(float lo, float hi) { unsigned r; asm volatile("v_cvt_pk_bf16_f32 %0, %1, %2" : "=v"(r) : "v"(lo), "v"(hi)); return r; }

struct Unit {
    const char* bptr;
    int arow0;
    int nrows;
    int pm, pn, e, ui;
};

template <class Epi, class Sched>
__device__ __forceinline__ void gemm_phase(LAS unsigned char* lds, const char* Abase, const int K, const Sched& S, const Epi& E) {
    const int tid = opaque_tid(), wid = __builtin_amdgcn_readfirstlane(tid >> 6), lane = tid & 63, wr = wid >> 2, wc = wid & 3, fr = lane & 15, fq = lane >> 4;
    const int nt = K / BK;
    int R0, C0, R1, C1; stage_rc(tid * 16, R0, C0); stage_rc(tid * 16 + 8192, R1, C1);
    unsigned voffB[2];
    { const int Rb0 = Epi::PERM ? ((R0 & ~31) + perm32(R0 & 31)) : R0, Rb1 = Epi::PERM ? ((R1 & ~31) + perm32(R1 & 31)) : R1;
      voffB[0] = (unsigned)(Rb0 * K + C0) * 2u; voffB[1] = (unsigned)(Rb1 * K + C1) * 2u; }
    const unsigned cA0 = (unsigned)C0 * 2u, cA1 = (unsigned)C1 * 2u;
    const int lda = S.lda(K);
    const unsigned kstepA = S.kstepA();
    const unsigned voffA0 = (unsigned)(R0 * lda + C0) * 2u, voffA1 = (unsigned)(R1 * lda + C1) * 2u;
    const unsigned kstep = (unsigned)(BK * 2);
    const unsigned hstep = (unsigned)(HALF * K * 2);
    const unsigned ldsw = (unsigned)wid * 1024u;
    const int aoff = lds_byte(wr * 64 + fr, fq * 8), boff = lds_byte(wc * 32 + fr, fq * 8);
#define PG8_SA(b, h) (((b) * 2 + (h)) * HTB)
#define PG8_SB(b, h) ((4 + (b) * 2 + (h)) * HTB)
#define PG8_STAGE_B(bufoff, gbase) do { \
        __builtin_amdgcn_global_load_lds((const unsigned*)((const char*)(gbase) + voffB[0]), (LAS unsigned*)(lds + (bufoff) + ldsw), 16, 0, 0); \
        __builtin_amdgcn_global_load_lds((const unsigned*)((const char*)(gbase) + voffB[1]), (LAS unsigned*)(lds + (bufoff) + ldsw + 8192), 16, 0, 0); } while (0)
#define PG8_STAGE_A(bufoff, gbase, pk) do { \
        const unsigned o0_ = Sched::GATHER ? (((pk) & 0xffffu) * (unsigned)lda * 2u + cA0) : voffA0; \
        const unsigned o1_ = Sched::GATHER ? (((pk) >> 16) * (unsigned)lda * 2u + cA1) : voffA1; \
        __builtin_amdgcn_global_load_lds((const unsigned*)((const char*)(gbase) + o0_), (LAS unsigned*)(lds + (bufoff) + ldsw), 16, 0, 0); \
        __builtin_amdgcn_global_load_lds((const unsigned*)((const char*)(gbase) + o1_), (LAS unsigned*)(lds + (bufoff) + ldsw + 8192), 16, 0, 0); } while (0)
#define PG8_LDA(dst, b, h) do { _Pragma("unroll") for (int m = 0; m < 4; ++m) _Pragma("unroll") for (int k = 0; k < 2; ++k) dst[m][k] = *(const LAS bf16x8*)(lds + PG8_SA(b, h) + aoff + m * 2048 + k * 1024); } while (0)
#define PG8_LDB(dst, b, h) do { _Pragma("unroll") for (int n = 0; n < 2; ++n) _Pragma("unroll") for (int k = 0; k < 2; ++k) dst[n][k] = *(const LAS bf16x8*)(lds + PG8_SB(b, h) + boff + n * 2048 + k * 1024); } while (0)
#define PG8_MMA(ai, bj, At, Bt) do { __builtin_amdgcn_s_setprio(1); _Pragma("unroll") for (int m = 0; m < 4; ++m) _Pragma("unroll") for (int n = 0; n < 2; ++n) _Pragma("unroll") for (int k = 0; k < 2; ++k) \
        acc[ai][bj][m][n] = __builtin_amdgcn_mfma_f32_16x16x32_bf16(Bt[n][k], At[m][k], acc[ai][bj][m][n], 0, 0, 0); __builtin_amdgcn_s_setprio(0); } while (0)
#define PG8_WAIT_V(n) asm volatile("s_waitcnt vmcnt(" #n ")" ::: "memory")
#define PG8_WAIT_L(n) asm volatile("s_waitcnt lgkmcnt(" #n ")" ::: "memory")
#define PG8_BAR __builtin_amdgcn_s_barrier()
#define PG8_SCHED __builtin_amdgcn_sched_barrier(0)
#define PG8_PACK(u, h) ((unsigned)S.arow((u), ((h) * 128 + R0) < (u).nrows ? ((h) * 128 + R0) : (u).nrows - 1) | ((unsigned)S.arow((u), ((h) * 128 + R1) < (u).nrows ? ((h) * 128 + R1) : (u).nrows - 1) << 16))
    Unit cur, nxt; int ui = 0;
    if (!S.next(0, cur)) return;
    f32x4 acc[2][2][4][2];
#pragma unroll
    for (int a = 0; a < 2; ++a)
#pragma unroll
        for (int b = 0; b < 2; ++b)
#pragma unroll
            for (int m = 0; m < 4; ++m)
#pragma unroll
                for (int n = 0; n < 2; ++n) acc[a][b][m][n] = (f32x4){0.f, 0.f, 0.f, 0.f};
    bf16x8 At[4][2], B0[2][2], B1[2][2];
    unsigned pC0 = 0u, pC1 = 0u, pN0 = 0u, pN1 = 0u;
    if (Sched::GATHER) { pC0 = PG8_PACK(cur, 0); pC1 = PG8_PACK(cur, 1); }
    const char* cB = cur.bptr;
    const char* cA = Sched::GATHER ? Abase : S.abase(cur, Abase) + (size_t)cur.arow0 * lda * 2;
    const unsigned hA = Sched::GATHER ? 0u : (unsigned)(HALF * lda * 2);
    PG8_STAGE_B(PG8_SB(0, 0), cB); PG8_STAGE_B(PG8_SB(0, 1), cB + hstep); PG8_STAGE_A(PG8_SA(0, 0), cA, pC0); PG8_STAGE_A(PG8_SA(0, 1), cA + hA, pC1);
    if (wr == 1) PG8_BAR;
    PG8_WAIT_V(2); PG8_BAR;
    PG8_STAGE_B(PG8_SB(1, 0), cB + kstep); PG8_STAGE_A(PG8_SA(1, 0), cA + kstepA, pC0); PG8_STAGE_B(PG8_SB(1, 1), cB + hstep + kstep);
    PG8_WAIT_V(6); PG8_BAR;
    for (;;) {
        const bool has_next = S.next(ui + 1, nxt);
        if (Sched::GATHER) { if (has_next) { pN0 = PG8_PACK(nxt, 0); pN1 = PG8_PACK(nxt, 1); } else { pN0 = pC0; pN1 = pC1; } }
        const char* nB = has_next ? nxt.bptr : cB;
        const char* nA = (Sched::GATHER || !has_next) ? cA : S.abase(nxt, Abase) + (size_t)nxt.arow0 * lda * 2;
        for (int t = 0; t < nt; t += 2) {
            const bool last = (t == nt - 2);
            const char* a1 = cA + (unsigned)(t + 1) * kstepA;
            const char* a2 = last ? nA : cA + (unsigned)(t + 2) * kstepA; const char* b2 = last ? nB : cB + (unsigned)(t + 2) * kstep;
            const char* a3 = a2 + kstepA; const char* b3 = b2 + kstep;
            const unsigned s0 = last ? pN0 : pC0, s1 = last ? pN1 : pC1;
            PG8_LDB(B0, 0, 0); PG8_LDB(B1, 0, 1); PG8_SCHED; PG8_LDA(At, 0, 0); PG8_STAGE_A(PG8_SA(1, 1), a1 + hA, pC1);
            PG8_WAIT_V(8); PG8_WAIT_L(0); PG8_BAR; PG8_MMA(0, 0, At, B0); PG8_MMA(0, 1, At, B1); PG8_BAR; PG8_SCHED;
            PG8_LDA(At, 0, 1); PG8_STAGE_B(PG8_SB(0, 0), b2); PG8_STAGE_B(PG8_SB(0, 1), b2 + hstep); PG8_STAGE_A(PG8_SA(0, 0), a2, s0);
            PG8_WAIT_V(8); PG8_WAIT_L(0); PG8_BAR; PG8_MMA(1, 0, At, B0); PG8_MMA(1, 1, At, B1); PG8_BAR; PG8_SCHED;
            PG8_LDB(B0, 1, 0); PG8_LDB(B1, 1, 1); PG8_SCHED; PG8_LDA(At, 1, 0); PG8_STAGE_A(PG8_SA(0, 1), a2 + hA, s1);
            PG8_WAIT_V(8); PG8_WAIT_L(0); PG8_BAR; PG8_MMA(0, 0, At, B0); PG8_MMA(0, 1, At, B1); PG8_BAR; PG8_SCHED;
            PG8_LDA(At, 1, 1); PG8_STAGE_B(PG8_SB(1, 0), b3); PG8_STAGE_B(PG8_SB(1, 1), b3 + hstep); PG8_STAGE_A(PG8_SA(1, 0), a3, s0);
            PG8_WAIT_V(8); PG8_WAIT_L(0); PG8_BAR; PG8_MMA(1, 0, At, B0); PG8_MMA(1, 1, At, B1); PG8_BAR; PG8_SCHED;
        }
        if (wr == 0) PG8_BAR;
        E(acc, cur, wr, wc, fr, fq);
        if (!has_next) break;
#pragma unroll
        for (int a = 0; a < 2; ++a)
#pragma unroll
            for (int b = 0; b < 2; ++b)
#pragma unroll
                for (int m = 0; m < 4; ++m)
#pragma unroll
                    for (int n = 0; n < 2; ++n) acc[a][b][m][n] = (f32x4){0.f, 0.f, 0.f, 0.f};
        cur = nxt; cB = nB; cA = nA; ++ui;
        pC0 = pN0; pC1 = pN1;
        if (wr == 1) PG8_BAR;
    }
    PG8_WAIT_V(0);
    PG8_BAR;
#undef PG8_SA
#undef PG8_SB
#undef PG8_STAGE_A
#undef PG8_STAGE_B
#undef PG8_LDA
#undef PG8_LDB
#undef PG8_MMA
#undef PG8_WAIT_V
#undef PG8_WAIT_L
#undef PG8_BAR
#undef PG8_SCHED
#undef PG8_PACK
}

struct DenseOrder {
    static constexpr bool GATHER = false;
    int nM, nN, nwg, G, c; const char* Bt; int K;
    __device__ void init(int M, int N, int K_, const bf16_t* Bt_, int G_, int c_) { nM = M / BM; nN = N / BM; nwg = nM * nN; G = G_; c = c_; Bt = (const char*)Bt_; K = K_; }
    __device__ __forceinline__ bool next(int i, Unit& u) const {
        const long L = (long)i * G + c; if (L >= nwg) return false;
        int wgid = (int)L; { const int q = nwg / 8, r = nwg % 8, xcd = wgid % 8, off = wgid / 8; wgid = (xcd < r ? xcd * (q + 1) : r * (q + 1) + (xcd - r) * q) + off; }
        const int nig = 8 * nN, gid = wgid / nig, fm = gid * 8, gsz = (nM - fm) < 8 ? (nM - fm) : 8;
        u.pm = fm + ((wgid % nig) % gsz); u.pn = (wgid % nig) / gsz;
        u.arow0 = u.pm * BM; u.nrows = BM; u.e = 0; u.ui = i;
        u.bptr = Bt + (size_t)u.pn * BM * K * 2;
        return true;
    }
    __device__ __forceinline__ int arow(const Unit& u, int r) const { return u.arow0 + r; }
    __device__ __forceinline__ int lda(int K_) const { return K_; }
    __device__ __forceinline__ unsigned kstepA() const { return 128u; }
    __device__ __forceinline__ const char* abase(const Unit&, const char* A) const { return A; }
};
}

struct EpiH {
    static constexpr bool PERM = true;
    bf16_t* H;
    __device__ __forceinline__ void operator()(const f32x4 (&acc)[2][2][4][2], const pg8::Unit& u, int wr, int wc, int fr, int fq) const {
        const int row0 = u.arow0 + wr * 64 + fr, col0 = u.pn * 256 + wc * 32 + 8 * fq;
#pragma unroll
        for (int ai = 0; ai < 2; ++ai)
#pragma unroll
            for (int m = 0; m < 4; ++m) {
                bf16_t* rowp = H + (size_t)(row0 + ai * 128 + m * 16) * HLD + col0;
#pragma unroll
                for (int bj = 0; bj < 2; ++bj) {
                    const f32x4 v0 = acc[ai][bj][m][0], v1 = acc[ai][bj][m][1];
                    u32x4 w; w.x = pg8::cvt_pk_bf16(v0[0], v0[1]); w.y = pg8::cvt_pk_bf16(v0[2], v0[3]); w.z = pg8::cvt_pk_bf16(v1[0], v1[1]); w.w = pg8::cvt_pk_bf16(v1[2], v1[3]);
                    *(u32x4*)(rowp + bj * 128) = w;
                }
            }
    }
};
struct EpiRes {
    static constexpr bool PERM = false;
    const float* xin; float* out;
    __device__ __forceinline__ void operator()(const f32x4 (&acc)[2][2][4][2], const pg8::Unit& u, int wr, int wc, int fr, int fq) const {
        const int row0 = u.arow0 + wr * 64 + fr, col0 = u.pn * 256 + wc * 32 + 4 * fq;
#pragma unroll
        for (int ai = 0; ai < 2; ++ai)
#pragma unroll
            for (int m = 0; m < 4; ++m) {
                const size_t off = (size_t)(row0 + ai * 128 + m * 16) * DM + col0;
#pragma unroll
                for (int bj = 0; bj < 2; ++bj)
#pragma unroll
                    for (int n = 0; n < 2; ++n) {
                        const f32x4 xv = *(const f32x4*)(xin + off + bj * 128 + n * 16);
                        *(f32x4*)(out + off + bj * 128 + n * 16) = xv * ALPHA + acc[ai][bj][m][n];
                    }
            }
    }
};

template <class RM>
__device__ __forceinline__ void transpose_item(const float* W, int K, int N, bf16_t* WT, RM rowmap, float* scr, int kb, int nb, int lane) {
    const int k0 = 64 * kb, n0 = 32 * nb;
    const int nn = n0 + (lane & 31);
    float tmp[32];
#pragma unroll
    for (int i = 0; i < 32; ++i) {
        const int kk = 2 * i + (lane >> 5);
        tmp[i] = nn < N ? W[(size_t)(k0 + kk) * N + nn] : 0.f;
    }
#pragma unroll
    for (int i = 0; i < 32; ++i) {
        const int kk = 2 * i + (lane >> 5);
        scr[kk * 33 + (lane & 31)] = tmp[i];
    }
    wave_sync();
    const int c = lane & 7;
#pragma unroll
    for (int j = 0; j < 4; ++j) {
        const int n = (lane >> 3) + 8 * j;
        const float* s = scr + (8 * c) * 33 + n;
        u32x4 o; o.x = pk2(s[0 * 33], s[1 * 33]); o.y = pk2(s[2 * 33], s[3 * 33]); o.z = pk2(s[4 * 33], s[5 * 33]); o.w = pk2(s[6 * 33], s[7 * 33]);
        const int dr = (n0 + n < N) ? rowmap(n0 + n) : -1;
        if (dr >= 0) *(u32x4*)(WT + (size_t)dr * K + k0 + 8 * c) = o;
    }
    wave_sync();
}

__device__ void phase_prologue(KA ka, int layer, float* smem) {
    PHASE_IDS
    const int lane = TID & 63, w = TID >> 6;
    float* scr = smem + w * 4096;
    const int gw = BID * NW + w, NGW = gridDim.x * NW;
    constexpr int I_IN = 16 * 89, I_OUT = 16 * 32, I_GU = 16 * 16, I_DN = 8 * 32;
    constexpr int I_LAYER = I_IN + I_OUT + 32 * I_GU + 16 * I_DN;
    for (int it = gw; it < I_LAYER; it += NGW) {
        int r = it;
        bf16_t* WT = PF(WT);
        if (r < I_IN) {
            transpose_item(PF(w_in) + (size_t)layer * DM * IC_SRC, DM, IC_SRC, WT + WT_IN,
                           [](int n) { return n < 1792 ? n : (n < 1816 ? 2816 + (n - 1792) : n - 24); }, scr, r / 89, r % 89, lane);
            continue;
        }
        r -= I_IN;
        if (r < I_OUT) {
            transpose_item(PF(w_out) + (size_t)layer * DM * DM, DM, DM, WT + WT_OUT, [](int n) { return n; }, scr, r / 32, r % 32, lane);
            continue;
        }
        r -= I_OUT;
        if (r < 32 * I_GU) {
            const int mat = r / I_GU, rr = r % I_GU, e = mat >> 1, isup = mat & 1;
            const float* W = (isup ? PF(w_up) : PF(w_gate)) + ((size_t)layer * 16 + e) * DM * 512;
            transpose_item(W, DM, 512, WT + WT_UP + (size_t)e * 1024 * 1024,
                           [isup](int n) { return (n >> 7) * 256 + isup * 128 + (n & 127); }, scr, rr / 16, rr % 16, lane);
            continue;
        }
        r -= 32 * I_GU;
        {
            const int e = r / I_DN, rr = r % I_DN;
            transpose_item(PF(w_down) + ((size_t)layer * 16 + e) * 512 * DM, 512, DM, WT + WT_DN + (size_t)e * 1024 * 512,
                           [](int n) { return n; }, scr, rr / 32, rr % 32, lane);
        }
    }
    for (int it = gw; it < 2 * 32 * 4; it += NGW) {
        const int which = it >> 7, rr = it & 127;
        transpose_item(PF(cmp_w1) + ((size_t)layer * 2 + which) * 2048 * 128, 2048, 128, PF(WT) + WT_C1 + (size_t)which * 256 * 2048, [](int n) { return n; }, scr, rr >> 2, rr & 3, lane);
    }
    for (int i = BID * NTHR + TID; i < 2 * 128 * 256; i += gridDim.x * NTHR) {
        const int which = i >> 15, q = i & 32767;
        u32x4 z; z.x = 0u; z.y = 0u; z.z = 0u; z.w = 0u;
        *(u32x4*)(PF(WT) + WT_C1 + (size_t)which * 256 * 2048 + (size_t)128 * 2048 + (size_t)q * 8) = z;
    }
    for (int o = gw; o < 256; o += NGW) {
        const int which = o >> 7, cc = o & 127;
        const float* w1 = PF(cmp_w1) + ((size_t)layer * 2 + which) * 2048 * 128;
        const float* pos = PF(cmp_pos) + ((size_t)layer * 2 + which) * 2048;
        float a = 0.f;
        for (int k = lane; k < 2048; k += 64) a = fmaf(pos[k], w1[(size_t)k * 128 + cc], a);
        a = wave_sum(a);
        if (lane == 0) PF(cbias)[o] = a;
    }
    for (int i = BID * NTHR + TID; i < 4 * 128 * 128; i += gridDim.x * NTHR) {
        const int s = i & 127, t = (i >> 7) & 127;
        PF(WT)[WT_GM + i] = (s <= t) ? f2bf(PF(gm_w_s)[(size_t)layer * 4 * 128 * 128 + i]) : (bf16_t)0;
    }
    for (int i = BID * NTHR + TID; i < 232 * 128; i += gridDim.x * NTHR) {
        const int q = i;
        u32x4 z; z.x = 0u; z.y = 0u; z.z = 0u; z.w = 0u;
        *(u32x4*)(PF(WT) + WT_IN + (size_t)2840 * 1024 + (size_t)q * 8) = z;
    }
    if (layer == 0)
    for (int row = gw; row < NTOK; row += NGW) {
        const f32x4* xr = (const f32x4*)(PF(x) + (size_t)row * DM) + lane;
        u32x2* o = (u32x2*)(PF(XB) + (size_t)row * DM) + lane;
#pragma unroll
        for (int j = 0; j < 4; ++j) {
            const f32x4 v = xr[64 * j];
            u32x2 ww; ww.x = pk2(v[0], v[1]); ww.y = pk2(v[2], v[3]);
            o[64 * j] = ww;
        }
    }
}

template <class AF, class BF, class EF>
__device__ __forceinline__ void gemm128(int tid, int m0, int n0, int M, int N, int K, AF af, BF bf, EF ef, float* smem) {
    float* As = smem;
    float* Bs = smem + 16 * 132;
    const bool active = tid < 256;
    const int tx = tid & 15, ty = (tid >> 4) & 15;
    float acc[8][8];
#pragma unroll
    for (int i = 0; i < 8; i++)
#pragma unroll
        for (int j = 0; j < 8; j++) acc[i][j] = 0.f;
#pragma unroll 1
    for (int k0 = 0; k0 < K; k0 += 16) {
        if (active) {
#pragma unroll
            for (int i = 0; i < 8; i++) {
                int e = tid + i * 256;
                int r = e >> 4, kk = e & 15;
                float v = 0.f;
                if (m0 + r < M) v = af(m0 + r, k0 + kk);
                As[kk * 132 + r] = v;
            }
#pragma unroll
            for (int i = 0; i < 8; i++) {
                int e = tid + i * 256;
                int kk = e >> 7, c = e & 127;
                float v = 0.f;
                if (n0 + c < N) v = bf(k0 + kk, n0 + c);
                Bs[kk * 132 + c] = v;
            }
        }
        __syncthreads();
        if (active) {
#pragma unroll 2
            for (int kk = 0; kk < 16; kk++) {
                asm volatile("" ::: "memory");
                float4 a0 = *(const float4*)&As[kk * 132 + ty * 8];
                float4 a1 = *(const float4*)&As[kk * 132 + ty * 8 + 4];
                float4 b0 = *(const float4*)&Bs[kk * 132 + tx * 8];
                float4 b1 = *(const float4*)&Bs[kk * 132 + tx * 8 + 4];
                float a[8] = {a0.x, a0.y, a0.z, a0.w, a1.x, a1.y, a1.z, a1.w};
                float b[8] = {b0.x, b0.y, b0.z, b0.w, b1.x, b1.y, b1.z, b1.w};
#pragma unroll
                for (int i = 0; i < 8; i++)
#pragma unroll
                    for (int j = 0; j < 8; j++) acc[i][j] = fmaf(a[i], b[j], acc[i][j]);
            }
        }
        __syncthreads();
    }
    if (active) {
#pragma unroll
        for (int i = 0; i < 8; i++)
#pragma unroll
            for (int j = 0; j < 8; j++) {
                int m = m0 + ty * 8 + i, n = n0 + tx * 8 + j;
                if (m < M && n < N) ef(m, n, acc[i][j]);
            }
    }
}

__device__ __forceinline__ void phase_inproj(KA ka, int layer, LAS unsigned char* lds) {
    pg8::DenseOrder S; S.init(NTOK, HLD, DM, PF(WT) + WT_IN, gridDim.x, opaque_bid());
    EpiH E{PF(H)};
    pg8::gemm_phase<EpiH, pg8::DenseOrder>(lds, (const char*)PF(XB), DM, S, E);
}
__device__ __forceinline__ void phase_outproj(KA ka, int layer, const float* xin, float* x1, LAS unsigned char* lds) {
    pg8::DenseOrder S; S.init(NTOK, DM, DM, PF(WT) + WT_OUT, gridDim.x, opaque_bid());
    EpiRes E{xin, x1};
    pg8::gemm_phase<EpiRes, pg8::DenseOrder>(lds, (const char*)PF(Y), DM, S, E);
}

__device__ void phase_ln1_route(KA ka, int layer, float* x1, float* smem, bool dry) {
    PHASE_IDS
    bf16_t* xb = PF(XB);
    float* x1o = dry ? (float*)PF(H) : x1;
    const int lane = TID & 63, w = TID >> 6;
    const float* g = PF(ln1_g) + layer * 1024;
    const float* bb = PF(ln1_b) + layer * 1024;
    const float* wg = PF(rg_w) + (size_t)layer * 1024 * 4;
    const float* we = PF(re_w) + (size_t)layer * 1024 * 16;
    const float* bg = PF(rg_b) + layer * 4;
    const float* be = PF(re_b) + layer * 16;
    int* cnt = (int*)(PF(ctl) + CW_CNT) + layer * 16 * 64 + (dry ? 2048 : 0);
    int* lcnt = (int*)(smem + 20 * 1024);
    int* rinfo = lcnt + 64;
    float* rwt = (float*)(rinfo + 4 * 128);
    if (TID < 32) lcnt[TID] = 0;
    float* WR = smem;
    __syncthreads();
    for (int idx = TID; idx < 20 * 1024; idx += NTHR) { const int o = idx >> 10, c = idx & 1023; WR[idx] = o < 4 ? wg[c * 4 + o] : we[c * 16 + (o - 4)]; }
    __syncthreads();
    int nloc = 0;
    for (int row = BID * NW + w; row < NTOK; row += gridDim.x * NW) {
        f32x4 v[4];
        float s = 0.f;
#pragma unroll
        for (int j = 0; j < 4; ++j) { v[j] = *(const f32x4*)(x1 + (size_t)row * DM + 256 * j + 4 * lane); s += (v[j][0] + v[j][1]) + (v[j][2] + v[j][3]); }
        const float mu = wave_sum(s) * (1.f / 1024.f);
        float q = 0.f;
#pragma unroll
        for (int j = 0; j < 4; ++j) { v[j] = v[j] - mu; q += (v[j][0] * v[j][0] + v[j][1] * v[j][1]) + (v[j][2] * v[j][2] + v[j][3] * v[j][3]); }
        const float rstd = rsqrtf(wave_sum(q) * (1.f / 1024.f) + 1e-5f);
#pragma unroll
        for (int j = 0; j < 4; ++j) {
            const int c = 256 * j + 4 * lane;
            v[j] = v[j] * rstd * *(const f32x4*)(g + c) + *(const f32x4*)(bb + c);
            *(f32x4*)(x1o + (size_t)row * DM + c) = v[j];
            u32x2 pw; pw.x = pk2(v[j][0], v[j][1]); pw.y = pk2(v[j][2], v[j][3]);
            *(u32x2*)(xb + (size_t)row * DM + c) = pw;
        }
        float lg[4], le[16];
#pragma unroll
        for (int o = 0; o < 20; ++o) {
            asm volatile("" ::: "memory");
            float a = 0.f;
#pragma unroll
            for (int j = 0; j < 4; ++j) {
                const f32x4 w4 = *(const f32x4*)(WR + o * 1024 + 256 * j + 4 * lane);
                a += (v[j][0] * w4[0] + v[j][1] * w4[1]) + (v[j][2] * w4[2] + v[j][3] * w4[3]);
            }
            a = wave_sum(a);
            if (o < 4) lg[o] = a + bg[o]; else le[o - 4] = a + be[o - 4];
        }
        float gm = fmaxf(fmaxf(lg[0], lg[1]), fmaxf(lg[2], lg[3]));
        float ge[4], gs = 0.f;
#pragma unroll
        for (int c = 0; c < 4; c++) { ge[c] = __expf(lg[c] - gm); gs += ge[c]; }
        int gi = 0; float gbest = ge[0];
#pragma unroll
        for (int c = 1; c < 4; c++) if (ge[c] > gbest) { gbest = ge[c]; gi = c; }
        float gval = gbest / gs;
        float ls[4];
#pragma unroll
        for (int e = 0; e < 4; e++) ls[e] = gi == 0 ? le[e] : gi == 1 ? le[4 + e] : gi == 2 ? le[8 + e] : le[12 + e];
        float em = fmaxf(fmaxf(ls[0], ls[1]), fmaxf(ls[2], ls[3]));
        float pe[4];
#pragma unroll
        for (int e = 0; e < 4; e++) pe[e] = __expf(ls[e] - em);
        int i1 = 0; float b1 = pe[0];
#pragma unroll
        for (int e = 1; e < 4; e++) if (pe[e] > b1) { b1 = pe[e]; i1 = e; }
        int i2 = -1; float b2 = -1.f;
#pragma unroll
        for (int e = 0; e < 4; e++) if (e != i1 && pe[e] > b2) { b2 = pe[e]; i2 = e; }
        float w1 = gval * b1 / (b1 + b2), w2 = gval * b2 / (b1 + b2);
        if (lane == 0) {
            const int e1 = gi * 4 + i1, e2 = gi * 4 + i2;
            const int lr = nloc * NW + w;
            rinfo[lr * 4 + 0] = e1; rinfo[lr * 4 + 1] = atomicAdd(&lcnt[e1], 1);
            rinfo[lr * 4 + 2] = e2; rinfo[lr * 4 + 3] = atomicAdd(&lcnt[e2], 1);
            rwt[lr * 2 + 0] = w1; rwt[lr * 2 + 1] = w2;
        }
        ++nloc;
    }
    __syncthreads();
    if (TID < 16) lcnt[16 + TID] = lcnt[TID] > 0 ? atomicAdd(&cnt[TID * 64], lcnt[TID]) : 0;
    __syncthreads();
    {
        const int nrows_blk = (NTOK - BID * NW + (int)gridDim.x * NW - 1) / ((int)gridDim.x * NW) * NW;
        for (int lr = TID; lr < nrows_blk; lr += NTHR) {
            const int row = BID * NW + (lr % NW) + (lr / NW) * (int)gridDim.x * NW;
            if (row < NTOK) {
                const int e1 = rinfo[lr * 4 + 0], p1 = lcnt[16 + e1] + rinfo[lr * 4 + 1];
                const int e2 = rinfo[lr * 4 + 2], p2 = lcnt[16 + e2] + rinfo[lr * 4 + 3];
                PF(list_tok)[e1 * NTOK + p1] = row; PF(list_w)[e1 * NTOK + p1] = rwt[lr * 2 + 0];
                PF(list_tok)[e2 * NTOK + p2] = row; PF(list_w)[e2 * NTOK + p2] = rwt[lr * 2 + 1];
                PF(tok_slot)[row * 2 + 0] = e1 * NTOK + p1; PF(tok_slot)[row * 2 + 1] = e2 * NTOK + p2;
            }
        }
    }
    __syncthreads();
}


template <bool GATHER_>
struct MoeOrder {
    static constexpr bool GATHER = GATHER_;
    const LAS int* tab; const LAS int* rowtab;
    const char* Bt; unsigned estride; int K, G, c;
    __device__ __forceinline__ bool next(int i, pg8::Unit& u) const {
        const int nwg = __builtin_amdgcn_readfirstlane(tab[48]) * 4;
        const int L = i * G + c; if (L >= nwg) return false;
        int wgid = L; { const int q = nwg / 8, r = nwg % 8, xcd = wgid % 8, off = wgid / 8; wgid = (xcd < r ? xcd * (q + 1) : r * (q + 1) + (xcd - r) * q) + off; }
        const int mg = wgid >> 2, nt = wgid & 3;
        int e = 0;
#pragma unroll
        for (int k = 1; k < 16; ++k) e = (__builtin_amdgcn_readfirstlane(tab[32 + k]) <= mg) ? k : e;
        const int mt = mg - __builtin_amdgcn_readfirstlane(tab[32 + e]);
        const int rem = __builtin_amdgcn_readfirstlane(tab[e]) - mt * 256;
        u.e = e; u.pm = mt; u.pn = nt; u.ui = i; u.nrows = rem < 256 ? rem : 256; u.arow0 = __builtin_amdgcn_readfirstlane(tab[16 + e]) + mt * 256;
        u.bptr = Bt + (size_t)e * estride + (size_t)nt * 256 * K * 2;
        return true;
    }
    __device__ __forceinline__ int arow(const pg8::Unit& u, int r) const { return GATHER_ ? rowtab[u.ui * 256 + r] : u.arow0 + r; }
    __device__ __forceinline__ int lda(int K_) const { return K_; }
    __device__ __forceinline__ unsigned kstepA() const { return 128u; }
    __device__ __forceinline__ const char* abase(const pg8::Unit&, const char* A) const { return A; }
};
__device__ __forceinline__ void moe_tables(KA ka, int layer, LAS unsigned char* lds, bool want_rows, int G, int c) {
    LAS int* tab = (LAS int*)(lds + LDS_MISC + 256);
    LAS int* rowtab = (LAS int*)(lds + LDS_MISC + 1024);
    const int tid = opaque_tid();
    const int* cnt = (const int*)(PF(ctl) + CW_CNT) + layer * 16 * 64;
    if (tid < 16) tab[tid] = __hip_atomic_load(&cnt[tid * 64], __ATOMIC_RELAXED, __HIP_MEMORY_SCOPE_AGENT);
    __syncthreads();
    if (tid == 0) {
        int b = 0, m = 0;
        for (int e = 0; e < 16; ++e) { tab[16 + e] = b; tab[32 + e] = m; b += tab[e]; m += (tab[e] + 255) >> 8; }
        tab[48] = m;
    }
    __syncthreads();
    if (want_rows) {
        MoeOrder<true> S{tab, rowtab, nullptr, 0u, 1024, G, c};
        const int* lt = PF(list_tok);
        for (int i = 0; i < 4; ++i) {
            pg8::Unit u;
            if (!S.next(i, u)) break;
            if (tid < 256) { const int r = tid < u.nrows ? tid : u.nrows - 1; rowtab[i * 256 + tid] = lt[u.e * NTOK + u.pm * 256 + r]; }
        }
        asm volatile("s_waitcnt vmcnt(0) lgkmcnt(0)" ::: "memory");
        __syncthreads();
    }
}
struct EpiUp {
    static constexpr bool PERM = true;
    bf16_t* hidden;
    __device__ __forceinline__ void operator()(const f32x4 (&acc)[2][2][4][2], const pg8::Unit& u, int wr, int wc, int fr, int fq) const {
#pragma unroll
        for (int ai = 0; ai < 2; ++ai)
#pragma unroll
            for (int m = 0; m < 4; ++m) {
                const int r = ai * 128 + wr * 64 + m * 16 + fr;
                if (r < u.nrows) {
                    bf16_t* rowp = hidden + (size_t)(u.arow0 + r) * 512 + u.pn * 128 + wc * 32 + 8 * fq;
                    float h[8];
#pragma unroll
                    for (int n = 0; n < 2; ++n)
#pragma unroll
                        for (int j = 0; j < 4; ++j) { const float g = acc[ai][0][m][n][j], uu = acc[ai][1][m][n][j]; h[n * 4 + j] = g * sigmoidf_(g) * uu; }
                    u32x4 w; w.x = pg8::cvt_pk_bf16(h[0], h[1]); w.y = pg8::cvt_pk_bf16(h[2], h[3]); w.z = pg8::cvt_pk_bf16(h[4], h[5]); w.w = pg8::cvt_pk_bf16(h[6], h[7]);
                    *(u32x4*)rowp = w;
                }
            }
    }
};
struct EpiDown {
    static constexpr bool PERM = true;
    bf16_t* Y2; const float* lw;
    __device__ __forceinline__ void operator()(const f32x4 (&acc)[2][2][4][2], const pg8::Unit& u, int wr, int wc, int fr, int fq) const {
#pragma unroll
        for (int ai = 0; ai < 2; ++ai)
#pragma unroll
            for (int m = 0; m < 4; ++m) {
                const int r = ai * 128 + wr * 64 + m * 16 + fr;
                if (r < u.nrows) {
                    const float wgt = lw[u.e * NTOK + u.pm * 256 + r];
                    bf16_t* rowp = Y2 + (size_t)(u.arow0 + r) * DM + u.pn * 256 + wc * 32 + 8 * fq;
#pragma unroll
                    for (int bj = 0; bj < 2; ++bj) {
                        const f32x4 v0 = acc[ai][bj][m][0] * wgt, v1 = acc[ai][bj][m][1] * wgt;
                        u32x4 w; w.x = pg8::cvt_pk_bf16(v0[0], v0[1]); w.y = pg8::cvt_pk_bf16(v0[2], v0[3]); w.z = pg8::cvt_pk_bf16(v1[0], v1[1]); w.w = pg8::cvt_pk_bf16(v1[2], v1[3]);
                        *(u32x4*)(rowp + bj * 128) = w;
                    }
                }
            }
    }
};
__device__ __forceinline__ void phase_moe_up(KA ka, int layer, LAS unsigned char* lds) {
    moe_tables(ka, layer, lds, true, gridDim.x, opaque_bid());
    MoeOrder<true> S{(const LAS int*)(lds + LDS_MISC + 256), (const LAS int*)(lds + LDS_MISC + 1024),
                     (const char*)(PF(WT) + WT_UP), (unsigned)(1024u * 1024u * 2u), 1024, (int)gridDim.x, opaque_bid()};
    EpiUp E{PF(Y)};
    pg8::gemm_phase<EpiUp, MoeOrder<true>>(lds, (const char*)PF(XB), 1024, S, E);
}
__device__ __forceinline__ void phase_moe_down(KA ka, int layer, LAS unsigned char* lds) {
    moe_tables(ka, layer, lds, false, gridDim.x, opaque_bid());
    MoeOrder<false> S{(const LAS int*)(lds + LDS_MISC + 256), (const LAS int*)(lds + LDS_MISC + 1024),
                      (const char*)(PF(WT) + WT_DN), (unsigned)(1024u * 512u * 2u), 512, (int)gridDim.x, opaque_bid()};
    EpiDown E{PF(H), PF(list_w)};
    pg8::gemm_phase<EpiDown, MoeOrder<false>>(lds, (const char*)PF(Y), 512, S, E);
}

__device__ void phase_ln2(KA ka, int layer, const float* x1, float* xo) {
    PHASE_IDS
    bf16_t* xb = PF(XB);
    const bf16_t* Y2 = PF(H);
    const int lane = TID & 63, w = TID >> 6;
    const float* g = PF(ln2_g) + layer * 1024;
    const float* bb = PF(ln2_b) + layer * 1024;
    const int* cnt = (const int*)(PF(ctl) + CW_CNT) + layer * 16 * 64;
    int mybase = 0;
    {
        int cv = lane < 16 ? __hip_atomic_load(&cnt[(lane & 15) * 64], __ATOMIC_RELAXED, __HIP_MEMORY_SCOPE_AGENT) : 0;
        int incl = cv;
#pragma unroll
        for (int o = 1; o < 16; o <<= 1) { int t = __shfl_up(incl, o); if ((lane & 15) >= o) incl += t; }
        mybase = incl - cv;
    }
    for (int row = BID * NW + w; row < NTOK; row += gridDim.x * NW) {
        const int ts1 = PF(tok_slot)[row * 2 + 0], ts2 = PF(tok_slot)[row * 2 + 1];
        const int s1 = __shfl(mybase, ts1 >> 14) + (ts1 & (NTOK - 1)), s2 = __shfl(mybase, ts2 >> 14) + (ts2 & (NTOK - 1));
        f32x4 v[4];
        float s = 0.f;
#pragma unroll
        for (int j = 0; j < 4; ++j) {
            const int c = 256 * j + 4 * lane;
            const f32x4 xv = *(const f32x4*)(x1 + (size_t)row * DM + c);
            const u32x2 ya = *(const u32x2*)(Y2 + (size_t)s1 * DM + c), yb = *(const u32x2*)(Y2 + (size_t)s2 * DM + c);
            f32x4 t;
            t[0] = __uint_as_float(ya.x << 16) + __uint_as_float(yb.x << 16); t[1] = __uint_as_float(ya.x & 0xffff0000u) + __uint_as_float(yb.x & 0xffff0000u);
            t[2] = __uint_as_float(ya.y << 16) + __uint_as_float(yb.y << 16); t[3] = __uint_as_float(ya.y & 0xffff0000u) + __uint_as_float(yb.y & 0xffff0000u);
            v[j] = xv * ALPHA + t;
            s += (v[j][0] + v[j][1]) + (v[j][2] + v[j][3]);
        }
        const float mu = wave_sum(s) * (1.f / 1024.f);
        float q = 0.f;
#pragma unroll
        for (int j = 0; j < 4; ++j) { v[j] = v[j] - mu; q += (v[j][0] * v[j][0] + v[j][1] * v[j][1]) + (v[j][2] * v[j][2] + v[j][3] * v[j][3]); }
        const float rstd = rsqrtf(wave_sum(q) * (1.f / 1024.f) + 1e-5f);
#pragma unroll
        for (int j = 0; j < 4; ++j) {
            const int c = 256 * j + 4 * lane;
            const f32x4 o = v[j] * rstd * *(const f32x4*)(g + c) + *(const f32x4*)(bb + c);
            *(f32x4*)(xo + (size_t)row * DM + c) = o;
            u32x2 pw; pw.x = pk2(o[0], o[1]); pw.y = pk2(o[2], o[3]);
            *(u32x2*)(xb + (size_t)row * DM + c) = pw;
        }
    }
}

#define MFMA16(a, b, c) __builtin_amdgcn_mfma_f32_16x16x32_bf16((a), (b), (c), 0, 0, 0)
constexpr int NSA_KT = 0, NSA_VT = 16384, NSA_IMP = 32768, NSA_FIN = 65536, NSA_SEL = LDS_MISC + 8192;

__device__ __forceinline__ int tile_off(int r, int c) { return r * 128 + ((c ^ ((r >> 1) & 7)) << 4); }

__device__ __forceinline__ unsigned cvtpk(float lo, float hi) { unsigned r; asm("v_cvt_pk_bf16_f32 %0, %1, %2" : "=v"(r) : "v"(lo), "v"(hi)); return r; }
struct SelMask { unsigned a, b, c, d; };
__device__ __forceinline__ unsigned selbit(unsigned a, unsigned b, unsigned c, unsigned d, int j) {
    const int k = j >> 5;
    const unsigned lo = (k & 1) ? b : a, hi = (k & 1) ? d : c;
    const unsigned r = (k & 2) ? hi : lo;
    return (r >> (j & 31)) & 1u;
}

struct NsaRT {
    bf16x8 q[2];
    f32x4 o[4];
    float m, l;
    int tk;
};

template <int MODE, int NST>
__device__ __forceinline__ void nsa_loop(LAS unsigned char* lds, int tid, int lane, int w, int jb, int je,
                                         const char* ksrc, size_t kstride, size_t ktile, const char* vsrc, size_t vstride, size_t vtile,
                                         NsaRT (&R)[2], const SelMask selm0, const SelMask selm1, float (&carry)[2], float* impw) {
    const int g = lane >> 4, qr = lane & 15;
    int tid2 = tid; asm volatile("" : "+v"(tid2));
    const int sr = tid2 >> 3, sc = (tid2 & 7) ^ ((sr >> 1) & 7);
    const char* kp = ksrc + (size_t)sr * kstride + sc * 16;
    const char* vp = vsrc + (size_t)sr * vstride + sc * 16;
    const unsigned ldsw = (unsigned)w * 1024u;
    const int fxq = (qr >> 1) & 7;
    const int ka0 = qr * 128 + ((g ^ fxq) << 4), ka1 = qr * 128 + (((4 + g) ^ fxq) << 4);
    const int vb = qr * 128 + (g & 1) * 8, vc = (g >> 1) ^ fxq;
    const int va0 = vb + (vc << 4), va1 = vb + ((vc ^ 2) << 4), va2 = vb + ((vc ^ 4) << 4), va3 = vb + ((vc ^ 6) << 4);
    if (jb > je) return;
    constexpr int D = NST - 1;
#define NSA_ISSUE(jj, st) do { const int jc_ = (jj) < je ? (jj) : je; \
        __builtin_amdgcn_global_load_lds((const unsigned*)(kp + (size_t)jc_ * ktile), (LAS unsigned*)(lds + (st) * 16384 + ldsw), 16, 0, 0); \
        if (MODE != 0) __builtin_amdgcn_global_load_lds((const unsigned*)(vp + (size_t)jc_ * vtile), (LAS unsigned*)(lds + (st) * 16384 + 8192 + ldsw), 16, 0, 0); } while (0)
#define NSA_WAIT_TILE() do { if (NST == 2) asm volatile("s_waitcnt vmcnt(0) lgkmcnt(0)" ::: "memory"); else asm volatile("s_waitcnt vmcnt(4) lgkmcnt(0)" ::: "memory"); } while (0)
#pragma unroll
    for (int d = 0; d < D; ++d) NSA_ISSUE(jb + d, d);
    NSA_WAIT_TILE();
    __builtin_amdgcn_s_barrier();
    for (int j = jb; j <= je; ++j) {
        const int cur = (j - jb) & (NST - 1);
        NSA_ISSUE(j + D, (j - jb + D) & (NST - 1));
        const LAS unsigned char* kt = lds + cur * 16384;
        const LAS unsigned char* vt = lds + cur * 16384 + 8192;
        bool anyact;
        {
            bool a = false;
#pragma unroll
            for (int rt = 0; rt < 2; ++rt) {
                const int tk = R[rt].tk;
                if (MODE <= 1) { const int nv = tk >= 31 ? ((tk - 31) >> 4) + 1 : 0; a = a || (nv > 64 * j); }
                else if (MODE == 2) a = a || ((rt == 0 ? selbit(selm0.a, selm0.b, selm0.c, selm0.d, j) : selbit(selm1.a, selm1.b, selm1.c, selm1.d, j)) != 0u);
                else a = a || ((64 * j <= tk) && (64 * j + 63 > tk - 512));
            }
            anyact = __any(a);
        }
        if (anyact) {
            f32x4 s[2][4];
#pragma unroll
            for (int t = 0; t < 4; ++t) {
                const bf16x8 k0 = *(const LAS bf16x8*)(kt + ka0 + t * 2048), k1 = *(const LAS bf16x8*)(kt + ka1 + t * 2048);
#pragma unroll
                for (int rt = 0; rt < 2; ++rt) {
                    s[rt][t] = (f32x4){0.f, 0.f, 0.f, 0.f};
                    s[rt][t] = MFMA16(k0, R[rt].q[0], s[rt][t]);
                    s[rt][t] = MFMA16(k1, R[rt].q[1], s[rt][t]);
                }
            }
            const int kb = 64 * j + 4 * g;
            bf16x8 pf[2][2];
            if (MODE == 1) {
#pragma unroll
                for (int rt = 0; rt < 2; ++rt) {
                    const int tk = R[rt].tk;
                    const int nv = tk >= 31 ? ((tk - 31) >> 4) + 1 : 0;
                    const float mL = R[rt].m * 1.44269504f, invl = R[rt].l > 0.f ? 1.f / R[rt].l : 0.f;
                    float p[4][4];
#pragma unroll
                    for (int t = 0; t < 4; ++t)
#pragma unroll
                        for (int i = 0; i < 4; ++i) { const int key = kb + 16 * t + i; p[t][i] = (key < nv) ? __builtin_amdgcn_exp2f(fmaf(s[rt][t][i], 1.44269504f, -mL)) * invl : 0.f; }
#pragma unroll
                    for (int t = 0; t < 4; ++t) {
                        const float own = (p[t][0] + p[t][1]) + (p[t][2] + p[t][3]);
                        const float x3 = p[t][3];
                        const float up_cur = __shfl(x3, (lane + 48) & 63);
                        const float up_prev = __shfl(carry[rt], (lane + 48) & 63);
                        float v = own + (g >= 1 ? up_cur : up_prev);
                        v += __shfl_xor(v, 1);
                        v += __shfl_xor(v, 2);
                        carry[rt] = x3;
                        if ((qr & 3) == 0) impw[(4 * rt + (qr >> 2)) * 128 + 16 * j + 4 * t + g] = v;
                    }
#pragma unroll
                    for (int ks = 0; ks < 2; ++ks) {
                        u32x4 pu; pu.x = cvtpk(p[2 * ks][0], p[2 * ks][1]); pu.y = cvtpk(p[2 * ks][2], p[2 * ks][3]); pu.z = cvtpk(p[2 * ks + 1][0], p[2 * ks + 1][1]); pu.w = cvtpk(p[2 * ks + 1][2], p[2 * ks + 1][3]);
                        pf[rt][ks] = __builtin_bit_cast(bf16x8, pu);
                    }
                }
            } else {
                int lim_hi[2], lim_lo[2];
                bool none[2], part[2];
#pragma unroll
                for (int rt = 0; rt < 2; ++rt) {
                    const int tk = R[rt].tk;
                    if (MODE == 0) { const int nv = tk >= 31 ? ((tk - 31) >> 4) + 1 : 0; lim_hi[rt] = nv - 1; lim_lo[rt] = -1; }
                    else if (MODE == 2) { lim_hi[rt] = ((rt == 0 ? selbit(selm0.a, selm0.b, selm0.c, selm0.d, j) : selbit(selm1.a, selm1.b, selm1.c, selm1.d, j)) != 0u) ? tk : -1; lim_lo[rt] = -1; }
                    else { lim_hi[rt] = tk; lim_lo[rt] = tk - 512; }
                    const bool full = (64 * j + 63 <= lim_hi[rt]) && (64 * j > lim_lo[rt]);
                    none[rt] = (64 * j > lim_hi[rt]) || (64 * j + 63 <= lim_lo[rt]);
                    part[rt] = !full && !none[rt];
                }
                float lmx[2];
                if (__any(part[0] || part[1])) {
#pragma unroll
                    for (int rt = 0; rt < 2; ++rt) {
                        float mx = NEG_INF;
#pragma unroll
                        for (int t = 0; t < 4; ++t)
#pragma unroll
                            for (int i = 0; i < 4; ++i) {
                                const int key = kb + 16 * t + i;
                                const bool ok = (key <= lim_hi[rt]) && (key > lim_lo[rt]);
                                s[rt][t][i] = ok ? s[rt][t][i] : NEG_INF;
                                mx = fmaxf(mx, s[rt][t][i]);
                            }
                        lmx[rt] = mx;
                        none[rt] = false;
                    }
                } else {
#pragma unroll
                    for (int rt = 0; rt < 2; ++rt) {
                        float mx = NEG_INF;
#pragma unroll
                        for (int t = 0; t < 4; ++t)
#pragma unroll
                            for (int i = 0; i < 4; ++i) mx = fmaxf(mx, s[rt][t][i]);
                        lmx[rt] = none[rt] ? NEG_INF : mx;
                    }
                }
                if (__any((lmx[0] > R[0].m + 6.f) || (lmx[1] > R[1].m + 6.f))) {
#pragma unroll
                    for (int rt = 0; rt < 2; ++rt) {
                        float mx = lmx[rt];
                        mx = fmaxf(mx, __shfl_xor(mx, 16));
                        mx = fmaxf(mx, __shfl_xor(mx, 32));
                        const float mn = fmaxf(R[rt].m, mx);
                        const float alpha = __expf(R[rt].m - mn);
                        R[rt].l *= alpha; R[rt].m = mn;
                        if (MODE != 0) {
#pragma unroll
                            for (int dt = 0; dt < 4; ++dt) R[rt].o[dt] = R[rt].o[dt] * alpha;
                        }
                    }
                }
#pragma unroll
                for (int rt = 0; rt < 2; ++rt) {
                    const float negmL = none[rt] ? -1e30f : -fmaxf(R[rt].m, -1e4f) * 1.44269504f;
                    float p[4][4];
                    float rs = 0.f;
#pragma unroll
                    for (int t = 0; t < 4; ++t)
#pragma unroll
                        for (int i = 0; i < 4; ++i) { p[t][i] = __builtin_amdgcn_exp2f(fmaf(s[rt][t][i], 1.44269504f, negmL)); rs += p[t][i]; }
                    R[rt].l += rs;
                    if (MODE != 0) {
#pragma unroll
                        for (int ks = 0; ks < 2; ++ks) {
                            u32x4 pu; pu.x = cvtpk(p[2 * ks][0], p[2 * ks][1]); pu.y = cvtpk(p[2 * ks][2], p[2 * ks][3]); pu.z = cvtpk(p[2 * ks + 1][0], p[2 * ks + 1][1]); pu.w = cvtpk(p[2 * ks + 1][2], p[2 * ks + 1][3]);
                            pf[rt][ks] = __builtin_bit_cast(bf16x8, pu);
                        }
                    }
                }
            }
            if (MODE != 0) {
#pragma unroll
                for (int ks = 0; ks < 2; ++ks)
#pragma unroll
                    for (int dt = 0; dt < 4; ++dt) {
                        const u32x2 lo = *(const LAS u32x2*)(vt + (ks ? va2 : va0) + dt * 2048);
                        const u32x2 hi = *(const LAS u32x2*)(vt + (ks ? va3 : va1) + dt * 2048);
                        u32x4 vu; vu.x = lo.x; vu.y = lo.y; vu.z = hi.x; vu.w = hi.y;
                        const bf16x8 vf = __builtin_bit_cast(bf16x8, vu);
                        R[0].o[dt] = MFMA16(vf, pf[0][ks], R[0].o[dt]);
                        R[1].o[dt] = MFMA16(vf, pf[1][ks], R[1].o[dt]);
                    }
            }
        }
        NSA_WAIT_TILE();
        __builtin_amdgcn_s_barrier();
    }
    asm volatile("s_waitcnt vmcnt(0)" ::: "memory");
    __builtin_amdgcn_s_barrier();
#undef NSA_ISSUE
#undef NSA_WAIT_TILE
}

__device__ void phase_nsa2(KA ka, int layer, LAS unsigned char* lds) {
    PHASE_IDS
    const int tid = TID, lane = tid & 63, w = __builtin_amdgcn_readfirstlane(tid >> 6), g = lane >> 4, qr = lane & 15;
    const bf16_t* H = PF(H);
    const bf16_t* kcb = PF(kcb);
    const bf16_t* vcT = PF(vcT);
    const bf16_t* vsT = PF(vsT);
    const bf16_t* vwT = PF(vwT);
    bf16_t* Y = PF(Y);
    const float* gate_b = PF(nsa_gate_b) + layer * 24;
    const float* ogain = PF(out_gain) + layer * 1024;
    float* impw = (float*)(lds + NSA_IMP + w * 4096);
    unsigned* selw = (unsigned*)(lds + NSA_SEL + w * 128);
    for (int base = BID; base < 256; base += gridDim.x) {
#pragma unroll 1
        for (int half = 0; half < 2; ++half) {
            const int it = half ? 511 - base : base;
            const int chunk = it >> 2, bh = it & 3, b = bh >> 1, hk = bh & 1;
            const size_t rowbase = (size_t)b * T_;
            const int t0w = chunk * 64 + w * 8;
            NsaRT R[2];
            LAS f32x4* finw = (LAS f32x4*)(lds + NSA_FIN + w * 8192) + lane;
#pragma unroll
            for (int rt = 0; rt < 2; ++rt) {
                const int tk = t0w + 4 * rt + (qr >> 2), hh = hk * 4 + (qr & 3);
                R[rt].tk = tk;
                const bf16_t* qp = H + (rowbase + tk) * HLD + C_NQ + hh * 64 + 8 * g;
#pragma unroll
                for (int ks = 0; ks < 2; ++ks) {
                    const u32x4 u = *(const u32x4*)(qp + 32 * ks);
                    const unsigned uu[4] = {u.x, u.y, u.z, u.w};
                    u32x4 o4;
#pragma unroll
                    for (int e = 0; e < 4; ++e) {
                        const float f0 = __uint_as_float(uu[e] << 16) * 0.125f, f1 = __uint_as_float(uu[e] & 0xffff0000u) * 0.125f;
                        o4[e] = (__float_as_uint(f0) >> 16) | (__float_as_uint(f1) & 0xffff0000u);
                    }
                    R[rt].q[ks] = __builtin_bit_cast(bf16x8, o4);
                }
                R[rt].m = NEG_INF; R[rt].l = 0.f;
#pragma unroll
                for (int dt = 0; dt < 4; ++dt) R[rt].o[dt] = (f32x4){0.f, 0.f, 0.f, 0.f};
            }
            SelMask selm0{0u, 0u, 0u, 0u}, selm1{0u, 0u, 0u, 0u};
            float carry[2] = {0.f, 0.f};
            const int tmax = chunk * 64 + 63;
            const int nvmax = tmax >= 31 ? ((tmax - 31) >> 4) + 1 : 0;
            const int nb = (nvmax + 63) >> 6;
            const char* kc_src = (const char*)(kcb + (size_t)bh * 512 * 64);
            const char* vc_src = (const char*)(vcT + (size_t)bh * 64 * 512);
            nsa_loop<0, 2>(lds, tid, lane, w, 0, nb - 1, kc_src, 128, 64 * 128, nullptr, 0, 0, R, selm0, selm1, carry, impw);
#pragma unroll
            for (int rt = 0; rt < 2; ++rt) { float l = R[rt].l; l += __shfl_xor(l, 16); l += __shfl_xor(l, 32); R[rt].l = l; }
            for (int i = lane; i < 8 * 128; i += 64) impw[i] = 0.f;
            wave_sync();
            nsa_loop<1, 2>(lds, tid, lane, w, 0, nb - 1, kc_src, 128, 64 * 128, vc_src, 512 * 2, 64 * 2, R, selm0, selm1, carry, impw);
#pragma unroll
            for (int rt = 0; rt < 2; ++rt) {
                const int hh = hk * 4 + (qr & 3);
                const float gt = sigmoidf_(bf2f(H[(rowbase + R[rt].tk) * HLD + C_NG + hh * 3 + 0]) + gate_b[hh * 3 + 0]);
#pragma unroll
                for (int dt = 0; dt < 4; ++dt) { finw[(rt * 4 + dt) * 64] = R[rt].o[dt] * gt; R[rt].o[dt] = (f32x4){0.f, 0.f, 0.f, 0.f}; }
            }
            wave_sync();
            {
                const int tl = lane >> 3, sub = lane & 7;
                const int tks = t0w + tl, curb = tks >> 6;
                float v[16];
#pragma unroll
                for (int i = 0; i < 16; ++i) {
                    const int jj = sub * 16 + i;
                    const float a = impw[tl * 128 + jj];
                    const bool forced = (jj == 0) || (jj == curb) || (jj == curb - 1);
                    v[i] = (jj <= curb) ? (a + (forced ? 1e4f : 0.f)) : NEG_INF;
                }
                wave_sync();
#pragma unroll
                for (int i = 0; i < 16; ++i) impw[tl * 128 + sub * 16 + i] = v[i];
                wave_sync();
                int cnt[16];
#pragma unroll
                for (int i = 0; i < 16; ++i) cnt[i] = 0;
                for (int jj = 0; jj < 128; ++jj) {
                    const float x = impw[tl * 128 + jj];
#pragma unroll
                    for (int i = 0; i < 16; ++i) cnt[i] += (x > v[i]) || (x == v[i] && jj < sub * 16 + i);
                }
                unsigned bits = 0u;
#pragma unroll
                for (int i = 0; i < 16; ++i) bits |= ((cnt[i] < 16) && (v[i] > 0.5f * NEG_INF)) ? (1u << i) : 0u;
                const unsigned other = __shfl_xor(bits, 1);
                const unsigned word = (sub & 1) ? ((bits << 16) | other) : (bits | (other << 16));
                if ((sub & 1) == 0) selw[tl * 4 + (sub >> 1)] = word;
                wave_sync();
                { const unsigned* q0 = selw + (qr >> 2) * 4; selm0.a = q0[0]; selm0.b = q0[1]; selm0.c = q0[2]; selm0.d = q0[3];
                  selm1.a = q0[16]; selm1.b = q0[17]; selm1.c = q0[18]; selm1.d = q0[19]; }
                wave_sync();
            }
#pragma unroll
            for (int rt = 0; rt < 2; ++rt) { R[rt].m = NEG_INF; R[rt].l = 0.f; }
            nsa_loop<2, 4>(lds, tid, lane, w, 0, chunk, (const char*)(H + rowbase * HLD + C_KS + hk * 64), (size_t)HLD * 2, (size_t)64 * HLD * 2,
                        (const char*)(vsT + (size_t)bh * 64 * T_), (size_t)T_ * 2, 64 * 2, R, selm0, selm1, carry, impw);
#pragma unroll
            for (int rt = 0; rt < 2; ++rt) {
                const int hh = hk * 4 + (qr & 3);
                const float gt = sigmoidf_(bf2f(H[(rowbase + R[rt].tk) * HLD + C_NG + hh * 3 + 1]) + gate_b[hh * 3 + 1]);
                float ltot = R[rt].l; ltot += __shfl_xor(ltot, 16); ltot += __shfl_xor(ltot, 32);
                const float sc = gt / ltot;
#pragma unroll
                for (int dt = 0; dt < 4; ++dt) { finw[(rt * 4 + dt) * 64] += R[rt].o[dt] * sc; R[rt].o[dt] = (f32x4){0.f, 0.f, 0.f, 0.f}; }
                R[rt].m = NEG_INF; R[rt].l = 0.f;
            }
            nsa_loop<3, 4>(lds, tid, lane, w, chunk >= 8 ? chunk - 8 : 0, chunk, (const char*)(H + rowbase * HLD + C_KW + hk * 64), (size_t)HLD * 2, (size_t)64 * HLD * 2,
                        (const char*)(vwT + (size_t)bh * 64 * T_), (size_t)T_ * 2, 64 * 2, R, selm0, selm1, carry, impw);
#pragma unroll
            for (int rt = 0; rt < 2; ++rt) {
                const int tk = R[rt].tk, hh = hk * 4 + (qr & 3);
                const float gt = sigmoidf_(bf2f(H[(rowbase + tk) * HLD + C_NG + hh * 3 + 2]) + gate_b[hh * 3 + 2]);
                float ltot = R[rt].l; ltot += __shfl_xor(ltot, 16); ltot += __shfl_xor(ltot, 32);
                const float sc = gt / ltot;
                bf16_t* yp = Y + (rowbase + tk) * DM + 256 + hh * 64 + 4 * g;
                f32x4 ov[4];
                float ss = 0.f;
#pragma unroll
                for (int dt = 0; dt < 4; ++dt) { ov[dt] = finw[(rt * 4 + dt) * 64] + R[rt].o[dt] * sc; ss += (ov[dt][0] * ov[dt][0] + ov[dt][1] * ov[dt][1]) + (ov[dt][2] * ov[dt][2] + ov[dt][3] * ov[dt][3]); }
                ss += __shfl_xor(ss, 16);
                ss += __shfl_xor(ss, 32);
                const float rn = rsqrtf(ss * (1.f / 64.f) + 1e-6f);
#pragma unroll
                for (int dt = 0; dt < 4; ++dt) {
                    const f32x4 o = ov[dt] * rn * *(const f32x4*)(ogain + 256 + hh * 64 + 16 * dt + 4 * g);
                    u32x2 wv; wv.x = pk2(o[0], o[1]); wv.y = pk2(o[2], o[3]);
                    *(u32x2*)(yp + 16 * dt) = wv;
                }
            }
        }
    }
}

__device__ void phase_vtrans(KA ka, float* smem) {
    PHASE_IDS
    const int lane = TID & 63, w = TID >> 6;
    bf16_t* scr = (bf16_t*)(smem + w * 4096);
    const bf16_t* H = PF(H);
    for (int it = BID * NW + w; it < 1024; it += gridDim.x * NW) {
        const int tt = it & 127, bh = (it >> 7) & 3, which = it >> 9;
        const int b = bh >> 1, hk = bh & 1;
        const size_t tok0 = (size_t)b * T_ + tt * 64;
        const int col = (which ? C_VW : C_VS) + hk * 64;
        bf16_t* dst = (which ? PF(vwT) : PF(vsT)) + (size_t)bh * 64 * T_ + tt * 64;
        wave_sync();
        for (int i = 0; i < 64; ++i) scr[lane * 66 + i] = H[(tok0 + i) * HLD + col + lane];
        wave_sync();
        for (int d = 0; d < 64; ++d) dst[(size_t)d * T_ + lane] = scr[d * 66 + lane];
    }
}

__device__ void phase_hgrnA(KA ka, int layer, LAS unsigned char* lds, int first, int nblk) {
    PHASE_IDS
    const int tid = TID, lane = tid & 63, w = __builtin_amdgcn_readfirstlane(tid >> 6), gq = lane >> 4, lc = lane & 15;
    float* Q = (float*)lds;
    float* K = Q + 64 * 68;
    float* Bc = K + 64 * 68;
    float* SEG = Bc + 64 * 68;
    LAS bf16_t* ATb = (LAS bf16_t*)(lds + 57344);
    LAS bf16_t* ItB = ATb + 64 * 72;
    LAS bf16_t* KtB = ItB + 64 * 72;
    const bf16_t* H = PF(H);
    const float* hgl = PF(hg_lower);
    float* hgU = PF(hgU); float* hgG = PF(hgG); bf16_t* hgQB = PF(hgQB); bf16_t* hgO = PF(hgO);
    if (BID < first) return;
    for (int item = BID - first; item < 1024; item += nblk) {
        const int c = item & 127, bh = item >> 7, h = bh & 3, b = bh >> 2;
        const size_t tok0 = (size_t)b * T_ + c * 64;
        __syncthreads();
#pragma unroll
        for (int i = 0; i < 8; ++i) {
            const int e = tid + i * NTHR, t = e >> 6, d = e & 63;
            float lb = 0.f;
            if (layer == 1) {
                const float h0 = hgl[h * 64 + d], h1 = hgl[256 + h * 64 + d];
                const float mx = fmaxf(h0, h1), e0 = expf(h0 - mx), e1 = expf(h1 - mx);
                lb = e1 / (e0 + e1);
            }
            const bf16_t* hp = H + (tok0 + t) * HLD + h * 64 + d;
            const float fl = bf2f(hp[C_HF]);
            const float sg = 1.f / (1.f + expf(-fl)), sgn = 1.f / (1.f + expf(fl));
            const float f = lb + (1.f - lb) * sg;
            Q[t * 68 + d] = bf2f(hp[C_HQ]);
            K[t * 68 + d] = (1.f - lb) * sgn;
            ItB[d * 72 + t] = hp[C_HI];
            Bc[t * 68 + d] = logf(fmaxf(f, 1e-38f));
        }
        __syncthreads();
        {
            const int d = lane, seg = w;
            float run = 0.f;
#pragma unroll
            for (int i = 0; i < 8; ++i) { run += Bc[(seg * 8 + i) * 68 + d]; Bc[(seg * 8 + i) * 68 + d] = run; }
            SEG[seg * 64 + d] = run;
            __syncthreads();
            float pre = 0.f;
            for (int s2 = 0; s2 < seg; ++s2) pre += SEG[s2 * 64 + d];
#pragma unroll
            for (int i = 0; i < 8; ++i) Bc[(seg * 8 + i) * 68 + d] += pre;
        }
        __syncthreads();
        {
            const int blk = tid >> 1, dh = tid & 1, tb = blk >> 4, sb = blk & 15;
            float acc[4][4];
#pragma unroll
            for (int i = 0; i < 4; ++i)
#pragma unroll
                for (int j = 0; j < 4; ++j) acc[i][j] = 0.f;
            if (sb <= tb) {
#pragma unroll 2
                for (int d0 = 32 * dh; d0 < 32 * dh + 32; d0 += 4) {
                    f32x4 qv[4], bt[4], kv[4], bsv[4];
#pragma unroll
                    for (int i = 0; i < 4; ++i) { qv[i] = *(const f32x4*)&Q[(4 * tb + i) * 68 + d0]; bt[i] = *(const f32x4*)&Bc[(4 * tb + i) * 68 + d0]; }
#pragma unroll
                    for (int j = 0; j < 4; ++j) { kv[j] = *(const f32x4*)&K[(4 * sb + j) * 68 + d0]; bsv[j] = *(const f32x4*)&Bc[(4 * sb + j) * 68 + d0]; }
#pragma unroll
                    for (int i = 0; i < 4; ++i)
#pragma unroll
                        for (int j = 0; j < 4; ++j)
#pragma unroll
                            for (int dd = 0; dd < 4; ++dd) acc[i][j] = fmaf(qv[i][dd] * kv[j][dd], __expf(fminf(bt[i][dd] - bsv[j][dd], 0.f)), acc[i][j]);
                }
            }
#pragma unroll
            for (int i = 0; i < 4; ++i)
#pragma unroll
                for (int j = 0; j < 4; ++j) { acc[i][j] += __shfl_xor(acc[i][j], 1); if (4 * sb + j > 4 * tb + i) acc[i][j] = 0.f; }
            if (dh == 0) {
#pragma unroll
                for (int i = 0; i < 4; ++i) {
                    u32x2 pw; pw.x = pk2(acc[i][0], acc[i][1]); pw.y = pk2(acc[i][2], acc[i][3]);
                    *(LAS u32x2*)(ATb + (4 * tb + i) * 72 + 4 * sb) = pw;
                }
            }
        }
#pragma unroll
        for (int i = 0; i < 8; ++i) {
            const int e = tid + i * NTHR, t = e >> 6, d = e & 63;
            const float bt = Bc[t * 68 + d];
            hgQB[(size_t)item * 4096 + e] = f2bf(Q[t * 68 + d] * __expf(bt));
            KtB[d * 72 + t] = f2bf(K[t * 68 + d] * __expf(Bc[63 * 68 + d] - bt));
        }
        if (tid < 64) hgG[(size_t)item * 64 + tid] = __expf(Bc[63 * 68 + tid]);
        __syncthreads();
#pragma unroll
        for (int q = 0; q < 4; ++q) {
            const int tile = w * 4 + q, isU = tile >> 4, rt_ = (tile >> 2) & 3, ct = tile & 3;
            const LAS bf16_t* Ab = (isU ? KtB : ATb) + (16 * rt_ + lc) * 72 + 8 * gq;
            const LAS bf16_t* Bb = ItB + (16 * ct + lc) * 72 + 8 * gq;
            f32x4 acc = (f32x4){0.f, 0.f, 0.f, 0.f};
            acc = MFMA16(*(const LAS bf16x8*)Ab, *(const LAS bf16x8*)Bb, acc);
            acc = MFMA16(*(const LAS bf16x8*)(Ab + 32), *(const LAS bf16x8*)(Bb + 32), acc);
#pragma unroll
            for (int i = 0; i < 4; ++i) {
                const int r = 16 * rt_ + 4 * gq + i, cc = 16 * ct + lc;
                if (isU) hgU[((size_t)item * 64 + r) * 64 + cc] = acc[i];
                else hgO[((size_t)item * 64 + r) * 64 + cc] = f2bf(acc[i]);
            }
        }
    }
}

__device__ void phase_hgrnB(KA ka) {
    PHASE_IDS
    const float* hgU = PF(hgU); const float* hgG = PF(hgG); float* hgS = PF(hgS);
    for (int gid = BID * NTHR + TID; gid < 32768; gid += gridDim.x * NTHR) {
        const int bh = gid >> 12, dv = gid & 4095, d = dv >> 6;
        float S = 0.f;
        for (int c0 = 0; c0 < 128; c0 += 8) {
            float u[8], gg[8];
#pragma unroll
            for (int k = 0; k < 8; ++k) { const size_t item = (size_t)bh * 128 + c0 + k; u[k] = hgU[item * 4096 + dv]; gg[k] = hgG[item * 64 + d]; }
#pragma unroll
            for (int k = 0; k < 8; ++k) { const size_t item = (size_t)bh * 128 + c0 + k; hgS[item * 4096 + dv] = S; S = fmaf(gg[k], S, u[k]); }
        }
    }
}

__device__ void phase_hgrnC(KA ka, int layer, LAS unsigned char* lds) {
    PHASE_IDS
    const int tid = TID, lane = tid & 63, w = __builtin_amdgcn_readfirstlane(tid >> 6), gq = lane >> 4, lc = lane & 15;
    LAS bf16_t* QBb = (LAS bf16_t*)lds;
    LAS bf16_t* StB = QBb + 64 * 72;
    float* OT = (float*)(lds + 32768);
    const bf16_t* H = PF(H);
    const float* hgS = PF(hgS); const bf16_t* hgQB = PF(hgQB); const bf16_t* hgO = PF(hgO);
    const float* og = PF(out_gain) + layer * 1024;
    bf16_t* Y = PF(Y);
    for (int item = BID; item < 1024; item += gridDim.x) {
        const int c = item & 127, bh = item >> 7, h = bh & 3, b = bh >> 2;
        const size_t tok0 = (size_t)b * T_ + c * 64;
        __syncthreads();
#pragma unroll
        for (int i = 0; i < 8; ++i) {
            const int e = tid + i * NTHR, r = e >> 6, cc = e & 63;
            QBb[r * 72 + cc] = hgQB[(size_t)item * 4096 + e];
            StB[cc * 72 + r] = f2bf(hgS[(size_t)item * 4096 + e]);
        }
        __syncthreads();
#pragma unroll
        for (int q = 0; q < 2; ++q) {
            const int tile = w * 2 + q, rt_ = tile >> 2, ct = tile & 3;
            const LAS bf16_t* Ab = QBb + (16 * rt_ + lc) * 72 + 8 * gq;
            const LAS bf16_t* Bb = StB + (16 * ct + lc) * 72 + 8 * gq;
            f32x4 acc = (f32x4){0.f, 0.f, 0.f, 0.f};
            acc = MFMA16(*(const LAS bf16x8*)Ab, *(const LAS bf16x8*)Bb, acc);
            acc = MFMA16(*(const LAS bf16x8*)(Ab + 32), *(const LAS bf16x8*)(Bb + 32), acc);
#pragma unroll
            for (int i = 0; i < 4; ++i) {
                const int t = 16 * rt_ + 4 * gq + i, v = 16 * ct + lc;
                OT[t * 65 + v] = acc[i] + bf2f(hgO[((size_t)item * 64 + t) * 64 + v]);
            }
        }
        __syncthreads();
#pragma unroll 1
        for (int i = 0; i < 8; ++i) {
            const int t = w + 8 * i, v = lane;
            const float acc = OT[t * 65 + v];
            const float ms = wave_sum(acc * acc) * (1.f / 64.f);
            const float hg = bf2f(H[(tok0 + t) * HLD + C_HG + h * 64 + v]);
            const float y = acc * rsqrtf(ms + 1e-6f) * og[768 + h * 64 + v] * (hg * sigmoidf_(hg));
            Y[(tok0 + t) * DM + 768 + h * 64 + v] = f2bf(y);
        }
    }
}

struct CmpOrder {
    static constexpr bool GATHER = false;
    const char* W1T; int c;
    __device__ __forceinline__ bool next(int i, pg8::Unit& u) const {
        if (i > 0 || c >= 16) return false;
        const int which = c >> 3, bh = (c >> 1) & 3, nt = c & 1;
        u.arow0 = (bh >> 1) * 512 + nt * 256; u.nrows = 256; u.pm = nt; u.pn = 0; u.e = which * 4 + bh; u.ui = 0;
        u.bptr = W1T + (size_t)which * 256 * 2048 * 2;
        return true;
    }
    __device__ __forceinline__ int arow(const pg8::Unit& u, int r) const { return u.arow0 + r; }
    __device__ __forceinline__ int lda(int) const { return 16 * HLD; }
    __device__ __forceinline__ unsigned kstepA() const { return (unsigned)(HLD * 2); }
    __device__ __forceinline__ const char* abase(const pg8::Unit& u, const char* A) const { return A + (((u.e >> 2) ? C_VC : C_KC) + (u.e & 1) * 64) * 2; }
};
struct EpiCmp {
    static constexpr bool PERM = true;
    bf16_t* G; const float* cbias;
    __device__ __forceinline__ void operator()(const f32x4 (&acc)[2][2][4][2], const pg8::Unit& u, int wr, int wc, int fr, int fq) const {
        const float* bp = cbias + (u.e >> 2) * 128 + wc * 32 + 8 * fq;
        const f32x4 b0 = *(const f32x4*)bp, b1 = *(const f32x4*)(bp + 4);
#pragma unroll
        for (int ai = 0; ai < 2; ++ai)
#pragma unroll
            for (int m = 0; m < 4; ++m) {
                const int r = ai * 128 + wr * 64 + m * 16 + fr;
                bf16_t* rowp = G + ((size_t)(u.e * 512 + u.pm * 256 + r)) * 128 + wc * 32 + 8 * fq;
                const f32x4 v0 = acc[ai][0][m][0] + b0, v1 = acc[ai][0][m][1] + b1;
                u32x4 w; w.x = pk2(gelu_t(v0[0]), gelu_t(v0[1])); w.y = pk2(gelu_t(v0[2]), gelu_t(v0[3])); w.z = pk2(gelu_t(v1[0]), gelu_t(v1[1])); w.w = pk2(gelu_t(v1[2]), gelu_t(v1[3]));
                *(u32x4*)rowp = w;
            }
    }
};
__device__ void phase_compress2(KA ka, int layer, LAS unsigned char* lds) {
    const int bid = opaque_bid();
    if (bid >= 16) return;
    CmpOrder S{(const char*)(PF(WT) + WT_C1), bid};
    EpiCmp E{PF(gb), PF(cbias)};
    pg8::gemm_phase<EpiCmp, CmpOrder>(lds, (const char*)PF(H), 2048, S, E);
    __syncthreads();
    const int tid = opaque_tid();
    const int which = bid >> 3, bh = (bid >> 1) & 3, nt = bid & 1;
    float* w2s = (float*)lds;
    const float* w2 = PF(cmp_w2) + ((size_t)layer * 2 + which) * 128 * 64;
    for (int i = tid; i < 128 * 64; i += NTHR) w2s[i] = w2[i];
    __syncthreads();
    const int r = tid >> 1, half = tid & 1;
    const bf16_t* grow = PF(gb) + ((size_t)((which * 4 + bh) * 512 + nt * 256 + r)) * 128;
    float acc[32];
#pragma unroll
    for (int j = 0; j < 32; ++j) acc[j] = 0.f;
    for (int c8 = 0; c8 < 16; ++c8) {
        const u32x4 gu = *(const u32x4*)(grow + c8 * 8);
        const unsigned gw[4] = {gu.x, gu.y, gu.z, gu.w};
#pragma unroll
        for (int e = 0; e < 8; ++e) {
            const float gv = (e & 1) ? __uint_as_float(gw[e >> 1] & 0xffff0000u) : __uint_as_float(gw[e >> 1] << 16);
            const float* wrow = w2s + (c8 * 8 + e) * 64 + half * 32;
#pragma unroll
            for (int j4 = 0; j4 < 8; ++j4) {
                const float4 w4 = *(const float4*)(wrow + j4 * 4);
                acc[j4 * 4 + 0] = fmaf(gv, w4.x, acc[j4 * 4 + 0]); acc[j4 * 4 + 1] = fmaf(gv, w4.y, acc[j4 * 4 + 1]);
                acc[j4 * 4 + 2] = fmaf(gv, w4.z, acc[j4 * 4 + 2]); acc[j4 * 4 + 3] = fmaf(gv, w4.w, acc[j4 * 4 + 3]);
            }
        }
    }
    const int n = nt * 256 + r;
    if (which == 0) {
        bf16_t* o = PF(kcb) + ((size_t)bh * 512 + n) * 64 + half * 32;
#pragma unroll
        for (int j = 0; j < 32; j += 2) *(unsigned*)(o + j) = pk2(acc[j], acc[j + 1]);
    } else {
        bf16_t* o = PF(vcT) + (size_t)bh * 64 * 512 + n;
#pragma unroll
        for (int j = 0; j < 32; ++j) o[(size_t)(half * 32 + j) * 512] = f2bf(acc[j]);
    }
    __syncthreads();
}

__device__ void phase_gmlp2(KA ka, int layer, LAS unsigned char* lds, int first, int nblk) {
    PHASE_IDS
    const int tid = TID, lane = tid & 63, w = __builtin_amdgcn_readfirstlane(tid >> 6), gq = lane >> 4, lc = lane & 15;
    LAS bf16_t* Vt = (LAS bf16_t*)lds;
    const float* gain = PF(gm_v_gain) + layer * 256;
    const float* bias = PF(gm_v_bias) + layer * 256;
    const float* bs = PF(gm_b_s) + layer * 4 * 128;
    const bf16_t* gmW = PF(WT) + WT_GM;
    const bf16_t* H = PF(H);
    bf16_t* Y = PF(Y);
    if (BID < first) return;
    for (int item = BID - first; item < 512; item += nblk) {
        const int g = item & 3, c = (item >> 2) & 63, b = item >> 8;
        const size_t tok0 = (size_t)b * T_ + (size_t)c * 128;
        __syncthreads();
        for (int i = 0; i < 16; ++i) {
            const int s = w * 16 + i;
            const float x = bf2f(H[(tok0 + s) * HLD + C_GV + g * 64 + lane]);
            const float ge = gelu_t(x);
            const float mu = wave_sum(ge) * (1.f / 64.f);
            const float dl = ge - mu;
            const float var = wave_sum(dl * dl) * (1.f / 64.f);
            Vt[lane * 136 + s] = f2bf(dl * rsqrtf(var + 1e-5f) * gain[g * 64 + lane] + bias[g * 64 + lane]);
        }
        __syncthreads();
        f32x4 acc[4];
#pragma unroll
        for (int ct = 0; ct < 4; ++ct) acc[ct] = (f32x4){0.f, 0.f, 0.f, 0.f};
        const bf16_t* wrow = gmW + ((size_t)g * 128 + 16 * w + lc) * 128 + 8 * gq;
        const int kmax = (16 * w + 15) >> 5;
        for (int ks = 0; ks <= kmax; ++ks) {
            const bf16x8 a = *(const bf16x8*)(wrow + 32 * ks);
#pragma unroll
            for (int ct = 0; ct < 4; ++ct) {
                const bf16x8 bfr = *(const LAS bf16x8*)(Vt + (16 * ct + lc) * 136 + 32 * ks + 8 * gq);
                acc[ct] = MFMA16(a, bfr, acc[ct]);
            }
        }
        const float* ogain = PF(out_gain) + layer * 1024;
#pragma unroll
        for (int i = 0; i < 4; ++i) {
            const int t = 16 * w + 4 * gq + i;
            float yv[4];
            float ss = 0.f;
#pragma unroll
            for (int ct = 0; ct < 4; ++ct) {
                const int d = 16 * ct + lc;
                const float z = acc[ct][i] + bs[g * 128 + t];
                const float u = gelu_t(bf2f(H[(tok0 + t) * HLD + C_GU + g * 64 + d]));
                yv[ct] = u * z;
                ss += yv[ct] * yv[ct];
            }
            ss += __shfl_xor(ss, 1); ss += __shfl_xor(ss, 2); ss += __shfl_xor(ss, 4); ss += __shfl_xor(ss, 8);
            const float rn = rsqrtf(ss * (1.f / 64.f) + 1e-6f);
#pragma unroll
            for (int ct = 0; ct < 4; ++ct) {
                const int d = 16 * ct + lc;
                Y[(tok0 + t) * DM + g * 64 + d] = f2bf(yv[ct] * rn * ogain[g * 64 + d]);
            }
        }
    }
}

#ifndef ONLY_Q
#define ONLY_Q -2
#endif
#ifndef QMASK
#define QMASK 0x3ff
#endif
#define QON(k) ((ONLY_Q == -2 && ((QMASK >> ((k) + 1)) & 1)) || ONLY_Q == (k))
#ifndef DUPMASK
#define DUPMASK 0
#endif
#define DUP(k) ((DUPMASK >> (k)) & 1)
#ifndef PROF_LO
#define PROF_LO -1
#endif
#ifndef PROF_HI
#define PROF_HI -1
#endif
#ifndef NPH_TOTAL
#define NPH_TOTAL 19
#endif
__global__ void __launch_bounds__(NTHR, 2) k_mega(P p0) {
    extern __shared__ __attribute__((aligned(16))) unsigned char lds_raw[];
    LAS unsigned char* lds = (LAS unsigned char*)lds_raw;
    float* smem = (float*)lds_raw;
    volatile LAS unsigned* misc = (volatile LAS unsigned*)(lds + LDS_MISC);
    if (threadIdx.x < 16) misc[threadIdx.x] = 0u;
    __syncthreads();
    XcdBarrier bar = xcd_barrier_post(p0.ctl + CW_BAR, misc);
    if (PROF_LO >= 0 && blockIdx.x == 0 && threadIdx.x == 0) ((unsigned long long*)(p0.ctl + 8192))[0] = __builtin_amdgcn_s_memrealtime();
#pragma unroll 1
    for (int ph = 0; ph < p0.nph; ph++) {
        const int layer = ph == 0 ? 0 : (ph - 1) / 9, q = ph == 0 ? -1 : (ph - 1) % 9;
        const int dupm = p0.pad;
#if defined(__HIP_DEVICE_COMPILE__)
        KA ka = (KA)__builtin_amdgcn_kernarg_segment_ptr();
        asm volatile("" : "+s"(ka));
#else
        KA ka = nullptr;
#endif
        const float* xin = layer == 0 ? PF(x) : PF(out);
        float* x1 = PF(out);
        if (q == -1 && QON(-1)) { for (int r = 0; r <= ((dupm >> 15) & 1); ++r) { phase_prologue(ka, 0, smem); __syncthreads(); } }
        else if (q == 0 && QON(0)) { for (int r = 0; r <= (dupm & 1); ++r) { phase_inproj(ka, layer, lds); __syncthreads(); } }
        else if (q == 1 && QON(1)) {
            const int nb1 = (int)gridDim.x > 32 ? 16 : 0, nwork = (int)gridDim.x - nb1;
            for (int r = 0; r <= ((dupm >> 12) & 1); ++r) { phase_compress2(ka, layer, lds); __syncthreads(); }
            for (int r = 0; r <= ((dupm >> 10) & 1); ++r) { phase_hgrnA(ka, layer, lds, nb1, nwork); __syncthreads(); }
            for (int r = 0; r <= ((dupm >> 11) & 1); ++r) { phase_gmlp2(ka, layer, lds, nb1, nwork); __syncthreads(); }
            for (int r = 0; r <= ((dupm >> 13) & 1); ++r) { phase_vtrans(ka, smem); __syncthreads(); }
        }
        else if (q == 2 && QON(2)) { for (int r = 0; r <= ((dupm >> 14) & 1); ++r) { phase_hgrnB(ka); __syncthreads(); } for (int r = 0; r <= ((dupm >> 2) & 1); ++r) { phase_nsa2(ka, layer, lds); __syncthreads(); } }
        else if (q == 3 && QON(3)) { for (int r = 0; r <= ((dupm >> 3) & 1); ++r) { phase_hgrnC(ka, layer, lds); __syncthreads(); } }
        else if (q == 4 && QON(4)) phase_outproj(ka, layer, xin, x1, lds);
        else if (q == 5 && QON(5)) { for (int r = ((dupm >> 5) & 1); r >= 0; --r) { phase_ln1_route(ka, layer, x1, smem, r == 1); __syncthreads(); } }
        else if (q == 6 && QON(6)) { for (int r = 0; r <= ((dupm >> 6) & 1); ++r) { phase_moe_up(ka, layer, lds); __syncthreads(); } }
        else if (q == 7 && QON(7)) { for (int r = 0; r <= ((dupm >> 7) & 1); ++r) { phase_moe_down(ka, layer, lds); __syncthreads(); } }
        else if (q == 8 && QON(8)) { phase_ln2(ka, layer, x1, PF(out)); if (layer == 0) { __syncthreads(); phase_prologue(ka, 1, smem); } }
        if (ph != NPH_TOTAL - 1 || PROF_LO >= 0) xcd_barrier(bar);
        if (PROF_LO >= 0 && blockIdx.x == 0 && threadIdx.x == 0) ((unsigned long long*)(p0.ctl + 8192))[ph + 1] = __builtin_amdgcn_s_memrealtime();
    }
    if (PROF_LO >= 0) {
        xcd_barrier(bar);
        const unsigned long long* ts = (const unsigned long long*)(p0.ctl + 8192);
        const unsigned long long t0 = __hip_atomic_load(&ts[PROF_LO], __ATOMIC_RELAXED, __HIP_MEMORY_SCOPE_AGENT), t1 = __hip_atomic_load(&ts[PROF_HI + 1], __ATOMIC_RELAXED, __HIP_MEMORY_SCOPE_AGENT);
        const float fac = 1.f + 1e-5f * (float)(t1 - t0);
        for (size_t i = (size_t)blockIdx.x * NTHR + threadIdx.x; i < (size_t)NTOK * DM; i += (size_t)gridDim.x * NTHR) p0.out[i] *= fac;
    }
}

static inline size_t align_up(size_t v, size_t a) { return (v + a - 1) / a * a; }

extern "C" void kernel_launch(void* const* d_in, const int* in_sizes, int n_in, void* d_out, int out_size, void* d_ws,
                              size_t ws_size, hipStream_t stream) {
    P p{};
    p.x = (const float*)d_in[0]; p.w_in = (const float*)d_in[1]; p.gm_v_gain = (const float*)d_in[2];
    p.gm_v_bias = (const float*)d_in[3]; p.gm_w_s = (const float*)d_in[4]; p.gm_b_s = (const float*)d_in[5];
    p.cmp_pos = (const float*)d_in[6]; p.cmp_w1 = (const float*)d_in[7]; p.cmp_w2 = (const float*)d_in[8];
    p.nsa_gate_b = (const float*)d_in[9]; p.hg_lower = (const float*)d_in[10]; p.out_gain = (const float*)d_in[11];
    p.w_out = (const float*)d_in[12]; p.ln1_g = (const float*)d_in[13]; p.ln1_b = (const float*)d_in[14];
    p.rg_w = (const float*)d_in[15]; p.rg_b = (const float*)d_in[16]; p.re_w = (const float*)d_in[17];
    p.re_b = (const float*)d_in[18]; p.w_gate = (const float*)d_in[19]; p.w_up = (const float*)d_in[20];
    p.w_down = (const float*)d_in[21]; p.ln2_g = (const float*)d_in[22]; p.ln2_b = (const float*)d_in[23];
    p.out = (float*)d_out;
    char* ws = (char*)d_ws;
    size_t off = 0;
    p.ctl = (unsigned*)(ws + off); off = align_up(off + CTL_BYTES, 256);
    p.WT = (bf16_t*)(ws + off); off = align_up(off + WT_LAYER * 2, 256);
    p.H = (bf16_t*)(ws + off); off = align_up(off + (size_t)NTOK * HLD * 2, 256);
    p.Y = (bf16_t*)(ws + off); off = align_up(off + (size_t)NTOK * DM * 2, 256);
    p.XB = (bf16_t*)(ws + off); off = align_up(off + (size_t)NTOK * DM * 2, 256);
    p.kcb = (bf16_t*)(ws + off); off = align_up(off + (size_t)4 * 512 * 64 * 2, 256);
    p.vcT = (bf16_t*)(ws + off); off = align_up(off + (size_t)4 * 64 * 512 * 2, 256);
    p.vsT = (bf16_t*)(ws + off); off = align_up(off + (size_t)4 * 64 * T_ * 2, 256);
    p.vwT = (bf16_t*)(ws + off); off = align_up(off + (size_t)4 * 64 * T_ * 2, 256);
    p.gb = (bf16_t*)(ws + off); off = align_up(off + (size_t)8 * 512 * 128 * 2, 256);
    p.cbias = (float*)(ws + off); off = align_up(off + 256 * 4, 256);
    p.list_tok = (int*)(ws + off); off = align_up(off + (size_t)16 * NTOK * 4, 256);
    p.list_w = (float*)(ws + off); off = align_up(off + (size_t)16 * NTOK * 4, 256);
    p.tok_slot = (int*)(ws + off); off = align_up(off + (size_t)NTOK * 2 * 4, 256);
    p.hgU = (float*)p.XB; p.hgS = p.hgU + (size_t)1024 * 4096;
    p.hgG = (float*)(ws + off); off = align_up(off + (size_t)1024 * 64 * 4, 256);
    p.hgQB = (bf16_t*)(ws + off); off = align_up(off + (size_t)1024 * 4096 * 2, 256);
    p.hgO = (bf16_t*)(ws + off); off = align_up(off + (size_t)1024 * 4096 * 2, 256);
    p.nph = NPH_TOTAL; p.pad = DUPMASK;
    (void)in_sizes; (void)n_in; (void)out_size;
    static int grid_blocks = 0;
    if (!grid_blocks) {
        int dev = 0, cus = 0, per_cu = 0;
        (void)hipGetDevice(&dev);
        (void)hipDeviceGetAttribute(&cus, hipDeviceAttributeMultiprocessorCount, dev);
        if (hipFuncSetAttribute((const void*)k_mega, hipFuncAttributeMaxDynamicSharedMemorySize, LDS_BYTES) != hipSuccess) { fprintf(stderr, "hipFuncSetAttribute failed\n"); grid_blocks = -1; return; }
        if (hipOccupancyMaxActiveBlocksPerMultiprocessor(&per_cu, (const void*)k_mega, NTHR, LDS_BYTES) != hipSuccess || per_cu < 1) { fprintf(stderr, "occupancy query says %d\n", per_cu); }
        (void)hipGetLastError();
        grid_blocks = cus;
        if (off > ws_size) { fprintf(stderr, "workspace too small: need %zu have %zu\n", off, ws_size); grid_blocks = -1; }
    }
    if (grid_blocks < 0) return;
    (void)hipMemsetAsync(p.ctl, 0, CTL_BYTES, stream);
    void* args[] = {&p};
    hipError_t e = hipLaunchCooperativeKernel((const void*)k_mega, dim3(grid_blocks), dim3(NTHR), args, LDS_BYTES, stream);
    if (e != hipSuccess) fprintf(stderr, "cooperative launch failed: %s (grid %d)\n", hipGetErrorString(e), grid_blocks);
}
```

```cpp
#include <hip/hip_runtime.h>
#include <cstdio>
#include <cstdint>

#define LAS __attribute__((address_space(3)))
typedef unsigned short bf16_t;
typedef short bf16x8 __attribute__((ext_vector_type(8)));
typedef float f32x4 __attribute__((ext_vector_type(4)));
typedef float f32x2 __attribute__((ext_vector_type(2)));
typedef unsigned u32x4 __attribute__((ext_vector_type(4)));
typedef unsigned u32x2 __attribute__((ext_vector_type(2)));

constexpr int NW = 8;
constexpr int NTHR = NW * 64;
constexpr int T_ = 8192;
constexpr int NTOK = 16384;
constexpr int DM = 1024;
constexpr int IC_SRC = 2840;
constexpr int HLD = 3072;
constexpr int C_GU = 0, C_GV = 256, C_NQ = 512, C_KC = 1024, C_VC = 1152, C_KS = 1280, C_VS = 1408,
              C_KW = 1536, C_VW = 1664, C_HQ = 1792, C_HF = 2048, C_HI = 2304, C_HG = 2560, C_NG = 2816;
constexpr int NCMP = 511;
constexpr float ALPHA = 1.4142135623730951f;
constexpr float NEG_INF = -1e30f;

constexpr size_t WT_IN = 0;
constexpr size_t WT_OUT = WT_IN + (size_t)3072 * 1024;
constexpr size_t WT_UP = WT_OUT + (size_t)1024 * 1024;
constexpr size_t WT_DN = WT_UP + (size_t)16 * 1024 * 1024;
constexpr size_t WT_C1 = WT_DN + (size_t)16 * 1024 * 512;
constexpr size_t WT_GM = WT_C1 + (size_t)2 * 256 * 2048;
constexpr size_t WT_LAYER = WT_GM + (size_t)4 * 128 * 128;

constexpr int LDS_STAGE = 131072;
constexpr int LDS_MISC = LDS_STAGE;
constexpr int LDS_BYTES = 147456;

constexpr int CW_BAR = 0;
constexpr int CW_CNT = 4096;
constexpr size_t CTL_BYTES = 65536;

struct P {
    const float* x; const float* w_in; const float* gm_v_gain; const float* gm_v_bias; const float* gm_w_s;
    const float* gm_b_s; const float* cmp_pos; const float* cmp_w1; const float* cmp_w2; const float* nsa_gate_b;
    const float* hg_lower; const float* out_gain; const float* w_out; const float* ln1_g; const float* ln1_b;
    const float* rg_w; const float* rg_b; const float* re_w; const float* re_b; const float* w_gate;
    const float* w_up; const float* w_down; const float* ln2_g; const float* ln2_b;
    float* out;
    unsigned* ctl;
    bf16_t* WT;
    bf16_t* H;
    bf16_t* Y;
    bf16_t* XB;
    bf16_t* kcb;
    bf16_t* vcT;
    bf16_t* vsT;
    bf16_t* vwT;
    bf16_t* gb;
    float* cbias;
    int* list_tok;
    float* list_w;
    int* tok_slot;
    float* hgU; float* hgG; float* hgS; bf16_t* hgQB; bf16_t* hgO;
    int nph; int pad;
};


typedef const __attribute__((address_space(4))) char* KA;
template <class T> __device__ __forceinline__ T ldarg(KA ka, size_t off) { return *(const __attribute__((address_space(4))) T*)(ka + off); }
#define PF(f) ldarg<decltype(P::f)>(ka, offsetof(P, f))

__device__ __forceinline__ float bf2f(bf16_t u) { return __uint_as_float(((unsigned)u) << 16); }
typedef __bf16 bf16x2_t __attribute__((ext_vector_type(2)));
__device__ __forceinline__ unsigned pk2(float lo, float hi) { f32x2 v; v.x = lo; v.y = hi; return __builtin_bit_cast(unsigned, __builtin_convertvector(v, bf16x2_t)); }
__device__ __forceinline__ bf16_t f2bf(float f) { return (bf16_t)(pk2(f, 0.f) & 0xffffu); }
__device__ __forceinline__ float gelu_t(float x) {
    const float u2 = -2.f * 0.7978845608028654f * (x + 0.044715f * x * x * x);
    return x / (1.f + __expf(u2));
}
__device__ __forceinline__ float gelu_slow(float x) {
    float u = 0.7978845608028654f * (x + 0.044715f * x * x * x);
    return 0.5f * x * (1.f + tanhf(u));
}
__device__ __forceinline__ float sigmoidf_(float x) { return 1.f / (1.f + __expf(-x)); }
__device__ __forceinline__ float wave_max(float v) {
#pragma unroll
    for (int o = 32; o > 0; o >>= 1) v = fmaxf(v, __shfl_xor(v, o));
    return v;
}
__device__ __forceinline__ float wave_sum(float v) {
#pragma unroll
    for (int o = 32; o > 0; o >>= 1) v += __shfl_xor(v, o);
    return v;
}
__device__ __forceinline__ void wave_sync() {
    __builtin_amdgcn_fence(__ATOMIC_RELEASE, "wavefront");
    __builtin_amdgcn_wave_barrier();
    __builtin_amdgcn_fence(__ATOMIC_ACQUIRE, "wavefront");
}
__device__ __forceinline__ int opaque_tid() { int t = threadIdx.x; asm volatile("" : "+v"(t)); return t; }
__device__ __forceinline__ int opaque_bid() { int b = blockIdx.x; asm volatile("" : "+s"(b)); return b; }
#define PHASE_IDS const int TID = opaque_tid(); const int BID = opaque_bid(); (void)TID; (void)BID;

#define XB_TMO      128
#define XB_XCNT(j)  (256  + 64 * (j))
#define XB_XSUB(j)  (1280 + 64 * (j))
#define XB_XGEN(j)  (2304 + 64 * (j))
#define XB_TOP      3328
#define XB_TOPGEN   3392
#define XCD_BAR_WORDS 3456
#define XB_SPIN_CAP (1u << 22)
__device__ __forceinline__ unsigned xb_ld(unsigned* p)              { return __hip_atomic_load(p, __ATOMIC_RELAXED, __HIP_MEMORY_SCOPE_AGENT); }
__device__ __forceinline__ unsigned xb_add(unsigned* p, unsigned v) { return __hip_atomic_fetch_add(p, v, __ATOMIC_RELAXED, __HIP_MEMORY_SCOPE_AGENT); }
__device__ __forceinline__ unsigned xb_xcc_id() { return (unsigned)__builtin_amdgcn_s_getreg((3 << 11) | 20) & 0xFu; }
#define XB_SPIN(cond, bar) do { unsigned _sp = 0; while (cond) { __builtin_amdgcn_s_sleep(1); \
    if ((++_sp & 255u) == 0u) { if (xb_ld(&(bar)[XB_TMO])) break; if (_sp > XB_SPIN_CAP) { atomicAdd(&(bar)[XB_TMO], 1u); break; } } } } while (0)
struct XcdBarrier { unsigned* bar; unsigned x; volatile LAS unsigned* st; };
__device__ __forceinline__ XcdBarrier xcd_barrier_post(unsigned* bar, volatile LAS unsigned* st) {
    XcdBarrier b; b.bar = bar; b.x = xb_xcc_id(); b.st = st;
    if (threadIdx.x == 0) (void)xb_add(&bar[XB_XCNT(b.x)], 1u);
    return b;
}
__device__ __forceinline__ void xcd_barrier_complete(unsigned* bar, unsigned x, unsigned& nloc, unsigned& nx) {
    const unsigned G = gridDim.x * gridDim.y * gridDim.z;
    unsigned sum, cnt, mine, sp = 0u;
    for (;;) {
        sum = 0u; cnt = 0u; mine = 0u;
#pragma unroll
        for (unsigned j = 0; j < 16; ++j) { const unsigned c = xb_ld(&bar[XB_XCNT(j)]); sum += c; cnt += (c > 0u) ? 1u : 0u; mine = (j == x) ? c : mine; }
        if (sum == G) break;
        __builtin_amdgcn_s_sleep(1);
        if ((++sp & 255u) == 0u) { if (xb_ld(&bar[XB_TMO])) break; if (sp > XB_SPIN_CAP) { atomicAdd(&bar[XB_TMO], 1u); break; } }
    }
    nloc = mine > 0u ? mine : 1u; nx = cnt > 0u ? cnt : 1u;
}
__device__ __forceinline__ void xcd_barrier(const XcdBarrier& b) {
    asm volatile("s_waitcnt vmcnt(0)" ::: "memory");
    __syncthreads();
    if (threadIdx.x == 0) {
        unsigned* bar = b.bar;
        __builtin_amdgcn_s_waitcnt(0);
        unsigned nloc = b.st[0], nx = b.st[1];
        if (nloc == 0u) { xcd_barrier_complete(bar, b.x, nloc, nx); b.st[0] = nloc; b.st[1] = nx; }
        const unsigned old = xb_add(&bar[XB_XSUB(b.x)], 1u);
        const unsigned gen = old / nloc;
        if (old + 1u == (gen + 1u) * nloc) {
            __builtin_amdgcn_fence(__ATOMIC_RELEASE, "agent");
            asm volatile("s_waitcnt vmcnt(0)" ::: "memory");
            const unsigned og = xb_add(&bar[XB_TOP], 1u);
            const unsigned tg = og / nx;
            if (og + 1u == (tg + 1u) * nx) xb_add(&bar[XB_TOPGEN], 1u);
            else XB_SPIN(xb_ld(&bar[XB_TOPGEN]) == tg, bar);
            __builtin_amdgcn_fence(__ATOMIC_ACQUIRE, "agent");
            xb_add(&bar[XB_XGEN(b.x)], 1u);
            asm volatile("s_waitcnt vmcnt(0)" ::: "memory");
        } else {
            XB_SPIN(xb_ld(&bar[XB_XGEN(b.x)]) == gen, bar);
            __builtin_amdgcn_fence(__ATOMIC_ACQUIRE, "agent");
            asm volatile("s_waitcnt vmcnt(0)" ::: "memory");
        }
    }
    __syncthreads();
}

namespace pg8 {
constexpr int BM = 256, BK = 64, HALF = 128, HTB = HALF * BK * 2, STAGE_BYTES = 8 * HTB;
__host__ __device__ __forceinline__ int lds_byte(int r, int c) { const int st = (r >> 4) * 2 + (c >> 5), rr = r & 15, cc = c & 31, ob = rr * 64 + cc * 2; return st * 1024 + (ob ^ (((ob >> 9) & 1) << 5)); }
__host__ __device__ __forceinline__ void stage_rc(int b, int& R, int& C) { const int st = b / 1024, sb = b % 1024, swz = sb ^ (((sb >> 9) & 1) << 5); R = (st >> 1) * 16 + swz / 64; C = (st & 1) * 32 + (swz % 64) / 2; }
__host__ __device__ __forceinline__ int perm32(int rho) { const int n = rho >> 4, i = rho & 15; return 8 * (i >> 2) + 4 * n + (i & 3); }
__device__ __forceinline__ unsigned cvt_pk_bf16(float lo, float hi) { return pk2(lo, hi); }

struct Unit {
    const char* bptr;
    int arow0;
    int nrows;
    int pm, pn, e, ui;
};

template <class Epi, class Sched>
__device__ __forceinline__ void gemm_phase(LAS unsigned char* lds, const char* Abase, const int K, const Sched& S, const Epi& E) {
    const int tid = opaque_tid(), wid = __builtin_amdgcn_readfirstlane(tid >> 6), lane = tid & 63, wr = wid >> 2, wc = wid & 3, fr = lane & 15, fq = lane >> 4;
    const int nt = K / BK;
    int R0, C0, R1, C1; stage_rc(tid * 16, R0, C0); stage_rc(tid * 16 + 8192, R1, C1);
    unsigned voffB[2];
    { const int Rb0 = Epi::PERM ? ((R0 & ~31) + perm32(R0 & 31)) : R0, Rb1 = Epi::PERM ? ((R1 & ~31) + perm32(R1 & 31)) : R1;
      voffB[0] = (unsigned)(Rb0 * K + C0) * 2u; voffB[1] = (unsigned)(Rb1 * K + C1) * 2u; }
    const unsigned cA0 = (unsigned)C0 * 2u, cA1 = (unsigned)C1 * 2u;
    const int lda = S.lda(K);
    const unsigned kstepA = S.kstepA();
    const unsigned voffA0 = (unsigned)(R0 * lda + C0) * 2u, voffA1 = (unsigned)(R1 * lda + C1) * 2u;
    const unsigned kstep = (unsigned)(BK * 2);
    const unsigned hstep = (unsigned)(HALF * K * 2);
    const unsigned ldsw = (unsigned)wid * 1024u;
    const int aoff = lds_byte(wr * 64 + fr, fq * 8), boff = lds_byte(wc * 32 + fr, fq * 8);
#define PG8_SA(b, h) (((b) * 2 + (h)) * HTB)
#define PG8_SB(b, h) ((4 + (b) * 2 + (h)) * HTB)
#define PG8_STAGE_B(bufoff, gbase) do { \
        __builtin_amdgcn_global_load_lds((const unsigned*)((const char*)(gbase) + voffB[0]), (LAS unsigned*)(lds + (bufoff) + ldsw), 16, 0, 0); \
        __builtin_amdgcn_global_load_lds((const unsigned*)((const char*)(gbase) + voffB[1]), (LAS unsigned*)(lds + (bufoff) + ldsw + 8192), 16, 0, 0); } while (0)
#define PG8_STAGE_A(bufoff, gbase, pk) do { \
        const unsigned o0_ = Sched::GATHER ? (((pk) & 0xffffu) * (unsigned)lda * 2u + cA0) : voffA0; \
        const unsigned o1_ = Sched::GATHER ? (((pk) >> 16) * (unsigned)lda * 2u + cA1) : voffA1; \
        __builtin_amdgcn_global_load_lds((const unsigned*)((const char*)(gbase) + o0_), (LAS unsigned*)(lds + (bufoff) + ldsw), 16, 0, 0); \
        __builtin_amdgcn_global_load_lds((const unsigned*)((const char*)(gbase) + o1_), (LAS unsigned*)(lds + (bufoff) + ldsw + 8192), 16, 0, 0); } while (0)
#define PG8_LDA(dst, b, h) do { _Pragma("unroll") for (int m = 0; m < 4; ++m) _Pragma("unroll") for (int k = 0; k < 2; ++k) dst[m][k] = *(const LAS bf16x8*)(lds + PG8_SA(b, h) + aoff + m * 2048 + k * 1024); } while (0)
#define PG8_LDB(dst, b, h) do { _Pragma("unroll") for (int n = 0; n < 2; ++n) _Pragma("unroll") for (int k = 0; k < 2; ++k) dst[n][k] = *(const LAS bf16x8*)(lds + PG8_SB(b, h) + boff + n * 2048 + k * 1024); } while (0)
#define PG8_MMA(ai, bj, At, Bt) do { __builtin_amdgcn_s_setprio(1); _Pragma("unroll") for (int m = 0; m < 4; ++m) _Pragma("unroll") for (int n = 0; n < 2; ++n) _Pragma("unroll") for (int k = 0; k < 2; ++k) \
        acc[ai][bj][m][n] = __builtin_amdgcn_mfma_f32_16x16x32_bf16(Bt[n][k], At[m][k], acc[ai][bj][m][n], 0, 0, 0); __builtin_amdgcn_s_setprio(0); } while (0)
#define PG8_WAIT_V(n) asm volatile("s_waitcnt vmcnt(" #n ")" ::: "memory")
#define PG8_WAIT_L(n) asm volatile("s_waitcnt lgkmcnt(" #n ")" ::: "memory")
#define PG8_BAR __builtin_amdgcn_s_barrier()
#define PG8_SCHED __builtin_amdgcn_sched_barrier(0)
#define PG8_PACK(u, h) ((unsigned)S.arow((u), ((h) * 128 + R0) < (u).nrows ? ((h) * 128 + R0) : (u).nrows - 1) | ((unsigned)S.arow((u), ((h) * 128 + R1) < (u).nrows ? ((h) * 128 + R1) : (u).nrows - 1) << 16))
    Unit cur, nxt; int ui = 0;
    if (!S.next(0, cur)) return;
    f32x4 acc[2][2][4][2];
#pragma unroll
    for (int a = 0; a < 2; ++a)
#pragma unroll
        for (int b = 0; b < 2; ++b)
#pragma unroll
            for (int m = 0; m < 4; ++m)
#pragma unroll
                for (int n = 0; n < 2; ++n) acc[a][b][m][n] = (f32x4){0.f, 0.f, 0.f, 0.f};
    bf16x8 At[4][2], B0[2][2], B1[2][2];
    unsigned pC0 = 0u, pC1 = 0u, pN0 = 0u, pN1 = 0u;
    if (Sched::GATHER) { pC0 = PG8_PACK(cur, 0); pC1 = PG8_PACK(cur, 1); }
    const char* cB = cur.bptr;
    const char* cA = Sched::GATHER ? Abase : S.abase(cur, Abase) + (size_t)cur.arow0 * lda * 2;
    const unsigned hA = Sched::GATHER ? 0u : (unsigned)(HALF * lda * 2);
    PG8_STAGE_B(PG8_SB(0, 0), cB); PG8_STAGE_B(PG8_SB(0, 1), cB + hstep); PG8_STAGE_A(PG8_SA(0, 0), cA, pC0); PG8_STAGE_A(PG8_SA(0, 1), cA + hA, pC1);
    if (wr == 1) PG8_BAR;
    PG8_WAIT_V(2); PG8_BAR;
    PG8_STAGE_B(PG8_SB(1, 0), cB + kstep); PG8_STAGE_A(PG8_SA(1, 0), cA + kstepA, pC0); PG8_STAGE_B(PG8_SB(1, 1), cB + hstep + kstep);
    PG8_WAIT_V(6); PG8_BAR;
    for (;;) {
        const bool has_next = S.next(ui + 1, nxt);
        if (Sched::GATHER) { if (has_next) { pN0 = PG8_PACK(nxt, 0); pN1 = PG8_PACK(nxt, 1); } else { pN0 = pC0; pN1 = pC1; } }
        const char* nB = has_next ? nxt.bptr : cB;
        const char* nA = (Sched::GATHER || !has_next) ? cA : S.abase(nxt, Abase) + (size_t)nxt.arow0 * lda * 2;
        for (int t = 0; t < nt; t += 2) {
            const bool last = (t == nt - 2);
            const char* a1 = cA + (unsigned)(t + 1) * kstepA;
            const char* a2 = last ? nA : cA + (unsigned)(t + 2) * kstepA; const char* b2 = last ? nB : cB + (unsigned)(t + 2) * kstep;
            const char* a3 = a2 + kstepA; const char* b3 = b2 + kstep;
            const unsigned s0 = last ? pN0 : pC0, s1 = last ? pN1 : pC1;
            PG8_LDB(B0, 0, 0); PG8_LDB(B1, 0, 1); PG8_SCHED; PG8_LDA(At, 0, 0); PG8_STAGE_A(PG8_SA(1, 1), a1 + hA, pC1);
            PG8_WAIT_V(8); PG8_WAIT_L(0); PG8_BAR; PG8_MMA(0, 0, At, B0); PG8_MMA(0, 1, At, B1); PG8_BAR; PG8_SCHED;
            PG8_LDA(At, 0, 1); PG8_STAGE_B(PG8_SB(0, 0), b2); PG8_STAGE_B(PG8_SB(0, 1), b2 + hstep); PG8_STAGE_A(PG8_SA(0, 0), a2, s0);
            PG8_WAIT_V(8); PG8_WAIT_L(0); PG8_BAR; PG8_MMA(1, 0, At, B0); PG8_MMA(1, 1, At, B1); PG8_BAR; PG8_SCHED;
            PG8_LDB(B0, 1, 0); PG8_LDB(B1, 1, 1); PG8_SCHED; PG8_LDA(At, 1, 0); PG8_STAGE_A(PG8_SA(0, 1), a2 + hA, s1);
            PG8_WAIT_V(8); PG8_WAIT_L(0); PG8_BAR; PG8_MMA(0, 0, At, B0); PG8_MMA(0, 1, At, B1); PG8_BAR; PG8_SCHED;
            PG8_LDA(At, 1, 1); PG8_STAGE_B(PG8_SB(1, 0), b3); PG8_STAGE_B(PG8_SB(1, 1), b3 + hstep); PG8_STAGE_A(PG8_SA(1, 0), a3, s0);
            PG8_WAIT_V(8); PG8_WAIT_L(0); PG8_BAR; PG8_MMA(1, 0, At, B0); PG8_MMA(1, 1, At, B1); PG8_BAR; PG8_SCHED;
        }
        if (wr == 0) PG8_BAR;
        E(acc, cur, wr, wc, fr, fq);
        if (!has_next) break;
#pragma unroll
        for (int a = 0; a < 2; ++a)
#pragma unroll
            for (int b = 0; b < 2; ++b)
#pragma unroll
                for (int m = 0; m < 4; ++m)
#pragma unroll
                    for (int n = 0; n < 2; ++n) acc[a][b][m][n] = (f32x4){0.f, 0.f, 0.f, 0.f};
        cur = nxt; cB = nB; cA = nA; ++ui;
        pC0 = pN0; pC1 = pN1;
        if (wr == 1) PG8_BAR;
    }
    PG8_WAIT_V(0);
    PG8_BAR;
#undef PG8_SA
#undef PG8_SB
#undef PG8_STAGE_A
#undef PG8_STAGE_B
#undef PG8_LDA
#undef PG8_LDB
#undef PG8_MMA
#undef PG8_WAIT_V
#undef PG8_WAIT_L
#undef PG8_BAR
#undef PG8_SCHED
#undef PG8_PACK
}

struct DenseOrder {
    static constexpr bool GATHER = false;
    int nM, nN, nwg, G, c; const char* Bt; int K;
    __device__ void init(int M, int N, int K_, const bf16_t* Bt_, int G_, int c_) { nM = M / BM; nN = N / BM; nwg = nM * nN; G = G_; c = c_; Bt = (const char*)Bt_; K = K_; }
    __device__ __forceinline__ bool next(int i, Unit& u) const {
        const long L = (long)i * G + c; if (L >= nwg) return false;
        int wgid = (int)L; { const int q = nwg / 8, r = nwg % 8, xcd = wgid % 8, off = wgid / 8; wgid = (xcd < r ? xcd * (q + 1) : r * (q + 1) + (xcd - r) * q) + off; }
        const int nig = 8 * nN, gid = wgid / nig, fm = gid * 8, gsz = (nM - fm) < 8 ? (nM - fm) : 8;
        u.pm = fm + ((wgid % nig) % gsz); u.pn = (wgid % nig) / gsz;
        u.arow0 = u.pm * BM; u.nrows = BM; u.e = 0; u.ui = i;
        u.bptr = Bt + (size_t)u.pn * BM * K * 2;
        return true;
    }
    __device__ __forceinline__ int arow(const Unit& u, int r) const { return u.arow0 + r; }
    __device__ __forceinline__ int lda(int K_) const { return K_; }
    __device__ __forceinline__ unsigned kstepA() const { return 128u; }
    __device__ __forceinline__ const char* abase(const Unit&, const char* A) const { return A; }
};
}

struct EpiH {
    static constexpr bool PERM = true;
    bf16_t* H;
    __device__ __forceinline__ void operator()(const f32x4 (&acc)[2][2][4][2], const pg8::Unit& u, int wr, int wc, int fr, int fq) const {
        const int row0 = u.arow0 + wr * 64 + fr, col0 = u.pn * 256 + wc * 32 + 8 * fq;
#pragma unroll
        for (int ai = 0; ai < 2; ++ai)
#pragma unroll
            for (int m = 0; m < 4; ++m) {
                bf16_t* rowp = H + (size_t)(row0 + ai * 128 + m * 16) * HLD + col0;
#pragma unroll
                for (int bj = 0; bj < 2; ++bj) {
                    const f32x4 v0 = acc[ai][bj][m][0], v1 = acc[ai][bj][m][1];
                    u32x4 w; w.x = pg8::cvt_pk_bf16(v0[0], v0[1]); w.y = pg8::cvt_pk_bf16(v0[2], v0[3]); w.z = pg8::cvt_pk_bf16(v1[0], v1[1]); w.w = pg8::cvt_pk_bf16(v1[2], v1[3]);
                    *(u32x4*)(rowp + bj * 128) = w;
                }
            }
    }
};
struct EpiRes {
    static constexpr bool PERM = false;
    const float* xin; float* out;
    __device__ __forceinline__ void operator()(const f32x4 (&acc)[2][2][4][2], const pg8::Unit& u, int wr, int wc, int fr, int fq) const {
        const int row0 = u.arow0 + wr * 64 + fr, col0 = u.pn * 256 + wc * 32 + 4 * fq;
#pragma unroll
        for (int ai = 0; ai < 2; ++ai)
#pragma unroll
            for (int m = 0; m < 4; ++m) {
                const size_t off = (size_t)(row0 + ai * 128 + m * 16) * DM + col0;
#pragma unroll
                for (int bj = 0; bj < 2; ++bj)
#pragma unroll
                    for (int n = 0; n < 2; ++n) {
                        const f32x4 xv = *(const f32x4*)(xin + off + bj * 128 + n * 16);
                        *(f32x4*)(out + off + bj * 128 + n * 16) = xv * ALPHA + acc[ai][bj][m][n];
                    }
            }
    }
};

template <class RM>
__device__ __forceinline__ void transpose_item(const float* W, int K, int N, bf16_t* WT, RM rowmap, float* scr, int kb, int nb, int lane) {
    const int k0 = 64 * kb, n0 = 32 * nb;
    const int nn = n0 + (lane & 31);
    float tmp[32];
#pragma unroll
    for (int i = 0; i < 32; ++i) {
        const int kk = 2 * i + (lane >> 5);
        tmp[i] = nn < N ? W[(size_t)(k0 + kk) * N + nn] : 0.f;
    }
#pragma unroll
    for (int i = 0; i < 32; ++i) {
        const int kk = 2 * i + (lane >> 5);
        scr[kk * 33 + (lane & 31)] = tmp[i];
    }
    wave_sync();
    const int c = lane & 7;
#pragma unroll
    for (int j = 0; j < 4; ++j) {
        const int n = (lane >> 3) + 8 * j;
        const float* s = scr + (8 * c) * 33 + n;
        u32x4 o; o.x = pk2(s[0 * 33], s[1 * 33]); o.y = pk2(s[2 * 33], s[3 * 33]); o.z = pk2(s[4 * 33], s[5 * 33]); o.w = pk2(s[6 * 33], s[7 * 33]);
        const int dr = (n0 + n < N) ? rowmap(n0 + n) : -1;
        if (dr >= 0) *(u32x4*)(WT + (size_t)dr * K + k0 + 8 * c) = o;
    }
    wave_sync();
}

__device__ void phase_prologue(KA ka, int layer, float* smem) {
    PHASE_IDS
    const int lane = TID & 63, w = TID >> 6;
    float* scr = smem + w * 4096;
    const int gw = BID * NW + w, NGW = gridDim.x * NW;
    constexpr int I_IN = 16 * 89, I_OUT = 16 * 32, I_GU = 16 * 16, I_DN = 8 * 32;
    constexpr int I_LAYER = I_IN + I_OUT + 32 * I_GU + 16 * I_DN;
    for (int it = gw; it < I_LAYER; it += NGW) {
        int r = it;
        bf16_t* WT = PF(WT);
        if (r < I_IN) {
            transpose_item(PF(w_in) + (size_t)layer * DM * IC_SRC, DM, IC_SRC, WT + WT_IN,
                           [](int n) { return n < 1792 ? n : (n < 1816 ? 2816 + (n - 1792) : n - 24); }, scr, r / 89, r % 89, lane);
            continue;
        }
        r -= I_IN;
        if (r < I_OUT) {
            transpose_item(PF(w_out) + (size_t)layer * DM * DM, DM, DM, WT + WT_OUT, [](int n) { return n; }, scr, r / 32, r % 32, lane);
            continue;
        }
        r -= I_OUT;
        if (r < 32 * I_GU) {
            const int mat = r / I_GU, rr = r % I_GU, e = mat >> 1, isup = mat & 1;
            const float* W = (isup ? PF(w_up) : PF(w_gate)) + ((size_t)layer * 16 + e) * DM * 512;
            transpose_item(W, DM, 512, WT + WT_UP + (size_t)e * 1024 * 1024,
                           [isup](int n) { return (n >> 7) * 256 + isup * 128 + (n & 127); }, scr, rr / 16, rr % 16, lane);
            continue;
        }
        r -= 32 * I_GU;
        {
            const int e = r / I_DN, rr = r % I_DN;
            transpose_item(PF(w_down) + ((size_t)layer * 16 + e) * 512 * DM, 512, DM, WT + WT_DN + (size_t)e * 1024 * 512,
                           [](int n) { return n; }, scr, rr / 32, rr % 32, lane);
        }
    }
    for (int it = gw; it < 2 * 32 * 4; it += NGW) {
        const int which = it >> 7, rr = it & 127;
        transpose_item(PF(cmp_w1) + ((size_t)layer * 2 + which) * 2048 * 128, 2048, 128, PF(WT) + WT_C1 + (size_t)which * 256 * 2048, [](int n) { return n; }, scr, rr >> 2, rr & 3, lane);
    }
    for (int i = BID * NTHR + TID; i < 2 * 128 * 256; i += gridDim.x * NTHR) {
        const int which = i >> 15, q = i & 32767;
        u32x4 z; z.x = 0u; z.y = 0u; z.z = 0u; z.w = 0u;
        *(u32x4*)(PF(WT) + WT_C1 + (size_t)which * 256 * 2048 + (size_t)128 * 2048 + (size_t)q * 8) = z;
    }
    for (int o = gw; o < 256; o += NGW) {
        const int which = o >> 7, cc = o & 127;
        const float* w1 = PF(cmp_w1) + ((size_t)layer * 2 + which) * 2048 * 128;
        const float* pos = PF(cmp_pos) + ((size_t)layer * 2 + which) * 2048;
        float a = 0.f;
        for (int k = lane; k < 2048; k += 64) a = fmaf(pos[k], w1[(size_t)k * 128 + cc], a);
        a = wave_sum(a);
        if (lane == 0) PF(cbias)[o] = a;
    }
    for (int i = BID * NTHR + TID; i < 4 * 128 * 128; i += gridDim.x * NTHR) {
        const int s = i & 127, t = (i >> 7) & 127;
        PF(WT)[WT_GM + i] = (s <= t) ? f2bf(PF(gm_w_s)[(size_t)layer * 4 * 128 * 128 + i]) : (bf16_t)0;
    }
    for (int i = BID * NTHR + TID; i < 232 * 128; i += gridDim.x * NTHR) {
        const int q = i;
        u32x4 z; z.x = 0u; z.y = 0u; z.z = 0u; z.w = 0u;
        *(u32x4*)(PF(WT) + WT_IN + (size_t)2840 * 1024 + (size_t)q * 8) = z;
    }
    if (layer == 0)
    for (int row = gw; row < NTOK; row += NGW) {
        const f32x4* xr = (const f32x4*)(PF(x) + (size_t)row * DM) + lane;
        u32x2* o = (u32x2*)(PF(XB) + (size_t)row * DM) + lane;
#pragma unroll
        for (int j = 0; j < 4; ++j) {
            const f32x4 v = xr[64 * j];
            u32x2 ww; ww.x = pk2(v[0], v[1]); ww.y = pk2(v[2], v[3]);
            o[64 * j] = ww;
        }
    }
}

template <class AF, class BF, class EF>
__device__ __forceinline__ void gemm128(int tid, int m0, int n0, int M, int N, int K, AF af, BF bf, EF ef, float* smem) {
    float* As = smem;
    float* Bs = smem + 16 * 132;
    const bool active = tid < 256;
    const int tx = tid & 15, ty = (tid >> 4) & 15;
    float acc[8][8];
#pragma unroll
    for (int i = 0; i < 8; i++)
#pragma unroll
        for (int j = 0; j < 8; j++) acc[i][j] = 0.f;
#pragma unroll 1
    for (int k0 = 0; k0 < K; k0 += 16) {
        if (active) {
#pragma unroll
            for (int i = 0; i < 8; i++) {
                int e = tid + i * 256;
                int r = e >> 4, kk = e & 15;
                float v = 0.f;
                if (m0 + r < M) v = af(m0 + r, k0 + kk);
                As[kk * 132 + r] = v;
            }
#pragma unroll
            for (int i = 0; i < 8; i++) {
                int e = tid + i * 256;
                int kk = e >> 7, c = e & 127;
                float v = 0.f;
                if (n0 + c < N) v = bf(k0 + kk, n0 + c);
                Bs[kk * 132 + c] = v;
            }
        }
        __syncthreads();
        if (active) {
#pragma unroll 2
            for (int kk = 0; kk < 16; kk++) {
                asm volatile("" ::: "memory");
                float4 a0 = *(const float4*)&As[kk * 132 + ty * 8];
                float4 a1 = *(const float4*)&As[kk * 132 + ty * 8 + 4];
                float4 b0 = *(const float4*)&Bs[kk * 132 + tx * 8];
                float4 b1 = *(const float4*)&Bs[kk * 132 + tx * 8 + 4];
                float a[8] = {a0.x, a0.y, a0.z, a0.w, a1.x, a1.y, a1.z, a1.w};
                float b[8] = {b0.x, b0.y, b0.z, b0.w, b1.x, b1.y, b1.z, b1.w};
#pragma unroll
                for (int i = 0; i < 8; i++)
#pragma unroll
                    for (int j = 0; j < 8; j++) acc[i][j] = fmaf(a[i], b[j], acc[i][j]);
            }
        }
        __syncthreads();
    }
    if (active) {
#pragma unroll
        for (int i = 0; i < 8; i++)
#pragma unroll
            for (int j = 0; j < 8; j++) {
                int m = m0 + ty * 8 + i, n = n0 + tx * 8 + j;
                if (m < M && n < N) ef(m, n, acc[i][j]);
            }
    }
}

__device__ __forceinline__ void phase_inproj(KA ka, int layer, LAS unsigned char* lds) {
    pg8::DenseOrder S; S.init(NTOK, HLD, DM, PF(WT) + WT_IN, gridDim.x, opaque_bid());
    EpiH E{PF(H)};
    pg8::gemm_phase<EpiH, pg8::DenseOrder>(lds, (const char*)PF(XB), DM, S, E);
}
__device__ __forceinline__ void phase_outproj(KA ka, int layer, const float* xin, float* x1, LAS unsigned char* lds) {
    pg8::DenseOrder S; S.init(NTOK, DM, DM, PF(WT) + WT_OUT, gridDim.x, opaque_bid());
    EpiRes E{xin, x1};
    pg8::gemm_phase<EpiRes, pg8::DenseOrder>(lds, (const char*)PF(Y), DM, S, E);
}

__device__ void phase_ln1_route(KA ka, int layer, float* x1, float* smem, bool dry) {
    PHASE_IDS
    bf16_t* xb = PF(XB);
    float* x1o = dry ? (float*)PF(H) : x1;
    const int lane = TID & 63, w = TID >> 6;
    const float* g = PF(ln1_g) + layer * 1024;
    const float* bb = PF(ln1_b) + layer * 1024;
    const float* wg = PF(rg_w) + (size_t)layer * 1024 * 4;
    const float* we = PF(re_w) + (size_t)layer * 1024 * 16;
    const float* bg = PF(rg_b) + layer * 4;
    const float* be = PF(re_b) + layer * 16;
    int* cnt = (int*)(PF(ctl) + CW_CNT) + layer * 16 * 64 + (dry ? 2048 : 0);
    int* lcnt = (int*)(smem + 20 * 1024);
    int* rinfo = lcnt + 64;
    float* rwt = (float*)(rinfo + 4 * 128);
    if (TID < 32) lcnt[TID] = 0;
    float* WR = smem;
    __syncthreads();
    for (int idx = TID; idx < 20 * 1024; idx += NTHR) { const int o = idx >> 10, c = idx & 1023; WR[idx] = o < 4 ? wg[c * 4 + o] : we[c * 16 + (o - 4)]; }
    __syncthreads();
    int nloc = 0;
    for (int row = BID * NW + w; row < NTOK; row += gridDim.x * NW) {
        f32x4 v[4];
        float s = 0.f;
#pragma unroll
        for (int j = 0; j < 4; ++j) { v[j] = *(const f32x4*)(x1 + (size_t)row * DM + 256 * j + 4 * lane); s += (v[j][0] + v[j][1]) + (v[j][2] + v[j][3]); }
        const float mu = wave_sum(s) * (1.f / 1024.f);
        float q = 0.f;
#pragma unroll
        for (int j = 0; j < 4; ++j) { v[j] = v[j] - mu; q += (v[j][0] * v[j][0] + v[j][1] * v[j][1]) + (v[j][2] * v[j][2] + v[j][3] * v[j][3]); }
        const float rstd = rsqrtf(wave_sum(q) * (1.f / 1024.f) + 1e-5f);
#pragma unroll
        for (int j = 0; j < 4; ++j) {
            const int c = 256 * j + 4 * lane;
            v[j] = v[j] * rstd * *(const f32x4*)(g + c) + *(const f32x4*)(bb + c);
            *(f32x4*)(x1o + (size_t)row * DM + c) = v[j];
            u32x2 pw; pw.x = pk2(v[j][0], v[j][1]); pw.y = pk2(v[j][2], v[j][3]);
            *(u32x2*)(xb + (size_t)row * DM + c) = pw;
        }
        float lg[4], le[16];
#pragma unroll
        for (int o = 0; o < 20; ++o) {
            asm volatile("" ::: "memory");
            float a = 0.f;
#pragma unroll
            for (int j = 0; j < 4; ++j) {
                const f32x4 w4 = *(const f32x4*)(WR + o * 1024 + 256 * j + 4 * lane);
                a += (v[j][0] * w4[0] + v[j][1] * w4[1]) + (v[j][2] * w4[2] + v[j][3] * w4[3]);
            }
            a = wave_sum(a);
            if (o < 4) lg[o] = a + bg[o]; else le[o - 4] = a + be[o - 4];
        }
        float gm = fmaxf(fmaxf(lg[0], lg[1]), fmaxf(lg[2], lg[3]));
        float ge[4], gs = 0.f;
#pragma unroll
        for (int c = 0; c < 4; c++) { ge[c] = __expf(lg[c] - gm); gs += ge[c]; }
        int gi = 0; float gbest = ge[0];
#pragma unroll
        for (int c = 1; c < 4; c++) if (ge[c] > gbest) { gbest = ge[c]; gi = c; }
        float gval = gbest / gs;
        float ls[4];
#pragma unroll
        for (int e = 0; e < 4; e++) ls[e] = gi == 0 ? le[e] : gi == 1 ? le[4 + e] : gi == 2 ? le[8 + e] : le[12 + e];
        float em = fmaxf(fmaxf(ls[0], ls[1]), fmaxf(ls[2], ls[3]));
        float pe[4];
#pragma unroll
        for (int e = 0; e < 4; e++) pe[e] = __expf(ls[e] - em);
        int i1 = 0; float b1 = pe[0];
#pragma unroll
        for (int e = 1; e < 4; e++) if (pe[e] > b1) { b1 = pe[e]; i1 = e; }
        int i2 = -1; float b2 = -1.f;
#pragma unroll
        for (int e = 0; e < 4; e++) if (e != i1 && pe[e] > b2) { b2 = pe[e]; i2 = e; }
        float w1 = gval * b1 / (b1 + b2), w2 = gval * b2 / (b1 + b2);
        if (lane == 0) {
            const int e1 = gi * 4 + i1, e2 = gi * 4 + i2;
            const int lr = nloc * NW + w;
            rinfo[lr * 4 + 0] = e1; rinfo[lr * 4 + 1] = atomicAdd(&lcnt[e1], 1);
            rinfo[lr * 4 + 2] = e2; rinfo[lr * 4 + 3] = atomicAdd(&lcnt[e2], 1);
            rwt[lr * 2 + 0] = w1; rwt[lr * 2 + 1] = w2;
        }
        ++nloc;
    }
    __syncthreads();
    if (TID < 16) lcnt[16 + TID] = lcnt[TID] > 0 ? atomicAdd(&cnt[TID * 64], lcnt[TID]) : 0;
    __syncthreads();
    {
        const int nrows_blk = (NTOK - BID * NW + (int)gridDim.x * NW - 1) / ((int)gridDim.x * NW) * NW;
        for (int lr = TID; lr < nrows_blk; lr += NTHR) {
            const int row = BID * NW + (lr % NW) + (lr / NW) * (int)gridDim.x * NW;
            if (row < NTOK) {
                const int e1 = rinfo[lr * 4 + 0], p1 = lcnt[16 + e1] + rinfo[lr * 4 + 1];
                const int e2 = rinfo[lr * 4 + 2], p2 = lcnt[16 + e2] + rinfo[lr * 4 + 3];
                PF(list_tok)[e1 * NTOK + p1] = row; PF(list_w)[e1 * NTOK + p1] = rwt[lr * 2 + 0];
                PF(list_tok)[e2 * NTOK + p2] = row; PF(list_w)[e2 * NTOK + p2] = rwt[lr * 2 + 1];
                PF(tok_slot)[row * 2 + 0] = e1 * NTOK + p1; PF(tok_slot)[row * 2 + 1] = e2 * NTOK + p2;
            }
        }
    }
    __syncthreads();
}


template <bool GATHER_>
struct MoeOrder {
    static constexpr bool GATHER = GATHER_;
    const LAS int* tab; const LAS int* rowtab;
    const char* Bt; unsigned estride; int K, G, c;
    __device__ __forceinline__ bool next(int i, pg8::Unit& u) const {
        const int nwg = __builtin_amdgcn_readfirstlane(tab[48]) * 4;
        const int L = i * G + c; if (L >= nwg) return false;
        int wgid = L; { const int q = nwg / 8, r = nwg % 8, xcd = wgid % 8, off = wgid / 8; wgid = (xcd < r ? xcd * (q + 1) : r * (q + 1) + (xcd - r) * q) + off; }
        const int mg = wgid >> 2, nt = wgid & 3;
        int e = 0;
#pragma unroll
        for (int k = 1; k < 16; ++k) e = (__builtin_amdgcn_readfirstlane(tab[32 + k]) <= mg) ? k : e;
        const int mt = mg - __builtin_amdgcn_readfirstlane(tab[32 + e]);
        const int rem = __builtin_amdgcn_readfirstlane(tab[e]) - mt * 256;
        u.e = e; u.pm = mt; u.pn = nt; u.ui = i; u.nrows = rem < 256 ? rem : 256; u.arow0 = __builtin_amdgcn_readfirstlane(tab[16 + e]) + mt * 256;
        u.bptr = Bt + (size_t)e * estride + (size_t)nt * 256 * K * 2;
        return true;
    }
    __device__ __forceinline__ int arow(const pg8::Unit& u, int r) const { return GATHER_ ? rowtab[u.ui * 256 + r] : u.arow0 + r; }
    __device__ __forceinline__ int lda(int K_) const { return K_; }
    __device__ __forceinline__ unsigned kstepA() const { return 128u; }
    __device__ __forceinline__ const char* abase(const pg8::Unit&, const char* A) const { return A; }
};
__device__ __forceinline__ void moe_tables(KA ka, int layer, LAS unsigned char* lds, bool want_rows, int G, int c) {
    LAS int* tab = (LAS int*)(lds + LDS_MISC + 256);
    LAS int* rowtab = (LAS int*)(lds + LDS_MISC + 1024);
    const int tid = opaque_tid();
    const int* cnt = (const int*)(PF(ctl) + CW_CNT) + layer * 16 * 64;
    if (tid < 16) tab[tid] = __hip_atomic_load(&cnt[tid * 64], __ATOMIC_RELAXED, __HIP_MEMORY_SCOPE_AGENT);
    __syncthreads();
    if (tid == 0) {
        int b = 0, m = 0;
        for (int e = 0; e < 16; ++e) { tab[16 + e] = b; tab[32 + e] = m; b += tab[e]; m += (tab[e] + 255) >> 8; }
        tab[48] = m;
    }
    __syncthreads();
    if (want_rows) {
        MoeOrder<true> S{tab, rowtab, nullptr, 0u, 1024, G, c};
        const int* lt = PF(list_tok);
        for (int i = 0; i < 4; ++i) {
            pg8::Unit u;
            if (!S.next(i, u)) break;
            if (tid < 256) { const int r = tid < u.nrows ? tid : u.nrows - 1; rowtab[i * 256 + tid] = lt[u.e * NTOK + u.pm * 256 + r]; }
        }
        asm volatile("s_waitcnt vmcnt(0) lgkmcnt(0)" ::: "memory");
        __syncthreads();
    }
}
struct EpiUp {
    static constexpr bool PERM = true;
    bf16_t* hidden;
    __device__ __forceinline__ void operator()(const f32x4 (&acc)[2][2][4][2], const pg8::Unit& u, int wr, int wc, int fr, int fq) const {
#pragma unroll
        for (int ai = 0; ai < 2; ++ai)
#pragma unroll
            for (int m = 0; m < 4; ++m) {
                const int r = ai * 128 + wr * 64 + m * 16 + fr;
                if (r < u.nrows) {
                    bf16_t* rowp = hidden + (size_t)(u.arow0 + r) * 512 + u.pn * 128 + wc * 32 + 8 * fq;
                    float h[8];
#pragma unroll
                    for (int n = 0; n < 2; ++n)
#pragma unroll
                        for (int j = 0; j < 4; ++j) { const float g = acc[ai][0][m][n][j], uu = acc[ai][1][m][n][j]; h[n * 4 + j] = g * sigmoidf_(g) * uu; }
                    u32x4 w; w.x = pg8::cvt_pk_bf16(h[0], h[1]); w.y = pg8::cvt_pk_bf16(h[2], h[3]); w.z = pg8::cvt_pk_bf16(h[4], h[5]); w.w = pg8::cvt_pk_bf16(h[6], h[7]);
                    *(u32x4*)rowp = w;
                }
            }
    }
};
struct EpiDown {
    static constexpr bool PERM = true;
    bf16_t* Y2; const float* lw;
    __device__ __forceinline__ void operator()(const f32x4 (&acc)[2][2][4][2], const pg8::Unit& u, int wr, int wc, int fr, int fq) const {
#pragma unroll
        for (int ai = 0; ai < 2; ++ai)
#pragma unroll
            for (int m = 0; m < 4; ++m) {
                const int r = ai * 128 + wr * 64 + m * 16 + fr;
                if (r < u.nrows) {
                    const float wgt = lw[u.e * NTOK + u.pm * 256 + r];
                    bf16_t* rowp = Y2 + (size_t)(u.arow0 + r) * DM + u.pn * 256 + wc * 32 + 8 * fq;
#pragma unroll
                    for (int bj = 0; bj < 2; ++bj) {
                        const f32x4 v0 = acc[ai][bj][m][0] * wgt, v1 = acc[ai][bj][m][1] * wgt;
                        u32x4 w; w.x = pg8::cvt_pk_bf16(v0[0], v0[1]); w.y = pg8::cvt_pk_bf16(v0[2], v0[3]); w.z = pg8::cvt_pk_bf16(v1[0], v1[1]); w.w = pg8::cvt_pk_bf16(v1[2], v1[3]);
                        *(u32x4*)(rowp + bj * 128) = w;
                    }
                }
            }
    }
};
__device__ __forceinline__ void phase_moe_up(KA ka, int layer, LAS unsigned char* lds) {
    moe_tables(ka, layer, lds, true, gridDim.x, opaque_bid());
    MoeOrder<true> S{(const LAS int*)(lds + LDS_MISC + 256), (const LAS int*)(lds + LDS_MISC + 1024),
                     (const char*)(PF(WT) + WT_UP), (unsigned)(1024u * 1024u * 2u), 1024, (int)gridDim.x, opaque_bid()};
    EpiUp E{PF(Y)};
    pg8::gemm_phase<EpiUp, MoeOrder<true>>(lds, (const char*)PF(XB), 1024, S, E);
}
__device__ __forceinline__ void phase_moe_down(KA ka, int layer, LAS unsigned char* lds) {
    moe_tables(ka, layer, lds, false, gridDim.x, opaque_bid());
    MoeOrder<false> S{(const LAS int*)(lds + LDS_MISC + 256), (const LAS int*)(lds + LDS_MISC + 1024),
                      (const char*)(PF(WT) + WT_DN), (unsigned)(1024u * 512u * 2u), 512, (int)gridDim.x, opaque_bid()};
    EpiDown E{PF(H), PF(list_w)};
    pg8::gemm_phase<EpiDown, MoeOrder<false>>(lds, (const char*)PF(Y), 512, S, E);
}

__device__ void phase_ln2(KA ka, int layer, const float* x1, float* xo) {
    PHASE_IDS
    bf16_t* xb = PF(XB);
    const bf16_t* Y2 = PF(H);
    const int lane = TID & 63, w = TID >> 6;
    const float* g = PF(ln2_g) + layer * 1024;
    const float* bb = PF(ln2_b) + layer * 1024;
    const int* cnt = (const int*)(PF(ctl) + CW_CNT) + layer * 16 * 64;
    int mybase = 0;
    {
        int cv = lane < 16 ? __hip_atomic_load(&cnt[(lane & 15) * 64], __ATOMIC_RELAXED, __HIP_MEMORY_SCOPE_AGENT) : 0;
        int incl = cv;
#pragma unroll
        for (int o = 1; o < 16; o <<= 1) { int t = __shfl_up(incl, o); if ((lane & 15) >= o) incl += t; }
        mybase = incl - cv;
    }
    for (int row = BID * NW + w; row < NTOK; row += gridDim.x * NW) {
        const int ts1 = PF(tok_slot)[row * 2 + 0], ts2 = PF(tok_slot)[row * 2 + 1];
        const int s1 = __shfl(mybase, ts1 >> 14) + (ts1 & (NTOK - 1)), s2 = __shfl(mybase, ts2 >> 14) + (ts2 & (NTOK - 1));
        f32x4 v[4];
        float s = 0.f;
#pragma unroll
        for (int j = 0; j < 4; ++j) {
            const int c = 256 * j + 4 * lane;
            const f32x4 xv = *(const f32x4*)(x1 + (size_t)row * DM + c);
            const u32x2 ya = *(const u32x2*)(Y2 + (size_t)s1 * DM + c), yb = *(const u32x2*)(Y2 + (size_t)s2 * DM + c);
            f32x4 t;
            t[0] = __uint_as_float(ya.x << 16) + __uint_as_float(yb.x << 16); t[1] = __uint_as_float(ya.x & 0xffff0000u) + __uint_as_float(yb.x & 0xffff0000u);
            t[2] = __uint_as_float(ya.y << 16) + __uint_as_float(yb.y << 16); t[3] = __uint_as_float(ya.y & 0xffff0000u) + __uint_as_float(yb.y & 0xffff0000u);
            v[j] = xv * ALPHA + t;
            s += (v[j][0] + v[j][1]) + (v[j][2] + v[j][3]);
        }
        const float mu = wave_sum(s) * (1.f / 1024.f);
        float q = 0.f;
#pragma unroll
        for (int j = 0; j < 4; ++j) { v[j] = v[j] - mu; q += (v[j][0] * v[j][0] + v[j][1] * v[j][1]) + (v[j][2] * v[j][2] + v[j][3] * v[j][3]); }
        const float rstd = rsqrtf(wave_sum(q) * (1.f / 1024.f) + 1e-5f);
#pragma unroll
        for (int j = 0; j < 4; ++j) {
            const int c = 256 * j + 4 * lane;
            const f32x4 o = v[j] * rstd * *(const f32x4*)(g + c) + *(const f32x4*)(bb + c);
            *(f32x4*)(xo + (size_t)row * DM + c) = o;
            u32x2 pw; pw.x = pk2(o[0], o[1]); pw.y = pk2(o[2], o[3]);
            *(u32x2*)(xb + (size_t)row * DM + c) = pw;
        }
    }
}

#define MFMA16(a, b, c) __builtin_amdgcn_mfma_f32_16x16x32_bf16((a), (b), (c), 0, 0, 0)
constexpr int NSA_KT = 0, NSA_VT = 16384, NSA_IMP = 32768, NSA_FIN = 65536, NSA_SEL = LDS_MISC + 8192;

__device__ __forceinline__ int tile_off(int r, int c) { return r * 128 + ((c ^ ((r >> 1) & 7)) << 4); }

__device__ __forceinline__ unsigned cvtpk(float lo, float hi) { return pk2(lo, hi); }
struct SelMask { unsigned a, b, c, d; };
__device__ __forceinline__ unsigned selbit(unsigned a, unsigned b, unsigned c, unsigned d, int j) {
    const int k = j >> 5;
    const unsigned lo = (k & 1) ? b : a, hi = (k & 1) ? d : c;
    const unsigned r = (k & 2) ? hi : lo;
    return (r >> (j & 31)) & 1u;
}

struct NsaRT {
    bf16x8 q[2];
    f32x4 o[4];
    float m, l;
    int tk;
};

template <int MODE, int NST>
__device__ __forceinline__ void nsa_loop(LAS unsigned char* lds, int tid, int lane, int w, int jb, int je,
                                         const char* ksrc, size_t kstride, size_t ktile, const char* vsrc, size_t vstride, size_t vtile,
                                         NsaRT (&R)[2], const SelMask selm0, const SelMask selm1, float (&carry)[2], float* impw) {
    const int g = lane >> 4, qr = lane & 15;
    int tid2 = tid; asm volatile("" : "+v"(tid2));
    const int sr = tid2 >> 3, sc = (tid2 & 7) ^ ((sr >> 1) & 7);
    const char* kp = ksrc + (size_t)sr * kstride + sc * 16;
    const char* vp = vsrc + (size_t)sr * vstride + sc * 16;
    const unsigned ldsw = (unsigned)w * 1024u;
    const int fxq = (qr >> 1) & 7;
    const int ka0 = qr * 128 + ((g ^ fxq) << 4), ka1 = qr * 128 + (((4 + g) ^ fxq) << 4);
    const int vb = qr * 128 + (g & 1) * 8, vc = (g >> 1) ^ fxq;
    const int va0 = vb + (vc << 4), va1 = vb + ((vc ^ 2) << 4), va2 = vb + ((vc ^ 4) << 4), va3 = vb + ((vc ^ 6) << 4);
    if (jb > je) return;
    constexpr int D = NST - 1;
#define NSA_ISSUE(jj, st) do { const int jc_ = (jj) < je ? (jj) : je; \
        __builtin_amdgcn_global_load_lds((const unsigned*)(kp + (size_t)jc_ * ktile), (LAS unsigned*)(lds + (st) * 16384 + ldsw), 16, 0, 0); \
        if (MODE != 0) __builtin_amdgcn_global_load_lds((const unsigned*)(vp + (size_t)jc_ * vtile), (LAS unsigned*)(lds + (st) * 16384 + 8192 + ldsw), 16, 0, 0); } while (0)
#define NSA_WAIT_TILE() do { if (NST == 2) asm volatile("s_waitcnt vmcnt(0) lgkmcnt(0)" ::: "memory"); else asm volatile("s_waitcnt vmcnt(4) lgkmcnt(0)" ::: "memory"); } while (0)
#pragma unroll
    for (int d = 0; d < D; ++d) NSA_ISSUE(jb + d, d);
    NSA_WAIT_TILE();
    __builtin_amdgcn_s_barrier();
    for (int j = jb; j <= je; ++j) {
        const int cur = (j - jb) & (NST - 1);
        NSA_ISSUE(j + D, (j - jb + D) & (NST - 1));
        const LAS unsigned char* kt = lds + cur * 16384;
        const LAS unsigned char* vt = lds + cur * 16384 + 8192;
        bool anyact;
        {
            bool a = false;
#pragma unroll
            for (int rt = 0; rt < 2; ++rt) {
                const int tk = R[rt].tk;
                if (MODE <= 1) { const int nv = tk >= 31 ? ((tk - 31) >> 4) + 1 : 0; a = a || (nv > 64 * j); }
                else if (MODE == 2) a = a || ((rt == 0 ? selbit(selm0.a, selm0.b, selm0.c, selm0.d, j) : selbit(selm1.a, selm1.b, selm1.c, selm1.d, j)) != 0u);
                else a = a || ((64 * j <= tk) && (64 * j + 63 > tk - 512));
            }
            anyact = __any(a);
        }
        if (anyact) {
            f32x4 s[2][4];
#pragma unroll
            for (int t = 0; t < 4; ++t) {
                const bf16x8 k0 = *(const LAS bf16x8*)(kt + ka0 + t * 2048), k1 = *(const LAS bf16x8*)(kt + ka1 + t * 2048);
#pragma unroll
                for (int rt = 0; rt < 2; ++rt) {
                    s[rt][t] = (f32x4){0.f, 0.f, 0.f, 0.f};
                    s[rt][t] = MFMA16(k0, R[rt].q[0], s[rt][t]);
                    s[rt][t] = MFMA16(k1, R[rt].q[1], s[rt][t]);
                }
            }
            const int kb = 64 * j + 4 * g;
            bf16x8 pf[2][2];
            if (MODE == 1) {
#pragma unroll
                for (int rt = 0; rt < 2; ++rt) {
                    const int tk = R[rt].tk;
                    const int nv = tk >= 31 ? ((tk - 31) >> 4) + 1 : 0;
                    const float mL = R[rt].m * 1.44269504f, invl = R[rt].l > 0.f ? 1.f / R[rt].l : 0.f;
                    float p[4][4];
#pragma unroll
                    for (int t = 0; t < 4; ++t)
#pragma unroll
                        for (int i = 0; i < 4; ++i) { const int key = kb + 16 * t + i; p[t][i] = (key < nv) ? __builtin_amdgcn_exp2f(fmaf(s[rt][t][i], 1.44269504f, -mL)) * invl : 0.f; }
#pragma unroll
                    for (int t = 0; t < 4; ++t) {
                        const float own = (p[t][0] + p[t][1]) + (p[t][2] + p[t][3]);
                        const float x3 = p[t][3];
                        const float up_cur = __shfl(x3, (lane + 48) & 63);
                        const float up_prev = __shfl(carry[rt], (lane + 48) & 63);
                        float v = own + (g >= 1 ? up_cur : up_prev);
                        v += __shfl_xor(v, 1);
                        v += __shfl_xor(v, 2);
                        carry[rt] = x3;
                        if ((qr & 3) == 0) impw[(4 * rt + (qr >> 2)) * 128 + 16 * j + 4 * t + g] = v;
                    }
#pragma unroll
                    for (int ks = 0; ks < 2; ++ks) {
                        u32x4 pu; pu.x = cvtpk(p[2 * ks][0], p[2 * ks][1]); pu.y = cvtpk(p[2 * ks][2], p[2 * ks][3]); pu.z = cvtpk(p[2 * ks + 1][0], p[2 * ks + 1][1]); pu.w = cvtpk(p[2 * ks + 1][2], p[2 * ks + 1][3]);
                        pf[rt][ks] = __builtin_bit_cast(bf16x8, pu);
                    }
                }
            } else {
                int lim_hi[2], lim_lo[2];
                bool none[2], part[2];
#pragma unroll
                for (int rt = 0; rt < 2; ++rt) {
                    const int tk = R[rt].tk;
                    if (MODE == 0) { const int nv = tk >= 31 ? ((tk - 31) >> 4) + 1 : 0; lim_hi[rt] = nv - 1; lim_lo[rt] = -1; }
                    else if (MODE == 2) { lim_hi[rt] = ((rt == 0 ? selbit(selm0.a, selm0.b, selm0.c, selm0.d, j) : selbit(selm1.a, selm1.b, selm1.c, selm1.d, j)) != 0u) ? tk : -1; lim_lo[rt] = -1; }
                    else { lim_hi[rt] = tk; lim_lo[rt] = tk - 512; }
                    const bool full = (64 * j + 63 <= lim_hi[rt]) && (64 * j > lim_lo[rt]);
                    none[rt] = (64 * j > lim_hi[rt]) || (64 * j + 63 <= lim_lo[rt]);
                    part[rt] = !full && !none[rt];
                }
                float lmx[2];
                if (__any(part[0] || part[1])) {
#pragma unroll
                    for (int rt = 0; rt < 2; ++rt) {
                        float mx = NEG_INF;
#pragma unroll
                        for (int t = 0; t < 4; ++t)
#pragma unroll
                            for (int i = 0; i < 4; ++i) {
                                const int key = kb + 16 * t + i;
                                const bool ok = (key <= lim_hi[rt]) && (key > lim_lo[rt]);
                                s[rt][t][i] = ok ? s[rt][t][i] : NEG_INF;
                                mx = fmaxf(mx, s[rt][t][i]);
                            }
                        lmx[rt] = mx;
                        none[rt] = false;
                    }
                } else {
#pragma unroll
                    for (int rt = 0; rt < 2; ++rt) {
                        float mx = NEG_INF;
#pragma unroll
                        for (int t = 0; t < 4; ++t)
#pragma unroll
                            for (int i = 0; i < 4; ++i) mx = fmaxf(mx, s[rt][t][i]);
                        lmx[rt] = none[rt] ? NEG_INF : mx;
                    }
                }
                if (__any((lmx[0] > R[0].m + 6.f) || (lmx[1] > R[1].m + 6.f))) {
#pragma unroll
                    for (int rt = 0; rt < 2; ++rt) {
                        float mx = lmx[rt];
                        mx = fmaxf(mx, __shfl_xor(mx, 16));
                        mx = fmaxf(mx, __shfl_xor(mx, 32));
                        const float mn = fmaxf(R[rt].m, mx);
                        const float alpha = __expf(R[rt].m - mn);
                        R[rt].l *= alpha; R[rt].m = mn;
                        if (MODE != 0) {
#pragma unroll
                            for (int dt = 0; dt < 4; ++dt) R[rt].o[dt] = R[rt].o[dt] * alpha;
                        }
                    }
                }
#pragma unroll
                for (int rt = 0; rt < 2; ++rt) {
                    const float negmL = none[rt] ? -1e30f : -fmaxf(R[rt].m, -1e4f) * 1.44269504f;
                    float p[4][4];
                    float rs = 0.f;
#pragma unroll
                    for (int t = 0; t < 4; ++t)
#pragma unroll
                        for (int i = 0; i < 4; ++i) { p[t][i] = __builtin_amdgcn_exp2f(fmaf(s[rt][t][i], 1.44269504f, negmL)); rs += p[t][i]; }
                    R[rt].l += rs;
                    if (MODE != 0) {
#pragma unroll
                        for (int ks = 0; ks < 2; ++ks) {
                            u32x4 pu; pu.x = cvtpk(p[2 * ks][0], p[2 * ks][1]); pu.y = cvtpk(p[2 * ks][2], p[2 * ks][3]); pu.z = cvtpk(p[2 * ks + 1][0], p[2 * ks + 1][1]); pu.w = cvtpk(p[2 * ks + 1][2], p[2 * ks + 1][3]);
                            pf[rt][ks] = __builtin_bit_cast(bf16x8, pu);
                        }
                    }
                }
            }
            if (MODE != 0) {
#pragma unroll
                for (int ks = 0; ks < 2; ++ks)
#pragma unroll
                    for (int dt = 0; dt < 4; ++dt) {
                        const u32x2 lo = *(const LAS u32x2*)(vt + (ks ? va2 : va0) + dt * 2048);
                        const u32x2 hi = *(const LAS u32x2*)(vt + (ks ? va3 : va1) + dt * 2048);
                        u32x4 vu; vu.x = lo.x; vu.y = lo.y; vu.z = hi.x; vu.w = hi.y;
                        const bf16x8 vf = __builtin_bit_cast(bf16x8, vu);
                        R[0].o[dt] = MFMA16(vf, pf[0][ks], R[0].o[dt]);
                        R[1].o[dt] = MFMA16(vf, pf[1][ks], R[1].o[dt]);
                    }
            }
        }
        NSA_WAIT_TILE();
        __builtin_amdgcn_s_barrier();
    }
    asm volatile("s_waitcnt vmcnt(0)" ::: "memory");
    __builtin_amdgcn_s_barrier();
#undef NSA_ISSUE
#undef NSA_WAIT_TILE
}

__device__ void phase_nsa2(KA ka, int layer, LAS unsigned char* lds) {
    PHASE_IDS
    const int tid = TID, lane = tid & 63, w = __builtin_amdgcn_readfirstlane(tid >> 6), g = lane >> 4, qr = lane & 15;
    const bf16_t* H = PF(H);
    const bf16_t* kcb = PF(kcb);
    const bf16_t* vcT = PF(vcT);
    const bf16_t* vsT = PF(vsT);
    const bf16_t* vwT = PF(vwT);
    bf16_t* Y = PF(Y);
    const float* gate_b = PF(nsa_gate_b) + layer * 24;
    const float* ogain = PF(out_gain) + layer * 1024;
    float* impw = (float*)(lds + NSA_IMP + w * 4096);
    unsigned* selw = (unsigned*)(lds + NSA_SEL + w * 128);
    for (int base = BID; base < 256; base += gridDim.x) {
#pragma unroll 1
        for (int half = 0; half < 2; ++half) {
            const int it = half ? 511 - base : base;
            const int chunk = it >> 2, bh = it & 3, b = bh >> 1, hk = bh & 1;
            const size_t rowbase = (size_t)b * T_;
            const int t0w = chunk * 64 + w * 8;
            NsaRT R[2];
            LAS f32x4* finw = (LAS f32x4*)(lds + NSA_FIN + w * 8192) + lane;
#pragma unroll
            for (int rt = 0; rt < 2; ++rt) {
                const int tk = t0w + 4 * rt + (qr >> 2), hh = hk * 4 + (qr & 3);
                R[rt].tk = tk;
                const bf16_t* qp = H + (rowbase + tk) * HLD + C_NQ + hh * 64 + 8 * g;
#pragma unroll
                for (int ks = 0; ks < 2; ++ks) {
                    const u32x4 u = *(const u32x4*)(qp + 32 * ks);
                    const unsigned uu[4] = {u.x, u.y, u.z, u.w};
                    u32x4 o4;
#pragma unroll
                    for (int e = 0; e < 4; ++e) {
                        const float f0 = __uint_as_float(uu[e] << 16) * 0.125f, f1 = __uint_as_float(uu[e] & 0xffff0000u) * 0.125f;
                        o4[e] = (__float_as_uint(f0) >> 16) | (__float_as_uint(f1) & 0xffff0000u);
                    }
                    R[rt].q[ks] = __builtin_bit_cast(bf16x8, o4);
                }
                R[rt].m = NEG_INF; R[rt].l = 0.f;
#pragma unroll
                for (int dt = 0; dt < 4; ++dt) R[rt].o[dt] = (f32x4){0.f, 0.f, 0.f, 0.f};
            }
            SelMask selm0{0u, 0u, 0u, 0u}, selm1{0u, 0u, 0u, 0u};
            float carry[2] = {0.f, 0.f};
            const int tmax = chunk * 64 + 63;
            const int nvmax = tmax >= 31 ? ((tmax - 31) >> 4) + 1 : 0;
            const int nb = (nvmax + 63) >> 6;
            const char* kc_src = (const char*)(kcb + (size_t)bh * 512 * 64);
            const char* vc_src = (const char*)(vcT + (size_t)bh * 64 * 512);
            nsa_loop<0, 2>(lds, tid, lane, w, 0, nb - 1, kc_src, 128, 64 * 128, nullptr, 0, 0, R, selm0, selm1, carry, impw);
#pragma unroll
            for (int rt = 0; rt < 2; ++rt) { float l = R[rt].l; l += __shfl_xor(l, 16); l += __shfl_xor(l, 32); R[rt].l = l; }
            for (int i = lane; i < 8 * 128; i += 64) impw[i] = 0.f;
            wave_sync();
            nsa_loop<1, 2>(lds, tid, lane, w, 0, nb - 1, kc_src, 128, 64 * 128, vc_src, 512 * 2, 64 * 2, R, selm0, selm1, carry, impw);
#pragma unroll
            for (int rt = 0; rt < 2; ++rt) {
                const int hh = hk * 4 + (qr & 3);
                const float gt = sigmoidf_(bf2f(H[(rowbase + R[rt].tk) * HLD + C_NG + hh * 3 + 0]) + gate_b[hh * 3 + 0]);
#pragma unroll
                for (int dt = 0; dt < 4; ++dt) { finw[(rt * 4 + dt) * 64] = R[rt].o[dt] * gt; R[rt].o[dt] = (f32x4){0.f, 0.f, 0.f, 0.f}; }
            }
            wave_sync();
            {
                const int tl = lane >> 3, sub = lane & 7;
                const int tks = t0w + tl, curb = tks >> 6;
                float v[16];
#pragma unroll
                for (int i = 0; i < 16; ++i) {
                    const int jj = sub * 16 + i;
                    const float a = impw[tl * 128 + jj];
                    const bool forced = (jj == 0) || (jj == curb) || (jj == curb - 1);
                    v[i] = (jj <= curb) ? (a + (forced ? 1e4f : 0.f)) : NEG_INF;
                }
                wave_sync();
#pragma unroll
                for (int i = 0; i < 16; ++i) impw[tl * 128 + sub * 16 + i] = v[i];
                wave_sync();
                int cnt[16];
#pragma unroll
                for (int i = 0; i < 16; ++i) cnt[i] = 0;
                for (int jj = 0; jj < 128; ++jj) {
                    const float x = impw[tl * 128 + jj];
#pragma unroll
                    for (int i = 0; i < 16; ++i) cnt[i] += (x > v[i]) || (x == v[i] && jj < sub * 16 + i);
                }
                unsigned bits = 0u;
#pragma unroll
                for (int i = 0; i < 16; ++i) bits |= ((cnt[i] < 16) && (v[i] > 0.5f * NEG_INF)) ? (1u << i) : 0u;
                const unsigned other = __shfl_xor(bits, 1);
                const unsigned word = (sub & 1) ? ((bits << 16) | other) : (bits | (other << 16));
                if ((sub & 1) == 0) selw[tl * 4 + (sub >> 1)] = word;
                wave_sync();
                { const unsigned* q0 = selw + (qr >> 2) * 4; selm0.a = q0[0]; selm0.b = q0[1]; selm0.c = q0[2]; selm0.d = q0[3];
                  selm1.a = q0[16]; selm1.b = q0[17]; selm1.c = q0[18]; selm1.d = q0[19]; }
                wave_sync();
            }
            __syncthreads();
#pragma unroll
            for (int rt = 0; rt < 2; ++rt) { R[rt].m = NEG_INF; R[rt].l = 0.f; }
            nsa_loop<2, 4>(lds, tid, lane, w, 0, chunk, (const char*)(H + rowbase * HLD + C_KS + hk * 64), (size_t)HLD * 2, (size_t)64 * HLD * 2,
                        (const char*)(vsT + (size_t)bh * 64 * T_), (size_t)T_ * 2, 64 * 2, R, selm0, selm1, carry, impw);
#pragma unroll
            for (int rt = 0; rt < 2; ++rt) {
                const int hh = hk * 4 + (qr & 3);
                const float gt = sigmoidf_(bf2f(H[(rowbase + R[rt].tk) * HLD + C_NG + hh * 3 + 1]) + gate_b[hh * 3 + 1]);
                float ltot = R[rt].l; ltot += __shfl_xor(ltot, 16); ltot += __shfl_xor(ltot, 32);
                const float sc = gt / ltot;
#pragma unroll
                for (int dt = 0; dt < 4; ++dt) { finw[(rt * 4 + dt) * 64] += R[rt].o[dt] * sc; R[rt].o[dt] = (f32x4){0.f, 0.f, 0.f, 0.f}; }
                R[rt].m = NEG_INF; R[rt].l = 0.f;
            }
            nsa_loop<3, 4>(lds, tid, lane, w, chunk >= 8 ? chunk - 8 : 0, chunk, (const char*)(H + rowbase * HLD + C_KW + hk * 64), (size_t)HLD * 2, (size_t)64 * HLD * 2,
                        (const char*)(vwT + (size_t)bh * 64 * T_), (size_t)T_ * 2, 64 * 2, R, selm0, selm1, carry, impw);
#pragma unroll
            for (int rt = 0; rt < 2; ++rt) {
                const int tk = R[rt].tk, hh = hk * 4 + (qr & 3);
                const float gt = sigmoidf_(bf2f(H[(rowbase + tk) * HLD + C_NG + hh * 3 + 2]) + gate_b[hh * 3 + 2]);
                float ltot = R[rt].l; ltot += __shfl_xor(ltot, 16); ltot += __shfl_xor(ltot, 32);
                const float sc = gt / ltot;
                bf16_t* yp = Y + (rowbase + tk) * DM + 256 + hh * 64 + 4 * g;
                f32x4 ov[4];
                float ss = 0.f;
#pragma unroll
                for (int dt = 0; dt < 4; ++dt) { ov[dt] = finw[(rt * 4 + dt) * 64] + R[rt].o[dt] * sc; ss += (ov[dt][0] * ov[dt][0] + ov[dt][1] * ov[dt][1]) + (ov[dt][2] * ov[dt][2] + ov[dt][3] * ov[dt][3]); }
                ss += __shfl_xor(ss, 16);
                ss += __shfl_xor(ss, 32);
                const float rn = rsqrtf(ss * (1.f / 64.f) + 1e-6f);
#pragma unroll
                for (int dt = 0; dt < 4; ++dt) {
                    const f32x4 o = ov[dt] * rn * *(const f32x4*)(ogain + 256 + hh * 64 + 16 * dt + 4 * g);
                    u32x2 wv; wv.x = pk2(o[0], o[1]); wv.y = pk2(o[2], o[3]);
                    *(u32x2*)(yp + 16 * dt) = wv;
                }
            }
        }
    }
}

__device__ void phase_vtrans(KA ka, float* smem) {
    PHASE_IDS
    const int lane = TID & 63, w = TID >> 6;
    bf16_t* scr = (bf16_t*)(smem + w * 4096);
    const bf16_t* H = PF(H);
    for (int it = BID * NW + w; it < 1024; it += gridDim.x * NW) {
        const int tt = it & 127, bh = (it >> 7) & 3, which = it >> 9;
        const int b = bh >> 1, hk = bh & 1;
        const size_t tok0 = (size_t)b * T_ + tt * 64;
        const int col = (which ? C_VW : C_VS) + hk * 64;
        bf16_t* dst = (which ? PF(vwT) : PF(vsT)) + (size_t)bh * 64 * T_ + tt * 64;
        wave_sync();
        for (int i = 0; i < 64; ++i) scr[lane * 66 + i] = H[(tok0 + i) * HLD + col + lane];
        wave_sync();
        for (int d = 0; d < 64; ++d) dst[(size_t)d * T_ + lane] = scr[d * 66 + lane];
    }
}

__device__ void phase_hgrnA(KA ka, int layer, LAS unsigned char* lds, int first, int nblk) {
    PHASE_IDS
    const int tid = TID, lane = tid & 63, w = __builtin_amdgcn_readfirstlane(tid >> 6), gq = lane >> 4, lc = lane & 15;
    float* Q = (float*)lds;
    float* K = Q + 64 * 68;
    float* Bc = K + 64 * 68;
    float* SEG = Bc + 64 * 68;
    LAS bf16_t* ATb = (LAS bf16_t*)(lds + 57344);
    LAS bf16_t* ItB = ATb + 64 * 72;
    LAS bf16_t* KtB = ItB + 64 * 72;
    const bf16_t* H = PF(H);
    const float* hgl = PF(hg_lower);
    float* hgU = PF(hgU); float* hgG = PF(hgG); bf16_t* hgQB = PF(hgQB); bf16_t* hgO = PF(hgO);
    if (BID < first) return;
    for (int item = BID - first; item < 1024; item += nblk) {
        const int c = item & 127, bh = item >> 7, h = bh & 3, b = bh >> 2;
        const size_t tok0 = (size_t)b * T_ + c * 64;
        __syncthreads();
#pragma unroll
        for (int i = 0; i < 8; ++i) {
            const int e = tid + i * NTHR, t = e >> 6, d = e & 63;
            float lb = 0.f;
            if (layer == 1) {
                const float h0 = hgl[h * 64 + d], h1 = hgl[256 + h * 64 + d];
                const float mx = fmaxf(h0, h1), e0 = expf(h0 - mx), e1 = expf(h1 - mx);
                lb = e1 / (e0 + e1);
            }
            const bf16_t* hp = H + (tok0 + t) * HLD + h * 64 + d;
            const float fl = bf2f(hp[C_HF]);
            const float sg = 1.f / (1.f + expf(-fl)), sgn = 1.f / (1.f + expf(fl));
            const float f = lb + (1.f - lb) * sg;
            Q[t * 68 + d] = bf2f(hp[C_HQ]);
            K[t * 68 + d] = (1.f - lb) * sgn;
            ItB[d * 72 + t] = hp[C_HI];
            Bc[t * 68 + d] = logf(fmaxf(f, 1e-38f));
        }
        __syncthreads();
        {
            const int d = lane, seg = w;
            float run = 0.f;
#pragma unroll
            for (int i = 0; i < 8; ++i) { run += Bc[(seg * 8 + i) * 68 + d]; Bc[(seg * 8 + i) * 68 + d] = run; }
            SEG[seg * 64 + d] = run;
            __syncthreads();
            float pre = 0.f;
            for (int s2 = 0; s2 < seg; ++s2) pre += SEG[s2 * 64 + d];
#pragma unroll
            for (int i = 0; i < 8; ++i) Bc[(seg * 8 + i) * 68 + d] += pre;
        }
        __syncthreads();
        {
            const int blk = tid >> 1, dh = tid & 1, tb = blk >> 4, sb = blk & 15;
            float acc[4][4];
#pragma unroll
            for (int i = 0; i < 4; ++i)
#pragma unroll
                for (int j = 0; j < 4; ++j) acc[i][j] = 0.f;
            if (sb <= tb) {
#pragma unroll 2
                for (int d0 = 32 * dh; d0 < 32 * dh + 32; d0 += 4) {
                    f32x4 qv[4], bt[4], kv[4], bsv[4];
#pragma unroll
                    for (int i = 0; i < 4; ++i) { qv[i] = *(const f32x4*)&Q[(4 * tb + i) * 68 + d0]; bt[i] = *(const f32x4*)&Bc[(4 * tb + i) * 68 + d0]; }
#pragma unroll
                    for (int j = 0; j < 4; ++j) { kv[j] = *(const f32x4*)&K[(4 * sb + j) * 68 + d0]; bsv[j] = *(const f32x4*)&Bc[(4 * sb + j) * 68 + d0]; }
#pragma unroll
                    for (int i = 0; i < 4; ++i)
#pragma unroll
                        for (int j = 0; j < 4; ++j)
#pragma unroll
                            for (int dd = 0; dd < 4; ++dd) acc[i][j] = fmaf(qv[i][dd] * kv[j][dd], __expf(fminf(bt[i][dd] - bsv[j][dd], 0.f)), acc[i][j]);
                }
            }
#pragma unroll
            for (int i = 0; i < 4; ++i)
#pragma unroll
                for (int j = 0; j < 4; ++j) { acc[i][j] += __shfl_xor(acc[i][j], 1); if (4 * sb + j > 4 * tb + i) acc[i][j] = 0.f; }
            if (dh == 0) {
#pragma unroll
                for (int i = 0; i < 4; ++i) {
                    u32x2 pw; pw.x = pk2(acc[i][0], acc[i][1]); pw.y = pk2(acc[i][2], acc[i][3]);
                    *(LAS u32x2*)(ATb + (4 * tb + i) * 72 + 4 * sb) = pw;
                }
            }
        }
#pragma unroll
        for (int i = 0; i < 8; ++i) {
            const int e = tid + i * NTHR, t = e >> 6, d = e & 63;
            const float bt = Bc[t * 68 + d];
            hgQB[(size_t)item * 4096 + e] = f2bf(Q[t * 68 + d] * __expf(bt));
            KtB[d * 72 + t] = f2bf(K[t * 68 + d] * __expf(Bc[63 * 68 + d] - bt));
        }
        if (tid < 64) hgG[(size_t)item * 64 + tid] = __expf(Bc[63 * 68 + tid]);
        __syncthreads();
#pragma unroll
        for (int q = 0; q < 4; ++q) {
            const int tile = w * 4 + q, isU = tile >> 4, rt_ = (tile >> 2) & 3, ct = tile & 3;
            const LAS bf16_t* Ab = (isU ? KtB : ATb) + (16 * rt_ + lc) * 72 + 8 * gq;
            const LAS bf16_t* Bb = ItB + (16 * ct + lc) * 72 + 8 * gq;
            f32x4 acc = (f32x4){0.f, 0.f, 0.f, 0.f};
            acc = MFMA16(*(const LAS bf16x8*)Ab, *(const LAS bf16x8*)Bb, acc);
            acc = MFMA16(*(const LAS bf16x8*)(Ab + 32), *(const LAS bf16x8*)(Bb + 32), acc);
#pragma unroll
            for (int i = 0; i < 4; ++i) {
                const int r = 16 * rt_ + 4 * gq + i, cc = 16 * ct + lc;
                if (isU) hgU[((size_t)item * 64 + r) * 64 + cc] = acc[i];
                else hgO[((size_t)item * 64 + r) * 64 + cc] = f2bf(acc[i]);
            }
        }
    }
}

__device__ void phase_hgrnB(KA ka) {
    PHASE_IDS
    const float* hgU = PF(hgU); const float* hgG = PF(hgG); float* hgS = PF(hgS);
    for (int gid = BID * NTHR + TID; gid < 32768; gid += gridDim.x * NTHR) {
        const int bh = gid >> 12, dv = gid & 4095, d = dv >> 6;
        float S = 0.f;
        for (int c0 = 0; c0 < 128; c0 += 8) {
            float u[8], gg[8];
#pragma unroll
            for (int k = 0; k < 8; ++k) { const size_t item = (size_t)bh * 128 + c0 + k; u[k] = hgU[item * 4096 + dv]; gg[k] = hgG[item * 64 + d]; }
#pragma unroll
            for (int k = 0; k < 8; ++k) { const size_t item = (size_t)bh * 128 + c0 + k; hgS[item * 4096 + dv] = S; S = fmaf(gg[k], S, u[k]); }
        }
    }
}

__device__ void phase_hgrnC(KA ka, int layer, LAS unsigned char* lds) {
    PHASE_IDS
    const int tid = TID, lane = tid & 63, w = __builtin_amdgcn_readfirstlane(tid >> 6), gq = lane >> 4, lc = lane & 15;
    LAS bf16_t* QBb = (LAS bf16_t*)lds;
    LAS bf16_t* StB = QBb + 64 * 72;
    float* OT = (float*)(lds + 32768);
    const bf16_t* H = PF(H);
    const float* hgS = PF(hgS); const bf16_t* hgQB = PF(hgQB); const bf16_t* hgO = PF(hgO);
    const float* og = PF(out_gain) + layer * 1024;
    bf16_t* Y = PF(Y);
    for (int item = BID; item < 1024; item += gridDim.x) {
        const int c = item & 127, bh = item >> 7, h = bh & 3, b = bh >> 2;
        const size_t tok0 = (size_t)b * T_ + c * 64;
        __syncthreads();
#pragma unroll
        for (int i = 0; i < 8; ++i) {
            const int e = tid + i * NTHR, r = e >> 6, cc = e & 63;
            QBb[r * 72 + cc] = hgQB[(size_t)item * 4096 + e];
            StB[cc * 72 + r] = f2bf(hgS[(size_t)item * 4096 + e]);
        }
        __syncthreads();
#pragma unroll
        for (int q = 0; q < 2; ++q) {
            const int tile = w * 2 + q, rt_ = tile >> 2, ct = tile & 3;
            const LAS bf16_t* Ab = QBb + (16 * rt_ + lc) * 72 + 8 * gq;
            const LAS bf16_t* Bb = StB + (16 * ct + lc) * 72 + 8 * gq;
            f32x4 acc = (f32x4){0.f, 0.f, 0.f, 0.f};
            acc = MFMA16(*(const LAS bf16x8*)Ab, *(const LAS bf16x8*)Bb, acc);
            acc = MFMA16(*(const LAS bf16x8*)(Ab + 32), *(const LAS bf16x8*)(Bb + 32), acc);
#pragma unroll
            for (int i = 0; i < 4; ++i) {
                const int t = 16 * rt_ + 4 * gq + i, v = 16 * ct + lc;
                OT[t * 65 + v] = acc[i] + bf2f(hgO[((size_t)item * 64 + t) * 64 + v]);
            }
        }
        __syncthreads();
#pragma unroll 1
        for (int i = 0; i < 8; ++i) {
            const int t = w + 8 * i, v = lane;
            const float acc = OT[t * 65 + v];
            const float ms = wave_sum(acc * acc) * (1.f / 64.f);
            const float hg = bf2f(H[(tok0 + t) * HLD + C_HG + h * 64 + v]);
            const float y = acc * rsqrtf(ms + 1e-6f) * og[768 + h * 64 + v] * (hg * sigmoidf_(hg));
            Y[(tok0 + t) * DM + 768 + h * 64 + v] = f2bf(y);
        }
    }
}

struct CmpOrder {
    static constexpr bool GATHER = false;
    const char* W1T; int c;
    __device__ __forceinline__ bool next(int i, pg8::Unit& u) const {
        if (i > 0 || c >= 16) return false;
        const int which = c >> 3, bh = (c >> 1) & 3, nt = c & 1;
        u.arow0 = (bh >> 1) * 512 + nt * 256; u.nrows = 256; u.pm = nt; u.pn = 0; u.e = which * 4 + bh; u.ui = 0;
        u.bptr = W1T + (size_t)which * 256 * 2048 * 2;
        return true;
    }
    __device__ __forceinline__ int arow(const pg8::Unit& u, int r) const { return u.arow0 + r; }
    __device__ __forceinline__ int lda(int) const { return 16 * HLD; }
    __device__ __forceinline__ unsigned kstepA() const { return (unsigned)(HLD * 2); }
    __device__ __forceinline__ const char* abase(const pg8::Unit& u, const char* A) const { return A + (((u.e >> 2) ? C_VC : C_KC) + (u.e & 1) * 64) * 2; }
};
struct EpiCmp {
    static constexpr bool PERM = true;
    bf16_t* G; const float* cbias;
    __device__ __forceinline__ void operator()(const f32x4 (&acc)[2][2][4][2], const pg8::Unit& u, int wr, int wc, int fr, int fq) const {
        const float* bp = cbias + (u.e >> 2) * 128 + wc * 32 + 8 * fq;
        const f32x4 b0 = *(const f32x4*)bp, b1 = *(const f32x4*)(bp + 4);
#pragma unroll
        for (int ai = 0; ai < 2; ++ai)
#pragma unroll
            for (int m = 0; m < 4; ++m) {
                const int r = ai * 128 + wr * 64 + m * 16 + fr;
                bf16_t* rowp = G + ((size_t)(u.e * 512 + u.pm * 256 + r)) * 128 + wc * 32 + 8 * fq;
                const f32x4 v0 = acc[ai][0][m][0] + b0, v1 = acc[ai][0][m][1] + b1;
                u32x4 w; w.x = pk2(gelu_slow(v0[0]), gelu_slow(v0[1])); w.y = pk2(gelu_slow(v0[2]), gelu_slow(v0[3])); w.z = pk2(gelu_slow(v1[0]), gelu_slow(v1[1])); w.w = pk2(gelu_slow(v1[2]), gelu_slow(v1[3]));
                *(u32x4*)rowp = w;
            }
    }
};
__device__ void phase_compress2(KA ka, int layer, LAS unsigned char* lds) {
    const int bid = opaque_bid();
    if (bid >= 16) return;
    CmpOrder S{(const char*)(PF(WT) + WT_C1), bid};
    EpiCmp E{PF(gb), PF(cbias)};
    pg8::gemm_phase<EpiCmp, CmpOrder>(lds, (const char*)PF(H), 2048, S, E);
    __syncthreads();
    const int tid = opaque_tid();
    const int which = bid >> 3, bh = (bid >> 1) & 3, nt = bid & 1;
    float* w2s = (float*)lds;
    const float* w2 = PF(cmp_w2) + ((size_t)layer * 2 + which) * 128 * 64;
    for (int i = tid; i < 128 * 64; i += NTHR) w2s[i] = w2[i];
    __syncthreads();
    const int r = tid >> 1, half = tid & 1;
    const bf16_t* grow = PF(gb) + ((size_t)((which * 4 + bh) * 512 + nt * 256 + r)) * 128;
    float acc[32];
#pragma unroll
    for (int j = 0; j < 32; ++j) acc[j] = 0.f;
    for (int c8 = 0; c8 < 16; ++c8) {
        const u32x4 gu = *(const u32x4*)(grow + c8 * 8);
        const unsigned gw[4] = {gu.x, gu.y, gu.z, gu.w};
#pragma unroll
        for (int e = 0; e < 8; ++e) {
            const float gv = (e & 1) ? __uint_as_float(gw[e >> 1] & 0xffff0000u) : __uint_as_float(gw[e >> 1] << 16);
            const float* wrow = w2s + (c8 * 8 + e) * 64 + half * 32;
#pragma unroll
            for (int j4 = 0; j4 < 8; ++j4) {
                const float4 w4 = *(const float4*)(wrow + j4 * 4);
                acc[j4 * 4 + 0] = fmaf(gv, w4.x, acc[j4 * 4 + 0]); acc[j4 * 4 + 1] = fmaf(gv, w4.y, acc[j4 * 4 + 1]);
                acc[j4 * 4 + 2] = fmaf(gv, w4.z, acc[j4 * 4 + 2]); acc[j4 * 4 + 3] = fmaf(gv, w4.w, acc[j4 * 4 + 3]);
            }
        }
    }
    const int n = nt * 256 + r;
    if (which == 0) {
        bf16_t* o = PF(kcb) + ((size_t)bh * 512 + n) * 64 + half * 32;
#pragma unroll
        for (int j = 0; j < 32; j += 2) *(unsigned*)(o + j) = pk2(acc[j], acc[j + 1]);
    } else {
        bf16_t* o = PF(vcT) + (size_t)bh * 64 * 512 + n;
#pragma unroll
        for (int j = 0; j < 32; ++j) o[(size_t)(half * 32 + j) * 512] = f2bf(acc[j]);
    }
    __syncthreads();
}

__device__ void phase_gmlp2(KA ka, int layer, LAS unsigned char* lds, int first, int nblk) {
    PHASE_IDS
    const int tid = TID, lane = tid & 63, w = __builtin_amdgcn_readfirstlane(tid >> 6), gq = lane >> 4, lc = lane & 15;
    LAS bf16_t* Vt = (LAS bf16_t*)lds;
    const float* gain = PF(gm_v_gain) + layer * 256;
    const float* bias = PF(gm_v_bias) + layer * 256;
    const float* bs = PF(gm_b_s) + layer * 4 * 128;
    const bf16_t* gmW = PF(WT) + WT_GM;
    const bf16_t* H = PF(H);
    bf16_t* Y = PF(Y);
    if (BID < first) return;
    for (int item = BID - first; item < 512; item += nblk) {
        const int g = item & 3, c = (item >> 2) & 63, b = item >> 8;
        const size_t tok0 = (size_t)b * T_ + (size_t)c * 128;
        __syncthreads();
        for (int i = 0; i < 16; ++i) {
            const int s = w * 16 + i;
            const float x = bf2f(H[(tok0 + s) * HLD + C_GV + g * 64 + lane]);
            const float ge = gelu_slow(x);
            const float mu = wave_sum(ge) * (1.f / 64.f);
            const float dl = ge - mu;
            const float var = wave_sum(dl * dl) * (1.f / 64.f);
            Vt[lane * 136 + s] = f2bf(dl * rsqrtf(var + 1e-5f) * gain[g * 64 + lane] + bias[g * 64 + lane]);
        }
        __syncthreads();
        f32x4 acc[4];
#pragma unroll
        for (int ct = 0; ct < 4; ++ct) acc[ct] = (f32x4){0.f, 0.f, 0.f, 0.f};
        const bf16_t* wrow = gmW + ((size_t)g * 128 + 16 * w + lc) * 128 + 8 * gq;
        const int kmax = (16 * w + 15) >> 5;
        for (int ks = 0; ks <= kmax; ++ks) {
            const bf16x8 a = *(const bf16x8*)(wrow + 32 * ks);
#pragma unroll
            for (int ct = 0; ct < 4; ++ct) {
                const bf16x8 bfr = *(const LAS bf16x8*)(Vt + (16 * ct + lc) * 136 + 32 * ks + 8 * gq);
                acc[ct] = MFMA16(a, bfr, acc[ct]);
            }
        }
        const float* ogain = PF(out_gain) + layer * 1024;
#pragma unroll
        for (int i = 0; i < 4; ++i) {
            const int t = 16 * w + 4 * gq + i;
            float yv[4];
            float ss = 0.f;
#pragma unroll
            for (int ct = 0; ct < 4; ++ct) {
                const int d = 16 * ct + lc;
                const float z = acc[ct][i] + bs[g * 128 + t];
                const float u = gelu_slow(bf2f(H[(tok0 + t) * HLD + C_GU + g * 64 + d]));
                yv[ct] = u * z;
                ss += yv[ct] * yv[ct];
            }
            ss += __shfl_xor(ss, 1); ss += __shfl_xor(ss, 2); ss += __shfl_xor(ss, 4); ss += __shfl_xor(ss, 8);
            const float rn = rsqrtf(ss * (1.f / 64.f) + 1e-6f);
#pragma unroll
            for (int ct = 0; ct < 4; ++ct) {
                const int d = 16 * ct + lc;
                Y[(tok0 + t) * DM + g * 64 + d] = f2bf(yv[ct] * rn * ogain[g * 64 + d]);
            }
        }
    }
}

#ifndef ONLY_Q
#define ONLY_Q -2
#endif
#ifndef QMASK
#define QMASK 0x3ff
#endif
#define QON(k) ((ONLY_Q == -2 && ((QMASK >> ((k) + 1)) & 1)) || ONLY_Q == (k))
#ifndef DUPMASK
#define DUPMASK 0
#endif
#define DUP(k) ((DUPMASK >> (k)) & 1)
#ifndef PROF_LO
#define PROF_LO -1
#endif
#ifndef PROF_HI
#define PROF_HI -1
#endif
#ifndef NPH_TOTAL
#define NPH_TOTAL 19
#endif
__global__ void __launch_bounds__(NTHR, 2) k_mega(P p0) {
    extern __shared__ __attribute__((aligned(16))) unsigned char lds_raw[];
    LAS unsigned char* lds = (LAS unsigned char*)lds_raw;
    float* smem = (float*)lds_raw;
    volatile LAS unsigned* misc = (volatile LAS unsigned*)(lds + LDS_MISC);
    if (threadIdx.x < 16) misc[threadIdx.x] = 0u;
    __syncthreads();
    XcdBarrier bar = xcd_barrier_post(p0.ctl + CW_BAR, misc);
    if (PROF_LO >= 0 && blockIdx.x == 0 && threadIdx.x == 0) ((unsigned long long*)(p0.ctl + 8192))[0] = __builtin_amdgcn_s_memrealtime();
#pragma unroll 1
    for (int ph = 0; ph < p0.nph; ph++) {
        const int layer = ph == 0 ? 0 : (ph - 1) / 9, q = ph == 0 ? -1 : (ph - 1) % 9;
        const int dupm = p0.pad;
#if defined(__HIP_DEVICE_COMPILE__)
        KA ka = (KA)__builtin_amdgcn_kernarg_segment_ptr();
        asm volatile("" : "+s"(ka));
#else
        KA ka = nullptr;
#endif
        const float* xin = layer == 0 ? PF(x) : PF(out);
        float* x1 = PF(out);
        if (q == -1 && QON(-1)) { for (int r = 0; r <= ((dupm >> 15) & 1); ++r) { phase_prologue(ka, 0, smem); __syncthreads(); } }
        else if (q == 0 && QON(0)) { for (int r = 0; r <= (dupm & 1); ++r) { phase_inproj(ka, layer, lds); __syncthreads(); } }
        else if (q == 1 && QON(1)) {
            const int nb1 = (int)gridDim.x > 32 ? 16 : 0, nwork = (int)gridDim.x - nb1;
            for (int r = 0; r <= ((dupm >> 12) & 1); ++r) { phase_compress2(ka, layer, lds); __syncthreads(); }
            for (int r = 0; r <= ((dupm >> 10) & 1); ++r) { phase_hgrnA(ka, layer, lds, nb1, nwork); __syncthreads(); }
            for (int r = 0; r <= ((dupm >> 11) & 1); ++r) { phase_gmlp2(ka, layer, lds, nb1, nwork); __syncthreads(); }
            for (int r = 0; r <= ((dupm >> 13) & 1); ++r) { phase_vtrans(ka, smem); __syncthreads(); }
        }
        else if (q == 2 && QON(2)) { for (int r = 0; r <= ((dupm >> 14) & 1); ++r) { phase_hgrnB(ka); __syncthreads(); } for (int r = 0; r <= ((dupm >> 2) & 1); ++r) { phase_nsa2(ka, layer, lds); __syncthreads(); } }
        else if (q == 3 && QON(3)) { for (int r = 0; r <= ((dupm >> 3) & 1); ++r) { phase_hgrnC(ka, layer, lds); __syncthreads(); } }
        else if (q == 4 && QON(4)) phase_outproj(ka, layer, xin, x1, lds);
        else if (q == 5 && QON(5)) { for (int r = ((dupm >> 5) & 1); r >= 0; --r) { phase_ln1_route(ka, layer, x1, smem, r == 1); __syncthreads(); } }
        else if (q == 6 && QON(6)) { for (int r = 0; r <= ((dupm >> 6) & 1); ++r) { phase_moe_up(ka, layer, lds); __syncthreads(); } }
        else if (q == 7 && QON(7)) { for (int r = 0; r <= ((dupm >> 7) & 1); ++r) { phase_moe_down(ka, layer, lds); __syncthreads(); } }
        else if (q == 8 && QON(8)) { phase_ln2(ka, layer, x1, PF(out)); if (layer == 0) { __syncthreads(); phase_prologue(ka, 1, smem); } }
        if (ph != NPH_TOTAL - 1 || PROF_LO >= 0) xcd_barrier(bar);
        if (PROF_LO >= 0 && blockIdx.x == 0 && threadIdx.x == 0) ((unsigned long long*)(p0.ctl + 8192))[ph + 1] = __builtin_amdgcn_s_memrealtime();
    }
    if (PROF_LO >= 0) {
        xcd_barrier(bar);
        const unsigned long long* ts = (const unsigned long long*)(p0.ctl + 8192);
        const unsigned long long t0 = __hip_atomic_load(&ts[PROF_LO], __ATOMIC_RELAXED, __HIP_MEMORY_SCOPE_AGENT), t1 = __hip_atomic_load(&ts[PROF_HI + 1], __ATOMIC_RELAXED, __HIP_MEMORY_SCOPE_AGENT);
        const float fac = 1.f + 1e-5f * (float)(t1 - t0);
        for (size_t i = (size_t)blockIdx.x * NTHR + threadIdx.x; i < (size_t)NTOK * DM; i += (size_t)gridDim.x * NTHR) p0.out[i] *= fac;
    }
}

static inline size_t align_up(size_t v, size_t a) { return (v + a - 1) / a * a; }

extern "C" void kernel_launch(void* const* d_in, const int* in_sizes, int n_in, void* d_out, int out_size, void* d_ws,
                              size_t ws_size, hipStream_t stream) {
    P p{};
    p.x = (const float*)d_in[0]; p.w_in = (const float*)d_in[1]; p.gm_v_gain = (const float*)d_in[2];
    p.gm_v_bias = (const float*)d_in[3]; p.gm_w_s = (const float*)d_in[4]; p.gm_b_s = (const float*)d_in[5];
    p.cmp_pos = (const float*)d_in[6]; p.cmp_w1 = (const float*)d_in[7]; p.cmp_w2 = (const float*)d_in[8];
    p.nsa_gate_b = (const float*)d_in[9]; p.hg_lower = (const float*)d_in[10]; p.out_gain = (const float*)d_in[11];
    p.w_out = (const float*)d_in[12]; p.ln1_g = (const float*)d_in[13]; p.ln1_b = (const float*)d_in[14];
    p.rg_w = (const float*)d_in[15]; p.rg_b = (const float*)d_in[16]; p.re_w = (const float*)d_in[17];
    p.re_b = (const float*)d_in[18]; p.w_gate = (const float*)d_in[19]; p.w_up = (const float*)d_in[20];
    p.w_down = (const float*)d_in[21]; p.ln2_g = (const float*)d_in[22]; p.ln2_b = (const float*)d_in[23];
    p.out = (float*)d_out;
    char* ws = (char*)d_ws;
    size_t off = 0;
    p.ctl = (unsigned*)(ws + off); off = align_up(off + CTL_BYTES, 256);
    p.WT = (bf16_t*)(ws + off); off = align_up(off + WT_LAYER * 2, 256);
    p.H = (bf16_t*)(ws + off); off = align_up(off + (size_t)(NTOK + 64) * HLD * 2, 256);
    p.Y = (bf16_t*)(ws + off); off = align_up(off + (size_t)NTOK * DM * 2, 256);
    p.XB = (bf16_t*)(ws + off); off = align_up(off + (size_t)NTOK * DM * 2, 256);
    p.kcb = (bf16_t*)(ws + off); off = align_up(off + (size_t)4 * 512 * 64 * 2, 256);
    p.vcT = (bf16_t*)(ws + off); off = align_up(off + (size_t)4 * 64 * 512 * 2, 256);
    p.vsT = (bf16_t*)(ws + off); off = align_up(off + (size_t)4 * 64 * T_ * 2, 256);
    p.vwT = (bf16_t*)(ws + off); off = align_up(off + (size_t)4 * 64 * T_ * 2, 256);
    p.gb = (bf16_t*)(ws + off); off = align_up(off + (size_t)8 * 512 * 128 * 2, 256);
    p.cbias = (float*)(ws + off); off = align_up(off + 256 * 4, 256);
    p.list_tok = (int*)(ws + off); off = align_up(off + (size_t)16 * NTOK * 4, 256);
    p.list_w = (float*)(ws + off); off = align_up(off + (size_t)16 * NTOK * 4, 256);
    p.tok_slot = (int*)(ws + off); off = align_up(off + (size_t)NTOK * 2 * 4, 256);
    p.hgU = (float*)p.XB; p.hgS = p.hgU + (size_t)1024 * 4096;
    p.hgG = (float*)(ws + off); off = align_up(off + (size_t)1024 * 64 * 4, 256);
    p.hgQB = (bf16_t*)(ws + off); off = align_up(off + (size_t)1024 * 4096 * 2, 256);
    p.hgO = (bf16_t*)(ws + off); off = align_up(off + (size_t)1024 * 4096 * 2, 256);
    p.nph = NPH_TOTAL; p.pad = DUPMASK;
    (void)in_sizes; (void)n_in; (void)out_size;
    static int grid_blocks = 0;
    if (!grid_blocks) {
        int dev = 0, cus = 0, per_cu = 0;
        (void)hipGetDevice(&dev);
        (void)hipDeviceGetAttribute(&cus, hipDeviceAttributeMultiprocessorCount, dev);
        if (hipFuncSetAttribute((const void*)k_mega, hipFuncAttributeMaxDynamicSharedMemorySize, LDS_BYTES) != hipSuccess) { fprintf(stderr, "hipFuncSetAttribute failed\n"); grid_blocks = -1; return; }
        if (hipOccupancyMaxActiveBlocksPerMultiprocessor(&per_cu, (const void*)k_mega, NTHR, LDS_BYTES) != hipSuccess || per_cu < 1) { fprintf(stderr, "occupancy query says %d\n", per_cu); }
        (void)hipGetLastError();
        grid_blocks = cus;
        if (off > ws_size) { fprintf(stderr, "workspace too small: need %zu have %zu\n", off, ws_size); grid_blocks = -1; }
    }
    if (grid_blocks < 0) return;
    (void)hipMemsetAsync(p.ctl, 0, CTL_BYTES, stream);
    void* args[] = {&p};
    hipError_t e = hipLaunchCooperativeKernel((const void*)k_mega, dim3(grid_blocks), dim3(NTHR), args, LDS_BYTES, stream);
    if (e != hipSuccess) fprintf(stderr, "cooperative launch failed: %s (grid %d)\n", hipGetErrorString(e), grid_blocks);
}
```

```cpp
#include <hip/hip_runtime.h>
#include <cstdio>
#include <cstdint>

#define LAS __attribute__((address_space(3)))
typedef unsigned short bf16_t;
typedef short bf16x8 __attribute__((ext_vector_type(8)));
typedef float f32x4 __attribute__((ext_vector_type(4)));
typedef float f32x2 __attribute__((ext_vector_type(2)));
typedef unsigned u32x4 __attribute__((ext_vector_type(4)));
typedef unsigned u32x2 __attribute__((ext_vector_type(2)));

constexpr int NW = 8;
constexpr int NTHR = NW * 64;
constexpr int T_ = 8192;
constexpr int NTOK = 16384;
constexpr int DM = 1024;
constexpr int IC_SRC = 2840;
constexpr int HLD = 3072;
constexpr int C_GU = 0, C_GV = 256, C_NQ = 512, C_KC = 1024, C_VC = 1152, C_KS = 1280, C_VS = 1408,
              C_KW = 1536, C_VW = 1664, C_HQ = 1792, C_HF = 2048, C_HI = 2304, C_HG = 2560, C_NG = 2816;
constexpr int NCMP = 511;
constexpr float ALPHA = 1.4142135623730951f;
constexpr float NEG_INF = -1e30f;

constexpr size_t WT_IN = 0;
constexpr size_t WT_OUT = WT_IN + (size_t)3072 * 1024;
constexpr size_t WT_UP = WT_OUT + (size_t)1024 * 1024;
constexpr size_t WT_DN = WT_UP + (size_t)16 * 1024 * 1024;
constexpr size_t WT_C1 = WT_DN + (size_t)16 * 1024 * 512;
constexpr size_t WT_GM = WT_C1 + (size_t)2 * 256 * 2048;
constexpr size_t WT_LAYER = WT_GM + (size_t)4 * 128 * 128;

constexpr int LDS_STAGE = 131072;
constexpr int LDS_MISC = LDS_STAGE;
constexpr int LDS_BYTES = 147456;

constexpr int CW_BAR = 0;
constexpr int CW_CNT = 4096;
constexpr size_t CTL_BYTES = 65536;

struct P {
    const float* x; const float* w_in; const float* gm_v_gain; const float* gm_v_bias; const float* gm_w_s;
    const float* gm_b_s; const float* cmp_pos; const float* cmp_w1; const float* cmp_w2; const float* nsa_gate_b;
    const float* hg_lower; const float* out_gain; const float* w_out; const float* ln1_g; const float* ln1_b;
    const float* rg_w; const float* rg_b; const float* re_w; const float* re_b; const float* w_gate;
    const float* w_up; const float* w_down; const float* ln2_g; const float* ln2_b;
    float* out;
    unsigned* ctl;
    bf16_t* WT;
    bf16_t* H;
    bf16_t* Y;
    bf16_t* XB;
    bf16_t* kcb;
    bf16_t* vcT;
    bf16_t* vsT;
    bf16_t* vwT;
    bf16_t* gb;
    float* cbias;
    int* list_tok;
    float* list_w;
    int* tok_slot;
    float* hgU; float* hgG; float* hgS; bf16_t* hgQB; bf16_t* hgO;
    int nph; int pad;
};


typedef const __attribute__((address_space(4))) char* KA;
template <class T> __device__ __forceinline__ T ldarg(KA ka, size_t off) { return *(const __attribute__((address_space(4))) T*)(ka + off); }
#define PF(f) ldarg<decltype(P::f)>(ka, offsetof(P, f))

__device__ __forceinline__ float bf2f(bf16_t u) { return __uint_as_float(((unsigned)u) << 16); }
typedef __bf16 bf16x2_t __attribute__((ext_vector_type(2)));
__device__ __forceinline__ unsigned pk2(float lo, float hi) { f32x2 v; v.x = lo; v.y = hi; return __builtin_bit_cast(unsigned, __builtin_convertvector(v, bf16x2_t)); }
__device__ __forceinline__ bf16_t f2bf(float f) { return (bf16_t)(pk2(f, 0.f) & 0xffffu); }
__device__ __forceinline__ float gelu_t(float x) {
    const float u2 = -2.f * 0.7978845608028654f * (x + 0.044715f * x * x * x);
    return x / (1.f + __expf(u2));
}
__device__ __forceinline__ float gelu_slow(float x) {
    float u = 0.7978845608028654f * (x + 0.044715f * x * x * x);
    return 0.5f * x * (1.f + tanhf(u));
}
__device__ __forceinline__ float sigmoidf_(float x) { return 1.f / (1.f + __expf(-x)); }
__device__ __forceinline__ float wave_max(float v) {
#pragma unroll
    for (int o = 32; o > 0; o >>= 1) v = fmaxf(v, __shfl_xor(v, o));
    return v;
}
__device__ __forceinline__ float wave_sum(float v) {
#pragma unroll
    for (int o = 32; o > 0; o >>= 1) v += __shfl_xor(v, o);
    return v;
}
__device__ __forceinline__ void wave_sync() {
    __builtin_amdgcn_fence(__ATOMIC_RELEASE, "wavefront");
    __builtin_amdgcn_wave_barrier();
    __builtin_amdgcn_fence(__ATOMIC_ACQUIRE, "wavefront");
}
__device__ __forceinline__ int opaque_tid() { int t = threadIdx.x; asm volatile("" : "+v"(t)); return t; }
__device__ __forceinline__ int opaque_bid() { int b = blockIdx.x; asm volatile("" : "+s"(b)); return b; }
#define PHASE_IDS const int TID = opaque_tid(); const int BID = opaque_bid(); (void)TID; (void)BID;

#define XB_TMO      128
#define XB_XCNT(j)  (256  + 64 * (j))
#define XB_XSUB(j)  (1280 + 64 * (j))
#define XB_XGEN(j)  (2304 + 64 * (j))
#define XB_TOP      3328
#define XB_TOPGEN   3392
#define XCD_BAR_WORDS 3456
#define XB_SPIN_CAP (1u << 22)
__device__ __forceinline__ unsigned xb_ld(unsigned* p)              { return __hip_atomic_load(p, __ATOMIC_RELAXED, __HIP_MEMORY_SCOPE_AGENT); }
__device__ __forceinline__ unsigned xb_add(unsigned* p, unsigned v) { return __hip_atomic_fetch_add(p, v, __ATOMIC_RELAXED, __HIP_MEMORY_SCOPE_AGENT); }
__device__ __forceinline__ unsigned xb_xcc_id() { return (unsigned)__builtin_amdgcn_s_getreg((3 << 11) | 20) & 0xFu; }
#define XB_SPIN(cond, bar) do { unsigned _sp = 0; while (cond) { __builtin_amdgcn_s_sleep(1); \
    if ((++_sp & 255u) == 0u) { if (xb_ld(&(bar)[XB_TMO])) break; if (_sp > XB_SPIN_CAP) { atomicAdd(&(bar)[XB_TMO], 1u); break; } } } } while (0)
struct XcdBarrier { unsigned* bar; unsigned x; volatile LAS unsigned* st; };
__device__ __forceinline__ XcdBarrier xcd_barrier_post(unsigned* bar, volatile LAS unsigned* st) {
    XcdBarrier b; b.bar = bar; b.x = xb_xcc_id(); b.st = st;
    if (threadIdx.x == 0) (void)xb_add(&bar[XB_XCNT(b.x)], 1u);
    return b;
}
__device__ __forceinline__ void xcd_barrier_complete(unsigned* bar, unsigned x, unsigned& nloc, unsigned& nx) {
    const unsigned G = gridDim.x * gridDim.y * gridDim.z;
    unsigned sum, cnt, mine, sp = 0u;
    for (;;) {
        sum = 0u; cnt = 0u; mine = 0u;
#pragma unroll
        for (unsigned j = 0; j < 16; ++j) { const unsigned c = xb_ld(&bar[XB_XCNT(j)]); sum += c; cnt += (c > 0u) ? 1u : 0u; mine = (j == x) ? c : mine; }
        if (sum == G) break;
        __builtin_amdgcn_s_sleep(1);
        if ((++sp & 255u) == 0u) { if (xb_ld(&bar[XB_TMO])) break; if (sp > XB_SPIN_CAP) { atomicAdd(&bar[XB_TMO], 1u); break; } }
    }
    nloc = mine > 0u ? mine : 1u; nx = cnt > 0u ? cnt : 1u;
}
__device__ __forceinline__ void xcd_barrier(const XcdBarrier& b) {
    asm volatile("s_waitcnt vmcnt(0)" ::: "memory");
    __syncthreads();
    if (threadIdx.x == 0) {
        unsigned* bar = b.bar;
        __builtin_amdgcn_s_waitcnt(0);
        unsigned nloc = b.st[0], nx = b.st[1];
        if (nloc == 0u) { xcd_barrier_complete(bar, b.x, nloc, nx); b.st[0] = nloc; b.st[1] = nx; }
        const unsigned old = xb_add(&bar[XB_XSUB(b.x)], 1u);
        const unsigned gen = old / nloc;
        if (old + 1u == (gen + 1u) * nloc) {
            __builtin_amdgcn_fence(__ATOMIC_RELEASE, "agent");
            asm volatile("s_waitcnt vmcnt(0)" ::: "memory");
            const unsigned og = xb_add(&bar[XB_TOP], 1u);
            const unsigned tg = og / nx;
            if (og + 1u == (tg + 1u) * nx) xb_add(&bar[XB_TOPGEN], 1u);
            else XB_SPIN(xb_ld(&bar[XB_TOPGEN]) == tg, bar);
            __builtin_amdgcn_fence(__ATOMIC_ACQUIRE, "agent");
            xb_add(&bar[XB_XGEN(b.x)], 1u);
            asm volatile("s_waitcnt vmcnt(0)" ::: "memory");
        } else {
            XB_SPIN(xb_ld(&bar[XB_XGEN(b.x)]) == gen, bar);
            __builtin_amdgcn_fence(__ATOMIC_ACQUIRE, "agent");
            asm volatile("s_waitcnt vmcnt(0)" ::: "memory");
        }
    }
    __syncthreads();
}

namespace pg8 {
constexpr int BM = 256, BK = 64, HALF = 128, HTB = HALF * BK * 2, STAGE_BYTES = 8 * HTB;
__host__ __device__ __forceinline__ int lds_byte(int r, int c) { const int st = (r >> 4) * 2 + (c >> 5), rr = r & 15, cc = c & 31, ob = rr * 64 + cc * 2; return st * 1024 + (ob ^ (((ob >> 9) & 1) << 5)); }
__host__ __device__ __forceinline__ void stage_rc(int b, int& R, int& C) { const int st = b / 1024, sb = b % 1024, swz = sb ^ (((sb >> 9) & 1) << 5); R = (st >> 1) * 16 + swz / 64; C = (st & 1) * 32 + (swz % 64) / 2; }
__host__ __device__ __forceinline__ int perm32(int rho) { const int n = rho >> 4, i = rho & 15; return 8 * (i >> 2) + 4 * n + (i & 3); }
__device__ __forceinline__ unsigned cvt_pk_bf16(float lo, float hi) { return pk2(lo, hi); }

struct Unit {
    const char* bptr;
    int arow0;
    int nrows;
    int pm, pn, e, ui;
};

template <class Epi, class Sched>
__device__ __forceinline__ void gemm_phase(LAS unsigned char* lds, const char* Abase, const int K, const Sched& S, const Epi& E) {
    const int tid = opaque_tid(), wid = __builtin_amdgcn_readfirstlane(tid >> 6), lane = tid & 63, wr = wid >> 2, wc = wid & 3, fr = lane & 15, fq = lane >> 4;
    const int nt = K / BK;
    int R0, C0, R1, C1; stage_rc(tid * 16, R0, C0); stage_rc(tid * 16 + 8192, R1, C1);
    unsigned voffB[2];
    { const int Rb0 = Epi::PERM ? ((R0 & ~31) + perm32(R0 & 31)) : R0, Rb1 = Epi::PERM ? ((R1 & ~31) + perm32(R1 & 31)) : R1;
      voffB[0] = (unsigned)(Rb0 * K + C0) * 2u; voffB[1] = (unsigned)(Rb1 * K + C1) * 2u; }
    const unsigned cA0 = (unsigned)C0 * 2u, cA1 = (unsigned)C1 * 2u;
    const int lda = S.lda(K);
    const unsigned kstepA = S.kstepA();
    const unsigned voffA0 = (unsigned)(R0 * lda + C0) * 2u, voffA1 = (unsigned)(R1 * lda + C1) * 2u;
    const unsigned kstep = (unsigned)(BK * 2);
    const unsigned hstep = (unsigned)(HALF * K * 2);
    const unsigned ldsw = (unsigned)wid * 1024u;
    const int aoff = lds_byte(wr * 64 + fr, fq * 8), boff = lds_byte(wc * 32 + fr, fq * 8);
#define PG8_SA(b, h) (((b) * 2 + (h)) * HTB)
#define PG8_SB(b, h) ((4 + (b) * 2 + (h)) * HTB)
#define PG8_STAGE_B(bufoff, gbase) do { \
        __builtin_amdgcn_global_load_lds((const unsigned*)((const char*)(gbase) + voffB[0]), (LAS unsigned*)(lds + (bufoff) + ldsw), 16, 0, 0); \
        __builtin_amdgcn_global_load_lds((const unsigned*)((const char*)(gbase) + voffB[1]), (LAS unsigned*)(lds + (bufoff) + ldsw + 8192), 16, 0, 0); } while (0)
#define PG8_STAGE_A(bufoff, gbase, pk) do { \
        const unsigned o0_ = Sched::GATHER ? (((pk) & 0xffffu) * (unsigned)lda * 2u + cA0) : voffA0; \
        const unsigned o1_ = Sched::GATHER ? (((pk) >> 16) * (unsigned)lda * 2u + cA1) : voffA1; \
        __builtin_amdgcn_global_load_lds((const unsigned*)((const char*)(gbase) + o0_), (LAS unsigned*)(lds + (bufoff) + ldsw), 16, 0, 0); \
        __builtin_amdgcn_global_load_lds((const unsigned*)((const char*)(gbase) + o1_), (LAS unsigned*)(lds + (bufoff) + ldsw + 8192), 16, 0, 0); } while (0)
#define PG8_LDA(dst, b, h) do { _Pragma("unroll") for (int m = 0; m < 4; ++m) _Pragma("unroll") for (int k = 0; k < 2; ++k) dst[m][k] = *(const LAS bf16x8*)(lds + PG8_SA(b, h) + aoff + m * 2048 + k * 1024); } while (0)
#define PG8_LDB(dst, b, h) do { _Pragma("unroll") for (int n = 0; n < 2; ++n) _Pragma("unroll") for (int k = 0; k < 2; ++k) dst[n][k] = *(const LAS bf16x8*)(lds + PG8_SB(b, h) + boff + n * 2048 + k * 1024); } while (0)
#define PG8_MMA(ai, bj, At, Bt) do { __builtin_amdgcn_s_setprio(1); _Pragma("unroll") for (int m = 0; m < 4; ++m) _Pragma("unroll") for (int n = 0; n < 2; ++n) _Pragma("unroll") for (int k = 0; k < 2; ++k) \
        acc[ai][bj][m][n] = __builtin_amdgcn_mfma_f32_16x16x32_bf16(Bt[n][k], At[m][k], acc[ai][bj][m][n], 0, 0, 0); __builtin_amdgcn_s_setprio(0); } while (0)
#define PG8_WAIT_V(n) asm volatile("s_waitcnt vmcnt(" #n ")" ::: "memory")
#define PG8_WAIT_L(n) asm volatile("s_waitcnt lgkmcnt(" #n ")" ::: "memory")
#define PG8_BAR __builtin_amdgcn_s_barrier()
#define PG8_SCHED __builtin_amdgcn_sched_barrier(0)
#define PG8_PACK(u, h) ((unsigned)S.arow((u), ((h) * 128 + R0) < (u).nrows ? ((h) * 128 + R0) : (u).nrows - 1) | ((unsigned)S.arow((u), ((h) * 128 + R1) < (u).nrows ? ((h) * 128 + R1) : (u).nrows - 1) << 16))
    Unit cur, nxt; int ui = 0;
    if (!S.next(0, cur)) return;
    f32x4 acc[2][2][4][2];
#pragma unroll
    for (int a = 0; a < 2; ++a)
#pragma unroll
        for (int b = 0; b < 2; ++b)
#pragma unroll
            for (int m = 0; m < 4; ++m)
#pragma unroll
                for (int n = 0; n < 2; ++n) acc[a][b][m][n] = (f32x4){0.f, 0.f, 0.f, 0.f};
    bf16x8 At[4][2], B0[2][2], B1[2][2];
    unsigned pC0 = 0u, pC1 = 0u, pN0 = 0u, pN1 = 0u;
    if (Sched::GATHER) { pC0 = PG8_PACK(cur, 0); pC1 = PG8_PACK(cur, 1); }
    const char* cB = cur.bptr;
    const char* cA = Sched::GATHER ? Abase : S.abase(cur, Abase) + (size_t)cur.arow0 * lda * 2;
    const unsigned hA = Sched::GATHER ? 0u : (unsigned)(HALF * lda * 2);
    PG8_STAGE_B(PG8_SB(0, 0), cB); PG8_STAGE_B(PG8_SB(0, 1), cB + hstep); PG8_STAGE_A(PG8_SA(0, 0), cA, pC0); PG8_STAGE_A(PG8_SA(0, 1), cA + hA, pC1);
    if (wr == 1) PG8_BAR;
    PG8_WAIT_V(2); PG8_BAR;
    PG8_STAGE_B(PG8_SB(1, 0), cB + kstep); PG8_STAGE_A(PG8_SA(1, 0), cA + kstepA, pC0); PG8_STAGE_B(PG8_SB(1, 1), cB + hstep + kstep);
    PG8_WAIT_V(6); PG8_BAR;
    for (;;) {
        const bool has_next = S.next(ui + 1, nxt);
        if (Sched::GATHER) { if (has_next) { pN0 = PG8_PACK(nxt, 0); pN1 = PG8_PACK(nxt, 1); } else { pN0 = pC0; pN1 = pC1; } }
        const char* nB = has_next ? nxt.bptr : cB;
        const char* nA = (Sched::GATHER || !has_next) ? cA : S.abase(nxt, Abase) + (size_t)nxt.arow0 * lda * 2;
        for (int t = 0; t < nt; t += 2) {
            const bool last = (t == nt - 2);
            const char* a1 = cA + (unsigned)(t + 1) * kstepA;
            const char* a2 = last ? nA : cA + (unsigned)(t + 2) * kstepA; const char* b2 = last ? nB : cB + (unsigned)(t + 2) * kstep;
            const char* a3 = a2 + kstepA; const char* b3 = b2 + kstep;
            const unsigned s0 = last ? pN0 : pC0, s1 = last ? pN1 : pC1;
            PG8_LDB(B0, 0, 0); PG8_LDB(B1, 0, 1); PG8_SCHED; PG8_LDA(At, 0, 0); PG8_STAGE_A(PG8_SA(1, 1), a1 + hA, pC1);
            PG8_WAIT_V(8); PG8_WAIT_L(0); PG8_BAR; PG8_MMA(0, 0, At, B0); PG8_MMA(0, 1, At, B1); PG8_BAR; PG8_SCHED;
            PG8_LDA(At, 0, 1); PG8_STAGE_B(PG8_SB(0, 0), b2); PG8_STAGE_B(PG8_SB(0, 1), b2 + hstep); PG8_STAGE_A(PG8_SA(0, 0), a2, s0);
            PG8_WAIT_V(8); PG8_WAIT_L(0); PG8_BAR; PG8_MMA(1, 0, At, B0); PG8_MMA(1, 1, At, B1); PG8_BAR; PG8_SCHED;
            PG8_LDB(B0, 1, 0); PG8_LDB(B1, 1, 1); PG8_SCHED; PG8_LDA(At, 1, 0); PG8_STAGE_A(PG8_SA(0, 1), a2 + hA, s1);
            PG8_WAIT_V(8); PG8_WAIT_L(0); PG8_BAR; PG8_MMA(0, 0, At, B0); PG8_MMA(0, 1, At, B1); PG8_BAR; PG8_SCHED;
            PG8_LDA(At, 1, 1); PG8_STAGE_B(PG8_SB(1, 0), b3); PG8_STAGE_B(PG8_SB(1, 1), b3 + hstep); PG8_STAGE_A(PG8_SA(1, 0), a3, s0);
            PG8_WAIT_V(8); PG8_WAIT_L(0); PG8_BAR; PG8_MMA(1, 0, At, B0); PG8_MMA(1, 1, At, B1); PG8_BAR; PG8_SCHED;
        }
        if (wr == 0) PG8_BAR;
        E(acc, cur, wr, wc, fr, fq);
        if (!has_next) break;
#pragma unroll
        for (int a = 0; a < 2; ++a)
#pragma unroll
            for (int b = 0; b < 2; ++b)
#pragma unroll
                for (int m = 0; m < 4; ++m)
#pragma unroll
                    for (int n = 0; n < 2; ++n) acc[a][b][m][n] = (f32x4){0.f, 0.f, 0.f, 0.f};
        cur = nxt; cB = nB; cA = nA; ++ui;
        pC0 = pN0; pC1 = pN1;
        if (wr == 1) PG8_BAR;
    }
    PG8_WAIT_V(0);
    PG8_BAR;
#undef PG8_SA
#undef PG8_SB
#undef PG8_STAGE_A
#undef PG8_STAGE_B
#undef PG8_LDA
#undef PG8_LDB
#undef PG8_MMA
#undef PG8_WAIT_V
#undef PG8_WAIT_L
#undef PG8_BAR
#undef PG8_SCHED
#undef PG8_PACK
}

struct DenseOrder {
    static constexpr bool GATHER = false;
    int nM, nN, nwg, G, c; const char* Bt; int K;
    __device__ void init(int M, int N, int K_, const bf16_t* Bt_, int G_, int c_) { nM = M / BM; nN = N / BM; nwg = nM * nN; G = G_; c = c_; Bt = (const char*)Bt_; K = K_; }
    __device__ __forceinline__ bool next(int i, Unit& u) const {
        const long L = (long)i * G + c; if (L >= nwg) return false;
        int wgid = (int)L; { const int q = nwg / 8, r = nwg % 8, xcd = wgid % 8, off = wgid / 8; wgid = (xcd < r ? xcd * (q + 1) : r * (q + 1) + (xcd - r) * q) + off; }
        const int nig = 8 * nN, gid = wgid / nig, fm = gid * 8, gsz = (nM - fm) < 8 ? (nM - fm) : 8;
        u.pm = fm + ((wgid % nig) % gsz); u.pn = (wgid % nig) / gsz;
        u.arow0 = u.pm * BM; u.nrows = BM; u.e = 0; u.ui = i;
        u.bptr = Bt + (size_t)u.pn * BM * K * 2;
        return true;
    }
    __device__ __forceinline__ int arow(const Unit& u, int r) const { return u.arow0 + r; }
    __device__ __forceinline__ int lda(int K_) const { return K_; }
    __device__ __forceinline__ unsigned kstepA() const { return 128u; }
    __device__ __forceinline__ const char* abase(const Unit&, const char* A) const { return A; }
};
}

struct EpiH {
    static constexpr bool PERM = true;
    bf16_t* H;
    __device__ __forceinline__ void operator()(const f32x4 (&acc)[2][2][4][2], const pg8::Unit& u, int wr, int wc, int fr, int fq) const {
        const int row0 = u.arow0 + wr * 64 + fr, col0 = u.pn * 256 + wc * 32 + 8 * fq;
#pragma unroll
        for (int ai = 0; ai < 2; ++ai)
#pragma unroll
            for (int m = 0; m < 4; ++m) {
                bf16_t* rowp = H + (size_t)(row0 + ai * 128 + m * 16) * HLD + col0;
#pragma unroll
                for (int bj = 0; bj < 2; ++bj) {
                    const f32x4 v0 = acc[ai][bj][m][0], v1 = acc[ai][bj][m][1];
                    u32x4 w; w.x = pg8::cvt_pk_bf16(v0[0], v0[1]); w.y = pg8::cvt_pk_bf16(v0[2], v0[3]); w.z = pg8::cvt_pk_bf16(v1[0], v1[1]); w.w = pg8::cvt_pk_bf16(v1[2], v1[3]);
                    *(u32x4*)(rowp + bj * 128) = w;
                }
            }
    }
};
struct EpiRes {
    static constexpr bool PERM = false;
    const float* xin; float* out;
    __device__ __forceinline__ void operator()(const f32x4 (&acc)[2][2][4][2], const pg8::Unit& u, int wr, int wc, int fr, int fq) const {
        const int row0 = u.arow0 + wr * 64 + fr, col0 = u.pn * 256 + wc * 32 + 4 * fq;
#pragma unroll
        for (int ai = 0; ai < 2; ++ai)
#pragma unroll
            for (int m = 0; m < 4; ++m) {
                const size_t off = (size_t)(row0 + ai * 128 + m * 16) * DM + col0;
#pragma unroll
                for (int bj = 0; bj < 2; ++bj)
#pragma unroll
                    for (int n = 0; n < 2; ++n) {
                        const f32x4 xv = *(const f32x4*)(xin + off + bj * 128 + n * 16);
                        *(f32x4*)(out + off + bj * 128 + n * 16) = xv * ALPHA + acc[ai][bj][m][n];
                    }
            }
    }
};

template <class RM>
__device__ __forceinline__ void transpose_item(const float* W, int K, int N, bf16_t* WT, RM rowmap, float* scr, int kb, int nb, int lane) {
    const int k0 = 64 * kb, n0 = 32 * nb;
    const int nn = n0 + (lane & 31);
    float tmp[32];
#pragma unroll
    for (int i = 0; i < 32; ++i) {
        const int kk = 2 * i + (lane >> 5);
        tmp[i] = nn < N ? W[(size_t)(k0 + kk) * N + nn] : 0.f;
    }
#pragma unroll
    for (int i = 0; i < 32; ++i) {
        const int kk = 2 * i + (lane >> 5);
        scr[kk * 33 + (lane & 31)] = tmp[i];
    }
    wave_sync();
    const int c = lane & 7;
#pragma unroll
    for (int j = 0; j < 4; ++j) {
        const int n = (lane >> 3) + 8 * j;
        const float* s = scr + (8 * c) * 33 + n;
        u32x4 o; o.x = pk2(s[0 * 33], s[1 * 33]); o.y = pk2(s[2 * 33], s[3 * 33]); o.z = pk2(s[4 * 33], s[5 * 33]); o.w = pk2(s[6 * 33], s[7 * 33]);
        const int dr = (n0 + n < N) ? rowmap(n0 + n) : -1;
        if (dr >= 0) *(u32x4*)(WT + (size_t)dr * K + k0 + 8 * c) = o;
    }
    wave_sync();
}

__device__ void phase_prologue(KA ka, int layer, float* smem) {
    PHASE_IDS
    const int lane = TID & 63, w = TID >> 6;
    float* scr = smem + w * 4096;
    const int gw = BID * NW + w, NGW = gridDim.x * NW;
    constexpr int I_IN = 16 * 89, I_OUT = 16 * 32, I_GU = 16 * 16, I_DN = 8 * 32;
    constexpr int I_LAYER = I_IN + I_OUT + 32 * I_GU + 16 * I_DN;
    for (int it = gw; it < I_LAYER; it += NGW) {
        int r = it;
        bf16_t* WT = PF(WT);
        if (r < I_IN) {
            transpose_item(PF(w_in) + (size_t)layer * DM * IC_SRC, DM, IC_SRC, WT + WT_IN,
                           [](int n) { return n < 1792 ? n : (n < 1816 ? 2816 + (n - 1792) : n - 24); }, scr, r / 89, r % 89, lane);
            continue;
        }
        r -= I_IN;
        if (r < I_OUT) {
            transpose_item(PF(w_out) + (size_t)layer * DM * DM, DM, DM, WT + WT_OUT, [](int n) { return n; }, scr, r / 32, r % 32, lane);
            continue;
        }
        r -= I_OUT;
        if (r < 32 * I_GU) {
            const int mat = r / I_GU, rr = r % I_GU, e = mat >> 1, isup = mat & 1;
            const float* W = (isup ? PF(w_up) : PF(w_gate)) + ((size_t)layer * 16 + e) * DM * 512;
            transpose_item(W, DM, 512, WT + WT_UP + (size_t)e * 1024 * 1024,
                           [isup](int n) { return (n >> 7) * 256 + isup * 128 + (n & 127); }, scr, rr / 16, rr % 16, lane);
            continue;
        }
        r -= 32 * I_GU;
        {
            const int e = r / I_DN, rr = r % I_DN;
            transpose_item(PF(w_down) + ((size_t)layer * 16 + e) * 512 * DM, 512, DM, WT + WT_DN + (size_t)e * 1024 * 512,
                           [](int n) { return n; }, scr, rr / 32, rr % 32, lane);
        }
    }
    for (int it = gw; it < 2 * 32 * 4; it += NGW) {
        const int which = it >> 7, rr = it & 127;
        transpose_item(PF(cmp_w1) + ((size_t)layer * 2 + which) * 2048 * 128, 2048, 128, PF(WT) + WT_C1 + (size_t)which * 256 * 2048, [](int n) { return n; }, scr, rr >> 2, rr & 3, lane);
    }
    for (int i = BID * NTHR + TID; i < 2 * 128 * 256; i += gridDim.x * NTHR) {
        const int which = i >> 15, q = i & 32767;
        u32x4 z; z.x = 0u; z.y = 0u; z.z = 0u; z.w = 0u;
        *(u32x4*)(PF(WT) + WT_C1 + (size_t)which * 256 * 2048 + (size_t)128 * 2048 + (size_t)q * 8) = z;
    }
    for (int o = gw; o < 256; o += NGW) {
        const int which = o >> 7, cc = o & 127;
        const float* w1 = PF(cmp_w1) + ((size_t)layer * 2 + which) * 2048 * 128;
        const float* pos = PF(cmp_pos) + ((size_t)layer * 2 + which) * 2048;
        float a = 0.f;
        for (int k = lane; k < 2048; k += 64) a = fmaf(pos[k], w1[(size_t)k * 128 + cc], a);
        a = wave_sum(a);
        if (lane == 0) PF(cbias)[o] = a;
    }
    for (int i = BID * NTHR + TID; i < 4 * 128 * 128; i += gridDim.x * NTHR) {
        const int s = i & 127, t = (i >> 7) & 127;
        PF(WT)[WT_GM + i] = (s <= t) ? f2bf(PF(gm_w_s)[(size_t)layer * 4 * 128 * 128 + i]) : (bf16_t)0;
    }
    for (int i = BID * NTHR + TID; i < 232 * 128; i += gridDim.x * NTHR) {
        const int q = i;
        u32x4 z; z.x = 0u; z.y = 0u; z.z = 0u; z.w = 0u;
        *(u32x4*)(PF(WT) + WT_IN + (size_t)2840 * 1024 + (size_t)q * 8) = z;
    }
    if (layer == 0)
    for (int row = gw; row < NTOK; row += NGW) {
        const f32x4* xr = (const f32x4*)(PF(x) + (size_t)row * DM) + lane;
        u32x2* o = (u32x2*)(PF(XB) + (size_t)row * DM) + lane;
#pragma unroll
        for (int j = 0; j < 4; ++j) {
            const f32x4 v = xr[64 * j];
            u32x2 ww; ww.x = pk2(v[0], v[1]); ww.y = pk2(v[2], v[3]);
            o[64 * j] = ww;
        }
    }
}

template <class AF, class BF, class EF>
__device__ __forceinline__ void gemm128(int tid, int m0, int n0, int M, int N, int K, AF af, BF bf, EF ef, float* smem) {
    float* As = smem;
    float* Bs = smem + 16 * 132;
    const bool active = tid < 256;
    const int tx = tid & 15, ty = (tid >> 4) & 15;
    float acc[8][8];
#pragma unroll
    for (int i = 0; i < 8; i++)
#pragma unroll
        for (int j = 0; j < 8; j++) acc[i][j] = 0.f;
#pragma unroll 1
    for (int k0 = 0; k0 < K; k0 += 16) {
        if (active) {
#pragma unroll
            for (int i = 0; i < 8; i++) {
                int e = tid + i * 256;
                int r = e >> 4, kk = e & 15;
                float v = 0.f;
                if (m0 + r < M) v = af(m0 + r, k0 + kk);
                As[kk * 132 + r] = v;
            }
#pragma unroll
            for (int i = 0; i < 8; i++) {
                int e = tid + i * 256;
                int kk = e >> 7, c = e & 127;
                float v = 0.f;
                if (n0 + c < N) v = bf(k0 + kk, n0 + c);
                Bs[kk * 132 + c] = v;
            }
        }
        __syncthreads();
        if (active) {
#pragma unroll 2
            for (int kk = 0; kk < 16; kk++) {
                asm volatile("" ::: "memory");
                float4 a0 = *(const float4*)&As[kk * 132 + ty * 8];
                float4 a1 = *(const float4*)&As[kk * 132 + ty * 8 + 4];
                float4 b0 = *(const float4*)&Bs[kk * 132 + tx * 8];
                float4 b1 = *(const float4*)&Bs[kk * 132 + tx * 8 + 4];
                float a[8] = {a0.x, a0.y, a0.z, a0.w, a1.x, a1.y, a1.z, a1.w};
                float b[8] = {b0.x, b0.y, b0.z, b0.w, b1.x, b1.y, b1.z, b1.w};
#pragma unroll
                for (int i = 0; i < 8; i++)
#pragma unroll
                    for (int j = 0; j < 8; j++) acc[i][j] = fmaf(a[i], b[j], acc[i][j]);
            }
        }
        __syncthreads();
    }
    if (active) {
#pragma unroll
        for (int i = 0; i < 8; i++)
#pragma unroll
            for (int j = 0; j < 8; j++) {
                int m = m0 + ty * 8 + i, n = n0 + tx * 8 + j;
                if (m < M && n < N) ef(m, n, acc[i][j]);
            }
    }
}

__device__ __forceinline__ void phase_inproj(KA ka, int layer, LAS unsigned char* lds) {
    pg8::DenseOrder S; S.init(NTOK, HLD, DM, PF(WT) + WT_IN, gridDim.x, opaque_bid());
    EpiH E{PF(H)};
    pg8::gemm_phase<EpiH, pg8::DenseOrder>(lds, (const char*)PF(XB), DM, S, E);
}
__device__ __forceinline__ void phase_outproj(KA ka, int layer, const float* xin, float* x1, LAS unsigned char* lds) {
    pg8::DenseOrder S; S.init(NTOK, DM, DM, PF(WT) + WT_OUT, gridDim.x, opaque_bid());
    EpiRes E{xin, x1};
    pg8::gemm_phase<EpiRes, pg8::DenseOrder>(lds, (const char*)PF(Y), DM, S, E);
}

__device__ void phase_ln1_route(KA ka, int layer, float* x1, float* smem, bool dry) {
    PHASE_IDS
    bf16_t* xb = PF(XB);
    float* x1o = dry ? (float*)PF(H) : x1;
    const int lane = TID & 63, w = TID >> 6;
    const float* g = PF(ln1_g) + layer * 1024;
    const float* bb = PF(ln1_b) + layer * 1024;
    const float* wg = PF(rg_w) + (size_t)layer * 1024 * 4;
    const float* we = PF(re_w) + (size_t)layer * 1024 * 16;
    const float* bg = PF(rg_b) + layer * 4;
    const float* be = PF(re_b) + layer * 16;
    int* cnt = (int*)(PF(ctl) + CW_CNT) + layer * 16 * 64 + (dry ? 2048 : 0);
    int* lcnt = (int*)(smem + 20 * 1024);
    int* rinfo = lcnt + 64;
    float* rwt = (float*)(rinfo + 4 * 128);
    if (TID < 32) lcnt[TID] = 0;
    float* WR = smem;
    __syncthreads();
    for (int idx = TID; idx < 20 * 1024; idx += NTHR) { const int o = idx >> 10, c = idx & 1023; WR[idx] = o < 4 ? wg[c * 4 + o] : we[c * 16 + (o - 4)]; }
    __syncthreads();
    int nloc = 0;
    for (int row = BID * NW + w; row < NTOK; row += gridDim.x * NW) {
        f32x4 v[4];
        float s = 0.f;
#pragma unroll
        for (int j = 0; j < 4; ++j) { v[j] = *(const f32x4*)(x1 + (size_t)row * DM + 256 * j + 4 * lane); s += (v[j][0] + v[j][1]) + (v[j][2] + v[j][3]); }
        const float mu = wave_sum(s) * (1.f / 1024.f);
        float q = 0.f;
#pragma unroll
        for (int j = 0; j < 4; ++j) { v[j] = v[j] - mu; q += (v[j][0] * v[j][0] + v[j][1] * v[j][1]) + (v[j][2] * v[j][2] + v[j][3] * v[j][3]); }
        const float rstd = rsqrtf(wave_sum(q) * (1.f / 1024.f) + 1e-5f);
#pragma unroll
        for (int j = 0; j < 4; ++j) {
            const int c = 256 * j + 4 * lane;
            v[j] = v[j] * rstd * *(const f32x4*)(g + c) + *(const f32x4*)(bb + c);
            *(f32x4*)(x1o + (size_t)row * DM + c) = v[j];
            u32x2 pw; pw.x = pk2(v[j][0], v[j][1]); pw.y = pk2(v[j][2], v[j][3]);
            *(u32x2*)(xb + (size_t)row * DM + c) = pw;
        }
        float lg[4], le[16];
#pragma unroll
        for (int o = 0; o < 20; ++o) {
            asm volatile("" ::: "memory");
            float a = 0.f;
#pragma unroll
            for (int j = 0; j < 4; ++j) {
                const f32x4 w4 = *(const f32x4*)(WR + o * 1024 + 256 * j + 4 * lane);
                a += (v[j][0] * w4[0] + v[j][1] * w4[1]) + (v[j][2] * w4[2] + v[j][3] * w4[3]);
            }
            a = wave_sum(a);
            if (o < 4) lg[o] = a + bg[o]; else le[o - 4] = a + be[o - 4];
        }
        float gm = fmaxf(fmaxf(lg[0], lg[1]), fmaxf(lg[2], lg[3]));
        float ge[4], gs = 0.f;
#pragma unroll
        for (int c = 0; c < 4; c++) { ge[c] = __expf(lg[c] - gm); gs += ge[c]; }
        int gi = 0; float gbest = ge[0];
#pragma unroll
        for (int c = 1; c < 4; c++) if (ge[c] > gbest) { gbest = ge[c]; gi = c; }
        float gval = gbest / gs;
        float ls[4];
#pragma unroll
        for (int e = 0; e < 4; e++) ls[e] = gi == 0 ? le[e] : gi == 1 ? le[4 + e] : gi == 2 ? le[8 + e] : le[12 + e];
        float em = fmaxf(fmaxf(ls[0], ls[1]), fmaxf(ls[2], ls[3]));
        float pe[4];
#pragma unroll
        for (int e = 0; e < 4; e++) pe[e] = __expf(ls[e] - em);
        int i1 = 0; float b1 = pe[0];
#pragma unroll
        for (int e = 1; e < 4; e++) if (pe[e] > b1) { b1 = pe[e]; i1 = e; }
        int i2 = -1; float b2 = -1.f;
#pragma unroll
        for (int e = 0; e < 4; e++) if (e != i1 && pe[e] > b2) { b2 = pe[e]; i2 = e; }
        float w1 = gval * b1 / (b1 + b2), w2 = gval * b2 / (b1 + b2);
        if (lane == 0) {
            const int e1 = gi * 4 + i1, e2 = gi * 4 + i2;
            const int lr = nloc * NW + w;
            rinfo[lr * 4 + 0] = e1; rinfo[lr * 4 + 1] = atomicAdd(&lcnt[e1], 1);
            rinfo[lr * 4 + 2] = e2; rinfo[lr * 4 + 3] = atomicAdd(&lcnt[e2], 1);
            rwt[lr * 2 + 0] = w1; rwt[lr * 2 + 1] = w2;
        }
        ++nloc;
    }
    __syncthreads();
    if (TID < 16) lcnt[16 + TID] = lcnt[TID] > 0 ? atomicAdd(&cnt[TID * 64], lcnt[TID]) : 0;
    __syncthreads();
    {
        const int nrows_blk = (NTOK - BID * NW + (int)gridDim.x * NW - 1) / ((int)gridDim.x * NW) * NW;
        for (int lr = TID; lr < nrows_blk; lr += NTHR) {
            const int row = BID * NW + (lr % NW) + (lr / NW) * (int)gridDim.x * NW;
            if (row < NTOK) {
                const int e1 = rinfo[lr * 4 + 0], p1 = lcnt[16 + e1] + rinfo[lr * 4 + 1];
                const int e2 = rinfo[lr * 4 + 2], p2 = lcnt[16 + e2] + rinfo[lr * 4 + 3];
                PF(list_tok)[e1 * NTOK + p1] = row; PF(list_w)[e1 * NTOK + p1] = rwt[lr * 2 + 0];
                PF(list_tok)[e2 * NTOK + p2] = row; PF(list_w)[e2 * NTOK + p2] = rwt[lr * 2 + 1];
                PF(tok_slot)[row * 2 + 0] = e1 * NTOK + p1; PF(tok_slot)[row * 2 + 1] = e2 * NTOK + p2;
            }
        }
    }
    __syncthreads();
}


template <bool GATHER_>
struct MoeOrder {
    static constexpr bool GATHER = GATHER_;
    const LAS int* tab; const LAS int* rowtab;
    const char* Bt; unsigned estride; int K, G, c;
    __device__ __forceinline__ bool next(int i, pg8::Unit& u) const {
        const int nwg = __builtin_amdgcn_readfirstlane(tab[48]) * 4;
        const int L = i * G + c; if (L >= nwg) return false;
        int wgid = L; { const int q = nwg / 8, r = nwg % 8, xcd = wgid % 8, off = wgid / 8; wgid = (xcd < r ? xcd * (q + 1) : r * (q + 1) + (xcd - r) * q) + off; }
        const int mg = wgid >> 2, nt = wgid & 3;
        int e = 0;
#pragma unroll
        for (int k = 1; k < 16; ++k) e = (__builtin_amdgcn_readfirstlane(tab[32 + k]) <= mg) ? k : e;
        const int mt = mg - __builtin_amdgcn_readfirstlane(tab[32 + e]);
        const int rem = __builtin_amdgcn_readfirstlane(tab[e]) - mt * 256;
        u.e = e; u.pm = mt; u.pn = nt; u.ui = i; u.nrows = rem < 256 ? rem : 256; u.arow0 = __builtin_amdgcn_readfirstlane(tab[16 + e]) + mt * 256;
        u.bptr = Bt + (size_t)e * estride + (size_t)nt * 256 * K * 2;
        return true;
    }
    __device__ __forceinline__ int arow(const pg8::Unit& u, int r) const { return GATHER_ ? rowtab[u.ui * 256 + r] : u.arow0 + r; }
    __device__ __forceinline__ int lda(int K_) const { return K_; }
    __device__ __forceinline__ unsigned kstepA() const { return 128u; }
    __device__ __forceinline__ const char* abase(const pg8::Unit&, const char* A) const { return A; }
};
__device__ __forceinline__ void moe_tables(KA ka, int layer, LAS unsigned char* lds, bool want_rows, int G, int c) {
    LAS int* tab = (LAS int*)(lds + LDS_MISC + 256);
    LAS int* rowtab = (LAS int*)(lds + LDS_MISC + 1024);
    const int tid = opaque_tid();
    const int* cnt = (const int*)(PF(ctl) + CW_CNT) + layer * 16 * 64;
    if (tid < 16) tab[tid] = __hip_atomic_load(&cnt[tid * 64], __ATOMIC_RELAXED, __HIP_MEMORY_SCOPE_AGENT);
    __syncthreads();
    if (tid == 0) {
        int b = 0, m = 0;
        for (int e = 0; e < 16; ++e) { tab[16 + e] = b; tab[32 + e] = m; b += tab[e]; m += (tab[e] + 255) >> 8; }
        tab[48] = m;
    }
    __syncthreads();
    if (want_rows) {
        MoeOrder<true> S{tab, rowtab, nullptr, 0u, 1024, G, c};
        const int* lt = PF(list_tok);
        for (int i = 0; i < 4; ++i) {
            pg8::Unit u;
            if (!S.next(i, u)) break;
            if (tid < 256) { const int r = tid < u.nrows ? tid : u.nrows - 1; rowtab[i * 256 + tid] = lt[u.e * NTOK + u.pm * 256 + r]; }
        }
        asm volatile("s_waitcnt vmcnt(0) lgkmcnt(0)" ::: "memory");
        __syncthreads();
    }
}
struct EpiUp {
    static constexpr bool PERM = true;
    bf16_t* hidden;
    __device__ __forceinline__ void operator()(const f32x4 (&acc)[2][2][4][2], const pg8::Unit& u, int wr, int wc, int fr, int fq) const {
#pragma unroll
        for (int ai = 0; ai < 2; ++ai)
#pragma unroll
            for (int m = 0; m < 4; ++m) {
                const int r = ai * 128 + wr * 64 + m * 16 + fr;
                if (r < u.nrows) {
                    bf16_t* rowp = hidden + (size_t)(u.arow0 + r) * 512 + u.pn * 128 + wc * 32 + 8 * fq;
                    float h[8];
#pragma unroll
                    for (int n = 0; n < 2; ++n)
#pragma unroll
                        for (int j = 0; j < 4; ++j) { const float g = acc[ai][0][m][n][j], uu = acc[ai][1][m][n][j]; h[n * 4 + j] = g * sigmoidf_(g) * uu; }
                    u32x4 w; w.x = pg8::cvt_pk_bf16(h[0], h[1]); w.y = pg8::cvt_pk_bf16(h[2], h[3]); w.z = pg8::cvt_pk_bf16(h[4], h[5]); w.w = pg8::cvt_pk_bf16(h[6], h[7]);
                    *(u32x4*)rowp = w;
                }
            }
    }
};
struct EpiDown {
    static constexpr bool PERM = true;
    bf16_t* Y2; const float* lw;
    __device__ __forceinline__ void operator()(const f32x4 (&acc)[2][2][4][2], const pg8::Unit& u, int wr, int wc, int fr, int fq) const {
#pragma unroll
        for (int ai = 0; ai < 2; ++ai)
#pragma unroll
            for (int m = 0; m < 4; ++m) {
                const int r = ai * 128 + wr * 64 + m * 16 + fr;
                if (r < u.nrows) {
                    const float wgt = lw[u.e * NTOK + u.pm * 256 + r];
                    bf16_t* rowp = Y2 + (size_t)(u.arow0 + r) * DM + u.pn * 256 + wc * 32 + 8 * fq;
#pragma unroll
                    for (int bj = 0; bj < 2; ++bj) {
                        const f32x4 v0 = acc[ai][bj][m][0] * wgt, v1 = acc[ai][bj][m][1] * wgt;
                        u32x4 w; w.x = pg8::cvt_pk_bf16(v0[0], v0[1]); w.y = pg8::cvt_pk_bf16(v0[2], v0[3]); w.z = pg8::cvt_pk_bf16(v1[0], v1[1]); w.w = pg8::cvt_pk_bf16(v1[2], v1[3]);
                        *(u32x4*)(rowp + bj * 128) = w;
                    }
                }
            }
    }
};
__device__ __forceinline__ void phase_moe_up(KA ka, int layer, LAS unsigned char* lds) {
    moe_tables(ka, layer, lds, true, gridDim.x, opaque_bid());
    MoeOrder<true> S{(const LAS int*)(lds + LDS_MISC + 256), (const LAS int*)(lds + LDS_MISC + 1024),
                     (const char*)(PF(WT) + WT_UP), (unsigned)(1024u * 1024u * 2u), 1024, (int)gridDim.x, opaque_bid()};
    EpiUp E{PF(Y)};
    pg8::gemm_phase<EpiUp, MoeOrder<true>>(lds, (const char*)PF(XB), 1024, S, E);
}
__device__ __forceinline__ void phase_moe_down(KA ka, int layer, LAS unsigned char* lds) {
    moe_tables(ka, layer, lds, false, gridDim.x, opaque_bid());
    MoeOrder<false> S{(const LAS int*)(lds + LDS_MISC + 256), (const LAS int*)(lds + LDS_MISC + 1024),
                      (const char*)(PF(WT) + WT_DN), (unsigned)(1024u * 512u * 2u), 512, (int)gridDim.x, opaque_bid()};
    EpiDown E{PF(H), PF(list_w)};
    pg8::gemm_phase<EpiDown, MoeOrder<false>>(lds, (const char*)PF(Y), 512, S, E);
}

__device__ void phase_ln2(KA ka, int layer, const float* x1, float* xo) {
    PHASE_IDS
    bf16_t* xb = PF(XB);
    const bf16_t* Y2 = PF(H);
    const int lane = TID & 63, w = TID >> 6;
    const float* g = PF(ln2_g) + layer * 1024;
    const float* bb = PF(ln2_b) + layer * 1024;
    const int* cnt = (const int*)(PF(ctl) + CW_CNT) + layer * 16 * 64;
    int mybase = 0;
    {
        int cv = lane < 16 ? __hip_atomic_load(&cnt[(lane & 15) * 64], __ATOMIC_RELAXED, __HIP_MEMORY_SCOPE_AGENT) : 0;
        int incl = cv;
#pragma unroll
        for (int o = 1; o < 16; o <<= 1) { int t = __shfl_up(incl, o); if ((lane & 15) >= o) incl += t; }
        mybase = incl - cv;
    }
    for (int row = BID * NW + w; row < NTOK; row += gridDim.x * NW) {
        const int ts1 = PF(tok_slot)[row * 2 + 0], ts2 = PF(tok_slot)[row * 2 + 1];
        const int s1 = __shfl(mybase, ts1 >> 14) + (ts1 & (NTOK - 1)), s2 = __shfl(mybase, ts2 >> 14) + (ts2 & (NTOK - 1));
        f32x4 v[4];
        float s = 0.f;
#pragma unroll
        for (int j = 0; j < 4; ++j) {
            const int c = 256 * j + 4 * lane;
            const f32x4 xv = *(const f32x4*)(x1 + (size_t)row * DM + c);
            const u32x2 ya = *(const u32x2*)(Y2 + (size_t)s1 * DM + c), yb = *(const u32x2*)(Y2 + (size_t)s2 * DM + c);
            f32x4 t;
            t[0] = __uint_as_float(ya.x << 16) + __uint_as_float(yb.x << 16); t[1] = __uint_as_float(ya.x & 0xffff0000u) + __uint_as_float(yb.x & 0xffff0000u);
            t[2] = __uint_as_float(ya.y << 16) + __uint_as_float(yb.y << 16); t[3] = __uint_as_float(ya.y & 0xffff0000u) + __uint_as_float(yb.y & 0xffff0000u);
            v[j] = xv * ALPHA + t;
            s += (v[j][0] + v[j][1]) + (v[j][2] + v[j][3]);
        }
        const float mu = wave_sum(s) * (1.f / 1024.f);
        float q = 0.f;
#pragma unroll
        for (int j = 0; j < 4; ++j) { v[j] = v[j] - mu; q += (v[j][0] * v[j][0] + v[j][1] * v[j][1]) + (v[j][2] * v[j][2] + v[j][3] * v[j][3]); }
        const float rstd = rsqrtf(wave_sum(q) * (1.f / 1024.f) + 1e-5f);
#pragma unroll
        for (int j = 0; j < 4; ++j) {
            const int c = 256 * j + 4 * lane;
            const f32x4 o = v[j] * rstd * *(const f32x4*)(g + c) + *(const f32x4*)(bb + c);
            *(f32x4*)(xo + (size_t)row * DM + c) = o;
            u32x2 pw; pw.x = pk2(o[0], o[1]); pw.y = pk2(o[2], o[3]);
            *(u32x2*)(xb + (size_t)row * DM + c) = pw;
        }
    }
}

#define MFMA16(a, b, c) __builtin_amdgcn_mfma_f32_16x16x32_bf16((a), (b), (c), 0, 0, 0)
constexpr int NSA_KT = 0, NSA_VT = 16384, NSA_IMP = 32768, NSA_FIN = 65536, NSA_SEL = LDS_MISC + 8192;

__device__ __forceinline__ int tile_off(int r, int c) { return r * 128 + ((c ^ ((r >> 1) & 7)) << 4); }

__device__ __forceinline__ unsigned cvtpk(float lo, float hi) { return pk2(lo, hi); }
struct SelMask { unsigned a, b, c, d; };
__device__ __forceinline__ unsigned selbit(unsigned a, unsigned b, unsigned c, unsigned d, int j) {
    const int k = j >> 5;
    const unsigned lo = (k & 1) ? b : a, hi = (k & 1) ? d : c;
    const unsigned r = (k & 2) ? hi : lo;
    return (r >> (j & 31)) & 1u;
}

struct NsaRT {
    bf16x8 q[2];
    f32x4 o[4];
    float m, l;
    int tk;
};

template <int MODE, int NST>
__device__ __forceinline__ void nsa_loop(LAS unsigned char* lds, int tid, int lane, int w, int jb, int je,
                                         const char* ksrc, size_t kstride, size_t ktile, const char* vsrc, size_t vstride, size_t vtile,
                                         NsaRT (&R)[2], const SelMask selm0, const SelMask selm1, float (&carry)[2], float* impw) {
    const int g = lane >> 4, qr = lane & 15;
    int tid2 = tid; asm volatile("" : "+v"(tid2));
    const int sr = tid2 >> 3, sc = (tid2 & 7) ^ ((sr >> 1) & 7);
    const char* kp = ksrc + (size_t)sr * kstride + sc * 16;
    const char* vp = vsrc + (size_t)sr * vstride + sc * 16;
    const unsigned ldsw = (unsigned)w * 1024u;
    const int fxq = (qr >> 1) & 7;
    const int ka0 = qr * 128 + ((g ^ fxq) << 4), ka1 = qr * 128 + (((4 + g) ^ fxq) << 4);
    const int vb = qr * 128 + (g & 1) * 8, vc = (g >> 1) ^ fxq;
    const int va0 = vb + (vc << 4), va1 = vb + ((vc ^ 2) << 4), va2 = vb + ((vc ^ 4) << 4), va3 = vb + ((vc ^ 6) << 4);
    if (jb > je) return;
    constexpr int D = NST - 1;
#define NSA_ISSUE(jj, st) do { const int jc_ = (jj) < je ? (jj) : je; \
        __builtin_amdgcn_global_load_lds((const unsigned*)(kp + (size_t)jc_ * ktile), (LAS unsigned*)(lds + (st) * 16384 + ldsw), 16, 0, 0); \
        if (MODE != 0) __builtin_amdgcn_global_load_lds((const unsigned*)(vp + (size_t)jc_ * vtile), (LAS unsigned*)(lds + (st) * 16384 + 8192 + ldsw), 16, 0, 0); } while (0)
#define NSA_WAIT_TILE() do { if (NST == 2) asm volatile("s_waitcnt vmcnt(0) lgkmcnt(0)" ::: "memory"); else asm volatile("s_waitcnt vmcnt(4) lgkmcnt(0)" ::: "memory"); } while (0)
#pragma unroll
    for (int d = 0; d < D; ++d) NSA_ISSUE(jb + d, d);
    NSA_WAIT_TILE();
    __builtin_amdgcn_s_barrier();
    for (int j = jb; j <= je; ++j) {
        const int cur = (j - jb) & (NST - 1);
        NSA_ISSUE(j + D, (j - jb + D) & (NST - 1));
        const LAS unsigned char* kt = lds + cur * 16384;
        const LAS unsigned char* vt = lds + cur * 16384 + 8192;
        bool anyact;
        {
            bool a = false;
#pragma unroll
            for (int rt = 0; rt < 2; ++rt) {
                const int tk = R[rt].tk;
                if (MODE <= 1) { const int nv = tk >= 31 ? ((tk - 31) >> 4) + 1 : 0; a = a || (nv > 64 * j); }
                else if (MODE == 2) a = a || ((rt == 0 ? selbit(selm0.a, selm0.b, selm0.c, selm0.d, j) : selbit(selm1.a, selm1.b, selm1.c, selm1.d, j)) != 0u);
                else a = a || ((64 * j <= tk) && (64 * j + 63 > tk - 512));
            }
            anyact = __any(a);
        }
        if (anyact) {
            f32x4 s[2][4];
#pragma unroll
            for (int t = 0; t < 4; ++t) {
                const bf16x8 k0 = *(const LAS bf16x8*)(kt + ka0 + t * 2048), k1 = *(const LAS bf16x8*)(kt + ka1 + t * 2048);
#pragma unroll
                for (int rt = 0; rt < 2; ++rt) {
                    s[rt][t] = (f32x4){0.f, 0.f, 0.f, 0.f};
                    s[rt][t] = MFMA16(k0, R[rt].q[0], s[rt][t]);
                    s[rt][t] = MFMA16(k1, R[rt].q[1], s[rt][t]);
                }
            }
            const int kb = 64 * j + 4 * g;
            bf16x8 pf[2][2];
            if (MODE == 1) {
#pragma unroll
                for (int rt = 0; rt < 2; ++rt) {
                    const int tk = R[rt].tk;
                    const int nv = tk >= 31 ? ((tk - 31) >> 4) + 1 : 0;
                    const float mL = R[rt].m * 1.44269504f, invl = R[rt].l > 0.f ? 1.f / R[rt].l : 0.f;
                    float p[4][4];
#pragma unroll
                    for (int t = 0; t < 4; ++t)
#pragma unroll
                        for (int i = 0; i < 4; ++i) { const int key = kb + 16 * t + i; p[t][i] = (key < nv) ? __builtin_amdgcn_exp2f(fmaf(s[rt][t][i], 1.44269504f, -mL)) * invl : 0.f; }
#pragma unroll
                    for (int t = 0; t < 4; ++t) {
                        const float own = (p[t][0] + p[t][1]) + (p[t][2] + p[t][3]);
                        const float x3 = p[t][3];
                        const float up_cur = __shfl(x3, (lane + 48) & 63);
                        const float up_prev = __shfl(carry[rt], (lane + 48) & 63);
                        float v = own + (g >= 1 ? up_cur : up_prev);
                        v += __shfl_xor(v, 1);
                        v += __shfl_xor(v, 2);
                        carry[rt] = x3;
                        if ((qr & 3) == 0) impw[(4 * rt + (qr >> 2)) * 128 + 16 * j + 4 * t + g] = v;
                    }
#pragma unroll
                    for (int ks = 0; ks < 2; ++ks) {
                        u32x4 pu; pu.x = cvtpk(p[2 * ks][0], p[2 * ks][1]); pu.y = cvtpk(p[2 * ks][2], p[2 * ks][3]); pu.z = cvtpk(p[2 * ks + 1][0], p[2 * ks + 1][1]); pu.w = cvtpk(p[2 * ks + 1][2], p[2 * ks + 1][3]);
                        pf[rt][ks] = __builtin_bit_cast(bf16x8, pu);
                    }
                }
            } else {
                int lim_hi[2], lim_lo[2];
                bool none[2], part[2];
#pragma unroll
                for (int rt = 0; rt < 2; ++rt) {
                    const int tk = R[rt].tk;
                    if (MODE == 0) { const int nv = tk >= 31 ? ((tk - 31) >> 4) + 1 : 0; lim_hi[rt] = nv - 1; lim_lo[rt] = -1; }
                    else if (MODE == 2) { lim_hi[rt] = ((rt == 0 ? selbit(selm0.a, selm0.b, selm0.c, selm0.d, j) : selbit(selm1.a, selm1.b, selm1.c, selm1.d, j)) != 0u) ? tk : -1; lim_lo[rt] = -1; }
                    else { lim_hi[rt] = tk; lim_lo[rt] = tk - 512; }
                    const bool full = (64 * j + 63 <= lim_hi[rt]) && (64 * j > lim_lo[rt]);
                    none[rt] = (64 * j > lim_hi[rt]) || (64 * j + 63 <= lim_lo[rt]);
                    part[rt] = !full && !none[rt];
                }
                float lmx[2];
                if (__any(part[0] || part[1])) {
#pragma unroll
                    for (int rt = 0; rt < 2; ++rt) {
                        float mx = NEG_INF;
#pragma unroll
                        for (int t = 0; t < 4; ++t)
#pragma unroll
                            for (int i = 0; i < 4; ++i) {
                                const int key = kb + 16 * t + i;
                                const bool ok = (key <= lim_hi[rt]) && (key > lim_lo[rt]);
                                s[rt][t][i] = ok ? s[rt][t][i] : NEG_INF;
                                mx = fmaxf(mx, s[rt][t][i]);
                            }
                        lmx[rt] = mx;
                        none[rt] = false;
                    }
                } else {
#pragma unroll
                    for (int rt = 0; rt < 2; ++rt) {
                        float mx = NEG_INF;
#pragma unroll
                        for (int t = 0; t < 4; ++t)
#pragma unroll
                            for (int i = 0; i < 4; ++i) mx = fmaxf(mx, s[rt][t][i]);
                        lmx[rt] = none[rt] ? NEG_INF : mx;
                    }
                }
                if (__any((lmx[0] > R[0].m + 6.f) || (lmx[1] > R[1].m + 6.f))) {
#pragma unroll
                    for (int rt = 0; rt < 2; ++rt) {
                        float mx = lmx[rt];
                        mx = fmaxf(mx, __shfl_xor(mx, 16));
                        mx = fmaxf(mx, __shfl_xor(mx, 32));
                        const float mn = fmaxf(R[rt].m, mx);
                        const float alpha = __expf(R[rt].m - mn);
                        R[rt].l *= alpha; R[rt].m = mn;
                        if (MODE != 0) {
#pragma unroll
                            for (int dt = 0; dt < 4; ++dt) R[rt].o[dt] = R[rt].o[dt] * alpha;
                        }
                    }
                }
#pragma unroll
                for (int rt = 0; rt < 2; ++rt) {
                    const float negmL = none[rt] ? -1e30f : -fmaxf(R[rt].m, -1e4f) * 1.44269504f;
                    float p[4][4];
                    float rs = 0.f;
#pragma unroll
                    for (int t = 0; t < 4; ++t)
#pragma unroll
                        for (int i = 0; i < 4; ++i) { p[t][i] = __builtin_amdgcn_exp2f(fmaf(s[rt][t][i], 1.44269504f, negmL)); rs += p[t][i]; }
                    R[rt].l += rs;
                    if (MODE != 0) {
#pragma unroll
                        for (int ks = 0; ks < 2; ++ks) {
                            u32x4 pu; pu.x = cvtpk(p[2 * ks][0], p[2 * ks][1]); pu.y = cvtpk(p[2 * ks][2], p[2 * ks][3]); pu.z = cvtpk(p[2 * ks + 1][0], p[2 * ks + 1][1]); pu.w = cvtpk(p[2 * ks + 1][2], p[2 * ks + 1][3]);
                            pf[rt][ks] = __builtin_bit_cast(bf16x8, pu);
                        }
                    }
                }
            }
            if (MODE != 0) {
#pragma unroll
                for (int ks = 0; ks < 2; ++ks)
#pragma unroll
                    for (int dt = 0; dt < 4; ++dt) {
                        const u32x2 lo = *(const LAS u32x2*)(vt + (ks ? va2 : va0) + dt * 2048);
                        const u32x2 hi = *(const LAS u32x2*)(vt + (ks ? va3 : va1) + dt * 2048);
                        u32x4 vu; vu.x = lo.x; vu.y = lo.y; vu.z = hi.x; vu.w = hi.y;
                        const bf16x8 vf = __builtin_bit_cast(bf16x8, vu);
                        R[0].o[dt] = MFMA16(vf, pf[0][ks], R[0].o[dt]);
                        R[1].o[dt] = MFMA16(vf, pf[1][ks], R[1].o[dt]);
                    }
            }
        }
        NSA_WAIT_TILE();
        __builtin_amdgcn_s_barrier();
    }
    asm volatile("s_waitcnt vmcnt(0)" ::: "memory");
    __builtin_amdgcn_s_barrier();
#undef NSA_ISSUE
#undef NSA_WAIT_TILE
}

__device__ void phase_nsa2(KA ka, int layer, LAS unsigned char* lds) {
    PHASE_IDS
    const int tid = TID, lane = tid & 63, w = __builtin_amdgcn_readfirstlane(tid >> 6), g = lane >> 4, qr = lane & 15;
    const bf16_t* H = PF(H);
    const bf16_t* kcb = PF(kcb);
    const bf16_t* vcT = PF(vcT);
    const bf16_t* vsT = PF(vsT);
    const bf16_t* vwT = PF(vwT);
    bf16_t* Y = PF(Y);
    const float* gate_b = PF(nsa_gate_b) + layer * 24;
    const float* ogain = PF(out_gain) + layer * 1024;
    float* impw = (float*)(lds + NSA_IMP + w * 4096);
    unsigned* selw = (unsigned*)(lds + NSA_SEL + w * 128);
    for (int base = BID; base < 256; base += gridDim.x) {
#pragma unroll 1
        for (int half = 0; half < 2; ++half) {
            const int it = half ? 511 - base : base;
            const int chunk = it >> 2, bh = it & 3, b = bh >> 1, hk = bh & 1;
            const size_t rowbase = (size_t)b * T_;
            const int t0w = chunk * 64 + w * 8;
            NsaRT R[2];
            LAS f32x4* finw = (LAS f32x4*)(lds + NSA_FIN + w * 8192) + lane;
#pragma unroll
            for (int rt = 0; rt < 2; ++rt) {
                const int tk = t0w + 4 * rt + (qr >> 2), hh = hk * 4 + (qr & 3);
                R[rt].tk = tk;
                const bf16_t* qp = H + (rowbase + tk) * HLD + C_NQ + hh * 64 + 8 * g;
#pragma unroll
                for (int ks = 0; ks < 2; ++ks) {
                    const u32x4 u = *(const u32x4*)(qp + 32 * ks);
                    const unsigned uu[4] = {u.x, u.y, u.z, u.w};
                    u32x4 o4;
#pragma unroll
                    for (int e = 0; e < 4; ++e) {
                        const float f0 = __uint_as_float(uu[e] << 16) * 0.125f, f1 = __uint_as_float(uu[e] & 0xffff0000u) * 0.125f;
                        o4[e] = (__float_as_uint(f0) >> 16) | (__float_as_uint(f1) & 0xffff0000u);
                    }
                    R[rt].q[ks] = __builtin_bit_cast(bf16x8, o4);
                }
                R[rt].m = NEG_INF; R[rt].l = 0.f;
#pragma unroll
                for (int dt = 0; dt < 4; ++dt) R[rt].o[dt] = (f32x4){0.f, 0.f, 0.f, 0.f};
            }
            SelMask selm0{0u, 0u, 0u, 0u}, selm1{0u, 0u, 0u, 0u};
            float carry[2] = {0.f, 0.f};
            const int tmax = chunk * 64 + 63;
            const int nvmax = tmax >= 31 ? ((tmax - 31) >> 4) + 1 : 0;
            const int nb = (nvmax + 63) >> 6;
            const char* kc_src = (const char*)(kcb + (size_t)bh * 512 * 64);
            const char* vc_src = (const char*)(vcT + (size_t)bh * 64 * 512);
            nsa_loop<0, 2>(lds, tid, lane, w, 0, nb - 1, kc_src, 128, 64 * 128, nullptr, 0, 0, R, selm0, selm1, carry, impw);
#pragma unroll
            for (int rt = 0; rt < 2; ++rt) { float l = R[rt].l; l += __shfl_xor(l, 16); l += __shfl_xor(l, 32); R[rt].l = l; }
            for (int i = lane; i < 8 * 128; i += 64) impw[i] = 0.f;
            wave_sync();
            nsa_loop<1, 2>(lds, tid, lane, w, 0, nb - 1, kc_src, 128, 64 * 128, vc_src, 512 * 2, 64 * 2, R, selm0, selm1, carry, impw);
#pragma unroll
            for (int rt = 0; rt < 2; ++rt) {
                const int hh = hk * 4 + (qr & 3);
                const float gt = sigmoidf_(bf2f(H[(rowbase + R[rt].tk) * HLD + C_NG + hh * 3 + 0]) + gate_b[hh * 3 + 0]);
#pragma unroll
                for (int dt = 0; dt < 4; ++dt) { finw[(rt * 4 + dt) * 64] = R[rt].o[dt] * gt; R[rt].o[dt] = (f32x4){0.f, 0.f, 0.f, 0.f}; }
            }
            wave_sync();
            {
                const int tl = lane >> 3, sub = lane & 7;
                const int tks = t0w + tl, curb = tks >> 6;
                float v[16];
#pragma unroll
                for (int i = 0; i < 16; ++i) {
                    const int jj = sub * 16 + i;
                    const float a = impw[tl * 128 + jj];
                    const bool forced = (jj == 0) || (jj == curb) || (jj == curb - 1);
                    v[i] = (jj <= curb) ? (a + (forced ? 1e4f : 0.f)) : NEG_INF;
                }
                wave_sync();
#pragma unroll
                for (int i = 0; i < 16; ++i) impw[tl * 128 + sub * 16 + i] = v[i];
                wave_sync();
                int cnt[16];
#pragma unroll
                for (int i = 0; i < 16; ++i) cnt[i] = 0;
                for (int jj = 0; jj < 128; ++jj) {
                    const float x = impw[tl * 128 + jj];
#pragma unroll
                    for (int i = 0; i < 16; ++i) cnt[i] += (x > v[i]) || (x == v[i] && jj < sub * 16 + i);
                }
                unsigned bits = 0u;
#pragma unroll
                for (int i = 0; i < 16; ++i) bits |= ((cnt[i] < 16) && (v[i] > 0.5f * NEG_INF)) ? (1u << i) : 0u;
                const unsigned other = __shfl_xor(bits, 1);
                const unsigned word = (sub & 1) ? ((bits << 16) | other) : (bits | (other << 16));
                if ((sub & 1) == 0) selw[tl * 4 + (sub >> 1)] = word;
                wave_sync();
                { const unsigned* q0 = selw + (qr >> 2) * 4; selm0.a = q0[0]; selm0.b = q0[1]; selm0.c = q0[2]; selm0.d = q0[3];
                  selm1.a = q0[16]; selm1.b = q0[17]; selm1.c = q0[18]; selm1.d = q0[19]; }
                wave_sync();
            }
            __syncthreads();
#pragma unroll
            for (int rt = 0; rt < 2; ++rt) { R[rt].m = NEG_INF; R[rt].l = 0.f; }
            nsa_loop<2, 4>(lds, tid, lane, w, 0, chunk, (const char*)(H + rowbase * HLD + C_KS + hk * 64), (size_t)HLD * 2, (size_t)64 * HLD * 2,
                        (const char*)(vsT + (size_t)bh * 64 * T_), (size_t)T_ * 2, 64 * 2, R, selm0, selm1, carry, impw);
#pragma unroll
            for (int rt = 0; rt < 2; ++rt) {
                const int hh = hk * 4 + (qr & 3);
                const float gt = sigmoidf_(bf2f(H[(rowbase + R[rt].tk) * HLD + C_NG + hh * 3 + 1]) + gate_b[hh * 3 + 1]);
                float ltot = R[rt].l; ltot += __shfl_xor(ltot, 16); ltot += __shfl_xor(ltot, 32);
                const float sc = gt / ltot;
#pragma unroll
                for (int dt = 0; dt < 4; ++dt) { finw[(rt * 4 + dt) * 64] += R[rt].o[dt] * sc; R[rt].o[dt] = (f32x4){0.f, 0.f, 0.f, 0.f}; }
                R[rt].m = NEG_INF; R[rt].l = 0.f;
            }
            nsa_loop<3, 4>(lds, tid, lane, w, chunk >= 8 ? chunk - 8 : 0, chunk, (const char*)(H + rowbase * HLD + C_KW + hk * 64), (size_t)HLD * 2, (size_t)64 * HLD * 2,
                        (const char*)(vwT + (size_t)bh * 64 * T_), (size_t)T_ * 2, 64 * 2, R, selm0, selm1, carry, impw);
#pragma unroll
            for (int rt = 0; rt < 2; ++rt) {
                const int tk = R[rt].tk, hh = hk * 4 + (qr & 3);
                const float gt = sigmoidf_(bf2f(H[(rowbase + tk) * HLD + C_NG + hh * 3 + 2]) + gate_b[hh * 3 + 2]);
                float ltot = R[rt].l; ltot += __shfl_xor(ltot, 16); ltot += __shfl_xor(ltot, 32);
                const float sc = gt / ltot;
                bf16_t* yp = Y + (rowbase + tk) * DM + 256 + hh * 64 + 4 * g;
                f32x4 ov[4];
                float ss = 0.f;
#pragma unroll
                for (int dt = 0; dt < 4; ++dt) { ov[dt] = finw[(rt * 4 + dt) * 64] + R[rt].o[dt] * sc; ss += (ov[dt][0] * ov[dt][0] + ov[dt][1] * ov[dt][1]) + (ov[dt][2] * ov[dt][2] + ov[dt][3] * ov[dt][3]); }
                ss += __shfl_xor(ss, 16);
                ss += __shfl_xor(ss, 32);
                const float rn = rsqrtf(ss * (1.f / 64.f) + 1e-6f);
#pragma unroll
                for (int dt = 0; dt < 4; ++dt) {
                    const f32x4 o = ov[dt] * rn * *(const f32x4*)(ogain + 256 + hh * 64 + 16 * dt + 4 * g);
                    u32x2 wv; wv.x = pk2(o[0], o[1]); wv.y = pk2(o[2], o[3]);
                    *(u32x2*)(yp + 16 * dt) = wv;
                }
            }
        }
    }
}

__device__ void phase_vtrans(KA ka, float* smem) {
    PHASE_IDS
    const int lane = TID & 63, w = TID >> 6;
    bf16_t* scr = (bf16_t*)(smem + w * 4096);
    const bf16_t* H = PF(H);
    for (int it = BID * NW + w; it < 1024; it += gridDim.x * NW) {
        const int tt = it & 127, bh = (it >> 7) & 3, which = it >> 9;
        const int b = bh >> 1, hk = bh & 1;
        const size_t tok0 = (size_t)b * T_ + tt * 64;
        const int col = (which ? C_VW : C_VS) + hk * 64;
        bf16_t* dst = (which ? PF(vwT) : PF(vsT)) + (size_t)bh * 64 * T_ + tt * 64;
        wave_sync();
        for (int i = 0; i < 64; ++i) scr[lane * 66 + i] = H[(tok0 + i) * HLD + col + lane];
        wave_sync();
        for (int d = 0; d < 64; ++d) dst[(size_t)d * T_ + lane] = scr[d * 66 + lane];
    }
}

__device__ void phase_hgrnA(KA ka, int layer, LAS unsigned char* lds, int first, int nblk) {
    PHASE_IDS
    const int tid = TID, lane = tid & 63, w = __builtin_amdgcn_readfirstlane(tid >> 6), gq = lane >> 4, lc = lane & 15;
    float* Q = (float*)lds;
    float* K = Q + 64 * 68;
    float* Bc = K + 64 * 68;
    float* SEG = Bc + 64 * 68;
    LAS bf16_t* ATb = (LAS bf16_t*)(lds + 57344);
    LAS bf16_t* ItB = ATb + 64 * 72;
    LAS bf16_t* KtB = ItB + 64 * 72;
    const bf16_t* H = PF(H);
    const float* hgl = PF(hg_lower);
    float* hgU = PF(hgU); float* hgG = PF(hgG); bf16_t* hgQB = PF(hgQB); bf16_t* hgO = PF(hgO);
    if (BID < first) return;
    for (int item = BID - first; item < 1024; item += nblk) {
        const int c = item & 127, bh = item >> 7, h = bh & 3, b = bh >> 2;
        const size_t tok0 = (size_t)b * T_ + c * 64;
        __syncthreads();
#pragma unroll
        for (int i = 0; i < 8; ++i) {
            const int e = tid + i * NTHR, t = e >> 6, d = e & 63;
            float lb = 0.f;
            if (layer == 1) {
                const float h0 = hgl[h * 64 + d], h1 = hgl[256 + h * 64 + d];
                const float mx = fmaxf(h0, h1), e0 = expf(h0 - mx), e1 = expf(h1 - mx);
                lb = e1 / (e0 + e1);
            }
            const bf16_t* hp = H + (tok0 + t) * HLD + h * 64 + d;
            const float fl = bf2f(hp[C_HF]);
            const float sg = 1.f / (1.f + expf(-fl)), sgn = 1.f / (1.f + expf(fl));
            const float f = lb + (1.f - lb) * sg;
            Q[t * 68 + d] = bf2f(hp[C_HQ]);
            K[t * 68 + d] = (1.f - lb) * sgn;
            ItB[d * 72 + t] = hp[C_HI];
            Bc[t * 68 + d] = logf(fmaxf(f, 1e-38f));
        }
        __syncthreads();
        {
            const int d = lane, seg = w;
            float run = 0.f;
#pragma unroll
            for (int i = 0; i < 8; ++i) { run += Bc[(seg * 8 + i) * 68 + d]; Bc[(seg * 8 + i) * 68 + d] = run; }
            SEG[seg * 64 + d] = run;
            __syncthreads();
            float pre = 0.f;
            for (int s2 = 0; s2 < seg; ++s2) pre += SEG[s2 * 64 + d];
#pragma unroll
            for (int i = 0; i < 8; ++i) Bc[(seg * 8 + i) * 68 + d] += pre;
        }
        __syncthreads();
        {
            const int blk = tid >> 1, dh = tid & 1, tb = blk >> 4, sb = blk & 15;
            float acc[4][4];
#pragma unroll
            for (int i = 0; i < 4; ++i)
#pragma unroll
                for (int j = 0; j < 4; ++j) acc[i][j] = 0.f;
            if (sb <= tb) {
#pragma unroll 2
                for (int d0 = 32 * dh; d0 < 32 * dh + 32; d0 += 4) {
                    f32x4 qv[4], bt[4], kv[4], bsv[4];
#pragma unroll
                    for (int i = 0; i < 4; ++i) { qv[i] = *(const f32x4*)&Q[(4 * tb + i) * 68 + d0]; bt[i] = *(const f32x4*)&Bc[(4 * tb + i) * 68 + d0]; }
#pragma unroll
                    for (int j = 0; j < 4; ++j) { kv[j] = *(const f32x4*)&K[(4 * sb + j) * 68 + d0]; bsv[j] = *(const f32x4*)&Bc[(4 * sb + j) * 68 + d0]; }
#pragma unroll
                    for (int i = 0; i < 4; ++i)
#pragma unroll
                        for (int j = 0; j < 4; ++j)
#pragma unroll
                            for (int dd = 0; dd < 4; ++dd) acc[i][j] = fmaf(qv[i][dd] * kv[j][dd], __expf(fminf(bt[i][dd] - bsv[j][dd], 0.f)), acc[i][j]);
                }
            }
#pragma unroll
            for (int i = 0; i < 4; ++i)
#pragma unroll
                for (int j = 0; j < 4; ++j) { acc[i][j] += __shfl_xor(acc[i][j], 1); if (4 * sb + j > 4 * tb + i) acc[i][j] = 0.f; }
            if (dh == 0) {
#pragma unroll
                for (int i = 0; i < 4; ++i) {
                    u32x2 pw; pw.x = pk2(acc[i][0], acc[i][1]); pw.y = pk2(acc[i][2], acc[i][3]);
                    *(LAS u32x2*)(ATb + (4 * tb + i) * 72 + 4 * sb) = pw;
                }
            }
        }
#pragma unroll
        for (int i = 0; i < 8; ++i) {
            const int e = tid + i * NTHR, t = e >> 6, d = e & 63;
            const float bt = Bc[t * 68 + d];
            hgQB[(size_t)item * 4096 + e] = f2bf(Q[t * 68 + d] * __expf(bt));
            KtB[d * 72 + t] = f2bf(K[t * 68 + d] * __expf(Bc[63 * 68 + d] - bt));
        }
        if (tid < 64) hgG[(size_t)item * 64 + tid] = __expf(Bc[63 * 68 + tid]);
        __syncthreads();
#pragma unroll
        for (int q = 0; q < 4; ++q) {
            const int tile = w * 4 + q, isU = tile >> 4, rt_ = (tile >> 2) & 3, ct = tile & 3;
            const LAS bf16_t* Ab = (isU ? KtB : ATb) + (16 * rt_ + lc) * 72 + 8 * gq;
            const LAS bf16_t* Bb = ItB + (16 * ct + lc) * 72 + 8 * gq;
            f32x4 acc = (f32x4){0.f, 0.f, 0.f, 0.f};
            acc = MFMA16(*(const LAS bf16x8*)Ab, *(const LAS bf16x8*)Bb, acc);
            acc = MFMA16(*(const LAS bf16x8*)(Ab + 32), *(const LAS bf16x8*)(Bb + 32), acc);
#pragma unroll
            for (int i = 0; i < 4; ++i) {
                const int r = 16 * rt_ + 4 * gq + i, cc = 16 * ct + lc;
                if (isU) hgU[((size_t)item * 64 + r) * 64 + cc] = acc[i];
                else hgO[((size_t)item * 64 + r) * 64 + cc] = f2bf(acc[i]);
            }
        }
    }
}

__device__ void phase_hgrnB(KA ka) {
    PHASE_IDS
    const float* hgU = PF(hgU); const float* hgG = PF(hgG); float* hgS = PF(hgS);
    for (int gid = BID * NTHR + TID; gid < 32768; gid += gridDim.x * NTHR) {
        const int bh = gid >> 12, dv = gid & 4095, d = dv >> 6;
        float S = 0.f;
        for (int c0 = 0; c0 < 128; c0 += 8) {
            float u[8], gg[8];
#pragma unroll
            for (int k = 0; k < 8; ++k) { const size_t item = (size_t)bh * 128 + c0 + k; u[k] = hgU[item * 4096 + dv]; gg[k] = hgG[item * 64 + d]; }
#pragma unroll
            for (int k = 0; k < 8; ++k) { const size_t item = (size_t)bh * 128 + c0 + k; hgS[item * 4096 + dv] = S; S = fmaf(gg[k], S, u[k]); }
        }
    }
}

__device__ void phase_hgrnC(KA ka, int layer, LAS unsigned char* lds) {
    PHASE_IDS
    const int tid = TID, lane = tid & 63, w = __builtin_amdgcn_readfirstlane(tid >> 6), gq = lane >> 4, lc = lane & 15;
    LAS bf16_t* QBb = (LAS bf16_t*)lds;
    LAS bf16_t* StB = QBb + 64 * 72;
    float* OT = (float*)(lds + 32768);
    const bf16_t* H = PF(H);
    const float* hgS = PF(hgS); const bf16_t* hgQB = PF(hgQB); const bf16_t* hgO = PF(hgO);
    const float* og = PF(out_gain) + layer * 1024;
    bf16_t* Y = PF(Y);
    for (int item = BID; item < 1024; item += gridDim.x) {
        const int c = item & 127, bh = item >> 7, h = bh & 3, b = bh >> 2;
        const size_t tok0 = (size_t)b * T_ + c * 64;
        __syncthreads();
#pragma unroll
        for (int i = 0; i < 8; ++i) {
            const int e = tid + i * NTHR, r = e >> 6, cc = e & 63;
            QBb[r * 72 + cc] = hgQB[(size_t)item * 4096 + e];
            StB[cc * 72 + r] = f2bf(hgS[(size_t)item * 4096 + e]);
        }
        __syncthreads();
#pragma unroll
        for (int q = 0; q < 2; ++q) {
            const int tile = w * 2 + q, rt_ = tile >> 2, ct = tile & 3;
            const LAS bf16_t* Ab = QBb + (16 * rt_ + lc) * 72 + 8 * gq;
            const LAS bf16_t* Bb = StB + (16 * ct + lc) * 72 + 8 * gq;
            f32x4 acc = (f32x4){0.f, 0.f, 0.f, 0.f};
            acc = MFMA16(*(const LAS bf16x8*)Ab, *(const LAS bf16x8*)Bb, acc);
            acc = MFMA16(*(const LAS bf16x8*)(Ab + 32), *(const LAS bf16x8*)(Bb + 32), acc);
#pragma unroll
            for (int i = 0; i < 4; ++i) {
                const int t = 16 * rt_ + 4 * gq + i, v = 16 * ct + lc;
                OT[t * 65 + v] = acc[i] + bf2f(hgO[((size_t)item * 64 + t) * 64 + v]);
            }
        }
        __syncthreads();
#pragma unroll 1
        for (int i = 0; i < 8; ++i) {
            const int t = w + 8 * i, v = lane;
            const float acc = OT[t * 65 + v];
            const float ms = wave_sum(acc * acc) * (1.f / 64.f);
            const float hg = bf2f(H[(tok0 + t) * HLD + C_HG + h * 64 + v]);
            const float y = acc * rsqrtf(ms + 1e-6f) * og[768 + h * 64 + v] * (hg * sigmoidf_(hg));
            Y[(tok0 + t) * DM + 768 + h * 64 + v] = f2bf(y);
        }
    }
}

struct CmpOrder {
    static constexpr bool GATHER = false;
    const char* W1T; int c;
    __device__ __forceinline__ bool next(int i, pg8::Unit& u) const {
        if (i > 0 || c >= 16) return false;
        const int which = c >> 3, bh = (c >> 1) & 3, nt = c & 1;
        u.arow0 = (bh >> 1) * 512 + nt * 256; u.nrows = 256; u.pm = nt; u.pn = 0; u.e = which * 4 + bh; u.ui = 0;
        u.bptr = W1T + (size_t)which * 256 * 2048 * 2;
        return true;
    }
    __device__ __forceinline__ int arow(const pg8::Unit& u, int r) const { return u.arow0 + r; }
    __device__ __forceinline__ int lda(int) const { return 16 * HLD; }
    __device__ __forceinline__ unsigned kstepA() const { return (unsigned)(HLD * 2); }
    __device__ __forceinline__ const char* abase(const pg8::Unit& u, const char* A) const { return A + (((u.e >> 2) ? C_VC : C_KC) + (u.e & 1) * 64) * 2; }
};
struct EpiCmp {
    static constexpr bool PERM = true;
    bf16_t* G; const float* cbias;
    __device__ __forceinline__ void operator()(const f32x4 (&acc)[2][2][4][2], const pg8::Unit& u, int wr, int wc, int fr, int fq) const {
        const float* bp = cbias + (u.e >> 2) * 128 + wc * 32 + 8 * fq;
        const f32x4 b0 = *(const f32x4*)bp, b1 = *(const f32x4*)(bp + 4);
#pragma unroll
        for (int ai = 0; ai < 2; ++ai)
#pragma unroll
            for (int m = 0; m < 4; ++m) {
                const int r = ai * 128 + wr * 64 + m * 16 + fr;
                bf16_t* rowp = G + ((size_t)(u.e * 512 + u.pm * 256 + r)) * 128 + wc * 32 + 8 * fq;
                const f32x4 v0 = acc[ai][0][m][0] + b0, v1 = acc[ai][0][m][1] + b1;
                u32x4 w; w.x = pk2(gelu_slow(v0[0]), gelu_slow(v0[1])); w.y = pk2(gelu_slow(v0[2]), gelu_slow(v0[3])); w.z = pk2(gelu_slow(v1[0]), gelu_slow(v1[1])); w.w = pk2(gelu_slow(v1[2]), gelu_slow(v1[3]));
                *(u32x4*)rowp = w;
            }
    }
};
__device__ void phase_compress2(KA ka, int layer, LAS unsigned char* lds) {
    const int bid = opaque_bid();
    if (bid >= 16) return;
    CmpOrder S{(const char*)(PF(WT) + WT_C1), bid};
    EpiCmp E{PF(gb), PF(cbias)};
    pg8::gemm_phase<EpiCmp, CmpOrder>(lds, (const char*)PF(H), 2048, S, E);
    __syncthreads();
    const int tid = opaque_tid();
    const int which = bid >> 3, bh = (bid >> 1) & 3, nt = bid & 1;
    float* w2s = (float*)lds;
    const float* w2 = PF(cmp_w2) + ((size_t)layer * 2 + which) * 128 * 64;
    for (int i = tid; i < 128 * 64; i += NTHR) w2s[i] = w2[i];
    __syncthreads();
    const int r = tid >> 1, half = tid & 1;
    const bf16_t* grow = PF(gb) + ((size_t)((which * 4 + bh) * 512 + nt * 256 + r)) * 128;
    float acc[32];
#pragma unroll
    for (int j = 0; j < 32; ++j) acc[j] = 0.f;
    for (int c8 = 0; c8 < 16; ++c8) {
        const u32x4 gu = *(const u32x4*)(grow + c8 * 8);
        const unsigned gw[4] = {gu.x, gu.y, gu.z, gu.w};
#pragma unroll
        for (int e = 0; e < 8; ++e) {
            const float gv = (e & 1) ? __uint_as_float(gw[e >> 1] & 0xffff0000u) : __uint_as_float(gw[e >> 1] << 16);
            const float* wrow = w2s + (c8 * 8 + e) * 64 + half * 32;
#pragma unroll
            for (int j4 = 0; j4 < 8; ++j4) {
                const float4 w4 = *(const float4*)(wrow + j4 * 4);
                acc[j4 * 4 + 0] = fmaf(gv, w4.x, acc[j4 * 4 + 0]); acc[j4 * 4 + 1] = fmaf(gv, w4.y, acc[j4 * 4 + 1]);
                acc[j4 * 4 + 2] = fmaf(gv, w4.z, acc[j4 * 4 + 2]); acc[j4 * 4 + 3] = fmaf(gv, w4.w, acc[j4 * 4 + 3]);
            }
        }
    }
    const int n = nt * 256 + r;
    if (which == 0) {
        bf16_t* o = PF(kcb) + ((size_t)bh * 512 + n) * 64 + half * 32;
#pragma unroll
        for (int j = 0; j < 32; j += 2) *(unsigned*)(o + j) = pk2(acc[j], acc[j + 1]);
    } else {
        bf16_t* o = PF(vcT) + (size_t)bh * 64 * 512 + n;
#pragma unroll
        for (int j = 0; j < 32; ++j) o[(size_t)(half * 32 + j) * 512] = f2bf(acc[j]);
    }
    __syncthreads();
}

__device__ void phase_gmlp2(KA ka, int layer, LAS unsigned char* lds, int first, int nblk) {
    PHASE_IDS
    const int tid = TID, lane = tid & 63, w = __builtin_amdgcn_readfirstlane(tid >> 6), gq = lane >> 4, lc = lane & 15;
    LAS bf16_t* Vt = (LAS bf16_t*)lds;
    const float* gain = PF(gm_v_gain) + layer * 256;
    const float* bias = PF(gm_v_bias) + layer * 256;
    const float* bs = PF(gm_b_s) + layer * 4 * 128;
    const bf16_t* gmW = PF(WT) + WT_GM;
    const bf16_t* H = PF(H);
    bf16_t* Y = PF(Y);
    if (BID < first) return;
    for (int item = BID - first; item < 512; item += nblk) {
        const int g = item & 3, c = (item >> 2) & 63, b = item >> 8;
        const size_t tok0 = (size_t)b * T_ + (size_t)c * 128;
        __syncthreads();
        for (int i = 0; i < 16; ++i) {
            const int s = w * 16 + i;
            const float x = bf2f(H[(tok0 + s) * HLD + C_GV + g * 64 + lane]);
            const float ge = gelu_slow(x);
            const float mu = wave_sum(ge) * (1.f / 64.f);
            const float dl = ge - mu;
            const float var = wave_sum(dl * dl) * (1.f / 64.f);
            Vt[lane * 136 + s] = f2bf(dl * rsqrtf(var + 1e-5f) * gain[g * 64 + lane] + bias[g * 64 + lane]);
        }
        __syncthreads();
        f32x4 acc[4];
#pragma unroll
        for (int ct = 0; ct < 4; ++ct) acc[ct] = (f32x4){0.f, 0.f, 0.f, 0.f};
        const bf16_t* wrow = gmW + ((size_t)g * 128 + 16 * w + lc) * 128 + 8 * gq;
        const int kmax = (16 * w + 15) >> 5;
        for (int ks = 0; ks <= kmax; ++ks) {
            const bf16x8 a = *(const bf16x8*)(wrow + 32 * ks);
#pragma unroll
            for (int ct = 0; ct < 4; ++ct) {
                const bf16x8 bfr = *(const LAS bf16x8*)(Vt + (16 * ct + lc) * 136 + 32 * ks + 8 * gq);
                acc[ct] = MFMA16(a, bfr, acc[ct]);
            }
        }
        const float* ogain = PF(out_gain) + layer * 1024;
#pragma unroll
        for (int i = 0; i < 4; ++i) {
            const int t = 16 * w + 4 * gq + i;
            float yv[4];
            float ss = 0.f;
#pragma unroll
            for (int ct = 0; ct < 4; ++ct) {
                const int d = 16 * ct + lc;
                const float z = acc[ct][i] + bs[g * 128 + t];
                const float u = gelu_slow(bf2f(H[(tok0 + t) * HLD + C_GU + g * 64 + d]));
                yv[ct] = u * z;
                ss += yv[ct] * yv[ct];
            }
            ss += __shfl_xor(ss, 1); ss += __shfl_xor(ss, 2); ss += __shfl_xor(ss, 4); ss += __shfl_xor(ss, 8);
            const float rn = rsqrtf(ss * (1.f / 64.f) + 1e-6f);
#pragma unroll
            for (int ct = 0; ct < 4; ++ct) {
                const int d = 16 * ct + lc;
                Y[(tok0 + t) * DM + g * 64 + d] = f2bf(yv[ct] * rn * ogain[g * 64 + d]);
            }
        }
    }
}

#ifndef ONLY_Q
#define ONLY_Q -2
#endif
#ifndef QMASK
#define QMASK 0x3ff
#endif
#define QON(k) ((ONLY_Q == -2 && ((QMASK >> ((k) + 1)) & 1)) || ONLY_Q == (k))
#ifndef DUPMASK
#define DUPMASK 0
#endif
#define DUP(k) ((DUPMASK >> (k)) & 1)
#ifndef PROF_LO
#define PROF_LO -1
#endif
#ifndef PROF_HI
#define PROF_HI -1
#endif
#ifndef NPH_TOTAL
#define NPH_TOTAL 19
#endif
__global__ void __launch_bounds__(NTHR, 2) k_mega(P p0) {
    extern __shared__ __attribute__((aligned(16))) unsigned char lds_raw[];
    LAS unsigned char* lds = (LAS unsigned char*)lds_raw;
    float* smem = (float*)lds_raw;
    volatile LAS unsigned* misc = (volatile LAS unsigned*)(lds + LDS_MISC);
    if (threadIdx.x < 16) misc[threadIdx.x] = 0u;
    __syncthreads();
    XcdBarrier bar = xcd_barrier_post(p0.ctl + CW_BAR, misc);
    if (PROF_LO >= 0 && blockIdx.x == 0 && threadIdx.x == 0) ((unsigned long long*)(p0.ctl + 8192))[0] = __builtin_amdgcn_s_memrealtime();
#pragma unroll 1
    for (int ph = 0; ph < p0.nph; ph++) {
        const int layer = ph == 0 ? 0 : (ph - 1) / 9, q = ph == 0 ? -1 : (ph - 1) % 9;
        const int dupm = p0.pad;
#if defined(__HIP_DEVICE_COMPILE__)
        KA ka = (KA)__builtin_amdgcn_kernarg_segment_ptr();
        asm volatile("" : "+s"(ka));
#else
        KA ka = nullptr;
#endif
        const float* xin = layer == 0 ? PF(x) : PF(out);
        float* x1 = PF(out);
        if (q == -1 && QON(-1)) { for (int r = 0; r <= ((dupm >> 15) & 1); ++r) { phase_prologue(ka, 0, smem); __syncthreads(); } }
        else if (q == 0 && QON(0)) { for (int r = 0; r <= (dupm & 1); ++r) { phase_inproj(ka, layer, lds); __syncthreads(); } }
        else if (q == 1 && QON(1)) {
            const int nb1 = (int)gridDim.x > 32 ? 16 : 0, nwork = (int)gridDim.x - nb1;
            for (int r = 0; r <= ((dupm >> 12) & 1); ++r) { phase_compress2(ka, layer, lds); __syncthreads(); }
            for (int r = 0; r <= ((dupm >> 10) & 1); ++r) { phase_hgrnA(ka, layer, lds, nb1, nwork); __syncthreads(); }
            for (int r = 0; r <= ((dupm >> 11) & 1); ++r) { phase_gmlp2(ka, layer, lds, nb1, nwork); __syncthreads(); }
            for (int r = 0; r <= ((dupm >> 13) & 1); ++r) { phase_vtrans(ka, smem); __syncthreads(); }
        }
        else if (q == 2 && QON(2)) { for (int r = 0; r <= ((dupm >> 14) & 1); ++r) { phase_hgrnB(ka); __syncthreads(); } for (int r = 0; r <= ((dupm >> 2) & 1); ++r) { phase_nsa2(ka, layer, lds); __syncthreads(); } }
        else if (q == 3 && QON(3)) { for (int r = 0; r <= ((dupm >> 3) & 1); ++r) { phase_hgrnC(ka, layer, lds); __syncthreads(); } }
        else if (q == 4 && QON(4)) phase_outproj(ka, layer, xin, x1, lds);
        else if (q == 5 && QON(5)) { for (int r = ((dupm >> 5) & 1); r >= 0; --r) { phase_ln1_route(ka, layer, x1, smem, r == 1); __syncthreads(); } }
        else if (q == 6 && QON(6)) { for (int r = 0; r <= ((dupm >> 6) & 1); ++r) { phase_moe_up(ka, layer, lds); __syncthreads(); } }
        else if (q == 7 && QON(7)) { for (int r = 0; r <= ((dupm >> 7) & 1); ++r) { phase_moe_down(ka, layer, lds); __syncthreads(); } }
        else if (q == 8 && QON(8)) { phase_ln2(ka, layer, x1, PF(out)); if (layer == 0) { __syncthreads(); phase_prologue(ka, 1, smem); } }
        if (ph != NPH_TOTAL - 1 || PROF_LO >= 0) xcd_barrier(bar);
        if (PROF_LO >= 0 && blockIdx.x == 0 && threadIdx.x == 0) ((unsigned long long*)(p0.ctl + 8192))[ph + 1] = __builtin_amdgcn_s_memrealtime();
    }
    if (PROF_LO >= 0) {
        xcd_barrier(bar);
        const unsigned long long* ts = (const unsigned long long*)(p0.ctl + 8192);
        const unsigned long long t0 = __hip_atomic_load(&ts[PROF_LO], __ATOMIC_RELAXED, __HIP_MEMORY_SCOPE_AGENT), t1 = __hip_atomic_load(&ts[PROF_HI + 1], __ATOMIC_RELAXED, __HIP_MEMORY_SCOPE_AGENT);
        const float fac = 1.f + 1e-5f * (float)(t1 - t0);
        for (size_t i = (size_t)blockIdx.x * NTHR + threadIdx.x; i < (size_t)NTOK * DM; i += (size_t)gridDim.x * NTHR) p0.out[i] *= fac;
    }
}

static inline size_t align_up(size_t v, size_t a) { return (v + a - 1) / a * a; }

extern "C" void kernel_launch(void* const* d_in, const int* in_sizes, int n_in, void* d_out, int out_size, void* d_ws,
                              size_t ws_size, hipStream_t stream) {
    P p{};
    p.x = (const float*)d_in[0]; p.w_in = (const float*)d_in[1]; p.gm_v_gain = (const float*)d_in[2];
    p.gm_v_bias = (const float*)d_in[3]; p.gm_w_s = (const float*)d_in[4]; p.gm_b_s = (const float*)d_in[5];
    p.cmp_pos = (const float*)d_in[6]; p.cmp_w1 = (const float*)d_in[7]; p.cmp_w2 = (const float*)d_in[8];
    p.nsa_gate_b = (const float*)d_in[9]; p.hg_lower = (const float*)d_in[10]; p.out_gain = (const float*)d_in[11];
    p.w_out = (const float*)d_in[12]; p.ln1_g = (const float*)d_in[13]; p.ln1_b = (const float*)d_in[14];
    p.rg_w = (const float*)d_in[15]; p.rg_b = (const float*)d_in[16]; p.re_w = (const float*)d_in[17];
    p.re_b = (const float*)d_in[18]; p.w_gate = (const float*)d_in[19]; p.w_up = (const float*)d_in[20];
    p.w_down = (const float*)d_in[21]; p.ln2_g = (const float*)d_in[22]; p.ln2_b = (const float*)d_in[23];
    p.out = (float*)d_out;
    char* ws = (char*)d_ws;
    size_t off = 0;
    p.ctl = (unsigned*)(ws + off); off = align_up(off + CTL_BYTES, 256);
    p.WT = (bf16_t*)(ws + off); off = align_up(off + WT_LAYER * 2, 256);
    p.H = (bf16_t*)(ws + off); off = align_up(off + (size_t)(NTOK + 64) * HLD * 2, 256);
    p.Y = (bf16_t*)(ws + off); off = align_up(off + (size_t)NTOK * DM * 2, 256);
    p.XB = (bf16_t*)(ws + off); off = align_up(off + (size_t)NTOK * DM * 2, 256);
    p.kcb = (bf16_t*)(ws + off); off = align_up(off + (size_t)4 * 512 * 64 * 2, 256);
    p.vcT = (bf16_t*)(ws + off); off = align_up(off + (size_t)4 * 64 * 512 * 2, 256);
    p.vsT = (bf16_t*)(ws + off); off = align_up(off + (size_t)4 * 64 * T_ * 2, 256);
    p.vwT = (bf16_t*)(ws + off); off = align_up(off + (size_t)4 * 64 * T_ * 2, 256);
    p.gb = (bf16_t*)(ws + off); off = align_up(off + (size_t)8 * 512 * 128 * 2, 256);
    p.cbias = (float*)(ws + off); off = align_up(off + 256 * 4, 256);
    p.list_tok = (int*)(ws + off); off = align_up(off + (size_t)16 * NTOK * 4, 256);
    p.list_w = (float*)(ws + off); off = align_up(off + (size_t)16 * NTOK * 4, 256);
    p.tok_slot = (int*)(ws + off); off = align_up(off + (size_t)NTOK * 2 * 4, 256);
    p.hgU = (float*)(ws + off); off = align_up(off + (size_t)1024 * 4096 * 4, 256);
    p.hgS = (float*)(ws + off); off = align_up(off + (size_t)1024 * 4096 * 4, 256);
    p.hgG = (float*)(ws + off); off = align_up(off + (size_t)1024 * 64 * 4, 256);
    p.hgQB = (bf16_t*)(ws + off); off = align_up(off + (size_t)1024 * 4096 * 2, 256);
    p.hgO = (bf16_t*)(ws + off); off = align_up(off + (size_t)1024 * 4096 * 2, 256);
    p.nph = NPH_TOTAL; p.pad = DUPMASK;
    (void)in_sizes; (void)n_in; (void)out_size;
    static int grid_blocks = 0;
    if (!grid_blocks) {
        int dev = 0, cus = 0, per_cu = 0;
        (void)hipGetDevice(&dev);
        (void)hipDeviceGetAttribute(&cus, hipDeviceAttributeMultiprocessorCount, dev);
        if (hipFuncSetAttribute((const void*)k_mega, hipFuncAttributeMaxDynamicSharedMemorySize, LDS_BYTES) != hipSuccess) { fprintf(stderr, "hipFuncSetAttribute failed\n"); grid_blocks = -1; return; }
        if (hipOccupancyMaxActiveBlocksPerMultiprocessor(&per_cu, (const void*)k_mega, NTHR, LDS_BYTES) != hipSuccess || per_cu < 1) { fprintf(stderr, "occupancy query says %d\n", per_cu); }
        (void)hipGetLastError();
        grid_blocks = cus;
        if (off > ws_size) { fprintf(stderr, "workspace too small: need %zu have %zu\n", off, ws_size); grid_blocks = -1; }
    }
    if (grid_blocks < 0) return;
    (void)hipMemsetAsync(p.ctl, 0, CTL_BYTES, stream);
    void* args[] = {&p};
    hipError_t e = hipLaunchCooperativeKernel((const void*)k_mega, dim3(grid_blocks), dim3(NTHR), args, LDS_BYTES, stream);
    if (e != hipSuccess) fprintf(stderr, "cooperative launch failed: %s (grid %d)\n", hipGetErrorString(e), grid_blocks);
}
```

```cpp
#include <hip/hip_runtime.h>
#include <cstdio>
#include <cstdint>

#define LAS __attribute__((address_space(3)))
typedef unsigned short bf16_t;
typedef short bf16x8 __attribute__((ext_vector_type(8)));
typedef float f32x4 __attribute__((ext_vector_type(4)));
typedef float f32x2 __attribute__((ext_vector_type(2)));
typedef unsigned u32x4 __attribute__((ext_vector_type(4)));
typedef unsigned u32x2 __attribute__((ext_vector_type(2)));

constexpr int NW = 8;
constexpr int NTHR = NW * 64;
constexpr int T_ = 8192;
constexpr int NTOK = 16384;
constexpr int DM = 1024;
constexpr int IC_SRC = 2840;
constexpr int HLD = 3072;
constexpr int C_GU = 0, C_GV = 256, C_NQ = 512, C_KC = 1024, C_VC = 1152, C_KS = 1280, C_VS = 1408,
              C_KW = 1536, C_VW = 1664, C_HQ = 1792, C_HF = 2048, C_HI = 2304, C_HG = 2560, C_NG = 2816;
constexpr int NCMP = 511;
constexpr float ALPHA = 1.4142135623730951f;
constexpr float NEG_INF = -1e30f;

constexpr size_t WT_IN = 0;
constexpr size_t WT_OUT = WT_IN + (size_t)3072 * 1024;
constexpr size_t WT_UP = WT_OUT + (size_t)1024 * 1024;
constexpr size_t WT_DN = WT_UP + (size_t)16 * 1024 * 1024;
constexpr size_t WT_C1 = WT_DN + (size_t)16 * 1024 * 512;
constexpr size_t WT_GM = WT_C1 + (size_t)2 * 256 * 2048;
constexpr size_t WT_LAYER = WT_GM + (size_t)4 * 128 * 128;

constexpr int LDS_STAGE = 131072;
constexpr int LDS_MISC = LDS_STAGE;
constexpr int LDS_BYTES = 147456;

constexpr int CW_BAR = 0;
constexpr int CW_CNT = 4096;
constexpr size_t CTL_BYTES = 65536;

struct P {
    const float* x; const float* w_in; const float* gm_v_gain; const float* gm_v_bias; const float* gm_w_s;
    const float* gm_b_s; const float* cmp_pos; const float* cmp_w1; const float* cmp_w2; const float* nsa_gate_b;
    const float* hg_lower; const float* out_gain; const float* w_out; const float* ln1_g; const float* ln1_b;
    const float* rg_w; const float* rg_b; const float* re_w; const float* re_b; const float* w_gate;
    const float* w_up; const float* w_down; const float* ln2_g; const float* ln2_b;
    float* out;
    unsigned* ctl;
    bf16_t* WT;
    bf16_t* H;
    bf16_t* Y;
    bf16_t* XB;
    bf16_t* kcb;
    bf16_t* vcT;
    bf16_t* vsT;
    bf16_t* vwT;
    bf16_t* gb;
    float* cbias;
    float* wrt;
    int* list_tok;
    float* list_w;
    int* tok_slot;
    float* hgU; float* hgG; float* hgS; bf16_t* hgQB; bf16_t* hgO;
    int nph; int pad;
};


typedef const __attribute__((address_space(4))) char* KA;
template <class T> __device__ __forceinline__ T ldarg(KA ka, size_t off) { return *(const __attribute__((address_space(4))) T*)(ka + off); }
#define PF(f) ldarg<decltype(P::f)>(ka, offsetof(P, f))

__device__ __forceinline__ float bf2f(bf16_t u) { return __uint_as_float(((unsigned)u) << 16); }
typedef __bf16 bf16x2_t __attribute__((ext_vector_type(2)));
__device__ __forceinline__ unsigned pk2(float lo, float hi) { f32x2 v; v.x = lo; v.y = hi; return __builtin_bit_cast(unsigned, __builtin_convertvector(v, bf16x2_t)); }
__device__ __forceinline__ bf16_t f2bf(float f) { return (bf16_t)(pk2(f, 0.f) & 0xffffu); }
__device__ __forceinline__ float gelu_t(float x) {
    const float u2 = -2.f * 0.7978845608028654f * (x + 0.044715f * x * x * x);
    return x / (1.f + __expf(u2));
}
__device__ __forceinline__ float gelu_slow(float x) {
    float u = 0.7978845608028654f * (x + 0.044715f * x * x * x);
    return 0.5f * x * (1.f + tanhf(u));
}
__device__ __forceinline__ float sigmoidf_(float x) { return 1.f / (1.f + __expf(-x)); }
__device__ __forceinline__ float wave_max(float v) {
#pragma unroll
    for (int o = 32; o > 0; o >>= 1) v = fmaxf(v, __shfl_xor(v, o));
    return v;
}
__device__ __forceinline__ float wave_sum(float v) {
#pragma unroll
    for (int o = 32; o > 0; o >>= 1) v += __shfl_xor(v, o);
    return v;
}
__device__ __forceinline__ void wave_sync() {
    __builtin_amdgcn_fence(__ATOMIC_RELEASE, "wavefront");
    __builtin_amdgcn_wave_barrier();
    __builtin_amdgcn_fence(__ATOMIC_ACQUIRE, "wavefront");
}
__device__ __forceinline__ f32x4 zero4() { f32x4 z = {0.f, 0.f, 0.f, 0.f}; asm volatile("" : "+v"(z)); return z; }
__device__ __forceinline__ int opaque_tid() { int t = threadIdx.x; asm volatile("" : "+v"(t)); return t; }
__device__ __forceinline__ int opaque_bid() { int b = blockIdx.x; asm volatile("" : "+s"(b)); return b; }
#define PHASE_IDS const int TID = opaque_tid(); const int BID = opaque_bid(); (void)TID; (void)BID;

#define XB_TMO      128
#define XB_XCNT(j)  (256  + 64 * (j))
#define XB_XSUB(j)  (1280 + 64 * (j))
#define XB_XGEN(j)  (2304 + 64 * (j))
#define XB_TOP      3328
#define XB_TOPGEN   3392
#define XCD_BAR_WORDS 3456
#define XB_SPIN_CAP (1u << 22)
__device__ __forceinline__ unsigned xb_ld(unsigned* p)              { return __hip_atomic_load(p, __ATOMIC_RELAXED, __HIP_MEMORY_SCOPE_AGENT); }
__device__ __forceinline__ unsigned xb_add(unsigned* p, unsigned v) { return __hip_atomic_fetch_add(p, v, __ATOMIC_RELAXED, __HIP_MEMORY_SCOPE_AGENT); }
__device__ __forceinline__ unsigned xb_xcc_id() { return (unsigned)__builtin_amdgcn_s_getreg((3 << 11) | 20) & 0xFu; }
#define XB_SPIN(cond, bar) do { unsigned _sp = 0; while (cond) { __builtin_amdgcn_s_sleep(1); \
    if ((++_sp & 255u) == 0u) { if (xb_ld(&(bar)[XB_TMO])) break; if (_sp > XB_SPIN_CAP) { atomicAdd(&(bar)[XB_TMO], 1u); break; } } } } while (0)
struct XcdBarrier { unsigned* bar; unsigned x; volatile LAS unsigned* st; };
__device__ __forceinline__ XcdBarrier xcd_barrier_post(unsigned* bar, volatile LAS unsigned* st) {
    XcdBarrier b; b.bar = bar; b.x = xb_xcc_id(); b.st = st;
    if (threadIdx.x == 0) (void)xb_add(&bar[XB_XCNT(b.x)], 1u);
    return b;
}
__device__ __forceinline__ void xcd_barrier_complete(unsigned* bar, unsigned x, unsigned& nloc, unsigned& nx) {
    const unsigned G = gridDim.x * gridDim.y * gridDim.z;
    unsigned sum, cnt, mine, sp = 0u;
    for (;;) {
        sum = 0u; cnt = 0u; mine = 0u;
#pragma unroll
        for (unsigned j = 0; j < 16; ++j) { const unsigned c = xb_ld(&bar[XB_XCNT(j)]); sum += c; cnt += (c > 0u) ? 1u : 0u; mine = (j == x) ? c : mine; }
        if (sum == G) break;
        __builtin_amdgcn_s_sleep(1);
        if ((++sp & 255u) == 0u) { if (xb_ld(&bar[XB_TMO])) break; if (sp > XB_SPIN_CAP) { atomicAdd(&bar[XB_TMO], 1u); break; } }
    }
    nloc = mine > 0u ? mine : 1u; nx = cnt > 0u ? cnt : 1u;
}
__device__ __forceinline__ void xcd_barrier(const XcdBarrier& b) {
    asm volatile("s_waitcnt vmcnt(0)" ::: "memory");
    __syncthreads();
    if (threadIdx.x == 0) {
        unsigned* bar = b.bar;
        __builtin_amdgcn_s_waitcnt(0);
        unsigned nloc = b.st[0], nx = b.st[1];
        if (nloc == 0u) { xcd_barrier_complete(bar, b.x, nloc, nx); b.st[0] = nloc; b.st[1] = nx; }
        const unsigned old = xb_add(&bar[XB_XSUB(b.x)], 1u);
        const unsigned gen = old / nloc;
        if (old + 1u == (gen + 1u) * nloc) {
            __builtin_amdgcn_fence(__ATOMIC_RELEASE, "agent");
            asm volatile("s_waitcnt vmcnt(0)" ::: "memory");
            const unsigned og = xb_add(&bar[XB_TOP], 1u);
            const unsigned tg = og / nx;
            if (og + 1u == (tg + 1u) * nx) xb_add(&bar[XB_TOPGEN], 1u);
            else XB_SPIN(xb_ld(&bar[XB_TOPGEN]) == tg, bar);
            __builtin_amdgcn_fence(__ATOMIC_ACQUIRE, "agent");
            xb_add(&bar[XB_XGEN(b.x)], 1u);
            asm volatile("s_waitcnt vmcnt(0)" ::: "memory");
        } else {
            XB_SPIN(xb_ld(&bar[XB_XGEN(b.x)]) == gen, bar);
            __builtin_amdgcn_fence(__ATOMIC_ACQUIRE, "agent");
            asm volatile("s_waitcnt vmcnt(0)" ::: "memory");
        }
    }
    __syncthreads();
}

namespace pg8 {
constexpr int BM = 256, BK = 64, HALF = 128, HTB = HALF * BK * 2, STAGE_BYTES = 8 * HTB;
__host__ __device__ __forceinline__ int lds_byte(int r, int c) { const int st = (r >> 4) * 2 + (c >> 5), rr = r & 15, cc = c & 31, ob = rr * 64 + cc * 2; return st * 1024 + (ob ^ (((ob >> 9) & 1) << 5)); }
__host__ __device__ __forceinline__ void stage_rc(int b, int& R, int& C) { const int st = b / 1024, sb = b % 1024, swz = sb ^ (((sb >> 9) & 1) << 5); R = (st >> 1) * 16 + swz / 64; C = (st & 1) * 32 + (swz % 64) / 2; }
__host__ __device__ __forceinline__ int perm32(int rho) { const int n = rho >> 4, i = rho & 15; return 8 * (i >> 2) + 4 * n + (i & 3); }
__device__ __forceinline__ unsigned cvt_pk_bf16(float lo, float hi) { return pk2(lo, hi); }

struct Unit {
    const char* bptr;
    int arow0;
    int nrows;
    int pm, pn, e, ui;
};

template <class Epi, class Sched>
__device__ __forceinline__ void gemm_phase(LAS unsigned char* lds, const char* Abase, const int K, const Sched& S, const Epi& E) {
    const int tid = opaque_tid(), wid = __builtin_amdgcn_readfirstlane(tid >> 6), lane = tid & 63, wr = wid >> 2, wc = wid & 3, fr = lane & 15, fq = lane >> 4;
    const int nt = K / BK;
    int R0, C0, R1, C1; stage_rc(tid * 16, R0, C0); stage_rc(tid * 16 + 8192, R1, C1);
    unsigned voffB[2];
    { const int Rb0 = Epi::PERM ? ((R0 & ~31) + perm32(R0 & 31)) : R0, Rb1 = Epi::PERM ? ((R1 & ~31) + perm32(R1 & 31)) : R1;
      voffB[0] = (unsigned)(Rb0 * K + C0) * 2u; voffB[1] = (unsigned)(Rb1 * K + C1) * 2u; }
    const unsigned cA0 = (unsigned)C0 * 2u, cA1 = (unsigned)C1 * 2u;
    const int lda = S.lda(K);
    const unsigned kstepA = S.kstepA();
    const unsigned voffA0 = (unsigned)(R0 * lda + C0) * 2u, voffA1 = (unsigned)(R1 * lda + C1) * 2u;
    const unsigned kstep = (unsigned)(BK * 2);
    const unsigned hstep = (unsigned)(HALF * K * 2);
    const unsigned ldsw = (unsigned)wid * 1024u;
    const int aoff = lds_byte(wr * 64 + fr, fq * 8), boff = lds_byte(wc * 32 + fr, fq * 8);
#define PG8_SA(b, h) (((b) * 2 + (h)) * HTB)
#define PG8_SB(b, h) ((4 + (b) * 2 + (h)) * HTB)
#define PG8_STAGE_B(bufoff, gbase) do { \
        __builtin_amdgcn_global_load_lds((const unsigned*)((const char*)(gbase) + voffB[0]), (LAS unsigned*)(lds + (bufoff) + ldsw), 16, 0, 0); \
        __builtin_amdgcn_global_load_lds((const unsigned*)((const char*)(gbase) + voffB[1]), (LAS unsigned*)(lds + (bufoff) + ldsw + 8192), 16, 0, 0); } while (0)
#define PG8_STAGE_A(bufoff, gbase, pk) do { \
        const unsigned o0_ = Sched::GATHER ? (((pk) & 0xffffu) * (unsigned)lda * 2u + cA0) : voffA0; \
        const unsigned o1_ = Sched::GATHER ? (((pk) >> 16) * (unsigned)lda * 2u + cA1) : voffA1; \
        __builtin_amdgcn_global_load_lds((const unsigned*)((const char*)(gbase) + o0_), (LAS unsigned*)(lds + (bufoff) + ldsw), 16, 0, 0); \
        __builtin_amdgcn_global_load_lds((const unsigned*)((const char*)(gbase) + o1_), (LAS unsigned*)(lds + (bufoff) + ldsw + 8192), 16, 0, 0); } while (0)
#define PG8_LDA(dst, b, h) do { _Pragma("unroll") for (int m = 0; m < 4; ++m) _Pragma("unroll") for (int k = 0; k < 2; ++k) dst[m][k] = *(const LAS bf16x8*)(lds + PG8_SA(b, h) + aoff + m * 2048 + k * 1024); } while (0)
#define PG8_LDB(dst, b, h) do { _Pragma("unroll") for (int n = 0; n < 2; ++n) _Pragma("unroll") for (int k = 0; k < 2; ++k) dst[n][k] = *(const LAS bf16x8*)(lds + PG8_SB(b, h) + boff + n * 2048 + k * 1024); } while (0)
#define PG8_MMA(ai, bj, At, Bt) do { __builtin_amdgcn_s_setprio(1); _Pragma("unroll") for (int m = 0; m < 4; ++m) _Pragma("unroll") for (int n = 0; n < 2; ++n) _Pragma("unroll") for (int k = 0; k < 2; ++k) \
        acc[ai][bj][m][n] = __builtin_amdgcn_mfma_f32_16x16x32_bf16(Bt[n][k], At[m][k], acc[ai][bj][m][n], 0, 0, 0); __builtin_amdgcn_s_setprio(0); } while (0)
#define PG8_WAIT_V(n) asm volatile("s_waitcnt vmcnt(" #n ")" ::: "memory")
#define PG8_WAIT_L(n) asm volatile("s_waitcnt lgkmcnt(" #n ")" ::: "memory")
#define PG8_BAR __builtin_amdgcn_s_barrier()
#define PG8_SCHED __builtin_amdgcn_sched_barrier(0)
#define PG8_PACK(u, h) ((unsigned)S.arow((u), ((h) * 128 + R0) < (u).nrows ? ((h) * 128 + R0) : (u).nrows - 1) | ((unsigned)S.arow((u), ((h) * 128 + R1) < (u).nrows ? ((h) * 128 + R1) : (u).nrows - 1) << 16))
    Unit cur, nxt; int ui = 0;
    if (!S.next(0, cur)) return;
    f32x4 acc[2][2][4][2];
    const f32x4 zv = zero4();
#pragma unroll
    for (int a = 0; a < 2; ++a)
#pragma unroll
        for (int b = 0; b < 2; ++b)
#pragma unroll
            for (int m = 0; m < 4; ++m)
#pragma unroll
                for (int n = 0; n < 2; ++n) acc[a][b][m][n] = zv;
    bf16x8 At[4][2], B0[2][2], B1[2][2];
    unsigned pC0 = 0u, pC1 = 0u, pN0 = 0u, pN1 = 0u;
    if (Sched::GATHER) { pC0 = PG8_PACK(cur, 0); pC1 = PG8_PACK(cur, 1); }
    const char* cB = cur.bptr;
    const char* cA = Sched::GATHER ? Abase : S.abase(cur, Abase) + (size_t)cur.arow0 * lda * 2;
    const unsigned hA = Sched::GATHER ? 0u : (unsigned)(HALF * lda * 2);
    PG8_STAGE_B(PG8_SB(0, 0), cB); PG8_STAGE_B(PG8_SB(0, 1), cB + hstep); PG8_STAGE_A(PG8_SA(0, 0), cA, pC0); PG8_STAGE_A(PG8_SA(0, 1), cA + hA, pC1);
    if (wr == 1) PG8_BAR;
    PG8_WAIT_V(2); PG8_BAR;
    PG8_STAGE_B(PG8_SB(1, 0), cB + kstep); PG8_STAGE_A(PG8_SA(1, 0), cA + kstepA, pC0); PG8_STAGE_B(PG8_SB(1, 1), cB + hstep + kstep);
    PG8_WAIT_V(6); PG8_BAR;
    for (;;) {
        const bool has_next = S.next(ui + 1, nxt);
        if (Sched::GATHER) { if (has_next) { pN0 = PG8_PACK(nxt, 0); pN1 = PG8_PACK(nxt, 1); } else { pN0 = pC0; pN1 = pC1; } }
        const char* nB = has_next ? nxt.bptr : cB;
        const char* nA = (Sched::GATHER || !has_next) ? cA : S.abase(nxt, Abase) + (size_t)nxt.arow0 * lda * 2;
        for (int t = 0; t < nt; t += 2) {
            const bool last = (t == nt - 2);
            const char* a1 = cA + (unsigned)(t + 1) * kstepA;
            const char* a2 = last ? nA : cA + (unsigned)(t + 2) * kstepA; const char* b2 = last ? nB : cB + (unsigned)(t + 2) * kstep;
            const char* a3 = a2 + kstepA; const char* b3 = b2 + kstep;
            const unsigned s0 = last ? pN0 : pC0, s1 = last ? pN1 : pC1;
            PG8_LDB(B0, 0, 0); PG8_LDB(B1, 0, 1); PG8_SCHED; PG8_LDA(At, 0, 0); PG8_STAGE_A(PG8_SA(1, 1), a1 + hA, pC1);
            PG8_WAIT_V(8); PG8_WAIT_L(0); PG8_BAR; PG8_MMA(0, 0, At, B0); PG8_MMA(0, 1, At, B1); PG8_BAR; PG8_SCHED;
            PG8_LDA(At, 0, 1); PG8_STAGE_B(PG8_SB(0, 0), b2); PG8_STAGE_B(PG8_SB(0, 1), b2 + hstep); PG8_STAGE_A(PG8_SA(0, 0), a2, s0);
            PG8_WAIT_V(8); PG8_WAIT_L(0); PG8_BAR; PG8_MMA(1, 0, At, B0); PG8_MMA(1, 1, At, B1); PG8_BAR; PG8_SCHED;
            PG8_LDB(B0, 1, 0); PG8_LDB(B1, 1, 1); PG8_SCHED; PG8_LDA(At, 1, 0); PG8_STAGE_A(PG8_SA(0, 1), a2 + hA, s1);
            PG8_WAIT_V(8); PG8_WAIT_L(0); PG8_BAR; PG8_MMA(0, 0, At, B0); PG8_MMA(0, 1, At, B1); PG8_BAR; PG8_SCHED;
            PG8_LDA(At, 1, 1); PG8_STAGE_B(PG8_SB(1, 0), b3); PG8_STAGE_B(PG8_SB(1, 1), b3 + hstep); PG8_STAGE_A(PG8_SA(1, 0), a3, s0);
            PG8_WAIT_V(8); PG8_WAIT_L(0); PG8_BAR; PG8_MMA(1, 0, At, B0); PG8_MMA(1, 1, At, B1); PG8_BAR; PG8_SCHED;
        }
        if (wr == 0) PG8_BAR;
        E(acc, cur, wr, wc, fr, fq);
        if (!has_next) break;
#pragma unroll
        for (int a = 0; a < 2; ++a)
#pragma unroll
            for (int b = 0; b < 2; ++b)
#pragma unroll
                for (int m = 0; m < 4; ++m)
#pragma unroll
                    for (int n = 0; n < 2; ++n) acc[a][b][m][n] = zv;
        cur = nxt; cB = nB; cA = nA; ++ui;
        pC0 = pN0; pC1 = pN1;
        if (wr == 1) PG8_BAR;
    }
    PG8_WAIT_V(0);
    PG8_BAR;
#undef PG8_SA
#undef PG8_SB
#undef PG8_STAGE_A
#undef PG8_STAGE_B
#undef PG8_LDA
#undef PG8_LDB
#undef PG8_MMA
#undef PG8_WAIT_V
#undef PG8_WAIT_L
#undef PG8_BAR
#undef PG8_SCHED
#undef PG8_PACK
}

struct DenseOrder {
    static constexpr bool GATHER = false;
    int nM, nN, nwg, G, c; const char* Bt; int K;
    __device__ void init(int M, int N, int K_, const bf16_t* Bt_, int G_, int c_) { nM = M / BM; nN = N / BM; nwg = nM * nN; G = G_; c = c_; Bt = (const char*)Bt_; K = K_; }
    __device__ __forceinline__ bool next(int i, Unit& u) const {
        const long L = (long)i * G + c; if (L >= nwg) return false;
        int wgid = (int)L; { const int q = nwg / 8, r = nwg % 8, xcd = wgid % 8, off = wgid / 8; wgid = (xcd < r ? xcd * (q + 1) : r * (q + 1) + (xcd - r) * q) + off; }
        const int nig = 8 * nN, gid = wgid / nig, fm = gid * 8, gsz = (nM - fm) < 8 ? (nM - fm) : 8;
        u.pm = fm + ((wgid % nig) % gsz); u.pn = (wgid % nig) / gsz;
        u.arow0 = u.pm * BM; u.nrows = BM; u.e = 0; u.ui = i;
        u.bptr = Bt + (size_t)u.pn * BM * K * 2;
        return true;
    }
    __device__ __forceinline__ int arow(const Unit& u, int r) const { return u.arow0 + r; }
    __device__ __forceinline__ int lda(int K_) const { return K_; }
    __device__ __forceinline__ unsigned kstepA() const { return 128u; }
    __device__ __forceinline__ const char* abase(const Unit&, const char* A) const { return A; }
};
}

struct EpiH {
    static constexpr bool PERM = true;
    bf16_t* H;
    __device__ __forceinline__ void operator()(const f32x4 (&acc)[2][2][4][2], const pg8::Unit& u, int wr, int wc, int fr, int fq) const {
        const int row0 = u.arow0 + wr * 64 + fr, col0 = u.pn * 256 + wc * 32 + 8 * fq;
#pragma unroll
        for (int ai = 0; ai < 2; ++ai)
#pragma unroll
            for (int m = 0; m < 4; ++m) {
                bf16_t* rowp = H + (size_t)(row0 + ai * 128 + m * 16) * HLD + col0;
#pragma unroll
                for (int bj = 0; bj < 2; ++bj) {
                    const f32x4 v0 = acc[ai][bj][m][0], v1 = acc[ai][bj][m][1];
                    u32x4 w; w.x = pg8::cvt_pk_bf16(v0[0], v0[1]); w.y = pg8::cvt_pk_bf16(v0[2], v0[3]); w.z = pg8::cvt_pk_bf16(v1[0], v1[1]); w.w = pg8::cvt_pk_bf16(v1[2], v1[3]);
                    *(u32x4*)(rowp + bj * 128) = w;
                }
            }
    }
};
struct EpiRes {
    static constexpr bool PERM = false;
    const float* xin; float* out;
    __device__ __forceinline__ void operator()(const f32x4 (&acc)[2][2][4][2], const pg8::Unit& u, int wr, int wc, int fr, int fq) const {
        const int row0 = u.arow0 + wr * 64 + fr, col0 = u.pn * 256 + wc * 32 + 4 * fq;
#pragma unroll
        for (int ai = 0; ai < 2; ++ai)
#pragma unroll
            for (int m = 0; m < 4; ++m) {
                const size_t off = (size_t)(row0 + ai * 128 + m * 16) * DM + col0;
#pragma unroll
                for (int bj = 0; bj < 2; ++bj)
#pragma unroll
                    for (int n = 0; n < 2; ++n) {
                        const f32x4 xv = *(const f32x4*)(xin + off + bj * 128 + n * 16);
                        *(f32x4*)(out + off + bj * 128 + n * 16) = xv * ALPHA + acc[ai][bj][m][n];
                    }
            }
    }
};

template <class RM>
__device__ __forceinline__ void transpose_item(const float* W, int K, int N, bf16_t* WT, RM rowmap, float* scr, int kb, int nb, int lane) {
    const int k0 = 64 * kb, n0 = 32 * nb;
    const int nn = n0 + (lane & 31);
    float tmp[32];
#pragma unroll
    for (int i = 0; i < 32; ++i) {
        const int kk = 2 * i + (lane >> 5);
        tmp[i] = nn < N ? W[(size_t)(k0 + kk) * N + nn] : 0.f;
    }
#pragma unroll
    for (int i = 0; i < 32; ++i) {
        const int kk = 2 * i + (lane >> 5);
        scr[kk * 33 + (lane & 31)] = tmp[i];
    }
    wave_sync();
    const int c = lane & 7;
#pragma unroll
    for (int j = 0; j < 4; ++j) {
        const int n = (lane >> 3) + 8 * j;
        const float* s = scr + (8 * c) * 33 + n;
        u32x4 o; o.x = pk2(s[0 * 33], s[1 * 33]); o.y = pk2(s[2 * 33], s[3 * 33]); o.z = pk2(s[4 * 33], s[5 * 33]); o.w = pk2(s[6 * 33], s[7 * 33]);
        const int dr = (n0 + n < N) ? rowmap(n0 + n) : -1;
        if (dr >= 0) *(u32x4*)(WT + (size_t)dr * K + k0 + 8 * c) = o;
    }
    wave_sync();
}

__device__ void phase_prologue(KA ka, int layer, float* smem) {
    PHASE_IDS
    const int lane = TID & 63, w = TID >> 6;
    float* scr = smem + w * 4096;
    const int gw = BID * NW + w, NGW = gridDim.x * NW;
    constexpr int I_IN = 16 * 89, I_OUT = 16 * 32, I_GU = 16 * 16, I_DN = 8 * 32;
    constexpr int I_LAYER = I_IN + I_OUT + 32 * I_GU + 16 * I_DN;
    for (int it = gw; it < I_LAYER; it += NGW) {
        int r = it;
        bf16_t* WT = PF(WT);
        if (r < I_IN) {
            transpose_item(PF(w_in) + (size_t)layer * DM * IC_SRC, DM, IC_SRC, WT + WT_IN,
                           [](int n) { return n < 1792 ? n : (n < 1816 ? 2816 + (n - 1792) : n - 24); }, scr, r / 89, r % 89, lane);
            continue;
        }
        r -= I_IN;
        if (r < I_OUT) {
            transpose_item(PF(w_out) + (size_t)layer * DM * DM, DM, DM, WT + WT_OUT, [](int n) { return n; }, scr, r / 32, r % 32, lane);
            continue;
        }
        r -= I_OUT;
        if (r < 32 * I_GU) {
            const int mat = r / I_GU, rr = r % I_GU, e = mat >> 1, isup = mat & 1;
            const float* W = (isup ? PF(w_up) : PF(w_gate)) + ((size_t)layer * 16 + e) * DM * 512;
            transpose_item(W, DM, 512, WT + WT_UP + (size_t)e * 1024 * 1024,
                           [isup](int n) { return (n >> 7) * 256 + isup * 128 + (n & 127); }, scr, rr / 16, rr % 16, lane);
            continue;
        }
        r -= 32 * I_GU;
        {
            const int e = r / I_DN, rr = r % I_DN;
            transpose_item(PF(w_down) + ((size_t)layer * 16 + e) * 512 * DM, 512, DM, WT + WT_DN + (size_t)e * 1024 * 512,
                           [](int n) { return n; }, scr, rr / 32, rr % 32, lane);
        }
    }
    for (int it = gw; it < 2 * 32 * 4; it += NGW) {
        const int which = it >> 7, rr = it & 127;
        transpose_item(PF(cmp_w1) + ((size_t)layer * 2 + which) * 2048 * 128, 2048, 128, PF(WT) + WT_C1 + (size_t)which * 256 * 2048, [](int n) { return n; }, scr, rr >> 2, rr & 3, lane);
    }
    for (int i = BID * NTHR + TID; i < 2 * 128 * 256; i += gridDim.x * NTHR) {
        const int which = i >> 15, q = i & 32767;
        const u32x4 z = __builtin_bit_cast(u32x4, zero4());
        *(u32x4*)(PF(WT) + WT_C1 + (size_t)which * 256 * 2048 + (size_t)128 * 2048 + (size_t)q * 8) = z;
    }
    for (int o = gw; o < 256; o += NGW) {
        const int which = o >> 7, cc = o & 127;
        const float* w1 = PF(cmp_w1) + ((size_t)layer * 2 + which) * 2048 * 128;
        const float* pos = PF(cmp_pos) + ((size_t)layer * 2 + which) * 2048;
        float a = 0.f;
        for (int k = lane; k < 2048; k += 64) a = fmaf(pos[k], w1[(size_t)k * 128 + cc], a);
        a = wave_sum(a);
        if (lane == 0) (PF(cbias) + layer * (256))[o] = a;
    }
    for (int i = BID * NTHR + TID; i < 4 * 128 * 128; i += gridDim.x * NTHR) {
        const int s = i & 127, t = (i >> 7) & 127;
        PF(WT)[WT_GM + i] = (s <= t) ? f2bf(PF(gm_w_s)[(size_t)layer * 4 * 128 * 128 + i]) : (bf16_t)0;
    }
    for (int i = BID * NTHR + TID; i < 20 * 1024; i += gridDim.x * NTHR) {
        const int o = i >> 10, cc = i & 1023;
        (PF(wrt) + layer * (20480))[i] = o < 4 ? PF(rg_w)[((size_t)layer * 1024 + cc) * 4 + o] : PF(re_w)[((size_t)layer * 1024 + cc) * 16 + (o - 4)];
    }
    for (int i = BID * NTHR + TID; i < 232 * 128; i += gridDim.x * NTHR) {
        const int q = i;
        const u32x4 z = __builtin_bit_cast(u32x4, zero4());
        *(u32x4*)(PF(WT) + WT_IN + (size_t)2840 * 1024 + (size_t)q * 8) = z;
    }
    if (layer == 0)
    for (int row = gw; row < NTOK; row += NGW) {
        const f32x4* xr = (const f32x4*)(PF(x) + (size_t)row * DM) + lane;
        u32x2* o = (u32x2*)(PF(XB) + (size_t)row * DM) + lane;
#pragma unroll
        for (int j = 0; j < 4; ++j) {
            const f32x4 v = xr[64 * j];
            u32x2 ww; ww.x = pk2(v[0], v[1]); ww.y = pk2(v[2], v[3]);
            o[64 * j] = ww;
        }
    }
}

template <class AF, class BF, class EF>
__device__ __forceinline__ void gemm128(int tid, int m0, int n0, int M, int N, int K, AF af, BF bf, EF ef, float* smem) {
    float* As = smem;
    float* Bs = smem + 16 * 132;
    const bool active = tid < 256;
    const int tx = tid & 15, ty = (tid >> 4) & 15;
    float acc[8][8];
#pragma unroll
    for (int i = 0; i < 8; i++)
#pragma unroll
        for (int j = 0; j < 8; j++) acc[i][j] = 0.f;
#pragma unroll 1
    for (int k0 = 0; k0 < K; k0 += 16) {
        if (active) {
#pragma unroll
            for (int i = 0; i < 8; i++) {
                int e = tid + i * 256;
                int r = e >> 4, kk = e & 15;
                float v = 0.f;
                if (m0 + r < M) v = af(m0 + r, k0 + kk);
                As[kk * 132 + r] = v;
            }
#pragma unroll
            for (int i = 0; i < 8; i++) {
                int e = tid + i * 256;
                int kk = e >> 7, c = e & 127;
                float v = 0.f;
                if (n0 + c < N) v = bf(k0 + kk, n0 + c);
                Bs[kk * 132 + c] = v;
            }
        }
        __syncthreads();
        if (active) {
#pragma unroll 2
            for (int kk = 0; kk < 16; kk++) {
                asm volatile("" ::: "memory");
                float4 a0 = *(const float4*)&As[kk * 132 + ty * 8];
                float4 a1 = *(const float4*)&As[kk * 132 + ty * 8 + 4];
                float4 b0 = *(const float4*)&Bs[kk * 132 + tx * 8];
                float4 b1 = *(const float4*)&Bs[kk * 132 + tx * 8 + 4];
                float a[8] = {a0.x, a0.y, a0.z, a0.w, a1.x, a1.y, a1.z, a1.w};
                float b[8] = {b0.x, b0.y, b0.z, b0.w, b1.x, b1.y, b1.z, b1.w};
#pragma unroll
                for (int i = 0; i < 8; i++)
#pragma unroll
                    for (int j = 0; j < 8; j++) acc[i][j] = fmaf(a[i], b[j], acc[i][j]);
            }
        }
        __syncthreads();
    }
    if (active) {
#pragma unroll
        for (int i = 0; i < 8; i++)
#pragma unroll
            for (int j = 0; j < 8; j++) {
                int m = m0 + ty * 8 + i, n = n0 + tx * 8 + j;
                if (m < M && n < N) ef(m, n, acc[i][j]);
            }
    }
}

__device__ __forceinline__ void phase_inproj(KA ka, int layer, LAS unsigned char* lds) {
    pg8::DenseOrder S; S.init(NTOK, HLD, DM, PF(WT) + WT_IN, gridDim.x, opaque_bid());
    EpiH E{PF(H)};
    pg8::gemm_phase<EpiH, pg8::DenseOrder>(lds, (const char*)PF(XB), DM, S, E);
}
__device__ __forceinline__ void phase_outproj(KA ka, int layer, const float* xin, float* x1, LAS unsigned char* lds) {
    pg8::DenseOrder S; S.init(NTOK, DM, DM, PF(WT) + WT_OUT, gridDim.x, opaque_bid());
    EpiRes E{xin, x1};
    pg8::gemm_phase<EpiRes, pg8::DenseOrder>(lds, (const char*)PF(Y), DM, S, E);
}

__device__ void phase_ln1_route(KA ka, int layer, float* x1, float* smem, bool dry) {
    PHASE_IDS
    bf16_t* xb = PF(XB);
    float* x1o = dry ? (float*)PF(H) : x1;
    const int lane = TID & 63, w = TID >> 6;
    const float* g = PF(ln1_g) + layer * 1024;
    const float* bb = PF(ln1_b) + layer * 1024;
    const float* wg = PF(rg_w) + (size_t)layer * 1024 * 4;
    const float* we = PF(re_w) + (size_t)layer * 1024 * 16;
    const float* bg = PF(rg_b) + layer * 4;
    const float* be = PF(re_b) + layer * 16;
    int* cnt = (int*)(PF(ctl) + CW_CNT) + layer * 16 * 64 + (dry ? 2048 : 0);
    int* lcnt = (int*)(smem + 20 * 1024);
    int* rinfo = lcnt + 64;
    float* rwt = (float*)(rinfo + 4 * 128);
    if (TID < 32) lcnt[TID] = 0;
    float* WR = smem;
    __syncthreads();
    for (int idx = TID; idx < 20 * 256; idx += NTHR) *(f32x4*)(WR + 4 * idx) = *(const f32x4*)((PF(wrt) + layer * (20480)) + 4 * idx);
    __syncthreads();
    int nloc = 0;
    for (int row = BID * NW + w; row < NTOK; row += gridDim.x * NW) {
        f32x4 v[4];
        float s = 0.f;
#pragma unroll
        for (int j = 0; j < 4; ++j) { v[j] = *(const f32x4*)(x1 + (size_t)row * DM + 256 * j + 4 * lane); s += (v[j][0] + v[j][1]) + (v[j][2] + v[j][3]); }
        const float mu = wave_sum(s) * (1.f / 1024.f);
        float q = 0.f;
#pragma unroll
        for (int j = 0; j < 4; ++j) { v[j] = v[j] - mu; q += (v[j][0] * v[j][0] + v[j][1] * v[j][1]) + (v[j][2] * v[j][2] + v[j][3] * v[j][3]); }
        const float rstd = rsqrtf(wave_sum(q) * (1.f / 1024.f) + 1e-5f);
#pragma unroll
        for (int j = 0; j < 4; ++j) {
            const int c = 256 * j + 4 * lane;
            v[j] = v[j] * rstd * *(const f32x4*)(g + c) + *(const f32x4*)(bb + c);
            *(f32x4*)(x1o + (size_t)row * DM + c) = v[j];
            u32x2 pw; pw.x = pk2(v[j][0], v[j][1]); pw.y = pk2(v[j][2], v[j][3]);
            *(u32x2*)(xb + (size_t)row * DM + c) = pw;
        }
        float lg[4], le[16];
#pragma unroll
        for (int o = 0; o < 20; ++o) {
            asm volatile("" ::: "memory");
            float a = 0.f;
#pragma unroll
            for (int j = 0; j < 4; ++j) {
                const f32x4 w4 = *(const f32x4*)(WR + o * 1024 + 256 * j + 4 * lane);
                a += (v[j][0] * w4[0] + v[j][1] * w4[1]) + (v[j][2] * w4[2] + v[j][3] * w4[3]);
            }
            a = wave_sum(a);
            if (o < 4) lg[o] = a + bg[o]; else le[o - 4] = a + be[o - 4];
        }
        float gm = fmaxf(fmaxf(lg[0], lg[1]), fmaxf(lg[2], lg[3]));
        float ge[4], gs = 0.f;
#pragma unroll
        for (int c = 0; c < 4; c++) { ge[c] = __expf(lg[c] - gm); gs += ge[c]; }
        int gi = 0; float gbest = ge[0];
#pragma unroll
        for (int c = 1; c < 4; c++) if (ge[c] > gbest) { gbest = ge[c]; gi = c; }
        float gval = gbest / gs;
        float ls[4];
#pragma unroll
        for (int e = 0; e < 4; e++) ls[e] = gi == 0 ? le[e] : gi == 1 ? le[4 + e] : gi == 2 ? le[8 + e] : le[12 + e];
        float em = fmaxf(fmaxf(ls[0], ls[1]), fmaxf(ls[2], ls[3]));
        float pe[4];
#pragma unroll
        for (int e = 0; e < 4; e++) pe[e] = __expf(ls[e] - em);
        int i1 = 0; float b1 = pe[0];
#pragma unroll
        for (int e = 1; e < 4; e++) if (pe[e] > b1) { b1 = pe[e]; i1 = e; }
        int i2 = -1; float b2 = -1.f;
#pragma unroll
        for (int e = 0; e < 4; e++) if (e != i1 && pe[e] > b2) { b2 = pe[e]; i2 = e; }
        float w1 = gval * b1 / (b1 + b2), w2 = gval * b2 / (b1 + b2);
        if (lane == 0) {
            const int e1 = gi * 4 + i1, e2 = gi * 4 + i2;
            const int lr = nloc * NW + w;
            rinfo[lr * 4 + 0] = e1; rinfo[lr * 4 + 1] = atomicAdd(&lcnt[e1], 1);
            rinfo[lr * 4 + 2] = e2; rinfo[lr * 4 + 3] = atomicAdd(&lcnt[e2], 1);
            rwt[lr * 2 + 0] = w1; rwt[lr * 2 + 1] = w2;
        }
        ++nloc;
    }
    __syncthreads();
    if (TID < 16) lcnt[16 + TID] = lcnt[TID] > 0 ? atomicAdd(&cnt[TID * 64], lcnt[TID]) : 0;
    __syncthreads();
    {
        const int nrows_blk = (NTOK - BID * NW + (int)gridDim.x * NW - 1) / ((int)gridDim.x * NW) * NW;
        for (int lr = TID; lr < nrows_blk; lr += NTHR) {
            const int row = BID * NW + (lr % NW) + (lr / NW) * (int)gridDim.x * NW;
            if (row < NTOK) {
                const int e1 = rinfo[lr * 4 + 0], p1 = lcnt[16 + e1] + rinfo[lr * 4 + 1];
                const int e2 = rinfo[lr * 4 + 2], p2 = lcnt[16 + e2] + rinfo[lr * 4 + 3];
                (PF(list_tok) + layer * ((size_t)16 * NTOK))[e1 * NTOK + p1] = row; (PF(list_w) + layer * ((size_t)16 * NTOK))[e1 * NTOK + p1] = rwt[lr * 2 + 0];
                (PF(list_tok) + layer * ((size_t)16 * NTOK))[e2 * NTOK + p2] = row; (PF(list_w) + layer * ((size_t)16 * NTOK))[e2 * NTOK + p2] = rwt[lr * 2 + 1];
                (PF(tok_slot) + layer * ((size_t)NTOK * 2))[row * 2 + 0] = e1 * NTOK + p1; (PF(tok_slot) + layer * ((size_t)NTOK * 2))[row * 2 + 1] = e2 * NTOK + p2;
            }
        }
    }
    __syncthreads();
}


template <bool GATHER_>
struct MoeOrder {
    static constexpr bool GATHER = GATHER_;
    const LAS int* tab; const LAS int* rowtab;
    const char* Bt; unsigned estride; int K, G, c;
    __device__ __forceinline__ bool next(int i, pg8::Unit& u) const {
        const int nwg = __builtin_amdgcn_readfirstlane(tab[48]) * 4;
        const int L = i * G + c; if (L >= nwg) return false;
        int wgid = L; { const int q = nwg / 8, r = nwg % 8, xcd = wgid % 8, off = wgid / 8; wgid = (xcd < r ? xcd * (q + 1) : r * (q + 1) + (xcd - r) * q) + off; }
        const int mg = wgid >> 2, nt = wgid & 3;
        int e = 0;
#pragma unroll
        for (int k = 1; k < 16; ++k) e = (__builtin_amdgcn_readfirstlane(tab[32 + k]) <= mg) ? k : e;
        const int mt = mg - __builtin_amdgcn_readfirstlane(tab[32 + e]);
        const int rem = __builtin_amdgcn_readfirstlane(tab[e]) - mt * 256;
        u.e = e; u.pm = mt; u.pn = nt; u.ui = i; u.nrows = rem < 256 ? rem : 256; u.arow0 = __builtin_amdgcn_readfirstlane(tab[16 + e]) + mt * 256;
        u.bptr = Bt + (size_t)e * estride + (size_t)nt * 256 * K * 2;
        return true;
    }
    __device__ __forceinline__ int arow(const pg8::Unit& u, int r) const { return GATHER_ ? rowtab[u.ui * 256 + r] : u.arow0 + r; }
    __device__ __forceinline__ int lda(int K_) const { return K_; }
    __device__ __forceinline__ unsigned kstepA() const { return 128u; }
    __device__ __forceinline__ const char* abase(const pg8::Unit&, const char* A) const { return A; }
};
__device__ __forceinline__ void moe_tables(KA ka, int layer, LAS unsigned char* lds, bool want_rows, int G, int c) {
    LAS int* tab = (LAS int*)(lds + LDS_MISC + 256);
    LAS int* rowtab = (LAS int*)(lds + LDS_MISC + 1024);
    const int tid = opaque_tid();
    const int* cnt = (const int*)(PF(ctl) + CW_CNT) + layer * 16 * 64;
    if (tid < 16) tab[tid] = __hip_atomic_load(&cnt[tid * 64], __ATOMIC_RELAXED, __HIP_MEMORY_SCOPE_AGENT);
    __syncthreads();
    if (tid == 0) {
        int b = 0, m = 0;
        for (int e = 0; e < 16; ++e) { tab[16 + e] = b; tab[32 + e] = m; b += tab[e]; m += (tab[e] + 255) >> 8; }
        tab[48] = m;
    }
    __syncthreads();
    if (want_rows) {
        MoeOrder<true> S{tab, rowtab, nullptr, 0u, 1024, G, c};
        const int* lt = (PF(list_tok) + layer * ((size_t)16 * NTOK));
        for (int i = 0; i < 4; ++i) {
            pg8::Unit u;
            if (!S.next(i, u)) break;
            if (tid < 256) { const int r = tid < u.nrows ? tid : u.nrows - 1; rowtab[i * 256 + tid] = lt[u.e * NTOK + u.pm * 256 + r]; }
        }
        asm volatile("s_waitcnt vmcnt(0) lgkmcnt(0)" ::: "memory");
        __syncthreads();
    }
}
struct EpiUp {
    static constexpr bool PERM = true;
    bf16_t* hidden;
    __device__ __forceinline__ void operator()(const f32x4 (&acc)[2][2][4][2], const pg8::Unit& u, int wr, int wc, int fr, int fq) const {
#pragma unroll
        for (int ai = 0; ai < 2; ++ai)
#pragma unroll
            for (int m = 0; m < 4; ++m) {
                const int r = ai * 128 + wr * 64 + m * 16 + fr;
                if (r < u.nrows) {
                    bf16_t* rowp = hidden + (size_t)(u.arow0 + r) * 512 + u.pn * 128 + wc * 32 + 8 * fq;
                    float h[8];
#pragma unroll
                    for (int n = 0; n < 2; ++n)
#pragma unroll
                        for (int j = 0; j < 4; ++j) { const float g = acc[ai][0][m][n][j], uu = acc[ai][1][m][n][j]; h[n * 4 + j] = g * sigmoidf_(g) * uu; }
                    u32x4 w; w.x = pg8::cvt_pk_bf16(h[0], h[1]); w.y = pg8::cvt_pk_bf16(h[2], h[3]); w.z = pg8::cvt_pk_bf16(h[4], h[5]); w.w = pg8::cvt_pk_bf16(h[6], h[7]);
                    *(u32x4*)rowp = w;
                }
            }
    }
};
struct EpiDown {
    static constexpr bool PERM = true;
    bf16_t* Y2; const float* lw;
    __device__ __forceinline__ void operator()(const f32x4 (&acc)[2][2][4][2], const pg8::Unit& u, int wr, int wc, int fr, int fq) const {
#pragma unroll
        for (int ai = 0; ai < 2; ++ai)
#pragma unroll
            for (int m = 0; m < 4; ++m) {
                const int r = ai * 128 + wr * 64 + m * 16 + fr;
                if (r < u.nrows) {
                    const float wgt = lw[u.e * NTOK + u.pm * 256 + r];
                    bf16_t* rowp = Y2 + (size_t)(u.arow0 + r) * DM + u.pn * 256 + wc * 32 + 8 * fq;
#pragma unroll
                    for (int bj = 0; bj < 2; ++bj) {
                        const f32x4 v0 = acc[ai][bj][m][0] * wgt, v1 = acc[ai][bj][m][1] * wgt;
                        u32x4 w; w.x = pg8::cvt_pk_bf16(v0[0], v0[1]); w.y = pg8::cvt_pk_bf16(v0[2], v0[3]); w.z = pg8::cvt_pk_bf16(v1[0], v1[1]); w.w = pg8::cvt_pk_bf16(v1[2], v1[3]);
                        *(u32x4*)(rowp + bj * 128) = w;
                    }
                }
            }
    }
};
__device__ __forceinline__ void phase_moe_up(KA ka, int layer, LAS unsigned char* lds) {
    moe_tables(ka, layer, lds, true, gridDim.x, opaque_bid());
    MoeOrder<true> S{(const LAS int*)(lds + LDS_MISC + 256), (const LAS int*)(lds + LDS_MISC + 1024),
                     (const char*)(PF(WT) + WT_UP), (unsigned)(1024u * 1024u * 2u), 1024, (int)gridDim.x, opaque_bid()};
    EpiUp E{PF(Y)};
    pg8::gemm_phase<EpiUp, MoeOrder<true>>(lds, (const char*)PF(XB), 1024, S, E);
}
__device__ __forceinline__ void phase_moe_down(KA ka, int layer, LAS unsigned char* lds) {
    moe_tables(ka, layer, lds, false, gridDim.x, opaque_bid());
    MoeOrder<false> S{(const LAS int*)(lds + LDS_MISC + 256), (const LAS int*)(lds + LDS_MISC + 1024),
                      (const char*)(PF(WT) + WT_DN), (unsigned)(1024u * 512u * 2u), 512, (int)gridDim.x, opaque_bid()};
    EpiDown E{PF(H), (PF(list_w) + layer * ((size_t)16 * NTOK))};
    pg8::gemm_phase<EpiDown, MoeOrder<false>>(lds, (const char*)PF(Y), 512, S, E);
}

__device__ void phase_ln2(KA ka, int layer, const float* x1, float* xo) {
    PHASE_IDS
    bf16_t* xb = PF(XB);
    const bf16_t* Y2 = PF(H);
    const int lane = TID & 63, w = TID >> 6;
    const float* g = PF(ln2_g) + layer * 1024;
    const float* bb = PF(ln2_b) + layer * 1024;
    const int* cnt = (const int*)(PF(ctl) + CW_CNT) + layer * 16 * 64;
    int mybase = 0;
    {
        int cv = lane < 16 ? __hip_atomic_load(&cnt[(lane & 15) * 64], __ATOMIC_RELAXED, __HIP_MEMORY_SCOPE_AGENT) : 0;
        int incl = cv;
#pragma unroll
        for (int o = 1; o < 16; o <<= 1) { int t = __shfl_up(incl, o); if ((lane & 15) >= o) incl += t; }
        mybase = incl - cv;
    }
    for (int row = BID * NW + w; row < NTOK; row += gridDim.x * NW) {
        const int ts1 = (PF(tok_slot) + layer * ((size_t)NTOK * 2))[row * 2 + 0], ts2 = (PF(tok_slot) + layer * ((size_t)NTOK * 2))[row * 2 + 1];
        const int s1 = __shfl(mybase, ts1 >> 14) + (ts1 & (NTOK - 1)), s2 = __shfl(mybase, ts2 >> 14) + (ts2 & (NTOK - 1));
        f32x4 v[4];
        float s = 0.f;
#pragma unroll
        for (int j = 0; j < 4; ++j) {
            const int c = 256 * j + 4 * lane;
            const f32x4 xv = *(const f32x4*)(x1 + (size_t)row * DM + c);
            const u32x2 ya = __builtin_nontemporal_load((const u32x2*)(Y2 + (size_t)s1 * DM + c)), yb = __builtin_nontemporal_load((const u32x2*)(Y2 + (size_t)s2 * DM + c));
            f32x4 t;
            t[0] = __uint_as_float(ya.x << 16) + __uint_as_float(yb.x << 16); t[1] = __uint_as_float(ya.x & 0xffff0000u) + __uint_as_float(yb.x & 0xffff0000u);
            t[2] = __uint_as_float(ya.y << 16) + __uint_as_float(yb.y << 16); t[3] = __uint_as_float(ya.y & 0xffff0000u) + __uint_as_float(yb.y & 0xffff0000u);
            v[j] = xv * ALPHA + t;
            s += (v[j][0] + v[j][1]) + (v[j][2] + v[j][3]);
        }
        const float mu = wave_sum(s) * (1.f / 1024.f);
        float q = 0.f;
#pragma unroll
        for (int j = 0; j < 4; ++j) { v[j] = v[j] - mu; q += (v[j][0] * v[j][0] + v[j][1] * v[j][1]) + (v[j][2] * v[j][2] + v[j][3] * v[j][3]); }
        const float rstd = rsqrtf(wave_sum(q) * (1.f / 1024.f) + 1e-5f);
#pragma unroll
        for (int j = 0; j < 4; ++j) {
            const int c = 256 * j + 4 * lane;
            const f32x4 o = v[j] * rstd * *(const f32x4*)(g + c) + *(const f32x4*)(bb + c);
            *(f32x4*)(xo + (size_t)row * DM + c) = o;
            u32x2 pw; pw.x = pk2(o[0], o[1]); pw.y = pk2(o[2], o[3]);
            *(u32x2*)(xb + (size_t)row * DM + c) = pw;
        }
    }
}

#define MFMA16(a, b, c) __builtin_amdgcn_mfma_f32_16x16x32_bf16((a), (b), (c), 0, 0, 0)
constexpr int NSA_KT = 0, NSA_VT = 16384, NSA_IMP = 32768, NSA_FIN = 65536, NSA_SEL = LDS_MISC + 8192;

__device__ __forceinline__ int tile_off(int r, int c) { return r * 128 + ((c ^ ((r >> 1) & 7)) << 4); }

__device__ __forceinline__ unsigned cvtpk(float lo, float hi) { return pk2(lo, hi); }
struct SelMask { unsigned a, b, c, d; };
__device__ __forceinline__ unsigned selbit(unsigned a, unsigned b, unsigned c, unsigned d, int j) {
    const int k = j >> 5;
    const unsigned lo = (k & 1) ? b : a, hi = (k & 1) ? d : c;
    const unsigned r = (k & 2) ? hi : lo;
    return (r >> (j & 31)) & 1u;
}

struct NsaRT {
    bf16x8 q[2];
    f32x4 o[4];
    float m, l;
    int tk;
};

template <int MODE, int NST>
__device__ __forceinline__ void nsa_loop(LAS unsigned char* lds, int tid, int lane, int w, int jb, int je,
                                         const char* ksrc, size_t kstride, size_t ktile, const char* vsrc, size_t vstride, size_t vtile,
                                         NsaRT (&R)[2], const SelMask selm0, const SelMask selm1, float (&carry)[2], float* impw) {
    const int g = lane >> 4, qr = lane & 15;
    int tid2 = tid; asm volatile("" : "+v"(tid2));
    const int sr = tid2 >> 3, sc = (tid2 & 7) ^ ((sr >> 1) & 7);
    const char* kp = ksrc + (size_t)sr * kstride + sc * 16;
    const char* vp = vsrc + (size_t)sr * vstride + sc * 16;
    const unsigned ldsw = (unsigned)w * 1024u;
    const int fxq = (qr >> 1) & 7;
    const int ka0 = qr * 128 + ((g ^ fxq) << 4), ka1 = qr * 128 + (((4 + g) ^ fxq) << 4);
    const int vb = qr * 128 + (g & 1) * 8, vc = (g >> 1) ^ fxq;
    const int va0 = vb + (vc << 4), va1 = vb + ((vc ^ 2) << 4), va2 = vb + ((vc ^ 4) << 4), va3 = vb + ((vc ^ 6) << 4);
    if (jb > je) return;
    constexpr int D = NST - 1;
#define NSA_ISSUE(jj, st) do { const int jc_ = (jj) < je ? (jj) : je; \
        __builtin_amdgcn_global_load_lds((const unsigned*)(kp + (size_t)jc_ * ktile), (LAS unsigned*)(lds + (st) * 16384 + ldsw), 16, 0, 0); \
        if (MODE != 0) __builtin_amdgcn_global_load_lds((const unsigned*)(vp + (size_t)jc_ * vtile), (LAS unsigned*)(lds + (st) * 16384 + 8192 + ldsw), 16, 0, 0); } while (0)
#define NSA_WAIT_TILE() do { if (NST == 2) asm volatile("s_waitcnt vmcnt(0) lgkmcnt(0)" ::: "memory"); else asm volatile("s_waitcnt vmcnt(4) lgkmcnt(0)" ::: "memory"); } while (0)
#pragma unroll
    for (int d = 0; d < D; ++d) NSA_ISSUE(jb + d, d);
    NSA_WAIT_TILE();
    __builtin_amdgcn_s_barrier();
    for (int j = jb; j <= je; ++j) {
        const int cur = (j - jb) & (NST - 1);
        NSA_ISSUE(j + D, (j - jb + D) & (NST - 1));
        const LAS unsigned char* kt = lds + cur * 16384;
        const LAS unsigned char* vt = lds + cur * 16384 + 8192;
        bool anyact;
        {
            bool a = false;
#pragma unroll
            for (int rt = 0; rt < 2; ++rt) {
                const int tk = R[rt].tk;
                if (MODE <= 1) { const int nv = tk >= 31 ? ((tk - 31) >> 4) + 1 : 0; a = a || (nv > 64 * j); }
                else if (MODE == 2) a = a || ((rt == 0 ? selbit(selm0.a, selm0.b, selm0.c, selm0.d, j) : selbit(selm1.a, selm1.b, selm1.c, selm1.d, j)) != 0u);
                else a = a || ((64 * j <= tk) && (64 * j + 63 > tk - 512));
            }
            anyact = __any(a);
        }
        if (anyact) {
            f32x4 s[2][4];
#pragma unroll
            for (int t = 0; t < 4; ++t) {
                const bf16x8 k0 = *(const LAS bf16x8*)(kt + ka0 + t * 2048), k1 = *(const LAS bf16x8*)(kt + ka1 + t * 2048);
#pragma unroll
                for (int rt = 0; rt < 2; ++rt) {
                    s[rt][t] = zero4();
                    s[rt][t] = MFMA16(k0, R[rt].q[0], s[rt][t]);
                    s[rt][t] = MFMA16(k1, R[rt].q[1], s[rt][t]);
                }
            }
            const int kb = 64 * j + 4 * g;
            bf16x8 pf[2][2];
            if (MODE == 1) {
#pragma unroll
                for (int rt = 0; rt < 2; ++rt) {
                    const int tk = R[rt].tk;
                    const int nv = tk >= 31 ? ((tk - 31) >> 4) + 1 : 0;
                    const float mL = R[rt].m * 1.44269504f, invl = R[rt].l > 0.f ? 1.f / R[rt].l : 0.f;
                    float p[4][4];
#pragma unroll
                    for (int t = 0; t < 4; ++t)
#pragma unroll
                        for (int i = 0; i < 4; ++i) { const int key = kb + 16 * t + i; p[t][i] = (key < nv) ? __builtin_amdgcn_exp2f(fmaf(s[rt][t][i], 1.44269504f, -mL)) * invl : 0.f; }
#pragma unroll
                    for (int t = 0; t < 4; ++t) {
                        const float own = (p[t][0] + p[t][1]) + (p[t][2] + p[t][3]);
                        const float x3 = p[t][3];
                        const float up_cur = __shfl(x3, (lane + 48) & 63);
                        const float up_prev = __shfl(carry[rt], (lane + 48) & 63);
                        float v = own + (g >= 1 ? up_cur : up_prev);
                        v += __shfl_xor(v, 1);
                        v += __shfl_xor(v, 2);
                        carry[rt] = x3;
                        if ((qr & 3) == 0) impw[(4 * rt + (qr >> 2)) * 128 + 16 * j + 4 * t + g] = v;
                    }
#pragma unroll
                    for (int ks = 0; ks < 2; ++ks) {
                        u32x4 pu; pu.x = cvtpk(p[2 * ks][0], p[2 * ks][1]); pu.y = cvtpk(p[2 * ks][2], p[2 * ks][3]); pu.z = cvtpk(p[2 * ks + 1][0], p[2 * ks + 1][1]); pu.w = cvtpk(p[2 * ks + 1][2], p[2 * ks + 1][3]);
                        pf[rt][ks] = __builtin_bit_cast(bf16x8, pu);
                    }
                }
            } else {
                int lim_hi[2], lim_lo[2];
                bool none[2], part[2];
#pragma unroll
                for (int rt = 0; rt < 2; ++rt) {
                    const int tk = R[rt].tk;
                    if (MODE == 0) { const int nv = tk >= 31 ? ((tk - 31) >> 4) + 1 : 0; lim_hi[rt] = nv - 1; lim_lo[rt] = -1; }
                    else if (MODE == 2) { lim_hi[rt] = ((rt == 0 ? selbit(selm0.a, selm0.b, selm0.c, selm0.d, j) : selbit(selm1.a, selm1.b, selm1.c, selm1.d, j)) != 0u) ? tk : -1; lim_lo[rt] = -1; }
                    else { lim_hi[rt] = tk; lim_lo[rt] = tk - 512; }
                    const bool full = (64 * j + 63 <= lim_hi[rt]) && (64 * j > lim_lo[rt]);
                    none[rt] = (64 * j > lim_hi[rt]) || (64 * j + 63 <= lim_lo[rt]);
                    part[rt] = !full && !none[rt];
                }
                float lmx[2];
                if (__any(part[0] || part[1])) {
#pragma unroll
                    for (int rt = 0; rt < 2; ++rt) {
                        float mx = NEG_INF;
#pragma unroll
                        for (int t = 0; t < 4; ++t)
#pragma unroll
                            for (int i = 0; i < 4; ++i) {
                                const int key = kb + 16 * t + i;
                                const bool ok = (key <= lim_hi[rt]) && (key > lim_lo[rt]);
                                s[rt][t][i] = ok ? s[rt][t][i] : NEG_INF;
                                mx = fmaxf(mx, s[rt][t][i]);
                            }
                        lmx[rt] = mx;
                        none[rt] = false;
                    }
                } else {
#pragma unroll
                    for (int rt = 0; rt < 2; ++rt) {
                        float mx = NEG_INF;
#pragma unroll
                        for (int t = 0; t < 4; ++t)
#pragma unroll
                            for (int i = 0; i < 4; ++i) mx = fmaxf(mx, s[rt][t][i]);
                        lmx[rt] = none[rt] ? NEG_INF : mx;
                    }
                }
                if (__any((lmx[0] > R[0].m + 6.f) || (lmx[1] > R[1].m + 6.f))) {
#pragma unroll
                    for (int rt = 0; rt < 2; ++rt) {
                        float mx = lmx[rt];
                        mx = fmaxf(mx, __shfl_xor(mx, 16));
                        mx = fmaxf(mx, __shfl_xor(mx, 32));
                        const float mn = fmaxf(R[rt].m, mx);
                        const float alpha = __expf(R[rt].m - mn);
                        R[rt].l *= alpha; R[rt].m = mn;
                        if (MODE != 0) {
#pragma unroll
                            for (int dt = 0; dt < 4; ++dt) R[rt].o[dt] = R[rt].o[dt] * alpha;
                        }
                    }
                }
#pragma unroll
                for (int rt = 0; rt < 2; ++rt) {
                    const float negmL = none[rt] ? -1e30f : -fmaxf(R[rt].m, -1e4f) * 1.44269504f;
                    float p[4][4];
                    float rs = 0.f;
#pragma unroll
                    for (int t = 0; t < 4; ++t)
#pragma unroll
                        for (int i = 0; i < 4; ++i) { p[t][i] = __builtin_amdgcn_exp2f(fmaf(s[rt][t][i], 1.44269504f, negmL)); rs += p[t][i]; }
                    R[rt].l += rs;
                    if (MODE != 0) {
#pragma unroll
                        for (int ks = 0; ks < 2; ++ks) {
                            u32x4 pu; pu.x = cvtpk(p[2 * ks][0], p[2 * ks][1]); pu.y = cvtpk(p[2 * ks][2], p[2 * ks][3]); pu.z = cvtpk(p[2 * ks + 1][0], p[2 * ks + 1][1]); pu.w = cvtpk(p[2 * ks + 1][2], p[2 * ks + 1][3]);
                            pf[rt][ks] = __builtin_bit_cast(bf16x8, pu);
                        }
                    }
                }
            }
            if (MODE != 0) {
#pragma unroll
                for (int ks = 0; ks < 2; ++ks)
#pragma unroll
                    for (int dt = 0; dt < 4; ++dt) {
                        const u32x2 lo = *(const LAS u32x2*)(vt + (ks ? va2 : va0) + dt * 2048);
                        const u32x2 hi = *(const LAS u32x2*)(vt + (ks ? va3 : va1) + dt * 2048);
                        u32x4 vu; vu.x = lo.x; vu.y = lo.y; vu.z = hi.x; vu.w = hi.y;
                        const bf16x8 vf = __builtin_bit_cast(bf16x8, vu);
                        R[0].o[dt] = MFMA16(vf, pf[0][ks], R[0].o[dt]);
                        R[1].o[dt] = MFMA16(vf, pf[1][ks], R[1].o[dt]);
                    }
            }
        }
        NSA_WAIT_TILE();
        __builtin_amdgcn_s_barrier();
    }
    asm volatile("s_waitcnt vmcnt(0)" ::: "memory");
    __builtin_amdgcn_s_barrier();
#undef NSA_ISSUE
#undef NSA_WAIT_TILE
}

__device__ void phase_nsa2(KA ka, int layer, LAS unsigned char* lds) {
    PHASE_IDS
    const int tid = TID, lane = tid & 63, w = __builtin_amdgcn_readfirstlane(tid >> 6), g = lane >> 4, qr = lane & 15;
    const bf16_t* H = PF(H);
    const bf16_t* kcb = (PF(kcb) + layer * ((size_t)4 * 512 * 64));
    const bf16_t* vcT = (PF(vcT) + layer * ((size_t)4 * 64 * 512));
    const bf16_t* vsT = PF(vsT);
    const bf16_t* vwT = PF(vwT);
    bf16_t* Y = PF(Y);
    const float* gate_b = PF(nsa_gate_b) + layer * 24;
    const float* ogain = PF(out_gain) + layer * 1024;
    float* impw = (float*)(lds + NSA_IMP + w * 4096);
    unsigned* selw = (unsigned*)(lds + NSA_SEL + w * 128);
    for (int base = BID; base < 256; base += gridDim.x) {
#pragma unroll 1
        for (int half = 0; half < 2; ++half) {
            const int it = half ? 511 - base : base;
            const int chunk = it >> 2, bh = it & 3, b = bh >> 1, hk = bh & 1;
            const size_t rowbase = (size_t)b * T_;
            const int t0w = chunk * 64 + w * 8;
            NsaRT R[2];
            LAS f32x4* finw = (LAS f32x4*)(lds + NSA_FIN + w * 8192) + lane;
#pragma unroll
            for (int rt = 0; rt < 2; ++rt) {
                const int tk = t0w + 4 * rt + (qr >> 2), hh = hk * 4 + (qr & 3);
                R[rt].tk = tk;
                const bf16_t* qp = H + (rowbase + tk) * HLD + C_NQ + hh * 64 + 8 * g;
#pragma unroll
                for (int ks = 0; ks < 2; ++ks) {
                    const u32x4 u = *(const u32x4*)(qp + 32 * ks);
                    const unsigned uu[4] = {u.x, u.y, u.z, u.w};
                    u32x4 o4;
#pragma unroll
                    for (int e = 0; e < 4; ++e) {
                        const float f0 = __uint_as_float(uu[e] << 16) * 0.125f, f1 = __uint_as_float(uu[e] & 0xffff0000u) * 0.125f;
                        o4[e] = (__float_as_uint(f0) >> 16) | (__float_as_uint(f1) & 0xffff0000u);
                    }
                    R[rt].q[ks] = __builtin_bit_cast(bf16x8, o4);
                }
                R[rt].m = NEG_INF; R[rt].l = 0.f;
#pragma unroll
                for (int dt = 0; dt < 4; ++dt) R[rt].o[dt] = zero4();
            }
            SelMask selm0{0u, 0u, 0u, 0u}, selm1{0u, 0u, 0u, 0u};
            float carry[2] = {0.f, 0.f};
            const int tmax = chunk * 64 + 63;
            const int nvmax = tmax >= 31 ? ((tmax - 31) >> 4) + 1 : 0;
            const int nb = (nvmax + 63) >> 6;
            const char* kc_src = (const char*)(kcb + (size_t)bh * 512 * 64);
            const char* vc_src = (const char*)(vcT + (size_t)bh * 64 * 512);
            nsa_loop<0, 2>(lds, tid, lane, w, 0, nb - 1, kc_src, 128, 64 * 128, nullptr, 0, 0, R, selm0, selm1, carry, impw);
#pragma unroll
            for (int rt = 0; rt < 2; ++rt) { float l = R[rt].l; l += __shfl_xor(l, 16); l += __shfl_xor(l, 32); R[rt].l = l; }
            for (int i = lane; i < 8 * 128; i += 64) impw[i] = 0.f;
            wave_sync();
            nsa_loop<1, 2>(lds, tid, lane, w, 0, nb - 1, kc_src, 128, 64 * 128, vc_src, 512 * 2, 64 * 2, R, selm0, selm1, carry, impw);
#pragma unroll
            for (int rt = 0; rt < 2; ++rt) {
                const int hh = hk * 4 + (qr & 3);
                const float gt = sigmoidf_(bf2f(H[(rowbase + R[rt].tk) * HLD + C_NG + hh * 3 + 0]) + gate_b[hh * 3 + 0]);
#pragma unroll
                for (int dt = 0; dt < 4; ++dt) { finw[(rt * 4 + dt) * 64] = R[rt].o[dt] * gt; R[rt].o[dt] = zero4(); }
            }
            wave_sync();
            {
                const int tl = lane >> 3, sub = lane & 7;
                const int tks = t0w + tl, curb = tks >> 6;
                float v[16];
#pragma unroll
                for (int i = 0; i < 16; ++i) {
                    const int jj = sub * 16 + i;
                    const float a = impw[tl * 128 + jj];
                    const bool forced = (jj == 0) || (jj == curb) || (jj == curb - 1);
                    v[i] = (jj <= curb) ? (a + (forced ? 1e4f : 0.f)) : NEG_INF;
                }
                wave_sync();
#pragma unroll
                for (int i = 0; i < 16; ++i) impw[tl * 128 + sub * 16 + i] = v[i];
                wave_sync();
                int cnt[16];
#pragma unroll
                for (int i = 0; i < 16; ++i) cnt[i] = 0;
                for (int jj = 0; jj < 128; ++jj) {
                    const float x = impw[tl * 128 + jj];
#pragma unroll
                    for (int i = 0; i < 16; ++i) cnt[i] += (x > v[i]) || (x == v[i] && jj < sub * 16 + i);
                }
                unsigned bits = 0u;
#pragma unroll
                for (int i = 0; i < 16; ++i) bits |= ((cnt[i] < 16) && (v[i] > 0.5f * NEG_INF)) ? (1u << i) : 0u;
                const unsigned other = __shfl_xor(bits, 1);
                const unsigned word = (sub & 1) ? ((bits << 16) | other) : (bits | (other << 16));
                if ((sub & 1) == 0) selw[tl * 4 + (sub >> 1)] = word;
                wave_sync();
                { const unsigned* q0 = selw + (qr >> 2) * 4; selm0.a = q0[0]; selm0.b = q0[1]; selm0.c = q0[2]; selm0.d = q0[3];
                  selm1.a = q0[16]; selm1.b = q0[17]; selm1.c = q0[18]; selm1.d = q0[19]; }
                wave_sync();
            }
            __syncthreads();
#pragma unroll
            for (int rt = 0; rt < 2; ++rt) { R[rt].m = NEG_INF; R[rt].l = 0.f; }
            nsa_loop<2, 4>(lds, tid, lane, w, 0, chunk, (const char*)(H + rowbase * HLD + C_KS + hk * 64), (size_t)HLD * 2, (size_t)64 * HLD * 2,
                        (const char*)(vsT + (size_t)bh * 64 * T_), (size_t)T_ * 2, 64 * 2, R, selm0, selm1, carry, impw);
#pragma unroll
            for (int rt = 0; rt < 2; ++rt) {
                const int hh = hk * 4 + (qr & 3);
                const float gt = sigmoidf_(bf2f(H[(rowbase + R[rt].tk) * HLD + C_NG + hh * 3 + 1]) + gate_b[hh * 3 + 1]);
                float ltot = R[rt].l; ltot += __shfl_xor(ltot, 16); ltot += __shfl_xor(ltot, 32);
                const float sc = gt / ltot;
#pragma unroll
                for (int dt = 0; dt < 4; ++dt) { finw[(rt * 4 + dt) * 64] += R[rt].o[dt] * sc; R[rt].o[dt] = zero4(); }
                R[rt].m = NEG_INF; R[rt].l = 0.f;
            }
            nsa_loop<3, 4>(lds, tid, lane, w, chunk >= 8 ? chunk - 8 : 0, chunk, (const char*)(H + rowbase * HLD + C_KW + hk * 64), (size_t)HLD * 2, (size_t)64 * HLD * 2,
                        (const char*)(vwT + (size_t)bh * 64 * T_), (size_t)T_ * 2, 64 * 2, R, selm0, selm1, carry, impw);
#pragma unroll
            for (int rt = 0; rt < 2; ++rt) {
                const int tk = R[rt].tk, hh = hk * 4 + (qr & 3);
                const float gt = sigmoidf_(bf2f(H[(rowbase + tk) * HLD + C_NG + hh * 3 + 2]) + gate_b[hh * 3 + 2]);
                float ltot = R[rt].l; ltot += __shfl_xor(ltot, 16); ltot += __shfl_xor(ltot, 32);
                const float sc = gt / ltot;
                bf16_t* yp = Y + (rowbase + tk) * DM + 256 + hh * 64 + 4 * g;
                f32x4 ov[4];
                float ss = 0.f;
#pragma unroll
                for (int dt = 0; dt < 4; ++dt) { ov[dt] = finw[(rt * 4 + dt) * 64] + R[rt].o[dt] * sc; ss += (ov[dt][0] * ov[dt][0] + ov[dt][1] * ov[dt][1]) + (ov[dt][2] * ov[dt][2] + ov[dt][3] * ov[dt][3]); }
                ss += __shfl_xor(ss, 16);
                ss += __shfl_xor(ss, 32);
                const float rn = rsqrtf(ss * (1.f / 64.f) + 1e-6f);
#pragma unroll
                for (int dt = 0; dt < 4; ++dt) {
                    const f32x4 o = ov[dt] * rn * *(const f32x4*)(ogain + 256 + hh * 64 + 16 * dt + 4 * g);
                    u32x2 wv; wv.x = pk2(o[0], o[1]); wv.y = pk2(o[2], o[3]);
                    *(u32x2*)(yp + 16 * dt) = wv;
                }
            }
        }
    }
}

__device__ void phase_vtrans(KA ka, float* smem) {
    PHASE_IDS
    const int lane = TID & 63, w = TID >> 6;
    bf16_t* scr = (bf16_t*)(smem + w * 4096);
    const bf16_t* H = PF(H);
    for (int it = BID * NW + w; it < 1024; it += gridDim.x * NW) {
        const int tt = it & 127, bh = (it >> 7) & 3, which = it >> 9;
        const int b = bh >> 1, hk = bh & 1;
        const size_t tok0 = (size_t)b * T_ + tt * 64;
        const int col = (which ? C_VW : C_VS) + hk * 64;
        bf16_t* dst = (which ? PF(vwT) : PF(vsT)) + (size_t)bh * 64 * T_ + tt * 64;
        wave_sync();
        for (int i = 0; i < 64; ++i) scr[lane * 66 + i] = H[(tok0 + i) * HLD + col + lane];
        wave_sync();
        for (int d = 0; d < 64; ++d) dst[(size_t)d * T_ + lane] = scr[d * 66 + lane];
    }
}

__device__ void phase_hgrnA(KA ka, int layer, LAS unsigned char* lds, int first, int nblk) {
    PHASE_IDS
    const int tid = TID, lane = tid & 63, w = __builtin_amdgcn_readfirstlane(tid >> 6), gq = lane >> 4, lc = lane & 15;
    float* Q = (float*)lds;
    float* K = Q + 64 * 68;
    float* Bc = K + 64 * 68;
    float* SEG = Bc + 64 * 68;
    LAS bf16_t* ATb = (LAS bf16_t*)(lds + 57344);
    LAS bf16_t* ItB = ATb + 64 * 72;
    LAS bf16_t* KtB = ItB + 64 * 72;
    const bf16_t* H = PF(H);
    const float* hgl = PF(hg_lower);
    float* hgU = PF(hgU); float* hgG = (PF(hgG) + layer * ((size_t)1024 * 64)); bf16_t* hgQB = PF(hgQB); bf16_t* hgO = PF(hgO);
    if (BID < first) return;
    float* LB = (float*)(lds + 98304);
    if (tid < 256) {
        float lb = 0.f;
        if (layer == 1) { const float h0 = hgl[tid], h1 = hgl[256 + tid]; const float mx = fmaxf(h0, h1), e0 = expf(h0 - mx), e1 = expf(h1 - mx); lb = e1 / (e0 + e1); }
        LB[tid] = lb;
    }
    for (int item = BID - first; item < 1024; item += nblk) {
        const int c = item & 127, bh = item >> 7, h = bh & 3, b = bh >> 2;
        const size_t tok0 = (size_t)b * T_ + c * 64;
        __syncthreads();
#pragma unroll
        for (int i = 0; i < 8; ++i) {
            const int e = tid + i * NTHR, t = e >> 6, d = e & 63;
            const float lb = LB[h * 64 + d];
            const bf16_t* hp = H + (tok0 + t) * HLD + h * 64 + d;
            const float fl = bf2f(hp[C_HF]);
            const float ex = __expf(-fl);
            const float sg = 1.f / (1.f + ex);
            const float f = lb + (1.f - lb) * sg;
            Q[t * 68 + d] = bf2f(hp[C_HQ]);
            K[t * 68 + d] = (1.f - lb) * (ex * sg);
            ItB[d * 72 + t] = hp[C_HI];
            Bc[t * 68 + d] = __logf(fmaxf(f, 1e-38f));
        }
        __syncthreads();
        {
            const int d = lane, seg = w;
            float run = 0.f;
#pragma unroll
            for (int i = 0; i < 8; ++i) { run += Bc[(seg * 8 + i) * 68 + d]; Bc[(seg * 8 + i) * 68 + d] = run; }
            SEG[seg * 64 + d] = run;
            __syncthreads();
            float pre = 0.f;
            for (int s2 = 0; s2 < seg; ++s2) pre += SEG[s2 * 64 + d];
#pragma unroll
            for (int i = 0; i < 8; ++i) Bc[(seg * 8 + i) * 68 + d] += pre;
        }
        __syncthreads();
        {
            const int blk = tid >> 1, dh = tid & 1, tb = blk >> 4, sb = blk & 15;
            float acc[4][4];
#pragma unroll
            for (int i = 0; i < 4; ++i)
#pragma unroll
                for (int j = 0; j < 4; ++j) acc[i][j] = 0.f;
            if (sb <= tb) {
#pragma unroll 2
                for (int d0 = 32 * dh; d0 < 32 * dh + 32; d0 += 4) {
                    f32x4 qv[4], bt[4], kv[4], bsv[4];
#pragma unroll
                    for (int i = 0; i < 4; ++i) { qv[i] = *(const f32x4*)&Q[(4 * tb + i) * 68 + d0]; bt[i] = *(const f32x4*)&Bc[(4 * tb + i) * 68 + d0]; }
#pragma unroll
                    for (int j = 0; j < 4; ++j) { kv[j] = *(const f32x4*)&K[(4 * sb + j) * 68 + d0]; bsv[j] = *(const f32x4*)&Bc[(4 * sb + j) * 68 + d0]; }
#pragma unroll
                    for (int i = 0; i < 4; ++i)
#pragma unroll
                        for (int j = 0; j < 4; ++j)
#pragma unroll
                            for (int dd = 0; dd < 4; ++dd) acc[i][j] = fmaf(qv[i][dd] * kv[j][dd], __expf(fminf(bt[i][dd] - bsv[j][dd], 0.f)), acc[i][j]);
                }
            }
#pragma unroll
            for (int i = 0; i < 4; ++i)
#pragma unroll
                for (int j = 0; j < 4; ++j) { acc[i][j] += __shfl_xor(acc[i][j], 1); if (4 * sb + j > 4 * tb + i) acc[i][j] = 0.f; }
            if (dh == 0) {
#pragma unroll
                for (int i = 0; i < 4; ++i) {
                    u32x2 pw; pw.x = pk2(acc[i][0], acc[i][1]); pw.y = pk2(acc[i][2], acc[i][3]);
                    *(LAS u32x2*)(ATb + (4 * tb + i) * 72 + 4 * sb) = pw;
                }
            }
        }
#pragma unroll
        for (int i = 0; i < 8; ++i) {
            const int e = tid + i * NTHR, t = e >> 6, d = e & 63;
            const float bt = Bc[t * 68 + d];
            hgQB[(size_t)item * 4096 + e] = f2bf(Q[t * 68 + d] * __expf(bt));
            KtB[d * 72 + t] = f2bf(K[t * 68 + d] * __expf(Bc[63 * 68 + d] - bt));
        }
        if (tid < 64) hgG[(size_t)item * 64 + tid] = __expf(Bc[63 * 68 + tid]);
        __syncthreads();
#pragma unroll
        for (int q = 0; q < 4; ++q) {
            const int tile = w * 4 + q, isU = tile >> 4, rt_ = (tile >> 2) & 3, ct = tile & 3;
            const LAS bf16_t* Ab = (isU ? KtB : ATb) + (16 * rt_ + lc) * 72 + 8 * gq;
            const LAS bf16_t* Bb = ItB + (16 * ct + lc) * 72 + 8 * gq;
            f32x4 acc = zero4();
            acc = MFMA16(*(const LAS bf16x8*)Ab, *(const LAS bf16x8*)Bb, acc);
            acc = MFMA16(*(const LAS bf16x8*)(Ab + 32), *(const LAS bf16x8*)(Bb + 32), acc);
#pragma unroll
            for (int i = 0; i < 4; ++i) {
                const int r = 16 * rt_ + 4 * gq + i, cc = 16 * ct + lc;
                if (isU) hgU[((size_t)item * 64 + r) * 64 + cc] = acc[i];
                else hgO[((size_t)item * 64 + r) * 64 + cc] = f2bf(acc[i]);
            }
        }
    }
}

__device__ void phase_hgrnB(KA ka, int layer) {
    PHASE_IDS
    const float* hgU = PF(hgU); const float* hgG = (PF(hgG) + layer * ((size_t)1024 * 64)); float* hgS = PF(hgS);
    for (int gid = BID * NTHR + TID; gid < 32768; gid += gridDim.x * NTHR) {
        const int bh = gid >> 12, dv = gid & 4095, d = dv >> 6;
        float S = 0.f;
        for (int c0 = 0; c0 < 128; c0 += 8) {
            float u[8], gg[8];
#pragma unroll
            for (int k = 0; k < 8; ++k) { const size_t item = (size_t)bh * 128 + c0 + k; u[k] = hgU[item * 4096 + dv]; gg[k] = hgG[item * 64 + d]; }
#pragma unroll
            for (int k = 0; k < 8; ++k) { const size_t item = (size_t)bh * 128 + c0 + k; hgS[item * 4096 + dv] = S; S = fmaf(gg[k], S, u[k]); }
        }
    }
}

__device__ void phase_hgrnC(KA ka, int layer, LAS unsigned char* lds) {
    PHASE_IDS
    const int tid = TID, lane = tid & 63, w = __builtin_amdgcn_readfirstlane(tid >> 6), gq = lane >> 4, lc = lane & 15;
    LAS bf16_t* QBb = (LAS bf16_t*)lds;
    LAS bf16_t* StB = QBb + 64 * 72;
    float* OT = (float*)(lds + 32768);
    const bf16_t* H = PF(H);
    const float* hgS = PF(hgS); const bf16_t* hgQB = PF(hgQB); const bf16_t* hgO = PF(hgO);
    const float* og = PF(out_gain) + layer * 1024;
    bf16_t* Y = PF(Y);
    for (int item = BID; item < 1024; item += gridDim.x) {
        const int c = item & 127, bh = item >> 7, h = bh & 3, b = bh >> 2;
        const size_t tok0 = (size_t)b * T_ + c * 64;
        __syncthreads();
#pragma unroll
        for (int i = 0; i < 8; ++i) {
            const int e = tid + i * NTHR, r = e >> 6, cc = e & 63;
            QBb[r * 72 + cc] = hgQB[(size_t)item * 4096 + e];
            StB[cc * 72 + r] = f2bf(hgS[(size_t)item * 4096 + e]);
        }
        __syncthreads();
#pragma unroll
        for (int q = 0; q < 2; ++q) {
            const int tile = w * 2 + q, rt_ = tile >> 2, ct = tile & 3;
            const LAS bf16_t* Ab = QBb + (16 * rt_ + lc) * 72 + 8 * gq;
            const LAS bf16_t* Bb = StB + (16 * ct + lc) * 72 + 8 * gq;
            f32x4 acc = zero4();
            acc = MFMA16(*(const LAS bf16x8*)Ab, *(const LAS bf16x8*)Bb, acc);
            acc = MFMA16(*(const LAS bf16x8*)(Ab + 32), *(const LAS bf16x8*)(Bb + 32), acc);
#pragma unroll
            for (int i = 0; i < 4; ++i) {
                const int t = 16 * rt_ + 4 * gq + i, v = 16 * ct + lc;
                OT[t * 65 + v] = acc[i] + bf2f(hgO[((size_t)item * 64 + t) * 64 + v]);
            }
        }
        __syncthreads();
#pragma unroll 1
        for (int i = 0; i < 8; ++i) {
            const int t = w + 8 * i, v = lane;
            const float acc = OT[t * 65 + v];
            const float ms = wave_sum(acc * acc) * (1.f / 64.f);
            const float hg = bf2f(H[(tok0 + t) * HLD + C_HG + h * 64 + v]);
            const float y = acc * rsqrtf(ms + 1e-6f) * og[768 + h * 64 + v] * (hg * sigmoidf_(hg));
            Y[(tok0 + t) * DM + 768 + h * 64 + v] = f2bf(y);
        }
    }
}

struct CmpOrder {
    static constexpr bool GATHER = false;
    const char* W1T; int c;
    __device__ __forceinline__ bool next(int i, pg8::Unit& u) const {
        if (i > 0 || c >= 16) return false;
        const int which = c >> 3, bh = (c >> 1) & 3, nt = c & 1;
        u.arow0 = (bh >> 1) * 512 + nt * 256; u.nrows = 256; u.pm = nt; u.pn = 0; u.e = which * 4 + bh; u.ui = 0;
        u.bptr = W1T + (size_t)which * 256 * 2048 * 2;
        return true;
    }
    __device__ __forceinline__ int arow(const pg8::Unit& u, int r) const { return u.arow0 + r; }
    __device__ __forceinline__ int lda(int) const { return 16 * HLD; }
    __device__ __forceinline__ unsigned kstepA() const { return (unsigned)(HLD * 2); }
    __device__ __forceinline__ const char* abase(const pg8::Unit& u, const char* A) const { return A + (((u.e >> 2) ? C_VC : C_KC) + (u.e & 1) * 64) * 2; }
};
struct EpiCmp {
    static constexpr bool PERM = true;
    bf16_t* G; const float* cbias;
    __device__ __forceinline__ void operator()(const f32x4 (&acc)[2][2][4][2], const pg8::Unit& u, int wr, int wc, int fr, int fq) const {
        const float* bp = cbias + (u.e >> 2) * 128 + wc * 32 + 8 * fq;
        const f32x4 b0 = *(const f32x4*)bp, b1 = *(const f32x4*)(bp + 4);
#pragma unroll
        for (int ai = 0; ai < 2; ++ai)
#pragma unroll
            for (int m = 0; m < 4; ++m) {
                const int r = ai * 128 + wr * 64 + m * 16 + fr;
                bf16_t* rowp = G + ((size_t)(u.e * 512 + u.pm * 256 + r)) * 128 + wc * 32 + 8 * fq;
                const f32x4 v0 = acc[ai][0][m][0] + b0, v1 = acc[ai][0][m][1] + b1;
                u32x4 w; w.x = pk2(gelu_slow(v0[0]), gelu_slow(v0[1])); w.y = pk2(gelu_slow(v0[2]), gelu_slow(v0[3])); w.z = pk2(gelu_slow(v1[0]), gelu_slow(v1[1])); w.w = pk2(gelu_slow(v1[2]), gelu_slow(v1[3]));
                *(u32x4*)rowp = w;
            }
    }
};
__device__ void phase_compress2(KA ka, int layer, LAS unsigned char* lds) {
    const int bid = opaque_bid();
    if (bid >= 16) return;
    CmpOrder S{(const char*)(PF(WT) + WT_C1), bid};
    EpiCmp E{(PF(gb) + layer * ((size_t)8 * 512 * 128)), (PF(cbias) + layer * (256))};
    pg8::gemm_phase<EpiCmp, CmpOrder>(lds, (const char*)PF(H), 2048, S, E);
    __syncthreads();
    const int tid = opaque_tid();
    const int which = bid >> 3, bh = (bid >> 1) & 3, nt = bid & 1;
    float* w2s = (float*)lds;
    const float* w2 = PF(cmp_w2) + ((size_t)layer * 2 + which) * 128 * 64;
    for (int i = tid; i < 128 * 64; i += NTHR) w2s[i] = w2[i];
    __syncthreads();
    const int r = tid >> 1, half = tid & 1;
    const bf16_t* grow = (PF(gb) + layer * ((size_t)8 * 512 * 128)) + ((size_t)((which * 4 + bh) * 512 + nt * 256 + r)) * 128;
    float acc[32];
#pragma unroll
    for (int j = 0; j < 32; ++j) acc[j] = 0.f;
    for (int c8 = 0; c8 < 16; ++c8) {
        const u32x4 gu = *(const u32x4*)(grow + c8 * 8);
        const unsigned gw[4] = {gu.x, gu.y, gu.z, gu.w};
#pragma unroll
        for (int e = 0; e < 8; ++e) {
            const float gv = (e & 1) ? __uint_as_float(gw[e >> 1] & 0xffff0000u) : __uint_as_float(gw[e >> 1] << 16);
            const float* wrow = w2s + (c8 * 8 + e) * 64 + half * 32;
#pragma unroll
            for (int j4 = 0; j4 < 8; ++j4) {
                const float4 w4 = *(const float4*)(wrow + j4 * 4);
                acc[j4 * 4 + 0] = fmaf(gv, w4.x, acc[j4 * 4 + 0]); acc[j4 * 4 + 1] = fmaf(gv, w4.y, acc[j4 * 4 + 1]);
                acc[j4 * 4 + 2] = fmaf(gv, w4.z, acc[j4 * 4 + 2]); acc[j4 * 4 + 3] = fmaf(gv, w4.w, acc[j4 * 4 + 3]);
            }
        }
    }
    const int n = nt * 256 + r;
    if (which == 0) {
        bf16_t* o = (PF(kcb) + layer * ((size_t)4 * 512 * 64)) + ((size_t)bh * 512 + n) * 64 + half * 32;
#pragma unroll
        for (int j = 0; j < 32; j += 2) *(unsigned*)(o + j) = pk2(acc[j], acc[j + 1]);
    } else {
        bf16_t* o = (PF(vcT) + layer * ((size_t)4 * 64 * 512)) + (size_t)bh * 64 * 512 + n;
#pragma unroll
        for (int j = 0; j < 32; ++j) o[(size_t)(half * 32 + j) * 512] = f2bf(acc[j]);
    }
    __syncthreads();
}

__device__ void phase_gmlp2(KA ka, int layer, LAS unsigned char* lds, int first, int nblk) {
    PHASE_IDS
    const int tid = TID, lane = tid & 63, w = __builtin_amdgcn_readfirstlane(tid >> 6), gq = lane >> 4, lc = lane & 15;
    LAS bf16_t* Vt = (LAS bf16_t*)lds;
    const float* gain = PF(gm_v_gain) + layer * 256;
    const float* bias = PF(gm_v_bias) + layer * 256;
    const float* bs = PF(gm_b_s) + layer * 4 * 128;
    const bf16_t* gmW = PF(WT) + WT_GM;
    const bf16_t* H = PF(H);
    bf16_t* Y = PF(Y);
    if (BID < first) return;
    for (int item = BID - first; item < 512; item += nblk) {
        const int g = item & 3, c = (item >> 2) & 63, b = item >> 8;
        const size_t tok0 = (size_t)b * T_ + (size_t)c * 128;
        __syncthreads();
#pragma unroll 4
        for (int i = 0; i < 16; ++i) {
            const int s = w * 16 + i;
            const float x = bf2f(H[(tok0 + s) * HLD + C_GV + g * 64 + lane]);
            const float ge = gelu_t(x);
            const float mu = wave_sum(ge) * (1.f / 64.f);
            const float dl = ge - mu;
            const float var = wave_sum(dl * dl) * (1.f / 64.f);
            Vt[lane * 136 + s] = f2bf(dl * rsqrtf(var + 1e-5f) * gain[g * 64 + lane] + bias[g * 64 + lane]);
        }
        __syncthreads();
        f32x4 acc[4];
#pragma unroll
        for (int ct = 0; ct < 4; ++ct) acc[ct] = zero4();
        const bf16_t* wrow = gmW + ((size_t)g * 128 + 16 * w + lc) * 128 + 8 * gq;
        const int kmax = (16 * w + 15) >> 5;
        for (int ks = 0; ks <= kmax; ++ks) {
            const bf16x8 a = *(const bf16x8*)(wrow + 32 * ks);
#pragma unroll
            for (int ct = 0; ct < 4; ++ct) {
                const bf16x8 bfr = *(const LAS bf16x8*)(Vt + (16 * ct + lc) * 136 + 32 * ks + 8 * gq);
                acc[ct] = MFMA16(a, bfr, acc[ct]);
            }
        }
        const float* ogain = PF(out_gain) + layer * 1024;
#pragma unroll
        for (int i = 0; i < 4; ++i) {
            const int t = 16 * w + 4 * gq + i;
            float yv[4];
            float ss = 0.f;
#pragma unroll
            for (int ct = 0; ct < 4; ++ct) {
                const int d = 16 * ct + lc;
                const float z = acc[ct][i] + bs[g * 128 + t];
                const float u = gelu_t(bf2f(H[(tok0 + t) * HLD + C_GU + g * 64 + d]));
                yv[ct] = u * z;
                ss += yv[ct] * yv[ct];
            }
            ss += __shfl_xor(ss, 1); ss += __shfl_xor(ss, 2); ss += __shfl_xor(ss, 4); ss += __shfl_xor(ss, 8);
            const float rn = rsqrtf(ss * (1.f / 64.f) + 1e-6f);
#pragma unroll
            for (int ct = 0; ct < 4; ++ct) {
                const int d = 16 * ct + lc;
                Y[(tok0 + t) * DM + g * 64 + d] = f2bf(yv[ct] * rn * ogain[g * 64 + d]);
            }
        }
    }
}

#ifndef ONLY_Q
#define ONLY_Q -2
#endif
#ifndef QMASK
#define QMASK 0x3ff
#endif
#define QON(k) ((ONLY_Q == -2 && ((QMASK >> ((k) + 1)) & 1)) || ONLY_Q == (k))
#ifndef DUPMASK
#define DUPMASK 0
#endif
#define DUP(k) ((DUPMASK >> (k)) & 1)
#ifndef PROF_LO
#define PROF_LO -1
#endif
#ifndef PROF_HI
#define PROF_HI -1
#endif
#ifndef NPH_TOTAL
#define NPH_TOTAL 19
#endif
__global__ void __launch_bounds__(NTHR, 2) k_mega(P p0) {
    extern __shared__ __attribute__((aligned(16))) unsigned char lds_raw[];
    LAS unsigned char* lds = (LAS unsigned char*)lds_raw;
    float* smem = (float*)lds_raw;
    volatile LAS unsigned* misc = (volatile LAS unsigned*)(lds + LDS_MISC);
    if (threadIdx.x < 16) misc[threadIdx.x] = 0u;
    __syncthreads();
    XcdBarrier bar = xcd_barrier_post(p0.ctl + CW_BAR, misc);
    if (PROF_LO >= 0 && blockIdx.x == 0 && threadIdx.x == 0) ((unsigned long long*)(p0.ctl + 8192))[0] = __builtin_amdgcn_s_memrealtime();
#pragma unroll 1
    for (int ph = 0; ph < p0.nph; ph++) {
        const int layer = ph == 0 ? 0 : (ph - 1) / 9, q = ph == 0 ? -1 : (ph - 1) % 9;
        const int dupm = p0.pad;
#if defined(__HIP_DEVICE_COMPILE__)
        KA ka = (KA)__builtin_amdgcn_kernarg_segment_ptr();
        asm volatile("" : "+s"(ka));
#else
        KA ka = nullptr;
#endif
        const float* xin = layer == 0 ? PF(x) : PF(out);
        float* x1 = PF(out);
        if (q == -1 && QON(-1)) { for (int r = 0; r <= ((dupm >> 15) & 1); ++r) { phase_prologue(ka, 0, smem); __syncthreads(); } }
        else if (q == 0 && QON(0)) { for (int r = 0; r <= (dupm & 1); ++r) { phase_inproj(ka, layer, lds); __syncthreads(); } }
        else if (q == 1 && QON(1)) {
            const int nb1 = (int)gridDim.x > 32 ? 16 : 0, nwork = (int)gridDim.x - nb1;
            for (int r = 0; r <= ((dupm >> 12) & 1); ++r) { phase_compress2(ka, layer, lds); __syncthreads(); }
            for (int r = 0; r <= ((dupm >> 10) & 1); ++r) { phase_hgrnA(ka, layer, lds, nb1, nwork); __syncthreads(); }
            for (int r = 0; r <= ((dupm >> 11) & 1); ++r) { phase_gmlp2(ka, layer, lds, nb1, nwork); __syncthreads(); }
            for (int r = 0; r <= ((dupm >> 13) & 1); ++r) { phase_vtrans(ka, smem); __syncthreads(); }
        }
        else if (q == 2 && QON(2)) { for (int r = 0; r <= ((dupm >> 14) & 1); ++r) { phase_hgrnB(ka, layer); __syncthreads(); } for (int r = 0; r <= ((dupm >> 2) & 1); ++r) { phase_nsa2(ka, layer, lds); __syncthreads(); } }
        else if (q == 3 && QON(3)) { for (int r = 0; r <= ((dupm >> 3) & 1); ++r) { phase_hgrnC(ka, layer, lds); __syncthreads(); } }
        else if (q == 4 && QON(4)) phase_outproj(ka, layer, xin, x1, lds);
        else if (q == 5 && QON(5)) { for (int r = ((dupm >> 5) & 1); r >= 0; --r) { phase_ln1_route(ka, layer, x1, smem, r == 1); __syncthreads(); } }
        else if (q == 6 && QON(6)) { for (int r = 0; r <= ((dupm >> 6) & 1); ++r) { phase_moe_up(ka, layer, lds); __syncthreads(); } }
        else if (q == 7 && QON(7)) { for (int r = 0; r <= ((dupm >> 7) & 1); ++r) { phase_moe_down(ka, layer, lds); __syncthreads(); } }
        else if (q == 8 && QON(8)) { phase_ln2(ka, layer, x1, PF(out)); if (layer == 0) { __syncthreads(); phase_prologue(ka, 1, smem); } }
        if (ph != NPH_TOTAL - 1 || PROF_LO >= 0) xcd_barrier(bar);
        if (PROF_LO >= 0 && blockIdx.x == 0 && threadIdx.x == 0) ((unsigned long long*)(p0.ctl + 8192))[ph + 1] = __builtin_amdgcn_s_memrealtime();
    }
    if (PROF_LO >= 0) {
        xcd_barrier(bar);
        const unsigned long long* ts = (const unsigned long long*)(p0.ctl + 8192);
        const unsigned long long t0 = __hip_atomic_load(&ts[PROF_LO], __ATOMIC_RELAXED, __HIP_MEMORY_SCOPE_AGENT), t1 = __hip_atomic_load(&ts[PROF_HI + 1], __ATOMIC_RELAXED, __HIP_MEMORY_SCOPE_AGENT);
        const float fac = 1.f + 1e-5f * (float)(t1 - t0);
        for (size_t i = (size_t)blockIdx.x * NTHR + threadIdx.x; i < (size_t)NTOK * DM; i += (size_t)gridDim.x * NTHR) p0.out[i] *= fac;
    }
}

static inline size_t align_up(size_t v, size_t a) { return (v + a - 1) / a * a; }

extern "C" void kernel_launch(void* const* d_in, const int* in_sizes, int n_in, void* d_out, int out_size, void* d_ws,
                              size_t ws_size, hipStream_t stream) {
    P p{};
    p.x = (const float*)d_in[0]; p.w_in = (const float*)d_in[1]; p.gm_v_gain = (const float*)d_in[2];
    p.gm_v_bias = (const float*)d_in[3]; p.gm_w_s = (const float*)d_in[4]; p.gm_b_s = (const float*)d_in[5];
    p.cmp_pos = (const float*)d_in[6]; p.cmp_w1 = (const float*)d_in[7]; p.cmp_w2 = (const float*)d_in[8];
    p.nsa_gate_b = (const float*)d_in[9]; p.hg_lower = (const float*)d_in[10]; p.out_gain = (const float*)d_in[11];
    p.w_out = (const float*)d_in[12]; p.ln1_g = (const float*)d_in[13]; p.ln1_b = (const float*)d_in[14];
    p.rg_w = (const float*)d_in[15]; p.rg_b = (const float*)d_in[16]; p.re_w = (const float*)d_in[17];
    p.re_b = (const float*)d_in[18]; p.w_gate = (const float*)d_in[19]; p.w_up = (const float*)d_in[20];
    p.w_down = (const float*)d_in[21]; p.ln2_g = (const float*)d_in[22]; p.ln2_b = (const float*)d_in[23];
    p.out = (float*)d_out;
    char* ws = (char*)d_ws;
    size_t off = 0;
    p.ctl = (unsigned*)(ws + off); off = align_up(off + CTL_BYTES, 256);
    p.WT = (bf16_t*)(ws + off); off = align_up(off + WT_LAYER * 2, 256);
    p.H = (bf16_t*)(ws + off); off = align_up(off + (size_t)(NTOK + 64) * HLD * 2, 256);
    p.Y = (bf16_t*)(ws + off); off = align_up(off + (size_t)NTOK * DM * 2, 256);
    p.XB = (bf16_t*)(ws + off); off = align_up(off + (size_t)NTOK * DM * 2, 256);
    p.kcb = (bf16_t*)(ws + off); off = align_up(off + 2 * ((size_t)4 * 512 * 64 * 2), 256);
    p.vcT = (bf16_t*)(ws + off); off = align_up(off + 2 * ((size_t)4 * 64 * 512 * 2), 256);
    p.vsT = (bf16_t*)(ws + off); off = align_up(off + (size_t)4 * 64 * T_ * 2, 256);
    p.vwT = (bf16_t*)(ws + off); off = align_up(off + (size_t)4 * 64 * T_ * 2, 256);
    p.gb = (bf16_t*)(ws + off); off = align_up(off + 2 * ((size_t)8 * 512 * 128 * 2), 256);
    p.cbias = (float*)(ws + off); off = align_up(off + 2 * (256 * 4), 256);
    p.wrt = (float*)(ws + off); off = align_up(off + 2 * (20 * 1024 * 4), 256);
    p.list_tok = (int*)(ws + off); off = align_up(off + 2 * ((size_t)16 * NTOK * 4), 256);
    p.list_w = (float*)(ws + off); off = align_up(off + 2 * ((size_t)16 * NTOK * 4), 256);
    p.tok_slot = (int*)(ws + off); off = align_up(off + 2 * ((size_t)NTOK * 2 * 4), 256);
    p.hgU = (float*)(ws + off); off = align_up(off + (size_t)1024 * 4096 * 4, 256);
    p.hgS = (float*)(ws + off); off = align_up(off + (size_t)1024 * 4096 * 4, 256);
    p.hgG = (float*)(ws + off); off = align_up(off + 2 * ((size_t)1024 * 64 * 4), 256);
    p.hgQB = (bf16_t*)(ws + off); off = align_up(off + (size_t)1024 * 4096 * 2, 256);
    p.hgO = (bf16_t*)(ws + off); off = align_up(off + (size_t)1024 * 4096 * 2, 256);
    p.nph = NPH_TOTAL; p.pad = DUPMASK;
    (void)in_sizes; (void)n_in; (void)out_size;
    static int grid_blocks = 0;
    if (!grid_blocks) {
        int dev = 0, cus = 0, per_cu = 0;
        (void)hipGetDevice(&dev);
        (void)hipDeviceGetAttribute(&cus, hipDeviceAttributeMultiprocessorCount, dev);
        if (hipFuncSetAttribute((const void*)k_mega, hipFuncAttributeMaxDynamicSharedMemorySize, LDS_BYTES) != hipSuccess) { fprintf(stderr, "hipFuncSetAttribute failed\n"); grid_blocks = -1; return; }
        if (hipOccupancyMaxActiveBlocksPerMultiprocessor(&per_cu, (const void*)k_mega, NTHR, LDS_BYTES) != hipSuccess || per_cu < 1) { fprintf(stderr, "occupancy query says %d\n", per_cu); }
        (void)hipGetLastError();
        grid_blocks = cus;
        if (off > ws_size) { fprintf(stderr, "workspace too small: need %zu have %zu\n", off, ws_size); grid_blocks = -1; }
    }
    if (grid_blocks < 0) return;
    (void)hipMemsetAsync(p.ctl, 0, CTL_BYTES, stream);
    void* args[] = {&p};
    hipError_t e = hipLaunchCooperativeKernel((const void*)k_mega, dim3(grid_blocks), dim3(NTHR), args, LDS_BYTES, stream);
    if (e != hipSuccess) fprintf(stderr, "cooperative launch failed: %s (grid %d)\n", hipGetErrorString(e), grid_blocks);
}
```

```cpp
#include <hip/hip_runtime.h>
#include <cstdio>
#include <cstdint>

#define LAS __attribute__((address_space(3)))
typedef unsigned short bf16_t;
typedef short bf16x8 __attribute__((ext_vector_type(8)));
typedef float f32x4 __attribute__((ext_vector_type(4)));
typedef float f32x2 __attribute__((ext_vector_type(2)));
typedef unsigned u32x4 __attribute__((ext_vector_type(4)));
typedef unsigned u32x2 __attribute__((ext_vector_type(2)));

constexpr int NW = 8;
constexpr int NTHR = NW * 64;
constexpr int T_ = 8192;
constexpr int NTOK = 16384;
constexpr int DM = 1024;
constexpr int IC_SRC = 2840;
constexpr int HLD = 3072;
constexpr int C_GU = 0, C_GV = 256, C_NQ = 512, C_KC = 1024, C_VC = 1152, C_KS = 1280, C_VS = 1408,
              C_KW = 1536, C_VW = 1664, C_HQ = 1792, C_HF = 2048, C_HI = 2304, C_HG = 2560, C_NG = 2816;
constexpr int NCMP = 511;
constexpr float ALPHA = 1.4142135623730951f;
constexpr float NEG_INF = -1e30f;

constexpr size_t WT_IN = 0;
constexpr size_t WT_OUT = WT_IN + (size_t)3072 * 1024;
constexpr size_t WT_UP = WT_OUT + (size_t)1024 * 1024;
constexpr size_t WT_DN = WT_UP + (size_t)16 * 1024 * 1024;
constexpr size_t WT_C1 = WT_DN + (size_t)16 * 1024 * 512;
constexpr size_t WT_GM = WT_C1 + (size_t)2 * 256 * 2048;
constexpr size_t WT_LAYER = WT_GM + (size_t)4 * 128 * 128;

constexpr int LDS_STAGE = 131072;
constexpr int LDS_MISC = LDS_STAGE;
constexpr int LDS_BYTES = 147456;

constexpr int CW_BAR = 0;
constexpr int CW_CNT = 4096;
constexpr size_t CTL_BYTES = 65536;

struct P {
    const float* x; const float* w_in; const float* gm_v_gain; const float* gm_v_bias; const float* gm_w_s;
    const float* gm_b_s; const float* cmp_pos; const float* cmp_w1; const float* cmp_w2; const float* nsa_gate_b;
    const float* hg_lower; const float* out_gain; const float* w_out; const float* ln1_g; const float* ln1_b;
    const float* rg_w; const float* rg_b; const float* re_w; const float* re_b; const float* w_gate;
    const float* w_up; const float* w_down; const float* ln2_g; const float* ln2_b;
    float* out;
    unsigned* ctl;
    bf16_t* WT;
    bf16_t* H;
    bf16_t* Y;
    bf16_t* XB;
    bf16_t* kcb;
    bf16_t* vcT;
    bf16_t* vsT;
    bf16_t* vwT;
    bf16_t* gb;
    float* cbias;
    float* wrt;
    int* list_tok;
    float* list_w;
    int* tok_slot;
    float* hgU; float* hgG; float* hgS; bf16_t* hgQB; bf16_t* hgO;
    int nph; int pad;
};


typedef const __attribute__((address_space(4))) char* KA;
template <class T> __device__ __forceinline__ T ldarg(KA ka, size_t off) { return *(const __attribute__((address_space(4))) T*)(ka + off); }
#define PF(f) ldarg<decltype(P::f)>(ka, offsetof(P, f))

__device__ __forceinline__ float bf2f(bf16_t u) { return __uint_as_float(((unsigned)u) << 16); }
typedef __bf16 bf16x2_t __attribute__((ext_vector_type(2)));
__device__ __forceinline__ unsigned pk2(float lo, float hi) { f32x2 v; v.x = lo; v.y = hi; return __builtin_bit_cast(unsigned, __builtin_convertvector(v, bf16x2_t)); }
__device__ __forceinline__ bf16_t f2bf(float f) { return (bf16_t)(pk2(f, 0.f) & 0xffffu); }
__device__ __forceinline__ float gelu_t(float x) {
    const float u2 = -2.f * 0.7978845608028654f * (x + 0.044715f * x * x * x);
    return x / (1.f + __expf(u2));
}
__device__ __forceinline__ float gelu_slow(float x) {
    float u = 0.7978845608028654f * (x + 0.044715f * x * x * x);
    return 0.5f * x * (1.f + tanhf(u));
}
__device__ __forceinline__ float sigmoidf_(float x) { return 1.f / (1.f + __expf(-x)); }
__device__ __forceinline__ float wave_max(float v) {
#pragma unroll
    for (int o = 32; o > 0; o >>= 1) v = fmaxf(v, __shfl_xor(v, o));
    return v;
}
__device__ __forceinline__ float wave_sum(float v) {
#pragma unroll
    for (int o = 32; o > 0; o >>= 1) v += __shfl_xor(v, o);
    return v;
}
__device__ __forceinline__ void wave_sync() {
    __builtin_amdgcn_fence(__ATOMIC_RELEASE, "wavefront");
    __builtin_amdgcn_wave_barrier();
    __builtin_amdgcn_fence(__ATOMIC_ACQUIRE, "wavefront");
}
__device__ __forceinline__ f32x4 zero4() { f32x4 z = {0.f, 0.f, 0.f, 0.f}; asm volatile("" : "+v"(z)); return z; }
constexpr int LDS_WTAB = LDS_MISC + 12288;
__device__ __forceinline__ int hw_slot() { return (int)(__builtin_amdgcn_s_getreg((5 << 11) | 4) & 63u); }
__device__ __forceinline__ int opaque_tid() {
    extern __shared__ __attribute__((aligned(16))) unsigned char lds_raw_[];
    const int wv = __builtin_amdgcn_readfirstlane(*(volatile LAS int*)((LAS unsigned char*)lds_raw_ + LDS_WTAB + 4 * hw_slot()));
    int t = wv * 64 + (int)__builtin_amdgcn_mbcnt_hi(~0u, __builtin_amdgcn_mbcnt_lo(~0u, 0u));
    asm volatile("" : "+v"(t));
    return t;
}
__device__ __forceinline__ int opaque_bid() { int b = blockIdx.x; asm volatile("" : "+s"(b)); return b; }
#define PHASE_IDS const int TID = opaque_tid(); const int BID = opaque_bid(); (void)TID; (void)BID;

#define XB_TMO      128
#define XB_XCNT(j)  (256  + 64 * (j))
#define XB_XSUB(j)  (1280 + 64 * (j))
#define XB_XGEN(j)  (2304 + 64 * (j))
#define XB_TOP      3328
#define XB_TOPGEN   3392
#define XCD_BAR_WORDS 3456
#define XB_SPIN_CAP (1u << 22)
__device__ __forceinline__ unsigned xb_ld(unsigned* p)              { return __hip_atomic_load(p, __ATOMIC_RELAXED, __HIP_MEMORY_SCOPE_AGENT); }
__device__ __forceinline__ unsigned xb_add(unsigned* p, unsigned v) { return __hip_atomic_fetch_add(p, v, __ATOMIC_RELAXED, __HIP_MEMORY_SCOPE_AGENT); }
__device__ __forceinline__ unsigned xb_xcc_id() { return (unsigned)__builtin_amdgcn_s_getreg((3 << 11) | 20) & 0xFu; }
#define XB_SPIN(cond, bar) do { unsigned _sp = 0; while (cond) { __builtin_amdgcn_s_sleep(1); \
    if ((++_sp & 255u) == 0u) { if (xb_ld(&(bar)[XB_TMO])) break; if (_sp > XB_SPIN_CAP) { atomicAdd(&(bar)[XB_TMO], 1u); break; } } } } while (0)
struct XcdBarrier { unsigned* bar; unsigned x; volatile LAS unsigned* st; };
__device__ __forceinline__ XcdBarrier xcd_barrier_post(unsigned* bar, volatile LAS unsigned* st) {
    XcdBarrier b; b.bar = bar; b.x = xb_xcc_id(); b.st = st;
    if (threadIdx.x == 0) (void)xb_add(&bar[XB_XCNT(b.x)], 1u);
    return b;
}
__device__ __forceinline__ void xcd_barrier_complete(unsigned* bar, unsigned x, unsigned& nloc, unsigned& nx) {
    const unsigned G = gridDim.x * gridDim.y * gridDim.z;
    unsigned sum, cnt, mine, sp = 0u;
    for (;;) {
        sum = 0u; cnt = 0u; mine = 0u;
#pragma unroll
        for (unsigned j = 0; j < 16; ++j) { const unsigned c = xb_ld(&bar[XB_XCNT(j)]); sum += c; cnt += (c > 0u) ? 1u : 0u; mine = (j == x) ? c : mine; }
        if (sum == G) break;
        __builtin_amdgcn_s_sleep(1);
        if ((++sp & 255u) == 0u) { if (xb_ld(&bar[XB_TMO])) break; if (sp > XB_SPIN_CAP) { atomicAdd(&bar[XB_TMO], 1u); break; } }
    }
    nloc = mine > 0u ? mine : 1u; nx = cnt > 0u ? cnt : 1u;
}
__device__ __forceinline__ void xcd_barrier(const XcdBarrier& b) {
    asm volatile("s_waitcnt vmcnt(0)" ::: "memory");
    __syncthreads();
    if (opaque_tid() == 0) {
        unsigned* bar = b.bar;
        __builtin_amdgcn_s_waitcnt(0);
        unsigned nloc = b.st[0], nx = b.st[1];
        if (nloc == 0u) { xcd_barrier_complete(bar, b.x, nloc, nx); b.st[0] = nloc; b.st[1] = nx; }
        const unsigned old = xb_add(&bar[XB_XSUB(b.x)], 1u);
        const unsigned gen = old / nloc;
        if (old + 1u == (gen + 1u) * nloc) {
            __builtin_amdgcn_fence(__ATOMIC_RELEASE, "agent");
            asm volatile("s_waitcnt vmcnt(0)" ::: "memory");
            const unsigned og = xb_add(&bar[XB_TOP], 1u);
            const unsigned tg = og / nx;
            if (og + 1u == (tg + 1u) * nx) xb_add(&bar[XB_TOPGEN], 1u);
            else XB_SPIN(xb_ld(&bar[XB_TOPGEN]) == tg, bar);
            __builtin_amdgcn_fence(__ATOMIC_ACQUIRE, "agent");
            xb_add(&bar[XB_XGEN(b.x)], 1u);
            asm volatile("s_waitcnt vmcnt(0)" ::: "memory");
        } else {
            XB_SPIN(xb_ld(&bar[XB_XGEN(b.x)]) == gen, bar);
            __builtin_amdgcn_fence(__ATOMIC_ACQUIRE, "agent");
            asm volatile("s_waitcnt vmcnt(0)" ::: "memory");
        }
    }
    __syncthreads();
}

namespace pg8 {
constexpr int BM = 256, BK = 64, HALF = 128, HTB = HALF * BK * 2, STAGE_BYTES = 8 * HTB;
__host__ __device__ __forceinline__ int lds_byte(int r, int c) { const int st = (r >> 4) * 2 + (c >> 5), rr = r & 15, cc = c & 31, ob = rr * 64 + cc * 2; return st * 1024 + (ob ^ (((ob >> 9) & 1) << 5)); }
__host__ __device__ __forceinline__ void stage_rc(int b, int& R, int& C) { const int st = b / 1024, sb = b % 1024, swz = sb ^ (((sb >> 9) & 1) << 5); R = (st >> 1) * 16 + swz / 64; C = (st & 1) * 32 + (swz % 64) / 2; }
__host__ __device__ __forceinline__ int perm32(int rho) { const int n = rho >> 4, i = rho & 15; return 8 * (i >> 2) + 4 * n + (i & 3); }
__device__ __forceinline__ unsigned cvt_pk_bf16(float lo, float hi) { return pk2(lo, hi); }

struct Unit {
    const char* bptr;
    int arow0;
    int nrows;
    int pm, pn, e, ui;
};

template <class Epi, class Sched>
__device__ __forceinline__ void gemm_phase(LAS unsigned char* lds, const char* Abase, const int K, const Sched& S, const Epi& E) {
    const int tid = opaque_tid(), wid = __builtin_amdgcn_readfirstlane(tid >> 6), lane = tid & 63, wr = wid >> 2, wc = wid & 3, fr = lane & 15, fq = lane >> 4;
    const int nt = K / BK;
    int R0, C0, R1, C1; stage_rc(tid * 16, R0, C0); stage_rc(tid * 16 + 8192, R1, C1);
    unsigned voffB[2];
    { const int Rb0 = Epi::PERM ? ((R0 & ~31) + perm32(R0 & 31)) : R0, Rb1 = Epi::PERM ? ((R1 & ~31) + perm32(R1 & 31)) : R1;
      voffB[0] = (unsigned)(Rb0 * K + C0) * 2u; voffB[1] = (unsigned)(Rb1 * K + C1) * 2u; }
    const unsigned cA0 = (unsigned)C0 * 2u, cA1 = (unsigned)C1 * 2u;
    const int lda = S.lda(K);
    const unsigned kstepA = S.kstepA();
    const unsigned voffA0 = (unsigned)(R0 * lda + C0) * 2u, voffA1 = (unsigned)(R1 * lda + C1) * 2u;
    const unsigned kstep = (unsigned)(BK * 2);
    const unsigned hstep = (unsigned)(HALF * K * 2);
    const unsigned ldsw = (unsigned)wid * 1024u;
    const int aoff = lds_byte(wr * 64 + fr, fq * 8), boff = lds_byte(wc * 32 + fr, fq * 8);
#define PG8_SA(b, h) (((b) * 2 + (h)) * HTB)
#define PG8_SB(b, h) ((4 + (b) * 2 + (h)) * HTB)
#define PG8_STAGE_B(bufoff, gbase) do { \
        __builtin_amdgcn_global_load_lds((const unsigned*)((const char*)(gbase) + voffB[0]), (LAS unsigned*)(lds + (bufoff) + ldsw), 16, 0, 0); \
        __builtin_amdgcn_global_load_lds((const unsigned*)((const char*)(gbase) + voffB[1]), (LAS unsigned*)(lds + (bufoff) + ldsw + 8192), 16, 0, 0); } while (0)
#define PG8_STAGE_A(bufoff, gbase, pk) do { \
        const unsigned o0_ = Sched::GATHER ? (((pk) & 0xffffu) * (unsigned)lda * 2u + cA0) : voffA0; \
        const unsigned o1_ = Sched::GATHER ? (((pk) >> 16) * (unsigned)lda * 2u + cA1) : voffA1; \
        __builtin_amdgcn_global_load_lds((const unsigned*)((const char*)(gbase) + o0_), (LAS unsigned*)(lds + (bufoff) + ldsw), 16, 0, 0); \
        __builtin_amdgcn_global_load_lds((const unsigned*)((const char*)(gbase) + o1_), (LAS unsigned*)(lds + (bufoff) + ldsw + 8192), 16, 0, 0); } while (0)
#define PG8_LDA(dst, b, h) do { _Pragma("unroll") for (int m = 0; m < 4; ++m) _Pragma("unroll") for (int k = 0; k < 2; ++k) dst[m][k] = *(const LAS bf16x8*)(lds + PG8_SA(b, h) + aoff + m * 2048 + k * 1024); } while (0)
#define PG8_LDB(dst, b, h) do { _Pragma("unroll") for (int n = 0; n < 2; ++n) _Pragma("unroll") for (int k = 0; k < 2; ++k) dst[n][k] = *(const LAS bf16x8*)(lds + PG8_SB(b, h) + boff + n * 2048 + k * 1024); } while (0)
#define PG8_MMA(ai, bj, At, Bt) do { __builtin_amdgcn_s_setprio(1); _Pragma("unroll") for (int m = 0; m < 4; ++m) _Pragma("unroll") for (int n = 0; n < 2; ++n) _Pragma("unroll") for (int k = 0; k < 2; ++k) \
        acc[ai][bj][m][n] = __builtin_amdgcn_mfma_f32_16x16x32_bf16(Bt[n][k], At[m][k], acc[ai][bj][m][n], 0, 0, 0); __builtin_amdgcn_s_setprio(0); } while (0)
#define PG8_WAIT_V(n) asm volatile("s_waitcnt vmcnt(" #n ")" ::: "memory")
#define PG8_WAIT_L(n) asm volatile("s_waitcnt lgkmcnt(" #n ")" ::: "memory")
#define PG8_BAR __builtin_amdgcn_s_barrier()
#define PG8_SCHED __builtin_amdgcn_sched_barrier(0)
#define PG8_PACK(u, h) ((unsigned)S.arow((u), ((h) * 128 + R0) < (u).nrows ? ((h) * 128 + R0) : (u).nrows - 1) | ((unsigned)S.arow((u), ((h) * 128 + R1) < (u).nrows ? ((h) * 128 + R1) : (u).nrows - 1) << 16))
    Unit cur, nxt; int ui = 0;
    if (!S.next(0, cur)) return;
    f32x4 acc[2][2][4][2];
    const f32x4 zv = zero4();
#pragma unroll
    for (int a = 0; a < 2; ++a)
#pragma unroll
        for (int b = 0; b < 2; ++b)
#pragma unroll
            for (int m = 0; m < 4; ++m)
#pragma unroll
                for (int n = 0; n < 2; ++n) acc[a][b][m][n] = zv;
    bf16x8 At[4][2], B0[2][2], B1[2][2];
    unsigned pC0 = 0u, pC1 = 0u, pN0 = 0u, pN1 = 0u;
    if (Sched::GATHER) { pC0 = PG8_PACK(cur, 0); pC1 = PG8_PACK(cur, 1); }
    const char* cB = cur.bptr;
    const char* cA = Sched::GATHER ? Abase : S.abase(cur, Abase) + (size_t)cur.arow0 * lda * 2;
    const unsigned hA = Sched::GATHER ? 0u : (unsigned)(HALF * lda * 2);
    PG8_STAGE_B(PG8_SB(0, 0), cB); PG8_STAGE_B(PG8_SB(0, 1), cB + hstep); PG8_STAGE_A(PG8_SA(0, 0), cA, pC0); PG8_STAGE_A(PG8_SA(0, 1), cA + hA, pC1);
    if (wr == 1) PG8_BAR;
    PG8_WAIT_V(2); PG8_BAR;
    PG8_STAGE_B(PG8_SB(1, 0), cB + kstep); PG8_STAGE_A(PG8_SA(1, 0), cA + kstepA, pC0); PG8_STAGE_B(PG8_SB(1, 1), cB + hstep + kstep);
    PG8_WAIT_V(6); PG8_BAR;
    for (;;) {
        const bool has_next = S.next(ui + 1, nxt);
        if (Sched::GATHER) { if (has_next) { pN0 = PG8_PACK(nxt, 0); pN1 = PG8_PACK(nxt, 1); } else { pN0 = pC0; pN1 = pC1; } }
        const char* nB = has_next ? nxt.bptr : cB;
        const char* nA = (Sched::GATHER || !has_next) ? cA : S.abase(nxt, Abase) + (size_t)nxt.arow0 * lda * 2;
        for (int t = 0; t < nt; t += 2) {
            const bool last = (t == nt - 2);
            const char* a1 = cA + (unsigned)(t + 1) * kstepA;
            const char* a2 = last ? nA : cA + (unsigned)(t + 2) * kstepA; const char* b2 = last ? nB : cB + (unsigned)(t + 2) * kstep;
            const char* a3 = a2 + kstepA; const char* b3 = b2 + kstep;
            const unsigned s0 = last ? pN0 : pC0, s1 = last ? pN1 : pC1;
            PG8_LDB(B0, 0, 0); PG8_LDB(B1, 0, 1); PG8_SCHED; PG8_LDA(At, 0, 0); PG8_STAGE_A(PG8_SA(1, 1), a1 + hA, pC1);
            PG8_WAIT_V(8); PG8_WAIT_L(0); PG8_BAR; PG8_MMA(0, 0, At, B0); PG8_MMA(0, 1, At, B1); PG8_BAR; PG8_SCHED;
            PG8_LDA(At, 0, 1); PG8_STAGE_B(PG8_SB(0, 0), b2); PG8_STAGE_B(PG8_SB(0, 1), b2 + hstep); PG8_STAGE_A(PG8_SA(0, 0), a2, s0);
            PG8_WAIT_V(8); PG8_WAIT_L(0); PG8_BAR; PG8_MMA(1, 0, At, B0); PG8_MMA(1, 1, At, B1); PG8_BAR; PG8_SCHED;
            PG8_LDB(B0, 1, 0); PG8_LDB(B1, 1, 1); PG8_SCHED; PG8_LDA(At, 1, 0); PG8_STAGE_A(PG8_SA(0, 1), a2 + hA, s1);
            PG8_WAIT_V(8); PG8_WAIT_L(0); PG8_BAR; PG8_MMA(0, 0, At, B0); PG8_MMA(0, 1, At, B1); PG8_BAR; PG8_SCHED;
            PG8_LDA(At, 1, 1); PG8_STAGE_B(PG8_SB(1, 0), b3); PG8_STAGE_B(PG8_SB(1, 1), b3 + hstep); PG8_STAGE_A(PG8_SA(1, 0), a3, s0);
            PG8_WAIT_V(8); PG8_WAIT_L(0); PG8_BAR; PG8_MMA(1, 0, At, B0); PG8_MMA(1, 1, At, B1); PG8_BAR; PG8_SCHED;
        }
        if (wr == 0) PG8_BAR;
        E(acc, cur, wr, wc, fr, fq);
        if (!has_next) break;
#pragma unroll
        for (int a = 0; a < 2; ++a)
#pragma unroll
            for (int b = 0; b < 2; ++b)
#pragma unroll
                for (int m = 0; m < 4; ++m)
#pragma unroll
                    for (int n = 0; n < 2; ++n) acc[a][b][m][n] = zv;
        cur = nxt; cB = nB; cA = nA; ++ui;
        pC0 = pN0; pC1 = pN1;
        if (wr == 1) PG8_BAR;
    }
    PG8_WAIT_V(0);
    PG8_BAR;
#undef PG8_SA
#undef PG8_SB
#undef PG8_STAGE_A
#undef PG8_STAGE_B
#undef PG8_LDA
#undef PG8_LDB
#undef PG8_MMA
#undef PG8_WAIT_V
#undef PG8_WAIT_L
#undef PG8_BAR
#undef PG8_SCHED
#undef PG8_PACK
}

struct DenseOrder {
    static constexpr bool GATHER = false;
    int nM, nN, nwg, G, c; const char* Bt; int K;
    __device__ void init(int M, int N, int K_, const bf16_t* Bt_, int G_, int c_) { nM = M / BM; nN = N / BM; nwg = nM * nN; G = G_; c = c_; Bt = (const char*)Bt_; K = K_; }
    __device__ __forceinline__ bool next(int i, Unit& u) const {
        const long L = (long)i * G + c; if (L >= nwg) return false;
        int wgid = (int)L; { const int q = nwg / 8, r = nwg % 8, xcd = wgid % 8, off = wgid / 8; wgid = (xcd < r ? xcd * (q + 1) : r * (q + 1) + (xcd - r) * q) + off; }
        const int nig = 8 * nN, gid = wgid / nig, fm = gid * 8, gsz = (nM - fm) < 8 ? (nM - fm) : 8;
        u.pm = fm + ((wgid % nig) % gsz); u.pn = (wgid % nig) / gsz;
        u.arow0 = u.pm * BM; u.nrows = BM; u.e = 0; u.ui = i;
        u.bptr = Bt + (size_t)u.pn * BM * K * 2;
        return true;
    }
    __device__ __forceinline__ int arow(const Unit& u, int r) const { return u.arow0 + r; }
    __device__ __forceinline__ int lda(int K_) const { return K_; }
    __device__ __forceinline__ unsigned kstepA() const { return 128u; }
    __device__ __forceinline__ const char* abase(const Unit&, const char* A) const { return A; }
};
}

struct EpiH {
    static constexpr bool PERM = true;
    bf16_t* H;
    __device__ __forceinline__ void operator()(const f32x4 (&acc)[2][2][4][2], const pg8::Unit& u, int wr, int wc, int fr, int fq) const {
        const int row0 = u.arow0 + wr * 64 + fr, col0 = u.pn * 256 + wc * 32 + 8 * fq;
#pragma unroll
        for (int ai = 0; ai < 2; ++ai)
#pragma unroll
            for (int m = 0; m < 4; ++m) {
                bf16_t* rowp = H + (size_t)(row0 + ai * 128 + m * 16) * HLD + col0;
#pragma unroll
                for (int bj = 0; bj < 2; ++bj) {
                    const f32x4 v0 = acc[ai][bj][m][0], v1 = acc[ai][bj][m][1];
                    u32x4 w; w.x = pg8::cvt_pk_bf16(v0[0], v0[1]); w.y = pg8::cvt_pk_bf16(v0[2], v0[3]); w.z = pg8::cvt_pk_bf16(v1[0], v1[1]); w.w = pg8::cvt_pk_bf16(v1[2], v1[3]);
                    *(u32x4*)(rowp + bj * 128) = w;
                }
            }
    }
};
struct EpiRes {
    static constexpr bool PERM = false;
    const float* xin; float* out;
    __device__ __forceinline__ void operator()(const f32x4 (&acc)[2][2][4][2], const pg8::Unit& u, int wr, int wc, int fr, int fq) const {
        const int row0 = u.arow0 + wr * 64 + fr, col0 = u.pn * 256 + wc * 32 + 4 * fq;
#pragma unroll
        for (int ai = 0; ai < 2; ++ai)
#pragma unroll
            for (int m = 0; m < 4; ++m) {
                const size_t off = (size_t)(row0 + ai * 128 + m * 16) * DM + col0;
#pragma unroll
                for (int bj = 0; bj < 2; ++bj)
#pragma unroll
                    for (int n = 0; n < 2; ++n) {
                        const f32x4 xv = *(const f32x4*)(xin + off + bj * 128 + n * 16);
                        *(f32x4*)(out + off + bj * 128 + n * 16) = xv * ALPHA + acc[ai][bj][m][n];
                    }
            }
    }
};

template <class RM>
__device__ __forceinline__ void transpose_item(const float* W, int K, int N, bf16_t* WT, RM rowmap, float* scr, int kb, int nb, int lane) {
    const int k0 = 64 * kb, n0 = 32 * nb;
    const int nn = n0 + (lane & 31);
    float tmp[32];
#pragma unroll
    for (int i = 0; i < 32; ++i) {
        const int kk = 2 * i + (lane >> 5);
        tmp[i] = nn < N ? W[(size_t)(k0 + kk) * N + nn] : 0.f;
    }
#pragma unroll
    for (int i = 0; i < 32; ++i) {
        const int kk = 2 * i + (lane >> 5);
        scr[kk * 33 + (lane & 31)] = tmp[i];
    }
    wave_sync();
    const int c = lane & 7;
#pragma unroll
    for (int j = 0; j < 4; ++j) {
        const int n = (lane >> 3) + 8 * j;
        const float* s = scr + (8 * c) * 33 + n;
        u32x4 o; o.x = pk2(s[0 * 33], s[1 * 33]); o.y = pk2(s[2 * 33], s[3 * 33]); o.z = pk2(s[4 * 33], s[5 * 33]); o.w = pk2(s[6 * 33], s[7 * 33]);
        const int dr = (n0 + n < N) ? rowmap(n0 + n) : -1;
        if (dr >= 0) *(u32x4*)(WT + (size_t)dr * K + k0 + 8 * c) = o;
    }
    wave_sync();
}

__device__ void phase_prologue(KA ka, int layer, float* smem) {
    PHASE_IDS
    const int lane = TID & 63, w = TID >> 6;
    float* scr = smem + w * 4096;
    const int gw = BID * NW + w, NGW = gridDim.x * NW;
    constexpr int I_IN = 16 * 89, I_OUT = 16 * 32, I_GU = 16 * 16, I_DN = 8 * 32;
    constexpr int I_LAYER = I_IN + I_OUT + 32 * I_GU + 16 * I_DN;
    for (int it = gw; it < I_LAYER; it += NGW) {
        int r = it;
        bf16_t* WT = PF(WT);
        if (r < I_IN) {
            transpose_item(PF(w_in) + (size_t)layer * DM * IC_SRC, DM, IC_SRC, WT + WT_IN,
                           [](int n) { return n < 1792 ? n : (n < 1816 ? 2816 + (n - 1792) : n - 24); }, scr, r / 89, r % 89, lane);
            continue;
        }
        r -= I_IN;
        if (r < I_OUT) {
            transpose_item(PF(w_out) + (size_t)layer * DM * DM, DM, DM, WT + WT_OUT, [](int n) { return n; }, scr, r / 32, r % 32, lane);
            continue;
        }
        r -= I_OUT;
        if (r < 32 * I_GU) {
            const int mat = r / I_GU, rr = r % I_GU, e = mat >> 1, isup = mat & 1;
            const float* W = (isup ? PF(w_up) : PF(w_gate)) + ((size_t)layer * 16 + e) * DM * 512;
            transpose_item(W, DM, 512, WT + WT_UP + (size_t)e * 1024 * 1024,
                           [isup](int n) { return (n >> 7) * 256 + isup * 128 + (n & 127); }, scr, rr / 16, rr % 16, lane);
            continue;
        }
        r -= 32 * I_GU;
        {
            const int e = r / I_DN, rr = r % I_DN;
            transpose_item(PF(w_down) + ((size_t)layer * 16 + e) * 512 * DM, 512, DM, WT + WT_DN + (size_t)e * 1024 * 512,
                           [](int n) { return n; }, scr, rr / 32, rr % 32, lane);
        }
    }
    for (int it = gw; it < 2 * 32 * 4; it += NGW) {
        const int which = it >> 7, rr = it & 127;
        transpose_item(PF(cmp_w1) + ((size_t)layer * 2 + which) * 2048 * 128, 2048, 128, PF(WT) + WT_C1 + (size_t)which * 256 * 2048, [](int n) { return n; }, scr, rr >> 2, rr & 3, lane);
    }
    for (int i = BID * NTHR + TID; i < 2 * 128 * 256; i += gridDim.x * NTHR) {
        const int which = i >> 15, q = i & 32767;
        const u32x4 z = __builtin_bit_cast(u32x4, zero4());
        *(u32x4*)(PF(WT) + WT_C1 + (size_t)which * 256 * 2048 + (size_t)128 * 2048 + (size_t)q * 8) = z;
    }
    for (int o = gw; o < 256; o += NGW) {
        const int which = o >> 7, cc = o & 127;
        const float* w1 = PF(cmp_w1) + ((size_t)layer * 2 + which) * 2048 * 128;
        const float* pos = PF(cmp_pos) + ((size_t)layer * 2 + which) * 2048;
        float a = 0.f;
        for (int k = lane; k < 2048; k += 64) a = fmaf(pos[k], w1[(size_t)k * 128 + cc], a);
        a = wave_sum(a);
        if (lane == 0) (PF(cbias) + layer * (256))[o] = a;
    }
    for (int i = BID * NTHR + TID; i < 4 * 128 * 128; i += gridDim.x * NTHR) {
        const int s = i & 127, t = (i >> 7) & 127;
        PF(WT)[WT_GM + i] = (s <= t) ? f2bf(PF(gm_w_s)[(size_t)layer * 4 * 128 * 128 + i]) : (bf16_t)0;
    }
    for (int i = BID * NTHR + TID; i < 20 * 1024; i += gridDim.x * NTHR) {
        const int o = i >> 10, cc = i & 1023;
        (PF(wrt) + layer * (20480))[i] = o < 4 ? PF(rg_w)[((size_t)layer * 1024 + cc) * 4 + o] : PF(re_w)[((size_t)layer * 1024 + cc) * 16 + (o - 4)];
    }
    for (int i = BID * NTHR + TID; i < 232 * 128; i += gridDim.x * NTHR) {
        const int q = i;
        const u32x4 z = __builtin_bit_cast(u32x4, zero4());
        *(u32x4*)(PF(WT) + WT_IN + (size_t)2840 * 1024 + (size_t)q * 8) = z;
    }
    if (layer == 0)
    for (int row = gw; row < NTOK; row += NGW) {
        const f32x4* xr = (const f32x4*)(PF(x) + (size_t)row * DM) + lane;
        u32x2* o = (u32x2*)(PF(XB) + (size_t)row * DM) + lane;
#pragma unroll
        for (int j = 0; j < 4; ++j) {
            const f32x4 v = xr[64 * j];
            u32x2 ww; ww.x = pk2(v[0], v[1]); ww.y = pk2(v[2], v[3]);
            o[64 * j] = ww;
        }
    }
}

template <class AF, class BF, class EF>
__device__ __forceinline__ void gemm128(int tid, int m0, int n0, int M, int N, int K, AF af, BF bf, EF ef, float* smem) {
    float* As = smem;
    float* Bs = smem + 16 * 132;
    const bool active = tid < 256;
    const int tx = tid & 15, ty = (tid >> 4) & 15;
    float acc[8][8];
#pragma unroll
    for (int i = 0; i < 8; i++)
#pragma unroll
        for (int j = 0; j < 8; j++) acc[i][j] = 0.f;
#pragma unroll 1
    for (int k0 = 0; k0 < K; k0 += 16) {
        if (active) {
#pragma unroll
            for (int i = 0; i < 8; i++) {
                int e = tid + i * 256;
                int r = e >> 4, kk = e & 15;
                float v = 0.f;
                if (m0 + r < M) v = af(m0 + r, k0 + kk);
                As[kk * 132 + r] = v;
            }
#pragma unroll
            for (int i = 0; i < 8; i++) {
                int e = tid + i * 256;
                int kk = e >> 7, c = e & 127;
                float v = 0.f;
                if (n0 + c < N) v = bf(k0 + kk, n0 + c);
                Bs[kk * 132 + c] = v;
            }
        }
        __syncthreads();
        if (active) {
#pragma unroll 2
            for (int kk = 0; kk < 16; kk++) {
                asm volatile("" ::: "memory");
                float4 a0 = *(const float4*)&As[kk * 132 + ty * 8];
                float4 a1 = *(const float4*)&As[kk * 132 + ty * 8 + 4];
                float4 b0 = *(const float4*)&Bs[kk * 132 + tx * 8];
                float4 b1 = *(const float4*)&Bs[kk * 132 + tx * 8 + 4];
                float a[8] = {a0.x, a0.y, a0.z, a0.w, a1.x, a1.y, a1.z, a1.w};
                float b[8] = {b0.x, b0.y, b0.z, b0.w, b1.x, b1.y, b1.z, b1.w};
#pragma unroll
                for (int i = 0; i < 8; i++)
#pragma unroll
                    for (int j = 0; j < 8; j++) acc[i][j] = fmaf(a[i], b[j], acc[i][j]);
            }
        }
        __syncthreads();
    }
    if (active) {
#pragma unroll
        for (int i = 0; i < 8; i++)
#pragma unroll
            for (int j = 0; j < 8; j++) {
                int m = m0 + ty * 8 + i, n = n0 + tx * 8 + j;
                if (m < M && n < N) ef(m, n, acc[i][j]);
            }
    }
}

__device__ __forceinline__ void phase_inproj(KA ka, int layer, LAS unsigned char* lds) {
    pg8::DenseOrder S; S.init(NTOK, HLD, DM, PF(WT) + WT_IN, gridDim.x, opaque_bid());
    EpiH E{PF(H)};
    pg8::gemm_phase<EpiH, pg8::DenseOrder>(lds, (const char*)PF(XB), DM, S, E);
}
__device__ __forceinline__ void phase_outproj(KA ka, int layer, const float* xin, float* x1, LAS unsigned char* lds) {
    pg8::DenseOrder S; S.init(NTOK, DM, DM, PF(WT) + WT_OUT, gridDim.x, opaque_bid());
    EpiRes E{xin, x1};
    pg8::gemm_phase<EpiRes, pg8::DenseOrder>(lds, (const char*)PF(Y), DM, S, E);
}

__device__ void phase_ln1_route(KA ka, int layer, float* x1, float* smem, bool dry) {
    PHASE_IDS
    bf16_t* xb = PF(XB);
    float* x1o = dry ? (float*)PF(H) : x1;
    const int lane = TID & 63, w = TID >> 6;
    const float* g = PF(ln1_g) + layer * 1024;
    const float* bb = PF(ln1_b) + layer * 1024;
    const float* wg = PF(rg_w) + (size_t)layer * 1024 * 4;
    const float* we = PF(re_w) + (size_t)layer * 1024 * 16;
    const float* bg = PF(rg_b) + layer * 4;
    const float* be = PF(re_b) + layer * 16;
    int* cnt = (int*)(PF(ctl) + CW_CNT) + layer * 16 * 64 + (dry ? 2048 : 0);
    int* lcnt = (int*)(smem + 20 * 1024);
    int* rinfo = lcnt + 64;
    float* rwt = (float*)(rinfo + 4 * 128);
    if (TID < 32) lcnt[TID] = 0;
    float* WR = smem;
    __syncthreads();
    for (int idx = TID; idx < 20 * 256; idx += NTHR) *(f32x4*)(WR + 4 * idx) = *(const f32x4*)((PF(wrt) + layer * (20480)) + 4 * idx);
    __syncthreads();
    int nloc = 0;
    for (int row = BID * NW + w; row < NTOK; row += gridDim.x * NW) {
        f32x4 v[4];
        float s = 0.f;
#pragma unroll
        for (int j = 0; j < 4; ++j) { v[j] = *(const f32x4*)(x1 + (size_t)row * DM + 256 * j + 4 * lane); s += (v[j][0] + v[j][1]) + (v[j][2] + v[j][3]); }
        const float mu = wave_sum(s) * (1.f / 1024.f);
        float q = 0.f;
#pragma unroll
        for (int j = 0; j < 4; ++j) { v[j] = v[j] - mu; q += (v[j][0] * v[j][0] + v[j][1] * v[j][1]) + (v[j][2] * v[j][2] + v[j][3] * v[j][3]); }
        const float rstd = rsqrtf(wave_sum(q) * (1.f / 1024.f) + 1e-5f);
#pragma unroll
        for (int j = 0; j < 4; ++j) {
            const int c = 256 * j + 4 * lane;
            v[j] = v[j] * rstd * *(const f32x4*)(g + c) + *(const f32x4*)(bb + c);
            *(f32x4*)(x1o + (size_t)row * DM + c) = v[j];
            u32x2 pw; pw.x = pk2(v[j][0], v[j][1]); pw.y = pk2(v[j][2], v[j][3]);
            *(u32x2*)(xb + (size_t)row * DM + c) = pw;
        }
        float lg[4], le[16];
#pragma unroll
        for (int o = 0; o < 20; ++o) {
            asm volatile("" ::: "memory");
            float a = 0.f;
#pragma unroll
            for (int j = 0; j < 4; ++j) {
                const f32x4 w4 = *(const f32x4*)(WR + o * 1024 + 256 * j + 4 * lane);
                a += (v[j][0] * w4[0] + v[j][1] * w4[1]) + (v[j][2] * w4[2] + v[j][3] * w4[3]);
            }
            a = wave_sum(a);
            if (o < 4) lg[o] = a + bg[o]; else le[o - 4] = a + be[o - 4];
        }
        float gm = fmaxf(fmaxf(lg[0], lg[1]), fmaxf(lg[2], lg[3]));
        float ge[4], gs = 0.f;
#pragma unroll
        for (int c = 0; c < 4; c++) { ge[c] = __expf(lg[c] - gm); gs += ge[c]; }
        int gi = 0; float gbest = ge[0];
#pragma unroll
        for (int c = 1; c < 4; c++) if (ge[c] > gbest) { gbest = ge[c]; gi = c; }
        float gval = gbest / gs;
        float ls[4];
#pragma unroll
        for (int e = 0; e < 4; e++) ls[e] = gi == 0 ? le[e] : gi == 1 ? le[4 + e] : gi == 2 ? le[8 + e] : le[12 + e];
        float em = fmaxf(fmaxf(ls[0], ls[1]), fmaxf(ls[2], ls[3]));
        float pe[4];
#pragma unroll
        for (int e = 0; e < 4; e++) pe[e] = __expf(ls[e] - em);
        int i1 = 0; float b1 = pe[0];
#pragma unroll
        for (int e = 1; e < 4; e++) if (pe[e] > b1) { b1 = pe[e]; i1 = e; }
        int i2 = -1; float b2 = -1.f;
#pragma unroll
        for (int e = 0; e < 4; e++) if (e != i1 && pe[e] > b2) { b2 = pe[e]; i2 = e; }
        float w1 = gval * b1 / (b1 + b2), w2 = gval * b2 / (b1 + b2);
        if (lane == 0) {
            const int e1 = gi * 4 + i1, e2 = gi * 4 + i2;
            const int lr = nloc * NW + w;
            rinfo[lr * 4 + 0] = e1; rinfo[lr * 4 + 1] = atomicAdd(&lcnt[e1], 1);
            rinfo[lr * 4 + 2] = e2; rinfo[lr * 4 + 3] = atomicAdd(&lcnt[e2], 1);
            rwt[lr * 2 + 0] = w1; rwt[lr * 2 + 1] = w2;
        }
        ++nloc;
    }
    __syncthreads();
    if (TID < 16) lcnt[16 + TID] = lcnt[TID] > 0 ? atomicAdd(&cnt[TID * 64], lcnt[TID]) : 0;
    __syncthreads();
    {
        const int nrows_blk = (NTOK - BID * NW + (int)gridDim.x * NW - 1) / ((int)gridDim.x * NW) * NW;
        for (int lr = TID; lr < nrows_blk; lr += NTHR) {
            const int row = BID * NW + (lr % NW) + (lr / NW) * (int)gridDim.x * NW;
            if (row < NTOK) {
                const int e1 = rinfo[lr * 4 + 0], p1 = lcnt[16 + e1] + rinfo[lr * 4 + 1];
                const int e2 = rinfo[lr * 4 + 2], p2 = lcnt[16 + e2] + rinfo[lr * 4 + 3];
                (PF(list_tok) + layer * ((size_t)16 * NTOK))[e1 * NTOK + p1] = row; (PF(list_w) + layer * ((size_t)16 * NTOK))[e1 * NTOK + p1] = rwt[lr * 2 + 0];
                (PF(list_tok) + layer * ((size_t)16 * NTOK))[e2 * NTOK + p2] = row; (PF(list_w) + layer * ((size_t)16 * NTOK))[e2 * NTOK + p2] = rwt[lr * 2 + 1];
                (PF(tok_slot) + layer * ((size_t)NTOK * 2))[row * 2 + 0] = e1 * NTOK + p1; (PF(tok_slot) + layer * ((size_t)NTOK * 2))[row * 2 + 1] = e2 * NTOK + p2;
            }
        }
    }
    __syncthreads();
}


template <bool GATHER_>
struct MoeOrder {
    static constexpr bool GATHER = GATHER_;
    const LAS int* tab; const LAS int* rowtab;
    const char* Bt; unsigned estride; int K, G, c;
    __device__ __forceinline__ bool next(int i, pg8::Unit& u) const {
        const int nwg = __builtin_amdgcn_readfirstlane(tab[48]) * 4;
        const int L = i * G + c; if (L >= nwg) return false;
        int wgid = L; { const int q = nwg / 8, r = nwg % 8, xcd = wgid % 8, off = wgid / 8; wgid = (xcd < r ? xcd * (q + 1) : r * (q + 1) + (xcd - r) * q) + off; }
        const int mg = wgid >> 2, nt = wgid & 3;
        int e = 0;
#pragma unroll
        for (int k = 1; k < 16; ++k) e = (__builtin_amdgcn_readfirstlane(tab[32 + k]) <= mg) ? k : e;
        const int mt = mg - __builtin_amdgcn_readfirstlane(tab[32 + e]);
        const int rem = __builtin_amdgcn_readfirstlane(tab[e]) - mt * 256;
        u.e = e; u.pm = mt; u.pn = nt; u.ui = i; u.nrows = rem < 256 ? rem : 256; u.arow0 = __builtin_amdgcn_readfirstlane(tab[16 + e]) + mt * 256;
        u.bptr = Bt + (size_t)e * estride + (size_t)nt * 256 * K * 2;
        return true;
    }
    __device__ __forceinline__ int arow(const pg8::Unit& u, int r) const { return GATHER_ ? rowtab[u.ui * 256 + r] : u.arow0 + r; }
    __device__ __forceinline__ int lda(int K_) const { return K_; }
    __device__ __forceinline__ unsigned kstepA() const { return 128u; }
    __device__ __forceinline__ const char* abase(const pg8::Unit&, const char* A) const { return A; }
};
__device__ __forceinline__ void moe_tables(KA ka, int layer, LAS unsigned char* lds, bool want_rows, int G, int c) {
    LAS int* tab = (LAS int*)(lds + LDS_MISC + 256);
    LAS int* rowtab = (LAS int*)(lds + LDS_MISC + 1024);
    const int tid = opaque_tid();
    const int* cnt = (const int*)(PF(ctl) + CW_CNT) + layer * 16 * 64;
    if (tid < 16) tab[tid] = __hip_atomic_load(&cnt[tid * 64], __ATOMIC_RELAXED, __HIP_MEMORY_SCOPE_AGENT);
    __syncthreads();
    if (tid == 0) {
        int b = 0, m = 0;
        for (int e = 0; e < 16; ++e) { tab[16 + e] = b; tab[32 + e] = m; b += tab[e]; m += (tab[e] + 255) >> 8; }
        tab[48] = m;
    }
    __syncthreads();
    if (want_rows) {
        MoeOrder<true> S{tab, rowtab, nullptr, 0u, 1024, G, c};
        const int* lt = (PF(list_tok) + layer * ((size_t)16 * NTOK));
        for (int i = 0; i < 4; ++i) {
            pg8::Unit u;
            if (!S.next(i, u)) break;
            if (tid < 256) { const int r = tid < u.nrows ? tid : u.nrows - 1; rowtab[i * 256 + tid] = lt[u.e * NTOK + u.pm * 256 + r]; }
        }
        asm volatile("s_waitcnt vmcnt(0) lgkmcnt(0)" ::: "memory");
        __syncthreads();
    }
}
struct EpiUp {
    static constexpr bool PERM = true;
    bf16_t* hidden;
    __device__ __forceinline__ void operator()(const f32x4 (&acc)[2][2][4][2], const pg8::Unit& u, int wr, int wc, int fr, int fq) const {
#pragma unroll
        for (int ai = 0; ai < 2; ++ai)
#pragma unroll
            for (int m = 0; m < 4; ++m) {
                const int r = ai * 128 + wr * 64 + m * 16 + fr;
                if (r < u.nrows) {
                    bf16_t* rowp = hidden + (size_t)(u.arow0 + r) * 512 + u.pn * 128 + wc * 32 + 8 * fq;
                    float h[8];
#pragma unroll
                    for (int n = 0; n < 2; ++n)
#pragma unroll
                        for (int j = 0; j < 4; ++j) { const float g = acc[ai][0][m][n][j], uu = acc[ai][1][m][n][j]; h[n * 4 + j] = g * sigmoidf_(g) * uu; }
                    u32x4 w; w.x = pg8::cvt_pk_bf16(h[0], h[1]); w.y = pg8::cvt_pk_bf16(h[2], h[3]); w.z = pg8::cvt_pk_bf16(h[4], h[5]); w.w = pg8::cvt_pk_bf16(h[6], h[7]);
                    *(u32x4*)rowp = w;
                }
            }
    }
};
struct EpiDown {
    static constexpr bool PERM = true;
    bf16_t* Y2; const float* lw;
    __device__ __forceinline__ void operator()(const f32x4 (&acc)[2][2][4][2], const pg8::Unit& u, int wr, int wc, int fr, int fq) const {
#pragma unroll
        for (int ai = 0; ai < 2; ++ai)
#pragma unroll
            for (int m = 0; m < 4; ++m) {
                const int r = ai * 128 + wr * 64 + m * 16 + fr;
                if (r < u.nrows) {
                    const float wgt = lw[u.e * NTOK + u.pm * 256 + r];
                    bf16_t* rowp = Y2 + (size_t)(u.arow0 + r) * DM + u.pn * 256 + wc * 32 + 8 * fq;
#pragma unroll
                    for (int bj = 0; bj < 2; ++bj) {
                        const f32x4 v0 = acc[ai][bj][m][0] * wgt, v1 = acc[ai][bj][m][1] * wgt;
                        u32x4 w; w.x = pg8::cvt_pk_bf16(v0[0], v0[1]); w.y = pg8::cvt_pk_bf16(v0[2], v0[3]); w.z = pg8::cvt_pk_bf16(v1[0], v1[1]); w.w = pg8::cvt_pk_bf16(v1[2], v1[3]);
                        *(u32x4*)(rowp + bj * 128) = w;
                    }
                }
            }
    }
};
__device__ __forceinline__ void phase_moe_up(KA ka, int layer, LAS unsigned char* lds) {
    moe_tables(ka, layer, lds, true, gridDim.x, opaque_bid());
    MoeOrder<true> S{(const LAS int*)(lds + LDS_MISC + 256), (const LAS int*)(lds + LDS_MISC + 1024),
                     (const char*)(PF(WT) + WT_UP), (unsigned)(1024u * 1024u * 2u), 1024, (int)gridDim.x, opaque_bid()};
    EpiUp E{PF(Y)};
    pg8::gemm_phase<EpiUp, MoeOrder<true>>(lds, (const char*)PF(XB), 1024, S, E);
}
__device__ __forceinline__ void phase_moe_down(KA ka, int layer, LAS unsigned char* lds) {
    moe_tables(ka, layer, lds, false, gridDim.x, opaque_bid());
    MoeOrder<false> S{(const LAS int*)(lds + LDS_MISC + 256), (const LAS int*)(lds + LDS_MISC + 1024),
                      (const char*)(PF(WT) + WT_DN), (unsigned)(1024u * 512u * 2u), 512, (int)gridDim.x, opaque_bid()};
    EpiDown E{PF(H), (PF(list_w) + layer * ((size_t)16 * NTOK))};
    pg8::gemm_phase<EpiDown, MoeOrder<false>>(lds, (const char*)PF(Y), 512, S, E);
}

__device__ void phase_ln2(KA ka, int layer, const float* x1, float* xo) {
    PHASE_IDS
    bf16_t* xb = PF(XB);
    const bf16_t* Y2 = PF(H);
    const int lane = TID & 63, w = TID >> 6;
    const float* g = PF(ln2_g) + layer * 1024;
    const float* bb = PF(ln2_b) + layer * 1024;
    const int* cnt = (const int*)(PF(ctl) + CW_CNT) + layer * 16 * 64;
    int mybase = 0;
    {
        int cv = lane < 16 ? __hip_atomic_load(&cnt[(lane & 15) * 64], __ATOMIC_RELAXED, __HIP_MEMORY_SCOPE_AGENT) : 0;
        int incl = cv;
#pragma unroll
        for (int o = 1; o < 16; o <<= 1) { int t = __shfl_up(incl, o); if ((lane & 15) >= o) incl += t; }
        mybase = incl - cv;
    }
    for (int row = BID * NW + w; row < NTOK; row += gridDim.x * NW) {
        const int ts1 = (PF(tok_slot) + layer * ((size_t)NTOK * 2))[row * 2 + 0], ts2 = (PF(tok_slot) + layer * ((size_t)NTOK * 2))[row * 2 + 1];
        const int s1 = __shfl(mybase, ts1 >> 14) + (ts1 & (NTOK - 1)), s2 = __shfl(mybase, ts2 >> 14) + (ts2 & (NTOK - 1));
        f32x4 v[4];
        float s = 0.f;
#pragma unroll
        for (int j = 0; j < 4; ++j) {
            const int c = 256 * j + 4 * lane;
            const f32x4 xv = *(const f32x4*)(x1 + (size_t)row * DM + c);
            const u32x2 ya = __builtin_nontemporal_load((const u32x2*)(Y2 + (size_t)s1 * DM + c)), yb = __builtin_nontemporal_load((const u32x2*)(Y2 + (size_t)s2 * DM + c));
            f32x4 t;
            t[0] = __uint_as_float(ya.x << 16) + __uint_as_float(yb.x << 16); t[1] = __uint_as_float(ya.x & 0xffff0000u) + __uint_as_float(yb.x & 0xffff0000u);
            t[2] = __uint_as_float(ya.y << 16) + __uint_as_float(yb.y << 16); t[3] = __uint_as_float(ya.y & 0xffff0000u) + __uint_as_float(yb.y & 0xffff0000u);
            v[j] = xv * ALPHA + t;
            s += (v[j][0] + v[j][1]) + (v[j][2] + v[j][3]);
        }
        const float mu = wave_sum(s) * (1.f / 1024.f);
        float q = 0.f;
#pragma unroll
        for (int j = 0; j < 4; ++j) { v[j] = v[j] - mu; q += (v[j][0] * v[j][0] + v[j][1] * v[j][1]) + (v[j][2] * v[j][2] + v[j][3] * v[j][3]); }
        const float rstd = rsqrtf(wave_sum(q) * (1.f / 1024.f) + 1e-5f);
#pragma unroll
        for (int j = 0; j < 4; ++j) {
            const int c = 256 * j + 4 * lane;
            const f32x4 o = v[j] * rstd * *(const f32x4*)(g + c) + *(const f32x4*)(bb + c);
            *(f32x4*)(xo + (size_t)row * DM + c) = o;
            u32x2 pw; pw.x = pk2(o[0], o[1]); pw.y = pk2(o[2], o[3]);
            *(u32x2*)(xb + (size_t)row * DM + c) = pw;
        }
    }
}

#define MFMA16(a, b, c) __builtin_amdgcn_mfma_f32_16x16x32_bf16((a), (b), (c), 0, 0, 0)
constexpr int NSA_KT = 0, NSA_VT = 16384, NSA_IMP = 32768, NSA_FIN = 65536, NSA_SEL = LDS_MISC + 8192;

__device__ __forceinline__ int tile_off(int r, int c) { return r * 128 + ((c ^ ((r >> 1) & 7)) << 4); }

__device__ __forceinline__ unsigned cvtpk(float lo, float hi) { return pk2(lo, hi); }
struct SelMask { unsigned a, b, c, d; };
__device__ __forceinline__ unsigned selbit(unsigned a, unsigned b, unsigned c, unsigned d, int j) {
    const int k = j >> 5;
    const unsigned lo = (k & 1) ? b : a, hi = (k & 1) ? d : c;
    const unsigned r = (k & 2) ? hi : lo;
    return (r >> (j & 31)) & 1u;
}

struct NsaRT {
    bf16x8 q[2];
    f32x4 o[4];
    float m, l;
};

template <int MODE, int NST>
__device__ __forceinline__ void nsa_loop(LAS unsigned char* lds, int tid, int lane, int w, int t0w, int jb, int je,
                                         const char* ksrc, size_t kstride, size_t ktile, const char* vsrc, size_t vstride, size_t vtile,
                                         NsaRT (&R)[2], const SelMask selm0, const SelMask selm1, float (&carry)[2], float* impw) {
    const int g = lane >> 4, qr = lane & 15;
    int tid2 = tid; asm volatile("" : "+v"(tid2));
    const int sr = tid2 >> 3, sc = (tid2 & 7) ^ ((sr >> 1) & 7);
    const char* kp = ksrc + (size_t)sr * kstride + sc * 16;
    const char* vp = vsrc + (size_t)sr * vstride + sc * 16;
    const unsigned ldsw = (unsigned)w * 1024u;
    const int fxq = (qr >> 1) & 7;
    const int ka0 = qr * 128 + ((g ^ fxq) << 4), ka1 = qr * 128 + (((4 + g) ^ fxq) << 4);
    const int vb = qr * 128 + (g & 1) * 8, vc = (g >> 1) ^ fxq;
    const int va0 = vb + (vc << 4), va1 = vb + ((vc ^ 2) << 4), va2 = vb + ((vc ^ 4) << 4), va3 = vb + ((vc ^ 6) << 4);
    if (jb > je) return;
    constexpr int D = NST - 1;
#define NSA_ISSUE(jj, st) do { const int jc_ = (jj) < je ? (jj) : je; \
        __builtin_amdgcn_global_load_lds((const unsigned*)(kp + (size_t)jc_ * ktile), (LAS unsigned*)(lds + (st) * 16384 + ldsw), 16, 0, 0); \
        if (MODE != 0) __builtin_amdgcn_global_load_lds((const unsigned*)(vp + (size_t)jc_ * vtile), (LAS unsigned*)(lds + (st) * 16384 + 8192 + ldsw), 16, 0, 0); } while (0)
#define NSA_WAIT_TILE() do { if (NST == 2) asm volatile("s_waitcnt vmcnt(0) lgkmcnt(0)" ::: "memory"); else asm volatile("s_waitcnt vmcnt(4) lgkmcnt(0)" ::: "memory"); } while (0)
#pragma unroll
    for (int d = 0; d < D; ++d) NSA_ISSUE(jb + d, d);
    NSA_WAIT_TILE();
    __builtin_amdgcn_s_barrier();
    for (int j = jb; j <= je; ++j) {
        const int cur = (j - jb) & (NST - 1);
        NSA_ISSUE(j + D, (j - jb + D) & (NST - 1));
        const LAS unsigned char* kt = lds + cur * 16384;
        const LAS unsigned char* vt = lds + cur * 16384 + 8192;
        bool anyact;
        {
            bool a = false;
#pragma unroll
            for (int rt = 0; rt < 2; ++rt) {
                const int tk = t0w + 4 * rt + (qr >> 2);
                if (MODE <= 1) { const int nv = tk >= 31 ? ((tk - 31) >> 4) + 1 : 0; a = a || (nv > 64 * j); }
                else if (MODE == 2) a = a || ((rt == 0 ? selbit(selm0.a, selm0.b, selm0.c, selm0.d, j) : selbit(selm1.a, selm1.b, selm1.c, selm1.d, j)) != 0u);
                else a = a || ((64 * j <= tk) && (64 * j + 63 > tk - 512));
            }
            anyact = __any(a);
        }
        if (anyact) {
            f32x4 s[2][4];
#pragma unroll
            for (int t = 0; t < 4; ++t) {
                const bf16x8 k0 = *(const LAS bf16x8*)(kt + ka0 + t * 2048), k1 = *(const LAS bf16x8*)(kt + ka1 + t * 2048);
#pragma unroll
                for (int rt = 0; rt < 2; ++rt) {
                    s[rt][t] = (f32x4){0.f, 0.f, 0.f, 0.f};
                    s[rt][t] = MFMA16(k0, R[rt].q[0], s[rt][t]);
                    s[rt][t] = MFMA16(k1, R[rt].q[1], s[rt][t]);
                }
            }
            const int kb = 64 * j + 4 * g;
            bf16x8 pf[2][2];
            if (MODE == 1) {
#pragma unroll
                for (int rt = 0; rt < 2; ++rt) {
                    const int tk = t0w + 4 * rt + (qr >> 2);
                    const int nv = tk >= 31 ? ((tk - 31) >> 4) + 1 : 0;
                    const float mL = R[rt].m * 1.44269504f, invl = R[rt].l > 0.f ? 1.f / R[rt].l : 0.f;
                    float p[4][4];
#pragma unroll
                    for (int t = 0; t < 4; ++t)
#pragma unroll
                        for (int i = 0; i < 4; ++i) { const int key = kb + 16 * t + i; p[t][i] = (key < nv) ? __builtin_amdgcn_exp2f(fmaf(s[rt][t][i], 1.44269504f, -mL)) * invl : 0.f; }
#pragma unroll
                    for (int t = 0; t < 4; ++t) {
                        const float own = (p[t][0] + p[t][1]) + (p[t][2] + p[t][3]);
                        const float x3 = p[t][3];
                        const float up_cur = __shfl(x3, (lane + 48) & 63);
                        const float up_prev = __shfl(carry[rt], (lane + 48) & 63);
                        float v = own + (g >= 1 ? up_cur : up_prev);
                        v += __shfl_xor(v, 1);
                        v += __shfl_xor(v, 2);
                        carry[rt] = x3;
                        if ((qr & 3) == 0) impw[(4 * rt + (qr >> 2)) * 128 + 16 * j + 4 * t + g] = v;
                    }
#pragma unroll
                    for (int ks = 0; ks < 2; ++ks) {
                        u32x4 pu; pu.x = cvtpk(p[2 * ks][0], p[2 * ks][1]); pu.y = cvtpk(p[2 * ks][2], p[2 * ks][3]); pu.z = cvtpk(p[2 * ks + 1][0], p[2 * ks + 1][1]); pu.w = cvtpk(p[2 * ks + 1][2], p[2 * ks + 1][3]);
                        pf[rt][ks] = __builtin_bit_cast(bf16x8, pu);
                    }
                }
            } else {
                int lim_hi[2], lim_lo[2];
                bool none[2], part[2];
#pragma unroll
                for (int rt = 0; rt < 2; ++rt) {
                    const int tk = t0w + 4 * rt + (qr >> 2);
                    if (MODE == 0) { const int nv = tk >= 31 ? ((tk - 31) >> 4) + 1 : 0; lim_hi[rt] = nv - 1; lim_lo[rt] = -1; }
                    else if (MODE == 2) { lim_hi[rt] = ((rt == 0 ? selbit(selm0.a, selm0.b, selm0.c, selm0.d, j) : selbit(selm1.a, selm1.b, selm1.c, selm1.d, j)) != 0u) ? tk : -1; lim_lo[rt] = -1; }
                    else { lim_hi[rt] = tk; lim_lo[rt] = tk - 512; }
                    const bool full = (64 * j + 63 <= lim_hi[rt]) && (64 * j > lim_lo[rt]);
                    none[rt] = (64 * j > lim_hi[rt]) || (64 * j + 63 <= lim_lo[rt]);
                    part[rt] = !full && !none[rt];
                }
                float lmx[2];
                if (__any(part[0] || part[1])) {
#pragma unroll
                    for (int rt = 0; rt < 2; ++rt) {
                        float mx = NEG_INF;
#pragma unroll
                        for (int t = 0; t < 4; ++t)
#pragma unroll
                            for (int i = 0; i < 4; ++i) {
                                const int key = kb + 16 * t + i;
                                const bool ok = (key <= lim_hi[rt]) && (key > lim_lo[rt]);
                                s[rt][t][i] = ok ? s[rt][t][i] : NEG_INF;
                                mx = fmaxf(mx, s[rt][t][i]);
                            }
                        lmx[rt] = mx;
                        none[rt] = false;
                    }
                } else {
#pragma unroll
                    for (int rt = 0; rt < 2; ++rt) {
                        float mx = NEG_INF;
#pragma unroll
                        for (int t = 0; t < 4; ++t)
#pragma unroll
                            for (int i = 0; i < 4; ++i) mx = fmaxf(mx, s[rt][t][i]);
                        lmx[rt] = none[rt] ? NEG_INF : mx;
                    }
                }
                if (__any((lmx[0] > R[0].m + 6.f) || (lmx[1] > R[1].m + 6.f))) {
#pragma unroll
                    for (int rt = 0; rt < 2; ++rt) {
                        float mx = lmx[rt];
                        mx = fmaxf(mx, __shfl_xor(mx, 16));
                        mx = fmaxf(mx, __shfl_xor(mx, 32));
                        const float mn = fmaxf(R[rt].m, mx);
                        const float alpha = __expf(R[rt].m - mn);
                        R[rt].l *= alpha; R[rt].m = mn;
                        if (MODE != 0) {
#pragma unroll
                            for (int dt = 0; dt < 4; ++dt) R[rt].o[dt] = R[rt].o[dt] * alpha;
                        }
                    }
                }
#pragma unroll
                for (int rt = 0; rt < 2; ++rt) {
                    const float negmL = none[rt] ? -1e30f : -fmaxf(R[rt].m, -1e4f) * 1.44269504f;
                    float p[4][4];
                    float rs = 0.f;
#pragma unroll
                    for (int t = 0; t < 4; ++t)
#pragma unroll
                        for (int i = 0; i < 4; ++i) { p[t][i] = __builtin_amdgcn_exp2f(fmaf(s[rt][t][i], 1.44269504f, negmL)); rs += p[t][i]; }
                    R[rt].l += rs;
                    if (MODE != 0) {
#pragma unroll
                        for (int ks = 0; ks < 2; ++ks) {
                            u32x4 pu; pu.x = cvtpk(p[2 * ks][0], p[2 * ks][1]); pu.y = cvtpk(p[2 * ks][2], p[2 * ks][3]); pu.z = cvtpk(p[2 * ks + 1][0], p[2 * ks + 1][1]); pu.w = cvtpk(p[2 * ks + 1][2], p[2 * ks + 1][3]);
                            pf[rt][ks] = __builtin_bit_cast(bf16x8, pu);
                        }
                    }
                }
            }
            if (MODE != 0) {
#pragma unroll
                for (int ks = 0; ks < 2; ++ks)
#pragma unroll
                    for (int dt = 0; dt < 4; ++dt) {
                        const u32x2 lo = *(const LAS u32x2*)(vt + (ks ? va2 : va0) + dt * 2048);
                        const u32x2 hi = *(const LAS u32x2*)(vt + (ks ? va3 : va1) + dt * 2048);
                        u32x4 vu; vu.x = lo.x; vu.y = lo.y; vu.z = hi.x; vu.w = hi.y;
                        const bf16x8 vf = __builtin_bit_cast(bf16x8, vu);
                        R[0].o[dt] = MFMA16(vf, pf[0][ks], R[0].o[dt]);
                        R[1].o[dt] = MFMA16(vf, pf[1][ks], R[1].o[dt]);
                    }
            }
        }
        NSA_WAIT_TILE();
        __builtin_amdgcn_s_barrier();
    }
    asm volatile("s_waitcnt vmcnt(0)" ::: "memory");
    __builtin_amdgcn_s_barrier();
#undef NSA_ISSUE
#undef NSA_WAIT_TILE
}

__device__ void phase_nsa2(KA ka, int layer, LAS unsigned char* lds) {
    PHASE_IDS
    const int tid = TID, lane = tid & 63, w = __builtin_amdgcn_readfirstlane(tid >> 6), g = lane >> 4, qr = lane & 15;
    const bf16_t* H = PF(H);
    const bf16_t* kcb = (PF(kcb) + layer * ((size_t)4 * 512 * 64));
    const bf16_t* vcT = (PF(vcT) + layer * ((size_t)4 * 64 * 512));
    const bf16_t* vsT = PF(vsT);
    const bf16_t* vwT = PF(vwT);
    bf16_t* Y = PF(Y);
    const float* gate_b = PF(nsa_gate_b) + layer * 24;
    const float* ogain = PF(out_gain) + layer * 1024;
    float* impw = (float*)(lds + NSA_IMP + w * 4096);
    unsigned* selw = (unsigned*)(lds + NSA_SEL + w * 128);
    for (int base = BID; base < 256; base += gridDim.x) {
#pragma unroll 1
        for (int half = 0; half < 2; ++half) {
            const int it = half ? 511 - base : base;
            const int chunk = it >> 2, bh = it & 3, b = bh >> 1, hk = bh & 1;
            const size_t rowbase = (size_t)b * T_;
            const int t0w = chunk * 64 + w * 8;
            NsaRT R[2];
            LAS f32x4* finw = (LAS f32x4*)(lds + NSA_FIN + w * 8192) + lane;
#pragma unroll
            for (int rt = 0; rt < 2; ++rt) {
                const int tk = t0w + 4 * rt + (qr >> 2), hh = hk * 4 + (qr & 3);
                const bf16_t* qp = H + (rowbase + tk) * HLD + C_NQ + hh * 64 + 8 * g;
#pragma unroll
                for (int ks = 0; ks < 2; ++ks) {
                    const u32x4 u = *(const u32x4*)(qp + 32 * ks);
                    const unsigned uu[4] = {u.x, u.y, u.z, u.w};
                    u32x4 o4;
#pragma unroll
                    for (int e = 0; e < 4; ++e) {
                        const float f0 = __uint_as_float(uu[e] << 16) * 0.125f, f1 = __uint_as_float(uu[e] & 0xffff0000u) * 0.125f;
                        o4[e] = (__float_as_uint(f0) >> 16) | (__float_as_uint(f1) & 0xffff0000u);
                    }
                    R[rt].q[ks] = __builtin_bit_cast(bf16x8, o4);
                }
                R[rt].m = NEG_INF; R[rt].l = 0.f;
#pragma unroll
                for (int dt = 0; dt < 4; ++dt) R[rt].o[dt] = zero4();
            }
            SelMask selm0{0u, 0u, 0u, 0u}, selm1{0u, 0u, 0u, 0u};
            float carry[2] = {0.f, 0.f};
            const int tmax = chunk * 64 + 63;
            const int nvmax = tmax >= 31 ? ((tmax - 31) >> 4) + 1 : 0;
            const int nb = (nvmax + 63) >> 6;
            const char* kc_src = (const char*)(kcb + (size_t)bh * 512 * 64);
            const char* vc_src = (const char*)(vcT + (size_t)bh * 64 * 512);
            nsa_loop<0, 2>(lds, tid, lane, w, t0w, 0, nb - 1, kc_src, 128, 64 * 128, nullptr, 0, 0, R, selm0, selm1, carry, impw);
#pragma unroll
            for (int rt = 0; rt < 2; ++rt) { float l = R[rt].l; l += __shfl_xor(l, 16); l += __shfl_xor(l, 32); R[rt].l = l; }
            for (int i = lane; i < 8 * 128; i += 64) impw[i] = 0.f;
            wave_sync();
            nsa_loop<1, 2>(lds, tid, lane, w, t0w, 0, nb - 1, kc_src, 128, 64 * 128, vc_src, 512 * 2, 64 * 2, R, selm0, selm1, carry, impw);
#pragma unroll
            for (int rt = 0; rt < 2; ++rt) {
                const int hh = hk * 4 + (qr & 3);
                const float gt = sigmoidf_(bf2f(H[(rowbase + (t0w + 4 * rt + (qr >> 2))) * HLD + C_NG + hh * 3 + 0]) + gate_b[hh * 3 + 0]);
#pragma unroll
                for (int dt = 0; dt < 4; ++dt) finw[(rt * 4 + dt) * 64] = R[rt].o[dt] * gt;
            }
            wave_sync();
            {
                const int tl = lane >> 3, sub = lane & 7;
                const int tks = t0w + tl, curb = tks >> 6;
                float v[16];
#pragma unroll
                for (int i = 0; i < 16; ++i) {
                    const int jj = sub * 16 + i;
                    const float a = impw[tl * 128 + jj];
                    const bool forced = (jj == 0) || (jj == curb) || (jj == curb - 1);
                    v[i] = (jj <= curb) ? (a + (forced ? 1e4f : 0.f)) : NEG_INF;
                }
                wave_sync();
#pragma unroll
                for (int i = 0; i < 16; ++i) impw[tl * 128 + sub * 16 + i] = v[i];
                wave_sync();
                int cnt[16];
#pragma unroll
                for (int i = 0; i < 16; ++i) cnt[i] = 0;
                for (int jj = 0; jj < 128; ++jj) {
                    const float x = impw[tl * 128 + jj];
#pragma unroll
                    for (int i = 0; i < 16; ++i) cnt[i] += (x > v[i]) || (x == v[i] && jj < sub * 16 + i);
                }
                unsigned bits = 0u;
#pragma unroll
                for (int i = 0; i < 16; ++i) bits |= ((cnt[i] < 16) && (v[i] > 0.5f * NEG_INF)) ? (1u << i) : 0u;
                const unsigned other = __shfl_xor(bits, 1);
                const unsigned word = (sub & 1) ? ((bits << 16) | other) : (bits | (other << 16));
                if ((sub & 1) == 0) selw[tl * 4 + (sub >> 1)] = word;
                wave_sync();
                { const unsigned* q0 = selw + (qr >> 2) * 4; selm0.a = q0[0]; selm0.b = q0[1]; selm0.c = q0[2]; selm0.d = q0[3];
                  selm1.a = q0[16]; selm1.b = q0[17]; selm1.c = q0[18]; selm1.d = q0[19]; }
                wave_sync();
            }
            __syncthreads();
#pragma unroll
            for (int rt = 0; rt < 2; ++rt) {
                R[rt].m = NEG_INF; R[rt].l = 0.f;
#pragma unroll
                for (int dt = 0; dt < 4; ++dt) R[rt].o[dt] = zero4();
            }
            nsa_loop<2, 4>(lds, tid, lane, w, t0w, 0, chunk, (const char*)(H + rowbase * HLD + C_KS + hk * 64), (size_t)HLD * 2, (size_t)64 * HLD * 2,
                        (const char*)(vsT + (size_t)bh * 64 * T_), (size_t)T_ * 2, 64 * 2, R, selm0, selm1, carry, impw);
#pragma unroll
            for (int rt = 0; rt < 2; ++rt) {
                const int hh = hk * 4 + (qr & 3);
                const float gt = sigmoidf_(bf2f(H[(rowbase + (t0w + 4 * rt + (qr >> 2))) * HLD + C_NG + hh * 3 + 1]) + gate_b[hh * 3 + 1]);
                float ltot = R[rt].l; ltot += __shfl_xor(ltot, 16); ltot += __shfl_xor(ltot, 32);
                const float sc = gt / ltot;
#pragma unroll
                for (int dt = 0; dt < 4; ++dt) { finw[(rt * 4 + dt) * 64] += R[rt].o[dt] * sc; R[rt].o[dt] = zero4(); }
                R[rt].m = NEG_INF; R[rt].l = 0.f;
            }
            nsa_loop<3, 4>(lds, tid, lane, w, t0w, chunk >= 8 ? chunk - 8 : 0, chunk, (const char*)(H + rowbase * HLD + C_KW + hk * 64), (size_t)HLD * 2, (size_t)64 * HLD * 2,
                        (const char*)(vwT + (size_t)bh * 64 * T_), (size_t)T_ * 2, 64 * 2, R, selm0, selm1, carry, impw);
#pragma unroll
            for (int rt = 0; rt < 2; ++rt) {
                const int tk = (t0w + 4 * rt + (qr >> 2)), hh = hk * 4 + (qr & 3);
                const float gt = sigmoidf_(bf2f(H[(rowbase + tk) * HLD + C_NG + hh * 3 + 2]) + gate_b[hh * 3 + 2]);
                float ltot = R[rt].l; ltot += __shfl_xor(ltot, 16); ltot += __shfl_xor(ltot, 32);
                const float sc = gt / ltot;
                bf16_t* yp = Y + (rowbase + tk) * DM + 256 + hh * 64 + 4 * g;
                f32x4 ov[4];
                float ss = 0.f;
#pragma unroll
                for (int dt = 0; dt < 4; ++dt) { ov[dt] = finw[(rt * 4 + dt) * 64] + R[rt].o[dt] * sc; ss += (ov[dt][0] * ov[dt][0] + ov[dt][1] * ov[dt][1]) + (ov[dt][2] * ov[dt][2] + ov[dt][3] * ov[dt][3]); }
                ss += __shfl_xor(ss, 16);
                ss += __shfl_xor(ss, 32);
                const float rn = rsqrtf(ss * (1.f / 64.f) + 1e-6f);
#pragma unroll
                for (int dt = 0; dt < 4; ++dt) {
                    const f32x4 o = ov[dt] * rn * *(const f32x4*)(ogain + 256 + hh * 64 + 16 * dt + 4 * g);
                    u32x2 wv; wv.x = pk2(o[0], o[1]); wv.y = pk2(o[2], o[3]);
                    *(u32x2*)(yp + 16 * dt) = wv;
                }
            }
        }
    }
}

__device__ void phase_vtrans(KA ka, float* smem) {
    PHASE_IDS
    const int lane = TID & 63, w = TID >> 6;
    bf16_t* scr = (bf16_t*)(smem + w * 4096);
    const bf16_t* H = PF(H);
    for (int it = BID * NW + w; it < 1024; it += gridDim.x * NW) {
        const int tt = it & 127, bh = (it >> 7) & 3, which = it >> 9;
        const int b = bh >> 1, hk = bh & 1;
        const size_t tok0 = (size_t)b * T_ + tt * 64;
        const int col = (which ? C_VW : C_VS) + hk * 64;
        bf16_t* dst = (which ? PF(vwT) : PF(vsT)) + (size_t)bh * 64 * T_ + tt * 64;
        wave_sync();
        for (int i = 0; i < 64; ++i) scr[lane * 66 + i] = H[(tok0 + i) * HLD + col + lane];
        wave_sync();
        for (int d = 0; d < 64; ++d) dst[(size_t)d * T_ + lane] = scr[d * 66 + lane];
    }
}

__device__ void phase_hgrnA(KA ka, int layer, LAS unsigned char* lds, int first, int nblk) {
    PHASE_IDS
    const int tid = TID, lane = tid & 63, w = __builtin_amdgcn_readfirstlane(tid >> 6), gq = lane >> 4, lc = lane & 15;
    float* Q = (float*)lds;
    float* K = Q + 64 * 68;
    float* Bc = K + 64 * 68;
    float* SEG = Bc + 64 * 68;
    LAS bf16_t* ATb = (LAS bf16_t*)(lds + 57344);
    LAS bf16_t* ItB = ATb + 64 * 72;
    LAS bf16_t* KtB = ItB + 64 * 72;
    const bf16_t* H = PF(H);
    const float* hgl = PF(hg_lower);
    float* hgU = PF(hgU); float* hgG = (PF(hgG) + layer * ((size_t)1024 * 64)); bf16_t* hgQB = PF(hgQB); bf16_t* hgO = PF(hgO);
    if (BID < first) return;
    float* LB = (float*)(lds + 98304);
    if (tid < 256) {
        float lb = 0.f;
        if (layer == 1) { const float h0 = hgl[tid], h1 = hgl[256 + tid]; const float mx = fmaxf(h0, h1), e0 = expf(h0 - mx), e1 = expf(h1 - mx); lb = e1 / (e0 + e1); }
        LB[tid] = lb;
    }
    for (int item = BID - first; item < 1024; item += nblk) {
        const int c = item & 127, bh = item >> 7, h = bh & 3, b = bh >> 2;
        const size_t tok0 = (size_t)b * T_ + c * 64;
        __syncthreads();
#pragma unroll
        for (int i = 0; i < 8; ++i) {
            const int e = tid + i * NTHR, t = e >> 6, d = e & 63;
            const float lb = LB[h * 64 + d];
            const bf16_t* hp = H + (tok0 + t) * HLD + h * 64 + d;
            const float fl = bf2f(hp[C_HF]);
            const float ex = __expf(-fl);
            const float sg = 1.f / (1.f + ex);
            const float f = lb + (1.f - lb) * sg;
            Q[t * 68 + d] = bf2f(hp[C_HQ]);
            K[t * 68 + d] = (1.f - lb) * (ex * sg);
            ItB[d * 72 + t] = hp[C_HI];
            Bc[t * 68 + d] = __logf(fmaxf(f, 1e-38f));
        }
        __syncthreads();
        {
            const int d = lane, seg = w;
            float run = 0.f;
#pragma unroll
            for (int i = 0; i < 8; ++i) { run += Bc[(seg * 8 + i) * 68 + d]; Bc[(seg * 8 + i) * 68 + d] = run; }
            SEG[seg * 64 + d] = run;
            __syncthreads();
            float pre = 0.f;
            for (int s2 = 0; s2 < seg; ++s2) pre += SEG[s2 * 64 + d];
#pragma unroll
            for (int i = 0; i < 8; ++i) Bc[(seg * 8 + i) * 68 + d] += pre;
        }
        __syncthreads();
        {
            const int blk = tid >> 1, dh = tid & 1, tb = blk >> 4, sb = blk & 15;
            float acc[4][4];
#pragma unroll
            for (int i = 0; i < 4; ++i)
#pragma unroll
                for (int j = 0; j < 4; ++j) acc[i][j] = 0.f;
            if (sb <= tb) {
#pragma unroll 2
                for (int d0 = 32 * dh; d0 < 32 * dh + 32; d0 += 4) {
                    f32x4 qv[4], bt[4], kv[4], bsv[4];
#pragma unroll
                    for (int i = 0; i < 4; ++i) { qv[i] = *(const f32x4*)&Q[(4 * tb + i) * 68 + d0]; bt[i] = *(const f32x4*)&Bc[(4 * tb + i) * 68 + d0]; }
#pragma unroll
                    for (int j = 0; j < 4; ++j) { kv[j] = *(const f32x4*)&K[(4 * sb + j) * 68 + d0]; bsv[j] = *(const f32x4*)&Bc[(4 * sb + j) * 68 + d0]; }
#pragma unroll
                    for (int i = 0; i < 4; ++i)
#pragma unroll
                        for (int j = 0; j < 4; ++j)
#pragma unroll
                            for (int dd = 0; dd < 4; ++dd) acc[i][j] = fmaf(qv[i][dd] * kv[j][dd], __expf(fminf(bt[i][dd] - bsv[j][dd], 0.f)), acc[i][j]);
                }
            }
#pragma unroll
            for (int i = 0; i < 4; ++i)
#pragma unroll
                for (int j = 0; j < 4; ++j) { acc[i][j] += __shfl_xor(acc[i][j], 1); if (4 * sb + j > 4 * tb + i) acc[i][j] = 0.f; }
            if (dh == 0) {
#pragma unroll
                for (int i = 0; i < 4; ++i) {
                    u32x2 pw; pw.x = pk2(acc[i][0], acc[i][1]); pw.y = pk2(acc[i][2], acc[i][3]);
                    *(LAS u32x2*)(ATb + (4 * tb + i) * 72 + 4 * sb) = pw;
                }
            }
        }
#pragma unroll
        for (int i = 0; i < 8; ++i) {
            const int e = tid + i * NTHR, t = e >> 6, d = e & 63;
            const float bt = Bc[t * 68 + d];
            hgQB[(size_t)item * 4096 + e] = f2bf(Q[t * 68 + d] * __expf(bt));
            KtB[d * 72 + t] = f2bf(K[t * 68 + d] * __expf(Bc[63 * 68 + d] - bt));
        }
        if (tid < 64) hgG[(size_t)item * 64 + tid] = __expf(Bc[63 * 68 + tid]);
        __syncthreads();
#pragma unroll
        for (int q = 0; q < 4; ++q) {
            const int tile = w * 4 + q, isU = tile >> 4, rt_ = (tile >> 2) & 3, ct = tile & 3;
            const LAS bf16_t* Ab = (isU ? KtB : ATb) + (16 * rt_ + lc) * 72 + 8 * gq;
            const LAS bf16_t* Bb = ItB + (16 * ct + lc) * 72 + 8 * gq;
            f32x4 acc = zero4();
            acc = MFMA16(*(const LAS bf16x8*)Ab, *(const LAS bf16x8*)Bb, acc);
            acc = MFMA16(*(const LAS bf16x8*)(Ab + 32), *(const LAS bf16x8*)(Bb + 32), acc);
#pragma unroll
            for (int i = 0; i < 4; ++i) {
                const int r = 16 * rt_ + 4 * gq + i, cc = 16 * ct + lc;
                if (isU) hgU[((size_t)item * 64 + r) * 64 + cc] = acc[i];
                else hgO[((size_t)item * 64 + r) * 64 + cc] = f2bf(acc[i]);
            }
        }
    }
}

__device__ void phase_hgrnB(KA ka, int layer) {
    PHASE_IDS
    const float* hgU = PF(hgU); const float* hgG = (PF(hgG) + layer * ((size_t)1024 * 64)); float* hgS = PF(hgS);
    for (int gid = BID * NTHR + TID; gid < 32768; gid += gridDim.x * NTHR) {
        const int bh = gid >> 12, dv = gid & 4095, d = dv >> 6;
        float S = 0.f;
        for (int c0 = 0; c0 < 128; c0 += 8) {
            float u[8], gg[8];
#pragma unroll
            for (int k = 0; k < 8; ++k) { const size_t item = (size_t)bh * 128 + c0 + k; u[k] = hgU[item * 4096 + dv]; gg[k] = hgG[item * 64 + d]; }
#pragma unroll
            for (int k = 0; k < 8; ++k) { const size_t item = (size_t)bh * 128 + c0 + k; hgS[item * 4096 + dv] = S; S = fmaf(gg[k], S, u[k]); }
        }
    }
}

__device__ void phase_hgrnC(KA ka, int layer, LAS unsigned char* lds) {
    PHASE_IDS
    const int tid = TID, lane = tid & 63, w = __builtin_amdgcn_readfirstlane(tid >> 6), gq = lane >> 4, lc = lane & 15;
    LAS bf16_t* QBb = (LAS bf16_t*)lds;
    LAS bf16_t* StB = QBb + 64 * 72;
    float* OT = (float*)(lds + 32768);
    const bf16_t* H = PF(H);
    const float* hgS = PF(hgS); const bf16_t* hgQB = PF(hgQB); const bf16_t* hgO = PF(hgO);
    const float* og = PF(out_gain) + layer * 1024;
    bf16_t* Y = PF(Y);
    for (int item = BID; item < 1024; item += gridDim.x) {
        const int c = item & 127, bh = item >> 7, h = bh & 3, b = bh >> 2;
        const size_t tok0 = (size_t)b * T_ + c * 64;
        __syncthreads();
#pragma unroll
        for (int i = 0; i < 8; ++i) {
            const int e = tid + i * NTHR, r = e >> 6, cc = e & 63;
            QBb[r * 72 + cc] = hgQB[(size_t)item * 4096 + e];
            StB[cc * 72 + r] = f2bf(hgS[(size_t)item * 4096 + e]);
        }
        __syncthreads();
#pragma unroll
        for (int q = 0; q < 2; ++q) {
            const int tile = w * 2 + q, rt_ = tile >> 2, ct = tile & 3;
            const LAS bf16_t* Ab = QBb + (16 * rt_ + lc) * 72 + 8 * gq;
            const LAS bf16_t* Bb = StB + (16 * ct + lc) * 72 + 8 * gq;
            f32x4 acc = zero4();
            acc = MFMA16(*(const LAS bf16x8*)Ab, *(const LAS bf16x8*)Bb, acc);
            acc = MFMA16(*(const LAS bf16x8*)(Ab + 32), *(const LAS bf16x8*)(Bb + 32), acc);
#pragma unroll
            for (int i = 0; i < 4; ++i) {
                const int t = 16 * rt_ + 4 * gq + i, v = 16 * ct + lc;
                OT[t * 65 + v] = acc[i] + bf2f(hgO[((size_t)item * 64 + t) * 64 + v]);
            }
        }
        __syncthreads();
#pragma unroll 1
        for (int i = 0; i < 8; ++i) {
            const int t = w + 8 * i, v = lane;
            const float acc = OT[t * 65 + v];
            const float ms = wave_sum(acc * acc) * (1.f / 64.f);
            const float hg = bf2f(H[(tok0 + t) * HLD + C_HG + h * 64 + v]);
            const float y = acc * rsqrtf(ms + 1e-6f) * og[768 + h * 64 + v] * (hg * sigmoidf_(hg));
            Y[(tok0 + t) * DM + 768 + h * 64 + v] = f2bf(y);
        }
    }
}

struct CmpOrder {
    static constexpr bool GATHER = false;
    const char* W1T; int c;
    __device__ __forceinline__ bool next(int i, pg8::Unit& u) const {
        if (i > 0 || c >= 16) return false;
        const int which = c >> 3, bh = (c >> 1) & 3, nt = c & 1;
        u.arow0 = (bh >> 1) * 512 + nt * 256; u.nrows = 256; u.pm = nt; u.pn = 0; u.e = which * 4 + bh; u.ui = 0;
        u.bptr = W1T + (size_t)which * 256 * 2048 * 2;
        return true;
    }
    __device__ __forceinline__ int arow(const pg8::Unit& u, int r) const { return u.arow0 + r; }
    __device__ __forceinline__ int lda(int) const { return 16 * HLD; }
    __device__ __forceinline__ unsigned kstepA() const { return (unsigned)(HLD * 2); }
    __device__ __forceinline__ const char* abase(const pg8::Unit& u, const char* A) const { return A + (((u.e >> 2) ? C_VC : C_KC) + (u.e & 1) * 64) * 2; }
};
struct EpiCmp {
    static constexpr bool PERM = true;
    bf16_t* G; const float* cbias;
    __device__ __forceinline__ void operator()(const f32x4 (&acc)[2][2][4][2], const pg8::Unit& u, int wr, int wc, int fr, int fq) const {
        const float* bp = cbias + (u.e >> 2) * 128 + wc * 32 + 8 * fq;
        const f32x4 b0 = *(const f32x4*)bp, b1 = *(const f32x4*)(bp + 4);
#pragma unroll
        for (int ai = 0; ai < 2; ++ai)
#pragma unroll
            for (int m = 0; m < 4; ++m) {
                const int r = ai * 128 + wr * 64 + m * 16 + fr;
                bf16_t* rowp = G + ((size_t)(u.e * 512 + u.pm * 256 + r)) * 128 + wc * 32 + 8 * fq;
                const f32x4 v0 = acc[ai][0][m][0] + b0, v1 = acc[ai][0][m][1] + b1;
                u32x4 w; w.x = pk2(gelu_slow(v0[0]), gelu_slow(v0[1])); w.y = pk2(gelu_slow(v0[2]), gelu_slow(v0[3])); w.z = pk2(gelu_slow(v1[0]), gelu_slow(v1[1])); w.w = pk2(gelu_slow(v1[2]), gelu_slow(v1[3]));
                *(u32x4*)rowp = w;
            }
    }
};
__device__ void phase_compress2(KA ka, int layer, LAS unsigned char* lds) {
    const int bid = opaque_bid();
    if (bid >= 16) return;
    CmpOrder S{(const char*)(PF(WT) + WT_C1), bid};
    EpiCmp E{(PF(gb) + layer * ((size_t)8 * 512 * 128)), (PF(cbias) + layer * (256))};
    pg8::gemm_phase<EpiCmp, CmpOrder>(lds, (const char*)PF(H), 2048, S, E);
    __syncthreads();
    const int tid = opaque_tid();
    const int which = bid >> 3, bh = (bid >> 1) & 3, nt = bid & 1;
    float* w2s = (float*)lds;
    const float* w2 = PF(cmp_w2) + ((size_t)layer * 2 + which) * 128 * 64;
    for (int i = tid; i < 128 * 64; i += NTHR) w2s[i] = w2[i];
    __syncthreads();
    const int r = tid >> 1, half = tid & 1;
    const bf16_t* grow = (PF(gb) + layer * ((size_t)8 * 512 * 128)) + ((size_t)((which * 4 + bh) * 512 + nt * 256 + r)) * 128;
    float acc[32];
#pragma unroll
    for (int j = 0; j < 32; ++j) acc[j] = 0.f;
    for (int c8 = 0; c8 < 16; ++c8) {
        const u32x4 gu = *(const u32x4*)(grow + c8 * 8);
        const unsigned gw[4] = {gu.x, gu.y, gu.z, gu.w};
#pragma unroll
        for (int e = 0; e < 8; ++e) {
            const float gv = (e & 1) ? __uint_as_float(gw[e >> 1] & 0xffff0000u) : __uint_as_float(gw[e >> 1] << 16);
            const float* wrow = w2s + (c8 * 8 + e) * 64 + half * 32;
#pragma unroll
            for (int j4 = 0; j4 < 8; ++j4) {
                const float4 w4 = *(const float4*)(wrow + j4 * 4);
                acc[j4 * 4 + 0] = fmaf(gv, w4.x, acc[j4 * 4 + 0]); acc[j4 * 4 + 1] = fmaf(gv, w4.y, acc[j4 * 4 + 1]);
                acc[j4 * 4 + 2] = fmaf(gv, w4.z, acc[j4 * 4 + 2]); acc[j4 * 4 + 3] = fmaf(gv, w4.w, acc[j4 * 4 + 3]);
            }
        }
    }
    const int n = nt * 256 + r;
    if (which == 0) {
        bf16_t* o = (PF(kcb) + layer * ((size_t)4 * 512 * 64)) + ((size_t)bh * 512 + n) * 64 + half * 32;
#pragma unroll
        for (int j = 0; j < 32; j += 2) *(unsigned*)(o + j) = pk2(acc[j], acc[j + 1]);
    } else {
        bf16_t* o = (PF(vcT) + layer * ((size_t)4 * 64 * 512)) + (size_t)bh * 64 * 512 + n;
#pragma unroll
        for (int j = 0; j < 32; ++j) o[(size_t)(half * 32 + j) * 512] = f2bf(acc[j]);
    }
    __syncthreads();
}

__device__ void phase_gmlp2(KA ka, int layer, LAS unsigned char* lds, int first, int nblk) {
    PHASE_IDS
    const int tid = TID, lane = tid & 63, w = __builtin_amdgcn_readfirstlane(tid >> 6), gq = lane >> 4, lc = lane & 15;
    LAS bf16_t* Vt = (LAS bf16_t*)lds;
    const float* gain = PF(gm_v_gain) + layer * 256;
    const float* bias = PF(gm_v_bias) + layer * 256;
    const float* bs = PF(gm_b_s) + layer * 4 * 128;
    const bf16_t* gmW = PF(WT) + WT_GM;
    const bf16_t* H = PF(H);
    bf16_t* Y = PF(Y);
    if (BID < first) return;
    for (int it = BID - first; it < 1536; it += nblk) {
        if (it < 1024) continue;
        const int item = it - 1024;
        const int g = item & 3, c = (item >> 2) & 63, b = item >> 8;
        const size_t tok0 = (size_t)b * T_ + (size_t)c * 128;
        __syncthreads();
#pragma unroll 4
        for (int i = 0; i < 16; ++i) {
            const int s = w * 16 + i;
            const float x = bf2f(H[(tok0 + s) * HLD + C_GV + g * 64 + lane]);
            const float ge = gelu_t(x);
            const float mu = wave_sum(ge) * (1.f / 64.f);
            const float dl = ge - mu;
            const float var = wave_sum(dl * dl) * (1.f / 64.f);
            Vt[lane * 136 + s] = f2bf(dl * rsqrtf(var + 1e-5f) * gain[g * 64 + lane] + bias[g * 64 + lane]);
        }
        __syncthreads();
        f32x4 acc[4];
#pragma unroll
        for (int ct = 0; ct < 4; ++ct) acc[ct] = zero4();
        const bf16_t* wrow = gmW + ((size_t)g * 128 + 16 * w + lc) * 128 + 8 * gq;
        const int kmax = (16 * w + 15) >> 5;
        for (int ks = 0; ks <= kmax; ++ks) {
            const bf16x8 a = *(const bf16x8*)(wrow + 32 * ks);
#pragma unroll
            for (int ct = 0; ct < 4; ++ct) {
                const bf16x8 bfr = *(const LAS bf16x8*)(Vt + (16 * ct + lc) * 136 + 32 * ks + 8 * gq);
                acc[ct] = MFMA16(a, bfr, acc[ct]);
            }
        }
        const float* ogain = PF(out_gain) + layer * 1024;
#pragma unroll
        for (int i = 0; i < 4; ++i) {
            const int t = 16 * w + 4 * gq + i;
            float yv[4];
            float ss = 0.f;
#pragma unroll
            for (int ct = 0; ct < 4; ++ct) {
                const int d = 16 * ct + lc;
                const float z = acc[ct][i] + bs[g * 128 + t];
                const float u = gelu_t(bf2f(H[(tok0 + t) * HLD + C_GU + g * 64 + d]));
                yv[ct] = u * z;
                ss += yv[ct] * yv[ct];
            }
            ss += __shfl_xor(ss, 1); ss += __shfl_xor(ss, 2); ss += __shfl_xor(ss, 4); ss += __shfl_xor(ss, 8);
            const float rn = rsqrtf(ss * (1.f / 64.f) + 1e-6f);
#pragma unroll
            for (int ct = 0; ct < 4; ++ct) {
                const int d = 16 * ct + lc;
                Y[(tok0 + t) * DM + g * 64 + d] = f2bf(yv[ct] * rn * ogain[g * 64 + d]);
            }
        }
    }
}

#ifndef ONLY_Q
#define ONLY_Q -2
#endif
#ifndef QMASK
#define QMASK 0x3ff
#endif
#define QON(k) ((ONLY_Q == -2 && ((QMASK >> ((k) + 1)) & 1)) || ONLY_Q == (k))
#ifndef DUPMASK
#define DUPMASK 0
#endif
#define DUP(k) ((DUPMASK >> (k)) & 1)
#ifndef PROF_LO
#define PROF_LO -1
#endif
#ifndef PROF_HI
#define PROF_HI -1
#endif
#ifndef WS_PROBE_PAD
#define WS_PROBE_PAD 0
#endif
#ifndef NPH_TOTAL
#define NPH_TOTAL 19
#endif
__global__ void __launch_bounds__(NTHR, 2) k_mega(P p0) {
    extern __shared__ __attribute__((aligned(16))) unsigned char lds_raw[];
    LAS unsigned char* lds = (LAS unsigned char*)lds_raw;
    float* smem = (float*)lds_raw;
    volatile LAS unsigned* misc = (volatile LAS unsigned*)(lds + LDS_MISC);
    if (threadIdx.x < 16) misc[threadIdx.x] = 0u;
    if ((threadIdx.x & 63) == 0) *(LAS int*)(lds + LDS_WTAB + 4 * hw_slot()) = (int)(threadIdx.x >> 6);
    __syncthreads();
    XcdBarrier bar = xcd_barrier_post(p0.ctl + CW_BAR, misc);
    if (PROF_LO >= 0 && blockIdx.x == 0 && threadIdx.x == 0) ((unsigned long long*)(p0.ctl + 8192))[0] = __builtin_amdgcn_s_memrealtime();
#pragma unroll 1
    for (int ph = 0; ph < p0.nph; ph++) {
        const int layer = ph == 0 ? 0 : (ph - 1) / 9, q = ph == 0 ? -1 : (ph - 1) % 9;
        const int dupm = p0.pad;
#if defined(__HIP_DEVICE_COMPILE__)
        KA ka = (KA)__builtin_amdgcn_kernarg_segment_ptr();
        asm volatile("" : "+s"(ka));
#else
        KA ka = nullptr;
#endif
        const float* xin = layer == 0 ? PF(x) : PF(out);
        float* x1 = PF(out);
        if (q == -1 && QON(-1)) { for (int r = 0; r <= ((dupm >> 15) & 1); ++r) { phase_prologue(ka, 0, smem); __syncthreads(); } }
        else if (q == 0 && QON(0)) { for (int r = 0; r <= (dupm & 1); ++r) { phase_inproj(ka, layer, lds); __syncthreads(); } }
        else if (q == 1 && QON(1)) {
            const int nb1 = (int)gridDim.x > 32 ? 16 : 0, nwork = (int)gridDim.x - nb1;
            for (int r = 0; r <= ((dupm >> 12) & 1); ++r) { phase_compress2(ka, layer, lds); __syncthreads(); }
            for (int r = 0; r <= ((dupm >> 10) & 1); ++r) { phase_hgrnA(ka, layer, lds, nb1, nwork); __syncthreads(); }
            for (int r = 0; r <= ((dupm >> 11) & 1); ++r) { phase_gmlp2(ka, layer, lds, nb1, nwork); __syncthreads(); }
            for (int r = 0; r <= ((dupm >> 13) & 1); ++r) { phase_vtrans(ka, smem); __syncthreads(); }
        }
        else if (q == 2 && QON(2)) { for (int r = 0; r <= ((dupm >> 14) & 1); ++r) { phase_hgrnB(ka, layer); __syncthreads(); } for (int r = 0; r <= ((dupm >> 2) & 1); ++r) { phase_nsa2(ka, layer, lds); __syncthreads(); } }
        else if (q == 3 && QON(3)) { for (int r = 0; r <= ((dupm >> 3) & 1); ++r) { phase_hgrnC(ka, layer, lds); __syncthreads(); } }
        else if (q == 4 && QON(4)) phase_outproj(ka, layer, xin, x1, lds);
        else if (q == 5 && QON(5)) { for (int r = ((dupm >> 5) & 1); r >= 0; --r) { phase_ln1_route(ka, layer, x1, smem, r == 1); __syncthreads(); } }
        else if (q == 6 && QON(6)) { for (int r = 0; r <= ((dupm >> 6) & 1); ++r) { phase_moe_up(ka, layer, lds); __syncthreads(); } }
        else if (q == 7 && QON(7)) { for (int r = 0; r <= ((dupm >> 7) & 1); ++r) { phase_moe_down(ka, layer, lds); __syncthreads(); } }
        else if (q == 8 && QON(8)) { phase_ln2(ka, layer, x1, PF(out)); if (layer == 0) { __syncthreads(); phase_prologue(ka, 1, smem); } }
        if (ph != NPH_TOTAL - 1 || PROF_LO >= 0) xcd_barrier(bar);
        if (PROF_LO >= 0 && blockIdx.x == 0 && threadIdx.x == 0) ((unsigned long long*)(p0.ctl + 8192))[ph + 1] = __builtin_amdgcn_s_memrealtime();
    }
    if (PROF_LO >= 0) {
        xcd_barrier(bar);
        const unsigned long long* ts = (const unsigned long long*)(p0.ctl + 8192);
        const unsigned long long t0 = __hip_atomic_load(&ts[PROF_LO], __ATOMIC_RELAXED, __HIP_MEMORY_SCOPE_AGENT), t1 = __hip_atomic_load(&ts[PROF_HI + 1], __ATOMIC_RELAXED, __HIP_MEMORY_SCOPE_AGENT);
        const float fac = 1.f + 1e-5f * (float)(t1 - t0);
        for (size_t i = (size_t)blockIdx.x * NTHR + threadIdx.x; i < (size_t)NTOK * DM; i += (size_t)gridDim.x * NTHR) p0.out[i] *= fac;
    }
}

static inline size_t align_up(size_t v, size_t a) { return (v + a - 1) / a * a; }

extern "C" void kernel_launch(void* const* d_in, const int* in_sizes, int n_in, void* d_out, int out_size, void* d_ws,
                              size_t ws_size, hipStream_t stream) {
    P p{};
    p.x = (const float*)d_in[0]; p.w_in = (const float*)d_in[1]; p.gm_v_gain = (const float*)d_in[2];
    p.gm_v_bias = (const float*)d_in[3]; p.gm_w_s = (const float*)d_in[4]; p.gm_b_s = (const float*)d_in[5];
    p.cmp_pos = (const float*)d_in[6]; p.cmp_w1 = (const float*)d_in[7]; p.cmp_w2 = (const float*)d_in[8];
    p.nsa_gate_b = (const float*)d_in[9]; p.hg_lower = (const float*)d_in[10]; p.out_gain = (const float*)d_in[11];
    p.w_out = (const float*)d_in[12]; p.ln1_g = (const float*)d_in[13]; p.ln1_b = (const float*)d_in[14];
    p.rg_w = (const float*)d_in[15]; p.rg_b = (const float*)d_in[16]; p.re_w = (const float*)d_in[17];
    p.re_b = (const float*)d_in[18]; p.w_gate = (const float*)d_in[19]; p.w_up = (const float*)d_in[20];
    p.w_down = (const float*)d_in[21]; p.ln2_g = (const float*)d_in[22]; p.ln2_b = (const float*)d_in[23];
    p.out = (float*)d_out;
    char* ws = (char*)d_ws;
    size_t off = 0;
    p.ctl = (unsigned*)(ws + off); off = align_up(off + CTL_BYTES, 256);
    p.WT = (bf16_t*)(ws + off); off = align_up(off + WT_LAYER * 2, 256);
    p.H = (bf16_t*)(ws + off); off = align_up(off + (size_t)(NTOK + 64) * HLD * 2, 256);
    p.Y = (bf16_t*)(ws + off); off = align_up(off + (size_t)NTOK * DM * 2, 256);
    p.XB = (bf16_t*)(ws + off); off = align_up(off + (size_t)NTOK * DM * 2, 256);
    p.kcb = (bf16_t*)(ws + off); off = align_up(off + 2 * ((size_t)4 * 512 * 64 * 2), 256);
    p.vcT = (bf16_t*)(ws + off); off = align_up(off + 2 * ((size_t)4 * 64 * 512 * 2), 256);
    p.vsT = (bf16_t*)(ws + off); off = align_up(off + (size_t)4 * 64 * T_ * 2, 256);
    p.vwT = (bf16_t*)(ws + off); off = align_up(off + (size_t)4 * 64 * T_ * 2, 256);
    p.gb = (bf16_t*)(ws + off); off = align_up(off + 2 * ((size_t)8 * 512 * 128 * 2), 256);
    p.cbias = (float*)(ws + off); off = align_up(off + 2 * (256 * 4), 256);
    p.wrt = (float*)(ws + off); off = align_up(off + 2 * (20 * 1024 * 4), 256);
    p.list_tok = (int*)(ws + off); off = align_up(off + 2 * ((size_t)16 * NTOK * 4), 256);
    p.list_w = (float*)(ws + off); off = align_up(off + 2 * ((size_t)16 * NTOK * 4), 256);
    p.tok_slot = (int*)(ws + off); off = align_up(off + 2 * ((size_t)NTOK * 2 * 4), 256);
    p.hgU = (float*)(ws + off); off = align_up(off + (size_t)1024 * 4096 * 4, 256);
    p.hgS = (float*)(ws + off); off = align_up(off + (size_t)1024 * 4096 * 4, 256);
    p.hgG = (float*)(ws + off); off = align_up(off + 2 * ((size_t)1024 * 64 * 4), 256);
    p.hgQB = (bf16_t*)(ws + off); off = align_up(off + (size_t)1024 * 4096 * 2, 256);
    p.hgO = (bf16_t*)(ws + off); off = align_up(off + (size_t)1024 * 4096 * 2, 256);
    p.nph = NPH_TOTAL; p.pad = DUPMASK;
    (void)in_sizes; (void)n_in; (void)out_size;
    static int grid_blocks = 0;
    if (!grid_blocks) {
        int dev = 0, cus = 0, per_cu = 0;
        (void)hipGetDevice(&dev);
        (void)hipDeviceGetAttribute(&cus, hipDeviceAttributeMultiprocessorCount, dev);
        if (hipFuncSetAttribute((const void*)k_mega, hipFuncAttributeMaxDynamicSharedMemorySize, LDS_BYTES) != hipSuccess) { fprintf(stderr, "hipFuncSetAttribute failed\n"); grid_blocks = -1; return; }
        if (hipOccupancyMaxActiveBlocksPerMultiprocessor(&per_cu, (const void*)k_mega, NTHR, LDS_BYTES) != hipSuccess || per_cu < 1) { fprintf(stderr, "occupancy query says %d\n", per_cu); }
        (void)hipGetLastError();
        grid_blocks = cus;
        off += (size_t)WS_PROBE_PAD;
        if (off > ws_size) { fprintf(stderr, "workspace too small: need %zu have %zu\n", off, ws_size); grid_blocks = -1; }
    }
    if (grid_blocks < 0) return;
    (void)hipMemsetAsync(p.ctl, 0, CTL_BYTES, stream);
    void* args[] = {&p};
    hipError_t e = hipLaunchCooperativeKernel((const void*)k_mega, dim3(grid_blocks), dim3(NTHR), args, LDS_BYTES, stream);
    if (e != hipSuccess) fprintf(stderr, "cooperative launch failed: %s (grid %d)\n", hipGetErrorString(e), grid_blocks);
}
```

```cpp
#include <hip/hip_runtime.h>
#include <cstdio>
#include <cstdint>

#define LAS __attribute__((address_space(3)))
typedef unsigned short bf16_t;
typedef short bf16x8 __attribute__((ext_vector_type(8)));
typedef float f32x4 __attribute__((ext_vector_type(4)));
typedef float f32x2 __attribute__((ext_vector_type(2)));
typedef unsigned u32x4 __attribute__((ext_vector_type(4)));
typedef unsigned u32x2 __attribute__((ext_vector_type(2)));

constexpr int NW = 8;
constexpr int NTHR = NW * 64;
constexpr int T_ = 8192;
constexpr int NTOK = 16384;
constexpr int DM = 1024;
constexpr int IC_SRC = 2840;
constexpr int HLD = 3072;
constexpr int C_GU = 0, C_GV = 256, C_NQ = 512, C_KC = 1024, C_VC = 1152, C_KS = 1280, C_VS = 1408,
              C_KW = 1536, C_VW = 1664, C_HQ = 1792, C_HF = 2048, C_HI = 2304, C_HG = 2560, C_NG = 2816;
constexpr int NCMP = 511;
constexpr float ALPHA = 1.4142135623730951f;
constexpr float NEG_INF = -1e30f;

constexpr size_t WT_IN = 0;
constexpr size_t WT_OUT = WT_IN + (size_t)3072 * 1024;
constexpr size_t WT_UP = WT_OUT + (size_t)1024 * 1024;
constexpr size_t WT_DN = WT_UP + (size_t)16 * 1024 * 1024;
constexpr size_t WT_C1 = WT_DN + (size_t)16 * 1024 * 512;
constexpr size_t WT_GM = WT_C1 + (size_t)2 * 256 * 2048;
constexpr size_t WT_LAYER = WT_GM + (size_t)4 * 128 * 128;

constexpr int LDS_STAGE = 131072;
constexpr int LDS_MISC = LDS_STAGE;
constexpr int LDS_BYTES = 147456;

constexpr int CW_BAR = 0;
constexpr int CW_CNT = 4096;
constexpr size_t CTL_BYTES = 65536;

struct P {
    const float* x; const float* w_in; const float* gm_v_gain; const float* gm_v_bias; const float* gm_w_s;
    const float* gm_b_s; const float* cmp_pos; const float* cmp_w1; const float* cmp_w2; const float* nsa_gate_b;
    const float* hg_lower; const float* out_gain; const float* w_out; const float* ln1_g; const float* ln1_b;
    const float* rg_w; const float* rg_b; const float* re_w; const float* re_b; const float* w_gate;
    const float* w_up; const float* w_down; const float* ln2_g; const float* ln2_b;
    float* out;
    unsigned* ctl;
    bf16_t* WT;
    bf16_t* H;
    bf16_t* Y;
    bf16_t* XB;
    bf16_t* kcb;
    bf16_t* vcT;
    bf16_t* vsT;
    bf16_t* vwT;
    bf16_t* gb;
    float* cbias;
    float* wrt;
    int* list_tok;
    float* list_w;
    int* tok_slot;
    float* hgU; float* hgG; float* hgS; bf16_t* hgQB; bf16_t* hgO;
    int nph; int pad;
};


typedef const __attribute__((address_space(4))) char* KA;
template <class T> __device__ __forceinline__ T ldarg(KA ka, size_t off) { return *(const __attribute__((address_space(4))) T*)(ka + off); }
#define PF(f) ldarg<decltype(P::f)>(ka, offsetof(P, f))

__device__ __forceinline__ float bf2f(bf16_t u) { return __uint_as_float(((unsigned)u) << 16); }
typedef __bf16 bf16x2_t __attribute__((ext_vector_type(2)));
__device__ __forceinline__ unsigned pk2(float lo, float hi) { f32x2 v; v.x = lo; v.y = hi; return __builtin_bit_cast(unsigned, __builtin_convertvector(v, bf16x2_t)); }
__device__ __forceinline__ bf16_t f2bf(float f) { return (bf16_t)(pk2(f, 0.f) & 0xffffu); }
__device__ __forceinline__ float gelu_t(float x) {
    const float u2 = -2.f * 0.7978845608028654f * (x + 0.044715f * x * x * x);
    return x / (1.f + __expf(u2));
}
__device__ __forceinline__ float gelu_slow(float x) {
    float u = 0.7978845608028654f * (x + 0.044715f * x * x * x);
    return 0.5f * x * (1.f + tanhf(u));
}
__device__ __forceinline__ float sigmoidf_(float x) { return 1.f / (1.f + __expf(-x)); }
__device__ __forceinline__ float wave_max(float v) {
#pragma unroll
    for (int o = 32; o > 0; o >>= 1) v = fmaxf(v, __shfl_xor(v, o));
    return v;
}
__device__ __forceinline__ float wave_sum(float v) {
#pragma unroll
    for (int o = 32; o > 0; o >>= 1) v += __shfl_xor(v, o);
    return v;
}
__device__ __forceinline__ void wave_sync() {
    __builtin_amdgcn_fence(__ATOMIC_RELEASE, "wavefront");
    __builtin_amdgcn_wave_barrier();
    __builtin_amdgcn_fence(__ATOMIC_ACQUIRE, "wavefront");
}
__device__ __forceinline__ f32x4 zero4() { f32x4 z = {0.f, 0.f, 0.f, 0.f}; asm volatile("" : "+v"(z)); return z; }
constexpr int LDS_WTAB = LDS_MISC + 12288;
__device__ __forceinline__ int hw_slot() { return (int)(__builtin_amdgcn_s_getreg((5 << 11) | 4) & 63u); }
__device__ __forceinline__ int opaque_tid() {
    extern __shared__ __attribute__((aligned(16))) unsigned char lds_raw_[];
    const int wv = __builtin_amdgcn_readfirstlane(*(volatile LAS int*)((LAS unsigned char*)lds_raw_ + LDS_WTAB + 4 * hw_slot()));
    int t = wv * 64 + (int)__builtin_amdgcn_mbcnt_hi(~0u, __builtin_amdgcn_mbcnt_lo(~0u, 0u));
    asm volatile("" : "+v"(t));
    return t;
}
__device__ __forceinline__ int opaque_bid() { int b = blockIdx.x; asm volatile("" : "+s"(b)); return b; }
#define PHASE_IDS const int TID = opaque_tid(); const int BID = opaque_bid(); (void)TID; (void)BID;

#define XB_TMO      128
#define XB_XCNT(j)  (256  + 64 * (j))
#define XB_XSUB(j)  (1280 + 64 * (j))
#define XB_XGEN(j)  (2304 + 64 * (j))
#define XB_TOP      3328
#define XB_TOPGEN   3392
#define XCD_BAR_WORDS 3456
#define XB_SPIN_CAP (1u << 22)
__device__ __forceinline__ unsigned xb_ld(unsigned* p)              { return __hip_atomic_load(p, __ATOMIC_RELAXED, __HIP_MEMORY_SCOPE_AGENT); }
__device__ __forceinline__ unsigned xb_add(unsigned* p, unsigned v) { return __hip_atomic_fetch_add(p, v, __ATOMIC_RELAXED, __HIP_MEMORY_SCOPE_AGENT); }
__device__ __forceinline__ unsigned xb_xcc_id() { return (unsigned)__builtin_amdgcn_s_getreg((3 << 11) | 20) & 0xFu; }
#define XB_SPIN(cond, bar) do { unsigned _sp = 0; while (cond) { __builtin_amdgcn_s_sleep(1); \
    if ((++_sp & 255u) == 0u) { if (xb_ld(&(bar)[XB_TMO])) break; if (_sp > XB_SPIN_CAP) { atomicAdd(&(bar)[XB_TMO], 1u); break; } } } } while (0)
struct XcdBarrier { unsigned* bar; unsigned x; volatile LAS unsigned* st; };
__device__ __forceinline__ XcdBarrier xcd_barrier_post(unsigned* bar, volatile LAS unsigned* st) {
    XcdBarrier b; b.bar = bar; b.x = xb_xcc_id(); b.st = st;
    if (threadIdx.x == 0) (void)xb_add(&bar[XB_XCNT(b.x)], 1u);
    return b;
}
__device__ __forceinline__ void xcd_barrier_complete(unsigned* bar, unsigned x, unsigned& nloc, unsigned& nx) {
    const unsigned G = gridDim.x * gridDim.y * gridDim.z;
    unsigned sum, cnt, mine, sp = 0u;
    for (;;) {
        sum = 0u; cnt = 0u; mine = 0u;
#pragma unroll
        for (unsigned j = 0; j < 16; ++j) { const unsigned c = xb_ld(&bar[XB_XCNT(j)]); sum += c; cnt += (c > 0u) ? 1u : 0u; mine = (j == x) ? c : mine; }
        if (sum == G) break;
        __builtin_amdgcn_s_sleep(1);
        if ((++sp & 255u) == 0u) { if (xb_ld(&bar[XB_TMO])) break; if (sp > XB_SPIN_CAP) { atomicAdd(&bar[XB_TMO], 1u); break; } }
    }
    nloc = mine > 0u ? mine : 1u; nx = cnt > 0u ? cnt : 1u;
}
__device__ __forceinline__ void xcd_barrier(const XcdBarrier& b) {
    asm volatile("s_waitcnt vmcnt(0)" ::: "memory");
    __syncthreads();
    if (opaque_tid() == 0) {
        unsigned* bar = b.bar;
        __builtin_amdgcn_s_waitcnt(0);
        unsigned nloc = b.st[0], nx = b.st[1];
        if (nloc == 0u) { xcd_barrier_complete(bar, b.x, nloc, nx); b.st[0] = nloc; b.st[1] = nx; }
        const unsigned old = xb_add(&bar[XB_XSUB(b.x)], 1u);
        const unsigned gen = old / nloc;
        if (old + 1u == (gen + 1u) * nloc) {
            __builtin_amdgcn_fence(__ATOMIC_RELEASE, "agent");
            asm volatile("s_waitcnt vmcnt(0)" ::: "memory");
            const unsigned og = xb_add(&bar[XB_TOP], 1u);
            const unsigned tg = og / nx;
            if (og + 1u == (tg + 1u) * nx) xb_add(&bar[XB_TOPGEN], 1u);
            else XB_SPIN(xb_ld(&bar[XB_TOPGEN]) == tg, bar);
            __builtin_amdgcn_fence(__ATOMIC_ACQUIRE, "agent");
            xb_add(&bar[XB_XGEN(b.x)], 1u);
            asm volatile("s_waitcnt vmcnt(0)" ::: "memory");
        } else {
            XB_SPIN(xb_ld(&bar[XB_XGEN(b.x)]) == gen, bar);
            __builtin_amdgcn_fence(__ATOMIC_ACQUIRE, "agent");
            asm volatile("s_waitcnt vmcnt(0)" ::: "memory");
        }
    }
    __syncthreads();
}

namespace pg8 {
constexpr int BM = 256, BK = 64, HALF = 128, HTB = HALF * BK * 2, STAGE_BYTES = 8 * HTB;
__host__ __device__ __forceinline__ int lds_byte(int r, int c) { const int st = (r >> 4) * 2 + (c >> 5), rr = r & 15, cc = c & 31, ob = rr * 64 + cc * 2; return st * 1024 + (ob ^ (((ob >> 9) & 1) << 5)); }
__host__ __device__ __forceinline__ void stage_rc(int b, int& R, int& C) { const int st = b / 1024, sb = b % 1024, swz = sb ^ (((sb >> 9) & 1) << 5); R = (st >> 1) * 16 + swz / 64; C = (st & 1) * 32 + (swz % 64) / 2; }
__host__ __device__ __forceinline__ int perm32(int rho) { const int n = rho >> 4, i = rho & 15; return 8 * (i >> 2) + 4 * n + (i & 3); }
__device__ __forceinline__ unsigned cvt_pk_bf16(float lo, float hi) { return pk2(lo, hi); }

struct Unit {
    const char* bptr;
    int arow0;
    int nrows;
    int pm, pn, e, ui;
};

template <class Epi, class Sched>
__device__ __forceinline__ void gemm_phase(LAS unsigned char* lds, const char* Abase, const int K, const Sched& S, const Epi& E) {
    const int tid = opaque_tid(), wid = __builtin_amdgcn_readfirstlane(tid >> 6), lane = tid & 63, wr = wid >> 2, wc = wid & 3, fr = lane & 15, fq = lane >> 4;
    const int nt = K / BK;
    int R0, C0, R1, C1; stage_rc(tid * 16, R0, C0); stage_rc(tid * 16 + 8192, R1, C1);
    unsigned voffB[2];
    { const int Rb0 = Epi::PERM ? ((R0 & ~31) + perm32(R0 & 31)) : R0, Rb1 = Epi::PERM ? ((R1 & ~31) + perm32(R1 & 31)) : R1;
      voffB[0] = (unsigned)(Rb0 * K + C0) * 2u; voffB[1] = (unsigned)(Rb1 * K + C1) * 2u; }
    const unsigned cA0 = (unsigned)C0 * 2u, cA1 = (unsigned)C1 * 2u;
    const int lda = S.lda(K);
    const unsigned kstepA = S.kstepA();
    const unsigned voffA0 = (unsigned)(R0 * lda + C0) * 2u, voffA1 = (unsigned)(R1 * lda + C1) * 2u;
    const unsigned kstep = (unsigned)(BK * 2);
    const unsigned hstep = (unsigned)(HALF * K * 2);
    const unsigned ldsw = (unsigned)wid * 1024u;
    const int aoff = lds_byte(wr * 64 + fr, fq * 8), boff = lds_byte(wc * 32 + fr, fq * 8);
#define PG8_SA(b, h) (((b) * 2 + (h)) * HTB)
#define PG8_SB(b, h) ((4 + (b) * 2 + (h)) * HTB)
#define PG8_STAGE_B(bufoff, gbase) do { \
        __builtin_amdgcn_global_load_lds((const unsigned*)((const char*)(gbase) + voffB[0]), (LAS unsigned*)(lds + (bufoff) + ldsw), 16, 0, 0); \
        __builtin_amdgcn_global_load_lds((const unsigned*)((const char*)(gbase) + voffB[1]), (LAS unsigned*)(lds + (bufoff) + ldsw + 8192), 16, 0, 0); } while (0)
#define PG8_STAGE_A(bufoff, gbase, pk) do { \
        const unsigned o0_ = Sched::GATHER ? (((pk) & 0xffffu) * (unsigned)lda * 2u + cA0) : voffA0; \
        const unsigned o1_ = Sched::GATHER ? (((pk) >> 16) * (unsigned)lda * 2u + cA1) : voffA1; \
        __builtin_amdgcn_global_load_lds((const unsigned*)((const char*)(gbase) + o0_), (LAS unsigned*)(lds + (bufoff) + ldsw), 16, 0, 0); \
        __builtin_amdgcn_global_load_lds((const unsigned*)((const char*)(gbase) + o1_), (LAS unsigned*)(lds + (bufoff) + ldsw + 8192), 16, 0, 0); } while (0)
#define PG8_LDA(dst, b, h) do { _Pragma("unroll") for (int m = 0; m < 4; ++m) _Pragma("unroll") for (int k = 0; k < 2; ++k) dst[m][k] = *(const LAS bf16x8*)(lds + PG8_SA(b, h) + aoff + m * 2048 + k * 1024); } while (0)
#define PG8_LDB(dst, b, h) do { _Pragma("unroll") for (int n = 0; n < 2; ++n) _Pragma("unroll") for (int k = 0; k < 2; ++k) dst[n][k] = *(const LAS bf16x8*)(lds + PG8_SB(b, h) + boff + n * 2048 + k * 1024); } while (0)
#define PG8_MMA(ai, bj, At, Bt) do { __builtin_amdgcn_s_setprio(1); _Pragma("unroll") for (int m = 0; m < 4; ++m) _Pragma("unroll") for (int n = 0; n < 2; ++n) _Pragma("unroll") for (int k = 0; k < 2; ++k) \
        acc[ai][bj][m][n] = __builtin_amdgcn_mfma_f32_16x16x32_bf16(Bt[n][k], At[m][k], acc[ai][bj][m][n], 0, 0, 0); __builtin_amdgcn_s_setprio(0); } while (0)
#define PG8_WAIT_V(n) asm volatile("s_waitcnt vmcnt(" #n ")" ::: "memory")
#define PG8_WAIT_L(n) asm volatile("s_waitcnt lgkmcnt(" #n ")" ::: "memory")
#define PG8_BAR __builtin_amdgcn_s_barrier()
#define PG8_SCHED __builtin_amdgcn_sched_barrier(0)
#define PG8_PACK(u, h) ((unsigned)S.arow((u), ((h) * 128 + R0) < (u).nrows ? ((h) * 128 + R0) : (u).nrows - 1) | ((unsigned)S.arow((u), ((h) * 128 + R1) < (u).nrows ? ((h) * 128 + R1) : (u).nrows - 1) << 16))
    Unit cur, nxt; int ui = 0;
    if (!S.next(0, cur)) return;
    f32x4 acc[2][2][4][2];
    const f32x4 zv = zero4();
#pragma unroll
    for (int a = 0; a < 2; ++a)
#pragma unroll
        for (int b = 0; b < 2; ++b)
#pragma unroll
            for (int m = 0; m < 4; ++m)
#pragma unroll
                for (int n = 0; n < 2; ++n) acc[a][b][m][n] = zv;
    bf16x8 At[4][2], B0[2][2], B1[2][2];
    unsigned pC0 = 0u, pC1 = 0u, pN0 = 0u, pN1 = 0u;
    if (Sched::GATHER) { pC0 = PG8_PACK(cur, 0); pC1 = PG8_PACK(cur, 1); }
    const char* cB = cur.bptr;
    const char* cA = Sched::GATHER ? Abase : S.abase(cur, Abase) + (size_t)cur.arow0 * lda * 2;
    const unsigned hA = Sched::GATHER ? 0u : (unsigned)(HALF * lda * 2);
    PG8_STAGE_B(PG8_SB(0, 0), cB); PG8_STAGE_B(PG8_SB(0, 1), cB + hstep); PG8_STAGE_A(PG8_SA(0, 0), cA, pC0); PG8_STAGE_A(PG8_SA(0, 1), cA + hA, pC1);
    if (wr == 1) PG8_BAR;
    PG8_WAIT_V(2); PG8_BAR;
    PG8_STAGE_B(PG8_SB(1, 0), cB + kstep); PG8_STAGE_A(PG8_SA(1, 0), cA + kstepA, pC0); PG8_STAGE_B(PG8_SB(1, 1), cB + hstep + kstep);
    PG8_WAIT_V(6); PG8_BAR;
    for (;;) {
        const bool has_next = S.next(ui + 1, nxt);
        if (Sched::GATHER) { if (has_next) { pN0 = PG8_PACK(nxt, 0); pN1 = PG8_PACK(nxt, 1); } else { pN0 = pC0; pN1 = pC1; } }
        const char* nB = has_next ? nxt.bptr : cB;
        const char* nA = (Sched::GATHER || !has_next) ? cA : S.abase(nxt, Abase) + (size_t)nxt.arow0 * lda * 2;
        for (int t = 0; t < nt; t += 2) {
            const bool last = (t == nt - 2);
            const char* a1 = cA + (unsigned)(t + 1) * kstepA;
            const char* a2 = last ? nA : cA + (unsigned)(t + 2) * kstepA; const char* b2 = last ? nB : cB + (unsigned)(t + 2) * kstep;
            const char* a3 = a2 + kstepA; const char* b3 = b2 + kstep;
            const unsigned s0 = last ? pN0 : pC0, s1 = last ? pN1 : pC1;
            PG8_LDB(B0, 0, 0); PG8_LDB(B1, 0, 1); PG8_SCHED; PG8_LDA(At, 0, 0); PG8_STAGE_A(PG8_SA(1, 1), a1 + hA, pC1);
            PG8_WAIT_V(8); PG8_WAIT_L(0); PG8_BAR; PG8_MMA(0, 0, At, B0); PG8_MMA(0, 1, At, B1); PG8_BAR; PG8_SCHED;
            PG8_LDA(At, 0, 1); PG8_STAGE_B(PG8_SB(0, 0), b2); PG8_STAGE_B(PG8_SB(0, 1), b2 + hstep); PG8_STAGE_A(PG8_SA(0, 0), a2, s0);
            PG8_WAIT_V(8); PG8_WAIT_L(0); PG8_BAR; PG8_MMA(1, 0, At, B0); PG8_MMA(1, 1, At, B1); PG8_BAR; PG8_SCHED;
            PG8_LDB(B0, 1, 0); PG8_LDB(B1, 1, 1); PG8_SCHED; PG8_LDA(At, 1, 0); PG8_STAGE_A(PG8_SA(0, 1), a2 + hA, s1);
            PG8_WAIT_V(8); PG8_WAIT_L(0); PG8_BAR; PG8_MMA(0, 0, At, B0); PG8_MMA(0, 1, At, B1); PG8_BAR; PG8_SCHED;
            PG8_LDA(At, 1, 1); PG8_STAGE_B(PG8_SB(1, 0), b3); PG8_STAGE_B(PG8_SB(1, 1), b3 + hstep); PG8_STAGE_A(PG8_SA(1, 0), a3, s0);
            PG8_WAIT_V(8); PG8_WAIT_L(0); PG8_BAR; PG8_MMA(1, 0, At, B0); PG8_MMA(1, 1, At, B1); PG8_BAR; PG8_SCHED;
        }
        if (wr == 0) PG8_BAR;
        E(acc, cur, wr, wc, fr, fq);
        if (!has_next) break;
#pragma unroll
        for (int a = 0; a < 2; ++a)
#pragma unroll
            for (int b = 0; b < 2; ++b)
#pragma unroll
                for (int m = 0; m < 4; ++m)
#pragma unroll
                    for (int n = 0; n < 2; ++n) acc[a][b][m][n] = zv;
        cur = nxt; cB = nB; cA = nA; ++ui;
        pC0 = pN0; pC1 = pN1;
        if (wr == 1) PG8_BAR;
    }
    PG8_WAIT_V(0);
    PG8_BAR;
#undef PG8_SA
#undef PG8_SB
#undef PG8_STAGE_A
#undef PG8_STAGE_B
#undef PG8_LDA
#undef PG8_LDB
#undef PG8_MMA
#undef PG8_WAIT_V
#undef PG8_WAIT_L
#undef PG8_BAR
#undef PG8_SCHED
#undef PG8_PACK
}

struct DenseOrder {
    static constexpr bool GATHER = false;
    int nM, nN, nwg, G, c; const char* Bt; int K;
    __device__ void init(int M, int N, int K_, const bf16_t* Bt_, int G_, int c_) { nM = M / BM; nN = N / BM; nwg = nM * nN; G = G_; c = c_; Bt = (const char*)Bt_; K = K_; }
    __device__ __forceinline__ bool next(int i, Unit& u) const {
        const long L = (long)i * G + c; if (L >= nwg) return false;
        int wgid = (int)L; { const int q = nwg / 8, r = nwg % 8, xcd = wgid % 8, off = wgid / 8; wgid = (xcd < r ? xcd * (q + 1) : r * (q + 1) + (xcd - r) * q) + off; }
        const int nig = 8 * nN, gid = wgid / nig, fm = gid * 8, gsz = (nM - fm) < 8 ? (nM - fm) : 8;
        u.pm = fm + ((wgid % nig) % gsz); u.pn = (wgid % nig) / gsz;
        u.arow0 = u.pm * BM; u.nrows = BM; u.e = 0; u.ui = i;
        u.bptr = Bt + (size_t)u.pn * BM * K * 2;
        return true;
    }
    __device__ __forceinline__ int arow(const Unit& u, int r) const { return u.arow0 + r; }
    __device__ __forceinline__ int lda(int K_) const { return K_; }
    __device__ __forceinline__ unsigned kstepA() const { return 128u; }
    __device__ __forceinline__ const char* abase(const Unit&, const char* A) const { return A; }
};
}

struct EpiH {
    static constexpr bool PERM = true;
    bf16_t* H;
    __device__ __forceinline__ void operator()(const f32x4 (&acc)[2][2][4][2], const pg8::Unit& u, int wr, int wc, int fr, int fq) const {
        const int row0 = u.arow0 + wr * 64 + fr, col0 = u.pn * 256 + wc * 32 + 8 * fq;
#pragma unroll
        for (int ai = 0; ai < 2; ++ai)
#pragma unroll
            for (int m = 0; m < 4; ++m) {
                bf16_t* rowp = H + (size_t)(row0 + ai * 128 + m * 16) * HLD + col0;
#pragma unroll
                for (int bj = 0; bj < 2; ++bj) {
                    const f32x4 v0 = acc[ai][bj][m][0], v1 = acc[ai][bj][m][1];
                    u32x4 w; w.x = pg8::cvt_pk_bf16(v0[0], v0[1]); w.y = pg8::cvt_pk_bf16(v0[2], v0[3]); w.z = pg8::cvt_pk_bf16(v1[0], v1[1]); w.w = pg8::cvt_pk_bf16(v1[2], v1[3]);
                    *(u32x4*)(rowp + bj * 128) = w;
                }
            }
    }
};
struct EpiRes {
    static constexpr bool PERM = false;
    const float* xin; float* out;
    __device__ __forceinline__ void operator()(const f32x4 (&acc)[2][2][4][2], const pg8::Unit& u, int wr, int wc, int fr, int fq) const {
        const int row0 = u.arow0 + wr * 64 + fr, col0 = u.pn * 256 + wc * 32 + 4 * fq;
#pragma unroll
        for (int ai = 0; ai < 2; ++ai)
#pragma unroll
            for (int m = 0; m < 4; ++m) {
                const size_t off = (size_t)(row0 + ai * 128 + m * 16) * DM + col0;
#pragma unroll
                for (int bj = 0; bj < 2; ++bj)
#pragma unroll
                    for (int n = 0; n < 2; ++n) {
                        const f32x4 xv = *(const f32x4*)(xin + off + bj * 128 + n * 16);
                        *(f32x4*)(out + off + bj * 128 + n * 16) = xv * ALPHA + acc[ai][bj][m][n];
                    }
            }
    }
};

template <class RM>
__device__ __forceinline__ void transpose_item(const float* W, int K, int N, bf16_t* WT, RM rowmap, float* scr, int kb, int nb, int lane) {
    const int k0 = 64 * kb, n0 = 32 * nb;
    const int nn = n0 + (lane & 31);
    float tmp[32];
#pragma unroll
    for (int i = 0; i < 32; ++i) {
        const int kk = 2 * i + (lane >> 5);
        tmp[i] = nn < N ? W[(size_t)(k0 + kk) * N + nn] : 0.f;
    }
#pragma unroll
    for (int i = 0; i < 32; ++i) {
        const int kk = 2 * i + (lane >> 5);
        scr[kk * 33 + (lane & 31)] = tmp[i];
    }
    wave_sync();
    const int c = lane & 7;
#pragma unroll
    for (int j = 0; j < 4; ++j) {
        const int n = (lane >> 3) + 8 * j;
        const float* s = scr + (8 * c) * 33 + n;
        u32x4 o; o.x = pk2(s[0 * 33], s[1 * 33]); o.y = pk2(s[2 * 33], s[3 * 33]); o.z = pk2(s[4 * 33], s[5 * 33]); o.w = pk2(s[6 * 33], s[7 * 33]);
        const int dr = (n0 + n < N) ? rowmap(n0 + n) : -1;
        if (dr >= 0) *(u32x4*)(WT + (size_t)dr * K + k0 + 8 * c) = o;
    }
    wave_sync();
}

__device__ void phase_prologue(KA ka, int layer, float* smem) {
    PHASE_IDS
    const int lane = TID & 63, w = TID >> 6;
    float* scr = smem + w * 4096;
    const int gw = BID * NW + w, NGW = gridDim.x * NW;
    constexpr int I_IN = 16 * 89, I_OUT = 16 * 32, I_GU = 16 * 16, I_DN = 8 * 32;
    constexpr int I_LAYER = I_IN + I_OUT + 32 * I_GU + 16 * I_DN;
    for (int it = gw; it < I_LAYER; it += NGW) {
        int r = it;
        bf16_t* WT = PF(WT);
        if (r < I_IN) {
            transpose_item(PF(w_in) + (size_t)layer * DM * IC_SRC, DM, IC_SRC, WT + WT_IN,
                           [](int n) { return n < 1792 ? n : (n < 1816 ? 2816 + (n - 1792) : n - 24); }, scr, r / 89, r % 89, lane);
            continue;
        }
        r -= I_IN;
        if (r < I_OUT) {
            transpose_item(PF(w_out) + (size_t)layer * DM * DM, DM, DM, WT + WT_OUT, [](int n) { return n; }, scr, r / 32, r % 32, lane);
            continue;
        }
        r -= I_OUT;
        if (r < 32 * I_GU) {
            const int mat = r / I_GU, rr = r % I_GU, e = mat >> 1, isup = mat & 1;
            const float* W = (isup ? PF(w_up) : PF(w_gate)) + ((size_t)layer * 16 + e) * DM * 512;
            transpose_item(W, DM, 512, WT + WT_UP + (size_t)e * 1024 * 1024,
                           [isup](int n) { return (n >> 7) * 256 + isup * 128 + (n & 127); }, scr, rr / 16, rr % 16, lane);
            continue;
        }
        r -= 32 * I_GU;
        {
            const int e = r / I_DN, rr = r % I_DN;
            transpose_item(PF(w_down) + ((size_t)layer * 16 + e) * 512 * DM, 512, DM, WT + WT_DN + (size_t)e * 1024 * 512,
                           [](int n) { return n; }, scr, rr / 32, rr % 32, lane);
        }
    }
    for (int it = gw; it < 2 * 32 * 4; it += NGW) {
        const int which = it >> 7, rr = it & 127;
        transpose_item(PF(cmp_w1) + ((size_t)layer * 2 + which) * 2048 * 128, 2048, 128, PF(WT) + WT_C1 + (size_t)which * 256 * 2048, [](int n) { return n; }, scr, rr >> 2, rr & 3, lane);
    }
    for (int i = BID * NTHR + TID; i < 2 * 128 * 256; i += gridDim.x * NTHR) {
        const int which = i >> 15, q = i & 32767;
        const u32x4 z = __builtin_bit_cast(u32x4, zero4());
        *(u32x4*)(PF(WT) + WT_C1 + (size_t)which * 256 * 2048 + (size_t)128 * 2048 + (size_t)q * 8) = z;
    }
    for (int o = gw; o < 256; o += NGW) {
        const int which = o >> 7, cc = o & 127;
        const float* w1 = PF(cmp_w1) + ((size_t)layer * 2 + which) * 2048 * 128;
        const float* pos = PF(cmp_pos) + ((size_t)layer * 2 + which) * 2048;
        float a = 0.f;
        for (int k = lane; k < 2048; k += 64) a = fmaf(pos[k], w1[(size_t)k * 128 + cc], a);
        a = wave_sum(a);
        if (lane == 0) (PF(cbias) + layer * (256))[o] = a;
    }
    for (int i = BID * NTHR + TID; i < 4 * 128 * 128; i += gridDim.x * NTHR) {
        const int s = i & 127, t = (i >> 7) & 127;
        PF(WT)[WT_GM + i] = (s <= t) ? f2bf(PF(gm_w_s)[(size_t)layer * 4 * 128 * 128 + i]) : (bf16_t)0;
    }
    for (int i = BID * NTHR + TID; i < 20 * 1024; i += gridDim.x * NTHR) {
        const int o = i >> 10, cc = i & 1023;
        (PF(wrt) + layer * (20480))[i] = o < 4 ? PF(rg_w)[((size_t)layer * 1024 + cc) * 4 + o] : PF(re_w)[((size_t)layer * 1024 + cc) * 16 + (o - 4)];
    }
    for (int i = BID * NTHR + TID; i < 232 * 128; i += gridDim.x * NTHR) {
        const int q = i;
        const u32x4 z = __builtin_bit_cast(u32x4, zero4());
        *(u32x4*)(PF(WT) + WT_IN + (size_t)2840 * 1024 + (size_t)q * 8) = z;
    }
    if (layer == 0)
    for (int row = gw; row < NTOK; row += NGW) {
        const f32x4* xr = (const f32x4*)(PF(x) + (size_t)row * DM) + lane;
        u32x2* o = (u32x2*)(PF(XB) + (size_t)row * DM) + lane;
#pragma unroll
        for (int j = 0; j < 4; ++j) {
            const f32x4 v = xr[64 * j];
            u32x2 ww; ww.x = pk2(v[0], v[1]); ww.y = pk2(v[2], v[3]);
            o[64 * j] = ww;
        }
    }
}

template <class AF, class BF, class EF>
__device__ __forceinline__ void gemm128(int tid, int m0, int n0, int M, int N, int K, AF af, BF bf, EF ef, float* smem) {
    float* As = smem;
    float* Bs = smem + 16 * 132;
    const bool active = tid < 256;
    const int tx = tid & 15, ty = (tid >> 4) & 15;
    float acc[8][8];
#pragma unroll
    for (int i = 0; i < 8; i++)
#pragma unroll
        for (int j = 0; j < 8; j++) acc[i][j] = 0.f;
#pragma unroll 1
    for (int k0 = 0; k0 < K; k0 += 16) {
        if (active) {
#pragma unroll
            for (int i = 0; i < 8; i++) {
                int e = tid + i * 256;
                int r = e >> 4, kk = e & 15;
                float v = 0.f;
                if (m0 + r < M) v = af(m0 + r, k0 + kk);
                As[kk * 132 + r] = v;
            }
#pragma unroll
            for (int i = 0; i < 8; i++) {
                int e = tid + i * 256;
                int kk = e >> 7, c = e & 127;
                float v = 0.f;
                if (n0 + c < N) v = bf(k0 + kk, n0 + c);
                Bs[kk * 132 + c] = v;
            }
        }
        __syncthreads();
        if (active) {
#pragma unroll 2
            for (int kk = 0; kk < 16; kk++) {
                asm volatile("" ::: "memory");
                float4 a0 = *(const float4*)&As[kk * 132 + ty * 8];
                float4 a1 = *(const float4*)&As[kk * 132 + ty * 8 + 4];
                float4 b0 = *(const float4*)&Bs[kk * 132 + tx * 8];
                float4 b1 = *(const float4*)&Bs[kk * 132 + tx * 8 + 4];
                float a[8] = {a0.x, a0.y, a0.z, a0.w, a1.x, a1.y, a1.z, a1.w};
                float b[8] = {b0.x, b0.y, b0.z, b0.w, b1.x, b1.y, b1.z, b1.w};
#pragma unroll
                for (int i = 0; i < 8; i++)
#pragma unroll
                    for (int j = 0; j < 8; j++) acc[i][j] = fmaf(a[i], b[j], acc[i][j]);
            }
        }
        __syncthreads();
    }
    if (active) {
#pragma unroll
        for (int i = 0; i < 8; i++)
#pragma unroll
            for (int j = 0; j < 8; j++) {
                int m = m0 + ty * 8 + i, n = n0 + tx * 8 + j;
                if (m < M && n < N) ef(m, n, acc[i][j]);
            }
    }
}

__device__ __forceinline__ void phase_inproj(KA ka, int layer, LAS unsigned char* lds) {
    pg8::DenseOrder S; S.init(NTOK, HLD, DM, PF(WT) + WT_IN, gridDim.x, opaque_bid());
    EpiH E{PF(H)};
    pg8::gemm_phase<EpiH, pg8::DenseOrder>(lds, (const char*)PF(XB), DM, S, E);
}
__device__ __forceinline__ void phase_outproj(KA ka, int layer, const float* xin, float* x1, LAS unsigned char* lds) {
    pg8::DenseOrder S; S.init(NTOK, DM, DM, PF(WT) + WT_OUT, gridDim.x, opaque_bid());
    EpiRes E{xin, x1};
    pg8::gemm_phase<EpiRes, pg8::DenseOrder>(lds, (const char*)PF(Y), DM, S, E);
}

__device__ void phase_ln1_route(KA ka, int layer, float* x1, float* smem, bool dry) {
    PHASE_IDS
    bf16_t* xb = PF(XB);
    float* x1o = dry ? (float*)PF(H) : x1;
    const int lane = TID & 63, w = TID >> 6;
    const float* g = PF(ln1_g) + layer * 1024;
    const float* bb = PF(ln1_b) + layer * 1024;
    const float* wg = PF(rg_w) + (size_t)layer * 1024 * 4;
    const float* we = PF(re_w) + (size_t)layer * 1024 * 16;
    const float* bg = PF(rg_b) + layer * 4;
    const float* be = PF(re_b) + layer * 16;
    int* cnt = (int*)(PF(ctl) + CW_CNT) + layer * 16 * 64 + (dry ? 2048 : 0);
    int* lcnt = (int*)(smem + 20 * 1024);
    int* rinfo = lcnt + 64;
    float* rwt = (float*)(rinfo + 4 * 128);
    if (TID < 32) lcnt[TID] = 0;
    float* WR = smem;
    __syncthreads();
    for (int idx = TID; idx < 20 * 256; idx += NTHR) *(f32x4*)(WR + 4 * idx) = *(const f32x4*)((PF(wrt) + layer * (20480)) + 4 * idx);
    __syncthreads();
    int nloc = 0;
    for (int row = BID * NW + w; row < NTOK; row += gridDim.x * NW) {
        f32x4 v[4];
        float s = 0.f;
#pragma unroll
        for (int j = 0; j < 4; ++j) { v[j] = *(const f32x4*)(x1 + (size_t)row * DM + 256 * j + 4 * lane); s += (v[j][0] + v[j][1]) + (v[j][2] + v[j][3]); }
        const float mu = wave_sum(s) * (1.f / 1024.f);
        float q = 0.f;
#pragma unroll
        for (int j = 0; j < 4; ++j) { v[j] = v[j] - mu; q += (v[j][0] * v[j][0] + v[j][1] * v[j][1]) + (v[j][2] * v[j][2] + v[j][3] * v[j][3]); }
        const float rstd = rsqrtf(wave_sum(q) * (1.f / 1024.f) + 1e-5f);
#pragma unroll
        for (int j = 0; j < 4; ++j) {
            const int c = 256 * j + 4 * lane;
            v[j] = v[j] * rstd * *(const f32x4*)(g + c) + *(const f32x4*)(bb + c);
            *(f32x4*)(x1o + (size_t)row * DM + c) = v[j];
            u32x2 pw; pw.x = pk2(v[j][0], v[j][1]); pw.y = pk2(v[j][2], v[j][3]);
            *(u32x2*)(xb + (size_t)row * DM + c) = pw;
        }
        float lg[4], le[16];
#pragma unroll
        for (int o = 0; o < 20; ++o) {
            asm volatile("" ::: "memory");
            float a = 0.f;
#pragma unroll
            for (int j = 0; j < 4; ++j) {
                const f32x4 w4 = *(const f32x4*)(WR + o * 1024 + 256 * j + 4 * lane);
                a += (v[j][0] * w4[0] + v[j][1] * w4[1]) + (v[j][2] * w4[2] + v[j][3] * w4[3]);
            }
            a = wave_sum(a);
            if (o < 4) lg[o] = a + bg[o]; else le[o - 4] = a + be[o - 4];
        }
        float gm = fmaxf(fmaxf(lg[0], lg[1]), fmaxf(lg[2], lg[3]));
        float ge[4], gs = 0.f;
#pragma unroll
        for (int c = 0; c < 4; c++) { ge[c] = __expf(lg[c] - gm); gs += ge[c]; }
        int gi = 0; float gbest = ge[0];
#pragma unroll
        for (int c = 1; c < 4; c++) if (ge[c] > gbest) { gbest = ge[c]; gi = c; }
        float gval = gbest / gs;
        float ls[4];
#pragma unroll
        for (int e = 0; e < 4; e++) ls[e] = gi == 0 ? le[e] : gi == 1 ? le[4 + e] : gi == 2 ? le[8 + e] : le[12 + e];
        float em = fmaxf(fmaxf(ls[0], ls[1]), fmaxf(ls[2], ls[3]));
        float pe[4];
#pragma unroll
        for (int e = 0; e < 4; e++) pe[e] = __expf(ls[e] - em);
        int i1 = 0; float b1 = pe[0];
#pragma unroll
        for (int e = 1; e < 4; e++) if (pe[e] > b1) { b1 = pe[e]; i1 = e; }
        int i2 = -1; float b2 = -1.f;
#pragma unroll
        for (int e = 0; e < 4; e++) if (e != i1 && pe[e] > b2) { b2 = pe[e]; i2 = e; }
        float w1 = gval * b1 / (b1 + b2), w2 = gval * b2 / (b1 + b2);
        if (lane == 0) {
            const int e1 = gi * 4 + i1, e2 = gi * 4 + i2;
            const int lr = nloc * NW + w;
            rinfo[lr * 4 + 0] = e1; rinfo[lr * 4 + 1] = atomicAdd(&lcnt[e1], 1);
            rinfo[lr * 4 + 2] = e2; rinfo[lr * 4 + 3] = atomicAdd(&lcnt[e2], 1);
            rwt[lr * 2 + 0] = w1; rwt[lr * 2 + 1] = w2;
        }
        ++nloc;
    }
    __syncthreads();
    if (TID < 16) lcnt[16 + TID] = lcnt[TID] > 0 ? atomicAdd(&cnt[TID * 64], lcnt[TID]) : 0;
    __syncthreads();
    {
        const int nrows_blk = (NTOK - BID * NW + (int)gridDim.x * NW - 1) / ((int)gridDim.x * NW) * NW;
        for (int lr = TID; lr < nrows_blk; lr += NTHR) {
            const int row = BID * NW + (lr % NW) + (lr / NW) * (int)gridDim.x * NW;
            if (row < NTOK) {
                const int e1 = rinfo[lr * 4 + 0], p1 = lcnt[16 + e1] + rinfo[lr * 4 + 1];
                const int e2 = rinfo[lr * 4 + 2], p2 = lcnt[16 + e2] + rinfo[lr * 4 + 3];
                (PF(list_tok) + layer * ((size_t)16 * NTOK))[e1 * NTOK + p1] = row; (PF(list_w) + layer * ((size_t)16 * NTOK))[e1 * NTOK + p1] = rwt[lr * 2 + 0];
                (PF(list_tok) + layer * ((size_t)16 * NTOK))[e2 * NTOK + p2] = row; (PF(list_w) + layer * ((size_t)16 * NTOK))[e2 * NTOK + p2] = rwt[lr * 2 + 1];
                (PF(tok_slot) + layer * ((size_t)NTOK * 2))[row * 2 + 0] = e1 * NTOK + p1; (PF(tok_slot) + layer * ((size_t)NTOK * 2))[row * 2 + 1] = e2 * NTOK + p2;
            }
        }
    }
    __syncthreads();
}


template <bool GATHER_>
struct MoeOrder {
    static constexpr bool GATHER = GATHER_;
    const LAS int* tab; const LAS int* rowtab;
    const char* Bt; unsigned estride; int K, G, c;
    __device__ __forceinline__ bool next(int i, pg8::Unit& u) const {
        const int nwg = __builtin_amdgcn_readfirstlane(tab[48]) * 4;
        const int L = i * G + c; if (L >= nwg) return false;
        int wgid = L; { const int q = nwg / 8, r = nwg % 8, xcd = wgid % 8, off = wgid / 8; wgid = (xcd < r ? xcd * (q + 1) : r * (q + 1) + (xcd - r) * q) + off; }
        const int mg = wgid >> 2, nt = wgid & 3;
        int e = 0;
#pragma unroll
        for (int k = 1; k < 16; ++k) e = (__builtin_amdgcn_readfirstlane(tab[32 + k]) <= mg) ? k : e;
        const int mt = mg - __builtin_amdgcn_readfirstlane(tab[32 + e]);
        const int rem = __builtin_amdgcn_readfirstlane(tab[e]) - mt * 256;
        u.e = e; u.pm = mt; u.pn = nt; u.ui = i; u.nrows = rem < 256 ? rem : 256; u.arow0 = __builtin_amdgcn_readfirstlane(tab[16 + e]) + mt * 256;
        u.bptr = Bt + (size_t)e * estride + (size_t)nt * 256 * K * 2;
        return true;
    }
    __device__ __forceinline__ int arow(const pg8::Unit& u, int r) const { return GATHER_ ? rowtab[u.ui * 256 + r] : u.arow0 + r; }
    __device__ __forceinline__ int lda(int K_) const { return K_; }
    __device__ __forceinline__ unsigned kstepA() const { return 128u; }
    __device__ __forceinline__ const char* abase(const pg8::Unit&, const char* A) const { return A; }
};
__device__ __forceinline__ void moe_tables(KA ka, int layer, LAS unsigned char* lds, bool want_rows, int G, int c) {
    LAS int* tab = (LAS int*)(lds + LDS_MISC + 256);
    LAS int* rowtab = (LAS int*)(lds + LDS_MISC + 1024);
    const int tid = opaque_tid();
    const int* cnt = (const int*)(PF(ctl) + CW_CNT) + layer * 16 * 64;
    if (tid < 16) tab[tid] = __hip_atomic_load(&cnt[tid * 64], __ATOMIC_RELAXED, __HIP_MEMORY_SCOPE_AGENT);
    __syncthreads();
    if (tid == 0) {
        int b = 0, m = 0;
        for (int e = 0; e < 16; ++e) { tab[16 + e] = b; tab[32 + e] = m; b += tab[e]; m += (tab[e] + 255) >> 8; }
        tab[48] = m;
    }
    __syncthreads();
    if (want_rows) {
        MoeOrder<true> S{tab, rowtab, nullptr, 0u, 1024, G, c};
        const int* lt = (PF(list_tok) + layer * ((size_t)16 * NTOK));
        for (int i = 0; i < 4; ++i) {
            pg8::Unit u;
            if (!S.next(i, u)) break;
            if (tid < 256) { const int r = tid < u.nrows ? tid : u.nrows - 1; rowtab[i * 256 + tid] = lt[u.e * NTOK + u.pm * 256 + r]; }
        }
        asm volatile("s_waitcnt vmcnt(0) lgkmcnt(0)" ::: "memory");
        __syncthreads();
    }
}
struct EpiUp {
    static constexpr bool PERM = true;
    bf16_t* hidden;
    __device__ __forceinline__ void operator()(const f32x4 (&acc)[2][2][4][2], const pg8::Unit& u, int wr, int wc, int fr, int fq) const {
#pragma unroll
        for (int ai = 0; ai < 2; ++ai)
#pragma unroll
            for (int m = 0; m < 4; ++m) {
                const int r = ai * 128 + wr * 64 + m * 16 + fr;
                if (r < u.nrows) {
                    bf16_t* rowp = hidden + (size_t)(u.arow0 + r) * 512 + u.pn * 128 + wc * 32 + 8 * fq;
                    float h[8];
#pragma unroll
                    for (int n = 0; n < 2; ++n)
#pragma unroll
                        for (int j = 0; j < 4; ++j) { const float g = acc[ai][0][m][n][j], uu = acc[ai][1][m][n][j]; h[n * 4 + j] = g * sigmoidf_(g) * uu; }
                    u32x4 w; w.x = pg8::cvt_pk_bf16(h[0], h[1]); w.y = pg8::cvt_pk_bf16(h[2], h[3]); w.z = pg8::cvt_pk_bf16(h[4], h[5]); w.w = pg8::cvt_pk_bf16(h[6], h[7]);
                    *(u32x4*)rowp = w;
                }
            }
    }
};
struct EpiDown {
    static constexpr bool PERM = true;
    bf16_t* Y2; const float* lw;
    __device__ __forceinline__ void operator()(const f32x4 (&acc)[2][2][4][2], const pg8::Unit& u, int wr, int wc, int fr, int fq) const {
#pragma unroll
        for (int ai = 0; ai < 2; ++ai)
#pragma unroll
            for (int m = 0; m < 4; ++m) {
                const int r = ai * 128 + wr * 64 + m * 16 + fr;
                if (r < u.nrows) {
                    const float wgt = lw[u.e * NTOK + u.pm * 256 + r];
                    bf16_t* rowp = Y2 + (size_t)(u.arow0 + r) * DM + u.pn * 256 + wc * 32 + 8 * fq;
#pragma unroll
                    for (int bj = 0; bj < 2; ++bj) {
                        const f32x4 v0 = acc[ai][bj][m][0] * wgt, v1 = acc[ai][bj][m][1] * wgt;
                        u32x4 w; w.x = pg8::cvt_pk_bf16(v0[0], v0[1]); w.y = pg8::cvt_pk_bf16(v0[2], v0[3]); w.z = pg8::cvt_pk_bf16(v1[0], v1[1]); w.w = pg8::cvt_pk_bf16(v1[2], v1[3]);
                        *(u32x4*)(rowp + bj * 128) = w;
                    }
                }
            }
    }
};
__device__ __forceinline__ void phase_moe_up(KA ka, int layer, LAS unsigned char* lds) {
    moe_tables(ka, layer, lds, true, gridDim.x, opaque_bid());
    MoeOrder<true> S{(const LAS int*)(lds + LDS_MISC + 256), (const LAS int*)(lds + LDS_MISC + 1024),
                     (const char*)(PF(WT) + WT_UP), (unsigned)(1024u * 1024u * 2u), 1024, (int)gridDim.x, opaque_bid()};
    EpiUp E{PF(Y)};
    pg8::gemm_phase<EpiUp, MoeOrder<true>>(lds, (const char*)PF(XB), 1024, S, E);
}
__device__ __forceinline__ void phase_moe_down(KA ka, int layer, LAS unsigned char* lds) {
    moe_tables(ka, layer, lds, false, gridDim.x, opaque_bid());
    MoeOrder<false> S{(const LAS int*)(lds + LDS_MISC + 256), (const LAS int*)(lds + LDS_MISC + 1024),
                      (const char*)(PF(WT) + WT_DN), (unsigned)(1024u * 512u * 2u), 512, (int)gridDim.x, opaque_bid()};
    EpiDown E{PF(H), (PF(list_w) + layer * ((size_t)16 * NTOK))};
    pg8::gemm_phase<EpiDown, MoeOrder<false>>(lds, (const char*)PF(Y), 512, S, E);
}

__device__ void phase_ln2(KA ka, int layer, const float* x1, float* xo) {
    PHASE_IDS
    bf16_t* xb = PF(XB);
    const bf16_t* Y2 = PF(H);
    const int lane = TID & 63, w = TID >> 6;
    const float* g = PF(ln2_g) + layer * 1024;
    const float* bb = PF(ln2_b) + layer * 1024;
    const int* cnt = (const int*)(PF(ctl) + CW_CNT) + layer * 16 * 64;
    int mybase = 0;
    {
        int cv = lane < 16 ? __hip_atomic_load(&cnt[(lane & 15) * 64], __ATOMIC_RELAXED, __HIP_MEMORY_SCOPE_AGENT) : 0;
        int incl = cv;
#pragma unroll
        for (int o = 1; o < 16; o <<= 1) { int t = __shfl_up(incl, o); if ((lane & 15) >= o) incl += t; }
        mybase = incl - cv;
    }
    for (int row = BID * NW + w; row < NTOK; row += gridDim.x * NW) {
        const int ts1 = (PF(tok_slot) + layer * ((size_t)NTOK * 2))[row * 2 + 0], ts2 = (PF(tok_slot) + layer * ((size_t)NTOK * 2))[row * 2 + 1];
        const int s1 = __shfl(mybase, ts1 >> 14) + (ts1 & (NTOK - 1)), s2 = __shfl(mybase, ts2 >> 14) + (ts2 & (NTOK - 1));
        f32x4 v[4];
        float s = 0.f;
#pragma unroll
        for (int j = 0; j < 4; ++j) {
            const int c = 256 * j + 4 * lane;
            const f32x4 xv = *(const f32x4*)(x1 + (size_t)row * DM + c);
            const u32x2 ya = __builtin_nontemporal_load((const u32x2*)(Y2 + (size_t)s1 * DM + c)), yb = __builtin_nontemporal_load((const u32x2*)(Y2 + (size_t)s2 * DM + c));
            f32x4 t;
            t[0] = __uint_as_float(ya.x << 16) + __uint_as_float(yb.x << 16); t[1] = __uint_as_float(ya.x & 0xffff0000u) + __uint_as_float(yb.x & 0xffff0000u);
            t[2] = __uint_as_float(ya.y << 16) + __uint_as_float(yb.y << 16); t[3] = __uint_as_float(ya.y & 0xffff0000u) + __uint_as_float(yb.y & 0xffff0000u);
            v[j] = xv * ALPHA + t;
            s += (v[j][0] + v[j][1]) + (v[j][2] + v[j][3]);
        }
        const float mu = wave_sum(s) * (1.f / 1024.f);
        float q = 0.f;
#pragma unroll
        for (int j = 0; j < 4; ++j) { v[j] = v[j] - mu; q += (v[j][0] * v[j][0] + v[j][1] * v[j][1]) + (v[j][2] * v[j][2] + v[j][3] * v[j][3]); }
        const float rstd = rsqrtf(wave_sum(q) * (1.f / 1024.f) + 1e-5f);
#pragma unroll
        for (int j = 0; j < 4; ++j) {
            const int c = 256 * j + 4 * lane;
            const f32x4 o = v[j] * rstd * *(const f32x4*)(g + c) + *(const f32x4*)(bb + c);
            *(f32x4*)(xo + (size_t)row * DM + c) = o;
            u32x2 pw; pw.x = pk2(o[0], o[1]); pw.y = pk2(o[2], o[3]);
            *(u32x2*)(xb + (size_t)row * DM + c) = pw;
        }
    }
}

#define MFMA16(a, b, c) __builtin_amdgcn_mfma_f32_16x16x32_bf16((a), (b), (c), 0, 0, 0)
constexpr int NSA_KT = 0, NSA_VT = 16384, NSA_IMP = 32768, NSA_FIN = 65536, NSA_SEL = LDS_MISC + 8192;

__device__ __forceinline__ int tile_off(int r, int c) { return r * 128 + ((c ^ ((r >> 1) & 7)) << 4); }

__device__ __forceinline__ unsigned cvtpk(float lo, float hi) { return pk2(lo, hi); }
struct SelMask { unsigned a, b, c, d; };
__device__ __forceinline__ unsigned selbit(unsigned a, unsigned b, unsigned c, unsigned d, int j) {
    const int k = j >> 5;
    const unsigned lo = (k & 1) ? b : a, hi = (k & 1) ? d : c;
    const unsigned r = (k & 2) ? hi : lo;
    return (r >> (j & 31)) & 1u;
}

struct NsaRT {
    bf16x8 q[2];
    f32x4 o[4];
    float m, l;
};

template <int MODE, int NST>
__device__ __forceinline__ void nsa_loop(LAS unsigned char* lds, int tid, int lane, int w, int t0w, int jb, int je,
                                         const char* ksrc, size_t kstride, size_t ktile, const char* vsrc, size_t vstride, size_t vtile,
                                         NsaRT (&R)[2], const SelMask selm0, const SelMask selm1, float (&carry)[2], float* impw) {
    const int g = lane >> 4, qr = lane & 15;
    int tid2 = tid; asm volatile("" : "+v"(tid2));
    const int sr = tid2 >> 3, sc = (tid2 & 7) ^ ((sr >> 1) & 7);
    const char* kp = ksrc + (size_t)sr * kstride + sc * 16;
    const char* vp = vsrc + (size_t)sr * vstride + sc * 16;
    const unsigned ldsw = (unsigned)w * 1024u;
    const int fxq = (qr >> 1) & 7;
    const int ka0 = qr * 128 + ((g ^ fxq) << 4), ka1 = qr * 128 + (((4 + g) ^ fxq) << 4);
    const int vb = qr * 128 + (g & 1) * 8, vc = (g >> 1) ^ fxq;
    const int va0 = vb + (vc << 4), va1 = vb + ((vc ^ 2) << 4), va2 = vb + ((vc ^ 4) << 4), va3 = vb + ((vc ^ 6) << 4);
    if (jb > je) return;
    constexpr bool PIPE = false && (MODE >= 2);
    constexpr int D = PIPE ? NST - 2 : NST - 1;
#define NSA_ISSUE(jj, st) do { const int jc_ = (jj) < je ? (jj) : je; \
        __builtin_amdgcn_global_load_lds((const unsigned*)(kp + (size_t)jc_ * ktile), (LAS unsigned*)(lds + (st) * 16384 + ldsw), 16, 0, 0); \
        if (MODE != 0) __builtin_amdgcn_global_load_lds((const unsigned*)(vp + (size_t)jc_ * vtile), (LAS unsigned*)(lds + (st) * 16384 + 8192 + ldsw), 16, 0, 0); } while (0)
#define NSA_WAIT_TILE() do { if (NST == 2) asm volatile("s_waitcnt vmcnt(0) lgkmcnt(0)" ::: "memory"); else if (PIPE) asm volatile("s_waitcnt vmcnt(2) lgkmcnt(0)" ::: "memory"); else asm volatile("s_waitcnt vmcnt(4) lgkmcnt(0)" ::: "memory"); } while (0)
#define NSA_PV(PF_, VT_) do { _Pragma("unroll") for (int ks = 0; ks < 2; ++ks) _Pragma("unroll") for (int dt = 0; dt < 4; ++dt) { \
        const u32x2 lo = *(const LAS u32x2*)((VT_) + (ks ? va2 : va0) + dt * 2048); const u32x2 hi = *(const LAS u32x2*)((VT_) + (ks ? va3 : va1) + dt * 2048); \
        u32x4 vu; vu.x = lo.x; vu.y = lo.y; vu.z = hi.x; vu.w = hi.y; const bf16x8 vf = __builtin_bit_cast(bf16x8, vu); \
        R[0].o[dt] = MFMA16(vf, PF_[0][ks], R[0].o[dt]); R[1].o[dt] = MFMA16(vf, PF_[1][ks], R[1].o[dt]); } } while (0)
#pragma unroll
    for (int d = 0; d < D; ++d) NSA_ISSUE(jb + d, d);
    NSA_WAIT_TILE();
    __builtin_amdgcn_s_barrier();
    bf16x8 pfp[2][2];
    bool havep = false;
    if (PIPE && w >= 4) __builtin_amdgcn_s_barrier();
    for (int j = jb; j <= je; ++j) {
        const int cur = (j - jb) & (NST - 1);
        NSA_ISSUE(j + D, (j - jb + D) & (NST - 1));
        const LAS unsigned char* kt = lds + cur * 16384;
        const LAS unsigned char* vt = lds + cur * 16384 + 8192;
        bool anyact;
        {
            bool a = false;
#pragma unroll
            for (int rt = 0; rt < 2; ++rt) {
                const int tk = t0w + 4 * rt + (qr >> 2);
                if (MODE <= 1) { const int nv = tk >= 31 ? ((tk - 31) >> 4) + 1 : 0; a = a || (nv > 64 * j); }
                else if (MODE == 2) a = a || ((rt == 0 ? selbit(selm0.a, selm0.b, selm0.c, selm0.d, j) : selbit(selm1.a, selm1.b, selm1.c, selm1.d, j)) != 0u);
                else a = a || ((64 * j <= tk) && (64 * j + 63 > tk - 512));
            }
            anyact = __any(a);
        }
        if (anyact) {
            f32x4 s[2][4];
#pragma unroll
            for (int t = 0; t < 4; ++t) {
                const bf16x8 k0 = *(const LAS bf16x8*)(kt + ka0 + t * 2048), k1 = *(const LAS bf16x8*)(kt + ka1 + t * 2048);
#pragma unroll
                for (int rt = 0; rt < 2; ++rt) {
                    s[rt][t] = (f32x4){0.f, 0.f, 0.f, 0.f};
                    s[rt][t] = MFMA16(k0, R[rt].q[0], s[rt][t]);
                    s[rt][t] = MFMA16(k1, R[rt].q[1], s[rt][t]);
                }
            }
            if (PIPE && havep) NSA_PV(pfp, lds + ((j - 1 - jb) & (NST - 1)) * 16384 + 8192);
            if (PIPE) { NSA_WAIT_TILE(); __builtin_amdgcn_s_barrier(); }
            const int kb = 64 * j + 4 * g;
            bf16x8 pf_local[2][2];
            bf16x8 (&pf)[2][2] = PIPE ? pfp : pf_local;
            if (MODE == 1) {
#pragma unroll
                for (int rt = 0; rt < 2; ++rt) {
                    const int tk = t0w + 4 * rt + (qr >> 2);
                    const int nv = tk >= 31 ? ((tk - 31) >> 4) + 1 : 0;
                    const float mL = R[rt].m * 1.44269504f, invl = R[rt].l > 0.f ? 1.f / R[rt].l : 0.f;
                    float p[4][4];
#pragma unroll
                    for (int t = 0; t < 4; ++t)
#pragma unroll
                        for (int i = 0; i < 4; ++i) { const int key = kb + 16 * t + i; p[t][i] = (key < nv) ? __builtin_amdgcn_exp2f(fmaf(s[rt][t][i], 1.44269504f, -mL)) * invl : 0.f; }
#pragma unroll
                    for (int t = 0; t < 4; ++t) {
                        const float own = (p[t][0] + p[t][1]) + (p[t][2] + p[t][3]);
                        const float x3 = p[t][3];
                        const float up_cur = __shfl(x3, (lane + 48) & 63);
                        const float up_prev = __shfl(carry[rt], (lane + 48) & 63);
                        float v = own + (g >= 1 ? up_cur : up_prev);
                        v += __shfl_xor(v, 1);
                        v += __shfl_xor(v, 2);
                        carry[rt] = x3;
                        if ((qr & 3) == 0) impw[(4 * rt + (qr >> 2)) * 128 + 16 * j + 4 * t + g] = v;
                    }
#pragma unroll
                    for (int ks = 0; ks < 2; ++ks) {
                        u32x4 pu; pu.x = cvtpk(p[2 * ks][0], p[2 * ks][1]); pu.y = cvtpk(p[2 * ks][2], p[2 * ks][3]); pu.z = cvtpk(p[2 * ks + 1][0], p[2 * ks + 1][1]); pu.w = cvtpk(p[2 * ks + 1][2], p[2 * ks + 1][3]);
                        pf[rt][ks] = __builtin_bit_cast(bf16x8, pu);
                    }
                }
            } else {
                int lim_hi[2], lim_lo[2];
                bool none[2], part[2];
#pragma unroll
                for (int rt = 0; rt < 2; ++rt) {
                    const int tk = t0w + 4 * rt + (qr >> 2);
                    if (MODE == 0) { const int nv = tk >= 31 ? ((tk - 31) >> 4) + 1 : 0; lim_hi[rt] = nv - 1; lim_lo[rt] = -1; }
                    else if (MODE == 2) { lim_hi[rt] = ((rt == 0 ? selbit(selm0.a, selm0.b, selm0.c, selm0.d, j) : selbit(selm1.a, selm1.b, selm1.c, selm1.d, j)) != 0u) ? tk : -1; lim_lo[rt] = -1; }
                    else { lim_hi[rt] = tk; lim_lo[rt] = tk - 512; }
                    const bool full = (64 * j + 63 <= lim_hi[rt]) && (64 * j > lim_lo[rt]);
                    none[rt] = (64 * j > lim_hi[rt]) || (64 * j + 63 <= lim_lo[rt]);
                    part[rt] = !full && !none[rt];
                }
                float lmx[2];
                if (__any(part[0] || part[1])) {
#pragma unroll
                    for (int rt = 0; rt < 2; ++rt) {
                        float mx = NEG_INF;
#pragma unroll
                        for (int t = 0; t < 4; ++t)
#pragma unroll
                            for (int i = 0; i < 4; ++i) {
                                const int key = kb + 16 * t + i;
                                const bool ok = (key <= lim_hi[rt]) && (key > lim_lo[rt]);
                                s[rt][t][i] = ok ? s[rt][t][i] : NEG_INF;
                                mx = fmaxf(mx, s[rt][t][i]);
                            }
                        lmx[rt] = mx;
                        none[rt] = false;
                    }
                } else {
#pragma unroll
                    for (int rt = 0; rt < 2; ++rt) {
                        float mx = NEG_INF;
#pragma unroll
                        for (int t = 0; t < 4; ++t)
#pragma unroll
                            for (int i = 0; i < 4; ++i) mx = fmaxf(mx, s[rt][t][i]);
                        lmx[rt] = none[rt] ? NEG_INF : mx;
                    }
                }
                if (__any((lmx[0] > R[0].m + 6.f) || (lmx[1] > R[1].m + 6.f))) {
#pragma unroll
                    for (int rt = 0; rt < 2; ++rt) {
                        float mx = lmx[rt];
                        mx = fmaxf(mx, __shfl_xor(mx, 16));
                        mx = fmaxf(mx, __shfl_xor(mx, 32));
                        const float mn = fmaxf(R[rt].m, mx);
                        const float alpha = __expf(R[rt].m - mn);
                        R[rt].l *= alpha; R[rt].m = mn;
                        if (MODE != 0) {
#pragma unroll
                            for (int dt = 0; dt < 4; ++dt) R[rt].o[dt] = R[rt].o[dt] * alpha;
                        }
                    }
                }
#pragma unroll
                for (int rt = 0; rt < 2; ++rt) {
                    const float negmL = none[rt] ? -1e30f : -fmaxf(R[rt].m, -1e4f) * 1.44269504f;
                    float p[4][4];
                    float rs = 0.f;
#pragma unroll
                    for (int t = 0; t < 4; ++t)
#pragma unroll
                        for (int i = 0; i < 4; ++i) { p[t][i] = __builtin_amdgcn_exp2f(fmaf(s[rt][t][i], 1.44269504f, negmL)); rs += p[t][i]; }
                    R[rt].l += rs;
                    if (MODE != 0) {
#pragma unroll
                        for (int ks = 0; ks < 2; ++ks) {
                            u32x4 pu; pu.x = cvtpk(p[2 * ks][0], p[2 * ks][1]); pu.y = cvtpk(p[2 * ks][2], p[2 * ks][3]); pu.z = cvtpk(p[2 * ks + 1][0], p[2 * ks + 1][1]); pu.w = cvtpk(p[2 * ks + 1][2], p[2 * ks + 1][3]);
                            pf[rt][ks] = __builtin_bit_cast(bf16x8, pu);
                        }
                    }
                }
            }
            if (MODE != 0 && !PIPE) NSA_PV(pf, vt);
        } else if (PIPE) {
            if (havep) NSA_PV(pfp, lds + ((j - 1 - jb) & (NST - 1)) * 16384 + 8192);
            NSA_WAIT_TILE(); __builtin_amdgcn_s_barrier();
        }
        if (PIPE) havep = anyact;
        if (!PIPE) NSA_WAIT_TILE();
        __builtin_amdgcn_s_barrier();
    }
    if (PIPE && havep) { NSA_PV(pfp, lds + ((je - jb) & (NST - 1)) * 16384 + 8192); asm volatile("s_waitcnt lgkmcnt(0)" ::: "memory"); }
    if (PIPE && w < 4) __builtin_amdgcn_s_barrier();
    asm volatile("s_waitcnt vmcnt(0)" ::: "memory");
    __builtin_amdgcn_s_barrier();
#undef NSA_ISSUE
#undef NSA_WAIT_TILE
#undef NSA_PV
}

__device__ void phase_nsa2(KA ka, int layer, LAS unsigned char* lds) {
    PHASE_IDS
    const int tid = TID, w = __builtin_amdgcn_readfirstlane(tid >> 6);
    int lane = tid & 63;
#define g (lane >> 4)
#define qr (lane & 15)
#define RELAUNDER() asm volatile("" : "+v"(lane))
    const bf16_t* H = PF(H);
    const bf16_t* kcb = (PF(kcb) + layer * ((size_t)4 * 512 * 64));
    const bf16_t* vcT = (PF(vcT) + layer * ((size_t)4 * 64 * 512));
    const bf16_t* vsT = PF(vsT);
    const bf16_t* vwT = PF(vwT);
    bf16_t* Y = PF(Y);
    const float* gate_b = PF(nsa_gate_b) + layer * 24;
    const float* ogain = PF(out_gain) + layer * 1024;
    float* impw = (float*)(lds + NSA_IMP + w * 4096);
    unsigned* selw = (unsigned*)(lds + NSA_SEL + w * 128);
    for (int base = BID; base < 256; base += gridDim.x) {
#pragma unroll 1
        for (int half = 0; half < 2; ++half) {
            const int it = half ? 511 - base : base;
            const int chunk = it >> 2, bh = it & 3, b = bh >> 1, hk = bh & 1;
            const size_t rowbase = (size_t)b * T_;
            const int t0w = chunk * 64 + w * 8;
            NsaRT R[2];
#define finw ((LAS f32x4*)(lds + NSA_FIN + w * 8192) + lane)
#pragma unroll
            for (int rt = 0; rt < 2; ++rt) {
                const int tk = t0w + 4 * rt + (qr >> 2), hh = hk * 4 + (qr & 3);
                const bf16_t* qp = H + (rowbase + tk) * HLD + C_NQ + hh * 64 + 8 * g;
#pragma unroll
                for (int ks = 0; ks < 2; ++ks) {
                    const u32x4 u = *(const u32x4*)(qp + 32 * ks);
                    const unsigned uu[4] = {u.x, u.y, u.z, u.w};
                    u32x4 o4;
#pragma unroll
                    for (int e = 0; e < 4; ++e) {
                        const float f0 = __uint_as_float(uu[e] << 16) * 0.125f, f1 = __uint_as_float(uu[e] & 0xffff0000u) * 0.125f;
                        o4[e] = (__float_as_uint(f0) >> 16) | (__float_as_uint(f1) & 0xffff0000u);
                    }
                    R[rt].q[ks] = __builtin_bit_cast(bf16x8, o4);
                }
                R[rt].m = NEG_INF; R[rt].l = 0.f;
#pragma unroll
                for (int dt = 0; dt < 4; ++dt) R[rt].o[dt] = zero4();
            }
            SelMask selm0{0u, 0u, 0u, 0u}, selm1{0u, 0u, 0u, 0u};
            float carry[2] = {0.f, 0.f};
            const int tmax = chunk * 64 + 63;
            const int nvmax = tmax >= 31 ? ((tmax - 31) >> 4) + 1 : 0;
            const int nb = (nvmax + 63) >> 6;
            const char* kc_src = (const char*)(kcb + (size_t)bh * 512 * 64);
            const char* vc_src = (const char*)(vcT + (size_t)bh * 64 * 512);
            nsa_loop<0, 2>(lds, tid, lane, w, t0w, 0, nb - 1, kc_src, 128, 64 * 128, nullptr, 0, 0, R, selm0, selm1, carry, impw);
            RELAUNDER();
#pragma unroll
            for (int rt = 0; rt < 2; ++rt) { float l = R[rt].l; l += __shfl_xor(l, 16); l += __shfl_xor(l, 32); R[rt].l = l; }
            for (int i = lane; i < 8 * 128; i += 64) impw[i] = 0.f;
            wave_sync();
            nsa_loop<1, 2>(lds, tid, lane, w, t0w, 0, nb - 1, kc_src, 128, 64 * 128, vc_src, 512 * 2, 64 * 2, R, selm0, selm1, carry, impw);
            RELAUNDER();
#pragma unroll
            for (int rt = 0; rt < 2; ++rt) {
                const int hh = hk * 4 + (qr & 3);
                const float gt = sigmoidf_(bf2f(H[(rowbase + (t0w + 4 * rt + (qr >> 2))) * HLD + C_NG + hh * 3 + 0]) + gate_b[hh * 3 + 0]);
#pragma unroll
                for (int dt = 0; dt < 4; ++dt) finw[(rt * 4 + dt) * 64] = R[rt].o[dt] * gt;
            }
            wave_sync();
            {
                const int tl = lane >> 3, sub = lane & 7;
                const int tks = t0w + tl, curb = tks >> 6;
                unsigned long long K[16];
                unsigned* impu = (unsigned*)impw;
                unsigned ku[16];
#pragma unroll
                for (int i = 0; i < 16; ++i) {
                    const int jj = sub * 16 + i;
                    const float a = impw[tl * 128 + jj];
                    const bool forced = (jj == 0) || (jj == curb) || (jj == curb - 1);
                    const float vv = a + (forced ? 1e4f : 0.f);
                    ku[i] = (jj <= curb) ? (__float_as_uint(vv) + 1u) : 0u;
                    K[i] = ((unsigned long long)ku[i] << 8) | (unsigned)(255 - jj);
                }
                wave_sync();
#pragma unroll
                for (int i = 0; i < 16; ++i) impu[tl * 128 + sub * 16 + i] = ku[i];
                wave_sync();
                int cnt[16];
#pragma unroll
                for (int i = 0; i < 16; ++i) cnt[i] = 0;
                const int jjmax = (t0w + 7) >> 6;
                for (int jj = 0; jj <= jjmax; ++jj) {
                    const unsigned long long X = ((unsigned long long)impu[tl * 128 + jj] << 8) | (unsigned)(255 - jj);
#pragma unroll
                    for (int i = 0; i < 16; ++i) cnt[i] += (X > K[i]) ? 1 : 0;
                }
                unsigned bits = 0u;
#pragma unroll
                for (int i = 0; i < 16; ++i) bits |= ((cnt[i] < 16) && (ku[i] != 0u)) ? (1u << i) : 0u;
                const unsigned other = __shfl_xor(bits, 1);
                const unsigned word = (sub & 1) ? ((bits << 16) | other) : (bits | (other << 16));
                if ((sub & 1) == 0) selw[tl * 4 + (sub >> 1)] = word;
                wave_sync();
                { const unsigned* q0 = selw + (qr >> 2) * 4; selm0.a = q0[0]; selm0.b = q0[1]; selm0.c = q0[2]; selm0.d = q0[3];
                  selm1.a = q0[16]; selm1.b = q0[17]; selm1.c = q0[18]; selm1.d = q0[19]; }
                wave_sync();
            }
            __syncthreads();
#pragma unroll
            for (int rt = 0; rt < 2; ++rt) {
                R[rt].m = NEG_INF; R[rt].l = 0.f;
#pragma unroll
                for (int dt = 0; dt < 4; ++dt) R[rt].o[dt] = zero4();
            }
            nsa_loop<2, 4>(lds, tid, lane, w, t0w, 0, chunk, (const char*)(H + rowbase * HLD + C_KS + hk * 64), (size_t)HLD * 2, (size_t)64 * HLD * 2,
                        (const char*)(vsT + (size_t)bh * 64 * T_), (size_t)T_ * 2, 64 * 2, R, selm0, selm1, carry, impw);
            RELAUNDER();
#pragma unroll
            for (int rt = 0; rt < 2; ++rt) {
                const int hh = hk * 4 + (qr & 3);
                const float gt = sigmoidf_(bf2f(H[(rowbase + (t0w + 4 * rt + (qr >> 2))) * HLD + C_NG + hh * 3 + 1]) + gate_b[hh * 3 + 1]);
                float ltot = R[rt].l; ltot += __shfl_xor(ltot, 16); ltot += __shfl_xor(ltot, 32);
                const float sc = gt / ltot;
#pragma unroll
                for (int dt = 0; dt < 4; ++dt) { finw[(rt * 4 + dt) * 64] += R[rt].o[dt] * sc; R[rt].o[dt] = zero4(); }
                R[rt].m = NEG_INF; R[rt].l = 0.f;
            }
            nsa_loop<3, 4>(lds, tid, lane, w, t0w, chunk >= 8 ? chunk - 8 : 0, chunk, (const char*)(H + rowbase * HLD + C_KW + hk * 64), (size_t)HLD * 2, (size_t)64 * HLD * 2,
                        (const char*)(vwT + (size_t)bh * 64 * T_), (size_t)T_ * 2, 64 * 2, R, selm0, selm1, carry, impw);
            RELAUNDER();
#pragma unroll
            for (int rt = 0; rt < 2; ++rt) {
                const int tk = (t0w + 4 * rt + (qr >> 2)), hh = hk * 4 + (qr & 3);
                const float gt = sigmoidf_(bf2f(H[(rowbase + tk) * HLD + C_NG + hh * 3 + 2]) + gate_b[hh * 3 + 2]);
                float ltot = R[rt].l; ltot += __shfl_xor(ltot, 16); ltot += __shfl_xor(ltot, 32);
                const float sc = gt / ltot;
                bf16_t* yp = Y + (rowbase + tk) * DM + 256 + hh * 64 + 4 * g;
                f32x4 ov[4];
                float ss = 0.f;
#pragma unroll
                for (int dt = 0; dt < 4; ++dt) { ov[dt] = finw[(rt * 4 + dt) * 64] + R[rt].o[dt] * sc; ss += (ov[dt][0] * ov[dt][0] + ov[dt][1] * ov[dt][1]) + (ov[dt][2] * ov[dt][2] + ov[dt][3] * ov[dt][3]); }
                ss += __shfl_xor(ss, 16);
                ss += __shfl_xor(ss, 32);
                const float rn = rsqrtf(ss * (1.f / 64.f) + 1e-6f);
#pragma unroll
                for (int dt = 0; dt < 4; ++dt) {
                    const f32x4 o = ov[dt] * rn * *(const f32x4*)(ogain + 256 + hh * 64 + 16 * dt + 4 * g);
                    u32x2 wv; wv.x = pk2(o[0], o[1]); wv.y = pk2(o[2], o[3]);
                    *(u32x2*)(yp + 16 * dt) = wv;
                }
            }
        }
    }
}
#undef g
#undef qr
#undef finw
#undef RELAUNDER

__device__ void phase_vtrans(KA ka, float* smem) {
    PHASE_IDS
    const int lane = TID & 63, w = TID >> 6;
    bf16_t* scr = (bf16_t*)(smem + w * 4096);
    const bf16_t* H = PF(H);
    for (int it = BID * NW + w; it < 1024; it += gridDim.x * NW) {
        const int tt = it & 127, bh = (it >> 7) & 3, which = it >> 9;
        const int b = bh >> 1, hk = bh & 1;
        const size_t tok0 = (size_t)b * T_ + tt * 64;
        const int col = (which ? C_VW : C_VS) + hk * 64;
        bf16_t* dst = (which ? PF(vwT) : PF(vsT)) + (size_t)bh * 64 * T_ + tt * 64;
        wave_sync();
        for (int i = 0; i < 64; ++i) scr[lane * 66 + i] = H[(tok0 + i) * HLD + col + lane];
        wave_sync();
        for (int d = 0; d < 64; ++d) dst[(size_t)d * T_ + lane] = scr[d * 66 + lane];
    }
}

__device__ void phase_hgrnA(KA ka, int layer, LAS unsigned char* lds, int first, int nblk) {
    PHASE_IDS
    const int tid = TID, lane = tid & 63, w = __builtin_amdgcn_readfirstlane(tid >> 6), gq = lane >> 4, lc = lane & 15;
    float* Q = (float*)lds;
    float* K = Q + 64 * 68;
    float* Bc = K + 64 * 68;
    float* SEG = Bc + 64 * 68;
    LAS bf16_t* ATb = (LAS bf16_t*)(lds + 57344);
    LAS bf16_t* ItB = ATb + 64 * 72;
    LAS bf16_t* KtB = ItB + 64 * 72;
    const bf16_t* H = PF(H);
    const float* hgl = PF(hg_lower);
    float* hgU = PF(hgU); float* hgG = (PF(hgG) + layer * ((size_t)1024 * 64)); bf16_t* hgQB = PF(hgQB); bf16_t* hgO = PF(hgO);
    if (BID < first) return;
    float* LB = (float*)(lds + 98304);
    if (tid < 256) {
        float lb = 0.f;
        if (layer == 1) { const float h0 = hgl[tid], h1 = hgl[256 + tid]; const float mx = fmaxf(h0, h1), e0 = expf(h0 - mx), e1 = expf(h1 - mx); lb = e1 / (e0 + e1); }
        LB[tid] = lb;
    }
    for (int item = BID - first; item < 1024; item += nblk) {
        const int c = item & 127, bh = item >> 7, h = bh & 3, b = bh >> 2;
        const size_t tok0 = (size_t)b * T_ + c * 64;
        __syncthreads();
#pragma unroll
        for (int i = 0; i < 8; ++i) {
            const int e = tid + i * NTHR, t = e >> 6, d = e & 63;
            const float lb = LB[h * 64 + d];
            const bf16_t* hp = H + (tok0 + t) * HLD + h * 64 + d;
            const float fl = bf2f(hp[C_HF]);
            const float ex = __expf(-fl);
            const float sg = 1.f / (1.f + ex);
            const float f = lb + (1.f - lb) * sg;
            Q[t * 68 + d] = bf2f(hp[C_HQ]);
            K[t * 68 + d] = (1.f - lb) * (ex * sg);
            ItB[d * 72 + t] = hp[C_HI];
            Bc[t * 68 + d] = __logf(fmaxf(f, 1e-38f));
        }
        __syncthreads();
        {
            const int d = lane, seg = w;
            float run = 0.f;
#pragma unroll
            for (int i = 0; i < 8; ++i) { run += Bc[(seg * 8 + i) * 68 + d]; Bc[(seg * 8 + i) * 68 + d] = run; }
            SEG[seg * 64 + d] = run;
            __syncthreads();
            float pre = 0.f;
            for (int s2 = 0; s2 < seg; ++s2) pre += SEG[s2 * 64 + d];
#pragma unroll
            for (int i = 0; i < 8; ++i) Bc[(seg * 8 + i) * 68 + d] += pre;
        }
        __syncthreads();
        {
            const int blk = tid >> 1, dh = tid & 1, tb = blk >> 4, sb = blk & 15;
            float acc[4][4];
#pragma unroll
            for (int i = 0; i < 4; ++i)
#pragma unroll
                for (int j = 0; j < 4; ++j) acc[i][j] = 0.f;
            if (sb <= tb) {
#pragma unroll 2
                for (int d0 = 32 * dh; d0 < 32 * dh + 32; d0 += 4) {
                    f32x4 qv[4], bt[4], kv[4], bsv[4];
#pragma unroll
                    for (int i = 0; i < 4; ++i) { qv[i] = *(const f32x4*)&Q[(4 * tb + i) * 68 + d0]; bt[i] = *(const f32x4*)&Bc[(4 * tb + i) * 68 + d0]; }
#pragma unroll
                    for (int j = 0; j < 4; ++j) { kv[j] = *(const f32x4*)&K[(4 * sb + j) * 68 + d0]; bsv[j] = *(const f32x4*)&Bc[(4 * sb + j) * 68 + d0]; }
#pragma unroll
                    for (int i = 0; i < 4; ++i)
#pragma unroll
                        for (int j = 0; j < 4; ++j)
#pragma unroll
                            for (int dd = 0; dd < 4; ++dd) acc[i][j] = fmaf(qv[i][dd] * kv[j][dd], __expf(fminf(bt[i][dd] - bsv[j][dd], 0.f)), acc[i][j]);
                }
            }
#pragma unroll
            for (int i = 0; i < 4; ++i)
#pragma unroll
                for (int j = 0; j < 4; ++j) { acc[i][j] += __shfl_xor(acc[i][j], 1); if (4 * sb + j > 4 * tb + i) acc[i][j] = 0.f; }
            if (dh == 0) {
#pragma unroll
                for (int i = 0; i < 4; ++i) {
                    u32x2 pw; pw.x = pk2(acc[i][0], acc[i][1]); pw.y = pk2(acc[i][2], acc[i][3]);
                    *(LAS u32x2*)(ATb + (4 * tb + i) * 72 + 4 * sb) = pw;
                }
            }
        }
#pragma unroll
        for (int i = 0; i < 8; ++i) {
            const int e = tid + i * NTHR, t = e >> 6, d = e & 63;
            const float bt = Bc[t * 68 + d];
            hgQB[(size_t)item * 4096 + e] = f2bf(Q[t * 68 + d] * __expf(bt));
            KtB[d * 72 + t] = f2bf(K[t * 68 + d] * __expf(Bc[63 * 68 + d] - bt));
        }
        if (tid < 64) hgG[(size_t)item * 64 + tid] = __expf(Bc[63 * 68 + tid]);
        __syncthreads();
#pragma unroll
        for (int q = 0; q < 4; ++q) {
            const int tile = w * 4 + q, isU = tile >> 4, rt_ = (tile >> 2) & 3, ct = tile & 3;
            const LAS bf16_t* Ab = (isU ? KtB : ATb) + (16 * rt_ + lc) * 72 + 8 * gq;
            const LAS bf16_t* Bb = ItB + (16 * ct + lc) * 72 + 8 * gq;
            f32x4 acc = zero4();
            acc = MFMA16(*(const LAS bf16x8*)Ab, *(const LAS bf16x8*)Bb, acc);
            acc = MFMA16(*(const LAS bf16x8*)(Ab + 32), *(const LAS bf16x8*)(Bb + 32), acc);
#pragma unroll
            for (int i = 0; i < 4; ++i) {
                const int r = 16 * rt_ + 4 * gq + i, cc = 16 * ct + lc;
                if (isU) hgU[((size_t)item * 64 + r) * 64 + cc] = acc[i];
                else hgO[((size_t)item * 64 + r) * 64 + cc] = f2bf(acc[i]);
            }
        }
    }
}

__device__ void phase_hgrnB(KA ka, int layer) {
    PHASE_IDS
    const float* hgU = PF(hgU); const float* hgG = (PF(hgG) + layer * ((size_t)1024 * 64)); float* hgS = PF(hgS);
    for (int gid = BID * NTHR + TID; gid < 32768; gid += gridDim.x * NTHR) {
        const int bh = gid >> 12, dv = gid & 4095, d = dv >> 6;
        float S = 0.f;
        for (int c0 = 0; c0 < 128; c0 += 8) {
            float u[8], gg[8];
#pragma unroll
            for (int k = 0; k < 8; ++k) { const size_t item = (size_t)bh * 128 + c0 + k; u[k] = hgU[item * 4096 + dv]; gg[k] = hgG[item * 64 + d]; }
#pragma unroll
            for (int k = 0; k < 8; ++k) { const size_t item = (size_t)bh * 128 + c0 + k; hgS[item * 4096 + dv] = S; S = fmaf(gg[k], S, u[k]); }
        }
    }
}

__device__ void phase_hgrnC(KA ka, int layer, LAS unsigned char* lds) {
    PHASE_IDS
    const int tid = TID, lane = tid & 63, w = __builtin_amdgcn_readfirstlane(tid >> 6), gq = lane >> 4, lc = lane & 15;
    LAS bf16_t* QBb = (LAS bf16_t*)lds;
    LAS bf16_t* StB = QBb + 64 * 72;
    float* OT = (float*)(lds + 32768);
    const bf16_t* H = PF(H);
    const float* hgS = PF(hgS); const bf16_t* hgQB = PF(hgQB); const bf16_t* hgO = PF(hgO);
    const float* og = PF(out_gain) + layer * 1024;
    bf16_t* Y = PF(Y);
    for (int item = BID; item < 1024; item += gridDim.x) {
        const int c = item & 127, bh = item >> 7, h = bh & 3, b = bh >> 2;
        const size_t tok0 = (size_t)b * T_ + c * 64;
        __syncthreads();
#pragma unroll
        for (int i = 0; i < 8; ++i) {
            const int e = tid + i * NTHR, r = e >> 6, cc = e & 63;
            QBb[r * 72 + cc] = hgQB[(size_t)item * 4096 + e];
            StB[cc * 72 + r] = f2bf(hgS[(size_t)item * 4096 + e]);
        }
        __syncthreads();
#pragma unroll
        for (int q = 0; q < 2; ++q) {
            const int tile = w * 2 + q, rt_ = tile >> 2, ct = tile & 3;
            const LAS bf16_t* Ab = QBb + (16 * rt_ + lc) * 72 + 8 * gq;
            const LAS bf16_t* Bb = StB + (16 * ct + lc) * 72 + 8 * gq;
            f32x4 acc = zero4();
            acc = MFMA16(*(const LAS bf16x8*)Ab, *(const LAS bf16x8*)Bb, acc);
            acc = MFMA16(*(const LAS bf16x8*)(Ab + 32), *(const LAS bf16x8*)(Bb + 32), acc);
#pragma unroll
            for (int i = 0; i < 4; ++i) {
                const int t = 16 * rt_ + 4 * gq + i, v = 16 * ct + lc;
                OT[t * 65 + v] = acc[i] + bf2f(hgO[((size_t)item * 64 + t) * 64 + v]);
            }
        }
        __syncthreads();
#pragma unroll 1
        for (int i = 0; i < 8; ++i) {
            const int t = w + 8 * i, v = lane;
            const float acc = OT[t * 65 + v];
            const float ms = wave_sum(acc * acc) * (1.f / 64.f);
            const float hg = bf2f(H[(tok0 + t) * HLD + C_HG + h * 64 + v]);
            const float y = acc * rsqrtf(ms + 1e-6f) * og[768 + h * 64 + v] * (hg * sigmoidf_(hg));
            Y[(tok0 + t) * DM + 768 + h * 64 + v] = f2bf(y);
        }
    }
}

struct CmpOrder {
    static constexpr bool GATHER = false;
    const char* W1T; int c;
    __device__ __forceinline__ bool next(int i, pg8::Unit& u) const {
        if (i > 0 || c >= 16) return false;
        const int which = c >> 3, bh = (c >> 1) & 3, nt = c & 1;
        u.arow0 = (bh >> 1) * 512 + nt * 256; u.nrows = 256; u.pm = nt; u.pn = 0; u.e = which * 4 + bh; u.ui = 0;
        u.bptr = W1T + (size_t)which * 256 * 2048 * 2;
        return true;
    }
    __device__ __forceinline__ int arow(const pg8::Unit& u, int r) const { return u.arow0 + r; }
    __device__ __forceinline__ int lda(int) const { return 16 * HLD; }
    __device__ __forceinline__ unsigned kstepA() const { return (unsigned)(HLD * 2); }
    __device__ __forceinline__ const char* abase(const pg8::Unit& u, const char* A) const { return A + (((u.e >> 2) ? C_VC : C_KC) + (u.e & 1) * 64) * 2; }
};
struct EpiCmp {
    static constexpr bool PERM = true;
    bf16_t* G; const float* cbias;
    __device__ __forceinline__ void operator()(const f32x4 (&acc)[2][2][4][2], const pg8::Unit& u, int wr, int wc, int fr, int fq) const {
        const float* bp = cbias + (u.e >> 2) * 128 + wc * 32 + 8 * fq;
        const f32x4 b0 = *(const f32x4*)bp, b1 = *(const f32x4*)(bp + 4);
#pragma unroll
        for (int ai = 0; ai < 2; ++ai)
#pragma unroll
            for (int m = 0; m < 4; ++m) {
                const int r = ai * 128 + wr * 64 + m * 16 + fr;
                bf16_t* rowp = G + ((size_t)(u.e * 512 + u.pm * 256 + r)) * 128 + wc * 32 + 8 * fq;
                const f32x4 v0 = acc[ai][0][m][0] + b0, v1 = acc[ai][0][m][1] + b1;
                u32x4 w; w.x = pk2(gelu_slow(v0[0]), gelu_slow(v0[1])); w.y = pk2(gelu_slow(v0[2]), gelu_slow(v0[3])); w.z = pk2(gelu_slow(v1[0]), gelu_slow(v1[1])); w.w = pk2(gelu_slow(v1[2]), gelu_slow(v1[3]));
                *(u32x4*)rowp = w;
            }
    }
};
__device__ void phase_compress2(KA ka, int layer, LAS unsigned char* lds) {
    const int bid = opaque_bid();
    if (bid >= 16) return;
    CmpOrder S{(const char*)(PF(WT) + WT_C1), bid};
    EpiCmp E{(PF(gb) + layer * ((size_t)8 * 512 * 128)), (PF(cbias) + layer * (256))};
    pg8::gemm_phase<EpiCmp, CmpOrder>(lds, (const char*)PF(H), 2048, S, E);
    __syncthreads();
    const int tid = opaque_tid();
    const int which = bid >> 3, bh = (bid >> 1) & 3, nt = bid & 1;
    float* w2s = (float*)lds;
    const float* w2 = PF(cmp_w2) + ((size_t)layer * 2 + which) * 128 * 64;
    for (int i = tid; i < 128 * 64; i += NTHR) w2s[i] = w2[i];
    __syncthreads();
    const int r = tid >> 1, half = tid & 1;
    const bf16_t* grow = (PF(gb) + layer * ((size_t)8 * 512 * 128)) + ((size_t)((which * 4 + bh) * 512 + nt * 256 + r)) * 128;
    float acc[32];
#pragma unroll
    for (int j = 0; j < 32; ++j) acc[j] = 0.f;
    for (int c8 = 0; c8 < 16; ++c8) {
        const u32x4 gu = *(const u32x4*)(grow + c8 * 8);
        const unsigned gw[4] = {gu.x, gu.y, gu.z, gu.w};
#pragma unroll
        for (int e = 0; e < 8; ++e) {
            const float gv = (e & 1) ? __uint_as_float(gw[e >> 1] & 0xffff0000u) : __uint_as_float(gw[e >> 1] << 16);
            const float* wrow = w2s + (c8 * 8 + e) * 64 + half * 32;
#pragma unroll
            for (int j4 = 0; j4 < 8; ++j4) {
                const float4 w4 = *(const float4*)(wrow + j4 * 4);
                acc[j4 * 4 + 0] = fmaf(gv, w4.x, acc[j4 * 4 + 0]); acc[j4 * 4 + 1] = fmaf(gv, w4.y, acc[j4 * 4 + 1]);
                acc[j4 * 4 + 2] = fmaf(gv, w4.z, acc[j4 * 4 + 2]); acc[j4 * 4 + 3] = fmaf(gv, w4.w, acc[j4 * 4 + 3]);
            }
        }
    }
    const int n = nt * 256 + r;
    if (which == 0) {
        bf16_t* o = (PF(kcb) + layer * ((size_t)4 * 512 * 64)) + ((size_t)bh * 512 + n) * 64 + half * 32;
#pragma unroll
        for (int j = 0; j < 32; j += 2) *(unsigned*)(o + j) = pk2(acc[j], acc[j + 1]);
    } else {
        bf16_t* o = (PF(vcT) + layer * ((size_t)4 * 64 * 512)) + (size_t)bh * 64 * 512 + n;
#pragma unroll
        for (int j = 0; j < 32; ++j) o[(size_t)(half * 32 + j) * 512] = f2bf(acc[j]);
    }
    __syncthreads();
}

__device__ void phase_gmlp2(KA ka, int layer, LAS unsigned char* lds, int first, int nblk) {
    PHASE_IDS
    const int tid = TID, lane = tid & 63, w = __builtin_amdgcn_readfirstlane(tid >> 6), gq = lane >> 4, lc = lane & 15;
    LAS bf16_t* Vt = (LAS bf16_t*)lds;
    const float* gain = PF(gm_v_gain) + layer * 256;
    const float* bias = PF(gm_v_bias) + layer * 256;
    const float* bs = PF(gm_b_s) + layer * 4 * 128;
    const bf16_t* gmW = PF(WT) + WT_GM;
    const bf16_t* H = PF(H);
    bf16_t* Y = PF(Y);
    if (BID < first) return;
    for (int it = BID - first; it < 1536; it += nblk) {
        if (it < 1024) continue;
        const int item = it - 1024;
        const int g = item & 3, c = (item >> 2) & 63, b = item >> 8;
        const size_t tok0 = (size_t)b * T_ + (size_t)c * 128;
        __syncthreads();
#pragma unroll 4
        for (int i = 0; i < 16; ++i) {
            const int s = w * 16 + i;
            const float x = bf2f(H[(tok0 + s) * HLD + C_GV + g * 64 + lane]);
            const float ge = gelu_t(x);
            const float mu = wave_sum(ge) * (1.f / 64.f);
            const float dl = ge - mu;
            const float var = wave_sum(dl * dl) * (1.f / 64.f);
            Vt[lane * 136 + s] = f2bf(dl * rsqrtf(var + 1e-5f) * gain[g * 64 + lane] + bias[g * 64 + lane]);
        }
        __syncthreads();
        f32x4 acc[4];
#pragma unroll
        for (int ct = 0; ct < 4; ++ct) acc[ct] = zero4();
        const bf16_t* wrow = gmW + ((size_t)g * 128 + 16 * w + lc) * 128 + 8 * gq;
        const int kmax = (16 * w + 15) >> 5;
        for (int ks = 0; ks <= kmax; ++ks) {
            const bf16x8 a = *(const bf16x8*)(wrow + 32 * ks);
#pragma unroll
            for (int ct = 0; ct < 4; ++ct) {
                const bf16x8 bfr = *(const LAS bf16x8*)(Vt + (16 * ct + lc) * 136 + 32 * ks + 8 * gq);
                acc[ct] = MFMA16(a, bfr, acc[ct]);
            }
        }
        const float* ogain = PF(out_gain) + layer * 1024;
#pragma unroll
        for (int i = 0; i < 4; ++i) {
            const int t = 16 * w + 4 * gq + i;
            float yv[4];
            float ss = 0.f;
#pragma unroll
            for (int ct = 0; ct < 4; ++ct) {
                const int d = 16 * ct + lc;
                const float z = acc[ct][i] + bs[g * 128 + t];
                const float u = gelu_t(bf2f(H[(tok0 + t) * HLD + C_GU + g * 64 + d]));
                yv[ct] = u * z;
                ss += yv[ct] * yv[ct];
            }
            ss += __shfl_xor(ss, 1); ss += __shfl_xor(ss, 2); ss += __shfl_xor(ss, 4); ss += __shfl_xor(ss, 8);
            const float rn = rsqrtf(ss * (1.f / 64.f) + 1e-6f);
#pragma unroll
            for (int ct = 0; ct < 4; ++ct) {
                const int d = 16 * ct + lc;
                Y[(tok0 + t) * DM + g * 64 + d] = f2bf(yv[ct] * rn * ogain[g * 64 + d]);
            }
        }
    }
}

#ifndef ONLY_Q
#define ONLY_Q -2
#endif
#ifndef QMASK
#define QMASK 0x3ff
#endif
#define QON(k) ((ONLY_Q == -2 && ((QMASK >> ((k) + 1)) & 1)) || ONLY_Q == (k))
#ifndef DUPMASK
#define DUPMASK 0
#endif
#define DUP(k) ((DUPMASK >> (k)) & 1)
#ifndef PROF_LO
#define PROF_LO -1
#endif
#ifndef PROF_HI
#define PROF_HI -1
#endif
#ifndef WS_PROBE_PAD
#define WS_PROBE_PAD 0
#endif
#ifndef NPH_TOTAL
#define NPH_TOTAL 19
#endif
__global__ void __launch_bounds__(NTHR, 2) k_mega(P p0) {
    extern __shared__ __attribute__((aligned(16))) unsigned char lds_raw[];
    LAS unsigned char* lds = (LAS unsigned char*)lds_raw;
    float* smem = (float*)lds_raw;
    volatile LAS unsigned* misc = (volatile LAS unsigned*)(lds + LDS_MISC);
    if (threadIdx.x < 16) misc[threadIdx.x] = 0u;
    if ((threadIdx.x & 63) == 0) *(LAS int*)(lds + LDS_WTAB + 4 * hw_slot()) = (int)(threadIdx.x >> 6);
    __syncthreads();
    XcdBarrier bar = xcd_barrier_post(p0.ctl + CW_BAR, misc);
    if (PROF_LO >= 0 && blockIdx.x == 0 && threadIdx.x == 0) ((unsigned long long*)(p0.ctl + 8192))[0] = __builtin_amdgcn_s_memrealtime();
#pragma unroll 1
    for (int ph = 0; ph < p0.nph; ph++) {
        const int layer = ph == 0 ? 0 : (ph - 1) / 9, q = ph == 0 ? -1 : (ph - 1) % 9;
        const int dupm = p0.pad;
#if defined(__HIP_DEVICE_COMPILE__)
        KA ka = (KA)__builtin_amdgcn_kernarg_segment_ptr();
        asm volatile("" : "+s"(ka));
#else
        KA ka = nullptr;
#endif
        const float* xin = layer == 0 ? PF(x) : PF(out);
        float* x1 = PF(out);
        if (q == -1 && QON(-1)) { for (int r = 0; r <= ((dupm >> 15) & 1); ++r) { phase_prologue(ka, 0, smem); __syncthreads(); } }
        else if (q == 0 && QON(0)) { for (int r = 0; r <= (dupm & 1); ++r) { phase_inproj(ka, layer, lds); __syncthreads(); } }
        else if (q == 1 && QON(1)) {
            const int nb1 = (int)gridDim.x > 32 ? 16 : 0, nwork = (int)gridDim.x - nb1;
            for (int r = 0; r <= ((dupm >> 12) & 1); ++r) { phase_compress2(ka, layer, lds); __syncthreads(); }
            for (int r = 0; r <= ((dupm >> 10) & 1); ++r) { phase_hgrnA(ka, layer, lds, nb1, nwork); __syncthreads(); }
            for (int r = 0; r <= ((dupm >> 11) & 1); ++r) { phase_gmlp2(ka, layer, lds, nb1, nwork); __syncthreads(); }
            for (int r = 0; r <= ((dupm >> 13) & 1); ++r) { phase_vtrans(ka, smem); __syncthreads(); }
        }
        else if (q == 2 && QON(2)) { for (int r = 0; r <= ((dupm >> 14) & 1); ++r) { phase_hgrnB(ka, layer); __syncthreads(); } for (int r = 0; r <= ((dupm >> 2) & 1); ++r) { phase_nsa2(ka, layer, lds); __syncthreads(); } }
        else if (q == 3 && QON(3)) { for (int r = 0; r <= ((dupm >> 3) & 1); ++r) { phase_hgrnC(ka, layer, lds); __syncthreads(); } }
        else if (q == 4 && QON(4)) phase_outproj(ka, layer, xin, x1, lds);
        else if (q == 5 && QON(5)) { for (int r = ((dupm >> 5) & 1); r >= 0; --r) { phase_ln1_route(ka, layer, x1, smem, r == 1); __syncthreads(); } }
        else if (q == 6 && QON(6)) { for (int r = 0; r <= ((dupm >> 6) & 1); ++r) { phase_moe_up(ka, layer, lds); __syncthreads(); } }
        else if (q == 7 && QON(7)) { for (int r = 0; r <= ((dupm >> 7) & 1); ++r) { phase_moe_down(ka, layer, lds); __syncthreads(); } }
        else if (q == 8 && QON(8)) { phase_ln2(ka, layer, x1, PF(out)); if (layer == 0) { __syncthreads(); phase_prologue(ka, 1, smem); } }
        if (ph != NPH_TOTAL - 1 || PROF_LO >= 0) xcd_barrier(bar);
        if (PROF_LO >= 0 && blockIdx.x == 0 && threadIdx.x == 0) ((unsigned long long*)(p0.ctl + 8192))[ph + 1] = __builtin_amdgcn_s_memrealtime();
    }
    if (PROF_LO >= 0) {
        xcd_barrier(bar);
        const unsigned long long* ts = (const unsigned long long*)(p0.ctl + 8192);
        const unsigned long long t0 = __hip_atomic_load(&ts[PROF_LO], __ATOMIC_RELAXED, __HIP_MEMORY_SCOPE_AGENT), t1 = __hip_atomic_load(&ts[PROF_HI + 1], __ATOMIC_RELAXED, __HIP_MEMORY_SCOPE_AGENT);
        const float fac = 1.f + 1e-5f * (float)(t1 - t0);
        for (size_t i = (size_t)blockIdx.x * NTHR + threadIdx.x; i < (size_t)NTOK * DM; i += (size_t)gridDim.x * NTHR) p0.out[i] *= fac;
    }
}

static inline size_t align_up(size_t v, size_t a) { return (v + a - 1) / a * a; }

extern "C" void kernel_launch(void* const* d_in, const int* in_sizes, int n_in, void* d_out, int out_size, void* d_ws,
                              size_t ws_size, hipStream_t stream) {
    P p{};
    p.x = (const float*)d_in[0]; p.w_in = (const float*)d_in[1]; p.gm_v_gain = (const float*)d_in[2];
    p.gm_v_bias = (const float*)d_in[3]; p.gm_w_s = (const float*)d_in[4]; p.gm_b_s = (const float*)d_in[5];
    p.cmp_pos = (const float*)d_in[6]; p.cmp_w1 = (const float*)d_in[7]; p.cmp_w2 = (const float*)d_in[8];
    p.nsa_gate_b = (const float*)d_in[9]; p.hg_lower = (const float*)d_in[10]; p.out_gain = (const float*)d_in[11];
    p.w_out = (const float*)d_in[12]; p.ln1_g = (const float*)d_in[13]; p.ln1_b = (const float*)d_in[14];
    p.rg_w = (const float*)d_in[15]; p.rg_b = (const float*)d_in[16]; p.re_w = (const float*)d_in[17];
    p.re_b = (const float*)d_in[18]; p.w_gate = (const float*)d_in[19]; p.w_up = (const float*)d_in[20];
    p.w_down = (const float*)d_in[21]; p.ln2_g = (const float*)d_in[22]; p.ln2_b = (const float*)d_in[23];
    p.out = (float*)d_out;
    char* ws = (char*)d_ws;
    size_t off = 0;
    p.ctl = (unsigned*)(ws + off); off = align_up(off + CTL_BYTES, 256);
    p.WT = (bf16_t*)(ws + off); off = align_up(off + WT_LAYER * 2, 256);
    p.H = (bf16_t*)(ws + off); off = align_up(off + (size_t)(NTOK + 64) * HLD * 2, 256);
    p.Y = (bf16_t*)(ws + off); off = align_up(off + (size_t)NTOK * DM * 2, 256);
    p.XB = (bf16_t*)(ws + off); off = align_up(off + (size_t)NTOK * DM * 2, 256);
    p.kcb = (bf16_t*)(ws + off); off = align_up(off + 2 * ((size_t)4 * 512 * 64 * 2), 256);
    p.vcT = (bf16_t*)(ws + off); off = align_up(off + 2 * ((size_t)4 * 64 * 512 * 2), 256);
    p.vsT = (bf16_t*)(ws + off); off = align_up(off + (size_t)4 * 64 * T_ * 2, 256);
    p.vwT = (bf16_t*)(ws + off); off = align_up(off + (size_t)4 * 64 * T_ * 2, 256);
    p.gb = (bf16_t*)(ws + off); off = align_up(off + 2 * ((size_t)8 * 512 * 128 * 2), 256);
    p.cbias = (float*)(ws + off); off = align_up(off + 2 * (256 * 4), 256);
    p.wrt = (float*)(ws + off); off = align_up(off + 2 * (20 * 1024 * 4), 256);
    p.list_tok = (int*)(ws + off); off = align_up(off + 2 * ((size_t)16 * NTOK * 4), 256);
    p.list_w = (float*)(ws + off); off = align_up(off + 2 * ((size_t)16 * NTOK * 4), 256);
    p.tok_slot = (int*)(ws + off); off = align_up(off + 2 * ((size_t)NTOK * 2 * 4), 256);
    p.hgU = (float*)(ws + off); off = align_up(off + (size_t)1024 * 4096 * 4, 256);
    p.hgS = (float*)(ws + off); off = align_up(off + (size_t)1024 * 4096 * 4, 256);
    p.hgG = (float*)(ws + off); off = align_up(off + 2 * ((size_t)1024 * 64 * 4), 256);
    p.hgQB = (bf16_t*)(ws + off); off = align_up(off + (size_t)1024 * 4096 * 2, 256);
    p.hgO = (bf16_t*)(ws + off); off = align_up(off + (size_t)1024 * 4096 * 2, 256);
    p.nph = NPH_TOTAL; p.pad = DUPMASK;
    (void)in_sizes; (void)n_in; (void)out_size;
    static int grid_blocks = 0;
    if (!grid_blocks) {
        int dev = 0, cus = 0, per_cu = 0;
        (void)hipGetDevice(&dev);
        (void)hipDeviceGetAttribute(&cus, hipDeviceAttributeMultiprocessorCount, dev);
        if (hipFuncSetAttribute((const void*)k_mega, hipFuncAttributeMaxDynamicSharedMemorySize, LDS_BYTES) != hipSuccess) { fprintf(stderr, "hipFuncSetAttribute failed\n"); grid_blocks = -1; return; }
        if (hipOccupancyMaxActiveBlocksPerMultiprocessor(&per_cu, (const void*)k_mega, NTHR, LDS_BYTES) != hipSuccess || per_cu < 1) { fprintf(stderr, "occupancy query says %d\n", per_cu); }
        (void)hipGetLastError();
        grid_blocks = cus;
        off += (size_t)WS_PROBE_PAD;
        if (off > ws_size) { fprintf(stderr, "workspace too small: need %zu have %zu\n", off, ws_size); grid_blocks = -1; }
    }
    if (grid_blocks < 0) return;
    (void)hipMemsetAsync(p.ctl, 0, CTL_BYTES, stream);
    void* args[] = {&p};
    hipError_t e = hipLaunchCooperativeKernel((const void*)k_mega, dim3(grid_blocks), dim3(NTHR), args, LDS_BYTES, stream);
    if (e != hipSuccess) fprintf(stderr, "cooperative launch failed: %s (grid %d)\n", hipGetErrorString(e), grid_blocks);
}
```

```cpp
#include <hip/hip_runtime.h>
#include <cstdio>
#include <cstdint>

#define LAS __attribute__((address_space(3)))
typedef unsigned short bf16_t;
typedef short bf16x8 __attribute__((ext_vector_type(8)));
typedef float f32x4 __attribute__((ext_vector_type(4)));
typedef float f32x2 __attribute__((ext_vector_type(2)));
typedef unsigned u32x4 __attribute__((ext_vector_type(4)));
typedef unsigned u32x2 __attribute__((ext_vector_type(2)));

constexpr int NW = 8;
constexpr int NTHR = NW * 64;
constexpr int T_ = 8192;
constexpr int NTOK = 16384;
constexpr int DM = 1024;
constexpr int IC_SRC = 2840;
constexpr int HLD = 3072;
constexpr int C_GU = 0, C_GV = 256, C_NQ = 512, C_KC = 1024, C_VC = 1152, C_KS = 1280, C_VS = 1408,
              C_KW = 1536, C_VW = 1664, C_HQ = 1792, C_HF = 2048, C_HI = 2304, C_HG = 2560, C_NG = 2816;
constexpr int NCMP = 511;
constexpr float ALPHA = 1.4142135623730951f;
constexpr float NEG_INF = -1e30f;

constexpr size_t WT_IN = 0;
constexpr size_t WT_OUT = WT_IN + (size_t)3072 * 1024;
constexpr size_t WT_UP = WT_OUT + (size_t)1024 * 1024;
constexpr size_t WT_DN = WT_UP + (size_t)16 * 1024 * 1024;
constexpr size_t WT_C1 = WT_DN + (size_t)16 * 1024 * 512;
constexpr size_t WT_GM = WT_C1 + (size_t)2 * 256 * 2048;
constexpr size_t WT_LAYER = WT_GM + (size_t)4 * 128 * 128;

constexpr int LDS_STAGE = 131072;
constexpr int LDS_MISC = LDS_STAGE;
constexpr int LDS_BYTES = 147456;

constexpr int CW_BAR = 0;
constexpr int CW_HG = 7168;
constexpr int CW_CNT = 4096;
constexpr size_t CTL_BYTES = 65536;

struct P {
    const float* x; const float* w_in; const float* gm_v_gain; const float* gm_v_bias; const float* gm_w_s;
    const float* gm_b_s; const float* cmp_pos; const float* cmp_w1; const float* cmp_w2; const float* nsa_gate_b;
    const float* hg_lower; const float* out_gain; const float* w_out; const float* ln1_g; const float* ln1_b;
    const float* rg_w; const float* rg_b; const float* re_w; const float* re_b; const float* w_gate;
    const float* w_up; const float* w_down; const float* ln2_g; const float* ln2_b;
    float* out;
    unsigned* ctl;
    bf16_t* WT;
    bf16_t* H;
    bf16_t* Y;
    bf16_t* XB;
    bf16_t* kcb;
    bf16_t* vcT;
    bf16_t* vsT;
    bf16_t* vwT;
    bf16_t* gb;
    float* cbias;
    float* wrt;
    int* list_tok;
    float* list_w;
    int* tok_slot;
    float* hgU; float* hgG; float* hgS; bf16_t* hgQB; bf16_t* hgO;
    int nph; int pad;
};


struct KA { const __attribute__((address_space(4))) char* p; int wv; };
template <class T> __device__ __forceinline__ T ldarg(KA ka, size_t off) { return *(const __attribute__((address_space(4))) T*)(ka.p + off); }
#define PF(f) ldarg<decltype(P::f)>(ka, offsetof(P, f))

__device__ __forceinline__ float bf2f(bf16_t u) { return __uint_as_float(((unsigned)u) << 16); }
typedef __bf16 bf16x2_t __attribute__((ext_vector_type(2)));
__device__ __forceinline__ unsigned pk2(float lo, float hi) { f32x2 v; v.x = lo; v.y = hi; return __builtin_bit_cast(unsigned, __builtin_convertvector(v, bf16x2_t)); }
__device__ __forceinline__ bf16_t f2bf(float f) { return (bf16_t)(pk2(f, 0.f) & 0xffffu); }
__device__ __forceinline__ float gelu_t(float x) {
    const float u2 = -2.f * 0.7978845608028654f * (x + 0.044715f * x * x * x);
    return x / (1.f + __expf(u2));
}
__device__ __forceinline__ float gelu_slow(float x) {
    float u = 0.7978845608028654f * (x + 0.044715f * x * x * x);
    return 0.5f * x * (1.f + tanhf(u));
}
__device__ __forceinline__ float sigmoidf_(float x) { return 1.f / (1.f + __expf(-x)); }
__device__ __forceinline__ float wave_max(float v) {
#pragma unroll
    for (int o = 32; o > 0; o >>= 1) v = fmaxf(v, __shfl_xor(v, o));
    return v;
}
__device__ __forceinline__ float wave_sum(float v) {
#pragma unroll
    for (int o = 32; o > 0; o >>= 1) v += __shfl_xor(v, o);
    return v;
}
__device__ __forceinline__ void wave_sync() {
    __builtin_amdgcn_fence(__ATOMIC_RELEASE, "wavefront");
    __builtin_amdgcn_wave_barrier();
    __builtin_amdgcn_fence(__ATOMIC_ACQUIRE, "wavefront");
}
__device__ __forceinline__ f32x4 zero4() { f32x4 z = {0.f, 0.f, 0.f, 0.f}; asm volatile("" : "+v"(z)); return z; }
__device__ __forceinline__ int opaque_tid(int wv) {
    int t = wv * 64 + (int)__builtin_amdgcn_mbcnt_hi(~0u, __builtin_amdgcn_mbcnt_lo(~0u, 0u));
    asm volatile("" : "+v"(t));
    return t;
}
__device__ __forceinline__ int opaque_bid() { int b = blockIdx.x; asm volatile("" : "+s"(b)); return b; }
#define PHASE_IDS const int TID = opaque_tid(ka.wv); const int BID = opaque_bid(); (void)TID; (void)BID;
__device__ __forceinline__ int queue_fetch(KA ka, unsigned* head, LAS unsigned char* lds) {
    volatile LAS int* slot = (volatile LAS int*)(lds + LDS_MISC + 48);
    if (opaque_tid(ka.wv) == 0) *slot = (int)__hip_atomic_fetch_add(head, 1u, __ATOMIC_RELAXED, __HIP_MEMORY_SCOPE_AGENT);
    __syncthreads();
    const int v = *slot;
    __syncthreads();
    return __builtin_amdgcn_readfirstlane(v);
}

#define XB_TMO      128
#define XB_XCNT(j)  (256  + 64 * (j))
#define XB_XSUB(j)  (1280 + 64 * (j))
#define XB_XGEN(j)  (2304 + 64 * (j))
#define XB_TOP      3328
#define XB_TOPGEN   3392
#define XCD_BAR_WORDS 3456
#define XB_SPIN_CAP (1u << 22)
__device__ __forceinline__ unsigned xb_ld(unsigned* p)              { return __hip_atomic_load(p, __ATOMIC_RELAXED, __HIP_MEMORY_SCOPE_AGENT); }
__device__ __forceinline__ unsigned xb_add(unsigned* p, unsigned v) { return __hip_atomic_fetch_add(p, v, __ATOMIC_RELAXED, __HIP_MEMORY_SCOPE_AGENT); }
__device__ __forceinline__ unsigned xb_xcc_id() { return (unsigned)__builtin_amdgcn_s_getreg((3 << 11) | 20) & 0xFu; }
#define XB_SPIN(cond, bar) do { unsigned _sp = 0; while (cond) { __builtin_amdgcn_s_sleep(1); \
    if ((++_sp & 255u) == 0u) { if (xb_ld(&(bar)[XB_TMO])) break; if (_sp > XB_SPIN_CAP) { atomicAdd(&(bar)[XB_TMO], 1u); break; } } } } while (0)
struct XcdBarrier { unsigned* bar; unsigned x; volatile LAS unsigned* st; int wv; };
__device__ __forceinline__ XcdBarrier xcd_barrier_post(unsigned* bar, volatile LAS unsigned* st) {
    XcdBarrier b; b.bar = bar; b.x = xb_xcc_id(); b.st = st;
    if (threadIdx.x == 0) (void)xb_add(&bar[XB_XCNT(b.x)], 1u);
    return b;
}
__device__ __forceinline__ void xcd_barrier_complete(unsigned* bar, unsigned x, unsigned& nloc, unsigned& nx) {
    const unsigned G = gridDim.x * gridDim.y * gridDim.z;
    unsigned sum, cnt, mine, sp = 0u;
    for (;;) {
        sum = 0u; cnt = 0u; mine = 0u;
#pragma unroll
        for (unsigned j = 0; j < 16; ++j) { const unsigned c = xb_ld(&bar[XB_XCNT(j)]); sum += c; cnt += (c > 0u) ? 1u : 0u; mine = (j == x) ? c : mine; }
        if (sum == G) break;
        __builtin_amdgcn_s_sleep(1);
        if ((++sp & 255u) == 0u) { if (xb_ld(&bar[XB_TMO])) break; if (sp > XB_SPIN_CAP) { atomicAdd(&bar[XB_TMO], 1u); break; } }
    }
    nloc = mine > 0u ? mine : 1u; nx = cnt > 0u ? cnt : 1u;
}
__device__ __forceinline__ void xcd_barrier(const XcdBarrier& b) {
    asm volatile("s_waitcnt vmcnt(0)" ::: "memory");
    __syncthreads();
    if (opaque_tid(b.wv) == 0) {
        unsigned* bar = b.bar;
        __builtin_amdgcn_s_waitcnt(0);
        unsigned nloc = b.st[0], nx = b.st[1];
        if (nloc == 0u) { xcd_barrier_complete(bar, b.x, nloc, nx); b.st[0] = nloc; b.st[1] = nx; }
        const unsigned old = xb_add(&bar[XB_XSUB(b.x)], 1u);
        const unsigned gen = old / nloc;
        if (old + 1u == (gen + 1u) * nloc) {
            __builtin_amdgcn_fence(__ATOMIC_RELEASE, "agent");
            asm volatile("s_waitcnt vmcnt(0)" ::: "memory");
            const unsigned og = xb_add(&bar[XB_TOP], 1u);
            const unsigned tg = og / nx;
            if (og + 1u != (tg + 1u) * nx) XB_SPIN(xb_ld(&bar[XB_TOP]) < (tg + 1u) * nx, bar);
            __builtin_amdgcn_fence(__ATOMIC_ACQUIRE, "agent");
            xb_add(&bar[XB_XGEN(b.x)], 1u);
            asm volatile("s_waitcnt vmcnt(0)" ::: "memory");
        } else {
            XB_SPIN(xb_ld(&bar[XB_XGEN(b.x)]) == gen, bar);
            __builtin_amdgcn_fence(__ATOMIC_ACQUIRE, "agent");
            asm volatile("s_waitcnt vmcnt(0)" ::: "memory");
        }
    }
    __syncthreads();
}

namespace pg8 {
constexpr int BM = 256, BK = 64, HALF = 128, HTB = HALF * BK * 2, STAGE_BYTES = 8 * HTB;
__host__ __device__ __forceinline__ int lds_byte(int r, int c) { const int st = (r >> 4) * 2 + (c >> 5), rr = r & 15, cc = c & 31, ob = rr * 64 + cc * 2; return st * 1024 + (ob ^ (((ob >> 9) & 1) << 5)); }
__host__ __device__ __forceinline__ void stage_rc(int b, int& R, int& C) { const int st = b / 1024, sb = b % 1024, swz = sb ^ (((sb >> 9) & 1) << 5); R = (st >> 1) * 16 + swz / 64; C = (st & 1) * 32 + (swz % 64) / 2; }
__host__ __device__ __forceinline__ int perm32(int rho) { const int n = rho >> 4, i = rho & 15; return 8 * (i >> 2) + 4 * n + (i & 3); }
__device__ __forceinline__ unsigned cvt_pk_bf16(float lo, float hi) { return pk2(lo, hi); }

struct Unit {
    const char* bptr;
    int arow0;
    int nrows;
    int pm, pn, e, ui;
};

template <class Epi, class Sched>
__device__ __forceinline__ void gemm_phase(LAS unsigned char* lds, const char* Abase, const int K, const Sched& S, const Epi& E, const int wv) {
    const int tid = opaque_tid(wv), wid = __builtin_amdgcn_readfirstlane(tid >> 6), lane = tid & 63, wr = wid >> 2, wc = wid & 3, fr = lane & 15, fq = lane >> 4;
    const int nt = K / BK;
    int R0, C0, R1, C1; stage_rc(tid * 16, R0, C0); stage_rc(tid * 16 + 8192, R1, C1);
    unsigned voffB[2];
    { const int Rb0 = Epi::PERM ? ((R0 & ~31) + perm32(R0 & 31)) : R0, Rb1 = Epi::PERM ? ((R1 & ~31) + perm32(R1 & 31)) : R1;
      voffB[0] = (unsigned)(Rb0 * K + C0) * 2u; voffB[1] = (unsigned)(Rb1 * K + C1) * 2u; }
    const unsigned cA0 = (unsigned)C0 * 2u, cA1 = (unsigned)C1 * 2u;
    const int lda = S.lda(K);
    const unsigned kstepA = S.kstepA();
    const unsigned voffA0 = (unsigned)(R0 * lda + C0) * 2u, voffA1 = (unsigned)(R1 * lda + C1) * 2u;
    const unsigned kstep = (unsigned)(BK * 2);
    const unsigned hstep = (unsigned)(HALF * K * 2);
    const unsigned ldsw = (unsigned)wid * 1024u;
    const int aoff = lds_byte(wr * 64 + fr, fq * 8), boff = lds_byte(wc * 32 + fr, fq * 8);
#define PG8_SA(b, h) (((b) * 2 + (h)) * HTB)
#define PG8_SB(b, h) ((4 + (b) * 2 + (h)) * HTB)
#define PG8_STAGE_B(bufoff, gbase) do { \
        __builtin_amdgcn_global_load_lds((const unsigned*)((const char*)(gbase) + voffB[0]), (LAS unsigned*)(lds + (bufoff) + ldsw), 16, 0, 0); \
        __builtin_amdgcn_global_load_lds((const unsigned*)((const char*)(gbase) + voffB[1]), (LAS unsigned*)(lds + (bufoff) + ldsw + 8192), 16, 0, 0); } while (0)
#define PG8_STAGE_A(bufoff, gbase, pk) do { \
        const unsigned o0_ = Sched::GATHER ? (((pk) & 0xffffu) * (unsigned)lda * 2u + cA0) : voffA0; \
        const unsigned o1_ = Sched::GATHER ? (((pk) >> 16) * (unsigned)lda * 2u + cA1) : voffA1; \
        __builtin_amdgcn_global_load_lds((const unsigned*)((const char*)(gbase) + o0_), (LAS unsigned*)(lds + (bufoff) + ldsw), 16, 0, 0); \
        __builtin_amdgcn_global_load_lds((const unsigned*)((const char*)(gbase) + o1_), (LAS unsigned*)(lds + (bufoff) + ldsw + 8192), 16, 0, 0); } while (0)
#define PG8_LDA(dst, b, h) do { _Pragma("unroll") for (int m = 0; m < 4; ++m) _Pragma("unroll") for (int k = 0; k < 2; ++k) dst[m][k] = *(const LAS bf16x8*)(lds + PG8_SA(b, h) + aoff + m * 2048 + k * 1024); } while (0)
#define PG8_LDB(dst, b, h) do { _Pragma("unroll") for (int n = 0; n < 2; ++n) _Pragma("unroll") for (int k = 0; k < 2; ++k) dst[n][k] = *(const LAS bf16x8*)(lds + PG8_SB(b, h) + boff + n * 2048 + k * 1024); } while (0)
#define PG8_MMA(ai, bj, At, Bt) do { __builtin_amdgcn_s_setprio(1); _Pragma("unroll") for (int m = 0; m < 4; ++m) _Pragma("unroll") for (int n = 0; n < 2; ++n) _Pragma("unroll") for (int k = 0; k < 2; ++k) \
        acc[ai][bj][m][n] = __builtin_amdgcn_mfma_f32_16x16x32_bf16(Bt[n][k], At[m][k], acc[ai][bj][m][n], 0, 0, 0); __builtin_amdgcn_s_setprio(0); } while (0)
#define PG8_WAIT_V(n) asm volatile("s_waitcnt vmcnt(" #n ")" ::: "memory")
#define PG8_WAIT_L(n) asm volatile("s_waitcnt lgkmcnt(" #n ")" ::: "memory")
#define PG8_BAR __builtin_amdgcn_s_barrier()
#define PG8_SCHED __builtin_amdgcn_sched_barrier(0)
#define PG8_PACK(u, h) ((unsigned)S.arow((u), ((h) * 128 + R0) < (u).nrows ? ((h) * 128 + R0) : (u).nrows - 1) | ((unsigned)S.arow((u), ((h) * 128 + R1) < (u).nrows ? ((h) * 128 + R1) : (u).nrows - 1) << 16))
    Unit cur, nxt; int ui = 0;
    if (!S.next(0, cur)) return;
    f32x4 acc[2][2][4][2];
    const f32x4 zv = zero4();
#pragma unroll
    for (int a = 0; a < 2; ++a)
#pragma unroll
        for (int b = 0; b < 2; ++b)
#pragma unroll
            for (int m = 0; m < 4; ++m)
#pragma unroll
                for (int n = 0; n < 2; ++n) acc[a][b][m][n] = zv;
    bf16x8 At[4][2], B0[2][2], B1[2][2];
    unsigned pC0 = 0u, pC1 = 0u, pN0 = 0u, pN1 = 0u;
    if (Sched::GATHER) { pC0 = PG8_PACK(cur, 0); pC1 = PG8_PACK(cur, 1); }
    const char* cB = cur.bptr;
    const char* cA = Sched::GATHER ? Abase : S.abase(cur, Abase) + (size_t)cur.arow0 * lda * 2;
    const unsigned hA = Sched::GATHER ? 0u : (unsigned)(HALF * lda * 2);
    PG8_STAGE_B(PG8_SB(0, 0), cB); PG8_STAGE_B(PG8_SB(0, 1), cB + hstep); PG8_STAGE_A(PG8_SA(0, 0), cA, pC0); PG8_STAGE_A(PG8_SA(0, 1), cA + hA, pC1);
    if (wr == 1) PG8_BAR;
    PG8_WAIT_V(2); PG8_BAR;
    PG8_STAGE_B(PG8_SB(1, 0), cB + kstep); PG8_STAGE_A(PG8_SA(1, 0), cA + kstepA, pC0); PG8_STAGE_B(PG8_SB(1, 1), cB + hstep + kstep);
    PG8_WAIT_V(6); PG8_BAR;
    for (;;) {
        const bool has_next = S.next(ui + 1, nxt);
        if (Sched::GATHER) { if (has_next) { pN0 = PG8_PACK(nxt, 0); pN1 = PG8_PACK(nxt, 1); } else { pN0 = pC0; pN1 = pC1; } }
        const char* nB = has_next ? nxt.bptr : cB;
        const char* nA = (Sched::GATHER || !has_next) ? cA : S.abase(nxt, Abase) + (size_t)nxt.arow0 * lda * 2;
        for (int t = 0; t < nt; t += 2) {
            const bool last = (t == nt - 2);
            const char* a1 = cA + (unsigned)(t + 1) * kstepA;
            const char* a2 = last ? nA : cA + (unsigned)(t + 2) * kstepA; const char* b2 = last ? nB : cB + (unsigned)(t + 2) * kstep;
            const char* a3 = a2 + kstepA; const char* b3 = b2 + kstep;
            const unsigned s0 = last ? pN0 : pC0, s1 = last ? pN1 : pC1;
            PG8_LDB(B0, 0, 0); PG8_LDB(B1, 0, 1); PG8_SCHED; PG8_LDA(At, 0, 0); PG8_STAGE_A(PG8_SA(1, 1), a1 + hA, pC1);
            PG8_WAIT_V(8); PG8_WAIT_L(0); PG8_BAR; PG8_MMA(0, 0, At, B0); PG8_MMA(0, 1, At, B1); PG8_BAR; PG8_SCHED;
            PG8_LDA(At, 0, 1); PG8_STAGE_B(PG8_SB(0, 0), b2); PG8_STAGE_B(PG8_SB(0, 1), b2 + hstep); PG8_STAGE_A(PG8_SA(0, 0), a2, s0);
            PG8_WAIT_V(8); PG8_WAIT_L(0); PG8_BAR; PG8_MMA(1, 0, At, B0); PG8_MMA(1, 1, At, B1); PG8_BAR; PG8_SCHED;
            PG8_LDB(B0, 1, 0); PG8_LDB(B1, 1, 1); PG8_SCHED; PG8_LDA(At, 1, 0); PG8_STAGE_A(PG8_SA(0, 1), a2 + hA, s1);
            PG8_WAIT_V(8); PG8_WAIT_L(0); PG8_BAR; PG8_MMA(0, 0, At, B0); PG8_MMA(0, 1, At, B1); PG8_BAR; PG8_SCHED;
            PG8_LDA(At, 1, 1); PG8_STAGE_B(PG8_SB(1, 0), b3); PG8_STAGE_B(PG8_SB(1, 1), b3 + hstep); PG8_STAGE_A(PG8_SA(1, 0), a3, s0);
            PG8_WAIT_V(8); PG8_WAIT_L(0); PG8_BAR; PG8_MMA(1, 0, At, B0); PG8_MMA(1, 1, At, B1); PG8_BAR; PG8_SCHED;
        }
        if (wr == 0) PG8_BAR;
        E(acc, cur, wr, wc, fr, fq);
        if (!has_next) break;
#pragma unroll
        for (int a = 0; a < 2; ++a)
#pragma unroll
            for (int b = 0; b < 2; ++b)
#pragma unroll
                for (int m = 0; m < 4; ++m)
#pragma unroll
                    for (int n = 0; n < 2; ++n) acc[a][b][m][n] = zv;
        cur = nxt; cB = nB; cA = nA; ++ui;
        pC0 = pN0; pC1 = pN1;
        if (wr == 1) PG8_BAR;
    }
    PG8_WAIT_V(0);
    PG8_BAR;
#undef PG8_SA
#undef PG8_SB
#undef PG8_STAGE_A
#undef PG8_STAGE_B
#undef PG8_LDA
#undef PG8_LDB
#undef PG8_MMA
#undef PG8_WAIT_V
#undef PG8_WAIT_L
#undef PG8_BAR
#undef PG8_SCHED
#undef PG8_PACK
}

struct DenseOrder {
    static constexpr bool GATHER = false;
    int nM, nN, nwg, G, c; const char* Bt; int K;
    __device__ void init(int M, int N, int K_, const bf16_t* Bt_, int G_, int c_) { nM = M / BM; nN = N / BM; nwg = nM * nN; G = G_; c = c_; Bt = (const char*)Bt_; K = K_; }
    __device__ __forceinline__ bool next(int i, Unit& u) const {
        const long L = (long)i * G + c; if (L >= nwg) return false;
        int wgid = (int)L; { const int q = nwg / 8, r = nwg % 8, xcd = wgid % 8, off = wgid / 8; wgid = (xcd < r ? xcd * (q + 1) : r * (q + 1) + (xcd - r) * q) + off; }
        const int nig = 8 * nN, gid = wgid / nig, fm = gid * 8, gsz = (nM - fm) < 8 ? (nM - fm) : 8;
        u.pm = fm + ((wgid % nig) % gsz); u.pn = (wgid % nig) / gsz;
        u.arow0 = u.pm * BM; u.nrows = BM; u.e = 0; u.ui = i;
        u.bptr = Bt + (size_t)u.pn * BM * K * 2;
        return true;
    }
    __device__ __forceinline__ int arow(const Unit& u, int r) const { return u.arow0 + r; }
    __device__ __forceinline__ int lda(int K_) const { return K_; }
    __device__ __forceinline__ unsigned kstepA() const { return 128u; }
    __device__ __forceinline__ const char* abase(const Unit&, const char* A) const { return A; }
};
}

struct EpiH {
    static constexpr bool PERM = true;
    bf16_t* H;
    __device__ __forceinline__ void operator()(const f32x4 (&acc)[2][2][4][2], const pg8::Unit& u, int wr, int wc, int fr, int fq) const {
        const int row0 = u.arow0 + wr * 64 + fr, col0 = u.pn * 256 + wc * 32 + 8 * fq;
#pragma unroll
        for (int ai = 0; ai < 2; ++ai)
#pragma unroll
            for (int m = 0; m < 4; ++m) {
                bf16_t* rowp = H + (size_t)(row0 + ai * 128 + m * 16) * HLD + col0;
#pragma unroll
                for (int bj = 0; bj < 2; ++bj) {
                    const f32x4 v0 = acc[ai][bj][m][0], v1 = acc[ai][bj][m][1];
                    u32x4 w; w.x = pg8::cvt_pk_bf16(v0[0], v0[1]); w.y = pg8::cvt_pk_bf16(v0[2], v0[3]); w.z = pg8::cvt_pk_bf16(v1[0], v1[1]); w.w = pg8::cvt_pk_bf16(v1[2], v1[3]);
                    *(u32x4*)(rowp + bj * 128) = w;
                }
            }
    }
};
struct EpiRes {
    static constexpr bool PERM = false;
    const float* xin; bf16_t* out; int layer;
    __device__ __forceinline__ void operator()(const f32x4 (&acc)[2][2][4][2], const pg8::Unit& u, int wr, int wc, int fr, int fq) const {
        const int row0 = u.arow0 + wr * 64 + fr, col0 = u.pn * 256 + wc * 32 + 4 * fq;
#pragma unroll
        for (int ai = 0; ai < 2; ++ai)
#pragma unroll
            for (int m = 0; m < 4; ++m) {
                const size_t off = (size_t)(row0 + ai * 128 + m * 16) * DM + col0;
#pragma unroll
                for (int bj = 0; bj < 2; ++bj)
#pragma unroll
                    for (int n = 0; n < 2; ++n) {
                        f32x4 xv;
                        if (layer == 0) xv = *(const f32x4*)(xin + off + bj * 128 + n * 16);
                        else { const u32x2 xw = *(const u32x2*)(out + off + bj * 128 + n * 16); xv[0] = __uint_as_float(xw.x << 16); xv[1] = __uint_as_float(xw.x & 0xffff0000u); xv[2] = __uint_as_float(xw.y << 16); xv[3] = __uint_as_float(xw.y & 0xffff0000u); }
                        const f32x4 r = xv * ALPHA + acc[ai][bj][m][n];
                        u32x2 pw; pw.x = pk2(r[0], r[1]); pw.y = pk2(r[2], r[3]);
                        *(u32x2*)(out + off + bj * 128 + n * 16) = pw;
                    }
            }
    }
};

template <class RM>
__device__ __forceinline__ void transpose_item(const float* W, int K, int N, bf16_t* WT, RM rowmap, float* scr, int kb, int nb, int lane) {
    const int k0 = 64 * kb, n0 = 32 * nb;
    const int nn = n0 + (lane & 31);
    float tmp[32];
#pragma unroll
    for (int i = 0; i < 32; ++i) {
        const int kk = 2 * i + (lane >> 5);
        tmp[i] = nn < N ? W[(size_t)(k0 + kk) * N + nn] : 0.f;
    }
#pragma unroll
    for (int i = 0; i < 32; ++i) {
        const int kk = 2 * i + (lane >> 5);
        scr[kk * 33 + (lane & 31)] = tmp[i];
    }
    wave_sync();
    const int c = lane & 7;
#pragma unroll
    for (int j = 0; j < 4; ++j) {
        const int n = (lane >> 3) + 8 * j;
        const float* s = scr + (8 * c) * 33 + n;
        u32x4 o; o.x = pk2(s[0 * 33], s[1 * 33]); o.y = pk2(s[2 * 33], s[3 * 33]); o.z = pk2(s[4 * 33], s[5 * 33]); o.w = pk2(s[6 * 33], s[7 * 33]);
        const int dr = (n0 + n < N) ? rowmap(n0 + n) : -1;
        if (dr >= 0) *(u32x4*)(WT + (size_t)dr * K + k0 + 8 * c) = o;
    }
    wave_sync();
}

__device__ void phase_prologue(KA ka, int layer, float* smem) {
    PHASE_IDS
    const int lane = TID & 63, w = TID >> 6;
    float* scr = smem + w * 4096;
    const int gw = BID * NW + w, NGW = gridDim.x * NW;
    constexpr int I_IN = 16 * 89, I_OUT = 16 * 32, I_GU = 16 * 16, I_DN = 8 * 32;
    constexpr int I_LAYER = I_IN + I_OUT + 32 * I_GU + 16 * I_DN;
    for (int it = gw; it < I_LAYER; it += NGW) {
        int r = it;
        bf16_t* WT = PF(WT);
        if (r < I_IN) {
            transpose_item(PF(w_in) + (size_t)layer * DM * IC_SRC, DM, IC_SRC, WT + WT_IN,
                           [](int n) { return n < 1792 ? n : (n < 1816 ? 2816 + (n - 1792) : n - 24); }, scr, r / 89, r % 89, lane);
            continue;
        }
        r -= I_IN;
        if (r < I_OUT) {
            transpose_item(PF(w_out) + (size_t)layer * DM * DM, DM, DM, WT + WT_OUT, [](int n) { return n; }, scr, r / 32, r % 32, lane);
            continue;
        }
        r -= I_OUT;
        if (r < 32 * I_GU) {
            const int mat = r / I_GU, rr = r % I_GU, e = mat >> 1, isup = mat & 1;
            const float* W = (isup ? PF(w_up) : PF(w_gate)) + ((size_t)layer * 16 + e) * DM * 512;
            transpose_item(W, DM, 512, WT + WT_UP + (size_t)e * 1024 * 1024,
                           [isup](int n) { return (n >> 7) * 256 + isup * 128 + (n & 127); }, scr, rr / 16, rr % 16, lane);
            continue;
        }
        r -= 32 * I_GU;
        {
            const int e = r / I_DN, rr = r % I_DN;
            transpose_item(PF(w_down) + ((size_t)layer * 16 + e) * 512 * DM, 512, DM, WT + WT_DN + (size_t)e * 1024 * 512,
                           [](int n) { return n; }, scr, rr / 32, rr % 32, lane);
        }
    }
    for (int it = gw; it < 2 * 32 * 4; it += NGW) {
        const int which = it >> 7, rr = it & 127;
        transpose_item(PF(cmp_w1) + ((size_t)layer * 2 + which) * 2048 * 128, 2048, 128, PF(WT) + WT_C1 + (size_t)which * 256 * 2048, [](int n) { return n; }, scr, rr >> 2, rr & 3, lane);
    }
    for (int i = BID * NTHR + TID; i < 2 * 128 * 256; i += gridDim.x * NTHR) {
        const int which = i >> 15, q = i & 32767;
        const u32x4 z = __builtin_bit_cast(u32x4, zero4());
        *(u32x4*)(PF(WT) + WT_C1 + (size_t)which * 256 * 2048 + (size_t)128 * 2048 + (size_t)q * 8) = z;
    }
    for (int o = gw; o < 256; o += NGW) {
        const int which = o >> 7, cc = o & 127;
        const float* w1 = PF(cmp_w1) + ((size_t)layer * 2 + which) * 2048 * 128;
        const float* pos = PF(cmp_pos) + ((size_t)layer * 2 + which) * 2048;
        float a = 0.f;
        for (int k = lane; k < 2048; k += 64) a = fmaf(pos[k], w1[(size_t)k * 128 + cc], a);
        a = wave_sum(a);
        if (lane == 0) (PF(cbias) + layer * (256))[o] = a;
    }
    for (int i = BID * NTHR + TID; i < 4 * 128 * 128; i += gridDim.x * NTHR) {
        const int s = i & 127, t = (i >> 7) & 127;
        PF(WT)[WT_GM + i] = (s <= t) ? f2bf(PF(gm_w_s)[(size_t)layer * 4 * 128 * 128 + i]) : (bf16_t)0;
    }
    for (int i = BID * NTHR + TID; i < 20 * 1024; i += gridDim.x * NTHR) {
        const int o = i >> 10, cc = i & 1023;
        (PF(wrt) + layer * (20480))[i] = o < 4 ? PF(rg_w)[((size_t)layer * 1024 + cc) * 4 + o] : PF(re_w)[((size_t)layer * 1024 + cc) * 16 + (o - 4)];
    }
    for (int i = BID * NTHR + TID; i < 232 * 128; i += gridDim.x * NTHR) {
        const int q = i;
        const u32x4 z = __builtin_bit_cast(u32x4, zero4());
        *(u32x4*)(PF(WT) + WT_IN + (size_t)2840 * 1024 + (size_t)q * 8) = z;
    }
    if (layer == 0)
    for (int row = gw; row < NTOK; row += NGW) {
        const f32x4* xr = (const f32x4*)(PF(x) + (size_t)row * DM) + lane;
        u32x2* o = (u32x2*)(PF(XB) + (size_t)row * DM) + lane;
#pragma unroll
        for (int j = 0; j < 4; ++j) {
            const f32x4 v = xr[64 * j];
            u32x2 ww; ww.x = pk2(v[0], v[1]); ww.y = pk2(v[2], v[3]);
            o[64 * j] = ww;
        }
    }
}

template <class AF, class BF, class EF>
__device__ __forceinline__ void gemm128(int tid, int m0, int n0, int M, int N, int K, AF af, BF bf, EF ef, float* smem) {
    float* As = smem;
    float* Bs = smem + 16 * 132;
    const bool active = tid < 256;
    const int tx = tid & 15, ty = (tid >> 4) & 15;
    float acc[8][8];
#pragma unroll
    for (int i = 0; i < 8; i++)
#pragma unroll
        for (int j = 0; j < 8; j++) acc[i][j] = 0.f;
#pragma unroll 1
    for (int k0 = 0; k0 < K; k0 += 16) {
        if (active) {
#pragma unroll
            for (int i = 0; i < 8; i++) {
                int e = tid + i * 256;
                int r = e >> 4, kk = e & 15;
                float v = 0.f;
                if (m0 + r < M) v = af(m0 + r, k0 + kk);
                As[kk * 132 + r] = v;
            }
#pragma unroll
            for (int i = 0; i < 8; i++) {
                int e = tid + i * 256;
                int kk = e >> 7, c = e & 127;
                float v = 0.f;
                if (n0 + c < N) v = bf(k0 + kk, n0 + c);
                Bs[kk * 132 + c] = v;
            }
        }
        __syncthreads();
        if (active) {
#pragma unroll 2
            for (int kk = 0; kk < 16; kk++) {
                asm volatile("" ::: "memory");
                float4 a0 = *(const float4*)&As[kk * 132 + ty * 8];
                float4 a1 = *(const float4*)&As[kk * 132 + ty * 8 + 4];
                float4 b0 = *(const float4*)&Bs[kk * 132 + tx * 8];
                float4 b1 = *(const float4*)&Bs[kk * 132 + tx * 8 + 4];
                float a[8] = {a0.x, a0.y, a0.z, a0.w, a1.x, a1.y, a1.z, a1.w};
                float b[8] = {b0.x, b0.y, b0.z, b0.w, b1.x, b1.y, b1.z, b1.w};
#pragma unroll
                for (int i = 0; i < 8; i++)
#pragma unroll
                    for (int j = 0; j < 8; j++) acc[i][j] = fmaf(a[i], b[j], acc[i][j]);
            }
        }
        __syncthreads();
    }
    if (active) {
#pragma unroll
        for (int i = 0; i < 8; i++)
#pragma unroll
            for (int j = 0; j < 8; j++) {
                int m = m0 + ty * 8 + i, n = n0 + tx * 8 + j;
                if (m < M && n < N) ef(m, n, acc[i][j]);
            }
    }
}

__device__ __forceinline__ void phase_inproj(KA ka, int layer, LAS unsigned char* lds) {
    pg8::DenseOrder S; S.init(NTOK, HLD, DM, PF(WT) + WT_IN, gridDim.x, opaque_bid());
    EpiH E{PF(H)};
    pg8::gemm_phase<EpiH, pg8::DenseOrder>(lds, (const char*)PF(XB), DM, S, E, ka.wv);
}
__device__ __forceinline__ void phase_outproj(KA ka, int layer, const float* xin, float* x1, LAS unsigned char* lds) {
    pg8::DenseOrder S; S.init(NTOK, DM, DM, PF(WT) + WT_OUT, gridDim.x, opaque_bid());
    EpiRes E{xin, PF(XB), layer}; (void)x1;
    pg8::gemm_phase<EpiRes, pg8::DenseOrder>(lds, (const char*)PF(Y), DM, S, E, ka.wv);
}

__device__ void phase_ln1_route(KA ka, int layer, float* x1, float* smem, bool dry) {
    PHASE_IDS
    bf16_t* xb = PF(XB);
    (void)x1;
    const int lane = TID & 63, w = TID >> 6;
    const float* g = PF(ln1_g) + layer * 1024;
    const float* bb = PF(ln1_b) + layer * 1024;
    const float* wg = PF(rg_w) + (size_t)layer * 1024 * 4;
    const float* we = PF(re_w) + (size_t)layer * 1024 * 16;
    const float* bg = PF(rg_b) + layer * 4;
    const float* be = PF(re_b) + layer * 16;
    int* cnt = (int*)(PF(ctl) + CW_CNT) + layer * 16 * 64 + (dry ? 2048 : 0);
    int* lcnt = (int*)(smem + 20 * 1024);
    int* rinfo = lcnt + 64;
    float* rwt = (float*)(rinfo + 4 * 128);
    if (TID < 32) lcnt[TID] = 0;
    float* WR = smem;
    __syncthreads();
    for (int idx = TID; idx < 20 * 256; idx += NTHR) *(f32x4*)(WR + 4 * idx) = *(const f32x4*)((PF(wrt) + layer * (20480)) + 4 * idx);
    __syncthreads();
    int nloc = 0;
    u32x2 xwn[4];
    if (BID * NW + w < NTOK) {
#pragma unroll
        for (int j = 0; j < 4; ++j) xwn[j] = *(const u32x2*)(xb + (size_t)(BID * NW + w) * DM + 256 * j + 4 * lane);
    }
    for (int row = BID * NW + w; row < NTOK; row += gridDim.x * NW) {
        f32x4 v[4];
        float s = 0.f;
        u32x2 xwc[4];
#pragma unroll
        for (int j = 0; j < 4; ++j) xwc[j] = xwn[j];
        if (row + (int)gridDim.x * NW < NTOK) {
#pragma unroll
            for (int j = 0; j < 4; ++j) xwn[j] = *(const u32x2*)(xb + (size_t)(row + gridDim.x * NW) * DM + 256 * j + 4 * lane);
        }
#pragma unroll
        for (int j = 0; j < 4; ++j) {
            const u32x2 xw = xwc[j];
            v[j][0] = __uint_as_float(xw.x << 16); v[j][1] = __uint_as_float(xw.x & 0xffff0000u); v[j][2] = __uint_as_float(xw.y << 16); v[j][3] = __uint_as_float(xw.y & 0xffff0000u);
            s += (v[j][0] + v[j][1]) + (v[j][2] + v[j][3]);
        }
        const float mu = wave_sum(s) * (1.f / 1024.f);
        float q = 0.f;
#pragma unroll
        for (int j = 0; j < 4; ++j) { v[j] = v[j] - mu; q += (v[j][0] * v[j][0] + v[j][1] * v[j][1]) + (v[j][2] * v[j][2] + v[j][3] * v[j][3]); }
        const float rstd = rsqrtf(wave_sum(q) * (1.f / 1024.f) + 1e-5f);
#pragma unroll
        for (int j = 0; j < 4; ++j) {
            const int c = 256 * j + 4 * lane;
            v[j] = v[j] * rstd * *(const f32x4*)(g + c) + *(const f32x4*)(bb + c);
            u32x2 pw; pw.x = pk2(v[j][0], v[j][1]); pw.y = pk2(v[j][2], v[j][3]);
            *(u32x2*)(xb + (size_t)row * DM + c) = pw;
        }
        float lg[4], le[16];
#pragma unroll
        for (int o = 0; o < 20; ++o) {
            asm volatile("" ::: "memory");
            float a = 0.f;
#pragma unroll
            for (int j = 0; j < 4; ++j) {
                const f32x4 w4 = *(const f32x4*)(WR + o * 1024 + 256 * j + 4 * lane);
                a += (v[j][0] * w4[0] + v[j][1] * w4[1]) + (v[j][2] * w4[2] + v[j][3] * w4[3]);
            }
            a = wave_sum(a);
            if (o < 4) lg[o] = a + bg[o]; else le[o - 4] = a + be[o - 4];
        }
        float gm = fmaxf(fmaxf(lg[0], lg[1]), fmaxf(lg[2], lg[3]));
        float ge[4], gs = 0.f;
#pragma unroll
        for (int c = 0; c < 4; c++) { ge[c] = __expf(lg[c] - gm); gs += ge[c]; }
        int gi = 0; float gbest = ge[0];
#pragma unroll
        for (int c = 1; c < 4; c++) if (ge[c] > gbest) { gbest = ge[c]; gi = c; }
        float gval = gbest / gs;
        float ls[4];
#pragma unroll
        for (int e = 0; e < 4; e++) ls[e] = gi == 0 ? le[e] : gi == 1 ? le[4 + e] : gi == 2 ? le[8 + e] : le[12 + e];
        float em = fmaxf(fmaxf(ls[0], ls[1]), fmaxf(ls[2], ls[3]));
        float pe[4];
#pragma unroll
        for (int e = 0; e < 4; e++) pe[e] = __expf(ls[e] - em);
        int i1 = 0; float b1 = pe[0];
#pragma unroll
        for (int e = 1; e < 4; e++) if (pe[e] > b1) { b1 = pe[e]; i1 = e; }
        int i2 = -1; float b2 = -1.f;
#pragma unroll
        for (int e = 0; e < 4; e++) if (e != i1 && pe[e] > b2) { b2 = pe[e]; i2 = e; }
        float w1 = gval * b1 / (b1 + b2), w2 = gval * b2 / (b1 + b2);
        if (lane == 0) {
            const int e1 = gi * 4 + i1, e2 = gi * 4 + i2;
            const int lr = nloc * NW + w;
            rinfo[lr * 4 + 0] = e1; rinfo[lr * 4 + 1] = atomicAdd(&lcnt[e1], 1);
            rinfo[lr * 4 + 2] = e2; rinfo[lr * 4 + 3] = atomicAdd(&lcnt[e2], 1);
            rwt[lr * 2 + 0] = w1; rwt[lr * 2 + 1] = w2;
        }
        ++nloc;
    }
    __syncthreads();
    if (TID < 16) lcnt[16 + TID] = lcnt[TID] > 0 ? atomicAdd(&cnt[TID * 64], lcnt[TID]) : 0;
    __syncthreads();
    {
        const int nrows_blk = (NTOK - BID * NW + (int)gridDim.x * NW - 1) / ((int)gridDim.x * NW) * NW;
        for (int lr = TID; lr < nrows_blk; lr += NTHR) {
            const int row = BID * NW + (lr % NW) + (lr / NW) * (int)gridDim.x * NW;
            if (row < NTOK) {
                const int e1 = rinfo[lr * 4 + 0], p1 = lcnt[16 + e1] + rinfo[lr * 4 + 1];
                const int e2 = rinfo[lr * 4 + 2], p2 = lcnt[16 + e2] + rinfo[lr * 4 + 3];
                (PF(list_tok) + layer * ((size_t)16 * NTOK))[e1 * NTOK + p1] = row; (PF(list_w) + layer * ((size_t)16 * NTOK))[e1 * NTOK + p1] = rwt[lr * 2 + 0];
                (PF(list_tok) + layer * ((size_t)16 * NTOK))[e2 * NTOK + p2] = row; (PF(list_w) + layer * ((size_t)16 * NTOK))[e2 * NTOK + p2] = rwt[lr * 2 + 1];
                (PF(tok_slot) + layer * ((size_t)NTOK * 2))[row * 2 + 0] = e1 * NTOK + p1; (PF(tok_slot) + layer * ((size_t)NTOK * 2))[row * 2 + 1] = e2 * NTOK + p2;
            }
        }
    }
    __syncthreads();
}


template <bool GATHER_>
struct MoeOrder {
    static constexpr bool GATHER = GATHER_;
    const LAS int* tab; const LAS int* rowtab;
    const char* Bt; unsigned estride; int K, G, c;
    __device__ __forceinline__ bool next(int i, pg8::Unit& u) const {
        const int nwg = __builtin_amdgcn_readfirstlane(tab[48]) * 4;
        const int L = i * G + c; if (L >= nwg) return false;
        int wgid = L; { const int q = nwg / 8, r = nwg % 8, xcd = wgid % 8, off = wgid / 8; wgid = (xcd < r ? xcd * (q + 1) : r * (q + 1) + (xcd - r) * q) + off; }
        const int mg = wgid >> 2, nt = wgid & 3;
        int e = 0;
#pragma unroll
        for (int k = 1; k < 16; ++k) e = (__builtin_amdgcn_readfirstlane(tab[32 + k]) <= mg) ? k : e;
        const int mt = mg - __builtin_amdgcn_readfirstlane(tab[32 + e]);
        const int rem = __builtin_amdgcn_readfirstlane(tab[e]) - mt * 256;
        u.e = e; u.pm = mt; u.pn = nt; u.ui = i; u.nrows = rem < 256 ? rem : 256; u.arow0 = __builtin_amdgcn_readfirstlane(tab[16 + e]) + mt * 256;
        u.bptr = Bt + (size_t)e * estride + (size_t)nt * 256 * K * 2;
        return true;
    }
    __device__ __forceinline__ int arow(const pg8::Unit& u, int r) const { return GATHER_ ? rowtab[u.ui * 256 + r] : u.arow0 + r; }
    __device__ __forceinline__ int lda(int K_) const { return K_; }
    __device__ __forceinline__ unsigned kstepA() const { return 128u; }
    __device__ __forceinline__ const char* abase(const pg8::Unit&, const char* A) const { return A; }
};
__device__ __forceinline__ void moe_tables(KA ka, int layer, LAS unsigned char* lds, bool want_rows, int G, int c) {
    LAS int* tab = (LAS int*)(lds + LDS_MISC + 256);
    LAS int* rowtab = (LAS int*)(lds + LDS_MISC + 1024);
    const int tid = opaque_tid(ka.wv);
    const int* cnt = (const int*)(PF(ctl) + CW_CNT) + layer * 16 * 64;
    if (tid < 16) tab[tid] = __hip_atomic_load(&cnt[tid * 64], __ATOMIC_RELAXED, __HIP_MEMORY_SCOPE_AGENT);
    __syncthreads();
    if (tid == 0) {
        int b = 0, m = 0;
        for (int e = 0; e < 16; ++e) { tab[16 + e] = b; tab[32 + e] = m; b += tab[e]; m += (tab[e] + 255) >> 8; }
        tab[48] = m;
    }
    __syncthreads();
    if (want_rows) {
        MoeOrder<true> S{tab, rowtab, nullptr, 0u, 1024, G, c};
        const int* lt = (PF(list_tok) + layer * ((size_t)16 * NTOK));
        for (int i = 0; i < 4; ++i) {
            pg8::Unit u;
            if (!S.next(i, u)) break;
            if (tid < 256) { const int r = tid < u.nrows ? tid : u.nrows - 1; rowtab[i * 256 + tid] = lt[u.e * NTOK + u.pm * 256 + r]; }
        }
        asm volatile("s_waitcnt vmcnt(0) lgkmcnt(0)" ::: "memory");
        __syncthreads();
    }
}
struct EpiUp {
    static constexpr bool PERM = true;
    bf16_t* hidden;
    __device__ __forceinline__ void operator()(const f32x4 (&acc)[2][2][4][2], const pg8::Unit& u, int wr, int wc, int fr, int fq) const {
#pragma unroll
        for (int ai = 0; ai < 2; ++ai)
#pragma unroll
            for (int m = 0; m < 4; ++m) {
                const int r = ai * 128 + wr * 64 + m * 16 + fr;
                if (r < u.nrows) {
                    bf16_t* rowp = hidden + (size_t)(u.arow0 + r) * 512 + u.pn * 128 + wc * 32 + 8 * fq;
                    float h[8];
#pragma unroll
                    for (int n = 0; n < 2; ++n)
#pragma unroll
                        for (int j = 0; j < 4; ++j) { const float g = acc[ai][0][m][n][j], uu = acc[ai][1][m][n][j]; h[n * 4 + j] = g * sigmoidf_(g) * uu; }
                    u32x4 w; w.x = pg8::cvt_pk_bf16(h[0], h[1]); w.y = pg8::cvt_pk_bf16(h[2], h[3]); w.z = pg8::cvt_pk_bf16(h[4], h[5]); w.w = pg8::cvt_pk_bf16(h[6], h[7]);
                    *(u32x4*)rowp = w;
                }
            }
    }
};
struct EpiDown {
    static constexpr bool PERM = true;
    bf16_t* Y2; const float* lw;
    __device__ __forceinline__ void operator()(const f32x4 (&acc)[2][2][4][2], const pg8::Unit& u, int wr, int wc, int fr, int fq) const {
#pragma unroll
        for (int ai = 0; ai < 2; ++ai)
#pragma unroll
            for (int m = 0; m < 4; ++m) {
                const int r = ai * 128 + wr * 64 + m * 16 + fr;
                if (r < u.nrows) {
                    const float wgt = lw[u.e * NTOK + u.pm * 256 + r];
                    bf16_t* rowp = Y2 + (size_t)(u.arow0 + r) * DM + u.pn * 256 + wc * 32 + 8 * fq;
#pragma unroll
                    for (int bj = 0; bj < 2; ++bj) {
                        const f32x4 v0 = acc[ai][bj][m][0] * wgt, v1 = acc[ai][bj][m][1] * wgt;
                        u32x4 w; w.x = pg8::cvt_pk_bf16(v0[0], v0[1]); w.y = pg8::cvt_pk_bf16(v0[2], v0[3]); w.z = pg8::cvt_pk_bf16(v1[0], v1[1]); w.w = pg8::cvt_pk_bf16(v1[2], v1[3]);
                        *(u32x4*)(rowp + bj * 128) = w;
                    }
                }
            }
    }
};
__device__ __forceinline__ void phase_moe_up(KA ka, int layer, LAS unsigned char* lds) {
    moe_tables(ka, layer, lds, true, gridDim.x, opaque_bid());
    MoeOrder<true> S{(const LAS int*)(lds + LDS_MISC + 256), (const LAS int*)(lds + LDS_MISC + 1024),
                     (const char*)(PF(WT) + WT_UP), (unsigned)(1024u * 1024u * 2u), 1024, (int)gridDim.x, opaque_bid()};
    EpiUp E{PF(Y)};
    pg8::gemm_phase<EpiUp, MoeOrder<true>>(lds, (const char*)PF(XB), 1024, S, E, ka.wv);
}
__device__ __forceinline__ void phase_moe_down(KA ka, int layer, LAS unsigned char* lds) {
    moe_tables(ka, layer, lds, false, gridDim.x, opaque_bid());
    MoeOrder<false> S{(const LAS int*)(lds + LDS_MISC + 256), (const LAS int*)(lds + LDS_MISC + 1024),
                      (const char*)(PF(WT) + WT_DN), (unsigned)(1024u * 512u * 2u), 512, (int)gridDim.x, opaque_bid()};
    EpiDown E{PF(H), (PF(list_w) + layer * ((size_t)16 * NTOK))};
    pg8::gemm_phase<EpiDown, MoeOrder<false>>(lds, (const char*)PF(Y), 512, S, E, ka.wv);
}

__device__ void phase_ln2(KA ka, int layer, const float* x1, float* xo) {
    PHASE_IDS
    bf16_t* xb = PF(XB);
    const bf16_t* Y2 = PF(H);
    const int lane = TID & 63, w = TID >> 6;
    const float* g = PF(ln2_g) + layer * 1024;
    const float* bb = PF(ln2_b) + layer * 1024;
    const int* cnt = (const int*)(PF(ctl) + CW_CNT) + layer * 16 * 64;
    int mybase = 0;
    {
        int cv = lane < 16 ? __hip_atomic_load(&cnt[(lane & 15) * 64], __ATOMIC_RELAXED, __HIP_MEMORY_SCOPE_AGENT) : 0;
        int incl = cv;
#pragma unroll
        for (int o = 1; o < 16; o <<= 1) { int t = __shfl_up(incl, o); if ((lane & 15) >= o) incl += t; }
        mybase = incl - cv;
    }
    const int* tsl = PF(tok_slot) + layer * ((size_t)NTOK * 2);
    const int rstride = gridDim.x * NW;
    int row = BID * NW + w;
    int tsa1 = 0, tsb1 = 0;
    u32x2 xw0[4], ya0[4], yb0[4];
#define LN2_LOAD(ROW, TSA, TSB, XW, YA, YB) do { \
        const int s1_ = __shfl(mybase, (TSA) >> 14) + ((TSA) & (NTOK - 1)), s2_ = __shfl(mybase, (TSB) >> 14) + ((TSB) & (NTOK - 1)); \
        _Pragma("unroll") for (int j = 0; j < 4; ++j) { const int c = 256 * j + 4 * lane; \
            XW[j] = *(const u32x2*)(xb + (size_t)(ROW) * DM + c);        \
              \
            YA[j] = __builtin_nontemporal_load((const u32x2*)(Y2 + (size_t)s1_ * DM + c)); YB[j] = __builtin_nontemporal_load((const u32x2*)(Y2 + (size_t)s2_ * DM + c)); } } while (0)
    if (row < NTOK) { const int tsa0 = tsl[row * 2 + 0], tsb0 = tsl[row * 2 + 1]; LN2_LOAD(row, tsa0, tsb0, xw0, ya0, yb0); }
    if (row + rstride < NTOK) { tsa1 = tsl[(row + rstride) * 2 + 0]; tsb1 = tsl[(row + rstride) * 2 + 1]; }
    for (; row < NTOK; row += rstride) {
        u32x2 xw1[4], ya1[4], yb1[4];
        const int nrow = row + rstride;
        if (nrow < NTOK) LN2_LOAD(nrow, tsa1, tsb1, xw1, ya1, yb1);
        int tsa2 = 0, tsb2 = 0;
        if (nrow + rstride < NTOK) { tsa2 = tsl[(nrow + rstride) * 2 + 0]; tsb2 = tsl[(nrow + rstride) * 2 + 1]; }
        f32x4 v[4];
        float s = 0.f;
#pragma unroll
        for (int j = 0; j < 4; ++j) {
            const u32x2 xw = xw0[j], ya = ya0[j], yb = yb0[j];
            f32x4 xv; xv[0] = __uint_as_float(xw.x << 16); xv[1] = __uint_as_float(xw.x & 0xffff0000u); xv[2] = __uint_as_float(xw.y << 16); xv[3] = __uint_as_float(xw.y & 0xffff0000u);
            f32x4 t;
            t[0] = __uint_as_float(ya.x << 16) + __uint_as_float(yb.x << 16); t[1] = __uint_as_float(ya.x & 0xffff0000u) + __uint_as_float(yb.x & 0xffff0000u);
            t[2] = __uint_as_float(ya.y << 16) + __uint_as_float(yb.y << 16); t[3] = __uint_as_float(ya.y & 0xffff0000u) + __uint_as_float(yb.y & 0xffff0000u);
            v[j] = xv * ALPHA + t;
            s += (v[j][0] + v[j][1]) + (v[j][2] + v[j][3]);
        }
        const float mu = wave_sum(s) * (1.f / 1024.f);
        float q = 0.f;
#pragma unroll
        for (int j = 0; j < 4; ++j) { v[j] = v[j] - mu; q += (v[j][0] * v[j][0] + v[j][1] * v[j][1]) + (v[j][2] * v[j][2] + v[j][3] * v[j][3]); }
        const float rstd = rsqrtf(wave_sum(q) * (1.f / 1024.f) + 1e-5f);
#pragma unroll
        for (int j = 0; j < 4; ++j) {
            const int c = 256 * j + 4 * lane;
            const f32x4 o = v[j] * rstd * *(const f32x4*)(g + c) + *(const f32x4*)(bb + c);
            if (layer == 1) *(f32x4*)(xo + (size_t)row * DM + c) = o;
            u32x2 pw; pw.x = pk2(o[0], o[1]); pw.y = pk2(o[2], o[3]);
            *(u32x2*)(xb + (size_t)row * DM + c) = pw;
        }
#pragma unroll
        for (int j = 0; j < 4; ++j) { xw0[j] = xw1[j]; ya0[j] = ya1[j]; yb0[j] = yb1[j]; }
        tsa1 = tsa2; tsb1 = tsb2;
    }
#undef LN2_LOAD
}

#define MFMA16(a, b, c) __builtin_amdgcn_mfma_f32_16x16x32_bf16((a), (b), (c), 0, 0, 0)
constexpr int NSA_KT = 0, NSA_VT = 16384, NSA_IMP = 32768, NSA_FIN = 65536, NSA_SEL = LDS_MISC + 8192;

__device__ __forceinline__ int tile_off(int r, int c) { return r * 128 + ((c ^ ((r >> 1) & 7)) << 4); }

__device__ __forceinline__ unsigned cvtpk(float lo, float hi) { return pk2(lo, hi); }
struct SelMask { unsigned a, b, c, d; };
__device__ __forceinline__ unsigned selbit(unsigned a, unsigned b, unsigned c, unsigned d, int j) {
    const int k = j >> 5;
    const unsigned lo = (k & 1) ? b : a, hi = (k & 1) ? d : c;
    const unsigned r = (k & 2) ? hi : lo;
    return (r >> (j & 31)) & 1u;
}

struct NsaRT {
    bf16x8 q[2];
    f32x4 o[4];
    float m, l;
};

template <int MODE, int NST>
__device__ __forceinline__ void nsa_loop(LAS unsigned char* lds, int tid, int lane, int w, int t0w, int jb, int je,
                                         const char* ksrc, size_t kstride, size_t ktile, const char* vsrc, size_t vstride, size_t vtile,
                                         NsaRT (&R)[2], const SelMask selm0, const SelMask selm1, float (&carry)[2], float* impw) {
    const int g = lane >> 4, qr = lane & 15;
    int tid2 = tid; asm volatile("" : "+v"(tid2));
    const int sr = tid2 >> 3, sc = (tid2 & 7) ^ ((sr >> 1) & 7);
    const char* kp = ksrc + (size_t)sr * kstride + sc * 16;
    const char* vp = vsrc + (size_t)sr * vstride + sc * 16;
    const unsigned ldsw = (unsigned)w * 1024u;
    const int fxq = (qr >> 1) & 7;
    const int ka0 = qr * 128 + ((g ^ fxq) << 4), ka1 = qr * 128 + (((4 + g) ^ fxq) << 4);
    const int vb = qr * 128 + (g & 1) * 8, vc = (g >> 1) ^ fxq;
    (void)vb; (void)vc;
    if (jb > je) return;
    constexpr bool PIPE = false && (MODE >= 2);
    constexpr int D = PIPE ? NST - 2 : NST - 1;
#define NSA_ISSUE(jj, st) do { const int jc_ = (jj) < je ? (jj) : je; \
        __builtin_amdgcn_global_load_lds((const unsigned*)(kp + (size_t)jc_ * ktile), (LAS unsigned*)(lds + (st) * 16384 + ldsw), 16, 0, 0); \
        if (MODE != 0) __builtin_amdgcn_global_load_lds((const unsigned*)(vp + (size_t)jc_ * vtile), (LAS unsigned*)(lds + (st) * 16384 + 8192 + ldsw), 16, 0, 0); } while (0)
#define NSA_WAIT_TILE() do { if (NST == 2) asm volatile("s_waitcnt vmcnt(0) lgkmcnt(0)" ::: "memory"); else if (PIPE) asm volatile("s_waitcnt vmcnt(2) lgkmcnt(0)" ::: "memory"); else asm volatile("s_waitcnt vmcnt(4) lgkmcnt(0)" ::: "memory"); } while (0)
#define NSA_PV(PF_, VT_) do { _Pragma("unroll") for (int ks = 0; ks < 2; ++ks) _Pragma("unroll") for (int dt = 0; dt < 4; ++dt) { \
          \
        const bf16x8 vf = *(const LAS bf16x8*)((VT_) + (ks ? ka1 : ka0) + dt * 2048); \
        R[0].o[dt] = MFMA16(vf, PF_[0][ks], R[0].o[dt]); R[1].o[dt] = MFMA16(vf, PF_[1][ks], R[1].o[dt]); } } while (0)
#pragma unroll
    for (int d = 0; d < D; ++d) NSA_ISSUE(jb + d, d);
    NSA_WAIT_TILE();
    __builtin_amdgcn_s_barrier();
    bf16x8 pfp[2][2];
    bool havep = false;
    if (PIPE && w >= 4) __builtin_amdgcn_s_barrier();
    for (int j = jb; j <= je; ++j) {
        const int cur = (j - jb) & (NST - 1);
        NSA_ISSUE(j + D, (j - jb + D) & (NST - 1));
        const LAS unsigned char* kt = lds + cur * 16384;
        const LAS unsigned char* vt = lds + cur * 16384 + 8192;
        bool anyact;
        {
            bool a = false;
#pragma unroll
            for (int rt = 0; rt < 2; ++rt) {
                const int tk = t0w + 4 * rt + (qr >> 2);
                if (MODE <= 1) { const int nv = tk >= 31 ? ((tk - 31) >> 4) + 1 : 0; a = a || (nv > 64 * j); }
                else if (MODE == 2) a = a || ((rt == 0 ? selbit(selm0.a, selm0.b, selm0.c, selm0.d, j) : selbit(selm1.a, selm1.b, selm1.c, selm1.d, j)) != 0u);
                else a = a || ((64 * j <= tk) && (64 * j + 63 > tk - 512));
            }
            anyact = __any(a);
        }
        if (anyact) {
            f32x4 s[2][4];
#pragma unroll
            for (int t = 0; t < 4; ++t) {
                const bf16x8 k0 = *(const LAS bf16x8*)(kt + ka0 + t * 2048), k1 = *(const LAS bf16x8*)(kt + ka1 + t * 2048);
#pragma unroll
                for (int rt = 0; rt < 2; ++rt) {
                    s[rt][t] = (f32x4){0.f, 0.f, 0.f, 0.f};
                    s[rt][t] = MFMA16(k0, R[rt].q[0], s[rt][t]);
                    s[rt][t] = MFMA16(k1, R[rt].q[1], s[rt][t]);
                }
            }
            if (PIPE && havep) NSA_PV(pfp, lds + ((j - 1 - jb) & (NST - 1)) * 16384 + 8192);
            if (PIPE) { NSA_WAIT_TILE(); __builtin_amdgcn_s_barrier(); }
            const int kb = 64 * j + 4 * g;
            bf16x8 pf_local[2][2];
            bf16x8 (&pf)[2][2] = PIPE ? pfp : pf_local;
            if (MODE == 1) {
#pragma unroll
                for (int rt = 0; rt < 2; ++rt) {
                    const int tk = t0w + 4 * rt + (qr >> 2);
                    const int nv = tk >= 31 ? ((tk - 31) >> 4) + 1 : 0;
                    const float mL = R[rt].m * 1.44269504f, invl = R[rt].l > 0.f ? 1.f / R[rt].l : 0.f;
                    float p[4][4];
#pragma unroll
                    for (int t = 0; t < 4; ++t)
#pragma unroll
                        for (int i = 0; i < 4; ++i) { const int key = kb + 16 * t + i; p[t][i] = (key < nv) ? __builtin_amdgcn_exp2f(fmaf(s[rt][t][i], 1.44269504f, -mL)) * invl : 0.f; }
#pragma unroll
                    for (int t = 0; t < 4; ++t) {
                        const float own = (p[t][0] + p[t][1]) + (p[t][2] + p[t][3]);
                        const float x3 = p[t][3];
                        const float up_cur = __shfl(x3, (lane + 48) & 63);
                        const float up_prev = __shfl(carry[rt], (lane + 48) & 63);
                        float v = own + (g >= 1 ? up_cur : up_prev);
                        v += __shfl_xor(v, 1);
                        v += __shfl_xor(v, 2);
                        carry[rt] = x3;
                        if ((qr & 3) == 0) impw[(4 * rt + (qr >> 2)) * 128 + 16 * j + 4 * t + g] = v;
                    }
#pragma unroll
                    for (int ks = 0; ks < 2; ++ks) {
                        u32x4 pu; pu.x = cvtpk(p[2 * ks][0], p[2 * ks][1]); pu.y = cvtpk(p[2 * ks][2], p[2 * ks][3]); pu.z = cvtpk(p[2 * ks + 1][0], p[2 * ks + 1][1]); pu.w = cvtpk(p[2 * ks + 1][2], p[2 * ks + 1][3]);
                        pf[rt][ks] = __builtin_bit_cast(bf16x8, pu);
                    }
                }
            } else {
                int lim_hi[2], lim_lo[2];
                bool none[2], part[2];
#pragma unroll
                for (int rt = 0; rt < 2; ++rt) {
                    const int tk = t0w + 4 * rt + (qr >> 2);
                    if (MODE == 0) { const int nv = tk >= 31 ? ((tk - 31) >> 4) + 1 : 0; lim_hi[rt] = nv - 1; lim_lo[rt] = -1; }
                    else if (MODE == 2) { lim_hi[rt] = ((rt == 0 ? selbit(selm0.a, selm0.b, selm0.c, selm0.d, j) : selbit(selm1.a, selm1.b, selm1.c, selm1.d, j)) != 0u) ? tk : -1; lim_lo[rt] = -1; }
                    else { lim_hi[rt] = tk; lim_lo[rt] = tk - 512; }
                    const bool full = (64 * j + 63 <= lim_hi[rt]) && (64 * j > lim_lo[rt]);
                    none[rt] = (64 * j > lim_hi[rt]) || (64 * j + 63 <= lim_lo[rt]);
                    part[rt] = !full && !none[rt];
                }
                float lmx[2];
                if (__any(part[0] || part[1])) {
#pragma unroll
                    for (int rt = 0; rt < 2; ++rt) {
                        float mx = NEG_INF;
#pragma unroll
                        for (int t = 0; t < 4; ++t)
#pragma unroll
                            for (int i = 0; i < 4; ++i) {
                                const int key = kb + 16 * t + i;
                                const bool ok = (key <= lim_hi[rt]) && (key > lim_lo[rt]);
                                s[rt][t][i] = ok ? s[rt][t][i] : NEG_INF;
                                mx = fmaxf(mx, s[rt][t][i]);
                            }
                        lmx[rt] = mx;
                        none[rt] = false;
                    }
                } else {
#pragma unroll
                    for (int rt = 0; rt < 2; ++rt) {
                        float mx = NEG_INF;
#pragma unroll
                        for (int t = 0; t < 4; ++t)
#pragma unroll
                            for (int i = 0; i < 4; ++i) mx = fmaxf(mx, s[rt][t][i]);
                        lmx[rt] = none[rt] ? NEG_INF : mx;
                    }
                }
                if (__any((lmx[0] > R[0].m + 6.f) || (lmx[1] > R[1].m + 6.f))) {
#pragma unroll
                    for (int rt = 0; rt < 2; ++rt) {
                        float mx = lmx[rt];
                        mx = fmaxf(mx, __shfl_xor(mx, 16));
                        mx = fmaxf(mx, __shfl_xor(mx, 32));
                        const float mn = fmaxf(R[rt].m, mx);
                        const float alpha = __expf(R[rt].m - mn);
                        R[rt].l *= alpha; R[rt].m = mn;
                        if (MODE != 0) {
#pragma unroll
                            for (int dt = 0; dt < 4; ++dt) R[rt].o[dt] = R[rt].o[dt] * alpha;
                        }
                    }
                }
#pragma unroll
                for (int rt = 0; rt < 2; ++rt) {
                    const float negmL = none[rt] ? -1e30f : -fmaxf(R[rt].m, -1e4f) * 1.44269504f;
                    float p[4][4];
                    float rs = 0.f;
                    f32x2 L2 = {1.44269504f, 1.44269504f}, N2 = {negmL, negmL};
                    asm volatile("" : "+v"(L2), "+v"(N2));
#pragma unroll
                    for (int t = 0; t < 4; ++t)
#pragma unroll
                        for (int i = 0; i < 4; i += 2) {
                            f32x2 sv; sv.x = s[rt][t][i]; sv.y = s[rt][t][i + 1];
                            const f32x2 a = sv * L2 + N2;
                            p[t][i] = __builtin_amdgcn_exp2f(a.x); p[t][i + 1] = __builtin_amdgcn_exp2f(a.y);
                            rs += p[t][i] + p[t][i + 1];
                        }
                    R[rt].l += rs;
                    if (MODE != 0) {
#pragma unroll
                        for (int ks = 0; ks < 2; ++ks) {
                            u32x4 pu; pu.x = cvtpk(p[2 * ks][0], p[2 * ks][1]); pu.y = cvtpk(p[2 * ks][2], p[2 * ks][3]); pu.z = cvtpk(p[2 * ks + 1][0], p[2 * ks + 1][1]); pu.w = cvtpk(p[2 * ks + 1][2], p[2 * ks + 1][3]);
                            pf[rt][ks] = __builtin_bit_cast(bf16x8, pu);
                        }
                    }
                }
            }
            if (MODE != 0 && !PIPE) NSA_PV(pf, vt);
        } else if (PIPE) {
            if (havep) NSA_PV(pfp, lds + ((j - 1 - jb) & (NST - 1)) * 16384 + 8192);
            NSA_WAIT_TILE(); __builtin_amdgcn_s_barrier();
        }
        if (PIPE) havep = anyact;
        if (!PIPE) NSA_WAIT_TILE();
        __builtin_amdgcn_s_barrier();
    }
    if (PIPE && havep) { NSA_PV(pfp, lds + ((je - jb) & (NST - 1)) * 16384 + 8192); asm volatile("s_waitcnt lgkmcnt(0)" ::: "memory"); }
    if (PIPE && w < 4) __builtin_amdgcn_s_barrier();
    asm volatile("s_waitcnt vmcnt(0)" ::: "memory");
    __builtin_amdgcn_s_barrier();
#undef NSA_ISSUE
#undef NSA_WAIT_TILE
#undef NSA_PV
}

__device__ void phase_nsa2(KA ka, int layer, LAS unsigned char* lds) {
    PHASE_IDS
    const int tid = TID, w = __builtin_amdgcn_readfirstlane(tid >> 6);
    int lane = tid & 63;
#define g (lane >> 4)
#define qr (lane & 15)
#define RELAUNDER() asm volatile("" : "+v"(lane))
    const bf16_t* H = PF(H);
    const bf16_t* kcb = (PF(kcb) + layer * ((size_t)4 * 512 * 64));
    const bf16_t* vcT = (PF(vcT) + layer * ((size_t)4 * 64 * 512));
    const bf16_t* vsT = PF(vsT);
    const bf16_t* vwT = PF(vwT);
    bf16_t* Y = PF(Y);
    const float* gate_b = PF(nsa_gate_b) + layer * 24;
    const float* ogain = PF(out_gain) + layer * 1024;
    float* impw = (float*)(lds + NSA_IMP + w * 4096);
    unsigned* selw = (unsigned*)(lds + NSA_SEL + w * 128);
    for (int base = BID; base < 256; base += gridDim.x) {
#pragma unroll 1
        for (int half = 0; half < 2; ++half) {
            const int it = half ? 511 - base : base;
            const int chunk = it >> 2, bh = it & 3, b = bh >> 1, hk = bh & 1;
            const size_t rowbase = (size_t)b * T_;
            const int t0w = chunk * 64 + w * 8;
            NsaRT R[2];
#define finw ((LAS f32x4*)(lds + NSA_FIN + w * 8192) + lane)
#pragma unroll
            for (int rt = 0; rt < 2; ++rt) {
                const int tk = t0w + 4 * rt + (qr >> 2), hh = hk * 4 + (qr & 3);
                const bf16_t* qp = H + (rowbase + tk) * HLD + C_NQ + hh * 64 + 8 * g;
#pragma unroll
                for (int ks = 0; ks < 2; ++ks) {
                    const u32x4 u = *(const u32x4*)(qp + 32 * ks);
                    const unsigned uu[4] = {u.x, u.y, u.z, u.w};
                    u32x4 o4;
#pragma unroll
                    for (int e = 0; e < 4; ++e) {
                        const float f0 = __uint_as_float(uu[e] << 16) * 0.125f, f1 = __uint_as_float(uu[e] & 0xffff0000u) * 0.125f;
                        o4[e] = (__float_as_uint(f0) >> 16) | (__float_as_uint(f1) & 0xffff0000u);
                    }
                    R[rt].q[ks] = __builtin_bit_cast(bf16x8, o4);
                }
                R[rt].m = NEG_INF; R[rt].l = 0.f;
#pragma unroll
                for (int dt = 0; dt < 4; ++dt) R[rt].o[dt] = zero4();
            }
            SelMask selm0{0u, 0u, 0u, 0u}, selm1{0u, 0u, 0u, 0u};
            float carry[2] = {0.f, 0.f};
            const int tmax = chunk * 64 + 63;
            const int nvmax = tmax >= 31 ? ((tmax - 31) >> 4) + 1 : 0;
            const int nb = (nvmax + 63) >> 6;
            const char* kc_src = (const char*)(kcb + (size_t)bh * 512 * 64);
            const char* vc_src = (const char*)(vcT + (size_t)bh * 64 * 512);
            nsa_loop<0, 2>(lds, tid, lane, w, t0w, 0, nb - 1, kc_src, 128, 64 * 128, nullptr, 0, 0, R, selm0, selm1, carry, impw);
            RELAUNDER();
#pragma unroll
            for (int rt = 0; rt < 2; ++rt) { float l = R[rt].l; l += __shfl_xor(l, 16); l += __shfl_xor(l, 32); R[rt].l = l; }
            for (int i = lane; i < 8 * 128; i += 64) impw[i] = 0.f;
            wave_sync();
            nsa_loop<1, 2>(lds, tid, lane, w, t0w, 0, nb - 1, kc_src, 128, 64 * 128, vc_src, 512 * 2, 64 * 2, R, selm0, selm1, carry, impw);
            RELAUNDER();
#pragma unroll
            for (int rt = 0; rt < 2; ++rt) {
                const int hh = hk * 4 + (qr & 3);
                const float gt = sigmoidf_(bf2f(H[(rowbase + (t0w + 4 * rt + (qr >> 2))) * HLD + C_NG + hh * 3 + 0]) + gate_b[hh * 3 + 0]);
#pragma unroll
                for (int dt = 0; dt < 4; ++dt) finw[(rt * 4 + dt) * 64] = R[rt].o[dt] * gt;
            }
            wave_sync();
            {
                const int tl = lane >> 3, sub = lane & 7;
                const int tks = t0w + tl, curb = tks >> 6;
                unsigned long long K[16];
                unsigned* impu = (unsigned*)impw;
                unsigned ku[16];
#pragma unroll
                for (int i = 0; i < 16; ++i) {
                    const int jj = sub * 16 + i;
                    const float a = impw[tl * 128 + jj];
                    const bool forced = (jj == 0) || (jj == curb) || (jj == curb - 1);
                    const float vv = a + (forced ? 1e4f : 0.f);
                    ku[i] = (jj <= curb) ? (__float_as_uint(vv) + 1u) : 0u;
                    K[i] = ((unsigned long long)ku[i] << 8) | (unsigned)(255 - jj);
                }
                wave_sync();
#pragma unroll
                for (int i = 0; i < 16; ++i) impu[tl * 128 + sub * 16 + i] = ku[i];
                wave_sync();
                int cnt[16];
#pragma unroll
                for (int i = 0; i < 16; ++i) cnt[i] = 0;
                const int jjmax = (t0w + 7) >> 6;
                for (int jj = 0; jj <= jjmax; ++jj) {
                    const unsigned long long X = ((unsigned long long)impu[tl * 128 + jj] << 8) | (unsigned)(255 - jj);
#pragma unroll
                    for (int i = 0; i < 16; ++i) cnt[i] += (X > K[i]) ? 1 : 0;
                }
                unsigned bits = 0u;
#pragma unroll
                for (int i = 0; i < 16; ++i) bits |= ((cnt[i] < 16) && (ku[i] != 0u)) ? (1u << i) : 0u;
                const unsigned other = __shfl_xor(bits, 1);
                const unsigned word = (sub & 1) ? ((bits << 16) | other) : (bits | (other << 16));
                if ((sub & 1) == 0) selw[tl * 4 + (sub >> 1)] = word;
                wave_sync();
                { const unsigned* q0 = selw + (qr >> 2) * 4; selm0.a = q0[0]; selm0.b = q0[1]; selm0.c = q0[2]; selm0.d = q0[3];
                  selm1.a = q0[16]; selm1.b = q0[17]; selm1.c = q0[18]; selm1.d = q0[19]; }
                wave_sync();
            }
            __syncthreads();
#pragma unroll
            for (int rt = 0; rt < 2; ++rt) {
                R[rt].m = NEG_INF; R[rt].l = 0.f;
#pragma unroll
                for (int dt = 0; dt < 4; ++dt) R[rt].o[dt] = zero4();
            }
            nsa_loop<2, 4>(lds, tid, lane, w, t0w, 0, chunk, (const char*)(H + rowbase * HLD + C_KS + hk * 64), (size_t)HLD * 2, (size_t)64 * HLD * 2,
                        (const char*)(vsT + (size_t)bh * 64 * T_), (size_t)T_ * 2, 64 * 2, R, selm0, selm1, carry, impw);
            RELAUNDER();
#pragma unroll
            for (int rt = 0; rt < 2; ++rt) {
                const int hh = hk * 4 + (qr & 3);
                const float gt = sigmoidf_(bf2f(H[(rowbase + (t0w + 4 * rt + (qr >> 2))) * HLD + C_NG + hh * 3 + 1]) + gate_b[hh * 3 + 1]);
                float ltot = R[rt].l; ltot += __shfl_xor(ltot, 16); ltot += __shfl_xor(ltot, 32);
                const float sc = gt / ltot;
#pragma unroll
                for (int dt = 0; dt < 4; ++dt) { finw[(rt * 4 + dt) * 64] += R[rt].o[dt] * sc; R[rt].o[dt] = zero4(); }
                R[rt].m = NEG_INF; R[rt].l = 0.f;
            }
            nsa_loop<3, 4>(lds, tid, lane, w, t0w, chunk >= 8 ? chunk - 8 : 0, chunk, (const char*)(H + rowbase * HLD + C_KW + hk * 64), (size_t)HLD * 2, (size_t)64 * HLD * 2,
                        (const char*)(vwT + (size_t)bh * 64 * T_), (size_t)T_ * 2, 64 * 2, R, selm0, selm1, carry, impw);
            RELAUNDER();
#pragma unroll
            for (int rt = 0; rt < 2; ++rt) {
                const int tk = (t0w + 4 * rt + (qr >> 2)), hh = hk * 4 + (qr & 3);
                const float gt = sigmoidf_(bf2f(H[(rowbase + tk) * HLD + C_NG + hh * 3 + 2]) + gate_b[hh * 3 + 2]);
                float ltot = R[rt].l; ltot += __shfl_xor(ltot, 16); ltot += __shfl_xor(ltot, 32);
                const float sc = gt / ltot;
                bf16_t* yp = Y + (rowbase + tk) * DM + 256 + hh * 64 + 4 * g;
                f32x4 ov[4];
                float ss = 0.f;
#pragma unroll
                for (int dt = 0; dt < 4; ++dt) { ov[dt] = finw[(rt * 4 + dt) * 64] + R[rt].o[dt] * sc; ss += (ov[dt][0] * ov[dt][0] + ov[dt][1] * ov[dt][1]) + (ov[dt][2] * ov[dt][2] + ov[dt][3] * ov[dt][3]); }
                ss += __shfl_xor(ss, 16);
                ss += __shfl_xor(ss, 32);
                const float rn = rsqrtf(ss * (1.f / 64.f) + 1e-6f);
#pragma unroll
                for (int dt = 0; dt < 4; ++dt) {
                    const f32x4 o = ov[dt] * rn * *(const f32x4*)(ogain + 256 + hh * 64 + 16 * dt + 4 * g);
                    u32x2 wv; wv.x = pk2(o[0], o[1]); wv.y = pk2(o[2], o[3]);
                    *(u32x2*)(yp + 16 * dt) = wv;
                }
            }
        }
    }
}
#undef g
#undef qr
#undef finw
#undef RELAUNDER

__device__ void phase_vtrans(KA ka, float* smem) {
    PHASE_IDS
    const int lane = TID & 63, w = TID >> 6;
    bf16_t* scr = (bf16_t*)(smem + w * 4096);
    const bf16_t* H = PF(H);
    const int kperm = (lane & 32) + 8 * ((lane & 15) >> 2) + 4 * ((lane >> 4) & 1) + (lane & 3);
    for (int it = BID * NW + w; it < 1024; it += gridDim.x * NW) {
        const int tt = it & 127, bh = (it >> 7) & 3, which = it >> 9;
        const int b = bh >> 1, hk = bh & 1;
        const size_t tok0 = (size_t)b * T_ + tt * 64;
        const int col = (which ? C_VW : C_VS) + hk * 64;
        bf16_t* dst = (which ? PF(vwT) : PF(vsT)) + (size_t)bh * 64 * T_ + tt * 64;
        wave_sync();
#pragma unroll 2
        for (int i0 = 0; i0 < 64; i0 += 16) {
            bf16_t hv[16];
#pragma unroll
            for (int i = 0; i < 16; ++i) hv[i] = H[(tok0 + i0 + i) * HLD + col + lane];
#pragma unroll
            for (int i = 0; i < 16; ++i) scr[lane * 66 + i0 + i] = hv[i];
        }
        wave_sync();
#pragma unroll 16
        for (int d = 0; d < 64; ++d) dst[(size_t)d * T_ + kperm] = scr[d * 66 + lane];
    }
}

__device__ void phase_hgrnA(KA ka, int layer, LAS unsigned char* lds, int first, int nblk) {
    PHASE_IDS
    const int tid = TID, lane = tid & 63, w = __builtin_amdgcn_readfirstlane(tid >> 6), gq = lane >> 4, lc = lane & 15;
    float* Q = (float*)lds;
    float* K = Q + 64 * 68;
    float* Bc = K + 64 * 68;
    float* SEG = Bc + 64 * 68;
    LAS bf16_t* ATb = (LAS bf16_t*)(lds + 57344);
    LAS bf16_t* ItB = ATb + 64 * 72;
    LAS bf16_t* KtB = ItB + 64 * 72;
    const bf16_t* H = PF(H);
    const float* hgl = PF(hg_lower);
    float* hgU = PF(hgU); float* hgG = (PF(hgG) + layer * ((size_t)1024 * 64)); bf16_t* hgQB = PF(hgQB); bf16_t* hgO = PF(hgO);
    if (BID < first) return;
    float* LB = (float*)(lds + 98304);
    if (tid < 256) {
        float lb = 0.f;
        if (layer == 1) { const float h0 = hgl[tid], h1 = hgl[256 + tid]; const float mx = fmaxf(h0, h1), e0 = expf(h0 - mx), e1 = expf(h1 - mx); lb = e1 / (e0 + e1); }
        LB[tid] = lb;
    }
    bf16_t pff[8], pfq[8], pfi[8];
#define HGA_FETCH(ITEM) do { const int c_ = (ITEM) & 127, bh_ = (ITEM) >> 7, h_ = bh_ & 3, b_ = bh_ >> 2; const size_t tk_ = (size_t)b_ * T_ + c_ * 64; \
        _Pragma("unroll") for (int i = 0; i < 8; ++i) { const int e = tid + i * NTHR, t = e >> 6, d = e & 63; const bf16_t* hp = H + (tk_ + t) * HLD + h_ * 64 + d; \
            pff[i] = hp[C_HF]; pfq[i] = hp[C_HQ]; pfi[i] = hp[C_HI]; } } while (0)
    if (BID - first < 1024) HGA_FETCH(BID - first);
    for (int item = BID - first; item < 1024; item += nblk) {
        const int c = item & 127, bh = item >> 7, h = bh & 3, b = bh >> 2;
        const size_t tok0 = (size_t)b * T_ + c * 64;
        __syncthreads();
#pragma unroll
        for (int i = 0; i < 8; ++i) {
            const int e = tid + i * NTHR, t = e >> 6, d = e & 63;
            const float lb = LB[h * 64 + d];
            const float fl = bf2f(pff[i]);
            const float ex = __expf(-fl);
            const float sg = 1.f / (1.f + ex);
            const float f = lb + (1.f - lb) * sg;
            Q[t * 68 + d] = bf2f(pfq[i]);
            K[t * 68 + d] = (1.f - lb) * (ex * sg);
            ItB[d * 72 + t] = pfi[i];
            Bc[t * 68 + d] = __logf(fmaxf(f, 1e-38f));
        }
        if (item + nblk < 1024) HGA_FETCH(item + nblk);
        __syncthreads();
        {
            const int d = lane, seg = w;
            float run = 0.f;
#pragma unroll
            for (int i = 0; i < 8; ++i) { run += Bc[(seg * 8 + i) * 68 + d]; Bc[(seg * 8 + i) * 68 + d] = run; }
            SEG[seg * 64 + d] = run;
            __syncthreads();
            float pre = 0.f;
            for (int s2 = 0; s2 < seg; ++s2) pre += SEG[s2 * 64 + d];
#pragma unroll
            for (int i = 0; i < 8; ++i) Bc[(seg * 8 + i) * 68 + d] += pre;
        }
        __syncthreads();
        {
            const int blk = tid >> 1, dh = tid & 1, db = blk >> 6, tp = (blk >> 3) & 7, sp = blk & 7;
            float a00 = 0.f, a01 = 0.f, a10 = 0.f, a11 = 0.f;
            const int t0 = 16 * db + 2 * tp, s0 = 16 * db + 2 * sp;
            if (sp <= tp) {
#pragma unroll 2
                for (int d0 = 32 * dh; d0 < 32 * dh + 32; d0 += 4) {
                    const f32x4 q0 = *(const f32x4*)&Q[t0 * 68 + d0], q1 = *(const f32x4*)&Q[(t0 + 1) * 68 + d0];
                    const f32x4 b0 = *(const f32x4*)&Bc[t0 * 68 + d0], b1 = *(const f32x4*)&Bc[(t0 + 1) * 68 + d0];
                    const f32x4 k0 = *(const f32x4*)&K[s0 * 68 + d0], k1 = *(const f32x4*)&K[(s0 + 1) * 68 + d0];
                    const f32x4 c0 = *(const f32x4*)&Bc[s0 * 68 + d0], c1 = *(const f32x4*)&Bc[(s0 + 1) * 68 + d0];
#pragma unroll
                    for (int dd = 0; dd < 4; ++dd) {
                        a00 = fmaf(q0[dd] * k0[dd], __expf(fminf(b0[dd] - c0[dd], 0.f)), a00);
                        a01 = fmaf(q0[dd] * k1[dd], __expf(fminf(b0[dd] - c1[dd], 0.f)), a01);
                        a10 = fmaf(q1[dd] * k0[dd], __expf(fminf(b1[dd] - c0[dd], 0.f)), a10);
                        a11 = fmaf(q1[dd] * k1[dd], __expf(fminf(b1[dd] - c1[dd], 0.f)), a11);
                    }
                }
            }
            a00 += __shfl_xor(a00, 1); a01 += __shfl_xor(a01, 1); a10 += __shfl_xor(a10, 1); a11 += __shfl_xor(a11, 1);
            if (s0 + 1 > t0) a01 = 0.f;
            if (sp > tp) { a00 = 0.f; a01 = 0.f; a10 = 0.f; a11 = 0.f; }
            if (dh == 0) {
                *(LAS unsigned*)(ATb + t0 * 72 + s0) = pk2(a00, a01);
                *(LAS unsigned*)(ATb + (t0 + 1) * 72 + s0) = pk2(a10, a11);
            }
            LAS bf16_t* QT = (LAS bf16_t*)(lds + 99328);
            LAS bf16_t* KT = (LAS bf16_t*)(lds + 106496);
#pragma unroll 1
            for (int i = 0; i < 3; ++i) {
                const int e = tid + i * NTHR, t = 16 + (e >> 5), d = 2 * (e & 31), R = (t & ~15) - 1;
                const float x0 = Q[t * 68 + d] * __expf(fminf(Bc[t * 68 + d] - Bc[R * 68 + d], 0.f));
                const float x1 = Q[t * 68 + d + 1] * __expf(fminf(Bc[t * 68 + d + 1] - Bc[R * 68 + d + 1], 0.f));
                *(LAS unsigned*)(QT + (t - 16) * 72 + d) = pk2(x0, x1);
            }
#pragma unroll 1
            for (int i = 0; i < 6; ++i) {
                const int e = tid + i * NTHR, row = e >> 5, d = 2 * (e & 31);
                const int rb = row < 16 ? 0 : (row < 48 ? 1 : 2);
                const int s = row - (rb == 0 ? 0 : (rb == 1 ? 16 : 48)), R = 16 * rb + 15;
                const float x0 = K[s * 68 + d] * __expf(fminf(Bc[R * 68 + d] - Bc[s * 68 + d], 0.f));
                const float x1 = K[s * 68 + d + 1] * __expf(fminf(Bc[R * 68 + d + 1] - Bc[s * 68 + d + 1], 0.f));
                *(LAS unsigned*)(KT + row * 72 + d) = pk2(x0, x1);
            }
        }
#pragma unroll
        for (int i = 0; i < 8; ++i) {
            const int e = tid + i * NTHR, t = e >> 6, d = e & 63;
            const float bt = Bc[t * 68 + d];
            hgQB[(size_t)item * 4096 + e] = f2bf(Q[t * 68 + d] * __expf(bt));
            KtB[d * 72 + t] = f2bf(K[t * 68 + d] * __expf(Bc[63 * 68 + d] - bt));
        }
        if (tid < 64) hgG[(size_t)item * 64 + tid] = __expf(Bc[63 * 68 + tid]);
        __syncthreads();
        {
            const LAS bf16_t* QT = (const LAS bf16_t*)(lds + 99328);
            const LAS bf16_t* KT = (const LAS bf16_t*)(lds + 106496);
            if (w < 6) {
                const int tb16 = w < 1 ? 1 : (w < 3 ? 2 : 3), sb16 = w - (tb16 == 1 ? 0 : (tb16 == 2 ? 1 : 3));
                const int kbase = (tb16 == 1 ? 0 : (tb16 == 2 ? 16 : 48)) + 16 * sb16;
                const LAS bf16_t* Ab = QT + (16 * (tb16 - 1) + lc) * 72 + 8 * gq;
                const LAS bf16_t* Bb = KT + (kbase + lc) * 72 + 8 * gq;
                f32x4 acc = zero4();
                acc = MFMA16(*(const LAS bf16x8*)Ab, *(const LAS bf16x8*)Bb, acc);
                acc = MFMA16(*(const LAS bf16x8*)(Ab + 32), *(const LAS bf16x8*)(Bb + 32), acc);
#pragma unroll
                for (int i = 0; i < 4; ++i) ATb[(16 * tb16 + 4 * gq + i) * 72 + 16 * sb16 + lc] = f2bf(acc[i]);
            } else {
                for (int e = tid - 384; e < 6 * 16 * 8; e += 128) {
                    const int bz = e >> 7, r = (e >> 3) & 15, cw = e & 7;
                    const int tb16 = bz < 3 ? 0 : (bz < 5 ? 1 : 2), sb16 = bz < 3 ? bz + 1 : (bz < 5 ? bz - 1 : 3);
                    *(LAS unsigned*)(ATb + (16 * tb16 + r) * 72 + 16 * sb16 + 2 * cw) = 0u;
                }
            }
        }
        __syncthreads();
#pragma unroll
        for (int q = 0; q < 4; ++q) {
            const int tile = w * 4 + q, isU = tile >> 4, rt_ = (tile >> 2) & 3, ct = tile & 3;
            const LAS bf16_t* Ab = (isU ? KtB : ATb) + (16 * rt_ + lc) * 72 + 8 * gq;
            const LAS bf16_t* Bb = ItB + (16 * ct + lc) * 72 + 8 * gq;
            f32x4 acc = zero4();
            acc = MFMA16(*(const LAS bf16x8*)Ab, *(const LAS bf16x8*)Bb, acc);
            acc = MFMA16(*(const LAS bf16x8*)(Ab + 32), *(const LAS bf16x8*)(Bb + 32), acc);
#pragma unroll
            for (int i = 0; i < 4; ++i) {
                const int r = 16 * rt_ + 4 * gq + i, cc = 16 * ct + lc;
                if (isU) hgU[((size_t)item * 64 + r) * 64 + cc] = acc[i];
                else hgO[((size_t)item * 64 + r) * 64 + cc] = f2bf(acc[i]);
            }
        }
    }
}

__device__ void phase_hgrnB(KA ka, int layer) {
    PHASE_IDS
    const float* hgU = PF(hgU); const float* hgG = (PF(hgG) + layer * ((size_t)1024 * 64)); float* hgS = PF(hgS);
    for (int gid = BID * NTHR + TID; gid < 32768; gid += gridDim.x * NTHR) {
        const int bh = gid >> 12, dv = gid & 4095, d = dv >> 6;
        float S = 0.f;
        for (int c0 = 0; c0 < 128; c0 += 8) {
            float u[8], gg[8];
#pragma unroll
            for (int k = 0; k < 8; ++k) { const size_t item = (size_t)bh * 128 + c0 + k; u[k] = hgU[item * 4096 + dv]; gg[k] = hgG[item * 64 + d]; }
#pragma unroll
            for (int k = 0; k < 8; ++k) { const size_t item = (size_t)bh * 128 + c0 + k; hgS[item * 4096 + dv] = S; S = fmaf(gg[k], S, u[k]); }
        }
    }
    if (BID * NTHR < 32768) {
        asm volatile("s_waitcnt vmcnt(0)" ::: "memory");
        __syncthreads();
        if (TID == 0) {
            __builtin_amdgcn_fence(__ATOMIC_RELEASE, "agent");
            asm volatile("s_waitcnt vmcnt(0)" ::: "memory");
            (void)__hip_atomic_fetch_add(PF(ctl) + CW_HG + layer * 128, 1u, __ATOMIC_RELAXED, __HIP_MEMORY_SCOPE_AGENT);
        }
    }
}

__device__ void phase_hgrnC(KA ka, int layer, LAS unsigned char* lds) {
    PHASE_IDS
    const int tid = TID, lane = tid & 63, w = __builtin_amdgcn_readfirstlane(tid >> 6), gq = lane >> 4, lc = lane & 15;
    LAS bf16_t* QBb = (LAS bf16_t*)lds;
    LAS bf16_t* StB = QBb + 64 * 72;
    float* OT = (float*)(lds + 32768);
    const bf16_t* H = PF(H);
    const float* hgS = PF(hgS); const bf16_t* hgQB = PF(hgQB); const bf16_t* hgO = PF(hgO);
    const float* og = PF(out_gain) + layer * 1024;
    bf16_t* Y = PF(Y);
    {
        unsigned* done = PF(ctl) + CW_HG + layer * 128;
        const unsigned need = (unsigned)((32768 + NTHR - 1) / NTHR < (int)gridDim.x ? (32768 + NTHR - 1) / NTHR : (int)gridDim.x);
        if (tid == 0) {
            unsigned* bar = PF(ctl) + CW_BAR;
            XB_SPIN(xb_ld(done) < need, bar);
            __builtin_amdgcn_fence(__ATOMIC_ACQUIRE, "agent");
            asm volatile("s_waitcnt vmcnt(0)" ::: "memory");
        }
        __syncthreads();
    }
    unsigned* qhead = PF(ctl) + CW_HG + layer * 128 + 64;
    for (int item = queue_fetch(ka, qhead, lds); item < 1024; item = queue_fetch(ka, qhead, lds)) {
        const int c = item & 127, bh = item >> 7, h = bh & 3, b = bh >> 2;
        const size_t tok0 = (size_t)b * T_ + c * 64;
        __syncthreads();
#pragma unroll
        for (int i = 0; i < 8; ++i) {
            const int e = tid + i * NTHR, r = e >> 6, cc = e & 63;
            QBb[r * 72 + cc] = hgQB[(size_t)item * 4096 + e];
            StB[cc * 72 + r] = f2bf(hgS[(size_t)item * 4096 + e]);
        }
        __syncthreads();
#pragma unroll
        for (int q = 0; q < 2; ++q) {
            const int tile = w * 2 + q, rt_ = tile >> 2, ct = tile & 3;
            const LAS bf16_t* Ab = QBb + (16 * rt_ + lc) * 72 + 8 * gq;
            const LAS bf16_t* Bb = StB + (16 * ct + lc) * 72 + 8 * gq;
            f32x4 acc = zero4();
            acc = MFMA16(*(const LAS bf16x8*)Ab, *(const LAS bf16x8*)Bb, acc);
            acc = MFMA16(*(const LAS bf16x8*)(Ab + 32), *(const LAS bf16x8*)(Bb + 32), acc);
#pragma unroll
            for (int i = 0; i < 4; ++i) {
                const int t = 16 * rt_ + 4 * gq + i, v = 16 * ct + lc;
                OT[t * 65 + v] = acc[i] + bf2f(hgO[((size_t)item * 64 + t) * 64 + v]);
            }
        }
        __syncthreads();
        {
            float av[8], ms[8], hgv[8];
#pragma unroll
            for (int i = 0; i < 8; ++i) hgv[i] = bf2f(H[(tok0 + w + 8 * i) * HLD + C_HG + h * 64 + lane]);
            const float ogv = og[768 + h * 64 + lane];
#pragma unroll
            for (int i = 0; i < 8; ++i) { av[i] = OT[(w + 8 * i) * 65 + lane]; ms[i] = av[i] * av[i]; }
#pragma unroll
            for (int off = 32; off > 0; off >>= 1) {
                float tt[8];
#pragma unroll
                for (int i = 0; i < 8; ++i) tt[i] = __shfl_xor(ms[i], off);
#pragma unroll
                for (int i = 0; i < 8; ++i) ms[i] += tt[i];
            }
#pragma unroll
            for (int i = 0; i < 8; ++i) {
                float r = ms[i] * (1.f / 64.f);
                asm volatile("" : "+v"(r));
                const float y = av[i] * rsqrtf(r + 1e-6f) * ogv * (hgv[i] * sigmoidf_(hgv[i]));
                Y[(tok0 + w + 8 * i) * DM + 768 + h * 64 + lane] = f2bf(y);
            }
        }
    }
}

struct CmpOrder {
    static constexpr bool GATHER = false;
    const char* W1T; int c;
    __device__ __forceinline__ bool next(int i, pg8::Unit& u) const {
        if (i > 0 || c >= 16) return false;
        const int which = c >> 3, bh = (c >> 1) & 3, nt = c & 1;
        u.arow0 = (bh >> 1) * 512 + nt * 256; u.nrows = 256; u.pm = nt; u.pn = 0; u.e = which * 4 + bh; u.ui = 0;
        u.bptr = W1T + (size_t)which * 256 * 2048 * 2;
        return true;
    }
    __device__ __forceinline__ int arow(const pg8::Unit& u, int r) const { return u.arow0 + r; }
    __device__ __forceinline__ int lda(int) const { return 16 * HLD; }
    __device__ __forceinline__ unsigned kstepA() const { return (unsigned)(HLD * 2); }
    __device__ __forceinline__ const char* abase(const pg8::Unit& u, const char* A) const { return A + (((u.e >> 2) ? C_VC : C_KC) + (u.e & 1) * 64) * 2; }
};
struct EpiCmp {
    static constexpr bool PERM = true;
    bf16_t* G; const float* cbias;
    __device__ __forceinline__ void operator()(const f32x4 (&acc)[2][2][4][2], const pg8::Unit& u, int wr, int wc, int fr, int fq) const {
        const float* bp = cbias + (u.e >> 2) * 128 + wc * 32 + 8 * fq;
        const f32x4 b0 = *(const f32x4*)bp, b1 = *(const f32x4*)(bp + 4);
#pragma unroll
        for (int ai = 0; ai < 2; ++ai)
#pragma unroll
            for (int m = 0; m < 4; ++m) {
                const int r = ai * 128 + wr * 64 + m * 16 + fr;
                bf16_t* rowp = G + ((size_t)(u.e * 512 + u.pm * 256 + r)) * 128 + wc * 32 + 8 * fq;
                const f32x4 v0 = acc[ai][0][m][0] + b0, v1 = acc[ai][0][m][1] + b1;
                u32x4 w; w.x = pk2(gelu_slow(v0[0]), gelu_slow(v0[1])); w.y = pk2(gelu_slow(v0[2]), gelu_slow(v0[3])); w.z = pk2(gelu_slow(v1[0]), gelu_slow(v1[1])); w.w = pk2(gelu_slow(v1[2]), gelu_slow(v1[3]));
                *(u32x4*)rowp = w;
            }
    }
};
__device__ void phase_compress2(KA ka, int layer, LAS unsigned char* lds) {
    const int bid = opaque_bid();
    if (bid >= 16) return;
    CmpOrder S{(const char*)(PF(WT) + WT_C1), bid};
    EpiCmp E{(PF(gb) + layer * ((size_t)8 * 512 * 128)), (PF(cbias) + layer * (256))};
    pg8::gemm_phase<EpiCmp, CmpOrder>(lds, (const char*)PF(H), 2048, S, E, ka.wv);
    __syncthreads();
    const int tid = opaque_tid(ka.wv);
    const int which = bid >> 3, bh = (bid >> 1) & 3, nt = bid & 1;
    float* w2s = (float*)lds;
    const float* w2 = PF(cmp_w2) + ((size_t)layer * 2 + which) * 128 * 64;
    for (int i = tid; i < 128 * 64; i += NTHR) w2s[i] = w2[i];
    __syncthreads();
    const int r = tid >> 1, half = tid & 1;
    const bf16_t* grow = (PF(gb) + layer * ((size_t)8 * 512 * 128)) + ((size_t)((which * 4 + bh) * 512 + nt * 256 + r)) * 128;
    float acc[32];
#pragma unroll
    for (int j = 0; j < 32; ++j) acc[j] = 0.f;
    for (int c8 = 0; c8 < 16; ++c8) {
        const u32x4 gu = *(const u32x4*)(grow + c8 * 8);
        const unsigned gw[4] = {gu.x, gu.y, gu.z, gu.w};
#pragma unroll
        for (int e = 0; e < 8; ++e) {
            const float gv = (e & 1) ? __uint_as_float(gw[e >> 1] & 0xffff0000u) : __uint_as_float(gw[e >> 1] << 16);
            const float* wrow = w2s + (c8 * 8 + e) * 64 + half * 32;
#pragma unroll
            for (int j4 = 0; j4 < 8; ++j4) {
                const float4 w4 = *(const float4*)(wrow + j4 * 4);
                acc[j4 * 4 + 0] = fmaf(gv, w4.x, acc[j4 * 4 + 0]); acc[j4 * 4 + 1] = fmaf(gv, w4.y, acc[j4 * 4 + 1]);
                acc[j4 * 4 + 2] = fmaf(gv, w4.z, acc[j4 * 4 + 2]); acc[j4 * 4 + 3] = fmaf(gv, w4.w, acc[j4 * 4 + 3]);
            }
        }
    }
    const int n = nt * 256 + r;
    if (which == 0) {
        bf16_t* o = (PF(kcb) + layer * ((size_t)4 * 512 * 64)) + ((size_t)bh * 512 + n) * 64 + half * 32;
#pragma unroll
        for (int j = 0; j < 32; j += 2) *(unsigned*)(o + j) = pk2(acc[j], acc[j + 1]);
    } else {
        const int np = (n & ~31) + 8 * ((n & 15) >> 2) + 4 * ((n >> 4) & 1) + (n & 3);
        bf16_t* o = (PF(vcT) + layer * ((size_t)4 * 64 * 512)) + (size_t)bh * 64 * 512 + np;
#pragma unroll
        for (int j = 0; j < 32; ++j) o[(size_t)(half * 32 + j) * 512] = f2bf(acc[j]);
    }
    __syncthreads();
}

__device__ void phase_gmlp2(KA ka, int layer, LAS unsigned char* lds, int first, int nblk) {
    PHASE_IDS
    const int tid = TID, lane = tid & 63, w = __builtin_amdgcn_readfirstlane(tid >> 6), gq = lane >> 4, lc = lane & 15;
    LAS bf16_t* Vt = (LAS bf16_t*)lds;
    const float* gain = PF(gm_v_gain) + layer * 256;
    const float* bias = PF(gm_v_bias) + layer * 256;
    const float* bs = PF(gm_b_s) + layer * 4 * 128;
    const bf16_t* gmW = PF(WT) + WT_GM;
    const bf16_t* H = PF(H);
    bf16_t* Y = PF(Y);
    if (BID < first) return;
    for (int it = BID - first; it < 1536; it += nblk) {
        if (it < 1024) continue;
        const int item = it - 1024;
        const int g = item & 3, c = (item >> 2) & 63, b = item >> 8;
        const size_t tok0 = (size_t)b * T_ + (size_t)c * 128;
        __syncthreads();
        bf16_t gvr[16], gur[16];
#pragma unroll
        for (int i = 0; i < 16; ++i) gvr[i] = H[(tok0 + w * 16 + i) * HLD + C_GV + g * 64 + lane];
#pragma unroll
        for (int i = 0; i < 4; ++i)
#pragma unroll
            for (int ct = 0; ct < 4; ++ct) gur[i * 4 + ct] = H[(tok0 + 16 * w + 4 * gq + i) * HLD + C_GU + g * 64 + 16 * ct + lc];
        const bf16_t* wrow = gmW + ((size_t)g * 128 + 16 * w + lc) * 128 + 8 * gq;
        const int kmax = (16 * w + 15) >> 5;
        bf16x8 afr[4];
#pragma unroll
        for (int ks = 0; ks < 4; ++ks) afr[ks] = *(const bf16x8*)(wrow + 32 * (ks <= kmax ? ks : 0));
        const float* ogain = PF(out_gain) + layer * 1024;
        float bsv[4], ogv[4];
#pragma unroll
        for (int i = 0; i < 4; ++i) bsv[i] = bs[g * 128 + 16 * w + 4 * gq + i];
#pragma unroll
        for (int ct = 0; ct < 4; ++ct) ogv[ct] = ogain[g * 64 + 16 * ct + lc];
        const float gn = gain[g * 64 + lane], bi = bias[g * 64 + lane];
        {
            float ge[16], sm[16];
#pragma unroll
            for (int i = 0; i < 16; ++i) { ge[i] = gelu_t(bf2f(gvr[i])); sm[i] = ge[i]; }
#pragma unroll
            for (int off = 32; off > 0; off >>= 1) {
                float tt[16];
#pragma unroll
                for (int i = 0; i < 16; ++i) tt[i] = __shfl_xor(sm[i], off);
#pragma unroll
                for (int i = 0; i < 16; ++i) sm[i] += tt[i];
            }
#pragma unroll
            for (int i = 0; i < 16; ++i) { ge[i] -= sm[i] * (1.f / 64.f); sm[i] = ge[i] * ge[i]; }
#pragma unroll
            for (int off = 32; off > 0; off >>= 1) {
                float tt[16];
#pragma unroll
                for (int i = 0; i < 16; ++i) tt[i] = __shfl_xor(sm[i], off);
#pragma unroll
                for (int i = 0; i < 16; ++i) sm[i] += tt[i];
            }
#pragma unroll
            for (int i = 0; i < 16; i += 2) {
                float r0 = sm[i] * (1.f / 64.f), r1 = sm[i + 1] * (1.f / 64.f);
                asm volatile("" : "+v"(r0), "+v"(r1));
                float v0 = ge[i] * rsqrtf(r0 + 1e-5f) * gn + bi, v1 = ge[i + 1] * rsqrtf(r1 + 1e-5f) * gn + bi;
                asm volatile("" : "+v"(v0), "+v"(v1));
                *(LAS unsigned*)(Vt + lane * 136 + w * 16 + i) = pk2(v0, v1);
            }
        }
        __syncthreads();
        f32x4 acc[4];
#pragma unroll
        for (int ct = 0; ct < 4; ++ct) acc[ct] = zero4();
#pragma unroll
        for (int ks = 0; ks < 4; ++ks) {
            if (ks <= kmax) {
#pragma unroll
                for (int ct = 0; ct < 4; ++ct) {
                    const bf16x8 bfr = *(const LAS bf16x8*)(Vt + (16 * ct + lc) * 136 + 32 * ks + 8 * gq);
                    acc[ct] = MFMA16(afr[ks], bfr, acc[ct]);
                }
            }
        }
#pragma unroll
        for (int i = 0; i < 4; ++i) {
            const int t = 16 * w + 4 * gq + i;
            float yv[4];
            float ss = 0.f;
#pragma unroll
            for (int ct = 0; ct < 4; ++ct) {
                const int d = 16 * ct + lc;
                float z = acc[ct][i] + bsv[i];
                asm volatile("" : "+v"(z));
                const float u = gelu_t(bf2f(gur[i * 4 + ct]));
                yv[ct] = u * z;
                asm volatile("" : "+v"(yv[ct]));
                ss += yv[ct] * yv[ct];
            }
            ss += __shfl_xor(ss, 1); ss += __shfl_xor(ss, 2); ss += __shfl_xor(ss, 4); ss += __shfl_xor(ss, 8);
            const float rn = rsqrtf(ss * (1.f / 64.f) + 1e-6f);
#pragma unroll
            for (int ct = 0; ct < 4; ++ct) {
                const int d = 16 * ct + lc;
                Y[(tok0 + t) * DM + g * 64 + d] = f2bf(yv[ct] * rn * ogv[ct]);
            }
        }
    }
}

#ifndef ONLY_Q
#define ONLY_Q -2
#endif
#ifndef QMASK
#define QMASK 0x3ff
#endif
#define QON(k) ((ONLY_Q == -2 && ((QMASK >> ((k) + 1)) & 1)) || ONLY_Q == (k))
#ifndef DUPMASK
#define DUPMASK 0
#endif
#define DUP(k) ((DUPMASK >> (k)) & 1)
#ifndef PROF_LO
#define PROF_LO -1
#endif
#ifndef PROF_HI
#define PROF_HI -1
#endif
#ifndef WS_PROBE_PAD
#define WS_PROBE_PAD 0
#endif
#ifndef NPH_TOTAL
#define NPH_TOTAL 19
#endif
__global__ void __launch_bounds__(NTHR, 2) k_mega(P p0) {
    extern __shared__ __attribute__((aligned(16))) unsigned char lds_raw[];
    LAS unsigned char* lds = (LAS unsigned char*)lds_raw;
    float* smem = (float*)lds_raw;
    volatile LAS unsigned* misc = (volatile LAS unsigned*)(lds + LDS_MISC);
    if (threadIdx.x < 16) misc[threadIdx.x] = 0u;
    __syncthreads();
    const int wv0 = __builtin_amdgcn_readfirstlane((int)(threadIdx.x >> 6));
    XcdBarrier bar = xcd_barrier_post(p0.ctl + CW_BAR, misc); bar.wv = wv0;
    if (PROF_LO >= 0 && blockIdx.x == 0 && threadIdx.x == 0) ((unsigned long long*)(p0.ctl + 8192))[0] = __builtin_amdgcn_s_memrealtime();
#pragma unroll 1
    for (int ph = 0; ph < p0.nph; ph++) {
        const int layer = ph == 0 ? 0 : (ph - 1) / 9, q = ph == 0 ? -1 : (ph - 1) % 9;
        const int dupm = p0.pad;
        KA ka; ka.wv = wv0;
#if defined(__HIP_DEVICE_COMPILE__)
        ka.p = (const __attribute__((address_space(4))) char*)__builtin_amdgcn_kernarg_segment_ptr();
        asm volatile("" : "+s"(ka.p));
#else
        ka.p = nullptr;
#endif
        const float* xin = layer == 0 ? PF(x) : PF(out);
        float* x1 = PF(out);
        if (q == -1 && QON(-1)) { for (int r = 0; r <= ((dupm >> 15) & 1); ++r) { phase_prologue(ka, 0, smem); __syncthreads(); } }
        else if (q == 0 && QON(0)) { for (int r = 0; r <= (dupm & 1); ++r) { phase_inproj(ka, layer, lds); __syncthreads(); } }
        else if (q == 1 && QON(1)) {
            const int nb1 = (int)gridDim.x > 32 ? 16 : 0, nwork = (int)gridDim.x - nb1;
            for (int r = 0; r <= ((dupm >> 12) & 1); ++r) { phase_compress2(ka, layer, lds); __syncthreads(); }
            for (int r = 0; r <= ((dupm >> 10) & 1); ++r) { phase_hgrnA(ka, layer, lds, nb1, nwork); __syncthreads(); }
            for (int r = 0; r <= ((dupm >> 11) & 1); ++r) { phase_gmlp2(ka, layer, lds, nb1, nwork); __syncthreads(); }
            for (int r = 0; r <= ((dupm >> 13) & 1); ++r) { phase_vtrans(ka, smem); __syncthreads(); }
        }
        else if (q == 2 && QON(2)) { for (int r = 0; r <= ((dupm >> 14) & 1); ++r) { phase_hgrnB(ka, layer); __syncthreads(); } for (int r = 0; r <= ((dupm >> 2) & 1); ++r) { phase_nsa2(ka, layer, lds); __syncthreads(); } phase_hgrnC(ka, layer, lds); __syncthreads(); }
        else if (q == 3) continue;
        else if (q == 4 && QON(4)) phase_outproj(ka, layer, xin, x1, lds);
        else if (q == 5 && QON(5)) { for (int r = ((dupm >> 5) & 1); r >= 0; --r) { phase_ln1_route(ka, layer, x1, smem, r == 1); __syncthreads(); } }
        else if (q == 6 && QON(6)) { for (int r = 0; r <= ((dupm >> 6) & 1); ++r) { phase_moe_up(ka, layer, lds); __syncthreads(); } }
        else if (q == 7 && QON(7)) { for (int r = 0; r <= ((dupm >> 7) & 1); ++r) { phase_moe_down(ka, layer, lds); __syncthreads(); } }
        else if (q == 8 && QON(8)) { phase_ln2(ka, layer, x1, PF(out)); if (layer == 0) { __syncthreads(); phase_prologue(ka, 1, smem); } }
        if (ph != NPH_TOTAL - 1 || PROF_LO >= 0) xcd_barrier(bar);
        if (PROF_LO >= 0 && blockIdx.x == 0 && threadIdx.x == 0) ((unsigned long long*)(p0.ctl + 8192))[ph + 1] = __builtin_amdgcn_s_memrealtime();
    }

#ifdef STALE_PROBE
    {
        xcd_barrier(bar);
        const int G = gridDim.x, b = blockIdx.x, tid = threadIdx.x, partner = (b + 1) % G;
        unsigned* T = (unsigned*)p0.hgU;
        for (int arm = 0; arm < 2; ++arm) for (int i = tid; i < 4096; i += NTHR) T[((size_t)(arm * G + b)) * 4096 + i] = 1000u + b;
        xcd_barrier(bar);
        unsigned sink = 0;
        for (int rep = 0; rep < 4; ++rep) for (int i = tid; i < 4096; i += NTHR) sink += T[(size_t)partner * 4096 + i];
        for (int rep = 0; rep < 4; ++rep) {
            for (int i = 0; i < 2; ++i) __builtin_amdgcn_global_load_lds((const unsigned*)(T + ((size_t)(G + partner)) * 4096 + (i * 512 + tid) * 4), (LAS unsigned*)(lds + i * 8192 + wv0 * 1024), 16, 0, 0);
            asm volatile("s_waitcnt vmcnt(0)" ::: "memory");
        }
        asm volatile("" :: "v"(sink));
        xcd_barrier(bar);
        for (int arm = 0; arm < 2; ++arm) for (int i = tid; i < 4096; i += NTHR) T[((size_t)(arm * G + b)) * 4096 + i] = 2000u + b;
        xcd_barrier(bar);
        unsigned bad0 = 0, bad1 = 0;
        for (int i = tid; i < 4096; i += NTHR) bad0 += (T[(size_t)partner * 4096 + i] != 2000u + partner);
        for (int i = 0; i < 2; ++i) __builtin_amdgcn_global_load_lds((const unsigned*)(T + ((size_t)(G + partner)) * 4096 + (i * 512 + tid) * 4), (LAS unsigned*)(lds + i * 8192 + wv0 * 1024), 16, 0, 0);
        asm volatile("s_waitcnt vmcnt(0)" ::: "memory");
        __syncthreads();
        for (int i = tid; i < 4096; i += NTHR) bad1 += (((LAS unsigned*)lds)[i] != 2000u + partner);
        unsigned* cnt2 = p0.ctl + 12288;
        if (bad0) atomicAdd(&cnt2[0], bad0);
        if (bad1) atomicAdd(&cnt2[64], bad1);
        xcd_barrier(bar);
        const unsigned c0 = __hip_atomic_load(&cnt2[0], __ATOMIC_RELAXED, __HIP_MEMORY_SCOPE_AGENT), c1 = __hip_atomic_load(&cnt2[64], __ATOMIC_RELAXED, __HIP_MEMORY_SCOPE_AGENT);
        const float fac = 1.f + (c0 ? 1.f : 0.f) + (c1 ? 2.f : 0.f);
        for (size_t i = (size_t)blockIdx.x * NTHR + threadIdx.x; i < (size_t)NTOK * DM; i += (size_t)gridDim.x * NTHR) p0.out[i] = fac;
    }
#endif
    if (PROF_LO >= 0) {
        xcd_barrier(bar);
        const unsigned long long* ts = (const unsigned long long*)(p0.ctl + 8192);
        const unsigned long long t0 = __hip_atomic_load(&ts[PROF_LO], __ATOMIC_RELAXED, __HIP_MEMORY_SCOPE_AGENT), t1 = __hip_atomic_load(&ts[PROF_HI + 1], __ATOMIC_RELAXED, __HIP_MEMORY_SCOPE_AGENT);
        const float fac = 1.f + 1e-5f * (float)(t1 - t0);
        for (size_t i = (size_t)blockIdx.x * NTHR + threadIdx.x; i < (size_t)NTOK * DM; i += (size_t)gridDim.x * NTHR) p0.out[i] *= fac;
    }
}

static inline size_t align_up(size_t v, size_t a) { return (v + a - 1) / a * a; }

extern "C" void kernel_launch(void* const* d_in, const int* in_sizes, int n_in, void* d_out, int out_size, void* d_ws,
                              size_t ws_size, hipStream_t stream) {
    P p{};
    p.x = (const float*)d_in[0]; p.w_in = (const float*)d_in[1]; p.gm_v_gain = (const float*)d_in[2];
    p.gm_v_bias = (const float*)d_in[3]; p.gm_w_s = (const float*)d_in[4]; p.gm_b_s = (const float*)d_in[5];
    p.cmp_pos = (const float*)d_in[6]; p.cmp_w1 = (const float*)d_in[7]; p.cmp_w2 = (const float*)d_in[8];
    p.nsa_gate_b = (const float*)d_in[9]; p.hg_lower = (const float*)d_in[10]; p.out_gain = (const float*)d_in[11];
    p.w_out = (const float*)d_in[12]; p.ln1_g = (const float*)d_in[13]; p.ln1_b = (const float*)d_in[14];
    p.rg_w = (const float*)d_in[15]; p.rg_b = (const float*)d_in[16]; p.re_w = (const float*)d_in[17];
    p.re_b = (const float*)d_in[18]; p.w_gate = (const float*)d_in[19]; p.w_up = (const float*)d_in[20];
    p.w_down = (const float*)d_in[21]; p.ln2_g = (const float*)d_in[22]; p.ln2_b = (const float*)d_in[23];
    p.out = (float*)d_out;
    char* ws = (char*)d_ws;
    size_t off = 0;
    p.ctl = (unsigned*)(ws + off); off = align_up(off + CTL_BYTES, 256);
    p.WT = (bf16_t*)(ws + off); off = align_up(off + WT_LAYER * 2, 256);
    p.H = (bf16_t*)(ws + off); off = align_up(off + (size_t)(NTOK + 64) * HLD * 2, 256);
    p.Y = (bf16_t*)(ws + off); off = align_up(off + (size_t)NTOK * DM * 2, 256);
    p.XB = (bf16_t*)(ws + off); off = align_up(off + (size_t)NTOK * DM * 2, 256);
    p.kcb = (bf16_t*)(ws + off); off = align_up(off + 2 * ((size_t)4 * 512 * 64 * 2), 256);
    p.vcT = (bf16_t*)(ws + off); off = align_up(off + 2 * ((size_t)4 * 64 * 512 * 2), 256);
    p.vsT = (bf16_t*)(ws + off); off = align_up(off + (size_t)4 * 64 * T_ * 2, 256);
    p.vwT = (bf16_t*)(ws + off); off = align_up(off + (size_t)4 * 64 * T_ * 2, 256);
    p.gb = (bf16_t*)(ws + off); off = align_up(off + 2 * ((size_t)8 * 512 * 128 * 2), 256);
    p.cbias = (float*)(ws + off); off = align_up(off + 2 * (256 * 4), 256);
    p.wrt = (float*)(ws + off); off = align_up(off + 2 * (20 * 1024 * 4), 256);
    p.list_tok = (int*)(ws + off); off = align_up(off + 2 * ((size_t)16 * NTOK * 4), 256);
    p.list_w = (float*)(ws + off); off = align_up(off + 2 * ((size_t)16 * NTOK * 4), 256);
    p.tok_slot = (int*)(ws + off); off = align_up(off + 2 * ((size_t)NTOK * 2 * 4), 256);
    p.hgU = (float*)(ws + off); off = align_up(off + (size_t)1024 * 4096 * 4, 256);
    p.hgS = (float*)(ws + off); off = align_up(off + (size_t)1024 * 4096 * 4, 256);
    p.hgG = (float*)(ws + off); off = align_up(off + 2 * ((size_t)1024 * 64 * 4), 256);
    p.hgQB = (bf16_t*)(ws + off); off = align_up(off + (size_t)1024 * 4096 * 2, 256);
    p.hgO = (bf16_t*)(ws + off); off = align_up(off + (size_t)1024 * 4096 * 2, 256);
#ifdef STALE_PROBE
    p.nph = 0; p.pad = 0;
#else
    p.nph = NPH_TOTAL; p.pad = DUPMASK;
#endif
    (void)in_sizes; (void)n_in; (void)out_size;
    static int grid_blocks = 0;
    if (!grid_blocks) {
        int dev = 0, cus = 0, per_cu = 0;
        (void)hipGetDevice(&dev);
        (void)hipDeviceGetAttribute(&cus, hipDeviceAttributeMultiprocessorCount, dev);
        if (hipFuncSetAttribute((const void*)k_mega, hipFuncAttributeMaxDynamicSharedMemorySize, LDS_BYTES) != hipSuccess) { fprintf(stderr, "hipFuncSetAttribute failed\n"); grid_blocks = -1; return; }
        if (hipOccupancyMaxActiveBlocksPerMultiprocessor(&per_cu, (const void*)k_mega, NTHR, LDS_BYTES) != hipSuccess || per_cu < 1) { fprintf(stderr, "occupancy query says %d\n", per_cu); }
        (void)hipGetLastError();
        grid_blocks = cus;
        off += (size_t)WS_PROBE_PAD;
        if (off > ws_size) { fprintf(stderr, "workspace too small: need %zu have %zu\n", off, ws_size); grid_blocks = -1; }
    }
    if (grid_blocks < 0) return;
    (void)hipMemsetAsync(p.ctl, 0, CTL_BYTES, stream);
    void* args[] = {&p};
    hipError_t e = hipLaunchCooperativeKernel((const void*)k_mega, dim3(grid_blocks), dim3(NTHR), args, LDS_BYTES, stream);
    if (e != hipSuccess) fprintf(stderr, "cooperative launch failed: %s (grid %d)\n", hipGetErrorString(e), grid_blocks);
}
```

```cpp
#include <hip/hip_runtime.h>
#include <cstdio>
#include <cstdint>

#define LAS __attribute__((address_space(3)))
typedef unsigned short bf16_t;
typedef short bf16x8 __attribute__((ext_vector_type(8)));
typedef float f32x4 __attribute__((ext_vector_type(4)));
typedef float f32x2 __attribute__((ext_vector_type(2)));
typedef unsigned u32x4 __attribute__((ext_vector_type(4)));
typedef unsigned u32x2 __attribute__((ext_vector_type(2)));

constexpr int NW = 8;
constexpr int NTHR = NW * 64;
constexpr int T_ = 8192;
constexpr int NTOK = 16384;
constexpr int DM = 1024;
constexpr int IC_SRC = 2840;
constexpr int HLD = 3072;
constexpr int C_GU = 0, C_GV = 256, C_NQ = 512, C_KC = 1024, C_VC = 1152, C_KS = 1280, C_VS = 1408,
              C_KW = 1536, C_VW = 1664, C_HQ = 1792, C_HF = 2048, C_HI = 2304, C_HG = 2560, C_NG = 2816;
constexpr int NCMP = 511;
constexpr float ALPHA = 1.4142135623730951f;
constexpr float NEG_INF = -1e30f;

constexpr size_t WT_IN = 0;
constexpr size_t WT_OUT = WT_IN + (size_t)3072 * 1024;
constexpr size_t WT_UP = WT_OUT + (size_t)1024 * 1024;
constexpr size_t WT_DN = WT_UP + (size_t)16 * 1024 * 1024;
constexpr size_t WT_C1 = WT_DN + (size_t)16 * 1024 * 512;
constexpr size_t WT_GM = WT_C1 + (size_t)2 * 256 * 2048;
constexpr size_t WT_LAYER = WT_GM + (size_t)4 * 128 * 128;

constexpr int LDS_STAGE = 131072;
constexpr int LDS_MISC = LDS_STAGE;
constexpr int LDS_BYTES = 147456;

constexpr int CW_BAR = 0;
constexpr int CW_HG = 7168;
constexpr int CW_CNT = 4096;
constexpr size_t CTL_BYTES = 65536;

struct P {
    const float* x; const float* w_in; const float* gm_v_gain; const float* gm_v_bias; const float* gm_w_s;
    const float* gm_b_s; const float* cmp_pos; const float* cmp_w1; const float* cmp_w2; const float* nsa_gate_b;
    const float* hg_lower; const float* out_gain; const float* w_out; const float* ln1_g; const float* ln1_b;
    const float* rg_w; const float* rg_b; const float* re_w; const float* re_b; const float* w_gate;
    const float* w_up; const float* w_down; const float* ln2_g; const float* ln2_b;
    float* out;
    unsigned* ctl;
    bf16_t* WT;
    bf16_t* H;
    bf16_t* Y;
    bf16_t* XB;
    bf16_t* kcb;
    bf16_t* vcT;
    bf16_t* vsT;
    bf16_t* vwT;
    bf16_t* gb;
    float* cbias;
    float* wrt;
    int* list_tok;
    float* list_w;
    int* tok_slot;
    float* hgU; float* hgG; float* hgS; bf16_t* hgQB; bf16_t* hgO;
    int nph; int pad;
};


struct KA { const __attribute__((address_space(4))) char* p; int wv; };
template <class T> __device__ __forceinline__ T ldarg(KA ka, size_t off) { return *(const __attribute__((address_space(4))) T*)(ka.p + off); }
#define PF(f) ldarg<decltype(P::f)>(ka, offsetof(P, f))

__device__ __forceinline__ float bf2f(bf16_t u) { return __uint_as_float(((unsigned)u) << 16); }
typedef __bf16 bf16x2_t __attribute__((ext_vector_type(2)));
__device__ __forceinline__ unsigned pk2(float lo, float hi) { f32x2 v; v.x = lo; v.y = hi; return __builtin_bit_cast(unsigned, __builtin_convertvector(v, bf16x2_t)); }
__device__ __forceinline__ bf16_t f2bf(float f) { return (bf16_t)(pk2(f, 0.f) & 0xffffu); }
__device__ __forceinline__ float gelu_t(float x) {
    const float u2 = -2.f * 0.7978845608028654f * (x + 0.044715f * x * x * x);
    return x / (1.f + __expf(u2));
}
__device__ __forceinline__ float gelu_slow(float x) {
    float u = 0.7978845608028654f * (x + 0.044715f * x * x * x);
    return 0.5f * x * (1.f + tanhf(u));
}
__device__ __forceinline__ float sigmoidf_(float x) { return 1.f / (1.f + __expf(-x)); }
__device__ __forceinline__ float wave_max(float v) {
#pragma unroll
    for (int o = 32; o > 0; o >>= 1) v = fmaxf(v, __shfl_xor(v, o));
    return v;
}
__device__ __forceinline__ float wave_sum(float v) {
#pragma unroll
    for (int o = 32; o > 0; o >>= 1) v += __shfl_xor(v, o);
    return v;
}
__device__ __forceinline__ void wave_sync() {
    __builtin_amdgcn_fence(__ATOMIC_RELEASE, "wavefront");
    __builtin_amdgcn_wave_barrier();
    __builtin_amdgcn_fence(__ATOMIC_ACQUIRE, "wavefront");
}
__device__ __forceinline__ f32x4 zero4() { f32x4 z = {0.f, 0.f, 0.f, 0.f}; asm volatile("" : "+v"(z)); return z; }
__device__ __forceinline__ int opaque_tid(int wv) {
    int t = wv * 64 + (int)__builtin_amdgcn_mbcnt_hi(~0u, __builtin_amdgcn_mbcnt_lo(~0u, 0u));
    asm volatile("" : "+v"(t));
    return t;
}
__device__ __forceinline__ int opaque_bid() { int b = blockIdx.x; asm volatile("" : "+s"(b)); return b; }
#define PHASE_IDS const int TID = opaque_tid(ka.wv); const int BID = opaque_bid(); (void)TID; (void)BID;
__device__ __forceinline__ int queue_fetch(KA ka, unsigned* head, LAS unsigned char* lds) {
    volatile LAS int* slot = (volatile LAS int*)(lds + LDS_MISC + 48);
    if (opaque_tid(ka.wv) == 0) *slot = (int)__hip_atomic_fetch_add(head, 1u, __ATOMIC_RELAXED, __HIP_MEMORY_SCOPE_AGENT);
    __syncthreads();
    const int v = *slot;
    __syncthreads();
    return __builtin_amdgcn_readfirstlane(v);
}

#define XB_TMO      128
#define XB_XCNT(j)  (256  + 64 * (j))
#define XB_XSUB(j)  (1280 + 64 * (j))
#define XB_XGEN(j)  (2304 + 64 * (j))
#define XB_TOP      3328
#define XB_TOPGEN   3392
#define XCD_BAR_WORDS 3456
#define XB_SPIN_CAP (1u << 22)
__device__ __forceinline__ unsigned xb_ld(unsigned* p)              { return __hip_atomic_load(p, __ATOMIC_RELAXED, __HIP_MEMORY_SCOPE_AGENT); }
__device__ __forceinline__ unsigned xb_add(unsigned* p, unsigned v) { return __hip_atomic_fetch_add(p, v, __ATOMIC_RELAXED, __HIP_MEMORY_SCOPE_AGENT); }
__device__ __forceinline__ unsigned xb_xcc_id() { return (unsigned)__builtin_amdgcn_s_getreg((3 << 11) | 20) & 0xFu; }
#define XB_SPIN(cond, bar) do { unsigned _sp = 0; while (cond) { __builtin_amdgcn_s_sleep(1); \
    if ((++_sp & 255u) == 0u) { if (xb_ld(&(bar)[XB_TMO])) break; if (_sp > XB_SPIN_CAP) { atomicAdd(&(bar)[XB_TMO], 1u); break; } } } } while (0)
struct XcdBarrier { unsigned* bar; unsigned x; volatile LAS unsigned* st; int wv; };
__device__ __forceinline__ XcdBarrier xcd_barrier_post(unsigned* bar, volatile LAS unsigned* st) {
    XcdBarrier b; b.bar = bar; b.x = xb_xcc_id(); b.st = st;
    if (threadIdx.x == 0) (void)xb_add(&bar[XB_XCNT(b.x)], 1u);
    return b;
}
__device__ __forceinline__ void xcd_barrier_complete(unsigned* bar, unsigned x, unsigned& nloc, unsigned& nx) {
    const unsigned G = gridDim.x * gridDim.y * gridDim.z;
    unsigned sum, cnt, mine, sp = 0u;
    for (;;) {
        sum = 0u; cnt = 0u; mine = 0u;
#pragma unroll
        for (unsigned j = 0; j < 16; ++j) { const unsigned c = xb_ld(&bar[XB_XCNT(j)]); sum += c; cnt += (c > 0u) ? 1u : 0u; mine = (j == x) ? c : mine; }
        if (sum == G) break;
        __builtin_amdgcn_s_sleep(1);
        if ((++sp & 255u) == 0u) { if (xb_ld(&bar[XB_TMO])) break; if (sp > XB_SPIN_CAP) { atomicAdd(&bar[XB_TMO], 1u); break; } }
    }
    nloc = mine > 0u ? mine : 1u; nx = cnt > 0u ? cnt : 1u;
}
__device__ __forceinline__ void xcd_barrier(const XcdBarrier& b) {
    asm volatile("s_waitcnt vmcnt(0)" ::: "memory");
    __syncthreads();
    if (opaque_tid(b.wv) == 0) {
        unsigned* bar = b.bar;
        __builtin_amdgcn_s_waitcnt(0);
        unsigned nloc = b.st[0], nx = b.st[1];
        if (nloc == 0u) { xcd_barrier_complete(bar, b.x, nloc, nx); b.st[0] = nloc; b.st[1] = nx; }
        const unsigned old = xb_add(&bar[XB_XSUB(b.x)], 1u);
        const unsigned gen = old / nloc;
        if (old + 1u == (gen + 1u) * nloc) {
            __builtin_amdgcn_fence(__ATOMIC_RELEASE, "agent");
            asm volatile("s_waitcnt vmcnt(0)" ::: "memory");
            const unsigned og = xb_add(&bar[XB_TOP], 1u);
            const unsigned tg = og / nx;
            if (og + 1u != (tg + 1u) * nx) XB_SPIN(xb_ld(&bar[XB_TOP]) < (tg + 1u) * nx, bar);
            __builtin_amdgcn_fence(__ATOMIC_ACQUIRE, "agent");
            xb_add(&bar[XB_XGEN(b.x)], 1u);
            asm volatile("s_waitcnt vmcnt(0)" ::: "memory");
        } else {
            XB_SPIN(xb_ld(&bar[XB_XGEN(b.x)]) == gen, bar);
            __builtin_amdgcn_fence(__ATOMIC_ACQUIRE, "agent");
            asm volatile("s_waitcnt vmcnt(0)" ::: "memory");
        }
    }
    __syncthreads();
}

namespace pg8 {
constexpr int BM = 256, BK = 64, HALF = 128, HTB = HALF * BK * 2, STAGE_BYTES = 8 * HTB;
__host__ __device__ __forceinline__ int lds_byte(int r, int c) { const int st = (r >> 4) * 2 + (c >> 5), rr = r & 15, cc = c & 31, ob = rr * 64 + cc * 2; return st * 1024 + (ob ^ (((ob >> 9) & 1) << 5)); }
__host__ __device__ __forceinline__ void stage_rc(int b, int& R, int& C) { const int st = b / 1024, sb = b % 1024, swz = sb ^ (((sb >> 9) & 1) << 5); R = (st >> 1) * 16 + swz / 64; C = (st & 1) * 32 + (swz % 64) / 2; }
__host__ __device__ __forceinline__ int perm32(int rho) { const int n = rho >> 4, i = rho & 15; return 8 * (i >> 2) + 4 * n + (i & 3); }
__device__ __forceinline__ unsigned cvt_pk_bf16(float lo, float hi) { return pk2(lo, hi); }

struct Unit {
    const char* bptr;
    int arow0;
    int nrows;
    int pm, pn, e, ui;
};

template <class Epi, class Sched>
__device__ __forceinline__ void gemm_phase(LAS unsigned char* lds, const char* Abase, const int K, const Sched& S, const Epi& E, const int wv) {
    const int tid = opaque_tid(wv), wid = __builtin_amdgcn_readfirstlane(tid >> 6), lane = tid & 63, wr = wid >> 2, wc = wid & 3, fr = lane & 15, fq = lane >> 4;
    const int nt = K / BK;
    int R0, C0, R1, C1; stage_rc(tid * 16, R0, C0); stage_rc(tid * 16 + 8192, R1, C1);
    unsigned voffB[2];
    { const int Rb0 = Epi::PERM ? ((R0 & ~31) + perm32(R0 & 31)) : R0, Rb1 = Epi::PERM ? ((R1 & ~31) + perm32(R1 & 31)) : R1;
      voffB[0] = (unsigned)(Rb0 * K + C0) * 2u; voffB[1] = (unsigned)(Rb1 * K + C1) * 2u; }
    const unsigned cA0 = (unsigned)C0 * 2u, cA1 = (unsigned)C1 * 2u;
    const int lda = S.lda(K);
    const unsigned kstepA = S.kstepA();
    const unsigned voffA0 = (unsigned)(R0 * lda + C0) * 2u, voffA1 = (unsigned)(R1 * lda + C1) * 2u;
    const unsigned kstep = (unsigned)(BK * 2);
    const unsigned hstep = (unsigned)(HALF * K * 2);
    const unsigned ldsw = (unsigned)wid * 1024u;
    const int aoff = lds_byte(wr * 64 + fr, fq * 8), boff = lds_byte(wc * 32 + fr, fq * 8);
#define PG8_SA(b, h) (((b) * 2 + (h)) * HTB)
#define PG8_SB(b, h) ((4 + (b) * 2 + (h)) * HTB)
#define PG8_STAGE_B(bufoff, gbase) do { \
        __builtin_amdgcn_global_load_lds((const unsigned*)((const char*)(gbase) + voffB[0]), (LAS unsigned*)(lds + (bufoff) + ldsw), 16, 0, 0); \
        __builtin_amdgcn_global_load_lds((const unsigned*)((const char*)(gbase) + voffB[1]), (LAS unsigned*)(lds + (bufoff) + ldsw + 8192), 16, 0, 0); } while (0)
#define PG8_STAGE_A(bufoff, gbase, pk) do { \
        const unsigned o0_ = Sched::GATHER ? (((pk) & 0xffffu) * (unsigned)lda * 2u + cA0) : voffA0; \
        const unsigned o1_ = Sched::GATHER ? (((pk) >> 16) * (unsigned)lda * 2u + cA1) : voffA1; \
        __builtin_amdgcn_global_load_lds((const unsigned*)((const char*)(gbase) + o0_), (LAS unsigned*)(lds + (bufoff) + ldsw), 16, 0, 0); \
        __builtin_amdgcn_global_load_lds((const unsigned*)((const char*)(gbase) + o1_), (LAS unsigned*)(lds + (bufoff) + ldsw + 8192), 16, 0, 0); } while (0)
#define PG8_LDA(dst, b, h) do { _Pragma("unroll") for (int m = 0; m < 4; ++m) _Pragma("unroll") for (int k = 0; k < 2; ++k) dst[m][k] = *(const LAS bf16x8*)(lds + PG8_SA(b, h) + aoff + m * 2048 + k * 1024); } while (0)
#define PG8_LDB(dst, b, h) do { _Pragma("unroll") for (int n = 0; n < 2; ++n) _Pragma("unroll") for (int k = 0; k < 2; ++k) dst[n][k] = *(const LAS bf16x8*)(lds + PG8_SB(b, h) + boff + n * 2048 + k * 1024); } while (0)
#define PG8_MMA(ai, bj, At, Bt) do { __builtin_amdgcn_s_setprio(1); _Pragma("unroll") for (int m = 0; m < 4; ++m) _Pragma("unroll") for (int n = 0; n < 2; ++n) _Pragma("unroll") for (int k = 0; k < 2; ++k) \
        acc[ai][bj][m][n] = __builtin_amdgcn_mfma_f32_16x16x32_bf16(Bt[n][k], At[m][k], acc[ai][bj][m][n], 0, 0, 0); __builtin_amdgcn_s_setprio(0); } while (0)
#define PG8_WAIT_V(n) asm volatile("s_waitcnt vmcnt(" #n ")" ::: "memory")
#define PG8_WAIT_L(n) asm volatile("s_waitcnt lgkmcnt(" #n ")" ::: "memory")
#define PG8_BAR __builtin_amdgcn_s_barrier()
#define PG8_SCHED __builtin_amdgcn_sched_barrier(0)
#define PG8_PACK(u, h) ((unsigned)S.arow((u), ((h) * 128 + R0) < (u).nrows ? ((h) * 128 + R0) : (u).nrows - 1) | ((unsigned)S.arow((u), ((h) * 128 + R1) < (u).nrows ? ((h) * 128 + R1) : (u).nrows - 1) << 16))
    Unit cur, nxt; int ui = 0;
    if (!S.next(0, cur)) return;
    f32x4 acc[2][2][4][2];
    const f32x4 zv = zero4();
#pragma unroll
    for (int a = 0; a < 2; ++a)
#pragma unroll
        for (int b = 0; b < 2; ++b)
#pragma unroll
            for (int m = 0; m < 4; ++m)
#pragma unroll
                for (int n = 0; n < 2; ++n) acc[a][b][m][n] = zv;
    bf16x8 At[4][2], B0[2][2], B1[2][2];
    unsigned pC0 = 0u, pC1 = 0u, pN0 = 0u, pN1 = 0u;
    if (Sched::GATHER) { pC0 = PG8_PACK(cur, 0); pC1 = PG8_PACK(cur, 1); }
    const char* cB = cur.bptr;
    const char* cA = Sched::GATHER ? Abase : S.abase(cur, Abase) + (size_t)cur.arow0 * lda * 2;
    const unsigned hA = Sched::GATHER ? 0u : (unsigned)(HALF * lda * 2);
    PG8_STAGE_B(PG8_SB(0, 0), cB); PG8_STAGE_B(PG8_SB(0, 1), cB + hstep); PG8_STAGE_A(PG8_SA(0, 0), cA, pC0); PG8_STAGE_A(PG8_SA(0, 1), cA + hA, pC1);
    if (wr == 1) PG8_BAR;
    PG8_WAIT_V(2); PG8_BAR;
    PG8_STAGE_B(PG8_SB(1, 0), cB + kstep); PG8_STAGE_A(PG8_SA(1, 0), cA + kstepA, pC0); PG8_STAGE_B(PG8_SB(1, 1), cB + hstep + kstep);
    PG8_WAIT_V(6); PG8_BAR;
    for (;;) {
        const bool has_next = S.next(ui + 1, nxt);
        if (Sched::GATHER) { if (has_next) { pN0 = PG8_PACK(nxt, 0); pN1 = PG8_PACK(nxt, 1); } else { pN0 = pC0; pN1 = pC1; } }
        const char* nB = has_next ? nxt.bptr : cB;
        const char* nA = (Sched::GATHER || !has_next) ? cA : S.abase(nxt, Abase) + (size_t)nxt.arow0 * lda * 2;
        for (int t = 0; t < nt; t += 2) {
            const bool last = (t == nt - 2);
            const char* a1 = cA + (unsigned)(t + 1) * kstepA;
            const char* a2 = last ? nA : cA + (unsigned)(t + 2) * kstepA; const char* b2 = last ? nB : cB + (unsigned)(t + 2) * kstep;
            const char* a3 = a2 + kstepA; const char* b3 = b2 + kstep;
            const unsigned s0 = last ? pN0 : pC0, s1 = last ? pN1 : pC1;
            PG8_LDB(B0, 0, 0); PG8_LDB(B1, 0, 1); PG8_SCHED; PG8_LDA(At, 0, 0); PG8_STAGE_A(PG8_SA(1, 1), a1 + hA, pC1);
            PG8_WAIT_V(8); PG8_WAIT_L(0); PG8_BAR; PG8_MMA(0, 0, At, B0); PG8_MMA(0, 1, At, B1); PG8_BAR; PG8_SCHED;
            PG8_LDA(At, 0, 1); PG8_STAGE_B(PG8_SB(0, 0), b2); PG8_STAGE_B(PG8_SB(0, 1), b2 + hstep); PG8_STAGE_A(PG8_SA(0, 0), a2, s0);
            PG8_WAIT_V(8); PG8_WAIT_L(0); PG8_BAR; PG8_MMA(1, 0, At, B0); PG8_MMA(1, 1, At, B1); PG8_BAR; PG8_SCHED;
            PG8_LDB(B0, 1, 0); PG8_LDB(B1, 1, 1); PG8_SCHED; PG8_LDA(At, 1, 0); PG8_STAGE_A(PG8_SA(0, 1), a2 + hA, s1);
            PG8_WAIT_V(8); PG8_WAIT_L(0); PG8_BAR; PG8_MMA(0, 0, At, B0); PG8_MMA(0, 1, At, B1); PG8_BAR; PG8_SCHED;
            PG8_LDA(At, 1, 1); PG8_STAGE_B(PG8_SB(1, 0), b3); PG8_STAGE_B(PG8_SB(1, 1), b3 + hstep); PG8_STAGE_A(PG8_SA(1, 0), a3, s0);
            PG8_WAIT_V(8); PG8_WAIT_L(0); PG8_BAR; PG8_MMA(1, 0, At, B0); PG8_MMA(1, 1, At, B1); PG8_BAR; PG8_SCHED;
        }
        if (wr == 0) PG8_BAR;
        E(acc, cur, wr, wc, fr, fq);
        if (!has_next) break;
#pragma unroll
        for (int a = 0; a < 2; ++a)
#pragma unroll
            for (int b = 0; b < 2; ++b)
#pragma unroll
                for (int m = 0; m < 4; ++m)
#pragma unroll
                    for (int n = 0; n < 2; ++n) acc[a][b][m][n] = zv;
        cur = nxt; cB = nB; cA = nA; ++ui;
        pC0 = pN0; pC1 = pN1;
        if (wr == 1) PG8_BAR;
    }
    PG8_WAIT_V(0);
    PG8_BAR;
#undef PG8_SA
#undef PG8_SB
#undef PG8_STAGE_A
#undef PG8_STAGE_B
#undef PG8_LDA
#undef PG8_LDB
#undef PG8_MMA
#undef PG8_WAIT_V
#undef PG8_WAIT_L
#undef PG8_BAR
#undef PG8_SCHED
#undef PG8_PACK
}

struct DenseOrder {
    static constexpr bool GATHER = false;
    int nM, nN, nwg, G, c; const char* Bt; int K;
    __device__ void init(int M, int N, int K_, const bf16_t* Bt_, int G_, int c_) { nM = M / BM; nN = N / BM; nwg = nM * nN; G = G_; c = c_; Bt = (const char*)Bt_; K = K_; }
    __device__ __forceinline__ bool next(int i, Unit& u) const {
        const long L = (long)i * G + c; if (L >= nwg) return false;
        int wgid = (int)L; { const int q = nwg / 8, r = nwg % 8, xcd = wgid % 8, off = wgid / 8; wgid = (xcd < r ? xcd * (q + 1) : r * (q + 1) + (xcd - r) * q) + off; }
        const int nig = 8 * nN, gid = wgid / nig, fm = gid * 8, gsz = (nM - fm) < 8 ? (nM - fm) : 8;
        u.pm = fm + ((wgid % nig) % gsz); u.pn = (wgid % nig) / gsz;
        u.arow0 = u.pm * BM; u.nrows = BM; u.e = 0; u.ui = i;
        u.bptr = Bt + (size_t)u.pn * BM * K * 2;
        return true;
    }
    __device__ __forceinline__ int arow(const Unit& u, int r) const { return u.arow0 + r; }
    __device__ __forceinline__ int lda(int K_) const { return K_; }
    __device__ __forceinline__ unsigned kstepA() const { return 128u; }
    __device__ __forceinline__ const char* abase(const Unit&, const char* A) const { return A; }
};
}

struct EpiH {
    static constexpr bool PERM = true;
    bf16_t* H;
    __device__ __forceinline__ void operator()(const f32x4 (&acc)[2][2][4][2], const pg8::Unit& u, int wr, int wc, int fr, int fq) const {
        const int row0 = u.arow0 + wr * 64 + fr, col0 = u.pn * 256 + wc * 32 + 8 * fq;
#pragma unroll
        for (int ai = 0; ai < 2; ++ai)
#pragma unroll
            for (int m = 0; m < 4; ++m) {
                bf16_t* rowp = H + (size_t)(row0 + ai * 128 + m * 16) * HLD + col0;
#pragma unroll
                for (int bj = 0; bj < 2; ++bj) {
                    const f32x4 v0 = acc[ai][bj][m][0], v1 = acc[ai][bj][m][1];
                    u32x4 w; w.x = pg8::cvt_pk_bf16(v0[0], v0[1]); w.y = pg8::cvt_pk_bf16(v0[2], v0[3]); w.z = pg8::cvt_pk_bf16(v1[0], v1[1]); w.w = pg8::cvt_pk_bf16(v1[2], v1[3]);
                    *(u32x4*)(rowp + bj * 128) = w;
                }
            }
    }
};
struct EpiRes {
    static constexpr bool PERM = false;
    const float* xin; bf16_t* out; int layer;
    __device__ __forceinline__ void operator()(const f32x4 (&acc)[2][2][4][2], const pg8::Unit& u, int wr, int wc, int fr, int fq) const {
        const int row0 = u.arow0 + wr * 64 + fr, col0 = u.pn * 256 + wc * 32 + 4 * fq;
#pragma unroll
        for (int ai = 0; ai < 2; ++ai)
#pragma unroll
            for (int m = 0; m < 4; ++m) {
                const size_t off = (size_t)(row0 + ai * 128 + m * 16) * DM + col0;
#pragma unroll
                for (int bj = 0; bj < 2; ++bj)
#pragma unroll
                    for (int n = 0; n < 2; ++n) {
                        f32x4 xv;
                        if (layer == 0) xv = *(const f32x4*)(xin + off + bj * 128 + n * 16);
                        else { const u32x2 xw = *(const u32x2*)(out + off + bj * 128 + n * 16); xv[0] = __uint_as_float(xw.x << 16); xv[1] = __uint_as_float(xw.x & 0xffff0000u); xv[2] = __uint_as_float(xw.y << 16); xv[3] = __uint_as_float(xw.y & 0xffff0000u); }
                        const f32x4 r = xv * ALPHA + acc[ai][bj][m][n];
                        u32x2 pw; pw.x = pk2(r[0], r[1]); pw.y = pk2(r[2], r[3]);
                        *(u32x2*)(out + off + bj * 128 + n * 16) = pw;
                    }
            }
    }
};

template <class RM>
__device__ __forceinline__ void transpose_item(const float* W, int K, int N, bf16_t* WT, RM rowmap, float* scr, int kb, int nb, int lane) {
    const int k0 = 64 * kb, n0 = 32 * nb;
    const int nn = n0 + (lane & 31);
    float tmp[32];
#pragma unroll
    for (int i = 0; i < 32; ++i) {
        const int kk = 2 * i + (lane >> 5);
        tmp[i] = nn < N ? W[(size_t)(k0 + kk) * N + nn] : 0.f;
    }
#pragma unroll
    for (int i = 0; i < 32; ++i) {
        const int kk = 2 * i + (lane >> 5);
        scr[kk * 33 + (lane & 31)] = tmp[i];
    }
    wave_sync();
    const int c = lane & 7;
#pragma unroll
    for (int j = 0; j < 4; ++j) {
        const int n = (lane >> 3) + 8 * j;
        const float* s = scr + (8 * c) * 33 + n;
        u32x4 o; o.x = pk2(s[0 * 33], s[1 * 33]); o.y = pk2(s[2 * 33], s[3 * 33]); o.z = pk2(s[4 * 33], s[5 * 33]); o.w = pk2(s[6 * 33], s[7 * 33]);
        const int dr = (n0 + n < N) ? rowmap(n0 + n) : -1;
        if (dr >= 0) *(u32x4*)(WT + (size_t)dr * K + k0 + 8 * c) = o;
    }
    wave_sync();
}

__device__ void phase_prologue(KA ka, int layer, float* smem) {
    PHASE_IDS
    const int lane = TID & 63, w = TID >> 6;
    float* scr = smem + w * 4096;
    const int gw = BID * NW + w, NGW = gridDim.x * NW;
    constexpr int I_IN = 16 * 89, I_OUT = 16 * 32, I_GU = 16 * 16, I_DN = 8 * 32;
    constexpr int I_LAYER = I_IN + I_OUT + 32 * I_GU + 16 * I_DN;
    for (int it = gw; it < I_LAYER; it += NGW) {
        int r = it;
        bf16_t* WT = PF(WT);
        if (r < I_IN) {
            transpose_item(PF(w_in) + (size_t)layer * DM * IC_SRC, DM, IC_SRC, WT + WT_IN,
                           [](int n) { return n < 1792 ? n : (n < 1816 ? 2816 + (n - 1792) : n - 24); }, scr, r / 89, r % 89, lane);
            continue;
        }
        r -= I_IN;
        if (r < I_OUT) {
            transpose_item(PF(w_out) + (size_t)layer * DM * DM, DM, DM, WT + WT_OUT, [](int n) { return n; }, scr, r / 32, r % 32, lane);
            continue;
        }
        r -= I_OUT;
        if (r < 32 * I_GU) {
            const int mat = r / I_GU, rr = r % I_GU, e = mat >> 1, isup = mat & 1;
            const float* W = (isup ? PF(w_up) : PF(w_gate)) + ((size_t)layer * 16 + e) * DM * 512;
            transpose_item(W, DM, 512, WT + WT_UP + (size_t)e * 1024 * 1024,
                           [isup](int n) { return (n >> 7) * 256 + isup * 128 + (n & 127); }, scr, rr / 16, rr % 16, lane);
            continue;
        }
        r -= 32 * I_GU;
        {
            const int e = r / I_DN, rr = r % I_DN;
            transpose_item(PF(w_down) + ((size_t)layer * 16 + e) * 512 * DM, 512, DM, WT + WT_DN + (size_t)e * 1024 * 512,
                           [](int n) { return n; }, scr, rr / 32, rr % 32, lane);
        }
    }
    for (int it = gw; it < 2 * 32 * 4; it += NGW) {
        const int which = it >> 7, rr = it & 127;
        transpose_item(PF(cmp_w1) + ((size_t)layer * 2 + which) * 2048 * 128, 2048, 128, PF(WT) + WT_C1 + (size_t)which * 256 * 2048, [](int n) { return n; }, scr, rr >> 2, rr & 3, lane);
    }
    for (int i = BID * NTHR + TID; i < 2 * 128 * 256; i += gridDim.x * NTHR) {
        const int which = i >> 15, q = i & 32767;
        const u32x4 z = __builtin_bit_cast(u32x4, zero4());
        *(u32x4*)(PF(WT) + WT_C1 + (size_t)which * 256 * 2048 + (size_t)128 * 2048 + (size_t)q * 8) = z;
    }
    for (int o = gw; o < 256; o += NGW) {
        const int which = o >> 7, cc = o & 127;
        const float* w1 = PF(cmp_w1) + ((size_t)layer * 2 + which) * 2048 * 128;
        const float* pos = PF(cmp_pos) + ((size_t)layer * 2 + which) * 2048;
        float a = 0.f;
        for (int k = lane; k < 2048; k += 64) a = fmaf(pos[k], w1[(size_t)k * 128 + cc], a);
        a = wave_sum(a);
        if (lane == 0) (PF(cbias) + layer * (256))[o] = a;
    }
    for (int i = BID * NTHR + TID; i < 4 * 128 * 128; i += gridDim.x * NTHR) {
        const int s = i & 127, t = (i >> 7) & 127;
        PF(WT)[WT_GM + i] = (s <= t) ? f2bf(PF(gm_w_s)[(size_t)layer * 4 * 128 * 128 + i]) : (bf16_t)0;
    }
    for (int i = BID * NTHR + TID; i < 20 * 1024; i += gridDim.x * NTHR) {
        const int o = i >> 10, cc = i & 1023;
        (PF(wrt) + layer * (20480))[i] = o < 4 ? PF(rg_w)[((size_t)layer * 1024 + cc) * 4 + o] : PF(re_w)[((size_t)layer * 1024 + cc) * 16 + (o - 4)];
    }
    for (int i = BID * NTHR + TID; i < 232 * 128; i += gridDim.x * NTHR) {
        const int q = i;
        const u32x4 z = __builtin_bit_cast(u32x4, zero4());
        *(u32x4*)(PF(WT) + WT_IN + (size_t)2840 * 1024 + (size_t)q * 8) = z;
    }
    if (layer == 0)
    for (int row = gw; row < NTOK; row += NGW) {
        const f32x4* xr = (const f32x4*)(PF(x) + (size_t)row * DM) + lane;
        u32x2* o = (u32x2*)(PF(XB) + (size_t)row * DM) + lane;
#pragma unroll
        for (int j = 0; j < 4; ++j) {
            const f32x4 v = xr[64 * j];
            u32x2 ww; ww.x = pk2(v[0], v[1]); ww.y = pk2(v[2], v[3]);
            o[64 * j] = ww;
        }
    }
}

template <class AF, class BF, class EF>
__device__ __forceinline__ void gemm128(int tid, int m0, int n0, int M, int N, int K, AF af, BF bf, EF ef, float* smem) {
    float* As = smem;
    float* Bs = smem + 16 * 132;
    const bool active = tid < 256;
    const int tx = tid & 15, ty = (tid >> 4) & 15;
    float acc[8][8];
#pragma unroll
    for (int i = 0; i < 8; i++)
#pragma unroll
        for (int j = 0; j < 8; j++) acc[i][j] = 0.f;
#pragma unroll 1
    for (int k0 = 0; k0 < K; k0 += 16) {
        if (active) {
#pragma unroll
            for (int i = 0; i < 8; i++) {
                int e = tid + i * 256;
                int r = e >> 4, kk = e & 15;
                float v = 0.f;
                if (m0 + r < M) v = af(m0 + r, k0 + kk);
                As[kk * 132 + r] = v;
            }
#pragma unroll
            for (int i = 0; i < 8; i++) {
                int e = tid + i * 256;
                int kk = e >> 7, c = e & 127;
                float v = 0.f;
                if (n0 + c < N) v = bf(k0 + kk, n0 + c);
                Bs[kk * 132 + c] = v;
            }
        }
        __syncthreads();
        if (active) {
#pragma unroll 2
            for (int kk = 0; kk < 16; kk++) {
                asm volatile("" ::: "memory");
                float4 a0 = *(const float4*)&As[kk * 132 + ty * 8];
                float4 a1 = *(const float4*)&As[kk * 132 + ty * 8 + 4];
                float4 b0 = *(const float4*)&Bs[kk * 132 + tx * 8];
                float4 b1 = *(const float4*)&Bs[kk * 132 + tx * 8 + 4];
                float a[8] = {a0.x, a0.y, a0.z, a0.w, a1.x, a1.y, a1.z, a1.w};
                float b[8] = {b0.x, b0.y, b0.z, b0.w, b1.x, b1.y, b1.z, b1.w};
#pragma unroll
                for (int i = 0; i < 8; i++)
#pragma unroll
                    for (int j = 0; j < 8; j++) acc[i][j] = fmaf(a[i], b[j], acc[i][j]);
            }
        }
        __syncthreads();
    }
    if (active) {
#pragma unroll
        for (int i = 0; i < 8; i++)
#pragma unroll
            for (int j = 0; j < 8; j++) {
                int m = m0 + ty * 8 + i, n = n0 + tx * 8 + j;
                if (m < M && n < N) ef(m, n, acc[i][j]);
            }
    }
}

__device__ __forceinline__ void phase_inproj(KA ka, int layer, LAS unsigned char* lds) {
    pg8::DenseOrder S; S.init(NTOK, HLD, DM, PF(WT) + WT_IN, gridDim.x, opaque_bid());
    EpiH E{PF(H)};
    pg8::gemm_phase<EpiH, pg8::DenseOrder>(lds, (const char*)PF(XB), DM, S, E, ka.wv);
}
__device__ __forceinline__ void phase_outproj(KA ka, int layer, const float* xin, float* x1, LAS unsigned char* lds) {
    pg8::DenseOrder S; S.init(NTOK, DM, DM, PF(WT) + WT_OUT, gridDim.x, opaque_bid());
    EpiRes E{xin, PF(XB), layer}; (void)x1;
    pg8::gemm_phase<EpiRes, pg8::DenseOrder>(lds, (const char*)PF(Y), DM, S, E, ka.wv);
}

__device__ void phase_ln1_route(KA ka, int layer, float* x1, float* smem, bool dry) {
    PHASE_IDS
    bf16_t* xb = PF(XB);
    (void)x1;
    const int lane = TID & 63, w = TID >> 6;
    const float* g = PF(ln1_g) + layer * 1024;
    const float* bb = PF(ln1_b) + layer * 1024;
    const float* wg = PF(rg_w) + (size_t)layer * 1024 * 4;
    const float* we = PF(re_w) + (size_t)layer * 1024 * 16;
    const float* bg = PF(rg_b) + layer * 4;
    const float* be = PF(re_b) + layer * 16;
    int* cnt = (int*)(PF(ctl) + CW_CNT) + layer * 16 * 64 + (dry ? 2048 : 0);
    int* lcnt = (int*)(smem + 20 * 1024);
    int* rinfo = lcnt + 64;
    float* rwt = (float*)(rinfo + 4 * 128);
    if (TID < 32) lcnt[TID] = 0;
    float* WR = smem;
    __syncthreads();
    for (int idx = TID; idx < 20 * 256; idx += NTHR) *(f32x4*)(WR + 4 * idx) = *(const f32x4*)((PF(wrt) + layer * (20480)) + 4 * idx);
    __syncthreads();
    int nloc = 0;
    u32x2 xwn[4];
    if (BID * NW + w < NTOK) {
#pragma unroll
        for (int j = 0; j < 4; ++j) xwn[j] = *(const u32x2*)(xb + (size_t)(BID * NW + w) * DM + 256 * j + 4 * lane);
    }
    for (int row = BID * NW + w; row < NTOK; row += gridDim.x * NW) {
        f32x4 v[4];
        float s = 0.f;
        u32x2 xwc[4];
#pragma unroll
        for (int j = 0; j < 4; ++j) xwc[j] = xwn[j];
        if (row + (int)gridDim.x * NW < NTOK) {
#pragma unroll
            for (int j = 0; j < 4; ++j) xwn[j] = *(const u32x2*)(xb + (size_t)(row + gridDim.x * NW) * DM + 256 * j + 4 * lane);
        }
#pragma unroll
        for (int j = 0; j < 4; ++j) {
            const u32x2 xw = xwc[j];
            v[j][0] = __uint_as_float(xw.x << 16); v[j][1] = __uint_as_float(xw.x & 0xffff0000u); v[j][2] = __uint_as_float(xw.y << 16); v[j][3] = __uint_as_float(xw.y & 0xffff0000u);
            s += (v[j][0] + v[j][1]) + (v[j][2] + v[j][3]);
        }
        const float mu = wave_sum(s) * (1.f / 1024.f);
        float q = 0.f;
#pragma unroll
        for (int j = 0; j < 4; ++j) { v[j] = v[j] - mu; q += (v[j][0] * v[j][0] + v[j][1] * v[j][1]) + (v[j][2] * v[j][2] + v[j][3] * v[j][3]); }
        const float rstd = rsqrtf(wave_sum(q) * (1.f / 1024.f) + 1e-5f);
#pragma unroll
        for (int j = 0; j < 4; ++j) {
            const int c = 256 * j + 4 * lane;
            v[j] = v[j] * rstd * *(const f32x4*)(g + c) + *(const f32x4*)(bb + c);
            u32x2 pw; pw.x = pk2(v[j][0], v[j][1]); pw.y = pk2(v[j][2], v[j][3]);
            *(u32x2*)(xb + (size_t)row * DM + c) = pw;
        }
        float lg[4], le[16];
#pragma unroll
        for (int o = 0; o < 20; ++o) {
            asm volatile("" ::: "memory");
            float a = 0.f;
#pragma unroll
            for (int j = 0; j < 4; ++j) {
                const f32x4 w4 = *(const f32x4*)(WR + o * 1024 + 256 * j + 4 * lane);
                a += (v[j][0] * w4[0] + v[j][1] * w4[1]) + (v[j][2] * w4[2] + v[j][3] * w4[3]);
            }
            a = wave_sum(a);
            if (o < 4) lg[o] = a + bg[o]; else le[o - 4] = a + be[o - 4];
        }
        float gm = fmaxf(fmaxf(lg[0], lg[1]), fmaxf(lg[2], lg[3]));
        float ge[4], gs = 0.f;
#pragma unroll
        for (int c = 0; c < 4; c++) { ge[c] = __expf(lg[c] - gm); gs += ge[c]; }
        int gi = 0; float gbest = ge[0];
#pragma unroll
        for (int c = 1; c < 4; c++) if (ge[c] > gbest) { gbest = ge[c]; gi = c; }
        float gval = gbest / gs;
        float ls[4];
#pragma unroll
        for (int e = 0; e < 4; e++) ls[e] = gi == 0 ? le[e] : gi == 1 ? le[4 + e] : gi == 2 ? le[8 + e] : le[12 + e];
        float em = fmaxf(fmaxf(ls[0], ls[1]), fmaxf(ls[2], ls[3]));
        float pe[4];
#pragma unroll
        for (int e = 0; e < 4; e++) pe[e] = __expf(ls[e] - em);
        int i1 = 0; float b1 = pe[0];
#pragma unroll
        for (int e = 1; e < 4; e++) if (pe[e] > b1) { b1 = pe[e]; i1 = e; }
        int i2 = -1; float b2 = -1.f;
#pragma unroll
        for (int e = 0; e < 4; e++) if (e != i1 && pe[e] > b2) { b2 = pe[e]; i2 = e; }
        float w1 = gval * b1 / (b1 + b2), w2 = gval * b2 / (b1 + b2);
        if (lane == 0) {
            const int e1 = gi * 4 + i1, e2 = gi * 4 + i2;
            const int lr = nloc * NW + w;
            rinfo[lr * 4 + 0] = e1; rinfo[lr * 4 + 1] = atomicAdd(&lcnt[e1], 1);
            rinfo[lr * 4 + 2] = e2; rinfo[lr * 4 + 3] = atomicAdd(&lcnt[e2], 1);
            rwt[lr * 2 + 0] = w1; rwt[lr * 2 + 1] = w2;
        }
        ++nloc;
    }
    __syncthreads();
    if (TID < 16) lcnt[16 + TID] = lcnt[TID] > 0 ? atomicAdd(&cnt[TID * 64], lcnt[TID]) : 0;
    __syncthreads();
    {
        const int nrows_blk = (NTOK - BID * NW + (int)gridDim.x * NW - 1) / ((int)gridDim.x * NW) * NW;
        for (int lr = TID; lr < nrows_blk; lr += NTHR) {
            const int row = BID * NW + (lr % NW) + (lr / NW) * (int)gridDim.x * NW;
            if (row < NTOK) {
                const int e1 = rinfo[lr * 4 + 0], p1 = lcnt[16 + e1] + rinfo[lr * 4 + 1];
                const int e2 = rinfo[lr * 4 + 2], p2 = lcnt[16 + e2] + rinfo[lr * 4 + 3];
                (PF(list_tok) + layer * ((size_t)16 * NTOK))[e1 * NTOK + p1] = row; (PF(list_w) + layer * ((size_t)16 * NTOK))[e1 * NTOK + p1] = rwt[lr * 2 + 0];
                (PF(list_tok) + layer * ((size_t)16 * NTOK))[e2 * NTOK + p2] = row; (PF(list_w) + layer * ((size_t)16 * NTOK))[e2 * NTOK + p2] = rwt[lr * 2 + 1];
                (PF(tok_slot) + layer * ((size_t)NTOK * 2))[row * 2 + 0] = e1 * NTOK + p1; (PF(tok_slot) + layer * ((size_t)NTOK * 2))[row * 2 + 1] = e2 * NTOK + p2;
            }
        }
    }
    __syncthreads();
}


template <bool GATHER_>
struct MoeOrder {
    static constexpr bool GATHER = GATHER_;
    const LAS int* tab; const LAS int* rowtab;
    const char* Bt; unsigned estride; int K, G, c;
    __device__ __forceinline__ bool next(int i, pg8::Unit& u) const {
        const int nwg = __builtin_amdgcn_readfirstlane(tab[48]) * 4;
        const int L = i * G + c; if (L >= nwg) return false;
        int wgid = L; { const int q = nwg / 8, r = nwg % 8, xcd = wgid % 8, off = wgid / 8; wgid = (xcd < r ? xcd * (q + 1) : r * (q + 1) + (xcd - r) * q) + off; }
        const int mg = wgid >> 2, nt = wgid & 3;
        int e = 0;
#pragma unroll
        for (int k = 1; k < 16; ++k) e = (__builtin_amdgcn_readfirstlane(tab[32 + k]) <= mg) ? k : e;
        const int mt = mg - __builtin_amdgcn_readfirstlane(tab[32 + e]);
        const int rem = __builtin_amdgcn_readfirstlane(tab[e]) - mt * 256;
        u.e = e; u.pm = mt; u.pn = nt; u.ui = i; u.nrows = rem < 256 ? rem : 256; u.arow0 = __builtin_amdgcn_readfirstlane(tab[16 + e]) + mt * 256;
        u.bptr = Bt + (size_t)e * estride + (size_t)nt * 256 * K * 2;
        return true;
    }
    __device__ __forceinline__ int arow(const pg8::Unit& u, int r) const { return GATHER_ ? rowtab[u.ui * 256 + r] : u.arow0 + r; }
    __device__ __forceinline__ int lda(int K_) const { return K_; }
    __device__ __forceinline__ unsigned kstepA() const { return 128u; }
    __device__ __forceinline__ const char* abase(const pg8::Unit&, const char* A) const { return A; }
};
__device__ __forceinline__ void moe_tables(KA ka, int layer, LAS unsigned char* lds, bool want_rows, int G, int c) {
    LAS int* tab = (LAS int*)(lds + LDS_MISC + 256);
    LAS int* rowtab = (LAS int*)(lds + LDS_MISC + 1024);
    const int tid = opaque_tid(ka.wv);
    const int* cnt = (const int*)(PF(ctl) + CW_CNT) + layer * 16 * 64;
    if (tid < 16) tab[tid] = __hip_atomic_load(&cnt[tid * 64], __ATOMIC_RELAXED, __HIP_MEMORY_SCOPE_AGENT);
    __syncthreads();
    if (tid == 0) {
        int b = 0, m = 0;
        for (int e = 0; e < 16; ++e) { tab[16 + e] = b; tab[32 + e] = m; b += tab[e]; m += (tab[e] + 255) >> 8; }
        tab[48] = m;
    }
    __syncthreads();
    if (want_rows) {
        MoeOrder<true> S{tab, rowtab, nullptr, 0u, 1024, G, c};
        const int* lt = (PF(list_tok) + layer * ((size_t)16 * NTOK));
        for (int i = 0; i < 4; ++i) {
            pg8::Unit u;
            if (!S.next(i, u)) break;
            if (tid < 256) { const int r = tid < u.nrows ? tid : u.nrows - 1; rowtab[i * 256 + tid] = lt[u.e * NTOK + u.pm * 256 + r]; }
        }
        asm volatile("s_waitcnt vmcnt(0) lgkmcnt(0)" ::: "memory");
        __syncthreads();
    }
}
struct EpiUp {
    static constexpr bool PERM = true;
    bf16_t* hidden;
    __device__ __forceinline__ void operator()(const f32x4 (&acc)[2][2][4][2], const pg8::Unit& u, int wr, int wc, int fr, int fq) const {
#pragma unroll
        for (int ai = 0; ai < 2; ++ai)
#pragma unroll
            for (int m = 0; m < 4; ++m) {
                const int r = ai * 128 + wr * 64 + m * 16 + fr;
                if (r < u.nrows) {
                    bf16_t* rowp = hidden + (size_t)(u.arow0 + r) * 512 + u.pn * 128 + wc * 32 + 8 * fq;
                    float h[8];
#pragma unroll
                    for (int n = 0; n < 2; ++n)
#pragma unroll
                        for (int j = 0; j < 4; ++j) { const float g = acc[ai][0][m][n][j], uu = acc[ai][1][m][n][j]; h[n * 4 + j] = g * sigmoidf_(g) * uu; }
                    u32x4 w; w.x = pg8::cvt_pk_bf16(h[0], h[1]); w.y = pg8::cvt_pk_bf16(h[2], h[3]); w.z = pg8::cvt_pk_bf16(h[4], h[5]); w.w = pg8::cvt_pk_bf16(h[6], h[7]);
                    *(u32x4*)rowp = w;
                }
            }
    }
};
struct EpiDown {
    static constexpr bool PERM = true;
    bf16_t* Y2; const float* lw;
    __device__ __forceinline__ void operator()(const f32x4 (&acc)[2][2][4][2], const pg8::Unit& u, int wr, int wc, int fr, int fq) const {
#pragma unroll
        for (int ai = 0; ai < 2; ++ai)
#pragma unroll
            for (int m = 0; m < 4; ++m) {
                const int r = ai * 128 + wr * 64 + m * 16 + fr;
                if (r < u.nrows) {
                    const float wgt = lw[u.e * NTOK + u.pm * 256 + r];
                    bf16_t* rowp = Y2 + (size_t)(u.arow0 + r) * DM + u.pn * 256 + wc * 32 + 8 * fq;
#pragma unroll
                    for (int bj = 0; bj < 2; ++bj) {
                        const f32x4 v0 = acc[ai][bj][m][0] * wgt, v1 = acc[ai][bj][m][1] * wgt;
                        u32x4 w; w.x = pg8::cvt_pk_bf16(v0[0], v0[1]); w.y = pg8::cvt_pk_bf16(v0[2], v0[3]); w.z = pg8::cvt_pk_bf16(v1[0], v1[1]); w.w = pg8::cvt_pk_bf16(v1[2], v1[3]);
                        *(u32x4*)(rowp + bj * 128) = w;
                    }
                }
            }
    }
};
__device__ __forceinline__ void phase_moe_up(KA ka, int layer, LAS unsigned char* lds) {
    moe_tables(ka, layer, lds, true, gridDim.x, opaque_bid());
    MoeOrder<true> S{(const LAS int*)(lds + LDS_MISC + 256), (const LAS int*)(lds + LDS_MISC + 1024),
                     (const char*)(PF(WT) + WT_UP), (unsigned)(1024u * 1024u * 2u), 1024, (int)gridDim.x, opaque_bid()};
    EpiUp E{PF(Y)};
    pg8::gemm_phase<EpiUp, MoeOrder<true>>(lds, (const char*)PF(XB), 1024, S, E, ka.wv);
}
__device__ __forceinline__ void phase_moe_down(KA ka, int layer, LAS unsigned char* lds) {
    moe_tables(ka, layer, lds, false, gridDim.x, opaque_bid());
    MoeOrder<false> S{(const LAS int*)(lds + LDS_MISC + 256), (const LAS int*)(lds + LDS_MISC + 1024),
                      (const char*)(PF(WT) + WT_DN), (unsigned)(1024u * 512u * 2u), 512, (int)gridDim.x, opaque_bid()};
    EpiDown E{PF(H), (PF(list_w) + layer * ((size_t)16 * NTOK))};
    pg8::gemm_phase<EpiDown, MoeOrder<false>>(lds, (const char*)PF(Y), 512, S, E, ka.wv);
}

__device__ void phase_ln2(KA ka, int layer, const float* x1, float* xo) {
    PHASE_IDS
    bf16_t* xb = PF(XB);
    const bf16_t* Y2 = PF(H);
    const int lane = TID & 63, w = TID >> 6;
    const float* g = PF(ln2_g) + layer * 1024;
    const float* bb = PF(ln2_b) + layer * 1024;
    const int* cnt = (const int*)(PF(ctl) + CW_CNT) + layer * 16 * 64;
    int mybase = 0;
    {
        int cv = lane < 16 ? __hip_atomic_load(&cnt[(lane & 15) * 64], __ATOMIC_RELAXED, __HIP_MEMORY_SCOPE_AGENT) : 0;
        int incl = cv;
#pragma unroll
        for (int o = 1; o < 16; o <<= 1) { int t = __shfl_up(incl, o); if ((lane & 15) >= o) incl += t; }
        mybase = incl - cv;
    }
    const int* tsl = PF(tok_slot) + layer * ((size_t)NTOK * 2);
    const int rstride = gridDim.x * NW;
    int row = BID * NW + w;
    int tsa1 = 0, tsb1 = 0;
    u32x2 xw0[4], ya0[4], yb0[4];
#define LN2_LOAD(ROW, TSA, TSB, XW, YA, YB) do { \
        const int s1_ = __shfl(mybase, (TSA) >> 14) + ((TSA) & (NTOK - 1)), s2_ = __shfl(mybase, (TSB) >> 14) + ((TSB) & (NTOK - 1)); \
        _Pragma("unroll") for (int j = 0; j < 4; ++j) { const int c = 256 * j + 4 * lane; \
            XW[j] = *(const u32x2*)(xb + (size_t)(ROW) * DM + c);        \
              \
            YA[j] = __builtin_nontemporal_load((const u32x2*)(Y2 + (size_t)s1_ * DM + c)); YB[j] = __builtin_nontemporal_load((const u32x2*)(Y2 + (size_t)s2_ * DM + c)); } } while (0)
    if (row < NTOK) { const int tsa0 = tsl[row * 2 + 0], tsb0 = tsl[row * 2 + 1]; LN2_LOAD(row, tsa0, tsb0, xw0, ya0, yb0); }
    if (row + rstride < NTOK) { tsa1 = tsl[(row + rstride) * 2 + 0]; tsb1 = tsl[(row + rstride) * 2 + 1]; }
    for (; row < NTOK; row += rstride) {
        u32x2 xw1[4], ya1[4], yb1[4];
        const int nrow = row + rstride;
        if (nrow < NTOK) LN2_LOAD(nrow, tsa1, tsb1, xw1, ya1, yb1);
        int tsa2 = 0, tsb2 = 0;
        if (nrow + rstride < NTOK) { tsa2 = tsl[(nrow + rstride) * 2 + 0]; tsb2 = tsl[(nrow + rstride) * 2 + 1]; }
        f32x4 v[4];
        float s = 0.f;
#pragma unroll
        for (int j = 0; j < 4; ++j) {
            const u32x2 xw = xw0[j], ya = ya0[j], yb = yb0[j];
            f32x4 xv; xv[0] = __uint_as_float(xw.x << 16); xv[1] = __uint_as_float(xw.x & 0xffff0000u); xv[2] = __uint_as_float(xw.y << 16); xv[3] = __uint_as_float(xw.y & 0xffff0000u);
            f32x4 t;
            t[0] = __uint_as_float(ya.x << 16) + __uint_as_float(yb.x << 16); t[1] = __uint_as_float(ya.x & 0xffff0000u) + __uint_as_float(yb.x & 0xffff0000u);
            t[2] = __uint_as_float(ya.y << 16) + __uint_as_float(yb.y << 16); t[3] = __uint_as_float(ya.y & 0xffff0000u) + __uint_as_float(yb.y & 0xffff0000u);
            v[j] = xv * ALPHA + t;
            s += (v[j][0] + v[j][1]) + (v[j][2] + v[j][3]);
        }
        const float mu = wave_sum(s) * (1.f / 1024.f);
        float q = 0.f;
#pragma unroll
        for (int j = 0; j < 4; ++j) { v[j] = v[j] - mu; q += (v[j][0] * v[j][0] + v[j][1] * v[j][1]) + (v[j][2] * v[j][2] + v[j][3] * v[j][3]); }
        const float rstd = rsqrtf(wave_sum(q) * (1.f / 1024.f) + 1e-5f);
#pragma unroll
        for (int j = 0; j < 4; ++j) {
            const int c = 256 * j + 4 * lane;
            const f32x4 o = v[j] * rstd * *(const f32x4*)(g + c) + *(const f32x4*)(bb + c);
            if (layer == 1) *(f32x4*)(xo + (size_t)row * DM + c) = o;
            u32x2 pw; pw.x = pk2(o[0], o[1]); pw.y = pk2(o[2], o[3]);
            *(u32x2*)(xb + (size_t)row * DM + c) = pw;
        }
#pragma unroll
        for (int j = 0; j < 4; ++j) { xw0[j] = xw1[j]; ya0[j] = ya1[j]; yb0[j] = yb1[j]; }
        tsa1 = tsa2; tsb1 = tsb2;
    }
#undef LN2_LOAD
}

#define MFMA16(a, b, c) __builtin_amdgcn_mfma_f32_16x16x32_bf16((a), (b), (c), 0, 0, 0)
constexpr int NSA_KT = 0, NSA_VT = 16384, NSA_IMP = 32768, NSA_FIN = 65536, NSA_SEL = LDS_MISC + 8192;

__device__ __forceinline__ int tile_off(int r, int c) { return r * 128 + ((c ^ ((r >> 1) & 7)) << 4); }

__device__ __forceinline__ unsigned cvtpk(float lo, float hi) { return pk2(lo, hi); }
struct SelMask { unsigned a, b, c, d; };
__device__ __forceinline__ unsigned selbit(unsigned a, unsigned b, unsigned c, unsigned d, int j) {
    const int k = j >> 5;
    const unsigned lo = (k & 1) ? b : a, hi = (k & 1) ? d : c;
    const unsigned r = (k & 2) ? hi : lo;
    return (r >> (j & 31)) & 1u;
}

struct NsaRT {
    bf16x8 q[2];
    f32x4 o[4];
    float m, l;
};

template <int MODE, int NST>
__device__ __forceinline__ void nsa_loop(LAS unsigned char* lds, int tid, int lane, int w, int t0w, int jb, int je,
                                         const char* ksrc, size_t kstride, size_t ktile, const char* vsrc, size_t vstride, size_t vtile,
                                         NsaRT (&R)[2], const SelMask selm0, const SelMask selm1, float (&carry)[2], float* impw) {
    const int g = lane >> 4, qr = lane & 15;
    int tid2 = tid; asm volatile("" : "+v"(tid2));
    const int sr = tid2 >> 3, sc = (tid2 & 7) ^ ((sr >> 1) & 7);
    const char* kp = ksrc + (size_t)sr * kstride + sc * 16;
    const char* vp = vsrc + (size_t)sr * vstride + sc * 16;
    const unsigned ldsw = (unsigned)w * 1024u;
    const int fxq = (qr >> 1) & 7;
    const int ka0 = qr * 128 + ((g ^ fxq) << 4), ka1 = qr * 128 + (((4 + g) ^ fxq) << 4);
    const int vb = qr * 128 + (g & 1) * 8, vc = (g >> 1) ^ fxq;
    (void)vb; (void)vc;
    if (jb > je) return;
    constexpr bool PIPE = false && (MODE >= 2);
    constexpr int D = PIPE ? NST - 2 : NST - 1;
#define NSA_ISSUE(jj, st) do { const int jc_ = (jj) < je ? (jj) : je; \
        __builtin_amdgcn_global_load_lds((const unsigned*)(kp + (size_t)jc_ * ktile), (LAS unsigned*)(lds + (st) * 16384 + ldsw), 16, 0, 0); \
        if (MODE != 0) __builtin_amdgcn_global_load_lds((const unsigned*)(vp + (size_t)jc_ * vtile), (LAS unsigned*)(lds + (st) * 16384 + 8192 + ldsw), 16, 0, 0); } while (0)
#define NSA_WAIT_TILE() do { if (NST == 2) asm volatile("s_waitcnt vmcnt(0) lgkmcnt(0)" ::: "memory"); else if (PIPE) asm volatile("s_waitcnt vmcnt(2) lgkmcnt(0)" ::: "memory"); else asm volatile("s_waitcnt vmcnt(4) lgkmcnt(0)" ::: "memory"); } while (0)
#define NSA_PV(PF_, VT_) do { _Pragma("unroll") for (int ks = 0; ks < 2; ++ks) _Pragma("unroll") for (int dt = 0; dt < 4; ++dt) { \
          \
        const bf16x8 vf = *(const LAS bf16x8*)((VT_) + (ks ? ka1 : ka0) + dt * 2048); \
        R[0].o[dt] = MFMA16(vf, PF_[0][ks], R[0].o[dt]); R[1].o[dt] = MFMA16(vf, PF_[1][ks], R[1].o[dt]); } } while (0)
    constexpr int TPB = (NST == 4 && !PIPE) ? 2 : 1;
    if (TPB == 2) { NSA_ISSUE(jb, 0); NSA_ISSUE(jb + 1, 1); asm volatile("s_waitcnt vmcnt(0) lgkmcnt(0)" ::: "memory"); }
    else {
#pragma unroll
        for (int d = 0; d < D; ++d) NSA_ISSUE(jb + d, d);
        NSA_WAIT_TILE();
    }
    __builtin_amdgcn_s_barrier();
    bf16x8 pfp[2][2];
    bool havep = false;
    if (PIPE && w >= 4) __builtin_amdgcn_s_barrier();
    for (int jp = jb; jp <= je; jp += TPB) {
      if (TPB == 2) { NSA_ISSUE(jp + 2, (jp - jb + 2) & (NST - 1)); NSA_ISSUE(jp + 3, (jp - jb + 3) & (NST - 1)); }
      else NSA_ISSUE(jp + D, (jp - jb + D) & (NST - 1));
#pragma unroll 1
      for (int j = jp; j < jp + TPB; ++j) {
        if (j > je) break;
        const int cur = (j - jb) & (NST - 1);
        const LAS unsigned char* kt = lds + cur * 16384;
        const LAS unsigned char* vt = lds + cur * 16384 + 8192;
        bool anyact;
        {
            bool a = false;
#pragma unroll
            for (int rt = 0; rt < 2; ++rt) {
                const int tk = t0w + 4 * rt + (qr >> 2);
                if (MODE <= 1) { const int nv = tk >= 31 ? ((tk - 31) >> 4) + 1 : 0; a = a || (nv > 64 * j); }
                else if (MODE == 2) a = a || ((rt == 0 ? selbit(selm0.a, selm0.b, selm0.c, selm0.d, j) : selbit(selm1.a, selm1.b, selm1.c, selm1.d, j)) != 0u);
                else a = a || ((64 * j <= tk) && (64 * j + 63 > tk - 512));
            }
            anyact = __any(a);
        }
        if (anyact) {
            f32x4 s[2][4];
#pragma unroll
            for (int t = 0; t < 4; ++t) {
                const bf16x8 k0 = *(const LAS bf16x8*)(kt + ka0 + t * 2048), k1 = *(const LAS bf16x8*)(kt + ka1 + t * 2048);
#pragma unroll
                for (int rt = 0; rt < 2; ++rt) {
                    s[rt][t] = (f32x4){0.f, 0.f, 0.f, 0.f};
                    s[rt][t] = MFMA16(k0, R[rt].q[0], s[rt][t]);
                    s[rt][t] = MFMA16(k1, R[rt].q[1], s[rt][t]);
                }
            }
            if (PIPE && havep) NSA_PV(pfp, lds + ((j - 1 - jb) & (NST - 1)) * 16384 + 8192);
            if (PIPE) { NSA_WAIT_TILE(); __builtin_amdgcn_s_barrier(); }
            const int kb = 64 * j + 4 * g;
            bf16x8 pf_local[2][2];
            bf16x8 (&pf)[2][2] = PIPE ? pfp : pf_local;
            if (MODE == 1) {
#pragma unroll
                for (int rt = 0; rt < 2; ++rt) {
                    const int tk = t0w + 4 * rt + (qr >> 2);
                    const int nv = tk >= 31 ? ((tk - 31) >> 4) + 1 : 0;
                    const float mL = R[rt].m * 1.44269504f, invl = R[rt].l > 0.f ? 1.f / R[rt].l : 0.f;
                    float p[4][4];
#pragma unroll
                    for (int t = 0; t < 4; ++t)
#pragma unroll
                        for (int i = 0; i < 4; ++i) { const int key = kb + 16 * t + i; p[t][i] = (key < nv) ? __builtin_amdgcn_exp2f(fmaf(s[rt][t][i], 1.44269504f, -mL)) * invl : 0.f; }
#pragma unroll
                    for (int t = 0; t < 4; ++t) {
                        const float own = (p[t][0] + p[t][1]) + (p[t][2] + p[t][3]);
                        const float x3 = p[t][3];
                        const float up_cur = __shfl(x3, (lane + 48) & 63);
                        const float up_prev = __shfl(carry[rt], (lane + 48) & 63);
                        float v = own + (g >= 1 ? up_cur : up_prev);
                        v += __shfl_xor(v, 1);
                        v += __shfl_xor(v, 2);
                        carry[rt] = x3;
                        if ((qr & 3) == 0) impw[(4 * rt + (qr >> 2)) * 128 + 16 * j + 4 * t + g] = v;
                    }
#pragma unroll
                    for (int ks = 0; ks < 2; ++ks) {
                        u32x4 pu; pu.x = cvtpk(p[2 * ks][0], p[2 * ks][1]); pu.y = cvtpk(p[2 * ks][2], p[2 * ks][3]); pu.z = cvtpk(p[2 * ks + 1][0], p[2 * ks + 1][1]); pu.w = cvtpk(p[2 * ks + 1][2], p[2 * ks + 1][3]);
                        pf[rt][ks] = __builtin_bit_cast(bf16x8, pu);
                    }
                }
            } else {
                int lim_hi[2], lim_lo[2];
                bool none[2], part[2];
#pragma unroll
                for (int rt = 0; rt < 2; ++rt) {
                    const int tk = t0w + 4 * rt + (qr >> 2);
                    if (MODE == 0) { const int nv = tk >= 31 ? ((tk - 31) >> 4) + 1 : 0; lim_hi[rt] = nv - 1; lim_lo[rt] = -1; }
                    else if (MODE == 2) { lim_hi[rt] = ((rt == 0 ? selbit(selm0.a, selm0.b, selm0.c, selm0.d, j) : selbit(selm1.a, selm1.b, selm1.c, selm1.d, j)) != 0u) ? tk : -1; lim_lo[rt] = -1; }
                    else { lim_hi[rt] = tk; lim_lo[rt] = tk - 512; }
                    const bool full = (64 * j + 63 <= lim_hi[rt]) && (64 * j > lim_lo[rt]);
                    none[rt] = (64 * j > lim_hi[rt]) || (64 * j + 63 <= lim_lo[rt]);
                    part[rt] = !full && !none[rt];
                }
                float lmx[2];
                if (__any(part[0] || part[1])) {
#pragma unroll
                    for (int rt = 0; rt < 2; ++rt) {
                        float mx = NEG_INF;
#pragma unroll
                        for (int t = 0; t < 4; ++t)
#pragma unroll
                            for (int i = 0; i < 4; ++i) {
                                const int key = kb + 16 * t + i;
                                const bool ok = (key <= lim_hi[rt]) && (key > lim_lo[rt]);
                                s[rt][t][i] = ok ? s[rt][t][i] : NEG_INF;
                                mx = fmaxf(mx, s[rt][t][i]);
                            }
                        lmx[rt] = mx;
                        none[rt] = false;
                    }
                } else {
#pragma unroll
                    for (int rt = 0; rt < 2; ++rt) {
                        float mx = NEG_INF;
#pragma unroll
                        for (int t = 0; t < 4; ++t)
#pragma unroll
                            for (int i = 0; i < 4; ++i) mx = fmaxf(mx, s[rt][t][i]);
                        lmx[rt] = none[rt] ? NEG_INF : mx;
                    }
                }
                if (__any((lmx[0] > R[0].m + 6.f) || (lmx[1] > R[1].m + 6.f))) {
#pragma unroll
                    for (int rt = 0; rt < 2; ++rt) {
                        float mx = lmx[rt];
                        mx = fmaxf(mx, __shfl_xor(mx, 16));
                        mx = fmaxf(mx, __shfl_xor(mx, 32));
                        const float mn = fmaxf(R[rt].m, mx);
                        const float alpha = __expf(R[rt].m - mn);
                        R[rt].l *= alpha; R[rt].m = mn;
                        if (MODE != 0) {
#pragma unroll
                            for (int dt = 0; dt < 4; ++dt) R[rt].o[dt] = R[rt].o[dt] * alpha;
                        }
                    }
                }
#pragma unroll
                for (int rt = 0; rt < 2; ++rt) {
                    const float negmL = none[rt] ? -1e30f : -fmaxf(R[rt].m, -1e4f) * 1.44269504f;
                    float p[4][4];
                    float rs = 0.f;
#pragma unroll
                    for (int t = 0; t < 4; ++t)
#pragma unroll
                        for (int i = 0; i < 4; ++i) { p[t][i] = __builtin_amdgcn_exp2f(fmaf(s[rt][t][i], 1.44269504f, negmL)); rs += p[t][i]; }
                    R[rt].l += rs;
                    if (MODE != 0) {
#pragma unroll
                        for (int ks = 0; ks < 2; ++ks) {
                            u32x4 pu; pu.x = cvtpk(p[2 * ks][0], p[2 * ks][1]); pu.y = cvtpk(p[2 * ks][2], p[2 * ks][3]); pu.z = cvtpk(p[2 * ks + 1][0], p[2 * ks + 1][1]); pu.w = cvtpk(p[2 * ks + 1][2], p[2 * ks + 1][3]);
                            pf[rt][ks] = __builtin_bit_cast(bf16x8, pu);
                        }
                    }
                }
            }
            if (MODE != 0 && !PIPE) NSA_PV(pf, vt);
        } else if (PIPE) {
            if (havep) NSA_PV(pfp, lds + ((j - 1 - jb) & (NST - 1)) * 16384 + 8192);
            NSA_WAIT_TILE(); __builtin_amdgcn_s_barrier();
        }
        if (PIPE) havep = anyact;
      }
        if (TPB == 2) asm volatile("s_waitcnt vmcnt(0) lgkmcnt(0)" ::: "memory");
        else if (!PIPE) NSA_WAIT_TILE();
        __builtin_amdgcn_s_barrier();
    }
    if (PIPE && havep) { NSA_PV(pfp, lds + ((je - jb) & (NST - 1)) * 16384 + 8192); asm volatile("s_waitcnt lgkmcnt(0)" ::: "memory"); }
    if (PIPE && w < 4) __builtin_amdgcn_s_barrier();
    asm volatile("s_waitcnt vmcnt(0)" ::: "memory");
    __builtin_amdgcn_s_barrier();
#undef NSA_ISSUE
#undef NSA_WAIT_TILE
#undef NSA_PV
}

__device__ void phase_nsa2(KA ka, int layer, LAS unsigned char* lds) {
    PHASE_IDS
    const int tid = TID, w = __builtin_amdgcn_readfirstlane(tid >> 6);
    int lane = tid & 63;
#define g (lane >> 4)
#define qr (lane & 15)
#define RELAUNDER() asm volatile("" : "+v"(lane))
    const bf16_t* H = PF(H);
    const bf16_t* kcb = (PF(kcb) + layer * ((size_t)4 * 512 * 64));
    const bf16_t* vcT = (PF(vcT) + layer * ((size_t)4 * 64 * 512));
    const bf16_t* vsT = PF(vsT);
    const bf16_t* vwT = PF(vwT);
    bf16_t* Y = PF(Y);
    const float* gate_b = PF(nsa_gate_b) + layer * 24;
    const float* ogain = PF(out_gain) + layer * 1024;
    float* impw = (float*)(lds + NSA_IMP + w * 4096);
    unsigned* selw = (unsigned*)(lds + NSA_SEL + w * 128);
    for (int base = BID; base < 256; base += gridDim.x) {
#pragma unroll 1
        for (int half = 0; half < 2; ++half) {
            const int it = half ? 511 - base : base;
            const int chunk = it >> 2, bh = it & 3, b = bh >> 1, hk = bh & 1;
            const size_t rowbase = (size_t)b * T_;
            const int t0w = chunk * 64 + w * 8;
            NsaRT R[2];
#define finw ((LAS f32x4*)(lds + NSA_FIN + w * 8192) + lane)
#pragma unroll
            for (int rt = 0; rt < 2; ++rt) {
                const int tk = t0w + 4 * rt + (qr >> 2), hh = hk * 4 + (qr & 3);
                const bf16_t* qp = H + (rowbase + tk) * HLD + C_NQ + hh * 64 + 8 * g;
#pragma unroll
                for (int ks = 0; ks < 2; ++ks) {
                    const u32x4 u = *(const u32x4*)(qp + 32 * ks);
                    const unsigned uu[4] = {u.x, u.y, u.z, u.w};
                    u32x4 o4;
#pragma unroll
                    for (int e = 0; e < 4; ++e) {
                        const float f0 = __uint_as_float(uu[e] << 16) * 0.125f, f1 = __uint_as_float(uu[e] & 0xffff0000u) * 0.125f;
                        o4[e] = (__float_as_uint(f0) >> 16) | (__float_as_uint(f1) & 0xffff0000u);
                    }
                    R[rt].q[ks] = __builtin_bit_cast(bf16x8, o4);
                }
                R[rt].m = NEG_INF; R[rt].l = 0.f;
#pragma unroll
                for (int dt = 0; dt < 4; ++dt) R[rt].o[dt] = zero4();
            }
            SelMask selm0{0u, 0u, 0u, 0u}, selm1{0u, 0u, 0u, 0u};
            float carry[2] = {0.f, 0.f};
            const int tmax = chunk * 64 + 63;
            const int nvmax = tmax >= 31 ? ((tmax - 31) >> 4) + 1 : 0;
            const int nb = (nvmax + 63) >> 6;
            const char* kc_src = (const char*)(kcb + (size_t)bh * 512 * 64);
            const char* vc_src = (const char*)(vcT + (size_t)bh * 64 * 512);
            nsa_loop<0, 2>(lds, tid, lane, w, t0w, 0, nb - 1, kc_src, 128, 64 * 128, nullptr, 0, 0, R, selm0, selm1, carry, impw);
            RELAUNDER();
#pragma unroll
            for (int rt = 0; rt < 2; ++rt) { float l = R[rt].l; l += __shfl_xor(l, 16); l += __shfl_xor(l, 32); R[rt].l = l; }
            for (int i = lane; i < 8 * 128; i += 64) impw[i] = 0.f;
            wave_sync();
            nsa_loop<1, 2>(lds, tid, lane, w, t0w, 0, nb - 1, kc_src, 128, 64 * 128, vc_src, 512 * 2, 64 * 2, R, selm0, selm1, carry, impw);
            RELAUNDER();
#pragma unroll
            for (int rt = 0; rt < 2; ++rt) {
                const int hh = hk * 4 + (qr & 3);
                const float gt = sigmoidf_(bf2f(H[(rowbase + (t0w + 4 * rt + (qr >> 2))) * HLD + C_NG + hh * 3 + 0]) + gate_b[hh * 3 + 0]);
#pragma unroll
                for (int dt = 0; dt < 4; ++dt) finw[(rt * 4 + dt) * 64] = R[rt].o[dt] * gt;
            }
            wave_sync();
            {
                const int tl = lane >> 3, sub = lane & 7;
                const int tks = t0w + tl, curb = tks >> 6;
                unsigned long long K[16];
                unsigned* impu = (unsigned*)impw;
                unsigned ku[16];
#pragma unroll
                for (int i = 0; i < 16; ++i) {
                    const int jj = sub * 16 + i;
                    const float a = impw[tl * 128 + jj];
                    const bool forced = (jj == 0) || (jj == curb) || (jj == curb - 1);
                    const float vv = a + (forced ? 1e4f : 0.f);
                    ku[i] = (jj <= curb) ? (__float_as_uint(vv) + 1u) : 0u;
                    K[i] = ((unsigned long long)ku[i] << 8) | (unsigned)(255 - jj);
                }
                wave_sync();
#pragma unroll
                for (int i = 0; i < 16; ++i) impu[tl * 128 + sub * 16 + i] = ku[i];
                wave_sync();
                int cnt[16];
#pragma unroll
                for (int i = 0; i < 16; ++i) cnt[i] = 0;
                const int jjmax = (t0w + 7) >> 6;
                for (int jj = 0; jj <= jjmax; ++jj) {
                    const unsigned long long X = ((unsigned long long)impu[tl * 128 + jj] << 8) | (unsigned)(255 - jj);
#pragma unroll
                    for (int i = 0; i < 16; ++i) cnt[i] += (X > K[i]) ? 1 : 0;
                }
                unsigned bits = 0u;
#pragma unroll
                for (int i = 0; i < 16; ++i) bits |= ((cnt[i] < 16) && (ku[i] != 0u)) ? (1u << i) : 0u;
                const unsigned other = __shfl_xor(bits, 1);
                const unsigned word = (sub & 1) ? ((bits << 16) | other) : (bits | (other << 16));
                if ((sub & 1) == 0) selw[tl * 4 + (sub >> 1)] = word;
                wave_sync();
                { const unsigned* q0 = selw + (qr >> 2) * 4; selm0.a = q0[0]; selm0.b = q0[1]; selm0.c = q0[2]; selm0.d = q0[3];
                  selm1.a = q0[16]; selm1.b = q0[17]; selm1.c = q0[18]; selm1.d = q0[19]; }
                wave_sync();
            }
            __syncthreads();
#pragma unroll
            for (int rt = 0; rt < 2; ++rt) {
                R[rt].m = NEG_INF; R[rt].l = 0.f;
#pragma unroll
                for (int dt = 0; dt < 4; ++dt) R[rt].o[dt] = zero4();
            }
            nsa_loop<2, 4>(lds, tid, lane, w, t0w, 0, chunk, (const char*)(H + rowbase * HLD + C_KS + hk * 64), (size_t)HLD * 2, (size_t)64 * HLD * 2,
                        (const char*)(vsT + (size_t)bh * 64 * T_), (size_t)T_ * 2, 64 * 2, R, selm0, selm1, carry, impw);
            RELAUNDER();
#pragma unroll
            for (int rt = 0; rt < 2; ++rt) {
                const int hh = hk * 4 + (qr & 3);
                const float gt = sigmoidf_(bf2f(H[(rowbase + (t0w + 4 * rt + (qr >> 2))) * HLD + C_NG + hh * 3 + 1]) + gate_b[hh * 3 + 1]);
                float ltot = R[rt].l; ltot += __shfl_xor(ltot, 16); ltot += __shfl_xor(ltot, 32);
                const float sc = gt / ltot;
#pragma unroll
                for (int dt = 0; dt < 4; ++dt) { finw[(rt * 4 + dt) * 64] += R[rt].o[dt] * sc; R[rt].o[dt] = zero4(); }
                R[rt].m = NEG_INF; R[rt].l = 0.f;
            }
            nsa_loop<3, 4>(lds, tid, lane, w, t0w, chunk >= 8 ? chunk - 8 : 0, chunk, (const char*)(H + rowbase * HLD + C_KW + hk * 64), (size_t)HLD * 2, (size_t)64 * HLD * 2,
                        (const char*)(vwT + (size_t)bh * 64 * T_), (size_t)T_ * 2, 64 * 2, R, selm0, selm1, carry, impw);
            RELAUNDER();
#pragma unroll
            for (int rt = 0; rt < 2; ++rt) {
                const int tk = (t0w + 4 * rt + (qr >> 2)), hh = hk * 4 + (qr & 3);
                const float gt = sigmoidf_(bf2f(H[(rowbase + tk) * HLD + C_NG + hh * 3 + 2]) + gate_b[hh * 3 + 2]);
                float ltot = R[rt].l; ltot += __shfl_xor(ltot, 16); ltot += __shfl_xor(ltot, 32);
                const float sc = gt / ltot;
                bf16_t* yp = Y + (rowbase + tk) * DM + 256 + hh * 64 + 4 * g;
                f32x4 ov[4];
                float ss = 0.f;
#pragma unroll
                for (int dt = 0; dt < 4; ++dt) { ov[dt] = finw[(rt * 4 + dt) * 64] + R[rt].o[dt] * sc; ss += (ov[dt][0] * ov[dt][0] + ov[dt][1] * ov[dt][1]) + (ov[dt][2] * ov[dt][2] + ov[dt][3] * ov[dt][3]); }
                ss += __shfl_xor(ss, 16);
                ss += __shfl_xor(ss, 32);
                const float rn = rsqrtf(ss * (1.f / 64.f) + 1e-6f);
#pragma unroll
                for (int dt = 0; dt < 4; ++dt) {
                    const f32x4 o = ov[dt] * rn * *(const f32x4*)(ogain + 256 + hh * 64 + 16 * dt + 4 * g);
                    u32x2 wv; wv.x = pk2(o[0], o[1]); wv.y = pk2(o[2], o[3]);
                    *(u32x2*)(yp + 16 * dt) = wv;
                }
            }
        }
    }
}
#undef g
#undef qr
#undef finw
#undef RELAUNDER

__device__ void phase_vtrans(KA ka, float* smem) {
    PHASE_IDS
    const int lane = TID & 63, w = TID >> 6;
    bf16_t* scr = (bf16_t*)(smem + w * 4096);
    const bf16_t* H = PF(H);
    const int kperm = (lane & 32) + 8 * ((lane & 15) >> 2) + 4 * ((lane >> 4) & 1) + (lane & 3);
    for (int it = BID * NW + w; it < 1024; it += gridDim.x * NW) {
        const int tt = it & 127, bh = (it >> 7) & 3, which = it >> 9;
        const int b = bh >> 1, hk = bh & 1;
        const size_t tok0 = (size_t)b * T_ + tt * 64;
        const int col = (which ? C_VW : C_VS) + hk * 64;
        bf16_t* dst = (which ? PF(vwT) : PF(vsT)) + (size_t)bh * 64 * T_ + tt * 64;
        wave_sync();
#pragma unroll 2
        for (int i0 = 0; i0 < 64; i0 += 16) {
            bf16_t hv[16];
#pragma unroll
            for (int i = 0; i < 16; ++i) hv[i] = H[(tok0 + i0 + i) * HLD + col + lane];
#pragma unroll
            for (int i = 0; i < 16; ++i) scr[lane * 66 + i0 + i] = hv[i];
        }
        wave_sync();
#pragma unroll 16
        for (int d = 0; d < 64; ++d) dst[(size_t)d * T_ + kperm] = scr[d * 66 + lane];
    }
}

__device__ void phase_hgrnA(KA ka, int layer, LAS unsigned char* lds, int first, int nblk) {
    PHASE_IDS
    const int tid = TID, lane = tid & 63, w = __builtin_amdgcn_readfirstlane(tid >> 6), gq = lane >> 4, lc = lane & 15;
    float* Q = (float*)lds;
    float* K = Q + 64 * 68;
    float* Bc = K + 64 * 68;
    float* SEG = Bc + 64 * 68;
    LAS bf16_t* ATb = (LAS bf16_t*)(lds + 57344);
    LAS bf16_t* ItB = ATb + 64 * 72;
    LAS bf16_t* KtB = ItB + 64 * 72;
    const bf16_t* H = PF(H);
    const float* hgl = PF(hg_lower);
    float* hgU = PF(hgU); float* hgG = (PF(hgG) + layer * ((size_t)1024 * 64)); bf16_t* hgQB = PF(hgQB); bf16_t* hgO = PF(hgO);
    if (BID < first) return;
    float* LB = (float*)(lds + 98304);
    if (tid < 256) {
        float lb = 0.f;
        if (layer == 1) { const float h0 = hgl[tid], h1 = hgl[256 + tid]; const float mx = fmaxf(h0, h1), e0 = expf(h0 - mx), e1 = expf(h1 - mx); lb = e1 / (e0 + e1); }
        LB[tid] = lb;
    }
    bf16_t pff[8], pfq[8], pfi[8];
#define HGA_FETCH(ITEM) do { const int c_ = (ITEM) & 127, bh_ = (ITEM) >> 7, h_ = bh_ & 3, b_ = bh_ >> 2; const size_t tk_ = (size_t)b_ * T_ + c_ * 64; \
        _Pragma("unroll") for (int i = 0; i < 8; ++i) { const int e = tid + i * NTHR, t = e >> 6, d = e & 63; const bf16_t* hp = H + (tk_ + t) * HLD + h_ * 64 + d; \
            pff[i] = hp[C_HF]; pfq[i] = hp[C_HQ]; pfi[i] = hp[C_HI]; } } while (0)
    if (BID - first < 1024) HGA_FETCH(BID - first);
    for (int item = BID - first; item < 1024; item += nblk) {
        const int c = item & 127, bh = item >> 7, h = bh & 3, b = bh >> 2;
        const size_t tok0 = (size_t)b * T_ + c * 64;
        __syncthreads();
#pragma unroll
        for (int i = 0; i < 8; ++i) {
            const int e = tid + i * NTHR, t = e >> 6, d = e & 63;
            const float lb = LB[h * 64 + d];
            const float fl = bf2f(pff[i]);
            const float ex = __expf(-fl);
            const float sg = 1.f / (1.f + ex);
            const float f = lb + (1.f - lb) * sg;
            Q[t * 68 + d] = bf2f(pfq[i]);
            K[t * 68 + d] = (1.f - lb) * (ex * sg);
            ItB[d * 72 + t] = pfi[i];
            Bc[t * 68 + d] = __logf(fmaxf(f, 1e-38f));
        }
        if (item + nblk < 1024) HGA_FETCH(item + nblk);
        __syncthreads();
        {
            const int d = lane, seg = w;
            float run = 0.f;
#pragma unroll
            for (int i = 0; i < 8; ++i) { run += Bc[(seg * 8 + i) * 68 + d]; Bc[(seg * 8 + i) * 68 + d] = run; }
            SEG[seg * 64 + d] = run;
            __syncthreads();
            float pre = 0.f;
            for (int s2 = 0; s2 < seg; ++s2) pre += SEG[s2 * 64 + d];
#pragma unroll
            for (int i = 0; i < 8; ++i) Bc[(seg * 8 + i) * 68 + d] += pre;
        }
        __syncthreads();
        {
            const int blk = tid >> 1, dh = tid & 1, db = blk >> 6, tp = (blk >> 3) & 7, sp = blk & 7;
            float a00 = 0.f, a01 = 0.f, a10 = 0.f, a11 = 0.f;
            const int t0 = 16 * db + 2 * tp, s0 = 16 * db + 2 * sp;
            if (sp <= tp) {
#pragma unroll 2
                for (int d0 = 32 * dh; d0 < 32 * dh + 32; d0 += 4) {
                    const f32x4 q0 = *(const f32x4*)&Q[t0 * 68 + d0], q1 = *(const f32x4*)&Q[(t0 + 1) * 68 + d0];
                    const f32x4 b0 = *(const f32x4*)&Bc[t0 * 68 + d0], b1 = *(const f32x4*)&Bc[(t0 + 1) * 68 + d0];
                    const f32x4 k0 = *(const f32x4*)&K[s0 * 68 + d0], k1 = *(const f32x4*)&K[(s0 + 1) * 68 + d0];
                    const f32x4 c0 = *(const f32x4*)&Bc[s0 * 68 + d0], c1 = *(const f32x4*)&Bc[(s0 + 1) * 68 + d0];
#pragma unroll
                    for (int dd = 0; dd < 4; ++dd) {
                        a00 = fmaf(q0[dd] * k0[dd], __expf(fminf(b0[dd] - c0[dd], 0.f)), a00);
                        a01 = fmaf(q0[dd] * k1[dd], __expf(fminf(b0[dd] - c1[dd], 0.f)), a01);
                        a10 = fmaf(q1[dd] * k0[dd], __expf(fminf(b1[dd] - c0[dd], 0.f)), a10);
                        a11 = fmaf(q1[dd] * k1[dd], __expf(fminf(b1[dd] - c1[dd], 0.f)), a11);
                    }
                }
            }
            a00 += __shfl_xor(a00, 1); a01 += __shfl_xor(a01, 1); a10 += __shfl_xor(a10, 1); a11 += __shfl_xor(a11, 1);
            if (s0 + 1 > t0) a01 = 0.f;
            if (sp > tp) { a00 = 0.f; a01 = 0.f; a10 = 0.f; a11 = 0.f; }
            if (dh == 0) {
                *(LAS unsigned*)(ATb + t0 * 72 + s0) = pk2(a00, a01);
                *(LAS unsigned*)(ATb + (t0 + 1) * 72 + s0) = pk2(a10, a11);
            }
            LAS bf16_t* QT = (LAS bf16_t*)(lds + 99328);
            LAS bf16_t* KT = (LAS bf16_t*)(lds + 106496);
#pragma unroll 1
            for (int i = 0; i < 3; ++i) {
                const int e = tid + i * NTHR, t = 16 + (e >> 5), d = 2 * (e & 31), R = (t & ~15) - 1;
                const float x0 = Q[t * 68 + d] * __expf(fminf(Bc[t * 68 + d] - Bc[R * 68 + d], 0.f));
                const float x1 = Q[t * 68 + d + 1] * __expf(fminf(Bc[t * 68 + d + 1] - Bc[R * 68 + d + 1], 0.f));
                *(LAS unsigned*)(QT + (t - 16) * 72 + d) = pk2(x0, x1);
            }
#pragma unroll 1
            for (int i = 0; i < 6; ++i) {
                const int e = tid + i * NTHR, row = e >> 5, d = 2 * (e & 31);
                const int rb = row < 16 ? 0 : (row < 48 ? 1 : 2);
                const int s = row - (rb == 0 ? 0 : (rb == 1 ? 16 : 48)), R = 16 * rb + 15;
                const float x0 = K[s * 68 + d] * __expf(fminf(Bc[R * 68 + d] - Bc[s * 68 + d], 0.f));
                const float x1 = K[s * 68 + d + 1] * __expf(fminf(Bc[R * 68 + d + 1] - Bc[s * 68 + d + 1], 0.f));
                *(LAS unsigned*)(KT + row * 72 + d) = pk2(x0, x1);
            }
        }
#pragma unroll
        for (int i = 0; i < 8; ++i) {
            const int e = tid + i * NTHR, t = e >> 6, d = e & 63;
            const float bt = Bc[t * 68 + d];
            hgQB[(size_t)item * 4096 + e] = f2bf(Q[t * 68 + d] * __expf(bt));
            KtB[d * 72 + t] = f2bf(K[t * 68 + d] * __expf(Bc[63 * 68 + d] - bt));
        }
        if (tid < 64) hgG[(size_t)item * 64 + tid] = __expf(Bc[63 * 68 + tid]);
        __syncthreads();
        {
            const LAS bf16_t* QT = (const LAS bf16_t*)(lds + 99328);
            const LAS bf16_t* KT = (const LAS bf16_t*)(lds + 106496);
            if (w < 6) {
                const int tb16 = w < 1 ? 1 : (w < 3 ? 2 : 3), sb16 = w - (tb16 == 1 ? 0 : (tb16 == 2 ? 1 : 3));
                const int kbase = (tb16 == 1 ? 0 : (tb16 == 2 ? 16 : 48)) + 16 * sb16;
                const LAS bf16_t* Ab = QT + (16 * (tb16 - 1) + lc) * 72 + 8 * gq;
                const LAS bf16_t* Bb = KT + (kbase + lc) * 72 + 8 * gq;
                f32x4 acc = zero4();
                acc = MFMA16(*(const LAS bf16x8*)Ab, *(const LAS bf16x8*)Bb, acc);
                acc = MFMA16(*(const LAS bf16x8*)(Ab + 32), *(const LAS bf16x8*)(Bb + 32), acc);
#pragma unroll
                for (int i = 0; i < 4; ++i) ATb[(16 * tb16 + 4 * gq + i) * 72 + 16 * sb16 + lc] = f2bf(acc[i]);
            } else {
                for (int e = tid - 384; e < 6 * 16 * 8; e += 128) {
                    const int bz = e >> 7, r = (e >> 3) & 15, cw = e & 7;
                    const int tb16 = bz < 3 ? 0 : (bz < 5 ? 1 : 2), sb16 = bz < 3 ? bz + 1 : (bz < 5 ? bz - 1 : 3);
                    *(LAS unsigned*)(ATb + (16 * tb16 + r) * 72 + 16 * sb16 + 2 * cw) = 0u;
                }
            }
        }
        __syncthreads();
#pragma unroll
        for (int q = 0; q < 4; ++q) {
            const int tile = w * 4 + q, isU = tile >> 4, rt_ = (tile >> 2) & 3, ct = tile & 3;
            const LAS bf16_t* Ab = (isU ? KtB : ATb) + (16 * rt_ + lc) * 72 + 8 * gq;
            const LAS bf16_t* Bb = ItB + (16 * ct + lc) * 72 + 8 * gq;
            f32x4 acc = zero4();
            acc = MFMA16(*(const LAS bf16x8*)Ab, *(const LAS bf16x8*)Bb, acc);
            acc = MFMA16(*(const LAS bf16x8*)(Ab + 32), *(const LAS bf16x8*)(Bb + 32), acc);
#pragma unroll
            for (int i = 0; i < 4; ++i) {
                const int r = 16 * rt_ + 4 * gq + i, cc = 16 * ct + lc;
                if (isU) hgU[((size_t)item * 64 + r) * 64 + cc] = acc[i];
                else hgO[((size_t)item * 64 + r) * 64 + cc] = f2bf(acc[i]);
            }
        }
    }
}

__device__ void phase_hgrnB(KA ka, int layer) {
    PHASE_IDS
    const float* hgU = PF(hgU); const float* hgG = (PF(hgG) + layer * ((size_t)1024 * 64)); float* hgS = PF(hgS);
    for (int gid = BID * NTHR + TID; gid < 32768; gid += gridDim.x * NTHR) {
        const int bh = gid >> 12, dv = gid & 4095, d = dv >> 6;
        float S = 0.f;
        for (int c0 = 0; c0 < 128; c0 += 8) {
            float u[8], gg[8];
#pragma unroll
            for (int k = 0; k < 8; ++k) { const size_t item = (size_t)bh * 128 + c0 + k; u[k] = hgU[item * 4096 + dv]; gg[k] = hgG[item * 64 + d]; }
#pragma unroll
            for (int k = 0; k < 8; ++k) { const size_t item = (size_t)bh * 128 + c0 + k; hgS[item * 4096 + dv] = S; S = fmaf(gg[k], S, u[k]); }
        }
    }
    if (BID * NTHR < 32768) {
        asm volatile("s_waitcnt vmcnt(0)" ::: "memory");
        __syncthreads();
        if (TID == 0) {
            __builtin_amdgcn_fence(__ATOMIC_RELEASE, "agent");
            asm volatile("s_waitcnt vmcnt(0)" ::: "memory");
            (void)__hip_atomic_fetch_add(PF(ctl) + CW_HG + layer * 128, 1u, __ATOMIC_RELAXED, __HIP_MEMORY_SCOPE_AGENT);
        }
    }
}

__device__ void phase_hgrnC(KA ka, int layer, LAS unsigned char* lds) {
    PHASE_IDS
    const int tid = TID, lane = tid & 63, w = __builtin_amdgcn_readfirstlane(tid >> 6), gq = lane >> 4, lc = lane & 15;
    LAS bf16_t* QBb = (LAS bf16_t*)lds;
    LAS bf16_t* StB = QBb + 64 * 72;
    float* OT = (float*)(lds + 32768);
    const bf16_t* H = PF(H);
    const float* hgS = PF(hgS); const bf16_t* hgQB = PF(hgQB); const bf16_t* hgO = PF(hgO);
    const float* og = PF(out_gain) + layer * 1024;
    bf16_t* Y = PF(Y);
    {
        unsigned* done = PF(ctl) + CW_HG + layer * 128;
        const unsigned need = (unsigned)((32768 + NTHR - 1) / NTHR < (int)gridDim.x ? (32768 + NTHR - 1) / NTHR : (int)gridDim.x);
        if (tid == 0) {
            unsigned* bar = PF(ctl) + CW_BAR;
            XB_SPIN(xb_ld(done) < need, bar);
            __builtin_amdgcn_fence(__ATOMIC_ACQUIRE, "agent");
            asm volatile("s_waitcnt vmcnt(0)" ::: "memory");
        }
        __syncthreads();
    }
    unsigned* qhead = PF(ctl) + CW_HG + layer * 128 + 64;
    for (int item = queue_fetch(ka, qhead, lds); item < 1024; item = queue_fetch(ka, qhead, lds)) {
        const int c = item & 127, bh = item >> 7, h = bh & 3, b = bh >> 2;
        const size_t tok0 = (size_t)b * T_ + c * 64;
        __syncthreads();
#pragma unroll
        for (int i = 0; i < 8; ++i) {
            const int e = tid + i * NTHR, r = e >> 6, cc = e & 63;
            QBb[r * 72 + cc] = hgQB[(size_t)item * 4096 + e];
            StB[cc * 72 + r] = f2bf(hgS[(size_t)item * 4096 + e]);
        }
        __syncthreads();
#pragma unroll
        for (int q = 0; q < 2; ++q) {
            const int tile = w * 2 + q, rt_ = tile >> 2, ct = tile & 3;
            const LAS bf16_t* Ab = QBb + (16 * rt_ + lc) * 72 + 8 * gq;
            const LAS bf16_t* Bb = StB + (16 * ct + lc) * 72 + 8 * gq;
            f32x4 acc = zero4();
            acc = MFMA16(*(const LAS bf16x8*)Ab, *(const LAS bf16x8*)Bb, acc);
            acc = MFMA16(*(const LAS bf16x8*)(Ab + 32), *(const LAS bf16x8*)(Bb + 32), acc);
#pragma unroll
            for (int i = 0; i < 4; ++i) {
                const int t = 16 * rt_ + 4 * gq + i, v = 16 * ct + lc;
                OT[t * 65 + v] = acc[i] + bf2f(hgO[((size_t)item * 64 + t) * 64 + v]);
            }
        }
        __syncthreads();
        {
            float av[8], ms[8], hgv[8];
#pragma unroll
            for (int i = 0; i < 8; ++i) hgv[i] = bf2f(H[(tok0 + w + 8 * i) * HLD + C_HG + h * 64 + lane]);
            const float ogv = og[768 + h * 64 + lane];
#pragma unroll
            for (int i = 0; i < 8; ++i) { av[i] = OT[(w + 8 * i) * 65 + lane]; ms[i] = av[i] * av[i]; }
#pragma unroll
            for (int off = 32; off > 0; off >>= 1) {
                float tt[8];
#pragma unroll
                for (int i = 0; i < 8; ++i) tt[i] = __shfl_xor(ms[i], off);
#pragma unroll
                for (int i = 0; i < 8; ++i) ms[i] += tt[i];
            }
#pragma unroll
            for (int i = 0; i < 8; ++i) {
                float r = ms[i] * (1.f / 64.f);
                asm volatile("" : "+v"(r));
                const float y = av[i] * rsqrtf(r + 1e-6f) * ogv * (hgv[i] * sigmoidf_(hgv[i]));
                Y[(tok0 + w + 8 * i) * DM + 768 + h * 64 + lane] = f2bf(y);
            }
        }
    }
}

struct CmpOrder {
    static constexpr bool GATHER = false;
    const char* W1T; int c;
    __device__ __forceinline__ bool next(int i, pg8::Unit& u) const {
        if (i > 0 || c >= 16) return false;
        const int which = c >> 3, bh = (c >> 1) & 3, nt = c & 1;
        u.arow0 = (bh >> 1) * 512 + nt * 256; u.nrows = 256; u.pm = nt; u.pn = 0; u.e = which * 4 + bh; u.ui = 0;
        u.bptr = W1T + (size_t)which * 256 * 2048 * 2;
        return true;
    }
    __device__ __forceinline__ int arow(const pg8::Unit& u, int r) const { return u.arow0 + r; }
    __device__ __forceinline__ int lda(int) const { return 16 * HLD; }
    __device__ __forceinline__ unsigned kstepA() const { return (unsigned)(HLD * 2); }
    __device__ __forceinline__ const char* abase(const pg8::Unit& u, const char* A) const { return A + (((u.e >> 2) ? C_VC : C_KC) + (u.e & 1) * 64) * 2; }
};
struct EpiCmp {
    static constexpr bool PERM = true;
    bf16_t* G; const float* cbias;
    __device__ __forceinline__ void operator()(const f32x4 (&acc)[2][2][4][2], const pg8::Unit& u, int wr, int wc, int fr, int fq) const {
        const float* bp = cbias + (u.e >> 2) * 128 + wc * 32 + 8 * fq;
        const f32x4 b0 = *(const f32x4*)bp, b1 = *(const f32x4*)(bp + 4);
#pragma unroll
        for (int ai = 0; ai < 2; ++ai)
#pragma unroll
            for (int m = 0; m < 4; ++m) {
                const int r = ai * 128 + wr * 64 + m * 16 + fr;
                bf16_t* rowp = G + ((size_t)(u.e * 512 + u.pm * 256 + r)) * 128 + wc * 32 + 8 * fq;
                const f32x4 v0 = acc[ai][0][m][0] + b0, v1 = acc[ai][0][m][1] + b1;
                u32x4 w; w.x = pk2(gelu_slow(v0[0]), gelu_slow(v0[1])); w.y = pk2(gelu_slow(v0[2]), gelu_slow(v0[3])); w.z = pk2(gelu_slow(v1[0]), gelu_slow(v1[1])); w.w = pk2(gelu_slow(v1[2]), gelu_slow(v1[3]));
                *(u32x4*)rowp = w;
            }
    }
};
__device__ void phase_compress2(KA ka, int layer, LAS unsigned char* lds) {
    const int bid = opaque_bid();
    if (bid >= 16) return;
    CmpOrder S{(const char*)(PF(WT) + WT_C1), bid};
    EpiCmp E{(PF(gb) + layer * ((size_t)8 * 512 * 128)), (PF(cbias) + layer * (256))};
    pg8::gemm_phase<EpiCmp, CmpOrder>(lds, (const char*)PF(H), 2048, S, E, ka.wv);
    __syncthreads();
    const int tid = opaque_tid(ka.wv);
    const int which = bid >> 3, bh = (bid >> 1) & 3, nt = bid & 1;
    float* w2s = (float*)lds;
    const float* w2 = PF(cmp_w2) + ((size_t)layer * 2 + which) * 128 * 64;
    for (int i = tid; i < 128 * 64; i += NTHR) w2s[i] = w2[i];
    __syncthreads();
    const int r = tid >> 1, half = tid & 1;
    const bf16_t* grow = (PF(gb) + layer * ((size_t)8 * 512 * 128)) + ((size_t)((which * 4 + bh) * 512 + nt * 256 + r)) * 128;
    float acc[32];
#pragma unroll
    for (int j = 0; j < 32; ++j) acc[j] = 0.f;
    for (int c8 = 0; c8 < 16; ++c8) {
        const u32x4 gu = *(const u32x4*)(grow + c8 * 8);
        const unsigned gw[4] = {gu.x, gu.y, gu.z, gu.w};
#pragma unroll
        for (int e = 0; e < 8; ++e) {
            const float gv = (e & 1) ? __uint_as_float(gw[e >> 1] & 0xffff0000u) : __uint_as_float(gw[e >> 1] << 16);
            const float* wrow = w2s + (c8 * 8 + e) * 64 + half * 32;
#pragma unroll
            for (int j4 = 0; j4 < 8; ++j4) {
                const float4 w4 = *(const float4*)(wrow + j4 * 4);
                acc[j4 * 4 + 0] = fmaf(gv, w4.x, acc[j4 * 4 + 0]); acc[j4 * 4 + 1] = fmaf(gv, w4.y, acc[j4 * 4 + 1]);
                acc[j4 * 4 + 2] = fmaf(gv, w4.z, acc[j4 * 4 + 2]); acc[j4 * 4 + 3] = fmaf(gv, w4.w, acc[j4 * 4 + 3]);
            }
        }
    }
    const int n = nt * 256 + r;
    if (which == 0) {
        bf16_t* o = (PF(kcb) + layer * ((size_t)4 * 512 * 64)) + ((size_t)bh * 512 + n) * 64 + half * 32;
#pragma unroll
        for (int j = 0; j < 32; j += 2) *(unsigned*)(o + j) = pk2(acc[j], acc[j + 1]);
    } else {
        const int np = (n & ~31) + 8 * ((n & 15) >> 2) + 4 * ((n >> 4) & 1) + (n & 3);
        bf16_t* o = (PF(vcT) + layer * ((size_t)4 * 64 * 512)) + (size_t)bh * 64 * 512 + np;
#pragma unroll
        for (int j = 0; j < 32; ++j) o[(size_t)(half * 32 + j) * 512] = f2bf(acc[j]);
    }
    __syncthreads();
}

__device__ void phase_gmlp2(KA ka, int layer, LAS unsigned char* lds, int first, int nblk) {
    PHASE_IDS
    const int tid = TID, lane = tid & 63, w = __builtin_amdgcn_readfirstlane(tid >> 6), gq = lane >> 4, lc = lane & 15;
    LAS bf16_t* Vt = (LAS bf16_t*)lds;
    const float* gain = PF(gm_v_gain) + layer * 256;
    const float* bias = PF(gm_v_bias) + layer * 256;
    const float* bs = PF(gm_b_s) + layer * 4 * 128;
    const bf16_t* gmW = PF(WT) + WT_GM;
    const bf16_t* H = PF(H);
    bf16_t* Y = PF(Y);
    if (BID < first) return;
    for (int it = BID - first; it < 1536; it += nblk) {
        if (it < 1024) continue;
        const int item = it - 1024;
        const int g = item & 3, c = (item >> 2) & 63, b = item >> 8;
        const size_t tok0 = (size_t)b * T_ + (size_t)c * 128;
        __syncthreads();
        bf16_t gvr[16], gur[16];
#pragma unroll
        for (int i = 0; i < 16; ++i) gvr[i] = H[(tok0 + w * 16 + i) * HLD + C_GV + g * 64 + lane];
#pragma unroll
        for (int i = 0; i < 4; ++i)
#pragma unroll
            for (int ct = 0; ct < 4; ++ct) gur[i * 4 + ct] = H[(tok0 + 16 * w + 4 * gq + i) * HLD + C_GU + g * 64 + 16 * ct + lc];
        const bf16_t* wrow = gmW + ((size_t)g * 128 + 16 * w + lc) * 128 + 8 * gq;
        const int kmax = (16 * w + 15) >> 5;
        bf16x8 afr[4];
#pragma unroll
        for (int ks = 0; ks < 4; ++ks) afr[ks] = *(const bf16x8*)(wrow + 32 * (ks <= kmax ? ks : 0));
        const float* ogain = PF(out_gain) + layer * 1024;
        float bsv[4], ogv[4];
#pragma unroll
        for (int i = 0; i < 4; ++i) bsv[i] = bs[g * 128 + 16 * w + 4 * gq + i];
#pragma unroll
        for (int ct = 0; ct < 4; ++ct) ogv[ct] = ogain[g * 64 + 16 * ct + lc];
        const float gn = gain[g * 64 + lane], bi = bias[g * 64 + lane];
        {
            float ge[16], sm[16];
#pragma unroll
            for (int i = 0; i < 16; ++i) { ge[i] = gelu_t(bf2f(gvr[i])); sm[i] = ge[i]; }
#pragma unroll
            for (int off = 32; off > 0; off >>= 1) {
                float tt[16];
#pragma unroll
                for (int i = 0; i < 16; ++i) tt[i] = __shfl_xor(sm[i], off);
#pragma unroll
                for (int i = 0; i < 16; ++i) sm[i] += tt[i];
            }
#pragma unroll
            for (int i = 0; i < 16; ++i) { ge[i] -= sm[i] * (1.f / 64.f); sm[i] = ge[i] * ge[i]; }
#pragma unroll
            for (int off = 32; off > 0; off >>= 1) {
                float tt[16];
#pragma unroll
                for (int i = 0; i < 16; ++i) tt[i] = __shfl_xor(sm[i], off);
#pragma unroll
                for (int i = 0; i < 16; ++i) sm[i] += tt[i];
            }
#pragma unroll
            for (int i = 0; i < 16; i += 2) {
                float r0 = sm[i] * (1.f / 64.f), r1 = sm[i + 1] * (1.f / 64.f);
                asm volatile("" : "+v"(r0), "+v"(r1));
                float v0 = ge[i] * rsqrtf(r0 + 1e-5f) * gn + bi, v1 = ge[i + 1] * rsqrtf(r1 + 1e-5f) * gn + bi;
                asm volatile("" : "+v"(v0), "+v"(v1));
                *(LAS unsigned*)(Vt + lane * 136 + w * 16 + i) = pk2(v0, v1);
            }
        }
        __syncthreads();
        f32x4 acc[4];
#pragma unroll
        for (int ct = 0; ct < 4; ++ct) acc[ct] = zero4();
#pragma unroll
        for (int ks = 0; ks < 4; ++ks) {
            if (ks <= kmax) {
#pragma unroll
                for (int ct = 0; ct < 4; ++ct) {
                    const bf16x8 bfr = *(const LAS bf16x8*)(Vt + (16 * ct + lc) * 136 + 32 * ks + 8 * gq);
                    acc[ct] = MFMA16(afr[ks], bfr, acc[ct]);
                }
            }
        }
#pragma unroll
        for (int i = 0; i < 4; ++i) {
            const int t = 16 * w + 4 * gq + i;
            float yv[4];
            float ss = 0.f;
#pragma unroll
            for (int ct = 0; ct < 4; ++ct) {
                const int d = 16 * ct + lc;
                float z = acc[ct][i] + bsv[i];
                asm volatile("" : "+v"(z));
                const float u = gelu_t(bf2f(gur[i * 4 + ct]));
                yv[ct] = u * z;
                asm volatile("" : "+v"(yv[ct]));
                ss += yv[ct] * yv[ct];
            }
            ss += __shfl_xor(ss, 1); ss += __shfl_xor(ss, 2); ss += __shfl_xor(ss, 4); ss += __shfl_xor(ss, 8);
            const float rn = rsqrtf(ss * (1.f / 64.f) + 1e-6f);
#pragma unroll
            for (int ct = 0; ct < 4; ++ct) {
                const int d = 16 * ct + lc;
                Y[(tok0 + t) * DM + g * 64 + d] = f2bf(yv[ct] * rn * ogv[ct]);
            }
        }
    }
}

#ifndef ONLY_Q
#define ONLY_Q -2
#endif
#ifndef QMASK
#define QMASK 0x3ff
#endif
#define QON(k) ((ONLY_Q == -2 && ((QMASK >> ((k) + 1)) & 1)) || ONLY_Q == (k))
#ifndef DUPMASK
#define DUPMASK 0
#endif
#define DUP(k) ((DUPMASK >> (k)) & 1)
#ifndef PROF_LO
#define PROF_LO -1
#endif
#ifndef PROF_HI
#define PROF_HI -1
#endif
#ifndef WS_PROBE_PAD
#define WS_PROBE_PAD 0
#endif
#ifndef NPH_TOTAL
#define NPH_TOTAL 19
#endif
__global__ void __launch_bounds__(NTHR, 2) k_mega(P p0) {
    extern __shared__ __attribute__((aligned(16))) unsigned char lds_raw[];
    LAS unsigned char* lds = (LAS unsigned char*)lds_raw;
    float* smem = (float*)lds_raw;
    volatile LAS unsigned* misc = (volatile LAS unsigned*)(lds + LDS_MISC);
    if (threadIdx.x < 16) misc[threadIdx.x] = 0u;
    __syncthreads();
    const int wv0 = __builtin_amdgcn_readfirstlane((int)(threadIdx.x >> 6));
    XcdBarrier bar = xcd_barrier_post(p0.ctl + CW_BAR, misc); bar.wv = wv0;
    if (PROF_LO >= 0 && blockIdx.x == 0 && threadIdx.x == 0) ((unsigned long long*)(p0.ctl + 8192))[0] = __builtin_amdgcn_s_memrealtime();
#pragma unroll 1
    for (int ph = 0; ph < p0.nph; ph++) {
        const int layer = ph == 0 ? 0 : (ph - 1) / 9, q = ph == 0 ? -1 : (ph - 1) % 9;
        const int dupm = p0.pad;
        KA ka; ka.wv = wv0;
#if defined(__HIP_DEVICE_COMPILE__)
        ka.p = (const __attribute__((address_space(4))) char*)__builtin_amdgcn_kernarg_segment_ptr();
        asm volatile("" : "+s"(ka.p));
#else
        ka.p = nullptr;
#endif
        const float* xin = layer == 0 ? PF(x) : PF(out);
        float* x1 = PF(out);
        if (q == -1 && QON(-1)) { for (int r = 0; r <= ((dupm >> 15) & 1); ++r) { phase_prologue(ka, 0, smem); __syncthreads(); } }
        else if (q == 0 && QON(0)) { for (int r = 0; r <= (dupm & 1); ++r) { phase_inproj(ka, layer, lds); __syncthreads(); } }
        else if (q == 1 && QON(1)) {
            const int nb1 = (int)gridDim.x > 32 ? 16 : 0, nwork = (int)gridDim.x - nb1;
            for (int r = 0; r <= ((dupm >> 12) & 1); ++r) { phase_compress2(ka, layer, lds); __syncthreads(); }
            for (int r = 0; r <= ((dupm >> 10) & 1); ++r) { phase_hgrnA(ka, layer, lds, nb1, nwork); __syncthreads(); }
            for (int r = 0; r <= ((dupm >> 11) & 1); ++r) { phase_gmlp2(ka, layer, lds, nb1, nwork); __syncthreads(); }
            for (int r = 0; r <= ((dupm >> 13) & 1); ++r) { phase_vtrans(ka, smem); __syncthreads(); }
        }
        else if (q == 2 && QON(2)) { for (int r = 0; r <= ((dupm >> 14) & 1); ++r) { phase_hgrnB(ka, layer); __syncthreads(); } for (int r = 0; r <= ((dupm >> 2) & 1); ++r) { phase_nsa2(ka, layer, lds); __syncthreads(); } phase_hgrnC(ka, layer, lds); __syncthreads(); }
        else if (q == 3) continue;
        else if (q == 4 && QON(4)) phase_outproj(ka, layer, xin, x1, lds);
        else if (q == 5 && QON(5)) { for (int r = ((dupm >> 5) & 1); r >= 0; --r) { phase_ln1_route(ka, layer, x1, smem, r == 1); __syncthreads(); } }
        else if (q == 6 && QON(6)) { for (int r = 0; r <= ((dupm >> 6) & 1); ++r) { phase_moe_up(ka, layer, lds); __syncthreads(); } }
        else if (q == 7 && QON(7)) { for (int r = 0; r <= ((dupm >> 7) & 1); ++r) { phase_moe_down(ka, layer, lds); __syncthreads(); } }
        else if (q == 8 && QON(8)) { phase_ln2(ka, layer, x1, PF(out)); if (layer == 0) { __syncthreads(); phase_prologue(ka, 1, smem); } }
        if (ph != NPH_TOTAL - 1 || PROF_LO >= 0) xcd_barrier(bar);
        if (PROF_LO >= 0 && blockIdx.x == 0 && threadIdx.x == 0) ((unsigned long long*)(p0.ctl + 8192))[ph + 1] = __builtin_amdgcn_s_memrealtime();
    }

#ifdef STALE_PROBE
    {
        xcd_barrier(bar);
        const int G = gridDim.x, b = blockIdx.x, tid = threadIdx.x, partner = (b + 1) % G;
        unsigned* T = (unsigned*)p0.hgU;
        for (int arm = 0; arm < 2; ++arm) for (int i = tid; i < 4096; i += NTHR) T[((size_t)(arm * G + b)) * 4096 + i] = 1000u + b;
        xcd_barrier(bar);
        unsigned sink = 0;
        for (int rep = 0; rep < 4; ++rep) for (int i = tid; i < 4096; i += NTHR) sink += T[(size_t)partner * 4096 + i];
        for (int rep = 0; rep < 4; ++rep) {
            for (int i = 0; i < 2; ++i) __builtin_amdgcn_global_load_lds((const unsigned*)(T + ((size_t)(G + partner)) * 4096 + (i * 512 + tid) * 4), (LAS unsigned*)(lds + i * 8192 + wv0 * 1024), 16, 0, 0);
            asm volatile("s_waitcnt vmcnt(0)" ::: "memory");
        }
        asm volatile("" :: "v"(sink));
        xcd_barrier(bar);
        for (int arm = 0; arm < 2; ++arm) for (int i = tid; i < 4096; i += NTHR) T[((size_t)(arm * G + b)) * 4096 + i] = 2000u + b;
        xcd_barrier(bar);
        unsigned bad0 = 0, bad1 = 0;
        for (int i = tid; i < 4096; i += NTHR) bad0 += (T[(size_t)partner * 4096 + i] != 2000u + partner);
        for (int i = 0; i < 2; ++i) __builtin_amdgcn_global_load_lds((const unsigned*)(T + ((size_t)(G + partner)) * 4096 + (i * 512 + tid) * 4), (LAS unsigned*)(lds + i * 8192 + wv0 * 1024), 16, 0, 0);
        asm volatile("s_waitcnt vmcnt(0)" ::: "memory");
        __syncthreads();
        for (int i = tid; i < 4096; i += NTHR) bad1 += (((LAS unsigned*)lds)[i] != 2000u + partner);
        unsigned* cnt2 = p0.ctl + 12288;
        if (bad0) atomicAdd(&cnt2[0], bad0);
        if (bad1) atomicAdd(&cnt2[64], bad1);
        xcd_barrier(bar);
        const unsigned c0 = __hip_atomic_load(&cnt2[0], __ATOMIC_RELAXED, __HIP_MEMORY_SCOPE_AGENT), c1 = __hip_atomic_load(&cnt2[64], __ATOMIC_RELAXED, __HIP_MEMORY_SCOPE_AGENT);
        const float fac = 1.f + (c0 ? 1.f : 0.f) + (c1 ? 2.f : 0.f);
        for (size_t i = (size_t)blockIdx.x * NTHR + threadIdx.x; i < (size_t)NTOK * DM; i += (size_t)gridDim.x * NTHR) p0.out[i] = fac;
    }
#endif
    if (PROF_LO >= 0) {
        xcd_barrier(bar);
        const unsigned long long* ts = (const unsigned long long*)(p0.ctl + 8192);
        const unsigned long long t0 = __hip_atomic_load(&ts[PROF_LO], __ATOMIC_RELAXED, __HIP_MEMORY_SCOPE_AGENT), t1 = __hip_atomic_load(&ts[PROF_HI + 1], __ATOMIC_RELAXED, __HIP_MEMORY_SCOPE_AGENT);
        const float fac = 1.f + 1e-5f * (float)(t1 - t0);
        for (size_t i = (size_t)blockIdx.x * NTHR + threadIdx.x; i < (size_t)NTOK * DM; i += (size_t)gridDim.x * NTHR) p0.out[i] *= fac;
    }
}

static inline size_t align_up(size_t v, size_t a) { return (v + a - 1) / a * a; }

extern "C" void kernel_launch(void* const* d_in, const int* in_sizes, int n_in, void* d_out, int out_size, void* d_ws,
                              size_t ws_size, hipStream_t stream) {
    P p{};
    p.x = (const float*)d_in[0]; p.w_in = (const float*)d_in[1]; p.gm_v_gain = (const float*)d_in[2];
    p.gm_v_bias = (const float*)d_in[3]; p.gm_w_s = (const float*)d_in[4]; p.gm_b_s = (const float*)d_in[5];
    p.cmp_pos = (const float*)d_in[6]; p.cmp_w1 = (const float*)d_in[7]; p.cmp_w2 = (const float*)d_in[8];
    p.nsa_gate_b = (const float*)d_in[9]; p.hg_lower = (const float*)d_in[10]; p.out_gain = (const float*)d_in[11];
    p.w_out = (const float*)d_in[12]; p.ln1_g = (const float*)d_in[13]; p.ln1_b = (const float*)d_in[14];
    p.rg_w = (const float*)d_in[15]; p.rg_b = (const float*)d_in[16]; p.re_w = (const float*)d_in[17];
    p.re_b = (const float*)d_in[18]; p.w_gate = (const float*)d_in[19]; p.w_up = (const float*)d_in[20];
    p.w_down = (const float*)d_in[21]; p.ln2_g = (const float*)d_in[22]; p.ln2_b = (const float*)d_in[23];
    p.out = (float*)d_out;
    char* ws = (char*)d_ws;
    size_t off = 0;
    p.ctl = (unsigned*)(ws + off); off = align_up(off + CTL_BYTES, 256);
    p.WT = (bf16_t*)(ws + off); off = align_up(off + WT_LAYER * 2, 256);
    p.H = (bf16_t*)(ws + off); off = align_up(off + (size_t)(NTOK + 64) * HLD * 2, 256);
    p.Y = (bf16_t*)(ws + off); off = align_up(off + (size_t)NTOK * DM * 2, 256);
    p.XB = (bf16_t*)(ws + off); off = align_up(off + (size_t)NTOK * DM * 2, 256);
    p.kcb = (bf16_t*)(ws + off); off = align_up(off + 2 * ((size_t)4 * 512 * 64 * 2), 256);
    p.vcT = (bf16_t*)(ws + off); off = align_up(off + 2 * ((size_t)4 * 64 * 512 * 2), 256);
    p.vsT = (bf16_t*)(ws + off); off = align_up(off + (size_t)4 * 64 * T_ * 2, 256);
    p.vwT = (bf16_t*)(ws + off); off = align_up(off + (size_t)4 * 64 * T_ * 2, 256);
    p.gb = (bf16_t*)(ws + off); off = align_up(off + 2 * ((size_t)8 * 512 * 128 * 2), 256);
    p.cbias = (float*)(ws + off); off = align_up(off + 2 * (256 * 4), 256);
    p.wrt = (float*)(ws + off); off = align_up(off + 2 * (20 * 1024 * 4), 256);
    p.list_tok = (int*)(ws + off); off = align_up(off + 2 * ((size_t)16 * NTOK * 4), 256);
    p.list_w = (float*)(ws + off); off = align_up(off + 2 * ((size_t)16 * NTOK * 4), 256);
    p.tok_slot = (int*)(ws + off); off = align_up(off + 2 * ((size_t)NTOK * 2 * 4), 256);
    p.hgU = (float*)(ws + off); off = align_up(off + (size_t)1024 * 4096 * 4, 256);
    p.hgS = (float*)(ws + off); off = align_up(off + (size_t)1024 * 4096 * 4, 256);
    p.hgG = (float*)(ws + off); off = align_up(off + 2 * ((size_t)1024 * 64 * 4), 256);
    p.hgQB = (bf16_t*)(ws + off); off = align_up(off + (size_t)1024 * 4096 * 2, 256);
    p.hgO = (bf16_t*)(ws + off); off = align_up(off + (size_t)1024 * 4096 * 2, 256);
#ifdef STALE_PROBE
    p.nph = 0; p.pad = 0;
#else
    p.nph = NPH_TOTAL; p.pad = DUPMASK;
#endif
    (void)in_sizes; (void)n_in; (void)out_size;
    static int grid_blocks = 0;
    if (!grid_blocks) {
        int dev = 0, cus = 0, per_cu = 0;
        (void)hipGetDevice(&dev);
        (void)hipDeviceGetAttribute(&cus, hipDeviceAttributeMultiprocessorCount, dev);
        if (hipFuncSetAttribute((const void*)k_mega, hipFuncAttributeMaxDynamicSharedMemorySize, LDS_BYTES) != hipSuccess) { fprintf(stderr, "hipFuncSetAttribute failed\n"); grid_blocks = -1; return; }
        if (hipOccupancyMaxActiveBlocksPerMultiprocessor(&per_cu, (const void*)k_mega, NTHR, LDS_BYTES) != hipSuccess || per_cu < 1) { fprintf(stderr, "occupancy query says %d\n", per_cu); }
        (void)hipGetLastError();
        grid_blocks = cus;
        off += (size_t)WS_PROBE_PAD;
        if (off > ws_size) { fprintf(stderr, "workspace too small: need %zu have %zu\n", off, ws_size); grid_blocks = -1; }
    }
    if (grid_blocks < 0) return;
    (void)hipMemsetAsync(p.ctl, 0, CTL_BYTES, stream);
    void* args[] = {&p};
    hipError_t e = hipLaunchCooperativeKernel((const void*)k_mega, dim3(grid_blocks), dim3(NTHR), args, LDS_BYTES, stream);
    if (e != hipSuccess) fprintf(stderr, "cooperative launch failed: %s (grid %d)\n", hipGetErrorString(e), grid_blocks);
}
```

```cpp
#include <hip/hip_runtime.h>
#include <cstdio>
#include <cstdint>

#define LAS __attribute__((address_space(3)))
typedef unsigned short bf16_t;
typedef short bf16x8 __attribute__((ext_vector_type(8)));
typedef float f32x4 __attribute__((ext_vector_type(4)));
typedef float f32x2 __attribute__((ext_vector_type(2)));
typedef unsigned u32x4 __attribute__((ext_vector_type(4)));
typedef unsigned u32x2 __attribute__((ext_vector_type(2)));

constexpr int NW = 8;
constexpr int NTHR = NW * 64;
constexpr int T_ = 8192;
constexpr int NTOK = 16384;
constexpr int DM = 1024;
constexpr int IC_SRC = 2840;
constexpr int HLD = 3072;
constexpr int C_GU = 0, C_GV = 256, C_NQ = 512, C_KC = 1024, C_VC = 1152, C_KS = 1280, C_VS = 1408,
              C_KW = 1536, C_VW = 1664, C_HQ = 1792, C_HF = 2048, C_HI = 2304, C_HG = 2560, C_NG = 2816;
constexpr int NCMP = 511;
constexpr float ALPHA = 1.4142135623730951f;
constexpr float NEG_INF = -1e30f;

constexpr size_t WT_IN = 0;
constexpr size_t WT_OUT = WT_IN + (size_t)3072 * 1024;
constexpr size_t WT_UP = WT_OUT + (size_t)1024 * 1024;
constexpr size_t WT_DN = WT_UP + (size_t)16 * 1024 * 1024;
constexpr size_t WT_C1 = WT_DN + (size_t)16 * 1024 * 512;
constexpr size_t WT_GM = WT_C1 + (size_t)2 * 256 * 2048;
constexpr size_t WT_LAYER = WT_GM + (size_t)4 * 128 * 128;

constexpr int LDS_STAGE = 131072;
constexpr int LDS_MISC = LDS_STAGE;
constexpr int LDS_BYTES = 147456;

constexpr int CW_BAR = 0;
constexpr int CW_HG = 7168;
constexpr int CW_CNT = 4096;
constexpr size_t CTL_BYTES = 65536;

struct P {
    const float* x; const float* w_in; const float* gm_v_gain; const float* gm_v_bias; const float* gm_w_s;
    const float* gm_b_s; const float* cmp_pos; const float* cmp_w1; const float* cmp_w2; const float* nsa_gate_b;
    const float* hg_lower; const float* out_gain; const float* w_out; const float* ln1_g; const float* ln1_b;
    const float* rg_w; const float* rg_b; const float* re_w; const float* re_b; const float* w_gate;
    const float* w_up; const float* w_down; const float* ln2_g; const float* ln2_b;
    float* out;
    unsigned* ctl;
    bf16_t* WT;
    bf16_t* H;
    bf16_t* Y;
    bf16_t* XB;
    bf16_t* kcb;
    bf16_t* vcT;
    bf16_t* vsT;
    bf16_t* vwT;
    bf16_t* gb;
    float* cbias;
    float* wrt;
    int* list_tok;
    float* list_w;
    int* tok_slot;
    float* hgU; float* hgG; float* hgS; bf16_t* hgQB; bf16_t* hgO;
    int nph; int pad;
};


struct KA { const __attribute__((address_space(4))) char* p; int wv; };
template <class T> __device__ __forceinline__ T ldarg(KA ka, size_t off) { return *(const __attribute__((address_space(4))) T*)(ka.p + off); }
#define PF(f) ldarg<decltype(P::f)>(ka, offsetof(P, f))

__device__ __forceinline__ float bf2f(bf16_t u) { return __uint_as_float(((unsigned)u) << 16); }
typedef __bf16 bf16x2_t __attribute__((ext_vector_type(2)));
__device__ __forceinline__ unsigned pk2(float lo, float hi) { f32x2 v; v.x = lo; v.y = hi; return __builtin_bit_cast(unsigned, __builtin_convertvector(v, bf16x2_t)); }
__device__ __forceinline__ bf16_t f2bf(float f) { return (bf16_t)(pk2(f, 0.f) & 0xffffu); }
__device__ __forceinline__ float gelu_t(float x) {
    const float u2 = -2.f * 0.7978845608028654f * (x + 0.044715f * x * x * x);
    return x * __builtin_amdgcn_rcpf(1.f + __expf(u2));
}
__device__ __forceinline__ float gelu_slow(float x) {
    float u = 0.7978845608028654f * (x + 0.044715f * x * x * x);
    return 0.5f * x * (1.f + tanhf(u));
}
__device__ __forceinline__ float sigmoidf_(float x) { return __builtin_amdgcn_rcpf(1.f + __expf(-x)); }
__device__ __forceinline__ float wave_max(float v) {
#pragma unroll
    for (int o = 32; o > 0; o >>= 1) v = fmaxf(v, __shfl_xor(v, o));
    return v;
}
__device__ __forceinline__ float wave_sum(float v) {
#pragma unroll
    for (int o = 32; o > 0; o >>= 1) v += __shfl_xor(v, o);
    return v;
}
__device__ __forceinline__ void wave_sync() {
    __builtin_amdgcn_fence(__ATOMIC_RELEASE, "wavefront");
    __builtin_amdgcn_wave_barrier();
    __builtin_amdgcn_fence(__ATOMIC_ACQUIRE, "wavefront");
}
__device__ __forceinline__ f32x4 zero4() { f32x4 z = {0.f, 0.f, 0.f, 0.f}; asm volatile("" : "+v"(z)); return z; }
__device__ __forceinline__ int opaque_tid(int wv) {
    int t = wv * 64 + (int)__builtin_amdgcn_mbcnt_hi(~0u, __builtin_amdgcn_mbcnt_lo(~0u, 0u));
    asm volatile("" : "+v"(t));
    return t;
}
__device__ __forceinline__ int opaque_bid() { int b = blockIdx.x; asm volatile("" : "+s"(b)); return b; }
#define PHASE_IDS const int TID = opaque_tid(ka.wv); const int BID = opaque_bid(); (void)TID; (void)BID;
__device__ __forceinline__ int queue_fetch(KA ka, unsigned* head, LAS unsigned char* lds) {
    volatile LAS int* slot = (volatile LAS int*)(lds + LDS_MISC + 48);
    if (opaque_tid(ka.wv) == 0) *slot = (int)__hip_atomic_fetch_add(head, 1u, __ATOMIC_RELAXED, __HIP_MEMORY_SCOPE_AGENT);
    __syncthreads();
    const int v = *slot;
    __syncthreads();
    return __builtin_amdgcn_readfirstlane(v);
}

#define XB_TMO      128
#define XB_XCNT(j)  (256  + 64 * (j))
#define XB_XSUB(j)  (1280 + 64 * (j))
#define XB_XGEN(j)  (2304 + 64 * (j))
#define XB_TOP      3328
#define XB_TOPGEN   3392
#define XCD_BAR_WORDS 3456
#define XB_SPIN_CAP (1u << 22)
__device__ __forceinline__ unsigned xb_ld(unsigned* p)              { return __hip_atomic_load(p, __ATOMIC_RELAXED, __HIP_MEMORY_SCOPE_AGENT); }
__device__ __forceinline__ unsigned xb_add(unsigned* p, unsigned v) { return __hip_atomic_fetch_add(p, v, __ATOMIC_RELAXED, __HIP_MEMORY_SCOPE_AGENT); }
__device__ __forceinline__ unsigned xb_xcc_id() { return (unsigned)__builtin_amdgcn_s_getreg((3 << 11) | 20) & 0xFu; }
#define XB_SPIN(cond, bar) do { unsigned _sp = 0; while (cond) { __builtin_amdgcn_s_sleep(1); \
    if ((++_sp & 255u) == 0u) { if (xb_ld(&(bar)[XB_TMO])) break; if (_sp > XB_SPIN_CAP) { atomicAdd(&(bar)[XB_TMO], 1u); break; } } } } while (0)
struct XcdBarrier { unsigned* bar; unsigned x; volatile LAS unsigned* st; int wv; };
__device__ __forceinline__ XcdBarrier xcd_barrier_post(unsigned* bar, volatile LAS unsigned* st) {
    XcdBarrier b; b.bar = bar; b.x = xb_xcc_id(); b.st = st;
    if (threadIdx.x == 0) (void)xb_add(&bar[XB_XCNT(b.x)], 1u);
    return b;
}
__device__ __forceinline__ void xcd_barrier_complete(unsigned* bar, unsigned x, unsigned& nloc, unsigned& nx) {
    const unsigned G = gridDim.x * gridDim.y * gridDim.z;
    unsigned sum, cnt, mine, sp = 0u;
    for (;;) {
        sum = 0u; cnt = 0u; mine = 0u;
#pragma unroll
        for (unsigned j = 0; j < 16; ++j) { const unsigned c = xb_ld(&bar[XB_XCNT(j)]); sum += c; cnt += (c > 0u) ? 1u : 0u; mine = (j == x) ? c : mine; }
        if (sum == G) break;
        __builtin_amdgcn_s_sleep(1);
        if ((++sp & 255u) == 0u) { if (xb_ld(&bar[XB_TMO])) break; if (sp > XB_SPIN_CAP) { atomicAdd(&bar[XB_TMO], 1u); break; } }
    }
    nloc = mine > 0u ? mine : 1u; nx = cnt > 0u ? cnt : 1u;
}
__device__ __forceinline__ void xcd_barrier(const XcdBarrier& b) {
    asm volatile("s_waitcnt vmcnt(0)" ::: "memory");
    __syncthreads();
    if (opaque_tid(b.wv) == 0) {
        unsigned* bar = b.bar;
        __builtin_amdgcn_s_waitcnt(0);
        unsigned nloc = b.st[0], nx = b.st[1];
        if (nloc == 0u) { xcd_barrier_complete(bar, b.x, nloc, nx); b.st[0] = nloc; b.st[1] = nx; }
        const unsigned old = xb_add(&bar[XB_XSUB(b.x)], 1u);
        const unsigned gen = old / nloc;
        if (old + 1u == (gen + 1u) * nloc) {
            __builtin_amdgcn_fence(__ATOMIC_RELEASE, "agent");
            asm volatile("s_waitcnt vmcnt(0)" ::: "memory");
            const unsigned og = xb_add(&bar[XB_TOP], 1u);
            const unsigned tg = og / nx;
            if (og + 1u != (tg + 1u) * nx) XB_SPIN(xb_ld(&bar[XB_TOP]) < (tg + 1u) * nx, bar);
            __builtin_amdgcn_fence(__ATOMIC_ACQUIRE, "agent");
            xb_add(&bar[XB_XGEN(b.x)], 1u);
            asm volatile("s_waitcnt vmcnt(0)" ::: "memory");
        } else {
            XB_SPIN(xb_ld(&bar[XB_XGEN(b.x)]) == gen, bar);
            __builtin_amdgcn_fence(__ATOMIC_ACQUIRE, "agent");
            asm volatile("s_waitcnt vmcnt(0)" ::: "memory");
        }
    }
    __syncthreads();
}

namespace pg8 {
constexpr int BM = 256, BK = 64, HALF = 128, HTB = HALF * BK * 2, STAGE_BYTES = 8 * HTB;
__host__ __device__ __forceinline__ int lds_byte(int r, int c) { const int st = (r >> 4) * 2 + (c >> 5), rr = r & 15, cc = c & 31, ob = rr * 64 + cc * 2; return st * 1024 + (ob ^ (((ob >> 9) & 1) << 5)); }
__host__ __device__ __forceinline__ void stage_rc(int b, int& R, int& C) { const int st = b / 1024, sb = b % 1024, swz = sb ^ (((sb >> 9) & 1) << 5); R = (st >> 1) * 16 + swz / 64; C = (st & 1) * 32 + (swz % 64) / 2; }
__host__ __device__ __forceinline__ int perm32(int rho) { const int n = rho >> 4, i = rho & 15; return 8 * (i >> 2) + 4 * n + (i & 3); }
__device__ __forceinline__ unsigned cvt_pk_bf16(float lo, float hi) { return pk2(lo, hi); }

struct Unit {
    const char* bptr;
    int arow0;
    int nrows;
    int pm, pn, e, ui;
};

template <class Epi, class Sched>
__device__ __forceinline__ void gemm_phase(LAS unsigned char* lds, const char* Abase, const int K, const Sched& S, const Epi& E, const int wv) {
    const int tid = opaque_tid(wv), wid = __builtin_amdgcn_readfirstlane(tid >> 6), lane = tid & 63, wr = wid >> 2, wc = wid & 3, fr = lane & 15, fq = lane >> 4;
    const int nt = K / BK;
    int R0, C0, R1, C1; stage_rc(tid * 16, R0, C0); stage_rc(tid * 16 + 8192, R1, C1);
    unsigned voffB[2];
    { const int Rb0 = Epi::PERM ? ((R0 & ~31) + perm32(R0 & 31)) : R0, Rb1 = Epi::PERM ? ((R1 & ~31) + perm32(R1 & 31)) : R1;
      voffB[0] = (unsigned)(Rb0 * K + C0) * 2u; voffB[1] = (unsigned)(Rb1 * K + C1) * 2u; }
    const unsigned cA0 = (unsigned)C0 * 2u, cA1 = (unsigned)C1 * 2u;
    const int lda = S.lda(K);
    const unsigned kstepA = S.kstepA();
    const unsigned voffA0 = (unsigned)(R0 * lda + C0) * 2u, voffA1 = (unsigned)(R1 * lda + C1) * 2u;
    const unsigned kstep = (unsigned)(BK * 2);
    const unsigned hstep = (unsigned)(HALF * K * 2);
    const unsigned ldsw = (unsigned)wid * 1024u;
    const int aoff = lds_byte(wr * 64 + fr, fq * 8), boff = lds_byte(wc * 32 + fr, fq * 8);
#define PG8_SA(b, h) (((b) * 2 + (h)) * HTB)
#define PG8_SB(b, h) ((4 + (b) * 2 + (h)) * HTB)
#define PG8_STAGE_B(bufoff, gbase) do { \
        __builtin_amdgcn_global_load_lds((const unsigned*)((const char*)(gbase) + voffB[0]), (LAS unsigned*)(lds + (bufoff) + ldsw), 16, 0, 0); \
        __builtin_amdgcn_global_load_lds((const unsigned*)((const char*)(gbase) + voffB[1]), (LAS unsigned*)(lds + (bufoff) + ldsw + 8192), 16, 0, 0); } while (0)
#define PG8_STAGE_A(bufoff, gbase, pk) do { \
        const unsigned o0_ = Sched::GATHER ? (((pk) & 0xffffu) * (unsigned)lda * 2u + cA0) : voffA0; \
        const unsigned o1_ = Sched::GATHER ? (((pk) >> 16) * (unsigned)lda * 2u + cA1) : voffA1; \
        __builtin_amdgcn_global_load_lds((const unsigned*)((const char*)(gbase) + o0_), (LAS unsigned*)(lds + (bufoff) + ldsw), 16, 0, 0); \
        __builtin_amdgcn_global_load_lds((const unsigned*)((const char*)(gbase) + o1_), (LAS unsigned*)(lds + (bufoff) + ldsw + 8192), 16, 0, 0); } while (0)
#define PG8_LDA(dst, b, h) do { _Pragma("unroll") for (int m = 0; m < 4; ++m) _Pragma("unroll") for (int k = 0; k < 2; ++k) dst[m][k] = *(const LAS bf16x8*)(lds + PG8_SA(b, h) + aoff + m * 2048 + k * 1024); } while (0)
#define PG8_LDB(dst, b, h) do { _Pragma("unroll") for (int n = 0; n < 2; ++n) _Pragma("unroll") for (int k = 0; k < 2; ++k) dst[n][k] = *(const LAS bf16x8*)(lds + PG8_SB(b, h) + boff + n * 2048 + k * 1024); } while (0)
#define PG8_MMA(ai, bj, At, Bt) do { __builtin_amdgcn_s_setprio(1); _Pragma("unroll") for (int m = 0; m < 4; ++m) _Pragma("unroll") for (int n = 0; n < 2; ++n) _Pragma("unroll") for (int k = 0; k < 2; ++k) \
        acc[ai][bj][m][n] = __builtin_amdgcn_mfma_f32_16x16x32_bf16(Bt[n][k], At[m][k], acc[ai][bj][m][n], 0, 0, 0); __builtin_amdgcn_s_setprio(0); } while (0)
#define PG8_WAIT_V(n) asm volatile("s_waitcnt vmcnt(" #n ")" ::: "memory")
#define PG8_WAIT_L(n) asm volatile("s_waitcnt lgkmcnt(" #n ")" ::: "memory")
#define PG8_BAR __builtin_amdgcn_s_barrier()
#define PG8_SCHED __builtin_amdgcn_sched_barrier(0)
#define PG8_PACK(u, h) ((unsigned)S.arow((u), ((h) * 128 + R0) < (u).nrows ? ((h) * 128 + R0) : (u).nrows - 1) | ((unsigned)S.arow((u), ((h) * 128 + R1) < (u).nrows ? ((h) * 128 + R1) : (u).nrows - 1) << 16))
    Unit cur, nxt; int ui = 0;
    if (!S.next(0, cur)) return;
    f32x4 acc[2][2][4][2];
    const f32x4 zv = zero4();
#pragma unroll
    for (int a = 0; a < 2; ++a)
#pragma unroll
        for (int b = 0; b < 2; ++b)
#pragma unroll
            for (int m = 0; m < 4; ++m)
#pragma unroll
                for (int n = 0; n < 2; ++n) acc[a][b][m][n] = zv;
    bf16x8 At[4][2], B0[2][2], B1[2][2];
    unsigned pC0 = 0u, pC1 = 0u, pN0 = 0u, pN1 = 0u;
    if (Sched::GATHER) { pC0 = PG8_PACK(cur, 0); pC1 = PG8_PACK(cur, 1); }
    const char* cB = cur.bptr;
    const char* cA = Sched::GATHER ? Abase : S.abase(cur, Abase) + (size_t)cur.arow0 * lda * 2;
    const unsigned hA = Sched::GATHER ? 0u : (unsigned)(HALF * lda * 2);
    PG8_STAGE_B(PG8_SB(0, 0), cB); PG8_STAGE_B(PG8_SB(0, 1), cB + hstep); PG8_STAGE_A(PG8_SA(0, 0), cA, pC0); PG8_STAGE_A(PG8_SA(0, 1), cA + hA, pC1);
    if (wr == 1) PG8_BAR;
    PG8_WAIT_V(2); PG8_BAR;
    PG8_STAGE_B(PG8_SB(1, 0), cB + kstep); PG8_STAGE_A(PG8_SA(1, 0), cA + kstepA, pC0); PG8_STAGE_B(PG8_SB(1, 1), cB + hstep + kstep);
    PG8_WAIT_V(6); PG8_BAR;
    for (;;) {
        const bool has_next = S.next(ui + 1, nxt);
        if (Sched::GATHER) { if (has_next) { pN0 = PG8_PACK(nxt, 0); pN1 = PG8_PACK(nxt, 1); } else { pN0 = pC0; pN1 = pC1; } }
        const char* nB = has_next ? nxt.bptr : cB;
        const char* nA = (Sched::GATHER || !has_next) ? cA : S.abase(nxt, Abase) + (size_t)nxt.arow0 * lda * 2;
        for (int t = 0; t < nt; t += 2) {
            const bool last = (t == nt - 2);
            const char* a1 = cA + (unsigned)(t + 1) * kstepA;
            const char* a2 = last ? nA : cA + (unsigned)(t + 2) * kstepA; const char* b2 = last ? nB : cB + (unsigned)(t + 2) * kstep;
            const char* a3 = a2 + kstepA; const char* b3 = b2 + kstep;
            const unsigned s0 = last ? pN0 : pC0, s1 = last ? pN1 : pC1;
            PG8_LDB(B0, 0, 0); PG8_LDB(B1, 0, 1); PG8_SCHED; PG8_LDA(At, 0, 0); PG8_STAGE_A(PG8_SA(1, 1), a1 + hA, pC1);
            PG8_WAIT_V(8); PG8_WAIT_L(0); PG8_BAR; PG8_MMA(0, 0, At, B0); PG8_MMA(0, 1, At, B1); PG8_BAR; PG8_SCHED;
            PG8_LDA(At, 0, 1); PG8_STAGE_B(PG8_SB(0, 0), b2); PG8_STAGE_B(PG8_SB(0, 1), b2 + hstep); PG8_STAGE_A(PG8_SA(0, 0), a2, s0);
            PG8_WAIT_V(8); PG8_WAIT_L(0); PG8_BAR; PG8_MMA(1, 0, At, B0); PG8_MMA(1, 1, At, B1); PG8_BAR; PG8_SCHED;
            PG8_LDB(B0, 1, 0); PG8_LDB(B1, 1, 1); PG8_SCHED; PG8_LDA(At, 1, 0); PG8_STAGE_A(PG8_SA(0, 1), a2 + hA, s1);
            PG8_WAIT_V(8); PG8_WAIT_L(0); PG8_BAR; PG8_MMA(0, 0, At, B0); PG8_MMA(0, 1, At, B1); PG8_BAR; PG8_SCHED;
            PG8_LDA(At, 1, 1); PG8_STAGE_B(PG8_SB(1, 0), b3); PG8_STAGE_B(PG8_SB(1, 1), b3 + hstep); PG8_STAGE_A(PG8_SA(1, 0), a3, s0);
            PG8_WAIT_V(8); PG8_WAIT_L(0); PG8_BAR; PG8_MMA(1, 0, At, B0); PG8_MMA(1, 1, At, B1); PG8_BAR; PG8_SCHED;
        }
        if (wr == 0) PG8_BAR;
        E(acc, cur, wr, wc, fr, fq);
        if (!has_next) break;
#pragma unroll
        for (int a = 0; a < 2; ++a)
#pragma unroll
            for (int b = 0; b < 2; ++b)
#pragma unroll
                for (int m = 0; m < 4; ++m)
#pragma unroll
                    for (int n = 0; n < 2; ++n) acc[a][b][m][n] = zv;
        cur = nxt; cB = nB; cA = nA; ++ui;
        pC0 = pN0; pC1 = pN1;
        if (wr == 1) PG8_BAR;
    }
    PG8_WAIT_V(0);
    PG8_BAR;
#undef PG8_SA
#undef PG8_SB
#undef PG8_STAGE_A
#undef PG8_STAGE_B
#undef PG8_LDA
#undef PG8_LDB
#undef PG8_MMA
#undef PG8_WAIT_V
#undef PG8_WAIT_L
#undef PG8_BAR
#undef PG8_SCHED
#undef PG8_PACK
}

struct DenseOrder {
    static constexpr bool GATHER = false;
    int nM, nN, nwg, G, c; const char* Bt; int K;
    __device__ void init(int M, int N, int K_, const bf16_t* Bt_, int G_, int c_) { nM = M / BM; nN = N / BM; nwg = nM * nN; G = G_; c = c_; Bt = (const char*)Bt_; K = K_; }
    __device__ __forceinline__ bool next(int i, Unit& u) const {
        const long L = (long)i * G + c; if (L >= nwg) return false;
        int wgid = (int)L; { const int q = nwg / 8, r = nwg % 8, xcd = wgid % 8, off = wgid / 8; wgid = (xcd < r ? xcd * (q + 1) : r * (q + 1) + (xcd - r) * q) + off; }
        const int nig = 8 * nN, gid = wgid / nig, fm = gid * 8, gsz = (nM - fm) < 8 ? (nM - fm) : 8;
        u.pm = fm + ((wgid % nig) % gsz); u.pn = (wgid % nig) / gsz;
        u.arow0 = u.pm * BM; u.nrows = BM; u.e = 0; u.ui = i;
        u.bptr = Bt + (size_t)u.pn * BM * K * 2;
        return true;
    }
    __device__ __forceinline__ int arow(const Unit& u, int r) const { return u.arow0 + r; }
    __device__ __forceinline__ int lda(int K_) const { return K_; }
    __device__ __forceinline__ unsigned kstepA() const { return 128u; }
    __device__ __forceinline__ const char* abase(const Unit&, const char* A) const { return A; }
};
}

struct EpiH {
    static constexpr bool PERM = true;
    bf16_t* H;
    __device__ __forceinline__ void operator()(const f32x4 (&acc)[2][2][4][2], const pg8::Unit& u, int wr, int wc, int fr, int fq) const {
        const int row0 = u.arow0 + wr * 64 + fr, col0 = u.pn * 256 + wc * 32 + 8 * fq;
#pragma unroll
        for (int ai = 0; ai < 2; ++ai)
#pragma unroll
            for (int m = 0; m < 4; ++m) {
                bf16_t* rowp = H + (size_t)(row0 + ai * 128 + m * 16) * HLD + col0;
#pragma unroll
                for (int bj = 0; bj < 2; ++bj) {
                    const f32x4 v0 = acc[ai][bj][m][0], v1 = acc[ai][bj][m][1];
                    u32x4 w; w.x = pg8::cvt_pk_bf16(v0[0], v0[1]); w.y = pg8::cvt_pk_bf16(v0[2], v0[3]); w.z = pg8::cvt_pk_bf16(v1[0], v1[1]); w.w = pg8::cvt_pk_bf16(v1[2], v1[3]);
                    *(u32x4*)(rowp + bj * 128) = w;
                }
            }
    }
};
struct EpiRes {
    static constexpr bool PERM = false;
    const float* xin; bf16_t* out; int layer;
    __device__ __forceinline__ void operator()(const f32x4 (&acc)[2][2][4][2], const pg8::Unit& u, int wr, int wc, int fr, int fq) const {
        const int row0 = u.arow0 + wr * 64 + fr, col0 = u.pn * 256 + wc * 32 + 4 * fq;
#pragma unroll
        for (int ai = 0; ai < 2; ++ai)
#pragma unroll
            for (int m = 0; m < 4; ++m) {
                const size_t off = (size_t)(row0 + ai * 128 + m * 16) * DM + col0;
#pragma unroll
                for (int bj = 0; bj < 2; ++bj)
#pragma unroll
                    for (int n = 0; n < 2; ++n) {
                        f32x4 xv;
                        if (layer == 0) xv = *(const f32x4*)(xin + off + bj * 128 + n * 16);
                        else { const u32x2 xw = *(const u32x2*)(out + off + bj * 128 + n * 16); xv[0] = __uint_as_float(xw.x << 16); xv[1] = __uint_as_float(xw.x & 0xffff0000u); xv[2] = __uint_as_float(xw.y << 16); xv[3] = __uint_as_float(xw.y & 0xffff0000u); }
                        const f32x4 r = xv * ALPHA + acc[ai][bj][m][n];
                        u32x2 pw; pw.x = pk2(r[0], r[1]); pw.y = pk2(r[2], r[3]);
                        *(u32x2*)(out + off + bj * 128 + n * 16) = pw;
                    }
            }
    }
};

template <class RM>
__device__ __forceinline__ void transpose_item(const float* W, int K, int N, bf16_t* WT, RM rowmap, float* scr, int kb, int nb, int lane) {
    const int k0 = 64 * kb, n0 = 32 * nb;
    const int nn = n0 + (lane & 31);
    float tmp[32];
#pragma unroll
    for (int i = 0; i < 32; ++i) {
        const int kk = 2 * i + (lane >> 5);
        tmp[i] = nn < N ? W[(size_t)(k0 + kk) * N + nn] : 0.f;
    }
#pragma unroll
    for (int i = 0; i < 32; ++i) {
        const int kk = 2 * i + (lane >> 5);
        scr[kk * 33 + (lane & 31)] = tmp[i];
    }
    wave_sync();
    const int c = lane & 7;
#pragma unroll
    for (int j = 0; j < 4; ++j) {
        const int n = (lane >> 3) + 8 * j;
        const float* s = scr + (8 * c) * 33 + n;
        u32x4 o; o.x = pk2(s[0 * 33], s[1 * 33]); o.y = pk2(s[2 * 33], s[3 * 33]); o.z = pk2(s[4 * 33], s[5 * 33]); o.w = pk2(s[6 * 33], s[7 * 33]);
        const int dr = (n0 + n < N) ? rowmap(n0 + n) : -1;
        if (dr >= 0) *(u32x4*)(WT + (size_t)dr * K + k0 + 8 * c) = o;
    }
    wave_sync();
}

__device__ void phase_prologue(KA ka, int layer, float* smem) {
    PHASE_IDS
    const int lane = TID & 63, w = TID >> 6;
    float* scr = smem + w * 4096;
    const int gw = BID * NW + w, NGW = gridDim.x * NW;
    constexpr int I_IN = 16 * 89, I_OUT = 16 * 32, I_GU = 16 * 16, I_DN = 8 * 32;
    constexpr int I_LAYER = I_IN + I_OUT + 32 * I_GU + 16 * I_DN;
    for (int it = gw; it < I_LAYER; it += NGW) {
        int r = it;
        bf16_t* WT = PF(WT);
        if (r < I_IN) {
            transpose_item(PF(w_in) + (size_t)layer * DM * IC_SRC, DM, IC_SRC, WT + WT_IN,
                           [](int n) { return n < 1792 ? n : (n < 1816 ? 2816 + (n - 1792) : n - 24); }, scr, r / 89, r % 89, lane);
            continue;
        }
        r -= I_IN;
        if (r < I_OUT) {
            transpose_item(PF(w_out) + (size_t)layer * DM * DM, DM, DM, WT + WT_OUT, [](int n) { return n; }, scr, r / 32, r % 32, lane);
            continue;
        }
        r -= I_OUT;
        if (r < 32 * I_GU) {
            const int mat = r / I_GU, rr = r % I_GU, e = mat >> 1, isup = mat & 1;
            const float* W = (isup ? PF(w_up) : PF(w_gate)) + ((size_t)layer * 16 + e) * DM * 512;
            transpose_item(W, DM, 512, WT + WT_UP + (size_t)e * 1024 * 1024,
                           [isup](int n) { return (n >> 7) * 256 + isup * 128 + (n & 127); }, scr, rr / 16, rr % 16, lane);
            continue;
        }
        r -= 32 * I_GU;
        {
            const int e = r / I_DN, rr = r % I_DN;
            transpose_item(PF(w_down) + ((size_t)layer * 16 + e) * 512 * DM, 512, DM, WT + WT_DN + (size_t)e * 1024 * 512,
                           [](int n) { return n; }, scr, rr / 32, rr % 32, lane);
        }
    }
    for (int it = gw; it < 2 * 32 * 4; it += NGW) {
        const int which = it >> 7, rr = it & 127;
        transpose_item(PF(cmp_w1) + ((size_t)layer * 2 + which) * 2048 * 128, 2048, 128, PF(WT) + WT_C1 + (size_t)which * 256 * 2048, [](int n) { return n; }, scr, rr >> 2, rr & 3, lane);
    }
    for (int i = BID * NTHR + TID; i < 2 * 128 * 256; i += gridDim.x * NTHR) {
        const int which = i >> 15, q = i & 32767;
        const u32x4 z = __builtin_bit_cast(u32x4, zero4());
        *(u32x4*)(PF(WT) + WT_C1 + (size_t)which * 256 * 2048 + (size_t)128 * 2048 + (size_t)q * 8) = z;
    }
    for (int o = gw; o < 256; o += NGW) {
        const int which = o >> 7, cc = o & 127;
        const float* w1 = PF(cmp_w1) + ((size_t)layer * 2 + which) * 2048 * 128;
        const float* pos = PF(cmp_pos) + ((size_t)layer * 2 + which) * 2048;
        float a = 0.f;
        for (int k = lane; k < 2048; k += 64) a = fmaf(pos[k], w1[(size_t)k * 128 + cc], a);
        a = wave_sum(a);
        if (lane == 0) (PF(cbias) + layer * (256))[o] = a;
    }
    for (int i = BID * NTHR + TID; i < 4 * 128 * 128; i += gridDim.x * NTHR) {
        const int s = i & 127, t = (i >> 7) & 127;
        PF(WT)[WT_GM + i] = (s <= t) ? f2bf(PF(gm_w_s)[(size_t)layer * 4 * 128 * 128 + i]) : (bf16_t)0;
    }
    for (int i = BID * NTHR + TID; i < 20 * 1024; i += gridDim.x * NTHR) {
        const int o = i >> 10, cc = i & 1023;
        (PF(wrt) + layer * (20480))[i] = o < 4 ? PF(rg_w)[((size_t)layer * 1024 + cc) * 4 + o] : PF(re_w)[((size_t)layer * 1024 + cc) * 16 + (o - 4)];
    }
    for (int i = BID * NTHR + TID; i < 232 * 128; i += gridDim.x * NTHR) {
        const int q = i;
        const u32x4 z = __builtin_bit_cast(u32x4, zero4());
        *(u32x4*)(PF(WT) + WT_IN + (size_t)2840 * 1024 + (size_t)q * 8) = z;
    }
    if (layer == 0)
    for (int row = gw; row < NTOK; row += 2 * NGW) {
        const int rowb = row + NGW < NTOK ? row + NGW : row;
        const f32x4* xr = (const f32x4*)(PF(x) + (size_t)row * DM) + lane;
        const f32x4* xs = (const f32x4*)(PF(x) + (size_t)rowb * DM) + lane;
        f32x4 va[4], vb[4];
#pragma unroll
        for (int j = 0; j < 4; ++j) { va[j] = xr[64 * j]; vb[j] = xs[64 * j]; }
        u32x2* o = (u32x2*)(PF(XB) + (size_t)row * DM) + lane;
        u32x2* ob = (u32x2*)(PF(XB) + (size_t)rowb * DM) + lane;
#pragma unroll
        for (int j = 0; j < 4; ++j) {
            u32x2 ww; ww.x = pk2(va[j][0], va[j][1]); ww.y = pk2(va[j][2], va[j][3]);
            o[64 * j] = ww;
            u32x2 wz; wz.x = pk2(vb[j][0], vb[j][1]); wz.y = pk2(vb[j][2], vb[j][3]);
            ob[64 * j] = wz;
        }
    }
}

template <class AF, class BF, class EF>
__device__ __forceinline__ void gemm128(int tid, int m0, int n0, int M, int N, int K, AF af, BF bf, EF ef, float* smem) {
    float* As = smem;
    float* Bs = smem + 16 * 132;
    const bool active = tid < 256;
    const int tx = tid & 15, ty = (tid >> 4) & 15;
    float acc[8][8];
#pragma unroll
    for (int i = 0; i < 8; i++)
#pragma unroll
        for (int j = 0; j < 8; j++) acc[i][j] = 0.f;
#pragma unroll 1
    for (int k0 = 0; k0 < K; k0 += 16) {
        if (active) {
#pragma unroll
            for (int i = 0; i < 8; i++) {
                int e = tid + i * 256;
                int r = e >> 4, kk = e & 15;
                float v = 0.f;
                if (m0 + r < M) v = af(m0 + r, k0 + kk);
                As[kk * 132 + r] = v;
            }
#pragma unroll
            for (int i = 0; i < 8; i++) {
                int e = tid + i * 256;
                int kk = e >> 7, c = e & 127;
                float v = 0.f;
                if (n0 + c < N) v = bf(k0 + kk, n0 + c);
                Bs[kk * 132 + c] = v;
            }
        }
        __syncthreads();
        if (active) {
#pragma unroll 2
            for (int kk = 0; kk < 16; kk++) {
                asm volatile("" ::: "memory");
                float4 a0 = *(const float4*)&As[kk * 132 + ty * 8];
                float4 a1 = *(const float4*)&As[kk * 132 + ty * 8 + 4];
                float4 b0 = *(const float4*)&Bs[kk * 132 + tx * 8];
                float4 b1 = *(const float4*)&Bs[kk * 132 + tx * 8 + 4];
                float a[8] = {a0.x, a0.y, a0.z, a0.w, a1.x, a1.y, a1.z, a1.w};
                float b[8] = {b0.x, b0.y, b0.z, b0.w, b1.x, b1.y, b1.z, b1.w};
#pragma unroll
                for (int i = 0; i < 8; i++)
#pragma unroll
                    for (int j = 0; j < 8; j++) acc[i][j] = fmaf(a[i], b[j], acc[i][j]);
            }
        }
        __syncthreads();
    }
    if (active) {
#pragma unroll
        for (int i = 0; i < 8; i++)
#pragma unroll
            for (int j = 0; j < 8; j++) {
                int m = m0 + ty * 8 + i, n = n0 + tx * 8 + j;
                if (m < M && n < N) ef(m, n, acc[i][j]);
            }
    }
}

__device__ __forceinline__ void phase_inproj(KA ka, int layer, LAS unsigned char* lds) {
    pg8::DenseOrder S; S.init(NTOK, HLD, DM, PF(WT) + WT_IN, gridDim.x, opaque_bid());
    EpiH E{PF(H)};
    pg8::gemm_phase<EpiH, pg8::DenseOrder>(lds, (const char*)PF(XB), DM, S, E, ka.wv);
}
__device__ __forceinline__ void phase_outproj(KA ka, int layer, const float* xin, float* x1, LAS unsigned char* lds) {
    pg8::DenseOrder S; S.init(NTOK, DM, DM, PF(WT) + WT_OUT, gridDim.x, opaque_bid());
    EpiRes E{xin, PF(XB), layer}; (void)x1;
    pg8::gemm_phase<EpiRes, pg8::DenseOrder>(lds, (const char*)PF(Y), DM, S, E, ka.wv);
}

__device__ void phase_ln1_route(KA ka, int layer, float* x1, float* smem, bool dry) {
    PHASE_IDS
    bf16_t* xb = PF(XB);
    (void)x1;
    const int lane = TID & 63, w = TID >> 6;
    const float* g = PF(ln1_g) + layer * 1024;
    const float* bb = PF(ln1_b) + layer * 1024;
    const float* wg = PF(rg_w) + (size_t)layer * 1024 * 4;
    const float* we = PF(re_w) + (size_t)layer * 1024 * 16;
    const float* bg = PF(rg_b) + layer * 4;
    const float* be = PF(re_b) + layer * 16;
    int* cnt = (int*)(PF(ctl) + CW_CNT) + layer * 16 * 64 + (dry ? 2048 : 0);
    int* lcnt = (int*)(smem + 20 * 1024);
    int* rinfo = lcnt + 64;
    float* rwt = (float*)(rinfo + 4 * 128);
    if (TID < 32) lcnt[TID] = 0;
    float* WR = smem;
    float bgv[4], bev[16];
#pragma unroll
    for (int o = 0; o < 4; ++o) bgv[o] = bg[o];
#pragma unroll
    for (int o = 0; o < 16; ++o) bev[o] = be[o];
    f32x4 g1v[4], b1v[4];
#pragma unroll
    for (int j = 0; j < 4; ++j) { g1v[j] = *(const f32x4*)(g + 256 * j + 4 * lane); b1v[j] = *(const f32x4*)(bb + 256 * j + 4 * lane); }
    u32x2 xwn[4];
    if (BID * NW + w < NTOK) {
#pragma unroll
        for (int j = 0; j < 4; ++j) xwn[j] = *(const u32x2*)(xb + (size_t)(BID * NW + w) * DM + 256 * j + 4 * lane);
    }
    __syncthreads();
    {
        const float* wsrc = PF(wrt) + layer * (20480);
        f32x4 wt[10];
#pragma unroll
        for (int q = 0; q < 10; ++q) wt[q] = *(const f32x4*)(wsrc + 4 * (TID + q * NTHR));
#pragma unroll
        for (int q = 0; q < 10; ++q) *(f32x4*)(WR + 4 * (TID + q * NTHR)) = wt[q];
    }
    __syncthreads();
    int nloc = 0;
    for (int row = BID * NW + w; row < NTOK; row += gridDim.x * NW) {
        f32x4 v[4];
        float s = 0.f;
        u32x2 xwc[4];
#pragma unroll
        for (int j = 0; j < 4; ++j) xwc[j] = xwn[j];
        if (row + (int)gridDim.x * NW < NTOK) {
#pragma unroll
            for (int j = 0; j < 4; ++j) xwn[j] = *(const u32x2*)(xb + (size_t)(row + gridDim.x * NW) * DM + 256 * j + 4 * lane);
        }
#pragma unroll
        for (int j = 0; j < 4; ++j) {
            const u32x2 xw = xwc[j];
            v[j][0] = __uint_as_float(xw.x << 16); v[j][1] = __uint_as_float(xw.x & 0xffff0000u); v[j][2] = __uint_as_float(xw.y << 16); v[j][3] = __uint_as_float(xw.y & 0xffff0000u);
            s += (v[j][0] + v[j][1]) + (v[j][2] + v[j][3]);
        }
        const float mu = wave_sum(s) * (1.f / 1024.f);
        float q = 0.f;
#pragma unroll
        for (int j = 0; j < 4; ++j) { v[j] = v[j] - mu; q += (v[j][0] * v[j][0] + v[j][1] * v[j][1]) + (v[j][2] * v[j][2] + v[j][3] * v[j][3]); }
        const float rstd = rsqrtf(wave_sum(q) * (1.f / 1024.f) + 1e-5f);
#pragma unroll
        for (int j = 0; j < 4; ++j) {
            const int c = 256 * j + 4 * lane;
            v[j] = v[j] * rstd * g1v[j] + b1v[j];
            u32x2 pw; pw.x = pk2(v[j][0], v[j][1]); pw.y = pk2(v[j][2], v[j][3]);
            *(u32x2*)(xb + (size_t)row * DM + c) = pw;
        }
        float lg[4], le[16];
#pragma unroll
        for (int o = 0; o < 20; ++o) {
            asm volatile("" ::: "memory");
            float a = 0.f;
#pragma unroll
            for (int j = 0; j < 4; ++j) {
                const f32x4 w4 = *(const f32x4*)(WR + o * 1024 + 256 * j + 4 * lane);
                a += (v[j][0] * w4[0] + v[j][1] * w4[1]) + (v[j][2] * w4[2] + v[j][3] * w4[3]);
            }
            a = wave_sum(a);
            if (o < 4) lg[o] = a + bgv[o]; else le[o - 4] = a + bev[o - 4];
        }
        float gm = fmaxf(fmaxf(lg[0], lg[1]), fmaxf(lg[2], lg[3]));
        float ge[4], gs = 0.f;
#pragma unroll
        for (int c = 0; c < 4; c++) { ge[c] = __expf(lg[c] - gm); gs += ge[c]; }
        int gi = 0; float gbest = ge[0];
#pragma unroll
        for (int c = 1; c < 4; c++) if (ge[c] > gbest) { gbest = ge[c]; gi = c; }
        float gval = gbest / gs;
        float ls[4];
#pragma unroll
        for (int e = 0; e < 4; e++) ls[e] = gi == 0 ? le[e] : gi == 1 ? le[4 + e] : gi == 2 ? le[8 + e] : le[12 + e];
        float em = fmaxf(fmaxf(ls[0], ls[1]), fmaxf(ls[2], ls[3]));
        float pe[4];
#pragma unroll
        for (int e = 0; e < 4; e++) pe[e] = __expf(ls[e] - em);
        int i1 = 0; float b1 = pe[0];
#pragma unroll
        for (int e = 1; e < 4; e++) if (pe[e] > b1) { b1 = pe[e]; i1 = e; }
        int i2 = -1; float b2 = -1.f;
#pragma unroll
        for (int e = 0; e < 4; e++) if (e != i1 && pe[e] > b2) { b2 = pe[e]; i2 = e; }
        float w1 = gval * b1 / (b1 + b2), w2 = gval * b2 / (b1 + b2);
        if (lane == 0) {
            const int e1 = gi * 4 + i1, e2 = gi * 4 + i2;
            const int lr = nloc * NW + w;
            rinfo[lr * 4 + 0] = e1; rinfo[lr * 4 + 1] = atomicAdd(&lcnt[e1], 1);
            rinfo[lr * 4 + 2] = e2; rinfo[lr * 4 + 3] = atomicAdd(&lcnt[e2], 1);
            rwt[lr * 2 + 0] = w1; rwt[lr * 2 + 1] = w2;
        }
        ++nloc;
    }
    __syncthreads();
    if (TID < 16) lcnt[16 + TID] = lcnt[TID] > 0 ? atomicAdd(&cnt[TID * 64], lcnt[TID]) : 0;
    __syncthreads();
    {
        const int nrows_blk = (NTOK - BID * NW + (int)gridDim.x * NW - 1) / ((int)gridDim.x * NW) * NW;
        for (int lr = TID; lr < nrows_blk; lr += NTHR) {
            const int row = BID * NW + (lr % NW) + (lr / NW) * (int)gridDim.x * NW;
            if (row < NTOK) {
                const int e1 = rinfo[lr * 4 + 0], p1 = lcnt[16 + e1] + rinfo[lr * 4 + 1];
                const int e2 = rinfo[lr * 4 + 2], p2 = lcnt[16 + e2] + rinfo[lr * 4 + 3];
                (PF(list_tok) + layer * ((size_t)16 * NTOK))[e1 * NTOK + p1] = row; (PF(list_w) + layer * ((size_t)16 * NTOK))[e1 * NTOK + p1] = rwt[lr * 2 + 0];
                (PF(list_tok) + layer * ((size_t)16 * NTOK))[e2 * NTOK + p2] = row; (PF(list_w) + layer * ((size_t)16 * NTOK))[e2 * NTOK + p2] = rwt[lr * 2 + 1];
                (PF(tok_slot) + layer * ((size_t)NTOK * 2))[row * 2 + 0] = e1 * NTOK + p1; (PF(tok_slot) + layer * ((size_t)NTOK * 2))[row * 2 + 1] = e2 * NTOK + p2;
            }
        }
    }
    __syncthreads();
}


template <bool GATHER_>
struct MoeOrder {
    static constexpr bool GATHER = GATHER_;
    const LAS int* tab; const LAS int* rowtab;
    const char* Bt; unsigned estride; int K, G, c;
    __device__ __forceinline__ bool next(int i, pg8::Unit& u) const {
        const int nwg = __builtin_amdgcn_readfirstlane(tab[48]) * 4;
        const int L = i * G + c; if (L >= nwg) return false;
        int wgid = L; { const int q = nwg / 8, r = nwg % 8, xcd = wgid % 8, off = wgid / 8; wgid = (xcd < r ? xcd * (q + 1) : r * (q + 1) + (xcd - r) * q) + off; }
        const int mg = wgid >> 2, nt = wgid & 3;
        int e = 0;
#pragma unroll
        for (int k = 1; k < 16; ++k) e = (__builtin_amdgcn_readfirstlane(tab[32 + k]) <= mg) ? k : e;
        const int mt = mg - __builtin_amdgcn_readfirstlane(tab[32 + e]);
        const int rem = __builtin_amdgcn_readfirstlane(tab[e]) - mt * 256;
        u.e = e; u.pm = mt; u.pn = nt; u.ui = i; u.nrows = rem < 256 ? rem : 256; u.arow0 = __builtin_amdgcn_readfirstlane(tab[16 + e]) + mt * 256;
        u.bptr = Bt + (size_t)e * estride + (size_t)nt * 256 * K * 2;
        return true;
    }
    __device__ __forceinline__ int arow(const pg8::Unit& u, int r) const { return GATHER_ ? rowtab[u.ui * 256 + r] : u.arow0 + r; }
    __device__ __forceinline__ int lda(int K_) const { return K_; }
    __device__ __forceinline__ unsigned kstepA() const { return 128u; }
    __device__ __forceinline__ const char* abase(const pg8::Unit&, const char* A) const { return A; }
};
__device__ __forceinline__ void moe_tables(KA ka, int layer, LAS unsigned char* lds, bool want_rows, int G, int c) {
    LAS int* tab = (LAS int*)(lds + LDS_MISC + 256);
    LAS int* rowtab = (LAS int*)(lds + LDS_MISC + 1024);
    const int tid = opaque_tid(ka.wv);
    const int* cnt = (const int*)(PF(ctl) + CW_CNT) + layer * 16 * 64;
    if (tid < 16) tab[tid] = __hip_atomic_load(&cnt[tid * 64], __ATOMIC_RELAXED, __HIP_MEMORY_SCOPE_AGENT);
    __syncthreads();
    if (tid == 0) {
        int b = 0, m = 0;
        for (int e = 0; e < 16; ++e) { tab[16 + e] = b; tab[32 + e] = m; b += tab[e]; m += (tab[e] + 255) >> 8; }
        tab[48] = m;
    }
    __syncthreads();
    if (want_rows) {
        MoeOrder<true> S{tab, rowtab, nullptr, 0u, 1024, G, c};
        const int* lt = (PF(list_tok) + layer * ((size_t)16 * NTOK));
        for (int i = 0; i < 4; ++i) {
            pg8::Unit u;
            if (!S.next(i, u)) break;
            if (tid < 256) { const int r = tid < u.nrows ? tid : u.nrows - 1; rowtab[i * 256 + tid] = lt[u.e * NTOK + u.pm * 256 + r]; }
        }
        asm volatile("s_waitcnt vmcnt(0) lgkmcnt(0)" ::: "memory");
        __syncthreads();
    }
}
struct EpiUp {
    static constexpr bool PERM = true;
    bf16_t* hidden;
    __device__ __forceinline__ void operator()(const f32x4 (&acc)[2][2][4][2], const pg8::Unit& u, int wr, int wc, int fr, int fq) const {
#pragma unroll
        for (int ai = 0; ai < 2; ++ai)
#pragma unroll
            for (int m = 0; m < 4; ++m) {
                const int r = ai * 128 + wr * 64 + m * 16 + fr;
                if (r < u.nrows) {
                    bf16_t* rowp = hidden + (size_t)(u.arow0 + r) * 512 + u.pn * 128 + wc * 32 + 8 * fq;
                    float h[8];
#pragma unroll
                    for (int n = 0; n < 2; ++n)
#pragma unroll
                        for (int j = 0; j < 4; ++j) { const float g = acc[ai][0][m][n][j], uu = acc[ai][1][m][n][j]; h[n * 4 + j] = g * sigmoidf_(g) * uu; }
                    u32x4 w; w.x = pg8::cvt_pk_bf16(h[0], h[1]); w.y = pg8::cvt_pk_bf16(h[2], h[3]); w.z = pg8::cvt_pk_bf16(h[4], h[5]); w.w = pg8::cvt_pk_bf16(h[6], h[7]);
                    *(u32x4*)rowp = w;
                }
            }
    }
};
struct EpiDown {
    static constexpr bool PERM = true;
    bf16_t* Y2; const float* lw;
    __device__ __forceinline__ void operator()(const f32x4 (&acc)[2][2][4][2], const pg8::Unit& u, int wr, int wc, int fr, int fq) const {
#pragma unroll
        for (int ai = 0; ai < 2; ++ai) {
            float wg4[4];
#pragma unroll
            for (int q = 0; q < 4; ++q) { const int rq = ai * 128 + wr * 64 + q * 16 + fr; wg4[q] = lw[u.e * NTOK + u.pm * 256 + (rq < u.nrows ? rq : u.nrows - 1)]; }
#pragma unroll
            for (int m = 0; m < 4; ++m) {
                const int r = ai * 128 + wr * 64 + m * 16 + fr;
                if (r < u.nrows) {
                    const float wgt = wg4[m];
                    bf16_t* rowp = Y2 + (size_t)(u.arow0 + r) * DM + u.pn * 256 + wc * 32 + 8 * fq;
#pragma unroll
                    for (int bj = 0; bj < 2; ++bj) {
                        const f32x4 v0 = acc[ai][bj][m][0] * wgt, v1 = acc[ai][bj][m][1] * wgt;
                        u32x4 w; w.x = pg8::cvt_pk_bf16(v0[0], v0[1]); w.y = pg8::cvt_pk_bf16(v0[2], v0[3]); w.z = pg8::cvt_pk_bf16(v1[0], v1[1]); w.w = pg8::cvt_pk_bf16(v1[2], v1[3]);
                        *(u32x4*)(rowp + bj * 128) = w;
                    }
                }
            }
        }
    }
};
__device__ __forceinline__ void phase_moe_up(KA ka, int layer, LAS unsigned char* lds) {
    moe_tables(ka, layer, lds, true, gridDim.x, opaque_bid());
    MoeOrder<true> S{(const LAS int*)(lds + LDS_MISC + 256), (const LAS int*)(lds + LDS_MISC + 1024),
                     (const char*)(PF(WT) + WT_UP), (unsigned)(1024u * 1024u * 2u), 1024, (int)gridDim.x, opaque_bid()};
    EpiUp E{PF(Y)};
    pg8::gemm_phase<EpiUp, MoeOrder<true>>(lds, (const char*)PF(XB), 1024, S, E, ka.wv);
}
__device__ __forceinline__ void phase_moe_down(KA ka, int layer, LAS unsigned char* lds) {
    moe_tables(ka, layer, lds, false, gridDim.x, opaque_bid());
    MoeOrder<false> S{(const LAS int*)(lds + LDS_MISC + 256), (const LAS int*)(lds + LDS_MISC + 1024),
                      (const char*)(PF(WT) + WT_DN), (unsigned)(1024u * 512u * 2u), 512, (int)gridDim.x, opaque_bid()};
    EpiDown E{PF(H), (PF(list_w) + layer * ((size_t)16 * NTOK))};
    pg8::gemm_phase<EpiDown, MoeOrder<false>>(lds, (const char*)PF(Y), 512, S, E, ka.wv);
}

__device__ void phase_ln2(KA ka, int layer, const float* x1, float* xo) {
    PHASE_IDS
    bf16_t* xb = PF(XB);
    const bf16_t* Y2 = PF(H);
    const int lane = TID & 63, w = TID >> 6;
    const float* g = PF(ln2_g) + layer * 1024;
    const float* bb = PF(ln2_b) + layer * 1024;
    const int* cnt = (const int*)(PF(ctl) + CW_CNT) + layer * 16 * 64;
    int mybase = 0;
    {
        int cv = lane < 16 ? __hip_atomic_load(&cnt[(lane & 15) * 64], __ATOMIC_RELAXED, __HIP_MEMORY_SCOPE_AGENT) : 0;
        int incl = cv;
#pragma unroll
        for (int o = 1; o < 16; o <<= 1) { int t = __shfl_up(incl, o); if ((lane & 15) >= o) incl += t; }
        mybase = incl - cv;
    }
    const int* tsl = PF(tok_slot) + layer * ((size_t)NTOK * 2);
    f32x4 g2v[4], b2v[4];
#pragma unroll
    for (int j = 0; j < 4; ++j) { g2v[j] = *(const f32x4*)(g + 256 * j + 4 * lane); b2v[j] = *(const f32x4*)(bb + 256 * j + 4 * lane); }
    const int rstride = gridDim.x * NW;
    int row = BID * NW + w;
    int tsa1 = 0, tsb1 = 0;
    u32x2 xw0[4], ya0[4], yb0[4];
#define LN2_LOAD(ROW, TSA, TSB, XW, YA, YB) do { \
        const int s1_ = __shfl(mybase, (TSA) >> 14) + ((TSA) & (NTOK - 1)), s2_ = __shfl(mybase, (TSB) >> 14) + ((TSB) & (NTOK - 1)); \
        _Pragma("unroll") for (int j = 0; j < 4; ++j) { const int c = 256 * j + 4 * lane; \
            XW[j] = *(const u32x2*)(xb + (size_t)(ROW) * DM + c);        \
              \
            YA[j] = __builtin_nontemporal_load((const u32x2*)(Y2 + (size_t)s1_ * DM + c)); YB[j] = __builtin_nontemporal_load((const u32x2*)(Y2 + (size_t)s2_ * DM + c)); } } while (0)
    if (row < NTOK) { const int tsa0 = tsl[row * 2 + 0], tsb0 = tsl[row * 2 + 1]; LN2_LOAD(row, tsa0, tsb0, xw0, ya0, yb0); }
    if (row + rstride < NTOK) { tsa1 = tsl[(row + rstride) * 2 + 0]; tsb1 = tsl[(row + rstride) * 2 + 1]; }
    for (; row < NTOK; row += rstride) {
        u32x2 xw1[4], ya1[4], yb1[4];
        const int nrow = row + rstride;
        if (nrow < NTOK) LN2_LOAD(nrow, tsa1, tsb1, xw1, ya1, yb1);
        int tsa2 = 0, tsb2 = 0;
        if (nrow + rstride < NTOK) { tsa2 = tsl[(nrow + rstride) * 2 + 0]; tsb2 = tsl[(nrow + rstride) * 2 + 1]; }
        f32x4 v[4];
        float s = 0.f;
#pragma unroll
        for (int j = 0; j < 4; ++j) {
            const u32x2 xw = xw0[j], ya = ya0[j], yb = yb0[j];
            f32x4 xv; xv[0] = __uint_as_float(xw.x << 16); xv[1] = __uint_as_float(xw.x & 0xffff0000u); xv[2] = __uint_as_float(xw.y << 16); xv[3] = __uint_as_float(xw.y & 0xffff0000u);
            f32x4 t;
            t[0] = __uint_as_float(ya.x << 16) + __uint_as_float(yb.x << 16); t[1] = __uint_as_float(ya.x & 0xffff0000u) + __uint_as_float(yb.x & 0xffff0000u);
            t[2] = __uint_as_float(ya.y << 16) + __uint_as_float(yb.y << 16); t[3] = __uint_as_float(ya.y & 0xffff0000u) + __uint_as_float(yb.y & 0xffff0000u);
            v[j] = xv * ALPHA + t;
            s += (v[j][0] + v[j][1]) + (v[j][2] + v[j][3]);
        }
        const float mu = wave_sum(s) * (1.f / 1024.f);
        float q = 0.f;
#pragma unroll
        for (int j = 0; j < 4; ++j) { v[j] = v[j] - mu; q += (v[j][0] * v[j][0] + v[j][1] * v[j][1]) + (v[j][2] * v[j][2] + v[j][3] * v[j][3]); }
        const float rstd = rsqrtf(wave_sum(q) * (1.f / 1024.f) + 1e-5f);
#pragma unroll
        for (int j = 0; j < 4; ++j) {
            const int c = 256 * j + 4 * lane;
            const f32x4 o = v[j] * rstd * g2v[j] + b2v[j];
            if (layer == 1) *(f32x4*)(xo + (size_t)row * DM + c) = o;
            if (layer == 0) {
                u32x2 pw; pw.x = pk2(o[0], o[1]); pw.y = pk2(o[2], o[3]);
                *(u32x2*)(xb + (size_t)row * DM + c) = pw;
            }
        }
#pragma unroll
        for (int j = 0; j < 4; ++j) { xw0[j] = xw1[j]; ya0[j] = ya1[j]; yb0[j] = yb1[j]; }
        tsa1 = tsa2; tsb1 = tsb2;
    }
#undef LN2_LOAD
}

#define MFMA16(a, b, c) __builtin_amdgcn_mfma_f32_16x16x32_bf16((a), (b), (c), 0, 0, 0)
constexpr int NSA_KT = 0, NSA_VT = 16384, NSA_IMP = 32768, NSA_FIN = 65536, NSA_SEL = LDS_MISC + 8192;

__device__ __forceinline__ int tile_off(int r, int c) { return r * 128 + ((c ^ ((r >> 1) & 7)) << 4); }

__device__ __forceinline__ unsigned cvtpk(float lo, float hi) { return pk2(lo, hi); }
struct SelMask { unsigned a, b, c, d; };
__device__ __forceinline__ unsigned selbit(unsigned a, unsigned b, unsigned c, unsigned d, int j) {
    const int k = j >> 5;
    const unsigned lo = (k & 1) ? b : a, hi = (k & 1) ? d : c;
    const unsigned r = (k & 2) ? hi : lo;
    return (r >> (j & 31)) & 1u;
}

struct NsaRT {
    bf16x8 q[2];
    f32x4 o[4];
    float m, l;
};

template <int MODE, int NST>
__device__ __forceinline__ void nsa_loop(LAS unsigned char* lds, int tid, int lane, int w, int t0w, int jb, int je,
                                         const char* ksrc, size_t kstride, size_t ktile, const char* vsrc, size_t vstride, size_t vtile,
                                         NsaRT (&R)[2], const SelMask selm0, const SelMask selm1, float (&carry)[2], float* impw) {
    const int g = lane >> 4, qr = lane & 15;
    int tid2 = tid; asm volatile("" : "+v"(tid2));
    const int sr = tid2 >> 3, sc = (tid2 & 7) ^ ((sr >> 1) & 7);
    const char* kp = ksrc + (size_t)sr * kstride + sc * 16;
    const char* vp = vsrc + (size_t)sr * vstride + sc * 16;
    const unsigned ldsw = (unsigned)w * 1024u;
    const int fxq = (qr >> 1) & 7;
    const int ka0 = qr * 128 + ((g ^ fxq) << 4), ka1 = qr * 128 + (((4 + g) ^ fxq) << 4);
    const int vb = qr * 128 + (g & 1) * 8, vc = (g >> 1) ^ fxq;
    (void)vb; (void)vc;
    if (jb > je) return;
    constexpr bool PIPE = false && (MODE >= 2);
    constexpr int D = PIPE ? NST - 2 : NST - 1;
#define NSA_ISSUE(jj, st) do { const int jc_ = (jj) < je ? (jj) : je; \
        __builtin_amdgcn_global_load_lds((const unsigned*)(kp + (size_t)jc_ * ktile), (LAS unsigned*)(lds + (st) * 16384 + ldsw), 16, 0, 0); \
        if (MODE != 0) __builtin_amdgcn_global_load_lds((const unsigned*)(vp + (size_t)jc_ * vtile), (LAS unsigned*)(lds + (st) * 16384 + 8192 + ldsw), 16, 0, 0); } while (0)
#define NSA_WAIT_TILE() do { if (NST == 2) asm volatile("s_waitcnt vmcnt(0) lgkmcnt(0)" ::: "memory"); else if (PIPE) asm volatile("s_waitcnt vmcnt(2) lgkmcnt(0)" ::: "memory"); else asm volatile("s_waitcnt vmcnt(4) lgkmcnt(0)" ::: "memory"); } while (0)
#define NSA_PV(PF_, VT_) do { _Pragma("unroll") for (int ks = 0; ks < 2; ++ks) _Pragma("unroll") for (int dt = 0; dt < 4; ++dt) { \
          \
        const bf16x8 vf = *(const LAS bf16x8*)((VT_) + (ks ? ka1 : ka0) + dt * 2048); \
        R[0].o[dt] = MFMA16(vf, PF_[0][ks], R[0].o[dt]); R[1].o[dt] = MFMA16(vf, PF_[1][ks], R[1].o[dt]); } } while (0)
    constexpr int TPB = (NST == 4 && !PIPE) ? 2 : 1;
    if (TPB == 2) { NSA_ISSUE(jb, 0); NSA_ISSUE(jb + 1, 1); asm volatile("s_waitcnt vmcnt(0) lgkmcnt(0)" ::: "memory"); }
    else {
#pragma unroll
        for (int d = 0; d < D; ++d) NSA_ISSUE(jb + d, d);
        NSA_WAIT_TILE();
    }
    __builtin_amdgcn_s_barrier();
    bf16x8 pfp[2][2];
    bool havep = false;
    if (PIPE && w >= 4) __builtin_amdgcn_s_barrier();
    for (int jp = jb; jp <= je; jp += TPB) {
      if (TPB == 2) { NSA_ISSUE(jp + 2, (jp - jb + 2) & (NST - 1)); NSA_ISSUE(jp + 3, (jp - jb + 3) & (NST - 1)); }
      else NSA_ISSUE(jp + D, (jp - jb + D) & (NST - 1));
#pragma unroll 1
      for (int j = jp; j < jp + TPB; ++j) {
        if (j > je) break;
        const int cur = (j - jb) & (NST - 1);
        const LAS unsigned char* kt = lds + cur * 16384;
        const LAS unsigned char* vt = lds + cur * 16384 + 8192;
        bool anyact;
        {
            bool a = false;
#pragma unroll
            for (int rt = 0; rt < 2; ++rt) {
                const int tk = t0w + 4 * rt + (qr >> 2);
                if (MODE <= 1) { const int nv = tk >= 31 ? ((tk - 31) >> 4) + 1 : 0; a = a || (nv > 64 * j); }
                else if (MODE == 2) a = a || ((rt == 0 ? selbit(selm0.a, selm0.b, selm0.c, selm0.d, j) : selbit(selm1.a, selm1.b, selm1.c, selm1.d, j)) != 0u);
                else a = a || ((64 * j <= tk) && (64 * j + 63 > tk - 512));
            }
            anyact = __any(a);
        }
        if (anyact) {
            f32x4 s[2][4];
#pragma unroll
            for (int t = 0; t < 4; ++t) {
                const bf16x8 k0 = *(const LAS bf16x8*)(kt + ka0 + t * 2048), k1 = *(const LAS bf16x8*)(kt + ka1 + t * 2048);
#pragma unroll
                for (int rt = 0; rt < 2; ++rt) {
                    s[rt][t] = (f32x4){0.f, 0.f, 0.f, 0.f};
                    s[rt][t] = MFMA16(k0, R[rt].q[0], s[rt][t]);
                    s[rt][t] = MFMA16(k1, R[rt].q[1], s[rt][t]);
                }
            }
            if (PIPE && havep) NSA_PV(pfp, lds + ((j - 1 - jb) & (NST - 1)) * 16384 + 8192);
            if (PIPE) { NSA_WAIT_TILE(); __builtin_amdgcn_s_barrier(); }
            const int kb = 64 * j + 4 * g;
            bf16x8 pf_local[2][2];
            bf16x8 (&pf)[2][2] = PIPE ? pfp : pf_local;
            if (MODE == 1) {
#pragma unroll
                for (int rt = 0; rt < 2; ++rt) {
                    const int tk = t0w + 4 * rt + (qr >> 2);
                    const int nv = tk >= 31 ? ((tk - 31) >> 4) + 1 : 0;
                    const float mL = R[rt].m * 1.44269504f, invl = R[rt].l > 0.f ? __builtin_amdgcn_rcpf(R[rt].l) : 0.f;
                    float p[4][4];
#pragma unroll
                    for (int t = 0; t < 4; ++t)
#pragma unroll
                        for (int i = 0; i < 4; ++i) { const int key = kb + 16 * t + i; p[t][i] = (key < nv) ? __builtin_amdgcn_exp2f(fmaf(s[rt][t][i], 1.44269504f, -mL)) * invl : 0.f; }
#pragma unroll
                    for (int t = 0; t < 4; ++t) {
                        const float own = (p[t][0] + p[t][1]) + (p[t][2] + p[t][3]);
                        const float x3 = p[t][3];
                        const float up_cur = __shfl(x3, (lane + 48) & 63);
                        const float up_prev = __shfl(carry[rt], (lane + 48) & 63);
                        float v = own + (g >= 1 ? up_cur : up_prev);
                        v += __shfl_xor(v, 1);
                        v += __shfl_xor(v, 2);
                        carry[rt] = x3;
                        if ((qr & 3) == 0) impw[(4 * rt + (qr >> 2)) * 128 + 16 * j + 4 * t + g] = v;
                    }
#pragma unroll
                    for (int ks = 0; ks < 2; ++ks) {
                        u32x4 pu; pu.x = cvtpk(p[2 * ks][0], p[2 * ks][1]); pu.y = cvtpk(p[2 * ks][2], p[2 * ks][3]); pu.z = cvtpk(p[2 * ks + 1][0], p[2 * ks + 1][1]); pu.w = cvtpk(p[2 * ks + 1][2], p[2 * ks + 1][3]);
                        pf[rt][ks] = __builtin_bit_cast(bf16x8, pu);
                    }
                }
            } else {
                int lim_hi[2], lim_lo[2];
                bool none[2], part[2];
#pragma unroll
                for (int rt = 0; rt < 2; ++rt) {
                    const int tk = t0w + 4 * rt + (qr >> 2);
                    if (MODE == 0) { const int nv = tk >= 31 ? ((tk - 31) >> 4) + 1 : 0; lim_hi[rt] = nv - 1; lim_lo[rt] = -1; }
                    else if (MODE == 2) { lim_hi[rt] = ((rt == 0 ? selbit(selm0.a, selm0.b, selm0.c, selm0.d, j) : selbit(selm1.a, selm1.b, selm1.c, selm1.d, j)) != 0u) ? tk : -1; lim_lo[rt] = -1; }
                    else { lim_hi[rt] = tk; lim_lo[rt] = tk - 512; }
                    const bool full = (64 * j + 63 <= lim_hi[rt]) && (64 * j > lim_lo[rt]);
                    none[rt] = (64 * j > lim_hi[rt]) || (64 * j + 63 <= lim_lo[rt]);
                    part[rt] = !full && !none[rt];
                }
                float lmx[2];
                if (__any(part[0] || part[1])) {
#pragma unroll
                    for (int rt = 0; rt < 2; ++rt) {
                        float mx = NEG_INF;
#pragma unroll
                        for (int t = 0; t < 4; ++t)
#pragma unroll
                            for (int i = 0; i < 4; ++i) {
                                const int key = kb + 16 * t + i;
                                const bool ok = (key <= lim_hi[rt]) && (key > lim_lo[rt]);
                                s[rt][t][i] = ok ? s[rt][t][i] : NEG_INF;
                                mx = fmaxf(mx, s[rt][t][i]);
                            }
                        lmx[rt] = mx;
                        none[rt] = false;
                    }
                } else {
#pragma unroll
                    for (int rt = 0; rt < 2; ++rt) {
                        float mx = NEG_INF;
#pragma unroll
                        for (int t = 0; t < 4; ++t)
#pragma unroll
                            for (int i = 0; i < 4; ++i) mx = fmaxf(mx, s[rt][t][i]);
                        lmx[rt] = none[rt] ? NEG_INF : mx;
                    }
                }
                if (__any((lmx[0] > R[0].m + 6.f) || (lmx[1] > R[1].m + 6.f))) {
#pragma unroll
                    for (int rt = 0; rt < 2; ++rt) {
                        float mx = lmx[rt];
                        mx = fmaxf(mx, __shfl_xor(mx, 16));
                        mx = fmaxf(mx, __shfl_xor(mx, 32));
                        const float mn = fmaxf(R[rt].m, mx);
                        const float alpha = __expf(R[rt].m - mn);
                        R[rt].l *= alpha; R[rt].m = mn;
                        if (MODE != 0) {
#pragma unroll
                            for (int dt = 0; dt < 4; ++dt) R[rt].o[dt] = R[rt].o[dt] * alpha;
                        }
                    }
                }
#pragma unroll
                for (int rt = 0; rt < 2; ++rt) {
                    const float negmL = none[rt] ? -1e30f : -fmaxf(R[rt].m, -1e4f) * 1.44269504f;
                    float p[4][4];
                    float rs = 0.f;
#pragma unroll
                    for (int t = 0; t < 4; ++t)
#pragma unroll
                        for (int i = 0; i < 4; ++i) { p[t][i] = __builtin_amdgcn_exp2f(fmaf(s[rt][t][i], 1.44269504f, negmL)); rs += p[t][i]; }
                    R[rt].l += rs;
                    if (MODE != 0) {
#pragma unroll
                        for (int ks = 0; ks < 2; ++ks) {
                            u32x4 pu; pu.x = cvtpk(p[2 * ks][0], p[2 * ks][1]); pu.y = cvtpk(p[2 * ks][2], p[2 * ks][3]); pu.z = cvtpk(p[2 * ks + 1][0], p[2 * ks + 1][1]); pu.w = cvtpk(p[2 * ks + 1][2], p[2 * ks + 1][3]);
                            pf[rt][ks] = __builtin_bit_cast(bf16x8, pu);
                        }
                    }
                }
            }
            if (MODE != 0 && !PIPE) NSA_PV(pf, vt);
        } else if (PIPE) {
            if (havep) NSA_PV(pfp, lds + ((j - 1 - jb) & (NST - 1)) * 16384 + 8192);
            NSA_WAIT_TILE(); __builtin_amdgcn_s_barrier();
        }
        if (PIPE) havep = anyact;
      }
        if (TPB == 2) asm volatile("s_waitcnt vmcnt(0) lgkmcnt(0)" ::: "memory");
        else if (!PIPE) NSA_WAIT_TILE();
        __builtin_amdgcn_s_barrier();
    }
    if (PIPE && havep) { NSA_PV(pfp, lds + ((je - jb) & (NST - 1)) * 16384 + 8192); asm volatile("s_waitcnt lgkmcnt(0)" ::: "memory"); }
    if (PIPE && w < 4) __builtin_amdgcn_s_barrier();
    asm volatile("s_waitcnt vmcnt(0)" ::: "memory");
    __builtin_amdgcn_s_barrier();
#undef NSA_ISSUE
#undef NSA_WAIT_TILE
#undef NSA_PV
}

__device__ void phase_nsa2(KA ka, int layer, LAS unsigned char* lds) {
    PHASE_IDS
    const int tid = TID, w = __builtin_amdgcn_readfirstlane(tid >> 6);
    int lane = tid & 63;
#define g (lane >> 4)
#define qr (lane & 15)
#define RELAUNDER() asm volatile("" : "+v"(lane))
    const bf16_t* H = PF(H);
    const bf16_t* kcb = (PF(kcb) + layer * ((size_t)4 * 512 * 64));
    const bf16_t* vcT = (PF(vcT) + layer * ((size_t)4 * 64 * 512));
    const bf16_t* vsT = PF(vsT);
    const bf16_t* vwT = PF(vwT);
    bf16_t* Y = PF(Y);
    const float* gate_b = PF(nsa_gate_b) + layer * 24;
    const float* ogain = PF(out_gain) + layer * 1024;
    float* impw = (float*)(lds + NSA_IMP + w * 4096);
    unsigned* selw = (unsigned*)(lds + NSA_SEL + w * 128);
    for (int base = BID; base < 256; base += gridDim.x) {
#pragma unroll 1
        for (int half = 0; half < 2; ++half) {
            const int it = half ? 511 - base : base;
            const int chunk = it >> 2, bh = it & 3, b = bh >> 1, hk = bh & 1;
            const size_t rowbase = (size_t)b * T_;
            const int t0w = chunk * 64 + w * 8;
            NsaRT R[2];
#define finw ((LAS f32x4*)(lds + NSA_FIN + w * 8192) + lane)
#pragma unroll
            for (int rt = 0; rt < 2; ++rt) {
                const int tk = t0w + 4 * rt + (qr >> 2), hh = hk * 4 + (qr & 3);
                const bf16_t* qp = H + (rowbase + tk) * HLD + C_NQ + hh * 64 + 8 * g;
#pragma unroll
                for (int ks = 0; ks < 2; ++ks) {
                    const u32x4 u = *(const u32x4*)(qp + 32 * ks);
                    const unsigned uu[4] = {u.x, u.y, u.z, u.w};
                    u32x4 o4;
#pragma unroll
                    for (int e = 0; e < 4; ++e) {
                        const float f0 = __uint_as_float(uu[e] << 16) * 0.125f, f1 = __uint_as_float(uu[e] & 0xffff0000u) * 0.125f;
                        o4[e] = (__float_as_uint(f0) >> 16) | (__float_as_uint(f1) & 0xffff0000u);
                    }
                    R[rt].q[ks] = __builtin_bit_cast(bf16x8, o4);
                }
                R[rt].m = NEG_INF; R[rt].l = 0.f;
#pragma unroll
                for (int dt = 0; dt < 4; ++dt) R[rt].o[dt] = zero4();
            }
            SelMask selm0{0u, 0u, 0u, 0u}, selm1{0u, 0u, 0u, 0u};
            float carry[2] = {0.f, 0.f};
            const int tmax = chunk * 64 + 63;
            const int nvmax = tmax >= 31 ? ((tmax - 31) >> 4) + 1 : 0;
            const int nb = (nvmax + 63) >> 6;
            const char* kc_src = (const char*)(kcb + (size_t)bh * 512 * 64);
            const char* vc_src = (const char*)(vcT + (size_t)bh * 64 * 512);
            nsa_loop<0, 2>(lds, tid, lane, w, t0w, 0, nb - 1, kc_src, 128, 64 * 128, nullptr, 0, 0, R, selm0, selm1, carry, impw);
            RELAUNDER();
#pragma unroll
            for (int rt = 0; rt < 2; ++rt) { float l = R[rt].l; l += __shfl_xor(l, 16); l += __shfl_xor(l, 32); R[rt].l = l; }
            for (int i = lane; i < 8 * 128; i += 64) impw[i] = 0.f;
            wave_sync();
            nsa_loop<1, 2>(lds, tid, lane, w, t0w, 0, nb - 1, kc_src, 128, 64 * 128, vc_src, 512 * 2, 64 * 2, R, selm0, selm1, carry, impw);
            RELAUNDER();
#pragma unroll
            for (int rt = 0; rt < 2; ++rt) {
                const int hh = hk * 4 + (qr & 3);
                const float gt = sigmoidf_(bf2f(H[(rowbase + (t0w + 4 * rt + (qr >> 2))) * HLD + C_NG + hh * 3 + 0]) + gate_b[hh * 3 + 0]);
#pragma unroll
                for (int dt = 0; dt < 4; ++dt) finw[(rt * 4 + dt) * 64] = R[rt].o[dt] * gt;
            }
            wave_sync();
            {
                const int tl = lane >> 3, sub = lane & 7;
                const int tks = t0w + tl, curb = tks >> 6;
                unsigned long long K[16];
                unsigned* impu = (unsigned*)impw;
                unsigned ku[16];
#pragma unroll
                for (int i = 0; i < 16; ++i) {
                    const int jj = sub * 16 + i;
                    const float a = impw[tl * 128 + jj];
                    const bool forced = (jj == 0) || (jj == curb) || (jj == curb - 1);
                    const float vv = a + (forced ? 1e4f : 0.f);
                    ku[i] = (jj <= curb) ? (__float_as_uint(vv) + 1u) : 0u;
                    K[i] = ((unsigned long long)ku[i] << 8) | (unsigned)(255 - jj);
                }
                wave_sync();
#pragma unroll
                for (int i = 0; i < 16; ++i) impu[tl * 128 + sub * 16 + i] = ku[i];
                wave_sync();
                int cnt[16];
#pragma unroll
                for (int i = 0; i < 16; ++i) cnt[i] = 0;
                const int jjmax = (t0w + 7) >> 6;
#pragma unroll 4
                for (int jj = 0; jj <= jjmax; ++jj) {
                    const unsigned long long X = ((unsigned long long)impu[tl * 128 + jj] << 8) | (unsigned)(255 - jj);
#pragma unroll
                    for (int i = 0; i < 16; ++i) cnt[i] += (X > K[i]) ? 1 : 0;
                }
                unsigned bits = 0u;
#pragma unroll
                for (int i = 0; i < 16; ++i) bits |= ((cnt[i] < 16) && (ku[i] != 0u)) ? (1u << i) : 0u;
                const unsigned other = __shfl_xor(bits, 1);
                const unsigned word = (sub & 1) ? ((bits << 16) | other) : (bits | (other << 16));
                if ((sub & 1) == 0) selw[tl * 4 + (sub >> 1)] = word;
                wave_sync();
                { const unsigned* q0 = selw + (qr >> 2) * 4; selm0.a = q0[0]; selm0.b = q0[1]; selm0.c = q0[2]; selm0.d = q0[3];
                  selm1.a = q0[16]; selm1.b = q0[17]; selm1.c = q0[18]; selm1.d = q0[19]; }
                wave_sync();
            }
            __syncthreads();
#pragma unroll
            for (int rt = 0; rt < 2; ++rt) {
                R[rt].m = NEG_INF; R[rt].l = 0.f;
#pragma unroll
                for (int dt = 0; dt < 4; ++dt) R[rt].o[dt] = zero4();
            }
            nsa_loop<2, 4>(lds, tid, lane, w, t0w, 0, chunk, (const char*)(H + rowbase * HLD + C_KS + hk * 64), (size_t)HLD * 2, (size_t)64 * HLD * 2,
                        (const char*)(vsT + (size_t)bh * 64 * T_), (size_t)T_ * 2, 64 * 2, R, selm0, selm1, carry, impw);
            RELAUNDER();
#pragma unroll
            for (int rt = 0; rt < 2; ++rt) {
                const int hh = hk * 4 + (qr & 3);
                const float gt = sigmoidf_(bf2f(H[(rowbase + (t0w + 4 * rt + (qr >> 2))) * HLD + C_NG + hh * 3 + 1]) + gate_b[hh * 3 + 1]);
                float ltot = R[rt].l; ltot += __shfl_xor(ltot, 16); ltot += __shfl_xor(ltot, 32);
                const float sc = gt / ltot;
#pragma unroll
                for (int dt = 0; dt < 4; ++dt) { finw[(rt * 4 + dt) * 64] += R[rt].o[dt] * sc; R[rt].o[dt] = zero4(); }
                R[rt].m = NEG_INF; R[rt].l = 0.f;
            }
            nsa_loop<3, 4>(lds, tid, lane, w, t0w, chunk >= 8 ? chunk - 8 : 0, chunk, (const char*)(H + rowbase * HLD + C_KW + hk * 64), (size_t)HLD * 2, (size_t)64 * HLD * 2,
                        (const char*)(vwT + (size_t)bh * 64 * T_), (size_t)T_ * 2, 64 * 2, R, selm0, selm1, carry, impw);
            RELAUNDER();
#pragma unroll
            for (int rt = 0; rt < 2; ++rt) {
                const int tk = (t0w + 4 * rt + (qr >> 2)), hh = hk * 4 + (qr & 3);
                const float gt = sigmoidf_(bf2f(H[(rowbase + tk) * HLD + C_NG + hh * 3 + 2]) + gate_b[hh * 3 + 2]);
                float ltot = R[rt].l; ltot += __shfl_xor(ltot, 16); ltot += __shfl_xor(ltot, 32);
                const float sc = gt / ltot;
                bf16_t* yp = Y + (rowbase + tk) * DM + 256 + hh * 64 + 4 * g;
                f32x4 ov[4];
                float ss = 0.f;
#pragma unroll
                for (int dt = 0; dt < 4; ++dt) { ov[dt] = finw[(rt * 4 + dt) * 64] + R[rt].o[dt] * sc; ss += (ov[dt][0] * ov[dt][0] + ov[dt][1] * ov[dt][1]) + (ov[dt][2] * ov[dt][2] + ov[dt][3] * ov[dt][3]); }
                ss += __shfl_xor(ss, 16);
                ss += __shfl_xor(ss, 32);
                const float rn = rsqrtf(ss * (1.f / 64.f) + 1e-6f);
#pragma unroll
                for (int dt = 0; dt < 4; ++dt) {
                    const f32x4 o = ov[dt] * rn * *(const f32x4*)(ogain + 256 + hh * 64 + 16 * dt + 4 * g);
                    u32x2 wv; wv.x = pk2(o[0], o[1]); wv.y = pk2(o[2], o[3]);
                    *(u32x2*)(yp + 16 * dt) = wv;
                }
            }
        }
    }
}
#undef g
#undef qr
#undef finw
#undef RELAUNDER

__device__ void phase_vtrans(KA ka, float* smem) {
    PHASE_IDS
    const int lane = TID & 63, w = TID >> 6;
    bf16_t* scr = (bf16_t*)(smem + w * 4096);
    const bf16_t* H = PF(H);
    const int kperm = (lane & 32) + 8 * ((lane & 15) >> 2) + 4 * ((lane >> 4) & 1) + (lane & 3);
    for (int it = BID * NW + w; it < 1024; it += gridDim.x * NW) {
        const int tt = it & 127, bh = (it >> 7) & 3, which = it >> 9;
        const int b = bh >> 1, hk = bh & 1;
        const size_t tok0 = (size_t)b * T_ + tt * 64;
        const int col = (which ? C_VW : C_VS) + hk * 64;
        bf16_t* dst = (which ? PF(vwT) : PF(vsT)) + (size_t)bh * 64 * T_ + tt * 64;
        wave_sync();
#pragma unroll 2
        for (int i0 = 0; i0 < 64; i0 += 16) {
            bf16_t hv[16];
#pragma unroll
            for (int i = 0; i < 16; ++i) hv[i] = H[(tok0 + i0 + i) * HLD + col + lane];
#pragma unroll
            for (int i = 0; i < 16; ++i) scr[lane * 66 + i0 + i] = hv[i];
        }
        wave_sync();
#pragma unroll 16
        for (int d = 0; d < 64; ++d) dst[(size_t)d * T_ + kperm] = scr[d * 66 + lane];
    }
}

__device__ void phase_hgrnA(KA ka, int layer, LAS unsigned char* lds, int first, int nblk) {
    PHASE_IDS
    const int tid = TID, lane = tid & 63, w = __builtin_amdgcn_readfirstlane(tid >> 6), gq = lane >> 4, lc = lane & 15;
    float* Q = (float*)lds;
    float* K = Q + 64 * 68;
    float* Bc = K + 64 * 68;
    float* SEG = Bc + 64 * 68;
    LAS bf16_t* ATb = (LAS bf16_t*)(lds + 57344);
    LAS bf16_t* ItB = ATb + 64 * 72;
    LAS bf16_t* KtB = ItB + 64 * 72;
    const bf16_t* H = PF(H);
    const float* hgl = PF(hg_lower);
    float* hgU = PF(hgU); float* hgG = (PF(hgG) + layer * ((size_t)1024 * 64)); bf16_t* hgQB = PF(hgQB); bf16_t* hgO = PF(hgO);
    if (BID < first) return;
    float* LB = (float*)(lds + 98304);
    if (tid < 256) {
        float lb = 0.f;
        if (layer == 1) { const float h0 = hgl[tid], h1 = hgl[256 + tid]; const float mx = fmaxf(h0, h1), e0 = expf(h0 - mx), e1 = expf(h1 - mx); lb = e1 / (e0 + e1); }
        LB[tid] = lb;
    }
    bf16_t pff[8], pfq[8], pfi[8];
#define HGA_FETCH(ITEM) do { const int c_ = (ITEM) & 127, bh_ = (ITEM) >> 7, h_ = bh_ & 3, b_ = bh_ >> 2; const size_t tk_ = (size_t)b_ * T_ + c_ * 64; \
        _Pragma("unroll") for (int i = 0; i < 8; ++i) { const int e = tid + i * NTHR, t = e >> 6, d = e & 63; const bf16_t* hp = H + (tk_ + t) * HLD + h_ * 64 + d; \
            pff[i] = hp[C_HF]; pfq[i] = hp[C_HQ]; pfi[i] = hp[C_HI]; } } while (0)
    if (BID - first < 1024) HGA_FETCH(BID - first);
    for (int item = BID - first; item < 1024; item += nblk) {
        const int c = item & 127, bh = item >> 7, h = bh & 3, b = bh >> 2;
        const size_t tok0 = (size_t)b * T_ + c * 64;
        __syncthreads();
#pragma unroll
        for (int i = 0; i < 8; ++i) {
            const int e = tid + i * NTHR, t = e >> 6, d = e & 63;
            const float lb = LB[h * 64 + d];
            const float fl = bf2f(pff[i]);
            const float ex = __expf(-fl);
            const float sg = __builtin_amdgcn_rcpf(1.f + ex);
            const float f = lb + (1.f - lb) * sg;
            Q[t * 68 + d] = bf2f(pfq[i]);
            K[t * 68 + d] = (1.f - lb) * (ex * sg);
            ItB[d * 72 + t] = pfi[i];
            Bc[t * 68 + d] = __logf(fmaxf(f, 1e-38f));
        }
        if (item + nblk < 1024) HGA_FETCH(item + nblk);
        __syncthreads();
        {
            const int d = lane, seg = w;
            float run = 0.f;
#pragma unroll
            for (int i = 0; i < 8; ++i) { run += Bc[(seg * 8 + i) * 68 + d]; Bc[(seg * 8 + i) * 68 + d] = run; }
            SEG[seg * 64 + d] = run;
            __syncthreads();
            float pre = 0.f;
            for (int s2 = 0; s2 < seg; ++s2) pre += SEG[s2 * 64 + d];
#pragma unroll
            for (int i = 0; i < 8; ++i) Bc[(seg * 8 + i) * 68 + d] += pre;
        }
        __syncthreads();
        {
            const int blk = tid >> 1, dh = tid & 1, db = blk >> 6, tp = (blk >> 3) & 7, sp = blk & 7;
            float a00 = 0.f, a01 = 0.f, a10 = 0.f, a11 = 0.f;
            const int t0 = 16 * db + 2 * tp, s0 = 16 * db + 2 * sp;
            if (sp <= tp) {
#pragma unroll 2
                for (int d0 = 32 * dh; d0 < 32 * dh + 32; d0 += 4) {
                    const f32x4 q0 = *(const f32x4*)&Q[t0 * 68 + d0], q1 = *(const f32x4*)&Q[(t0 + 1) * 68 + d0];
                    const f32x4 b0 = *(const f32x4*)&Bc[t0 * 68 + d0], b1 = *(const f32x4*)&Bc[(t0 + 1) * 68 + d0];
                    const f32x4 k0 = *(const f32x4*)&K[s0 * 68 + d0], k1 = *(const f32x4*)&K[(s0 + 1) * 68 + d0];
                    const f32x4 c0 = *(const f32x4*)&Bc[s0 * 68 + d0], c1 = *(const f32x4*)&Bc[(s0 + 1) * 68 + d0];
#pragma unroll
                    for (int dd = 0; dd < 4; ++dd) {
                        a00 = fmaf(q0[dd] * k0[dd], __expf(fminf(b0[dd] - c0[dd], 0.f)), a00);
                        a01 = fmaf(q0[dd] * k1[dd], __expf(fminf(b0[dd] - c1[dd], 0.f)), a01);
                        a10 = fmaf(q1[dd] * k0[dd], __expf(fminf(b1[dd] - c0[dd], 0.f)), a10);
                        a11 = fmaf(q1[dd] * k1[dd], __expf(fminf(b1[dd] - c1[dd], 0.f)), a11);
                    }
                }
            }
            a00 += __shfl_xor(a00, 1); a01 += __shfl_xor(a01, 1); a10 += __shfl_xor(a10, 1); a11 += __shfl_xor(a11, 1);
            if (s0 + 1 > t0) a01 = 0.f;
            if (sp > tp) { a00 = 0.f; a01 = 0.f; a10 = 0.f; a11 = 0.f; }
            if (dh == 0) {
                *(LAS unsigned*)(ATb + t0 * 72 + s0) = pk2(a00, a01);
                *(LAS unsigned*)(ATb + (t0 + 1) * 72 + s0) = pk2(a10, a11);
            }
            LAS bf16_t* QT = (LAS bf16_t*)(lds + 99328);
            LAS bf16_t* KT = (LAS bf16_t*)(lds + 106496);
#pragma unroll 1
            for (int i = 0; i < 3; ++i) {
                const int e = tid + i * NTHR, t = 16 + (e >> 5), d = 2 * (e & 31), R = (t & ~15) - 1;
                const float x0 = Q[t * 68 + d] * __expf(fminf(Bc[t * 68 + d] - Bc[R * 68 + d], 0.f));
                const float x1 = Q[t * 68 + d + 1] * __expf(fminf(Bc[t * 68 + d + 1] - Bc[R * 68 + d + 1], 0.f));
                *(LAS unsigned*)(QT + (t - 16) * 72 + d) = pk2(x0, x1);
            }
#pragma unroll 1
            for (int i = 0; i < 6; ++i) {
                const int e = tid + i * NTHR, row = e >> 5, d = 2 * (e & 31);
                const int rb = row < 16 ? 0 : (row < 48 ? 1 : 2);
                const int s = row - (rb == 0 ? 0 : (rb == 1 ? 16 : 48)), R = 16 * rb + 15;
                const float x0 = K[s * 68 + d] * __expf(fminf(Bc[R * 68 + d] - Bc[s * 68 + d], 0.f));
                const float x1 = K[s * 68 + d + 1] * __expf(fminf(Bc[R * 68 + d + 1] - Bc[s * 68 + d + 1], 0.f));
                *(LAS unsigned*)(KT + row * 72 + d) = pk2(x0, x1);
            }
        }
#pragma unroll
        for (int i = 0; i < 8; ++i) {
            const int e = tid + i * NTHR, t = e >> 6, d = e & 63;
            const float bt = Bc[t * 68 + d];
            hgQB[(size_t)item * 4096 + e] = f2bf(Q[t * 68 + d] * __expf(bt));
            KtB[d * 72 + t] = f2bf(K[t * 68 + d] * __expf(Bc[63 * 68 + d] - bt));
        }
        if (tid < 64) hgG[(size_t)item * 64 + tid] = __expf(Bc[63 * 68 + tid]);
        __syncthreads();
        {
            const LAS bf16_t* QT = (const LAS bf16_t*)(lds + 99328);
            const LAS bf16_t* KT = (const LAS bf16_t*)(lds + 106496);
            if (w < 6) {
                const int tb16 = w < 1 ? 1 : (w < 3 ? 2 : 3), sb16 = w - (tb16 == 1 ? 0 : (tb16 == 2 ? 1 : 3));
                const int kbase = (tb16 == 1 ? 0 : (tb16 == 2 ? 16 : 48)) + 16 * sb16;
                const LAS bf16_t* Ab = QT + (16 * (tb16 - 1) + lc) * 72 + 8 * gq;
                const LAS bf16_t* Bb = KT + (kbase + lc) * 72 + 8 * gq;
                f32x4 acc = zero4();
                acc = MFMA16(*(const LAS bf16x8*)Ab, *(const LAS bf16x8*)Bb, acc);
                acc = MFMA16(*(const LAS bf16x8*)(Ab + 32), *(const LAS bf16x8*)(Bb + 32), acc);
#pragma unroll
                for (int i = 0; i < 4; ++i) ATb[(16 * tb16 + 4 * gq + i) * 72 + 16 * sb16 + lc] = f2bf(acc[i]);
            } else {
                for (int e = tid - 384; e < 6 * 16 * 8; e += 128) {
                    const int bz = e >> 7, r = (e >> 3) & 15, cw = e & 7;
                    const int tb16 = bz < 3 ? 0 : (bz < 5 ? 1 : 2), sb16 = bz < 3 ? bz + 1 : (bz < 5 ? bz - 1 : 3);
                    *(LAS unsigned*)(ATb + (16 * tb16 + r) * 72 + 16 * sb16 + 2 * cw) = 0u;
                }
            }
        }
        __syncthreads();
#pragma unroll
        for (int q = 0; q < 4; ++q) {
            const int tile = w * 4 + q, isU = tile >> 4, rt_ = (tile >> 2) & 3, ct = tile & 3;
            const LAS bf16_t* Ab = (isU ? KtB : ATb) + (16 * rt_ + lc) * 72 + 8 * gq;
            const LAS bf16_t* Bb = ItB + (16 * ct + lc) * 72 + 8 * gq;
            f32x4 acc = zero4();
            acc = MFMA16(*(const LAS bf16x8*)Ab, *(const LAS bf16x8*)Bb, acc);
            acc = MFMA16(*(const LAS bf16x8*)(Ab + 32), *(const LAS bf16x8*)(Bb + 32), acc);
#pragma unroll
            for (int i = 0; i < 4; ++i) {
                const int r = 16 * rt_ + 4 * gq + i, cc = 16 * ct + lc;
                if (isU) hgU[((size_t)item * 64 + r) * 64 + cc] = acc[i];
                else hgO[((size_t)item * 64 + r) * 64 + cc] = f2bf(acc[i]);
            }
        }
    }
}

__device__ void phase_hgrnB(KA ka, int layer) {
    PHASE_IDS
    const float* hgU = PF(hgU); const float* hgG = (PF(hgG) + layer * ((size_t)1024 * 64)); float* hgS = PF(hgS);
    for (int gid = BID * NTHR + TID; gid < 32768; gid += gridDim.x * NTHR) {
        const int bh = gid >> 12, dv = gid & 4095, d = dv >> 6;
        float S = 0.f;
        for (int c0 = 0; c0 < 128; c0 += 8) {
            float u[8], gg[8];
#pragma unroll
            for (int k = 0; k < 8; ++k) { const size_t item = (size_t)bh * 128 + c0 + k; u[k] = hgU[item * 4096 + dv]; gg[k] = hgG[item * 64 + d]; }
#pragma unroll
            for (int k = 0; k < 8; ++k) { const size_t item = (size_t)bh * 128 + c0 + k; hgS[item * 4096 + dv] = S; S = fmaf(gg[k], S, u[k]); }
        }
    }
    if (BID * NTHR < 32768) {
        asm volatile("s_waitcnt vmcnt(0)" ::: "memory");
        __syncthreads();
        if (TID == 0) {
            __builtin_amdgcn_fence(__ATOMIC_RELEASE, "agent");
            asm volatile("s_waitcnt vmcnt(0)" ::: "memory");
            (void)__hip_atomic_fetch_add(PF(ctl) + CW_HG + layer * 128, 1u, __ATOMIC_RELAXED, __HIP_MEMORY_SCOPE_AGENT);
        }
    }
}

__device__ void phase_hgrnC(KA ka, int layer, LAS unsigned char* lds) {
    PHASE_IDS
    const int tid = TID, lane = tid & 63, w = __builtin_amdgcn_readfirstlane(tid >> 6), gq = lane >> 4, lc = lane & 15;
    LAS bf16_t* QBb = (LAS bf16_t*)lds;
    LAS bf16_t* StB = QBb + 64 * 72;
    float* OT = (float*)(lds + 32768);
    const bf16_t* H = PF(H);
    const float* hgS = PF(hgS); const bf16_t* hgQB = PF(hgQB); const bf16_t* hgO = PF(hgO);
    const float* og = PF(out_gain) + layer * 1024;
    bf16_t* Y = PF(Y);
    {
        unsigned* done = PF(ctl) + CW_HG + layer * 128;
        const unsigned need = (unsigned)((32768 + NTHR - 1) / NTHR < (int)gridDim.x ? (32768 + NTHR - 1) / NTHR : (int)gridDim.x);
        if (tid == 0) {
            unsigned* bar = PF(ctl) + CW_BAR;
            XB_SPIN(xb_ld(done) < need, bar);
            __builtin_amdgcn_fence(__ATOMIC_ACQUIRE, "agent");
            asm volatile("s_waitcnt vmcnt(0)" ::: "memory");
        }
        __syncthreads();
    }
    unsigned* qhead = PF(ctl) + CW_HG + layer * 128 + 64;
    for (int item = queue_fetch(ka, qhead, lds); item < 1024; item = queue_fetch(ka, qhead, lds)) {
        const int c = item & 127, bh = item >> 7, h = bh & 3, b = bh >> 2;
        const size_t tok0 = (size_t)b * T_ + c * 64;
        __syncthreads();
#pragma unroll
        for (int i = 0; i < 8; ++i) {
            const int e = tid + i * NTHR, r = e >> 6, cc = e & 63;
            QBb[r * 72 + cc] = hgQB[(size_t)item * 4096 + e];
            StB[cc * 72 + r] = f2bf(hgS[(size_t)item * 4096 + e]);
        }
        __syncthreads();
#pragma unroll
        for (int q = 0; q < 2; ++q) {
            const int tile = w * 2 + q, rt_ = tile >> 2, ct = tile & 3;
            const LAS bf16_t* Ab = QBb + (16 * rt_ + lc) * 72 + 8 * gq;
            const LAS bf16_t* Bb = StB + (16 * ct + lc) * 72 + 8 * gq;
            f32x4 acc = zero4();
            acc = MFMA16(*(const LAS bf16x8*)Ab, *(const LAS bf16x8*)Bb, acc);
            acc = MFMA16(*(const LAS bf16x8*)(Ab + 32), *(const LAS bf16x8*)(Bb + 32), acc);
#pragma unroll
            for (int i = 0; i < 4; ++i) {
                const int t = 16 * rt_ + 4 * gq + i, v = 16 * ct + lc;
                OT[t * 65 + v] = acc[i] + bf2f(hgO[((size_t)item * 64 + t) * 64 + v]);
            }
        }
        __syncthreads();
        {
            float av[8], ms[8], hgv[8];
#pragma unroll
            for (int i = 0; i < 8; ++i) hgv[i] = bf2f(H[(tok0 + w + 8 * i) * HLD + C_HG + h * 64 + lane]);
            const float ogv = og[768 + h * 64 + lane];
#pragma unroll
            for (int i = 0; i < 8; ++i) { av[i] = OT[(w + 8 * i) * 65 + lane]; ms[i] = av[i] * av[i]; }
#pragma unroll
            for (int off = 32; off > 0; off >>= 1) {
                float tt[8];
#pragma unroll
                for (int i = 0; i < 8; ++i) tt[i] = __shfl_xor(ms[i], off);
#pragma unroll
                for (int i = 0; i < 8; ++i) ms[i] += tt[i];
            }
#pragma unroll
            for (int i = 0; i < 8; ++i) {
                float r = ms[i] * (1.f / 64.f);
                asm volatile("" : "+v"(r));
                const float y = av[i] * rsqrtf(r + 1e-6f) * ogv * (hgv[i] * sigmoidf_(hgv[i]));
                Y[(tok0 + w + 8 * i) * DM + 768 + h * 64 + lane] = f2bf(y);
            }
        }
    }
}

struct CmpOrder {
    static constexpr bool GATHER = false;
    const char* W1T; int c;
    __device__ __forceinline__ bool next(int i, pg8::Unit& u) const {
        if (i > 0 || c >= 16) return false;
        const int which = c >> 3, bh = (c >> 1) & 3, nt = c & 1;
        u.arow0 = (bh >> 1) * 512 + nt * 256; u.nrows = 256; u.pm = nt; u.pn = 0; u.e = which * 4 + bh; u.ui = 0;
        u.bptr = W1T + (size_t)which * 256 * 2048 * 2;
        return true;
    }
    __device__ __forceinline__ int arow(const pg8::Unit& u, int r) const { return u.arow0 + r; }
    __device__ __forceinline__ int lda(int) const { return 16 * HLD; }
    __device__ __forceinline__ unsigned kstepA() const { return (unsigned)(HLD * 2); }
    __device__ __forceinline__ const char* abase(const pg8::Unit& u, const char* A) const { return A + (((u.e >> 2) ? C_VC : C_KC) + (u.e & 1) * 64) * 2; }
};
struct EpiCmp {
    static constexpr bool PERM = true;
    bf16_t* G; const float* cbias;
    __device__ __forceinline__ void operator()(const f32x4 (&acc)[2][2][4][2], const pg8::Unit& u, int wr, int wc, int fr, int fq) const {
        const float* bp = cbias + (u.e >> 2) * 128 + wc * 32 + 8 * fq;
        const f32x4 b0 = *(const f32x4*)bp, b1 = *(const f32x4*)(bp + 4);
#pragma unroll
        for (int ai = 0; ai < 2; ++ai)
#pragma unroll
            for (int m = 0; m < 4; ++m) {
                const int r = ai * 128 + wr * 64 + m * 16 + fr;
                bf16_t* rowp = G + ((size_t)(u.e * 512 + u.pm * 256 + r)) * 128 + wc * 32 + 8 * fq;
                const f32x4 v0 = acc[ai][0][m][0] + b0, v1 = acc[ai][0][m][1] + b1;
                u32x4 w; w.x = pk2(gelu_slow(v0[0]), gelu_slow(v0[1])); w.y = pk2(gelu_slow(v0[2]), gelu_slow(v0[3])); w.z = pk2(gelu_slow(v1[0]), gelu_slow(v1[1])); w.w = pk2(gelu_slow(v1[2]), gelu_slow(v1[3]));
                *(u32x4*)rowp = w;
            }
    }
};
__device__ void phase_compress2(KA ka, int layer, LAS unsigned char* lds) {
    const int bid = opaque_bid();
    if (bid >= 16) return;
    CmpOrder S{(const char*)(PF(WT) + WT_C1), bid};
    EpiCmp E{(PF(gb) + layer * ((size_t)8 * 512 * 128)), (PF(cbias) + layer * (256))};
    pg8::gemm_phase<EpiCmp, CmpOrder>(lds, (const char*)PF(H), 2048, S, E, ka.wv);
    __syncthreads();
    const int tid = opaque_tid(ka.wv);
    const int which = bid >> 3, bh = (bid >> 1) & 3, nt = bid & 1;
    float* w2s = (float*)lds;
    const float* w2 = PF(cmp_w2) + ((size_t)layer * 2 + which) * 128 * 64;
    for (int i = tid; i < 128 * 64; i += NTHR) w2s[i] = w2[i];
    __syncthreads();
    const int r = tid >> 1, half = tid & 1;
    const bf16_t* grow = (PF(gb) + layer * ((size_t)8 * 512 * 128)) + ((size_t)((which * 4 + bh) * 512 + nt * 256 + r)) * 128;
    float acc[32];
#pragma unroll
    for (int j = 0; j < 32; ++j) acc[j] = 0.f;
    for (int c8 = 0; c8 < 16; ++c8) {
        const u32x4 gu = *(const u32x4*)(grow + c8 * 8);
        const unsigned gw[4] = {gu.x, gu.y, gu.z, gu.w};
#pragma unroll
        for (int e = 0; e < 8; ++e) {
            const float gv = (e & 1) ? __uint_as_float(gw[e >> 1] & 0xffff0000u) : __uint_as_float(gw[e >> 1] << 16);
            const float* wrow = w2s + (c8 * 8 + e) * 64 + half * 32;
#pragma unroll
            for (int j4 = 0; j4 < 8; ++j4) {
                const float4 w4 = *(const float4*)(wrow + j4 * 4);
                acc[j4 * 4 + 0] = fmaf(gv, w4.x, acc[j4 * 4 + 0]); acc[j4 * 4 + 1] = fmaf(gv, w4.y, acc[j4 * 4 + 1]);
                acc[j4 * 4 + 2] = fmaf(gv, w4.z, acc[j4 * 4 + 2]); acc[j4 * 4 + 3] = fmaf(gv, w4.w, acc[j4 * 4 + 3]);
            }
        }
    }
    const int n = nt * 256 + r;
    if (which == 0) {
        bf16_t* o = (PF(kcb) + layer * ((size_t)4 * 512 * 64)) + ((size_t)bh * 512 + n) * 64 + half * 32;
#pragma unroll
        for (int j = 0; j < 32; j += 2) *(unsigned*)(o + j) = pk2(acc[j], acc[j + 1]);
    } else {
        const int np = (n & ~31) + 8 * ((n & 15) >> 2) + 4 * ((n >> 4) & 1) + (n & 3);
        bf16_t* o = (PF(vcT) + layer * ((size_t)4 * 64 * 512)) + (size_t)bh * 64 * 512 + np;
#pragma unroll
        for (int j = 0; j < 32; ++j) o[(size_t)(half * 32 + j) * 512] = f2bf(acc[j]);
    }
    __syncthreads();
}

__device__ void phase_gmlp2(KA ka, int layer, LAS unsigned char* lds, int first, int nblk) {
    PHASE_IDS
    const int tid = TID, lane = tid & 63, w = __builtin_amdgcn_readfirstlane(tid >> 6), gq = lane >> 4, lc = lane & 15;
    LAS bf16_t* Vt = (LAS bf16_t*)lds;
    const float* gain = PF(gm_v_gain) + layer * 256;
    const float* bias = PF(gm_v_bias) + layer * 256;
    const float* bs = PF(gm_b_s) + layer * 4 * 128;
    const bf16_t* gmW = PF(WT) + WT_GM;
    const bf16_t* H = PF(H);
    bf16_t* Y = PF(Y);
    if (BID < first) return;
    for (int it = BID - first; it < 1536; it += nblk) {
        if (it < 1024) continue;
        const int item = it - 1024;
        const int g = item & 3, c = (item >> 2) & 63, b = item >> 8;
        const size_t tok0 = (size_t)b * T_ + (size_t)c * 128;
        __syncthreads();
        bf16_t gvr[16], gur[16];
#pragma unroll
        for (int i = 0; i < 16; ++i) gvr[i] = H[(tok0 + w * 16 + i) * HLD + C_GV + g * 64 + lane];
#pragma unroll
        for (int i = 0; i < 4; ++i)
#pragma unroll
            for (int ct = 0; ct < 4; ++ct) gur[i * 4 + ct] = H[(tok0 + 16 * w + 4 * gq + i) * HLD + C_GU + g * 64 + 16 * ct + lc];
        const bf16_t* wrow = gmW + ((size_t)g * 128 + 16 * w + lc) * 128 + 8 * gq;
        const int kmax = (16 * w + 15) >> 5;
        bf16x8 afr[4];
#pragma unroll
        for (int ks = 0; ks < 4; ++ks) afr[ks] = *(const bf16x8*)(wrow + 32 * (ks <= kmax ? ks : 0));
        const float* ogain = PF(out_gain) + layer * 1024;
        float bsv[4], ogv[4];
#pragma unroll
        for (int i = 0; i < 4; ++i) bsv[i] = bs[g * 128 + 16 * w + 4 * gq + i];
#pragma unroll
        for (int ct = 0; ct < 4; ++ct) ogv[ct] = ogain[g * 64 + 16 * ct + lc];
        const float gn = gain[g * 64 + lane], bi = bias[g * 64 + lane];
        {
            float ge[16], sm[16];
#pragma unroll
            for (int i = 0; i < 16; ++i) { ge[i] = gelu_t(bf2f(gvr[i])); sm[i] = ge[i]; }
#pragma unroll
            for (int off = 32; off > 0; off >>= 1) {
                float tt[16];
#pragma unroll
                for (int i = 0; i < 16; ++i) tt[i] = __shfl_xor(sm[i], off);
#pragma unroll
                for (int i = 0; i < 16; ++i) sm[i] += tt[i];
            }
#pragma unroll
            for (int i = 0; i < 16; ++i) { ge[i] -= sm[i] * (1.f / 64.f); sm[i] = ge[i] * ge[i]; }
#pragma unroll
            for (int off = 32; off > 0; off >>= 1) {
                float tt[16];
#pragma unroll
                for (int i = 0; i < 16; ++i) tt[i] = __shfl_xor(sm[i], off);
#pragma unroll
                for (int i = 0; i < 16; ++i) sm[i] += tt[i];
            }
#pragma unroll
            for (int i = 0; i < 16; i += 2) {
                float r0 = sm[i] * (1.f / 64.f), r1 = sm[i + 1] * (1.f / 64.f);
                asm volatile("" : "+v"(r0), "+v"(r1));
                float v0 = ge[i] * rsqrtf(r0 + 1e-5f) * gn + bi, v1 = ge[i + 1] * rsqrtf(r1 + 1e-5f) * gn + bi;
                asm volatile("" : "+v"(v0), "+v"(v1));
                *(LAS unsigned*)(Vt + lane * 136 + w * 16 + i) = pk2(v0, v1);
            }
        }
        __syncthreads();
        f32x4 acc[4];
#pragma unroll
        for (int ct = 0; ct < 4; ++ct) acc[ct] = zero4();
#pragma unroll
        for (int ks = 0; ks < 4; ++ks) {
            if (ks <= kmax) {
#pragma unroll
                for (int ct = 0; ct < 4; ++ct) {
                    const bf16x8 bfr = *(const LAS bf16x8*)(Vt + (16 * ct + lc) * 136 + 32 * ks + 8 * gq);
                    acc[ct] = MFMA16(afr[ks], bfr, acc[ct]);
                }
            }
        }
#pragma unroll
        for (int i = 0; i < 4; ++i) {
            const int t = 16 * w + 4 * gq + i;
            float yv[4];
            float ss = 0.f;
#pragma unroll
            for (int ct = 0; ct < 4; ++ct) {
                const int d = 16 * ct + lc;
                float z = acc[ct][i] + bsv[i];
                asm volatile("" : "+v"(z));
                const float u = gelu_t(bf2f(gur[i * 4 + ct]));
                yv[ct] = u * z;
                asm volatile("" : "+v"(yv[ct]));
                ss += yv[ct] * yv[ct];
            }
            ss += __shfl_xor(ss, 1); ss += __shfl_xor(ss, 2); ss += __shfl_xor(ss, 4); ss += __shfl_xor(ss, 8);
            const float rn = rsqrtf(ss * (1.f / 64.f) + 1e-6f);
#pragma unroll
            for (int ct = 0; ct < 4; ++ct) {
                const int d = 16 * ct + lc;
                Y[(tok0 + t) * DM + g * 64 + d] = f2bf(yv[ct] * rn * ogv[ct]);
            }
        }
    }
}

#ifndef ONLY_Q
#define ONLY_Q -2
#endif
#ifndef QMASK
#define QMASK 0x3ff
#endif
#define QON(k) ((ONLY_Q == -2 && ((QMASK >> ((k) + 1)) & 1)) || ONLY_Q == (k))
#ifndef DUPMASK
#define DUPMASK 0
#endif
#define DUP(k) ((DUPMASK >> (k)) & 1)
#ifndef PROF_LO
#define PROF_LO -1
#endif
#ifndef PROF_HI
#define PROF_HI -1
#endif
#ifndef WS_PROBE_PAD
#define WS_PROBE_PAD 0
#endif
#ifndef NPH_TOTAL
#define NPH_TOTAL 19
#endif
__global__ void __launch_bounds__(NTHR, 2) k_mega(P p0) {
    extern __shared__ __attribute__((aligned(16))) unsigned char lds_raw[];
    LAS unsigned char* lds = (LAS unsigned char*)lds_raw;
    float* smem = (float*)lds_raw;
    volatile LAS unsigned* misc = (volatile LAS unsigned*)(lds + LDS_MISC);
    if (threadIdx.x < 16) misc[threadIdx.x] = 0u;
    __syncthreads();
    const int wv0 = __builtin_amdgcn_readfirstlane((int)(threadIdx.x >> 6));
    XcdBarrier bar = xcd_barrier_post(p0.ctl + CW_BAR, misc); bar.wv = wv0;
    if (PROF_LO >= 0 && blockIdx.x == 0 && threadIdx.x == 0) ((unsigned long long*)(p0.ctl + 8192))[0] = __builtin_amdgcn_s_memrealtime();
#pragma unroll 1
    for (int ph = 0; ph < p0.nph; ph++) {
        const int layer = ph == 0 ? 0 : (ph - 1) / 9, q = ph == 0 ? -1 : (ph - 1) % 9;
        const int dupm = p0.pad;
        KA ka; ka.wv = wv0;
#if defined(__HIP_DEVICE_COMPILE__)
        ka.p = (const __attribute__((address_space(4))) char*)__builtin_amdgcn_kernarg_segment_ptr();
        asm volatile("" : "+s"(ka.p));
#else
        ka.p = nullptr;
#endif
        const float* xin = layer == 0 ? PF(x) : PF(out);
        float* x1 = PF(out);
        if (q == -1 && QON(-1)) { for (int r = 0; r <= ((dupm >> 15) & 1); ++r) { phase_prologue(ka, 0, smem); __syncthreads(); } }
        else if (q == 0 && QON(0)) { for (int r = 0; r <= (dupm & 1); ++r) { phase_inproj(ka, layer, lds); __syncthreads(); } }
        else if (q == 1 && QON(1)) {
            const int nb1 = (int)gridDim.x > 32 ? 16 : 0, nwork = (int)gridDim.x - nb1;
            for (int r = 0; r <= ((dupm >> 12) & 1); ++r) { phase_compress2(ka, layer, lds); __syncthreads(); }
            for (int r = 0; r <= ((dupm >> 10) & 1); ++r) { phase_hgrnA(ka, layer, lds, nb1, nwork); __syncthreads(); }
            for (int r = 0; r <= ((dupm >> 11) & 1); ++r) { phase_gmlp2(ka, layer, lds, nb1, nwork); __syncthreads(); }
            for (int r = 0; r <= ((dupm >> 13) & 1); ++r) { phase_vtrans(ka, smem); __syncthreads(); }
        }
        else if (q == 2 && QON(2)) { for (int r = 0; r <= ((dupm >> 14) & 1); ++r) { phase_hgrnB(ka, layer); __syncthreads(); } for (int r = 0; r <= ((dupm >> 2) & 1); ++r) { phase_nsa2(ka, layer, lds); __syncthreads(); } phase_hgrnC(ka, layer, lds); __syncthreads(); }
        else if (q == 3) continue;
        else if (q == 4 && QON(4)) phase_outproj(ka, layer, xin, x1, lds);
        else if (q == 5 && QON(5)) { for (int r = ((dupm >> 5) & 1); r >= 0; --r) { phase_ln1_route(ka, layer, x1, smem, r == 1); __syncthreads(); } }
        else if (q == 6 && QON(6)) { for (int r = 0; r <= ((dupm >> 6) & 1); ++r) { phase_moe_up(ka, layer, lds); __syncthreads(); } }
        else if (q == 7 && QON(7)) { for (int r = 0; r <= ((dupm >> 7) & 1); ++r) { phase_moe_down(ka, layer, lds); __syncthreads(); } }
        else if (q == 8 && QON(8)) { phase_ln2(ka, layer, x1, PF(out)); if (layer == 0) { __syncthreads(); phase_prologue(ka, 1, smem); } }
        if (ph != NPH_TOTAL - 1 || PROF_LO >= 0) xcd_barrier(bar);
        if (PROF_LO >= 0 && blockIdx.x == 0 && threadIdx.x == 0) ((unsigned long long*)(p0.ctl + 8192))[ph + 1] = __builtin_amdgcn_s_memrealtime();
    }

#ifdef STALE_PROBE
    {
        xcd_barrier(bar);
        const int G = gridDim.x, b = blockIdx.x, tid = threadIdx.x, partner = (b + 1) % G;
        unsigned* T = (unsigned*)p0.hgU;
        for (int arm = 0; arm < 2; ++arm) for (int i = tid; i < 4096; i += NTHR) T[((size_t)(arm * G + b)) * 4096 + i] = 1000u + b;
        xcd_barrier(bar);
        unsigned sink = 0;
        for (int rep = 0; rep < 4; ++rep) for (int i = tid; i < 4096; i += NTHR) sink += T[(size_t)partner * 4096 + i];
        for (int rep = 0; rep < 4; ++rep) {
            for (int i = 0; i < 2; ++i) __builtin_amdgcn_global_load_lds((const unsigned*)(T + ((size_t)(G + partner)) * 4096 + (i * 512 + tid) * 4), (LAS unsigned*)(lds + i * 8192 + wv0 * 1024), 16, 0, 0);
            asm volatile("s_waitcnt vmcnt(0)" ::: "memory");
        }
        asm volatile("" :: "v"(sink));
        xcd_barrier(bar);
        for (int arm = 0; arm < 2; ++arm) for (int i = tid; i < 4096; i += NTHR) T[((size_t)(arm * G + b)) * 4096 + i] = 2000u + b;
        xcd_barrier(bar);
        unsigned bad0 = 0, bad1 = 0;
        for (int i = tid; i < 4096; i += NTHR) bad0 += (T[(size_t)partner * 4096 + i] != 2000u + partner);
        for (int i = 0; i < 2; ++i) __builtin_amdgcn_global_load_lds((const unsigned*)(T + ((size_t)(G + partner)) * 4096 + (i * 512 + tid) * 4), (LAS unsigned*)(lds + i * 8192 + wv0 * 1024), 16, 0, 0);
        asm volatile("s_waitcnt vmcnt(0)" ::: "memory");
        __syncthreads();
        for (int i = tid; i < 4096; i += NTHR) bad1 += (((LAS unsigned*)lds)[i] != 2000u + partner);
        unsigned* cnt2 = p0.ctl + 12288;
        if (bad0) atomicAdd(&cnt2[0], bad0);
        if (bad1) atomicAdd(&cnt2[64], bad1);
        xcd_barrier(bar);
        const unsigned c0 = __hip_atomic_load(&cnt2[0], __ATOMIC_RELAXED, __HIP_MEMORY_SCOPE_AGENT), c1 = __hip_atomic_load(&cnt2[64], __ATOMIC_RELAXED, __HIP_MEMORY_SCOPE_AGENT);
        const float fac = 1.f + (c0 ? 1.f : 0.f) + (c1 ? 2.f : 0.f);
        for (size_t i = (size_t)blockIdx.x * NTHR + threadIdx.x; i < (size_t)NTOK * DM; i += (size_t)gridDim.x * NTHR) p0.out[i] = fac;
    }
#endif
    if (PROF_LO >= 0) {
        xcd_barrier(bar);
        const unsigned long long* ts = (const unsigned long long*)(p0.ctl + 8192);
        const unsigned long long t0 = __hip_atomic_load(&ts[PROF_LO], __ATOMIC_RELAXED, __HIP_MEMORY_SCOPE_AGENT), t1 = __hip_atomic_load(&ts[PROF_HI + 1], __ATOMIC_RELAXED, __HIP_MEMORY_SCOPE_AGENT);
        const float fac = 1.f + 1e-5f * (float)(t1 - t0);
        for (size_t i = (size_t)blockIdx.x * NTHR + threadIdx.x; i < (size_t)NTOK * DM; i += (size_t)gridDim.x * NTHR) p0.out[i] *= fac;
    }
}

static inline size_t align_up(size_t v, size_t a) { return (v + a - 1) / a * a; }

extern "C" void kernel_launch(void* const* d_in, const int* in_sizes, int n_in, void* d_out, int out_size, void* d_ws,
                              size_t ws_size, hipStream_t stream) {
    P p{};
    p.x = (const float*)d_in[0]; p.w_in = (const float*)d_in[1]; p.gm_v_gain = (const float*)d_in[2];
    p.gm_v_bias = (const float*)d_in[3]; p.gm_w_s = (const float*)d_in[4]; p.gm_b_s = (const float*)d_in[5];
    p.cmp_pos = (const float*)d_in[6]; p.cmp_w1 = (const float*)d_in[7]; p.cmp_w2 = (const float*)d_in[8];
    p.nsa_gate_b = (const float*)d_in[9]; p.hg_lower = (const float*)d_in[10]; p.out_gain = (const float*)d_in[11];
    p.w_out = (const float*)d_in[12]; p.ln1_g = (const float*)d_in[13]; p.ln1_b = (const float*)d_in[14];
    p.rg_w = (const float*)d_in[15]; p.rg_b = (const float*)d_in[16]; p.re_w = (const float*)d_in[17];
    p.re_b = (const float*)d_in[18]; p.w_gate = (const float*)d_in[19]; p.w_up = (const float*)d_in[20];
    p.w_down = (const float*)d_in[21]; p.ln2_g = (const float*)d_in[22]; p.ln2_b = (const float*)d_in[23];
    p.out = (float*)d_out;
    char* ws = (char*)d_ws;
    size_t off = 0;
    p.ctl = (unsigned*)(ws + off); off = align_up(off + CTL_BYTES, 256);
    p.WT = (bf16_t*)(ws + off); off = align_up(off + WT_LAYER * 2, 256);
    p.H = (bf16_t*)(ws + off); off = align_up(off + (size_t)(NTOK + 64) * HLD * 2, 256);
    p.Y = (bf16_t*)(ws + off); off = align_up(off + (size_t)NTOK * DM * 2, 256);
    p.XB = (bf16_t*)(ws + off); off = align_up(off + (size_t)NTOK * DM * 2, 256);
    p.kcb = (bf16_t*)(ws + off); off = align_up(off + 2 * ((size_t)4 * 512 * 64 * 2), 256);
    p.vcT = (bf16_t*)(ws + off); off = align_up(off + 2 * ((size_t)4 * 64 * 512 * 2), 256);
    p.vsT = (bf16_t*)(ws + off); off = align_up(off + (size_t)4 * 64 * T_ * 2, 256);
    p.vwT = (bf16_t*)(ws + off); off = align_up(off + (size_t)4 * 64 * T_ * 2, 256);
    p.gb = (bf16_t*)(ws + off); off = align_up(off + 2 * ((size_t)8 * 512 * 128 * 2), 256);
    p.cbias = (float*)(ws + off); off = align_up(off + 2 * (256 * 4), 256);
    p.wrt = (float*)(ws + off); off = align_up(off + 2 * (20 * 1024 * 4), 256);
    p.list_tok = (int*)(ws + off); off = align_up(off + 2 * ((size_t)16 * NTOK * 4), 256);
    p.list_w = (float*)(ws + off); off = align_up(off + 2 * ((size_t)16 * NTOK * 4), 256);
    p.tok_slot = (int*)(ws + off); off = align_up(off + 2 * ((size_t)NTOK * 2 * 4), 256);
    p.hgU = (float*)(ws + off); off = align_up(off + (size_t)1024 * 4096 * 4, 256);
    p.hgS = (float*)(ws + off); off = align_up(off + (size_t)1024 * 4096 * 4, 256);
    p.hgG = (float*)(ws + off); off = align_up(off + 2 * ((size_t)1024 * 64 * 4), 256);
    p.hgQB = (bf16_t*)(ws + off); off = align_up(off + (size_t)1024 * 4096 * 2, 256);
    p.hgO = (bf16_t*)(ws + off); off = align_up(off + (size_t)1024 * 4096 * 2, 256);
#ifdef STALE_PROBE
    p.nph = 0; p.pad = 0;
#else
    p.nph = NPH_TOTAL; p.pad = DUPMASK;
#endif
    (void)in_sizes; (void)n_in; (void)out_size;
    static int grid_blocks = 0;
    if (!grid_blocks) {
        int dev = 0, cus = 0, per_cu = 0;
        (void)hipGetDevice(&dev);
        (void)hipDeviceGetAttribute(&cus, hipDeviceAttributeMultiprocessorCount, dev);
        if (hipFuncSetAttribute((const void*)k_mega, hipFuncAttributeMaxDynamicSharedMemorySize, LDS_BYTES) != hipSuccess) { fprintf(stderr, "hipFuncSetAttribute failed\n"); grid_blocks = -1; return; }
        if (hipOccupancyMaxActiveBlocksPerMultiprocessor(&per_cu, (const void*)k_mega, NTHR, LDS_BYTES) != hipSuccess || per_cu < 1) { fprintf(stderr, "occupancy query says %d\n", per_cu); }
        (void)hipGetLastError();
        grid_blocks = cus;
        off += (size_t)WS_PROBE_PAD;
        if (off > ws_size) { fprintf(stderr, "workspace too small: need %zu have %zu\n", off, ws_size); grid_blocks = -1; }
    }
    if (grid_blocks < 0) return;
    (void)hipMemsetAsync(p.ctl, 0, CTL_BYTES, stream);
    void* args[] = {&p};
    hipError_t e = hipLaunchCooperativeKernel((const void*)k_mega, dim3(grid_blocks), dim3(NTHR), args, LDS_BYTES, stream);
    if (e != hipSuccess) fprintf(stderr, "cooperative launch failed: %s (grid %d)\n", hipGetErrorString(e), grid_blocks);
}
```
